# Optimizing an MI355X kernel written in HIP

```python
import math
import jax
import jax.numpy as jnp
from jax import lax
import numpy as np

D_MODEL = 2048
BATCH = 8
SEQ = 2048
DEPTH = 2

GRID_W = 64
CTX_LEN = 256
EPS = 1e-6
N_MOD = 6

D_MIX = D_MODEL
HY_W = D_MIX // 4
MLA_NOPE = 128
MLA_ROPE = 64
MLA_V = 128
MLA_HEADS = (D_MIX - HY_W) // 2 // MLA_V
MLA_Q_RANK = 3 * D_MODEL // 8
MLA_KV_RANK = D_MODEL // 8
GQA_HEAD_DIM = 128
GQA_HEADS = (D_MIX - HY_W) // 2 // GQA_HEAD_DIM
GQA_KV_HEADS = 2

HY_ORDER = 2
HY_SHORT = 3
HY_BANDS = 16
HY_POS_DIM = 1 + 2 * HY_BANDS
HY_FILTER_HIDDEN = 64
HY_TARGET = 1e-2
HY_FAST = 0.3
HY_SLOW = 1.5

ROPE_THETA = 10000.0
Q_BLOCK = 128

N_EXPERTS = 64
TOP_K = 6
N_GROUPS = 8
TOPK_GROUPS = 4
EXPERT_HIDDEN = D_MODEL // 4
ROUTED_SCALE = 2.5
MOE_BLOCK = 256

HY_COLS = 3 * HY_W
GQA_Q_COLS = GQA_HEADS * GQA_HEAD_DIM
GQA_KV_COLS = GQA_KV_HEADS * GQA_HEAD_DIM
KV_START = HY_COLS + MLA_Q_RANK + GQA_Q_COLS
IN_COLS = KV_START + MLA_KV_RANK + MLA_ROPE + 2 * GQA_KV_COLS
Q_SPLITS = (HY_COLS, HY_COLS + MLA_Q_RANK)
KV_SPLITS = (MLA_KV_RANK, MLA_KV_RANK + MLA_ROPE, MLA_KV_RANK + MLA_ROPE + GQA_KV_COLS)

kernel_name = "hybrid_dit_hyena_mla_gqa_moe"

F32 = jnp.float32


def rmsnorm(x, g):
    xf = x.astype(F32)
    y = xf * lax.rsqrt(jnp.mean(xf * xf, axis=-1, keepdims=True) + EPS)
    return (y * g.astype(F32)).astype(x.dtype)


def modulate(h, shift, scale):
    return h * (1 + scale) + shift


def adaln(s, w, b):
    m = (s @ w + b).reshape(s.shape[0], N_MOD, -1)
    return tuple(m[:, i, None, :] for i in range(N_MOD))


def swiglu(x, wg, wu, wd):
    return (jax.nn.silu(x @ wg) * (x @ wu)) @ wd


def axial_angles(n, rot_dim):
    rows = n // GRID_W
    row = jnp.repeat(jnp.arange(rows, dtype=F32), GRID_W)
    col = jnp.tile(jnp.arange(GRID_W, dtype=F32), rows)
    axis_dim = rot_dim // 2
    inv = ROPE_THETA ** (-jnp.arange(0, axis_dim, 2, dtype=F32) / axis_dim)
    return (row[:, None] * inv, col[:, None] * inv)


def rotate_half(x, ang):
    x1, x2 = jnp.split(x.astype(F32), 2, axis=-1)
    cos = jnp.cos(ang)[:, None, :]
    sin = jnp.sin(ang)[:, None, :]
    return jnp.concatenate([x1 * cos - x2 * sin, x1 * sin + x2 * cos], axis=-1)


def rope_2d(x, ang):
    ang_row, ang_col = ang
    xr, xc = jnp.split(x, 2, axis=-1)
    return jnp.concatenate([rotate_half(xr, ang_row), rotate_half(xc, ang_col)], axis=-1).astype(x.dtype)


def attend(q, k, v, scale):
    bsz, lq, h, dk = q.shape
    g = k.shape[2]
    qg = q.reshape(bsz, lq, g, h // g, dk)
    s = jnp.einsum('bqgrd,bkgd->bgrqk', qg, k, preferred_element_type=F32) * scale
    p = jax.nn.softmax(s, axis=-1)
    o = jnp.einsum('bgrqk,bkgd->bqgrd', p.astype(v.dtype), v)
    return o.reshape(bsz, lq, h, v.shape[-1])


def attend_blocked(q, k, v, scale):
    bsz, lq, h, dk = q.shape
    nb = lq // Q_BLOCK
    qb = q.reshape(bsz, nb, Q_BLOCK, h, dk).transpose(1, 0, 2, 3, 4)
    ob = lax.map(lambda qi: attend(qi, k, v, scale), qb)
    return ob.transpose(1, 0, 2, 3, 4).reshape(bsz, lq, h, v.shape[-1])


def short_conv(u, w):
    up = jnp.pad(u, ((0, 0), (1, 1), (0, 0)))
    return up[:, :-2] * w[0] + up[:, 1:-1] * w[1] + up[:, 2:] * w[2]


def hyena_filters(n, w1, b1, w2, b2, w3, freq):
    t = jnp.linspace(0.0, 1.0, n, dtype=F32)[:, None]
    ang = 2.0 * math.pi * jnp.arange(n, dtype=F32)[:, None] / n
    bands = jnp.linspace(1e-4, HY_BANDS - 1, HY_BANDS, dtype=F32)
    feats = jnp.concatenate([t, jnp.cos(ang * bands), jnp.sin(ang * bands)], axis=-1)
    fr = freq.astype(F32)
    hdn = jnp.sin(fr * (feats @ w1.astype(F32) + b1.astype(F32)))
    hdn = jnp.sin(fr * (hdn @ w2.astype(F32) + b2.astype(F32)))
    h = (hdn @ w3.astype(F32)).reshape(n, HY_ORDER, 2, HY_W)
    deltas = jnp.abs(jnp.linspace(math.log(HY_TARGET) / HY_SLOW, math.log(HY_TARGET) / HY_FAST, HY_W, dtype=F32))
    h = h * jnp.exp(-t * deltas)[:, None, None, :]
    h_fwd, h_bwd = h[:, :, 0], h[:, :, 1]
    k = jnp.concatenate([h_fwd, jnp.zeros_like(h_fwd[:1]), h_bwd[:0:-1]], axis=0)
    k = k * lax.rsqrt(jnp.sum(k * k, axis=0, keepdims=True) + EPS)
    return jnp.fft.rfft(k, n=2 * n, axis=0)


def long_conv(z, kf, skip):
    n = z.shape[1]
    zf32 = z.astype(F32)
    zf = jnp.fft.rfft(zf32, n=2 * n, axis=1)
    y = jnp.fft.irfft(zf * kf[None], n=2 * n, axis=1)[:, :n]
    return (y + zf32 * skip.astype(F32)).astype(z.dtype)


def hyena_mixer(u, conv_w, w1, b1, w2, b2, w3, freq, skip):
    n = u.shape[1]
    v, x1, x2 = jnp.split(short_conv(u, conv_w), 3, axis=-1)
    kf = hyena_filters(n, w1, b1, w2, b2, w3, freq)
    z = x1 * long_conv(v, kf[:, 0], skip[0])
    return x2 * long_conv(z, kf[:, 1], skip[1])


def mla_queries(cq, q_norm, w_uq, ang):
    bsz, n, _ = cq.shape
    q = (rmsnorm(cq, q_norm) @ w_uq).reshape(bsz, n, MLA_HEADS, MLA_NOPE + MLA_ROPE)
    if ang is None:
        return q
    return jnp.concatenate([q[..., :MLA_NOPE], rope_2d(q[..., MLA_NOPE:], ang)], axis=-1)


def mla_keys_values(ckv, k_rope, kv_norm, w_ukv, ang):
    bsz, n, _ = ckv.shape
    kv = (rmsnorm(ckv, kv_norm) @ w_ukv).reshape(bsz, n, MLA_HEADS, MLA_NOPE + MLA_V)
    k_nope, v = kv[..., :MLA_NOPE], kv[..., MLA_NOPE:]
    kr = k_rope[:, :, None, :]
    if ang is not None:
        kr = rope_2d(kr, ang)
    k = jnp.concatenate([k_nope, jnp.broadcast_to(kr, (bsz, n, MLA_HEADS, MLA_ROPE))], axis=-1)
    return k, v


def gqa_queries(q, q_norm, ang):
    bsz, n, _ = q.shape
    q = rmsnorm(q.reshape(bsz, n, GQA_HEADS, GQA_HEAD_DIM), q_norm)
    return q if ang is None else rope_2d(q, ang)


def gqa_keys_values(k, v, k_norm, ang):
    bsz, n, _ = k.shape
    k = rmsnorm(k.reshape(bsz, n, GQA_KV_HEADS, GQA_HEAD_DIM), k_norm)
    if ang is not None:
        k = rope_2d(k, ang)
    return k, v.reshape(bsz, n, GQA_KV_HEADS, GQA_HEAD_DIM)


def token_mixer(h_lat, h_ctx, ctx_out, w_in, w_out, hy_conv, hy_w1, hy_b1, hy_w2, hy_b2, hy_w3,
                hy_freq, hy_skip, mla_q_norm, mla_kv_norm, mla_w_uq, mla_w_ukv, gqa_q_norm, gqa_k_norm):
    bsz, n, _ = h_lat.shape
    ang_mla = axial_angles(n, MLA_ROPE)
    ang_gqa = axial_angles(n, GQA_HEAD_DIM)
    mla_scale = (MLA_NOPE + MLA_ROPE) ** -0.5
    gqa_scale = GQA_HEAD_DIM ** -0.5

    p_lat = h_lat @ w_in
    hy_lat, mq_lat, gq_lat = jnp.split(p_lat[..., :KV_START], Q_SPLITS, axis=-1)
    ckv_lat, kr_lat, gk_lat, gv_lat = jnp.split(p_lat[..., KV_START:], KV_SPLITS, axis=-1)
    if ctx_out:
        p_ctx = h_ctx @ w_in
        hy_ctx, mq_ctx, gq_ctx = jnp.split(p_ctx[..., :KV_START], Q_SPLITS, axis=-1)
        kv_ctx = p_ctx[..., KV_START:]
    else:
        kv_ctx = h_ctx @ w_in[:, KV_START:]
    ckv_ctx, kr_ctx, gk_ctx, gv_ctx = jnp.split(kv_ctx, KV_SPLITS, axis=-1)

    mk_ctx, mv_ctx = mla_keys_values(ckv_ctx, kr_ctx, mla_kv_norm, mla_w_ukv, None)
    mk_lat, mv_lat = mla_keys_values(ckv_lat, kr_lat, mla_kv_norm, mla_w_ukv, ang_mla)
    gk_c, gv_c = gqa_keys_values(gk_ctx, gv_ctx, gqa_k_norm, None)
    gk_l, gv_l = gqa_keys_values(gk_lat, gv_lat, gqa_k_norm, ang_gqa)

    mo = attend_blocked(mla_queries(mq_lat, mla_q_norm, mla_w_uq, ang_mla),
                        jnp.concatenate([mk_ctx, mk_lat], axis=1),
                        jnp.concatenate([mv_ctx, mv_lat], axis=1), mla_scale)
    go = attend_blocked(gqa_queries(gq_lat, gqa_q_norm, ang_gqa),
                        jnp.concatenate([gk_c, gk_l], axis=1),
                        jnp.concatenate([gv_c, gv_l], axis=1), gqa_scale)
    ho = hyena_mixer(hy_lat, hy_conv, hy_w1, hy_b1, hy_w2, hy_b2, hy_w3, hy_freq, hy_skip)
    out_lat = jnp.concatenate([ho, mo.reshape(bsz, n, -1), go.reshape(bsz, n, -1)], axis=-1) @ w_out
    if not ctx_out:
        return out_lat, None

    n_ctx = h_ctx.shape[1]
    mo_c = attend(mla_queries(mq_ctx, mla_q_norm, mla_w_uq, None), mk_ctx, mv_ctx, mla_scale)
    go_c = attend(gqa_queries(gq_ctx, gqa_q_norm, None), gk_c, gv_c, gqa_scale)
    ho_c = hyena_mixer(hy_ctx, hy_conv, hy_w1, hy_b1, hy_w2, hy_b2, hy_w3, hy_freq, hy_skip)
    out_ctx = jnp.concatenate([ho_c, mo_c.reshape(bsz, n_ctx, -1), go_c.reshape(bsz, n_ctx, -1)], axis=-1) @ w_out
    return out_lat, out_ctx


def moe_ffn(h, router_w, router_bias, w_gate, w_up, w_down, sh_gate, sh_up, sh_down):
    n_tok, d = h.shape
    scores = jax.nn.sigmoid((h @ router_w).astype(F32))
    biased = scores + router_bias.astype(F32)
    grp = biased.reshape(n_tok, N_GROUPS, N_EXPERTS // N_GROUPS)
    grp_score = lax.top_k(grp, 2)[0].sum(-1)
    _, g_idx = lax.top_k(grp_score, TOPK_GROUPS)
    g_mask = jax.nn.one_hot(g_idx, N_GROUPS, dtype=F32).sum(1) > 0
    e_mask = jnp.repeat(g_mask, N_EXPERTS // N_GROUPS, axis=1)
    _, e_idx = lax.top_k(jnp.where(e_mask, biased, -jnp.inf), TOP_K)
    gates = jnp.take_along_axis(scores, e_idx, axis=1)
    gates = gates / jnp.sum(gates, axis=-1, keepdims=True) * ROUTED_SCALE

    n_pairs = n_tok * TOP_K
    e_flat = e_idx.reshape(-1)
    tok_flat = jnp.repeat(jnp.arange(n_tok, dtype=jnp.int32), TOP_K)
    g_flat = gates.reshape(-1)
    order = jnp.argsort(e_flat)
    e_sorted = e_flat[order]
    counts = jnp.zeros((N_EXPERTS,), jnp.int32).at[e_flat].add(1)
    starts = jnp.cumsum(counts) - counts
    padded = (counts + MOE_BLOCK - 1) // MOE_BLOCK * MOE_BLOCK
    p_ends = jnp.cumsum(padded)
    p_starts = p_ends - padded
    dest = p_starts[e_sorted] + jnp.arange(n_pairs, dtype=jnp.int32) - starts[e_sorted]
    n_blocks = -(-n_pairs // MOE_BLOCK) + N_EXPERTS
    n_rows = n_blocks * MOE_BLOCK
    buf_tok = jnp.full((n_rows,), n_tok, jnp.int32).at[dest].set(tok_flat[order])
    buf_gate = jnp.zeros((n_rows,), F32).at[dest].set(g_flat[order])
    blk_start = jnp.arange(n_blocks, dtype=jnp.int32) * MOE_BLOCK
    blk_expert = jnp.minimum(jnp.searchsorted(p_ends, blk_start, side='right'), N_EXPERTS - 1)
    h_pad = jnp.concatenate([h, jnp.zeros((1, d), h.dtype)], axis=0)

    def expert_block(acc, blk):
        toks, wts, e = blk
        yb = swiglu(h_pad[toks], w_gate[e], w_up[e], w_down[e])
        return acc.at[toks].add(yb * wts[:, None].astype(yb.dtype)), None

    acc, _ = lax.scan(expert_block, jnp.zeros((n_tok + 1, d), h.dtype),
                      (buf_tok.reshape(n_blocks, MOE_BLOCK), buf_gate.reshape(n_blocks, MOE_BLOCK), blk_expert))
    return swiglu(h, sh_gate, sh_up, sh_down) + acc[:n_tok]


def setup_inputs(seed: int = 0) -> dict:
    key = jax.random.key(seed)
    ks = jax.random.split(key, 31)
    L = DEPTH

    def nrm(k, shape, scale):
        return jax.random.normal(k, shape, F32) * scale

    return {
        "x": nrm(ks[0], (BATCH, SEQ, D_MODEL), 1.0),
        "c": nrm(ks[1], (BATCH, D_MODEL), 1.0),
        "ctx": nrm(ks[2], (BATCH, CTX_LEN, D_MODEL), 1.0),
        "c_ctx": nrm(ks[3], (D_MODEL,), 1.0),
        "ada_w": nrm(ks[4], (L, D_MODEL, N_MOD * D_MODEL), 0.5 * D_MODEL ** -0.5),
        "ada_b": nrm(ks[5], (L, N_MOD * D_MODEL), 0.02),
        "norm_g": 1.0 + nrm(ks[6], (L, 4, D_MODEL), 0.05),
        "w_in": nrm(ks[7], (L, D_MODEL, IN_COLS), D_MODEL ** -0.5),
        "w_out": nrm(ks[8], (L, D_MIX, D_MODEL), D_MIX ** -0.5),
        "hy_conv": nrm(ks[9], (L, HY_SHORT, HY_COLS), HY_SHORT ** -0.5),
        "hy_w1": nrm(ks[10], (L, HY_POS_DIM, HY_FILTER_HIDDEN), HY_POS_DIM ** -0.5),
        "hy_b1": nrm(ks[11], (L, HY_FILTER_HIDDEN), 0.1),
        "hy_w2": nrm(ks[12], (L, HY_FILTER_HIDDEN, HY_FILTER_HIDDEN), HY_FILTER_HIDDEN ** -0.5),
        "hy_b2": nrm(ks[13], (L, HY_FILTER_HIDDEN), 0.1),
        "hy_w3": nrm(ks[14], (L, HY_FILTER_HIDDEN, HY_ORDER * 2 * HY_W), HY_FILTER_HIDDEN ** -0.5),
        "hy_freq": 1.0 + nrm(ks[15], (L, HY_FILTER_HIDDEN), 0.1),
        "hy_skip": nrm(ks[16], (L, HY_ORDER, HY_W), 0.1),
        "mla_q_norm": 1.0 + nrm(ks[17], (L, MLA_Q_RANK), 0.05),
        "mla_kv_norm": 1.0 + nrm(ks[18], (L, MLA_KV_RANK), 0.05),
        "mla_w_uq": nrm(ks[19], (L, MLA_Q_RANK, MLA_HEADS * (MLA_NOPE + MLA_ROPE)), MLA_Q_RANK ** -0.5),
        "mla_w_ukv": nrm(ks[20], (L, MLA_KV_RANK, MLA_HEADS * (MLA_NOPE + MLA_V)), MLA_KV_RANK ** -0.5),
        "gqa_q_norm": 1.0 + nrm(ks[21], (L, GQA_HEAD_DIM), 0.05),
        "gqa_k_norm": 1.0 + nrm(ks[22], (L, GQA_HEAD_DIM), 0.05),
        "router_w": nrm(ks[23], (L, D_MODEL, N_EXPERTS), D_MODEL ** -0.5),
        "router_bias": nrm(ks[24], (L, N_EXPERTS), 0.01),
        "exp_w_gate": nrm(ks[25], (L, N_EXPERTS, D_MODEL, EXPERT_HIDDEN), D_MODEL ** -0.5),
        "exp_w_up": nrm(ks[26], (L, N_EXPERTS, D_MODEL, EXPERT_HIDDEN), D_MODEL ** -0.5),
        "exp_w_down": nrm(ks[27], (L, N_EXPERTS, EXPERT_HIDDEN, D_MODEL), EXPERT_HIDDEN ** -0.5),
        "sh_w_gate": nrm(ks[28], (L, D_MODEL, EXPERT_HIDDEN), D_MODEL ** -0.5),
        "sh_w_up": nrm(ks[29], (L, D_MODEL, EXPERT_HIDDEN), D_MODEL ** -0.5),
        "sh_w_down": nrm(ks[30], (L, EXPERT_HIDDEN, D_MODEL), EXPERT_HIDDEN ** -0.5),
    }


def reference(x, c, ctx, c_ctx, ada_w, ada_b, norm_g, w_in, w_out, hy_conv, hy_w1, hy_b1, hy_w2, hy_b2,
              hy_w3, hy_freq, hy_skip, mla_q_norm, mla_kv_norm, mla_w_uq, mla_w_ukv, gqa_q_norm, gqa_k_norm,
              router_w, router_bias, exp_w_gate, exp_w_up, exp_w_down, sh_w_gate, sh_w_up, sh_w_down):
    bsz, n, d = x.shape
    n_ctx = ctx.shape[1]
    s_lat = jax.nn.silu(c)
    s_ctx = jax.nn.silu(c_ctx)[None]
    for l in range(DEPTH):
        last = l == DEPTH - 1
        sh_a, sc_a, g_a, sh_f, sc_f, g_f = adaln(s_lat, ada_w[l], ada_b[l])
        csh_a, csc_a, cg_a, csh_f, csc_f, cg_f = adaln(s_ctx, ada_w[l], ada_b[l])

        h_lat = modulate(rmsnorm(x, norm_g[l, 0]), sh_a, sc_a)
        h_ctx = modulate(rmsnorm(ctx, norm_g[l, 0]), csh_a, csc_a)
        mix_lat, mix_ctx = token_mixer(h_lat, h_ctx, not last, w_in[l], w_out[l], hy_conv[l], hy_w1[l],
                                       hy_b1[l], hy_w2[l], hy_b2[l], hy_w3[l], hy_freq[l], hy_skip[l],
                                       mla_q_norm[l], mla_kv_norm[l], mla_w_uq[l], mla_w_ukv[l],
                                       gqa_q_norm[l], gqa_k_norm[l])
        x = x + g_a * rmsnorm(mix_lat, norm_g[l, 1])

        f_lat = modulate(rmsnorm(x, norm_g[l, 2]), sh_f, sc_f).reshape(bsz * n, d)
        moe_args = (router_w[l], router_bias[l], exp_w_gate[l], exp_w_up[l], exp_w_down[l],
                    sh_w_gate[l], sh_w_up[l], sh_w_down[l])
        if last:
            y = moe_ffn(f_lat, *moe_args).reshape(bsz, n, d)
        else:
            ctx = ctx + cg_a * rmsnorm(mix_ctx, norm_g[l, 1])
            f_ctx = modulate(rmsnorm(ctx, norm_g[l, 2]), csh_f, csc_f).reshape(bsz * n_ctx, d)
            y_all = moe_ffn(jnp.concatenate([f_lat, f_ctx], axis=0), *moe_args)
            y = y_all[:bsz * n].reshape(bsz, n, d)
            ctx = ctx + cg_f * rmsnorm(y_all[bsz * n:].reshape(bsz, n_ctx, d), norm_g[l, 3])
        x = x + g_f * rmsnorm(y, norm_g[l, 3])
    return x
```

```cpp
#define MEGA 1
#include <hip/hip_runtime.h>
#include <stdint.h>
#include <stdio.h>

#define LAS __attribute__((address_space(3)))
typedef unsigned short bf16_t;
typedef short bf16x8 __attribute__((ext_vector_type(8)));
typedef short s16x4 __attribute__((ext_vector_type(4)));
typedef float f32x4 __attribute__((ext_vector_type(4)));
typedef float f32x16 __attribute__((ext_vector_type(16)));
typedef unsigned u32x4 __attribute__((ext_vector_type(4)));
typedef unsigned u32x2 __attribute__((ext_vector_type(2)));

constexpr int DM = 2048, NB = 8, SEQ = 2048, CTXL = 256, NLAT = NB * SEQ, NCTX = NB * CTXL, NTOK = NLAT + NCTX, NLAYER = 2;
constexpr int NP = 4096;
constexpr int C_CQ = 1536, C_GQ = 2304, C_CKV = 3072, C_KR = 3328, C_GK = 3392, C_GV = 3648, IN_COLS = 3904;
constexpr int NEXP = 64, TOPK = 6, EH = 512;
constexpr int LK = CTXL + SEQ;
constexpr int RSLOTS = 126976;
constexpr int NSLOTS = RSLOTS + NTOK;
constexpr int MAXTILES = NSLOTS / 256;
constexpr int NQP = 1280;
constexpr float EPS = 1e-6f;
constexpr int NTHREADS = 512;

constexpr size_t al256(size_t x) { return (x + 255) & ~(size_t)255; }
constexpr size_t O_CTL = 0;
constexpr size_t CTL_BYTES = 65536;
constexpr size_t O_MOD = O_CTL + CTL_BYTES;
constexpr size_t O_HSS = O_MOD + al256((size_t)NLAYER * 9 * 12288 * 4);
constexpr size_t ZERO_BYTES = O_HSS + al256((size_t)NLAYER * 2 * 2 * 512 * 4);
constexpr size_t O_HF = ZERO_BYTES;
constexpr size_t HF_L0 = (size_t)2 * 2 * 512 * 2048, HF_L1 = (size_t)2 * 2 * 512 * 256, HF_LAYER = HF_L0 + HF_L1;
constexpr size_t O_WIN = O_HF + al256(NLAYER * HF_LAYER * 4);
constexpr size_t O_WOUT = O_WIN + (size_t)NLAYER * NP * DM * 2;
constexpr size_t O_WUQ = O_WOUT + (size_t)NLAYER * DM * DM * 2;
constexpr size_t O_WUKV = O_WUQ + al256((size_t)NLAYER * NQP * 768 * 2);
constexpr size_t O_EGU = O_WUKV + al256((size_t)NLAYER * 1536 * 256 * 2);
constexpr size_t O_ED = O_EGU + (size_t)65 * 1024 * 2048 * 2;
constexpr size_t O_X = O_ED + (size_t)65 * 2048 * 512 * 2;
constexpr size_t O_H = O_X + (size_t)NTOK * DM * 4;
constexpr size_t O_EIDX = O_H + (size_t)NTOK * DM * 2;
constexpr size_t O_GATE = O_EIDX + (size_t)NTOK * 8 * 4;
constexpr size_t O_SLOT = O_GATE + (size_t)NTOK * 8 * 4;
constexpr size_t O_STOK = O_SLOT + (size_t)NTOK * 8 * 4;
constexpr size_t O_HID = O_STOK + al256((size_t)NSLOTS * 4);
constexpr size_t O_A = O_HID + (size_t)NSLOTS * EH * 2;
constexpr size_t O_P = O_A;
constexpr size_t O_QRAW = O_P + (size_t)NTOK * NP * 2;
constexpr size_t O_KVRAW = O_QRAW + (size_t)NTOK * NQP * 2;
constexpr size_t O_QM = O_KVRAW + (size_t)NTOK * 1536 * 2;
constexpr size_t O_QMC = O_QM + (size_t)NB * 6 * SEQ * 192 * 2;
constexpr size_t O_KM = O_QMC + (size_t)NB * 6 * CTXL * 192 * 2;
constexpr size_t O_VM = O_KM + (size_t)NB * 6 * LK * 192 * 2;
constexpr size_t O_QG = O_VM + (size_t)NB * 6 * LK * 128 * 2;
constexpr size_t O_QGC = O_QG + (size_t)NB * 6 * SEQ * 128 * 2;
constexpr size_t O_KG = O_QGC + (size_t)NB * 6 * CTXL * 128 * 2;
constexpr size_t O_VG = O_KG + (size_t)NB * 2 * LK * 128 * 2;
constexpr size_t O_VT = O_VG + (size_t)NB * 2 * LK * 128 * 2;
constexpr size_t O_X1T = O_VT + (size_t)512 * NTOK * 2;
constexpr size_t O_Y2T = O_X1T + (size_t)512 * NTOK * 2;
constexpr size_t O_MIX = O_Y2T + (size_t)512 * NTOK * 2;
constexpr size_t O_OUT = O_MIX + (size_t)NTOK * DM * 2;
constexpr size_t O_AEND = O_OUT + (size_t)NTOK * DM * 2;
constexpr size_t O_DOUT = O_A;
static_assert(O_DOUT + (size_t)NSLOTS * DM * 2 <= O_AEND, "DOUT must fit the mixer scratch region");
constexpr size_t WS_END = O_AEND;

constexpr int CW_BAR = 0;
constexpr int CW_CNT = 4096;
constexpr int CW_CUR = 4096 + 128;
constexpr int CW_Q = 4096 + 256;

constexpr int LDS_BYTES = 148480;
constexpr int LDS_MISC = 147456;
constexpr int LDS_TILES = 131072;

struct Params { const float* in[31]; float* out; unsigned char* ws; int layer; int pad; };

enum { I_X = 0, I_C, I_CTX, I_CCTX, I_ADAW, I_ADAB, I_NORMG, I_WIN, I_WOUT, I_HYCONV, I_HYW1, I_HYB1, I_HYW2, I_HYB2, I_HYW3, I_HYFREQ, I_HYSKIP,
       I_MQN, I_MKVN, I_WUQ, I_WUKV, I_GQN, I_GKN, I_RW, I_RB, I_EG, I_EU, I_EDN, I_SG, I_SU, I_SD };

__device__ __forceinline__ int otid() { int t = threadIdx.x; asm volatile("" : "+v"(t)); return t; }
__device__ __forceinline__ float bf2f(bf16_t v) { return __uint_as_float(((unsigned)v) << 16); }
__device__ __forceinline__ bf16_t f2bf(float f) { unsigned u = __float_as_uint(f); u += 0x7FFFu + ((u >> 16) & 1u); return (bf16_t)(u >> 16); }
__device__ __forceinline__ unsigned pk2(float lo, float hi) { unsigned r; asm volatile("v_cvt_pk_bf16_f32 %0, %1, %2" : "=v"(r) : "v"(lo), "v"(hi)); return r; }
__device__ __forceinline__ float wave_sum(float v) {
#pragma unroll
    for (int o = 32; o >= 1; o >>= 1) v += __shfl_xor(v, o);
    return v;
}
__device__ __forceinline__ float rdlane(float v, int l) { return __int_as_float(__builtin_amdgcn_readlane(__float_as_int(v), l)); }
__device__ __forceinline__ float silu_f(float x) { return x / (1.0f + __expf(-x)); }
__device__ __forceinline__ const float* resid_src(const Params& p, int l, int row) {
    if (l == 0) return row < NLAT ? p.in[I_X] + (size_t)row * DM : p.in[I_CTX] + (size_t)(row - NLAT) * DM;
    return (const float*)(p.ws + O_X) + (size_t)row * DM;
}
__device__ __forceinline__ int row_batch(int row) { return row < NLAT ? row >> 11 : 8; }
#define ROWCOL(j, lane) ((j) * 256 + (lane) * 4)


struct GUnit { int arow0; const bf16_t* B; int orow0, ocol0; };
struct GemmDesc { const bf16_t* A; int lda; const int* ridx; int ldb; int K; };

struct EpiStoreBf16 {
    bf16_t* O; int ldo;
    __device__ __forceinline__ void operator()(const f32x4 (&acc)[2][2][4][2], const GUnit& u, int wr, int wc, int fr, int fq) const {
#pragma unroll
        for (int ai = 0; ai < 2; ++ai)
#pragma unroll
            for (int m = 0; m < 4; ++m) {
                bf16_t* rowp = O + (size_t)(u.orow0 + ai * 128 + wr * 64 + m * 16 + fr) * ldo + u.ocol0 + wc * 32 + 4 * fq;
#pragma unroll
                for (int bj = 0; bj < 2; ++bj)
#pragma unroll
                    for (int n = 0; n < 2; ++n) { const f32x4 v = acc[ai][bj][m][n]; u32x2 w; w.x = pk2(v[0], v[1]); w.y = pk2(v[2], v[3]); *(u32x2*)(rowp + bj * 128 + n * 16) = w; }
            }
    }
};
struct EpiSwiGLU {
    bf16_t* O;
    __device__ __forceinline__ void operator()(const f32x4 (&acc)[2][2][4][2], const GUnit& u, int wr, int wc, int fr, int fq) const {
#pragma unroll
        for (int ai = 0; ai < 2; ++ai)
#pragma unroll
            for (int m = 0; m < 4; ++m) {
                bf16_t* rowp = O + (size_t)(u.orow0 + ai * 128 + wr * 64 + m * 16 + fr) * EH + u.ocol0 + wc * 32 + 4 * fq;
#pragma unroll
                for (int n = 0; n < 2; ++n) { const f32x4 g = acc[ai][0][m][n], up = acc[ai][1][m][n]; float h[4];
#pragma unroll
                    for (int j = 0; j < 4; ++j) h[j] = silu_f(g[j]) * up[j];
                    u32x2 w; w.x = pk2(h[0], h[1]); w.y = pk2(h[2], h[3]); *(u32x2*)(rowp + n * 16) = w; }
            }
    }
};

template <class Epi>
__device__ __forceinline__ void gemm_unit_simple(const GemmDesc& g, const GUnit& u, const Epi& E) {
    int tid = otid();
    const int wid = tid >> 6, lane = tid & 63, wr = wid >> 2, wc = wid & 3, fr = lane & 15, fq = lane >> 4;
    f32x4 acc[2][2][4][2];
#pragma unroll
    for (int a = 0; a < 2; ++a)
#pragma unroll
        for (int b = 0; b < 2; ++b)
#pragma unroll
            for (int m = 0; m < 4; ++m)
#pragma unroll
                for (int n = 0; n < 2; ++n) acc[a][b][m][n] = (f32x4){0.f, 0.f, 0.f, 0.f};
    const bf16_t* ap[2][4]; const bf16_t* bp[2][2];
#pragma unroll
    for (int ai = 0; ai < 2; ++ai)
#pragma unroll
        for (int m = 0; m < 4; ++m) { const int r = u.arow0 + ai * 128 + wr * 64 + m * 16 + fr; int src = g.ridx ? g.ridx[r] : r; if (src < 0) src = 0; ap[ai][m] = g.A + (size_t)src * g.lda + 8 * fq; }
#pragma unroll
    for (int bj = 0; bj < 2; ++bj)
#pragma unroll
        for (int n = 0; n < 2; ++n) bp[bj][n] = u.B + (size_t)(bj * 128 + wc * 32 + n * 16 + fr) * g.ldb + 8 * fq;
    int Kq = g.K; asm volatile("" : "+s"(Kq));
#pragma unroll 1
    for (int k0 = 0; k0 < Kq; k0 += 32) {
        bf16x8 a[2][4], b[2][2];
#pragma unroll
        for (int ai = 0; ai < 2; ++ai)
#pragma unroll
            for (int m = 0; m < 4; ++m) a[ai][m] = *(const bf16x8*)(ap[ai][m] + k0);
#pragma unroll
        for (int bj = 0; bj < 2; ++bj)
#pragma unroll
            for (int n = 0; n < 2; ++n) b[bj][n] = *(const bf16x8*)(bp[bj][n] + k0);
#pragma unroll
        for (int ai = 0; ai < 2; ++ai)
#pragma unroll
            for (int bj = 0; bj < 2; ++bj)
#pragma unroll
                for (int m = 0; m < 4; ++m)
#pragma unroll
                    for (int n = 0; n < 2; ++n) acc[ai][bj][m][n] = __builtin_amdgcn_mfma_f32_16x16x32_bf16(b[bj][n], a[ai][m], acc[ai][bj][m][n], 0, 0, 0);
    }
    E(acc, u, wr, wc, fr, fq);
}

struct DenseSched {
    const bf16_t* Bt; int ldb, nM, nN, row0, pn0;
    __device__ __forceinline__ int count() const { return nM * nN; }
    __device__ __forceinline__ void unit(int i, GUnit& u) const { const int pm = i / nN, pn = pn0 + i % nN; u.arow0 = row0 + pm * 256; u.B = Bt + (size_t)pn * 256 * ldb; u.orow0 = u.arow0; u.ocol0 = pn * 256; }
};
struct MoeSched {
    const LAS int* te; const LAS int* ts; int ntiles, npn; const bf16_t* Bt; size_t estride; int ldb, ocolw;
    __device__ __forceinline__ int count() const { return ntiles * npn; }
    __device__ __forceinline__ void unit(int i, GUnit& u) const { const int t = i / npn, pn = i % npn; const int e = te[t]; u.arow0 = ts[t]; u.B = Bt + (size_t)e * estride + (size_t)pn * 256 * ldb; u.orow0 = u.arow0; u.ocol0 = pn * ocolw; }
};
template <class Sched, class Epi>
__device__ __forceinline__ void gemm_phase_simple(const GemmDesc& g, const Sched& S, const Epi& E) {
    const int n = S.count();
    for (int i = blockIdx.x; i < n; i += gridDim.x) { GUnit u; S.unit(i, u); gemm_unit_simple(g, u, E); }
}
__device__ __forceinline__ int moe_build_tiles(const unsigned* cnt, int nshared, LAS int* te, LAS int* ts, LAS int* misc) {
    __syncthreads();
    if (otid() == 0) {
        int nt = 0, run = 0;
        for (int e = 0; e < NEXP; ++e) { const int c = (int)cnt[e], ntile = (c + 255) >> 8; for (int j = 0; j < ntile; ++j) { te[nt] = e; ts[nt] = run + j * 256; ++nt; } run += ntile * 256; }
        for (int j = 0; j < nshared; ++j) { te[nt] = NEXP; ts[nt] = RSLOTS + j * 256; ++nt; }
        misc[0] = nt;
    }
    __syncthreads();
    return misc[0];
}
#ifndef FAST_GEMM
#define FAST_GEMM 0
#endif
#if !FAST_GEMM
#define GEMM_PHASE(g, S, E) gemm_phase_simple(g, S, E)
#endif

#define SBAR() __builtin_amdgcn_sched_barrier(0)
__device__ __forceinline__ int crow(int r, int hi) { return (r & 3) + 8 * (r >> 2) + 4 * hi; }
template <int DQK> __device__ __forceinline__ int kaddr(int row, int chunk) {
    const int sw = (DQK == 128) ? (row & 7) : ((row >> 1) & 7);
    return row * (DQK * 2) + ((chunk ^ sw) << 4);
}
__device__ __forceinline__ void partialSM(f32x16& p0, f32x16& p1, float& m_reg, float& mn, float& alpha, float C, float thr) {
    float pmax = p0[0];
#pragma unroll
    for (int r = 1; r < 16; ++r) pmax = fmaxf(pmax, p0[r]);
#pragma unroll
    for (int r = 0; r < 16; ++r) pmax = fmaxf(pmax, p1[r]);
    { auto rr = __builtin_amdgcn_permlane32_swap(__float_as_uint(pmax), __float_as_uint(pmax), false, false);
      pmax = fmaxf(__uint_as_float(rr[0]), __uint_as_float(rr[1])); }
    if (__builtin_expect(__all(pmax - m_reg <= thr), 1)) { mn = m_reg; alpha = 1.f; }
    else { mn = fmaxf(m_reg, pmax); alpha = __builtin_amdgcn_exp2f((m_reg - mn) * C); m_reg = mn; }
    const float mnC = -mn * C;
#pragma unroll
    for (int r = 0; r < 16; ++r) p0[r] = fmaf(p0[r], C, mnC);
#pragma unroll
    for (int r = 0; r < 16; ++r) p1[r] = fmaf(p1[r], C, mnC);
#pragma unroll
    for (int r = 0; r < 16; ++r) p0[r] = __builtin_amdgcn_exp2f(p0[r]);
}
__device__ __forceinline__ void finishSM(f32x16& p0, f32x16& p1, float alpha, float& l_reg, bf16x8& pa0, bf16x8& pa1, bf16x8& pa2, bf16x8& pa3) {
#pragma unroll
    for (int r = 0; r < 16; ++r) p1[r] = __builtin_amdgcn_exp2f(p1[r]);
    float ps = 0;
#pragma unroll
    for (int r = 0; r < 16; ++r) ps += p0[r];
#pragma unroll
    for (int r = 0; r < 16; ++r) ps += p1[r];
    { auto rr = __builtin_amdgcn_permlane32_swap(__float_as_uint(ps), __float_as_uint(ps), false, false);
      ps = __uint_as_float(rr[0]) + __uint_as_float(rr[1]); }
    l_reg = l_reg * alpha + ps;
#define PK4(P, BASE, OUT) do { unsigned a0 = pk2(P[BASE + 0], P[BASE + 1]), a1 = pk2(P[BASE + 2], P[BASE + 3]);   \
    unsigned b0 = pk2(P[BASE + 4], P[BASE + 5]), b1 = pk2(P[BASE + 6], P[BASE + 7]);                              \
    auto r0 = __builtin_amdgcn_permlane32_swap(a0, b0, false, false); auto r1 = __builtin_amdgcn_permlane32_swap(a1, b1, false, false); \
    u32x4 w = {r0[0], r1[0], r0[1], r1[1]}; OUT = *reinterpret_cast<bf16x8*>(&w); } while (0)
    PK4(p0, 0, pa0); PK4(p0, 8, pa1); PK4(p1, 0, pa2); PK4(p1, 8, pa3);
#undef PK4
}
template <int DQK> __device__ __forceinline__ void qkt(f32x16& p0, f32x16& p1, const char* Ks, const bf16x8* qr, int r32, int hi) {
    p0 = f32x16{}; p1 = f32x16{};
#pragma unroll
    for (int d0 = 0; d0 < DQK / 16; ++d0) { const int ch = 2 * d0 + hi;
        const bf16x8 b0 = *reinterpret_cast<const bf16x8*>(Ks + kaddr<DQK>(r32, ch));
        const bf16x8 b1 = *reinterpret_cast<const bf16x8*>(Ks + kaddr<DQK>(32 + r32, ch));
        p0 = __builtin_amdgcn_mfma_f32_32x32x16_bf16(b0, qr[d0], p0, 0, 0, 0);
        p1 = __builtin_amdgcn_mfma_f32_32x32x16_bf16(b1, qr[d0], p1, 0, 0, 0); }
}
__device__ __forceinline__ int v_st(int k, int c) { const int kk = (k & ~0xC) | ((k & 4) << 1) | ((k & 8) >> 1); return ((kk >> 3) * 4 + (c >> 5)) * 512 + ((kk & 7) * 32 + (c & 31)) * 2; }
__device__ __forceinline__ int v_rd_base(int lane) { return ((lane & 3) << 3) | (((lane >> 2) & 3) << 6) | (((lane >> 4) & 1) << 5) | (((lane >> 5) & 1) << 8); }
constexpr int v_rd_off(int d0, int ks, int half) { return d0 * 512 + ks * 4096 + half * 2048; }
template <int OFF> __device__ __forceinline__ s16x4 tr_read(int vb) {
    s16x4 r; asm volatile("ds_read_b64_tr_b16 %0, %1 offset:%2" : "=&v"(r) : "v"(vb), "i"(OFF) : "memory"); return r;
}
template <int D0> __device__ __forceinline__ void pv_one(f32x16& od, int vb, bf16x8 pa0, bf16x8 pa1, bf16x8 pa2, bf16x8 pa3) {
    const s16x4 l0 = tr_read<v_rd_off(D0, 0, 0)>(vb), h0 = tr_read<v_rd_off(D0, 0, 1)>(vb), l1 = tr_read<v_rd_off(D0, 1, 0)>(vb), h1 = tr_read<v_rd_off(D0, 1, 1)>(vb);
    const s16x4 l2 = tr_read<v_rd_off(D0, 2, 0)>(vb), h2 = tr_read<v_rd_off(D0, 2, 1)>(vb), l3 = tr_read<v_rd_off(D0, 3, 0)>(vb), h3 = tr_read<v_rd_off(D0, 3, 1)>(vb);
    asm volatile("s_waitcnt lgkmcnt(0)" ::: "memory"); SBAR();
#define PK(L, H) (bf16x8){L[0], L[1], L[2], L[3], H[0], H[1], H[2], H[3]}
    od = __builtin_amdgcn_mfma_f32_32x32x16_bf16(pa0, PK(l0, h0), od, 0, 0, 0);
    od = __builtin_amdgcn_mfma_f32_32x32x16_bf16(pa1, PK(l1, h1), od, 0, 0, 0);
    od = __builtin_amdgcn_mfma_f32_32x32x16_bf16(pa2, PK(l2, h2), od, 0, 0, 0);
    od = __builtin_amdgcn_mfma_f32_32x32x16_bf16(pa3, PK(l3, h3), od, 0, 0, 0);
#undef PK
}
__device__ __forceinline__ void pv_d0(f32x16* o, int vb, bf16x8 pa0, bf16x8 pa1, bf16x8 pa2, bf16x8 pa3) {
    pv_one<0>(o[0], vb, pa0, pa1, pa2, pa3); pv_one<1>(o[1], vb, pa0, pa1, pa2, pa3); pv_one<2>(o[2], vb, pa0, pa1, pa2, pa3); pv_one<3>(o[3], vb, pa0, pa1, pa2, pa3);
}

template <int DQK, int SDEPTH>
__device__ __forceinline__ void attn_body(const bf16_t* __restrict__ Qb, const bf16_t* __restrict__ Kh, const bf16_t* __restrict__ Vh, bf16_t* __restrict__ Ob, int ldo, int nkeys, float scale, char* lds) {
    constexpr int SHM_V = 64 * 128 * 2, SHM_K = 64 * DQK * 2, NKC = DQK / 8, KPT = NKC / 8;
    int tid = otid();
    const int wid = tid >> 6, lane = tid & 63, r32 = lane & 31, hi = lane >> 5;
    char* V_lds = lds; char* K_lds = lds + 2 * SHM_V;
    float* ws = (float*)(lds + 2 * SHM_V + 2 * SHM_K) + wid * 64; float* li_l = ws; float* al_l = ws + 32;
    const float C = scale * 1.4426950408889634f, thr = 8.0f / scale;
    float m_reg = -1e30f, l_reg = 0; f32x16 o[4] = {}; bf16x8 qr[DQK / 16];
    const bf16_t* Qw = Qb + (long)(wid * 32 + r32) * DQK + hi * 8;
#pragma unroll
    for (int d0 = 0; d0 < DQK / 16; ++d0) qr[d0] = *reinterpret_cast<const bf16x8*>(Qw + d0 * 16);
    const int sr = tid >> 4, sc = (tid & 15) * 8, vst0 = v_st(sr, sc), vst1 = v_st(32 + sr, sc);
    int kgo[KPT], klo[KPT];
#pragma unroll
    for (int i = 0; i < KPT; ++i) { const int q = tid + 512 * i, row = q / NKC, ch = q % NKC; kgo[i] = row * DQK + ch * 8; klo[i] = kaddr<DQK>(row, ch); }
    const int vb0 = (int)(uintptr_t)V_lds + v_rd_base(lane);
    struct { bf16x8 vs0, vs1, ks[KPT]; } sr_[SDEPTH ? SDEPTH : 1];
#define SLOAD(i, k0) do { sr_[i].vs0 = *reinterpret_cast<const bf16x8*>(&Vh[(long)((k0) + sr) * 128 + sc]); sr_[i].vs1 = *reinterpret_cast<const bf16x8*>(&Vh[(long)((k0) + 32 + sr) * 128 + sc]); \
    _Pragma("unroll") for (int _q = 0; _q < KPT; ++_q) sr_[i].ks[_q] = *reinterpret_cast<const bf16x8*>(&Kh[(long)(k0) * DQK + kgo[_q]]); } while (0)
#define SWRITE(b, i) do { *(bf16x8*)(V_lds + (b) * SHM_V + vst0) = sr_[i].vs0; *(bf16x8*)(V_lds + (b) * SHM_V + vst1) = sr_[i].vs1; \
    _Pragma("unroll") for (int _q = 0; _q < KPT; ++_q) *(bf16x8*)(K_lds + (b) * SHM_K + klo[_q]) = sr_[i].ks[_q]; } while (0)
#define SWAIT() do { if constexpr (SDEPTH == 2) { if constexpr (KPT == 2) asm volatile("s_waitcnt vmcnt(4)" ::: "memory"); else asm volatile("s_waitcnt vmcnt(5)" ::: "memory"); } \
    else asm volatile("s_waitcnt vmcnt(0)" ::: "memory"); } while (0)
#define RESC(a) do { if (__any((a) < 1.f)) { if (hi == 0) al_l[r32] = (a); asm volatile("s_waitcnt lgkmcnt(0)" ::: "memory"); \
    _Pragma("unroll") for (int d = 0; d < 4; ++d) _Pragma("unroll") for (int r = 0; r < 16; ++r) o[d][r] *= al_l[crow(r, hi)]; } } while (0)
    bf16x8 pa0, pa1, pa2, pa3; const int NT = nkeys / 64;
    if constexpr (SDEPTH == 0) {
        f32x16 pA0, pA1; float mnA, alA;
        SLOAD(0, 0); asm volatile("s_waitcnt vmcnt(0)" ::: "memory"); SWRITE(0, 0); __syncthreads();
        for (int j = 0; j < NT; ++j) {
            const int bo = j & 1;
            if (j + 1 < NT) SLOAD(0, (j + 1) * 64);
            SBAR(); qkt<DQK>(pA0, pA1, K_lds + bo * SHM_K, qr, r32, hi); partialSM(pA0, pA1, m_reg, mnA, alA, C, thr);
            RESC(alA); finishSM(pA0, pA1, alA, l_reg, pa0, pa1, pa2, pa3); SBAR();
            pv_d0(o, vb0 + bo * SHM_V, pa0, pa1, pa2, pa3);
            if (j + 1 < NT) { asm volatile("s_waitcnt vmcnt(0)" ::: "memory"); SWRITE(bo ^ 1, 0); }
            __syncthreads();
        }
    } else {
    f32x16 pA0, pA1, pB0, pB1; float mnA, mnB, alA, alB;
    constexpr int SE = 0, SO = SDEPTH - 1;
    SLOAD(SE, 0); asm volatile("s_waitcnt vmcnt(0)" ::: "memory"); SWRITE(0, SE); __syncthreads();
    qkt<DQK>(pA0, pA1, K_lds, qr, r32, hi); partialSM(pA0, pA1, m_reg, mnA, alA, C, thr);
    SLOAD(SO, 64); if constexpr (SDEPTH == 2) { if (2 < NT) SLOAD(SE, 2 * 64); }
    SWAIT(); SWRITE(1, SO); __syncthreads();
    for (int j = 1; j + 1 < NT; j += 2) {
        SBAR(); qkt<DQK>(pB0, pB1, K_lds + SHM_K, qr, r32, hi);
        finishSM(pA0, pA1, alA, l_reg, pa0, pa1, pa2, pa3); SBAR();
        SLOAD(SO, (j + SDEPTH) * 64); SBAR();
        pv_d0(o, vb0, pa0, pa1, pa2, pa3); partialSM(pB0, pB1, m_reg, mnB, alB, C, thr);
        __syncthreads(); SWAIT(); SWRITE(0, SE);
        RESC(alB); __syncthreads();
        SBAR(); qkt<DQK>(pA0, pA1, K_lds, qr, r32, hi);
        finishSM(pB0, pB1, alB, l_reg, pa0, pa1, pa2, pa3); SBAR();
        if (SDEPTH == 1 || j + 3 < NT) SLOAD(SE, (j + 1 + SDEPTH) * 64); SBAR();
        pv_d0(o, vb0 + SHM_V, pa0, pa1, pa2, pa3); partialSM(pA0, pA1, m_reg, mnA, alA, C, thr);
        __syncthreads(); SWAIT(); SWRITE(1, SO);
        RESC(alA); __syncthreads();
    }
    SBAR(); qkt<DQK>(pB0, pB1, K_lds + SHM_K, qr, r32, hi);
    finishSM(pA0, pA1, alA, l_reg, pa0, pa1, pa2, pa3); SBAR();
    pv_d0(o, vb0, pa0, pa1, pa2, pa3); partialSM(pB0, pB1, m_reg, mnB, alB, C, thr);
    __syncthreads(); RESC(alB);
    finishSM(pB0, pB1, alB, l_reg, pa0, pa1, pa2, pa3); SBAR();
    pv_d0(o, vb0 + SHM_V, pa0, pa1, pa2, pa3);
    }
    if (hi == 0) li_l[r32] = l_reg; asm volatile("s_waitcnt lgkmcnt(0)" ::: "memory");
    float rli[16];
#pragma unroll
    for (int r = 0; r < 16; ++r) rli[r] = __builtin_amdgcn_rcpf(li_l[crow(r, hi)]);
    bf16_t* Ow = Ob + (long)(wid * 32) * ldo;
#pragma unroll
    for (int r = 0; r < 16; ++r) { const int orow = crow(r, hi);
#pragma unroll
        for (int d0 = 0; d0 < 4; ++d0) Ow[(long)orow * ldo + d0 * 32 + r32] = f2bf(o[d0][r] * rli[r]); }
    __syncthreads();
#undef SLOAD
#undef SWRITE
#undef SWAIT
#undef RESC
}

__device__ __forceinline__ void cvt_tile(const float* __restrict__ src, int ldsrc, int k0, int n0, bf16_t* __restrict__ dst, int lddst, int drow0, const float* __restrict__ kscale, LAS float* tile) {
    int tid = otid();
    { const int r = tid >> 4, c4 = (tid & 15) * 4;
#pragma unroll
      for (int ps = 0; ps < 2; ++ps) { const int k = r + 32 * ps; const f32x4 v = *(const f32x4*)(src + (size_t)(k0 + k) * ldsrc + n0 + c4); const float s = kscale ? kscale[k0 + k] : 1.0f;
          tile[k * 65 + c4 + 0] = v[0] * s; tile[k * 65 + c4 + 1] = v[1] * s; tile[k * 65 + c4 + 2] = v[2] * s; tile[k * 65 + c4 + 3] = v[3] * s; } }
    __syncthreads();
    { const int n = tid >> 3, kc = (tid & 7) * 8; float v[8];
#pragma unroll
      for (int j = 0; j < 8; ++j) v[j] = tile[(kc + j) * 65 + n];
      u32x4 w; w.x = pk2(v[0], v[1]); w.y = pk2(v[2], v[3]); w.z = pk2(v[4], v[5]); w.w = pk2(v[6], v[7]);
      *(u32x4*)(dst + (size_t)(drow0 + n) * lddst + k0 + kc) = w; }
    __syncthreads();
}
constexpr int CVT_SMALL = 1952 + 1024 + 216 + 96;
__device__ __forceinline__ void cvt_small_task(const Params& p, int l, int t, LAS float* tile) {
    unsigned char* ws = p.ws;
    if (t < 1952) { const int kb = t / 61, nb = t % 61; cvt_tile(p.in[I_WIN] + (size_t)l * DM * IN_COLS, IN_COLS, kb * 64, nb * 64, (bf16_t*)(ws + O_WIN) + (size_t)l * NP * DM, DM, nb * 64, nullptr, tile); return; }
    t -= 1952;
    if (t < 1024) { const int kb = t >> 5, nb = t & 31; cvt_tile(p.in[I_WOUT] + (size_t)l * DM * DM, DM, kb * 64, nb * 64, (bf16_t*)(ws + O_WOUT) + (size_t)l * DM * DM, DM, nb * 64, nullptr, tile); return; }
    t -= 1024;
    if (t < 216) { const int kb = t / 18, nb = t % 18; cvt_tile(p.in[I_WUQ] + (size_t)l * 768 * 1152, 1152, kb * 64, nb * 64, (bf16_t*)(ws + O_WUQ) + (size_t)l * NQP * 768, 768, nb * 64, p.in[I_MQN] + l * 768, tile); return; }
    t -= 216;
    { const int kb = t / 24, nb = t % 24; cvt_tile(p.in[I_WUKV] + (size_t)l * 256 * 1536, 1536, kb * 64, nb * 64, (bf16_t*)(ws + O_WUKV) + (size_t)l * 1536 * 256, 256, nb * 64, p.in[I_MKVN] + l * 256, tile); }
}
constexpr int CVT_EXP = 65 * 768;
__device__ __forceinline__ void cvt_exp_task(const Params& p, int l, int t, LAS float* tile) {
    unsigned char* ws = p.ws;
    const int e = t / 768, r = t % 768, which = r >> 8, q = r & 255;
    bf16_t* gu = (bf16_t*)(ws + O_EGU) + (size_t)e * 1024 * 2048; bf16_t* dn = (bf16_t*)(ws + O_ED) + (size_t)e * 2048 * 512;
    if (which < 2) {
        const float* src = (e < NEXP) ? p.in[which == 0 ? I_EG : I_EU] + ((size_t)l * NEXP + e) * DM * EH : p.in[which == 0 ? I_SG : I_SU] + (size_t)l * DM * EH;
        const int kb = q >> 3, nb = q & 7, n0 = nb * 64;
        cvt_tile(src, EH, kb * 64, n0, gu, DM, (n0 >> 7) * 256 + (n0 & 127) + which * 128, nullptr, tile);
    } else {
        const float* src = (e < NEXP) ? p.in[I_EDN] + ((size_t)l * NEXP + e) * EH * DM : p.in[I_SD] + (size_t)l * EH * DM;
        const int kb = q >> 5, nb = q & 31;
        cvt_tile(src, DM, kb * 64, nb * 64, dn, EH, nb * 64, nullptr, tile);
    }
}
__device__ __forceinline__ void adaln_tasks(const Params& p, LAS float* lf) {
    const int lane = otid() & 63, wid = otid() >> 6;
    float* MOD = (float*)(p.ws + O_MOD);
    for (int task = blockIdx.x; task < 384; task += gridDim.x) {
        const int cb = task % 192, l = task / 192, col = cb * 64 + lane;
        const float* W = p.in[I_ADAW] + (size_t)l * DM * 12288 + col;
        float acc[9];
#pragma unroll
        for (int r = 0; r < 9; ++r) acc[r] = 0.f;
        for (int kb = wid * 256; kb < wid * 256 + 256; kb += 64) {
            float sv[9];
#pragma unroll
            for (int r = 0; r < 8; ++r) sv[r] = silu_f(p.in[I_C][r * DM + kb + lane]);
            sv[8] = silu_f(p.in[I_CCTX][kb + lane]);
#pragma unroll 8
            for (int kk = 0; kk < 64; ++kk) { const float w = W[(size_t)(kb + kk) * 12288];
#pragma unroll
                for (int r = 0; r < 9; ++r) acc[r] += rdlane(sv[r], kk) * w; }
        }
#pragma unroll
        for (int r = 0; r < 9; ++r) lf[(wid * 9 + r) * 64 + lane] = acc[r];
        __syncthreads();
        for (int r = wid; r < 9; r += 8) { float s = p.in[I_ADAB][l * 12288 + col];
#pragma unroll
            for (int w = 0; w < 8; ++w) s += lf[(w * 9 + r) * 64 + lane];
            MOD[(size_t)(l * 9 + r) * 12288 + col] = s; }
        __syncthreads();
    }
}
__device__ __forceinline__ void hss_tasks(const Params& p) {
    const int lane = otid() & 63, gw = blockIdx.x * 8 + (otid() >> 6), GW = gridDim.x * 8;
    for (int task = gw; task < 3 * 1024; task += GW) {
        const int set = task >> 10, l = (set == 1) ? 1 : 0, nset = (set == 2) ? 1 : 0, ord = (task >> 9) & 1, ch = task & 511, n = nset ? 256 : 2048;
        const float* HF = (const float*)(p.ws + O_HF) + (size_t)l * HF_LAYER + (nset ? HF_L0 : 0);
        const float* hf = HF + (size_t)((ord * 2 + 0) * 512 + ch) * n; const float* hb = HF + (size_t)((ord * 2 + 1) * 512 + ch) * n;
        float s = 0.f;
        for (int i = lane; i < n; i += 64) { const float a = hf[i], b = (i == 0) ? 0.f : hb[i]; s += a * a + b * b; }
        s = wave_sum(s);
        if (lane == 0) ((float*)(p.ws + O_HSS))[(size_t)((l * 2 + nset) * 2 + ord) * 512 + ch] = s;
    }
}
__device__ __forceinline__ void hyf_task(const Params& p, int l, int nset, int i0, LAS float* lf) {
    int tid = otid(); const int n = nset ? 256 : 2048;
    LAS float* feats = lf; LAS float* hd1 = lf + 8 * 33; LAS float* hd2 = hd1 + 512;
    if (tid < 8 * 33) { const int pos = tid / 33, f = tid % 33, i = i0 + pos; const float t = (float)i / (float)(n - 1), ang = 6.283185307179586f * (float)i / (float)n; float v;
        if (f == 0) v = t; else { const int j = (f - 1) & 15; const float band = 1e-4f + (float)j * ((15.0f - 1e-4f) / 15.0f); v = (f <= 16) ? cosf(ang * band) : sinf(ang * band); }
        feats[tid] = v; }
    __syncthreads();
    { const int pos = tid >> 6, j = tid & 63; const float* w1 = p.in[I_HYW1] + l * 33 * 64; float s = p.in[I_HYB1][l * 64 + j];
      for (int f = 0; f < 33; ++f) s += feats[pos * 33 + f] * w1[f * 64 + j];
      hd1[tid] = sinf(p.in[I_HYFREQ][l * 64 + j] * s); }
    __syncthreads();
    { const int pos = tid >> 6, j = tid & 63; const float* w2 = p.in[I_HYW2] + l * 64 * 64; float s = p.in[I_HYB2][l * 64 + j];
      for (int f = 0; f < 64; ++f) s += hd1[pos * 64 + f] * w2[f * 64 + j];
      hd2[tid] = sinf(p.in[I_HYFREQ][l * 64 + j] * s); }
    __syncthreads();
    const float* w3 = p.in[I_HYW3] + (size_t)l * 64 * 2048 + tid * 4;
    f32x4 acc[8];
#pragma unroll
    for (int q = 0; q < 8; ++q) acc[q] = (f32x4){0.f, 0.f, 0.f, 0.f};
    for (int j = 0; j < 64; ++j) { const f32x4 w = *(const f32x4*)(w3 + (size_t)j * 2048);
#pragma unroll
        for (int q = 0; q < 8; ++q) acc[q] += w * hd2[q * 64 + j]; }
    float* HF = (float*)(p.ws + O_HF) + (size_t)l * HF_LAYER + (nset ? HF_L0 : 0);
#pragma unroll
    for (int c = 0; c < 4; ++c) { const int col = tid * 4 + c, ord = col >> 10, dir = (col >> 9) & 1, ch = col & 511;
        const float delta = 3.0701134573253944f + (float)ch * ((15.350567286626973f - 3.0701134573253944f) / 511.0f); float v[8];
#pragma unroll
        for (int q = 0; q < 8; ++q) { const int i = i0 + q; const float t = (float)i / (float)(n - 1); v[q] = acc[q][c] * __expf(-t * delta); }
        float* dst = HF + (size_t)((ord * 2 + dir) * 512 + ch) * n + i0;
        *(f32x4*)dst = (f32x4){v[0], v[1], v[2], v[3]}; *(f32x4*)(dst + 4) = (f32x4){v[4], v[5], v[6], v[7]};    }
    __syncthreads();
}
__device__ __forceinline__ void phase_prologue(const Params& p, LAS unsigned char* lds) {
    const int tid = otid(); LAS float* lf = (LAS float*)lds;
    { const size_t gt = (size_t)blockIdx.x * NTHREADS + tid, GT = (size_t)gridDim.x * NTHREADS;
      for (int l = 0; l < NLAYER; ++l) {
          u32x4* z1 = (u32x4*)((bf16_t*)(p.ws + O_WIN) + ((size_t)l * NP + IN_COLS) * DM); const size_t n1 = (size_t)(NP - IN_COLS) * DM * 2 / 16;
          for (size_t i = gt; i < n1; i += GT) z1[i] = (u32x4){0u, 0u, 0u, 0u};
          u32x4* z2 = (u32x4*)((bf16_t*)(p.ws + O_WUQ) + ((size_t)l * NQP + 1152) * 768); const size_t n2 = (size_t)(NQP - 1152) * 768 * 2 / 16;
          for (size_t i = gt; i < n2; i += GT) z2[i] = (u32x4){0u, 0u, 0u, 0u};
      } }
    adaln_tasks(p, lf);
    for (int t = blockIdx.x; t < 544; t += gridDim.x) { if (t < 512) hyf_task(p, t >> 8, 0, (t & 255) * 8, lf); else hyf_task(p, 0, 1, (t - 512) * 8, lf); }
    for (int t = blockIdx.x; t < NLAYER * CVT_SMALL; t += gridDim.x) cvt_small_task(p, t / CVT_SMALL, t % CVT_SMALL, lf);
    for (int t = blockIdx.x; t < CVT_EXP; t += gridDim.x) cvt_exp_task(p, 0, t, lf);
}

__device__ __forceinline__ void norm1_row(const Params& p, int l, int row, const float (&x)[32], int lane) {
    float ss = 0.f;
#pragma unroll
    for (int i = 0; i < 32; ++i) ss += x[i] * x[i];
    ss = wave_sum(ss); const float rstd = rsqrtf(ss * (1.0f / DM) + EPS);
    const float* g = p.in[I_NORMG] + (size_t)(l * 4 + 0) * DM; const float* mod = (const float*)(p.ws + O_MOD) + (size_t)(l * 9 + row_batch(row)) * 12288;
    bf16_t* H = (bf16_t*)(p.ws + O_H) + (size_t)row * DM;
#pragma unroll
    for (int j = 0; j < 8; ++j) { const int c = ROWCOL(j, lane); const f32x4 gv = *(const f32x4*)(g + c), sh = *(const f32x4*)(mod + c), sc = *(const f32x4*)(mod + DM + c); float h[4];
#pragma unroll
        for (int q = 0; q < 4; ++q) h[q] = x[j * 4 + q] * rstd * gv[q] * (1.0f + sc[q]) + sh[q];
        u32x2 w; w.x = pk2(h[0], h[1]); w.y = pk2(h[2], h[3]); *(u32x2*)(H + c) = w; }
}
__device__ __forceinline__ void phase_norm1(const Params& p, int l) {
    const int lane = otid() & 63, gw = blockIdx.x * 8 + (otid() >> 6), GW = gridDim.x * 8;
    for (int row = gw; row < NTOK; row += GW) { const float* src = resid_src(p, l, row); float x[32];
#pragma unroll
        for (int j = 0; j < 8; ++j) { const f32x4 v = *(const f32x4*)(src + ROWCOL(j, lane)); x[j * 4] = v[0]; x[j * 4 + 1] = v[1]; x[j * 4 + 2] = v[2]; x[j * 4 + 3] = v[3]; }
        norm1_row(p, l, row, x, lane); }
}

template <int HALF> __device__ __forceinline__ float rope1(float x, int e, float a) {
    float s, c; sincosf(a, &s, &c); const float pr = __shfl_xor(x, HALF);
    return (e & HALF) ? pr * s + x * c : x * c - pr * s;
}
__device__ __forceinline__ void gqa_post_row(const Params& p, int l, int row, int lane) {
    const bf16_t* P = (const bf16_t*)(p.ws + O_P) + (size_t)row * NP;
    const bool isctx = row >= NLAT; const int b = isctx ? (row - NLAT) >> 8 : row >> 11, t = isctx ? (row - NLAT) & 255 : row & 2047;
    const float inv = exp2f(-(float)(lane & 31) * (13.287712379549449f / 32.0f));
    const float a0 = (float)(t >> 6) * inv, a1 = (float)(t & 63) * inv;
    const float* qn = p.in[I_GQN] + l * 128; const float* kn = p.in[I_GKN] + l * 128;
    for (int h = 0; h < 6; ++h) {
        float x0 = bf2f(P[C_GQ + h * 128 + lane]), x1 = bf2f(P[C_GQ + h * 128 + 64 + lane]);
        const float rstd = rsqrtf(wave_sum(x0 * x0 + x1 * x1) * (1.0f / 128.0f) + EPS);
        x0 *= rstd * qn[lane]; x1 *= rstd * qn[64 + lane];
        if (!isctx) { x0 = rope1<32>(x0, lane, a0); x1 = rope1<32>(x1, lane, a1); }
        bf16_t* dst = isctx ? (bf16_t*)(p.ws + O_QGC) + ((size_t)(b * 6 + h) * CTXL + t) * 128 : (bf16_t*)(p.ws + O_QG) + ((size_t)(b * 6 + h) * SEQ + t) * 128;
        dst[lane] = f2bf(x0); dst[64 + lane] = f2bf(x1);
    }
    const int kpos = isctx ? t : CTXL + t;
    for (int h = 0; h < 2; ++h) {
        float x0 = bf2f(P[C_GK + h * 128 + lane]), x1 = bf2f(P[C_GK + h * 128 + 64 + lane]);
        const float rstd = rsqrtf(wave_sum(x0 * x0 + x1 * x1) * (1.0f / 128.0f) + EPS);
        x0 *= rstd * kn[lane]; x1 *= rstd * kn[64 + lane];
        if (!isctx) { x0 = rope1<32>(x0, lane, a0); x1 = rope1<32>(x1, lane, a1); }
        bf16_t* kd = (bf16_t*)(p.ws + O_KG) + ((size_t)(b * 2 + h) * LK + kpos) * 128; kd[lane] = f2bf(x0); kd[64 + lane] = f2bf(x1);
        bf16_t* vd = (bf16_t*)(p.ws + O_VG) + ((size_t)(b * 2 + h) * LK + kpos) * 128; vd[lane] = P[C_GV + h * 128 + lane]; vd[64 + lane] = P[C_GV + h * 128 + 64 + lane];
    }
}
__device__ __forceinline__ void seq_of(int row, int& s0, int& n) { if (row < NLAT) { s0 = row & ~2047; n = SEQ; } else { s0 = NLAT + ((row - NLAT) & ~255); n = CTXL; } }
__device__ __forceinline__ void load_conv_tile(const bf16_t* P, int t0, int pc0, LAS float* u) {
    int s0, n; seq_of(t0, s0, n);
    for (int i = otid(); i < 66 * 64; i += NTHREADS) { const int r = i >> 6, c = i & 63, row = t0 - 1 + r;
        u[r * 65 + c] = (row >= s0 && row < s0 + n) ? bf2f(P[(size_t)row * NP + pc0 + c]) : 0.f; }
}
__device__ __forceinline__ void hy_prep_task(const Params& p, int l, int t0, int c0, LAS float* u) {
    const bf16_t* P = (const bf16_t*)(p.ws + O_P);
    load_conv_tile(P, t0, c0, u);
    __syncthreads();
    const int tid = otid(), c = tid >> 3, tc = (tid & 7) * 8; const float* cw = p.in[I_HYCONV] + (size_t)l * 3 * 1536 + c0 + c;
    const float w0 = cw[0], w1 = cw[1536], w2 = cw[3072]; float y[8];
#pragma unroll
    for (int j = 0; j < 8; ++j) y[j] = w0 * u[(tc + j) * 65 + c] + w1 * u[(tc + j + 1) * 65 + c] + w2 * u[(tc + j + 2) * 65 + c];
    const int ch = c0 + c; bf16_t* dst = (ch < 512 ? (bf16_t*)(p.ws + O_VT) + (size_t)ch * NTOK : (bf16_t*)(p.ws + O_X1T) + (size_t)(ch - 512) * NTOK) + t0 + tc;
    u32x4 w; w.x = pk2(y[0], y[1]); w.y = pk2(y[2], y[3]); w.z = pk2(y[4], y[5]); w.w = pk2(y[6], y[7]); *(u32x4*)dst = w;
    __syncthreads();
}
__device__ __forceinline__ void mla_post_row(const Params& p, int l, int row, int lane) {
    const bf16_t* P = (const bf16_t*)(p.ws + O_P) + (size_t)row * NP;
    const bool isctx = row >= NLAT; const int b = isctx ? (row - NLAT) >> 8 : row >> 11, t = isctx ? (row - NLAT) & 255 : row & 2047;
    float sq = 0.f, skv = 0.f;
#pragma unroll
    for (int j = 0; j < 12; ++j) { const float v = bf2f(P[C_CQ + j * 64 + lane]); sq += v * v; }
#pragma unroll
    for (int j = 0; j < 4; ++j) { const float v = bf2f(P[C_CKV + j * 64 + lane]); skv += v * v; }
    const float rq = rsqrtf(wave_sum(sq) * (1.0f / 768.0f) + EPS), rkv = rsqrtf(wave_sum(skv) * (1.0f / 256.0f) + EPS);
    const int half = lane >> 5, e = lane & 31;
    const float inv = exp2f(-(float)(e & 15) * (13.287712379549449f / 16.0f));
    const float ang = (float)(half ? (t & 63) : (t >> 6)) * inv;
    const bf16_t* QR = (const bf16_t*)(p.ws + O_QRAW) + (size_t)row * NQP; const bf16_t* KV = (const bf16_t*)(p.ws + O_KVRAW) + (size_t)row * 1536;
    float kr = bf2f(P[C_KR + lane]); if (!isctx) kr = rope1<16>(kr, e, ang);
    const bf16_t krb = f2bf(kr); const int kpos = isctx ? t : CTXL + t;
    for (int h = 0; h < 6; ++h) {
        bf16_t* qd = isctx ? (bf16_t*)(p.ws + O_QMC) + ((size_t)(b * 6 + h) * CTXL + t) * 192 : (bf16_t*)(p.ws + O_QM) + ((size_t)(b * 6 + h) * SEQ + t) * 192;
        qd[lane] = f2bf(bf2f(QR[h * 192 + lane]) * rq); qd[64 + lane] = f2bf(bf2f(QR[h * 192 + 64 + lane]) * rq);
        float qr = bf2f(QR[h * 192 + 128 + lane]) * rq; if (!isctx) qr = rope1<16>(qr, e, ang);
        qd[128 + lane] = f2bf(qr);
        bf16_t* kd = (bf16_t*)(p.ws + O_KM) + ((size_t)(b * 6 + h) * LK + kpos) * 192;
        kd[lane] = f2bf(bf2f(KV[h * 256 + lane]) * rkv); kd[64 + lane] = f2bf(bf2f(KV[h * 256 + 64 + lane]) * rkv); kd[128 + lane] = krb;
        bf16_t* vd = (bf16_t*)(p.ws + O_VM) + ((size_t)(b * 6 + h) * LK + kpos) * 128;
        vd[lane] = f2bf(bf2f(KV[h * 256 + 128 + lane]) * rkv); vd[64 + lane] = f2bf(bf2f(KV[h * 256 + 192 + lane]) * rkv);
    }
}

__device__ __forceinline__ void hyconv_unit_valu(const Params& p, int l, int nset, int c, LAS float* lf) {
    const int tid = otid(), n = nset ? CTXL : SEQ, tokbase = nset ? NLAT : 0;
    LAS float* kc = lf; LAS float* z = lf + 4096; LAS float* z2 = z + 8 * SEQ;
    const float* HF = (const float*)(p.ws + O_HF) + (size_t)l * HF_LAYER + (nset ? HF_L0 : 0); const float* HSS = (const float*)(p.ws + O_HSS) + (size_t)((l * 2 + nset) * 2) * 512;
    const bf16_t* VT = (const bf16_t*)(p.ws + O_VT) + (size_t)c * NTOK + tokbase; const bf16_t* X1T = (const bf16_t*)(p.ws + O_X1T) + (size_t)c * NTOK + tokbase;
    bf16_t* Y2T = (bf16_t*)(p.ws + O_Y2T) + (size_t)c * NTOK + tokbase;
    for (int i = tid; i < 8 * n; i += NTHREADS) z[i] = bf2f(VT[i]);
    for (int ord = 0; ord < 2; ++ord) {
        const float rs = rsqrtf(HSS[ord * 512 + c] + EPS); const float* hf = HF + (size_t)((ord * 2 + 0) * 512 + c) * n; const float* hb = HF + (size_t)((ord * 2 + 1) * 512 + c) * n;
        for (int m = tid; m < 2 * n; m += NTHREADS) { const int lag = m - (n - 1); kc[m] = (m == 2 * n - 1) ? 0.f : (lag >= 0 ? hf[lag] : hb[-lag]) * rs; }
        __syncthreads();
        const LAS float* zs = ord ? z2 : z; const float skip = p.in[I_HYSKIP][(size_t)(l * 2 + ord) * 512 + c];
        for (int q = tid; q < n; q += NTHREADS) {
            const int b = q / (n >> 3), t0 = (q % (n >> 3)) * 8; float acc[8];
#pragma unroll
            for (int j = 0; j < 8; ++j) acc[j] = 0.f;
            const LAS float* zb = zs + b * n;
            for (int sb = 0; sb < n; sb += 8) {
                const LAS float* kb = kc + (t0 - sb + n - 8); float w[16];
#pragma unroll
                for (int i = 0; i < 4; ++i) { const f32x4 v = *(const LAS f32x4*)(kb + 4 * i); w[4 * i] = v[0]; w[4 * i + 1] = v[1]; w[4 * i + 2] = v[2]; w[4 * i + 3] = v[3]; }
                const f32x4 za = *(const LAS f32x4*)(zb + sb), zc = *(const LAS f32x4*)(zb + sb + 4); const float zv[8] = {za[0], za[1], za[2], za[3], zc[0], zc[1], zc[2], zc[3]};
#pragma unroll
                for (int ss = 0; ss < 8; ++ss)
#pragma unroll
                    for (int j = 0; j < 8; ++j) acc[j] += w[j - ss + 7] * zv[ss];
            }
            if (ord == 0) {
#pragma unroll
                for (int j = 0; j < 8; ++j) { const int idx = b * n + t0 + j; z2[idx] = bf2f(X1T[idx]) * (acc[j] + skip * z[idx]); }
            } else { float y[8];
#pragma unroll
                for (int j = 0; j < 8; ++j) y[j] = acc[j] + skip * z2[b * n + t0 + j];
                u32x4 w; w.x = pk2(y[0], y[1]); w.y = pk2(y[2], y[3]); w.z = pk2(y[4], y[5]); w.w = pk2(y[6], y[7]); *(u32x4*)(Y2T + b * n + t0) = w; }
        }
        __syncthreads();
    }
}
__device__ __forceinline__ void hy_fin_task(const Params& p, int l, int t0, int c0, LAS float* u) {
    const bf16_t* P = (const bf16_t*)(p.ws + O_P); LAS float* y = u + 66 * 65;
    load_conv_tile(P, t0, 1024 + c0, u);
    const int tid = otid();
    { const int c = tid >> 3, tc = (tid & 7) * 8; const u32x4 v = *(const u32x4*)((const bf16_t*)(p.ws + O_Y2T) + (size_t)(c0 + c) * NTOK + t0 + tc);
#pragma unroll
      for (int j = 0; j < 4; ++j) { y[c * 65 + tc + 2 * j] = __uint_as_float(v[j] << 16); y[c * 65 + tc + 2 * j + 1] = __uint_as_float(v[j] & 0xffff0000u); } }
    __syncthreads();
    { const int t = tid >> 3, cc = (tid & 7) * 8; const float* cw = p.in[I_HYCONV] + (size_t)l * 3 * 1536 + 1024 + c0 + cc; float o[8];
#pragma unroll
      for (int j = 0; j < 8; ++j) { const int c = cc + j; const float x2 = cw[j] * u[t * 65 + c] + cw[1536 + j] * u[(t + 1) * 65 + c] + cw[3072 + j] * u[(t + 2) * 65 + c]; o[j] = x2 * y[c * 65 + t]; }
      u32x4 w; w.x = pk2(o[0], o[1]); w.y = pk2(o[2], o[3]); w.z = pk2(o[4], o[5]); w.w = pk2(o[6], o[7]);
      *(u32x4*)((bf16_t*)(p.ws + O_MIX) + (size_t)(t0 + t) * DM + c0 + cc) = w; }
    __syncthreads();
}

__device__ __forceinline__ void mla_unit(const Params& p, int b, int h, int qb, bool ctxq, LAS unsigned char* lds) {
    unsigned char* ws = p.ws;
    const bf16_t* Q = ctxq ? (const bf16_t*)(ws + O_QMC) + (size_t)(b * 6 + h) * CTXL * 192 : (const bf16_t*)(ws + O_QM) + ((size_t)(b * 6 + h) * SEQ + qb * 256) * 192;
    bf16_t* O = (bf16_t*)(ws + O_MIX) + (size_t)(ctxq ? NLAT + b * CTXL : b * SEQ + qb * 256) * DM + 512 + h * 128;
    attn_body<192, 0>(Q, (const bf16_t*)(ws + O_KM) + (size_t)(b * 6 + h) * LK * 192, (const bf16_t*)(ws + O_VM) + (size_t)(b * 6 + h) * LK * 128, O, DM, ctxq ? CTXL : LK, 0.07216878364870322f, (char*)lds);
}
__device__ __forceinline__ void gqa_unit(const Params& p, int b, int h, int qb, bool ctxq, LAS unsigned char* lds) {
    unsigned char* ws = p.ws;
    const bf16_t* Q = ctxq ? (const bf16_t*)(ws + O_QGC) + (size_t)(b * 6 + h) * CTXL * 128 : (const bf16_t*)(ws + O_QG) + ((size_t)(b * 6 + h) * SEQ + qb * 256) * 128;
    bf16_t* O = (bf16_t*)(ws + O_MIX) + (size_t)(ctxq ? NLAT + b * CTXL : b * SEQ + qb * 256) * DM + 1280 + h * 128;
    attn_body<128, 2>(Q, (const bf16_t*)(ws + O_KG) + (size_t)(b * 2 + h / 3) * LK * 128, (const bf16_t*)(ws + O_VG) + (size_t)(b * 2 + h / 3) * LK * 128, O, DM, ctxq ? CTXL : LK, 0.08838834764831845f, (char*)lds);
}
__device__ __forceinline__ void phase_mixer(const Params& p, int l, LAS unsigned char* lds) {
    const int G = gridDim.x, bid = blockIdx.x; const bool last = (l == NLAYER - 1);
    for (int u = bid; u < 384 + (last ? 0 : 48); u += G) { if (u < 384) mla_unit(p, u / 48, (u >> 3) % 6, u & 7, false, lds); else mla_unit(p, (u - 384) / 6, (u - 384) % 6, 0, true, lds); }
    for (int u = (bid + G / 2) % G; u < 384 + (last ? 0 : 48); u += G) { if (u < 384) gqa_unit(p, u / 48, (u >> 3) % 6, u & 7, false, lds); else gqa_unit(p, (u - 384) / 6, (u - 384) % 6, 0, true, lds); }
    for (int u = bid; u < (last ? 512 : 1024); u += G) hyconv_unit_valu(p, l, u >> 9, u & 511, (LAS float*)lds);
}

__device__ __forceinline__ void phase_route(const Params& p, int l, LAS unsigned char* lds) {
    const int tid = otid(), wid = tid >> 6, lane = tid & 63; const bool last = (l == NLAYER - 1); const int NR = last ? NLAT : NTOK;
    LAS float* frow = (LAS float*)lds; LAS float* part = frow + 8 * DM;
    const float* g1 = p.in[I_NORMG] + (size_t)(l * 4 + 1) * DM; const float* g2 = p.in[I_NORMG] + (size_t)(l * 4 + 2) * DM;
    const float* RW = p.in[I_RW] + (size_t)l * DM * NEXP; unsigned* cnt = (unsigned*)(p.ws + O_CTL) + CW_CNT + l * 64;
    { int* stok = (int*)(p.ws + O_STOK); for (int i = blockIdx.x * NTHREADS + tid; i < NSLOTS; i += gridDim.x * NTHREADS) stok[i] = (i < RSLOTS) ? -1 : ((i - RSLOTS) < NR ? i - RSLOTS : -1); }
    for (int g = blockIdx.x; g < NR / 8; g += gridDim.x) {
        const int row = g * 8 + wid; const float* mod = (const float*)(p.ws + O_MOD) + (size_t)(l * 9 + row_batch(row)) * 12288;
        { const bf16_t* O = (const bf16_t*)(p.ws + O_OUT) + (size_t)row * DM; const float* rs = resid_src(p, l, row); float* X = (float*)(p.ws + O_X) + (size_t)row * DM; bf16_t* H = (bf16_t*)(p.ws + O_H) + (size_t)row * DM;
          float o[32], x[32]; float ss = 0.f;
#pragma unroll
          for (int j = 0; j < 8; ++j) { const u32x2 v = *(const u32x2*)(O + ROWCOL(j, lane)); o[j * 4] = __uint_as_float(v.x << 16); o[j * 4 + 1] = __uint_as_float(v.x & 0xffff0000u); o[j * 4 + 2] = __uint_as_float(v.y << 16); o[j * 4 + 3] = __uint_as_float(v.y & 0xffff0000u); }
#pragma unroll
          for (int i = 0; i < 32; ++i) ss += o[i] * o[i];
          const float r1 = rsqrtf(wave_sum(ss) * (1.0f / DM) + EPS); float s2 = 0.f;
#pragma unroll
          for (int j = 0; j < 8; ++j) { const int c = ROWCOL(j, lane); const f32x4 xv = *(const f32x4*)(rs + c), gv = *(const f32x4*)(g1 + c), ga = *(const f32x4*)(mod + 2 * DM + c); f32x4 xn;
#pragma unroll
              for (int q = 0; q < 4; ++q) { xn[q] = xv[q] + ga[q] * (o[j * 4 + q] * r1 * gv[q]); x[j * 4 + q] = xn[q]; s2 += xn[q] * xn[q]; }
              *(f32x4*)(X + c) = xn; }
          const float r2 = rsqrtf(wave_sum(s2) * (1.0f / DM) + EPS);
#pragma unroll
          for (int j = 0; j < 8; ++j) { const int c = ROWCOL(j, lane); const f32x4 gv = *(const f32x4*)(g2 + c), sh = *(const f32x4*)(mod + 3 * DM + c), sc = *(const f32x4*)(mod + 4 * DM + c); f32x4 f;
#pragma unroll
              for (int q = 0; q < 4; ++q) f[q] = x[j * 4 + q] * r2 * gv[q] * (1.0f + sc[q]) + sh[q];
              u32x2 w; w.x = pk2(f[0], f[1]); w.y = pk2(f[2], f[3]); *(u32x2*)(H + c) = w; *(LAS f32x4*)(frow + wid * DM + c) = f; } }
        __syncthreads();
        { float acc[8];
#pragma unroll
          for (int r = 0; r < 8; ++r) acc[r] = 0.f;
          for (int k = wid * 256; k < wid * 256 + 256; k += 4) { const float w0 = RW[(size_t)k * 64 + lane], w1 = RW[(size_t)(k + 1) * 64 + lane], w2 = RW[(size_t)(k + 2) * 64 + lane], w3 = RW[(size_t)(k + 3) * 64 + lane];
#pragma unroll
              for (int r = 0; r < 8; ++r) { const f32x4 fv = *(const LAS f32x4*)(frow + r * DM + k); acc[r] += fv[0] * w0 + fv[1] * w1 + fv[2] * w2 + fv[3] * w3; } }
#pragma unroll
          for (int r = 0; r < 8; ++r) part[(wid * 8 + r) * 64 + lane] = acc[r]; }
        __syncthreads();
        { float logit = 0.f;
#pragma unroll
          for (int w = 0; w < 8; ++w) logit += part[(w * 8 + wid) * 64 + lane];
          const float score = 1.0f / (1.0f + expf(-logit)), biased = score + p.in[I_RB][l * 64 + lane];
          float m1 = biased; m1 = fmaxf(m1, __shfl_xor(m1, 1)); m1 = fmaxf(m1, __shfl_xor(m1, 2)); m1 = fmaxf(m1, __shfl_xor(m1, 4));
          const unsigned long long bal = __ballot(biased == m1); const int first = __builtin_ctz((unsigned)((bal >> (lane & ~7)) & 0xffull));
          float m2 = ((lane & 7) == first) ? -INFINITY : biased; m2 = fmaxf(m2, __shfl_xor(m2, 1)); m2 = fmaxf(m2, __shfl_xor(m2, 2)); m2 = fmaxf(m2, __shfl_xor(m2, 4));
          const float gs = m1 + m2; const int grp = lane >> 3; int rank = 0;
#pragma unroll
          for (int q = 0; q < 8; ++q) { const float v = rdlane(gs, q * 8); rank += (v > gs || (v == gs && q < grp)) ? 1 : 0; }
          const float cand = (rank < 4) ? biased : -INFINITY; int re = 0;
          for (int q = 0; q < 64; ++q) { const float v = rdlane(cand, q); re += (v > cand || (v == cand && q < lane)) ? 1 : 0; }
          const bool sel = re < TOPK; const float ssum = wave_sum(sel ? score : 0.f);
          if (sel) { ((int*)(p.ws + O_EIDX))[(size_t)row * 8 + re] = lane; ((float*)(p.ws + O_GATE))[(size_t)row * 8 + re] = score / ssum * 2.5f; atomicAdd(&cnt[lane], 1u); } }
        __syncthreads();
    }
}
__device__ __forceinline__ void phase_place(const Params& p, int l, LAS unsigned char* lds) {
    const int tid = otid(); const int NR = (l == NLAYER - 1) ? NLAT : NTOK; LAS int* pstart = (LAS int*)lds;
    const unsigned* cnt = (const unsigned*)(p.ws + O_CTL) + CW_CNT + l * 64; unsigned* cur = (unsigned*)(p.ws + O_CTL) + CW_CUR + l * 64;
    if (tid == 0) { int run = 0; for (int e = 0; e < NEXP; ++e) { pstart[e] = run; run += ((int)cnt[e] + 255) & ~255; } }
    __syncthreads();
    const int* eidx = (const int*)(p.ws + O_EIDX); int* slot = (int*)(p.ws + O_SLOT); int* stok = (int*)(p.ws + O_STOK);
    for (int i = blockIdx.x * NTHREADS + tid; i < NR * TOPK; i += gridDim.x * NTHREADS) { const int row = i / TOPK, k = i % TOPK, e = eidx[(size_t)row * 8 + k];
        const int s = pstart[e] + (int)atomicAdd(&cur[e], 1u); slot[(size_t)row * 8 + k] = s; stok[s] = row; }
    __syncthreads();
}
__device__ __forceinline__ void phase_final(const Params& p, int l) {
    const int lane = otid() & 63, gw = blockIdx.x * 8 + (otid() >> 6), GW = gridDim.x * 8; const bool last = (l == NLAYER - 1); const int NR = last ? NLAT : NTOK;
    const bf16_t* DO = (const bf16_t*)(p.ws + O_DOUT); const float* g3 = p.in[I_NORMG] + (size_t)(l * 4 + 3) * DM;
    for (int row = gw; row < NR; row += GW) {
        float y[32];
        { const bf16_t* src = DO + (size_t)(RSLOTS + row) * DM;
#pragma unroll
          for (int j = 0; j < 8; ++j) { const u32x2 v = *(const u32x2*)(src + ROWCOL(j, lane)); y[j * 4] = __uint_as_float(v.x << 16); y[j * 4 + 1] = __uint_as_float(v.x & 0xffff0000u); y[j * 4 + 2] = __uint_as_float(v.y << 16); y[j * 4 + 3] = __uint_as_float(v.y & 0xffff0000u); } }
        for (int k = 0; k < TOPK; ++k) { const int s = ((const int*)(p.ws + O_SLOT))[(size_t)row * 8 + k]; const float gt = ((const float*)(p.ws + O_GATE))[(size_t)row * 8 + k]; const bf16_t* src = DO + (size_t)s * DM;
#pragma unroll
            for (int j = 0; j < 8; ++j) { const u32x2 v = *(const u32x2*)(src + ROWCOL(j, lane)); y[j * 4] += gt * __uint_as_float(v.x << 16); y[j * 4 + 1] += gt * __uint_as_float(v.x & 0xffff0000u); y[j * 4 + 2] += gt * __uint_as_float(v.y << 16); y[j * 4 + 3] += gt * __uint_as_float(v.y & 0xffff0000u); } }
        float ss = 0.f;
#pragma unroll
        for (int i = 0; i < 32; ++i) ss += y[i] * y[i];
        const float r = rsqrtf(wave_sum(ss) * (1.0f / DM) + EPS); const float* mod = (const float*)(p.ws + O_MOD) + (size_t)(l * 9 + row_batch(row)) * 12288;
        float* X = (float*)(p.ws + O_X) + (size_t)row * DM; float x[32];
#pragma unroll
        for (int j = 0; j < 8; ++j) { const int c = ROWCOL(j, lane); const f32x4 xv = *(const f32x4*)(X + c), gv = *(const f32x4*)(g3 + c), gf = *(const f32x4*)(mod + 5 * DM + c); f32x4 xn;
#pragma unroll
            for (int q = 0; q < 4; ++q) { xn[q] = xv[q] + gf[q] * (y[j * 4 + q] * r * gv[q]); x[j * 4 + q] = xn[q]; }
            if (last) *(f32x4*)(p.out + (size_t)row * DM + c) = xn; else *(f32x4*)(X + c) = xn; }
        if (!last) norm1_row(p, l + 1, row, x, lane);
    }
}

#define XB_TMO      128
#define XB_XCNT(j)  (256  + 64 * (j))
#define XB_XSUB(j)  (1280 + 64 * (j))
#define XB_XGEN(j)  (2304 + 64 * (j))
#define XB_TOP      3328
#define XB_TOPGEN   3392
#define XCD_BAR_WORDS 3456
#define XB_SPIN_CAP (1u << 23)

__device__ __forceinline__ unsigned xb_ld(unsigned* p)              { return __hip_atomic_load(p, __ATOMIC_RELAXED, __HIP_MEMORY_SCOPE_AGENT); }
__device__ __forceinline__ unsigned xb_add(unsigned* p, unsigned v) { return __hip_atomic_fetch_add(p, v, __ATOMIC_RELAXED, __HIP_MEMORY_SCOPE_AGENT); }
__device__ __forceinline__ unsigned xb_xcc_id() { return (unsigned)__builtin_amdgcn_s_getreg((3 << 11) | 20) & 0xFu; }
#define XB_SPIN(cond, bar) do { unsigned _sp = 0; while (cond) { __builtin_amdgcn_s_sleep(1); \
    if ((++_sp & 255u) == 0u) { if (xb_ld(&(bar)[XB_TMO])) break; if (_sp > XB_SPIN_CAP) { atomicAdd(&(bar)[XB_TMO], 1u); break; } } } } while (0)

struct XcdBarrier {
    unsigned* bar; unsigned x;
    volatile LAS unsigned* st;
};

__device__ __forceinline__ XcdBarrier xcd_barrier_post(unsigned* bar, volatile LAS unsigned* st) {
    XcdBarrier b; b.bar = bar; b.x = xb_xcc_id(); b.st = st;
    if (threadIdx.x == 0) (void)xb_add(&bar[XB_XCNT(b.x)], 1u);
    return b;
}
__device__ __forceinline__ void xcd_barrier_complete(unsigned* bar, unsigned x, unsigned& nloc, unsigned& nx) {
    const unsigned G = gridDim.x * gridDim.y * gridDim.z;
    unsigned sum, cnt, mine, sp = 0u;
    for (;;) {
        sum = 0u; cnt = 0u; mine = 0u;
#pragma unroll
        for (unsigned j = 0; j < 16; ++j) { const unsigned c = xb_ld(&bar[XB_XCNT(j)]); sum += c; cnt += (c > 0u) ? 1u : 0u; mine = (j == x) ? c : mine; }
        if (sum == G) break;
        __builtin_amdgcn_s_sleep(1);
        if ((++sp & 255u) == 0u) { if (xb_ld(&bar[XB_TMO])) break; if (sp > XB_SPIN_CAP) { atomicAdd(&bar[XB_TMO], 1u); break; } }
    }
    nloc = mine > 0u ? mine : 1u; nx = cnt > 0u ? cnt : 1u;
}

__device__ __forceinline__ void xcd_barrier(const XcdBarrier& b) {
    asm volatile("s_waitcnt vmcnt(0)" ::: "memory");
    __syncthreads();
    if (threadIdx.x == 0) {
        unsigned* bar = b.bar;
        __builtin_amdgcn_s_waitcnt(0);
        unsigned nloc = b.st[0], nx = b.st[1];
        if (nloc == 0u) { xcd_barrier_complete(bar, b.x, nloc, nx); b.st[0] = nloc; b.st[1] = nx; }
        const unsigned old = xb_add(&bar[XB_XSUB(b.x)], 1u);
        const unsigned gen = old / nloc;
        if (old + 1u == (gen + 1u) * nloc) {
            __builtin_amdgcn_fence(__ATOMIC_RELEASE, "agent");
            asm volatile("s_waitcnt vmcnt(0)" ::: "memory");
            const unsigned og = xb_add(&bar[XB_TOP], 1u);
            const unsigned tg = og / nx;
            if (og + 1u == (tg + 1u) * nx) xb_add(&bar[XB_TOPGEN], 1u);
            else XB_SPIN(xb_ld(&bar[XB_TOPGEN]) == tg, bar);
            __builtin_amdgcn_fence(__ATOMIC_ACQUIRE, "agent");
            xb_add(&bar[XB_XGEN(b.x)], 1u);
            asm volatile("s_waitcnt vmcnt(0)" ::: "memory");
        } else {
            XB_SPIN(xb_ld(&bar[XB_XGEN(b.x)]) == gen, bar);
            __builtin_amdgcn_fence(__ATOMIC_ACQUIRE, "agent");
            asm volatile("s_waitcnt vmcnt(0)" ::: "memory");
        }
    }
    __syncthreads();
}


enum { PH_PRO = 0, PH_NORM1, PH_WIN, PH_POSTA, PH_POSTB, PH_MIXER, PH_HYFIN, PH_WOUT, PH_ROUTE, PH_PLACE, PH_GEMM1, PH_GEMM2, PH_FINAL, PH_COUNT };

template <int PH>
__device__ __forceinline__ void run_phase(const Params& p_in, int l, LAS unsigned char* lds) {
    Params p = p_in; { unsigned char* w = p.ws; asm volatile("" : "+s"(w)); p.ws = w; }
    unsigned char* ws = p.ws; const bool last = (l == NLAYER - 1);
    const int gw = blockIdx.x * 8 + (otid() >> 6), GW = gridDim.x * 8, lane = otid() & 63;
    if constexpr (PH == PH_PRO) { phase_prologue(p, lds); }
    if constexpr (PH == PH_NORM1) { phase_norm1(p, l); }
    if constexpr (PH == PH_WIN) {
        GemmDesc g{(const bf16_t*)(ws + O_H), DM, nullptr, DM, DM}; EpiStoreBf16 E{(bf16_t*)(ws + O_P), NP};
        const bf16_t* Bt = (const bf16_t*)(ws + O_WIN) + (size_t)l * NP * DM;
        if (!last) { DenseSched S{Bt, DM, NTOK / 256, 16, 0, 0}; GEMM_PHASE(g, S, E); }
        else { DenseSched S{Bt, DM, NLAT / 256, 16, 0, 0}; GEMM_PHASE(g, S, E); DenseSched S2{Bt, DM, NCTX / 256, 4, NLAT, 12}; GEMM_PHASE(g, S2, E); }
    }
    if constexpr (PH == PH_POSTA) {
#ifndef DBG_SKIP
#define DBG_SKIP 0
#endif
        if (!(DBG_SKIP & 1)) { GemmDesc g{(const bf16_t*)(ws + O_P) + C_CQ, NP, nullptr, 768, 768}; EpiStoreBf16 E{(bf16_t*)(ws + O_QRAW), NQP};
          DenseSched S{(const bf16_t*)(ws + O_WUQ) + (size_t)l * NQP * 768, 768, (last ? NLAT : NTOK) / 256, 5, 0, 0}; GEMM_PHASE(g, S, E); }
        if (!(DBG_SKIP & 2)) { GemmDesc g{(const bf16_t*)(ws + O_P) + C_CKV, NP, nullptr, 256, 256}; EpiStoreBf16 E{(bf16_t*)(ws + O_KVRAW), 1536};
          DenseSched S{(const bf16_t*)(ws + O_WUKV) + (size_t)l * 1536 * 256, 256, NTOK / 256, 6, 0, 0}; GEMM_PHASE(g, S, E); }
        const int ntt = (last ? NLAT : NTOK) / 64;
        if (!(DBG_SKIP & 4)) for (int t = blockIdx.x; t < ntt * 16; t += gridDim.x) hy_prep_task(p, l, (t >> 4) * 64, (t & 15) * 64, (LAS float*)lds);
        if (!(DBG_SKIP & 8)) for (int row = gw; row < NTOK; row += GW) gqa_post_row(p, l, row, lane);
    }
    if constexpr (PH == PH_POSTB) { if (l == 0) hss_tasks(p); for (int row = gw; row < NTOK; row += GW) mla_post_row(p, l, row, lane); }
    if constexpr (PH == PH_MIXER) { phase_mixer(p, l, lds); }
    if constexpr (PH == PH_HYFIN) { const int ntt = (last ? NLAT : NTOK) / 64; for (int t = blockIdx.x; t < ntt * 8; t += gridDim.x) hy_fin_task(p, l, (t >> 3) * 64, (t & 7) * 64, (LAS float*)lds); }
    if constexpr (PH == PH_WOUT) {
        GemmDesc g{(const bf16_t*)(ws + O_MIX), DM, nullptr, DM, DM}; EpiStoreBf16 E{(bf16_t*)(ws + O_OUT), DM};
        DenseSched S{(const bf16_t*)(ws + O_WOUT) + (size_t)l * DM * DM, DM, (last ? NLAT : NTOK) / 256, 8, 0, 0}; GEMM_PHASE(g, S, E);
    }
    if constexpr (PH == PH_ROUTE) { phase_route(p, l, lds); }
    if constexpr (PH == PH_PLACE) { phase_place(p, l, lds); }
    if constexpr (PH == PH_GEMM1 || PH == PH_GEMM2) {
        LAS int* te = (LAS int*)(lds + LDS_TILES); LAS int* ts = te + MAXTILES; LAS int* misc = (LAS int*)(lds + LDS_MISC) + 16;
        const int nt = moe_build_tiles((const unsigned*)(ws + O_CTL) + CW_CNT + l * 64, (last ? NLAT : NTOK) / 256, te, ts, misc);
        if constexpr (PH == PH_GEMM1) {
            GemmDesc g{(const bf16_t*)(ws + O_H), DM, (const int*)(ws + O_STOK), DM, DM}; EpiSwiGLU E{(bf16_t*)(ws + O_HID)};
            MoeSched S{te, ts, nt, 4, (const bf16_t*)(ws + O_EGU), (size_t)1024 * 2048, DM, 128}; GEMM_PHASE(g, S, E);
        } else {
            GemmDesc g{(const bf16_t*)(ws + O_HID), EH, nullptr, EH, EH}; EpiStoreBf16 E{(bf16_t*)(ws + O_DOUT), DM};
            MoeSched S{te, ts, nt, 8, (const bf16_t*)(ws + O_ED), (size_t)2048 * 512, EH, 256}; GEMM_PHASE(g, S, E);
        }
        __syncthreads();
    }
    if constexpr (PH == PH_FINAL) {
        phase_final(p, l);
        if (!last) for (int t = blockIdx.x; t < CVT_EXP; t += gridDim.x) cvt_exp_task(p, l + 1, t, (LAS float*)lds);
    }
}

#ifndef MEGA
#define MEGA 0
#endif


#if MEGA
__global__ void __launch_bounds__(NTHREADS, 2) mega_fwd(Params p) {
    extern __shared__ __attribute__((aligned(16))) unsigned char lds_raw[];
    LAS unsigned char* lds = (LAS unsigned char*)lds_raw;
    volatile LAS unsigned* xbw = (volatile LAS unsigned*)(lds + LDS_MISC);
    if (otid() == 0) { xbw[0] = 0u; xbw[1] = 0u; }
    __syncthreads();
    { const XcdBarrier b0 = xcd_barrier_post((unsigned*)(p.ws + O_CTL) + CW_BAR, xbw); if (otid() == 0) xbw[2] = b0.x; }
    __syncthreads();
#define GRID_BAR() do { XcdBarrier b_; b_.bar = (unsigned*)(p.ws + O_CTL) + CW_BAR; b_.x = xbw[2]; b_.st = xbw; xcd_barrier(b_); } while (0)
    run_phase<PH_PRO>(p, 0, lds); GRID_BAR();
    for (int l = 0; l < NLAYER; ++l) {
        if (l == 0) { run_phase<PH_NORM1>(p, l, lds); GRID_BAR(); }
        run_phase<PH_WIN>(p, l, lds); GRID_BAR();
        run_phase<PH_POSTA>(p, l, lds); GRID_BAR();
        run_phase<PH_POSTB>(p, l, lds); GRID_BAR();
        run_phase<PH_MIXER>(p, l, lds); GRID_BAR();
        run_phase<PH_HYFIN>(p, l, lds); GRID_BAR();
        run_phase<PH_WOUT>(p, l, lds); GRID_BAR();
        run_phase<PH_ROUTE>(p, l, lds); GRID_BAR();
        run_phase<PH_PLACE>(p, l, lds); GRID_BAR();
        run_phase<PH_GEMM1>(p, l, lds); GRID_BAR();
        run_phase<PH_GEMM2>(p, l, lds); GRID_BAR();
        run_phase<PH_FINAL>(p, l, lds);
        if (l + 1 < NLAYER) GRID_BAR();
    }
}
#endif

#if !MEGA
template <int PH> __global__ void __launch_bounds__(NTHREADS, 2) k_phase(Params p) {
    extern __shared__ __attribute__((aligned(16))) unsigned char lds_raw[];
    run_phase<PH>(p, p.layer, (LAS unsigned char*)lds_raw);
}
template <int PH> static bool prep_phase() { return hipFuncSetAttribute((const void*)k_phase<PH>, hipFuncAttributeMaxDynamicSharedMemorySize, LDS_BYTES) == hipSuccess; }
static int g_nlaunch = 0;
#ifndef DBG_STOP
#define DBG_STOP 1000
#define DBG_DUMP 0
#else
#define DBG_DUMP 1
#ifndef DBG_SET
#define DBG_SET 31
#endif
#endif
template <int PH> static void launch_phase(Params p, int l, hipStream_t st) { if (g_nlaunch++ >= DBG_STOP) return; p.layer = l; hipLaunchKernelGGL(k_phase<PH>, dim3(256), dim3(NTHREADS), LDS_BYTES, st, p); }
#endif


#if DBG_DUMP
__device__ __forceinline__ float san(float x) { return (x == x && fabsf(x) < 1e6f) ? x : 1.0f; }
__global__ void __launch_bounds__(256) k_dump(Params p) {
    const size_t N = (size_t)NLAT * DM;
    const bf16_t* b1 = (const bf16_t*)(p.ws + O_WIN); const size_t n1 = (O_X - O_WIN) / 2;
    const bf16_t* b2 = (const bf16_t*)(p.ws + O_H); const size_t n2 = (size_t)NTOK * DM;
    const bf16_t* b3 = (const bf16_t*)(p.ws + O_A); const size_t n3 = (O_AEND - O_A) / 2;
    const float* f1 = (const float*)(p.ws + O_MOD); const size_t m1 = (O_WIN - O_MOD) / 4;
    const float* f2 = (const float*)(p.ws + O_X); const size_t m2 = (size_t)NTOK * DM;
    for (size_t i = (size_t)blockIdx.x * 256 + otid(); i < N; i += (size_t)gridDim.x * 256) {
        float v = 0.f;
        if (DBG_SET & 1) for (size_t e = i; e < n1; e += N) v += san(bf2f(b1[e]));
        if (DBG_SET & 2) for (size_t e = i; e < n2; e += N) v += san(bf2f(b2[e]));
        if (DBG_SET & 4) for (size_t e = i; e < n3; e += N) v += san(bf2f(b3[e]));
        if (DBG_SET & 8) for (size_t e = i; e < m1; e += N) v += san(f1[e]);
        if (DBG_SET & 16) for (size_t e = i; e < m2; e += N) v += san(f2[e]);
        if (DBG_SET & 32) v += san(bf2f(((const bf16_t*)(p.ws + O_WUKV))[i % ((size_t)2 * 1536 * 256)]));
        if (DBG_SET & 64) { const size_t r = i % NTOK, c = (i / NTOK) % 256; v += san(bf2f(((const bf16_t*)(p.ws + O_P))[r * NP + C_CKV + c])); }
        if (DBG_SET & 128) v += san(bf2f(((const bf16_t*)(p.ws + O_KVRAW))[i % ((size_t)NTOK * 1536)]));
        p.out[i] = v;
    }
}
#endif
static int g_grid = 0;
extern "C" void kernel_launch(void* const* d_in, const int* in_sizes, int n_in, void* d_out, int out_size, void* d_ws, size_t ws_size, hipStream_t stream) {
    static int ok = 0;
    if (ok == 0) {
        if (n_in != 31 || in_sizes[0] != NLAT * DM || out_size != NLAT * DM || ws_size < WS_END) { fprintf(stderr, "kernel_launch: unexpected shapes (n_in %d, ws %zu, need %zu)\n", n_in, ws_size, (size_t)WS_END); ok = -1; return; }
        bool good = true;
#if !MEGA
        good = good && prep_phase<0>() && prep_phase<1>() && prep_phase<2>() && prep_phase<3>() && prep_phase<4>() && prep_phase<5>() && prep_phase<6>() && prep_phase<7>() && prep_phase<8>() && prep_phase<9>() && prep_phase<10>() && prep_phase<11>() && prep_phase<12>();
#endif
#if MEGA
        good = hipFuncSetAttribute((const void*)mega_fwd, hipFuncAttributeMaxDynamicSharedMemorySize, LDS_BYTES) == hipSuccess;
        int dev = 0, cus = 0, per_cu = 0;
        if (hipGetDevice(&dev) != hipSuccess || hipDeviceGetAttribute(&cus, hipDeviceAttributeMultiprocessorCount, dev) != hipSuccess) good = false;
        if (good && (hipOccupancyMaxActiveBlocksPerMultiprocessor(&per_cu, (const void*)mega_fwd, NTHREADS, LDS_BYTES) != hipSuccess || per_cu < 1)) { fprintf(stderr, "kernel_launch: occupancy query says %d workgroups per CU\n", per_cu); good = false; }
        g_grid = cus;
#endif
        if (!good) { fprintf(stderr, "kernel_launch: set-up failed\n"); ok = -1; return; }
        ok = 1;
    }
    if (ok < 0) return;
    Params p{}; for (int i = 0; i < 31; ++i) p.in[i] = (const float*)d_in[i]; p.out = (float*)d_out; p.ws = (unsigned char*)d_ws; p.layer = 0; p.pad = 0;
#ifdef POISON_WS
    hipMemsetAsync((char*)d_ws, 0xFF, WS_END, stream);
#endif
    hipMemsetAsync((char*)d_ws + O_CTL, 0, ZERO_BYTES, stream);
#if !MEGA
    g_nlaunch = 0;
    launch_phase<PH_PRO>(p, 0, stream);
    for (int l = 0; l < NLAYER; ++l) {
        if (l == 0) launch_phase<PH_NORM1>(p, l, stream);
        launch_phase<PH_WIN>(p, l, stream); launch_phase<PH_POSTA>(p, l, stream); launch_phase<PH_POSTB>(p, l, stream); launch_phase<PH_MIXER>(p, l, stream);
        launch_phase<PH_HYFIN>(p, l, stream); launch_phase<PH_WOUT>(p, l, stream); launch_phase<PH_ROUTE>(p, l, stream); launch_phase<PH_PLACE>(p, l, stream);
        launch_phase<PH_GEMM1>(p, l, stream); launch_phase<PH_GEMM2>(p, l, stream); launch_phase<PH_FINAL>(p, l, stream);
    }
#if DBG_DUMP
    hipLaunchKernelGGL(k_dump, dim3(2048), dim3(256), 0, stream, p);
#endif
#else
    hipLaunchKernelGGL(mega_fwd, dim3(g_grid), dim3(NTHREADS), LDS_BYTES, stream, p);
#endif
}
```

```cpp
#define FAST_GEMM 1
#define MEGA 1
#include <hip/hip_runtime.h>
#include <stdint.h>
#include <stdio.h>

#define LAS __attribute__((address_space(3)))
typedef unsigned short bf16_t;
typedef short bf16x8 __attribute__((ext_vector_type(8)));
typedef short s16x4 __attribute__((ext_vector_type(4)));
typedef float f32x4 __attribute__((ext_vector_type(4)));
typedef float f32x16 __attribute__((ext_vector_type(16)));
typedef unsigned u32x4 __attribute__((ext_vector_type(4)));
typedef unsigned u32x2 __attribute__((ext_vector_type(2)));

constexpr int DM = 2048, NB = 8, SEQ = 2048, CTXL = 256, NLAT = NB * SEQ, NCTX = NB * CTXL, NTOK = NLAT + NCTX, NLAYER = 2;
constexpr int NP = 4096;
constexpr int C_CQ = 1536, C_GQ = 2304, C_CKV = 3072, C_KR = 3328, C_GK = 3392, C_GV = 3648, IN_COLS = 3904;
constexpr int NEXP = 64, TOPK = 6, EH = 512;
constexpr int LK = CTXL + SEQ;
constexpr int RSLOTS = 126976;
constexpr int NSLOTS = RSLOTS + NTOK;
constexpr int MAXTILES = NSLOTS / 256;
constexpr int NQP = 1280;
constexpr float EPS = 1e-6f;
constexpr int NTHREADS = 512;

constexpr size_t al256(size_t x) { return (x + 255) & ~(size_t)255; }
constexpr size_t O_CTL = 0;
constexpr size_t CTL_BYTES = 65536;
constexpr size_t O_MOD = O_CTL + CTL_BYTES;
constexpr size_t O_HSS = O_MOD + al256((size_t)NLAYER * 9 * 12288 * 4);
constexpr size_t ZERO_BYTES = O_HSS + al256((size_t)NLAYER * 2 * 2 * 512 * 4);
constexpr size_t O_HF = ZERO_BYTES;
constexpr size_t HF_L0 = (size_t)2 * 2 * 512 * 2048, HF_L1 = (size_t)2 * 2 * 512 * 256, HF_LAYER = HF_L0 + HF_L1;
constexpr size_t O_WIN = O_HF + al256(NLAYER * HF_LAYER * 4);
constexpr size_t O_WOUT = O_WIN + (size_t)NLAYER * NP * DM * 2;
constexpr size_t O_WUQ = O_WOUT + (size_t)NLAYER * DM * DM * 2;
constexpr size_t O_WUKV = O_WUQ + al256((size_t)NLAYER * NQP * 768 * 2);
constexpr size_t O_EGU = O_WUKV + al256((size_t)NLAYER * 1536 * 256 * 2);
constexpr size_t O_ED = O_EGU + (size_t)65 * 1024 * 2048 * 2;
constexpr size_t O_X = O_ED + (size_t)65 * 2048 * 512 * 2;
constexpr size_t O_H = O_X + (size_t)NTOK * DM * 4;
constexpr size_t O_EIDX = O_H + (size_t)NTOK * DM * 2;
constexpr size_t O_GATE = O_EIDX + (size_t)NTOK * 8 * 4;
constexpr size_t O_SLOT = O_GATE + (size_t)NTOK * 8 * 4;
constexpr size_t O_STOK = O_SLOT + (size_t)NTOK * 8 * 4;
constexpr size_t O_HID = O_STOK + al256((size_t)NSLOTS * 4);
constexpr size_t O_A = O_HID + (size_t)NSLOTS * EH * 2;
constexpr size_t O_P = O_A;
constexpr size_t O_QRAW = O_P + (size_t)NTOK * NP * 2;
constexpr size_t O_KVRAW = O_QRAW + (size_t)NTOK * NQP * 2;
constexpr size_t O_QM = O_KVRAW + (size_t)NTOK * 1536 * 2;
constexpr size_t O_QMC = O_QM + (size_t)NB * 6 * SEQ * 192 * 2;
constexpr size_t O_KM = O_QMC + (size_t)NB * 6 * CTXL * 192 * 2;
constexpr size_t O_VM = O_KM + (size_t)NB * 6 * LK * 192 * 2;
constexpr size_t O_QG = O_VM + (size_t)NB * 6 * LK * 128 * 2;
constexpr size_t O_QGC = O_QG + (size_t)NB * 6 * SEQ * 128 * 2;
constexpr size_t O_KG = O_QGC + (size_t)NB * 6 * CTXL * 128 * 2;
constexpr size_t O_VG = O_KG + (size_t)NB * 2 * LK * 128 * 2;
constexpr size_t O_VT = O_VG + (size_t)NB * 2 * LK * 128 * 2;
constexpr size_t O_X1T = O_VT + (size_t)512 * NTOK * 2;
constexpr size_t O_Y2T = O_X1T + (size_t)512 * NTOK * 2;
constexpr size_t O_MIX = O_Y2T + (size_t)512 * NTOK * 2;
constexpr size_t O_OUT = O_MIX + (size_t)NTOK * DM * 2;
constexpr size_t O_AEND = O_OUT + (size_t)NTOK * DM * 2;
constexpr size_t O_DOUT = O_A;
static_assert(O_DOUT + (size_t)NSLOTS * DM * 2 <= O_AEND, "DOUT must fit the mixer scratch region");
constexpr size_t WS_END = O_AEND;

constexpr int CW_BAR = 0;
constexpr int CW_CNT = 4096;
constexpr int CW_CUR = 4096 + 128;
constexpr int CW_Q = 4096 + 256;

constexpr int LDS_BYTES = 148480;
constexpr int LDS_MISC = 147456;
constexpr int LDS_TILES = 131072;

struct Params { const float* in[31]; float* out; unsigned char* ws; int layer; int pad; };

enum { I_X = 0, I_C, I_CTX, I_CCTX, I_ADAW, I_ADAB, I_NORMG, I_WIN, I_WOUT, I_HYCONV, I_HYW1, I_HYB1, I_HYW2, I_HYB2, I_HYW3, I_HYFREQ, I_HYSKIP,
       I_MQN, I_MKVN, I_WUQ, I_WUKV, I_GQN, I_GKN, I_RW, I_RB, I_EG, I_EU, I_EDN, I_SG, I_SU, I_SD };

__device__ __forceinline__ int otid() { int t = threadIdx.x; asm volatile("" : "+v"(t)); return t; }
__device__ __forceinline__ float bf2f(bf16_t v) { return __uint_as_float(((unsigned)v) << 16); }
__device__ __forceinline__ bf16_t f2bf(float f) { unsigned u = __float_as_uint(f); u += 0x7FFFu + ((u >> 16) & 1u); return (bf16_t)(u >> 16); }
__device__ __forceinline__ unsigned pk2(float lo, float hi) { unsigned r; asm volatile("v_cvt_pk_bf16_f32 %0, %1, %2" : "=v"(r) : "v"(lo), "v"(hi)); return r; }
__device__ __forceinline__ float wave_sum(float v) {
#pragma unroll
    for (int o = 32; o >= 1; o >>= 1) v += __shfl_xor(v, o);
    return v;
}
__device__ __forceinline__ float rdlane(float v, int l) { return __int_as_float(__builtin_amdgcn_readlane(__float_as_int(v), l)); }
__device__ __forceinline__ float silu_f(float x) { return x / (1.0f + __expf(-x)); }
__device__ __forceinline__ const float* resid_src(const Params& p, int l, int row) {
    if (l == 0) return row < NLAT ? p.in[I_X] + (size_t)row * DM : p.in[I_CTX] + (size_t)(row - NLAT) * DM;
    return (const float*)(p.ws + O_X) + (size_t)row * DM;
}
__device__ __forceinline__ int row_batch(int row) { return row < NLAT ? row >> 11 : 8; }
#define ROWCOL(j, lane) ((j) * 256 + (lane) * 4)


struct GUnit { int arow0; const bf16_t* B; int orow0, ocol0; };
struct GemmDesc { const bf16_t* A; int lda; const int* ridx; int ldb; int K; };

struct EpiStoreBf16 {
    bf16_t* O; int ldo;
    __device__ __forceinline__ void operator()(const f32x4 (&acc)[2][2][4][2], const GUnit& u, int wr, int wc, int fr, int fq) const {
#pragma unroll
        for (int ai = 0; ai < 2; ++ai)
#pragma unroll
            for (int m = 0; m < 4; ++m) {
                bf16_t* rowp = O + (size_t)(u.orow0 + ai * 128 + wr * 64 + m * 16 + fr) * ldo + u.ocol0 + wc * 32 + 4 * fq;
#pragma unroll
                for (int bj = 0; bj < 2; ++bj)
#pragma unroll
                    for (int n = 0; n < 2; ++n) { const f32x4 v = acc[ai][bj][m][n]; u32x2 w; w.x = pk2(v[0], v[1]); w.y = pk2(v[2], v[3]); *(u32x2*)(rowp + bj * 128 + n * 16) = w; }
            }
    }
};
struct EpiSwiGLU {
    bf16_t* O;
    __device__ __forceinline__ void operator()(const f32x4 (&acc)[2][2][4][2], const GUnit& u, int wr, int wc, int fr, int fq) const {
#pragma unroll
        for (int ai = 0; ai < 2; ++ai)
#pragma unroll
            for (int m = 0; m < 4; ++m) {
                bf16_t* rowp = O + (size_t)(u.orow0 + ai * 128 + wr * 64 + m * 16 + fr) * EH + u.ocol0 + wc * 32 + 4 * fq;
#pragma unroll
                for (int n = 0; n < 2; ++n) { const f32x4 g = acc[ai][0][m][n], up = acc[ai][1][m][n]; float h[4];
#pragma unroll
                    for (int j = 0; j < 4; ++j) h[j] = silu_f(g[j]) * up[j];
                    u32x2 w; w.x = pk2(h[0], h[1]); w.y = pk2(h[2], h[3]); *(u32x2*)(rowp + n * 16) = w; }
            }
    }
};

template <class Epi>
__device__ __forceinline__ void gemm_unit_simple(const GemmDesc& g, const GUnit& u, const Epi& E) {
    int tid = otid();
    const int wid = tid >> 6, lane = tid & 63, wr = wid >> 2, wc = wid & 3, fr = lane & 15, fq = lane >> 4;
    f32x4 acc[2][2][4][2];
#pragma unroll
    for (int a = 0; a < 2; ++a)
#pragma unroll
        for (int b = 0; b < 2; ++b)
#pragma unroll
            for (int m = 0; m < 4; ++m)
#pragma unroll
                for (int n = 0; n < 2; ++n) acc[a][b][m][n] = (f32x4){0.f, 0.f, 0.f, 0.f};
    const bf16_t* ap[2][4]; const bf16_t* bp[2][2];
#pragma unroll
    for (int ai = 0; ai < 2; ++ai)
#pragma unroll
        for (int m = 0; m < 4; ++m) { const int r = u.arow0 + ai * 128 + wr * 64 + m * 16 + fr; int src = g.ridx ? g.ridx[r] : r; if (src < 0) src = 0; ap[ai][m] = g.A + (size_t)src * g.lda + 8 * fq; }
#pragma unroll
    for (int bj = 0; bj < 2; ++bj)
#pragma unroll
        for (int n = 0; n < 2; ++n) bp[bj][n] = u.B + (size_t)(bj * 128 + wc * 32 + n * 16 + fr) * g.ldb + 8 * fq;
    int Kq = g.K; asm volatile("" : "+s"(Kq));
#pragma unroll 1
    for (int k0 = 0; k0 < Kq; k0 += 32) {
        bf16x8 a[2][4], b[2][2];
#pragma unroll
        for (int ai = 0; ai < 2; ++ai)
#pragma unroll
            for (int m = 0; m < 4; ++m) a[ai][m] = *(const bf16x8*)(ap[ai][m] + k0);
#pragma unroll
        for (int bj = 0; bj < 2; ++bj)
#pragma unroll
            for (int n = 0; n < 2; ++n) b[bj][n] = *(const bf16x8*)(bp[bj][n] + k0);
#pragma unroll
        for (int ai = 0; ai < 2; ++ai)
#pragma unroll
            for (int bj = 0; bj < 2; ++bj)
#pragma unroll
                for (int m = 0; m < 4; ++m)
#pragma unroll
                    for (int n = 0; n < 2; ++n) acc[ai][bj][m][n] = __builtin_amdgcn_mfma_f32_16x16x32_bf16(b[bj][n], a[ai][m], acc[ai][bj][m][n], 0, 0, 0);
    }
    E(acc, u, wr, wc, fr, fq);
}

struct DenseSched {
    const bf16_t* Bt; int ldb, nM, nN, row0, pn0;
    __device__ __forceinline__ int count() const { return nM * nN; }
    __device__ __forceinline__ void unit(int i, GUnit& u) const { const int pm = i / nN, pn = pn0 + i % nN; u.arow0 = row0 + pm * 256; u.B = Bt + (size_t)pn * 256 * ldb; u.orow0 = u.arow0; u.ocol0 = pn * 256; }
};
struct MoeSched {
    const LAS int* te; const LAS int* ts; int ntiles, npn; const bf16_t* Bt; size_t estride; int ldb, ocolw;
    __device__ __forceinline__ int count() const { return ntiles * npn; }
    __device__ __forceinline__ void unit(int i, GUnit& u) const { const int t = i / npn, pn = i % npn; const int e = te[t]; u.arow0 = ts[t]; u.B = Bt + (size_t)e * estride + (size_t)pn * 256 * ldb; u.orow0 = u.arow0; u.ocol0 = pn * ocolw; }
};
template <class Sched, class Epi>
__device__ __forceinline__ void gemm_phase_simple(const GemmDesc& g, const Sched& S, const Epi& E) {
    const int n = S.count();
    for (int i = blockIdx.x; i < n; i += gridDim.x) { GUnit u; S.unit(i, u); gemm_unit_simple(g, u, E); }
}
__device__ __forceinline__ int moe_build_tiles(const unsigned* cnt, int nshared, LAS int* te, LAS int* ts, LAS int* misc) {
    __syncthreads();
    if (otid() == 0) {
        int nt = 0, run = 0;
        for (int e = 0; e < NEXP; ++e) { const int c = (int)cnt[e], ntile = (c + 255) >> 8; for (int j = 0; j < ntile; ++j) { te[nt] = e; ts[nt] = run + j * 256; ++nt; } run += ntile * 256; }
        for (int j = 0; j < nshared; ++j) { te[nt] = NEXP; ts[nt] = RSLOTS + j * 256; ++nt; }
        misc[0] = nt;
    }
    __syncthreads();
    return misc[0];
}
#ifndef FAST_GEMM
#define FAST_GEMM 0
#endif
#if !FAST_GEMM
#define GEMM_PHASE(g, S, E) gemm_phase_simple(g, S, E)
#endif

#if FAST_GEMM
constexpr int HTB = 128 * 64 * 2;
__device__ __forceinline__ int lds_byte(int r, int c) { const int st = (r >> 4) * 2 + (c >> 5), rr = r & 15, cc = c & 31, ob = rr * 64 + cc * 2; return st * 1024 + (ob ^ (((ob >> 9) & 1) << 5)); }
__device__ __forceinline__ void stage_rc(int b, int& R, int& C) { const int st = b / 1024, sb = b % 1024, swz = sb ^ (((sb >> 9) & 1) << 5); R = (st >> 1) * 16 + swz / 64; C = (st & 1) * 32 + (swz % 64) / 2; }

template <class Sched, class Epi>
__device__ __forceinline__ void gemm_phase_fast(LAS unsigned char* lds, const GemmDesc& g, const Sched& S, const Epi& E) {
    const int tid = otid(), wid = __builtin_amdgcn_readfirstlane(tid >> 6), lane = tid & 63, wr = wid >> 2, wc = wid & 3, fr = lane & 15, fq = lane >> 4;
    const int K = g.K, nt = K / 64, nunits = S.count(), G = gridDim.x, c0 = blockIdx.x;
    if (c0 >= nunits) return;
    int R[2], C[2]; unsigned voffB[2];
#pragma unroll
    for (int i = 0; i < 2; ++i) { stage_rc(tid * 16 + i * 8192, R[i], C[i]); voffB[i] = (unsigned)(R[i] * g.ldb + C[i]) * 2u; }
    const size_t kstep = 128;
    const size_t hstepB = (size_t)128 * g.ldb * 2;
    const unsigned ldsw = (unsigned)wid * 1024u;
    const int aoff = lds_byte(wr * 64 + fr, fq * 8), boff = lds_byte(wc * 32 + fr, fq * 8);
    const char* Ab = (const char*)g.A;
#define F_SA(b, h) (((b) * 2 + (h)) * HTB)
#define F_SB(b, h) ((4 + (b) * 2 + (h)) * HTB)
#define F_STAGE(bufoff, gbase, voff) do { _Pragma("unroll") for (int _i = 0; _i < 2; ++_i) \
        __builtin_amdgcn_global_load_lds((const unsigned*)((const char*)(gbase) + (voff)[_i]), (LAS unsigned*)(lds + (bufoff) + ldsw + _i * 8192), 16, 0, 0); } while (0)
#define F_LDA(dst, b, h) do { _Pragma("unroll") for (int m = 0; m < 4; ++m) _Pragma("unroll") for (int k = 0; k < 2; ++k) dst[m][k] = *(const LAS bf16x8*)(lds + F_SA(b, h) + aoff + m * 2048 + k * 1024); } while (0)
#define F_LDB(dst, b, h) do { _Pragma("unroll") for (int n = 0; n < 2; ++n) _Pragma("unroll") for (int k = 0; k < 2; ++k) dst[n][k] = *(const LAS bf16x8*)(lds + F_SB(b, h) + boff + n * 2048 + k * 1024); } while (0)
#define F_MMA(ai, bj, At, Bt) do { __builtin_amdgcn_s_setprio(1); _Pragma("unroll") for (int m = 0; m < 4; ++m) _Pragma("unroll") for (int n = 0; n < 2; ++n) _Pragma("unroll") for (int k = 0; k < 2; ++k) \
        acc[ai][bj][m][n] = __builtin_amdgcn_mfma_f32_16x16x32_bf16(Bt[n][k], At[m][k], acc[ai][bj][m][n], 0, 0, 0); __builtin_amdgcn_s_setprio(0); } while (0)
#define F_WAIT_V(n) asm volatile("s_waitcnt vmcnt(" #n ")" ::: "memory")
#define F_WAIT_L(n) asm volatile("s_waitcnt lgkmcnt(" #n ")" ::: "memory")
#define F_BAR __builtin_amdgcn_s_barrier()
#define F_SCHED __builtin_amdgcn_sched_barrier(0)
#define F_AROWS(u, dst) do { _Pragma("unroll") for (int _h = 0; _h < 2; ++_h) _Pragma("unroll") for (int _i = 0; _i < 2; ++_i) { const int _r = (u).arow0 + _h * 128 + R[_i]; int _s = g.ridx ? g.ridx[_r] : _r; if (_s < 0) _s = 0; dst[_h][_i] = _s; } } while (0)
#define F_AOFFS(src, dst) do { _Pragma("unroll") for (int _h = 0; _h < 2; ++_h) _Pragma("unroll") for (int _i = 0; _i < 2; ++_i) dst[_h][_i] = ((unsigned)src[_h][_i] * (unsigned)g.lda + (unsigned)C[_i]) * 2u; } while (0)
    GUnit cur, nxt; int ui = 0;
    S.unit(c0, cur);
    f32x4 acc[2][2][4][2];
#pragma unroll
    for (int a = 0; a < 2; ++a)
#pragma unroll
        for (int b = 0; b < 2; ++b)
#pragma unroll
            for (int m = 0; m < 4; ++m)
#pragma unroll
                for (int n = 0; n < 2; ++n) acc[a][b][m][n] = (f32x4){0.f, 0.f, 0.f, 0.f};
    bf16x8 At[4][2], B0[2][2], B1[2][2];
    unsigned voA[2][2]; int rnx[2][2];
    F_AROWS(cur, rnx); F_AOFFS(rnx, voA);
    const char* cB = (const char*)cur.B;
    F_STAGE(F_SB(0, 0), cB, voffB); F_STAGE(F_SA(0, 0), Ab, voA[0]); F_STAGE(F_SB(0, 1), cB + hstepB, voffB); F_STAGE(F_SA(0, 1), Ab, voA[1]);
    if (wr == 1) F_BAR;
    F_WAIT_V(4); F_BAR;
    F_STAGE(F_SB(1, 0), cB + kstep, voffB); F_STAGE(F_SA(1, 0), Ab + kstep, voA[0]); F_STAGE(F_SB(1, 1), cB + hstepB + kstep, voffB);
    F_WAIT_V(6); F_BAR;
    for (;;) {
        const int Ln = (ui + 1) * G + c0; const bool has_next = Ln < nunits;
        if (has_next) { S.unit(Ln, nxt); F_AROWS(nxt, rnx); }
        const char* nB = has_next ? (const char*)nxt.B : cB;
        for (int t = 0; t < nt; t += 2) {
            const bool last = (t == nt - 2);
            const char* a1 = Ab + (size_t)(t + 1) * kstep;
            const char* a2 = last ? Ab : Ab + (size_t)(t + 2) * kstep; const char* b2 = last ? nB : cB + (size_t)(t + 2) * kstep;
            const char* a3 = a2 + kstep; const char* b3 = b2 + kstep;
            F_LDB(B0, 0, 0); F_SCHED; F_LDA(At, 0, 0); F_STAGE(F_SA(1, 1), a1, voA[1]);
            if (last && has_next) F_AOFFS(rnx, voA);
            F_WAIT_L(8); F_BAR; F_WAIT_L(0); F_MMA(0, 0, At, B0); F_BAR; F_SCHED;
            F_LDB(B1, 0, 1); F_STAGE(F_SB(0, 0), b2, voffB);
            F_BAR; F_WAIT_L(0); F_MMA(0, 1, At, B1); F_BAR;
            F_LDA(At, 0, 1); F_STAGE(F_SA(0, 0), a2, voA[0]);
            F_BAR; F_WAIT_L(0); F_MMA(1, 0, At, B0); F_BAR; F_SCHED;
            F_STAGE(F_SB(0, 1), b2 + hstepB, voffB);
            F_WAIT_V(6); F_BAR; F_MMA(1, 1, At, B1); F_BAR;
            F_LDB(B0, 1, 0); F_SCHED; F_LDA(At, 1, 0); F_STAGE(F_SA(0, 1), a2, voA[1]);
            F_WAIT_L(8); F_BAR; F_WAIT_L(0); F_MMA(0, 0, At, B0); F_BAR; F_SCHED;
            F_LDB(B1, 1, 1); F_STAGE(F_SB(1, 0), b3, voffB);
            F_BAR; F_WAIT_L(0); F_MMA(0, 1, At, B1); F_BAR;
            F_LDA(At, 1, 1); F_STAGE(F_SA(1, 0), a3, voA[0]);
            F_BAR; F_WAIT_L(0); F_MMA(1, 0, At, B0); F_BAR; F_SCHED;
            F_STAGE(F_SB(1, 1), b3 + hstepB, voffB);
            F_WAIT_V(6); F_BAR; F_MMA(1, 1, At, B1); F_BAR;
        }
        E(acc, cur, wr, wc, fr, fq);
        if (!has_next) break;
#pragma unroll
        for (int a = 0; a < 2; ++a)
#pragma unroll
            for (int b = 0; b < 2; ++b)
#pragma unroll
                for (int m = 0; m < 4; ++m)
#pragma unroll
                    for (int n = 0; n < 2; ++n) acc[a][b][m][n] = (f32x4){0.f, 0.f, 0.f, 0.f};
        cur = nxt; cB = nB; ++ui;
    }
    F_WAIT_V(0);
    if (wr == 0) F_BAR;
    F_BAR;
#undef F_SA
#undef F_SB
#undef F_STAGE
#undef F_LDA
#undef F_LDB
#undef F_MMA
#undef F_WAIT_V
#undef F_WAIT_L
#undef F_BAR
#undef F_SCHED
#undef F_AROWS
#undef F_AOFFS
}
#define GEMM_PHASE(g, S, E) gemm_phase_fast(lds, g, S, E)
#endif

#define SBAR() __builtin_amdgcn_sched_barrier(0)
__device__ __forceinline__ int crow(int r, int hi) { return (r & 3) + 8 * (r >> 2) + 4 * hi; }
template <int DQK> __device__ __forceinline__ int kaddr(int row, int chunk) {
    const int sw = (DQK == 128) ? (row & 7) : ((row >> 1) & 7);
    return row * (DQK * 2) + ((chunk ^ sw) << 4);
}
__device__ __forceinline__ void partialSM(f32x16& p0, f32x16& p1, float& m_reg, float& mn, float& alpha, float C, float thr) {
    float pmax = p0[0];
#pragma unroll
    for (int r = 1; r < 16; ++r) pmax = fmaxf(pmax, p0[r]);
#pragma unroll
    for (int r = 0; r < 16; ++r) pmax = fmaxf(pmax, p1[r]);
    { auto rr = __builtin_amdgcn_permlane32_swap(__float_as_uint(pmax), __float_as_uint(pmax), false, false);
      pmax = fmaxf(__uint_as_float(rr[0]), __uint_as_float(rr[1])); }
    if (__builtin_expect(__all(pmax - m_reg <= thr), 1)) { mn = m_reg; alpha = 1.f; }
    else { mn = fmaxf(m_reg, pmax); alpha = __builtin_amdgcn_exp2f((m_reg - mn) * C); m_reg = mn; }
    const float mnC = -mn * C;
#pragma unroll
    for (int r = 0; r < 16; ++r) p0[r] = fmaf(p0[r], C, mnC);
#pragma unroll
    for (int r = 0; r < 16; ++r) p1[r] = fmaf(p1[r], C, mnC);
#pragma unroll
    for (int r = 0; r < 16; ++r) p0[r] = __builtin_amdgcn_exp2f(p0[r]);
}
__device__ __forceinline__ void finishSM(f32x16& p0, f32x16& p1, float alpha, float& l_reg, bf16x8& pa0, bf16x8& pa1, bf16x8& pa2, bf16x8& pa3) {
#pragma unroll
    for (int r = 0; r < 16; ++r) p1[r] = __builtin_amdgcn_exp2f(p1[r]);
    float ps = 0;
#pragma unroll
    for (int r = 0; r < 16; ++r) ps += p0[r];
#pragma unroll
    for (int r = 0; r < 16; ++r) ps += p1[r];
    { auto rr = __builtin_amdgcn_permlane32_swap(__float_as_uint(ps), __float_as_uint(ps), false, false);
      ps = __uint_as_float(rr[0]) + __uint_as_float(rr[1]); }
    l_reg = l_reg * alpha + ps;
#define PK4(P, BASE, OUT) do { unsigned a0 = pk2(P[BASE + 0], P[BASE + 1]), a1 = pk2(P[BASE + 2], P[BASE + 3]);   \
    unsigned b0 = pk2(P[BASE + 4], P[BASE + 5]), b1 = pk2(P[BASE + 6], P[BASE + 7]);                              \
    auto r0 = __builtin_amdgcn_permlane32_swap(a0, b0, false, false); auto r1 = __builtin_amdgcn_permlane32_swap(a1, b1, false, false); \
    u32x4 w = {r0[0], r1[0], r0[1], r1[1]}; OUT = *reinterpret_cast<bf16x8*>(&w); } while (0)
    PK4(p0, 0, pa0); PK4(p0, 8, pa1); PK4(p1, 0, pa2); PK4(p1, 8, pa3);
#undef PK4
}
template <int DQK> __device__ __forceinline__ void qkt(f32x16& p0, f32x16& p1, const char* Ks, const bf16x8* qr, int r32, int hi) {
    p0 = f32x16{}; p1 = f32x16{};
#pragma unroll
    for (int d0 = 0; d0 < DQK / 16; ++d0) { const int ch = 2 * d0 + hi;
        const bf16x8 b0 = *reinterpret_cast<const bf16x8*>(Ks + kaddr<DQK>(r32, ch));
        const bf16x8 b1 = *reinterpret_cast<const bf16x8*>(Ks + kaddr<DQK>(32 + r32, ch));
        p0 = __builtin_amdgcn_mfma_f32_32x32x16_bf16(b0, qr[d0], p0, 0, 0, 0);
        p1 = __builtin_amdgcn_mfma_f32_32x32x16_bf16(b1, qr[d0], p1, 0, 0, 0); }
}
__device__ __forceinline__ int v_st(int k, int c) { const int kk = (k & ~0xC) | ((k & 4) << 1) | ((k & 8) >> 1); return ((kk >> 3) * 4 + (c >> 5)) * 512 + ((kk & 7) * 32 + (c & 31)) * 2; }
__device__ __forceinline__ int v_rd_base(int lane) { return ((lane & 3) << 3) | (((lane >> 2) & 3) << 6) | (((lane >> 4) & 1) << 5) | (((lane >> 5) & 1) << 8); }
constexpr int v_rd_off(int d0, int ks, int half) { return d0 * 512 + ks * 4096 + half * 2048; }
template <int OFF> __device__ __forceinline__ s16x4 tr_read(int vb) {
    s16x4 r; asm volatile("ds_read_b64_tr_b16 %0, %1 offset:%2" : "=&v"(r) : "v"(vb), "i"(OFF) : "memory"); return r;
}
template <int D0> __device__ __forceinline__ void pv_one(f32x16& od, int vb, bf16x8 pa0, bf16x8 pa1, bf16x8 pa2, bf16x8 pa3) {
    const s16x4 l0 = tr_read<v_rd_off(D0, 0, 0)>(vb), h0 = tr_read<v_rd_off(D0, 0, 1)>(vb), l1 = tr_read<v_rd_off(D0, 1, 0)>(vb), h1 = tr_read<v_rd_off(D0, 1, 1)>(vb);
    const s16x4 l2 = tr_read<v_rd_off(D0, 2, 0)>(vb), h2 = tr_read<v_rd_off(D0, 2, 1)>(vb), l3 = tr_read<v_rd_off(D0, 3, 0)>(vb), h3 = tr_read<v_rd_off(D0, 3, 1)>(vb);
    asm volatile("s_waitcnt lgkmcnt(0)" ::: "memory"); SBAR();
#define PK(L, H) (bf16x8){L[0], L[1], L[2], L[3], H[0], H[1], H[2], H[3]}
    od = __builtin_amdgcn_mfma_f32_32x32x16_bf16(pa0, PK(l0, h0), od, 0, 0, 0);
    od = __builtin_amdgcn_mfma_f32_32x32x16_bf16(pa1, PK(l1, h1), od, 0, 0, 0);
    od = __builtin_amdgcn_mfma_f32_32x32x16_bf16(pa2, PK(l2, h2), od, 0, 0, 0);
    od = __builtin_amdgcn_mfma_f32_32x32x16_bf16(pa3, PK(l3, h3), od, 0, 0, 0);
#undef PK
}
__device__ __forceinline__ void pv_d0(f32x16* o, int vb, bf16x8 pa0, bf16x8 pa1, bf16x8 pa2, bf16x8 pa3) {
    pv_one<0>(o[0], vb, pa0, pa1, pa2, pa3); pv_one<1>(o[1], vb, pa0, pa1, pa2, pa3); pv_one<2>(o[2], vb, pa0, pa1, pa2, pa3); pv_one<3>(o[3], vb, pa0, pa1, pa2, pa3);
}

template <int DQK, int SDEPTH>
__device__ __forceinline__ void attn_body(const bf16_t* __restrict__ Qb, const bf16_t* __restrict__ Kh, const bf16_t* __restrict__ Vh, bf16_t* __restrict__ Ob, int ldo, int nkeys, float scale, char* lds) {
    constexpr int SHM_V = 64 * 128 * 2, SHM_K = 64 * DQK * 2, NKC = DQK / 8, KPT = NKC / 8;
    int tid = otid();
    const int wid = tid >> 6, lane = tid & 63, r32 = lane & 31, hi = lane >> 5;
    char* V_lds = lds; char* K_lds = lds + 2 * SHM_V;
    float* ws = (float*)(lds + 2 * SHM_V + 2 * SHM_K) + wid * 64; float* li_l = ws; float* al_l = ws + 32;
    const float C = scale * 1.4426950408889634f, thr = 8.0f / scale;
    float m_reg = -1e30f, l_reg = 0; f32x16 o[4] = {}; bf16x8 qr[DQK / 16];
    const bf16_t* Qw = Qb + (long)(wid * 32 + r32) * DQK + hi * 8;
#pragma unroll
    for (int d0 = 0; d0 < DQK / 16; ++d0) qr[d0] = *reinterpret_cast<const bf16x8*>(Qw + d0 * 16);
    const int sr = tid >> 4, sc = (tid & 15) * 8, vst0 = v_st(sr, sc), vst1 = v_st(32 + sr, sc);
    int kgo[KPT], klo[KPT];
#pragma unroll
    for (int i = 0; i < KPT; ++i) { const int q = tid + 512 * i, row = q / NKC, ch = q % NKC; kgo[i] = row * DQK + ch * 8; klo[i] = kaddr<DQK>(row, ch); }
    const int vb0 = (int)(uintptr_t)V_lds + v_rd_base(lane);
    struct { bf16x8 vs0, vs1, ks[KPT]; } sr_[SDEPTH ? SDEPTH : 1];
#define SLOAD(i, k0) do { sr_[i].vs0 = *reinterpret_cast<const bf16x8*>(&Vh[(long)((k0) + sr) * 128 + sc]); sr_[i].vs1 = *reinterpret_cast<const bf16x8*>(&Vh[(long)((k0) + 32 + sr) * 128 + sc]); \
    _Pragma("unroll") for (int _q = 0; _q < KPT; ++_q) sr_[i].ks[_q] = *reinterpret_cast<const bf16x8*>(&Kh[(long)(k0) * DQK + kgo[_q]]); } while (0)
#define SWRITE(b, i) do { *(bf16x8*)(V_lds + (b) * SHM_V + vst0) = sr_[i].vs0; *(bf16x8*)(V_lds + (b) * SHM_V + vst1) = sr_[i].vs1; \
    _Pragma("unroll") for (int _q = 0; _q < KPT; ++_q) *(bf16x8*)(K_lds + (b) * SHM_K + klo[_q]) = sr_[i].ks[_q]; } while (0)
#define SWAIT() do { if constexpr (SDEPTH == 2) { if constexpr (KPT == 2) asm volatile("s_waitcnt vmcnt(4)" ::: "memory"); else asm volatile("s_waitcnt vmcnt(5)" ::: "memory"); } \
    else asm volatile("s_waitcnt vmcnt(0)" ::: "memory"); } while (0)
#define RESC(a) do { if (__any((a) < 1.f)) { if (hi == 0) al_l[r32] = (a); asm volatile("s_waitcnt lgkmcnt(0)" ::: "memory"); \
    _Pragma("unroll") for (int d = 0; d < 4; ++d) _Pragma("unroll") for (int r = 0; r < 16; ++r) o[d][r] *= al_l[crow(r, hi)]; } } while (0)
    bf16x8 pa0, pa1, pa2, pa3; const int NT = nkeys / 64;
    if constexpr (SDEPTH == 0) {
        f32x16 pA0, pA1; float mnA, alA;
        SLOAD(0, 0); asm volatile("s_waitcnt vmcnt(0)" ::: "memory"); SWRITE(0, 0); __syncthreads();
        for (int j = 0; j < NT; ++j) {
            const int bo = j & 1;
            if (j + 1 < NT) SLOAD(0, (j + 1) * 64);
            SBAR(); qkt<DQK>(pA0, pA1, K_lds + bo * SHM_K, qr, r32, hi); partialSM(pA0, pA1, m_reg, mnA, alA, C, thr);
            RESC(alA); finishSM(pA0, pA1, alA, l_reg, pa0, pa1, pa2, pa3); SBAR();
            pv_d0(o, vb0 + bo * SHM_V, pa0, pa1, pa2, pa3);
            if (j + 1 < NT) { asm volatile("s_waitcnt vmcnt(0)" ::: "memory"); SWRITE(bo ^ 1, 0); }
            __syncthreads();
        }
    } else {
    f32x16 pA0, pA1, pB0, pB1; float mnA, mnB, alA, alB;
    constexpr int SE = 0, SO = SDEPTH - 1;
    SLOAD(SE, 0); asm volatile("s_waitcnt vmcnt(0)" ::: "memory"); SWRITE(0, SE); __syncthreads();
    qkt<DQK>(pA0, pA1, K_lds, qr, r32, hi); partialSM(pA0, pA1, m_reg, mnA, alA, C, thr);
    SLOAD(SO, 64); if constexpr (SDEPTH == 2) { if (2 < NT) SLOAD(SE, 2 * 64); }
    SWAIT(); SWRITE(1, SO); __syncthreads();
    for (int j = 1; j + 1 < NT; j += 2) {
        SBAR(); qkt<DQK>(pB0, pB1, K_lds + SHM_K, qr, r32, hi);
        finishSM(pA0, pA1, alA, l_reg, pa0, pa1, pa2, pa3); SBAR();
        SLOAD(SO, (j + SDEPTH) * 64); SBAR();
        pv_d0(o, vb0, pa0, pa1, pa2, pa3); partialSM(pB0, pB1, m_reg, mnB, alB, C, thr);
        __syncthreads(); SWAIT(); SWRITE(0, SE);
        RESC(alB); __syncthreads();
        SBAR(); qkt<DQK>(pA0, pA1, K_lds, qr, r32, hi);
        finishSM(pB0, pB1, alB, l_reg, pa0, pa1, pa2, pa3); SBAR();
        if (SDEPTH == 1 || j + 3 < NT) SLOAD(SE, (j + 1 + SDEPTH) * 64); SBAR();
        pv_d0(o, vb0 + SHM_V, pa0, pa1, pa2, pa3); partialSM(pA0, pA1, m_reg, mnA, alA, C, thr);
        __syncthreads(); SWAIT(); SWRITE(1, SO);
        RESC(alA); __syncthreads();
    }
    SBAR(); qkt<DQK>(pB0, pB1, K_lds + SHM_K, qr, r32, hi);
    finishSM(pA0, pA1, alA, l_reg, pa0, pa1, pa2, pa3); SBAR();
    pv_d0(o, vb0, pa0, pa1, pa2, pa3); partialSM(pB0, pB1, m_reg, mnB, alB, C, thr);
    __syncthreads(); RESC(alB);
    finishSM(pB0, pB1, alB, l_reg, pa0, pa1, pa2, pa3); SBAR();
    pv_d0(o, vb0 + SHM_V, pa0, pa1, pa2, pa3);
    }
    if (hi == 0) li_l[r32] = l_reg; asm volatile("s_waitcnt lgkmcnt(0)" ::: "memory");
    float rli[16];
#pragma unroll
    for (int r = 0; r < 16; ++r) rli[r] = __builtin_amdgcn_rcpf(li_l[crow(r, hi)]);
    bf16_t* Ow = Ob + (long)(wid * 32) * ldo;
#pragma unroll
    for (int r = 0; r < 16; ++r) { const int orow = crow(r, hi);
#pragma unroll
        for (int d0 = 0; d0 < 4; ++d0) Ow[(long)orow * ldo + d0 * 32 + r32] = f2bf(o[d0][r] * rli[r]); }
    __syncthreads();
#undef SLOAD
#undef SWRITE
#undef SWAIT
#undef RESC
}

__device__ __forceinline__ void cvt_tile(const float* __restrict__ src, int ldsrc, int k0, int n0, bf16_t* __restrict__ dst, int lddst, int drow0, const float* __restrict__ kscale, LAS float* tile) {
    int tid = otid();
    { const int r = tid >> 4, c4 = (tid & 15) * 4;
#pragma unroll
      for (int ps = 0; ps < 2; ++ps) { const int k = r + 32 * ps; const f32x4 v = *(const f32x4*)(src + (size_t)(k0 + k) * ldsrc + n0 + c4); const float s = kscale ? kscale[k0 + k] : 1.0f;
          tile[k * 65 + c4 + 0] = v[0] * s; tile[k * 65 + c4 + 1] = v[1] * s; tile[k * 65 + c4 + 2] = v[2] * s; tile[k * 65 + c4 + 3] = v[3] * s; } }
    __syncthreads();
    { const int n = tid >> 3, kc = (tid & 7) * 8; float v[8];
#pragma unroll
      for (int j = 0; j < 8; ++j) v[j] = tile[(kc + j) * 65 + n];
      u32x4 w; w.x = pk2(v[0], v[1]); w.y = pk2(v[2], v[3]); w.z = pk2(v[4], v[5]); w.w = pk2(v[6], v[7]);
      *(u32x4*)(dst + (size_t)(drow0 + n) * lddst + k0 + kc) = w; }
    __syncthreads();
}
constexpr int CVT_SMALL = 1952 + 1024 + 216 + 96;
__device__ __forceinline__ void cvt_small_task(const Params& p, int l, int t, LAS float* tile) {
    unsigned char* ws = p.ws;
    if (t < 1952) { const int kb = t / 61, nb = t % 61; cvt_tile(p.in[I_WIN] + (size_t)l * DM * IN_COLS, IN_COLS, kb * 64, nb * 64, (bf16_t*)(ws + O_WIN) + (size_t)l * NP * DM, DM, nb * 64, nullptr, tile); return; }
    t -= 1952;
    if (t < 1024) { const int kb = t >> 5, nb = t & 31; cvt_tile(p.in[I_WOUT] + (size_t)l * DM * DM, DM, kb * 64, nb * 64, (bf16_t*)(ws + O_WOUT) + (size_t)l * DM * DM, DM, nb * 64, nullptr, tile); return; }
    t -= 1024;
    if (t < 216) { const int kb = t / 18, nb = t % 18; cvt_tile(p.in[I_WUQ] + (size_t)l * 768 * 1152, 1152, kb * 64, nb * 64, (bf16_t*)(ws + O_WUQ) + (size_t)l * NQP * 768, 768, nb * 64, p.in[I_MQN] + l * 768, tile); return; }
    t -= 216;
    { const int kb = t / 24, nb = t % 24; cvt_tile(p.in[I_WUKV] + (size_t)l * 256 * 1536, 1536, kb * 64, nb * 64, (bf16_t*)(ws + O_WUKV) + (size_t)l * 1536 * 256, 256, nb * 64, p.in[I_MKVN] + l * 256, tile); }
}
constexpr int CVT_EXP = 65 * 768;
__device__ __forceinline__ void cvt_exp_task(const Params& p, int l, int t, LAS float* tile) {
    unsigned char* ws = p.ws;
    const int e = t / 768, r = t % 768, which = r >> 8, q = r & 255;
    bf16_t* gu = (bf16_t*)(ws + O_EGU) + (size_t)e * 1024 * 2048; bf16_t* dn = (bf16_t*)(ws + O_ED) + (size_t)e * 2048 * 512;
    if (which < 2) {
        const float* src = (e < NEXP) ? p.in[which == 0 ? I_EG : I_EU] + ((size_t)l * NEXP + e) * DM * EH : p.in[which == 0 ? I_SG : I_SU] + (size_t)l * DM * EH;
        const int kb = q >> 3, nb = q & 7, n0 = nb * 64;
        cvt_tile(src, EH, kb * 64, n0, gu, DM, (n0 >> 7) * 256 + (n0 & 127) + which * 128, nullptr, tile);
    } else {
        const float* src = (e < NEXP) ? p.in[I_EDN] + ((size_t)l * NEXP + e) * EH * DM : p.in[I_SD] + (size_t)l * EH * DM;
        const int kb = q >> 5, nb = q & 31;
        cvt_tile(src, DM, kb * 64, nb * 64, dn, EH, nb * 64, nullptr, tile);
    }
}
__device__ __forceinline__ void adaln_tasks(const Params& p, LAS float* lf) {
    const int lane = otid() & 63, wid = otid() >> 6;
    float* MOD = (float*)(p.ws + O_MOD);
    for (int task = blockIdx.x; task < 384; task += gridDim.x) {
        const int cb = task % 192, l = task / 192, col = cb * 64 + lane;
        const float* W = p.in[I_ADAW] + (size_t)l * DM * 12288 + col;
        float acc[9];
#pragma unroll
        for (int r = 0; r < 9; ++r) acc[r] = 0.f;
        for (int kb = wid * 256; kb < wid * 256 + 256; kb += 64) {
            float sv[9];
#pragma unroll
            for (int r = 0; r < 8; ++r) sv[r] = silu_f(p.in[I_C][r * DM + kb + lane]);
            sv[8] = silu_f(p.in[I_CCTX][kb + lane]);
#pragma unroll 8
            for (int kk = 0; kk < 64; ++kk) { const float w = W[(size_t)(kb + kk) * 12288];
#pragma unroll
                for (int r = 0; r < 9; ++r) acc[r] += rdlane(sv[r], kk) * w; }
        }
#pragma unroll
        for (int r = 0; r < 9; ++r) lf[(wid * 9 + r) * 64 + lane] = acc[r];
        __syncthreads();
        for (int r = wid; r < 9; r += 8) { float s = p.in[I_ADAB][l * 12288 + col];
#pragma unroll
            for (int w = 0; w < 8; ++w) s += lf[(w * 9 + r) * 64 + lane];
            MOD[(size_t)(l * 9 + r) * 12288 + col] = s; }
        __syncthreads();
    }
}
__device__ __forceinline__ void hss_tasks(const Params& p) {
    const int lane = otid() & 63, gw = blockIdx.x * 8 + (otid() >> 6), GW = gridDim.x * 8;
    for (int task = gw; task < 3 * 1024; task += GW) {
        const int set = task >> 10, l = (set == 1) ? 1 : 0, nset = (set == 2) ? 1 : 0, ord = (task >> 9) & 1, ch = task & 511, n = nset ? 256 : 2048;
        const float* HF = (const float*)(p.ws + O_HF) + (size_t)l * HF_LAYER + (nset ? HF_L0 : 0);
        const float* hf = HF + (size_t)((ord * 2 + 0) * 512 + ch) * n; const float* hb = HF + (size_t)((ord * 2 + 1) * 512 + ch) * n;
        float s = 0.f;
        for (int i = lane; i < n; i += 64) { const float a = hf[i], b = (i == 0) ? 0.f : hb[i]; s += a * a + b * b; }
        s = wave_sum(s);
        if (lane == 0) ((float*)(p.ws + O_HSS))[(size_t)((l * 2 + nset) * 2 + ord) * 512 + ch] = s;
    }
}
__device__ __forceinline__ void hyf_task(const Params& p, int l, int nset, int i0, LAS float* lf) {
    int tid = otid(); const int n = nset ? 256 : 2048;
    LAS float* feats = lf; LAS float* hd1 = lf + 8 * 33; LAS float* hd2 = hd1 + 512;
    if (tid < 8 * 33) { const int pos = tid / 33, f = tid % 33, i = i0 + pos; const float t = (float)i / (float)(n - 1), ang = 6.283185307179586f * (float)i / (float)n; float v;
        if (f == 0) v = t; else { const int j = (f - 1) & 15; const float band = 1e-4f + (float)j * ((15.0f - 1e-4f) / 15.0f); v = (f <= 16) ? cosf(ang * band) : sinf(ang * band); }
        feats[tid] = v; }
    __syncthreads();
    { const int pos = tid >> 6, j = tid & 63; const float* w1 = p.in[I_HYW1] + l * 33 * 64; float s = p.in[I_HYB1][l * 64 + j];
      for (int f = 0; f < 33; ++f) s += feats[pos * 33 + f] * w1[f * 64 + j];
      hd1[tid] = sinf(p.in[I_HYFREQ][l * 64 + j] * s); }
    __syncthreads();
    { const int pos = tid >> 6, j = tid & 63; const float* w2 = p.in[I_HYW2] + l * 64 * 64; float s = p.in[I_HYB2][l * 64 + j];
      for (int f = 0; f < 64; ++f) s += hd1[pos * 64 + f] * w2[f * 64 + j];
      hd2[tid] = sinf(p.in[I_HYFREQ][l * 64 + j] * s); }
    __syncthreads();
    const float* w3 = p.in[I_HYW3] + (size_t)l * 64 * 2048 + tid * 4;
    f32x4 acc[8];
#pragma unroll
    for (int q = 0; q < 8; ++q) acc[q] = (f32x4){0.f, 0.f, 0.f, 0.f};
    for (int j = 0; j < 64; ++j) { const f32x4 w = *(const f32x4*)(w3 + (size_t)j * 2048);
#pragma unroll
        for (int q = 0; q < 8; ++q) acc[q] += w * hd2[q * 64 + j]; }
    float* HF = (float*)(p.ws + O_HF) + (size_t)l * HF_LAYER + (nset ? HF_L0 : 0);
#pragma unroll
    for (int c = 0; c < 4; ++c) { const int col = tid * 4 + c, ord = col >> 10, dir = (col >> 9) & 1, ch = col & 511;
        const float delta = 3.0701134573253944f + (float)ch * ((15.350567286626973f - 3.0701134573253944f) / 511.0f); float v[8];
#pragma unroll
        for (int q = 0; q < 8; ++q) { const int i = i0 + q; const float t = (float)i / (float)(n - 1); v[q] = acc[q][c] * __expf(-t * delta); }
        float* dst = HF + (size_t)((ord * 2 + dir) * 512 + ch) * n + i0;
        *(f32x4*)dst = (f32x4){v[0], v[1], v[2], v[3]}; *(f32x4*)(dst + 4) = (f32x4){v[4], v[5], v[6], v[7]};    }
    __syncthreads();
}
__device__ __forceinline__ void phase_prologue(const Params& p, LAS unsigned char* lds) {
    const int tid = otid(); LAS float* lf = (LAS float*)lds;
    { const size_t gt = (size_t)blockIdx.x * NTHREADS + tid, GT = (size_t)gridDim.x * NTHREADS;
      for (int l = 0; l < NLAYER; ++l) {
          u32x4* z1 = (u32x4*)((bf16_t*)(p.ws + O_WIN) + ((size_t)l * NP + IN_COLS) * DM); const size_t n1 = (size_t)(NP - IN_COLS) * DM * 2 / 16;
          for (size_t i = gt; i < n1; i += GT) z1[i] = (u32x4){0u, 0u, 0u, 0u};
          u32x4* z2 = (u32x4*)((bf16_t*)(p.ws + O_WUQ) + ((size_t)l * NQP + 1152) * 768); const size_t n2 = (size_t)(NQP - 1152) * 768 * 2 / 16;
          for (size_t i = gt; i < n2; i += GT) z2[i] = (u32x4){0u, 0u, 0u, 0u};
      } }
    adaln_tasks(p, lf);
    for (int t = blockIdx.x; t < 544; t += gridDim.x) { if (t < 512) hyf_task(p, t >> 8, 0, (t & 255) * 8, lf); else hyf_task(p, 0, 1, (t - 512) * 8, lf); }
    for (int t = blockIdx.x; t < NLAYER * CVT_SMALL; t += gridDim.x) cvt_small_task(p, t / CVT_SMALL, t % CVT_SMALL, lf);
    for (int t = blockIdx.x; t < CVT_EXP; t += gridDim.x) cvt_exp_task(p, 0, t, lf);
}

__device__ __forceinline__ void norm1_row(const Params& p, int l, int row, const float (&x)[32], int lane) {
    float ss = 0.f;
#pragma unroll
    for (int i = 0; i < 32; ++i) ss += x[i] * x[i];
    ss = wave_sum(ss); const float rstd = rsqrtf(ss * (1.0f / DM) + EPS);
    const float* g = p.in[I_NORMG] + (size_t)(l * 4 + 0) * DM; const float* mod = (const float*)(p.ws + O_MOD) + (size_t)(l * 9 + row_batch(row)) * 12288;
    bf16_t* H = (bf16_t*)(p.ws + O_H) + (size_t)row * DM;
#pragma unroll
    for (int j = 0; j < 8; ++j) { const int c = ROWCOL(j, lane); const f32x4 gv = *(const f32x4*)(g + c), sh = *(const f32x4*)(mod + c), sc = *(const f32x4*)(mod + DM + c); float h[4];
#pragma unroll
        for (int q = 0; q < 4; ++q) h[q] = x[j * 4 + q] * rstd * gv[q] * (1.0f + sc[q]) + sh[q];
        u32x2 w; w.x = pk2(h[0], h[1]); w.y = pk2(h[2], h[3]); *(u32x2*)(H + c) = w; }
}
__device__ __forceinline__ void phase_norm1(const Params& p, int l) {
    const int lane = otid() & 63, gw = blockIdx.x * 8 + (otid() >> 6), GW = gridDim.x * 8;
    for (int row = gw; row < NTOK; row += GW) { const float* src = resid_src(p, l, row); float x[32];
#pragma unroll
        for (int j = 0; j < 8; ++j) { const f32x4 v = *(const f32x4*)(src + ROWCOL(j, lane)); x[j * 4] = v[0]; x[j * 4 + 1] = v[1]; x[j * 4 + 2] = v[2]; x[j * 4 + 3] = v[3]; }
        norm1_row(p, l, row, x, lane); }
}

template <int HALF> __device__ __forceinline__ float rope1(float x, int e, float a) {
    float s, c; sincosf(a, &s, &c); const float pr = __shfl_xor(x, HALF);
    return (e & HALF) ? pr * s + x * c : x * c - pr * s;
}
__device__ __forceinline__ void gqa_post_row(const Params& p, int l, int row, int lane) {
    const bf16_t* P = (const bf16_t*)(p.ws + O_P) + (size_t)row * NP;
    const bool isctx = row >= NLAT; const int b = isctx ? (row - NLAT) >> 8 : row >> 11, t = isctx ? (row - NLAT) & 255 : row & 2047;
    const float inv = exp2f(-(float)(lane & 31) * (13.287712379549449f / 32.0f));
    const float a0 = (float)(t >> 6) * inv, a1 = (float)(t & 63) * inv;
    const float* qn = p.in[I_GQN] + l * 128; const float* kn = p.in[I_GKN] + l * 128;
    for (int h = 0; h < 6; ++h) {
        float x0 = bf2f(P[C_GQ + h * 128 + lane]), x1 = bf2f(P[C_GQ + h * 128 + 64 + lane]);
        const float rstd = rsqrtf(wave_sum(x0 * x0 + x1 * x1) * (1.0f / 128.0f) + EPS);
        x0 *= rstd * qn[lane]; x1 *= rstd * qn[64 + lane];
        if (!isctx) { x0 = rope1<32>(x0, lane, a0); x1 = rope1<32>(x1, lane, a1); }
        bf16_t* dst = isctx ? (bf16_t*)(p.ws + O_QGC) + ((size_t)(b * 6 + h) * CTXL + t) * 128 : (bf16_t*)(p.ws + O_QG) + ((size_t)(b * 6 + h) * SEQ + t) * 128;
        dst[lane] = f2bf(x0); dst[64 + lane] = f2bf(x1);
    }
    const int kpos = isctx ? t : CTXL + t;
    for (int h = 0; h < 2; ++h) {
        float x0 = bf2f(P[C_GK + h * 128 + lane]), x1 = bf2f(P[C_GK + h * 128 + 64 + lane]);
        const float rstd = rsqrtf(wave_sum(x0 * x0 + x1 * x1) * (1.0f / 128.0f) + EPS);
        x0 *= rstd * kn[lane]; x1 *= rstd * kn[64 + lane];
        if (!isctx) { x0 = rope1<32>(x0, lane, a0); x1 = rope1<32>(x1, lane, a1); }
        bf16_t* kd = (bf16_t*)(p.ws + O_KG) + ((size_t)(b * 2 + h) * LK + kpos) * 128; kd[lane] = f2bf(x0); kd[64 + lane] = f2bf(x1);
        bf16_t* vd = (bf16_t*)(p.ws + O_VG) + ((size_t)(b * 2 + h) * LK + kpos) * 128; vd[lane] = P[C_GV + h * 128 + lane]; vd[64 + lane] = P[C_GV + h * 128 + 64 + lane];
    }
}
__device__ __forceinline__ void seq_of(int row, int& s0, int& n) { if (row < NLAT) { s0 = row & ~2047; n = SEQ; } else { s0 = NLAT + ((row - NLAT) & ~255); n = CTXL; } }
__device__ __forceinline__ void load_conv_tile(const bf16_t* P, int t0, int pc0, LAS float* u) {
    int s0, n; seq_of(t0, s0, n);
    for (int i = otid(); i < 66 * 64; i += NTHREADS) { const int r = i >> 6, c = i & 63, row = t0 - 1 + r;
        u[r * 65 + c] = (row >= s0 && row < s0 + n) ? bf2f(P[(size_t)row * NP + pc0 + c]) : 0.f; }
}
__device__ __forceinline__ void hy_prep_task(const Params& p, int l, int t0, int c0, LAS float* u) {
    const bf16_t* P = (const bf16_t*)(p.ws + O_P);
    load_conv_tile(P, t0, c0, u);
    __syncthreads();
    const int tid = otid(), c = tid >> 3, tc = (tid & 7) * 8; const float* cw = p.in[I_HYCONV] + (size_t)l * 3 * 1536 + c0 + c;
    const float w0 = cw[0], w1 = cw[1536], w2 = cw[3072]; float y[8];
#pragma unroll
    for (int j = 0; j < 8; ++j) y[j] = w0 * u[(tc + j) * 65 + c] + w1 * u[(tc + j + 1) * 65 + c] + w2 * u[(tc + j + 2) * 65 + c];
    const int ch = c0 + c; bf16_t* dst = (ch < 512 ? (bf16_t*)(p.ws + O_VT) + (size_t)ch * NTOK : (bf16_t*)(p.ws + O_X1T) + (size_t)(ch - 512) * NTOK) + t0 + tc;
    u32x4 w; w.x = pk2(y[0], y[1]); w.y = pk2(y[2], y[3]); w.z = pk2(y[4], y[5]); w.w = pk2(y[6], y[7]); *(u32x4*)dst = w;
    __syncthreads();
}
__device__ __forceinline__ void mla_post_row(const Params& p, int l, int row, int lane) {
    const bf16_t* P = (const bf16_t*)(p.ws + O_P) + (size_t)row * NP;
    const bool isctx = row >= NLAT; const int b = isctx ? (row - NLAT) >> 8 : row >> 11, t = isctx ? (row - NLAT) & 255 : row & 2047;
    float sq = 0.f, skv = 0.f;
#pragma unroll
    for (int j = 0; j < 12; ++j) { const float v = bf2f(P[C_CQ + j * 64 + lane]); sq += v * v; }
#pragma unroll
    for (int j = 0; j < 4; ++j) { const float v = bf2f(P[C_CKV + j * 64 + lane]); skv += v * v; }
    const float rq = rsqrtf(wave_sum(sq) * (1.0f / 768.0f) + EPS), rkv = rsqrtf(wave_sum(skv) * (1.0f / 256.0f) + EPS);
    const int half = lane >> 5, e = lane & 31;
    const float inv = exp2f(-(float)(e & 15) * (13.287712379549449f / 16.0f));
    const float ang = (float)(half ? (t & 63) : (t >> 6)) * inv;
    const bf16_t* QR = (const bf16_t*)(p.ws + O_QRAW) + (size_t)row * NQP; const bf16_t* KV = (const bf16_t*)(p.ws + O_KVRAW) + (size_t)row * 1536;
    float kr = bf2f(P[C_KR + lane]); if (!isctx) kr = rope1<16>(kr, e, ang);
    const bf16_t krb = f2bf(kr); const int kpos = isctx ? t : CTXL + t;
    for (int h = 0; h < 6; ++h) {
        bf16_t* qd = isctx ? (bf16_t*)(p.ws + O_QMC) + ((size_t)(b * 6 + h) * CTXL + t) * 192 : (bf16_t*)(p.ws + O_QM) + ((size_t)(b * 6 + h) * SEQ + t) * 192;
        qd[lane] = f2bf(bf2f(QR[h * 192 + lane]) * rq); qd[64 + lane] = f2bf(bf2f(QR[h * 192 + 64 + lane]) * rq);
        float qr = bf2f(QR[h * 192 + 128 + lane]) * rq; if (!isctx) qr = rope1<16>(qr, e, ang);
        qd[128 + lane] = f2bf(qr);
        bf16_t* kd = (bf16_t*)(p.ws + O_KM) + ((size_t)(b * 6 + h) * LK + kpos) * 192;
        kd[lane] = f2bf(bf2f(KV[h * 256 + lane]) * rkv); kd[64 + lane] = f2bf(bf2f(KV[h * 256 + 64 + lane]) * rkv); kd[128 + lane] = krb;
        bf16_t* vd = (bf16_t*)(p.ws + O_VM) + ((size_t)(b * 6 + h) * LK + kpos) * 128;
        vd[lane] = f2bf(bf2f(KV[h * 256 + 128 + lane]) * rkv); vd[64 + lane] = f2bf(bf2f(KV[h * 256 + 192 + lane]) * rkv);
    }
}

__device__ __forceinline__ void hyconv_unit_valu(const Params& p, int l, int nset, int c, LAS float* lf) {
    const int tid = otid(), n = nset ? CTXL : SEQ, tokbase = nset ? NLAT : 0;
    LAS float* kc = lf; LAS float* z = lf + 4096; LAS float* z2 = z + 8 * SEQ;
    const float* HF = (const float*)(p.ws + O_HF) + (size_t)l * HF_LAYER + (nset ? HF_L0 : 0); const float* HSS = (const float*)(p.ws + O_HSS) + (size_t)((l * 2 + nset) * 2) * 512;
    const bf16_t* VT = (const bf16_t*)(p.ws + O_VT) + (size_t)c * NTOK + tokbase; const bf16_t* X1T = (const bf16_t*)(p.ws + O_X1T) + (size_t)c * NTOK + tokbase;
    bf16_t* Y2T = (bf16_t*)(p.ws + O_Y2T) + (size_t)c * NTOK + tokbase;
    for (int i = tid; i < 8 * n; i += NTHREADS) z[i] = bf2f(VT[i]);
    for (int ord = 0; ord < 2; ++ord) {
        const float rs = rsqrtf(HSS[ord * 512 + c] + EPS); const float* hf = HF + (size_t)((ord * 2 + 0) * 512 + c) * n; const float* hb = HF + (size_t)((ord * 2 + 1) * 512 + c) * n;
        for (int m = tid; m < 2 * n; m += NTHREADS) { const int lag = m - (n - 1); kc[m] = (m == 2 * n - 1) ? 0.f : (lag >= 0 ? hf[lag] : hb[-lag]) * rs; }
        __syncthreads();
        const LAS float* zs = ord ? z2 : z; const float skip = p.in[I_HYSKIP][(size_t)(l * 2 + ord) * 512 + c];
        for (int q = tid; q < n; q += NTHREADS) {
            const int b = q / (n >> 3), t0 = (q % (n >> 3)) * 8; float acc[8];
#pragma unroll
            for (int j = 0; j < 8; ++j) acc[j] = 0.f;
            const LAS float* zb = zs + b * n;
            for (int sb = 0; sb < n; sb += 8) {
                const LAS float* kb = kc + (t0 - sb + n - 8); float w[16];
#pragma unroll
                for (int i = 0; i < 4; ++i) { const f32x4 v = *(const LAS f32x4*)(kb + 4 * i); w[4 * i] = v[0]; w[4 * i + 1] = v[1]; w[4 * i + 2] = v[2]; w[4 * i + 3] = v[3]; }
                const f32x4 za = *(const LAS f32x4*)(zb + sb), zc = *(const LAS f32x4*)(zb + sb + 4); const float zv[8] = {za[0], za[1], za[2], za[3], zc[0], zc[1], zc[2], zc[3]};
#pragma unroll
                for (int ss = 0; ss < 8; ++ss)
#pragma unroll
                    for (int j = 0; j < 8; ++j) acc[j] += w[j - ss + 7] * zv[ss];
            }
            if (ord == 0) {
#pragma unroll
                for (int j = 0; j < 8; ++j) { const int idx = b * n + t0 + j; z2[idx] = bf2f(X1T[idx]) * (acc[j] + skip * z[idx]); }
            } else { float y[8];
#pragma unroll
                for (int j = 0; j < 8; ++j) y[j] = acc[j] + skip * z2[b * n + t0 + j];
                u32x4 w; w.x = pk2(y[0], y[1]); w.y = pk2(y[2], y[3]); w.z = pk2(y[4], y[5]); w.w = pk2(y[6], y[7]); *(u32x4*)(Y2T + b * n + t0) = w; }
        }
        __syncthreads();
    }
}
__device__ __forceinline__ void hy_fin_task(const Params& p, int l, int t0, int c0, LAS float* u) {
    const bf16_t* P = (const bf16_t*)(p.ws + O_P); LAS float* y = u + 66 * 65;
    load_conv_tile(P, t0, 1024 + c0, u);
    const int tid = otid();
    { const int c = tid >> 3, tc = (tid & 7) * 8; const u32x4 v = *(const u32x4*)((const bf16_t*)(p.ws + O_Y2T) + (size_t)(c0 + c) * NTOK + t0 + tc);
#pragma unroll
      for (int j = 0; j < 4; ++j) { y[c * 65 + tc + 2 * j] = __uint_as_float(v[j] << 16); y[c * 65 + tc + 2 * j + 1] = __uint_as_float(v[j] & 0xffff0000u); } }
    __syncthreads();
    { const int t = tid >> 3, cc = (tid & 7) * 8; const float* cw = p.in[I_HYCONV] + (size_t)l * 3 * 1536 + 1024 + c0 + cc; float o[8];
#pragma unroll
      for (int j = 0; j < 8; ++j) { const int c = cc + j; const float x2 = cw[j] * u[t * 65 + c] + cw[1536 + j] * u[(t + 1) * 65 + c] + cw[3072 + j] * u[(t + 2) * 65 + c]; o[j] = x2 * y[c * 65 + t]; }
      u32x4 w; w.x = pk2(o[0], o[1]); w.y = pk2(o[2], o[3]); w.z = pk2(o[4], o[5]); w.w = pk2(o[6], o[7]);
      *(u32x4*)((bf16_t*)(p.ws + O_MIX) + (size_t)(t0 + t) * DM + c0 + cc) = w; }
    __syncthreads();
}

__device__ __forceinline__ void mla_unit(const Params& p, int b, int h, int qb, bool ctxq, LAS unsigned char* lds) {
    unsigned char* ws = p.ws;
    const bf16_t* Q = ctxq ? (const bf16_t*)(ws + O_QMC) + (size_t)(b * 6 + h) * CTXL * 192 : (const bf16_t*)(ws + O_QM) + ((size_t)(b * 6 + h) * SEQ + qb * 256) * 192;
    bf16_t* O = (bf16_t*)(ws + O_MIX) + (size_t)(ctxq ? NLAT + b * CTXL : b * SEQ + qb * 256) * DM + 512 + h * 128;
    attn_body<192, 0>(Q, (const bf16_t*)(ws + O_KM) + (size_t)(b * 6 + h) * LK * 192, (const bf16_t*)(ws + O_VM) + (size_t)(b * 6 + h) * LK * 128, O, DM, ctxq ? CTXL : LK, 0.07216878364870322f, (char*)lds);
}
__device__ __forceinline__ void gqa_unit(const Params& p, int b, int h, int qb, bool ctxq, LAS unsigned char* lds) {
    unsigned char* ws = p.ws;
    const bf16_t* Q = ctxq ? (const bf16_t*)(ws + O_QGC) + (size_t)(b * 6 + h) * CTXL * 128 : (const bf16_t*)(ws + O_QG) + ((size_t)(b * 6 + h) * SEQ + qb * 256) * 128;
    bf16_t* O = (bf16_t*)(ws + O_MIX) + (size_t)(ctxq ? NLAT + b * CTXL : b * SEQ + qb * 256) * DM + 1280 + h * 128;
    attn_body<128, 2>(Q, (const bf16_t*)(ws + O_KG) + (size_t)(b * 2 + h / 3) * LK * 128, (const bf16_t*)(ws + O_VG) + (size_t)(b * 2 + h / 3) * LK * 128, O, DM, ctxq ? CTXL : LK, 0.08838834764831845f, (char*)lds);
}
__device__ __forceinline__ void phase_mixer(const Params& p, int l, LAS unsigned char* lds) {
    const int G = gridDim.x, bid = blockIdx.x; const bool last = (l == NLAYER - 1);
    for (int u = bid; u < 384 + (last ? 0 : 48); u += G) { if (u < 384) mla_unit(p, u / 48, (u >> 3) % 6, u & 7, false, lds); else mla_unit(p, (u - 384) / 6, (u - 384) % 6, 0, true, lds); }
    for (int u = (bid + G / 2) % G; u < 384 + (last ? 0 : 48); u += G) { if (u < 384) gqa_unit(p, u / 48, (u >> 3) % 6, u & 7, false, lds); else gqa_unit(p, (u - 384) / 6, (u - 384) % 6, 0, true, lds); }
    for (int u = bid; u < (last ? 512 : 1024); u += G) hyconv_unit_valu(p, l, u >> 9, u & 511, (LAS float*)lds);
}

__device__ __forceinline__ void phase_route(const Params& p, int l, LAS unsigned char* lds) {
    const int tid = otid(), wid = tid >> 6, lane = tid & 63; const bool last = (l == NLAYER - 1); const int NR = last ? NLAT : NTOK;
    LAS float* frow = (LAS float*)lds; LAS float* part = frow + 8 * DM;
    const float* g1 = p.in[I_NORMG] + (size_t)(l * 4 + 1) * DM; const float* g2 = p.in[I_NORMG] + (size_t)(l * 4 + 2) * DM;
    const float* RW = p.in[I_RW] + (size_t)l * DM * NEXP; unsigned* cnt = (unsigned*)(p.ws + O_CTL) + CW_CNT + l * 64;
    { int* stok = (int*)(p.ws + O_STOK); for (int i = blockIdx.x * NTHREADS + tid; i < NSLOTS; i += gridDim.x * NTHREADS) stok[i] = (i < RSLOTS) ? -1 : ((i - RSLOTS) < NR ? i - RSLOTS : -1); }
    for (int g = blockIdx.x; g < NR / 8; g += gridDim.x) {
        const int row = g * 8 + wid; const float* mod = (const float*)(p.ws + O_MOD) + (size_t)(l * 9 + row_batch(row)) * 12288;
        { const bf16_t* O = (const bf16_t*)(p.ws + O_OUT) + (size_t)row * DM; const float* rs = resid_src(p, l, row); float* X = (float*)(p.ws + O_X) + (size_t)row * DM; bf16_t* H = (bf16_t*)(p.ws + O_H) + (size_t)row * DM;
          float o[32], x[32]; float ss = 0.f;
#pragma unroll
          for (int j = 0; j < 8; ++j) { const u32x2 v = *(const u32x2*)(O + ROWCOL(j, lane)); o[j * 4] = __uint_as_float(v.x << 16); o[j * 4 + 1] = __uint_as_float(v.x & 0xffff0000u); o[j * 4 + 2] = __uint_as_float(v.y << 16); o[j * 4 + 3] = __uint_as_float(v.y & 0xffff0000u); }
#pragma unroll
          for (int i = 0; i < 32; ++i) ss += o[i] * o[i];
          const float r1 = rsqrtf(wave_sum(ss) * (1.0f / DM) + EPS); float s2 = 0.f;
#pragma unroll
          for (int j = 0; j < 8; ++j) { const int c = ROWCOL(j, lane); const f32x4 xv = *(const f32x4*)(rs + c), gv = *(const f32x4*)(g1 + c), ga = *(const f32x4*)(mod + 2 * DM + c); f32x4 xn;
#pragma unroll
              for (int q = 0; q < 4; ++q) { xn[q] = xv[q] + ga[q] * (o[j * 4 + q] * r1 * gv[q]); x[j * 4 + q] = xn[q]; s2 += xn[q] * xn[q]; }
              *(f32x4*)(X + c) = xn; }
          const float r2 = rsqrtf(wave_sum(s2) * (1.0f / DM) + EPS);
#pragma unroll
          for (int j = 0; j < 8; ++j) { const int c = ROWCOL(j, lane); const f32x4 gv = *(const f32x4*)(g2 + c), sh = *(const f32x4*)(mod + 3 * DM + c), sc = *(const f32x4*)(mod + 4 * DM + c); f32x4 f;
#pragma unroll
              for (int q = 0; q < 4; ++q) f[q] = x[j * 4 + q] * r2 * gv[q] * (1.0f + sc[q]) + sh[q];
              u32x2 w; w.x = pk2(f[0], f[1]); w.y = pk2(f[2], f[3]); *(u32x2*)(H + c) = w; *(LAS f32x4*)(frow + wid * DM + c) = f; } }
        __syncthreads();
        { float acc[8];
#pragma unroll
          for (int r = 0; r < 8; ++r) acc[r] = 0.f;
          for (int k = wid * 256; k < wid * 256 + 256; k += 4) { const float w0 = RW[(size_t)k * 64 + lane], w1 = RW[(size_t)(k + 1) * 64 + lane], w2 = RW[(size_t)(k + 2) * 64 + lane], w3 = RW[(size_t)(k + 3) * 64 + lane];
#pragma unroll
              for (int r = 0; r < 8; ++r) { const f32x4 fv = *(const LAS f32x4*)(frow + r * DM + k); acc[r] += fv[0] * w0 + fv[1] * w1 + fv[2] * w2 + fv[3] * w3; } }
#pragma unroll
          for (int r = 0; r < 8; ++r) part[(wid * 8 + r) * 64 + lane] = acc[r]; }
        __syncthreads();
        { float logit = 0.f;
#pragma unroll
          for (int w = 0; w < 8; ++w) logit += part[(w * 8 + wid) * 64 + lane];
          const float score = 1.0f / (1.0f + expf(-logit)), biased = score + p.in[I_RB][l * 64 + lane];
          float m1 = biased; m1 = fmaxf(m1, __shfl_xor(m1, 1)); m1 = fmaxf(m1, __shfl_xor(m1, 2)); m1 = fmaxf(m1, __shfl_xor(m1, 4));
          const unsigned long long bal = __ballot(biased == m1); const int first = __builtin_ctz((unsigned)((bal >> (lane & ~7)) & 0xffull));
          float m2 = ((lane & 7) == first) ? -INFINITY : biased; m2 = fmaxf(m2, __shfl_xor(m2, 1)); m2 = fmaxf(m2, __shfl_xor(m2, 2)); m2 = fmaxf(m2, __shfl_xor(m2, 4));
          const float gs = m1 + m2; const int grp = lane >> 3; int rank = 0;
#pragma unroll
          for (int q = 0; q < 8; ++q) { const float v = rdlane(gs, q * 8); rank += (v > gs || (v == gs && q < grp)) ? 1 : 0; }
          const float cand = (rank < 4) ? biased : -INFINITY; int re = 0;
          for (int q = 0; q < 64; ++q) { const float v = rdlane(cand, q); re += (v > cand || (v == cand && q < lane)) ? 1 : 0; }
          const bool sel = re < TOPK; const float ssum = wave_sum(sel ? score : 0.f);
          if (sel) { ((int*)(p.ws + O_EIDX))[(size_t)row * 8 + re] = lane; ((float*)(p.ws + O_GATE))[(size_t)row * 8 + re] = score / ssum * 2.5f; atomicAdd(&cnt[lane], 1u); } }
        __syncthreads();
    }
}
__device__ __forceinline__ void phase_place(const Params& p, int l, LAS unsigned char* lds) {
    const int tid = otid(); const int NR = (l == NLAYER - 1) ? NLAT : NTOK; LAS int* pstart = (LAS int*)lds;
    const unsigned* cnt = (const unsigned*)(p.ws + O_CTL) + CW_CNT + l * 64; unsigned* cur = (unsigned*)(p.ws + O_CTL) + CW_CUR + l * 64;
    if (tid == 0) { int run = 0; for (int e = 0; e < NEXP; ++e) { pstart[e] = run; run += ((int)cnt[e] + 255) & ~255; } }
    __syncthreads();
    const int* eidx = (const int*)(p.ws + O_EIDX); int* slot = (int*)(p.ws + O_SLOT); int* stok = (int*)(p.ws + O_STOK);
    for (int i = blockIdx.x * NTHREADS + tid; i < NR * TOPK; i += gridDim.x * NTHREADS) { const int row = i / TOPK, k = i % TOPK, e = eidx[(size_t)row * 8 + k];
        const int s = pstart[e] + (int)atomicAdd(&cur[e], 1u); slot[(size_t)row * 8 + k] = s; stok[s] = row; }
    __syncthreads();
}
__device__ __forceinline__ void phase_final(const Params& p, int l) {
    const int lane = otid() & 63, gw = blockIdx.x * 8 + (otid() >> 6), GW = gridDim.x * 8; const bool last = (l == NLAYER - 1); const int NR = last ? NLAT : NTOK;
    const bf16_t* DO = (const bf16_t*)(p.ws + O_DOUT); const float* g3 = p.in[I_NORMG] + (size_t)(l * 4 + 3) * DM;
    for (int row = gw; row < NR; row += GW) {
        float y[32];
        { const bf16_t* src = DO + (size_t)(RSLOTS + row) * DM;
#pragma unroll
          for (int j = 0; j < 8; ++j) { const u32x2 v = *(const u32x2*)(src + ROWCOL(j, lane)); y[j * 4] = __uint_as_float(v.x << 16); y[j * 4 + 1] = __uint_as_float(v.x & 0xffff0000u); y[j * 4 + 2] = __uint_as_float(v.y << 16); y[j * 4 + 3] = __uint_as_float(v.y & 0xffff0000u); } }
        for (int k = 0; k < TOPK; ++k) { const int s = ((const int*)(p.ws + O_SLOT))[(size_t)row * 8 + k]; const float gt = ((const float*)(p.ws + O_GATE))[(size_t)row * 8 + k]; const bf16_t* src = DO + (size_t)s * DM;
#pragma unroll
            for (int j = 0; j < 8; ++j) { const u32x2 v = *(const u32x2*)(src + ROWCOL(j, lane)); y[j * 4] += gt * __uint_as_float(v.x << 16); y[j * 4 + 1] += gt * __uint_as_float(v.x & 0xffff0000u); y[j * 4 + 2] += gt * __uint_as_float(v.y << 16); y[j * 4 + 3] += gt * __uint_as_float(v.y & 0xffff0000u); } }
        float ss = 0.f;
#pragma unroll
        for (int i = 0; i < 32; ++i) ss += y[i] * y[i];
        const float r = rsqrtf(wave_sum(ss) * (1.0f / DM) + EPS); const float* mod = (const float*)(p.ws + O_MOD) + (size_t)(l * 9 + row_batch(row)) * 12288;
        float* X = (float*)(p.ws + O_X) + (size_t)row * DM; float x[32];
#pragma unroll
        for (int j = 0; j < 8; ++j) { const int c = ROWCOL(j, lane); const f32x4 xv = *(const f32x4*)(X + c), gv = *(const f32x4*)(g3 + c), gf = *(const f32x4*)(mod + 5 * DM + c); f32x4 xn;
#pragma unroll
            for (int q = 0; q < 4; ++q) { xn[q] = xv[q] + gf[q] * (y[j * 4 + q] * r * gv[q]); x[j * 4 + q] = xn[q]; }
            if (last) *(f32x4*)(p.out + (size_t)row * DM + c) = xn; else *(f32x4*)(X + c) = xn; }
        if (!last) norm1_row(p, l + 1, row, x, lane);
    }
}

#define XB_TMO      128
#define XB_XCNT(j)  (256  + 64 * (j))
#define XB_XSUB(j)  (1280 + 64 * (j))
#define XB_XGEN(j)  (2304 + 64 * (j))
#define XB_TOP      3328
#define XB_TOPGEN   3392
#define XCD_BAR_WORDS 3456
#define XB_SPIN_CAP (1u << 23)

__device__ __forceinline__ unsigned xb_ld(unsigned* p)              { return __hip_atomic_load(p, __ATOMIC_RELAXED, __HIP_MEMORY_SCOPE_AGENT); }
__device__ __forceinline__ unsigned xb_add(unsigned* p, unsigned v) { return __hip_atomic_fetch_add(p, v, __ATOMIC_RELAXED, __HIP_MEMORY_SCOPE_AGENT); }
__device__ __forceinline__ unsigned xb_xcc_id() { return (unsigned)__builtin_amdgcn_s_getreg((3 << 11) | 20) & 0xFu; }
#define XB_SPIN(cond, bar) do { unsigned _sp = 0; while (cond) { __builtin_amdgcn_s_sleep(1); \
    if ((++_sp & 255u) == 0u) { if (xb_ld(&(bar)[XB_TMO])) break; if (_sp > XB_SPIN_CAP) { atomicAdd(&(bar)[XB_TMO], 1u); break; } } } } while (0)

struct XcdBarrier {
    unsigned* bar; unsigned x;
    volatile LAS unsigned* st;
};

__device__ __forceinline__ XcdBarrier xcd_barrier_post(unsigned* bar, volatile LAS unsigned* st) {
    XcdBarrier b; b.bar = bar; b.x = xb_xcc_id(); b.st = st;
    if (threadIdx.x == 0) (void)xb_add(&bar[XB_XCNT(b.x)], 1u);
    return b;
}
__device__ __forceinline__ void xcd_barrier_complete(unsigned* bar, unsigned x, unsigned& nloc, unsigned& nx) {
    const unsigned G = gridDim.x * gridDim.y * gridDim.z;
    unsigned sum, cnt, mine, sp = 0u;
    for (;;) {
        sum = 0u; cnt = 0u; mine = 0u;
#pragma unroll
        for (unsigned j = 0; j < 16; ++j) { const unsigned c = xb_ld(&bar[XB_XCNT(j)]); sum += c; cnt += (c > 0u) ? 1u : 0u; mine = (j == x) ? c : mine; }
        if (sum == G) break;
        __builtin_amdgcn_s_sleep(1);
        if ((++sp & 255u) == 0u) { if (xb_ld(&bar[XB_TMO])) break; if (sp > XB_SPIN_CAP) { atomicAdd(&bar[XB_TMO], 1u); break; } }
    }
    nloc = mine > 0u ? mine : 1u; nx = cnt > 0u ? cnt : 1u;
}

__device__ __forceinline__ void xcd_barrier(const XcdBarrier& b) {
    asm volatile("s_waitcnt vmcnt(0)" ::: "memory");
    __syncthreads();
    if (threadIdx.x == 0) {
        unsigned* bar = b.bar;
        __builtin_amdgcn_s_waitcnt(0);
        unsigned nloc = b.st[0], nx = b.st[1];
        if (nloc == 0u) { xcd_barrier_complete(bar, b.x, nloc, nx); b.st[0] = nloc; b.st[1] = nx; }
        const unsigned old = xb_add(&bar[XB_XSUB(b.x)], 1u);
        const unsigned gen = old / nloc;
        if (old + 1u == (gen + 1u) * nloc) {
            __builtin_amdgcn_fence(__ATOMIC_RELEASE, "agent");
            asm volatile("s_waitcnt vmcnt(0)" ::: "memory");
            const unsigned og = xb_add(&bar[XB_TOP], 1u);
            const unsigned tg = og / nx;
            if (og + 1u == (tg + 1u) * nx) xb_add(&bar[XB_TOPGEN], 1u);
            else XB_SPIN(xb_ld(&bar[XB_TOPGEN]) == tg, bar);
            __builtin_amdgcn_fence(__ATOMIC_ACQUIRE, "agent");
            xb_add(&bar[XB_XGEN(b.x)], 1u);
            asm volatile("s_waitcnt vmcnt(0)" ::: "memory");
        } else {
            XB_SPIN(xb_ld(&bar[XB_XGEN(b.x)]) == gen, bar);
            __builtin_amdgcn_fence(__ATOMIC_ACQUIRE, "agent");
            asm volatile("s_waitcnt vmcnt(0)" ::: "memory");
        }
    }
    __syncthreads();
}


enum { PH_PRO = 0, PH_NORM1, PH_WIN, PH_POSTA, PH_POSTB, PH_MIXER, PH_HYFIN, PH_WOUT, PH_ROUTE, PH_PLACE, PH_GEMM1, PH_GEMM2, PH_FINAL, PH_COUNT };

template <int PH>
__device__ __forceinline__ void run_phase(const Params& p_in, int l, LAS unsigned char* lds) {
    Params p = p_in; { unsigned char* w = p.ws; asm volatile("" : "+s"(w)); p.ws = w; }
    unsigned char* ws = p.ws; const bool last = (l == NLAYER - 1);
    const int gw = blockIdx.x * 8 + (otid() >> 6), GW = gridDim.x * 8, lane = otid() & 63;
    if constexpr (PH == PH_PRO) { phase_prologue(p, lds); }
    if constexpr (PH == PH_NORM1) { phase_norm1(p, l); }
    if constexpr (PH == PH_WIN) {
        GemmDesc g{(const bf16_t*)(ws + O_H), DM, nullptr, DM, DM}; EpiStoreBf16 E{(bf16_t*)(ws + O_P), NP};
        const bf16_t* Bt = (const bf16_t*)(ws + O_WIN) + (size_t)l * NP * DM;
        if (!last) { DenseSched S{Bt, DM, NTOK / 256, 16, 0, 0}; GEMM_PHASE(g, S, E); }
        else { DenseSched S{Bt, DM, NLAT / 256, 16, 0, 0}; GEMM_PHASE(g, S, E); DenseSched S2{Bt, DM, NCTX / 256, 4, NLAT, 12}; GEMM_PHASE(g, S2, E); }
    }
    if constexpr (PH == PH_POSTA) {
#ifndef DBG_SKIP
#define DBG_SKIP 0
#endif
        if (!(DBG_SKIP & 1)) { GemmDesc g{(const bf16_t*)(ws + O_P) + C_CQ, NP, nullptr, 768, 768}; EpiStoreBf16 E{(bf16_t*)(ws + O_QRAW), NQP};
          DenseSched S{(const bf16_t*)(ws + O_WUQ) + (size_t)l * NQP * 768, 768, (last ? NLAT : NTOK) / 256, 5, 0, 0}; GEMM_PHASE(g, S, E); }
        if (!(DBG_SKIP & 2)) { GemmDesc g{(const bf16_t*)(ws + O_P) + C_CKV, NP, nullptr, 256, 256}; EpiStoreBf16 E{(bf16_t*)(ws + O_KVRAW), 1536};
          DenseSched S{(const bf16_t*)(ws + O_WUKV) + (size_t)l * 1536 * 256, 256, NTOK / 256, 6, 0, 0}; GEMM_PHASE(g, S, E); }
        const int ntt = (last ? NLAT : NTOK) / 64;
        if (!(DBG_SKIP & 4)) for (int t = blockIdx.x; t < ntt * 16; t += gridDim.x) hy_prep_task(p, l, (t >> 4) * 64, (t & 15) * 64, (LAS float*)lds);
        if (!(DBG_SKIP & 8)) for (int row = gw; row < NTOK; row += GW) gqa_post_row(p, l, row, lane);
    }
    if constexpr (PH == PH_POSTB) { if (l == 0) hss_tasks(p); for (int row = gw; row < NTOK; row += GW) mla_post_row(p, l, row, lane); }
    if constexpr (PH == PH_MIXER) { phase_mixer(p, l, lds); }
    if constexpr (PH == PH_HYFIN) { const int ntt = (last ? NLAT : NTOK) / 64; for (int t = blockIdx.x; t < ntt * 8; t += gridDim.x) hy_fin_task(p, l, (t >> 3) * 64, (t & 7) * 64, (LAS float*)lds); }
    if constexpr (PH == PH_WOUT) {
        GemmDesc g{(const bf16_t*)(ws + O_MIX), DM, nullptr, DM, DM}; EpiStoreBf16 E{(bf16_t*)(ws + O_OUT), DM};
        DenseSched S{(const bf16_t*)(ws + O_WOUT) + (size_t)l * DM * DM, DM, (last ? NLAT : NTOK) / 256, 8, 0, 0}; GEMM_PHASE(g, S, E);
    }
    if constexpr (PH == PH_ROUTE) { phase_route(p, l, lds); }
    if constexpr (PH == PH_PLACE) { phase_place(p, l, lds); }
    if constexpr (PH == PH_GEMM1 || PH == PH_GEMM2) {
        LAS int* te = (LAS int*)(lds + LDS_TILES); LAS int* ts = te + MAXTILES; LAS int* misc = (LAS int*)(lds + LDS_MISC) + 16;
        const int nt = moe_build_tiles((const unsigned*)(ws + O_CTL) + CW_CNT + l * 64, (last ? NLAT : NTOK) / 256, te, ts, misc);
        if constexpr (PH == PH_GEMM1) {
            GemmDesc g{(const bf16_t*)(ws + O_H), DM, (const int*)(ws + O_STOK), DM, DM}; EpiSwiGLU E{(bf16_t*)(ws + O_HID)};
            MoeSched S{te, ts, nt, 4, (const bf16_t*)(ws + O_EGU), (size_t)1024 * 2048, DM, 128}; GEMM_PHASE(g, S, E);
        } else {
            GemmDesc g{(const bf16_t*)(ws + O_HID), EH, nullptr, EH, EH}; EpiStoreBf16 E{(bf16_t*)(ws + O_DOUT), DM};
            MoeSched S{te, ts, nt, 8, (const bf16_t*)(ws + O_ED), (size_t)2048 * 512, EH, 256}; GEMM_PHASE(g, S, E);
        }
        __syncthreads();
    }
    if constexpr (PH == PH_FINAL) {
        phase_final(p, l);
        if (!last) for (int t = blockIdx.x; t < CVT_EXP; t += gridDim.x) cvt_exp_task(p, l + 1, t, (LAS float*)lds);
    }
}

#ifndef MEGA
#define MEGA 0
#endif


#if MEGA
__global__ void __launch_bounds__(NTHREADS, 2) mega_fwd(Params p) {
    extern __shared__ __attribute__((aligned(16))) unsigned char lds_raw[];
    LAS unsigned char* lds = (LAS unsigned char*)lds_raw;
    volatile LAS unsigned* xbw = (volatile LAS unsigned*)(lds + LDS_MISC);
    if (otid() == 0) { xbw[0] = 0u; xbw[1] = 0u; }
    __syncthreads();
    { const XcdBarrier b0 = xcd_barrier_post((unsigned*)(p.ws + O_CTL) + CW_BAR, xbw); if (otid() == 0) xbw[2] = b0.x; }
    __syncthreads();
#define GRID_BAR() do { XcdBarrier b_; b_.bar = (unsigned*)(p.ws + O_CTL) + CW_BAR; b_.x = xbw[2]; b_.st = xbw; xcd_barrier(b_); } while (0)
    run_phase<PH_PRO>(p, 0, lds); GRID_BAR();
    for (int l = 0; l < NLAYER; ++l) {
        if (l == 0) { run_phase<PH_NORM1>(p, l, lds); GRID_BAR(); }
        run_phase<PH_WIN>(p, l, lds); GRID_BAR();
        run_phase<PH_POSTA>(p, l, lds); GRID_BAR();
        run_phase<PH_POSTB>(p, l, lds); GRID_BAR();
        run_phase<PH_MIXER>(p, l, lds); GRID_BAR();
        run_phase<PH_HYFIN>(p, l, lds); GRID_BAR();
        run_phase<PH_WOUT>(p, l, lds); GRID_BAR();
        run_phase<PH_ROUTE>(p, l, lds); GRID_BAR();
        run_phase<PH_PLACE>(p, l, lds); GRID_BAR();
        run_phase<PH_GEMM1>(p, l, lds); GRID_BAR();
        run_phase<PH_GEMM2>(p, l, lds); GRID_BAR();
        run_phase<PH_FINAL>(p, l, lds);
        if (l + 1 < NLAYER) GRID_BAR();
    }
}
#endif

#if !MEGA
template <int PH> __global__ void __launch_bounds__(NTHREADS, 2) k_phase(Params p) {
    extern __shared__ __attribute__((aligned(16))) unsigned char lds_raw[];
    run_phase<PH>(p, p.layer, (LAS unsigned char*)lds_raw);
}
template <int PH> static bool prep_phase() { return hipFuncSetAttribute((const void*)k_phase<PH>, hipFuncAttributeMaxDynamicSharedMemorySize, LDS_BYTES) == hipSuccess; }
static int g_nlaunch = 0;
#ifndef DBG_STOP
#define DBG_STOP 1000
#define DBG_DUMP 0
#else
#define DBG_DUMP 1
#ifndef DBG_SET
#define DBG_SET 31
#endif
#endif
template <int PH> static void launch_phase(Params p, int l, hipStream_t st) { if (g_nlaunch++ >= DBG_STOP) return; p.layer = l; hipLaunchKernelGGL(k_phase<PH>, dim3(256), dim3(NTHREADS), LDS_BYTES, st, p); }
#endif


#if DBG_DUMP
__device__ __forceinline__ float san(float x) { return (x == x && fabsf(x) < 1e6f) ? x : 1.0f; }
__global__ void __launch_bounds__(256) k_dump(Params p) {
    const size_t N = (size_t)NLAT * DM;
    const bf16_t* b1 = (const bf16_t*)(p.ws + O_WIN); const size_t n1 = (O_X - O_WIN) / 2;
    const bf16_t* b2 = (const bf16_t*)(p.ws + O_H); const size_t n2 = (size_t)NTOK * DM;
    const bf16_t* b3 = (const bf16_t*)(p.ws + O_A); const size_t n3 = (O_AEND - O_A) / 2;
    const float* f1 = (const float*)(p.ws + O_MOD); const size_t m1 = (O_WIN - O_MOD) / 4;
    const float* f2 = (const float*)(p.ws + O_X); const size_t m2 = (size_t)NTOK * DM;
    for (size_t i = (size_t)blockIdx.x * 256 + otid(); i < N; i += (size_t)gridDim.x * 256) {
        float v = 0.f;
        if (DBG_SET & 1) for (size_t e = i; e < n1; e += N) v += san(bf2f(b1[e]));
        if (DBG_SET & 2) for (size_t e = i; e < n2; e += N) v += san(bf2f(b2[e]));
        if (DBG_SET & 4) for (size_t e = i; e < n3; e += N) v += san(bf2f(b3[e]));
        if (DBG_SET & 8) for (size_t e = i; e < m1; e += N) v += san(f1[e]);
        if (DBG_SET & 16) for (size_t e = i; e < m2; e += N) v += san(f2[e]);
        if (DBG_SET & 32) v += san(bf2f(((const bf16_t*)(p.ws + O_WUKV))[i % ((size_t)2 * 1536 * 256)]));
        if (DBG_SET & 64) { const size_t r = i % NTOK, c = (i / NTOK) % 256; v += san(bf2f(((const bf16_t*)(p.ws + O_P))[r * NP + C_CKV + c])); }
        if (DBG_SET & 128) v += san(bf2f(((const bf16_t*)(p.ws + O_KVRAW))[i % ((size_t)NTOK * 1536)]));
        p.out[i] = v;
    }
}
#endif
static int g_grid = 0;
extern "C" void kernel_launch(void* const* d_in, const int* in_sizes, int n_in, void* d_out, int out_size, void* d_ws, size_t ws_size, hipStream_t stream) {
    static int ok = 0;
    if (ok == 0) {
        if (n_in != 31 || in_sizes[0] != NLAT * DM || out_size != NLAT * DM || ws_size < WS_END) { fprintf(stderr, "kernel_launch: unexpected shapes (n_in %d, ws %zu, need %zu)\n", n_in, ws_size, (size_t)WS_END); ok = -1; return; }
        bool good = true;
#if !MEGA
        good = good && prep_phase<0>() && prep_phase<1>() && prep_phase<2>() && prep_phase<3>() && prep_phase<4>() && prep_phase<5>() && prep_phase<6>() && prep_phase<7>() && prep_phase<8>() && prep_phase<9>() && prep_phase<10>() && prep_phase<11>() && prep_phase<12>();
#endif
#if MEGA
        good = hipFuncSetAttribute((const void*)mega_fwd, hipFuncAttributeMaxDynamicSharedMemorySize, LDS_BYTES) == hipSuccess;
        int dev = 0, cus = 0, per_cu = 0;
        if (hipGetDevice(&dev) != hipSuccess || hipDeviceGetAttribute(&cus, hipDeviceAttributeMultiprocessorCount, dev) != hipSuccess) good = false;
        if (good && (hipOccupancyMaxActiveBlocksPerMultiprocessor(&per_cu, (const void*)mega_fwd, NTHREADS, LDS_BYTES) != hipSuccess || per_cu < 1)) { fprintf(stderr, "kernel_launch: occupancy query says %d workgroups per CU\n", per_cu); good = false; }
        g_grid = cus;
#endif
        if (!good) { fprintf(stderr, "kernel_launch: set-up failed\n"); ok = -1; return; }
        ok = 1;
    }
    if (ok < 0) return;
    Params p{}; for (int i = 0; i < 31; ++i) p.in[i] = (const float*)d_in[i]; p.out = (float*)d_out; p.ws = (unsigned char*)d_ws; p.layer = 0; p.pad = 0;
#ifdef POISON_WS
    hipMemsetAsync((char*)d_ws, 0xFF, WS_END, stream);
#endif
    hipMemsetAsync((char*)d_ws + O_CTL, 0, ZERO_BYTES, stream);
#if !MEGA
    g_nlaunch = 0;
    launch_phase<PH_PRO>(p, 0, stream);
    for (int l = 0; l < NLAYER; ++l) {
        if (l == 0) launch_phase<PH_NORM1>(p, l, stream);
        launch_phase<PH_WIN>(p, l, stream); launch_phase<PH_POSTA>(p, l, stream); launch_phase<PH_POSTB>(p, l, stream); launch_phase<PH_MIXER>(p, l, stream);
        launch_phase<PH_HYFIN>(p, l, stream); launch_phase<PH_WOUT>(p, l, stream); launch_phase<PH_ROUTE>(p, l, stream); launch_phase<PH_PLACE>(p, l, stream);
        launch_phase<PH_GEMM1>(p, l, stream); launch_phase<PH_GEMM2>(p, l, stream); launch_phase<PH_FINAL>(p, l, stream);
    }
#if DBG_DUMP
    hipLaunchKernelGGL(k_dump, dim3(2048), dim3(256), 0, stream, p);
#endif
#else
    hipLaunchKernelGGL(mega_fwd, dim3(g_grid), dim3(NTHREADS), LDS_BYTES, stream, p);
#endif
}
```

```cpp
#define FAST_GEMM 1
#define MEGA 1
#include <hip/hip_runtime.h>
#include <stdint.h>
#include <stdio.h>

#define LAS __attribute__((address_space(3)))
typedef unsigned short bf16_t;
typedef short bf16x8 __attribute__((ext_vector_type(8)));
typedef short s16x4 __attribute__((ext_vector_type(4)));
typedef float f32x4 __attribute__((ext_vector_type(4)));
typedef float f32x16 __attribute__((ext_vector_type(16)));
typedef unsigned u32x4 __attribute__((ext_vector_type(4)));
typedef unsigned u32x2 __attribute__((ext_vector_type(2)));

constexpr int DM = 2048, NB = 8, SEQ = 2048, CTXL = 256, NLAT = NB * SEQ, NCTX = NB * CTXL, NTOK = NLAT + NCTX, NLAYER = 2;
constexpr int NP = 4096;
constexpr int C_CQ = 1536, C_GQ = 2304, C_CKV = 3072, C_KR = 3328, C_GK = 3392, C_GV = 3648, IN_COLS = 3904;
constexpr int NEXP = 64, TOPK = 6, EH = 512;
constexpr int LK = CTXL + SEQ;
constexpr int RSLOTS = 126976;
constexpr int NSLOTS = RSLOTS + NTOK;
constexpr int MAXTILES = NSLOTS / 256;
constexpr int NQP = 1280;
constexpr float EPS = 1e-6f;
constexpr int NTHREADS = 512;

constexpr size_t al256(size_t x) { return (x + 255) & ~(size_t)255; }
constexpr size_t O_CTL = 0;
constexpr size_t CTL_BYTES = 65536;
constexpr size_t O_MOD = O_CTL + CTL_BYTES;
constexpr size_t O_HSS = O_MOD + al256((size_t)NLAYER * 9 * 12288 * 4);
constexpr size_t ZERO_BYTES = O_HSS + al256((size_t)NLAYER * 2 * 2 * 512 * 4);
constexpr size_t O_HF = ZERO_BYTES;
constexpr size_t HF_L0 = (size_t)2 * 2 * 512 * 2048, HF_L1 = (size_t)2 * 2 * 512 * 256, HF_LAYER = HF_L0 + HF_L1;
constexpr size_t O_WIN = O_HF + al256(NLAYER * HF_LAYER * 4);
constexpr size_t O_WOUT = O_WIN + (size_t)NLAYER * NP * DM * 2;
constexpr size_t O_WUQ = O_WOUT + (size_t)NLAYER * DM * DM * 2;
constexpr size_t O_WUKV = O_WUQ + al256((size_t)NLAYER * NQP * 768 * 2);
constexpr size_t O_EGU = O_WUKV + al256((size_t)NLAYER * 1536 * 256 * 2);
constexpr size_t O_ED = O_EGU + (size_t)65 * 1024 * 2048 * 2;
constexpr size_t O_X = O_ED + (size_t)65 * 2048 * 512 * 2;
constexpr size_t O_H = O_X + (size_t)NTOK * DM * 4;
constexpr size_t O_EIDX = O_H + (size_t)NTOK * DM * 2;
constexpr size_t O_GATE = O_EIDX + (size_t)NTOK * 8 * 4;
constexpr size_t O_SLOT = O_GATE + (size_t)NTOK * 8 * 4;
constexpr size_t O_STOK = O_SLOT + (size_t)NTOK * 8 * 4;
constexpr size_t O_HID = O_STOK + al256((size_t)NSLOTS * 4);
constexpr size_t O_A = O_HID + (size_t)NSLOTS * EH * 2;
constexpr size_t O_P = O_A;
constexpr size_t O_QRAW = O_P + (size_t)NTOK * NP * 2;
constexpr size_t O_KVRAW = O_QRAW + (size_t)NTOK * NQP * 2;
constexpr size_t O_QM = O_KVRAW + (size_t)NTOK * 1536 * 2;
constexpr size_t O_QMC = O_QM + (size_t)NB * 6 * SEQ * 192 * 2;
constexpr size_t O_KM = O_QMC + (size_t)NB * 6 * CTXL * 192 * 2;
constexpr size_t O_VM = O_KM + (size_t)NB * 6 * LK * 192 * 2;
constexpr size_t O_QG = O_VM + (size_t)NB * 6 * LK * 128 * 2;
constexpr size_t O_QGC = O_QG + (size_t)NB * 6 * SEQ * 128 * 2;
constexpr size_t O_KG = O_QGC + (size_t)NB * 6 * CTXL * 128 * 2;
constexpr size_t O_VG = O_KG + (size_t)NB * 2 * LK * 128 * 2;
constexpr size_t O_VT = O_VG + (size_t)NB * 2 * LK * 128 * 2;
constexpr size_t O_X1T = O_VT + (size_t)512 * NTOK * 2;
constexpr size_t O_Y2T = O_X1T + (size_t)512 * NTOK * 2;
constexpr size_t O_MIX = O_Y2T + (size_t)512 * NTOK * 2;
constexpr size_t O_OUT = O_MIX + (size_t)NTOK * DM * 2;
constexpr size_t O_AEND = O_OUT + (size_t)NTOK * DM * 2;
constexpr size_t O_DOUT = O_A;
static_assert(O_DOUT + (size_t)NSLOTS * DM * 2 <= O_AEND, "DOUT must fit the mixer scratch region");
constexpr size_t WS_END = O_AEND;

constexpr int CW_BAR = 0;
constexpr int CW_CNT = 4096;
constexpr int CW_CUR = 4096 + 128;
constexpr int CW_Q = 4096 + 256;

constexpr int LDS_BYTES = 148480;
constexpr int LDS_MISC = 147456;
constexpr int LDS_TILES = 131072;

struct Params { const float* in[31]; float* out; unsigned char* ws; int layer; int pad; };

enum { I_X = 0, I_C, I_CTX, I_CCTX, I_ADAW, I_ADAB, I_NORMG, I_WIN, I_WOUT, I_HYCONV, I_HYW1, I_HYB1, I_HYW2, I_HYB2, I_HYW3, I_HYFREQ, I_HYSKIP,
       I_MQN, I_MKVN, I_WUQ, I_WUKV, I_GQN, I_GKN, I_RW, I_RB, I_EG, I_EU, I_EDN, I_SG, I_SU, I_SD };

__device__ __forceinline__ int otid() { int t = threadIdx.x; asm volatile("" : "+v"(t)); return t; }
__device__ __forceinline__ float bf2f(bf16_t v) { return __uint_as_float(((unsigned)v) << 16); }
__device__ __forceinline__ bf16_t f2bf(float f) { unsigned u = __float_as_uint(f); u += 0x7FFFu + ((u >> 16) & 1u); return (bf16_t)(u >> 16); }
__device__ __forceinline__ unsigned pk2(float lo, float hi) { unsigned r; asm volatile("v_cvt_pk_bf16_f32 %0, %1, %2" : "=v"(r) : "v"(lo), "v"(hi)); return r; }
__device__ __forceinline__ float wave_sum(float v) {
#pragma unroll
    for (int o = 32; o >= 1; o >>= 1) v += __shfl_xor(v, o);
    return v;
}
__device__ __forceinline__ float rdlane(float v, int l) { return __int_as_float(__builtin_amdgcn_readlane(__float_as_int(v), l)); }
__device__ __forceinline__ float silu_f(float x) { return x / (1.0f + __expf(-x)); }
__device__ __forceinline__ const float* resid_src(const Params& p, int l, int row) {
    if (l == 0) return row < NLAT ? p.in[I_X] + (size_t)row * DM : p.in[I_CTX] + (size_t)(row - NLAT) * DM;
    return (const float*)(p.ws + O_X) + (size_t)row * DM;
}
__device__ __forceinline__ int row_batch(int row) { return row < NLAT ? row >> 11 : 8; }
#define ROWCOL(j, lane) ((j) * 256 + (lane) * 4)


struct GUnit { int arow0; const bf16_t* B; int orow0, ocol0; };
struct GemmDesc { const bf16_t* A; int lda; const int* ridx; int ldb; int K; };

struct EpiStoreBf16 {
    bf16_t* O; int ldo;
    __device__ __forceinline__ void operator()(const f32x4 (&acc)[2][2][4][2], const GUnit& u, int wr, int wc, int fr, int fq) const {
#pragma unroll
        for (int ai = 0; ai < 2; ++ai)
#pragma unroll
            for (int m = 0; m < 4; ++m) {
                bf16_t* rowp = O + (size_t)(u.orow0 + ai * 128 + wr * 64 + m * 16 + fr) * ldo + u.ocol0 + wc * 32 + 4 * fq;
#pragma unroll
                for (int bj = 0; bj < 2; ++bj)
#pragma unroll
                    for (int n = 0; n < 2; ++n) { const f32x4 v = acc[ai][bj][m][n]; u32x2 w; w.x = pk2(v[0], v[1]); w.y = pk2(v[2], v[3]); *(u32x2*)(rowp + bj * 128 + n * 16) = w; }
            }
    }
};
struct EpiSwiGLU {
    bf16_t* O;
    __device__ __forceinline__ void operator()(const f32x4 (&acc)[2][2][4][2], const GUnit& u, int wr, int wc, int fr, int fq) const {
#pragma unroll
        for (int ai = 0; ai < 2; ++ai)
#pragma unroll
            for (int m = 0; m < 4; ++m) {
                bf16_t* rowp = O + (size_t)(u.orow0 + ai * 128 + wr * 64 + m * 16 + fr) * EH + u.ocol0 + wc * 32 + 4 * fq;
#pragma unroll
                for (int n = 0; n < 2; ++n) { const f32x4 g = acc[ai][0][m][n], up = acc[ai][1][m][n]; float h[4];
#pragma unroll
                    for (int j = 0; j < 4; ++j) h[j] = silu_f(g[j]) * up[j];
                    u32x2 w; w.x = pk2(h[0], h[1]); w.y = pk2(h[2], h[3]); *(u32x2*)(rowp + n * 16) = w; }
            }
    }
};

template <class Epi>
__device__ __forceinline__ void gemm_unit_simple(const GemmDesc& g, const GUnit& u, const Epi& E) {
    int tid = otid();
    const int wid = tid >> 6, lane = tid & 63, wr = wid >> 2, wc = wid & 3, fr = lane & 15, fq = lane >> 4;
    f32x4 acc[2][2][4][2];
#pragma unroll
    for (int a = 0; a < 2; ++a)
#pragma unroll
        for (int b = 0; b < 2; ++b)
#pragma unroll
            for (int m = 0; m < 4; ++m)
#pragma unroll
                for (int n = 0; n < 2; ++n) acc[a][b][m][n] = (f32x4){0.f, 0.f, 0.f, 0.f};
    const bf16_t* ap[2][4]; const bf16_t* bp[2][2];
#pragma unroll
    for (int ai = 0; ai < 2; ++ai)
#pragma unroll
        for (int m = 0; m < 4; ++m) { const int r = u.arow0 + ai * 128 + wr * 64 + m * 16 + fr; int src = g.ridx ? g.ridx[r] : r; if (src < 0) src = 0; ap[ai][m] = g.A + (size_t)src * g.lda + 8 * fq; }
#pragma unroll
    for (int bj = 0; bj < 2; ++bj)
#pragma unroll
        for (int n = 0; n < 2; ++n) bp[bj][n] = u.B + (size_t)(bj * 128 + wc * 32 + n * 16 + fr) * g.ldb + 8 * fq;
    int Kq = g.K; asm volatile("" : "+s"(Kq));
#pragma unroll 1
    for (int k0 = 0; k0 < Kq; k0 += 32) {
        bf16x8 a[2][4], b[2][2];
#pragma unroll
        for (int ai = 0; ai < 2; ++ai)
#pragma unroll
            for (int m = 0; m < 4; ++m) a[ai][m] = *(const bf16x8*)(ap[ai][m] + k0);
#pragma unroll
        for (int bj = 0; bj < 2; ++bj)
#pragma unroll
            for (int n = 0; n < 2; ++n) b[bj][n] = *(const bf16x8*)(bp[bj][n] + k0);
#pragma unroll
        for (int ai = 0; ai < 2; ++ai)
#pragma unroll
            for (int bj = 0; bj < 2; ++bj)
#pragma unroll
                for (int m = 0; m < 4; ++m)
#pragma unroll
                    for (int n = 0; n < 2; ++n) acc[ai][bj][m][n] = __builtin_amdgcn_mfma_f32_16x16x32_bf16(b[bj][n], a[ai][m], acc[ai][bj][m][n], 0, 0, 0);
    }
    E(acc, u, wr, wc, fr, fq);
}

struct DenseSched {
    const bf16_t* Bt; int ldb, nM, nN, row0, pn0;
    __device__ __forceinline__ int count() const { return nM * nN; }
    __device__ __forceinline__ void unit(int i, GUnit& u) const { const int pm = i / nN, pn = pn0 + i % nN; u.arow0 = row0 + pm * 256; u.B = Bt + (size_t)pn * 256 * ldb; u.orow0 = u.arow0; u.ocol0 = pn * 256; }
};
struct MoeSched {
    const LAS int* te; const LAS int* ts; int ntiles, npn; const bf16_t* Bt; size_t estride; int ldb, ocolw;
    __device__ __forceinline__ int count() const { return ntiles * npn; }
    __device__ __forceinline__ void unit(int i, GUnit& u) const { const int t = i / npn, pn = i % npn; const int e = te[t]; u.arow0 = ts[t]; u.B = Bt + (size_t)e * estride + (size_t)pn * 256 * ldb; u.orow0 = u.arow0; u.ocol0 = pn * ocolw; }
};
template <class Sched, class Epi>
__device__ __forceinline__ void gemm_phase_simple(const GemmDesc& g, const Sched& S, const Epi& E) {
    const int n = S.count();
    for (int i = blockIdx.x; i < n; i += gridDim.x) { GUnit u; S.unit(i, u); gemm_unit_simple(g, u, E); }
}
__device__ __forceinline__ int moe_build_tiles(const unsigned* cnt, int nshared, LAS int* te, LAS int* ts, LAS int* misc) {
    __syncthreads();
    if (otid() == 0) {
        int nt = 0, run = 0;
        for (int e = 0; e < NEXP; ++e) { const int c = (int)cnt[e], ntile = (c + 255) >> 8; for (int j = 0; j < ntile; ++j) { te[nt] = e; ts[nt] = run + j * 256; ++nt; } run += ntile * 256; }
        for (int j = 0; j < nshared; ++j) { te[nt] = NEXP; ts[nt] = RSLOTS + j * 256; ++nt; }
        misc[0] = nt;
    }
    __syncthreads();
    return misc[0];
}
#ifndef FAST_GEMM
#define FAST_GEMM 0
#endif
#if !FAST_GEMM
#define GEMM_PHASE(g, S, E) gemm_phase_simple(g, S, E)
#endif

#if FAST_GEMM
constexpr int HTB = 128 * 64 * 2;
__device__ __forceinline__ int lds_byte(int r, int c) { const int st = (r >> 4) * 2 + (c >> 5), rr = r & 15, cc = c & 31, ob = rr * 64 + cc * 2; return st * 1024 + (ob ^ (((ob >> 9) & 1) << 5)); }
__device__ __forceinline__ void stage_rc(int b, int& R, int& C) { const int st = b / 1024, sb = b % 1024, swz = sb ^ (((sb >> 9) & 1) << 5); R = (st >> 1) * 16 + swz / 64; C = (st & 1) * 32 + (swz % 64) / 2; }

template <class Sched, class Epi>
__device__ __forceinline__ void gemm_phase_fast(LAS unsigned char* lds, const GemmDesc& g, const Sched& S, const Epi& E) {
    const int tid = otid(), wid = __builtin_amdgcn_readfirstlane(tid >> 6), lane = tid & 63, wr = wid >> 2, wc = wid & 3, fr = lane & 15, fq = lane >> 4;
    const int K = g.K, nt = K / 64, nunits = S.count(), G = gridDim.x, c0 = blockIdx.x;
    if (c0 >= nunits) return;
    int R[2], C[2]; unsigned voffB[2];
#pragma unroll
    for (int i = 0; i < 2; ++i) { stage_rc(tid * 16 + i * 8192, R[i], C[i]); voffB[i] = (unsigned)(R[i] * g.ldb + C[i]) * 2u; }
    const size_t kstep = 128;
    const size_t hstepB = (size_t)128 * g.ldb * 2;
    const unsigned ldsw = (unsigned)wid * 1024u;
    const int aoff = lds_byte(wr * 64 + fr, fq * 8), boff = lds_byte(wc * 32 + fr, fq * 8);
    const char* Ab = (const char*)g.A;
#define F_SA(b, h) (((b) * 2 + (h)) * HTB)
#define F_SB(b, h) ((4 + (b) * 2 + (h)) * HTB)
#define F_STAGE(bufoff, gbase, voff) do { _Pragma("unroll") for (int _i = 0; _i < 2; ++_i) \
        __builtin_amdgcn_global_load_lds((const unsigned*)((const char*)(gbase) + (voff)[_i]), (LAS unsigned*)(lds + (bufoff) + ldsw + _i * 8192), 16, 0, 0); } while (0)
#define F_LDA(dst, b, h) do { _Pragma("unroll") for (int m = 0; m < 4; ++m) _Pragma("unroll") for (int k = 0; k < 2; ++k) dst[m][k] = *(const LAS bf16x8*)(lds + F_SA(b, h) + aoff + m * 2048 + k * 1024); } while (0)
#define F_LDB(dst, b, h) do { _Pragma("unroll") for (int n = 0; n < 2; ++n) _Pragma("unroll") for (int k = 0; k < 2; ++k) dst[n][k] = *(const LAS bf16x8*)(lds + F_SB(b, h) + boff + n * 2048 + k * 1024); } while (0)
#define F_MMA(ai, bj, At, Bt) do { __builtin_amdgcn_s_setprio(1); _Pragma("unroll") for (int m = 0; m < 4; ++m) _Pragma("unroll") for (int n = 0; n < 2; ++n) _Pragma("unroll") for (int k = 0; k < 2; ++k) \
        acc[ai][bj][m][n] = __builtin_amdgcn_mfma_f32_16x16x32_bf16(Bt[n][k], At[m][k], acc[ai][bj][m][n], 0, 0, 0); __builtin_amdgcn_s_setprio(0); } while (0)
#define F_WAIT_V(n) asm volatile("s_waitcnt vmcnt(" #n ")" ::: "memory")
#define F_WAIT_L(n) asm volatile("s_waitcnt lgkmcnt(" #n ")" ::: "memory")
#define F_BAR __builtin_amdgcn_s_barrier()
#define F_SCHED __builtin_amdgcn_sched_barrier(0)
#define F_AROWS(u, dst) do { _Pragma("unroll") for (int _h = 0; _h < 2; ++_h) _Pragma("unroll") for (int _i = 0; _i < 2; ++_i) { const int _r = (u).arow0 + _h * 128 + R[_i]; int _s = g.ridx ? g.ridx[_r] : _r; if (_s < 0) _s = 0; dst[_h][_i] = _s; } } while (0)
#define F_AOFFS(src, dst) do { _Pragma("unroll") for (int _h = 0; _h < 2; ++_h) _Pragma("unroll") for (int _i = 0; _i < 2; ++_i) dst[_h][_i] = ((unsigned)src[_h][_i] * (unsigned)g.lda + (unsigned)C[_i]) * 2u; } while (0)
    GUnit cur, nxt; int ui = 0;
    S.unit(c0, cur);
    f32x4 acc[2][2][4][2];
#pragma unroll
    for (int a = 0; a < 2; ++a)
#pragma unroll
        for (int b = 0; b < 2; ++b)
#pragma unroll
            for (int m = 0; m < 4; ++m)
#pragma unroll
                for (int n = 0; n < 2; ++n) acc[a][b][m][n] = (f32x4){0.f, 0.f, 0.f, 0.f};
    bf16x8 At[4][2], B0[2][2], B1[2][2];
    unsigned voA[2][2]; int rnx[2][2];
    F_AROWS(cur, rnx); F_AOFFS(rnx, voA);
    const char* cB = (const char*)cur.B;
    F_STAGE(F_SB(0, 0), cB, voffB); F_STAGE(F_SA(0, 0), Ab, voA[0]); F_STAGE(F_SB(0, 1), cB + hstepB, voffB); F_STAGE(F_SA(0, 1), Ab, voA[1]);
    if (wr == 1) F_BAR;
    F_WAIT_V(4); F_BAR;
    F_STAGE(F_SB(1, 0), cB + kstep, voffB); F_STAGE(F_SA(1, 0), Ab + kstep, voA[0]); F_STAGE(F_SB(1, 1), cB + hstepB + kstep, voffB);
    F_WAIT_V(6); F_BAR;
    for (;;) {
        const int Ln = (ui + 1) * G + c0; const bool has_next = Ln < nunits;
        if (has_next) { S.unit(Ln, nxt); F_AROWS(nxt, rnx); }
        const char* nB = has_next ? (const char*)nxt.B : cB;
        for (int t = 0; t < nt; t += 2) {
            const bool last = (t == nt - 2);
            const char* a1 = Ab + (size_t)(t + 1) * kstep;
            const char* a2 = last ? Ab : Ab + (size_t)(t + 2) * kstep; const char* b2 = last ? nB : cB + (size_t)(t + 2) * kstep;
            const char* a3 = a2 + kstep; const char* b3 = b2 + kstep;
            F_LDB(B0, 0, 0); F_SCHED; F_LDA(At, 0, 0); F_STAGE(F_SA(1, 1), a1, voA[1]);
            if (last && has_next) F_AOFFS(rnx, voA);
            F_WAIT_L(8); F_BAR; F_WAIT_L(0); F_MMA(0, 0, At, B0); F_BAR; F_SCHED;
            F_LDB(B1, 0, 1); F_STAGE(F_SB(0, 0), b2, voffB);
            F_BAR; F_WAIT_L(0); F_MMA(0, 1, At, B1); F_BAR;
            F_LDA(At, 0, 1); F_STAGE(F_SA(0, 0), a2, voA[0]);
            F_BAR; F_WAIT_L(0); F_MMA(1, 0, At, B0); F_BAR; F_SCHED;
            F_STAGE(F_SB(0, 1), b2 + hstepB, voffB);
            F_WAIT_V(6); F_BAR; F_MMA(1, 1, At, B1); F_BAR;
            F_LDB(B0, 1, 0); F_SCHED; F_LDA(At, 1, 0); F_STAGE(F_SA(0, 1), a2, voA[1]);
            F_WAIT_L(8); F_BAR; F_WAIT_L(0); F_MMA(0, 0, At, B0); F_BAR; F_SCHED;
            F_LDB(B1, 1, 1); F_STAGE(F_SB(1, 0), b3, voffB);
            F_BAR; F_WAIT_L(0); F_MMA(0, 1, At, B1); F_BAR;
            F_LDA(At, 1, 1); F_STAGE(F_SA(1, 0), a3, voA[0]);
            F_BAR; F_WAIT_L(0); F_MMA(1, 0, At, B0); F_BAR; F_SCHED;
            F_STAGE(F_SB(1, 1), b3 + hstepB, voffB);
            F_WAIT_V(6); F_BAR; F_MMA(1, 1, At, B1); F_BAR;
        }
        E(acc, cur, wr, wc, fr, fq);
        if (!has_next) break;
#pragma unroll
        for (int a = 0; a < 2; ++a)
#pragma unroll
            for (int b = 0; b < 2; ++b)
#pragma unroll
                for (int m = 0; m < 4; ++m)
#pragma unroll
                    for (int n = 0; n < 2; ++n) acc[a][b][m][n] = (f32x4){0.f, 0.f, 0.f, 0.f};
        cur = nxt; cB = nB; ++ui;
    }
    F_WAIT_V(0);
    if (wr == 0) F_BAR;
    F_BAR;
#undef F_SA
#undef F_SB
#undef F_STAGE
#undef F_LDA
#undef F_LDB
#undef F_MMA
#undef F_WAIT_V
#undef F_WAIT_L
#undef F_BAR
#undef F_SCHED
#undef F_AROWS
#undef F_AOFFS
}
#define GEMM_PHASE(g, S, E) gemm_phase_fast(lds, g, S, E)
#endif

#define SBAR() __builtin_amdgcn_sched_barrier(0)
__device__ __forceinline__ int crow(int r, int hi) { return (r & 3) + 8 * (r >> 2) + 4 * hi; }
template <int DQK> __device__ __forceinline__ int kaddr(int row, int chunk) {
    const int sw = (DQK == 128) ? (row & 7) : ((row >> 1) & 7);
    return row * (DQK * 2) + ((chunk ^ sw) << 4);
}
__device__ __forceinline__ void partialSM(f32x16& p0, f32x16& p1, float& m_reg, float& mn, float& alpha, float C, float thr) {
    float pmax = p0[0];
#pragma unroll
    for (int r = 1; r < 16; ++r) pmax = fmaxf(pmax, p0[r]);
#pragma unroll
    for (int r = 0; r < 16; ++r) pmax = fmaxf(pmax, p1[r]);
    { auto rr = __builtin_amdgcn_permlane32_swap(__float_as_uint(pmax), __float_as_uint(pmax), false, false);
      pmax = fmaxf(__uint_as_float(rr[0]), __uint_as_float(rr[1])); }
    if (__builtin_expect(__all(pmax - m_reg <= thr), 1)) { mn = m_reg; alpha = 1.f; }
    else { mn = fmaxf(m_reg, pmax); alpha = __builtin_amdgcn_exp2f((m_reg - mn) * C); m_reg = mn; }
    const float mnC = -mn * C;
#pragma unroll
    for (int r = 0; r < 16; ++r) p0[r] = fmaf(p0[r], C, mnC);
#pragma unroll
    for (int r = 0; r < 16; ++r) p1[r] = fmaf(p1[r], C, mnC);
#pragma unroll
    for (int r = 0; r < 16; ++r) p0[r] = __builtin_amdgcn_exp2f(p0[r]);
}
__device__ __forceinline__ void finishSM(f32x16& p0, f32x16& p1, float alpha, float& l_reg, bf16x8& pa0, bf16x8& pa1, bf16x8& pa2, bf16x8& pa3) {
#pragma unroll
    for (int r = 0; r < 16; ++r) p1[r] = __builtin_amdgcn_exp2f(p1[r]);
    float ps = 0;
#pragma unroll
    for (int r = 0; r < 16; ++r) ps += p0[r];
#pragma unroll
    for (int r = 0; r < 16; ++r) ps += p1[r];
    { auto rr = __builtin_amdgcn_permlane32_swap(__float_as_uint(ps), __float_as_uint(ps), false, false);
      ps = __uint_as_float(rr[0]) + __uint_as_float(rr[1]); }
    l_reg = l_reg * alpha + ps;
#define PK4(P, BASE, OUT) do { unsigned a0 = pk2(P[BASE + 0], P[BASE + 1]), a1 = pk2(P[BASE + 2], P[BASE + 3]);   \
    unsigned b0 = pk2(P[BASE + 4], P[BASE + 5]), b1 = pk2(P[BASE + 6], P[BASE + 7]);                              \
    auto r0 = __builtin_amdgcn_permlane32_swap(a0, b0, false, false); auto r1 = __builtin_amdgcn_permlane32_swap(a1, b1, false, false); \
    u32x4 w = {r0[0], r1[0], r0[1], r1[1]}; OUT = *reinterpret_cast<bf16x8*>(&w); } while (0)
    PK4(p0, 0, pa0); PK4(p0, 8, pa1); PK4(p1, 0, pa2); PK4(p1, 8, pa3);
#undef PK4
}
template <int DQK> __device__ __forceinline__ void qkt(f32x16& p0, f32x16& p1, const char* Ks, const bf16x8* qr, int r32, int hi) {
    p0 = f32x16{}; p1 = f32x16{};
#pragma unroll
    for (int d0 = 0; d0 < DQK / 16; ++d0) { const int ch = 2 * d0 + hi;
        const bf16x8 b0 = *reinterpret_cast<const bf16x8*>(Ks + kaddr<DQK>(r32, ch));
        const bf16x8 b1 = *reinterpret_cast<const bf16x8*>(Ks + kaddr<DQK>(32 + r32, ch));
        p0 = __builtin_amdgcn_mfma_f32_32x32x16_bf16(b0, qr[d0], p0, 0, 0, 0);
        p1 = __builtin_amdgcn_mfma_f32_32x32x16_bf16(b1, qr[d0], p1, 0, 0, 0); }
}
__device__ __forceinline__ int v_st(int k, int c) { const int kk = (k & ~0xC) | ((k & 4) << 1) | ((k & 8) >> 1); return ((kk >> 3) * 4 + (c >> 5)) * 512 + ((kk & 7) * 32 + (c & 31)) * 2; }
__device__ __forceinline__ int v_rd_base(int lane) { return ((lane & 3) << 3) | (((lane >> 2) & 3) << 6) | (((lane >> 4) & 1) << 5) | (((lane >> 5) & 1) << 8); }
constexpr int v_rd_off(int d0, int ks, int half) { return d0 * 512 + ks * 4096 + half * 2048; }
template <int OFF> __device__ __forceinline__ s16x4 tr_read(int vb) {
    s16x4 r; asm volatile("ds_read_b64_tr_b16 %0, %1 offset:%2" : "=&v"(r) : "v"(vb), "i"(OFF) : "memory"); return r;
}
template <int D0> __device__ __forceinline__ void pv_one(f32x16& od, int vb, bf16x8 pa0, bf16x8 pa1, bf16x8 pa2, bf16x8 pa3) {
    const s16x4 l0 = tr_read<v_rd_off(D0, 0, 0)>(vb), h0 = tr_read<v_rd_off(D0, 0, 1)>(vb), l1 = tr_read<v_rd_off(D0, 1, 0)>(vb), h1 = tr_read<v_rd_off(D0, 1, 1)>(vb);
    const s16x4 l2 = tr_read<v_rd_off(D0, 2, 0)>(vb), h2 = tr_read<v_rd_off(D0, 2, 1)>(vb), l3 = tr_read<v_rd_off(D0, 3, 0)>(vb), h3 = tr_read<v_rd_off(D0, 3, 1)>(vb);
    asm volatile("s_waitcnt lgkmcnt(0)" ::: "memory"); SBAR();
#define PK(L, H) (bf16x8){L[0], L[1], L[2], L[3], H[0], H[1], H[2], H[3]}
    od = __builtin_amdgcn_mfma_f32_32x32x16_bf16(pa0, PK(l0, h0), od, 0, 0, 0);
    od = __builtin_amdgcn_mfma_f32_32x32x16_bf16(pa1, PK(l1, h1), od, 0, 0, 0);
    od = __builtin_amdgcn_mfma_f32_32x32x16_bf16(pa2, PK(l2, h2), od, 0, 0, 0);
    od = __builtin_amdgcn_mfma_f32_32x32x16_bf16(pa3, PK(l3, h3), od, 0, 0, 0);
#undef PK
}
__device__ __forceinline__ void pv_d0(f32x16* o, int vb, bf16x8 pa0, bf16x8 pa1, bf16x8 pa2, bf16x8 pa3) {
    pv_one<0>(o[0], vb, pa0, pa1, pa2, pa3); pv_one<1>(o[1], vb, pa0, pa1, pa2, pa3); pv_one<2>(o[2], vb, pa0, pa1, pa2, pa3); pv_one<3>(o[3], vb, pa0, pa1, pa2, pa3);
}

template <int DQK, int SDEPTH>
__device__ __forceinline__ void attn_body(const bf16_t* __restrict__ Qb, const bf16_t* __restrict__ Kh, const bf16_t* __restrict__ Vh, bf16_t* __restrict__ Ob, int ldo, int nkeys, float scale, char* lds) {
    constexpr int SHM_V = 64 * 128 * 2, SHM_K = 64 * DQK * 2, NKC = DQK / 8, KPT = NKC / 8;
    int tid = otid();
    const int wid = tid >> 6, lane = tid & 63, r32 = lane & 31, hi = lane >> 5;
    char* V_lds = lds; char* K_lds = lds + 2 * SHM_V;
    float* ws = (float*)(lds + 2 * SHM_V + 2 * SHM_K) + wid * 64; float* li_l = ws; float* al_l = ws + 32;
    const float C = scale * 1.4426950408889634f, thr = 8.0f / scale;
    float m_reg = -1e30f, l_reg = 0; f32x16 o[4] = {}; bf16x8 qr[DQK / 16];
    const bf16_t* Qw = Qb + (long)(wid * 32 + r32) * DQK + hi * 8;
#pragma unroll
    for (int d0 = 0; d0 < DQK / 16; ++d0) qr[d0] = *reinterpret_cast<const bf16x8*>(Qw + d0 * 16);
    const int sr = tid >> 4, sc = (tid & 15) * 8, vst0 = v_st(sr, sc), vst1 = v_st(32 + sr, sc);
    int kgo[KPT], klo[KPT];
#pragma unroll
    for (int i = 0; i < KPT; ++i) { const int q = tid + 512 * i, row = q / NKC, ch = q % NKC; kgo[i] = row * DQK + ch * 8; klo[i] = kaddr<DQK>(row, ch); }
    const int vb0 = (int)(uintptr_t)V_lds + v_rd_base(lane);
    struct { bf16x8 vs0, vs1, ks[KPT]; } sr_[SDEPTH ? SDEPTH : 1];
#define SLOAD(i, k0) do { sr_[i].vs0 = *reinterpret_cast<const bf16x8*>(&Vh[(long)((k0) + sr) * 128 + sc]); sr_[i].vs1 = *reinterpret_cast<const bf16x8*>(&Vh[(long)((k0) + 32 + sr) * 128 + sc]); \
    _Pragma("unroll") for (int _q = 0; _q < KPT; ++_q) sr_[i].ks[_q] = *reinterpret_cast<const bf16x8*>(&Kh[(long)(k0) * DQK + kgo[_q]]); } while (0)
#define SWRITE(b, i) do { *(bf16x8*)(V_lds + (b) * SHM_V + vst0) = sr_[i].vs0; *(bf16x8*)(V_lds + (b) * SHM_V + vst1) = sr_[i].vs1; \
    _Pragma("unroll") for (int _q = 0; _q < KPT; ++_q) *(bf16x8*)(K_lds + (b) * SHM_K + klo[_q]) = sr_[i].ks[_q]; } while (0)
#define SWAIT() do { if constexpr (SDEPTH == 2) { if constexpr (KPT == 2) asm volatile("s_waitcnt vmcnt(4)" ::: "memory"); else asm volatile("s_waitcnt vmcnt(5)" ::: "memory"); } \
    else asm volatile("s_waitcnt vmcnt(0)" ::: "memory"); } while (0)
#define RESC(a) do { if (__any((a) < 1.f)) { if (hi == 0) al_l[r32] = (a); asm volatile("s_waitcnt lgkmcnt(0)" ::: "memory"); \
    _Pragma("unroll") for (int d = 0; d < 4; ++d) _Pragma("unroll") for (int r = 0; r < 16; ++r) o[d][r] *= al_l[crow(r, hi)]; } } while (0)
    bf16x8 pa0, pa1, pa2, pa3; const int NT = nkeys / 64;
    if constexpr (SDEPTH == 0) {
        f32x16 pA0, pA1; float mnA, alA;
        SLOAD(0, 0); asm volatile("s_waitcnt vmcnt(0)" ::: "memory"); SWRITE(0, 0); __syncthreads();
        for (int j = 0; j < NT; ++j) {
            const int bo = j & 1;
            if (j + 1 < NT) SLOAD(0, (j + 1) * 64);
            SBAR(); qkt<DQK>(pA0, pA1, K_lds + bo * SHM_K, qr, r32, hi); partialSM(pA0, pA1, m_reg, mnA, alA, C, thr);
            RESC(alA); finishSM(pA0, pA1, alA, l_reg, pa0, pa1, pa2, pa3); SBAR();
            pv_d0(o, vb0 + bo * SHM_V, pa0, pa1, pa2, pa3);
            if (j + 1 < NT) { asm volatile("s_waitcnt vmcnt(0)" ::: "memory"); SWRITE(bo ^ 1, 0); }
            __syncthreads();
        }
    } else {
    f32x16 pA0, pA1, pB0, pB1; float mnA, mnB, alA, alB;
    constexpr int SE = 0, SO = SDEPTH - 1;
    SLOAD(SE, 0); asm volatile("s_waitcnt vmcnt(0)" ::: "memory"); SWRITE(0, SE); __syncthreads();
    qkt<DQK>(pA0, pA1, K_lds, qr, r32, hi); partialSM(pA0, pA1, m_reg, mnA, alA, C, thr);
    SLOAD(SO, 64); if constexpr (SDEPTH == 2) { if (2 < NT) SLOAD(SE, 2 * 64); }
    SWAIT(); SWRITE(1, SO); __syncthreads();
    for (int j = 1; j + 1 < NT; j += 2) {
        SBAR(); qkt<DQK>(pB0, pB1, K_lds + SHM_K, qr, r32, hi);
        finishSM(pA0, pA1, alA, l_reg, pa0, pa1, pa2, pa3); SBAR();
        SLOAD(SO, (j + SDEPTH) * 64); SBAR();
        pv_d0(o, vb0, pa0, pa1, pa2, pa3); partialSM(pB0, pB1, m_reg, mnB, alB, C, thr);
        __syncthreads(); SWAIT(); SWRITE(0, SE);
        RESC(alB); __syncthreads();
        SBAR(); qkt<DQK>(pA0, pA1, K_lds, qr, r32, hi);
        finishSM(pB0, pB1, alB, l_reg, pa0, pa1, pa2, pa3); SBAR();
        if (SDEPTH == 1 || j + 3 < NT) SLOAD(SE, (j + 1 + SDEPTH) * 64); SBAR();
        pv_d0(o, vb0 + SHM_V, pa0, pa1, pa2, pa3); partialSM(pA0, pA1, m_reg, mnA, alA, C, thr);
        __syncthreads(); SWAIT(); SWRITE(1, SO);
        RESC(alA); __syncthreads();
    }
    SBAR(); qkt<DQK>(pB0, pB1, K_lds + SHM_K, qr, r32, hi);
    finishSM(pA0, pA1, alA, l_reg, pa0, pa1, pa2, pa3); SBAR();
    pv_d0(o, vb0, pa0, pa1, pa2, pa3); partialSM(pB0, pB1, m_reg, mnB, alB, C, thr);
    __syncthreads(); RESC(alB);
    finishSM(pB0, pB1, alB, l_reg, pa0, pa1, pa2, pa3); SBAR();
    pv_d0(o, vb0 + SHM_V, pa0, pa1, pa2, pa3);
    }
    if (hi == 0) li_l[r32] = l_reg; asm volatile("s_waitcnt lgkmcnt(0)" ::: "memory");
    float rli[16];
#pragma unroll
    for (int r = 0; r < 16; ++r) rli[r] = __builtin_amdgcn_rcpf(li_l[crow(r, hi)]);
    bf16_t* Ow = Ob + (long)(wid * 32) * ldo;
#pragma unroll
    for (int r = 0; r < 16; ++r) { const int orow = crow(r, hi);
#pragma unroll
        for (int d0 = 0; d0 < 4; ++d0) Ow[(long)orow * ldo + d0 * 32 + r32] = f2bf(o[d0][r] * rli[r]); }
    __syncthreads();
#undef SLOAD
#undef SWRITE
#undef SWAIT
#undef RESC
}

struct CvtMat { const float* src; bf16_t* dst; const float* kscale; int N, lddst, nb, mode; };
__device__ __forceinline__ void cvt_block(const CvtMat& m, int kb, int nbk, int lane) {
    const int a = lane & 7, ng = lane >> 3, k0 = kb * 64 + 8 * a, n0 = nbk * 32 + 4 * ng;
    const float* s = m.src + (size_t)k0 * m.N + n0;
    f32x4 v[8];
#pragma unroll
    for (int j = 0; j < 8; ++j) v[j] = *(const f32x4*)(s + (size_t)j * m.N);
    if (m.kscale) {
#pragma unroll
        for (int j = 0; j < 8; ++j) v[j] *= m.kscale[k0 + j];
    }
#pragma unroll
    for (int i = 0; i < 4; ++i) { const int n = n0 + i, row = (m.mode == 0) ? n : ((n >> 7) * 256 + (n & 127) + (m.mode - 1) * 128);
        u32x4 w; w.x = pk2(v[0][i], v[1][i]); w.y = pk2(v[2][i], v[3][i]); w.z = pk2(v[4][i], v[5][i]); w.w = pk2(v[6][i], v[7][i]);
        *(u32x4*)(m.dst + (size_t)row * m.lddst + k0) = w; }
}
constexpr int CVT_SMALL = 3904 + 2048 + 432 + 192;
__device__ __forceinline__ void cvt_small_task(const Params& p, int l, int t, int lane) {
    unsigned char* ws = p.ws; CvtMat m;
    if (t < 3904) { m = CvtMat{p.in[I_WIN] + (size_t)l * DM * IN_COLS, (bf16_t*)(ws + O_WIN) + (size_t)l * NP * DM, nullptr, IN_COLS, DM, 122, 0}; }
    else if ((t -= 3904) < 2048) { m = CvtMat{p.in[I_WOUT] + (size_t)l * DM * DM, (bf16_t*)(ws + O_WOUT) + (size_t)l * DM * DM, nullptr, DM, DM, 64, 0}; }
    else if ((t -= 2048) < 432) { m = CvtMat{p.in[I_WUQ] + (size_t)l * 768 * 1152, (bf16_t*)(ws + O_WUQ) + (size_t)l * NQP * 768, p.in[I_MQN] + l * 768, 1152, 768, 36, 0}; }
    else { t -= 432; m = CvtMat{p.in[I_WUKV] + (size_t)l * 256 * 1536, (bf16_t*)(ws + O_WUKV) + (size_t)l * 1536 * 256, p.in[I_MKVN] + l * 256, 1536, 256, 48, 0}; }
    cvt_block(m, t / m.nb, t % m.nb, lane);
}
constexpr int CVT_EXP = 65 * 1536;
__device__ __forceinline__ void cvt_exp_task(const Params& p, int l, int t, int lane) {
    unsigned char* ws = p.ws;
    const int e = t / 1536, r = t % 1536, which = r >> 9, q = r & 511; CvtMat m;
    if (which < 2) {
        const float* src = (e < NEXP) ? p.in[which == 0 ? I_EG : I_EU] + ((size_t)l * NEXP + e) * DM * EH : p.in[which == 0 ? I_SG : I_SU] + (size_t)l * DM * EH;
        m = CvtMat{src, (bf16_t*)(ws + O_EGU) + (size_t)e * 1024 * 2048, nullptr, EH, DM, 16, 1 + which};
    } else {
        const float* src = (e < NEXP) ? p.in[I_EDN] + ((size_t)l * NEXP + e) * EH * DM : p.in[I_SD] + (size_t)l * EH * DM;
        m = CvtMat{src, (bf16_t*)(ws + O_ED) + (size_t)e * 2048 * 512, nullptr, DM, EH, 64, 0};
    }
    cvt_block(m, q / m.nb, q % m.nb, lane);
}
__device__ __forceinline__ void cvt_exp_all(const Params& p, int l) {
    const int lane = otid() & 63, gw = blockIdx.x * 8 + (otid() >> 6), GW = gridDim.x * 8;
    for (int t = gw; t < CVT_EXP; t += GW) cvt_exp_task(p, l, t, lane);
}
__device__ __forceinline__ void adaln_tasks(const Params& p, LAS float* lf) {
    const int lane = otid() & 63, wid = otid() >> 6;
    float* MOD = (float*)(p.ws + O_MOD);
    for (int task = blockIdx.x; task < 384; task += gridDim.x) {
        const int cb = task % 192, l = task / 192, col = cb * 64 + lane;
        const float* W = p.in[I_ADAW] + (size_t)l * DM * 12288 + col;
        float acc[9];
#pragma unroll
        for (int r = 0; r < 9; ++r) acc[r] = 0.f;
        for (int kb = wid * 256; kb < wid * 256 + 256; kb += 64) {
            float sv[9];
#pragma unroll
            for (int r = 0; r < 8; ++r) sv[r] = silu_f(p.in[I_C][r * DM + kb + lane]);
            sv[8] = silu_f(p.in[I_CCTX][kb + lane]);
#pragma unroll 8
            for (int kk = 0; kk < 64; ++kk) { const float w = W[(size_t)(kb + kk) * 12288];
#pragma unroll
                for (int r = 0; r < 9; ++r) acc[r] += rdlane(sv[r], kk) * w; }
        }
#pragma unroll
        for (int r = 0; r < 9; ++r) lf[(wid * 9 + r) * 64 + lane] = acc[r];
        __syncthreads();
        for (int r = wid; r < 9; r += 8) { float s = p.in[I_ADAB][l * 12288 + col];
#pragma unroll
            for (int w = 0; w < 8; ++w) s += lf[(w * 9 + r) * 64 + lane];
            MOD[(size_t)(l * 9 + r) * 12288 + col] = s; }
        __syncthreads();
    }
}
__device__ __forceinline__ void hss_tasks(const Params& p) {
    const int lane = otid() & 63, gw = blockIdx.x * 8 + (otid() >> 6), GW = gridDim.x * 8;
    for (int task = gw; task < 3 * 1024; task += GW) {
        const int set = task >> 10, l = (set == 1) ? 1 : 0, nset = (set == 2) ? 1 : 0, ord = (task >> 9) & 1, ch = task & 511, n = nset ? 256 : 2048;
        const float* HF = (const float*)(p.ws + O_HF) + (size_t)l * HF_LAYER + (nset ? HF_L0 : 0);
        const float* hf = HF + (size_t)((ord * 2 + 0) * 512 + ch) * n; const float* hb = HF + (size_t)((ord * 2 + 1) * 512 + ch) * n;
        float s = 0.f;
        for (int i = lane; i < n; i += 64) { const float a = hf[i], b = (i == 0) ? 0.f : hb[i]; s += a * a + b * b; }
        s = wave_sum(s);
        if (lane == 0) ((float*)(p.ws + O_HSS))[(size_t)((l * 2 + nset) * 2 + ord) * 512 + ch] = s;
    }
}
__device__ __forceinline__ void hyf_task(const Params& p, int l, int nset, int i0, LAS float* lf) {
    int tid = otid(); const int n = nset ? 256 : 2048;
    LAS float* feats = lf; LAS float* hd1 = lf + 8 * 33; LAS float* hd2 = hd1 + 512;
    if (tid < 8 * 33) { const int pos = tid / 33, f = tid % 33, i = i0 + pos; const float t = (float)i / (float)(n - 1), ang = 6.283185307179586f * (float)i / (float)n; float v;
        if (f == 0) v = t; else { const int j = (f - 1) & 15; const float band = 1e-4f + (float)j * ((15.0f - 1e-4f) / 15.0f); v = (f <= 16) ? cosf(ang * band) : sinf(ang * band); }
        feats[tid] = v; }
    __syncthreads();
    { const int pos = tid >> 6, j = tid & 63; const float* w1 = p.in[I_HYW1] + l * 33 * 64; float s = p.in[I_HYB1][l * 64 + j];
      for (int f = 0; f < 33; ++f) s += feats[pos * 33 + f] * w1[f * 64 + j];
      hd1[tid] = sinf(p.in[I_HYFREQ][l * 64 + j] * s); }
    __syncthreads();
    { const int pos = tid >> 6, j = tid & 63; const float* w2 = p.in[I_HYW2] + l * 64 * 64; float s = p.in[I_HYB2][l * 64 + j];
      for (int f = 0; f < 64; ++f) s += hd1[pos * 64 + f] * w2[f * 64 + j];
      hd2[tid] = sinf(p.in[I_HYFREQ][l * 64 + j] * s); }
    __syncthreads();
    const float* w3 = p.in[I_HYW3] + (size_t)l * 64 * 2048 + tid * 4;
    f32x4 acc[8];
#pragma unroll
    for (int q = 0; q < 8; ++q) acc[q] = (f32x4){0.f, 0.f, 0.f, 0.f};
    for (int j = 0; j < 64; ++j) { const f32x4 w = *(const f32x4*)(w3 + (size_t)j * 2048);
#pragma unroll
        for (int q = 0; q < 8; ++q) acc[q] += w * hd2[q * 64 + j]; }
    float* HF = (float*)(p.ws + O_HF) + (size_t)l * HF_LAYER + (nset ? HF_L0 : 0);
#pragma unroll
    for (int c = 0; c < 4; ++c) { const int col = tid * 4 + c, ord = col >> 10, dir = (col >> 9) & 1, ch = col & 511;
        const float delta = 3.0701134573253944f + (float)ch * ((15.350567286626973f - 3.0701134573253944f) / 511.0f); float v[8];
#pragma unroll
        for (int q = 0; q < 8; ++q) { const int i = i0 + q; const float t = (float)i / (float)(n - 1); v[q] = acc[q][c] * __expf(-t * delta); }
        float* dst = HF + (size_t)((ord * 2 + dir) * 512 + ch) * n + i0;
        *(f32x4*)dst = (f32x4){v[0], v[1], v[2], v[3]}; *(f32x4*)(dst + 4) = (f32x4){v[4], v[5], v[6], v[7]};    }
    __syncthreads();
}
__device__ __forceinline__ void phase_prologue(const Params& p, LAS unsigned char* lds) {
    const int tid = otid(); LAS float* lf = (LAS float*)lds;
    { const size_t gt = (size_t)blockIdx.x * NTHREADS + tid, GT = (size_t)gridDim.x * NTHREADS;
      for (int l = 0; l < NLAYER; ++l) {
          u32x4* z1 = (u32x4*)((bf16_t*)(p.ws + O_WIN) + ((size_t)l * NP + IN_COLS) * DM); const size_t n1 = (size_t)(NP - IN_COLS) * DM * 2 / 16;
          for (size_t i = gt; i < n1; i += GT) z1[i] = (u32x4){0u, 0u, 0u, 0u};
          u32x4* z2 = (u32x4*)((bf16_t*)(p.ws + O_WUQ) + ((size_t)l * NQP + 1152) * 768); const size_t n2 = (size_t)(NQP - 1152) * 768 * 2 / 16;
          for (size_t i = gt; i < n2; i += GT) z2[i] = (u32x4){0u, 0u, 0u, 0u};
      } }
    adaln_tasks(p, lf);
    for (int t = blockIdx.x; t < 544; t += gridDim.x) { if (t < 512) hyf_task(p, t >> 8, 0, (t & 255) * 8, lf); else hyf_task(p, 0, 1, (t - 512) * 8, lf); }
    { const int lane = tid & 63, gw = blockIdx.x * 8 + (tid >> 6), GW = gridDim.x * 8;
      for (int t = gw; t < NLAYER * CVT_SMALL; t += GW) cvt_small_task(p, t / CVT_SMALL, t % CVT_SMALL, lane); }
    cvt_exp_all(p, 0);
}

__device__ __forceinline__ void norm1_row(const Params& p, int l, int row, const float (&x)[32], int lane) {
    float ss = 0.f;
#pragma unroll
    for (int i = 0; i < 32; ++i) ss += x[i] * x[i];
    ss = wave_sum(ss); const float rstd = rsqrtf(ss * (1.0f / DM) + EPS);
    const float* g = p.in[I_NORMG] + (size_t)(l * 4 + 0) * DM; const float* mod = (const float*)(p.ws + O_MOD) + (size_t)(l * 9 + row_batch(row)) * 12288;
    bf16_t* H = (bf16_t*)(p.ws + O_H) + (size_t)row * DM;
#pragma unroll
    for (int j = 0; j < 8; ++j) { const int c = ROWCOL(j, lane); const f32x4 gv = *(const f32x4*)(g + c), sh = *(const f32x4*)(mod + c), sc = *(const f32x4*)(mod + DM + c); float h[4];
#pragma unroll
        for (int q = 0; q < 4; ++q) h[q] = x[j * 4 + q] * rstd * gv[q] * (1.0f + sc[q]) + sh[q];
        u32x2 w; w.x = pk2(h[0], h[1]); w.y = pk2(h[2], h[3]); *(u32x2*)(H + c) = w; }
}
__device__ __forceinline__ void phase_norm1(const Params& p, int l) {
    const int lane = otid() & 63, gw = blockIdx.x * 8 + (otid() >> 6), GW = gridDim.x * 8;
    for (int row = gw; row < NTOK; row += GW) { const float* src = resid_src(p, l, row); float x[32];
#pragma unroll
        for (int j = 0; j < 8; ++j) { const f32x4 v = *(const f32x4*)(src + ROWCOL(j, lane)); x[j * 4] = v[0]; x[j * 4 + 1] = v[1]; x[j * 4 + 2] = v[2]; x[j * 4 + 3] = v[3]; }
        norm1_row(p, l, row, x, lane); }
}

template <int HALF> __device__ __forceinline__ float rope1(float x, int e, float a) {
    float s, c; sincosf(a, &s, &c); const float pr = __shfl_xor(x, HALF);
    return (e & HALF) ? pr * s + x * c : x * c - pr * s;
}
__device__ __forceinline__ void gqa_post_row(const Params& p, int l, int row, int lane) {
    const bf16_t* P = (const bf16_t*)(p.ws + O_P) + (size_t)row * NP;
    const bool isctx = row >= NLAT; const int b = isctx ? (row - NLAT) >> 8 : row >> 11, t = isctx ? (row - NLAT) & 255 : row & 2047;
    const float inv = exp2f(-(float)(lane & 31) * (13.287712379549449f / 32.0f));
    const float a0 = (float)(t >> 6) * inv, a1 = (float)(t & 63) * inv;
    const float* qn = p.in[I_GQN] + l * 128; const float* kn = p.in[I_GKN] + l * 128;
    for (int h = 0; h < 6; ++h) {
        float x0 = bf2f(P[C_GQ + h * 128 + lane]), x1 = bf2f(P[C_GQ + h * 128 + 64 + lane]);
        const float rstd = rsqrtf(wave_sum(x0 * x0 + x1 * x1) * (1.0f / 128.0f) + EPS);
        x0 *= rstd * qn[lane]; x1 *= rstd * qn[64 + lane];
        if (!isctx) { x0 = rope1<32>(x0, lane, a0); x1 = rope1<32>(x1, lane, a1); }
        bf16_t* dst = isctx ? (bf16_t*)(p.ws + O_QGC) + ((size_t)(b * 6 + h) * CTXL + t) * 128 : (bf16_t*)(p.ws + O_QG) + ((size_t)(b * 6 + h) * SEQ + t) * 128;
        dst[lane] = f2bf(x0); dst[64 + lane] = f2bf(x1);
    }
    const int kpos = isctx ? t : CTXL + t;
    for (int h = 0; h < 2; ++h) {
        float x0 = bf2f(P[C_GK + h * 128 + lane]), x1 = bf2f(P[C_GK + h * 128 + 64 + lane]);
        const float rstd = rsqrtf(wave_sum(x0 * x0 + x1 * x1) * (1.0f / 128.0f) + EPS);
        x0 *= rstd * kn[lane]; x1 *= rstd * kn[64 + lane];
        if (!isctx) { x0 = rope1<32>(x0, lane, a0); x1 = rope1<32>(x1, lane, a1); }
        bf16_t* kd = (bf16_t*)(p.ws + O_KG) + ((size_t)(b * 2 + h) * LK + kpos) * 128; kd[lane] = f2bf(x0); kd[64 + lane] = f2bf(x1);
        bf16_t* vd = (bf16_t*)(p.ws + O_VG) + ((size_t)(b * 2 + h) * LK + kpos) * 128; vd[lane] = P[C_GV + h * 128 + lane]; vd[64 + lane] = P[C_GV + h * 128 + 64 + lane];
    }
}
__device__ __forceinline__ void seq_of(int row, int& s0, int& n) { if (row < NLAT) { s0 = row & ~2047; n = SEQ; } else { s0 = NLAT + ((row - NLAT) & ~255); n = CTXL; } }
__device__ __forceinline__ void load_conv_tile(const bf16_t* P, int t0, int pc0, LAS float* u) {
    int s0, n; seq_of(t0, s0, n);
    for (int i = otid(); i < 66 * 64; i += NTHREADS) { const int r = i >> 6, c = i & 63, row = t0 - 1 + r;
        u[r * 65 + c] = (row >= s0 && row < s0 + n) ? bf2f(P[(size_t)row * NP + pc0 + c]) : 0.f; }
}
__device__ __forceinline__ void hy_prep_task(const Params& p, int l, int t0, int c0, LAS float* u) {
    const bf16_t* P = (const bf16_t*)(p.ws + O_P);
    load_conv_tile(P, t0, c0, u);
    __syncthreads();
    const int tid = otid(), c = tid >> 3, tc = (tid & 7) * 8; const float* cw = p.in[I_HYCONV] + (size_t)l * 3 * 1536 + c0 + c;
    const float w0 = cw[0], w1 = cw[1536], w2 = cw[3072]; float y[8];
#pragma unroll
    for (int j = 0; j < 8; ++j) y[j] = w0 * u[(tc + j) * 65 + c] + w1 * u[(tc + j + 1) * 65 + c] + w2 * u[(tc + j + 2) * 65 + c];
    const int ch = c0 + c; bf16_t* dst = (ch < 512 ? (bf16_t*)(p.ws + O_VT) + (size_t)ch * NTOK : (bf16_t*)(p.ws + O_X1T) + (size_t)(ch - 512) * NTOK) + t0 + tc;
    u32x4 w; w.x = pk2(y[0], y[1]); w.y = pk2(y[2], y[3]); w.z = pk2(y[4], y[5]); w.w = pk2(y[6], y[7]); *(u32x4*)dst = w;
    __syncthreads();
}
__device__ __forceinline__ void mla_post_row(const Params& p, int l, int row, int lane) {
    const bf16_t* P = (const bf16_t*)(p.ws + O_P) + (size_t)row * NP;
    const bool isctx = row >= NLAT; const int b = isctx ? (row - NLAT) >> 8 : row >> 11, t = isctx ? (row - NLAT) & 255 : row & 2047;
    float sq = 0.f, skv = 0.f;
#pragma unroll
    for (int j = 0; j < 12; ++j) { const float v = bf2f(P[C_CQ + j * 64 + lane]); sq += v * v; }
#pragma unroll
    for (int j = 0; j < 4; ++j) { const float v = bf2f(P[C_CKV + j * 64 + lane]); skv += v * v; }
    const float rq = rsqrtf(wave_sum(sq) * (1.0f / 768.0f) + EPS), rkv = rsqrtf(wave_sum(skv) * (1.0f / 256.0f) + EPS);
    const int half = lane >> 5, e = lane & 31;
    const float inv = exp2f(-(float)(e & 15) * (13.287712379549449f / 16.0f));
    const float ang = (float)(half ? (t & 63) : (t >> 6)) * inv;
    const bf16_t* QR = (const bf16_t*)(p.ws + O_QRAW) + (size_t)row * NQP; const bf16_t* KV = (const bf16_t*)(p.ws + O_KVRAW) + (size_t)row * 1536;
    float kr = bf2f(P[C_KR + lane]); if (!isctx) kr = rope1<16>(kr, e, ang);
    const bf16_t krb = f2bf(kr); const int kpos = isctx ? t : CTXL + t;
    for (int h = 0; h < 6; ++h) {
        bf16_t* qd = isctx ? (bf16_t*)(p.ws + O_QMC) + ((size_t)(b * 6 + h) * CTXL + t) * 192 : (bf16_t*)(p.ws + O_QM) + ((size_t)(b * 6 + h) * SEQ + t) * 192;
        qd[lane] = f2bf(bf2f(QR[h * 192 + lane]) * rq); qd[64 + lane] = f2bf(bf2f(QR[h * 192 + 64 + lane]) * rq);
        float qr = bf2f(QR[h * 192 + 128 + lane]) * rq; if (!isctx) qr = rope1<16>(qr, e, ang);
        qd[128 + lane] = f2bf(qr);
        bf16_t* kd = (bf16_t*)(p.ws + O_KM) + ((size_t)(b * 6 + h) * LK + kpos) * 192;
        kd[lane] = f2bf(bf2f(KV[h * 256 + lane]) * rkv); kd[64 + lane] = f2bf(bf2f(KV[h * 256 + 64 + lane]) * rkv); kd[128 + lane] = krb;
        bf16_t* vd = (bf16_t*)(p.ws + O_VM) + ((size_t)(b * 6 + h) * LK + kpos) * 128;
        vd[lane] = f2bf(bf2f(KV[h * 256 + 128 + lane]) * rkv); vd[64 + lane] = f2bf(bf2f(KV[h * 256 + 192 + lane]) * rkv);
    }
}

__device__ __forceinline__ void hyconv_unit_valu(const Params& p, int l, int nset, int c, LAS float* lf) {
    const int tid = otid(), n = nset ? CTXL : SEQ, tokbase = nset ? NLAT : 0;
    LAS float* kc = lf; LAS float* z = lf + 4096; LAS float* z2 = z + 8 * SEQ;
    const float* HF = (const float*)(p.ws + O_HF) + (size_t)l * HF_LAYER + (nset ? HF_L0 : 0); const float* HSS = (const float*)(p.ws + O_HSS) + (size_t)((l * 2 + nset) * 2) * 512;
    const bf16_t* VT = (const bf16_t*)(p.ws + O_VT) + (size_t)c * NTOK + tokbase; const bf16_t* X1T = (const bf16_t*)(p.ws + O_X1T) + (size_t)c * NTOK + tokbase;
    bf16_t* Y2T = (bf16_t*)(p.ws + O_Y2T) + (size_t)c * NTOK + tokbase;
    for (int i = tid; i < 8 * n; i += NTHREADS) z[i] = bf2f(VT[i]);
    for (int ord = 0; ord < 2; ++ord) {
        const float rs = rsqrtf(HSS[ord * 512 + c] + EPS); const float* hf = HF + (size_t)((ord * 2 + 0) * 512 + c) * n; const float* hb = HF + (size_t)((ord * 2 + 1) * 512 + c) * n;
        for (int m = tid; m < 2 * n; m += NTHREADS) { const int lag = m - (n - 1); kc[m] = (m == 2 * n - 1) ? 0.f : (lag >= 0 ? hf[lag] : hb[-lag]) * rs; }
        __syncthreads();
        const LAS float* zs = ord ? z2 : z; const float skip = p.in[I_HYSKIP][(size_t)(l * 2 + ord) * 512 + c];
        for (int q = tid; q < n; q += NTHREADS) {
            const int b = q / (n >> 3), t0 = (q % (n >> 3)) * 8; float acc[8];
#pragma unroll
            for (int j = 0; j < 8; ++j) acc[j] = 0.f;
            const LAS float* zb = zs + b * n;
            for (int sb = 0; sb < n; sb += 8) {
                const LAS float* kb = kc + (t0 - sb + n - 8); float w[16];
#pragma unroll
                for (int i = 0; i < 4; ++i) { const f32x4 v = *(const LAS f32x4*)(kb + 4 * i); w[4 * i] = v[0]; w[4 * i + 1] = v[1]; w[4 * i + 2] = v[2]; w[4 * i + 3] = v[3]; }
                const f32x4 za = *(const LAS f32x4*)(zb + sb), zc = *(const LAS f32x4*)(zb + sb + 4); const float zv[8] = {za[0], za[1], za[2], za[3], zc[0], zc[1], zc[2], zc[3]};
#pragma unroll
                for (int ss = 0; ss < 8; ++ss)
#pragma unroll
                    for (int j = 0; j < 8; ++j) acc[j] += w[j - ss + 7] * zv[ss];
            }
            if (ord == 0) {
#pragma unroll
                for (int j = 0; j < 8; ++j) { const int idx = b * n + t0 + j; z2[idx] = bf2f(X1T[idx]) * (acc[j] + skip * z[idx]); }
            } else { float y[8];
#pragma unroll
                for (int j = 0; j < 8; ++j) y[j] = acc[j] + skip * z2[b * n + t0 + j];
                u32x4 w; w.x = pk2(y[0], y[1]); w.y = pk2(y[2], y[3]); w.z = pk2(y[4], y[5]); w.w = pk2(y[6], y[7]); *(u32x4*)(Y2T + b * n + t0) = w; }
        }
        __syncthreads();
    }
}
__device__ __forceinline__ void hy_fin_task(const Params& p, int l, int t0, int c0, LAS float* u) {
    const bf16_t* P = (const bf16_t*)(p.ws + O_P); LAS float* y = u + 66 * 65;
    load_conv_tile(P, t0, 1024 + c0, u);
    const int tid = otid();
    { const int c = tid >> 3, tc = (tid & 7) * 8; const u32x4 v = *(const u32x4*)((const bf16_t*)(p.ws + O_Y2T) + (size_t)(c0 + c) * NTOK + t0 + tc);
#pragma unroll
      for (int j = 0; j < 4; ++j) { y[c * 65 + tc + 2 * j] = __uint_as_float(v[j] << 16); y[c * 65 + tc + 2 * j + 1] = __uint_as_float(v[j] & 0xffff0000u); } }
    __syncthreads();
    { const int t = tid >> 3, cc = (tid & 7) * 8; const float* cw = p.in[I_HYCONV] + (size_t)l * 3 * 1536 + 1024 + c0 + cc; float o[8];
#pragma unroll
      for (int j = 0; j < 8; ++j) { const int c = cc + j; const float x2 = cw[j] * u[t * 65 + c] + cw[1536 + j] * u[(t + 1) * 65 + c] + cw[3072 + j] * u[(t + 2) * 65 + c]; o[j] = x2 * y[c * 65 + t]; }
      u32x4 w; w.x = pk2(o[0], o[1]); w.y = pk2(o[2], o[3]); w.z = pk2(o[4], o[5]); w.w = pk2(o[6], o[7]);
      *(u32x4*)((bf16_t*)(p.ws + O_MIX) + (size_t)(t0 + t) * DM + c0 + cc) = w; }
    __syncthreads();
}

__device__ __forceinline__ void mla_unit(const Params& p, int b, int h, int qb, bool ctxq, LAS unsigned char* lds) {
    unsigned char* ws = p.ws;
    const bf16_t* Q = ctxq ? (const bf16_t*)(ws + O_QMC) + (size_t)(b * 6 + h) * CTXL * 192 : (const bf16_t*)(ws + O_QM) + ((size_t)(b * 6 + h) * SEQ + qb * 256) * 192;
    bf16_t* O = (bf16_t*)(ws + O_MIX) + (size_t)(ctxq ? NLAT + b * CTXL : b * SEQ + qb * 256) * DM + 512 + h * 128;
    attn_body<192, 0>(Q, (const bf16_t*)(ws + O_KM) + (size_t)(b * 6 + h) * LK * 192, (const bf16_t*)(ws + O_VM) + (size_t)(b * 6 + h) * LK * 128, O, DM, ctxq ? CTXL : LK, 0.07216878364870322f, (char*)lds);
}
__device__ __forceinline__ void gqa_unit(const Params& p, int b, int h, int qb, bool ctxq, LAS unsigned char* lds) {
    unsigned char* ws = p.ws;
    const bf16_t* Q = ctxq ? (const bf16_t*)(ws + O_QGC) + (size_t)(b * 6 + h) * CTXL * 128 : (const bf16_t*)(ws + O_QG) + ((size_t)(b * 6 + h) * SEQ + qb * 256) * 128;
    bf16_t* O = (bf16_t*)(ws + O_MIX) + (size_t)(ctxq ? NLAT + b * CTXL : b * SEQ + qb * 256) * DM + 1280 + h * 128;
    attn_body<128, 2>(Q, (const bf16_t*)(ws + O_KG) + (size_t)(b * 2 + h / 3) * LK * 128, (const bf16_t*)(ws + O_VG) + (size_t)(b * 2 + h / 3) * LK * 128, O, DM, ctxq ? CTXL : LK, 0.08838834764831845f, (char*)lds);
}
__device__ __forceinline__ void phase_mixer(const Params& p, int l, LAS unsigned char* lds) {
    const int G = gridDim.x, bid = blockIdx.x; const bool last = (l == NLAYER - 1);
    for (int u = bid; u < 384 + (last ? 0 : 48); u += G) { if (u < 384) mla_unit(p, u / 48, (u >> 3) % 6, u & 7, false, lds); else mla_unit(p, (u - 384) / 6, (u - 384) % 6, 0, true, lds); }
    for (int u = (bid + G / 2) % G; u < 384 + (last ? 0 : 48); u += G) { if (u < 384) gqa_unit(p, u / 48, (u >> 3) % 6, u & 7, false, lds); else gqa_unit(p, (u - 384) / 6, (u - 384) % 6, 0, true, lds); }
    for (int u = bid; u < (last ? 512 : 1024); u += G) hyconv_unit_valu(p, l, u >> 9, u & 511, (LAS float*)lds);
}

__device__ __forceinline__ void phase_route(const Params& p, int l, LAS unsigned char* lds) {
    const int tid = otid(), wid = tid >> 6, lane = tid & 63; const bool last = (l == NLAYER - 1); const int NR = last ? NLAT : NTOK;
    LAS float* frow = (LAS float*)lds; LAS float* part = frow + 8 * DM;
    const float* g1 = p.in[I_NORMG] + (size_t)(l * 4 + 1) * DM; const float* g2 = p.in[I_NORMG] + (size_t)(l * 4 + 2) * DM;
    const float* RW = p.in[I_RW] + (size_t)l * DM * NEXP; unsigned* cnt = (unsigned*)(p.ws + O_CTL) + CW_CNT + l * 64;
    { int* stok = (int*)(p.ws + O_STOK); for (int i = blockIdx.x * NTHREADS + tid; i < NSLOTS; i += gridDim.x * NTHREADS) stok[i] = (i < RSLOTS) ? -1 : ((i - RSLOTS) < NR ? i - RSLOTS : -1); }
    for (int g = blockIdx.x; g < NR / 8; g += gridDim.x) {
        const int row = g * 8 + wid; const float* mod = (const float*)(p.ws + O_MOD) + (size_t)(l * 9 + row_batch(row)) * 12288;
        { const bf16_t* O = (const bf16_t*)(p.ws + O_OUT) + (size_t)row * DM; const float* rs = resid_src(p, l, row); float* X = (float*)(p.ws + O_X) + (size_t)row * DM; bf16_t* H = (bf16_t*)(p.ws + O_H) + (size_t)row * DM;
          float o[32], x[32]; float ss = 0.f;
#pragma unroll
          for (int j = 0; j < 8; ++j) { const u32x2 v = *(const u32x2*)(O + ROWCOL(j, lane)); o[j * 4] = __uint_as_float(v.x << 16); o[j * 4 + 1] = __uint_as_float(v.x & 0xffff0000u); o[j * 4 + 2] = __uint_as_float(v.y << 16); o[j * 4 + 3] = __uint_as_float(v.y & 0xffff0000u); }
#pragma unroll
          for (int i = 0; i < 32; ++i) ss += o[i] * o[i];
          const float r1 = rsqrtf(wave_sum(ss) * (1.0f / DM) + EPS); float s2 = 0.f;
#pragma unroll
          for (int j = 0; j < 8; ++j) { const int c = ROWCOL(j, lane); const f32x4 xv = *(const f32x4*)(rs + c), gv = *(const f32x4*)(g1 + c), ga = *(const f32x4*)(mod + 2 * DM + c); f32x4 xn;
#pragma unroll
              for (int q = 0; q < 4; ++q) { xn[q] = xv[q] + ga[q] * (o[j * 4 + q] * r1 * gv[q]); x[j * 4 + q] = xn[q]; s2 += xn[q] * xn[q]; }
              *(f32x4*)(X + c) = xn; }
          const float r2 = rsqrtf(wave_sum(s2) * (1.0f / DM) + EPS);
#pragma unroll
          for (int j = 0; j < 8; ++j) { const int c = ROWCOL(j, lane); const f32x4 gv = *(const f32x4*)(g2 + c), sh = *(const f32x4*)(mod + 3 * DM + c), sc = *(const f32x4*)(mod + 4 * DM + c); f32x4 f;
#pragma unroll
              for (int q = 0; q < 4; ++q) f[q] = x[j * 4 + q] * r2 * gv[q] * (1.0f + sc[q]) + sh[q];
              u32x2 w; w.x = pk2(f[0], f[1]); w.y = pk2(f[2], f[3]); *(u32x2*)(H + c) = w; *(LAS f32x4*)(frow + wid * DM + c) = f; } }
        __syncthreads();
        { float acc[8];
#pragma unroll
          for (int r = 0; r < 8; ++r) acc[r] = 0.f;
          for (int k = wid * 256; k < wid * 256 + 256; k += 4) { const float w0 = RW[(size_t)k * 64 + lane], w1 = RW[(size_t)(k + 1) * 64 + lane], w2 = RW[(size_t)(k + 2) * 64 + lane], w3 = RW[(size_t)(k + 3) * 64 + lane];
#pragma unroll
              for (int r = 0; r < 8; ++r) { const f32x4 fv = *(const LAS f32x4*)(frow + r * DM + k); acc[r] += fv[0] * w0 + fv[1] * w1 + fv[2] * w2 + fv[3] * w3; } }
#pragma unroll
          for (int r = 0; r < 8; ++r) part[(wid * 8 + r) * 64 + lane] = acc[r]; }
        __syncthreads();
        { float logit = 0.f;
#pragma unroll
          for (int w = 0; w < 8; ++w) logit += part[(w * 8 + wid) * 64 + lane];
          const float score = 1.0f / (1.0f + expf(-logit)), biased = score + p.in[I_RB][l * 64 + lane];
          float m1 = biased; m1 = fmaxf(m1, __shfl_xor(m1, 1)); m1 = fmaxf(m1, __shfl_xor(m1, 2)); m1 = fmaxf(m1, __shfl_xor(m1, 4));
          const unsigned long long bal = __ballot(biased == m1); const int first = __builtin_ctz((unsigned)((bal >> (lane & ~7)) & 0xffull));
          float m2 = ((lane & 7) == first) ? -INFINITY : biased; m2 = fmaxf(m2, __shfl_xor(m2, 1)); m2 = fmaxf(m2, __shfl_xor(m2, 2)); m2 = fmaxf(m2, __shfl_xor(m2, 4));
          const float gs = m1 + m2; const int grp = lane >> 3; int rank = 0;
#pragma unroll
          for (int q = 0; q < 8; ++q) { const float v = rdlane(gs, q * 8); rank += (v > gs || (v == gs && q < grp)) ? 1 : 0; }
          const float cand = (rank < 4) ? biased : -INFINITY; int re = 0;
          for (int q = 0; q < 64; ++q) { const float v = rdlane(cand, q); re += (v > cand || (v == cand && q < lane)) ? 1 : 0; }
          const bool sel = re < TOPK; const float ssum = wave_sum(sel ? score : 0.f);
          if (sel) { ((int*)(p.ws + O_EIDX))[(size_t)row * 8 + re] = lane; ((float*)(p.ws + O_GATE))[(size_t)row * 8 + re] = score / ssum * 2.5f; atomicAdd(&cnt[lane], 1u); } }
        __syncthreads();
    }
}
__device__ __forceinline__ void phase_place(const Params& p, int l, LAS unsigned char* lds) {
    const int tid = otid(); const int NR = (l == NLAYER - 1) ? NLAT : NTOK; LAS int* pstart = (LAS int*)lds;
    const unsigned* cnt = (const unsigned*)(p.ws + O_CTL) + CW_CNT + l * 64; unsigned* cur = (unsigned*)(p.ws + O_CTL) + CW_CUR + l * 64;
    if (tid == 0) { int run = 0; for (int e = 0; e < NEXP; ++e) { pstart[e] = run; run += ((int)cnt[e] + 255) & ~255; } }
    __syncthreads();
    const int* eidx = (const int*)(p.ws + O_EIDX); int* slot = (int*)(p.ws + O_SLOT); int* stok = (int*)(p.ws + O_STOK);
    for (int i = blockIdx.x * NTHREADS + tid; i < NR * TOPK; i += gridDim.x * NTHREADS) { const int row = i / TOPK, k = i % TOPK, e = eidx[(size_t)row * 8 + k];
        const int s = pstart[e] + (int)atomicAdd(&cur[e], 1u); slot[(size_t)row * 8 + k] = s; stok[s] = row; }
    __syncthreads();
}
__device__ __forceinline__ void phase_final(const Params& p, int l) {
    const int lane = otid() & 63, gw = blockIdx.x * 8 + (otid() >> 6), GW = gridDim.x * 8; const bool last = (l == NLAYER - 1); const int NR = last ? NLAT : NTOK;
    const bf16_t* DO = (const bf16_t*)(p.ws + O_DOUT); const float* g3 = p.in[I_NORMG] + (size_t)(l * 4 + 3) * DM;
    for (int row = gw; row < NR; row += GW) {
        float y[32];
        { const bf16_t* src = DO + (size_t)(RSLOTS + row) * DM;
#pragma unroll
          for (int j = 0; j < 8; ++j) { const u32x2 v = *(const u32x2*)(src + ROWCOL(j, lane)); y[j * 4] = __uint_as_float(v.x << 16); y[j * 4 + 1] = __uint_as_float(v.x & 0xffff0000u); y[j * 4 + 2] = __uint_as_float(v.y << 16); y[j * 4 + 3] = __uint_as_float(v.y & 0xffff0000u); } }
        for (int k = 0; k < TOPK; ++k) { const int s = ((const int*)(p.ws + O_SLOT))[(size_t)row * 8 + k]; const float gt = ((const float*)(p.ws + O_GATE))[(size_t)row * 8 + k]; const bf16_t* src = DO + (size_t)s * DM;
#pragma unroll
            for (int j = 0; j < 8; ++j) { const u32x2 v = *(const u32x2*)(src + ROWCOL(j, lane)); y[j * 4] += gt * __uint_as_float(v.x << 16); y[j * 4 + 1] += gt * __uint_as_float(v.x & 0xffff0000u); y[j * 4 + 2] += gt * __uint_as_float(v.y << 16); y[j * 4 + 3] += gt * __uint_as_float(v.y & 0xffff0000u); } }
        float ss = 0.f;
#pragma unroll
        for (int i = 0; i < 32; ++i) ss += y[i] * y[i];
        const float r = rsqrtf(wave_sum(ss) * (1.0f / DM) + EPS); const float* mod = (const float*)(p.ws + O_MOD) + (size_t)(l * 9 + row_batch(row)) * 12288;
        float* X = (float*)(p.ws + O_X) + (size_t)row * DM; float x[32];
#pragma unroll
        for (int j = 0; j < 8; ++j) { const int c = ROWCOL(j, lane); const f32x4 xv = *(const f32x4*)(X + c), gv = *(const f32x4*)(g3 + c), gf = *(const f32x4*)(mod + 5 * DM + c); f32x4 xn;
#pragma unroll
            for (int q = 0; q < 4; ++q) { xn[q] = xv[q] + gf[q] * (y[j * 4 + q] * r * gv[q]); x[j * 4 + q] = xn[q]; }
            if (last) *(f32x4*)(p.out + (size_t)row * DM + c) = xn; else *(f32x4*)(X + c) = xn; }
        if (!last) norm1_row(p, l + 1, row, x, lane);
    }
}

#define XB_TMO      128
#define XB_XCNT(j)  (256  + 64 * (j))
#define XB_XSUB(j)  (1280 + 64 * (j))
#define XB_XGEN(j)  (2304 + 64 * (j))
#define XB_TOP      3328
#define XB_TOPGEN   3392
#define XCD_BAR_WORDS 3456
#define XB_SPIN_CAP (1u << 23)

__device__ __forceinline__ unsigned xb_ld(unsigned* p)              { return __hip_atomic_load(p, __ATOMIC_RELAXED, __HIP_MEMORY_SCOPE_AGENT); }
__device__ __forceinline__ unsigned xb_add(unsigned* p, unsigned v) { return __hip_atomic_fetch_add(p, v, __ATOMIC_RELAXED, __HIP_MEMORY_SCOPE_AGENT); }
__device__ __forceinline__ unsigned xb_xcc_id() { return (unsigned)__builtin_amdgcn_s_getreg((3 << 11) | 20) & 0xFu; }
#define XB_SPIN(cond, bar) do { unsigned _sp = 0; while (cond) { __builtin_amdgcn_s_sleep(1); \
    if ((++_sp & 255u) == 0u) { if (xb_ld(&(bar)[XB_TMO])) break; if (_sp > XB_SPIN_CAP) { atomicAdd(&(bar)[XB_TMO], 1u); break; } } } } while (0)

struct XcdBarrier {
    unsigned* bar; unsigned x;
    volatile LAS unsigned* st;
};

__device__ __forceinline__ XcdBarrier xcd_barrier_post(unsigned* bar, volatile LAS unsigned* st) {
    XcdBarrier b; b.bar = bar; b.x = xb_xcc_id(); b.st = st;
    if (threadIdx.x == 0) (void)xb_add(&bar[XB_XCNT(b.x)], 1u);
    return b;
}
__device__ __forceinline__ void xcd_barrier_complete(unsigned* bar, unsigned x, unsigned& nloc, unsigned& nx) {
    const unsigned G = gridDim.x * gridDim.y * gridDim.z;
    unsigned sum, cnt, mine, sp = 0u;
    for (;;) {
        sum = 0u; cnt = 0u; mine = 0u;
#pragma unroll
        for (unsigned j = 0; j < 16; ++j) { const unsigned c = xb_ld(&bar[XB_XCNT(j)]); sum += c; cnt += (c > 0u) ? 1u : 0u; mine = (j == x) ? c : mine; }
        if (sum == G) break;
        __builtin_amdgcn_s_sleep(1);
        if ((++sp & 255u) == 0u) { if (xb_ld(&bar[XB_TMO])) break; if (sp > XB_SPIN_CAP) { atomicAdd(&bar[XB_TMO], 1u); break; } }
    }
    nloc = mine > 0u ? mine : 1u; nx = cnt > 0u ? cnt : 1u;
}

__device__ __forceinline__ void xcd_barrier(const XcdBarrier& b) {
    asm volatile("s_waitcnt vmcnt(0)" ::: "memory");
    __syncthreads();
    if (threadIdx.x == 0) {
        unsigned* bar = b.bar;
        __builtin_amdgcn_s_waitcnt(0);
        unsigned nloc = b.st[0], nx = b.st[1];
        if (nloc == 0u) { xcd_barrier_complete(bar, b.x, nloc, nx); b.st[0] = nloc; b.st[1] = nx; }
        const unsigned old = xb_add(&bar[XB_XSUB(b.x)], 1u);
        const unsigned gen = old / nloc;
        if (old + 1u == (gen + 1u) * nloc) {
            __builtin_amdgcn_fence(__ATOMIC_RELEASE, "agent");
            asm volatile("s_waitcnt vmcnt(0)" ::: "memory");
            const unsigned og = xb_add(&bar[XB_TOP], 1u);
            const unsigned tg = og / nx;
            if (og + 1u == (tg + 1u) * nx) xb_add(&bar[XB_TOPGEN], 1u);
            else XB_SPIN(xb_ld(&bar[XB_TOPGEN]) == tg, bar);
            __builtin_amdgcn_fence(__ATOMIC_ACQUIRE, "agent");
            xb_add(&bar[XB_XGEN(b.x)], 1u);
            asm volatile("s_waitcnt vmcnt(0)" ::: "memory");
        } else {
            XB_SPIN(xb_ld(&bar[XB_XGEN(b.x)]) == gen, bar);
            __builtin_amdgcn_fence(__ATOMIC_ACQUIRE, "agent");
            asm volatile("s_waitcnt vmcnt(0)" ::: "memory");
        }
    }
    __syncthreads();
}


enum { PH_PRO = 0, PH_NORM1, PH_WIN, PH_POSTA, PH_POSTB, PH_MIXER, PH_HYFIN, PH_WOUT, PH_ROUTE, PH_PLACE, PH_GEMM1, PH_GEMM2, PH_FINAL, PH_COUNT };

template <int PH>
__device__ __forceinline__ void run_phase(const Params& p_in, int l, LAS unsigned char* lds) {
    Params p = p_in; { unsigned char* w = p.ws; asm volatile("" : "+s"(w)); p.ws = w; }
    unsigned char* ws = p.ws; const bool last = (l == NLAYER - 1);
    const int gw = blockIdx.x * 8 + (otid() >> 6), GW = gridDim.x * 8, lane = otid() & 63;
    if constexpr (PH == PH_PRO) { phase_prologue(p, lds); }
    if constexpr (PH == PH_NORM1) { phase_norm1(p, l); }
    if constexpr (PH == PH_WIN) {
        GemmDesc g{(const bf16_t*)(ws + O_H), DM, nullptr, DM, DM}; EpiStoreBf16 E{(bf16_t*)(ws + O_P), NP};
        const bf16_t* Bt = (const bf16_t*)(ws + O_WIN) + (size_t)l * NP * DM;
        if (!last) { DenseSched S{Bt, DM, NTOK / 256, 16, 0, 0}; GEMM_PHASE(g, S, E); }
        else { DenseSched S{Bt, DM, NLAT / 256, 16, 0, 0}; GEMM_PHASE(g, S, E); DenseSched S2{Bt, DM, NCTX / 256, 4, NLAT, 12}; GEMM_PHASE(g, S2, E); }
    }
    if constexpr (PH == PH_POSTA) {
#ifndef DBG_SKIP
#define DBG_SKIP 0
#endif
        if (!(DBG_SKIP & 1)) { GemmDesc g{(const bf16_t*)(ws + O_P) + C_CQ, NP, nullptr, 768, 768}; EpiStoreBf16 E{(bf16_t*)(ws + O_QRAW), NQP};
          DenseSched S{(const bf16_t*)(ws + O_WUQ) + (size_t)l * NQP * 768, 768, (last ? NLAT : NTOK) / 256, 5, 0, 0}; GEMM_PHASE(g, S, E); }
        if (!(DBG_SKIP & 2)) { GemmDesc g{(const bf16_t*)(ws + O_P) + C_CKV, NP, nullptr, 256, 256}; EpiStoreBf16 E{(bf16_t*)(ws + O_KVRAW), 1536};
          DenseSched S{(const bf16_t*)(ws + O_WUKV) + (size_t)l * 1536 * 256, 256, NTOK / 256, 6, 0, 0}; GEMM_PHASE(g, S, E); }
        const int ntt = (last ? NLAT : NTOK) / 64;
        if (!(DBG_SKIP & 4)) for (int t = blockIdx.x; t < ntt * 16; t += gridDim.x) hy_prep_task(p, l, (t >> 4) * 64, (t & 15) * 64, (LAS float*)lds);
        if (!(DBG_SKIP & 8)) for (int row = gw; row < NTOK; row += GW) gqa_post_row(p, l, row, lane);
    }
    if constexpr (PH == PH_POSTB) { if (l == 0) hss_tasks(p); for (int row = gw; row < NTOK; row += GW) mla_post_row(p, l, row, lane); }
    if constexpr (PH == PH_MIXER) { phase_mixer(p, l, lds); }
    if constexpr (PH == PH_HYFIN) { const int ntt = (last ? NLAT : NTOK) / 64; for (int t = blockIdx.x; t < ntt * 8; t += gridDim.x) hy_fin_task(p, l, (t >> 3) * 64, (t & 7) * 64, (LAS float*)lds); }
    if constexpr (PH == PH_WOUT) {
        GemmDesc g{(const bf16_t*)(ws + O_MIX), DM, nullptr, DM, DM}; EpiStoreBf16 E{(bf16_t*)(ws + O_OUT), DM};
        DenseSched S{(const bf16_t*)(ws + O_WOUT) + (size_t)l * DM * DM, DM, (last ? NLAT : NTOK) / 256, 8, 0, 0}; GEMM_PHASE(g, S, E);
    }
    if constexpr (PH == PH_ROUTE) { phase_route(p, l, lds); }
    if constexpr (PH == PH_PLACE) { phase_place(p, l, lds); }
    if constexpr (PH == PH_GEMM1 || PH == PH_GEMM2) {
        LAS int* te = (LAS int*)(lds + LDS_TILES); LAS int* ts = te + MAXTILES; LAS int* misc = (LAS int*)(lds + LDS_MISC) + 16;
        const int nt = moe_build_tiles((const unsigned*)(ws + O_CTL) + CW_CNT + l * 64, (last ? NLAT : NTOK) / 256, te, ts, misc);
        if constexpr (PH == PH_GEMM1) {
            GemmDesc g{(const bf16_t*)(ws + O_H), DM, (const int*)(ws + O_STOK), DM, DM}; EpiSwiGLU E{(bf16_t*)(ws + O_HID)};
            MoeSched S{te, ts, nt, 4, (const bf16_t*)(ws + O_EGU), (size_t)1024 * 2048, DM, 128}; GEMM_PHASE(g, S, E);
        } else {
            GemmDesc g{(const bf16_t*)(ws + O_HID), EH, nullptr, EH, EH}; EpiStoreBf16 E{(bf16_t*)(ws + O_DOUT), DM};
            MoeSched S{te, ts, nt, 8, (const bf16_t*)(ws + O_ED), (size_t)2048 * 512, EH, 256}; GEMM_PHASE(g, S, E);
        }
        __syncthreads();
    }
    if constexpr (PH == PH_FINAL) {
        phase_final(p, l);
        if (!last) cvt_exp_all(p, l + 1);
    }
}

#ifndef MEGA
#define MEGA 0
#endif


#if MEGA
__global__ void __launch_bounds__(NTHREADS, 2) mega_fwd(Params p) {
    extern __shared__ __attribute__((aligned(16))) unsigned char lds_raw[];
    LAS unsigned char* lds = (LAS unsigned char*)lds_raw;
    volatile LAS unsigned* xbw = (volatile LAS unsigned*)(lds + LDS_MISC);
    if (otid() == 0) { xbw[0] = 0u; xbw[1] = 0u; }
    __syncthreads();
    { const XcdBarrier b0 = xcd_barrier_post((unsigned*)(p.ws + O_CTL) + CW_BAR, xbw); if (otid() == 0) xbw[2] = b0.x; }
    __syncthreads();
#define GRID_BAR() do { XcdBarrier b_; b_.bar = (unsigned*)(p.ws + O_CTL) + CW_BAR; b_.x = xbw[2]; b_.st = xbw; xcd_barrier(b_); } while (0)
    run_phase<PH_PRO>(p, 0, lds); GRID_BAR();
    for (int l = 0; l < NLAYER; ++l) {
        if (l == 0) { run_phase<PH_NORM1>(p, l, lds); GRID_BAR(); }
        run_phase<PH_WIN>(p, l, lds); GRID_BAR();
        run_phase<PH_POSTA>(p, l, lds); GRID_BAR();
        run_phase<PH_POSTB>(p, l, lds); GRID_BAR();
        run_phase<PH_MIXER>(p, l, lds); GRID_BAR();
        run_phase<PH_HYFIN>(p, l, lds); GRID_BAR();
        run_phase<PH_WOUT>(p, l, lds); GRID_BAR();
        run_phase<PH_ROUTE>(p, l, lds); GRID_BAR();
        run_phase<PH_PLACE>(p, l, lds); GRID_BAR();
        run_phase<PH_GEMM1>(p, l, lds); GRID_BAR();
        run_phase<PH_GEMM2>(p, l, lds); GRID_BAR();
        run_phase<PH_FINAL>(p, l, lds);
        if (l + 1 < NLAYER) GRID_BAR();
    }
}
#endif

#if !MEGA
template <int PH> __global__ void __launch_bounds__(NTHREADS, 2) k_phase(Params p) {
    extern __shared__ __attribute__((aligned(16))) unsigned char lds_raw[];
    run_phase<PH>(p, p.layer, (LAS unsigned char*)lds_raw);
}
template <int PH> static bool prep_phase() { return hipFuncSetAttribute((const void*)k_phase<PH>, hipFuncAttributeMaxDynamicSharedMemorySize, LDS_BYTES) == hipSuccess; }
static int g_nlaunch = 0;
#ifndef DBG_STOP
#define DBG_STOP 1000
#define DBG_DUMP 0
#else
#define DBG_DUMP 1
#ifndef DBG_SET
#define DBG_SET 31
#endif
#endif
template <int PH> static void launch_phase(Params p, int l, hipStream_t st) { if (g_nlaunch++ >= DBG_STOP) return; p.layer = l; hipLaunchKernelGGL(k_phase<PH>, dim3(256), dim3(NTHREADS), LDS_BYTES, st, p); }
#endif


#if DBG_DUMP
__device__ __forceinline__ float san(float x) { return (x == x && fabsf(x) < 1e6f) ? x : 1.0f; }
__global__ void __launch_bounds__(256) k_dump(Params p) {
    const size_t N = (size_t)NLAT * DM;
    const bf16_t* b1 = (const bf16_t*)(p.ws + O_WIN); const size_t n1 = (O_X - O_WIN) / 2;
    const bf16_t* b2 = (const bf16_t*)(p.ws + O_H); const size_t n2 = (size_t)NTOK * DM;
    const bf16_t* b3 = (const bf16_t*)(p.ws + O_A); const size_t n3 = (O_AEND - O_A) / 2;
    const float* f1 = (const float*)(p.ws + O_MOD); const size_t m1 = (O_WIN - O_MOD) / 4;
    const float* f2 = (const float*)(p.ws + O_X); const size_t m2 = (size_t)NTOK * DM;
    for (size_t i = (size_t)blockIdx.x * 256 + otid(); i < N; i += (size_t)gridDim.x * 256) {
        float v = 0.f;
        if (DBG_SET & 1) for (size_t e = i; e < n1; e += N) v += san(bf2f(b1[e]));
        if (DBG_SET & 2) for (size_t e = i; e < n2; e += N) v += san(bf2f(b2[e]));
        if (DBG_SET & 4) for (size_t e = i; e < n3; e += N) v += san(bf2f(b3[e]));
        if (DBG_SET & 8) for (size_t e = i; e < m1; e += N) v += san(f1[e]);
        if (DBG_SET & 16) for (size_t e = i; e < m2; e += N) v += san(f2[e]);
        if (DBG_SET & 32) v += san(bf2f(((const bf16_t*)(p.ws + O_WUKV))[i % ((size_t)2 * 1536 * 256)]));
        if (DBG_SET & 64) { const size_t r = i % NTOK, c = (i / NTOK) % 256; v += san(bf2f(((const bf16_t*)(p.ws + O_P))[r * NP + C_CKV + c])); }
        if (DBG_SET & 128) v += san(bf2f(((const bf16_t*)(p.ws + O_KVRAW))[i % ((size_t)NTOK * 1536)]));
        p.out[i] = v;
    }
}
#endif
static int g_grid = 0;
extern "C" void kernel_launch(void* const* d_in, const int* in_sizes, int n_in, void* d_out, int out_size, void* d_ws, size_t ws_size, hipStream_t stream) {
    static int ok = 0;
    if (ok == 0) {
        if (n_in != 31 || in_sizes[0] != NLAT * DM || out_size != NLAT * DM || ws_size < WS_END) { fprintf(stderr, "kernel_launch: unexpected shapes (n_in %d, ws %zu, need %zu)\n", n_in, ws_size, (size_t)WS_END); ok = -1; return; }
        bool good = true;
#if !MEGA
        good = good && prep_phase<0>() && prep_phase<1>() && prep_phase<2>() && prep_phase<3>() && prep_phase<4>() && prep_phase<5>() && prep_phase<6>() && prep_phase<7>() && prep_phase<8>() && prep_phase<9>() && prep_phase<10>() && prep_phase<11>() && prep_phase<12>();
#endif
#if MEGA
        good = hipFuncSetAttribute((const void*)mega_fwd, hipFuncAttributeMaxDynamicSharedMemorySize, LDS_BYTES) == hipSuccess;
        int dev = 0, cus = 0, per_cu = 0;
        if (hipGetDevice(&dev) != hipSuccess || hipDeviceGetAttribute(&cus, hipDeviceAttributeMultiprocessorCount, dev) != hipSuccess) good = false;
        if (good && (hipOccupancyMaxActiveBlocksPerMultiprocessor(&per_cu, (const void*)mega_fwd, NTHREADS, LDS_BYTES) != hipSuccess || per_cu < 1)) { fprintf(stderr, "kernel_launch: occupancy query says %d workgroups per CU\n", per_cu); good = false; }
        g_grid = cus;
#endif
        if (!good) { fprintf(stderr, "kernel_launch: set-up failed\n"); ok = -1; return; }
        ok = 1;
    }
    if (ok < 0) return;
    Params p{}; for (int i = 0; i < 31; ++i) p.in[i] = (const float*)d_in[i]; p.out = (float*)d_out; p.ws = (unsigned char*)d_ws; p.layer = 0; p.pad = 0;
#ifdef POISON_WS
    hipMemsetAsync((char*)d_ws, 0xFF, WS_END, stream);
#endif
    hipMemsetAsync((char*)d_ws + O_CTL, 0, ZERO_BYTES, stream);
#if !MEGA
    g_nlaunch = 0;
    launch_phase<PH_PRO>(p, 0, stream);
    for (int l = 0; l < NLAYER; ++l) {
        if (l == 0) launch_phase<PH_NORM1>(p, l, stream);
        launch_phase<PH_WIN>(p, l, stream); launch_phase<PH_POSTA>(p, l, stream); launch_phase<PH_POSTB>(p, l, stream); launch_phase<PH_MIXER>(p, l, stream);
        launch_phase<PH_HYFIN>(p, l, stream); launch_phase<PH_WOUT>(p, l, stream); launch_phase<PH_ROUTE>(p, l, stream); launch_phase<PH_PLACE>(p, l, stream);
        launch_phase<PH_GEMM1>(p, l, stream); launch_phase<PH_GEMM2>(p, l, stream); launch_phase<PH_FINAL>(p, l, stream);
    }
#if DBG_DUMP
    hipLaunchKernelGGL(k_dump, dim3(2048), dim3(256), 0, stream, p);
#endif
#else
    hipLaunchKernelGGL(mega_fwd, dim3(g_grid), dim3(NTHREADS), LDS_BYTES, stream, p);
#endif
}
```

```cpp
#define GQA_SD 1
#define FAST_GEMM 1
#define MEGA 1
#include <hip/hip_runtime.h>
#include <stdint.h>
#include <stdio.h>

#define LAS __attribute__((address_space(3)))
typedef unsigned short bf16_t;
typedef short bf16x8 __attribute__((ext_vector_type(8)));
typedef short s16x4 __attribute__((ext_vector_type(4)));
typedef float f32x4 __attribute__((ext_vector_type(4)));
typedef float f32x16 __attribute__((ext_vector_type(16)));
typedef unsigned u32x4 __attribute__((ext_vector_type(4)));
typedef unsigned u32x2 __attribute__((ext_vector_type(2)));

constexpr int DM = 2048, NB = 8, SEQ = 2048, CTXL = 256, NLAT = NB * SEQ, NCTX = NB * CTXL, NTOK = NLAT + NCTX, NLAYER = 2;
constexpr int NP = 4096;
constexpr int C_CQ = 1536, C_GQ = 2304, C_CKV = 3072, C_KR = 3328, C_GK = 3392, C_GV = 3648, IN_COLS = 3904;
constexpr int NEXP = 64, TOPK = 6, EH = 512;
constexpr int LK = CTXL + SEQ;
constexpr int RSLOTS = 126976;
constexpr int NSLOTS = RSLOTS + NTOK;
constexpr int MAXTILES = NSLOTS / 256;
constexpr int NQP = 1280;
constexpr float EPS = 1e-6f;
constexpr int NTHREADS = 512;
#ifndef GQA_SD
#define GQA_SD 2
#endif
#ifndef HY_MFMA
#define HY_MFMA 1
#endif

constexpr size_t al256(size_t x) { return (x + 255) & ~(size_t)255; }
constexpr size_t O_CTL = 0;
constexpr size_t CTL_BYTES = 65536;
constexpr size_t O_MOD = O_CTL + CTL_BYTES;
constexpr size_t O_HSS = O_MOD + al256((size_t)NLAYER * 9 * 12288 * 4);
constexpr size_t ZERO_BYTES = O_HSS + al256((size_t)NLAYER * 2 * 2 * 512 * 4);
constexpr size_t O_HF = ZERO_BYTES;
constexpr size_t HF_L0 = (size_t)2 * 2 * 512 * 2048, HF_L1 = (size_t)2 * 2 * 512 * 256, HF_LAYER = HF_L0 + HF_L1;
constexpr size_t O_WIN = O_HF + al256(NLAYER * HF_LAYER * 4);
constexpr size_t O_WOUT = O_WIN + (size_t)NLAYER * NP * DM * 2;
constexpr size_t O_WUQ = O_WOUT + (size_t)NLAYER * DM * DM * 2;
constexpr size_t O_WUKV = O_WUQ + al256((size_t)NLAYER * NQP * 768 * 2);
constexpr size_t O_EGU = O_WUKV + al256((size_t)NLAYER * 1536 * 256 * 2);
constexpr size_t O_ED = O_EGU + (size_t)65 * 1024 * 2048 * 2;
constexpr size_t O_X = O_ED + (size_t)65 * 2048 * 512 * 2;
constexpr size_t O_H = O_X + (size_t)NTOK * DM * 4;
constexpr size_t O_EIDX = O_H + (size_t)NTOK * DM * 2;
constexpr size_t O_GATE = O_EIDX + (size_t)NTOK * 8 * 4;
constexpr size_t O_SLOT = O_GATE + (size_t)NTOK * 8 * 4;
constexpr size_t O_STOK = O_SLOT + (size_t)NTOK * 8 * 4;
constexpr size_t O_HID = O_STOK + al256((size_t)NSLOTS * 4);
constexpr size_t O_A = O_HID + (size_t)NSLOTS * EH * 2;
constexpr size_t O_P = O_A;
constexpr size_t O_QRAW = O_P + (size_t)NTOK * NP * 2;
constexpr size_t O_KVRAW = O_QRAW + (size_t)NTOK * NQP * 2;
constexpr size_t O_QM = O_KVRAW + (size_t)NTOK * 1536 * 2;
constexpr size_t O_QMC = O_QM + (size_t)NB * 6 * SEQ * 192 * 2;
constexpr size_t O_KM = O_QMC + (size_t)NB * 6 * CTXL * 192 * 2;
constexpr size_t O_VM = O_KM + (size_t)NB * 6 * LK * 192 * 2;
constexpr size_t O_QG = O_VM + (size_t)NB * 6 * LK * 128 * 2;
constexpr size_t O_QGC = O_QG + (size_t)NB * 6 * SEQ * 128 * 2;
constexpr size_t O_KG = O_QGC + (size_t)NB * 6 * CTXL * 128 * 2;
constexpr size_t O_VG = O_KG + (size_t)NB * 2 * LK * 128 * 2;
constexpr size_t O_VT = O_VG + (size_t)NB * 2 * LK * 128 * 2;
constexpr size_t O_X1T = O_VT + (size_t)512 * NTOK * 2;
constexpr size_t O_Y2T = O_X1T + (size_t)512 * NTOK * 2;
constexpr size_t O_MIX = O_Y2T + (size_t)512 * NTOK * 2;
constexpr size_t O_OUT = O_MIX + (size_t)NTOK * DM * 2;
constexpr size_t O_AEND = O_OUT + (size_t)NTOK * DM * 2;
constexpr size_t O_DOUT = O_A;
static_assert(O_DOUT + (size_t)NSLOTS * DM * 2 <= O_AEND, "DOUT must fit the mixer scratch region");
constexpr size_t WS_END = O_AEND;

constexpr int CW_BAR = 0;
constexpr int CW_CNT = 4096;
constexpr int CW_CUR = 4096 + 128;
constexpr int CW_Q = 4096 + 256;

constexpr int LDS_BYTES = 148480;
constexpr int LDS_MISC = 147456;
constexpr int LDS_TILES = 131072;

struct Params { const float* in[31]; float* out; unsigned char* ws; int layer; int pad; };

enum { I_X = 0, I_C, I_CTX, I_CCTX, I_ADAW, I_ADAB, I_NORMG, I_WIN, I_WOUT, I_HYCONV, I_HYW1, I_HYB1, I_HYW2, I_HYB2, I_HYW3, I_HYFREQ, I_HYSKIP,
       I_MQN, I_MKVN, I_WUQ, I_WUKV, I_GQN, I_GKN, I_RW, I_RB, I_EG, I_EU, I_EDN, I_SG, I_SU, I_SD };

__device__ __forceinline__ int otid() { int t = threadIdx.x; asm volatile("" : "+v"(t)); return t; }
__device__ __forceinline__ float bf2f(bf16_t v) { return __uint_as_float(((unsigned)v) << 16); }
__device__ __forceinline__ bf16_t f2bf(float f) { unsigned u = __float_as_uint(f); u += 0x7FFFu + ((u >> 16) & 1u); return (bf16_t)(u >> 16); }
__device__ __forceinline__ unsigned pk2(float lo, float hi) { unsigned r; asm volatile("v_cvt_pk_bf16_f32 %0, %1, %2" : "=v"(r) : "v"(lo), "v"(hi)); return r; }
__device__ __forceinline__ float wave_sum(float v) {
#pragma unroll
    for (int o = 32; o >= 1; o >>= 1) v += __shfl_xor(v, o);
    return v;
}
__device__ __forceinline__ float rdlane(float v, int l) { return __int_as_float(__builtin_amdgcn_readlane(__float_as_int(v), l)); }
__device__ __forceinline__ float silu_f(float x) { return x / (1.0f + __expf(-x)); }
__device__ __forceinline__ const float* resid_src(const Params& p, int l, int row) {
    if (l == 0) return row < NLAT ? p.in[I_X] + (size_t)row * DM : p.in[I_CTX] + (size_t)(row - NLAT) * DM;
    return (const float*)(p.ws + O_X) + (size_t)row * DM;
}
__device__ __forceinline__ int row_batch(int row) { return row < NLAT ? row >> 11 : 8; }
#define ROWCOL(j, lane) ((j) * 256 + (lane) * 4)


struct GUnit { int arow0; const bf16_t* B; int orow0, ocol0; };
struct GemmDesc { const bf16_t* A; int lda; const int* ridx; int ldb; int K; };

struct EpiStoreBf16 {
    bf16_t* O; int ldo;
    __device__ __forceinline__ void operator()(const f32x4 (&acc)[2][2][4][2], const GUnit& u, int wr, int wc, int fr, int fq) const {
#pragma unroll
        for (int ai = 0; ai < 2; ++ai)
#pragma unroll
            for (int m = 0; m < 4; ++m) {
                bf16_t* rowp = O + (size_t)(u.orow0 + ai * 128 + wr * 64 + m * 16 + fr) * ldo + u.ocol0 + wc * 32 + 4 * fq;
#pragma unroll
                for (int bj = 0; bj < 2; ++bj)
#pragma unroll
                    for (int n = 0; n < 2; ++n) { const f32x4 v = acc[ai][bj][m][n]; u32x2 w; w.x = pk2(v[0], v[1]); w.y = pk2(v[2], v[3]); *(u32x2*)(rowp + bj * 128 + n * 16) = w; }
            }
    }
};
struct EpiSwiGLU {
    bf16_t* O;
    __device__ __forceinline__ void operator()(const f32x4 (&acc)[2][2][4][2], const GUnit& u, int wr, int wc, int fr, int fq) const {
#pragma unroll
        for (int ai = 0; ai < 2; ++ai)
#pragma unroll
            for (int m = 0; m < 4; ++m) {
                bf16_t* rowp = O + (size_t)(u.orow0 + ai * 128 + wr * 64 + m * 16 + fr) * EH + u.ocol0 + wc * 32 + 4 * fq;
#pragma unroll
                for (int n = 0; n < 2; ++n) { const f32x4 g = acc[ai][0][m][n], up = acc[ai][1][m][n]; float h[4];
#pragma unroll
                    for (int j = 0; j < 4; ++j) h[j] = silu_f(g[j]) * up[j];
                    u32x2 w; w.x = pk2(h[0], h[1]); w.y = pk2(h[2], h[3]); *(u32x2*)(rowp + n * 16) = w; }
            }
    }
};

template <class Epi>
__device__ __forceinline__ void gemm_unit_simple(const GemmDesc& g, const GUnit& u, const Epi& E) {
    int tid = otid();
    const int wid = tid >> 6, lane = tid & 63, wr = wid >> 2, wc = wid & 3, fr = lane & 15, fq = lane >> 4;
    f32x4 acc[2][2][4][2];
#pragma unroll
    for (int a = 0; a < 2; ++a)
#pragma unroll
        for (int b = 0; b < 2; ++b)
#pragma unroll
            for (int m = 0; m < 4; ++m)
#pragma unroll
                for (int n = 0; n < 2; ++n) acc[a][b][m][n] = (f32x4){0.f, 0.f, 0.f, 0.f};
    const bf16_t* ap[2][4]; const bf16_t* bp[2][2];
#pragma unroll
    for (int ai = 0; ai < 2; ++ai)
#pragma unroll
        for (int m = 0; m < 4; ++m) { const int r = u.arow0 + ai * 128 + wr * 64 + m * 16 + fr; int src = g.ridx ? g.ridx[r] : r; if (src < 0) src = 0; ap[ai][m] = g.A + (size_t)src * g.lda + 8 * fq; }
#pragma unroll
    for (int bj = 0; bj < 2; ++bj)
#pragma unroll
        for (int n = 0; n < 2; ++n) bp[bj][n] = u.B + (size_t)(bj * 128 + wc * 32 + n * 16 + fr) * g.ldb + 8 * fq;
    int Kq = g.K; asm volatile("" : "+s"(Kq));
#pragma unroll 1
    for (int k0 = 0; k0 < Kq; k0 += 32) {
        bf16x8 a[2][4], b[2][2];
#pragma unroll
        for (int ai = 0; ai < 2; ++ai)
#pragma unroll
            for (int m = 0; m < 4; ++m) a[ai][m] = *(const bf16x8*)(ap[ai][m] + k0);
#pragma unroll
        for (int bj = 0; bj < 2; ++bj)
#pragma unroll
            for (int n = 0; n < 2; ++n) b[bj][n] = *(const bf16x8*)(bp[bj][n] + k0);
#pragma unroll
        for (int ai = 0; ai < 2; ++ai)
#pragma unroll
            for (int bj = 0; bj < 2; ++bj)
#pragma unroll
                for (int m = 0; m < 4; ++m)
#pragma unroll
                    for (int n = 0; n < 2; ++n) acc[ai][bj][m][n] = __builtin_amdgcn_mfma_f32_16x16x32_bf16(b[bj][n], a[ai][m], acc[ai][bj][m][n], 0, 0, 0);
    }
    E(acc, u, wr, wc, fr, fq);
}

struct DenseSched {
    const bf16_t* Bt; int ldb, nM, nN, row0, pn0;
    __device__ __forceinline__ int count() const { return nM * nN; }
    __device__ __forceinline__ void unit(int i, GUnit& u) const { const int pm = i / nN, pn = pn0 + i % nN; u.arow0 = row0 + pm * 256; u.B = Bt + (size_t)pn * 256 * ldb; u.orow0 = u.arow0; u.ocol0 = pn * 256; }
};
struct MoeSched {
    const LAS int* te; const LAS int* ts; int ntiles, npn; const bf16_t* Bt; size_t estride; int ldb, ocolw;
    __device__ __forceinline__ int count() const { return ntiles * npn; }
    __device__ __forceinline__ void unit(int i, GUnit& u) const { const int t = i / npn, pn = i % npn; const int e = te[t]; u.arow0 = ts[t]; u.B = Bt + (size_t)e * estride + (size_t)pn * 256 * ldb; u.orow0 = u.arow0; u.ocol0 = pn * ocolw; }
};
template <class Sched, class Epi>
__device__ __forceinline__ void gemm_phase_simple(const GemmDesc& g, const Sched& S, const Epi& E) {
    const int n = S.count();
    for (int i = blockIdx.x; i < n; i += gridDim.x) { GUnit u; S.unit(i, u); gemm_unit_simple(g, u, E); }
}
__device__ __forceinline__ int moe_build_tiles(const unsigned* cnt, int nshared, LAS int* te, LAS int* ts, LAS int* misc) {
    __syncthreads();
    if (otid() == 0) {
        int nt = 0, run = 0;
        for (int e = 0; e < NEXP; ++e) { const int c = (int)cnt[e], ntile = (c + 255) >> 8; for (int j = 0; j < ntile; ++j) { te[nt] = e; ts[nt] = run + j * 256; ++nt; } run += ntile * 256; }
        for (int j = 0; j < nshared; ++j) { te[nt] = NEXP; ts[nt] = RSLOTS + j * 256; ++nt; }
        misc[0] = nt;
    }
    __syncthreads();
    return misc[0];
}
#ifndef FAST_GEMM
#define FAST_GEMM 0
#endif
#if !FAST_GEMM
#define GEMM_PHASE(g, S, E) gemm_phase_simple(g, S, E)
#endif

#if FAST_GEMM
constexpr int HTB = 128 * 64 * 2;
__device__ __forceinline__ int lds_byte(int r, int c) { const int st = (r >> 4) * 2 + (c >> 5), rr = r & 15, cc = c & 31, ob = rr * 64 + cc * 2; return st * 1024 + (ob ^ (((ob >> 9) & 1) << 5)); }
__device__ __forceinline__ void stage_rc(int b, int& R, int& C) { const int st = b / 1024, sb = b % 1024, swz = sb ^ (((sb >> 9) & 1) << 5); R = (st >> 1) * 16 + swz / 64; C = (st & 1) * 32 + (swz % 64) / 2; }

template <class Sched, class Epi>
__device__ __forceinline__ void gemm_phase_fast(LAS unsigned char* lds, const GemmDesc& g, const Sched& S, const Epi& E) {
    const int tid = otid(), wid = __builtin_amdgcn_readfirstlane(tid >> 6), lane = tid & 63, wr = wid >> 2, wc = wid & 3, fr = lane & 15, fq = lane >> 4;
    const int K = g.K, nt = K / 64, nunits = S.count(), G = gridDim.x, c0 = blockIdx.x;
    if (c0 >= nunits) return;
    int R[2], C[2]; unsigned voffB[2];
#pragma unroll
    for (int i = 0; i < 2; ++i) { stage_rc(tid * 16 + i * 8192, R[i], C[i]); voffB[i] = (unsigned)(R[i] * g.ldb + C[i]) * 2u; }
    const size_t kstep = 128;
    const size_t hstepB = (size_t)128 * g.ldb * 2;
    const unsigned ldsw = (unsigned)wid * 1024u;
    const int aoff = lds_byte(wr * 64 + fr, fq * 8), boff = lds_byte(wc * 32 + fr, fq * 8);
    const char* Ab = (const char*)g.A;
#define F_SA(b, h) (((b) * 2 + (h)) * HTB)
#define F_SB(b, h) ((4 + (b) * 2 + (h)) * HTB)
#define F_STAGE(bufoff, gbase, voff) do { _Pragma("unroll") for (int _i = 0; _i < 2; ++_i) \
        __builtin_amdgcn_global_load_lds((const unsigned*)((const char*)(gbase) + (voff)[_i]), (LAS unsigned*)(lds + (bufoff) + ldsw + _i * 8192), 16, 0, 0); } while (0)
#define F_LDA(dst, b, h) do { _Pragma("unroll") for (int m = 0; m < 4; ++m) _Pragma("unroll") for (int k = 0; k < 2; ++k) dst[m][k] = *(const LAS bf16x8*)(lds + F_SA(b, h) + aoff + m * 2048 + k * 1024); } while (0)
#define F_LDB(dst, b, h) do { _Pragma("unroll") for (int n = 0; n < 2; ++n) _Pragma("unroll") for (int k = 0; k < 2; ++k) dst[n][k] = *(const LAS bf16x8*)(lds + F_SB(b, h) + boff + n * 2048 + k * 1024); } while (0)
#define F_MMA(ai, bj, At, Bt) do { __builtin_amdgcn_s_setprio(1); _Pragma("unroll") for (int m = 0; m < 4; ++m) _Pragma("unroll") for (int n = 0; n < 2; ++n) _Pragma("unroll") for (int k = 0; k < 2; ++k) \
        acc[ai][bj][m][n] = __builtin_amdgcn_mfma_f32_16x16x32_bf16(Bt[n][k], At[m][k], acc[ai][bj][m][n], 0, 0, 0); __builtin_amdgcn_s_setprio(0); } while (0)
#define F_WAIT_V(n) asm volatile("s_waitcnt vmcnt(" #n ")" ::: "memory")
#define F_WAIT_L(n) asm volatile("s_waitcnt lgkmcnt(" #n ")" ::: "memory")
#define F_BAR __builtin_amdgcn_s_barrier()
#define F_SCHED __builtin_amdgcn_sched_barrier(0)
#define F_AROWS(u, dst) do { _Pragma("unroll") for (int _h = 0; _h < 2; ++_h) _Pragma("unroll") for (int _i = 0; _i < 2; ++_i) { const int _r = (u).arow0 + _h * 128 + R[_i]; int _s = g.ridx ? g.ridx[_r] : _r; if (_s < 0) _s = 0; dst[_h][_i] = _s; } } while (0)
#define F_AOFFS(src, dst) do { _Pragma("unroll") for (int _h = 0; _h < 2; ++_h) _Pragma("unroll") for (int _i = 0; _i < 2; ++_i) dst[_h][_i] = ((unsigned)src[_h][_i] * (unsigned)g.lda + (unsigned)C[_i]) * 2u; } while (0)
    GUnit cur, nxt; int ui = 0;
    S.unit(c0, cur);
    f32x4 acc[2][2][4][2];
#pragma unroll
    for (int a = 0; a < 2; ++a)
#pragma unroll
        for (int b = 0; b < 2; ++b)
#pragma unroll
            for (int m = 0; m < 4; ++m)
#pragma unroll
                for (int n = 0; n < 2; ++n) acc[a][b][m][n] = (f32x4){0.f, 0.f, 0.f, 0.f};
    bf16x8 At[4][2], B0[2][2], B1[2][2];
    unsigned voA[2][2]; int rnx[2][2];
    F_AROWS(cur, rnx); F_AOFFS(rnx, voA);
    const char* cB = (const char*)cur.B;
    F_STAGE(F_SB(0, 0), cB, voffB); F_STAGE(F_SA(0, 0), Ab, voA[0]); F_STAGE(F_SB(0, 1), cB + hstepB, voffB); F_STAGE(F_SA(0, 1), Ab, voA[1]);
    if (wr == 1) F_BAR;
    F_WAIT_V(4); F_BAR;
    F_STAGE(F_SB(1, 0), cB + kstep, voffB); F_STAGE(F_SA(1, 0), Ab + kstep, voA[0]); F_STAGE(F_SB(1, 1), cB + hstepB + kstep, voffB);
    F_WAIT_V(6); F_BAR;
    for (;;) {
        const int Ln = (ui + 1) * G + c0; const bool has_next = Ln < nunits;
        if (has_next) { S.unit(Ln, nxt); F_AROWS(nxt, rnx); }
        const char* nB = has_next ? (const char*)nxt.B : cB;
        for (int t = 0; t < nt; t += 2) {
            const bool last = (t == nt - 2);
            const char* a1 = Ab + (size_t)(t + 1) * kstep;
            const char* a2 = last ? Ab : Ab + (size_t)(t + 2) * kstep; const char* b2 = last ? nB : cB + (size_t)(t + 2) * kstep;
            const char* a3 = a2 + kstep; const char* b3 = b2 + kstep;
            F_LDB(B0, 0, 0); F_SCHED; F_LDA(At, 0, 0); F_STAGE(F_SA(1, 1), a1, voA[1]);
            if (last && has_next) F_AOFFS(rnx, voA);
            F_WAIT_L(8); F_BAR; F_WAIT_L(0); F_MMA(0, 0, At, B0); F_BAR; F_SCHED;
            F_LDB(B1, 0, 1); F_STAGE(F_SB(0, 0), b2, voffB);
            F_BAR; F_WAIT_L(0); F_MMA(0, 1, At, B1); F_BAR;
            F_LDA(At, 0, 1); F_STAGE(F_SA(0, 0), a2, voA[0]);
            F_BAR; F_WAIT_L(0); F_MMA(1, 0, At, B0); F_BAR; F_SCHED;
            F_STAGE(F_SB(0, 1), b2 + hstepB, voffB);
            F_WAIT_V(6); F_BAR; F_MMA(1, 1, At, B1); F_BAR;
            F_LDB(B0, 1, 0); F_SCHED; F_LDA(At, 1, 0); F_STAGE(F_SA(0, 1), a2, voA[1]);
            F_WAIT_L(8); F_BAR; F_WAIT_L(0); F_MMA(0, 0, At, B0); F_BAR; F_SCHED;
            F_LDB(B1, 1, 1); F_STAGE(F_SB(1, 0), b3, voffB);
            F_BAR; F_WAIT_L(0); F_MMA(0, 1, At, B1); F_BAR;
            F_LDA(At, 1, 1); F_STAGE(F_SA(1, 0), a3, voA[0]);
            F_BAR; F_WAIT_L(0); F_MMA(1, 0, At, B0); F_BAR; F_SCHED;
            F_STAGE(F_SB(1, 1), b3 + hstepB, voffB);
            F_WAIT_V(6); F_BAR; F_MMA(1, 1, At, B1); F_BAR;
        }
        E(acc, cur, wr, wc, fr, fq);
        if (!has_next) break;
#pragma unroll
        for (int a = 0; a < 2; ++a)
#pragma unroll
            for (int b = 0; b < 2; ++b)
#pragma unroll
                for (int m = 0; m < 4; ++m)
#pragma unroll
                    for (int n = 0; n < 2; ++n) acc[a][b][m][n] = (f32x4){0.f, 0.f, 0.f, 0.f};
        cur = nxt; cB = nB; ++ui;
    }
    F_WAIT_V(0);
    if (wr == 0) F_BAR;
    F_BAR;
#undef F_SA
#undef F_SB
#undef F_STAGE
#undef F_LDA
#undef F_LDB
#undef F_MMA
#undef F_WAIT_V
#undef F_WAIT_L
#undef F_BAR
#undef F_SCHED
#undef F_AROWS
#undef F_AOFFS
}
#define GEMM_PHASE(g, S, E) gemm_phase_fast(lds, g, S, E)
#endif

#define SBAR() __builtin_amdgcn_sched_barrier(0)
__device__ __forceinline__ int crow(int r, int hi) { return (r & 3) + 8 * (r >> 2) + 4 * hi; }
template <int DQK> __device__ __forceinline__ int kaddr(int row, int chunk) {
    const int sw = (DQK == 128) ? (row & 7) : ((row >> 1) & 7);
    return row * (DQK * 2) + ((chunk ^ sw) << 4);
}
__device__ __forceinline__ void partialSM(f32x16& p0, f32x16& p1, float& m_reg, float& mn, float& alpha, float C, float thr) {
    float pmax = p0[0];
#pragma unroll
    for (int r = 1; r < 16; ++r) pmax = fmaxf(pmax, p0[r]);
#pragma unroll
    for (int r = 0; r < 16; ++r) pmax = fmaxf(pmax, p1[r]);
    { auto rr = __builtin_amdgcn_permlane32_swap(__float_as_uint(pmax), __float_as_uint(pmax), false, false);
      pmax = fmaxf(__uint_as_float(rr[0]), __uint_as_float(rr[1])); }
    if (__builtin_expect(__all(pmax - m_reg <= thr), 1)) { mn = m_reg; alpha = 1.f; }
    else { mn = fmaxf(m_reg, pmax); alpha = __builtin_amdgcn_exp2f((m_reg - mn) * C); m_reg = mn; }
    const float mnC = -mn * C;
#pragma unroll
    for (int r = 0; r < 16; ++r) p0[r] = fmaf(p0[r], C, mnC);
#pragma unroll
    for (int r = 0; r < 16; ++r) p1[r] = fmaf(p1[r], C, mnC);
#pragma unroll
    for (int r = 0; r < 16; ++r) p0[r] = __builtin_amdgcn_exp2f(p0[r]);
}
__device__ __forceinline__ void finishSM(f32x16& p0, f32x16& p1, float alpha, float& l_reg, bf16x8& pa0, bf16x8& pa1, bf16x8& pa2, bf16x8& pa3) {
#pragma unroll
    for (int r = 0; r < 16; ++r) p1[r] = __builtin_amdgcn_exp2f(p1[r]);
    float ps = 0;
#pragma unroll
    for (int r = 0; r < 16; ++r) ps += p0[r];
#pragma unroll
    for (int r = 0; r < 16; ++r) ps += p1[r];
    { auto rr = __builtin_amdgcn_permlane32_swap(__float_as_uint(ps), __float_as_uint(ps), false, false);
      ps = __uint_as_float(rr[0]) + __uint_as_float(rr[1]); }
    l_reg = l_reg * alpha + ps;
#define PK4(P, BASE, OUT) do { unsigned a0 = pk2(P[BASE + 0], P[BASE + 1]), a1 = pk2(P[BASE + 2], P[BASE + 3]);   \
    unsigned b0 = pk2(P[BASE + 4], P[BASE + 5]), b1 = pk2(P[BASE + 6], P[BASE + 7]);                              \
    auto r0 = __builtin_amdgcn_permlane32_swap(a0, b0, false, false); auto r1 = __builtin_amdgcn_permlane32_swap(a1, b1, false, false); \
    u32x4 w = {r0[0], r1[0], r0[1], r1[1]}; OUT = *reinterpret_cast<bf16x8*>(&w); } while (0)
    PK4(p0, 0, pa0); PK4(p0, 8, pa1); PK4(p1, 0, pa2); PK4(p1, 8, pa3);
#undef PK4
}
template <int DQK> __device__ __forceinline__ void qkt(f32x16& p0, f32x16& p1, const char* Ks, const bf16x8* qr, int r32, int hi) {
    p0 = f32x16{}; p1 = f32x16{};
#pragma unroll
    for (int d0 = 0; d0 < DQK / 16; ++d0) { const int ch = 2 * d0 + hi;
        const bf16x8 b0 = *reinterpret_cast<const bf16x8*>(Ks + kaddr<DQK>(r32, ch));
        const bf16x8 b1 = *reinterpret_cast<const bf16x8*>(Ks + kaddr<DQK>(32 + r32, ch));
        p0 = __builtin_amdgcn_mfma_f32_32x32x16_bf16(b0, qr[d0], p0, 0, 0, 0);
        p1 = __builtin_amdgcn_mfma_f32_32x32x16_bf16(b1, qr[d0], p1, 0, 0, 0); }
}
__device__ __forceinline__ int v_st(int k, int c) { const int kk = (k & ~0xC) | ((k & 4) << 1) | ((k & 8) >> 1); return ((kk >> 3) * 4 + (c >> 5)) * 512 + ((kk & 7) * 32 + (c & 31)) * 2; }
__device__ __forceinline__ int v_rd_base(int lane) { return ((lane & 3) << 3) | (((lane >> 2) & 3) << 6) | (((lane >> 4) & 1) << 5) | (((lane >> 5) & 1) << 8); }
constexpr int v_rd_off(int d0, int ks, int half) { return d0 * 512 + ks * 4096 + half * 2048; }
template <int OFF> __device__ __forceinline__ s16x4 tr_read(int vb) {
    s16x4 r; asm volatile("ds_read_b64_tr_b16 %0, %1 offset:%2" : "=&v"(r) : "v"(vb), "i"(OFF) : "memory"); return r;
}
template <int D0> __device__ __forceinline__ void pv_one(f32x16& od, int vb, bf16x8 pa0, bf16x8 pa1, bf16x8 pa2, bf16x8 pa3) {
    const s16x4 l0 = tr_read<v_rd_off(D0, 0, 0)>(vb), h0 = tr_read<v_rd_off(D0, 0, 1)>(vb), l1 = tr_read<v_rd_off(D0, 1, 0)>(vb), h1 = tr_read<v_rd_off(D0, 1, 1)>(vb);
    const s16x4 l2 = tr_read<v_rd_off(D0, 2, 0)>(vb), h2 = tr_read<v_rd_off(D0, 2, 1)>(vb), l3 = tr_read<v_rd_off(D0, 3, 0)>(vb), h3 = tr_read<v_rd_off(D0, 3, 1)>(vb);
    asm volatile("s_waitcnt lgkmcnt(0)" ::: "memory"); SBAR();
#define PK(L, H) (bf16x8){L[0], L[1], L[2], L[3], H[0], H[1], H[2], H[3]}
    od = __builtin_amdgcn_mfma_f32_32x32x16_bf16(pa0, PK(l0, h0), od, 0, 0, 0);
    od = __builtin_amdgcn_mfma_f32_32x32x16_bf16(pa1, PK(l1, h1), od, 0, 0, 0);
    od = __builtin_amdgcn_mfma_f32_32x32x16_bf16(pa2, PK(l2, h2), od, 0, 0, 0);
    od = __builtin_amdgcn_mfma_f32_32x32x16_bf16(pa3, PK(l3, h3), od, 0, 0, 0);
#undef PK
}
__device__ __forceinline__ void pv_d0(f32x16* o, int vb, bf16x8 pa0, bf16x8 pa1, bf16x8 pa2, bf16x8 pa3) {
    pv_one<0>(o[0], vb, pa0, pa1, pa2, pa3); pv_one<1>(o[1], vb, pa0, pa1, pa2, pa3); pv_one<2>(o[2], vb, pa0, pa1, pa2, pa3); pv_one<3>(o[3], vb, pa0, pa1, pa2, pa3);
}

template <int DQK, int SDEPTH>
__device__ __forceinline__ void attn_body(const bf16_t* __restrict__ Qb, const bf16_t* __restrict__ Kh, const bf16_t* __restrict__ Vh, bf16_t* __restrict__ Ob, int ldo, int nkeys, float scale, char* lds) {
    constexpr int SHM_V = 64 * 128 * 2, SHM_K = 64 * DQK * 2, NKC = DQK / 8, KPT = NKC / 8;
    int tid = otid();
    const int wid = tid >> 6, lane = tid & 63, r32 = lane & 31, hi = lane >> 5;
    char* V_lds = lds; char* K_lds = lds + 2 * SHM_V;
    float* ws = (float*)(lds + 2 * SHM_V + 2 * SHM_K) + wid * 64; float* li_l = ws; float* al_l = ws + 32;
    const float C = scale * 1.4426950408889634f, thr = 8.0f / scale;
    float m_reg = -1e30f, l_reg = 0; f32x16 o[4] = {}; bf16x8 qr[DQK / 16];
    const bf16_t* Qw = Qb + (long)(wid * 32 + r32) * DQK + hi * 8;
#pragma unroll
    for (int d0 = 0; d0 < DQK / 16; ++d0) qr[d0] = *reinterpret_cast<const bf16x8*>(Qw + d0 * 16);
    const int sr = tid >> 4, sc = (tid & 15) * 8, vst0 = v_st(sr, sc), vst1 = v_st(32 + sr, sc);
    int kgo[KPT], klo[KPT];
#pragma unroll
    for (int i = 0; i < KPT; ++i) { const int q = tid + 512 * i, row = q / NKC, ch = q % NKC; kgo[i] = row * DQK + ch * 8; klo[i] = kaddr<DQK>(row, ch); }
    const int vb0 = (int)(uintptr_t)V_lds + v_rd_base(lane);
    struct { bf16x8 vs0, vs1, ks[KPT]; } sr_[SDEPTH ? SDEPTH : 1];
#define SLOAD(i, k0) do { sr_[i].vs0 = *reinterpret_cast<const bf16x8*>(&Vh[(long)((k0) + sr) * 128 + sc]); sr_[i].vs1 = *reinterpret_cast<const bf16x8*>(&Vh[(long)((k0) + 32 + sr) * 128 + sc]); \
    _Pragma("unroll") for (int _q = 0; _q < KPT; ++_q) sr_[i].ks[_q] = *reinterpret_cast<const bf16x8*>(&Kh[(long)(k0) * DQK + kgo[_q]]); } while (0)
#define SWRITE(b, i) do { *(bf16x8*)(V_lds + (b) * SHM_V + vst0) = sr_[i].vs0; *(bf16x8*)(V_lds + (b) * SHM_V + vst1) = sr_[i].vs1; \
    _Pragma("unroll") for (int _q = 0; _q < KPT; ++_q) *(bf16x8*)(K_lds + (b) * SHM_K + klo[_q]) = sr_[i].ks[_q]; } while (0)
#define SWAIT() do { if constexpr (SDEPTH == 2) { if constexpr (KPT == 2) asm volatile("s_waitcnt vmcnt(4)" ::: "memory"); else asm volatile("s_waitcnt vmcnt(5)" ::: "memory"); } \
    else asm volatile("s_waitcnt vmcnt(0)" ::: "memory"); } while (0)
#define RESC(a) do { if (__any((a) < 1.f)) { if (hi == 0) al_l[r32] = (a); asm volatile("s_waitcnt lgkmcnt(0)" ::: "memory"); \
    _Pragma("unroll") for (int d = 0; d < 4; ++d) _Pragma("unroll") for (int r = 0; r < 16; ++r) o[d][r] *= al_l[crow(r, hi)]; } } while (0)
    bf16x8 pa0, pa1, pa2, pa3; const int NT = nkeys / 64;
    if constexpr (SDEPTH == 0) {
        f32x16 pA0, pA1; float mnA, alA;
        SLOAD(0, 0); asm volatile("s_waitcnt vmcnt(0)" ::: "memory"); SWRITE(0, 0); __syncthreads();
        for (int j = 0; j < NT; ++j) {
            const int bo = j & 1;
            if (j + 1 < NT) SLOAD(0, (j + 1) * 64);
            SBAR(); qkt<DQK>(pA0, pA1, K_lds + bo * SHM_K, qr, r32, hi); partialSM(pA0, pA1, m_reg, mnA, alA, C, thr);
            RESC(alA); finishSM(pA0, pA1, alA, l_reg, pa0, pa1, pa2, pa3); SBAR();
            pv_d0(o, vb0 + bo * SHM_V, pa0, pa1, pa2, pa3);
            if (j + 1 < NT) { asm volatile("s_waitcnt vmcnt(0)" ::: "memory"); SWRITE(bo ^ 1, 0); }
            __syncthreads();
        }
    } else {
    f32x16 pA0, pA1, pB0, pB1; float mnA, mnB, alA, alB;
    constexpr int SE = 0, SO = SDEPTH - 1;
    SLOAD(SE, 0); asm volatile("s_waitcnt vmcnt(0)" ::: "memory"); SWRITE(0, SE); __syncthreads();
    qkt<DQK>(pA0, pA1, K_lds, qr, r32, hi); partialSM(pA0, pA1, m_reg, mnA, alA, C, thr);
    SLOAD(SO, 64); if constexpr (SDEPTH == 2) { if (2 < NT) SLOAD(SE, 2 * 64); }
    SWAIT(); SWRITE(1, SO); __syncthreads();
    for (int j = 1; j + 1 < NT; j += 2) {
        SBAR(); qkt<DQK>(pB0, pB1, K_lds + SHM_K, qr, r32, hi);
        finishSM(pA0, pA1, alA, l_reg, pa0, pa1, pa2, pa3); SBAR();
        SLOAD(SO, (j + SDEPTH) * 64); SBAR();
        pv_d0(o, vb0, pa0, pa1, pa2, pa3); partialSM(pB0, pB1, m_reg, mnB, alB, C, thr);
        __syncthreads(); SWAIT(); SWRITE(0, SE);
        RESC(alB); __syncthreads();
        SBAR(); qkt<DQK>(pA0, pA1, K_lds, qr, r32, hi);
        finishSM(pB0, pB1, alB, l_reg, pa0, pa1, pa2, pa3); SBAR();
        if (SDEPTH == 1 || j + 3 < NT) SLOAD(SE, (j + 1 + SDEPTH) * 64); SBAR();
        pv_d0(o, vb0 + SHM_V, pa0, pa1, pa2, pa3); partialSM(pA0, pA1, m_reg, mnA, alA, C, thr);
        __syncthreads(); SWAIT(); SWRITE(1, SO);
        RESC(alA); __syncthreads();
    }
    SBAR(); qkt<DQK>(pB0, pB1, K_lds + SHM_K, qr, r32, hi);
    finishSM(pA0, pA1, alA, l_reg, pa0, pa1, pa2, pa3); SBAR();
    pv_d0(o, vb0, pa0, pa1, pa2, pa3); partialSM(pB0, pB1, m_reg, mnB, alB, C, thr);
    __syncthreads(); RESC(alB);
    finishSM(pB0, pB1, alB, l_reg, pa0, pa1, pa2, pa3); SBAR();
    pv_d0(o, vb0 + SHM_V, pa0, pa1, pa2, pa3);
    }
    if (hi == 0) li_l[r32] = l_reg; asm volatile("s_waitcnt lgkmcnt(0)" ::: "memory");
    float rli[16];
#pragma unroll
    for (int r = 0; r < 16; ++r) rli[r] = __builtin_amdgcn_rcpf(li_l[crow(r, hi)]);
    bf16_t* Ow = Ob + (long)(wid * 32) * ldo;
#pragma unroll
    for (int r = 0; r < 16; ++r) { const int orow = crow(r, hi);
#pragma unroll
        for (int d0 = 0; d0 < 4; ++d0) Ow[(long)orow * ldo + d0 * 32 + r32] = f2bf(o[d0][r] * rli[r]); }
    __syncthreads();
#undef SLOAD
#undef SWRITE
#undef SWAIT
#undef RESC
}

struct CvtMat { const float* src; bf16_t* dst; const float* kscale; int N, lddst, nb, mode; };
__device__ __forceinline__ void cvt_block(const CvtMat& m, int kb, int nbk, int lane) {
    const int a = lane & 7, ng = lane >> 3, k0 = kb * 64 + 8 * a, n0 = nbk * 32 + 4 * ng;
    const float* s = m.src + (size_t)k0 * m.N + n0;
    f32x4 v[8];
#pragma unroll
    for (int j = 0; j < 8; ++j) v[j] = *(const f32x4*)(s + (size_t)j * m.N);
    if (m.kscale) {
#pragma unroll
        for (int j = 0; j < 8; ++j) v[j] *= m.kscale[k0 + j];
    }
#pragma unroll
    for (int i = 0; i < 4; ++i) { const int n = n0 + i, row = (m.mode == 0) ? n : ((n >> 7) * 256 + (n & 127) + (m.mode - 1) * 128);
        u32x4 w; w.x = pk2(v[0][i], v[1][i]); w.y = pk2(v[2][i], v[3][i]); w.z = pk2(v[4][i], v[5][i]); w.w = pk2(v[6][i], v[7][i]);
        *(u32x4*)(m.dst + (size_t)row * m.lddst + k0) = w; }
}
constexpr int CVT_SMALL = 3904 + 2048 + 432 + 192;
__device__ __forceinline__ void cvt_small_task(const Params& p, int l, int t, int lane) {
    unsigned char* ws = p.ws; CvtMat m;
    if (t < 3904) { m = CvtMat{p.in[I_WIN] + (size_t)l * DM * IN_COLS, (bf16_t*)(ws + O_WIN) + (size_t)l * NP * DM, nullptr, IN_COLS, DM, 122, 0}; }
    else if ((t -= 3904) < 2048) { m = CvtMat{p.in[I_WOUT] + (size_t)l * DM * DM, (bf16_t*)(ws + O_WOUT) + (size_t)l * DM * DM, nullptr, DM, DM, 64, 0}; }
    else if ((t -= 2048) < 432) { m = CvtMat{p.in[I_WUQ] + (size_t)l * 768 * 1152, (bf16_t*)(ws + O_WUQ) + (size_t)l * NQP * 768, p.in[I_MQN] + l * 768, 1152, 768, 36, 0}; }
    else { t -= 432; m = CvtMat{p.in[I_WUKV] + (size_t)l * 256 * 1536, (bf16_t*)(ws + O_WUKV) + (size_t)l * 1536 * 256, p.in[I_MKVN] + l * 256, 1536, 256, 48, 0}; }
    cvt_block(m, t / m.nb, t % m.nb, lane);
}
constexpr int CVT_EXP = 65 * 1536;
__device__ __forceinline__ void cvt_exp_task(const Params& p, int l, int t, int lane) {
    unsigned char* ws = p.ws;
    const int e = t / 1536, r = t % 1536, which = r >> 9, q = r & 511; CvtMat m;
    if (which < 2) {
        const float* src = (e < NEXP) ? p.in[which == 0 ? I_EG : I_EU] + ((size_t)l * NEXP + e) * DM * EH : p.in[which == 0 ? I_SG : I_SU] + (size_t)l * DM * EH;
        m = CvtMat{src, (bf16_t*)(ws + O_EGU) + (size_t)e * 1024 * 2048, nullptr, EH, DM, 16, 1 + which};
    } else {
        const float* src = (e < NEXP) ? p.in[I_EDN] + ((size_t)l * NEXP + e) * EH * DM : p.in[I_SD] + (size_t)l * EH * DM;
        m = CvtMat{src, (bf16_t*)(ws + O_ED) + (size_t)e * 2048 * 512, nullptr, DM, EH, 64, 0};
    }
    cvt_block(m, q / m.nb, q % m.nb, lane);
}
__device__ __forceinline__ void cvt_exp_all(const Params& p, int l) {
    const int lane = otid() & 63, gw = blockIdx.x * 8 + (otid() >> 6), GW = gridDim.x * 8;
    for (int t = gw; t < CVT_EXP; t += GW) cvt_exp_task(p, l, t, lane);
}
__device__ __forceinline__ void adaln_tasks(const Params& p, LAS float* lf) {
    const int lane = otid() & 63, wid = otid() >> 6;
    float* MOD = (float*)(p.ws + O_MOD);
    for (int task = blockIdx.x; task < 384; task += gridDim.x) {
        const int cb = task % 192, l = task / 192, col = cb * 64 + lane;
        const float* W = p.in[I_ADAW] + (size_t)l * DM * 12288 + col;
        float acc[9];
#pragma unroll
        for (int r = 0; r < 9; ++r) acc[r] = 0.f;
        for (int kb = wid * 256; kb < wid * 256 + 256; kb += 64) {
            float sv[9];
#pragma unroll
            for (int r = 0; r < 8; ++r) sv[r] = silu_f(p.in[I_C][r * DM + kb + lane]);
            sv[8] = silu_f(p.in[I_CCTX][kb + lane]);
#pragma unroll 8
            for (int kk = 0; kk < 64; ++kk) { const float w = W[(size_t)(kb + kk) * 12288];
#pragma unroll
                for (int r = 0; r < 9; ++r) acc[r] += rdlane(sv[r], kk) * w; }
        }
#pragma unroll
        for (int r = 0; r < 9; ++r) lf[(wid * 9 + r) * 64 + lane] = acc[r];
        __syncthreads();
        for (int r = wid; r < 9; r += 8) { float s = p.in[I_ADAB][l * 12288 + col];
#pragma unroll
            for (int w = 0; w < 8; ++w) s += lf[(w * 9 + r) * 64 + lane];
            MOD[(size_t)(l * 9 + r) * 12288 + col] = s; }
        __syncthreads();
    }
}
__device__ __forceinline__ void hss_tasks(const Params& p) {
    const int lane = otid() & 63, gw = blockIdx.x * 8 + (otid() >> 6), GW = gridDim.x * 8;
    for (int task = gw; task < 3 * 1024; task += GW) {
        const int set = task >> 10, l = (set == 1) ? 1 : 0, nset = (set == 2) ? 1 : 0, ord = (task >> 9) & 1, ch = task & 511, n = nset ? 256 : 2048;
        const float* HF = (const float*)(p.ws + O_HF) + (size_t)l * HF_LAYER + (nset ? HF_L0 : 0);
        const float* hf = HF + (size_t)((ord * 2 + 0) * 512 + ch) * n; const float* hb = HF + (size_t)((ord * 2 + 1) * 512 + ch) * n;
        float s = 0.f;
        for (int i = lane; i < n; i += 64) { const float a = hf[i], b = (i == 0) ? 0.f : hb[i]; s += a * a + b * b; }
        s = wave_sum(s);
        if (lane == 0) ((float*)(p.ws + O_HSS))[(size_t)((l * 2 + nset) * 2 + ord) * 512 + ch] = s;
    }
}
__device__ __forceinline__ void hyf_task(const Params& p, int l, int nset, int i0, LAS float* lf) {
    int tid = otid(); const int n = nset ? 256 : 2048;
    LAS float* feats = lf; LAS float* hd1 = lf + 8 * 33; LAS float* hd2 = hd1 + 512;
    if (tid < 8 * 33) { const int pos = tid / 33, f = tid % 33, i = i0 + pos; const float t = (float)i / (float)(n - 1), ang = 6.283185307179586f * (float)i / (float)n; float v;
        if (f == 0) v = t; else { const int j = (f - 1) & 15; const float band = 1e-4f + (float)j * ((15.0f - 1e-4f) / 15.0f); v = (f <= 16) ? cosf(ang * band) : sinf(ang * band); }
        feats[tid] = v; }
    __syncthreads();
    { const int pos = tid >> 6, j = tid & 63; const float* w1 = p.in[I_HYW1] + l * 33 * 64; float s = p.in[I_HYB1][l * 64 + j];
      for (int f = 0; f < 33; ++f) s += feats[pos * 33 + f] * w1[f * 64 + j];
      hd1[tid] = sinf(p.in[I_HYFREQ][l * 64 + j] * s); }
    __syncthreads();
    { const int pos = tid >> 6, j = tid & 63; const float* w2 = p.in[I_HYW2] + l * 64 * 64; float s = p.in[I_HYB2][l * 64 + j];
      for (int f = 0; f < 64; ++f) s += hd1[pos * 64 + f] * w2[f * 64 + j];
      hd2[tid] = sinf(p.in[I_HYFREQ][l * 64 + j] * s); }
    __syncthreads();
    const float* w3 = p.in[I_HYW3] + (size_t)l * 64 * 2048 + tid * 4;
    f32x4 acc[8];
#pragma unroll
    for (int q = 0; q < 8; ++q) acc[q] = (f32x4){0.f, 0.f, 0.f, 0.f};
    for (int j = 0; j < 64; ++j) { const f32x4 w = *(const f32x4*)(w3 + (size_t)j * 2048);
#pragma unroll
        for (int q = 0; q < 8; ++q) acc[q] += w * hd2[q * 64 + j]; }
    float* HF = (float*)(p.ws + O_HF) + (size_t)l * HF_LAYER + (nset ? HF_L0 : 0);
#pragma unroll
    for (int c = 0; c < 4; ++c) { const int col = tid * 4 + c, ord = col >> 10, dir = (col >> 9) & 1, ch = col & 511;
        const float delta = 3.0701134573253944f + (float)ch * ((15.350567286626973f - 3.0701134573253944f) / 511.0f); float v[8];
#pragma unroll
        for (int q = 0; q < 8; ++q) { const int i = i0 + q; const float t = (float)i / (float)(n - 1); v[q] = acc[q][c] * __expf(-t * delta); }
        float* dst = HF + (size_t)((ord * 2 + dir) * 512 + ch) * n + i0;
        *(f32x4*)dst = (f32x4){v[0], v[1], v[2], v[3]}; *(f32x4*)(dst + 4) = (f32x4){v[4], v[5], v[6], v[7]};    }
    __syncthreads();
}
__device__ __forceinline__ void phase_prologue(const Params& p, LAS unsigned char* lds) {
    const int tid = otid(); LAS float* lf = (LAS float*)lds;
    { const size_t gt = (size_t)blockIdx.x * NTHREADS + tid, GT = (size_t)gridDim.x * NTHREADS;
      for (int l = 0; l < NLAYER; ++l) {
          u32x4* z1 = (u32x4*)((bf16_t*)(p.ws + O_WIN) + ((size_t)l * NP + IN_COLS) * DM); const size_t n1 = (size_t)(NP - IN_COLS) * DM * 2 / 16;
          for (size_t i = gt; i < n1; i += GT) z1[i] = (u32x4){0u, 0u, 0u, 0u};
          u32x4* z2 = (u32x4*)((bf16_t*)(p.ws + O_WUQ) + ((size_t)l * NQP + 1152) * 768); const size_t n2 = (size_t)(NQP - 1152) * 768 * 2 / 16;
          for (size_t i = gt; i < n2; i += GT) z2[i] = (u32x4){0u, 0u, 0u, 0u};
      } }
    adaln_tasks(p, lf);
    for (int t = blockIdx.x; t < 544; t += gridDim.x) { if (t < 512) hyf_task(p, t >> 8, 0, (t & 255) * 8, lf); else hyf_task(p, 0, 1, (t - 512) * 8, lf); }
    { const int lane = tid & 63, gw = blockIdx.x * 8 + (tid >> 6), GW = gridDim.x * 8;
      for (int t = gw; t < NLAYER * CVT_SMALL; t += GW) cvt_small_task(p, t / CVT_SMALL, t % CVT_SMALL, lane); }
    cvt_exp_all(p, 0);
}

__device__ __forceinline__ void norm1_row(const Params& p, int l, int row, const float (&x)[32], int lane) {
    float ss = 0.f;
#pragma unroll
    for (int i = 0; i < 32; ++i) ss += x[i] * x[i];
    ss = wave_sum(ss); const float rstd = rsqrtf(ss * (1.0f / DM) + EPS);
    const float* g = p.in[I_NORMG] + (size_t)(l * 4 + 0) * DM; const float* mod = (const float*)(p.ws + O_MOD) + (size_t)(l * 9 + row_batch(row)) * 12288;
    bf16_t* H = (bf16_t*)(p.ws + O_H) + (size_t)row * DM;
#pragma unroll
    for (int j = 0; j < 8; ++j) { const int c = ROWCOL(j, lane); const f32x4 gv = *(const f32x4*)(g + c), sh = *(const f32x4*)(mod + c), sc = *(const f32x4*)(mod + DM + c); float h[4];
#pragma unroll
        for (int q = 0; q < 4; ++q) h[q] = x[j * 4 + q] * rstd * gv[q] * (1.0f + sc[q]) + sh[q];
        u32x2 w; w.x = pk2(h[0], h[1]); w.y = pk2(h[2], h[3]); *(u32x2*)(H + c) = w; }
}
__device__ __forceinline__ void phase_norm1(const Params& p, int l) {
    const int lane = otid() & 63, gw = blockIdx.x * 8 + (otid() >> 6), GW = gridDim.x * 8;
    for (int row = gw; row < NTOK; row += GW) { const float* src = resid_src(p, l, row); float x[32];
#pragma unroll
        for (int j = 0; j < 8; ++j) { const f32x4 v = *(const f32x4*)(src + ROWCOL(j, lane)); x[j * 4] = v[0]; x[j * 4 + 1] = v[1]; x[j * 4 + 2] = v[2]; x[j * 4 + 3] = v[3]; }
        norm1_row(p, l, row, x, lane); }
}

template <int HALF> __device__ __forceinline__ float rope1(float x, int e, float a) {
    float s, c; sincosf(a, &s, &c); const float pr = __shfl_xor(x, HALF);
    return (e & HALF) ? pr * s + x * c : x * c - pr * s;
}
__device__ __forceinline__ void gqa_post_row(const Params& p, int l, int row, int lane) {
    const bf16_t* P = (const bf16_t*)(p.ws + O_P) + (size_t)row * NP;
    const bool isctx = row >= NLAT; const int b = isctx ? (row - NLAT) >> 8 : row >> 11, t = isctx ? (row - NLAT) & 255 : row & 2047;
    const float inv = exp2f(-(float)(lane & 31) * (13.287712379549449f / 32.0f));
    const float a0 = (float)(t >> 6) * inv, a1 = (float)(t & 63) * inv;
    const float* qn = p.in[I_GQN] + l * 128; const float* kn = p.in[I_GKN] + l * 128;
    for (int h = 0; h < 6; ++h) {
        float x0 = bf2f(P[C_GQ + h * 128 + lane]), x1 = bf2f(P[C_GQ + h * 128 + 64 + lane]);
        const float rstd = rsqrtf(wave_sum(x0 * x0 + x1 * x1) * (1.0f / 128.0f) + EPS);
        x0 *= rstd * qn[lane]; x1 *= rstd * qn[64 + lane];
        if (!isctx) { x0 = rope1<32>(x0, lane, a0); x1 = rope1<32>(x1, lane, a1); }
        bf16_t* dst = isctx ? (bf16_t*)(p.ws + O_QGC) + ((size_t)(b * 6 + h) * CTXL + t) * 128 : (bf16_t*)(p.ws + O_QG) + ((size_t)(b * 6 + h) * SEQ + t) * 128;
        dst[lane] = f2bf(x0); dst[64 + lane] = f2bf(x1);
    }
    const int kpos = isctx ? t : CTXL + t;
    for (int h = 0; h < 2; ++h) {
        float x0 = bf2f(P[C_GK + h * 128 + lane]), x1 = bf2f(P[C_GK + h * 128 + 64 + lane]);
        const float rstd = rsqrtf(wave_sum(x0 * x0 + x1 * x1) * (1.0f / 128.0f) + EPS);
        x0 *= rstd * kn[lane]; x1 *= rstd * kn[64 + lane];
        if (!isctx) { x0 = rope1<32>(x0, lane, a0); x1 = rope1<32>(x1, lane, a1); }
        bf16_t* kd = (bf16_t*)(p.ws + O_KG) + ((size_t)(b * 2 + h) * LK + kpos) * 128; kd[lane] = f2bf(x0); kd[64 + lane] = f2bf(x1);
        bf16_t* vd = (bf16_t*)(p.ws + O_VG) + ((size_t)(b * 2 + h) * LK + kpos) * 128; vd[lane] = P[C_GV + h * 128 + lane]; vd[64 + lane] = P[C_GV + h * 128 + 64 + lane];
    }
}
__device__ __forceinline__ void seq_of(int row, int& s0, int& n) { if (row < NLAT) { s0 = row & ~2047; n = SEQ; } else { s0 = NLAT + ((row - NLAT) & ~255); n = CTXL; } }
__device__ __forceinline__ void load_conv_tile(const bf16_t* P, int t0, int pc0, LAS float* u) {
    int s0, n; seq_of(t0, s0, n);
    for (int i = otid(); i < 66 * 64; i += NTHREADS) { const int r = i >> 6, c = i & 63, row = t0 - 1 + r;
        u[r * 65 + c] = (row >= s0 && row < s0 + n) ? bf2f(P[(size_t)row * NP + pc0 + c]) : 0.f; }
}
__device__ __forceinline__ void hy_prep_task(const Params& p, int l, int t0, int c0, LAS float* u) {
    const bf16_t* P = (const bf16_t*)(p.ws + O_P);
    load_conv_tile(P, t0, c0, u);
    __syncthreads();
    const int tid = otid(), c = tid >> 3, tc = (tid & 7) * 8; const float* cw = p.in[I_HYCONV] + (size_t)l * 3 * 1536 + c0 + c;
    const float w0 = cw[0], w1 = cw[1536], w2 = cw[3072]; float y[8];
#pragma unroll
    for (int j = 0; j < 8; ++j) y[j] = w0 * u[(tc + j) * 65 + c] + w1 * u[(tc + j + 1) * 65 + c] + w2 * u[(tc + j + 2) * 65 + c];
    const int ch = c0 + c; bf16_t* dst = (ch < 512 ? (bf16_t*)(p.ws + O_VT) + (size_t)ch * NTOK : (bf16_t*)(p.ws + O_X1T) + (size_t)(ch - 512) * NTOK) + t0 + tc;
    u32x4 w; w.x = pk2(y[0], y[1]); w.y = pk2(y[2], y[3]); w.z = pk2(y[4], y[5]); w.w = pk2(y[6], y[7]); *(u32x4*)dst = w;
    __syncthreads();
}
__device__ __forceinline__ void mla_post_row(const Params& p, int l, int row, int lane) {
    const bf16_t* P = (const bf16_t*)(p.ws + O_P) + (size_t)row * NP;
    const bool isctx = row >= NLAT; const int b = isctx ? (row - NLAT) >> 8 : row >> 11, t = isctx ? (row - NLAT) & 255 : row & 2047;
    float sq = 0.f, skv = 0.f;
#pragma unroll
    for (int j = 0; j < 12; ++j) { const float v = bf2f(P[C_CQ + j * 64 + lane]); sq += v * v; }
#pragma unroll
    for (int j = 0; j < 4; ++j) { const float v = bf2f(P[C_CKV + j * 64 + lane]); skv += v * v; }
    const float rq = rsqrtf(wave_sum(sq) * (1.0f / 768.0f) + EPS), rkv = rsqrtf(wave_sum(skv) * (1.0f / 256.0f) + EPS);
    const int half = lane >> 5, e = lane & 31;
    const float inv = exp2f(-(float)(e & 15) * (13.287712379549449f / 16.0f));
    const float ang = (float)(half ? (t & 63) : (t >> 6)) * inv;
    const bf16_t* QR = (const bf16_t*)(p.ws + O_QRAW) + (size_t)row * NQP; const bf16_t* KV = (const bf16_t*)(p.ws + O_KVRAW) + (size_t)row * 1536;
    float kr = bf2f(P[C_KR + lane]); if (!isctx) kr = rope1<16>(kr, e, ang);
    const bf16_t krb = f2bf(kr); const int kpos = isctx ? t : CTXL + t;
    for (int h = 0; h < 6; ++h) {
        bf16_t* qd = isctx ? (bf16_t*)(p.ws + O_QMC) + ((size_t)(b * 6 + h) * CTXL + t) * 192 : (bf16_t*)(p.ws + O_QM) + ((size_t)(b * 6 + h) * SEQ + t) * 192;
        qd[lane] = f2bf(bf2f(QR[h * 192 + lane]) * rq); qd[64 + lane] = f2bf(bf2f(QR[h * 192 + 64 + lane]) * rq);
        float qr = bf2f(QR[h * 192 + 128 + lane]) * rq; if (!isctx) qr = rope1<16>(qr, e, ang);
        qd[128 + lane] = f2bf(qr);
        bf16_t* kd = (bf16_t*)(p.ws + O_KM) + ((size_t)(b * 6 + h) * LK + kpos) * 192;
        kd[lane] = f2bf(bf2f(KV[h * 256 + lane]) * rkv); kd[64 + lane] = f2bf(bf2f(KV[h * 256 + 64 + lane]) * rkv); kd[128 + lane] = krb;
        bf16_t* vd = (bf16_t*)(p.ws + O_VM) + ((size_t)(b * 6 + h) * LK + kpos) * 128;
        vd[lane] = f2bf(bf2f(KV[h * 256 + 128 + lane]) * rkv); vd[64 + lane] = f2bf(bf2f(KV[h * 256 + 192 + lane]) * rkv);
    }
}

__device__ __forceinline__ void hyconv_unit_valu(const Params& p, int l, int nset, int c, LAS float* lf) {
    const int tid = otid(), n = nset ? CTXL : SEQ, tokbase = nset ? NLAT : 0;
    LAS float* kc = lf; LAS float* z = lf + 4096; LAS float* z2 = z + 8 * SEQ;
    const float* HF = (const float*)(p.ws + O_HF) + (size_t)l * HF_LAYER + (nset ? HF_L0 : 0); const float* HSS = (const float*)(p.ws + O_HSS) + (size_t)((l * 2 + nset) * 2) * 512;
    const bf16_t* VT = (const bf16_t*)(p.ws + O_VT) + (size_t)c * NTOK + tokbase; const bf16_t* X1T = (const bf16_t*)(p.ws + O_X1T) + (size_t)c * NTOK + tokbase;
    bf16_t* Y2T = (bf16_t*)(p.ws + O_Y2T) + (size_t)c * NTOK + tokbase;
    for (int i = tid; i < 8 * n; i += NTHREADS) z[i] = bf2f(VT[i]);
    for (int ord = 0; ord < 2; ++ord) {
        const float rs = rsqrtf(HSS[ord * 512 + c] + EPS); const float* hf = HF + (size_t)((ord * 2 + 0) * 512 + c) * n; const float* hb = HF + (size_t)((ord * 2 + 1) * 512 + c) * n;
        for (int m = tid; m < 2 * n; m += NTHREADS) { const int lag = m - (n - 1); kc[m] = (m == 2 * n - 1) ? 0.f : (lag >= 0 ? hf[lag] : hb[-lag]) * rs; }
        __syncthreads();
        const LAS float* zs = ord ? z2 : z; const float skip = p.in[I_HYSKIP][(size_t)(l * 2 + ord) * 512 + c];
        for (int q = tid; q < n; q += NTHREADS) {
            const int b = q / (n >> 3), t0 = (q % (n >> 3)) * 8; float acc[8];
#pragma unroll
            for (int j = 0; j < 8; ++j) acc[j] = 0.f;
            const LAS float* zb = zs + b * n;
            for (int sb = 0; sb < n; sb += 8) {
                const LAS float* kb = kc + (t0 - sb + n - 8); float w[16];
#pragma unroll
                for (int i = 0; i < 4; ++i) { const f32x4 v = *(const LAS f32x4*)(kb + 4 * i); w[4 * i] = v[0]; w[4 * i + 1] = v[1]; w[4 * i + 2] = v[2]; w[4 * i + 3] = v[3]; }
                const f32x4 za = *(const LAS f32x4*)(zb + sb), zc = *(const LAS f32x4*)(zb + sb + 4); const float zv[8] = {za[0], za[1], za[2], za[3], zc[0], zc[1], zc[2], zc[3]};
#pragma unroll
                for (int ss = 0; ss < 8; ++ss)
#pragma unroll
                    for (int j = 0; j < 8; ++j) acc[j] += w[j - ss + 7] * zv[ss];
            }
            if (ord == 0) {
#pragma unroll
                for (int j = 0; j < 8; ++j) { const int idx = b * n + t0 + j; z2[idx] = bf2f(X1T[idx]) * (acc[j] + skip * z[idx]); }
            } else { float y[8];
#pragma unroll
                for (int j = 0; j < 8; ++j) y[j] = acc[j] + skip * z2[b * n + t0 + j];
                u32x4 w; w.x = pk2(y[0], y[1]); w.y = pk2(y[2], y[3]); w.z = pk2(y[4], y[5]); w.w = pk2(y[6], y[7]); *(u32x4*)(Y2T + b * n + t0) = w; }
        }
        __syncthreads();
    }
}
constexpr int HC_COPYB = 8256, HC_ROWB = 4560, HC_PAD = 112, HC_KR = 4112, HC_M0 = 2064;
constexpr int HC_ZOFF = 8 * HC_COPYB, HC_Z2OFF = HC_ZOFF + 8 * HC_ROWB;
__device__ __forceinline__ void hyconv_unit_mfma(const Params& p, int l, int c, LAS unsigned char* lds) {
    const int tid = otid(), wid = tid >> 6, lane = tid & 63;
    LAS unsigned char* CP = lds; LAS unsigned char* Zr = lds + HC_ZOFF; LAS unsigned char* Z2r = lds + HC_Z2OFF;
    const float* HF = (const float*)(p.ws + O_HF) + (size_t)l * HF_LAYER; const float* HSS = (const float*)(p.ws + O_HSS) + (size_t)(l * 4) * 512;
    const bf16_t* VT = (const bf16_t*)(p.ws + O_VT) + (size_t)c * NTOK; const bf16_t* X1T = (const bf16_t*)(p.ws + O_X1T) + (size_t)c * NTOK; bf16_t* Y2T = (bf16_t*)(p.ws + O_Y2T) + (size_t)c * NTOK;
    for (int q = tid; q < 8 * 256; q += NTHREADS) { const int b = q >> 8, ch = q & 255; *(LAS u32x4*)(Zr + b * HC_ROWB + (HC_PAD + ch * 8) * 2) = *(const u32x4*)(VT + b * SEQ + ch * 8); }
    for (int q = tid; q < 8 * 29; q += NTHREADS) { const int b = q / 29, ch = q % 29; const int e0 = ch < 14 ? ch * 8 : HC_PAD + SEQ + (ch - 14) * 8; *(LAS u32x4*)(Zr + b * HC_ROWB + e0 * 2) = (u32x4){0u, 0u, 0u, 0u}; }
    const int a = lane & 31, kg = lane >> 5, bq = a >> 2, isub = a & 3;
    const int Aoff = (a & 7) * HC_COPYB + (HC_M0 - 8 * (a >> 3) + 8 * kg) * 2;
    const int g0 = 2 * wid;
    const int Boff = bq * HC_ROWB + (HC_PAD + 128 * g0 + 32 * isub + 8 * kg) * 2;
    for (int ord = 0; ord < 2; ++ord) {
        LAS float* kr = (LAS float*)(ord == 0 ? Z2r : Zr);
        { const float rs = rsqrtf(HSS[ord * 512 + c] + EPS); const float* hf = HF + (size_t)((ord * 2 + 0) * 512 + c) * SEQ; const float* hb = HF + (size_t)((ord * 2 + 1) * 512 + c) * SEQ;
          for (int m = tid; m < HC_KR; m += NTHREADS) { const int lag = HC_M0 - m; float v = 0.f; if (lag >= 0 && lag < SEQ) v = hf[lag] * rs; else if (lag < 0 && lag > -SEQ) v = hb[-lag] * rs; kr[m] = v; } }
        __syncthreads();
        for (int q = tid; q < 8 * 516; q += NTHREADS) { const int sft = q / 516, ch = q % 516; float v[8];
#pragma unroll
            for (int j = 0; j < 8; ++j) { const int m = ch * 8 + j - sft; v[j] = (m >= 0 && m < HC_KR) ? kr[m] : 0.f; }
            u32x4 w; w.x = pk2(v[0], v[1]); w.y = pk2(v[2], v[3]); w.z = pk2(v[4], v[5]); w.w = pk2(v[6], v[7]); *(LAS u32x4*)(CP + sft * HC_COPYB + ch * 16) = w; }
        __syncthreads();
        if (ord == 0) for (int q = tid; q < 8 * 29; q += NTHREADS) { const int b = q / 29, ch = q % 29; const int e0 = ch < 14 ? ch * 8 : HC_PAD + SEQ + (ch - 14) * 8; *(LAS u32x4*)(Z2r + b * HC_ROWB + e0 * 2) = (u32x4){0u, 0u, 0u, 0u}; }
        const LAS unsigned char* Zs = ord ? Z2r : Zr;
        f32x16 acc0 = {}, acc1 = {};
        const int e_lo = 16 * wid - 127, e_mid0 = 16 * wid - 119, e_mid1 = 16 * wid + 7, e_hi = 16 * wid + 15;
        for (int e = e_lo; e < e_mid0; ++e) { const bf16x8 A = *(const LAS bf16x8*)(CP + Aoff - 32 * e); const bf16x8 B0 = *(const LAS bf16x8*)(Zs + Boff - 32 * e);
            acc0 = __builtin_amdgcn_mfma_f32_32x32x16_bf16(A, B0, acc0, 0, 0, 0); }
#pragma unroll 2
        for (int e = e_mid0; e <= e_mid1; ++e) { const bf16x8 A = *(const LAS bf16x8*)(CP + Aoff - 32 * e); const bf16x8 B0 = *(const LAS bf16x8*)(Zs + Boff - 32 * e); const bf16x8 B1 = *(const LAS bf16x8*)(Zs + Boff + 256 - 32 * e);
            acc0 = __builtin_amdgcn_mfma_f32_32x32x16_bf16(A, B0, acc0, 0, 0, 0); acc1 = __builtin_amdgcn_mfma_f32_32x32x16_bf16(A, B1, acc1, 0, 0, 0); }
        for (int e = e_mid1 + 1; e <= e_hi; ++e) { const bf16x8 A = *(const LAS bf16x8*)(CP + Aoff - 32 * e); const bf16x8 B1 = *(const LAS bf16x8*)(Zs + Boff + 256 - 32 * e);
            acc1 = __builtin_amdgcn_mfma_f32_32x32x16_bf16(A, B1, acc1, 0, 0, 0); }
        const float skip = p.in[I_HYSKIP][(size_t)(l * 2 + ord) * 512 + c];
#pragma unroll
        for (int gi = 0; gi < 2; ++gi) {
#pragma unroll
            for (int q = 0; q < 4; ++q) { const int t = 128 * (g0 + gi) + 32 * isub + 8 * q + 4 * kg; float y[4];
#pragma unroll
                for (int j = 0; j < 4; ++j) y[j] = gi ? acc1[4 * q + j] : acc0[4 * q + j];
                const u32x2 zz = *(const LAS u32x2*)(Zs + bq * HC_ROWB + (HC_PAD + t) * 2);
                const float z0 = __uint_as_float(zz.x << 16), z1 = __uint_as_float(zz.x & 0xffff0000u), z2 = __uint_as_float(zz.y << 16), z3 = __uint_as_float(zz.y & 0xffff0000u);
                y[0] += skip * z0; y[1] += skip * z1; y[2] += skip * z2; y[3] += skip * z3;
                if (ord == 0) { const u32x2 xx = *(const u32x2*)(X1T + bq * SEQ + t);
                    y[0] *= __uint_as_float(xx.x << 16); y[1] *= __uint_as_float(xx.x & 0xffff0000u); y[2] *= __uint_as_float(xx.y << 16); y[3] *= __uint_as_float(xx.y & 0xffff0000u);
                    u32x2 w; w.x = pk2(y[0], y[1]); w.y = pk2(y[2], y[3]); *(LAS u32x2*)(Z2r + bq * HC_ROWB + (HC_PAD + t) * 2) = w; }
                else { u32x2 w; w.x = pk2(y[0], y[1]); w.y = pk2(y[2], y[3]); *(u32x2*)(Y2T + bq * SEQ + t) = w; } }
        }
        __syncthreads();
    }
}
__device__ __forceinline__ void hy_fin_task(const Params& p, int l, int t0, int c0, LAS float* u) {
    const bf16_t* P = (const bf16_t*)(p.ws + O_P); LAS float* y = u + 66 * 65;
    load_conv_tile(P, t0, 1024 + c0, u);
    const int tid = otid();
    { const int c = tid >> 3, tc = (tid & 7) * 8; const u32x4 v = *(const u32x4*)((const bf16_t*)(p.ws + O_Y2T) + (size_t)(c0 + c) * NTOK + t0 + tc);
#pragma unroll
      for (int j = 0; j < 4; ++j) { y[c * 65 + tc + 2 * j] = __uint_as_float(v[j] << 16); y[c * 65 + tc + 2 * j + 1] = __uint_as_float(v[j] & 0xffff0000u); } }
    __syncthreads();
    { const int t = tid >> 3, cc = (tid & 7) * 8; const float* cw = p.in[I_HYCONV] + (size_t)l * 3 * 1536 + 1024 + c0 + cc; float o[8];
#pragma unroll
      for (int j = 0; j < 8; ++j) { const int c = cc + j; const float x2 = cw[j] * u[t * 65 + c] + cw[1536 + j] * u[(t + 1) * 65 + c] + cw[3072 + j] * u[(t + 2) * 65 + c]; o[j] = x2 * y[c * 65 + t]; }
      u32x4 w; w.x = pk2(o[0], o[1]); w.y = pk2(o[2], o[3]); w.z = pk2(o[4], o[5]); w.w = pk2(o[6], o[7]);
      *(u32x4*)((bf16_t*)(p.ws + O_MIX) + (size_t)(t0 + t) * DM + c0 + cc) = w; }
    __syncthreads();
}

__device__ __forceinline__ void mla_unit(const Params& p, int b, int h, int qb, bool ctxq, LAS unsigned char* lds) {
    unsigned char* ws = p.ws;
    const bf16_t* Q = ctxq ? (const bf16_t*)(ws + O_QMC) + (size_t)(b * 6 + h) * CTXL * 192 : (const bf16_t*)(ws + O_QM) + ((size_t)(b * 6 + h) * SEQ + qb * 256) * 192;
    bf16_t* O = (bf16_t*)(ws + O_MIX) + (size_t)(ctxq ? NLAT + b * CTXL : b * SEQ + qb * 256) * DM + 512 + h * 128;
    attn_body<192, 0>(Q, (const bf16_t*)(ws + O_KM) + (size_t)(b * 6 + h) * LK * 192, (const bf16_t*)(ws + O_VM) + (size_t)(b * 6 + h) * LK * 128, O, DM, ctxq ? CTXL : LK, 0.07216878364870322f, (char*)lds);
}
__device__ __forceinline__ void gqa_unit(const Params& p, int b, int h, int qb, bool ctxq, LAS unsigned char* lds) {
    unsigned char* ws = p.ws;
    const bf16_t* Q = ctxq ? (const bf16_t*)(ws + O_QGC) + (size_t)(b * 6 + h) * CTXL * 128 : (const bf16_t*)(ws + O_QG) + ((size_t)(b * 6 + h) * SEQ + qb * 256) * 128;
    bf16_t* O = (bf16_t*)(ws + O_MIX) + (size_t)(ctxq ? NLAT + b * CTXL : b * SEQ + qb * 256) * DM + 1280 + h * 128;
    attn_body<128, GQA_SD>(Q, (const bf16_t*)(ws + O_KG) + (size_t)(b * 2 + h / 3) * LK * 128, (const bf16_t*)(ws + O_VG) + (size_t)(b * 2 + h / 3) * LK * 128, O, DM, ctxq ? CTXL : LK, 0.08838834764831845f, (char*)lds);
}
__device__ __forceinline__ void phase_mixer(const Params& p, int l, LAS unsigned char* lds) {
    const int G = gridDim.x, bid = blockIdx.x; const bool last = (l == NLAYER - 1);
    for (int u = bid; u < 384 + (last ? 0 : 48); u += G) { if (u < 384) mla_unit(p, u / 48, (u >> 3) % 6, u & 7, false, lds); else mla_unit(p, (u - 384) / 6, (u - 384) % 6, 0, true, lds); }
    for (int u = (bid + G / 2) % G; u < 384 + (last ? 0 : 48); u += G) { if (u < 384) gqa_unit(p, u / 48, (u >> 3) % 6, u & 7, false, lds); else gqa_unit(p, (u - 384) / 6, (u - 384) % 6, 0, true, lds); }
#ifndef CONV_REP
#define CONV_REP 1
#endif
    for (int rep = 0; rep < CONV_REP; ++rep) {
#if HY_MFMA
    for (int u = bid; u < 512; u += G) hyconv_unit_mfma(p, l, u, lds);
    if (!last) for (int u = bid; u < 512; u += G) hyconv_unit_valu(p, l, 1, u, (LAS float*)lds);
#else
    for (int u = bid; u < (last ? 512 : 1024); u += G) hyconv_unit_valu(p, l, u >> 9, u & 511, (LAS float*)lds);
#endif
    }
}

__device__ __forceinline__ void phase_route(const Params& p, int l, LAS unsigned char* lds) {
    const int tid = otid(), wid = tid >> 6, lane = tid & 63; const bool last = (l == NLAYER - 1); const int NR = last ? NLAT : NTOK;
    LAS float* frow = (LAS float*)lds; LAS float* part = frow + 8 * DM;
    const float* g1 = p.in[I_NORMG] + (size_t)(l * 4 + 1) * DM; const float* g2 = p.in[I_NORMG] + (size_t)(l * 4 + 2) * DM;
    const float* RW = p.in[I_RW] + (size_t)l * DM * NEXP; unsigned* cnt = (unsigned*)(p.ws + O_CTL) + CW_CNT + l * 64;
    { int* stok = (int*)(p.ws + O_STOK); for (int i = blockIdx.x * NTHREADS + tid; i < NSLOTS; i += gridDim.x * NTHREADS) stok[i] = (i < RSLOTS) ? -1 : ((i - RSLOTS) < NR ? i - RSLOTS : -1); }
    for (int g = blockIdx.x; g < NR / 8; g += gridDim.x) {
        const int row = g * 8 + wid; const float* mod = (const float*)(p.ws + O_MOD) + (size_t)(l * 9 + row_batch(row)) * 12288;
        { const bf16_t* O = (const bf16_t*)(p.ws + O_OUT) + (size_t)row * DM; const float* rs = resid_src(p, l, row); float* X = (float*)(p.ws + O_X) + (size_t)row * DM; bf16_t* H = (bf16_t*)(p.ws + O_H) + (size_t)row * DM;
          float o[32], x[32]; float ss = 0.f;
#pragma unroll
          for (int j = 0; j < 8; ++j) { const u32x2 v = *(const u32x2*)(O + ROWCOL(j, lane)); o[j * 4] = __uint_as_float(v.x << 16); o[j * 4 + 1] = __uint_as_float(v.x & 0xffff0000u); o[j * 4 + 2] = __uint_as_float(v.y << 16); o[j * 4 + 3] = __uint_as_float(v.y & 0xffff0000u); }
#pragma unroll
          for (int i = 0; i < 32; ++i) ss += o[i] * o[i];
          const float r1 = rsqrtf(wave_sum(ss) * (1.0f / DM) + EPS); float s2 = 0.f;
#pragma unroll
          for (int j = 0; j < 8; ++j) { const int c = ROWCOL(j, lane); const f32x4 xv = *(const f32x4*)(rs + c), gv = *(const f32x4*)(g1 + c), ga = *(const f32x4*)(mod + 2 * DM + c); f32x4 xn;
#pragma unroll
              for (int q = 0; q < 4; ++q) { xn[q] = xv[q] + ga[q] * (o[j * 4 + q] * r1 * gv[q]); x[j * 4 + q] = xn[q]; s2 += xn[q] * xn[q]; }
              *(f32x4*)(X + c) = xn; }
          const float r2 = rsqrtf(wave_sum(s2) * (1.0f / DM) + EPS);
#pragma unroll
          for (int j = 0; j < 8; ++j) { const int c = ROWCOL(j, lane); const f32x4 gv = *(const f32x4*)(g2 + c), sh = *(const f32x4*)(mod + 3 * DM + c), sc = *(const f32x4*)(mod + 4 * DM + c); f32x4 f;
#pragma unroll
              for (int q = 0; q < 4; ++q) f[q] = x[j * 4 + q] * r2 * gv[q] * (1.0f + sc[q]) + sh[q];
              u32x2 w; w.x = pk2(f[0], f[1]); w.y = pk2(f[2], f[3]); *(u32x2*)(H + c) = w; *(LAS f32x4*)(frow + wid * DM + c) = f; } }
        __syncthreads();
        { float acc[8];
#pragma unroll
          for (int r = 0; r < 8; ++r) acc[r] = 0.f;
          for (int k = wid * 256; k < wid * 256 + 256; k += 4) { const float w0 = RW[(size_t)k * 64 + lane], w1 = RW[(size_t)(k + 1) * 64 + lane], w2 = RW[(size_t)(k + 2) * 64 + lane], w3 = RW[(size_t)(k + 3) * 64 + lane];
#pragma unroll
              for (int r = 0; r < 8; ++r) { const f32x4 fv = *(const LAS f32x4*)(frow + r * DM + k); acc[r] += fv[0] * w0 + fv[1] * w1 + fv[2] * w2 + fv[3] * w3; } }
#pragma unroll
          for (int r = 0; r < 8; ++r) part[(wid * 8 + r) * 64 + lane] = acc[r]; }
        __syncthreads();
        { float logit = 0.f;
#pragma unroll
          for (int w = 0; w < 8; ++w) logit += part[(w * 8 + wid) * 64 + lane];
          const float score = 1.0f / (1.0f + expf(-logit)), biased = score + p.in[I_RB][l * 64 + lane];
          float m1 = biased; m1 = fmaxf(m1, __shfl_xor(m1, 1)); m1 = fmaxf(m1, __shfl_xor(m1, 2)); m1 = fmaxf(m1, __shfl_xor(m1, 4));
          const unsigned long long bal = __ballot(biased == m1); const int first = __builtin_ctz((unsigned)((bal >> (lane & ~7)) & 0xffull));
          float m2 = ((lane & 7) == first) ? -INFINITY : biased; m2 = fmaxf(m2, __shfl_xor(m2, 1)); m2 = fmaxf(m2, __shfl_xor(m2, 2)); m2 = fmaxf(m2, __shfl_xor(m2, 4));
          const float gs = m1 + m2; const int grp = lane >> 3; int rank = 0;
#pragma unroll
          for (int q = 0; q < 8; ++q) { const float v = rdlane(gs, q * 8); rank += (v > gs || (v == gs && q < grp)) ? 1 : 0; }
          const float cand = (rank < 4) ? biased : -INFINITY; int re = 0;
          for (int q = 0; q < 64; ++q) { const float v = rdlane(cand, q); re += (v > cand || (v == cand && q < lane)) ? 1 : 0; }
          const bool sel = re < TOPK; const float ssum = wave_sum(sel ? score : 0.f);
          if (sel) { ((int*)(p.ws + O_EIDX))[(size_t)row * 8 + re] = lane; ((float*)(p.ws + O_GATE))[(size_t)row * 8 + re] = score / ssum * 2.5f; atomicAdd(&cnt[lane], 1u); } }
        __syncthreads();
    }
}
__device__ __forceinline__ void phase_place(const Params& p, int l, LAS unsigned char* lds) {
    const int tid = otid(); const int NR = (l == NLAYER - 1) ? NLAT : NTOK; LAS int* pstart = (LAS int*)lds;
    const unsigned* cnt = (const unsigned*)(p.ws + O_CTL) + CW_CNT + l * 64; unsigned* cur = (unsigned*)(p.ws + O_CTL) + CW_CUR + l * 64;
    if (tid == 0) { int run = 0; for (int e = 0; e < NEXP; ++e) { pstart[e] = run; run += ((int)cnt[e] + 255) & ~255; } }
    __syncthreads();
    const int* eidx = (const int*)(p.ws + O_EIDX); int* slot = (int*)(p.ws + O_SLOT); int* stok = (int*)(p.ws + O_STOK);
    for (int i = blockIdx.x * NTHREADS + tid; i < NR * TOPK; i += gridDim.x * NTHREADS) { const int row = i / TOPK, k = i % TOPK, e = eidx[(size_t)row * 8 + k];
        const int s = pstart[e] + (int)atomicAdd(&cur[e], 1u); slot[(size_t)row * 8 + k] = s; stok[s] = row; }
    __syncthreads();
}
__device__ __forceinline__ void phase_final(const Params& p, int l) {
    const int lane = otid() & 63, gw = blockIdx.x * 8 + (otid() >> 6), GW = gridDim.x * 8; const bool last = (l == NLAYER - 1); const int NR = last ? NLAT : NTOK;
    const bf16_t* DO = (const bf16_t*)(p.ws + O_DOUT); const float* g3 = p.in[I_NORMG] + (size_t)(l * 4 + 3) * DM;
    for (int row = gw; row < NR; row += GW) {
        float y[32];
        { const bf16_t* src = DO + (size_t)(RSLOTS + row) * DM;
#pragma unroll
          for (int j = 0; j < 8; ++j) { const u32x2 v = *(const u32x2*)(src + ROWCOL(j, lane)); y[j * 4] = __uint_as_float(v.x << 16); y[j * 4 + 1] = __uint_as_float(v.x & 0xffff0000u); y[j * 4 + 2] = __uint_as_float(v.y << 16); y[j * 4 + 3] = __uint_as_float(v.y & 0xffff0000u); } }
        for (int k = 0; k < TOPK; ++k) { const int s = ((const int*)(p.ws + O_SLOT))[(size_t)row * 8 + k]; const float gt = ((const float*)(p.ws + O_GATE))[(size_t)row * 8 + k]; const bf16_t* src = DO + (size_t)s * DM;
#pragma unroll
            for (int j = 0; j < 8; ++j) { const u32x2 v = *(const u32x2*)(src + ROWCOL(j, lane)); y[j * 4] += gt * __uint_as_float(v.x << 16); y[j * 4 + 1] += gt * __uint_as_float(v.x & 0xffff0000u); y[j * 4 + 2] += gt * __uint_as_float(v.y << 16); y[j * 4 + 3] += gt * __uint_as_float(v.y & 0xffff0000u); } }
        float ss = 0.f;
#pragma unroll
        for (int i = 0; i < 32; ++i) ss += y[i] * y[i];
        const float r = rsqrtf(wave_sum(ss) * (1.0f / DM) + EPS); const float* mod = (const float*)(p.ws + O_MOD) + (size_t)(l * 9 + row_batch(row)) * 12288;
        float* X = (float*)(p.ws + O_X) + (size_t)row * DM; float x[32];
#pragma unroll
        for (int j = 0; j < 8; ++j) { const int c = ROWCOL(j, lane); const f32x4 xv = *(const f32x4*)(X + c), gv = *(const f32x4*)(g3 + c), gf = *(const f32x4*)(mod + 5 * DM + c); f32x4 xn;
#pragma unroll
            for (int q = 0; q < 4; ++q) { xn[q] = xv[q] + gf[q] * (y[j * 4 + q] * r * gv[q]); x[j * 4 + q] = xn[q]; }
            if (last) *(f32x4*)(p.out + (size_t)row * DM + c) = xn; else *(f32x4*)(X + c) = xn; }
        if (!last) norm1_row(p, l + 1, row, x, lane);
    }
}

#define XB_TMO      128
#define XB_XCNT(j)  (256  + 64 * (j))
#define XB_XSUB(j)  (1280 + 64 * (j))
#define XB_XGEN(j)  (2304 + 64 * (j))
#define XB_TOP      3328
#define XB_TOPGEN   3392
#define XCD_BAR_WORDS 3456
#define XB_SPIN_CAP (1u << 23)

__device__ __forceinline__ unsigned xb_ld(unsigned* p)              { return __hip_atomic_load(p, __ATOMIC_RELAXED, __HIP_MEMORY_SCOPE_AGENT); }
__device__ __forceinline__ unsigned xb_add(unsigned* p, unsigned v) { return __hip_atomic_fetch_add(p, v, __ATOMIC_RELAXED, __HIP_MEMORY_SCOPE_AGENT); }
__device__ __forceinline__ unsigned xb_xcc_id() { return (unsigned)__builtin_amdgcn_s_getreg((3 << 11) | 20) & 0xFu; }
#define XB_SPIN(cond, bar) do { unsigned _sp = 0; while (cond) { __builtin_amdgcn_s_sleep(1); \
    if ((++_sp & 255u) == 0u) { if (xb_ld(&(bar)[XB_TMO])) break; if (_sp > XB_SPIN_CAP) { atomicAdd(&(bar)[XB_TMO], 1u); break; } } } } while (0)

struct XcdBarrier {
    unsigned* bar; unsigned x;
    volatile LAS unsigned* st;
};

__device__ __forceinline__ XcdBarrier xcd_barrier_post(unsigned* bar, volatile LAS unsigned* st) {
    XcdBarrier b; b.bar = bar; b.x = xb_xcc_id(); b.st = st;
    if (threadIdx.x == 0) (void)xb_add(&bar[XB_XCNT(b.x)], 1u);
    return b;
}
__device__ __forceinline__ void xcd_barrier_complete(unsigned* bar, unsigned x, unsigned& nloc, unsigned& nx) {
    const unsigned G = gridDim.x * gridDim.y * gridDim.z;
    unsigned sum, cnt, mine, sp = 0u;
    for (;;) {
        sum = 0u; cnt = 0u; mine = 0u;
#pragma unroll
        for (unsigned j = 0; j < 16; ++j) { const unsigned c = xb_ld(&bar[XB_XCNT(j)]); sum += c; cnt += (c > 0u) ? 1u : 0u; mine = (j == x) ? c : mine; }
        if (sum == G) break;
        __builtin_amdgcn_s_sleep(1);
        if ((++sp & 255u) == 0u) { if (xb_ld(&bar[XB_TMO])) break; if (sp > XB_SPIN_CAP) { atomicAdd(&bar[XB_TMO], 1u); break; } }
    }
    nloc = mine > 0u ? mine : 1u; nx = cnt > 0u ? cnt : 1u;
}

__device__ __forceinline__ void xcd_barrier(const XcdBarrier& b) {
    asm volatile("s_waitcnt vmcnt(0)" ::: "memory");
    __syncthreads();
    if (threadIdx.x == 0) {
        unsigned* bar = b.bar;
        __builtin_amdgcn_s_waitcnt(0);
        unsigned nloc = b.st[0], nx = b.st[1];
        if (nloc == 0u) { xcd_barrier_complete(bar, b.x, nloc, nx); b.st[0] = nloc; b.st[1] = nx; }
        const unsigned old = xb_add(&bar[XB_XSUB(b.x)], 1u);
        const unsigned gen = old / nloc;
        if (old + 1u == (gen + 1u) * nloc) {
            __builtin_amdgcn_fence(__ATOMIC_RELEASE, "agent");
            asm volatile("s_waitcnt vmcnt(0)" ::: "memory");
            const unsigned og = xb_add(&bar[XB_TOP], 1u);
            const unsigned tg = og / nx;
            if (og + 1u == (tg + 1u) * nx) xb_add(&bar[XB_TOPGEN], 1u);
            else XB_SPIN(xb_ld(&bar[XB_TOPGEN]) == tg, bar);
            __builtin_amdgcn_fence(__ATOMIC_ACQUIRE, "agent");
            xb_add(&bar[XB_XGEN(b.x)], 1u);
            asm volatile("s_waitcnt vmcnt(0)" ::: "memory");
        } else {
            XB_SPIN(xb_ld(&bar[XB_XGEN(b.x)]) == gen, bar);
            __builtin_amdgcn_fence(__ATOMIC_ACQUIRE, "agent");
            asm volatile("s_waitcnt vmcnt(0)" ::: "memory");
        }
    }
    __syncthreads();
}


enum { PH_PRO = 0, PH_NORM1, PH_WIN, PH_POSTA, PH_POSTB, PH_MIXER, PH_HYFIN, PH_WOUT, PH_ROUTE, PH_PLACE, PH_GEMM1, PH_GEMM2, PH_FINAL, PH_COUNT };

template <int PH>
__device__ __forceinline__ void run_phase(const Params& p_in, int l, LAS unsigned char* lds) {
    Params p = p_in; { unsigned char* w = p.ws; asm volatile("" : "+s"(w)); p.ws = w; }
    unsigned char* ws = p.ws; const bool last = (l == NLAYER - 1);
    const int gw = blockIdx.x * 8 + (otid() >> 6), GW = gridDim.x * 8, lane = otid() & 63;
    if constexpr (PH == PH_PRO) { phase_prologue(p, lds); }
    if constexpr (PH == PH_NORM1) { phase_norm1(p, l); }
    if constexpr (PH == PH_WIN) {
        GemmDesc g{(const bf16_t*)(ws + O_H), DM, nullptr, DM, DM}; EpiStoreBf16 E{(bf16_t*)(ws + O_P), NP};
        const bf16_t* Bt = (const bf16_t*)(ws + O_WIN) + (size_t)l * NP * DM;
        if (!last) { DenseSched S{Bt, DM, NTOK / 256, 16, 0, 0}; GEMM_PHASE(g, S, E); }
        else { DenseSched S{Bt, DM, NLAT / 256, 16, 0, 0}; GEMM_PHASE(g, S, E); DenseSched S2{Bt, DM, NCTX / 256, 4, NLAT, 12}; GEMM_PHASE(g, S2, E); }
    }
    if constexpr (PH == PH_POSTA) {
#ifndef DBG_SKIP
#define DBG_SKIP 0
#endif
        if (!(DBG_SKIP & 1)) { GemmDesc g{(const bf16_t*)(ws + O_P) + C_CQ, NP, nullptr, 768, 768}; EpiStoreBf16 E{(bf16_t*)(ws + O_QRAW), NQP};
          DenseSched S{(const bf16_t*)(ws + O_WUQ) + (size_t)l * NQP * 768, 768, (last ? NLAT : NTOK) / 256, 5, 0, 0}; GEMM_PHASE(g, S, E); }
        if (!(DBG_SKIP & 2)) { GemmDesc g{(const bf16_t*)(ws + O_P) + C_CKV, NP, nullptr, 256, 256}; EpiStoreBf16 E{(bf16_t*)(ws + O_KVRAW), 1536};
          DenseSched S{(const bf16_t*)(ws + O_WUKV) + (size_t)l * 1536 * 256, 256, NTOK / 256, 6, 0, 0}; GEMM_PHASE(g, S, E); }
        const int ntt = (last ? NLAT : NTOK) / 64;
        if (!(DBG_SKIP & 4)) for (int t = blockIdx.x; t < ntt * 16; t += gridDim.x) hy_prep_task(p, l, (t >> 4) * 64, (t & 15) * 64, (LAS float*)lds);
        if (!(DBG_SKIP & 8)) for (int row = gw; row < NTOK; row += GW) gqa_post_row(p, l, row, lane);
    }
    if constexpr (PH == PH_POSTB) { if (l == 0) hss_tasks(p); for (int row = gw; row < NTOK; row += GW) mla_post_row(p, l, row, lane); }
    if constexpr (PH == PH_MIXER) { phase_mixer(p, l, lds); }
    if constexpr (PH == PH_HYFIN) { const int ntt = (last ? NLAT : NTOK) / 64; for (int t = blockIdx.x; t < ntt * 8; t += gridDim.x) hy_fin_task(p, l, (t >> 3) * 64, (t & 7) * 64, (LAS float*)lds); }
    if constexpr (PH == PH_WOUT) {
        GemmDesc g{(const bf16_t*)(ws + O_MIX), DM, nullptr, DM, DM}; EpiStoreBf16 E{(bf16_t*)(ws + O_OUT), DM};
        DenseSched S{(const bf16_t*)(ws + O_WOUT) + (size_t)l * DM * DM, DM, (last ? NLAT : NTOK) / 256, 8, 0, 0}; GEMM_PHASE(g, S, E);
    }
    if constexpr (PH == PH_ROUTE) { phase_route(p, l, lds); }
    if constexpr (PH == PH_PLACE) { phase_place(p, l, lds); }
    if constexpr (PH == PH_GEMM1 || PH == PH_GEMM2) {
        LAS int* te = (LAS int*)(lds + LDS_TILES); LAS int* ts = te + MAXTILES; LAS int* misc = (LAS int*)(lds + LDS_MISC) + 16;
        const int nt = moe_build_tiles((const unsigned*)(ws + O_CTL) + CW_CNT + l * 64, (last ? NLAT : NTOK) / 256, te, ts, misc);
        if constexpr (PH == PH_GEMM1) {
            GemmDesc g{(const bf16_t*)(ws + O_H), DM, (const int*)(ws + O_STOK), DM, DM}; EpiSwiGLU E{(bf16_t*)(ws + O_HID)};
            MoeSched S{te, ts, nt, 4, (const bf16_t*)(ws + O_EGU), (size_t)1024 * 2048, DM, 128}; GEMM_PHASE(g, S, E);
        } else {
            GemmDesc g{(const bf16_t*)(ws + O_HID), EH, nullptr, EH, EH}; EpiStoreBf16 E{(bf16_t*)(ws + O_DOUT), DM};
            MoeSched S{te, ts, nt, 8, (const bf16_t*)(ws + O_ED), (size_t)2048 * 512, EH, 256}; GEMM_PHASE(g, S, E);
        }
        __syncthreads();
    }
    if constexpr (PH == PH_FINAL) {
        phase_final(p, l);
        if (!last) cvt_exp_all(p, l + 1);
    }
}

#ifndef MEGA
#define MEGA 0
#endif


#if MEGA
__global__ void __launch_bounds__(NTHREADS, 2) mega_fwd(Params p) {
    extern __shared__ __attribute__((aligned(16))) unsigned char lds_raw[];
    LAS unsigned char* lds = (LAS unsigned char*)lds_raw;
    volatile LAS unsigned* xbw = (volatile LAS unsigned*)(lds + LDS_MISC);
    if (otid() == 0) { xbw[0] = 0u; xbw[1] = 0u; }
    __syncthreads();
    { const XcdBarrier b0 = xcd_barrier_post((unsigned*)(p.ws + O_CTL) + CW_BAR, xbw); if (otid() == 0) xbw[2] = b0.x; }
    __syncthreads();
#define GRID_BAR() do { XcdBarrier b_; b_.bar = (unsigned*)(p.ws + O_CTL) + CW_BAR; b_.x = xbw[2]; b_.st = xbw; xcd_barrier(b_); } while (0)
#ifndef DBL_MASK
#define DBL_MASK 0
#endif
#define RUNP(PH, l) do { run_phase<PH>(p, l, lds); GRID_BAR(); if ((DBL_MASK >> PH) & 1) { run_phase<PH>(p, l, lds); GRID_BAR(); } } while (0)
#ifndef DLY_MASK
#define DLY_MASK 0
#endif
#define RUND(PH, l) do { if ((DLY_MASK >> PH) & 1) { const unsigned long long t0_ = wall_clock64(); run_phase<PH>(p, l, lds); const unsigned long long t1_ = wall_clock64(); while (wall_clock64() < t1_ + (t1_ - t0_)) __builtin_amdgcn_s_sleep(8); } else run_phase<PH>(p, l, lds); } while (0)
    RUNP(PH_PRO, 0);
    for (int l = 0; l < NLAYER; ++l) {
        if (l == 0) RUNP(PH_NORM1, l);
        RUNP(PH_WIN, l); RUNP(PH_POSTA, l); RUNP(PH_POSTB, l); RUNP(PH_MIXER, l); RUNP(PH_HYFIN, l); RUNP(PH_WOUT, l);
        RUND(PH_ROUTE, l); GRID_BAR();
        RUND(PH_PLACE, l); GRID_BAR();
        RUNP(PH_GEMM1, l); RUNP(PH_GEMM2, l);
        RUND(PH_FINAL, l);
        if (l + 1 < NLAYER) GRID_BAR();
    }
}
#endif

#if !MEGA
template <int PH> __global__ void __launch_bounds__(NTHREADS, 2) k_phase(Params p) {
    extern __shared__ __attribute__((aligned(16))) unsigned char lds_raw[];
    run_phase<PH>(p, p.layer, (LAS unsigned char*)lds_raw);
}
template <int PH> static bool prep_phase() { return hipFuncSetAttribute((const void*)k_phase<PH>, hipFuncAttributeMaxDynamicSharedMemorySize, LDS_BYTES) == hipSuccess; }
static int g_nlaunch = 0;
#ifndef DBG_STOP
#define DBG_STOP 1000
#define DBG_DUMP 0
#else
#define DBG_DUMP 1
#ifndef DBG_SET
#define DBG_SET 31
#endif
#endif
template <int PH> static void launch_phase(Params p, int l, hipStream_t st) { if (g_nlaunch++ >= DBG_STOP) return; p.layer = l; hipLaunchKernelGGL(k_phase<PH>, dim3(256), dim3(NTHREADS), LDS_BYTES, st, p); }
#endif


#if DBG_DUMP
__device__ __forceinline__ float san(float x) { return (x == x && fabsf(x) < 1e6f) ? x : 1.0f; }
__global__ void __launch_bounds__(256) k_dump(Params p) {
    const size_t N = (size_t)NLAT * DM;
    const bf16_t* b1 = (const bf16_t*)(p.ws + O_WIN); const size_t n1 = (O_X - O_WIN) / 2;
    const bf16_t* b2 = (const bf16_t*)(p.ws + O_H); const size_t n2 = (size_t)NTOK * DM;
    const bf16_t* b3 = (const bf16_t*)(p.ws + O_A); const size_t n3 = (O_AEND - O_A) / 2;
    const float* f1 = (const float*)(p.ws + O_MOD); const size_t m1 = (O_WIN - O_MOD) / 4;
    const float* f2 = (const float*)(p.ws + O_X); const size_t m2 = (size_t)NTOK * DM;
    for (size_t i = (size_t)blockIdx.x * 256 + otid(); i < N; i += (size_t)gridDim.x * 256) {
        float v = 0.f;
        if (DBG_SET & 1) for (size_t e = i; e < n1; e += N) v += san(bf2f(b1[e]));
        if (DBG_SET & 2) for (size_t e = i; e < n2; e += N) v += san(bf2f(b2[e]));
        if (DBG_SET & 4) for (size_t e = i; e < n3; e += N) v += san(bf2f(b3[e]));
        if (DBG_SET & 8) for (size_t e = i; e < m1; e += N) v += san(f1[e]);
        if (DBG_SET & 16) for (size_t e = i; e < m2; e += N) v += san(f2[e]);
        if (DBG_SET & 32) v += san(bf2f(((const bf16_t*)(p.ws + O_WUKV))[i % ((size_t)2 * 1536 * 256)]));
        if (DBG_SET & 64) { const size_t r = i % NTOK, c = (i / NTOK) % 256; v += san(bf2f(((const bf16_t*)(p.ws + O_P))[r * NP + C_CKV + c])); }
        if (DBG_SET & 128) v += san(bf2f(((const bf16_t*)(p.ws + O_KVRAW))[i % ((size_t)NTOK * 1536)]));
        p.out[i] = v;
    }
}
#endif
static int g_grid = 0;
extern "C" void kernel_launch(void* const* d_in, const int* in_sizes, int n_in, void* d_out, int out_size, void* d_ws, size_t ws_size, hipStream_t stream) {
    static int ok = 0;
    if (ok == 0) {
        if (n_in != 31 || in_sizes[0] != NLAT * DM || out_size != NLAT * DM || ws_size < WS_END) { fprintf(stderr, "kernel_launch: unexpected shapes (n_in %d, ws %zu, need %zu)\n", n_in, ws_size, (size_t)WS_END); ok = -1; return; }
        bool good = true;
#if !MEGA
        good = good && prep_phase<0>() && prep_phase<1>() && prep_phase<2>() && prep_phase<3>() && prep_phase<4>() && prep_phase<5>() && prep_phase<6>() && prep_phase<7>() && prep_phase<8>() && prep_phase<9>() && prep_phase<10>() && prep_phase<11>() && prep_phase<12>();
#endif
#if MEGA
        good = hipFuncSetAttribute((const void*)mega_fwd, hipFuncAttributeMaxDynamicSharedMemorySize, LDS_BYTES) == hipSuccess;
        int dev = 0, cus = 0, per_cu = 0;
        if (hipGetDevice(&dev) != hipSuccess || hipDeviceGetAttribute(&cus, hipDeviceAttributeMultiprocessorCount, dev) != hipSuccess) good = false;
        if (good && (hipOccupancyMaxActiveBlocksPerMultiprocessor(&per_cu, (const void*)mega_fwd, NTHREADS, LDS_BYTES) != hipSuccess || per_cu < 1)) { fprintf(stderr, "kernel_launch: occupancy query says %d workgroups per CU\n", per_cu); good = false; }
        g_grid = cus;
#endif
        if (!good) { fprintf(stderr, "kernel_launch: set-up failed\n"); ok = -1; return; }
        ok = 1;
    }
    if (ok < 0) return;
    Params p{}; for (int i = 0; i < 31; ++i) p.in[i] = (const float*)d_in[i]; p.out = (float*)d_out; p.ws = (unsigned char*)d_ws; p.layer = 0; p.pad = 0;
#ifdef POISON_WS
    hipMemsetAsync((char*)d_ws, 0xFF, WS_END, stream);
#endif
    hipMemsetAsync((char*)d_ws + O_CTL, 0, ZERO_BYTES, stream);
#if !MEGA
    g_nlaunch = 0;
    launch_phase<PH_PRO>(p, 0, stream);
    for (int l = 0; l < NLAYER; ++l) {
        if (l == 0) launch_phase<PH_NORM1>(p, l, stream);
        launch_phase<PH_WIN>(p, l, stream); launch_phase<PH_POSTA>(p, l, stream); launch_phase<PH_POSTB>(p, l, stream); launch_phase<PH_MIXER>(p, l, stream);
        launch_phase<PH_HYFIN>(p, l, stream); launch_phase<PH_WOUT>(p, l, stream); launch_phase<PH_ROUTE>(p, l, stream); launch_phase<PH_PLACE>(p, l, stream);
        launch_phase<PH_GEMM1>(p, l, stream); launch_phase<PH_GEMM2>(p, l, stream); launch_phase<PH_FINAL>(p, l, stream);
    }
#if DBG_DUMP
    hipLaunchKernelGGL(k_dump, dim3(2048), dim3(256), 0, stream, p);
#endif
#else
    hipLaunchKernelGGL(mega_fwd, dim3(g_grid), dim3(NTHREADS), LDS_BYTES, stream, p);
#endif
}
```

```cpp
#define GQA_SD 1
#define FAST_GEMM 1
#define MEGA 1
#include <hip/hip_runtime.h>
#include <stdint.h>
#include <stdio.h>

#define LAS __attribute__((address_space(3)))
typedef unsigned short bf16_t;
typedef short bf16x8 __attribute__((ext_vector_type(8)));
typedef short s16x4 __attribute__((ext_vector_type(4)));
typedef float f32x4 __attribute__((ext_vector_type(4)));
typedef float f32x16 __attribute__((ext_vector_type(16)));
typedef unsigned u32x4 __attribute__((ext_vector_type(4)));
typedef unsigned u32x2 __attribute__((ext_vector_type(2)));

constexpr int DM = 2048, NB = 8, SEQ = 2048, CTXL = 256, NLAT = NB * SEQ, NCTX = NB * CTXL, NTOK = NLAT + NCTX, NLAYER = 2;
constexpr int NP = 4096;
constexpr int C_CQ = 1536, C_GQ = 2304, C_CKV = 3072, C_KR = 3328, C_GK = 3392, C_GV = 3648, IN_COLS = 3904;
constexpr int NEXP = 64, TOPK = 6, EH = 512;
constexpr int LK = CTXL + SEQ;
constexpr int RSLOTS = 126976;
constexpr int NSLOTS = RSLOTS + NTOK;
constexpr int MAXTILES = NSLOTS / 256;
constexpr int NQP = 1280;
constexpr float EPS = 1e-6f;
constexpr int NTHREADS = 512;
#ifndef GQA_SD
#define GQA_SD 2
#endif
#ifndef HY_MFMA
#define HY_MFMA 1
#endif

constexpr size_t al256(size_t x) { return (x + 255) & ~(size_t)255; }
constexpr size_t O_CTL = 0;
constexpr size_t CTL_BYTES = 65536;
constexpr size_t O_MOD = O_CTL + CTL_BYTES;
constexpr size_t O_HSS = O_MOD + al256((size_t)NLAYER * 9 * 12288 * 4);
constexpr size_t ZERO_BYTES = O_HSS + al256((size_t)NLAYER * 2 * 2 * 512 * 4);
constexpr size_t O_HF = ZERO_BYTES;
constexpr size_t HF_L0 = (size_t)2 * 2 * 512 * 2048, HF_L1 = (size_t)2 * 2 * 512 * 256, HF_LAYER = HF_L0 + HF_L1;
constexpr size_t O_WIN = O_HF + al256(NLAYER * HF_LAYER * 4);
constexpr size_t O_WOUT = O_WIN + (size_t)NLAYER * NP * DM * 2;
constexpr size_t O_WUQ = O_WOUT + (size_t)NLAYER * DM * DM * 2;
constexpr size_t O_WUKV = O_WUQ + al256((size_t)NLAYER * NQP * 768 * 2);
constexpr size_t O_EGU = O_WUKV + al256((size_t)NLAYER * 1536 * 256 * 2);
constexpr size_t O_ED = O_EGU + (size_t)65 * 1024 * 2048 * 2;
constexpr size_t O_X = O_ED + (size_t)65 * 2048 * 512 * 2;
constexpr size_t O_H = O_X + (size_t)NTOK * DM * 4;
constexpr size_t O_EIDX = O_H + (size_t)NTOK * DM * 2;
constexpr size_t O_GATE = O_EIDX + (size_t)NTOK * 8 * 4;
constexpr size_t O_SLOT = O_GATE + (size_t)NTOK * 8 * 4;
constexpr size_t O_STOK = O_SLOT + (size_t)NTOK * 8 * 4;
constexpr size_t O_HID = O_STOK + al256((size_t)NSLOTS * 4);
constexpr size_t O_A = O_HID + (size_t)NSLOTS * EH * 2;
constexpr size_t O_P = O_A;
constexpr size_t O_QRAW = O_P + (size_t)NTOK * NP * 2;
constexpr size_t O_KVRAW = O_QRAW + (size_t)NTOK * NQP * 2;
constexpr size_t O_QM = O_KVRAW + (size_t)NTOK * 1536 * 2;
constexpr size_t O_QMC = O_QM + (size_t)NB * 6 * SEQ * 192 * 2;
constexpr size_t O_KM = O_QMC + (size_t)NB * 6 * CTXL * 192 * 2;
constexpr size_t O_VM = O_KM + (size_t)NB * 6 * LK * 192 * 2;
constexpr size_t O_QG = O_VM + (size_t)NB * 6 * LK * 128 * 2;
constexpr size_t O_QGC = O_QG + (size_t)NB * 6 * SEQ * 128 * 2;
constexpr size_t O_KG = O_QGC + (size_t)NB * 6 * CTXL * 128 * 2;
constexpr size_t O_VG = O_KG + (size_t)NB * 2 * LK * 128 * 2;
constexpr size_t O_VT = O_VG + (size_t)NB * 2 * LK * 128 * 2;
constexpr size_t O_X1T = O_VT + (size_t)512 * NTOK * 2;
constexpr size_t O_Y2T = O_X1T + (size_t)512 * NTOK * 2;
constexpr size_t O_MIX = O_Y2T + (size_t)512 * NTOK * 2;
constexpr size_t O_OUT = O_MIX + (size_t)NTOK * DM * 2;
constexpr size_t O_AEND = O_OUT + (size_t)NTOK * DM * 2;
constexpr size_t O_DOUT = O_A;
static_assert(O_DOUT + (size_t)NSLOTS * DM * 2 <= O_AEND, "DOUT must fit the mixer scratch region");
constexpr size_t WS_END = O_AEND;

constexpr int CW_BAR = 0;
constexpr int CW_CNT = 4096;
constexpr int CW_CUR = 4096 + 128;
constexpr int CW_Q = 4096 + 256;

constexpr int LDS_BYTES = 148480;
constexpr int LDS_MISC = 147456;
constexpr int LDS_TILES = 131072;

struct Params { const float* in[31]; float* out; unsigned char* ws; int layer; int pad; };

enum { I_X = 0, I_C, I_CTX, I_CCTX, I_ADAW, I_ADAB, I_NORMG, I_WIN, I_WOUT, I_HYCONV, I_HYW1, I_HYB1, I_HYW2, I_HYB2, I_HYW3, I_HYFREQ, I_HYSKIP,
       I_MQN, I_MKVN, I_WUQ, I_WUKV, I_GQN, I_GKN, I_RW, I_RB, I_EG, I_EU, I_EDN, I_SG, I_SU, I_SD };

__device__ __forceinline__ int otid() { int t = threadIdx.x; asm volatile("" : "+v"(t)); return t; }
__device__ __forceinline__ int owid() { return __builtin_amdgcn_readfirstlane(otid() >> 6); }
__device__ __forceinline__ float bf2f(bf16_t v) { return __uint_as_float(((unsigned)v) << 16); }
__device__ __forceinline__ bf16_t f2bf(float f) { unsigned u = __float_as_uint(f); u += 0x7FFFu + ((u >> 16) & 1u); return (bf16_t)(u >> 16); }
__device__ __forceinline__ unsigned pk2(float lo, float hi) { unsigned r; asm volatile("v_cvt_pk_bf16_f32 %0, %1, %2" : "=v"(r) : "v"(lo), "v"(hi)); return r; }
__device__ __forceinline__ float wave_sum(float v) {
#pragma unroll
    for (int o = 32; o >= 1; o >>= 1) v += __shfl_xor(v, o);
    return v;
}
__device__ __forceinline__ float rdlane(float v, int l) { return __int_as_float(__builtin_amdgcn_readlane(__float_as_int(v), l)); }
__device__ __forceinline__ float silu_f(float x) { return x / (1.0f + __expf(-x)); }
__device__ __forceinline__ const float* resid_src(const Params& p, int l, int row) {
    if (l == 0) return row < NLAT ? p.in[I_X] + (size_t)row * DM : p.in[I_CTX] + (size_t)(row - NLAT) * DM;
    return (const float*)(p.ws + O_X) + (size_t)row * DM;
}
__device__ __forceinline__ int row_batch(int row) { return row < NLAT ? row >> 11 : 8; }
#define ROWCOL(j, lane) ((j) * 256 + (lane) * 4)


struct GUnit { int arow0; const bf16_t* B; int orow0, ocol0; };
struct GemmDesc { const bf16_t* A; int lda; const int* ridx; int ldb; int K; };

struct EpiStoreBf16 {
    bf16_t* O; int ldo;
    __device__ __forceinline__ void operator()(const f32x4 (&acc)[2][2][4][2], const GUnit& u, int wr, int wc, int fr, int fq) const {
#pragma unroll
        for (int ai = 0; ai < 2; ++ai)
#pragma unroll
            for (int m = 0; m < 4; ++m) {
                bf16_t* rowp = O + (size_t)(u.orow0 + ai * 128 + wr * 64 + m * 16 + fr) * ldo + u.ocol0 + wc * 32 + 4 * fq;
#pragma unroll
                for (int bj = 0; bj < 2; ++bj)
#pragma unroll
                    for (int n = 0; n < 2; ++n) { const f32x4 v = acc[ai][bj][m][n]; u32x2 w; w.x = pk2(v[0], v[1]); w.y = pk2(v[2], v[3]); *(u32x2*)(rowp + bj * 128 + n * 16) = w; }
            }
    }
};
struct EpiSwiGLU {
    bf16_t* O;
    __device__ __forceinline__ void operator()(const f32x4 (&acc)[2][2][4][2], const GUnit& u, int wr, int wc, int fr, int fq) const {
#pragma unroll
        for (int ai = 0; ai < 2; ++ai)
#pragma unroll
            for (int m = 0; m < 4; ++m) {
                bf16_t* rowp = O + (size_t)(u.orow0 + ai * 128 + wr * 64 + m * 16 + fr) * EH + u.ocol0 + wc * 32 + 4 * fq;
#pragma unroll
                for (int n = 0; n < 2; ++n) { const f32x4 g = acc[ai][0][m][n], up = acc[ai][1][m][n]; float h[4];
#pragma unroll
                    for (int j = 0; j < 4; ++j) h[j] = silu_f(g[j]) * up[j];
                    u32x2 w; w.x = pk2(h[0], h[1]); w.y = pk2(h[2], h[3]); *(u32x2*)(rowp + n * 16) = w; }
            }
    }
};

template <class Epi>
__device__ __forceinline__ void gemm_unit_simple(const GemmDesc& g, const GUnit& u, const Epi& E) {
    int tid = otid();
    const int wid = __builtin_amdgcn_readfirstlane(tid >> 6), lane = tid & 63, wr = wid >> 2, wc = wid & 3, fr = lane & 15, fq = lane >> 4;
    f32x4 acc[2][2][4][2];
#pragma unroll
    for (int a = 0; a < 2; ++a)
#pragma unroll
        for (int b = 0; b < 2; ++b)
#pragma unroll
            for (int m = 0; m < 4; ++m)
#pragma unroll
                for (int n = 0; n < 2; ++n) acc[a][b][m][n] = (f32x4){0.f, 0.f, 0.f, 0.f};
    const bf16_t* ap[2][4]; const bf16_t* bp[2][2];
#pragma unroll
    for (int ai = 0; ai < 2; ++ai)
#pragma unroll
        for (int m = 0; m < 4; ++m) { const int r = u.arow0 + ai * 128 + wr * 64 + m * 16 + fr; int src = g.ridx ? g.ridx[r] : r; if (src < 0) src = 0; ap[ai][m] = g.A + (size_t)src * g.lda + 8 * fq; }
#pragma unroll
    for (int bj = 0; bj < 2; ++bj)
#pragma unroll
        for (int n = 0; n < 2; ++n) bp[bj][n] = u.B + (size_t)(bj * 128 + wc * 32 + n * 16 + fr) * g.ldb + 8 * fq;
    int Kq = g.K; asm volatile("" : "+s"(Kq));
#pragma unroll 1
    for (int k0 = 0; k0 < Kq; k0 += 32) {
        bf16x8 a[2][4], b[2][2];
#pragma unroll
        for (int ai = 0; ai < 2; ++ai)
#pragma unroll
            for (int m = 0; m < 4; ++m) a[ai][m] = *(const bf16x8*)(ap[ai][m] + k0);
#pragma unroll
        for (int bj = 0; bj < 2; ++bj)
#pragma unroll
            for (int n = 0; n < 2; ++n) b[bj][n] = *(const bf16x8*)(bp[bj][n] + k0);
#pragma unroll
        for (int ai = 0; ai < 2; ++ai)
#pragma unroll
            for (int bj = 0; bj < 2; ++bj)
#pragma unroll
                for (int m = 0; m < 4; ++m)
#pragma unroll
                    for (int n = 0; n < 2; ++n) acc[ai][bj][m][n] = __builtin_amdgcn_mfma_f32_16x16x32_bf16(b[bj][n], a[ai][m], acc[ai][bj][m][n], 0, 0, 0);
    }
    E(acc, u, wr, wc, fr, fq);
}

struct DenseSched {
    const bf16_t* Bt; int ldb, nM, nN, row0, pn0;
    __device__ __forceinline__ int count() const { return nM * nN; }
    __device__ __forceinline__ void unit(int i, GUnit& u) const { const int pm = i / nN, pn = pn0 + i % nN; u.arow0 = row0 + pm * 256; u.B = Bt + (size_t)pn * 256 * ldb; u.orow0 = u.arow0; u.ocol0 = pn * 256; }
};
struct MoeSched {
    const LAS int* te; const LAS int* ts; int ntiles, npn; const bf16_t* Bt; size_t estride; int ldb, ocolw;
    __device__ __forceinline__ int count() const { return ntiles * npn; }
    __device__ __forceinline__ void unit(int i, GUnit& u) const { const int t = i / npn, pn = i % npn; const int e = te[t]; u.arow0 = ts[t]; u.B = Bt + (size_t)e * estride + (size_t)pn * 256 * ldb; u.orow0 = u.arow0; u.ocol0 = pn * ocolw; }
};
template <class Sched, class Epi>
__device__ __forceinline__ void gemm_phase_simple(const GemmDesc& g, const Sched& S, const Epi& E) {
    const int n = S.count();
    for (int i = blockIdx.x; i < n; i += gridDim.x) { GUnit u; S.unit(i, u); gemm_unit_simple(g, u, E); }
}
__device__ __forceinline__ int wave_incl_scan(int v, int lane) {
#pragma unroll
    for (int o = 1; o < 64; o <<= 1) { const int t = __shfl_up(v, o); if (lane >= o) v += t; }
    return v;
}
__device__ __forceinline__ int moe_build_tiles(const unsigned* cnt, int nshared, LAS int* te, LAS int* ts, LAS int* misc) {
    __syncthreads();
    const int tid = otid();
    if (tid < 64) {
        const int c = (int)cnt[tid], ntile = (c + 255) >> 8, incl = wave_incl_scan(ntile, tid), first = incl - ntile;
        for (int j = 0; j < ntile; ++j) { te[first + j] = tid; ts[first + j] = (first + j) * 256; }
        const int nrt = __shfl(incl, 63);
        for (int j = tid; j < nshared; j += 64) { te[nrt + j] = NEXP; ts[nrt + j] = RSLOTS + j * 256; }
        if (tid == 0) misc[0] = nrt + nshared;
    }
    __syncthreads();
    return misc[0];
}
#ifndef FAST_GEMM
#define FAST_GEMM 0
#endif
#if !FAST_GEMM
#define GEMM_PHASE(g, S, E) gemm_phase_simple(g, S, E)
#endif

#if FAST_GEMM
constexpr int HTB = 128 * 64 * 2;
__device__ __forceinline__ int lds_byte(int r, int c) { const int st = (r >> 4) * 2 + (c >> 5), rr = r & 15, cc = c & 31, ob = rr * 64 + cc * 2; return st * 1024 + (ob ^ (((ob >> 9) & 1) << 5)); }
__device__ __forceinline__ void stage_rc(int b, int& R, int& C) { const int st = b / 1024, sb = b % 1024, swz = sb ^ (((sb >> 9) & 1) << 5); R = (st >> 1) * 16 + swz / 64; C = (st & 1) * 32 + (swz % 64) / 2; }

template <class Sched, class Epi>
__device__ __forceinline__ void gemm_phase_fast(LAS unsigned char* lds, const GemmDesc& g, const Sched& S, const Epi& E) {
    const int tid = otid(), wid = __builtin_amdgcn_readfirstlane(tid >> 6), lane = tid & 63, wr = wid >> 2, wc = wid & 3, fr = lane & 15, fq = lane >> 4;
    const int K = g.K, nt = K / 64, nunits = S.count(), G = gridDim.x, c0 = blockIdx.x;
    if (c0 >= nunits) return;
    int R[2], C[2]; unsigned voffB[2];
#pragma unroll
    for (int i = 0; i < 2; ++i) { stage_rc(tid * 16 + i * 8192, R[i], C[i]); voffB[i] = (unsigned)(R[i] * g.ldb + C[i]) * 2u; }
    const size_t kstep = 128;
    const size_t hstepB = (size_t)128 * g.ldb * 2;
    const unsigned ldsw = (unsigned)wid * 1024u;
    const int aoff = lds_byte(wr * 64 + fr, fq * 8), boff = lds_byte(wc * 32 + fr, fq * 8);
    const char* Ab = (const char*)g.A;
#define F_SA(b, h) (((b) * 2 + (h)) * HTB)
#define F_SB(b, h) ((4 + (b) * 2 + (h)) * HTB)
#define F_STAGE(bufoff, gbase, voff) do { _Pragma("unroll") for (int _i = 0; _i < 2; ++_i) \
        __builtin_amdgcn_global_load_lds((const unsigned*)((const char*)(gbase) + (voff)[_i]), (LAS unsigned*)(lds + (bufoff) + ldsw + _i * 8192), 16, 0, 0); } while (0)
#define F_LDA(dst, b, h) do { _Pragma("unroll") for (int m = 0; m < 4; ++m) _Pragma("unroll") for (int k = 0; k < 2; ++k) dst[m][k] = *(const LAS bf16x8*)(lds + F_SA(b, h) + aoff + m * 2048 + k * 1024); } while (0)
#define F_LDB(dst, b, h) do { _Pragma("unroll") for (int n = 0; n < 2; ++n) _Pragma("unroll") for (int k = 0; k < 2; ++k) dst[n][k] = *(const LAS bf16x8*)(lds + F_SB(b, h) + boff + n * 2048 + k * 1024); } while (0)
#define F_MMA(ai, bj, At, Bt) do { __builtin_amdgcn_s_setprio(1); _Pragma("unroll") for (int m = 0; m < 4; ++m) _Pragma("unroll") for (int n = 0; n < 2; ++n) _Pragma("unroll") for (int k = 0; k < 2; ++k) \
        acc[ai][bj][m][n] = __builtin_amdgcn_mfma_f32_16x16x32_bf16(Bt[n][k], At[m][k], acc[ai][bj][m][n], 0, 0, 0); __builtin_amdgcn_s_setprio(0); } while (0)
#define F_WAIT_V(n) asm volatile("s_waitcnt vmcnt(" #n ")" ::: "memory")
#define F_WAIT_L(n) asm volatile("s_waitcnt lgkmcnt(" #n ")" ::: "memory")
#define F_BAR __builtin_amdgcn_s_barrier()
#define F_SCHED __builtin_amdgcn_sched_barrier(0)
#define F_AROWS(u, dst) do { _Pragma("unroll") for (int _h = 0; _h < 2; ++_h) _Pragma("unroll") for (int _i = 0; _i < 2; ++_i) { const int _r = (u).arow0 + _h * 128 + R[_i]; int _s = g.ridx ? g.ridx[_r] : _r; if (_s < 0) _s = 0; dst[_h][_i] = _s; } } while (0)
#define F_AOFFS(src, dst) do { _Pragma("unroll") for (int _h = 0; _h < 2; ++_h) _Pragma("unroll") for (int _i = 0; _i < 2; ++_i) dst[_h][_i] = ((unsigned)src[_h][_i] * (unsigned)g.lda + (unsigned)C[_i]) * 2u; } while (0)
    GUnit cur, nxt; int ui = 0;
    S.unit(c0, cur);
    f32x4 acc[2][2][4][2];
#pragma unroll
    for (int a = 0; a < 2; ++a)
#pragma unroll
        for (int b = 0; b < 2; ++b)
#pragma unroll
            for (int m = 0; m < 4; ++m)
#pragma unroll
                for (int n = 0; n < 2; ++n) acc[a][b][m][n] = (f32x4){0.f, 0.f, 0.f, 0.f};
    bf16x8 At[4][2], B0[2][2], B1[2][2];
    unsigned voA[2][2]; int rnx[2][2];
    F_AROWS(cur, rnx); F_AOFFS(rnx, voA);
    const char* cB = (const char*)cur.B;
    F_STAGE(F_SB(0, 0), cB, voffB); F_STAGE(F_SA(0, 0), Ab, voA[0]); F_STAGE(F_SB(0, 1), cB + hstepB, voffB); F_STAGE(F_SA(0, 1), Ab, voA[1]);
    if (wr == 1) F_BAR;
    F_WAIT_V(4); F_BAR;
    F_STAGE(F_SB(1, 0), cB + kstep, voffB); F_STAGE(F_SA(1, 0), Ab + kstep, voA[0]); F_STAGE(F_SB(1, 1), cB + hstepB + kstep, voffB);
    F_WAIT_V(6); F_BAR;
    for (;;) {
        const int Ln = (ui + 1) * G + c0; const bool has_next = Ln < nunits;
        if (has_next) { S.unit(Ln, nxt); F_AROWS(nxt, rnx); }
        const char* nB = has_next ? (const char*)nxt.B : cB;
        for (int t = 0; t < nt; t += 2) {
            const bool last = (t == nt - 2);
            const char* a1 = Ab + (size_t)(t + 1) * kstep;
            const char* a2 = last ? Ab : Ab + (size_t)(t + 2) * kstep; const char* b2 = last ? nB : cB + (size_t)(t + 2) * kstep;
            const char* a3 = a2 + kstep; const char* b3 = b2 + kstep;
            F_LDB(B0, 0, 0); F_SCHED; F_LDA(At, 0, 0); F_STAGE(F_SA(1, 1), a1, voA[1]);
            if (last && has_next) F_AOFFS(rnx, voA);
            F_WAIT_L(8); F_BAR; F_WAIT_L(0); F_MMA(0, 0, At, B0); F_BAR; F_SCHED;
            F_LDB(B1, 0, 1); F_STAGE(F_SB(0, 0), b2, voffB);
            F_BAR; F_WAIT_L(0); F_MMA(0, 1, At, B1); F_BAR;
            F_LDA(At, 0, 1); F_STAGE(F_SA(0, 0), a2, voA[0]);
            F_BAR; F_WAIT_L(0); F_MMA(1, 0, At, B0); F_BAR; F_SCHED;
            F_STAGE(F_SB(0, 1), b2 + hstepB, voffB);
            F_WAIT_V(6); F_BAR; F_MMA(1, 1, At, B1); F_BAR;
            F_LDB(B0, 1, 0); F_SCHED; F_LDA(At, 1, 0); F_STAGE(F_SA(0, 1), a2, voA[1]);
            F_WAIT_L(8); F_BAR; F_WAIT_L(0); F_MMA(0, 0, At, B0); F_BAR; F_SCHED;
            F_LDB(B1, 1, 1); F_STAGE(F_SB(1, 0), b3, voffB);
            F_BAR; F_WAIT_L(0); F_MMA(0, 1, At, B1); F_BAR;
            F_LDA(At, 1, 1); F_STAGE(F_SA(1, 0), a3, voA[0]);
            F_BAR; F_WAIT_L(0); F_MMA(1, 0, At, B0); F_BAR; F_SCHED;
            F_STAGE(F_SB(1, 1), b3 + hstepB, voffB);
            F_WAIT_V(6); F_BAR; F_MMA(1, 1, At, B1); F_BAR;
        }
        E(acc, cur, wr, wc, fr, fq);
        if (!has_next) break;
#pragma unroll
        for (int a = 0; a < 2; ++a)
#pragma unroll
            for (int b = 0; b < 2; ++b)
#pragma unroll
                for (int m = 0; m < 4; ++m)
#pragma unroll
                    for (int n = 0; n < 2; ++n) acc[a][b][m][n] = (f32x4){0.f, 0.f, 0.f, 0.f};
        cur = nxt; cB = nB; ++ui;
    }
    F_WAIT_V(0);
    if (wr == 0) F_BAR;
    F_BAR;
#undef F_SA
#undef F_SB
#undef F_STAGE
#undef F_LDA
#undef F_LDB
#undef F_MMA
#undef F_WAIT_V
#undef F_WAIT_L
#undef F_BAR
#undef F_SCHED
#undef F_AROWS
#undef F_AOFFS
}
#define GEMM_PHASE(g, S, E) gemm_phase_fast(lds, g, S, E)
#endif

#define SBAR() __builtin_amdgcn_sched_barrier(0)
__device__ __forceinline__ int crow(int r, int hi) { return (r & 3) + 8 * (r >> 2) + 4 * hi; }
template <int DQK> __device__ __forceinline__ int kaddr(int row, int chunk) {
    const int sw = (DQK == 128) ? (row & 7) : ((row >> 1) & 7);
    return row * (DQK * 2) + ((chunk ^ sw) << 4);
}
__device__ __forceinline__ void partialSM(f32x16& p0, f32x16& p1, float& m_reg, float& mn, float& alpha, float C, float thr) {
    float pmax = p0[0];
#pragma unroll
    for (int r = 1; r < 16; ++r) pmax = fmaxf(pmax, p0[r]);
#pragma unroll
    for (int r = 0; r < 16; ++r) pmax = fmaxf(pmax, p1[r]);
    { auto rr = __builtin_amdgcn_permlane32_swap(__float_as_uint(pmax), __float_as_uint(pmax), false, false);
      pmax = fmaxf(__uint_as_float(rr[0]), __uint_as_float(rr[1])); }
    if (__builtin_expect(__all(pmax - m_reg <= thr), 1)) { mn = m_reg; alpha = 1.f; }
    else { mn = fmaxf(m_reg, pmax); alpha = __builtin_amdgcn_exp2f((m_reg - mn) * C); m_reg = mn; }
    const float mnC = -mn * C;
#pragma unroll
    for (int r = 0; r < 16; ++r) p0[r] = fmaf(p0[r], C, mnC);
#pragma unroll
    for (int r = 0; r < 16; ++r) p1[r] = fmaf(p1[r], C, mnC);
#pragma unroll
    for (int r = 0; r < 16; ++r) p0[r] = __builtin_amdgcn_exp2f(p0[r]);
}
__device__ __forceinline__ void finishSM(f32x16& p0, f32x16& p1, float alpha, float& l_reg, bf16x8& pa0, bf16x8& pa1, bf16x8& pa2, bf16x8& pa3) {
#pragma unroll
    for (int r = 0; r < 16; ++r) p1[r] = __builtin_amdgcn_exp2f(p1[r]);
    float ps = 0;
#pragma unroll
    for (int r = 0; r < 16; ++r) ps += p0[r];
#pragma unroll
    for (int r = 0; r < 16; ++r) ps += p1[r];
    { auto rr = __builtin_amdgcn_permlane32_swap(__float_as_uint(ps), __float_as_uint(ps), false, false);
      ps = __uint_as_float(rr[0]) + __uint_as_float(rr[1]); }
    l_reg = l_reg * alpha + ps;
#define PK4(P, BASE, OUT) do { unsigned a0 = pk2(P[BASE + 0], P[BASE + 1]), a1 = pk2(P[BASE + 2], P[BASE + 3]);   \
    unsigned b0 = pk2(P[BASE + 4], P[BASE + 5]), b1 = pk2(P[BASE + 6], P[BASE + 7]);                              \
    auto r0 = __builtin_amdgcn_permlane32_swap(a0, b0, false, false); auto r1 = __builtin_amdgcn_permlane32_swap(a1, b1, false, false); \
    u32x4 w = {r0[0], r1[0], r0[1], r1[1]}; OUT = *reinterpret_cast<bf16x8*>(&w); } while (0)
    PK4(p0, 0, pa0); PK4(p0, 8, pa1); PK4(p1, 0, pa2); PK4(p1, 8, pa3);
#undef PK4
}
template <int DQK> __device__ __forceinline__ void qkt(f32x16& p0, f32x16& p1, const char* Ks, const bf16x8* qr, int r32, int hi) {
    p0 = f32x16{}; p1 = f32x16{};
#pragma unroll
    for (int d0 = 0; d0 < DQK / 16; ++d0) { const int ch = 2 * d0 + hi;
        const bf16x8 b0 = *reinterpret_cast<const bf16x8*>(Ks + kaddr<DQK>(r32, ch));
        const bf16x8 b1 = *reinterpret_cast<const bf16x8*>(Ks + kaddr<DQK>(32 + r32, ch));
        p0 = __builtin_amdgcn_mfma_f32_32x32x16_bf16(b0, qr[d0], p0, 0, 0, 0);
        p1 = __builtin_amdgcn_mfma_f32_32x32x16_bf16(b1, qr[d0], p1, 0, 0, 0); }
}
__device__ __forceinline__ int v_st(int k, int c) { const int kk = (k & ~0xC) | ((k & 4) << 1) | ((k & 8) >> 1); return ((kk >> 3) * 4 + (c >> 5)) * 512 + ((kk & 7) * 32 + (c & 31)) * 2; }
__device__ __forceinline__ int v_rd_base(int lane) { return ((lane & 3) << 3) | (((lane >> 2) & 3) << 6) | (((lane >> 4) & 1) << 5) | (((lane >> 5) & 1) << 8); }
constexpr int v_rd_off(int d0, int ks, int half) { return d0 * 512 + ks * 4096 + half * 2048; }
template <int OFF> __device__ __forceinline__ s16x4 tr_read(int vb) {
    s16x4 r; asm volatile("ds_read_b64_tr_b16 %0, %1 offset:%2" : "=&v"(r) : "v"(vb), "i"(OFF) : "memory"); return r;
}
template <int D0> __device__ __forceinline__ void pv_one(f32x16& od, int vb, bf16x8 pa0, bf16x8 pa1, bf16x8 pa2, bf16x8 pa3) {
    const s16x4 l0 = tr_read<v_rd_off(D0, 0, 0)>(vb), h0 = tr_read<v_rd_off(D0, 0, 1)>(vb), l1 = tr_read<v_rd_off(D0, 1, 0)>(vb), h1 = tr_read<v_rd_off(D0, 1, 1)>(vb);
    const s16x4 l2 = tr_read<v_rd_off(D0, 2, 0)>(vb), h2 = tr_read<v_rd_off(D0, 2, 1)>(vb), l3 = tr_read<v_rd_off(D0, 3, 0)>(vb), h3 = tr_read<v_rd_off(D0, 3, 1)>(vb);
    asm volatile("s_waitcnt lgkmcnt(0)" ::: "memory"); SBAR();
#define PK(L, H) (bf16x8){L[0], L[1], L[2], L[3], H[0], H[1], H[2], H[3]}
    od = __builtin_amdgcn_mfma_f32_32x32x16_bf16(pa0, PK(l0, h0), od, 0, 0, 0);
    od = __builtin_amdgcn_mfma_f32_32x32x16_bf16(pa1, PK(l1, h1), od, 0, 0, 0);
    od = __builtin_amdgcn_mfma_f32_32x32x16_bf16(pa2, PK(l2, h2), od, 0, 0, 0);
    od = __builtin_amdgcn_mfma_f32_32x32x16_bf16(pa3, PK(l3, h3), od, 0, 0, 0);
#undef PK
}
__device__ __forceinline__ void pv_d0(f32x16* o, int vb, bf16x8 pa0, bf16x8 pa1, bf16x8 pa2, bf16x8 pa3) {
    pv_one<0>(o[0], vb, pa0, pa1, pa2, pa3); pv_one<1>(o[1], vb, pa0, pa1, pa2, pa3); pv_one<2>(o[2], vb, pa0, pa1, pa2, pa3); pv_one<3>(o[3], vb, pa0, pa1, pa2, pa3);
}

template <int DQK, int SDEPTH>
__device__ __forceinline__ void attn_body(const bf16_t* __restrict__ Qb, const bf16_t* __restrict__ Kh, const bf16_t* __restrict__ Vh, bf16_t* __restrict__ Ob, int ldo, int nkeys, float scale, char* lds) {
    constexpr int SHM_V = 64 * 128 * 2, SHM_K = 64 * DQK * 2, NKC = DQK / 8, KPT = NKC / 8;
    int tid = otid();
    const int wid = __builtin_amdgcn_readfirstlane(tid >> 6), lane = tid & 63, r32 = lane & 31, hi = lane >> 5;
    char* V_lds = lds; char* K_lds = lds + 2 * SHM_V;
    float* ws = (float*)(lds + 2 * SHM_V + 2 * SHM_K) + wid * 64; float* li_l = ws; float* al_l = ws + 32;
    const float C = scale * 1.4426950408889634f, thr = 8.0f / scale;
    float m_reg = -1e30f, l_reg = 0; f32x16 o[4] = {}; bf16x8 qr[DQK / 16];
    const bf16_t* Qw = Qb + (long)(wid * 32 + r32) * DQK + hi * 8;
#pragma unroll
    for (int d0 = 0; d0 < DQK / 16; ++d0) qr[d0] = *reinterpret_cast<const bf16x8*>(Qw + d0 * 16);
    const int sr = tid >> 4, sc = (tid & 15) * 8, vst0 = v_st(sr, sc), vst1 = v_st(32 + sr, sc);
    int kgo[KPT], klo[KPT];
#pragma unroll
    for (int i = 0; i < KPT; ++i) { const int q = tid + 512 * i, row = q / NKC, ch = q % NKC; kgo[i] = row * DQK + ch * 8; klo[i] = kaddr<DQK>(row, ch); }
    const int vb0 = (int)(uintptr_t)V_lds + v_rd_base(lane);
    struct { bf16x8 vs0, vs1, ks[KPT]; } sr_[SDEPTH ? SDEPTH : 1];
#define SLOAD(i, k0) do { sr_[i].vs0 = *reinterpret_cast<const bf16x8*>(&Vh[(long)((k0) + sr) * 128 + sc]); sr_[i].vs1 = *reinterpret_cast<const bf16x8*>(&Vh[(long)((k0) + 32 + sr) * 128 + sc]); \
    _Pragma("unroll") for (int _q = 0; _q < KPT; ++_q) sr_[i].ks[_q] = *reinterpret_cast<const bf16x8*>(&Kh[(long)(k0) * DQK + kgo[_q]]); } while (0)
#define SWRITE(b, i) do { *(bf16x8*)(V_lds + (b) * SHM_V + vst0) = sr_[i].vs0; *(bf16x8*)(V_lds + (b) * SHM_V + vst1) = sr_[i].vs1; \
    _Pragma("unroll") for (int _q = 0; _q < KPT; ++_q) *(bf16x8*)(K_lds + (b) * SHM_K + klo[_q]) = sr_[i].ks[_q]; } while (0)
#define SWAIT() do { if constexpr (SDEPTH == 2) { if constexpr (KPT == 2) asm volatile("s_waitcnt vmcnt(4)" ::: "memory"); else asm volatile("s_waitcnt vmcnt(5)" ::: "memory"); } \
    else asm volatile("s_waitcnt vmcnt(0)" ::: "memory"); } while (0)
#define RESC(a) do { if (__any((a) < 1.f)) { if (hi == 0) al_l[r32] = (a); asm volatile("s_waitcnt lgkmcnt(0)" ::: "memory"); \
    _Pragma("unroll") for (int d = 0; d < 4; ++d) _Pragma("unroll") for (int r = 0; r < 16; ++r) o[d][r] *= al_l[crow(r, hi)]; } } while (0)
    bf16x8 pa0, pa1, pa2, pa3; const int NT = nkeys / 64;
    if constexpr (SDEPTH == 0) {
        f32x16 pA0, pA1; float mnA, alA;
        SLOAD(0, 0); asm volatile("s_waitcnt vmcnt(0)" ::: "memory"); SWRITE(0, 0); __syncthreads();
        for (int j = 0; j < NT; ++j) {
            const int bo = j & 1;
            if (j + 1 < NT) SLOAD(0, (j + 1) * 64);
            SBAR(); qkt<DQK>(pA0, pA1, K_lds + bo * SHM_K, qr, r32, hi); partialSM(pA0, pA1, m_reg, mnA, alA, C, thr);
            RESC(alA); finishSM(pA0, pA1, alA, l_reg, pa0, pa1, pa2, pa3); SBAR();
            pv_d0(o, vb0 + bo * SHM_V, pa0, pa1, pa2, pa3);
            if (j + 1 < NT) { asm volatile("s_waitcnt vmcnt(0)" ::: "memory"); SWRITE(bo ^ 1, 0); }
            __syncthreads();
        }
    } else {
    f32x16 pA0, pA1, pB0, pB1; float mnA, mnB, alA, alB;
    constexpr int SE = 0, SO = SDEPTH - 1;
    SLOAD(SE, 0); asm volatile("s_waitcnt vmcnt(0)" ::: "memory"); SWRITE(0, SE); __syncthreads();
    qkt<DQK>(pA0, pA1, K_lds, qr, r32, hi); partialSM(pA0, pA1, m_reg, mnA, alA, C, thr);
    SLOAD(SO, 64); if constexpr (SDEPTH == 2) { if (2 < NT) SLOAD(SE, 2 * 64); }
    SWAIT(); SWRITE(1, SO); __syncthreads();
    for (int j = 1; j + 1 < NT; j += 2) {
        SBAR(); qkt<DQK>(pB0, pB1, K_lds + SHM_K, qr, r32, hi);
        finishSM(pA0, pA1, alA, l_reg, pa0, pa1, pa2, pa3); SBAR();
        SLOAD(SO, (j + SDEPTH) * 64); SBAR();
        pv_d0(o, vb0, pa0, pa1, pa2, pa3); partialSM(pB0, pB1, m_reg, mnB, alB, C, thr);
        __syncthreads(); SWAIT(); SWRITE(0, SE);
        RESC(alB); __syncthreads();
        SBAR(); qkt<DQK>(pA0, pA1, K_lds, qr, r32, hi);
        finishSM(pB0, pB1, alB, l_reg, pa0, pa1, pa2, pa3); SBAR();
        if (SDEPTH == 1 || j + 3 < NT) SLOAD(SE, (j + 1 + SDEPTH) * 64); SBAR();
        pv_d0(o, vb0 + SHM_V, pa0, pa1, pa2, pa3); partialSM(pA0, pA1, m_reg, mnA, alA, C, thr);
        __syncthreads(); SWAIT(); SWRITE(1, SO);
        RESC(alA); __syncthreads();
    }
    SBAR(); qkt<DQK>(pB0, pB1, K_lds + SHM_K, qr, r32, hi);
    finishSM(pA0, pA1, alA, l_reg, pa0, pa1, pa2, pa3); SBAR();
    pv_d0(o, vb0, pa0, pa1, pa2, pa3); partialSM(pB0, pB1, m_reg, mnB, alB, C, thr);
    __syncthreads(); RESC(alB);
    finishSM(pB0, pB1, alB, l_reg, pa0, pa1, pa2, pa3); SBAR();
    pv_d0(o, vb0 + SHM_V, pa0, pa1, pa2, pa3);
    }
    if (hi == 0) li_l[r32] = l_reg; asm volatile("s_waitcnt lgkmcnt(0)" ::: "memory");
    float rli[16];
#pragma unroll
    for (int r = 0; r < 16; ++r) rli[r] = __builtin_amdgcn_rcpf(li_l[crow(r, hi)]);
    bf16_t* Ow = Ob + (long)(wid * 32) * ldo;
#pragma unroll
    for (int r = 0; r < 16; ++r) { const int orow = crow(r, hi);
#pragma unroll
        for (int d0 = 0; d0 < 4; ++d0) Ow[(long)orow * ldo + d0 * 32 + r32] = f2bf(o[d0][r] * rli[r]); }
    __syncthreads();
#undef SLOAD
#undef SWRITE
#undef SWAIT
#undef RESC
}

struct CvtMat { const float* src; bf16_t* dst; const float* kscale; int N, lddst, nb, mode; };
__device__ __forceinline__ void cvt_block(const CvtMat& m, int kb, int nbk, int lane) {
    const int a = lane & 7, ng = lane >> 3, k0 = kb * 64 + 8 * a, n0 = nbk * 32 + 4 * ng;
    const float* s = m.src + (size_t)k0 * m.N + n0;
    f32x4 v[8];
#pragma unroll
    for (int j = 0; j < 8; ++j) v[j] = *(const f32x4*)(s + (size_t)j * m.N);
    if (m.kscale) {
#pragma unroll
        for (int j = 0; j < 8; ++j) v[j] *= m.kscale[k0 + j];
    }
#pragma unroll
    for (int i = 0; i < 4; ++i) { const int n = n0 + i, row = (m.mode == 0) ? n : ((n >> 7) * 256 + (n & 127) + (m.mode - 1) * 128);
        u32x4 w; w.x = pk2(v[0][i], v[1][i]); w.y = pk2(v[2][i], v[3][i]); w.z = pk2(v[4][i], v[5][i]); w.w = pk2(v[6][i], v[7][i]);
        *(u32x4*)(m.dst + (size_t)row * m.lddst + k0) = w; }
}
constexpr int CVT_SMALL = 3904 + 2048 + 432 + 192;
__device__ __forceinline__ void cvt_small_task(const Params& p, int l, int t, int lane) {
    unsigned char* ws = p.ws; CvtMat m;
    if (t < 3904) { m = CvtMat{p.in[I_WIN] + (size_t)l * DM * IN_COLS, (bf16_t*)(ws + O_WIN) + (size_t)l * NP * DM, nullptr, IN_COLS, DM, 122, 0}; }
    else if ((t -= 3904) < 2048) { m = CvtMat{p.in[I_WOUT] + (size_t)l * DM * DM, (bf16_t*)(ws + O_WOUT) + (size_t)l * DM * DM, nullptr, DM, DM, 64, 0}; }
    else if ((t -= 2048) < 432) { m = CvtMat{p.in[I_WUQ] + (size_t)l * 768 * 1152, (bf16_t*)(ws + O_WUQ) + (size_t)l * NQP * 768, p.in[I_MQN] + l * 768, 1152, 768, 36, 0}; }
    else { t -= 432; m = CvtMat{p.in[I_WUKV] + (size_t)l * 256 * 1536, (bf16_t*)(ws + O_WUKV) + (size_t)l * 1536 * 256, p.in[I_MKVN] + l * 256, 1536, 256, 48, 0}; }
    cvt_block(m, t / m.nb, t % m.nb, lane);
}
constexpr int CVT_EXP = 65 * 1536;
__device__ __forceinline__ void cvt_exp_task(const Params& p, int l, int t, int lane) {
    unsigned char* ws = p.ws;
    const int e = t / 1536, r = t % 1536, which = r >> 9, q = r & 511; CvtMat m;
    if (which < 2) {
        const float* src = (e < NEXP) ? p.in[which == 0 ? I_EG : I_EU] + ((size_t)l * NEXP + e) * DM * EH : p.in[which == 0 ? I_SG : I_SU] + (size_t)l * DM * EH;
        m = CvtMat{src, (bf16_t*)(ws + O_EGU) + (size_t)e * 1024 * 2048, nullptr, EH, DM, 16, 1 + which};
    } else {
        const float* src = (e < NEXP) ? p.in[I_EDN] + ((size_t)l * NEXP + e) * EH * DM : p.in[I_SD] + (size_t)l * EH * DM;
        m = CvtMat{src, (bf16_t*)(ws + O_ED) + (size_t)e * 2048 * 512, nullptr, DM, EH, 64, 0};
    }
    cvt_block(m, q / m.nb, q % m.nb, lane);
}
__device__ __forceinline__ void cvt_exp_all(const Params& p, int l) {
    const int lane = otid() & 63, gw = blockIdx.x * 8 + owid(), GW = gridDim.x * 8;
    for (int t = gw; t < CVT_EXP; t += GW) cvt_exp_task(p, l, t, lane);
}
__device__ __forceinline__ void adaln_tasks(const Params& p, LAS float* lf) {
    const int lane = otid() & 63, wid = owid();
    float* MOD = (float*)(p.ws + O_MOD);
    for (int task = blockIdx.x; task < 384; task += gridDim.x) {
        const int cb = task % 192, l = task / 192, col = cb * 64 + lane;
        const float* W = p.in[I_ADAW] + (size_t)l * DM * 12288 + col;
        float acc[9];
#pragma unroll
        for (int r = 0; r < 9; ++r) acc[r] = 0.f;
        for (int kb = wid * 256; kb < wid * 256 + 256; kb += 64) {
            float sv[9];
#pragma unroll
            for (int r = 0; r < 8; ++r) sv[r] = silu_f(p.in[I_C][r * DM + kb + lane]);
            sv[8] = silu_f(p.in[I_CCTX][kb + lane]);
#pragma unroll 8
            for (int kk = 0; kk < 64; ++kk) { const float w = W[(size_t)(kb + kk) * 12288];
#pragma unroll
                for (int r = 0; r < 9; ++r) acc[r] += rdlane(sv[r], kk) * w; }
        }
#pragma unroll
        for (int r = 0; r < 9; ++r) lf[(wid * 9 + r) * 64 + lane] = acc[r];
        __syncthreads();
        for (int r = wid; r < 9; r += 8) { float s = p.in[I_ADAB][l * 12288 + col];
#pragma unroll
            for (int w = 0; w < 8; ++w) s += lf[(w * 9 + r) * 64 + lane];
            MOD[(size_t)(l * 9 + r) * 12288 + col] = s; }
        __syncthreads();
    }
}
__device__ __forceinline__ void hss_tasks(const Params& p) {
    const int lane = otid() & 63, gw = blockIdx.x * 8 + owid(), GW = gridDim.x * 8;
    for (int task = gw; task < 3 * 1024; task += GW) {
        const int set = task >> 10, l = (set == 1) ? 1 : 0, nset = (set == 2) ? 1 : 0, ord = (task >> 9) & 1, ch = task & 511, n = nset ? 256 : 2048;
        const float* HF = (const float*)(p.ws + O_HF) + (size_t)l * HF_LAYER + (nset ? HF_L0 : 0);
        const float* hf = HF + (size_t)((ord * 2 + 0) * 512 + ch) * n; const float* hb = HF + (size_t)((ord * 2 + 1) * 512 + ch) * n;
        float s = 0.f;
        for (int i = lane; i < n; i += 64) { const float a = hf[i], b = (i == 0) ? 0.f : hb[i]; s += a * a + b * b; }
        s = wave_sum(s);
        if (lane == 0) ((float*)(p.ws + O_HSS))[(size_t)((l * 2 + nset) * 2 + ord) * 512 + ch] = s;
    }
}
__device__ __forceinline__ void hyf_task(const Params& p, int l, int nset, int i0, LAS float* lf) {
    int tid = otid(); const int n = nset ? 256 : 2048;
    LAS float* feats = lf; LAS float* hd1 = lf + 8 * 33; LAS float* hd2 = hd1 + 512;
    if (tid < 8 * 33) { const int pos = tid / 33, f = tid % 33, i = i0 + pos; const float t = (float)i / (float)(n - 1), ang = 6.283185307179586f * (float)i / (float)n; float v;
        if (f == 0) v = t; else { const int j = (f - 1) & 15; const float band = 1e-4f + (float)j * ((15.0f - 1e-4f) / 15.0f); v = (f <= 16) ? cosf(ang * band) : sinf(ang * band); }
        feats[tid] = v; }
    __syncthreads();
    { const int pos = tid >> 6, j = tid & 63; const float* w1 = p.in[I_HYW1] + l * 33 * 64; float s = p.in[I_HYB1][l * 64 + j];
      for (int f = 0; f < 33; ++f) s += feats[pos * 33 + f] * w1[f * 64 + j];
      hd1[tid] = sinf(p.in[I_HYFREQ][l * 64 + j] * s); }
    __syncthreads();
    { const int pos = tid >> 6, j = tid & 63; const float* w2 = p.in[I_HYW2] + l * 64 * 64; float s = p.in[I_HYB2][l * 64 + j];
      for (int f = 0; f < 64; ++f) s += hd1[pos * 64 + f] * w2[f * 64 + j];
      hd2[tid] = sinf(p.in[I_HYFREQ][l * 64 + j] * s); }
    __syncthreads();
    const float* w3 = p.in[I_HYW3] + (size_t)l * 64 * 2048 + tid * 4;
    f32x4 acc[8];
#pragma unroll
    for (int q = 0; q < 8; ++q) acc[q] = (f32x4){0.f, 0.f, 0.f, 0.f};
    for (int j = 0; j < 64; ++j) { const f32x4 w = *(const f32x4*)(w3 + (size_t)j * 2048);
#pragma unroll
        for (int q = 0; q < 8; ++q) acc[q] += w * hd2[q * 64 + j]; }
    float* HF = (float*)(p.ws + O_HF) + (size_t)l * HF_LAYER + (nset ? HF_L0 : 0);
#pragma unroll
    for (int c = 0; c < 4; ++c) { const int col = tid * 4 + c, ord = col >> 10, dir = (col >> 9) & 1, ch = col & 511;
        const float delta = 3.0701134573253944f + (float)ch * ((15.350567286626973f - 3.0701134573253944f) / 511.0f); float v[8];
#pragma unroll
        for (int q = 0; q < 8; ++q) { const int i = i0 + q; const float t = (float)i / (float)(n - 1); v[q] = acc[q][c] * __expf(-t * delta); }
        float* dst = HF + (size_t)((ord * 2 + dir) * 512 + ch) * n + i0;
        *(f32x4*)dst = (f32x4){v[0], v[1], v[2], v[3]}; *(f32x4*)(dst + 4) = (f32x4){v[4], v[5], v[6], v[7]};    }
    __syncthreads();
}
__device__ __forceinline__ void phase_prologue(const Params& p, LAS unsigned char* lds) {
    const int tid = otid(); LAS float* lf = (LAS float*)lds;
    { const size_t gt = (size_t)blockIdx.x * NTHREADS + tid, GT = (size_t)gridDim.x * NTHREADS;
      for (int l = 0; l < NLAYER; ++l) {
          u32x4* z1 = (u32x4*)((bf16_t*)(p.ws + O_WIN) + ((size_t)l * NP + IN_COLS) * DM); const size_t n1 = (size_t)(NP - IN_COLS) * DM * 2 / 16;
          for (size_t i = gt; i < n1; i += GT) z1[i] = (u32x4){0u, 0u, 0u, 0u};
          u32x4* z2 = (u32x4*)((bf16_t*)(p.ws + O_WUQ) + ((size_t)l * NQP + 1152) * 768); const size_t n2 = (size_t)(NQP - 1152) * 768 * 2 / 16;
          for (size_t i = gt; i < n2; i += GT) z2[i] = (u32x4){0u, 0u, 0u, 0u};
      } }
    adaln_tasks(p, lf);
    for (int t = blockIdx.x; t < 544; t += gridDim.x) { if (t < 512) hyf_task(p, t >> 8, 0, (t & 255) * 8, lf); else hyf_task(p, 0, 1, (t - 512) * 8, lf); }
    { const int lane = tid & 63, gw = blockIdx.x * 8 + owid(), GW = gridDim.x * 8;
      for (int t = gw; t < NLAYER * CVT_SMALL; t += GW) cvt_small_task(p, t / CVT_SMALL, t % CVT_SMALL, lane); }
    cvt_exp_all(p, 0);
}

__device__ __forceinline__ void norm1_row(const Params& p, int l, int row, const float (&x)[32], int lane) {
    float ss = 0.f;
#pragma unroll
    for (int i = 0; i < 32; ++i) ss += x[i] * x[i];
    ss = wave_sum(ss); const float rstd = rsqrtf(ss * (1.0f / DM) + EPS);
    const float* g = p.in[I_NORMG] + (size_t)(l * 4 + 0) * DM; const float* mod = (const float*)(p.ws + O_MOD) + (size_t)(l * 9 + row_batch(row)) * 12288;
    bf16_t* H = (bf16_t*)(p.ws + O_H) + (size_t)row * DM;
#pragma unroll
    for (int j = 0; j < 8; ++j) { const int c = ROWCOL(j, lane); const f32x4 gv = *(const f32x4*)(g + c), sh = *(const f32x4*)(mod + c), sc = *(const f32x4*)(mod + DM + c); float h[4];
#pragma unroll
        for (int q = 0; q < 4; ++q) h[q] = x[j * 4 + q] * rstd * gv[q] * (1.0f + sc[q]) + sh[q];
        u32x2 w; w.x = pk2(h[0], h[1]); w.y = pk2(h[2], h[3]); *(u32x2*)(H + c) = w; }
}
__device__ __forceinline__ void phase_norm1(const Params& p, int l) {
    const int lane = otid() & 63, gw = blockIdx.x * 8 + owid(), GW = gridDim.x * 8;
    const int lane0 = lane;
    for (int row = gw; row < NTOK; row += GW) { int lane = lane0; asm volatile("" : "+v"(lane)); const float* src = resid_src(p, l, row); float x[32];
#pragma unroll
        for (int j = 0; j < 8; ++j) { const f32x4 v = *(const f32x4*)(src + ROWCOL(j, lane)); x[j * 4] = v[0]; x[j * 4 + 1] = v[1]; x[j * 4 + 2] = v[2]; x[j * 4 + 3] = v[3]; }
        norm1_row(p, l, row, x, lane); }
}

template <int HALF> __device__ __forceinline__ float rope1(float x, int e, float a) {
    float s, c; sincosf(a, &s, &c); const float pr = __shfl_xor(x, HALF);
    return (e & HALF) ? pr * s + x * c : x * c - pr * s;
}
__device__ __forceinline__ void gqa_post_row(const Params& p, int l, int row, int lane) {
    const bf16_t* P = (const bf16_t*)(p.ws + O_P) + (size_t)row * NP;
    const bool isctx = row >= NLAT; const int b = isctx ? (row - NLAT) >> 8 : row >> 11, t = isctx ? (row - NLAT) & 255 : row & 2047;
    const float inv = exp2f(-(float)(lane & 31) * (13.287712379549449f / 32.0f));
    const float a0 = (float)(t >> 6) * inv, a1 = (float)(t & 63) * inv;
    const float* qn = p.in[I_GQN] + l * 128; const float* kn = p.in[I_GKN] + l * 128;
    for (int h = 0; h < 6; ++h) {
        float x0 = bf2f(P[C_GQ + h * 128 + lane]), x1 = bf2f(P[C_GQ + h * 128 + 64 + lane]);
        const float rstd = rsqrtf(wave_sum(x0 * x0 + x1 * x1) * (1.0f / 128.0f) + EPS);
        x0 *= rstd * qn[lane]; x1 *= rstd * qn[64 + lane];
        if (!isctx) { x0 = rope1<32>(x0, lane, a0); x1 = rope1<32>(x1, lane, a1); }
        bf16_t* dst = isctx ? (bf16_t*)(p.ws + O_QGC) + ((size_t)(b * 6 + h) * CTXL + t) * 128 : (bf16_t*)(p.ws + O_QG) + ((size_t)(b * 6 + h) * SEQ + t) * 128;
        dst[lane] = f2bf(x0); dst[64 + lane] = f2bf(x1);
    }
    const int kpos = isctx ? t : CTXL + t;
    for (int h = 0; h < 2; ++h) {
        float x0 = bf2f(P[C_GK + h * 128 + lane]), x1 = bf2f(P[C_GK + h * 128 + 64 + lane]);
        const float rstd = rsqrtf(wave_sum(x0 * x0 + x1 * x1) * (1.0f / 128.0f) + EPS);
        x0 *= rstd * kn[lane]; x1 *= rstd * kn[64 + lane];
        if (!isctx) { x0 = rope1<32>(x0, lane, a0); x1 = rope1<32>(x1, lane, a1); }
        bf16_t* kd = (bf16_t*)(p.ws + O_KG) + ((size_t)(b * 2 + h) * LK + kpos) * 128; kd[lane] = f2bf(x0); kd[64 + lane] = f2bf(x1);
        bf16_t* vd = (bf16_t*)(p.ws + O_VG) + ((size_t)(b * 2 + h) * LK + kpos) * 128; vd[lane] = P[C_GV + h * 128 + lane]; vd[64 + lane] = P[C_GV + h * 128 + 64 + lane];
    }
}
__device__ __forceinline__ void seq_of(int row, int& s0, int& n) { if (row < NLAT) { s0 = row & ~2047; n = SEQ; } else { s0 = NLAT + ((row - NLAT) & ~255); n = CTXL; } }
__device__ __forceinline__ void load_conv_tile(const bf16_t* P, int t0, int pc0, LAS float* u) {
    int s0, n; seq_of(t0, s0, n);
    for (int i = otid(); i < 66 * 64; i += NTHREADS) { const int r = i >> 6, c = i & 63, row = t0 - 1 + r;
        u[r * 65 + c] = (row >= s0 && row < s0 + n) ? bf2f(P[(size_t)row * NP + pc0 + c]) : 0.f; }
}
__device__ __forceinline__ void hy_prep_task(const Params& p, int l, int t0, int c0, LAS float* u) {
    const bf16_t* P = (const bf16_t*)(p.ws + O_P);
    load_conv_tile(P, t0, c0, u);
    __syncthreads();
    const int tid = otid(), c = tid >> 3, tc = (tid & 7) * 8; const float* cw = p.in[I_HYCONV] + (size_t)l * 3 * 1536 + c0 + c;
    const float w0 = cw[0], w1 = cw[1536], w2 = cw[3072]; float y[8];
#pragma unroll
    for (int j = 0; j < 8; ++j) y[j] = w0 * u[(tc + j) * 65 + c] + w1 * u[(tc + j + 1) * 65 + c] + w2 * u[(tc + j + 2) * 65 + c];
    const int ch = c0 + c; bf16_t* dst = (ch < 512 ? (bf16_t*)(p.ws + O_VT) + (size_t)ch * NTOK : (bf16_t*)(p.ws + O_X1T) + (size_t)(ch - 512) * NTOK) + t0 + tc;
    u32x4 w; w.x = pk2(y[0], y[1]); w.y = pk2(y[2], y[3]); w.z = pk2(y[4], y[5]); w.w = pk2(y[6], y[7]); *(u32x4*)dst = w;
    __syncthreads();
}
__device__ __forceinline__ void mla_post_row(const Params& p, int l, int row, int lane) {
    const bf16_t* P = (const bf16_t*)(p.ws + O_P) + (size_t)row * NP;
    const bool isctx = row >= NLAT; const int b = isctx ? (row - NLAT) >> 8 : row >> 11, t = isctx ? (row - NLAT) & 255 : row & 2047;
    float sq = 0.f, skv = 0.f;
#pragma unroll
    for (int j = 0; j < 12; ++j) { const float v = bf2f(P[C_CQ + j * 64 + lane]); sq += v * v; }
#pragma unroll
    for (int j = 0; j < 4; ++j) { const float v = bf2f(P[C_CKV + j * 64 + lane]); skv += v * v; }
    const float rq = rsqrtf(wave_sum(sq) * (1.0f / 768.0f) + EPS), rkv = rsqrtf(wave_sum(skv) * (1.0f / 256.0f) + EPS);
    const int half = lane >> 5, e = lane & 31;
    const float inv = exp2f(-(float)(e & 15) * (13.287712379549449f / 16.0f));
    const float ang = (float)(half ? (t & 63) : (t >> 6)) * inv;
    const bf16_t* QR = (const bf16_t*)(p.ws + O_QRAW) + (size_t)row * NQP; const bf16_t* KV = (const bf16_t*)(p.ws + O_KVRAW) + (size_t)row * 1536;
    float kr = bf2f(P[C_KR + lane]); if (!isctx) kr = rope1<16>(kr, e, ang);
    const bf16_t krb = f2bf(kr); const int kpos = isctx ? t : CTXL + t;
    for (int h = 0; h < 6; ++h) {
        bf16_t* qd = isctx ? (bf16_t*)(p.ws + O_QMC) + ((size_t)(b * 6 + h) * CTXL + t) * 192 : (bf16_t*)(p.ws + O_QM) + ((size_t)(b * 6 + h) * SEQ + t) * 192;
        qd[lane] = f2bf(bf2f(QR[h * 192 + lane]) * rq); qd[64 + lane] = f2bf(bf2f(QR[h * 192 + 64 + lane]) * rq);
        float qr = bf2f(QR[h * 192 + 128 + lane]) * rq; if (!isctx) qr = rope1<16>(qr, e, ang);
        qd[128 + lane] = f2bf(qr);
        bf16_t* kd = (bf16_t*)(p.ws + O_KM) + ((size_t)(b * 6 + h) * LK + kpos) * 192;
        kd[lane] = f2bf(bf2f(KV[h * 256 + lane]) * rkv); kd[64 + lane] = f2bf(bf2f(KV[h * 256 + 64 + lane]) * rkv); kd[128 + lane] = krb;
        bf16_t* vd = (bf16_t*)(p.ws + O_VM) + ((size_t)(b * 6 + h) * LK + kpos) * 128;
        vd[lane] = f2bf(bf2f(KV[h * 256 + 128 + lane]) * rkv); vd[64 + lane] = f2bf(bf2f(KV[h * 256 + 192 + lane]) * rkv);
    }
}

__device__ __forceinline__ void hyconv_unit_valu(const Params& p, int l, int nset, int c, LAS float* lf) {
    const int tid = otid(), n = nset ? CTXL : SEQ, tokbase = nset ? NLAT : 0;
    LAS float* kc = lf; LAS float* z = lf + 4096; LAS float* z2 = z + 8 * SEQ;
    const float* HF = (const float*)(p.ws + O_HF) + (size_t)l * HF_LAYER + (nset ? HF_L0 : 0); const float* HSS = (const float*)(p.ws + O_HSS) + (size_t)((l * 2 + nset) * 2) * 512;
    const bf16_t* VT = (const bf16_t*)(p.ws + O_VT) + (size_t)c * NTOK + tokbase; const bf16_t* X1T = (const bf16_t*)(p.ws + O_X1T) + (size_t)c * NTOK + tokbase;
    bf16_t* Y2T = (bf16_t*)(p.ws + O_Y2T) + (size_t)c * NTOK + tokbase;
    for (int i = tid; i < 8 * n; i += NTHREADS) z[i] = bf2f(VT[i]);
    for (int ord = 0; ord < 2; ++ord) {
        const float rs = rsqrtf(HSS[ord * 512 + c] + EPS); const float* hf = HF + (size_t)((ord * 2 + 0) * 512 + c) * n; const float* hb = HF + (size_t)((ord * 2 + 1) * 512 + c) * n;
        for (int m = tid; m < 2 * n; m += NTHREADS) { const int lag = m - (n - 1); kc[m] = (m == 2 * n - 1) ? 0.f : (lag >= 0 ? hf[lag] : hb[-lag]) * rs; }
        __syncthreads();
        const LAS float* zs = ord ? z2 : z; const float skip = p.in[I_HYSKIP][(size_t)(l * 2 + ord) * 512 + c];
        for (int q = tid; q < n; q += NTHREADS) {
            const int b = q / (n >> 3), t0 = (q % (n >> 3)) * 8; float acc[8];
#pragma unroll
            for (int j = 0; j < 8; ++j) acc[j] = 0.f;
            const LAS float* zb = zs + b * n;
            for (int sb = 0; sb < n; sb += 8) {
                const LAS float* kb = kc + (t0 - sb + n - 8); float w[16];
#pragma unroll
                for (int i = 0; i < 4; ++i) { const f32x4 v = *(const LAS f32x4*)(kb + 4 * i); w[4 * i] = v[0]; w[4 * i + 1] = v[1]; w[4 * i + 2] = v[2]; w[4 * i + 3] = v[3]; }
                const f32x4 za = *(const LAS f32x4*)(zb + sb), zc = *(const LAS f32x4*)(zb + sb + 4); const float zv[8] = {za[0], za[1], za[2], za[3], zc[0], zc[1], zc[2], zc[3]};
#pragma unroll
                for (int ss = 0; ss < 8; ++ss)
#pragma unroll
                    for (int j = 0; j < 8; ++j) acc[j] += w[j - ss + 7] * zv[ss];
            }
            if (ord == 0) {
#pragma unroll
                for (int j = 0; j < 8; ++j) { const int idx = b * n + t0 + j; z2[idx] = bf2f(X1T[idx]) * (acc[j] + skip * z[idx]); }
            } else { float y[8];
#pragma unroll
                for (int j = 0; j < 8; ++j) y[j] = acc[j] + skip * z2[b * n + t0 + j];
                u32x4 w; w.x = pk2(y[0], y[1]); w.y = pk2(y[2], y[3]); w.z = pk2(y[4], y[5]); w.w = pk2(y[6], y[7]); *(u32x4*)(Y2T + b * n + t0) = w; }
        }
        __syncthreads();
    }
}
constexpr int HC_COPYB = 8256, HC_ROWB = 4560, HC_PAD = 112, HC_KR = 4112, HC_M0 = 2064;
constexpr int HC_ZOFF = 8 * HC_COPYB, HC_Z2OFF = HC_ZOFF + 8 * HC_ROWB;
__device__ __forceinline__ void hyconv_unit_mfma(const Params& p, int l, int c, LAS unsigned char* lds) {
    const int tid = otid(), wid = __builtin_amdgcn_readfirstlane(tid >> 6), lane = tid & 63;
    LAS unsigned char* CP = lds; LAS unsigned char* Zr = lds + HC_ZOFF; LAS unsigned char* Z2r = lds + HC_Z2OFF;
    const float* HF = (const float*)(p.ws + O_HF) + (size_t)l * HF_LAYER; const float* HSS = (const float*)(p.ws + O_HSS) + (size_t)(l * 4) * 512;
    const bf16_t* VT = (const bf16_t*)(p.ws + O_VT) + (size_t)c * NTOK; const bf16_t* X1T = (const bf16_t*)(p.ws + O_X1T) + (size_t)c * NTOK; bf16_t* Y2T = (bf16_t*)(p.ws + O_Y2T) + (size_t)c * NTOK;
    for (int q = tid; q < 8 * 256; q += NTHREADS) { const int b = q >> 8, ch = q & 255; *(LAS u32x4*)(Zr + b * HC_ROWB + (HC_PAD + ch * 8) * 2) = *(const u32x4*)(VT + b * SEQ + ch * 8); }
    for (int q = tid; q < 8 * 29; q += NTHREADS) { const int b = q / 29, ch = q % 29; const int e0 = ch < 14 ? ch * 8 : HC_PAD + SEQ + (ch - 14) * 8; *(LAS u32x4*)(Zr + b * HC_ROWB + e0 * 2) = (u32x4){0u, 0u, 0u, 0u}; }
    const int a = lane & 31, kg = lane >> 5, bq = a >> 2, isub = a & 3;
    const int Aoff = (a & 7) * HC_COPYB + (HC_M0 - 8 * (a >> 3) + 8 * kg) * 2;
    const int g0 = 2 * wid;
    const int Boff = bq * HC_ROWB + (HC_PAD + 128 * g0 + 32 * isub + 8 * kg) * 2;
    for (int ord = 0; ord < 2; ++ord) {
        LAS float* kr = (LAS float*)(ord == 0 ? Z2r : Zr);
        { const float rs = rsqrtf(HSS[ord * 512 + c] + EPS); const float* hf = HF + (size_t)((ord * 2 + 0) * 512 + c) * SEQ; const float* hb = HF + (size_t)((ord * 2 + 1) * 512 + c) * SEQ;
          for (int m = tid; m < HC_KR; m += NTHREADS) { const int lag = HC_M0 - m; float v = 0.f; if (lag >= 0 && lag < SEQ) v = hf[lag] * rs; else if (lag < 0 && lag > -SEQ) v = hb[-lag] * rs; kr[m] = v; } }
        __syncthreads();
        for (int q = tid; q < 8 * 516; q += NTHREADS) { const int sft = q / 516, ch = q % 516; float v[8];
#pragma unroll
            for (int j = 0; j < 8; ++j) { const int m = ch * 8 + j - sft; v[j] = (m >= 0 && m < HC_KR) ? kr[m] : 0.f; }
            u32x4 w; w.x = pk2(v[0], v[1]); w.y = pk2(v[2], v[3]); w.z = pk2(v[4], v[5]); w.w = pk2(v[6], v[7]); *(LAS u32x4*)(CP + sft * HC_COPYB + ch * 16) = w; }
        __syncthreads();
        if (ord == 0) for (int q = tid; q < 8 * 29; q += NTHREADS) { const int b = q / 29, ch = q % 29; const int e0 = ch < 14 ? ch * 8 : HC_PAD + SEQ + (ch - 14) * 8; *(LAS u32x4*)(Z2r + b * HC_ROWB + e0 * 2) = (u32x4){0u, 0u, 0u, 0u}; }
        const LAS unsigned char* Zs = ord ? Z2r : Zr;
        f32x16 acc0 = {}, acc1 = {};
        const int e_lo = 16 * wid - 127, e_mid0 = 16 * wid - 119, e_mid1 = 16 * wid + 7, e_hi = 16 * wid + 15;
        for (int e = e_lo; e < e_mid0; ++e) { const bf16x8 A = *(const LAS bf16x8*)(CP + Aoff - 32 * e); const bf16x8 B0 = *(const LAS bf16x8*)(Zs + Boff - 32 * e);
            acc0 = __builtin_amdgcn_mfma_f32_32x32x16_bf16(A, B0, acc0, 0, 0, 0); }
#pragma unroll 2
        for (int e = e_mid0; e <= e_mid1; ++e) { const bf16x8 A = *(const LAS bf16x8*)(CP + Aoff - 32 * e); const bf16x8 B0 = *(const LAS bf16x8*)(Zs + Boff - 32 * e); const bf16x8 B1 = *(const LAS bf16x8*)(Zs + Boff + 256 - 32 * e);
            acc0 = __builtin_amdgcn_mfma_f32_32x32x16_bf16(A, B0, acc0, 0, 0, 0); acc1 = __builtin_amdgcn_mfma_f32_32x32x16_bf16(A, B1, acc1, 0, 0, 0); }
        for (int e = e_mid1 + 1; e <= e_hi; ++e) { const bf16x8 A = *(const LAS bf16x8*)(CP + Aoff - 32 * e); const bf16x8 B1 = *(const LAS bf16x8*)(Zs + Boff + 256 - 32 * e);
            acc1 = __builtin_amdgcn_mfma_f32_32x32x16_bf16(A, B1, acc1, 0, 0, 0); }
        const float skip = p.in[I_HYSKIP][(size_t)(l * 2 + ord) * 512 + c];
#pragma unroll
        for (int gi = 0; gi < 2; ++gi) {
#pragma unroll
            for (int q = 0; q < 4; ++q) { const int t = 128 * (g0 + gi) + 32 * isub + 8 * q + 4 * kg; float y[4];
#pragma unroll
                for (int j = 0; j < 4; ++j) y[j] = gi ? acc1[4 * q + j] : acc0[4 * q + j];
                const u32x2 zz = *(const LAS u32x2*)(Zs + bq * HC_ROWB + (HC_PAD + t) * 2);
                const float z0 = __uint_as_float(zz.x << 16), z1 = __uint_as_float(zz.x & 0xffff0000u), z2 = __uint_as_float(zz.y << 16), z3 = __uint_as_float(zz.y & 0xffff0000u);
                y[0] += skip * z0; y[1] += skip * z1; y[2] += skip * z2; y[3] += skip * z3;
                if (ord == 0) { const u32x2 xx = *(const u32x2*)(X1T + bq * SEQ + t);
                    y[0] *= __uint_as_float(xx.x << 16); y[1] *= __uint_as_float(xx.x & 0xffff0000u); y[2] *= __uint_as_float(xx.y << 16); y[3] *= __uint_as_float(xx.y & 0xffff0000u);
                    u32x2 w; w.x = pk2(y[0], y[1]); w.y = pk2(y[2], y[3]); *(LAS u32x2*)(Z2r + bq * HC_ROWB + (HC_PAD + t) * 2) = w; }
                else { u32x2 w; w.x = pk2(y[0], y[1]); w.y = pk2(y[2], y[3]); *(u32x2*)(Y2T + bq * SEQ + t) = w; } }
        }
        __syncthreads();
    }
}
__device__ __forceinline__ void hy_fin_task(const Params& p, int l, int t0, int c0, LAS float* u) {
    const bf16_t* P = (const bf16_t*)(p.ws + O_P); LAS float* y = u + 66 * 65;
    load_conv_tile(P, t0, 1024 + c0, u);
    const int tid = otid();
    { const int c = tid >> 3, tc = (tid & 7) * 8; const u32x4 v = *(const u32x4*)((const bf16_t*)(p.ws + O_Y2T) + (size_t)(c0 + c) * NTOK + t0 + tc);
#pragma unroll
      for (int j = 0; j < 4; ++j) { y[c * 65 + tc + 2 * j] = __uint_as_float(v[j] << 16); y[c * 65 + tc + 2 * j + 1] = __uint_as_float(v[j] & 0xffff0000u); } }
    __syncthreads();
    { const int t = tid >> 3, cc = (tid & 7) * 8; const float* cw = p.in[I_HYCONV] + (size_t)l * 3 * 1536 + 1024 + c0 + cc; float o[8];
#pragma unroll
      for (int j = 0; j < 8; ++j) { const int c = cc + j; const float x2 = cw[j] * u[t * 65 + c] + cw[1536 + j] * u[(t + 1) * 65 + c] + cw[3072 + j] * u[(t + 2) * 65 + c]; o[j] = x2 * y[c * 65 + t]; }
      u32x4 w; w.x = pk2(o[0], o[1]); w.y = pk2(o[2], o[3]); w.z = pk2(o[4], o[5]); w.w = pk2(o[6], o[7]);
      *(u32x4*)((bf16_t*)(p.ws + O_MIX) + (size_t)(t0 + t) * DM + c0 + cc) = w; }
    __syncthreads();
}

__device__ __forceinline__ void mla_unit(const Params& p, int b, int h, int qb, bool ctxq, LAS unsigned char* lds) {
    unsigned char* ws = p.ws;
    const bf16_t* Q = ctxq ? (const bf16_t*)(ws + O_QMC) + (size_t)(b * 6 + h) * CTXL * 192 : (const bf16_t*)(ws + O_QM) + ((size_t)(b * 6 + h) * SEQ + qb * 256) * 192;
    bf16_t* O = (bf16_t*)(ws + O_MIX) + (size_t)(ctxq ? NLAT + b * CTXL : b * SEQ + qb * 256) * DM + 512 + h * 128;
    attn_body<192, 0>(Q, (const bf16_t*)(ws + O_KM) + (size_t)(b * 6 + h) * LK * 192, (const bf16_t*)(ws + O_VM) + (size_t)(b * 6 + h) * LK * 128, O, DM, ctxq ? CTXL : LK, 0.07216878364870322f, (char*)lds);
}
__device__ __forceinline__ void gqa_unit(const Params& p, int b, int h, int qb, bool ctxq, LAS unsigned char* lds) {
    unsigned char* ws = p.ws;
    const bf16_t* Q = ctxq ? (const bf16_t*)(ws + O_QGC) + (size_t)(b * 6 + h) * CTXL * 128 : (const bf16_t*)(ws + O_QG) + ((size_t)(b * 6 + h) * SEQ + qb * 256) * 128;
    bf16_t* O = (bf16_t*)(ws + O_MIX) + (size_t)(ctxq ? NLAT + b * CTXL : b * SEQ + qb * 256) * DM + 1280 + h * 128;
    attn_body<128, GQA_SD>(Q, (const bf16_t*)(ws + O_KG) + (size_t)(b * 2 + h / 3) * LK * 128, (const bf16_t*)(ws + O_VG) + (size_t)(b * 2 + h / 3) * LK * 128, O, DM, ctxq ? CTXL : LK, 0.08838834764831845f, (char*)lds);
}
__device__ __forceinline__ void phase_mixer(const Params& p, int l, LAS unsigned char* lds) {
    const int G = gridDim.x, bid = blockIdx.x; const bool last = (l == NLAYER - 1);
    for (int u = bid; u < 384 + (last ? 0 : 48); u += G) { if (u < 384) mla_unit(p, u / 48, (u >> 3) % 6, u & 7, false, lds); else mla_unit(p, (u - 384) / 6, (u - 384) % 6, 0, true, lds); }
    for (int u = (bid + G / 2) % G; u < 384 + (last ? 0 : 48); u += G) { if (u < 384) gqa_unit(p, u / 48, (u >> 3) % 6, u & 7, false, lds); else gqa_unit(p, (u - 384) / 6, (u - 384) % 6, 0, true, lds); }
#ifndef CONV_REP
#define CONV_REP 1
#endif
    for (int rep = 0; rep < CONV_REP; ++rep) {
#if HY_MFMA
    for (int u = bid; u < 512; u += G) hyconv_unit_mfma(p, l, u, lds);
    if (!last) for (int u = bid; u < 512; u += G) hyconv_unit_valu(p, l, 1, u, (LAS float*)lds);
#else
    for (int u = bid; u < (last ? 512 : 1024); u += G) hyconv_unit_valu(p, l, u >> 9, u & 511, (LAS float*)lds);
#endif
    }
}

__device__ __forceinline__ void phase_route(const Params& p, int l, LAS unsigned char* lds) {
    const int tid = otid(), wid = __builtin_amdgcn_readfirstlane(tid >> 6), lane = tid & 63; const bool last = (l == NLAYER - 1); const int NR = last ? NLAT : NTOK;
    LAS float* frow = (LAS float*)lds; LAS float* part = frow + 8 * DM;
    const float* g1 = p.in[I_NORMG] + (size_t)(l * 4 + 1) * DM; const float* g2 = p.in[I_NORMG] + (size_t)(l * 4 + 2) * DM;
    const float* RW = p.in[I_RW] + (size_t)l * DM * NEXP; unsigned* cnt = (unsigned*)(p.ws + O_CTL) + CW_CNT + l * 64;
    { int* stok = (int*)(p.ws + O_STOK); for (int i = blockIdx.x * NTHREADS + tid; i < NSLOTS; i += gridDim.x * NTHREADS) stok[i] = (i < RSLOTS) ? -1 : ((i - RSLOTS) < NR ? i - RSLOTS : -1); }
    const int lane0 = lane;
    for (int g = blockIdx.x; g < NR / 8; g += gridDim.x) {
        int lane = lane0; asm volatile("" : "+v"(lane));
        const int row = g * 8 + wid; const float* mod = (const float*)(p.ws + O_MOD) + (size_t)(l * 9 + row_batch(row)) * 12288;
        { const bf16_t* O = (const bf16_t*)(p.ws + O_OUT) + (size_t)row * DM; const float* rs = resid_src(p, l, row); float* X = (float*)(p.ws + O_X) + (size_t)row * DM; bf16_t* H = (bf16_t*)(p.ws + O_H) + (size_t)row * DM;
          float o[32], x[32]; float ss = 0.f;
#pragma unroll
          for (int j = 0; j < 8; ++j) { const u32x2 v = *(const u32x2*)(O + ROWCOL(j, lane)); o[j * 4] = __uint_as_float(v.x << 16); o[j * 4 + 1] = __uint_as_float(v.x & 0xffff0000u); o[j * 4 + 2] = __uint_as_float(v.y << 16); o[j * 4 + 3] = __uint_as_float(v.y & 0xffff0000u); }
#pragma unroll
          for (int i = 0; i < 32; ++i) ss += o[i] * o[i];
          const float r1 = rsqrtf(wave_sum(ss) * (1.0f / DM) + EPS); float s2 = 0.f;
#pragma unroll
          for (int j = 0; j < 8; ++j) { const int c = ROWCOL(j, lane); const f32x4 xv = *(const f32x4*)(rs + c), gv = *(const f32x4*)(g1 + c), ga = *(const f32x4*)(mod + 2 * DM + c); f32x4 xn;
#pragma unroll
              for (int q = 0; q < 4; ++q) { xn[q] = xv[q] + ga[q] * (o[j * 4 + q] * r1 * gv[q]); x[j * 4 + q] = xn[q]; s2 += xn[q] * xn[q]; }
              *(f32x4*)(X + c) = xn; }
          const float r2 = rsqrtf(wave_sum(s2) * (1.0f / DM) + EPS);
#pragma unroll
          for (int j = 0; j < 8; ++j) { const int c = ROWCOL(j, lane); const f32x4 gv = *(const f32x4*)(g2 + c), sh = *(const f32x4*)(mod + 3 * DM + c), sc = *(const f32x4*)(mod + 4 * DM + c); f32x4 f;
#pragma unroll
              for (int q = 0; q < 4; ++q) f[q] = x[j * 4 + q] * r2 * gv[q] * (1.0f + sc[q]) + sh[q];
              u32x2 w; w.x = pk2(f[0], f[1]); w.y = pk2(f[2], f[3]); *(u32x2*)(H + c) = w; *(LAS f32x4*)(frow + wid * DM + c) = f; } }
        __syncthreads();
        { float acc[8];
#pragma unroll
          for (int r = 0; r < 8; ++r) acc[r] = 0.f;
          for (int k = wid * 256; k < wid * 256 + 256; k += 4) { const float w0 = RW[(size_t)k * 64 + lane], w1 = RW[(size_t)(k + 1) * 64 + lane], w2 = RW[(size_t)(k + 2) * 64 + lane], w3 = RW[(size_t)(k + 3) * 64 + lane];
#pragma unroll
              for (int r = 0; r < 8; ++r) { const f32x4 fv = *(const LAS f32x4*)(frow + r * DM + k); acc[r] += fv[0] * w0 + fv[1] * w1 + fv[2] * w2 + fv[3] * w3; } }
#pragma unroll
          for (int r = 0; r < 8; ++r) part[(wid * 8 + r) * 64 + lane] = acc[r]; }
        __syncthreads();
        { float logit = 0.f;
#pragma unroll
          for (int w = 0; w < 8; ++w) logit += part[(w * 8 + wid) * 64 + lane];
          const float score = 1.0f / (1.0f + expf(-logit)), biased = score + p.in[I_RB][l * 64 + lane];
          float m1 = biased; m1 = fmaxf(m1, __shfl_xor(m1, 1)); m1 = fmaxf(m1, __shfl_xor(m1, 2)); m1 = fmaxf(m1, __shfl_xor(m1, 4));
          const unsigned long long bal = __ballot(biased == m1); const int first = __builtin_ctz((unsigned)((bal >> (lane & ~7)) & 0xffull));
          float m2 = ((lane & 7) == first) ? -INFINITY : biased; m2 = fmaxf(m2, __shfl_xor(m2, 1)); m2 = fmaxf(m2, __shfl_xor(m2, 2)); m2 = fmaxf(m2, __shfl_xor(m2, 4));
          const float gs = m1 + m2; const int grp = lane >> 3; int rank = 0;
#pragma unroll
          for (int q = 0; q < 8; ++q) { const float v = rdlane(gs, q * 8); rank += (v > gs || (v == gs && q < grp)) ? 1 : 0; }
          const float cand = (rank < 4) ? biased : -INFINITY; int re = 0;
          for (int q = 0; q < 64; ++q) { const float v = rdlane(cand, q); re += (v > cand || (v == cand && q < lane)) ? 1 : 0; }
          const bool sel = re < TOPK; const float ssum = wave_sum(sel ? score : 0.f);
          if (sel) { ((int*)(p.ws + O_EIDX))[(size_t)row * 8 + re] = lane; ((float*)(p.ws + O_GATE))[(size_t)row * 8 + re] = score / ssum * 2.5f; atomicAdd(&cnt[lane], 1u); } }
        __syncthreads();
    }
}
__device__ __forceinline__ void phase_place(const Params& p, int l, LAS unsigned char* lds) {
    const int tid = otid(); const int NR = (l == NLAYER - 1) ? NLAT : NTOK; LAS int* pstart = (LAS int*)lds;
    const unsigned* cnt = (const unsigned*)(p.ws + O_CTL) + CW_CNT + l * 64; unsigned* cur = (unsigned*)(p.ws + O_CTL) + CW_CUR + l * 64;
    if (tid < 64) { const int ntile = ((int)cnt[tid] + 255) >> 8; pstart[tid] = (wave_incl_scan(ntile, tid) - ntile) * 256; }
    __syncthreads();
    const int* eidx = (const int*)(p.ws + O_EIDX); int* slot = (int*)(p.ws + O_SLOT); int* stok = (int*)(p.ws + O_STOK);
    for (int i = blockIdx.x * NTHREADS + tid; i < NR * TOPK; i += gridDim.x * NTHREADS) { const int row = i / TOPK, k = i % TOPK, e = eidx[(size_t)row * 8 + k];
        const int s = pstart[e] + (int)atomicAdd(&cur[e], 1u); slot[(size_t)row * 8 + k] = s; stok[s] = row; }
    __syncthreads();
}
__device__ __forceinline__ void phase_final(const Params& p, int l) {
    const int lane = otid() & 63, gw = blockIdx.x * 8 + owid(), GW = gridDim.x * 8; const bool last = (l == NLAYER - 1); const int NR = last ? NLAT : NTOK;
    const bf16_t* DO = (const bf16_t*)(p.ws + O_DOUT); const float* g3 = p.in[I_NORMG] + (size_t)(l * 4 + 3) * DM;
    const int lane0 = lane;
    for (int row = gw; row < NR; row += GW) {
        int lane = lane0; asm volatile("" : "+v"(lane));
        const int sl = (lane < TOPK) ? ((const int*)(p.ws + O_SLOT))[(size_t)row * 8 + lane] : 0; const float gl = (lane < TOPK) ? ((const float*)(p.ws + O_GATE))[(size_t)row * 8 + lane] : 0.f;
        float y[32];
#pragma unroll
        for (int i = 0; i < 32; ++i) y[i] = 0.f;
#pragma unroll
        for (int kb = 0; kb < 7; kb += 4) {
            u32x2 v[4][8]; float gt[4];
#pragma unroll
            for (int kk = 0; kk < 4; ++kk) { const int k = kb + kk; if (k < 7) { const int s = (k == 0) ? RSLOTS + row : __builtin_amdgcn_readlane(sl, k - 1); const bf16_t* src = DO + (size_t)s * DM; gt[kk] = (k == 0) ? 1.0f : rdlane(gl, k - 1);
#pragma unroll
                for (int j = 0; j < 8; ++j) v[kk][j] = *(const u32x2*)(src + ROWCOL(j, lane)); } }
#pragma unroll
            for (int kk = 0; kk < 4; ++kk) { if (kb + kk < 7) {
#pragma unroll
                for (int j = 0; j < 8; ++j) { const float g = gt[kk]; y[j * 4] += g * __uint_as_float(v[kk][j].x << 16); y[j * 4 + 1] += g * __uint_as_float(v[kk][j].x & 0xffff0000u); y[j * 4 + 2] += g * __uint_as_float(v[kk][j].y << 16); y[j * 4 + 3] += g * __uint_as_float(v[kk][j].y & 0xffff0000u); } } }
        }
        float ss = 0.f;
#pragma unroll
        for (int i = 0; i < 32; ++i) ss += y[i] * y[i];
        const float r = rsqrtf(wave_sum(ss) * (1.0f / DM) + EPS); const float* mod = (const float*)(p.ws + O_MOD) + (size_t)(l * 9 + row_batch(row)) * 12288;
        float* X = (float*)(p.ws + O_X) + (size_t)row * DM; float x[32];
#pragma unroll
        for (int j = 0; j < 8; ++j) { const int c = ROWCOL(j, lane); const f32x4 xv = *(const f32x4*)(X + c), gv = *(const f32x4*)(g3 + c), gf = *(const f32x4*)(mod + 5 * DM + c); f32x4 xn;
#pragma unroll
            for (int q = 0; q < 4; ++q) { xn[q] = xv[q] + gf[q] * (y[j * 4 + q] * r * gv[q]); x[j * 4 + q] = xn[q]; }
            if (last) *(f32x4*)(p.out + (size_t)row * DM + c) = xn; else *(f32x4*)(X + c) = xn; }
        if (!last) norm1_row(p, l + 1, row, x, lane);
    }
}

#define XB_TMO      128
#define XB_XCNT(j)  (256  + 64 * (j))
#define XB_XSUB(j)  (1280 + 64 * (j))
#define XB_XGEN(j)  (2304 + 64 * (j))
#define XB_TOP      3328
#define XB_TOPGEN   3392
#define XCD_BAR_WORDS 3456
#define XB_SPIN_CAP (1u << 23)

__device__ __forceinline__ unsigned xb_ld(unsigned* p)              { return __hip_atomic_load(p, __ATOMIC_RELAXED, __HIP_MEMORY_SCOPE_AGENT); }
__device__ __forceinline__ unsigned xb_add(unsigned* p, unsigned v) { return __hip_atomic_fetch_add(p, v, __ATOMIC_RELAXED, __HIP_MEMORY_SCOPE_AGENT); }
__device__ __forceinline__ unsigned xb_xcc_id() { return (unsigned)__builtin_amdgcn_s_getreg((3 << 11) | 20) & 0xFu; }
#define XB_SPIN(cond, bar) do { unsigned _sp = 0; while (cond) { __builtin_amdgcn_s_sleep(1); \
    if ((++_sp & 255u) == 0u) { if (xb_ld(&(bar)[XB_TMO])) break; if (_sp > XB_SPIN_CAP) { atomicAdd(&(bar)[XB_TMO], 1u); break; } } } } while (0)

struct XcdBarrier {
    unsigned* bar; unsigned x;
    volatile LAS unsigned* st;
};

__device__ __forceinline__ XcdBarrier xcd_barrier_post(unsigned* bar, volatile LAS unsigned* st) {
    XcdBarrier b; b.bar = bar; b.x = xb_xcc_id(); b.st = st;
    if (threadIdx.x == 0) (void)xb_add(&bar[XB_XCNT(b.x)], 1u);
    return b;
}
__device__ __forceinline__ void xcd_barrier_complete(unsigned* bar, unsigned x, unsigned& nloc, unsigned& nx) {
    const unsigned G = gridDim.x * gridDim.y * gridDim.z;
    unsigned sum, cnt, mine, sp = 0u;
    for (;;) {
        sum = 0u; cnt = 0u; mine = 0u;
#pragma unroll
        for (unsigned j = 0; j < 16; ++j) { const unsigned c = xb_ld(&bar[XB_XCNT(j)]); sum += c; cnt += (c > 0u) ? 1u : 0u; mine = (j == x) ? c : mine; }
        if (sum == G) break;
        __builtin_amdgcn_s_sleep(1);
        if ((++sp & 255u) == 0u) { if (xb_ld(&bar[XB_TMO])) break; if (sp > XB_SPIN_CAP) { atomicAdd(&bar[XB_TMO], 1u); break; } }
    }
    nloc = mine > 0u ? mine : 1u; nx = cnt > 0u ? cnt : 1u;
}

__device__ __forceinline__ void xcd_barrier(const XcdBarrier& b) {
    asm volatile("s_waitcnt vmcnt(0)" ::: "memory");
    __syncthreads();
    if (threadIdx.x == 0) {
        unsigned* bar = b.bar;
        __builtin_amdgcn_s_waitcnt(0);
        unsigned nloc = b.st[0], nx = b.st[1];
        if (nloc == 0u) { xcd_barrier_complete(bar, b.x, nloc, nx); b.st[0] = nloc; b.st[1] = nx; }
        const unsigned old = xb_add(&bar[XB_XSUB(b.x)], 1u);
        const unsigned gen = old / nloc;
        if (old + 1u == (gen + 1u) * nloc) {
            __builtin_amdgcn_fence(__ATOMIC_RELEASE, "agent");
            asm volatile("s_waitcnt vmcnt(0)" ::: "memory");
            const unsigned og = xb_add(&bar[XB_TOP], 1u);
            const unsigned tg = og / nx;
            if (og + 1u == (tg + 1u) * nx) xb_add(&bar[XB_TOPGEN], 1u);
            else XB_SPIN(xb_ld(&bar[XB_TOPGEN]) == tg, bar);
            __builtin_amdgcn_fence(__ATOMIC_ACQUIRE, "agent");
            xb_add(&bar[XB_XGEN(b.x)], 1u);
            asm volatile("s_waitcnt vmcnt(0)" ::: "memory");
        } else {
            XB_SPIN(xb_ld(&bar[XB_XGEN(b.x)]) == gen, bar);
            __builtin_amdgcn_fence(__ATOMIC_ACQUIRE, "agent");
            asm volatile("s_waitcnt vmcnt(0)" ::: "memory");
        }
    }
    __syncthreads();
}


enum { PH_PRO = 0, PH_NORM1, PH_WIN, PH_POSTA, PH_POSTB, PH_MIXER, PH_HYFIN, PH_WOUT, PH_ROUTE, PH_PLACE, PH_GEMM1, PH_GEMM2, PH_FINAL, PH_COUNT };

template <int PH>
__device__ __forceinline__ void run_phase(const Params& p_in, int l, LAS unsigned char* lds) {
    Params p = p_in; { unsigned char* w = p.ws; asm volatile("" : "+s"(w)); p.ws = w; }
    unsigned char* ws = p.ws; const bool last = (l == NLAYER - 1);
    const int gw = blockIdx.x * 8 + owid(), GW = gridDim.x * 8, lane = otid() & 63;
    if constexpr (PH == PH_PRO) { phase_prologue(p, lds); }
    if constexpr (PH == PH_NORM1) { phase_norm1(p, l); }
    if constexpr (PH == PH_WIN) {
        GemmDesc g{(const bf16_t*)(ws + O_H), DM, nullptr, DM, DM}; EpiStoreBf16 E{(bf16_t*)(ws + O_P), NP};
        const bf16_t* Bt = (const bf16_t*)(ws + O_WIN) + (size_t)l * NP * DM;
        if (!last) { DenseSched S{Bt, DM, NTOK / 256, 16, 0, 0}; GEMM_PHASE(g, S, E); }
        else { DenseSched S{Bt, DM, NLAT / 256, 16, 0, 0}; GEMM_PHASE(g, S, E); DenseSched S2{Bt, DM, NCTX / 256, 4, NLAT, 12}; GEMM_PHASE(g, S2, E); }
    }
    if constexpr (PH == PH_POSTA) {
#ifndef DBG_SKIP
#define DBG_SKIP 0
#endif
        if (!(DBG_SKIP & 1)) { GemmDesc g{(const bf16_t*)(ws + O_P) + C_CQ, NP, nullptr, 768, 768}; EpiStoreBf16 E{(bf16_t*)(ws + O_QRAW), NQP};
          DenseSched S{(const bf16_t*)(ws + O_WUQ) + (size_t)l * NQP * 768, 768, (last ? NLAT : NTOK) / 256, 5, 0, 0}; GEMM_PHASE(g, S, E); }
        if (!(DBG_SKIP & 2)) { GemmDesc g{(const bf16_t*)(ws + O_P) + C_CKV, NP, nullptr, 256, 256}; EpiStoreBf16 E{(bf16_t*)(ws + O_KVRAW), 1536};
          DenseSched S{(const bf16_t*)(ws + O_WUKV) + (size_t)l * 1536 * 256, 256, NTOK / 256, 6, 0, 0}; GEMM_PHASE(g, S, E); }
        const int ntt = (last ? NLAT : NTOK) / 64;
        if (!(DBG_SKIP & 4)) for (int t = blockIdx.x; t < ntt * 16; t += gridDim.x) hy_prep_task(p, l, (t >> 4) * 64, (t & 15) * 64, (LAS float*)lds);
        if (!(DBG_SKIP & 8)) for (int row = gw; row < NTOK; row += GW) gqa_post_row(p, l, row, lane);
    }
    if constexpr (PH == PH_POSTB) { if (l == 0) hss_tasks(p); for (int row = gw; row < NTOK; row += GW) mla_post_row(p, l, row, lane); }
    if constexpr (PH == PH_MIXER) { phase_mixer(p, l, lds); }
    if constexpr (PH == PH_HYFIN) { const int ntt = (last ? NLAT : NTOK) / 64; for (int t = blockIdx.x; t < ntt * 8; t += gridDim.x) hy_fin_task(p, l, (t >> 3) * 64, (t & 7) * 64, (LAS float*)lds); }
    if constexpr (PH == PH_WOUT) {
        GemmDesc g{(const bf16_t*)(ws + O_MIX), DM, nullptr, DM, DM}; EpiStoreBf16 E{(bf16_t*)(ws + O_OUT), DM};
        DenseSched S{(const bf16_t*)(ws + O_WOUT) + (size_t)l * DM * DM, DM, (last ? NLAT : NTOK) / 256, 8, 0, 0}; GEMM_PHASE(g, S, E);
    }
    if constexpr (PH == PH_ROUTE) { phase_route(p, l, lds); }
    if constexpr (PH == PH_PLACE) { phase_place(p, l, lds); }
    if constexpr (PH == PH_GEMM1 || PH == PH_GEMM2) {
        LAS int* te = (LAS int*)(lds + LDS_TILES); LAS int* ts = te + MAXTILES; LAS int* misc = (LAS int*)(lds + LDS_MISC) + 16;
        const int nt = moe_build_tiles((const unsigned*)(ws + O_CTL) + CW_CNT + l * 64, (last ? NLAT : NTOK) / 256, te, ts, misc);
        if constexpr (PH == PH_GEMM1) {
            GemmDesc g{(const bf16_t*)(ws + O_H), DM, (const int*)(ws + O_STOK), DM, DM}; EpiSwiGLU E{(bf16_t*)(ws + O_HID)};
            MoeSched S{te, ts, nt, 4, (const bf16_t*)(ws + O_EGU), (size_t)1024 * 2048, DM, 128}; GEMM_PHASE(g, S, E);
        } else {
            GemmDesc g{(const bf16_t*)(ws + O_HID), EH, nullptr, EH, EH}; EpiStoreBf16 E{(bf16_t*)(ws + O_DOUT), DM};
            MoeSched S{te, ts, nt, 8, (const bf16_t*)(ws + O_ED), (size_t)2048 * 512, EH, 256}; GEMM_PHASE(g, S, E);
        }
        __syncthreads();
    }
    if constexpr (PH == PH_FINAL) {
        phase_final(p, l);
        if (!last) cvt_exp_all(p, l + 1);
    }
}

#ifndef MEGA
#define MEGA 0
#endif


#if MEGA
__global__ void __launch_bounds__(NTHREADS, 2) mega_fwd(Params p) {
    extern __shared__ __attribute__((aligned(16))) unsigned char lds_raw[];
    LAS unsigned char* lds = (LAS unsigned char*)lds_raw;
    volatile LAS unsigned* xbw = (volatile LAS unsigned*)(lds + LDS_MISC);
    if (otid() == 0) { xbw[0] = 0u; xbw[1] = 0u; }
    __syncthreads();
    { const XcdBarrier b0 = xcd_barrier_post((unsigned*)(p.ws + O_CTL) + CW_BAR, xbw); if (otid() == 0) xbw[2] = b0.x; }
    __syncthreads();
#define GRID_BAR() do { XcdBarrier b_; b_.bar = (unsigned*)(p.ws + O_CTL) + CW_BAR; b_.x = xbw[2]; b_.st = xbw; xcd_barrier(b_); } while (0)
#ifndef DBL_MASK
#define DBL_MASK 0
#endif
#define RUNP(PH, l) do { run_phase<PH>(p, l, lds); GRID_BAR(); if ((DBL_MASK >> PH) & 1) { run_phase<PH>(p, l, lds); GRID_BAR(); } } while (0)
#ifndef DLY_MASK
#define DLY_MASK 0
#endif
#define RUND(PH, l) do { if ((DLY_MASK >> PH) & 1) { const unsigned long long t0_ = wall_clock64(); run_phase<PH>(p, l, lds); const unsigned long long t1_ = wall_clock64(); while (wall_clock64() < t1_ + (t1_ - t0_)) __builtin_amdgcn_s_sleep(8); } else run_phase<PH>(p, l, lds); } while (0)
    RUNP(PH_PRO, 0);
#define LAYER(l) do { if ((l) == 0) RUNP(PH_NORM1, l); \
        RUNP(PH_WIN, l); RUNP(PH_POSTA, l); RUNP(PH_POSTB, l); RUNP(PH_MIXER, l); RUNP(PH_HYFIN, l); RUNP(PH_WOUT, l); \
        RUND(PH_ROUTE, l); GRID_BAR(); RUND(PH_PLACE, l); GRID_BAR(); RUNP(PH_GEMM1, l); RUNP(PH_GEMM2, l); RUND(PH_FINAL, l); \
        if ((l) + 1 < NLAYER) GRID_BAR(); } while (0)
    LAYER(0);
    LAYER(1);
}
#endif

#if !MEGA
template <int PH> __global__ void __launch_bounds__(NTHREADS, 2) k_phase(Params p) {
    extern __shared__ __attribute__((aligned(16))) unsigned char lds_raw[];
    run_phase<PH>(p, p.layer, (LAS unsigned char*)lds_raw);
}
template <int PH> static bool prep_phase() { return hipFuncSetAttribute((const void*)k_phase<PH>, hipFuncAttributeMaxDynamicSharedMemorySize, LDS_BYTES) == hipSuccess; }
static int g_nlaunch = 0;
#ifndef DBG_STOP
#define DBG_STOP 1000
#define DBG_DUMP 0
#else
#define DBG_DUMP 1
#ifndef DBG_SET
#define DBG_SET 31
#endif
#endif
template <int PH> static void launch_phase(Params p, int l, hipStream_t st) { if (g_nlaunch++ >= DBG_STOP) return; p.layer = l; hipLaunchKernelGGL(k_phase<PH>, dim3(256), dim3(NTHREADS), LDS_BYTES, st, p); }
#endif


#if DBG_DUMP
__device__ __forceinline__ float san(float x) { return (x == x && fabsf(x) < 1e6f) ? x : 1.0f; }
__global__ void __launch_bounds__(256) k_dump(Params p) {
    const size_t N = (size_t)NLAT * DM;
    const bf16_t* b1 = (const bf16_t*)(p.ws + O_WIN); const size_t n1 = (O_X - O_WIN) / 2;
    const bf16_t* b2 = (const bf16_t*)(p.ws + O_H); const size_t n2 = (size_t)NTOK * DM;
    const bf16_t* b3 = (const bf16_t*)(p.ws + O_A); const size_t n3 = (O_AEND - O_A) / 2;
    const float* f1 = (const float*)(p.ws + O_MOD); const size_t m1 = (O_WIN - O_MOD) / 4;
    const float* f2 = (const float*)(p.ws + O_X); const size_t m2 = (size_t)NTOK * DM;
    for (size_t i = (size_t)blockIdx.x * 256 + otid(); i < N; i += (size_t)gridDim.x * 256) {
        float v = 0.f;
        if (DBG_SET & 1) for (size_t e = i; e < n1; e += N) v += san(bf2f(b1[e]));
        if (DBG_SET & 2) for (size_t e = i; e < n2; e += N) v += san(bf2f(b2[e]));
        if (DBG_SET & 4) for (size_t e = i; e < n3; e += N) v += san(bf2f(b3[e]));
        if (DBG_SET & 8) for (size_t e = i; e < m1; e += N) v += san(f1[e]);
        if (DBG_SET & 16) for (size_t e = i; e < m2; e += N) v += san(f2[e]);
        if (DBG_SET & 32) v += san(bf2f(((const bf16_t*)(p.ws + O_WUKV))[i % ((size_t)2 * 1536 * 256)]));
        if (DBG_SET & 64) { const size_t r = i % NTOK, c = (i / NTOK) % 256; v += san(bf2f(((const bf16_t*)(p.ws + O_P))[r * NP + C_CKV + c])); }
        if (DBG_SET & 128) v += san(bf2f(((const bf16_t*)(p.ws + O_KVRAW))[i % ((size_t)NTOK * 1536)]));
        p.out[i] = v;
    }
}
#endif
static int g_grid = 0;
extern "C" void kernel_launch(void* const* d_in, const int* in_sizes, int n_in, void* d_out, int out_size, void* d_ws, size_t ws_size, hipStream_t stream) {
    static int ok = 0;
    if (ok == 0) {
        if (n_in != 31 || in_sizes[0] != NLAT * DM || out_size != NLAT * DM || ws_size < WS_END) { fprintf(stderr, "kernel_launch: unexpected shapes (n_in %d, ws %zu, need %zu)\n", n_in, ws_size, (size_t)WS_END); ok = -1; return; }
        bool good = true;
#if !MEGA
        good = good && prep_phase<0>() && prep_phase<1>() && prep_phase<2>() && prep_phase<3>() && prep_phase<4>() && prep_phase<5>() && prep_phase<6>() && prep_phase<7>() && prep_phase<8>() && prep_phase<9>() && prep_phase<10>() && prep_phase<11>() && prep_phase<12>();
#endif
#if MEGA
        good = hipFuncSetAttribute((const void*)mega_fwd, hipFuncAttributeMaxDynamicSharedMemorySize, LDS_BYTES) == hipSuccess;
        int dev = 0, cus = 0, per_cu = 0;
        if (hipGetDevice(&dev) != hipSuccess || hipDeviceGetAttribute(&cus, hipDeviceAttributeMultiprocessorCount, dev) != hipSuccess) good = false;
        if (good && (hipOccupancyMaxActiveBlocksPerMultiprocessor(&per_cu, (const void*)mega_fwd, NTHREADS, LDS_BYTES) != hipSuccess || per_cu < 1)) { fprintf(stderr, "kernel_launch: occupancy query says %d workgroups per CU\n", per_cu); good = false; }
        g_grid = cus;
#endif
        if (!good) { fprintf(stderr, "kernel_launch: set-up failed\n"); ok = -1; return; }
        ok = 1;
    }
    if (ok < 0) return;
    Params p{}; for (int i = 0; i < 31; ++i) p.in[i] = (const float*)d_in[i]; p.out = (float*)d_out; p.ws = (unsigned char*)d_ws; p.layer = 0; p.pad = 0;
#ifdef POISON_WS
    hipMemsetAsync((char*)d_ws, 0xFF, WS_END, stream);
#endif
    hipMemsetAsync((char*)d_ws + O_CTL, 0, ZERO_BYTES, stream);
#if !MEGA
    g_nlaunch = 0;
    launch_phase<PH_PRO>(p, 0, stream);
    for (int l = 0; l < NLAYER; ++l) {
        if (l == 0) launch_phase<PH_NORM1>(p, l, stream);
        launch_phase<PH_WIN>(p, l, stream); launch_phase<PH_POSTA>(p, l, stream); launch_phase<PH_POSTB>(p, l, stream); launch_phase<PH_MIXER>(p, l, stream);
        launch_phase<PH_HYFIN>(p, l, stream); launch_phase<PH_WOUT>(p, l, stream); launch_phase<PH_ROUTE>(p, l, stream); launch_phase<PH_PLACE>(p, l, stream);
        launch_phase<PH_GEMM1>(p, l, stream); launch_phase<PH_GEMM2>(p, l, stream); launch_phase<PH_FINAL>(p, l, stream);
    }
#if DBG_DUMP
    hipLaunchKernelGGL(k_dump, dim3(2048), dim3(256), 0, stream, p);
#endif
#else
    hipLaunchKernelGGL(mega_fwd, dim3(g_grid), dim3(NTHREADS), LDS_BYTES, stream, p);
#endif
}
```

```cpp
#define GQA_SD 1
#define FAST_GEMM 1
#define MEGA 1
#include <hip/hip_runtime.h>
#include <stdint.h>
#include <stdio.h>

#define LAS __attribute__((address_space(3)))
typedef unsigned short bf16_t;
typedef short bf16x8 __attribute__((ext_vector_type(8)));
typedef short s16x4 __attribute__((ext_vector_type(4)));
typedef float f32x4 __attribute__((ext_vector_type(4)));
typedef float f32x16 __attribute__((ext_vector_type(16)));
typedef unsigned u32x4 __attribute__((ext_vector_type(4)));
typedef unsigned u32x2 __attribute__((ext_vector_type(2)));

constexpr int DM = 2048, NB = 8, SEQ = 2048, CTXL = 256, NLAT = NB * SEQ, NCTX = NB * CTXL, NTOK = NLAT + NCTX, NLAYER = 2;
constexpr int NP = 4096;
constexpr int C_CQ = 1536, C_GQ = 2304, C_CKV = 3072, C_KR = 3328, C_GK = 3392, C_GV = 3648, IN_COLS = 3904;
constexpr int NEXP = 64, TOPK = 6, EH = 512;
constexpr int LK = CTXL + SEQ;
constexpr int RSLOTS = 126976;
constexpr int NSLOTS = RSLOTS + NTOK;
constexpr int MAXTILES = NSLOTS / 256;
constexpr int NQP = 1280;
constexpr float EPS = 1e-6f;
constexpr int NTHREADS = 512;
#ifndef GQA_SD
#define GQA_SD 2
#endif
#ifndef HY_MFMA
#define HY_MFMA 1
#endif

constexpr size_t al256(size_t x) { return (x + 255) & ~(size_t)255; }
constexpr size_t O_CTL = 0;
constexpr size_t CTL_BYTES = 65536;
constexpr size_t O_MOD = O_CTL + CTL_BYTES;
constexpr size_t O_HSS = O_MOD + al256((size_t)NLAYER * 9 * 12288 * 4);
constexpr size_t ZERO_BYTES = O_HSS + al256((size_t)NLAYER * 2 * 2 * 512 * 4);
constexpr size_t O_HF = ZERO_BYTES;
constexpr size_t HF_L0 = (size_t)2 * 2 * 512 * 2048, HF_L1 = (size_t)2 * 2 * 512 * 256, HF_LAYER = HF_L0 + HF_L1;
constexpr size_t O_WIN = O_HF + al256(NLAYER * HF_LAYER * 4);
constexpr size_t O_WOUT = O_WIN + (size_t)NLAYER * NP * DM * 2;
constexpr size_t O_WUQ = O_WOUT + (size_t)NLAYER * DM * DM * 2;
constexpr size_t O_WUKV = O_WUQ + al256((size_t)NLAYER * NQP * 768 * 2);
constexpr size_t O_EGU = O_WUKV + al256((size_t)NLAYER * 1536 * 256 * 2);
constexpr size_t O_ED = O_EGU + (size_t)65 * 1024 * 2048 * 2;
constexpr size_t O_X = O_ED + (size_t)65 * 2048 * 512 * 2;
constexpr size_t O_H = O_X + (size_t)NTOK * DM * 4;
constexpr size_t O_EIDX = O_H + (size_t)NTOK * DM * 2;
constexpr size_t O_GATE = O_EIDX + (size_t)NTOK * 8 * 4;
constexpr size_t O_SLOT = O_GATE + (size_t)NTOK * 8 * 4;
constexpr size_t O_STOK = O_SLOT + (size_t)NTOK * 8 * 4;
constexpr size_t O_WCNT = O_STOK + al256((size_t)NSLOTS * 4);
constexpr size_t O_HID = O_WCNT + (size_t)1024 * 64 * 4;
constexpr size_t O_A = O_HID + (size_t)NSLOTS * EH * 2;
constexpr size_t O_P = O_A;
constexpr size_t O_QRAW = O_P + (size_t)NTOK * NP * 2;
constexpr size_t O_KVRAW = O_QRAW + (size_t)NTOK * NQP * 2;
constexpr size_t O_QM = O_KVRAW + (size_t)NTOK * 1536 * 2;
constexpr size_t O_QMC = O_QM + (size_t)NB * 6 * SEQ * 192 * 2;
constexpr size_t O_KM = O_QMC + (size_t)NB * 6 * CTXL * 192 * 2;
constexpr size_t O_VM = O_KM + (size_t)NB * 6 * LK * 192 * 2;
constexpr size_t O_QG = O_VM + (size_t)NB * 6 * LK * 128 * 2;
constexpr size_t O_QGC = O_QG + (size_t)NB * 6 * SEQ * 128 * 2;
constexpr size_t O_KG = O_QGC + (size_t)NB * 6 * CTXL * 128 * 2;
constexpr size_t O_VG = O_KG + (size_t)NB * 2 * LK * 128 * 2;
constexpr size_t O_VT = O_VG + (size_t)NB * 2 * LK * 128 * 2;
constexpr size_t O_X1T = O_VT + (size_t)512 * NTOK * 2;
constexpr size_t O_Y2T = O_X1T + (size_t)512 * NTOK * 2;
constexpr size_t O_MIX = O_Y2T + (size_t)512 * NTOK * 2;
constexpr size_t O_OUT = O_MIX + (size_t)NTOK * DM * 2;
constexpr size_t O_AEND = O_OUT + (size_t)NTOK * DM * 2;
constexpr size_t O_DOUT = O_A;
static_assert(O_DOUT + (size_t)NSLOTS * DM * 2 <= O_AEND, "DOUT must fit the mixer scratch region");
constexpr size_t WS_END = O_AEND;

constexpr int CW_BAR = 0;
constexpr int CW_CNT = 4096;
constexpr int CW_CUR = 4096 + 128;
constexpr int CW_Q = 4096 + 256;

constexpr int LDS_BYTES = 148480;
constexpr int LDS_MISC = 147456;
constexpr int LDS_TILES = 131072;
constexpr int LDS_CNTL = LDS_MISC + 512;

struct Params { const float* in[31]; float* out; unsigned char* ws; int layer; int pad; };

enum { I_X = 0, I_C, I_CTX, I_CCTX, I_ADAW, I_ADAB, I_NORMG, I_WIN, I_WOUT, I_HYCONV, I_HYW1, I_HYB1, I_HYW2, I_HYB2, I_HYW3, I_HYFREQ, I_HYSKIP,
       I_MQN, I_MKVN, I_WUQ, I_WUKV, I_GQN, I_GKN, I_RW, I_RB, I_EG, I_EU, I_EDN, I_SG, I_SU, I_SD };

__device__ __forceinline__ int otid() { int t = threadIdx.x; asm volatile("" : "+v"(t)); return t; }
__device__ __forceinline__ int owid() { return __builtin_amdgcn_readfirstlane(otid() >> 6); }
__device__ __forceinline__ float bf2f(bf16_t v) { return __uint_as_float(((unsigned)v) << 16); }
__device__ __forceinline__ bf16_t f2bf(float f) { unsigned u = __float_as_uint(f); u += 0x7FFFu + ((u >> 16) & 1u); return (bf16_t)(u >> 16); }
__device__ __forceinline__ unsigned pk2(float lo, float hi) { unsigned r; asm volatile("v_cvt_pk_bf16_f32 %0, %1, %2" : "=v"(r) : "v"(lo), "v"(hi)); return r; }
__device__ __forceinline__ float wave_sum(float v) {
#pragma unroll
    for (int o = 32; o >= 1; o >>= 1) v += __shfl_xor(v, o);
    return v;
}
__device__ __forceinline__ float rdlane(float v, int l) { return __int_as_float(__builtin_amdgcn_readlane(__float_as_int(v), l)); }
__device__ __forceinline__ float silu_f(float x) { return x / (1.0f + __expf(-x)); }
__device__ __forceinline__ const float* resid_src(const Params& p, int l, int row) {
    if (l == 0) return row < NLAT ? p.in[I_X] + (size_t)row * DM : p.in[I_CTX] + (size_t)(row - NLAT) * DM;
    return (const float*)(p.ws + O_X) + (size_t)row * DM;
}
__device__ __forceinline__ int row_batch(int row) { return row < NLAT ? row >> 11 : 8; }
#define ROWCOL(j, lane) ((j) * 256 + (lane) * 4)


struct GUnit { int arow0; const bf16_t* B; int orow0, ocol0; };
struct GemmDesc { const bf16_t* A; int lda; const int* ridx; int ldb; int K; };

struct EpiStoreBf16 {
    bf16_t* O; int ldo;
    __device__ __forceinline__ void operator()(const f32x4 (&acc)[2][2][4][2], const GUnit& u, int wr, int wc, int fr, int fq) const {
#pragma unroll
        for (int ai = 0; ai < 2; ++ai)
#pragma unroll
            for (int m = 0; m < 4; ++m) {
                bf16_t* rowp = O + (size_t)(u.orow0 + ai * 128 + wr * 64 + m * 16 + fr) * ldo + u.ocol0 + wc * 32 + 4 * fq;
#pragma unroll
                for (int bj = 0; bj < 2; ++bj)
#pragma unroll
                    for (int n = 0; n < 2; ++n) { const f32x4 v = acc[ai][bj][m][n]; u32x2 w; w.x = pk2(v[0], v[1]); w.y = pk2(v[2], v[3]); *(u32x2*)(rowp + bj * 128 + n * 16) = w; }
            }
    }
};
struct EpiSwiGLU {
    bf16_t* O;
    __device__ __forceinline__ void operator()(const f32x4 (&acc)[2][2][4][2], const GUnit& u, int wr, int wc, int fr, int fq) const {
#pragma unroll
        for (int ai = 0; ai < 2; ++ai)
#pragma unroll
            for (int m = 0; m < 4; ++m) {
                bf16_t* rowp = O + (size_t)(u.orow0 + ai * 128 + wr * 64 + m * 16 + fr) * EH + u.ocol0 + wc * 32 + 4 * fq;
#pragma unroll
                for (int n = 0; n < 2; ++n) { const f32x4 g = acc[ai][0][m][n], up = acc[ai][1][m][n]; float h[4];
#pragma unroll
                    for (int j = 0; j < 4; ++j) h[j] = silu_f(g[j]) * up[j];
                    u32x2 w; w.x = pk2(h[0], h[1]); w.y = pk2(h[2], h[3]); *(u32x2*)(rowp + n * 16) = w; }
            }
    }
};

template <class Epi>
__device__ __forceinline__ void gemm_unit_simple(const GemmDesc& g, const GUnit& u, const Epi& E) {
    int tid = otid();
    const int wid = __builtin_amdgcn_readfirstlane(tid >> 6), lane = tid & 63, wr = wid >> 2, wc = wid & 3, fr = lane & 15, fq = lane >> 4;
    f32x4 acc[2][2][4][2];
#pragma unroll
    for (int a = 0; a < 2; ++a)
#pragma unroll
        for (int b = 0; b < 2; ++b)
#pragma unroll
            for (int m = 0; m < 4; ++m)
#pragma unroll
                for (int n = 0; n < 2; ++n) acc[a][b][m][n] = (f32x4){0.f, 0.f, 0.f, 0.f};
    const bf16_t* ap[2][4]; const bf16_t* bp[2][2];
#pragma unroll
    for (int ai = 0; ai < 2; ++ai)
#pragma unroll
        for (int m = 0; m < 4; ++m) { const int r = u.arow0 + ai * 128 + wr * 64 + m * 16 + fr; int src = g.ridx ? g.ridx[r] : r; if (src < 0) src = 0; ap[ai][m] = g.A + (size_t)src * g.lda + 8 * fq; }
#pragma unroll
    for (int bj = 0; bj < 2; ++bj)
#pragma unroll
        for (int n = 0; n < 2; ++n) bp[bj][n] = u.B + (size_t)(bj * 128 + wc * 32 + n * 16 + fr) * g.ldb + 8 * fq;
    int Kq = g.K; asm volatile("" : "+s"(Kq));
#pragma unroll 1
    for (int k0 = 0; k0 < Kq; k0 += 32) {
        bf16x8 a[2][4], b[2][2];
#pragma unroll
        for (int ai = 0; ai < 2; ++ai)
#pragma unroll
            for (int m = 0; m < 4; ++m) a[ai][m] = *(const bf16x8*)(ap[ai][m] + k0);
#pragma unroll
        for (int bj = 0; bj < 2; ++bj)
#pragma unroll
            for (int n = 0; n < 2; ++n) b[bj][n] = *(const bf16x8*)(bp[bj][n] + k0);
#pragma unroll
        for (int ai = 0; ai < 2; ++ai)
#pragma unroll
            for (int bj = 0; bj < 2; ++bj)
#pragma unroll
                for (int m = 0; m < 4; ++m)
#pragma unroll
                    for (int n = 0; n < 2; ++n) acc[ai][bj][m][n] = __builtin_amdgcn_mfma_f32_16x16x32_bf16(b[bj][n], a[ai][m], acc[ai][bj][m][n], 0, 0, 0);
    }
    E(acc, u, wr, wc, fr, fq);
}

struct DenseSched {
    const bf16_t* Bt; int ldb, nM, nN, row0, pn0;
    __device__ __forceinline__ int count() const { return nM * nN; }
    __device__ __forceinline__ void unit(int i, GUnit& u) const { const int pm = i / nN, pn = pn0 + i % nN; u.arow0 = row0 + pm * 256; u.B = Bt + (size_t)pn * 256 * ldb; u.orow0 = u.arow0; u.ocol0 = pn * 256; }
};
struct MoeSched {
    const LAS int* te; const LAS int* ts; int ntiles, npn; const bf16_t* Bt; size_t estride; int ldb, ocolw;
    __device__ __forceinline__ int count() const { return ntiles * npn; }
    __device__ __forceinline__ void unit(int i, GUnit& u) const { const int t = i / npn, pn = i % npn; const int e = te[t]; u.arow0 = ts[t]; u.B = Bt + (size_t)e * estride + (size_t)pn * 256 * ldb; u.orow0 = u.arow0; u.ocol0 = pn * ocolw; }
};
template <class Sched, class Epi>
__device__ __forceinline__ void gemm_phase_simple(const GemmDesc& g, const Sched& S, const Epi& E) {
    const int n = S.count();
    for (int i = blockIdx.x; i < n; i += gridDim.x) { GUnit u; S.unit(i, u); gemm_unit_simple(g, u, E); }
}
__device__ __forceinline__ int wave_incl_scan(int v, int lane) {
#pragma unroll
    for (int o = 1; o < 64; o <<= 1) { const int t = __shfl_up(v, o); if (lane >= o) v += t; }
    return v;
}
__device__ __forceinline__ int moe_build_tiles(const unsigned* cnt, int nshared, LAS int* te, LAS int* ts, LAS int* misc) {
    __syncthreads();
    const int tid = otid();
    if (tid < 64) {
        const int c = (int)cnt[tid], ntile = (c + 255) >> 8, incl = wave_incl_scan(ntile, tid), first = incl - ntile;
        for (int j = 0; j < ntile; ++j) { te[first + j] = tid; ts[first + j] = (first + j) * 256; }
        const int nrt = __shfl(incl, 63);
        for (int j = tid; j < nshared; j += 64) { te[nrt + j] = NEXP; ts[nrt + j] = RSLOTS + j * 256; }
        if (tid == 0) misc[0] = nrt + nshared;
    }
    __syncthreads();
    return misc[0];
}
#ifndef FAST_GEMM
#define FAST_GEMM 0
#endif
#if !FAST_GEMM
#define GEMM_PHASE(g, S, E) gemm_phase_simple(g, S, E)
#endif

#if FAST_GEMM
constexpr int HTB = 128 * 64 * 2;
__device__ __forceinline__ int lds_byte(int r, int c) { const int st = (r >> 4) * 2 + (c >> 5), rr = r & 15, cc = c & 31, ob = rr * 64 + cc * 2; return st * 1024 + (ob ^ (((ob >> 9) & 1) << 5)); }
__device__ __forceinline__ void stage_rc(int b, int& R, int& C) { const int st = b / 1024, sb = b % 1024, swz = sb ^ (((sb >> 9) & 1) << 5); R = (st >> 1) * 16 + swz / 64; C = (st & 1) * 32 + (swz % 64) / 2; }

template <class Sched, class Epi>
__device__ __forceinline__ void gemm_phase_fast(LAS unsigned char* lds, const GemmDesc& g, const Sched& S, const Epi& E) {
    const int tid = otid(), wid = __builtin_amdgcn_readfirstlane(tid >> 6), lane = tid & 63, wr = wid >> 2, wc = wid & 3, fr = lane & 15, fq = lane >> 4;
    const int K = g.K, nt = K / 64, nunits = S.count(), G = gridDim.x, c0 = blockIdx.x;
    if (c0 >= nunits) return;
    int R[2], C[2]; unsigned voffB[2];
#pragma unroll
    for (int i = 0; i < 2; ++i) { stage_rc(tid * 16 + i * 8192, R[i], C[i]); voffB[i] = (unsigned)(R[i] * g.ldb + C[i]) * 2u; }
    const size_t kstep = 128;
    const size_t hstepB = (size_t)128 * g.ldb * 2;
    const unsigned ldsw = (unsigned)wid * 1024u;
    const int aoff = lds_byte(wr * 64 + fr, fq * 8), boff = lds_byte(wc * 32 + fr, fq * 8);
    const char* Ab = (const char*)g.A;
#define F_SA(b, h) (((b) * 2 + (h)) * HTB)
#define F_SB(b, h) ((4 + (b) * 2 + (h)) * HTB)
#define F_STAGE(bufoff, gbase, voff) do { _Pragma("unroll") for (int _i = 0; _i < 2; ++_i) \
        __builtin_amdgcn_global_load_lds((const unsigned*)((const char*)(gbase) + (voff)[_i]), (LAS unsigned*)(lds + (bufoff) + ldsw + _i * 8192), 16, 0, 0); } while (0)
#define F_LDA(dst, b, h) do { _Pragma("unroll") for (int m = 0; m < 4; ++m) _Pragma("unroll") for (int k = 0; k < 2; ++k) dst[m][k] = *(const LAS bf16x8*)(lds + F_SA(b, h) + aoff + m * 2048 + k * 1024); } while (0)
#define F_LDB(dst, b, h) do { _Pragma("unroll") for (int n = 0; n < 2; ++n) _Pragma("unroll") for (int k = 0; k < 2; ++k) dst[n][k] = *(const LAS bf16x8*)(lds + F_SB(b, h) + boff + n * 2048 + k * 1024); } while (0)
#define F_MMA(ai, bj, At, Bt) do { __builtin_amdgcn_s_setprio(1); _Pragma("unroll") for (int m = 0; m < 4; ++m) _Pragma("unroll") for (int n = 0; n < 2; ++n) _Pragma("unroll") for (int k = 0; k < 2; ++k) \
        acc[ai][bj][m][n] = __builtin_amdgcn_mfma_f32_16x16x32_bf16(Bt[n][k], At[m][k], acc[ai][bj][m][n], 0, 0, 0); __builtin_amdgcn_s_setprio(0); } while (0)
#define F_WAIT_V(n) asm volatile("s_waitcnt vmcnt(" #n ")" ::: "memory")
#define F_WAIT_L(n) asm volatile("s_waitcnt lgkmcnt(" #n ")" ::: "memory")
#define F_BAR __builtin_amdgcn_s_barrier()
#define F_SCHED __builtin_amdgcn_sched_barrier(0)
#define F_AROWS(u, dst) do { _Pragma("unroll") for (int _h = 0; _h < 2; ++_h) _Pragma("unroll") for (int _i = 0; _i < 2; ++_i) { const int _r = (u).arow0 + _h * 128 + R[_i]; int _s = g.ridx ? g.ridx[_r] : _r; if (_s < 0) _s = 0; dst[_h][_i] = _s; } } while (0)
#define F_AOFFS(src, dst) do { _Pragma("unroll") for (int _h = 0; _h < 2; ++_h) _Pragma("unroll") for (int _i = 0; _i < 2; ++_i) dst[_h][_i] = ((unsigned)src[_h][_i] * (unsigned)g.lda + (unsigned)C[_i]) * 2u; } while (0)
    GUnit cur, nxt; int ui = 0;
    S.unit(c0, cur);
    f32x4 acc[2][2][4][2];
#pragma unroll
    for (int a = 0; a < 2; ++a)
#pragma unroll
        for (int b = 0; b < 2; ++b)
#pragma unroll
            for (int m = 0; m < 4; ++m)
#pragma unroll
                for (int n = 0; n < 2; ++n) acc[a][b][m][n] = (f32x4){0.f, 0.f, 0.f, 0.f};
    bf16x8 At[4][2], B0[2][2], B1[2][2];
    unsigned voA[2][2]; int rnx[2][2];
    F_AROWS(cur, rnx); F_AOFFS(rnx, voA);
    const char* cB = (const char*)cur.B;
    F_STAGE(F_SB(0, 0), cB, voffB); F_STAGE(F_SA(0, 0), Ab, voA[0]); F_STAGE(F_SB(0, 1), cB + hstepB, voffB); F_STAGE(F_SA(0, 1), Ab, voA[1]);
    if (wr == 1) F_BAR;
    F_WAIT_V(4); F_BAR;
    F_STAGE(F_SB(1, 0), cB + kstep, voffB); F_STAGE(F_SA(1, 0), Ab + kstep, voA[0]); F_STAGE(F_SB(1, 1), cB + hstepB + kstep, voffB);
    F_WAIT_V(6); F_BAR;
    for (;;) {
        const int Ln = (ui + 1) * G + c0; const bool has_next = Ln < nunits;
        if (has_next) { S.unit(Ln, nxt); F_AROWS(nxt, rnx); }
        const char* nB = has_next ? (const char*)nxt.B : cB;
        for (int t = 0; t < nt; t += 2) {
            const bool last = (t == nt - 2);
            const char* a1 = Ab + (size_t)(t + 1) * kstep;
            const char* a2 = last ? Ab : Ab + (size_t)(t + 2) * kstep; const char* b2 = last ? nB : cB + (size_t)(t + 2) * kstep;
            const char* a3 = a2 + kstep; const char* b3 = b2 + kstep;
            F_LDB(B0, 0, 0); F_SCHED; F_LDA(At, 0, 0); F_STAGE(F_SA(1, 1), a1, voA[1]);
            if (last && has_next) F_AOFFS(rnx, voA);
            F_WAIT_L(8); F_BAR; F_WAIT_L(0); F_MMA(0, 0, At, B0); F_BAR; F_SCHED;
            F_LDB(B1, 0, 1); F_STAGE(F_SB(0, 0), b2, voffB);
            F_BAR; F_WAIT_L(0); F_MMA(0, 1, At, B1); F_BAR;
            F_LDA(At, 0, 1); F_STAGE(F_SA(0, 0), a2, voA[0]);
            F_BAR; F_WAIT_L(0); F_MMA(1, 0, At, B0); F_BAR; F_SCHED;
            F_STAGE(F_SB(0, 1), b2 + hstepB, voffB);
            F_WAIT_V(6); F_BAR; F_MMA(1, 1, At, B1); F_BAR;
            F_LDB(B0, 1, 0); F_SCHED; F_LDA(At, 1, 0); F_STAGE(F_SA(0, 1), a2, voA[1]);
            F_WAIT_L(8); F_BAR; F_WAIT_L(0); F_MMA(0, 0, At, B0); F_BAR; F_SCHED;
            F_LDB(B1, 1, 1); F_STAGE(F_SB(1, 0), b3, voffB);
            F_BAR; F_WAIT_L(0); F_MMA(0, 1, At, B1); F_BAR;
            F_LDA(At, 1, 1); F_STAGE(F_SA(1, 0), a3, voA[0]);
            F_BAR; F_WAIT_L(0); F_MMA(1, 0, At, B0); F_BAR; F_SCHED;
            F_STAGE(F_SB(1, 1), b3 + hstepB, voffB);
            F_WAIT_V(6); F_BAR; F_MMA(1, 1, At, B1); F_BAR;
        }
        E(acc, cur, wr, wc, fr, fq);
        if (!has_next) break;
#pragma unroll
        for (int a = 0; a < 2; ++a)
#pragma unroll
            for (int b = 0; b < 2; ++b)
#pragma unroll
                for (int m = 0; m < 4; ++m)
#pragma unroll
                    for (int n = 0; n < 2; ++n) acc[a][b][m][n] = (f32x4){0.f, 0.f, 0.f, 0.f};
        cur = nxt; cB = nB; ++ui;
    }
    F_WAIT_V(0);
    if (wr == 0) F_BAR;
    F_BAR;
#undef F_SA
#undef F_SB
#undef F_STAGE
#undef F_LDA
#undef F_LDB
#undef F_MMA
#undef F_WAIT_V
#undef F_WAIT_L
#undef F_BAR
#undef F_SCHED
#undef F_AROWS
#undef F_AOFFS
}
#define GEMM_PHASE(g, S, E) gemm_phase_fast(lds, g, S, E)
#endif

#define SBAR() __builtin_amdgcn_sched_barrier(0)
__device__ __forceinline__ int crow(int r, int hi) { return (r & 3) + 8 * (r >> 2) + 4 * hi; }
template <int DQK> __device__ __forceinline__ int kaddr(int row, int chunk) {
    const int sw = (DQK == 128) ? (row & 7) : ((row >> 1) & 7);
    return row * (DQK * 2) + ((chunk ^ sw) << 4);
}
__device__ __forceinline__ void partialSM(f32x16& p0, f32x16& p1, float& m_reg, float& mn, float& alpha, float C, float thr) {
    float pmax = p0[0];
#pragma unroll
    for (int r = 1; r < 16; ++r) pmax = fmaxf(pmax, p0[r]);
#pragma unroll
    for (int r = 0; r < 16; ++r) pmax = fmaxf(pmax, p1[r]);
    { auto rr = __builtin_amdgcn_permlane32_swap(__float_as_uint(pmax), __float_as_uint(pmax), false, false);
      pmax = fmaxf(__uint_as_float(rr[0]), __uint_as_float(rr[1])); }
    if (__builtin_expect(__all(pmax - m_reg <= thr), 1)) { mn = m_reg; alpha = 1.f; }
    else { mn = fmaxf(m_reg, pmax); alpha = __builtin_amdgcn_exp2f((m_reg - mn) * C); m_reg = mn; }
    const float mnC = -mn * C;
#pragma unroll
    for (int r = 0; r < 16; ++r) p0[r] = fmaf(p0[r], C, mnC);
#pragma unroll
    for (int r = 0; r < 16; ++r) p1[r] = fmaf(p1[r], C, mnC);
#pragma unroll
    for (int r = 0; r < 16; ++r) p0[r] = __builtin_amdgcn_exp2f(p0[r]);
}
__device__ __forceinline__ void finishSM(f32x16& p0, f32x16& p1, float alpha, float& l_reg, bf16x8& pa0, bf16x8& pa1, bf16x8& pa2, bf16x8& pa3) {
#pragma unroll
    for (int r = 0; r < 16; ++r) p1[r] = __builtin_amdgcn_exp2f(p1[r]);
    float ps = 0;
#pragma unroll
    for (int r = 0; r < 16; ++r) ps += p0[r];
#pragma unroll
    for (int r = 0; r < 16; ++r) ps += p1[r];
    { auto rr = __builtin_amdgcn_permlane32_swap(__float_as_uint(ps), __float_as_uint(ps), false, false);
      ps = __uint_as_float(rr[0]) + __uint_as_float(rr[1]); }
    l_reg = l_reg * alpha + ps;
#define PK4(P, BASE, OUT) do { unsigned a0 = pk2(P[BASE + 0], P[BASE + 1]), a1 = pk2(P[BASE + 2], P[BASE + 3]);   \
    unsigned b0 = pk2(P[BASE + 4], P[BASE + 5]), b1 = pk2(P[BASE + 6], P[BASE + 7]);                              \
    auto r0 = __builtin_amdgcn_permlane32_swap(a0, b0, false, false); auto r1 = __builtin_amdgcn_permlane32_swap(a1, b1, false, false); \
    u32x4 w = {r0[0], r1[0], r0[1], r1[1]}; OUT = *reinterpret_cast<bf16x8*>(&w); } while (0)
    PK4(p0, 0, pa0); PK4(p0, 8, pa1); PK4(p1, 0, pa2); PK4(p1, 8, pa3);
#undef PK4
}
template <int DQK> __device__ __forceinline__ void qkt(f32x16& p0, f32x16& p1, const char* Ks, const bf16x8* qr, int r32, int hi) {
    p0 = f32x16{}; p1 = f32x16{};
#pragma unroll
    for (int d0 = 0; d0 < DQK / 16; ++d0) { const int ch = 2 * d0 + hi;
        const bf16x8 b0 = *reinterpret_cast<const bf16x8*>(Ks + kaddr<DQK>(r32, ch));
        const bf16x8 b1 = *reinterpret_cast<const bf16x8*>(Ks + kaddr<DQK>(32 + r32, ch));
        p0 = __builtin_amdgcn_mfma_f32_32x32x16_bf16(b0, qr[d0], p0, 0, 0, 0);
        p1 = __builtin_amdgcn_mfma_f32_32x32x16_bf16(b1, qr[d0], p1, 0, 0, 0); }
}
__device__ __forceinline__ int v_st(int k, int c) { const int kk = (k & ~0xC) | ((k & 4) << 1) | ((k & 8) >> 1); return ((kk >> 3) * 4 + (c >> 5)) * 512 + ((kk & 7) * 32 + (c & 31)) * 2; }
__device__ __forceinline__ int v_rd_base(int lane) { return ((lane & 3) << 3) | (((lane >> 2) & 3) << 6) | (((lane >> 4) & 1) << 5) | (((lane >> 5) & 1) << 8); }
constexpr int v_rd_off(int d0, int ks, int half) { return d0 * 512 + ks * 4096 + half * 2048; }
template <int OFF> __device__ __forceinline__ s16x4 tr_read(int vb) {
    s16x4 r; asm volatile("ds_read_b64_tr_b16 %0, %1 offset:%2" : "=&v"(r) : "v"(vb), "i"(OFF) : "memory"); return r;
}
template <int D0> __device__ __forceinline__ void pv_one(f32x16& od, int vb, bf16x8 pa0, bf16x8 pa1, bf16x8 pa2, bf16x8 pa3) {
    const s16x4 l0 = tr_read<v_rd_off(D0, 0, 0)>(vb), h0 = tr_read<v_rd_off(D0, 0, 1)>(vb), l1 = tr_read<v_rd_off(D0, 1, 0)>(vb), h1 = tr_read<v_rd_off(D0, 1, 1)>(vb);
    const s16x4 l2 = tr_read<v_rd_off(D0, 2, 0)>(vb), h2 = tr_read<v_rd_off(D0, 2, 1)>(vb), l3 = tr_read<v_rd_off(D0, 3, 0)>(vb), h3 = tr_read<v_rd_off(D0, 3, 1)>(vb);
    asm volatile("s_waitcnt lgkmcnt(0)" ::: "memory"); SBAR();
#define PK(L, H) (bf16x8){L[0], L[1], L[2], L[3], H[0], H[1], H[2], H[3]}
    od = __builtin_amdgcn_mfma_f32_32x32x16_bf16(pa0, PK(l0, h0), od, 0, 0, 0);
    od = __builtin_amdgcn_mfma_f32_32x32x16_bf16(pa1, PK(l1, h1), od, 0, 0, 0);
    od = __builtin_amdgcn_mfma_f32_32x32x16_bf16(pa2, PK(l2, h2), od, 0, 0, 0);
    od = __builtin_amdgcn_mfma_f32_32x32x16_bf16(pa3, PK(l3, h3), od, 0, 0, 0);
#undef PK
}
__device__ __forceinline__ void pv_d0(f32x16* o, int vb, bf16x8 pa0, bf16x8 pa1, bf16x8 pa2, bf16x8 pa3) {
    pv_one<0>(o[0], vb, pa0, pa1, pa2, pa3); pv_one<1>(o[1], vb, pa0, pa1, pa2, pa3); pv_one<2>(o[2], vb, pa0, pa1, pa2, pa3); pv_one<3>(o[3], vb, pa0, pa1, pa2, pa3);
}

template <int DQK, int SDEPTH>
__device__ __forceinline__ void attn_body(const bf16_t* __restrict__ Qb, const bf16_t* __restrict__ Kh, const bf16_t* __restrict__ Vh, bf16_t* __restrict__ Ob, int ldo, int nkeys, float scale, char* lds) {
    constexpr int SHM_V = 64 * 128 * 2, SHM_K = 64 * DQK * 2, NKC = DQK / 8, KPT = NKC / 8;
    int tid = otid();
    const int wid = __builtin_amdgcn_readfirstlane(tid >> 6), lane = tid & 63, r32 = lane & 31, hi = lane >> 5;
    char* V_lds = lds; char* K_lds = lds + 2 * SHM_V;
    float* ws = (float*)(lds + 2 * SHM_V + 2 * SHM_K) + wid * 64; float* li_l = ws; float* al_l = ws + 32;
    const float C = scale * 1.4426950408889634f, thr = 8.0f / scale;
    float m_reg = -1e30f, l_reg = 0; f32x16 o[4] = {}; bf16x8 qr[DQK / 16];
    const bf16_t* Qw = Qb + (long)(wid * 32 + r32) * DQK + hi * 8;
#pragma unroll
    for (int d0 = 0; d0 < DQK / 16; ++d0) qr[d0] = *reinterpret_cast<const bf16x8*>(Qw + d0 * 16);
    const int sr = tid >> 4, sc = (tid & 15) * 8, vst0 = v_st(sr, sc), vst1 = v_st(32 + sr, sc);
    int kgo[KPT], klo[KPT];
#pragma unroll
    for (int i = 0; i < KPT; ++i) { const int q = tid + 512 * i, row = q / NKC, ch = q % NKC; kgo[i] = row * DQK + ch * 8; klo[i] = kaddr<DQK>(row, ch); }
    const int vb0 = (int)(uintptr_t)V_lds + v_rd_base(lane);
    struct { bf16x8 vs0, vs1, ks[KPT]; } sr_[SDEPTH ? SDEPTH : 1];
#define SLOAD(i, k0) do { sr_[i].vs0 = *reinterpret_cast<const bf16x8*>(&Vh[(long)((k0) + sr) * 128 + sc]); sr_[i].vs1 = *reinterpret_cast<const bf16x8*>(&Vh[(long)((k0) + 32 + sr) * 128 + sc]); \
    _Pragma("unroll") for (int _q = 0; _q < KPT; ++_q) sr_[i].ks[_q] = *reinterpret_cast<const bf16x8*>(&Kh[(long)(k0) * DQK + kgo[_q]]); } while (0)
#define SWRITE(b, i) do { *(bf16x8*)(V_lds + (b) * SHM_V + vst0) = sr_[i].vs0; *(bf16x8*)(V_lds + (b) * SHM_V + vst1) = sr_[i].vs1; \
    _Pragma("unroll") for (int _q = 0; _q < KPT; ++_q) *(bf16x8*)(K_lds + (b) * SHM_K + klo[_q]) = sr_[i].ks[_q]; } while (0)
#define SWAIT() do { if constexpr (SDEPTH == 2) { if constexpr (KPT == 2) asm volatile("s_waitcnt vmcnt(4)" ::: "memory"); else asm volatile("s_waitcnt vmcnt(5)" ::: "memory"); } \
    else asm volatile("s_waitcnt vmcnt(0)" ::: "memory"); } while (0)
#define RESC(a) do { if (__any((a) < 1.f)) { if (hi == 0) al_l[r32] = (a); asm volatile("s_waitcnt lgkmcnt(0)" ::: "memory"); \
    _Pragma("unroll") for (int d = 0; d < 4; ++d) _Pragma("unroll") for (int r = 0; r < 16; ++r) o[d][r] *= al_l[crow(r, hi)]; } } while (0)
    bf16x8 pa0, pa1, pa2, pa3; const int NT = nkeys / 64;
    if constexpr (SDEPTH == 0) {
        f32x16 pA0, pA1; float mnA, alA;
        SLOAD(0, 0); asm volatile("s_waitcnt vmcnt(0)" ::: "memory"); SWRITE(0, 0); __syncthreads();
        for (int j = 0; j < NT; ++j) {
            const int bo = j & 1;
            if (j + 1 < NT) SLOAD(0, (j + 1) * 64);
            SBAR(); qkt<DQK>(pA0, pA1, K_lds + bo * SHM_K, qr, r32, hi); partialSM(pA0, pA1, m_reg, mnA, alA, C, thr);
            RESC(alA); finishSM(pA0, pA1, alA, l_reg, pa0, pa1, pa2, pa3); SBAR();
            pv_d0(o, vb0 + bo * SHM_V, pa0, pa1, pa2, pa3);
            if (j + 1 < NT) { asm volatile("s_waitcnt vmcnt(0)" ::: "memory"); SWRITE(bo ^ 1, 0); }
            __syncthreads();
        }
    } else {
    f32x16 pA0, pA1, pB0, pB1; float mnA, mnB, alA, alB;
    constexpr int SE = 0, SO = SDEPTH - 1;
    SLOAD(SE, 0); asm volatile("s_waitcnt vmcnt(0)" ::: "memory"); SWRITE(0, SE); __syncthreads();
    qkt<DQK>(pA0, pA1, K_lds, qr, r32, hi); partialSM(pA0, pA1, m_reg, mnA, alA, C, thr);
    SLOAD(SO, 64); if constexpr (SDEPTH == 2) { if (2 < NT) SLOAD(SE, 2 * 64); }
    SWAIT(); SWRITE(1, SO); __syncthreads();
    for (int j = 1; j + 1 < NT; j += 2) {
        SBAR(); qkt<DQK>(pB0, pB1, K_lds + SHM_K, qr, r32, hi);
        finishSM(pA0, pA1, alA, l_reg, pa0, pa1, pa2, pa3); SBAR();
        SLOAD(SO, (j + SDEPTH) * 64); SBAR();
        pv_d0(o, vb0, pa0, pa1, pa2, pa3); partialSM(pB0, pB1, m_reg, mnB, alB, C, thr);
        __syncthreads(); SWAIT(); SWRITE(0, SE);
        RESC(alB); __syncthreads();
        SBAR(); qkt<DQK>(pA0, pA1, K_lds, qr, r32, hi);
        finishSM(pB0, pB1, alB, l_reg, pa0, pa1, pa2, pa3); SBAR();
        if (SDEPTH == 1 || j + 3 < NT) SLOAD(SE, (j + 1 + SDEPTH) * 64); SBAR();
        pv_d0(o, vb0 + SHM_V, pa0, pa1, pa2, pa3); partialSM(pA0, pA1, m_reg, mnA, alA, C, thr);
        __syncthreads(); SWAIT(); SWRITE(1, SO);
        RESC(alA); __syncthreads();
    }
    SBAR(); qkt<DQK>(pB0, pB1, K_lds + SHM_K, qr, r32, hi);
    finishSM(pA0, pA1, alA, l_reg, pa0, pa1, pa2, pa3); SBAR();
    pv_d0(o, vb0, pa0, pa1, pa2, pa3); partialSM(pB0, pB1, m_reg, mnB, alB, C, thr);
    __syncthreads(); RESC(alB);
    finishSM(pB0, pB1, alB, l_reg, pa0, pa1, pa2, pa3); SBAR();
    pv_d0(o, vb0 + SHM_V, pa0, pa1, pa2, pa3);
    }
    if (hi == 0) li_l[r32] = l_reg; asm volatile("s_waitcnt lgkmcnt(0)" ::: "memory");
    float rli[16];
#pragma unroll
    for (int r = 0; r < 16; ++r) rli[r] = __builtin_amdgcn_rcpf(li_l[crow(r, hi)]);
    bf16_t* Ow = Ob + (long)(wid * 32) * ldo;
#pragma unroll
    for (int r = 0; r < 16; ++r) { const int orow = crow(r, hi);
#pragma unroll
        for (int d0 = 0; d0 < 4; ++d0) Ow[(long)orow * ldo + d0 * 32 + r32] = f2bf(o[d0][r] * rli[r]); }
    __syncthreads();
#undef SLOAD
#undef SWRITE
#undef SWAIT
#undef RESC
}

struct CvtMat { const float* src; bf16_t* dst; const float* kscale; int N, lddst, nb, mode; };
__device__ __forceinline__ void cvt_block(const CvtMat& m, int kb, int nbk, int lane) {
    const int a = lane & 7, ng = lane >> 3, k0 = kb * 64 + 8 * a, n0 = nbk * 32 + 4 * ng;
    const float* s = m.src + (size_t)k0 * m.N + n0;
    f32x4 v[8];
#pragma unroll
    for (int j = 0; j < 8; ++j) v[j] = *(const f32x4*)(s + (size_t)j * m.N);
    if (m.kscale) {
#pragma unroll
        for (int j = 0; j < 8; ++j) v[j] *= m.kscale[k0 + j];
    }
#pragma unroll
    for (int i = 0; i < 4; ++i) { const int n = n0 + i, row = (m.mode == 0) ? n : ((n >> 7) * 256 + (n & 127) + (m.mode - 1) * 128);
        u32x4 w; w.x = pk2(v[0][i], v[1][i]); w.y = pk2(v[2][i], v[3][i]); w.z = pk2(v[4][i], v[5][i]); w.w = pk2(v[6][i], v[7][i]);
        *(u32x4*)(m.dst + (size_t)row * m.lddst + k0) = w; }
}
constexpr int CVT_SMALL = 3904 + 2048 + 432 + 192;
__device__ __forceinline__ void cvt_small_task(const Params& p, int l, int t, int lane) {
    unsigned char* ws = p.ws; CvtMat m;
    if (t < 3904) { m = CvtMat{p.in[I_WIN] + (size_t)l * DM * IN_COLS, (bf16_t*)(ws + O_WIN) + (size_t)l * NP * DM, nullptr, IN_COLS, DM, 122, 0}; }
    else if ((t -= 3904) < 2048) { m = CvtMat{p.in[I_WOUT] + (size_t)l * DM * DM, (bf16_t*)(ws + O_WOUT) + (size_t)l * DM * DM, nullptr, DM, DM, 64, 0}; }
    else if ((t -= 2048) < 432) { m = CvtMat{p.in[I_WUQ] + (size_t)l * 768 * 1152, (bf16_t*)(ws + O_WUQ) + (size_t)l * NQP * 768, p.in[I_MQN] + l * 768, 1152, 768, 36, 0}; }
    else { t -= 432; m = CvtMat{p.in[I_WUKV] + (size_t)l * 256 * 1536, (bf16_t*)(ws + O_WUKV) + (size_t)l * 1536 * 256, p.in[I_MKVN] + l * 256, 1536, 256, 48, 0}; }
    cvt_block(m, t / m.nb, t % m.nb, lane);
}
constexpr int CVT_EXP = 65 * 1536;
__device__ __forceinline__ void cvt_exp_task(const Params& p, int l, int t, int lane) {
    unsigned char* ws = p.ws;
    const int e = t / 1536, r = t % 1536, which = r >> 9, q = r & 511; CvtMat m;
    if (which < 2) {
        const float* src = (e < NEXP) ? p.in[which == 0 ? I_EG : I_EU] + ((size_t)l * NEXP + e) * DM * EH : p.in[which == 0 ? I_SG : I_SU] + (size_t)l * DM * EH;
        m = CvtMat{src, (bf16_t*)(ws + O_EGU) + (size_t)e * 1024 * 2048, nullptr, EH, DM, 16, 1 + which};
    } else {
        const float* src = (e < NEXP) ? p.in[I_EDN] + ((size_t)l * NEXP + e) * EH * DM : p.in[I_SD] + (size_t)l * EH * DM;
        m = CvtMat{src, (bf16_t*)(ws + O_ED) + (size_t)e * 2048 * 512, nullptr, DM, EH, 64, 0};
    }
    cvt_block(m, q / m.nb, q % m.nb, lane);
}
__device__ __forceinline__ void cvt_exp_all(const Params& p, int l) {
    const int lane = otid() & 63, gw = blockIdx.x * 8 + owid(), GW = gridDim.x * 8;
    for (int t = gw; t < CVT_EXP; t += GW) cvt_exp_task(p, l, t, lane);
}
__device__ __forceinline__ void adaln_tasks(const Params& p, LAS float* lf) {
    const int lane = otid() & 63, wid = owid();
    float* MOD = (float*)(p.ws + O_MOD);
    for (int task = blockIdx.x; task < 384; task += gridDim.x) {
        const int cb = task % 192, l = task / 192, col = cb * 64 + lane;
        const float* W = p.in[I_ADAW] + (size_t)l * DM * 12288 + col;
        float acc[9];
#pragma unroll
        for (int r = 0; r < 9; ++r) acc[r] = 0.f;
        for (int kb = wid * 256; kb < wid * 256 + 256; kb += 64) {
            float sv[9];
#pragma unroll
            for (int r = 0; r < 8; ++r) sv[r] = silu_f(p.in[I_C][r * DM + kb + lane]);
            sv[8] = silu_f(p.in[I_CCTX][kb + lane]);
#pragma unroll 8
            for (int kk = 0; kk < 64; ++kk) { const float w = W[(size_t)(kb + kk) * 12288];
#pragma unroll
                for (int r = 0; r < 9; ++r) acc[r] += rdlane(sv[r], kk) * w; }
        }
#pragma unroll
        for (int r = 0; r < 9; ++r) lf[(wid * 9 + r) * 64 + lane] = acc[r];
        __syncthreads();
        for (int r = wid; r < 9; r += 8) { float s = p.in[I_ADAB][l * 12288 + col];
#pragma unroll
            for (int w = 0; w < 8; ++w) s += lf[(w * 9 + r) * 64 + lane];
            MOD[(size_t)(l * 9 + r) * 12288 + col] = s; }
        __syncthreads();
    }
}
__device__ __forceinline__ void hss_tasks(const Params& p) {
    const int lane = otid() & 63, gw = blockIdx.x * 8 + owid(), GW = gridDim.x * 8;
    for (int task = gw; task < 3 * 1024; task += GW) {
        const int set = task >> 10, l = (set == 1) ? 1 : 0, nset = (set == 2) ? 1 : 0, ord = (task >> 9) & 1, ch = task & 511, n = nset ? 256 : 2048;
        const float* HF = (const float*)(p.ws + O_HF) + (size_t)l * HF_LAYER + (nset ? HF_L0 : 0);
        const float* hf = HF + (size_t)((ord * 2 + 0) * 512 + ch) * n; const float* hb = HF + (size_t)((ord * 2 + 1) * 512 + ch) * n;
        float s = 0.f;
        for (int i = lane; i < n; i += 64) { const float a = hf[i], b = (i == 0) ? 0.f : hb[i]; s += a * a + b * b; }
        s = wave_sum(s);
        if (lane == 0) ((float*)(p.ws + O_HSS))[(size_t)((l * 2 + nset) * 2 + ord) * 512 + ch] = s;
    }
}
__device__ __forceinline__ void hyf_task(const Params& p, int l, int nset, int i0, LAS float* lf) {
    int tid = otid(); const int n = nset ? 256 : 2048;
    LAS float* feats = lf; LAS float* hd1 = lf + 8 * 33; LAS float* hd2 = hd1 + 512;
    if (tid < 8 * 33) { const int pos = tid / 33, f = tid % 33, i = i0 + pos; const float t = (float)i / (float)(n - 1), ang = 6.283185307179586f * (float)i / (float)n; float v;
        if (f == 0) v = t; else { const int j = (f - 1) & 15; const float band = 1e-4f + (float)j * ((15.0f - 1e-4f) / 15.0f); v = (f <= 16) ? cosf(ang * band) : sinf(ang * band); }
        feats[tid] = v; }
    __syncthreads();
    { const int pos = tid >> 6, j = tid & 63; const float* w1 = p.in[I_HYW1] + l * 33 * 64; float s = p.in[I_HYB1][l * 64 + j];
      for (int f = 0; f < 33; ++f) s += feats[pos * 33 + f] * w1[f * 64 + j];
      hd1[tid] = sinf(p.in[I_HYFREQ][l * 64 + j] * s); }
    __syncthreads();
    { const int pos = tid >> 6, j = tid & 63; const float* w2 = p.in[I_HYW2] + l * 64 * 64; float s = p.in[I_HYB2][l * 64 + j];
      for (int f = 0; f < 64; ++f) s += hd1[pos * 64 + f] * w2[f * 64 + j];
      hd2[tid] = sinf(p.in[I_HYFREQ][l * 64 + j] * s); }
    __syncthreads();
    const float* w3 = p.in[I_HYW3] + (size_t)l * 64 * 2048 + tid * 4;
    f32x4 acc[8];
#pragma unroll
    for (int q = 0; q < 8; ++q) acc[q] = (f32x4){0.f, 0.f, 0.f, 0.f};
    for (int j = 0; j < 64; ++j) { const f32x4 w = *(const f32x4*)(w3 + (size_t)j * 2048);
#pragma unroll
        for (int q = 0; q < 8; ++q) acc[q] += w * hd2[q * 64 + j]; }
    float* HF = (float*)(p.ws + O_HF) + (size_t)l * HF_LAYER + (nset ? HF_L0 : 0);
#pragma unroll
    for (int c = 0; c < 4; ++c) { const int col = tid * 4 + c, ord = col >> 10, dir = (col >> 9) & 1, ch = col & 511;
        const float delta = 3.0701134573253944f + (float)ch * ((15.350567286626973f - 3.0701134573253944f) / 511.0f); float v[8];
#pragma unroll
        for (int q = 0; q < 8; ++q) { const int i = i0 + q; const float t = (float)i / (float)(n - 1); v[q] = acc[q][c] * __expf(-t * delta); }
        float* dst = HF + (size_t)((ord * 2 + dir) * 512 + ch) * n + i0;
        *(f32x4*)dst = (f32x4){v[0], v[1], v[2], v[3]}; *(f32x4*)(dst + 4) = (f32x4){v[4], v[5], v[6], v[7]};    }
    __syncthreads();
}
__device__ __forceinline__ void phase_prologue(const Params& p, LAS unsigned char* lds) {
    const int tid = otid(); LAS float* lf = (LAS float*)lds;
    { const size_t gt = (size_t)blockIdx.x * NTHREADS + tid, GT = (size_t)gridDim.x * NTHREADS;
      for (int l = 0; l < NLAYER; ++l) {
          u32x4* z1 = (u32x4*)((bf16_t*)(p.ws + O_WIN) + ((size_t)l * NP + IN_COLS) * DM); const size_t n1 = (size_t)(NP - IN_COLS) * DM * 2 / 16;
          for (size_t i = gt; i < n1; i += GT) z1[i] = (u32x4){0u, 0u, 0u, 0u};
          u32x4* z2 = (u32x4*)((bf16_t*)(p.ws + O_WUQ) + ((size_t)l * NQP + 1152) * 768); const size_t n2 = (size_t)(NQP - 1152) * 768 * 2 / 16;
          for (size_t i = gt; i < n2; i += GT) z2[i] = (u32x4){0u, 0u, 0u, 0u};
      } }
    adaln_tasks(p, lf);
    for (int t = blockIdx.x; t < 544; t += gridDim.x) { if (t < 512) hyf_task(p, t >> 8, 0, (t & 255) * 8, lf); else hyf_task(p, 0, 1, (t - 512) * 8, lf); }
    { const int lane = tid & 63, gw = blockIdx.x * 8 + owid(), GW = gridDim.x * 8;
      for (int t = gw; t < NLAYER * CVT_SMALL; t += GW) cvt_small_task(p, t / CVT_SMALL, t % CVT_SMALL, lane); }
    cvt_exp_all(p, 0);
}

__device__ __forceinline__ void norm1_row(const Params& p, int l, int row, const float (&x)[32], int lane) {
    float ss = 0.f;
#pragma unroll
    for (int i = 0; i < 32; ++i) ss += x[i] * x[i];
    ss = wave_sum(ss); const float rstd = rsqrtf(ss * (1.0f / DM) + EPS);
    const float* g = p.in[I_NORMG] + (size_t)(l * 4 + 0) * DM; const float* mod = (const float*)(p.ws + O_MOD) + (size_t)(l * 9 + row_batch(row)) * 12288;
    bf16_t* H = (bf16_t*)(p.ws + O_H) + (size_t)row * DM;
#pragma unroll
    for (int j = 0; j < 8; ++j) { const int c = ROWCOL(j, lane); const f32x4 gv = *(const f32x4*)(g + c), sh = *(const f32x4*)(mod + c), sc = *(const f32x4*)(mod + DM + c); float h[4];
#pragma unroll
        for (int q = 0; q < 4; ++q) h[q] = x[j * 4 + q] * rstd * gv[q] * (1.0f + sc[q]) + sh[q];
        u32x2 w; w.x = pk2(h[0], h[1]); w.y = pk2(h[2], h[3]); *(u32x2*)(H + c) = w; }
}
__device__ __forceinline__ void phase_norm1(const Params& p, int l) {
    const int lane = otid() & 63, gw = blockIdx.x * 8 + owid(), GW = gridDim.x * 8;
    const int lane0 = lane;
    for (int row = gw; row < NTOK; row += GW) { int lane = lane0; asm volatile("" : "+v"(lane)); const float* src = resid_src(p, l, row); float x[32];
#pragma unroll
        for (int j = 0; j < 8; ++j) { const f32x4 v = *(const f32x4*)(src + ROWCOL(j, lane)); x[j * 4] = v[0]; x[j * 4 + 1] = v[1]; x[j * 4 + 2] = v[2]; x[j * 4 + 3] = v[3]; }
        norm1_row(p, l, row, x, lane); }
}

template <int HALF> __device__ __forceinline__ float rope1(float x, int e, float a) {
    float s, c; sincosf(a, &s, &c); const float pr = __shfl_xor(x, HALF);
    return (e & HALF) ? pr * s + x * c : x * c - pr * s;
}
__device__ __forceinline__ void gqa_post_row(const Params& p, int l, int row, int lane) {
    const bf16_t* P = (const bf16_t*)(p.ws + O_P) + (size_t)row * NP;
    const bool isctx = row >= NLAT; const int b = isctx ? (row - NLAT) >> 8 : row >> 11, t = isctx ? (row - NLAT) & 255 : row & 2047;
    const float inv = exp2f(-(float)(lane & 31) * (13.287712379549449f / 32.0f));
    const float a0 = (float)(t >> 6) * inv, a1 = (float)(t & 63) * inv;
    const float* qn = p.in[I_GQN] + l * 128; const float* kn = p.in[I_GKN] + l * 128;
    for (int h = 0; h < 6; ++h) {
        float x0 = bf2f(P[C_GQ + h * 128 + lane]), x1 = bf2f(P[C_GQ + h * 128 + 64 + lane]);
        const float rstd = rsqrtf(wave_sum(x0 * x0 + x1 * x1) * (1.0f / 128.0f) + EPS);
        x0 *= rstd * qn[lane]; x1 *= rstd * qn[64 + lane];
        if (!isctx) { x0 = rope1<32>(x0, lane, a0); x1 = rope1<32>(x1, lane, a1); }
        bf16_t* dst = isctx ? (bf16_t*)(p.ws + O_QGC) + ((size_t)(b * 6 + h) * CTXL + t) * 128 : (bf16_t*)(p.ws + O_QG) + ((size_t)(b * 6 + h) * SEQ + t) * 128;
        dst[lane] = f2bf(x0); dst[64 + lane] = f2bf(x1);
    }
    const int kpos = isctx ? t : CTXL + t;
    for (int h = 0; h < 2; ++h) {
        float x0 = bf2f(P[C_GK + h * 128 + lane]), x1 = bf2f(P[C_GK + h * 128 + 64 + lane]);
        const float rstd = rsqrtf(wave_sum(x0 * x0 + x1 * x1) * (1.0f / 128.0f) + EPS);
        x0 *= rstd * kn[lane]; x1 *= rstd * kn[64 + lane];
        if (!isctx) { x0 = rope1<32>(x0, lane, a0); x1 = rope1<32>(x1, lane, a1); }
        bf16_t* kd = (bf16_t*)(p.ws + O_KG) + ((size_t)(b * 2 + h) * LK + kpos) * 128; kd[lane] = f2bf(x0); kd[64 + lane] = f2bf(x1);
        bf16_t* vd = (bf16_t*)(p.ws + O_VG) + ((size_t)(b * 2 + h) * LK + kpos) * 128; vd[lane] = P[C_GV + h * 128 + lane]; vd[64 + lane] = P[C_GV + h * 128 + 64 + lane];
    }
}
__device__ __forceinline__ void seq_of(int row, int& s0, int& n) { if (row < NLAT) { s0 = row & ~2047; n = SEQ; } else { s0 = NLAT + ((row - NLAT) & ~255); n = CTXL; } }
__device__ __forceinline__ void load_conv_tile(const bf16_t* P, int t0, int pc0, LAS float* u) {
    int s0, n; seq_of(t0, s0, n);
    for (int i = otid(); i < 66 * 64; i += NTHREADS) { const int r = i >> 6, c = i & 63, row = t0 - 1 + r;
        u[r * 65 + c] = (row >= s0 && row < s0 + n) ? bf2f(P[(size_t)row * NP + pc0 + c]) : 0.f; }
}
__device__ __forceinline__ void hy_prep_task(const Params& p, int l, int t0, int c0, LAS float* u) {
    const bf16_t* P = (const bf16_t*)(p.ws + O_P);
    load_conv_tile(P, t0, c0, u);
    __syncthreads();
    const int tid = otid(), c = tid >> 3, tc = (tid & 7) * 8; const float* cw = p.in[I_HYCONV] + (size_t)l * 3 * 1536 + c0 + c;
    const float w0 = cw[0], w1 = cw[1536], w2 = cw[3072]; float y[8];
#pragma unroll
    for (int j = 0; j < 8; ++j) y[j] = w0 * u[(tc + j) * 65 + c] + w1 * u[(tc + j + 1) * 65 + c] + w2 * u[(tc + j + 2) * 65 + c];
    const int ch = c0 + c; bf16_t* dst = (ch < 512 ? (bf16_t*)(p.ws + O_VT) + (size_t)ch * NTOK : (bf16_t*)(p.ws + O_X1T) + (size_t)(ch - 512) * NTOK) + t0 + tc;
    u32x4 w; w.x = pk2(y[0], y[1]); w.y = pk2(y[2], y[3]); w.z = pk2(y[4], y[5]); w.w = pk2(y[6], y[7]); *(u32x4*)dst = w;
    __syncthreads();
}
__device__ __forceinline__ void mla_post_row(const Params& p, int l, int row, int lane) {
    const bf16_t* P = (const bf16_t*)(p.ws + O_P) + (size_t)row * NP;
    const bool isctx = row >= NLAT; const int b = isctx ? (row - NLAT) >> 8 : row >> 11, t = isctx ? (row - NLAT) & 255 : row & 2047;
    float sq = 0.f, skv = 0.f;
#pragma unroll
    for (int j = 0; j < 12; ++j) { const float v = bf2f(P[C_CQ + j * 64 + lane]); sq += v * v; }
#pragma unroll
    for (int j = 0; j < 4; ++j) { const float v = bf2f(P[C_CKV + j * 64 + lane]); skv += v * v; }
    const float rq = rsqrtf(wave_sum(sq) * (1.0f / 768.0f) + EPS), rkv = rsqrtf(wave_sum(skv) * (1.0f / 256.0f) + EPS);
    const int half = lane >> 5, e = lane & 31;
    const float inv = exp2f(-(float)(e & 15) * (13.287712379549449f / 16.0f));
    const float ang = (float)(half ? (t & 63) : (t >> 6)) * inv;
    const bf16_t* QR = (const bf16_t*)(p.ws + O_QRAW) + (size_t)row * NQP; const bf16_t* KV = (const bf16_t*)(p.ws + O_KVRAW) + (size_t)row * 1536;
    float kr = bf2f(P[C_KR + lane]); if (!isctx) kr = rope1<16>(kr, e, ang);
    const bf16_t krb = f2bf(kr); const int kpos = isctx ? t : CTXL + t;
    for (int h = 0; h < 6; ++h) {
        bf16_t* qd = isctx ? (bf16_t*)(p.ws + O_QMC) + ((size_t)(b * 6 + h) * CTXL + t) * 192 : (bf16_t*)(p.ws + O_QM) + ((size_t)(b * 6 + h) * SEQ + t) * 192;
        qd[lane] = f2bf(bf2f(QR[h * 192 + lane]) * rq); qd[64 + lane] = f2bf(bf2f(QR[h * 192 + 64 + lane]) * rq);
        float qr = bf2f(QR[h * 192 + 128 + lane]) * rq; if (!isctx) qr = rope1<16>(qr, e, ang);
        qd[128 + lane] = f2bf(qr);
        bf16_t* kd = (bf16_t*)(p.ws + O_KM) + ((size_t)(b * 6 + h) * LK + kpos) * 192;
        kd[lane] = f2bf(bf2f(KV[h * 256 + lane]) * rkv); kd[64 + lane] = f2bf(bf2f(KV[h * 256 + 64 + lane]) * rkv); kd[128 + lane] = krb;
        bf16_t* vd = (bf16_t*)(p.ws + O_VM) + ((size_t)(b * 6 + h) * LK + kpos) * 128;
        vd[lane] = f2bf(bf2f(KV[h * 256 + 128 + lane]) * rkv); vd[64 + lane] = f2bf(bf2f(KV[h * 256 + 192 + lane]) * rkv);
    }
}

__device__ __forceinline__ void hyconv_unit_valu(const Params& p, int l, int nset, int c, LAS float* lf) {
    const int tid = otid(), n = nset ? CTXL : SEQ, tokbase = nset ? NLAT : 0;
    LAS float* kc = lf; LAS float* z = lf + 4096; LAS float* z2 = z + 8 * SEQ;
    const float* HF = (const float*)(p.ws + O_HF) + (size_t)l * HF_LAYER + (nset ? HF_L0 : 0); const float* HSS = (const float*)(p.ws + O_HSS) + (size_t)((l * 2 + nset) * 2) * 512;
    const bf16_t* VT = (const bf16_t*)(p.ws + O_VT) + (size_t)c * NTOK + tokbase; const bf16_t* X1T = (const bf16_t*)(p.ws + O_X1T) + (size_t)c * NTOK + tokbase;
    bf16_t* Y2T = (bf16_t*)(p.ws + O_Y2T) + (size_t)c * NTOK + tokbase;
    for (int i = tid; i < 8 * n; i += NTHREADS) z[i] = bf2f(VT[i]);
    for (int ord = 0; ord < 2; ++ord) {
        const float rs = rsqrtf(HSS[ord * 512 + c] + EPS); const float* hf = HF + (size_t)((ord * 2 + 0) * 512 + c) * n; const float* hb = HF + (size_t)((ord * 2 + 1) * 512 + c) * n;
        for (int m = tid; m < 2 * n; m += NTHREADS) { const int lag = m - (n - 1); kc[m] = (m == 2 * n - 1) ? 0.f : (lag >= 0 ? hf[lag] : hb[-lag]) * rs; }
        __syncthreads();
        const LAS float* zs = ord ? z2 : z; const float skip = p.in[I_HYSKIP][(size_t)(l * 2 + ord) * 512 + c];
        for (int q = tid; q < n; q += NTHREADS) {
            const int b = q / (n >> 3), t0 = (q % (n >> 3)) * 8; float acc[8];
#pragma unroll
            for (int j = 0; j < 8; ++j) acc[j] = 0.f;
            const LAS float* zb = zs + b * n;
            for (int sb = 0; sb < n; sb += 8) {
                const LAS float* kb = kc + (t0 - sb + n - 8); float w[16];
#pragma unroll
                for (int i = 0; i < 4; ++i) { const f32x4 v = *(const LAS f32x4*)(kb + 4 * i); w[4 * i] = v[0]; w[4 * i + 1] = v[1]; w[4 * i + 2] = v[2]; w[4 * i + 3] = v[3]; }
                const f32x4 za = *(const LAS f32x4*)(zb + sb), zc = *(const LAS f32x4*)(zb + sb + 4); const float zv[8] = {za[0], za[1], za[2], za[3], zc[0], zc[1], zc[2], zc[3]};
#pragma unroll
                for (int ss = 0; ss < 8; ++ss)
#pragma unroll
                    for (int j = 0; j < 8; ++j) acc[j] += w[j - ss + 7] * zv[ss];
            }
            if (ord == 0) {
#pragma unroll
                for (int j = 0; j < 8; ++j) { const int idx = b * n + t0 + j; z2[idx] = bf2f(X1T[idx]) * (acc[j] + skip * z[idx]); }
            } else { float y[8];
#pragma unroll
                for (int j = 0; j < 8; ++j) y[j] = acc[j] + skip * z2[b * n + t0 + j];
                u32x4 w; w.x = pk2(y[0], y[1]); w.y = pk2(y[2], y[3]); w.z = pk2(y[4], y[5]); w.w = pk2(y[6], y[7]); *(u32x4*)(Y2T + b * n + t0) = w; }
        }
        __syncthreads();
    }
}
constexpr int HC_COPYB = 8256, HC_ROWB = 4560, HC_PAD = 112, HC_KR = 4112, HC_M0 = 2064;
constexpr int HC_ZOFF = 8 * HC_COPYB, HC_Z2OFF = HC_ZOFF + 8 * HC_ROWB;
__device__ __forceinline__ void hyconv_unit_mfma(const Params& p, int l, int c, LAS unsigned char* lds) {
    const int tid = otid(), wid = __builtin_amdgcn_readfirstlane(tid >> 6), lane = tid & 63;
    LAS unsigned char* CP = lds; LAS unsigned char* Zr = lds + HC_ZOFF; LAS unsigned char* Z2r = lds + HC_Z2OFF;
    const float* HF = (const float*)(p.ws + O_HF) + (size_t)l * HF_LAYER; const float* HSS = (const float*)(p.ws + O_HSS) + (size_t)(l * 4) * 512;
    const bf16_t* VT = (const bf16_t*)(p.ws + O_VT) + (size_t)c * NTOK; const bf16_t* X1T = (const bf16_t*)(p.ws + O_X1T) + (size_t)c * NTOK; bf16_t* Y2T = (bf16_t*)(p.ws + O_Y2T) + (size_t)c * NTOK;
    for (int q = tid; q < 8 * 256; q += NTHREADS) { const int b = q >> 8, ch = q & 255; *(LAS u32x4*)(Zr + b * HC_ROWB + (HC_PAD + ch * 8) * 2) = *(const u32x4*)(VT + b * SEQ + ch * 8); }
    for (int q = tid; q < 8 * 29; q += NTHREADS) { const int b = q / 29, ch = q % 29; const int e0 = ch < 14 ? ch * 8 : HC_PAD + SEQ + (ch - 14) * 8; *(LAS u32x4*)(Zr + b * HC_ROWB + e0 * 2) = (u32x4){0u, 0u, 0u, 0u}; }
    const int a = lane & 31, kg = lane >> 5, bq = a >> 2, isub = a & 3;
    const int Aoff = (a & 7) * HC_COPYB + (HC_M0 - 8 * (a >> 3) + 8 * kg) * 2;
    const int g0 = 2 * wid;
    const int Boff = bq * HC_ROWB + (HC_PAD + 128 * g0 + 32 * isub + 8 * kg) * 2;
    for (int ord = 0; ord < 2; ++ord) {
        LAS float* kr = (LAS float*)(ord == 0 ? Z2r : Zr);
        { const float rs = rsqrtf(HSS[ord * 512 + c] + EPS); const float* hf = HF + (size_t)((ord * 2 + 0) * 512 + c) * SEQ; const float* hb = HF + (size_t)((ord * 2 + 1) * 512 + c) * SEQ;
          for (int m = tid; m < HC_KR; m += NTHREADS) { const int lag = HC_M0 - m; float v = 0.f; if (lag >= 0 && lag < SEQ) v = hf[lag] * rs; else if (lag < 0 && lag > -SEQ) v = hb[-lag] * rs; kr[m] = v; } }
        __syncthreads();
        for (int q = tid; q < 8 * 516; q += NTHREADS) { const int sft = q / 516, ch = q % 516; float v[8];
#pragma unroll
            for (int j = 0; j < 8; ++j) { const int m = ch * 8 + j - sft; v[j] = (m >= 0 && m < HC_KR) ? kr[m] : 0.f; }
            u32x4 w; w.x = pk2(v[0], v[1]); w.y = pk2(v[2], v[3]); w.z = pk2(v[4], v[5]); w.w = pk2(v[6], v[7]); *(LAS u32x4*)(CP + sft * HC_COPYB + ch * 16) = w; }
        __syncthreads();
        if (ord == 0) for (int q = tid; q < 8 * 29; q += NTHREADS) { const int b = q / 29, ch = q % 29; const int e0 = ch < 14 ? ch * 8 : HC_PAD + SEQ + (ch - 14) * 8; *(LAS u32x4*)(Z2r + b * HC_ROWB + e0 * 2) = (u32x4){0u, 0u, 0u, 0u}; }
        const LAS unsigned char* Zs = ord ? Z2r : Zr;
        f32x16 acc0 = {}, acc1 = {};
        const int e_lo = 16 * wid - 127, e_mid0 = 16 * wid - 119, e_mid1 = 16 * wid + 7, e_hi = 16 * wid + 15;
        for (int e = e_lo; e < e_mid0; ++e) { const bf16x8 A = *(const LAS bf16x8*)(CP + Aoff - 32 * e); const bf16x8 B0 = *(const LAS bf16x8*)(Zs + Boff - 32 * e);
            acc0 = __builtin_amdgcn_mfma_f32_32x32x16_bf16(A, B0, acc0, 0, 0, 0); }
#pragma unroll 2
        for (int e = e_mid0; e <= e_mid1; ++e) { const bf16x8 A = *(const LAS bf16x8*)(CP + Aoff - 32 * e); const bf16x8 B0 = *(const LAS bf16x8*)(Zs + Boff - 32 * e); const bf16x8 B1 = *(const LAS bf16x8*)(Zs + Boff + 256 - 32 * e);
            acc0 = __builtin_amdgcn_mfma_f32_32x32x16_bf16(A, B0, acc0, 0, 0, 0); acc1 = __builtin_amdgcn_mfma_f32_32x32x16_bf16(A, B1, acc1, 0, 0, 0); }
        for (int e = e_mid1 + 1; e <= e_hi; ++e) { const bf16x8 A = *(const LAS bf16x8*)(CP + Aoff - 32 * e); const bf16x8 B1 = *(const LAS bf16x8*)(Zs + Boff + 256 - 32 * e);
            acc1 = __builtin_amdgcn_mfma_f32_32x32x16_bf16(A, B1, acc1, 0, 0, 0); }
        const float skip = p.in[I_HYSKIP][(size_t)(l * 2 + ord) * 512 + c];
#pragma unroll
        for (int gi = 0; gi < 2; ++gi) {
#pragma unroll
            for (int q = 0; q < 4; ++q) { const int t = 128 * (g0 + gi) + 32 * isub + 8 * q + 4 * kg; float y[4];
#pragma unroll
                for (int j = 0; j < 4; ++j) y[j] = gi ? acc1[4 * q + j] : acc0[4 * q + j];
                const u32x2 zz = *(const LAS u32x2*)(Zs + bq * HC_ROWB + (HC_PAD + t) * 2);
                const float z0 = __uint_as_float(zz.x << 16), z1 = __uint_as_float(zz.x & 0xffff0000u), z2 = __uint_as_float(zz.y << 16), z3 = __uint_as_float(zz.y & 0xffff0000u);
                y[0] += skip * z0; y[1] += skip * z1; y[2] += skip * z2; y[3] += skip * z3;
                if (ord == 0) { const u32x2 xx = *(const u32x2*)(X1T + bq * SEQ + t);
                    y[0] *= __uint_as_float(xx.x << 16); y[1] *= __uint_as_float(xx.x & 0xffff0000u); y[2] *= __uint_as_float(xx.y << 16); y[3] *= __uint_as_float(xx.y & 0xffff0000u);
                    u32x2 w; w.x = pk2(y[0], y[1]); w.y = pk2(y[2], y[3]); *(LAS u32x2*)(Z2r + bq * HC_ROWB + (HC_PAD + t) * 2) = w; }
                else { u32x2 w; w.x = pk2(y[0], y[1]); w.y = pk2(y[2], y[3]); *(u32x2*)(Y2T + bq * SEQ + t) = w; } }
        }
        __syncthreads();
    }
}
__device__ __forceinline__ void hy_fin_task(const Params& p, int l, int t0, int c0, LAS float* u) {
    const bf16_t* P = (const bf16_t*)(p.ws + O_P); LAS float* y = u + 66 * 65;
    load_conv_tile(P, t0, 1024 + c0, u);
    const int tid = otid();
    { const int c = tid >> 3, tc = (tid & 7) * 8; const u32x4 v = *(const u32x4*)((const bf16_t*)(p.ws + O_Y2T) + (size_t)(c0 + c) * NTOK + t0 + tc);
#pragma unroll
      for (int j = 0; j < 4; ++j) { y[c * 65 + tc + 2 * j] = __uint_as_float(v[j] << 16); y[c * 65 + tc + 2 * j + 1] = __uint_as_float(v[j] & 0xffff0000u); } }
    __syncthreads();
    { const int t = tid >> 3, cc = (tid & 7) * 8; const float* cw = p.in[I_HYCONV] + (size_t)l * 3 * 1536 + 1024 + c0 + cc; float o[8];
#pragma unroll
      for (int j = 0; j < 8; ++j) { const int c = cc + j; const float x2 = cw[j] * u[t * 65 + c] + cw[1536 + j] * u[(t + 1) * 65 + c] + cw[3072 + j] * u[(t + 2) * 65 + c]; o[j] = x2 * y[c * 65 + t]; }
      u32x4 w; w.x = pk2(o[0], o[1]); w.y = pk2(o[2], o[3]); w.z = pk2(o[4], o[5]); w.w = pk2(o[6], o[7]);
      *(u32x4*)((bf16_t*)(p.ws + O_MIX) + (size_t)(t0 + t) * DM + c0 + cc) = w; }
    __syncthreads();
}

__device__ __forceinline__ void mla_unit(const Params& p, int b, int h, int qb, bool ctxq, LAS unsigned char* lds) {
    unsigned char* ws = p.ws;
    const bf16_t* Q = ctxq ? (const bf16_t*)(ws + O_QMC) + (size_t)(b * 6 + h) * CTXL * 192 : (const bf16_t*)(ws + O_QM) + ((size_t)(b * 6 + h) * SEQ + qb * 256) * 192;
    bf16_t* O = (bf16_t*)(ws + O_MIX) + (size_t)(ctxq ? NLAT + b * CTXL : b * SEQ + qb * 256) * DM + 512 + h * 128;
    attn_body<192, 0>(Q, (const bf16_t*)(ws + O_KM) + (size_t)(b * 6 + h) * LK * 192, (const bf16_t*)(ws + O_VM) + (size_t)(b * 6 + h) * LK * 128, O, DM, ctxq ? CTXL : LK, 0.07216878364870322f, (char*)lds);
}
__device__ __forceinline__ void gqa_unit(const Params& p, int b, int h, int qb, bool ctxq, LAS unsigned char* lds) {
    unsigned char* ws = p.ws;
    const bf16_t* Q = ctxq ? (const bf16_t*)(ws + O_QGC) + (size_t)(b * 6 + h) * CTXL * 128 : (const bf16_t*)(ws + O_QG) + ((size_t)(b * 6 + h) * SEQ + qb * 256) * 128;
    bf16_t* O = (bf16_t*)(ws + O_MIX) + (size_t)(ctxq ? NLAT + b * CTXL : b * SEQ + qb * 256) * DM + 1280 + h * 128;
    attn_body<128, GQA_SD>(Q, (const bf16_t*)(ws + O_KG) + (size_t)(b * 2 + h / 3) * LK * 128, (const bf16_t*)(ws + O_VG) + (size_t)(b * 2 + h / 3) * LK * 128, O, DM, ctxq ? CTXL : LK, 0.08838834764831845f, (char*)lds);
}
__device__ __forceinline__ void phase_mixer(const Params& p, int l, LAS unsigned char* lds) {
    const int G = gridDim.x, bid = blockIdx.x; const bool last = (l == NLAYER - 1);
    for (int u = bid; u < 384 + (last ? 0 : 48); u += G) { if (u < 384) mla_unit(p, u / 48, (u >> 3) % 6, u & 7, false, lds); else mla_unit(p, (u - 384) / 6, (u - 384) % 6, 0, true, lds); }
    for (int u = (bid + G / 2) % G; u < 384 + (last ? 0 : 48); u += G) { if (u < 384) gqa_unit(p, u / 48, (u >> 3) % 6, u & 7, false, lds); else gqa_unit(p, (u - 384) / 6, (u - 384) % 6, 0, true, lds); }
#ifndef CONV_REP
#define CONV_REP 1
#endif
    for (int rep = 0; rep < CONV_REP; ++rep) {
#if HY_MFMA
    for (int u = bid; u < 512; u += G) hyconv_unit_mfma(p, l, u, lds);
    if (!last) for (int u = bid; u < 512; u += G) hyconv_unit_valu(p, l, 1, u, (LAS float*)lds);
#else
    for (int u = bid; u < (last ? 512 : 1024); u += G) hyconv_unit_valu(p, l, u >> 9, u & 511, (LAS float*)lds);
#endif
    }
}

constexpr int RT_FS = DM + 4;
__device__ __forceinline__ void route_row_pre(const Params& p, int l, int row, int lane, LAS float* fdst, const float* g1, const float* g2) {
    const float* mod = (const float*)(p.ws + O_MOD) + (size_t)(l * 9 + row_batch(row)) * 12288;
    const bf16_t* O = (const bf16_t*)(p.ws + O_OUT) + (size_t)row * DM; const float* rs = resid_src(p, l, row); float* X = (float*)(p.ws + O_X) + (size_t)row * DM; bf16_t* H = (bf16_t*)(p.ws + O_H) + (size_t)row * DM;
    float o[32], x[32]; float ss = 0.f;
#pragma unroll
    for (int j = 0; j < 8; ++j) { const u32x2 v = *(const u32x2*)(O + ROWCOL(j, lane)); o[j * 4] = __uint_as_float(v.x << 16); o[j * 4 + 1] = __uint_as_float(v.x & 0xffff0000u); o[j * 4 + 2] = __uint_as_float(v.y << 16); o[j * 4 + 3] = __uint_as_float(v.y & 0xffff0000u); }
#pragma unroll
    for (int i = 0; i < 32; ++i) ss += o[i] * o[i];
    const float r1 = rsqrtf(wave_sum(ss) * (1.0f / DM) + EPS); float s2 = 0.f;
#pragma unroll
    for (int j = 0; j < 8; ++j) { const int c = ROWCOL(j, lane); const f32x4 xv = *(const f32x4*)(rs + c), gv = *(const f32x4*)(g1 + c), ga = *(const f32x4*)(mod + 2 * DM + c); f32x4 xn;
#pragma unroll
        for (int q = 0; q < 4; ++q) { xn[q] = xv[q] + ga[q] * (o[j * 4 + q] * r1 * gv[q]); x[j * 4 + q] = xn[q]; s2 += xn[q] * xn[q]; }
        *(f32x4*)(X + c) = xn; }
    const float r2 = rsqrtf(wave_sum(s2) * (1.0f / DM) + EPS);
#pragma unroll
    for (int j = 0; j < 8; ++j) { const int c = ROWCOL(j, lane); const f32x4 gv = *(const f32x4*)(g2 + c), sh = *(const f32x4*)(mod + 3 * DM + c), sc = *(const f32x4*)(mod + 4 * DM + c); f32x4 f;
#pragma unroll
        for (int q = 0; q < 4; ++q) f[q] = x[j * 4 + q] * r2 * gv[q] * (1.0f + sc[q]) + sh[q];
        u32x2 w; w.x = pk2(f[0], f[1]); w.y = pk2(f[2], f[3]); *(u32x2*)(H + c) = w; *(LAS f32x4*)(fdst + c) = f; }
}
__device__ __forceinline__ void route_row_topk(const Params& p, int l, int row, int lane, float logit, LAS unsigned* cntL) {
    const float score = 1.0f / (1.0f + expf(-logit)), biased = score + p.in[I_RB][l * 64 + lane];
    float m1 = biased; m1 = fmaxf(m1, __shfl_xor(m1, 1)); m1 = fmaxf(m1, __shfl_xor(m1, 2)); m1 = fmaxf(m1, __shfl_xor(m1, 4));
    const unsigned long long bal = __ballot(biased == m1); const int first = __builtin_ctz((unsigned)((bal >> (lane & ~7)) & 0xffull));
    float m2 = ((lane & 7) == first) ? -INFINITY : biased; m2 = fmaxf(m2, __shfl_xor(m2, 1)); m2 = fmaxf(m2, __shfl_xor(m2, 2)); m2 = fmaxf(m2, __shfl_xor(m2, 4));
    const float gs = m1 + m2; const int grp = lane >> 3; int rank = 0;
#pragma unroll
    for (int q = 0; q < 8; ++q) { const float v = rdlane(gs, q * 8); rank += (v > gs || (v == gs && q < grp)) ? 1 : 0; }
    const float cand = (rank < 4) ? biased : -INFINITY; int re = 0;
    for (int q = 0; q < 64; ++q) { const float v = rdlane(cand, q); re += (v > cand || (v == cand && q < lane)) ? 1 : 0; }
    const bool sel = re < TOPK; const float ssum = wave_sum(sel ? score : 0.f);
    if (sel) { ((int*)(p.ws + O_EIDX))[(size_t)row * 8 + re] = lane; ((float*)(p.ws + O_GATE))[(size_t)row * 8 + re] = score / ssum * 2.5f;
        ((int*)(p.ws + O_SLOT))[(size_t)row * 8 + re] = (int)__hip_atomic_fetch_add(&cntL[lane], 1u, __ATOMIC_RELAXED, __HIP_MEMORY_SCOPE_WORKGROUP); }
}
__device__ __forceinline__ void phase_route(const Params& p, int l, LAS unsigned char* lds) {
    const int tid = otid(), wid = __builtin_amdgcn_readfirstlane(tid >> 6), lane0 = tid & 63; const bool last = (l == NLAYER - 1); const int NR = last ? NLAT : NTOK;
    LAS float* frow = (LAS float*)lds; LAS float* part = frow;
    const float* g1 = p.in[I_NORMG] + (size_t)(l * 4 + 1) * DM; const float* g2 = p.in[I_NORMG] + (size_t)(l * 4 + 2) * DM;
    const float* RW = p.in[I_RW] + (size_t)l * DM * NEXP; LAS unsigned* cntL = (LAS unsigned*)(lds + LDS_CNTL);
    if (tid < 64) cntL[tid] = 0u;
    { int* stok = (int*)(p.ws + O_STOK); for (int i = blockIdx.x * NTHREADS + tid; i < NSLOTS; i += gridDim.x * NTHREADS) stok[i] = (i < RSLOTS) ? -1 : ((i - RSLOTS) < NR ? i - RSLOTS : -1); }
    for (int g = blockIdx.x; g < NR / 16; g += gridDim.x) {
        int lane = lane0; asm volatile("" : "+v"(lane));
        for (int rr = 0; rr < 2; ++rr) route_row_pre(p, l, g * 16 + wid * 2 + rr, lane, frow + (wid * 2 + rr) * RT_FS, g1, g2);
        __syncthreads();
        f32x4 acc[4];
#pragma unroll
        for (int j = 0; j < 4; ++j) acc[j] = (f32x4){0.f, 0.f, 0.f, 0.f};
        { const int r16 = lane & 15, kq = lane >> 4; const LAS float* fa = frow + r16 * RT_FS + wid * 256 + 4 * kq; const float* rb = RW + (size_t)(wid * 256 + 4 * kq) * 64 + 4 * r16;
#pragma unroll 2
          for (int st = 0; st < 16; ++st) { const f32x4 a = *(const LAS f32x4*)(fa + 16 * st); f32x4 b[4];
#pragma unroll
              for (int i = 0; i < 4; ++i) b[i] = *(const f32x4*)(rb + (size_t)(16 * st + i) * 64);
#pragma unroll
              for (int i = 0; i < 4; ++i)
#pragma unroll
                  for (int j = 0; j < 4; ++j) acc[j] = __builtin_amdgcn_mfma_f32_16x16x4f32(a[i], b[i][j], acc[j], 0, 0, 0); }
          __syncthreads();
#pragma unroll
          for (int r = 0; r < 4; ++r) *(LAS f32x4*)(part + (wid * 16 + 4 * kq + r) * 64 + 4 * r16) = (f32x4){acc[0][r], acc[1][r], acc[2][r], acc[3][r]}; }
        __syncthreads();
        for (int rr = 0; rr < 2; ++rr) { const int r16 = wid * 2 + rr; float logit = 0.f;
#pragma unroll
            for (int w = 0; w < 8; ++w) logit += part[(w * 16 + r16) * 64 + lane];
            route_row_topk(p, l, g * 16 + r16, lane, logit, cntL); }
        __syncthreads();
    }
    __syncthreads();
    if (tid < 64) ((unsigned*)(p.ws + O_WCNT))[blockIdx.x * 64 + tid] = cntL[tid];
}
__device__ __forceinline__ void phase_place(const Params& p, int l, LAS unsigned char* lds) {
    const int tid = otid(); const int NR = (l == NLAYER - 1) ? NLAT : NTOK, G = gridDim.x;
    LAS int* woff = (LAS int*)lds; LAS int* csum = woff + 512 * 64; LAS int* pstart = csum + 8 * 64;
    const unsigned* wcnt = (const unsigned*)(p.ws + O_WCNT);
    for (int i = tid; i < G * 64; i += NTHREADS) woff[i] = (int)wcnt[i];
    __syncthreads();
    { const int e = tid & 63, ch = tid >> 6, cs = (G + 7) >> 3, w0 = ch * cs, w1 = (w0 + cs < G) ? w0 + cs : G; int run = 0;
      for (int w = w0; w < w1; ++w) { const int t = woff[w * 64 + e]; woff[w * 64 + e] = run; run += t; }
      csum[ch * 64 + e] = run;
      __syncthreads();
      int base = 0, tot = 0;
#pragma unroll
      for (int c2 = 0; c2 < 8; ++c2) { const int v = csum[c2 * 64 + e]; if (c2 < ch) base += v; tot += v; }
      for (int w = w0; w < w1; ++w) woff[w * 64 + e] += base;
      if (tid < 64) { const int ntile = (tot + 255) >> 8; pstart[tid] = (wave_incl_scan(ntile, tid) - ntile) * 256;
          if (blockIdx.x == 0) ((unsigned*)(p.ws + O_CTL))[CW_CNT + l * 64 + tid] = (unsigned)tot; } }
    __syncthreads();
    const int* eidx = (const int*)(p.ws + O_EIDX); int* slot = (int*)(p.ws + O_SLOT); int* stok = (int*)(p.ws + O_STOK);
    for (int i = blockIdx.x * NTHREADS + tid; i < NR * TOPK; i += G * NTHREADS) { const int row = i / TOPK, k = i % TOPK, e = eidx[(size_t)row * 8 + k], wg = (row >> 4) % G;
        const int s = pstart[e] + woff[wg * 64 + e] + slot[(size_t)row * 8 + k]; slot[(size_t)row * 8 + k] = s; stok[s] = row; }
    __syncthreads();
}
__device__ __forceinline__ void phase_final(const Params& p, int l) {
    const int lane = otid() & 63, gw = blockIdx.x * 8 + owid(), GW = gridDim.x * 8; const bool last = (l == NLAYER - 1); const int NR = last ? NLAT : NTOK;
    const bf16_t* DO = (const bf16_t*)(p.ws + O_DOUT); const float* g3 = p.in[I_NORMG] + (size_t)(l * 4 + 3) * DM;
    const int lane0 = lane;
    for (int row = gw; row < NR; row += GW) {
        int lane = lane0; asm volatile("" : "+v"(lane));
        const int sl = (lane < TOPK) ? ((const int*)(p.ws + O_SLOT))[(size_t)row * 8 + lane] : 0; const float gl = (lane < TOPK) ? ((const float*)(p.ws + O_GATE))[(size_t)row * 8 + lane] : 0.f;
        float y[32];
#pragma unroll
        for (int i = 0; i < 32; ++i) y[i] = 0.f;
#pragma unroll
        for (int kb = 0; kb < 7; kb += 4) {
            u32x2 v[4][8]; float gt[4];
#pragma unroll
            for (int kk = 0; kk < 4; ++kk) { const int k = kb + kk; if (k < 7) { const int s = (k == 0) ? RSLOTS + row : __builtin_amdgcn_readlane(sl, k - 1); const bf16_t* src = DO + (size_t)s * DM; gt[kk] = (k == 0) ? 1.0f : rdlane(gl, k - 1);
#pragma unroll
                for (int j = 0; j < 8; ++j) v[kk][j] = *(const u32x2*)(src + ROWCOL(j, lane)); } }
#pragma unroll
            for (int kk = 0; kk < 4; ++kk) { if (kb + kk < 7) {
#pragma unroll
                for (int j = 0; j < 8; ++j) { const float g = gt[kk]; y[j * 4] += g * __uint_as_float(v[kk][j].x << 16); y[j * 4 + 1] += g * __uint_as_float(v[kk][j].x & 0xffff0000u); y[j * 4 + 2] += g * __uint_as_float(v[kk][j].y << 16); y[j * 4 + 3] += g * __uint_as_float(v[kk][j].y & 0xffff0000u); } } }
        }
        float ss = 0.f;
#pragma unroll
        for (int i = 0; i < 32; ++i) ss += y[i] * y[i];
        const float r = rsqrtf(wave_sum(ss) * (1.0f / DM) + EPS); const float* mod = (const float*)(p.ws + O_MOD) + (size_t)(l * 9 + row_batch(row)) * 12288;
        float* X = (float*)(p.ws + O_X) + (size_t)row * DM; float x[32];
#pragma unroll
        for (int j = 0; j < 8; ++j) { const int c = ROWCOL(j, lane); const f32x4 xv = *(const f32x4*)(X + c), gv = *(const f32x4*)(g3 + c), gf = *(const f32x4*)(mod + 5 * DM + c); f32x4 xn;
#pragma unroll
            for (int q = 0; q < 4; ++q) { xn[q] = xv[q] + gf[q] * (y[j * 4 + q] * r * gv[q]); x[j * 4 + q] = xn[q]; }
            if (last) *(f32x4*)(p.out + (size_t)row * DM + c) = xn; else *(f32x4*)(X + c) = xn; }
        if (!last) norm1_row(p, l + 1, row, x, lane);
    }
}

#define XB_TMO      128
#define XB_XCNT(j)  (256  + 64 * (j))
#define XB_XSUB(j)  (1280 + 64 * (j))
#define XB_XGEN(j)  (2304 + 64 * (j))
#define XB_TOP      3328
#define XB_TOPGEN   3392
#define XCD_BAR_WORDS 3456
#define XB_SPIN_CAP (1u << 23)

__device__ __forceinline__ unsigned xb_ld(unsigned* p)              { return __hip_atomic_load(p, __ATOMIC_RELAXED, __HIP_MEMORY_SCOPE_AGENT); }
__device__ __forceinline__ unsigned xb_add(unsigned* p, unsigned v) { return __hip_atomic_fetch_add(p, v, __ATOMIC_RELAXED, __HIP_MEMORY_SCOPE_AGENT); }
__device__ __forceinline__ unsigned xb_xcc_id() { return (unsigned)__builtin_amdgcn_s_getreg((3 << 11) | 20) & 0xFu; }
#define XB_SPIN(cond, bar) do { unsigned _sp = 0; while (cond) { __builtin_amdgcn_s_sleep(1); \
    if ((++_sp & 255u) == 0u) { if (xb_ld(&(bar)[XB_TMO])) break; if (_sp > XB_SPIN_CAP) { atomicAdd(&(bar)[XB_TMO], 1u); break; } } } } while (0)

struct XcdBarrier {
    unsigned* bar; unsigned x;
    volatile LAS unsigned* st;
};

__device__ __forceinline__ XcdBarrier xcd_barrier_post(unsigned* bar, volatile LAS unsigned* st) {
    XcdBarrier b; b.bar = bar; b.x = xb_xcc_id(); b.st = st;
    if (threadIdx.x == 0) (void)xb_add(&bar[XB_XCNT(b.x)], 1u);
    return b;
}
__device__ __forceinline__ void xcd_barrier_complete(unsigned* bar, unsigned x, unsigned& nloc, unsigned& nx) {
    const unsigned G = gridDim.x * gridDim.y * gridDim.z;
    unsigned sum, cnt, mine, sp = 0u;
    for (;;) {
        sum = 0u; cnt = 0u; mine = 0u;
#pragma unroll
        for (unsigned j = 0; j < 16; ++j) { const unsigned c = xb_ld(&bar[XB_XCNT(j)]); sum += c; cnt += (c > 0u) ? 1u : 0u; mine = (j == x) ? c : mine; }
        if (sum == G) break;
        __builtin_amdgcn_s_sleep(1);
        if ((++sp & 255u) == 0u) { if (xb_ld(&bar[XB_TMO])) break; if (sp > XB_SPIN_CAP) { atomicAdd(&bar[XB_TMO], 1u); break; } }
    }
    nloc = mine > 0u ? mine : 1u; nx = cnt > 0u ? cnt : 1u;
}

__device__ __forceinline__ void xcd_barrier(const XcdBarrier& b) {
    asm volatile("s_waitcnt vmcnt(0)" ::: "memory");
    __syncthreads();
    if (threadIdx.x == 0) {
        unsigned* bar = b.bar;
        __builtin_amdgcn_s_waitcnt(0);
        unsigned nloc = b.st[0], nx = b.st[1];
        if (nloc == 0u) { xcd_barrier_complete(bar, b.x, nloc, nx); b.st[0] = nloc; b.st[1] = nx; }
        const unsigned old = xb_add(&bar[XB_XSUB(b.x)], 1u);
        const unsigned gen = old / nloc;
        if (old + 1u == (gen + 1u) * nloc) {
            __builtin_amdgcn_fence(__ATOMIC_RELEASE, "agent");
            asm volatile("s_waitcnt vmcnt(0)" ::: "memory");
            const unsigned og = xb_add(&bar[XB_TOP], 1u);
            const unsigned tg = og / nx;
            if (og + 1u == (tg + 1u) * nx) xb_add(&bar[XB_TOPGEN], 1u);
            else XB_SPIN(xb_ld(&bar[XB_TOPGEN]) == tg, bar);
            __builtin_amdgcn_fence(__ATOMIC_ACQUIRE, "agent");
            xb_add(&bar[XB_XGEN(b.x)], 1u);
            asm volatile("s_waitcnt vmcnt(0)" ::: "memory");
        } else {
            XB_SPIN(xb_ld(&bar[XB_XGEN(b.x)]) == gen, bar);
            __builtin_amdgcn_fence(__ATOMIC_ACQUIRE, "agent");
            asm volatile("s_waitcnt vmcnt(0)" ::: "memory");
        }
    }
    __syncthreads();
}


enum { PH_PRO = 0, PH_NORM1, PH_WIN, PH_POSTA, PH_POSTB, PH_MIXER, PH_HYFIN, PH_WOUT, PH_ROUTE, PH_PLACE, PH_GEMM1, PH_GEMM2, PH_FINAL, PH_COUNT };

template <int PH>
__device__ __forceinline__ void run_phase(const Params& p_in, int l, LAS unsigned char* lds) {
    Params p = p_in; { unsigned char* w = p.ws; asm volatile("" : "+s"(w)); p.ws = w; }
    unsigned char* ws = p.ws; const bool last = (l == NLAYER - 1);
    const int gw = blockIdx.x * 8 + owid(), GW = gridDim.x * 8, lane = otid() & 63;
    if constexpr (PH == PH_PRO) { phase_prologue(p, lds); }
    if constexpr (PH == PH_NORM1) { phase_norm1(p, l); }
    if constexpr (PH == PH_WIN) {
        GemmDesc g{(const bf16_t*)(ws + O_H), DM, nullptr, DM, DM}; EpiStoreBf16 E{(bf16_t*)(ws + O_P), NP};
        const bf16_t* Bt = (const bf16_t*)(ws + O_WIN) + (size_t)l * NP * DM;
        if (!last) { DenseSched S{Bt, DM, NTOK / 256, 16, 0, 0}; GEMM_PHASE(g, S, E); }
        else { DenseSched S{Bt, DM, NLAT / 256, 16, 0, 0}; GEMM_PHASE(g, S, E); DenseSched S2{Bt, DM, NCTX / 256, 4, NLAT, 12}; GEMM_PHASE(g, S2, E); }
    }
    if constexpr (PH == PH_POSTA) {
#ifndef DBG_SKIP
#define DBG_SKIP 0
#endif
        if (!(DBG_SKIP & 1)) { GemmDesc g{(const bf16_t*)(ws + O_P) + C_CQ, NP, nullptr, 768, 768}; EpiStoreBf16 E{(bf16_t*)(ws + O_QRAW), NQP};
          DenseSched S{(const bf16_t*)(ws + O_WUQ) + (size_t)l * NQP * 768, 768, (last ? NLAT : NTOK) / 256, 5, 0, 0}; GEMM_PHASE(g, S, E); }
        if (!(DBG_SKIP & 2)) { GemmDesc g{(const bf16_t*)(ws + O_P) + C_CKV, NP, nullptr, 256, 256}; EpiStoreBf16 E{(bf16_t*)(ws + O_KVRAW), 1536};
          DenseSched S{(const bf16_t*)(ws + O_WUKV) + (size_t)l * 1536 * 256, 256, NTOK / 256, 6, 0, 0}; GEMM_PHASE(g, S, E); }
        const int ntt = (last ? NLAT : NTOK) / 64;
        if (!(DBG_SKIP & 4)) for (int t = blockIdx.x; t < ntt * 16; t += gridDim.x) hy_prep_task(p, l, (t >> 4) * 64, (t & 15) * 64, (LAS float*)lds);
        if (!(DBG_SKIP & 8)) for (int row = gw; row < NTOK; row += GW) gqa_post_row(p, l, row, lane);
    }
    if constexpr (PH == PH_POSTB) { if (l == 0) hss_tasks(p); for (int row = gw; row < NTOK; row += GW) mla_post_row(p, l, row, lane); }
    if constexpr (PH == PH_MIXER) { phase_mixer(p, l, lds); }
    if constexpr (PH == PH_HYFIN) { const int ntt = (last ? NLAT : NTOK) / 64; for (int t = blockIdx.x; t < ntt * 8; t += gridDim.x) hy_fin_task(p, l, (t >> 3) * 64, (t & 7) * 64, (LAS float*)lds); }
    if constexpr (PH == PH_WOUT) {
        GemmDesc g{(const bf16_t*)(ws + O_MIX), DM, nullptr, DM, DM}; EpiStoreBf16 E{(bf16_t*)(ws + O_OUT), DM};
        DenseSched S{(const bf16_t*)(ws + O_WOUT) + (size_t)l * DM * DM, DM, (last ? NLAT : NTOK) / 256, 8, 0, 0}; GEMM_PHASE(g, S, E);
    }
    if constexpr (PH == PH_ROUTE) { phase_route(p, l, lds); }
    if constexpr (PH == PH_PLACE) { phase_place(p, l, lds); }
    if constexpr (PH == PH_GEMM1 || PH == PH_GEMM2) {
        LAS int* te = (LAS int*)(lds + LDS_TILES); LAS int* ts = te + MAXTILES; LAS int* misc = (LAS int*)(lds + LDS_MISC) + 16;
        const int nt = moe_build_tiles((const unsigned*)(ws + O_CTL) + CW_CNT + l * 64, (last ? NLAT : NTOK) / 256, te, ts, misc);
        if constexpr (PH == PH_GEMM1) {
            GemmDesc g{(const bf16_t*)(ws + O_H), DM, (const int*)(ws + O_STOK), DM, DM}; EpiSwiGLU E{(bf16_t*)(ws + O_HID)};
            MoeSched S{te, ts, nt, 4, (const bf16_t*)(ws + O_EGU), (size_t)1024 * 2048, DM, 128}; GEMM_PHASE(g, S, E);
        } else {
            GemmDesc g{(const bf16_t*)(ws + O_HID), EH, nullptr, EH, EH}; EpiStoreBf16 E{(bf16_t*)(ws + O_DOUT), DM};
            MoeSched S{te, ts, nt, 8, (const bf16_t*)(ws + O_ED), (size_t)2048 * 512, EH, 256}; GEMM_PHASE(g, S, E);
        }
        __syncthreads();
    }
    if constexpr (PH == PH_FINAL) {
        phase_final(p, l);
        if (!last) cvt_exp_all(p, l + 1);
    }
}

#ifndef MEGA
#define MEGA 0
#endif


#if MEGA
__global__ void __launch_bounds__(NTHREADS, 2) mega_fwd(Params p) {
    extern __shared__ __attribute__((aligned(16))) unsigned char lds_raw[];
    LAS unsigned char* lds = (LAS unsigned char*)lds_raw;
    volatile LAS unsigned* xbw = (volatile LAS unsigned*)(lds + LDS_MISC);
    if (otid() == 0) { xbw[0] = 0u; xbw[1] = 0u; }
    __syncthreads();
    { const XcdBarrier b0 = xcd_barrier_post((unsigned*)(p.ws + O_CTL) + CW_BAR, xbw); if (otid() == 0) xbw[2] = b0.x; }
    __syncthreads();
#define GRID_BAR() do { XcdBarrier b_; b_.bar = (unsigned*)(p.ws + O_CTL) + CW_BAR; b_.x = xbw[2]; b_.st = xbw; xcd_barrier(b_); } while (0)
#ifndef DBL_MASK
#define DBL_MASK 0
#endif
#define RUNP(PH, l) do { run_phase<PH>(p, l, lds); GRID_BAR(); if ((DBL_MASK >> PH) & 1) { run_phase<PH>(p, l, lds); GRID_BAR(); } } while (0)
#ifndef DLY_MASK
#define DLY_MASK 0
#endif
#define RUND(PH, l) do { if ((DLY_MASK >> PH) & 1) { const unsigned long long t0_ = wall_clock64(); run_phase<PH>(p, l, lds); const unsigned long long t1_ = wall_clock64(); while (wall_clock64() < t1_ + (t1_ - t0_)) __builtin_amdgcn_s_sleep(8); } else run_phase<PH>(p, l, lds); } while (0)
    RUNP(PH_PRO, 0);
#define LAYER(l) do { if ((l) == 0) RUNP(PH_NORM1, l); \
        RUNP(PH_WIN, l); RUNP(PH_POSTA, l); RUNP(PH_POSTB, l); RUNP(PH_MIXER, l); RUNP(PH_HYFIN, l); RUNP(PH_WOUT, l); \
        RUND(PH_ROUTE, l); GRID_BAR(); RUND(PH_PLACE, l); GRID_BAR(); RUNP(PH_GEMM1, l); RUNP(PH_GEMM2, l); RUND(PH_FINAL, l); \
        if ((l) + 1 < NLAYER) GRID_BAR(); } while (0)
    LAYER(0);
    LAYER(1);
}
#endif

#if !MEGA
template <int PH> __global__ void __launch_bounds__(NTHREADS, 2) k_phase(Params p) {
    extern __shared__ __attribute__((aligned(16))) unsigned char lds_raw[];
    run_phase<PH>(p, p.layer, (LAS unsigned char*)lds_raw);
}
template <int PH> static bool prep_phase() { return hipFuncSetAttribute((const void*)k_phase<PH>, hipFuncAttributeMaxDynamicSharedMemorySize, LDS_BYTES) == hipSuccess; }
static int g_nlaunch = 0;
#ifndef DBG_STOP
#define DBG_STOP 1000
#define DBG_DUMP 0
#else
#define DBG_DUMP 1
#ifndef DBG_SET
#define DBG_SET 31
#endif
#endif
template <int PH> static void launch_phase(Params p, int l, hipStream_t st) { if (g_nlaunch++ >= DBG_STOP) return; p.layer = l; hipLaunchKernelGGL(k_phase<PH>, dim3(256), dim3(NTHREADS), LDS_BYTES, st, p); }
#endif


#if DBG_DUMP
__device__ __forceinline__ float san(float x) { return (x == x && fabsf(x) < 1e6f) ? x : 1.0f; }
__global__ void __launch_bounds__(256) k_dump(Params p) {
    const size_t N = (size_t)NLAT * DM;
    const bf16_t* b1 = (const bf16_t*)(p.ws + O_WIN); const size_t n1 = (O_X - O_WIN) / 2;
    const bf16_t* b2 = (const bf16_t*)(p.ws + O_H); const size_t n2 = (size_t)NTOK * DM;
    const bf16_t* b3 = (const bf16_t*)(p.ws + O_A); const size_t n3 = (O_AEND - O_A) / 2;
    const float* f1 = (const float*)(p.ws + O_MOD); const size_t m1 = (O_WIN - O_MOD) / 4;
    const float* f2 = (const float*)(p.ws + O_X); const size_t m2 = (size_t)NTOK * DM;
    for (size_t i = (size_t)blockIdx.x * 256 + otid(); i < N; i += (size_t)gridDim.x * 256) {
        float v = 0.f;
        if (DBG_SET & 1) for (size_t e = i; e < n1; e += N) v += san(bf2f(b1[e]));
        if (DBG_SET & 2) for (size_t e = i; e < n2; e += N) v += san(bf2f(b2[e]));
        if (DBG_SET & 4) for (size_t e = i; e < n3; e += N) v += san(bf2f(b3[e]));
        if (DBG_SET & 8) for (size_t e = i; e < m1; e += N) v += san(f1[e]);
        if (DBG_SET & 16) for (size_t e = i; e < m2; e += N) v += san(f2[e]);
        if (DBG_SET & 32) v += san(bf2f(((const bf16_t*)(p.ws + O_WUKV))[i % ((size_t)2 * 1536 * 256)]));
        if (DBG_SET & 64) { const size_t r = i % NTOK, c = (i / NTOK) % 256; v += san(bf2f(((const bf16_t*)(p.ws + O_P))[r * NP + C_CKV + c])); }
        if (DBG_SET & 128) v += san(bf2f(((const bf16_t*)(p.ws + O_KVRAW))[i % ((size_t)NTOK * 1536)]));
        p.out[i] = v;
    }
}
#endif
static int g_grid = 0;
extern "C" void kernel_launch(void* const* d_in, const int* in_sizes, int n_in, void* d_out, int out_size, void* d_ws, size_t ws_size, hipStream_t stream) {
    static int ok = 0;
    if (ok == 0) {
        if (n_in != 31 || in_sizes[0] != NLAT * DM || out_size != NLAT * DM || ws_size < WS_END) { fprintf(stderr, "kernel_launch: unexpected shapes (n_in %d, ws %zu, need %zu)\n", n_in, ws_size, (size_t)WS_END); ok = -1; return; }
        bool good = true;
#if !MEGA
        good = good && prep_phase<0>() && prep_phase<1>() && prep_phase<2>() && prep_phase<3>() && prep_phase<4>() && prep_phase<5>() && prep_phase<6>() && prep_phase<7>() && prep_phase<8>() && prep_phase<9>() && prep_phase<10>() && prep_phase<11>() && prep_phase<12>();
#endif
#if MEGA
        good = hipFuncSetAttribute((const void*)mega_fwd, hipFuncAttributeMaxDynamicSharedMemorySize, LDS_BYTES) == hipSuccess;
        int dev = 0, cus = 0, per_cu = 0;
        if (hipGetDevice(&dev) != hipSuccess || hipDeviceGetAttribute(&cus, hipDeviceAttributeMultiprocessorCount, dev) != hipSuccess) good = false;
        if (good && (hipOccupancyMaxActiveBlocksPerMultiprocessor(&per_cu, (const void*)mega_fwd, NTHREADS, LDS_BYTES) != hipSuccess || per_cu < 1)) { fprintf(stderr, "kernel_launch: occupancy query says %d workgroups per CU\n", per_cu); good = false; }
        g_grid = cus;
#endif
        if (!good) { fprintf(stderr, "kernel_launch: set-up failed\n"); ok = -1; return; }
        ok = 1;
    }
    if (ok < 0) return;
    Params p{}; for (int i = 0; i < 31; ++i) p.in[i] = (const float*)d_in[i]; p.out = (float*)d_out; p.ws = (unsigned char*)d_ws; p.layer = 0; p.pad = 0;
#ifdef POISON_WS
    hipMemsetAsync((char*)d_ws, 0xFF, WS_END, stream);
#endif
    hipMemsetAsync((char*)d_ws + O_CTL, 0, ZERO_BYTES, stream);
#if !MEGA
    g_nlaunch = 0;
    launch_phase<PH_PRO>(p, 0, stream);
    for (int l = 0; l < NLAYER; ++l) {
        if (l == 0) launch_phase<PH_NORM1>(p, l, stream);
        launch_phase<PH_WIN>(p, l, stream); launch_phase<PH_POSTA>(p, l, stream); launch_phase<PH_POSTB>(p, l, stream); launch_phase<PH_MIXER>(p, l, stream);
        launch_phase<PH_HYFIN>(p, l, stream); launch_phase<PH_WOUT>(p, l, stream); launch_phase<PH_ROUTE>(p, l, stream); launch_phase<PH_PLACE>(p, l, stream);
        launch_phase<PH_GEMM1>(p, l, stream); launch_phase<PH_GEMM2>(p, l, stream); launch_phase<PH_FINAL>(p, l, stream);
    }
#if DBG_DUMP
    hipLaunchKernelGGL(k_dump, dim3(2048), dim3(256), 0, stream, p);
#endif
#else
    hipLaunchKernelGGL(mega_fwd, dim3(g_grid), dim3(NTHREADS), LDS_BYTES, stream, p);
#endif
}
```

```cpp
#define GQA_SD 1
#define FAST_GEMM 1
#define MEGA 1
#include <hip/hip_runtime.h>
#include <stdint.h>
#include <stdio.h>

#define LAS __attribute__((address_space(3)))
typedef unsigned short bf16_t;
typedef short bf16x8 __attribute__((ext_vector_type(8)));
typedef short s16x4 __attribute__((ext_vector_type(4)));
typedef float f32x4 __attribute__((ext_vector_type(4)));
typedef float f32x16 __attribute__((ext_vector_type(16)));
typedef unsigned u32x4 __attribute__((ext_vector_type(4)));
typedef unsigned u32x2 __attribute__((ext_vector_type(2)));

constexpr int DM = 2048, NB = 8, SEQ = 2048, CTXL = 256, NLAT = NB * SEQ, NCTX = NB * CTXL, NTOK = NLAT + NCTX, NLAYER = 2;
constexpr int NP = 4096;
constexpr int C_CQ = 1536, C_GQ = 2304, C_CKV = 3072, C_KR = 3328, C_GK = 3392, C_GV = 3648, IN_COLS = 3904;
constexpr int NEXP = 64, TOPK = 6, EH = 512;
constexpr int LK = CTXL + SEQ;
constexpr int RSLOTS = 126976;
constexpr int NSLOTS = RSLOTS + NTOK;
constexpr int MAXTILES = NSLOTS / 256;
constexpr int NQP = 1280;
constexpr float EPS = 1e-6f;
constexpr int NTHREADS = 512;
#ifndef GQA_SD
#define GQA_SD 2
#endif
#ifndef HY_MFMA
#define HY_MFMA 1
#endif

constexpr size_t al256(size_t x) { return (x + 255) & ~(size_t)255; }
constexpr size_t O_CTL = 0;
constexpr size_t CTL_BYTES = 65536;
constexpr size_t O_MOD = O_CTL + CTL_BYTES;
constexpr size_t O_HSS = O_MOD + al256((size_t)NLAYER * 9 * 12288 * 4);
constexpr size_t ZERO_BYTES = O_HSS + al256((size_t)NLAYER * 2 * 2 * 512 * 4);
constexpr size_t O_HF = ZERO_BYTES;
constexpr size_t HF_L0 = (size_t)2 * 2 * 512 * 2048, HF_L1 = (size_t)2 * 2 * 512 * 256, HF_LAYER = HF_L0 + HF_L1;
constexpr size_t O_WIN = O_HF + al256(NLAYER * HF_LAYER * 4);
constexpr size_t O_WOUT = O_WIN + (size_t)NLAYER * NP * DM * 2;
constexpr size_t O_WUQ = O_WOUT + (size_t)NLAYER * DM * DM * 2;
constexpr size_t O_WUKV = O_WUQ + al256((size_t)NLAYER * NQP * 768 * 2);
constexpr size_t O_EGU = O_WUKV + al256((size_t)NLAYER * 1536 * 256 * 2);
constexpr size_t O_ED = O_EGU + (size_t)65 * 1024 * 2048 * 2;
constexpr size_t O_X = O_ED + (size_t)65 * 2048 * 512 * 2;
constexpr size_t O_H = O_X + (size_t)NTOK * DM * 4;
constexpr size_t O_EIDX = O_H + (size_t)NTOK * DM * 2;
constexpr size_t O_GATE = O_EIDX + (size_t)NTOK * 8 * 4;
constexpr size_t O_SLOT = O_GATE + (size_t)NTOK * 8 * 4;
constexpr size_t O_STOK = O_SLOT + (size_t)NTOK * 8 * 4;
constexpr size_t O_WCNT = O_STOK + al256((size_t)NSLOTS * 4);
constexpr size_t O_ROPE = O_WCNT + (size_t)1024 * 64 * 4;
constexpr size_t O_HID = O_ROPE + (size_t)(64 * 32 + 64 * 16) * 8;
constexpr size_t O_A = O_HID + (size_t)NSLOTS * EH * 2;
constexpr size_t O_P = O_A;
constexpr size_t O_QRAW = O_P + (size_t)NTOK * NP * 2;
constexpr size_t O_KVRAW = O_QRAW + (size_t)NTOK * NQP * 2;
constexpr size_t O_QM = O_KVRAW + (size_t)NTOK * 1536 * 2;
constexpr size_t O_QMC = O_QM + (size_t)NB * 6 * SEQ * 192 * 2;
constexpr size_t O_KM = O_QMC + (size_t)NB * 6 * CTXL * 192 * 2;
constexpr size_t O_VM = O_KM + (size_t)NB * 6 * LK * 192 * 2;
constexpr size_t O_QG = O_VM + (size_t)NB * 6 * LK * 128 * 2;
constexpr size_t O_QGC = O_QG + (size_t)NB * 6 * SEQ * 128 * 2;
constexpr size_t O_KG = O_QGC + (size_t)NB * 6 * CTXL * 128 * 2;
constexpr size_t O_VG = O_KG + (size_t)NB * 2 * LK * 128 * 2;
constexpr size_t O_VT = O_VG + (size_t)NB * 2 * LK * 128 * 2;
constexpr size_t O_X1T = O_VT + (size_t)512 * NTOK * 2;
constexpr size_t O_Y2T = O_X1T + (size_t)512 * NTOK * 2;
constexpr size_t O_MIX = O_Y2T + (size_t)512 * NTOK * 2;
constexpr size_t O_OUT = O_MIX + (size_t)NTOK * DM * 2;
constexpr size_t O_AEND = O_OUT + (size_t)NTOK * DM * 2;
constexpr size_t O_DOUT = O_A;
static_assert(O_DOUT + (size_t)NSLOTS * DM * 2 <= O_AEND, "DOUT must fit the mixer scratch region");
constexpr size_t WS_END = O_AEND;

constexpr int CW_BAR = 0;
constexpr int CW_CNT = 4096;
constexpr int CW_CUR = 4096 + 128;
constexpr int CW_Q = 4096 + 256;

constexpr int LDS_BYTES = 148480;
constexpr int LDS_MISC = 147456;
constexpr int LDS_TILES = 131072;
constexpr int LDS_CNTL = LDS_MISC + 512;

struct Params { const float* in[31]; float* out; unsigned char* ws; int layer; int pad; };

enum { I_X = 0, I_C, I_CTX, I_CCTX, I_ADAW, I_ADAB, I_NORMG, I_WIN, I_WOUT, I_HYCONV, I_HYW1, I_HYB1, I_HYW2, I_HYB2, I_HYW3, I_HYFREQ, I_HYSKIP,
       I_MQN, I_MKVN, I_WUQ, I_WUKV, I_GQN, I_GKN, I_RW, I_RB, I_EG, I_EU, I_EDN, I_SG, I_SU, I_SD };

__device__ __forceinline__ int otid() { int t = threadIdx.x; asm volatile("" : "+v"(t)); return t; }
__device__ __forceinline__ int owid() { return __builtin_amdgcn_readfirstlane(otid() >> 6); }
__device__ __forceinline__ float bf2f(bf16_t v) { return __uint_as_float(((unsigned)v) << 16); }
__device__ __forceinline__ bf16_t f2bf(float f) { unsigned u = __float_as_uint(f); u += 0x7FFFu + ((u >> 16) & 1u); return (bf16_t)(u >> 16); }
__device__ __forceinline__ unsigned pk2(float lo, float hi) { unsigned r; asm volatile("v_cvt_pk_bf16_f32 %0, %1, %2" : "=v"(r) : "v"(lo), "v"(hi)); return r; }
__device__ __forceinline__ float wave_sum(float v) {
#pragma unroll
    for (int o = 32; o >= 1; o >>= 1) v += __shfl_xor(v, o);
    return v;
}
__device__ __forceinline__ float rdlane(float v, int l) { return __int_as_float(__builtin_amdgcn_readlane(__float_as_int(v), l)); }
__device__ __forceinline__ float silu_f(float x) { return x / (1.0f + __expf(-x)); }
__device__ __forceinline__ const float* resid_src(const Params& p, int l, int row) {
    if (l == 0) return row < NLAT ? p.in[I_X] + (size_t)row * DM : p.in[I_CTX] + (size_t)(row - NLAT) * DM;
    return (const float*)(p.ws + O_X) + (size_t)row * DM;
}
__device__ __forceinline__ int row_batch(int row) { return row < NLAT ? row >> 11 : 8; }
#define ROWCOL(j, lane) ((j) * 256 + (lane) * 4)


struct GUnit { int arow0; const bf16_t* B; int orow0, ocol0; };
struct GemmDesc { const bf16_t* A; int lda; const int* ridx; int ldb; int K; };

struct EpiStoreBf16 {
    bf16_t* O; int ldo;
    __device__ __forceinline__ void operator()(const f32x4 (&acc)[2][2][4][2], const GUnit& u, int wr, int wc, int fr, int fq) const {
#pragma unroll
        for (int ai = 0; ai < 2; ++ai)
#pragma unroll
            for (int m = 0; m < 4; ++m) {
                bf16_t* rowp = O + (size_t)(u.orow0 + ai * 128 + wr * 64 + m * 16 + fr) * ldo + u.ocol0 + wc * 32 + 4 * fq;
#pragma unroll
                for (int bj = 0; bj < 2; ++bj)
#pragma unroll
                    for (int n = 0; n < 2; ++n) { const f32x4 v = acc[ai][bj][m][n]; u32x2 w; w.x = pk2(v[0], v[1]); w.y = pk2(v[2], v[3]); *(u32x2*)(rowp + bj * 128 + n * 16) = w; }
            }
    }
};
struct EpiSwiGLU {
    bf16_t* O;
    __device__ __forceinline__ void operator()(const f32x4 (&acc)[2][2][4][2], const GUnit& u, int wr, int wc, int fr, int fq) const {
#pragma unroll
        for (int ai = 0; ai < 2; ++ai)
#pragma unroll
            for (int m = 0; m < 4; ++m) {
                bf16_t* rowp = O + (size_t)(u.orow0 + ai * 128 + wr * 64 + m * 16 + fr) * EH + u.ocol0 + wc * 32 + 4 * fq;
#pragma unroll
                for (int n = 0; n < 2; ++n) { const f32x4 g = acc[ai][0][m][n], up = acc[ai][1][m][n]; float h[4];
#pragma unroll
                    for (int j = 0; j < 4; ++j) h[j] = silu_f(g[j]) * up[j];
                    u32x2 w; w.x = pk2(h[0], h[1]); w.y = pk2(h[2], h[3]); *(u32x2*)(rowp + n * 16) = w; }
            }
    }
};

template <class Epi>
__device__ __forceinline__ void gemm_unit_simple(const GemmDesc& g, const GUnit& u, const Epi& E) {
    int tid = otid();
    const int wid = __builtin_amdgcn_readfirstlane(tid >> 6), lane = tid & 63, wr = wid >> 2, wc = wid & 3, fr = lane & 15, fq = lane >> 4;
    f32x4 acc[2][2][4][2];
#pragma unroll
    for (int a = 0; a < 2; ++a)
#pragma unroll
        for (int b = 0; b < 2; ++b)
#pragma unroll
            for (int m = 0; m < 4; ++m)
#pragma unroll
                for (int n = 0; n < 2; ++n) acc[a][b][m][n] = (f32x4){0.f, 0.f, 0.f, 0.f};
    const bf16_t* ap[2][4]; const bf16_t* bp[2][2];
#pragma unroll
    for (int ai = 0; ai < 2; ++ai)
#pragma unroll
        for (int m = 0; m < 4; ++m) { const int r = u.arow0 + ai * 128 + wr * 64 + m * 16 + fr; int src = g.ridx ? g.ridx[r] : r; if (src < 0) src = 0; ap[ai][m] = g.A + (size_t)src * g.lda + 8 * fq; }
#pragma unroll
    for (int bj = 0; bj < 2; ++bj)
#pragma unroll
        for (int n = 0; n < 2; ++n) bp[bj][n] = u.B + (size_t)(bj * 128 + wc * 32 + n * 16 + fr) * g.ldb + 8 * fq;
    int Kq = g.K; asm volatile("" : "+s"(Kq));
#pragma unroll 1
    for (int k0 = 0; k0 < Kq; k0 += 32) {
        bf16x8 a[2][4], b[2][2];
#pragma unroll
        for (int ai = 0; ai < 2; ++ai)
#pragma unroll
            for (int m = 0; m < 4; ++m) a[ai][m] = *(const bf16x8*)(ap[ai][m] + k0);
#pragma unroll
        for (int bj = 0; bj < 2; ++bj)
#pragma unroll
            for (int n = 0; n < 2; ++n) b[bj][n] = *(const bf16x8*)(bp[bj][n] + k0);
#pragma unroll
        for (int ai = 0; ai < 2; ++ai)
#pragma unroll
            for (int bj = 0; bj < 2; ++bj)
#pragma unroll
                for (int m = 0; m < 4; ++m)
#pragma unroll
                    for (int n = 0; n < 2; ++n) acc[ai][bj][m][n] = __builtin_amdgcn_mfma_f32_16x16x32_bf16(b[bj][n], a[ai][m], acc[ai][bj][m][n], 0, 0, 0);
    }
    E(acc, u, wr, wc, fr, fq);
}

struct DenseSched {
    const bf16_t* Bt; int ldb, nM, nN, row0, pn0;
    __device__ __forceinline__ int count() const { return nM * nN; }
    __device__ __forceinline__ void unit(int i, GUnit& u) const { const int pm = i / nN, pn = pn0 + i % nN; u.arow0 = row0 + pm * 256; u.B = Bt + (size_t)pn * 256 * ldb; u.orow0 = u.arow0; u.ocol0 = pn * 256; }
};
struct MoeSched {
    const LAS int* te; const LAS int* ts; int ntiles, npn; const bf16_t* Bt; size_t estride; int ldb, ocolw;
    __device__ __forceinline__ int count() const { return ntiles * npn; }
    __device__ __forceinline__ void unit(int i, GUnit& u) const { const int t = i / npn, pn = i % npn; const int e = te[t]; u.arow0 = ts[t]; u.B = Bt + (size_t)e * estride + (size_t)pn * 256 * ldb; u.orow0 = u.arow0; u.ocol0 = pn * ocolw; }
};
template <class Sched, class Epi>
__device__ __forceinline__ void gemm_phase_simple(const GemmDesc& g, const Sched& S, const Epi& E) {
    const int n = S.count();
    for (int i = blockIdx.x; i < n; i += gridDim.x) { GUnit u; S.unit(i, u); gemm_unit_simple(g, u, E); }
}
__device__ __forceinline__ int wave_incl_scan(int v, int lane) {
#pragma unroll
    for (int o = 1; o < 64; o <<= 1) { const int t = __shfl_up(v, o); if (lane >= o) v += t; }
    return v;
}
__device__ __forceinline__ int moe_build_tiles(const unsigned* cnt, int nshared, LAS int* te, LAS int* ts, LAS int* misc) {
    __syncthreads();
    const int tid = otid();
    if (tid < 64) {
        const int c = (int)cnt[tid], ntile = (c + 255) >> 8, incl = wave_incl_scan(ntile, tid), first = incl - ntile;
        for (int j = 0; j < ntile; ++j) { te[first + j] = tid; ts[first + j] = (first + j) * 256; }
        const int nrt = __shfl(incl, 63);
        for (int j = tid; j < nshared; j += 64) { te[nrt + j] = NEXP; ts[nrt + j] = RSLOTS + j * 256; }
        if (tid == 0) misc[0] = nrt + nshared;
    }
    __syncthreads();
    return misc[0];
}
#ifndef FAST_GEMM
#define FAST_GEMM 0
#endif
#if !FAST_GEMM
#define GEMM_PHASE(g, S, E) gemm_phase_simple(g, S, E)
#endif

#if FAST_GEMM
constexpr int HTB = 128 * 64 * 2;
__device__ __forceinline__ int lds_byte(int r, int c) { const int st = (r >> 4) * 2 + (c >> 5), rr = r & 15, cc = c & 31, ob = rr * 64 + cc * 2; return st * 1024 + (ob ^ (((ob >> 9) & 1) << 5)); }
__device__ __forceinline__ void stage_rc(int b, int& R, int& C) { const int st = b / 1024, sb = b % 1024, swz = sb ^ (((sb >> 9) & 1) << 5); R = (st >> 1) * 16 + swz / 64; C = (st & 1) * 32 + (swz % 64) / 2; }

template <class Sched, class Epi>
__device__ __forceinline__ void gemm_phase_fast(LAS unsigned char* lds, const GemmDesc& g, const Sched& S, const Epi& E) {
    const int tid = otid(), wid = __builtin_amdgcn_readfirstlane(tid >> 6), lane = tid & 63, wr = wid >> 2, wc = wid & 3, fr = lane & 15, fq = lane >> 4;
    const int K = g.K, nt = K / 64, nunits = S.count(), G = gridDim.x, c0 = blockIdx.x;
    if (c0 >= nunits) return;
    int R[2], C[2]; unsigned voffB[2];
#pragma unroll
    for (int i = 0; i < 2; ++i) { stage_rc(tid * 16 + i * 8192, R[i], C[i]); voffB[i] = (unsigned)(R[i] * g.ldb + C[i]) * 2u; }
    const size_t kstep = 128;
    const size_t hstepB = (size_t)128 * g.ldb * 2;
    const unsigned ldsw = (unsigned)wid * 1024u;
    const int aoff = lds_byte(wr * 64 + fr, fq * 8), boff = lds_byte(wc * 32 + fr, fq * 8);
    const char* Ab = (const char*)g.A;
#define F_SA(b, h) (((b) * 2 + (h)) * HTB)
#define F_SB(b, h) ((4 + (b) * 2 + (h)) * HTB)
#define F_STAGE(bufoff, gbase, voff) do { _Pragma("unroll") for (int _i = 0; _i < 2; ++_i) \
        __builtin_amdgcn_global_load_lds((const unsigned*)((const char*)(gbase) + (voff)[_i]), (LAS unsigned*)(lds + (bufoff) + ldsw + _i * 8192), 16, 0, 0); } while (0)
#define F_LDA(dst, b, h) do { _Pragma("unroll") for (int m = 0; m < 4; ++m) _Pragma("unroll") for (int k = 0; k < 2; ++k) dst[m][k] = *(const LAS bf16x8*)(lds + F_SA(b, h) + aoff + m * 2048 + k * 1024); } while (0)
#define F_LDB(dst, b, h) do { _Pragma("unroll") for (int n = 0; n < 2; ++n) _Pragma("unroll") for (int k = 0; k < 2; ++k) dst[n][k] = *(const LAS bf16x8*)(lds + F_SB(b, h) + boff + n * 2048 + k * 1024); } while (0)
#define F_MMA(ai, bj, At, Bt) do { __builtin_amdgcn_s_setprio(1); _Pragma("unroll") for (int m = 0; m < 4; ++m) _Pragma("unroll") for (int n = 0; n < 2; ++n) _Pragma("unroll") for (int k = 0; k < 2; ++k) \
        acc[ai][bj][m][n] = __builtin_amdgcn_mfma_f32_16x16x32_bf16(Bt[n][k], At[m][k], acc[ai][bj][m][n], 0, 0, 0); __builtin_amdgcn_s_setprio(0); } while (0)
#define F_WAIT_V(n) asm volatile("s_waitcnt vmcnt(" #n ")" ::: "memory")
#define F_WAIT_L(n) asm volatile("s_waitcnt lgkmcnt(" #n ")" ::: "memory")
#define F_BAR __builtin_amdgcn_s_barrier()
#define F_SCHED __builtin_amdgcn_sched_barrier(0)
#define F_AROWS(u, dst) do { _Pragma("unroll") for (int _h = 0; _h < 2; ++_h) _Pragma("unroll") for (int _i = 0; _i < 2; ++_i) { const int _r = (u).arow0 + _h * 128 + R[_i]; int _s = g.ridx ? g.ridx[_r] : _r; if (_s < 0) _s = 0; dst[_h][_i] = _s; } } while (0)
#define F_AOFFS(src, dst) do { _Pragma("unroll") for (int _h = 0; _h < 2; ++_h) _Pragma("unroll") for (int _i = 0; _i < 2; ++_i) dst[_h][_i] = ((unsigned)src[_h][_i] * (unsigned)g.lda + (unsigned)C[_i]) * 2u; } while (0)
    GUnit cur, nxt; int ui = 0;
    S.unit(c0, cur);
    f32x4 acc[2][2][4][2];
#pragma unroll
    for (int a = 0; a < 2; ++a)
#pragma unroll
        for (int b = 0; b < 2; ++b)
#pragma unroll
            for (int m = 0; m < 4; ++m)
#pragma unroll
                for (int n = 0; n < 2; ++n) acc[a][b][m][n] = (f32x4){0.f, 0.f, 0.f, 0.f};
    bf16x8 At[4][2], B0[2][2], B1[2][2];
    unsigned voA[2][2]; int rnx[2][2];
    F_AROWS(cur, rnx); F_AOFFS(rnx, voA);
    const char* cB = (const char*)cur.B;
    F_STAGE(F_SB(0, 0), cB, voffB); F_STAGE(F_SA(0, 0), Ab, voA[0]); F_STAGE(F_SB(0, 1), cB + hstepB, voffB); F_STAGE(F_SA(0, 1), Ab, voA[1]);
    if (wr == 1) F_BAR;
    F_WAIT_V(4); F_BAR;
    F_STAGE(F_SB(1, 0), cB + kstep, voffB); F_STAGE(F_SA(1, 0), Ab + kstep, voA[0]); F_STAGE(F_SB(1, 1), cB + hstepB + kstep, voffB);
    F_WAIT_V(6); F_BAR;
    for (;;) {
        const int Ln = (ui + 1) * G + c0; const bool has_next = Ln < nunits;
        if (has_next) { S.unit(Ln, nxt); F_AROWS(nxt, rnx); }
        const char* nB = has_next ? (const char*)nxt.B : cB;
        for (int t = 0; t < nt; t += 2) {
            const bool last = (t == nt - 2);
            const char* a1 = Ab + (size_t)(t + 1) * kstep;
            const char* a2 = last ? Ab : Ab + (size_t)(t + 2) * kstep; const char* b2 = last ? nB : cB + (size_t)(t + 2) * kstep;
            const char* a3 = a2 + kstep; const char* b3 = b2 + kstep;
            F_LDB(B0, 0, 0); F_SCHED; F_LDA(At, 0, 0); F_STAGE(F_SA(1, 1), a1, voA[1]);
            if (last && has_next) F_AOFFS(rnx, voA);
            F_WAIT_L(8); F_BAR; F_WAIT_L(0); F_MMA(0, 0, At, B0); F_BAR; F_SCHED;
            F_LDB(B1, 0, 1); F_STAGE(F_SB(0, 0), b2, voffB);
            F_BAR; F_WAIT_L(0); F_MMA(0, 1, At, B1); F_BAR;
            F_LDA(At, 0, 1); F_STAGE(F_SA(0, 0), a2, voA[0]);
            F_BAR; F_WAIT_L(0); F_MMA(1, 0, At, B0); F_BAR; F_SCHED;
            F_STAGE(F_SB(0, 1), b2 + hstepB, voffB);
            F_WAIT_V(6); F_BAR; F_MMA(1, 1, At, B1); F_BAR;
            F_LDB(B0, 1, 0); F_SCHED; F_LDA(At, 1, 0); F_STAGE(F_SA(0, 1), a2, voA[1]);
            F_WAIT_L(8); F_BAR; F_WAIT_L(0); F_MMA(0, 0, At, B0); F_BAR; F_SCHED;
            F_LDB(B1, 1, 1); F_STAGE(F_SB(1, 0), b3, voffB);
            F_BAR; F_WAIT_L(0); F_MMA(0, 1, At, B1); F_BAR;
            F_LDA(At, 1, 1); F_STAGE(F_SA(1, 0), a3, voA[0]);
            F_BAR; F_WAIT_L(0); F_MMA(1, 0, At, B0); F_BAR; F_SCHED;
            F_STAGE(F_SB(1, 1), b3 + hstepB, voffB);
            F_WAIT_V(6); F_BAR; F_MMA(1, 1, At, B1); F_BAR;
        }
        E(acc, cur, wr, wc, fr, fq);
        if (!has_next) break;
#pragma unroll
        for (int a = 0; a < 2; ++a)
#pragma unroll
            for (int b = 0; b < 2; ++b)
#pragma unroll
                for (int m = 0; m < 4; ++m)
#pragma unroll
                    for (int n = 0; n < 2; ++n) acc[a][b][m][n] = (f32x4){0.f, 0.f, 0.f, 0.f};
        cur = nxt; cB = nB; ++ui;
    }
    F_WAIT_V(0);
    if (wr == 0) F_BAR;
    F_BAR;
#undef F_SA
#undef F_SB
#undef F_STAGE
#undef F_LDA
#undef F_LDB
#undef F_MMA
#undef F_WAIT_V
#undef F_WAIT_L
#undef F_BAR
#undef F_SCHED
#undef F_AROWS
#undef F_AOFFS
}
#define GEMM_PHASE(g, S, E) gemm_phase_fast(lds, g, S, E)
#endif

#define SBAR() __builtin_amdgcn_sched_barrier(0)
__device__ __forceinline__ int crow(int r, int hi) { return (r & 3) + 8 * (r >> 2) + 4 * hi; }
template <int DQK> __device__ __forceinline__ int kaddr(int row, int chunk) {
    const int sw = (DQK == 128) ? (row & 7) : ((row >> 1) & 7);
    return row * (DQK * 2) + ((chunk ^ sw) << 4);
}
__device__ __forceinline__ void partialSM(f32x16& p0, f32x16& p1, float& m_reg, float& mn, float& alpha, float C, float thr) {
    float pmax = p0[0];
#pragma unroll
    for (int r = 1; r < 16; ++r) pmax = fmaxf(pmax, p0[r]);
#pragma unroll
    for (int r = 0; r < 16; ++r) pmax = fmaxf(pmax, p1[r]);
    { auto rr = __builtin_amdgcn_permlane32_swap(__float_as_uint(pmax), __float_as_uint(pmax), false, false);
      pmax = fmaxf(__uint_as_float(rr[0]), __uint_as_float(rr[1])); }
    if (__builtin_expect(__all(pmax - m_reg <= thr), 1)) { mn = m_reg; alpha = 1.f; }
    else { mn = fmaxf(m_reg, pmax); alpha = __builtin_amdgcn_exp2f((m_reg - mn) * C); m_reg = mn; }
    const float mnC = -mn * C;
#pragma unroll
    for (int r = 0; r < 16; ++r) p0[r] = fmaf(p0[r], C, mnC);
#pragma unroll
    for (int r = 0; r < 16; ++r) p1[r] = fmaf(p1[r], C, mnC);
#pragma unroll
    for (int r = 0; r < 16; ++r) p0[r] = __builtin_amdgcn_exp2f(p0[r]);
}
__device__ __forceinline__ void finishSM(f32x16& p0, f32x16& p1, float alpha, float& l_reg, bf16x8& pa0, bf16x8& pa1, bf16x8& pa2, bf16x8& pa3) {
#pragma unroll
    for (int r = 0; r < 16; ++r) p1[r] = __builtin_amdgcn_exp2f(p1[r]);
    float ps = 0;
#pragma unroll
    for (int r = 0; r < 16; ++r) ps += p0[r];
#pragma unroll
    for (int r = 0; r < 16; ++r) ps += p1[r];
    { auto rr = __builtin_amdgcn_permlane32_swap(__float_as_uint(ps), __float_as_uint(ps), false, false);
      ps = __uint_as_float(rr[0]) + __uint_as_float(rr[1]); }
    l_reg = l_reg * alpha + ps;
#define PK4(P, BASE, OUT) do { unsigned a0 = pk2(P[BASE + 0], P[BASE + 1]), a1 = pk2(P[BASE + 2], P[BASE + 3]);   \
    unsigned b0 = pk2(P[BASE + 4], P[BASE + 5]), b1 = pk2(P[BASE + 6], P[BASE + 7]);                              \
    auto r0 = __builtin_amdgcn_permlane32_swap(a0, b0, false, false); auto r1 = __builtin_amdgcn_permlane32_swap(a1, b1, false, false); \
    u32x4 w = {r0[0], r1[0], r0[1], r1[1]}; OUT = *reinterpret_cast<bf16x8*>(&w); } while (0)
    PK4(p0, 0, pa0); PK4(p0, 8, pa1); PK4(p1, 0, pa2); PK4(p1, 8, pa3);
#undef PK4
}
template <int DQK> __device__ __forceinline__ void qkt(f32x16& p0, f32x16& p1, const char* Ks, const bf16x8* qr, int r32, int hi) {
    p0 = f32x16{}; p1 = f32x16{};
#pragma unroll
    for (int d0 = 0; d0 < DQK / 16; ++d0) { const int ch = 2 * d0 + hi;
        const bf16x8 b0 = *reinterpret_cast<const bf16x8*>(Ks + kaddr<DQK>(r32, ch));
        const bf16x8 b1 = *reinterpret_cast<const bf16x8*>(Ks + kaddr<DQK>(32 + r32, ch));
        p0 = __builtin_amdgcn_mfma_f32_32x32x16_bf16(b0, qr[d0], p0, 0, 0, 0);
        p1 = __builtin_amdgcn_mfma_f32_32x32x16_bf16(b1, qr[d0], p1, 0, 0, 0); }
}
__device__ __forceinline__ int v_st(int k, int c) { const int kk = (k & ~0xC) | ((k & 4) << 1) | ((k & 8) >> 1); return ((kk >> 3) * 4 + (c >> 5)) * 512 + ((kk & 7) * 32 + (c & 31)) * 2; }
__device__ __forceinline__ int v_rd_base(int lane) { return ((lane & 3) << 3) | (((lane >> 2) & 3) << 6) | (((lane >> 4) & 1) << 5) | (((lane >> 5) & 1) << 8); }
constexpr int v_rd_off(int d0, int ks, int half) { return d0 * 512 + ks * 4096 + half * 2048; }
template <int OFF> __device__ __forceinline__ s16x4 tr_read(int vb) {
    s16x4 r; asm volatile("ds_read_b64_tr_b16 %0, %1 offset:%2" : "=&v"(r) : "v"(vb), "i"(OFF) : "memory"); return r;
}
template <int D0> __device__ __forceinline__ void pv_one(f32x16& od, int vb, bf16x8 pa0, bf16x8 pa1, bf16x8 pa2, bf16x8 pa3) {
    const s16x4 l0 = tr_read<v_rd_off(D0, 0, 0)>(vb), h0 = tr_read<v_rd_off(D0, 0, 1)>(vb), l1 = tr_read<v_rd_off(D0, 1, 0)>(vb), h1 = tr_read<v_rd_off(D0, 1, 1)>(vb);
    const s16x4 l2 = tr_read<v_rd_off(D0, 2, 0)>(vb), h2 = tr_read<v_rd_off(D0, 2, 1)>(vb), l3 = tr_read<v_rd_off(D0, 3, 0)>(vb), h3 = tr_read<v_rd_off(D0, 3, 1)>(vb);
    asm volatile("s_waitcnt lgkmcnt(0)" ::: "memory"); SBAR();
#define PK(L, H) (bf16x8){L[0], L[1], L[2], L[3], H[0], H[1], H[2], H[3]}
    od = __builtin_amdgcn_mfma_f32_32x32x16_bf16(pa0, PK(l0, h0), od, 0, 0, 0);
    od = __builtin_amdgcn_mfma_f32_32x32x16_bf16(pa1, PK(l1, h1), od, 0, 0, 0);
    od = __builtin_amdgcn_mfma_f32_32x32x16_bf16(pa2, PK(l2, h2), od, 0, 0, 0);
    od = __builtin_amdgcn_mfma_f32_32x32x16_bf16(pa3, PK(l3, h3), od, 0, 0, 0);
#undef PK
}
__device__ __forceinline__ void pv_d0(f32x16* o, int vb, bf16x8 pa0, bf16x8 pa1, bf16x8 pa2, bf16x8 pa3) {
    pv_one<0>(o[0], vb, pa0, pa1, pa2, pa3); pv_one<1>(o[1], vb, pa0, pa1, pa2, pa3); pv_one<2>(o[2], vb, pa0, pa1, pa2, pa3); pv_one<3>(o[3], vb, pa0, pa1, pa2, pa3);
}

template <int DQK, int SDEPTH>
__device__ __forceinline__ void attn_body(const bf16_t* __restrict__ Qb, const bf16_t* __restrict__ Kh, const bf16_t* __restrict__ Vh, bf16_t* __restrict__ Ob, int ldo, int nkeys, float scale, char* lds) {
    constexpr int SHM_V = 64 * 128 * 2, SHM_K = 64 * DQK * 2, NKC = DQK / 8, KPT = NKC / 8;
    int tid = otid();
    const int wid = __builtin_amdgcn_readfirstlane(tid >> 6), lane = tid & 63, r32 = lane & 31, hi = lane >> 5;
    char* V_lds = lds; char* K_lds = lds + 2 * SHM_V;
    float* ws = (float*)(lds + 2 * SHM_V + 2 * SHM_K) + wid * 64; float* li_l = ws; float* al_l = ws + 32;
    const float C = scale * 1.4426950408889634f, thr = 8.0f / scale;
    float m_reg = -1e30f, l_reg = 0; f32x16 o[4] = {}; bf16x8 qr[DQK / 16];
    const bf16_t* Qw = Qb + (long)(wid * 32 + r32) * DQK + hi * 8;
#pragma unroll
    for (int d0 = 0; d0 < DQK / 16; ++d0) qr[d0] = *reinterpret_cast<const bf16x8*>(Qw + d0 * 16);
    const int sr = tid >> 4, sc = (tid & 15) * 8, vst0 = v_st(sr, sc), vst1 = v_st(32 + sr, sc);
    int kgo[KPT], klo[KPT];
#pragma unroll
    for (int i = 0; i < KPT; ++i) { const int q = tid + 512 * i, row = q / NKC, ch = q % NKC; kgo[i] = row * DQK + ch * 8; klo[i] = kaddr<DQK>(row, ch); }
    const int vb0 = (int)(uintptr_t)V_lds + v_rd_base(lane);
    struct { bf16x8 vs0, vs1, ks[KPT]; } sr_[SDEPTH ? SDEPTH : 1];
#define SLOAD(i, k0) do { sr_[i].vs0 = *reinterpret_cast<const bf16x8*>(&Vh[(long)((k0) + sr) * 128 + sc]); sr_[i].vs1 = *reinterpret_cast<const bf16x8*>(&Vh[(long)((k0) + 32 + sr) * 128 + sc]); \
    _Pragma("unroll") for (int _q = 0; _q < KPT; ++_q) sr_[i].ks[_q] = *reinterpret_cast<const bf16x8*>(&Kh[(long)(k0) * DQK + kgo[_q]]); } while (0)
#define SWRITE(b, i) do { *(bf16x8*)(V_lds + (b) * SHM_V + vst0) = sr_[i].vs0; *(bf16x8*)(V_lds + (b) * SHM_V + vst1) = sr_[i].vs1; \
    _Pragma("unroll") for (int _q = 0; _q < KPT; ++_q) *(bf16x8*)(K_lds + (b) * SHM_K + klo[_q]) = sr_[i].ks[_q]; } while (0)
#define SWAIT() do { if constexpr (SDEPTH == 2) { if constexpr (KPT == 2) asm volatile("s_waitcnt vmcnt(4)" ::: "memory"); else asm volatile("s_waitcnt vmcnt(5)" ::: "memory"); } \
    else asm volatile("s_waitcnt vmcnt(0)" ::: "memory"); } while (0)
#define RESC(a) do { if (__any((a) < 1.f)) { if (hi == 0) al_l[r32] = (a); asm volatile("s_waitcnt lgkmcnt(0)" ::: "memory"); \
    _Pragma("unroll") for (int d = 0; d < 4; ++d) _Pragma("unroll") for (int r = 0; r < 16; ++r) o[d][r] *= al_l[crow(r, hi)]; } } while (0)
    bf16x8 pa0, pa1, pa2, pa3; const int NT = nkeys / 64;
    if constexpr (SDEPTH == 0) {
        f32x16 pA0, pA1; float mnA, alA;
        SLOAD(0, 0); asm volatile("s_waitcnt vmcnt(0)" ::: "memory"); SWRITE(0, 0); __syncthreads();
        for (int j = 0; j < NT; ++j) {
            const int bo = j & 1;
            if (j + 1 < NT) SLOAD(0, (j + 1) * 64);
            SBAR(); qkt<DQK>(pA0, pA1, K_lds + bo * SHM_K, qr, r32, hi); partialSM(pA0, pA1, m_reg, mnA, alA, C, thr);
            RESC(alA); finishSM(pA0, pA1, alA, l_reg, pa0, pa1, pa2, pa3); SBAR();
            pv_d0(o, vb0 + bo * SHM_V, pa0, pa1, pa2, pa3);
            if (j + 1 < NT) { asm volatile("s_waitcnt vmcnt(0)" ::: "memory"); SWRITE(bo ^ 1, 0); }
            __syncthreads();
        }
    } else {
    f32x16 pA0, pA1, pB0, pB1; float mnA, mnB, alA, alB;
    constexpr int SE = 0, SO = SDEPTH - 1;
    SLOAD(SE, 0); asm volatile("s_waitcnt vmcnt(0)" ::: "memory"); SWRITE(0, SE); __syncthreads();
    qkt<DQK>(pA0, pA1, K_lds, qr, r32, hi); partialSM(pA0, pA1, m_reg, mnA, alA, C, thr);
    SLOAD(SO, 64); if constexpr (SDEPTH == 2) { if (2 < NT) SLOAD(SE, 2 * 64); }
    SWAIT(); SWRITE(1, SO); __syncthreads();
    for (int j = 1; j + 1 < NT; j += 2) {
        SBAR(); qkt<DQK>(pB0, pB1, K_lds + SHM_K, qr, r32, hi);
        finishSM(pA0, pA1, alA, l_reg, pa0, pa1, pa2, pa3); SBAR();
        SLOAD(SO, (j + SDEPTH) * 64); SBAR();
        pv_d0(o, vb0, pa0, pa1, pa2, pa3); partialSM(pB0, pB1, m_reg, mnB, alB, C, thr);
        __syncthreads(); SWAIT(); SWRITE(0, SE);
        RESC(alB); __syncthreads();
        SBAR(); qkt<DQK>(pA0, pA1, K_lds, qr, r32, hi);
        finishSM(pB0, pB1, alB, l_reg, pa0, pa1, pa2, pa3); SBAR();
        if (SDEPTH == 1 || j + 3 < NT) SLOAD(SE, (j + 1 + SDEPTH) * 64); SBAR();
        pv_d0(o, vb0 + SHM_V, pa0, pa1, pa2, pa3); partialSM(pA0, pA1, m_reg, mnA, alA, C, thr);
        __syncthreads(); SWAIT(); SWRITE(1, SO);
        RESC(alA); __syncthreads();
    }
    SBAR(); qkt<DQK>(pB0, pB1, K_lds + SHM_K, qr, r32, hi);
    finishSM(pA0, pA1, alA, l_reg, pa0, pa1, pa2, pa3); SBAR();
    pv_d0(o, vb0, pa0, pa1, pa2, pa3); partialSM(pB0, pB1, m_reg, mnB, alB, C, thr);
    __syncthreads(); RESC(alB);
    finishSM(pB0, pB1, alB, l_reg, pa0, pa1, pa2, pa3); SBAR();
    pv_d0(o, vb0 + SHM_V, pa0, pa1, pa2, pa3);
    }
    if (hi == 0) li_l[r32] = l_reg; asm volatile("s_waitcnt lgkmcnt(0)" ::: "memory");
    float rli[16];
#pragma unroll
    for (int r = 0; r < 16; ++r) rli[r] = __builtin_amdgcn_rcpf(li_l[crow(r, hi)]);
    bf16_t* Ow = Ob + (long)(wid * 32) * ldo;
#pragma unroll
    for (int r = 0; r < 16; ++r) { const int orow = crow(r, hi);
#pragma unroll
        for (int d0 = 0; d0 < 4; ++d0) Ow[(long)orow * ldo + d0 * 32 + r32] = f2bf(o[d0][r] * rli[r]); }
    __syncthreads();
#undef SLOAD
#undef SWRITE
#undef SWAIT
#undef RESC
}

struct CvtMat { const float* src; bf16_t* dst; const float* kscale; int N, lddst, nb, mode; };
__device__ __forceinline__ void cvt_block(const CvtMat& m, int kb, int nbk, int lane) {
    const int a = lane & 7, ng = lane >> 3, k0 = kb * 64 + 8 * a, n0 = nbk * 32 + 4 * ng;
    const float* s = m.src + (size_t)k0 * m.N + n0;
    f32x4 v[8];
#pragma unroll
    for (int j = 0; j < 8; ++j) v[j] = *(const f32x4*)(s + (size_t)j * m.N);
    if (m.kscale) {
#pragma unroll
        for (int j = 0; j < 8; ++j) v[j] *= m.kscale[k0 + j];
    }
#pragma unroll
    for (int i = 0; i < 4; ++i) { const int n = n0 + i, row = (m.mode == 0) ? n : ((n >> 7) * 256 + (n & 127) + (m.mode - 1) * 128);
        u32x4 w; w.x = pk2(v[0][i], v[1][i]); w.y = pk2(v[2][i], v[3][i]); w.z = pk2(v[4][i], v[5][i]); w.w = pk2(v[6][i], v[7][i]);
        *(u32x4*)(m.dst + (size_t)row * m.lddst + k0) = w; }
}
constexpr int CVT_SMALL = 3904 + 2048 + 432 + 192;
__device__ __forceinline__ void cvt_small_task(const Params& p, int l, int t, int lane) {
    unsigned char* ws = p.ws; CvtMat m;
    if (t < 3904) { m = CvtMat{p.in[I_WIN] + (size_t)l * DM * IN_COLS, (bf16_t*)(ws + O_WIN) + (size_t)l * NP * DM, nullptr, IN_COLS, DM, 122, 0}; }
    else if ((t -= 3904) < 2048) { m = CvtMat{p.in[I_WOUT] + (size_t)l * DM * DM, (bf16_t*)(ws + O_WOUT) + (size_t)l * DM * DM, nullptr, DM, DM, 64, 0}; }
    else if ((t -= 2048) < 432) { m = CvtMat{p.in[I_WUQ] + (size_t)l * 768 * 1152, (bf16_t*)(ws + O_WUQ) + (size_t)l * NQP * 768, p.in[I_MQN] + l * 768, 1152, 768, 36, 0}; }
    else { t -= 432; m = CvtMat{p.in[I_WUKV] + (size_t)l * 256 * 1536, (bf16_t*)(ws + O_WUKV) + (size_t)l * 1536 * 256, p.in[I_MKVN] + l * 256, 1536, 256, 48, 0}; }
    cvt_block(m, t / m.nb, t % m.nb, lane);
}
constexpr int CVT_EXP = 65 * 1536;
__device__ __forceinline__ void cvt_exp_task(const Params& p, int l, int t, int lane) {
    unsigned char* ws = p.ws;
    const int e = t / 1536, r = t % 1536, which = r >> 9, q = r & 511; CvtMat m;
    if (which < 2) {
        const float* src = (e < NEXP) ? p.in[which == 0 ? I_EG : I_EU] + ((size_t)l * NEXP + e) * DM * EH : p.in[which == 0 ? I_SG : I_SU] + (size_t)l * DM * EH;
        m = CvtMat{src, (bf16_t*)(ws + O_EGU) + (size_t)e * 1024 * 2048, nullptr, EH, DM, 16, 1 + which};
    } else {
        const float* src = (e < NEXP) ? p.in[I_EDN] + ((size_t)l * NEXP + e) * EH * DM : p.in[I_SD] + (size_t)l * EH * DM;
        m = CvtMat{src, (bf16_t*)(ws + O_ED) + (size_t)e * 2048 * 512, nullptr, DM, EH, 64, 0};
    }
    cvt_block(m, q / m.nb, q % m.nb, lane);
}
__device__ __forceinline__ void cvt_exp_all(const Params& p, int l) {
    const int lane = otid() & 63, gw = blockIdx.x * 8 + owid(), GW = gridDim.x * 8;
    for (int t = gw; t < CVT_EXP; t += GW) cvt_exp_task(p, l, t, lane);
}
__device__ __forceinline__ void adaln_tasks(const Params& p, LAS float* lf) {
    const int lane = otid() & 63, wid = owid();
    float* MOD = (float*)(p.ws + O_MOD);
    for (int task = blockIdx.x; task < 384; task += gridDim.x) {
        const int cb = task % 192, l = task / 192, col = cb * 64 + lane;
        const float* W = p.in[I_ADAW] + (size_t)l * DM * 12288 + col;
        float acc[9];
#pragma unroll
        for (int r = 0; r < 9; ++r) acc[r] = 0.f;
        for (int kb = wid * 256; kb < wid * 256 + 256; kb += 64) {
            float sv[9];
#pragma unroll
            for (int r = 0; r < 8; ++r) sv[r] = silu_f(p.in[I_C][r * DM + kb + lane]);
            sv[8] = silu_f(p.in[I_CCTX][kb + lane]);
#pragma unroll 8
            for (int kk = 0; kk < 64; ++kk) { const float w = W[(size_t)(kb + kk) * 12288];
#pragma unroll
                for (int r = 0; r < 9; ++r) acc[r] += rdlane(sv[r], kk) * w; }
        }
#pragma unroll
        for (int r = 0; r < 9; ++r) lf[(wid * 9 + r) * 64 + lane] = acc[r];
        __syncthreads();
        for (int r = wid; r < 9; r += 8) { float s = p.in[I_ADAB][l * 12288 + col];
#pragma unroll
            for (int w = 0; w < 8; ++w) s += lf[(w * 9 + r) * 64 + lane];
            MOD[(size_t)(l * 9 + r) * 12288 + col] = s; }
        __syncthreads();
    }
}
__device__ __forceinline__ void hss_tasks(const Params& p) {
    const int lane = otid() & 63, gw = blockIdx.x * 8 + owid(), GW = gridDim.x * 8;
    for (int task = gw; task < 3 * 1024; task += GW) {
        const int set = task >> 10, l = (set == 1) ? 1 : 0, nset = (set == 2) ? 1 : 0, ord = (task >> 9) & 1, ch = task & 511, n = nset ? 256 : 2048;
        const float* HF = (const float*)(p.ws + O_HF) + (size_t)l * HF_LAYER + (nset ? HF_L0 : 0);
        const float* hf = HF + (size_t)((ord * 2 + 0) * 512 + ch) * n; const float* hb = HF + (size_t)((ord * 2 + 1) * 512 + ch) * n;
        float s = 0.f;
        for (int i = lane; i < n; i += 64) { const float a = hf[i], b = (i == 0) ? 0.f : hb[i]; s += a * a + b * b; }
        s = wave_sum(s);
        if (lane == 0) ((float*)(p.ws + O_HSS))[(size_t)((l * 2 + nset) * 2 + ord) * 512 + ch] = s;
    }
}
__device__ __forceinline__ void hyf_task(const Params& p, int l, int nset, int i0, LAS float* lf) {
    int tid = otid(); const int n = nset ? 256 : 2048;
    LAS float* feats = lf; LAS float* hd1 = lf + 8 * 33; LAS float* hd2 = hd1 + 512;
    if (tid < 8 * 33) { const int pos = tid / 33, f = tid % 33, i = i0 + pos; const float t = (float)i / (float)(n - 1), ang = 6.283185307179586f * (float)i / (float)n; float v;
        if (f == 0) v = t; else { const int j = (f - 1) & 15; const float band = 1e-4f + (float)j * ((15.0f - 1e-4f) / 15.0f); v = (f <= 16) ? cosf(ang * band) : sinf(ang * band); }
        feats[tid] = v; }
    __syncthreads();
    { const int pos = tid >> 6, j = tid & 63; const float* w1 = p.in[I_HYW1] + l * 33 * 64; float s = p.in[I_HYB1][l * 64 + j];
      for (int f = 0; f < 33; ++f) s += feats[pos * 33 + f] * w1[f * 64 + j];
      hd1[tid] = sinf(p.in[I_HYFREQ][l * 64 + j] * s); }
    __syncthreads();
    { const int pos = tid >> 6, j = tid & 63; const float* w2 = p.in[I_HYW2] + l * 64 * 64; float s = p.in[I_HYB2][l * 64 + j];
      for (int f = 0; f < 64; ++f) s += hd1[pos * 64 + f] * w2[f * 64 + j];
      hd2[tid] = sinf(p.in[I_HYFREQ][l * 64 + j] * s); }
    __syncthreads();
    const float* w3 = p.in[I_HYW3] + (size_t)l * 64 * 2048 + tid * 4;
    f32x4 acc[8];
#pragma unroll
    for (int q = 0; q < 8; ++q) acc[q] = (f32x4){0.f, 0.f, 0.f, 0.f};
    for (int j = 0; j < 64; ++j) { const f32x4 w = *(const f32x4*)(w3 + (size_t)j * 2048);
#pragma unroll
        for (int q = 0; q < 8; ++q) acc[q] += w * hd2[q * 64 + j]; }
    float* HF = (float*)(p.ws + O_HF) + (size_t)l * HF_LAYER + (nset ? HF_L0 : 0);
#pragma unroll
    for (int c = 0; c < 4; ++c) { const int col = tid * 4 + c, ord = col >> 10, dir = (col >> 9) & 1, ch = col & 511;
        const float delta = 3.0701134573253944f + (float)ch * ((15.350567286626973f - 3.0701134573253944f) / 511.0f); float v[8];
#pragma unroll
        for (int q = 0; q < 8; ++q) { const int i = i0 + q; const float t = (float)i / (float)(n - 1); v[q] = acc[q][c] * __expf(-t * delta); }
        float* dst = HF + (size_t)((ord * 2 + dir) * 512 + ch) * n + i0;
        *(f32x4*)dst = (f32x4){v[0], v[1], v[2], v[3]}; *(f32x4*)(dst + 4) = (f32x4){v[4], v[5], v[6], v[7]};    }
    __syncthreads();
}
__device__ __forceinline__ void rope_tables(const Params& p);
__device__ __forceinline__ void phase_prologue(const Params& p, LAS unsigned char* lds) {
    const int tid = otid(); LAS float* lf = (LAS float*)lds;
    { const size_t gt = (size_t)blockIdx.x * NTHREADS + tid, GT = (size_t)gridDim.x * NTHREADS;
      for (int l = 0; l < NLAYER; ++l) {
          u32x4* z1 = (u32x4*)((bf16_t*)(p.ws + O_WIN) + ((size_t)l * NP + IN_COLS) * DM); const size_t n1 = (size_t)(NP - IN_COLS) * DM * 2 / 16;
          for (size_t i = gt; i < n1; i += GT) z1[i] = (u32x4){0u, 0u, 0u, 0u};
          u32x4* z2 = (u32x4*)((bf16_t*)(p.ws + O_WUQ) + ((size_t)l * NQP + 1152) * 768); const size_t n2 = (size_t)(NQP - 1152) * 768 * 2 / 16;
          for (size_t i = gt; i < n2; i += GT) z2[i] = (u32x4){0u, 0u, 0u, 0u};
      } }
    rope_tables(p);
    adaln_tasks(p, lf);
    for (int t = blockIdx.x; t < 544; t += gridDim.x) { if (t < 512) hyf_task(p, t >> 8, 0, (t & 255) * 8, lf); else hyf_task(p, 0, 1, (t - 512) * 8, lf); }
    { const int lane = tid & 63, gw = blockIdx.x * 8 + owid(), GW = gridDim.x * 8;
      for (int t = gw; t < NLAYER * CVT_SMALL; t += GW) cvt_small_task(p, t / CVT_SMALL, t % CVT_SMALL, lane); }
    cvt_exp_all(p, 0);
}

__device__ __forceinline__ void norm1_row(const Params& p, int l, int row, const float (&x)[32], int lane) {
    float ss = 0.f;
#pragma unroll
    for (int i = 0; i < 32; ++i) ss += x[i] * x[i];
    ss = wave_sum(ss); const float rstd = rsqrtf(ss * (1.0f / DM) + EPS);
    const float* g = p.in[I_NORMG] + (size_t)(l * 4 + 0) * DM; const float* mod = (const float*)(p.ws + O_MOD) + (size_t)(l * 9 + row_batch(row)) * 12288;
    bf16_t* H = (bf16_t*)(p.ws + O_H) + (size_t)row * DM;
#pragma unroll
    for (int j = 0; j < 8; ++j) { const int c = ROWCOL(j, lane); const f32x4 gv = *(const f32x4*)(g + c), sh = *(const f32x4*)(mod + c), sc = *(const f32x4*)(mod + DM + c); float h[4];
#pragma unroll
        for (int q = 0; q < 4; ++q) h[q] = x[j * 4 + q] * rstd * gv[q] * (1.0f + sc[q]) + sh[q];
        u32x2 w; w.x = pk2(h[0], h[1]); w.y = pk2(h[2], h[3]); *(u32x2*)(H + c) = w; }
}
__device__ __forceinline__ void phase_norm1(const Params& p, int l) {
    const int lane = otid() & 63, gw = blockIdx.x * 8 + owid(), GW = gridDim.x * 8;
    const int lane0 = lane;
    for (int row = gw; row < NTOK; row += GW) { int lane = lane0; asm volatile("" : "+v"(lane)); const float* src = resid_src(p, l, row); float x[32];
#pragma unroll
        for (int j = 0; j < 8; ++j) { const f32x4 v = *(const f32x4*)(src + ROWCOL(j, lane)); x[j * 4] = v[0]; x[j * 4 + 1] = v[1]; x[j * 4 + 2] = v[2]; x[j * 4 + 3] = v[3]; }
        norm1_row(p, l, row, x, lane); }
}

__device__ __forceinline__ void rope_tables(const Params& p) {
    float* T = (float*)(p.ws + O_ROPE);
    for (int i = blockIdx.x * NTHREADS + otid(); i < 64 * 32 + 64 * 16; i += gridDim.x * NTHREADS) {
        float a; if (i < 64 * 32) a = (float)(i >> 5) * exp2f(-(float)(i & 31) * (13.287712379549449f / 32.0f)); else { const int q = i - 64 * 32; a = (float)(q >> 4) * exp2f(-(float)(q & 15) * (13.287712379549449f / 16.0f)); }
        float sn, cs; sincosf(a, &sn, &cs); T[2 * i] = cs; T[2 * i + 1] = sn; }
}
__device__ __forceinline__ void unpack8(const u32x4 v, float (&x)[8]) {
#pragma unroll
    for (int j = 0; j < 4; ++j) { x[2 * j] = __uint_as_float(v[j] << 16); x[2 * j + 1] = __uint_as_float(v[j] & 0xffff0000u); }
}
__device__ __forceinline__ u32x4 pack8(const float (&x)[8]) { u32x4 w; w.x = pk2(x[0], x[1]); w.y = pk2(x[2], x[3]); w.z = pk2(x[4], x[5]); w.w = pk2(x[6], x[7]); return w; }
template <int PX> __device__ __forceinline__ void rope8(float (&x)[8], const float* cs, bool second) {
#pragma unroll
    for (int j = 0; j < 8; ++j) { const float pr = __shfl_xor(x[j], PX), c = cs[2 * j], sn = cs[2 * j + 1]; x[j] = second ? pr * sn + x[j] * c : x[j] * c - pr * sn; }
}
__device__ __forceinline__ void gqa_post_row(const Params& p, int l, int row, int lane) {
    const bf16_t* P = (const bf16_t*)(p.ws + O_P) + (size_t)row * NP;
    const bool isctx = row >= NLAT; const int b = isctx ? (row - NLAT) >> 8 : row >> 11, t = isctx ? (row - NLAT) & 255 : row & 2047;
    const int j = lane & 15, hq = lane >> 4, half = j >> 3; const bool second = (j >> 2) & 1;
    const float* cs = (const float*)(p.ws + O_ROPE) + ((size_t)(half ? (t & 63) : (t >> 6)) * 32 + 8 * (j & 3)) * 2;
    const int kpos = isctx ? t : CTXL + t;
#pragma unroll
    for (int ps = 0; ps < 2; ++ps) {
        const bool isk = (ps == 1) && (hq >= 2); const int h = (ps == 0) ? hq : (isk ? hq - 2 : 4 + hq);
        const bf16_t* src = P + (isk ? C_GK : C_GQ) + h * 128 + 8 * j; const float* gn = (isk ? p.in[I_GKN] : p.in[I_GQN]) + l * 128 + 8 * j;
        float x[8]; unpack8(*(const u32x4*)src, x);
        float ss = 0.f;
#pragma unroll
        for (int q = 0; q < 8; ++q) ss += x[q] * x[q];
        ss += __shfl_xor(ss, 1); ss += __shfl_xor(ss, 2); ss += __shfl_xor(ss, 4); ss += __shfl_xor(ss, 8);
        const float rstd = rsqrtf(ss * (1.0f / 128.0f) + EPS); const f32x4 g0 = *(const f32x4*)gn, g1 = *(const f32x4*)(gn + 4);
#pragma unroll
        for (int q = 0; q < 4; ++q) { x[q] *= rstd * g0[q]; x[4 + q] *= rstd * g1[q]; }
        if (!isctx) rope8<4>(x, cs, second);
        bf16_t* dst = isk ? (bf16_t*)(p.ws + O_KG) + ((size_t)(b * 2 + h) * LK + kpos) * 128
                          : (isctx ? (bf16_t*)(p.ws + O_QGC) + ((size_t)(b * 6 + h) * CTXL + t) * 128 : (bf16_t*)(p.ws + O_QG) + ((size_t)(b * 6 + h) * SEQ + t) * 128);
        *(u32x4*)(dst + 8 * j) = pack8(x);
    }
    if (lane < 32) { const int h = lane >> 4; *(u32x4*)((bf16_t*)(p.ws + O_VG) + ((size_t)(b * 2 + h) * LK + kpos) * 128 + 8 * j) = *(const u32x4*)(P + C_GV + h * 128 + 8 * j); }
}
__device__ __forceinline__ void seq_of(int row, int& s0, int& n) { if (row < NLAT) { s0 = row & ~2047; n = SEQ; } else { s0 = NLAT + ((row - NLAT) & ~255); n = CTXL; } }
__device__ __forceinline__ void load_conv_tile(const bf16_t* P, int t0, int pc0, LAS float* u) {
    int s0, n; seq_of(t0, s0, n);
    for (int i = otid(); i < 66 * 64; i += NTHREADS) { const int r = i >> 6, c = i & 63, row = t0 - 1 + r;
        u[r * 65 + c] = (row >= s0 && row < s0 + n) ? bf2f(P[(size_t)row * NP + pc0 + c]) : 0.f; }
}
__device__ __forceinline__ void hy_prep_task(const Params& p, int l, int t0, int c0, LAS float* u) {
    const bf16_t* P = (const bf16_t*)(p.ws + O_P);
    load_conv_tile(P, t0, c0, u);
    __syncthreads();
    const int tid = otid(), c = tid >> 3, tc = (tid & 7) * 8; const float* cw = p.in[I_HYCONV] + (size_t)l * 3 * 1536 + c0 + c;
    const float w0 = cw[0], w1 = cw[1536], w2 = cw[3072]; float y[8];
#pragma unroll
    for (int j = 0; j < 8; ++j) y[j] = w0 * u[(tc + j) * 65 + c] + w1 * u[(tc + j + 1) * 65 + c] + w2 * u[(tc + j + 2) * 65 + c];
    const int ch = c0 + c; bf16_t* dst = (ch < 512 ? (bf16_t*)(p.ws + O_VT) + (size_t)ch * NTOK : (bf16_t*)(p.ws + O_X1T) + (size_t)(ch - 512) * NTOK) + t0 + tc;
    u32x4 w; w.x = pk2(y[0], y[1]); w.y = pk2(y[2], y[3]); w.z = pk2(y[4], y[5]); w.w = pk2(y[6], y[7]); *(u32x4*)dst = w;
    __syncthreads();
}
__device__ __forceinline__ void mla_post_row(const Params& p, int l, int row, int lane) {
    const bf16_t* P = (const bf16_t*)(p.ws + O_P) + (size_t)row * NP;
    const bool isctx = row >= NLAT; const int b = isctx ? (row - NLAT) >> 8 : row >> 11, t = isctx ? (row - NLAT) & 255 : row & 2047;
    float sq = 0.f, skv = 0.f; float x[8];
    unpack8(*(const u32x4*)(P + C_CQ + 8 * lane), x);
#pragma unroll
    for (int q = 0; q < 8; ++q) sq += x[q] * x[q];
    if (lane < 32) { unpack8(*(const u32x4*)(P + C_CQ + 512 + 8 * lane), x);
#pragma unroll
        for (int q = 0; q < 8; ++q) sq += x[q] * x[q];
        unpack8(*(const u32x4*)(P + C_CKV + 8 * lane), x);
#pragma unroll
        for (int q = 0; q < 8; ++q) skv += x[q] * x[q]; }
    const float rq = rsqrtf(wave_sum(sq) * (1.0f / 768.0f) + EPS), rkv = rsqrtf(wave_sum(skv) * (1.0f / 256.0f) + EPS);
    const bf16_t* QR = (const bf16_t*)(p.ws + O_QRAW) + (size_t)row * NQP; const bf16_t* KV = (const bf16_t*)(p.ws + O_KVRAW) + (size_t)row * 1536;
    const int kpos = isctx ? t : CTXL + t;
    const float* RM = (const float*)(p.ws + O_ROPE) + 64 * 32 * 2;
#pragma unroll
    for (int ps = 0; ps < 3; ++ps) { const int id = ps * 64 + lane; const bool act = id < 144; const int h = act ? id / 24 : 0, cj = act ? id % 24 : 0, rc = cj - 16;
        unpack8(*(const u32x4*)(QR + h * 192 + 8 * cj), x);
#pragma unroll
        for (int q = 0; q < 8; ++q) x[q] *= rq;
        if (!isctx) { const int rcc = rc < 0 ? 0 : rc; const float* cs = RM + ((size_t)((rcc >> 2) ? (t & 63) : (t >> 6)) * 16 + 8 * (rcc & 1)) * 2; float y[8];
#pragma unroll
            for (int q = 0; q < 8; ++q) y[q] = x[q];
            rope8<2>(y, cs, (rcc >> 1) & 1);
            if (rc >= 0) {
#pragma unroll
                for (int q = 0; q < 8; ++q) x[q] = y[q]; } }
        bf16_t* qd = isctx ? (bf16_t*)(p.ws + O_QMC) + ((size_t)(b * 6 + h) * CTXL + t) * 192 : (bf16_t*)(p.ws + O_QM) + ((size_t)(b * 6 + h) * SEQ + t) * 192;
        if (act) *(u32x4*)(qd + 8 * cj) = pack8(x); }
#pragma unroll
    for (int ps = 0; ps < 3; ++ps) { const int id = ps * 64 + lane, h = id >> 5, c = id & 31;
        unpack8(*(const u32x4*)(KV + h * 256 + 8 * c), x);
#pragma unroll
        for (int q = 0; q < 8; ++q) x[q] *= rkv;
        bf16_t* d = (c < 16) ? (bf16_t*)(p.ws + O_KM) + ((size_t)(b * 6 + h) * LK + kpos) * 192 + 8 * c : (bf16_t*)(p.ws + O_VM) + ((size_t)(b * 6 + h) * LK + kpos) * 128 + 8 * (c - 16);
        *(u32x4*)d = pack8(x); }
    { const int h = lane >> 3, rc = lane & 7; unpack8(*(const u32x4*)(P + C_KR + 8 * rc), x);
      if (!isctx) { const float* cs = RM + ((size_t)((rc >> 2) ? (t & 63) : (t >> 6)) * 16 + 8 * (rc & 1)) * 2; rope8<2>(x, cs, (rc >> 1) & 1); }
      if (lane < 48) *(u32x4*)((bf16_t*)(p.ws + O_KM) + ((size_t)(b * 6 + h) * LK + kpos) * 192 + 128 + 8 * rc) = pack8(x); }
}

__device__ __forceinline__ void hyconv_unit_valu(const Params& p, int l, int nset, int c, LAS float* lf) {
    const int tid = otid(), n = nset ? CTXL : SEQ, tokbase = nset ? NLAT : 0;
    LAS float* kc = lf; LAS float* z = lf + 4096; LAS float* z2 = z + 8 * SEQ;
    const float* HF = (const float*)(p.ws + O_HF) + (size_t)l * HF_LAYER + (nset ? HF_L0 : 0); const float* HSS = (const float*)(p.ws + O_HSS) + (size_t)((l * 2 + nset) * 2) * 512;
    const bf16_t* VT = (const bf16_t*)(p.ws + O_VT) + (size_t)c * NTOK + tokbase; const bf16_t* X1T = (const bf16_t*)(p.ws + O_X1T) + (size_t)c * NTOK + tokbase;
    bf16_t* Y2T = (bf16_t*)(p.ws + O_Y2T) + (size_t)c * NTOK + tokbase;
    for (int i = tid; i < 8 * n; i += NTHREADS) z[i] = bf2f(VT[i]);
    for (int ord = 0; ord < 2; ++ord) {
        const float rs = rsqrtf(HSS[ord * 512 + c] + EPS); const float* hf = HF + (size_t)((ord * 2 + 0) * 512 + c) * n; const float* hb = HF + (size_t)((ord * 2 + 1) * 512 + c) * n;
        for (int m = tid; m < 2 * n; m += NTHREADS) { const int lag = m - (n - 1); kc[m] = (m == 2 * n - 1) ? 0.f : (lag >= 0 ? hf[lag] : hb[-lag]) * rs; }
        __syncthreads();
        const LAS float* zs = ord ? z2 : z; const float skip = p.in[I_HYSKIP][(size_t)(l * 2 + ord) * 512 + c];
        for (int q = tid; q < n; q += NTHREADS) {
            const int b = q / (n >> 3), t0 = (q % (n >> 3)) * 8; float acc[8];
#pragma unroll
            for (int j = 0; j < 8; ++j) acc[j] = 0.f;
            const LAS float* zb = zs + b * n;
            for (int sb = 0; sb < n; sb += 8) {
                const LAS float* kb = kc + (t0 - sb + n - 8); float w[16];
#pragma unroll
                for (int i = 0; i < 4; ++i) { const f32x4 v = *(const LAS f32x4*)(kb + 4 * i); w[4 * i] = v[0]; w[4 * i + 1] = v[1]; w[4 * i + 2] = v[2]; w[4 * i + 3] = v[3]; }
                const f32x4 za = *(const LAS f32x4*)(zb + sb), zc = *(const LAS f32x4*)(zb + sb + 4); const float zv[8] = {za[0], za[1], za[2], za[3], zc[0], zc[1], zc[2], zc[3]};
#pragma unroll
                for (int ss = 0; ss < 8; ++ss)
#pragma unroll
                    for (int j = 0; j < 8; ++j) acc[j] += w[j - ss + 7] * zv[ss];
            }
            if (ord == 0) {
#pragma unroll
                for (int j = 0; j < 8; ++j) { const int idx = b * n + t0 + j; z2[idx] = bf2f(X1T[idx]) * (acc[j] + skip * z[idx]); }
            } else { float y[8];
#pragma unroll
                for (int j = 0; j < 8; ++j) y[j] = acc[j] + skip * z2[b * n + t0 + j];
                u32x4 w; w.x = pk2(y[0], y[1]); w.y = pk2(y[2], y[3]); w.z = pk2(y[4], y[5]); w.w = pk2(y[6], y[7]); *(u32x4*)(Y2T + b * n + t0) = w; }
        }
        __syncthreads();
    }
}
constexpr int HC_COPYB = 8256, HC_ROWB = 4560, HC_PAD = 112, HC_KR = 4112, HC_M0 = 2064;
constexpr int HC_ZOFF = 8 * HC_COPYB, HC_Z2OFF = HC_ZOFF + 8 * HC_ROWB;
__device__ __forceinline__ void hyconv_unit_mfma(const Params& p, int l, int c, LAS unsigned char* lds) {
    const int tid = otid(), wid = __builtin_amdgcn_readfirstlane(tid >> 6), lane = tid & 63;
    LAS unsigned char* CP = lds; LAS unsigned char* Zr = lds + HC_ZOFF; LAS unsigned char* Z2r = lds + HC_Z2OFF;
    const float* HF = (const float*)(p.ws + O_HF) + (size_t)l * HF_LAYER; const float* HSS = (const float*)(p.ws + O_HSS) + (size_t)(l * 4) * 512;
    const bf16_t* VT = (const bf16_t*)(p.ws + O_VT) + (size_t)c * NTOK; const bf16_t* X1T = (const bf16_t*)(p.ws + O_X1T) + (size_t)c * NTOK; bf16_t* Y2T = (bf16_t*)(p.ws + O_Y2T) + (size_t)c * NTOK;
    for (int q = tid; q < 8 * 256; q += NTHREADS) { const int b = q >> 8, ch = q & 255; *(LAS u32x4*)(Zr + b * HC_ROWB + (HC_PAD + ch * 8) * 2) = *(const u32x4*)(VT + b * SEQ + ch * 8); }
    for (int q = tid; q < 8 * 29; q += NTHREADS) { const int b = q / 29, ch = q % 29; const int e0 = ch < 14 ? ch * 8 : HC_PAD + SEQ + (ch - 14) * 8; *(LAS u32x4*)(Zr + b * HC_ROWB + e0 * 2) = (u32x4){0u, 0u, 0u, 0u}; }
    const int a = lane & 31, kg = lane >> 5, bq = a >> 2, isub = a & 3;
    const int Aoff = (a & 7) * HC_COPYB + (HC_M0 - 8 * (a >> 3) + 8 * kg) * 2;
    const int g0 = 2 * wid;
    const int Boff = bq * HC_ROWB + (HC_PAD + 128 * g0 + 32 * isub + 8 * kg) * 2;
    for (int ord = 0; ord < 2; ++ord) {
        LAS float* kr = (LAS float*)(ord == 0 ? Z2r : Zr);
        { const float rs = rsqrtf(HSS[ord * 512 + c] + EPS); const float* hf = HF + (size_t)((ord * 2 + 0) * 512 + c) * SEQ; const float* hb = HF + (size_t)((ord * 2 + 1) * 512 + c) * SEQ;
          for (int m = tid; m < HC_KR; m += NTHREADS) { const int lag = HC_M0 - m; float v = 0.f; if (lag >= 0 && lag < SEQ) v = hf[lag] * rs; else if (lag < 0 && lag > -SEQ) v = hb[-lag] * rs; kr[m] = v; } }
        __syncthreads();
        for (int q = tid; q < 8 * 516; q += NTHREADS) { const int sft = q / 516, ch = q % 516; float v[8];
#pragma unroll
            for (int j = 0; j < 8; ++j) { const int m = ch * 8 + j - sft; v[j] = (m >= 0 && m < HC_KR) ? kr[m] : 0.f; }
            u32x4 w; w.x = pk2(v[0], v[1]); w.y = pk2(v[2], v[3]); w.z = pk2(v[4], v[5]); w.w = pk2(v[6], v[7]); *(LAS u32x4*)(CP + sft * HC_COPYB + ch * 16) = w; }
        __syncthreads();
        if (ord == 0) for (int q = tid; q < 8 * 29; q += NTHREADS) { const int b = q / 29, ch = q % 29; const int e0 = ch < 14 ? ch * 8 : HC_PAD + SEQ + (ch - 14) * 8; *(LAS u32x4*)(Z2r + b * HC_ROWB + e0 * 2) = (u32x4){0u, 0u, 0u, 0u}; }
        const LAS unsigned char* Zs = ord ? Z2r : Zr;
        f32x16 acc0 = {}, acc1 = {};
        const int e_lo = 16 * wid - 127, e_mid0 = 16 * wid - 119, e_mid1 = 16 * wid + 7, e_hi = 16 * wid + 15;
        for (int e = e_lo; e < e_mid0; ++e) { const bf16x8 A = *(const LAS bf16x8*)(CP + Aoff - 32 * e); const bf16x8 B0 = *(const LAS bf16x8*)(Zs + Boff - 32 * e);
            acc0 = __builtin_amdgcn_mfma_f32_32x32x16_bf16(A, B0, acc0, 0, 0, 0); }
#pragma unroll 2
        for (int e = e_mid0; e <= e_mid1; ++e) { const bf16x8 A = *(const LAS bf16x8*)(CP + Aoff - 32 * e); const bf16x8 B0 = *(const LAS bf16x8*)(Zs + Boff - 32 * e); const bf16x8 B1 = *(const LAS bf16x8*)(Zs + Boff + 256 - 32 * e);
            acc0 = __builtin_amdgcn_mfma_f32_32x32x16_bf16(A, B0, acc0, 0, 0, 0); acc1 = __builtin_amdgcn_mfma_f32_32x32x16_bf16(A, B1, acc1, 0, 0, 0); }
        for (int e = e_mid1 + 1; e <= e_hi; ++e) { const bf16x8 A = *(const LAS bf16x8*)(CP + Aoff - 32 * e); const bf16x8 B1 = *(const LAS bf16x8*)(Zs + Boff + 256 - 32 * e);
            acc1 = __builtin_amdgcn_mfma_f32_32x32x16_bf16(A, B1, acc1, 0, 0, 0); }
        const float skip = p.in[I_HYSKIP][(size_t)(l * 2 + ord) * 512 + c];
#pragma unroll
        for (int gi = 0; gi < 2; ++gi) {
#pragma unroll
            for (int q = 0; q < 4; ++q) { const int t = 128 * (g0 + gi) + 32 * isub + 8 * q + 4 * kg; float y[4];
#pragma unroll
                for (int j = 0; j < 4; ++j) y[j] = gi ? acc1[4 * q + j] : acc0[4 * q + j];
                const u32x2 zz = *(const LAS u32x2*)(Zs + bq * HC_ROWB + (HC_PAD + t) * 2);
                const float z0 = __uint_as_float(zz.x << 16), z1 = __uint_as_float(zz.x & 0xffff0000u), z2 = __uint_as_float(zz.y << 16), z3 = __uint_as_float(zz.y & 0xffff0000u);
                y[0] += skip * z0; y[1] += skip * z1; y[2] += skip * z2; y[3] += skip * z3;
                if (ord == 0) { const u32x2 xx = *(const u32x2*)(X1T + bq * SEQ + t);
                    y[0] *= __uint_as_float(xx.x << 16); y[1] *= __uint_as_float(xx.x & 0xffff0000u); y[2] *= __uint_as_float(xx.y << 16); y[3] *= __uint_as_float(xx.y & 0xffff0000u);
                    u32x2 w; w.x = pk2(y[0], y[1]); w.y = pk2(y[2], y[3]); *(LAS u32x2*)(Z2r + bq * HC_ROWB + (HC_PAD + t) * 2) = w; }
                else { u32x2 w; w.x = pk2(y[0], y[1]); w.y = pk2(y[2], y[3]); *(u32x2*)(Y2T + bq * SEQ + t) = w; } }
        }
        __syncthreads();
    }
}
__device__ __forceinline__ void hy_fin_task(const Params& p, int l, int t0, int c0, LAS float* u) {
    const bf16_t* P = (const bf16_t*)(p.ws + O_P); LAS float* y = u + 66 * 65;
    load_conv_tile(P, t0, 1024 + c0, u);
    const int tid = otid();
    { const int c = tid >> 3, tc = (tid & 7) * 8; const u32x4 v = *(const u32x4*)((const bf16_t*)(p.ws + O_Y2T) + (size_t)(c0 + c) * NTOK + t0 + tc);
#pragma unroll
      for (int j = 0; j < 4; ++j) { y[c * 65 + tc + 2 * j] = __uint_as_float(v[j] << 16); y[c * 65 + tc + 2 * j + 1] = __uint_as_float(v[j] & 0xffff0000u); } }
    __syncthreads();
    { const int t = tid >> 3, cc = (tid & 7) * 8; const float* cw = p.in[I_HYCONV] + (size_t)l * 3 * 1536 + 1024 + c0 + cc; float o[8];
#pragma unroll
      for (int j = 0; j < 8; ++j) { const int c = cc + j; const float x2 = cw[j] * u[t * 65 + c] + cw[1536 + j] * u[(t + 1) * 65 + c] + cw[3072 + j] * u[(t + 2) * 65 + c]; o[j] = x2 * y[c * 65 + t]; }
      u32x4 w; w.x = pk2(o[0], o[1]); w.y = pk2(o[2], o[3]); w.z = pk2(o[4], o[5]); w.w = pk2(o[6], o[7]);
      *(u32x4*)((bf16_t*)(p.ws + O_MIX) + (size_t)(t0 + t) * DM + c0 + cc) = w; }
    __syncthreads();
}

__device__ __forceinline__ void mla_unit(const Params& p, int b, int h, int qb, bool ctxq, LAS unsigned char* lds) {
    unsigned char* ws = p.ws;
    const bf16_t* Q = ctxq ? (const bf16_t*)(ws + O_QMC) + (size_t)(b * 6 + h) * CTXL * 192 : (const bf16_t*)(ws + O_QM) + ((size_t)(b * 6 + h) * SEQ + qb * 256) * 192;
    bf16_t* O = (bf16_t*)(ws + O_MIX) + (size_t)(ctxq ? NLAT + b * CTXL : b * SEQ + qb * 256) * DM + 512 + h * 128;
    attn_body<192, 0>(Q, (const bf16_t*)(ws + O_KM) + (size_t)(b * 6 + h) * LK * 192, (const bf16_t*)(ws + O_VM) + (size_t)(b * 6 + h) * LK * 128, O, DM, ctxq ? CTXL : LK, 0.07216878364870322f, (char*)lds);
}
__device__ __forceinline__ void gqa_unit(const Params& p, int b, int h, int qb, bool ctxq, LAS unsigned char* lds) {
    unsigned char* ws = p.ws;
    const bf16_t* Q = ctxq ? (const bf16_t*)(ws + O_QGC) + (size_t)(b * 6 + h) * CTXL * 128 : (const bf16_t*)(ws + O_QG) + ((size_t)(b * 6 + h) * SEQ + qb * 256) * 128;
    bf16_t* O = (bf16_t*)(ws + O_MIX) + (size_t)(ctxq ? NLAT + b * CTXL : b * SEQ + qb * 256) * DM + 1280 + h * 128;
    attn_body<128, GQA_SD>(Q, (const bf16_t*)(ws + O_KG) + (size_t)(b * 2 + h / 3) * LK * 128, (const bf16_t*)(ws + O_VG) + (size_t)(b * 2 + h / 3) * LK * 128, O, DM, ctxq ? CTXL : LK, 0.08838834764831845f, (char*)lds);
}
__device__ __forceinline__ void phase_mixer(const Params& p, int l, LAS unsigned char* lds) {
    const int G = gridDim.x, bid = blockIdx.x; const bool last = (l == NLAYER - 1);
    for (int u = bid; u < 384 + (last ? 0 : 48); u += G) { if (u < 384) mla_unit(p, u / 48, (u >> 3) % 6, u & 7, false, lds); else mla_unit(p, (u - 384) / 6, (u - 384) % 6, 0, true, lds); }
    for (int u = (bid + G / 2) % G; u < 384 + (last ? 0 : 48); u += G) { if (u < 384) gqa_unit(p, u / 48, (u >> 3) % 6, u & 7, false, lds); else gqa_unit(p, (u - 384) / 6, (u - 384) % 6, 0, true, lds); }
#ifndef CONV_REP
#define CONV_REP 1
#endif
    for (int rep = 0; rep < CONV_REP; ++rep) {
#if HY_MFMA
    for (int u = bid; u < 512; u += G) hyconv_unit_mfma(p, l, u, lds);
    if (!last) for (int u = bid; u < 512; u += G) hyconv_unit_valu(p, l, 1, u, (LAS float*)lds);
#else
    for (int u = bid; u < (last ? 512 : 1024); u += G) hyconv_unit_valu(p, l, u >> 9, u & 511, (LAS float*)lds);
#endif
    }
}

constexpr int RT_FS = DM + 4;
__device__ __forceinline__ void route_row_pre(const Params& p, int l, int row, int lane, LAS float* fdst, const float* g1, const float* g2) {
    const float* mod = (const float*)(p.ws + O_MOD) + (size_t)(l * 9 + row_batch(row)) * 12288;
    const bf16_t* O = (const bf16_t*)(p.ws + O_OUT) + (size_t)row * DM; const float* rs = resid_src(p, l, row); float* X = (float*)(p.ws + O_X) + (size_t)row * DM; bf16_t* H = (bf16_t*)(p.ws + O_H) + (size_t)row * DM;
    float o[32], x[32]; float ss = 0.f;
#pragma unroll
    for (int j = 0; j < 8; ++j) { const u32x2 v = *(const u32x2*)(O + ROWCOL(j, lane)); o[j * 4] = __uint_as_float(v.x << 16); o[j * 4 + 1] = __uint_as_float(v.x & 0xffff0000u); o[j * 4 + 2] = __uint_as_float(v.y << 16); o[j * 4 + 3] = __uint_as_float(v.y & 0xffff0000u); }
#pragma unroll
    for (int i = 0; i < 32; ++i) ss += o[i] * o[i];
    const float r1 = rsqrtf(wave_sum(ss) * (1.0f / DM) + EPS); float s2 = 0.f;
#pragma unroll
    for (int j = 0; j < 8; ++j) { const int c = ROWCOL(j, lane); const f32x4 xv = *(const f32x4*)(rs + c), gv = *(const f32x4*)(g1 + c), ga = *(const f32x4*)(mod + 2 * DM + c); f32x4 xn;
#pragma unroll
        for (int q = 0; q < 4; ++q) { xn[q] = xv[q] + ga[q] * (o[j * 4 + q] * r1 * gv[q]); x[j * 4 + q] = xn[q]; s2 += xn[q] * xn[q]; }
        *(f32x4*)(X + c) = xn; }
    const float r2 = rsqrtf(wave_sum(s2) * (1.0f / DM) + EPS);
#pragma unroll
    for (int j = 0; j < 8; ++j) { const int c = ROWCOL(j, lane); const f32x4 gv = *(const f32x4*)(g2 + c), sh = *(const f32x4*)(mod + 3 * DM + c), sc = *(const f32x4*)(mod + 4 * DM + c); f32x4 f;
#pragma unroll
        for (int q = 0; q < 4; ++q) f[q] = x[j * 4 + q] * r2 * gv[q] * (1.0f + sc[q]) + sh[q];
        u32x2 w; w.x = pk2(f[0], f[1]); w.y = pk2(f[2], f[3]); *(u32x2*)(H + c) = w; *(LAS f32x4*)(fdst + c) = f; }
}
__device__ __forceinline__ void route_row_topk(const Params& p, int l, int row, int lane, float logit, LAS unsigned* cntL) {
    const float score = 1.0f / (1.0f + expf(-logit)), biased = score + p.in[I_RB][l * 64 + lane];
    float m1 = biased; m1 = fmaxf(m1, __shfl_xor(m1, 1)); m1 = fmaxf(m1, __shfl_xor(m1, 2)); m1 = fmaxf(m1, __shfl_xor(m1, 4));
    const unsigned long long bal = __ballot(biased == m1); const int first = __builtin_ctz((unsigned)((bal >> (lane & ~7)) & 0xffull));
    float m2 = ((lane & 7) == first) ? -INFINITY : biased; m2 = fmaxf(m2, __shfl_xor(m2, 1)); m2 = fmaxf(m2, __shfl_xor(m2, 2)); m2 = fmaxf(m2, __shfl_xor(m2, 4));
    const float gs = m1 + m2; const int grp = lane >> 3; int rank = 0;
#pragma unroll
    for (int q = 0; q < 8; ++q) { const float v = rdlane(gs, q * 8); rank += (v > gs || (v == gs && q < grp)) ? 1 : 0; }
    const float cand = (rank < 4) ? biased : -INFINITY; int re = 0;
    for (int q = 0; q < 64; ++q) { const float v = rdlane(cand, q); re += (v > cand || (v == cand && q < lane)) ? 1 : 0; }
    const bool sel = re < TOPK; const float ssum = wave_sum(sel ? score : 0.f);
    if (sel) { ((int*)(p.ws + O_EIDX))[(size_t)row * 8 + re] = lane; ((float*)(p.ws + O_GATE))[(size_t)row * 8 + re] = score / ssum * 2.5f;
        ((int*)(p.ws + O_SLOT))[(size_t)row * 8 + re] = (int)__hip_atomic_fetch_add(&cntL[lane], 1u, __ATOMIC_RELAXED, __HIP_MEMORY_SCOPE_WORKGROUP); }
}
__device__ __forceinline__ void phase_route(const Params& p, int l, LAS unsigned char* lds) {
    const int tid = otid(), wid = __builtin_amdgcn_readfirstlane(tid >> 6), lane0 = tid & 63; const bool last = (l == NLAYER - 1); const int NR = last ? NLAT : NTOK;
    LAS float* frow = (LAS float*)lds; LAS float* part = frow;
    const float* g1 = p.in[I_NORMG] + (size_t)(l * 4 + 1) * DM; const float* g2 = p.in[I_NORMG] + (size_t)(l * 4 + 2) * DM;
    const float* RW = p.in[I_RW] + (size_t)l * DM * NEXP; LAS unsigned* cntL = (LAS unsigned*)(lds + LDS_CNTL);
    if (tid < 64) cntL[tid] = 0u;
    { int* stok = (int*)(p.ws + O_STOK); for (int i = blockIdx.x * NTHREADS + tid; i < NSLOTS; i += gridDim.x * NTHREADS) stok[i] = (i < RSLOTS) ? -1 : ((i - RSLOTS) < NR ? i - RSLOTS : -1); }
    for (int g = blockIdx.x; g < NR / 16; g += gridDim.x) {
        int lane = lane0; asm volatile("" : "+v"(lane));
        for (int rr = 0; rr < 2; ++rr) route_row_pre(p, l, g * 16 + wid * 2 + rr, lane, frow + (wid * 2 + rr) * RT_FS, g1, g2);
        __syncthreads();
        f32x4 acc[4];
#pragma unroll
        for (int j = 0; j < 4; ++j) acc[j] = (f32x4){0.f, 0.f, 0.f, 0.f};
        { const int r16 = lane & 15, kq = lane >> 4; const LAS float* fa = frow + r16 * RT_FS + wid * 256 + 4 * kq; const float* rb = RW + (size_t)(wid * 256 + 4 * kq) * 64 + 4 * r16;
#pragma unroll 2
          for (int st = 0; st < 16; ++st) { const f32x4 a = *(const LAS f32x4*)(fa + 16 * st); f32x4 b[4];
#pragma unroll
              for (int i = 0; i < 4; ++i) b[i] = *(const f32x4*)(rb + (size_t)(16 * st + i) * 64);
#pragma unroll
              for (int i = 0; i < 4; ++i)
#pragma unroll
                  for (int j = 0; j < 4; ++j) acc[j] = __builtin_amdgcn_mfma_f32_16x16x4f32(a[i], b[i][j], acc[j], 0, 0, 0); }
          __syncthreads();
#pragma unroll
          for (int r = 0; r < 4; ++r) *(LAS f32x4*)(part + (wid * 16 + 4 * kq + r) * 64 + 4 * r16) = (f32x4){acc[0][r], acc[1][r], acc[2][r], acc[3][r]}; }
        __syncthreads();
        for (int rr = 0; rr < 2; ++rr) { const int r16 = wid * 2 + rr; float logit = 0.f;
#pragma unroll
            for (int w = 0; w < 8; ++w) logit += part[(w * 16 + r16) * 64 + lane];
            route_row_topk(p, l, g * 16 + r16, lane, logit, cntL); }
        __syncthreads();
    }
    __syncthreads();
    if (tid < 64) ((unsigned*)(p.ws + O_WCNT))[blockIdx.x * 64 + tid] = cntL[tid];
}
__device__ __forceinline__ void phase_place(const Params& p, int l, LAS unsigned char* lds) {
    const int tid = otid(); const int NR = (l == NLAYER - 1) ? NLAT : NTOK, G = gridDim.x;
    LAS int* woff = (LAS int*)lds; LAS int* csum = woff + 512 * 64; LAS int* pstart = csum + 8 * 64;
    const unsigned* wcnt = (const unsigned*)(p.ws + O_WCNT);
    for (int i = tid; i < G * 64; i += NTHREADS) woff[i] = (int)wcnt[i];
    __syncthreads();
    { const int e = tid & 63, ch = tid >> 6, cs = (G + 7) >> 3, w0 = ch * cs, w1 = (w0 + cs < G) ? w0 + cs : G; int run = 0;
      for (int w = w0; w < w1; ++w) { const int t = woff[w * 64 + e]; woff[w * 64 + e] = run; run += t; }
      csum[ch * 64 + e] = run;
      __syncthreads();
      int base = 0, tot = 0;
#pragma unroll
      for (int c2 = 0; c2 < 8; ++c2) { const int v = csum[c2 * 64 + e]; if (c2 < ch) base += v; tot += v; }
      for (int w = w0; w < w1; ++w) woff[w * 64 + e] += base;
      if (tid < 64) { const int ntile = (tot + 255) >> 8; pstart[tid] = (wave_incl_scan(ntile, tid) - ntile) * 256;
          if (blockIdx.x == 0) ((unsigned*)(p.ws + O_CTL))[CW_CNT + l * 64 + tid] = (unsigned)tot; } }
    __syncthreads();
    const int* eidx = (const int*)(p.ws + O_EIDX); int* slot = (int*)(p.ws + O_SLOT); int* stok = (int*)(p.ws + O_STOK);
    for (int i = blockIdx.x * NTHREADS + tid; i < NR * TOPK; i += G * NTHREADS) { const int row = i / TOPK, k = i % TOPK, e = eidx[(size_t)row * 8 + k], wg = (row >> 4) % G;
        const int s = pstart[e] + woff[wg * 64 + e] + slot[(size_t)row * 8 + k]; slot[(size_t)row * 8 + k] = s; stok[s] = row; }
    __syncthreads();
}
__device__ __forceinline__ void phase_final(const Params& p, int l) {
    const int lane = otid() & 63, gw = blockIdx.x * 8 + owid(), GW = gridDim.x * 8; const bool last = (l == NLAYER - 1); const int NR = last ? NLAT : NTOK;
    const bf16_t* DO = (const bf16_t*)(p.ws + O_DOUT); const float* g3 = p.in[I_NORMG] + (size_t)(l * 4 + 3) * DM;
    const int lane0 = lane;
    for (int row = gw; row < NR; row += GW) {
        int lane = lane0; asm volatile("" : "+v"(lane));
        const int sl = (lane < TOPK) ? ((const int*)(p.ws + O_SLOT))[(size_t)row * 8 + lane] : 0; const float gl = (lane < TOPK) ? ((const float*)(p.ws + O_GATE))[(size_t)row * 8 + lane] : 0.f;
        float y[32];
#pragma unroll
        for (int i = 0; i < 32; ++i) y[i] = 0.f;
#pragma unroll
        for (int kb = 0; kb < 7; kb += 4) {
            u32x2 v[4][8]; float gt[4];
#pragma unroll
            for (int kk = 0; kk < 4; ++kk) { const int k = kb + kk; if (k < 7) { const int s = (k == 0) ? RSLOTS + row : __builtin_amdgcn_readlane(sl, k - 1); const bf16_t* src = DO + (size_t)s * DM; gt[kk] = (k == 0) ? 1.0f : rdlane(gl, k - 1);
#pragma unroll
                for (int j = 0; j < 8; ++j) v[kk][j] = *(const u32x2*)(src + ROWCOL(j, lane)); } }
#pragma unroll
            for (int kk = 0; kk < 4; ++kk) { if (kb + kk < 7) {
#pragma unroll
                for (int j = 0; j < 8; ++j) { const float g = gt[kk]; y[j * 4] += g * __uint_as_float(v[kk][j].x << 16); y[j * 4 + 1] += g * __uint_as_float(v[kk][j].x & 0xffff0000u); y[j * 4 + 2] += g * __uint_as_float(v[kk][j].y << 16); y[j * 4 + 3] += g * __uint_as_float(v[kk][j].y & 0xffff0000u); } } }
        }
        float ss = 0.f;
#pragma unroll
        for (int i = 0; i < 32; ++i) ss += y[i] * y[i];
        const float r = rsqrtf(wave_sum(ss) * (1.0f / DM) + EPS); const float* mod = (const float*)(p.ws + O_MOD) + (size_t)(l * 9 + row_batch(row)) * 12288;
        float* X = (float*)(p.ws + O_X) + (size_t)row * DM; float x[32];
#pragma unroll
        for (int j = 0; j < 8; ++j) { const int c = ROWCOL(j, lane); const f32x4 xv = *(const f32x4*)(X + c), gv = *(const f32x4*)(g3 + c), gf = *(const f32x4*)(mod + 5 * DM + c); f32x4 xn;
#pragma unroll
            for (int q = 0; q < 4; ++q) { xn[q] = xv[q] + gf[q] * (y[j * 4 + q] * r * gv[q]); x[j * 4 + q] = xn[q]; }
            if (last) *(f32x4*)(p.out + (size_t)row * DM + c) = xn; else *(f32x4*)(X + c) = xn; }
        if (!last) norm1_row(p, l + 1, row, x, lane);
    }
}

#define XB_TMO      128
#define XB_XCNT(j)  (256  + 64 * (j))
#define XB_XSUB(j)  (1280 + 64 * (j))
#define XB_XGEN(j)  (2304 + 64 * (j))
#define XB_TOP      3328
#define XB_TOPGEN   3392
#define XCD_BAR_WORDS 3456
#define XB_SPIN_CAP (1u << 23)

__device__ __forceinline__ unsigned xb_ld(unsigned* p)              { return __hip_atomic_load(p, __ATOMIC_RELAXED, __HIP_MEMORY_SCOPE_AGENT); }
__device__ __forceinline__ unsigned xb_add(unsigned* p, unsigned v) { return __hip_atomic_fetch_add(p, v, __ATOMIC_RELAXED, __HIP_MEMORY_SCOPE_AGENT); }
__device__ __forceinline__ unsigned xb_xcc_id() { return (unsigned)__builtin_amdgcn_s_getreg((3 << 11) | 20) & 0xFu; }
#define XB_SPIN(cond, bar) do { unsigned _sp = 0; while (cond) { __builtin_amdgcn_s_sleep(1); \
    if ((++_sp & 255u) == 0u) { if (xb_ld(&(bar)[XB_TMO])) break; if (_sp > XB_SPIN_CAP) { atomicAdd(&(bar)[XB_TMO], 1u); break; } } } } while (0)

struct XcdBarrier {
    unsigned* bar; unsigned x;
    volatile LAS unsigned* st;
};

__device__ __forceinline__ XcdBarrier xcd_barrier_post(unsigned* bar, volatile LAS unsigned* st) {
    XcdBarrier b; b.bar = bar; b.x = xb_xcc_id(); b.st = st;
    if (threadIdx.x == 0) (void)xb_add(&bar[XB_XCNT(b.x)], 1u);
    return b;
}
__device__ __forceinline__ void xcd_barrier_complete(unsigned* bar, unsigned x, unsigned& nloc, unsigned& nx) {
    const unsigned G = gridDim.x * gridDim.y * gridDim.z;
    unsigned sum, cnt, mine, sp = 0u;
    for (;;) {
        sum = 0u; cnt = 0u; mine = 0u;
#pragma unroll
        for (unsigned j = 0; j < 16; ++j) { const unsigned c = xb_ld(&bar[XB_XCNT(j)]); sum += c; cnt += (c > 0u) ? 1u : 0u; mine = (j == x) ? c : mine; }
        if (sum == G) break;
        __builtin_amdgcn_s_sleep(1);
        if ((++sp & 255u) == 0u) { if (xb_ld(&bar[XB_TMO])) break; if (sp > XB_SPIN_CAP) { atomicAdd(&bar[XB_TMO], 1u); break; } }
    }
    nloc = mine > 0u ? mine : 1u; nx = cnt > 0u ? cnt : 1u;
}

__device__ __forceinline__ void xcd_barrier(const XcdBarrier& b) {
    asm volatile("s_waitcnt vmcnt(0)" ::: "memory");
    __syncthreads();
    if (threadIdx.x == 0) {
        unsigned* bar = b.bar;
        __builtin_amdgcn_s_waitcnt(0);
        unsigned nloc = b.st[0], nx = b.st[1];
        if (nloc == 0u) { xcd_barrier_complete(bar, b.x, nloc, nx); b.st[0] = nloc; b.st[1] = nx; }
        const unsigned old = xb_add(&bar[XB_XSUB(b.x)], 1u);
        const unsigned gen = old / nloc;
        if (old + 1u == (gen + 1u) * nloc) {
            __builtin_amdgcn_fence(__ATOMIC_RELEASE, "agent");
            asm volatile("s_waitcnt vmcnt(0)" ::: "memory");
            const unsigned og = xb_add(&bar[XB_TOP], 1u);
            const unsigned tg = og / nx;
            if (og + 1u == (tg + 1u) * nx) xb_add(&bar[XB_TOPGEN], 1u);
            else XB_SPIN(xb_ld(&bar[XB_TOPGEN]) == tg, bar);
            __builtin_amdgcn_fence(__ATOMIC_ACQUIRE, "agent");
            xb_add(&bar[XB_XGEN(b.x)], 1u);
            asm volatile("s_waitcnt vmcnt(0)" ::: "memory");
        } else {
            XB_SPIN(xb_ld(&bar[XB_XGEN(b.x)]) == gen, bar);
            __builtin_amdgcn_fence(__ATOMIC_ACQUIRE, "agent");
            asm volatile("s_waitcnt vmcnt(0)" ::: "memory");
        }
    }
    __syncthreads();
}


enum { PH_PRO = 0, PH_NORM1, PH_WIN, PH_POSTA, PH_POSTB, PH_MIXER, PH_HYFIN, PH_WOUT, PH_ROUTE, PH_PLACE, PH_GEMM1, PH_GEMM2, PH_FINAL, PH_COUNT };

template <int PH>
__device__ __forceinline__ void run_phase(const Params& p_in, int l, LAS unsigned char* lds) {
    Params p = p_in; { unsigned char* w = p.ws; asm volatile("" : "+s"(w)); p.ws = w; }
    unsigned char* ws = p.ws; const bool last = (l == NLAYER - 1);
    const int gw = blockIdx.x * 8 + owid(), GW = gridDim.x * 8, lane = otid() & 63;
    if constexpr (PH == PH_PRO) { phase_prologue(p, lds); }
    if constexpr (PH == PH_NORM1) { phase_norm1(p, l); }
    if constexpr (PH == PH_WIN) {
        GemmDesc g{(const bf16_t*)(ws + O_H), DM, nullptr, DM, DM}; EpiStoreBf16 E{(bf16_t*)(ws + O_P), NP};
        const bf16_t* Bt = (const bf16_t*)(ws + O_WIN) + (size_t)l * NP * DM;
        if (!last) { DenseSched S{Bt, DM, NTOK / 256, 16, 0, 0}; GEMM_PHASE(g, S, E); }
        else { DenseSched S{Bt, DM, NLAT / 256, 16, 0, 0}; GEMM_PHASE(g, S, E); DenseSched S2{Bt, DM, NCTX / 256, 4, NLAT, 12}; GEMM_PHASE(g, S2, E); }
    }
    if constexpr (PH == PH_POSTA) {
#ifndef DBG_SKIP
#define DBG_SKIP 0
#endif
        if (!(DBG_SKIP & 1)) { GemmDesc g{(const bf16_t*)(ws + O_P) + C_CQ, NP, nullptr, 768, 768}; EpiStoreBf16 E{(bf16_t*)(ws + O_QRAW), NQP};
          DenseSched S{(const bf16_t*)(ws + O_WUQ) + (size_t)l * NQP * 768, 768, (last ? NLAT : NTOK) / 256, 5, 0, 0}; GEMM_PHASE(g, S, E); }
        if (!(DBG_SKIP & 2)) { GemmDesc g{(const bf16_t*)(ws + O_P) + C_CKV, NP, nullptr, 256, 256}; EpiStoreBf16 E{(bf16_t*)(ws + O_KVRAW), 1536};
          DenseSched S{(const bf16_t*)(ws + O_WUKV) + (size_t)l * 1536 * 256, 256, NTOK / 256, 6, 0, 0}; GEMM_PHASE(g, S, E); }
        const int ntt = (last ? NLAT : NTOK) / 64;
        if (!(DBG_SKIP & 4)) for (int t = blockIdx.x; t < ntt * 16; t += gridDim.x) hy_prep_task(p, l, (t >> 4) * 64, (t & 15) * 64, (LAS float*)lds);
        if (!(DBG_SKIP & 8)) for (int row = gw; row < NTOK; row += GW) gqa_post_row(p, l, row, lane);
    }
    if constexpr (PH == PH_POSTB) { if (l == 0) hss_tasks(p); for (int row = gw; row < NTOK; row += GW) mla_post_row(p, l, row, lane); }
    if constexpr (PH == PH_MIXER) { phase_mixer(p, l, lds); }
    if constexpr (PH == PH_HYFIN) { const int ntt = (last ? NLAT : NTOK) / 64; for (int t = blockIdx.x; t < ntt * 8; t += gridDim.x) hy_fin_task(p, l, (t >> 3) * 64, (t & 7) * 64, (LAS float*)lds); }
    if constexpr (PH == PH_WOUT) {
        GemmDesc g{(const bf16_t*)(ws + O_MIX), DM, nullptr, DM, DM}; EpiStoreBf16 E{(bf16_t*)(ws + O_OUT), DM};
        DenseSched S{(const bf16_t*)(ws + O_WOUT) + (size_t)l * DM * DM, DM, (last ? NLAT : NTOK) / 256, 8, 0, 0}; GEMM_PHASE(g, S, E);
    }
    if constexpr (PH == PH_ROUTE) { phase_route(p, l, lds); }
    if constexpr (PH == PH_PLACE) { phase_place(p, l, lds); }
    if constexpr (PH == PH_GEMM1 || PH == PH_GEMM2) {
        LAS int* te = (LAS int*)(lds + LDS_TILES); LAS int* ts = te + MAXTILES; LAS int* misc = (LAS int*)(lds + LDS_MISC) + 16;
        const int nt = moe_build_tiles((const unsigned*)(ws + O_CTL) + CW_CNT + l * 64, (last ? NLAT : NTOK) / 256, te, ts, misc);
        if constexpr (PH == PH_GEMM1) {
            GemmDesc g{(const bf16_t*)(ws + O_H), DM, (const int*)(ws + O_STOK), DM, DM}; EpiSwiGLU E{(bf16_t*)(ws + O_HID)};
            MoeSched S{te, ts, nt, 4, (const bf16_t*)(ws + O_EGU), (size_t)1024 * 2048, DM, 128}; GEMM_PHASE(g, S, E);
        } else {
            GemmDesc g{(const bf16_t*)(ws + O_HID), EH, nullptr, EH, EH}; EpiStoreBf16 E{(bf16_t*)(ws + O_DOUT), DM};
            MoeSched S{te, ts, nt, 8, (const bf16_t*)(ws + O_ED), (size_t)2048 * 512, EH, 256}; GEMM_PHASE(g, S, E);
        }
        __syncthreads();
    }
    if constexpr (PH == PH_FINAL) {
        phase_final(p, l);
        if (!last) cvt_exp_all(p, l + 1);
    }
}

#ifndef MEGA
#define MEGA 0
#endif


#if MEGA
__global__ void __launch_bounds__(NTHREADS, 2) mega_fwd(Params p) {
    extern __shared__ __attribute__((aligned(16))) unsigned char lds_raw[];
    LAS unsigned char* lds = (LAS unsigned char*)lds_raw;
    volatile LAS unsigned* xbw = (volatile LAS unsigned*)(lds + LDS_MISC);
    if (otid() == 0) { xbw[0] = 0u; xbw[1] = 0u; }
    __syncthreads();
    { const XcdBarrier b0 = xcd_barrier_post((unsigned*)(p.ws + O_CTL) + CW_BAR, xbw); if (otid() == 0) xbw[2] = b0.x; }
    __syncthreads();
#define GRID_BAR() do { XcdBarrier b_; b_.bar = (unsigned*)(p.ws + O_CTL) + CW_BAR; b_.x = xbw[2]; b_.st = xbw; xcd_barrier(b_); } while (0)
#ifndef DBL_MASK
#define DBL_MASK 0
#endif
#define RUNP(PH, l) do { run_phase<PH>(p, l, lds); GRID_BAR(); if ((DBL_MASK >> PH) & 1) { run_phase<PH>(p, l, lds); GRID_BAR(); } } while (0)
#ifndef DLY_MASK
#define DLY_MASK 0
#endif
#define RUND(PH, l) do { if ((DLY_MASK >> PH) & 1) { const unsigned long long t0_ = wall_clock64(); run_phase<PH>(p, l, lds); const unsigned long long t1_ = wall_clock64(); while (wall_clock64() < t1_ + (t1_ - t0_)) __builtin_amdgcn_s_sleep(8); } else run_phase<PH>(p, l, lds); } while (0)
    RUNP(PH_PRO, 0);
#define LAYER(l) do { if ((l) == 0) RUNP(PH_NORM1, l); \
        RUNP(PH_WIN, l); RUNP(PH_POSTA, l); RUNP(PH_POSTB, l); RUNP(PH_MIXER, l); RUNP(PH_HYFIN, l); RUNP(PH_WOUT, l); \
        RUND(PH_ROUTE, l); GRID_BAR(); RUND(PH_PLACE, l); GRID_BAR(); RUNP(PH_GEMM1, l); RUNP(PH_GEMM2, l); RUND(PH_FINAL, l); \
        if ((l) + 1 < NLAYER) GRID_BAR(); } while (0)
    LAYER(0);
    LAYER(1);
}
#endif

#if !MEGA
template <int PH> __global__ void __launch_bounds__(NTHREADS, 2) k_phase(Params p) {
    extern __shared__ __attribute__((aligned(16))) unsigned char lds_raw[];
    run_phase<PH>(p, p.layer, (LAS unsigned char*)lds_raw);
}
template <int PH> static bool prep_phase() { return hipFuncSetAttribute((const void*)k_phase<PH>, hipFuncAttributeMaxDynamicSharedMemorySize, LDS_BYTES) == hipSuccess; }
static int g_nlaunch = 0;
#ifndef DBG_STOP
#define DBG_STOP 1000
#define DBG_DUMP 0
#else
#define DBG_DUMP 1
#ifndef DBG_SET
#define DBG_SET 31
#endif
#endif
template <int PH> static void launch_phase(Params p, int l, hipStream_t st) { if (g_nlaunch++ >= DBG_STOP) return; p.layer = l; hipLaunchKernelGGL(k_phase<PH>, dim3(256), dim3(NTHREADS), LDS_BYTES, st, p); }
#endif


#if DBG_DUMP
__device__ __forceinline__ float san(float x) { return (x == x && fabsf(x) < 1e6f) ? x : 1.0f; }
__global__ void __launch_bounds__(256) k_dump(Params p) {
    const size_t N = (size_t)NLAT * DM;
    const bf16_t* b1 = (const bf16_t*)(p.ws + O_WIN); const size_t n1 = (O_X - O_WIN) / 2;
    const bf16_t* b2 = (const bf16_t*)(p.ws + O_H); const size_t n2 = (size_t)NTOK * DM;
    const bf16_t* b3 = (const bf16_t*)(p.ws + O_A); const size_t n3 = (O_AEND - O_A) / 2;
    const float* f1 = (const float*)(p.ws + O_MOD); const size_t m1 = (O_WIN - O_MOD) / 4;
    const float* f2 = (const float*)(p.ws + O_X); const size_t m2 = (size_t)NTOK * DM;
    for (size_t i = (size_t)blockIdx.x * 256 + otid(); i < N; i += (size_t)gridDim.x * 256) {
        float v = 0.f;
        if (DBG_SET & 1) for (size_t e = i; e < n1; e += N) v += san(bf2f(b1[e]));
        if (DBG_SET & 2) for (size_t e = i; e < n2; e += N) v += san(bf2f(b2[e]));
        if (DBG_SET & 4) for (size_t e = i; e < n3; e += N) v += san(bf2f(b3[e]));
        if (DBG_SET & 8) for (size_t e = i; e < m1; e += N) v += san(f1[e]);
        if (DBG_SET & 16) for (size_t e = i; e < m2; e += N) v += san(f2[e]);
        if (DBG_SET & 32) v += san(bf2f(((const bf16_t*)(p.ws + O_WUKV))[i % ((size_t)2 * 1536 * 256)]));
        if (DBG_SET & 64) { const size_t r = i % NTOK, c = (i / NTOK) % 256; v += san(bf2f(((const bf16_t*)(p.ws + O_P))[r * NP + C_CKV + c])); }
        if (DBG_SET & 128) v += san(bf2f(((const bf16_t*)(p.ws + O_KVRAW))[i % ((size_t)NTOK * 1536)]));
        p.out[i] = v;
    }
}
#endif
static int g_grid = 0;
extern "C" void kernel_launch(void* const* d_in, const int* in_sizes, int n_in, void* d_out, int out_size, void* d_ws, size_t ws_size, hipStream_t stream) {
    static int ok = 0;
    if (ok == 0) {
        if (n_in != 31 || in_sizes[0] != NLAT * DM || out_size != NLAT * DM || ws_size < WS_END) { fprintf(stderr, "kernel_launch: unexpected shapes (n_in %d, ws %zu, need %zu)\n", n_in, ws_size, (size_t)WS_END); ok = -1; return; }
        bool good = true;
#if !MEGA
        good = good && prep_phase<0>() && prep_phase<1>() && prep_phase<2>() && prep_phase<3>() && prep_phase<4>() && prep_phase<5>() && prep_phase<6>() && prep_phase<7>() && prep_phase<8>() && prep_phase<9>() && prep_phase<10>() && prep_phase<11>() && prep_phase<12>();
#endif
#if MEGA
        good = hipFuncSetAttribute((const void*)mega_fwd, hipFuncAttributeMaxDynamicSharedMemorySize, LDS_BYTES) == hipSuccess;
        int dev = 0, cus = 0, per_cu = 0;
        if (hipGetDevice(&dev) != hipSuccess || hipDeviceGetAttribute(&cus, hipDeviceAttributeMultiprocessorCount, dev) != hipSuccess) good = false;
        if (good && (hipOccupancyMaxActiveBlocksPerMultiprocessor(&per_cu, (const void*)mega_fwd, NTHREADS, LDS_BYTES) != hipSuccess || per_cu < 1)) { fprintf(stderr, "kernel_launch: occupancy query says %d workgroups per CU\n", per_cu); good = false; }
        g_grid = cus;
#endif
        if (!good) { fprintf(stderr, "kernel_launch: set-up failed\n"); ok = -1; return; }
        ok = 1;
    }
    if (ok < 0) return;
    Params p{}; for (int i = 0; i < 31; ++i) p.in[i] = (const float*)d_in[i]; p.out = (float*)d_out; p.ws = (unsigned char*)d_ws; p.layer = 0; p.pad = 0;
#ifdef POISON_WS
    hipMemsetAsync((char*)d_ws, 0xFF, WS_END, stream);
#endif
    hipMemsetAsync((char*)d_ws + O_CTL, 0, ZERO_BYTES, stream);
#if !MEGA
    g_nlaunch = 0;
    launch_phase<PH_PRO>(p, 0, stream);
    for (int l = 0; l < NLAYER; ++l) {
        if (l == 0) launch_phase<PH_NORM1>(p, l, stream);
        launch_phase<PH_WIN>(p, l, stream); launch_phase<PH_POSTA>(p, l, stream); launch_phase<PH_POSTB>(p, l, stream); launch_phase<PH_MIXER>(p, l, stream);
        launch_phase<PH_HYFIN>(p, l, stream); launch_phase<PH_WOUT>(p, l, stream); launch_phase<PH_ROUTE>(p, l, stream); launch_phase<PH_PLACE>(p, l, stream);
        launch_phase<PH_GEMM1>(p, l, stream); launch_phase<PH_GEMM2>(p, l, stream); launch_phase<PH_FINAL>(p, l, stream);
    }
#if DBG_DUMP
    hipLaunchKernelGGL(k_dump, dim3(2048), dim3(256), 0, stream, p);
#endif
#else
    hipLaunchKernelGGL(mega_fwd, dim3(g_grid), dim3(NTHREADS), LDS_BYTES, stream, p);
#endif
}
```

```cpp
#define MOE_FP8 1
#define GQA_SD 1
#define FAST_GEMM 1
#define MEGA 1
#include <hip/hip_runtime.h>
#include <stdint.h>
#include <stdio.h>

#define LAS __attribute__((address_space(3)))
typedef unsigned short bf16_t;
typedef short bf16x8 __attribute__((ext_vector_type(8)));
typedef short s16x4 __attribute__((ext_vector_type(4)));
typedef float f32x4 __attribute__((ext_vector_type(4)));
typedef float f32x16 __attribute__((ext_vector_type(16)));
typedef unsigned u32x4 __attribute__((ext_vector_type(4)));
typedef unsigned u32x2 __attribute__((ext_vector_type(2)));

constexpr int DM = 2048, NB = 8, SEQ = 2048, CTXL = 256, NLAT = NB * SEQ, NCTX = NB * CTXL, NTOK = NLAT + NCTX, NLAYER = 2;
constexpr int NP = 4096;
constexpr int C_CQ = 1536, C_GQ = 2304, C_CKV = 3072, C_KR = 3328, C_GK = 3392, C_GV = 3648, IN_COLS = 3904;
constexpr int NEXP = 64, TOPK = 6, EH = 512;
constexpr int LK = CTXL + SEQ;
constexpr int RSLOTS = 126976;
constexpr int NSLOTS = RSLOTS + NTOK;
constexpr int MAXTILES = NSLOTS / 256;
constexpr int NQP = 1280;
constexpr float EPS = 1e-6f;
constexpr int NTHREADS = 512;
#ifndef GQA_SD
#define GQA_SD 2
#endif
#ifndef HY_MFMA
#define HY_MFMA 1
#endif
#ifndef MOE_FP8
#define MOE_FP8 0
#endif

constexpr size_t al256(size_t x) { return (x + 255) & ~(size_t)255; }
constexpr size_t O_CTL = 0;
constexpr size_t CTL_BYTES = 65536;
constexpr size_t O_MOD = O_CTL + CTL_BYTES;
constexpr size_t O_HSS = O_MOD + al256((size_t)NLAYER * 9 * 12288 * 4);
constexpr size_t ZERO_BYTES = O_HSS + al256((size_t)NLAYER * 2 * 2 * 512 * 4);
constexpr size_t O_HF = ZERO_BYTES;
constexpr size_t HF_L0 = (size_t)2 * 2 * 512 * 2048, HF_L1 = (size_t)2 * 2 * 512 * 256, HF_LAYER = HF_L0 + HF_L1;
constexpr size_t O_WIN = O_HF + al256(NLAYER * HF_LAYER * 4);
constexpr size_t O_WOUT = O_WIN + (size_t)NLAYER * NP * DM * 2;
constexpr size_t O_WUQ = O_WOUT + (size_t)NLAYER * DM * DM * 2;
constexpr size_t O_WUKV = O_WUQ + al256((size_t)NLAYER * NQP * 768 * 2);
constexpr size_t O_EGU = O_WUKV + al256((size_t)NLAYER * 1536 * 256 * 2);
constexpr size_t O_ED = O_EGU + (size_t)65 * 1024 * 2048 * 2;
constexpr size_t O_X = O_ED + (size_t)65 * 2048 * 512 * 2;
constexpr size_t O_H = O_X + (size_t)NTOK * DM * 4;
constexpr size_t O_EIDX = O_H + (size_t)NTOK * DM * 2;
constexpr size_t O_GATE = O_EIDX + (size_t)NTOK * 8 * 4;
constexpr size_t O_SLOT = O_GATE + (size_t)NTOK * 8 * 4;
constexpr size_t O_STOK = O_SLOT + (size_t)NTOK * 8 * 4;
constexpr size_t O_WCNT = O_STOK + al256((size_t)NSLOTS * 4);
constexpr size_t O_ROPE = O_WCNT + (size_t)1024 * 64 * 4;
constexpr size_t O_HID = O_ROPE + (size_t)(64 * 32 + 64 * 16) * 8;
constexpr size_t O_A = O_HID + (size_t)NSLOTS * EH * 2;
constexpr size_t O_P = O_A;
constexpr size_t O_QRAW = O_P + (size_t)NTOK * NP * 2;
constexpr size_t O_KVRAW = O_QRAW + (size_t)NTOK * NQP * 2;
constexpr size_t O_QM = O_KVRAW + (size_t)NTOK * 1536 * 2;
constexpr size_t O_QMC = O_QM + (size_t)NB * 6 * SEQ * 192 * 2;
constexpr size_t O_KM = O_QMC + (size_t)NB * 6 * CTXL * 192 * 2;
constexpr size_t O_VM = O_KM + (size_t)NB * 6 * LK * 192 * 2;
constexpr size_t O_QG = O_VM + (size_t)NB * 6 * LK * 128 * 2;
constexpr size_t O_QGC = O_QG + (size_t)NB * 6 * SEQ * 128 * 2;
constexpr size_t O_KG = O_QGC + (size_t)NB * 6 * CTXL * 128 * 2;
constexpr size_t O_VG = O_KG + (size_t)NB * 2 * LK * 128 * 2;
constexpr size_t O_VT = O_VG + (size_t)NB * 2 * LK * 128 * 2;
constexpr size_t O_X1T = O_VT + (size_t)512 * NTOK * 2;
constexpr size_t O_Y2T = O_X1T + (size_t)512 * NTOK * 2;
constexpr size_t O_MIX = O_Y2T + (size_t)512 * NTOK * 2;
constexpr size_t O_OUT = O_MIX + (size_t)NTOK * DM * 2;
constexpr size_t O_AEND = O_OUT + (size_t)NTOK * DM * 2;
constexpr size_t O_DOUT = O_A;
static_assert(O_DOUT + (size_t)NSLOTS * DM * 2 <= O_AEND, "DOUT must fit the mixer scratch region");
constexpr size_t WS_END = O_AEND;

constexpr int CW_BAR = 0;
constexpr int CW_CNT = 4096;
constexpr int CW_CUR = 4096 + 128;
constexpr int CW_Q = 4096 + 256;

constexpr int LDS_BYTES = 148480;
constexpr int LDS_MISC = 147456;
constexpr int LDS_TILES = 131072;
constexpr int LDS_CNTL = LDS_MISC + 512;

struct Params { const float* in[31]; float* out; unsigned char* ws; int layer; int pad; };

enum { I_X = 0, I_C, I_CTX, I_CCTX, I_ADAW, I_ADAB, I_NORMG, I_WIN, I_WOUT, I_HYCONV, I_HYW1, I_HYB1, I_HYW2, I_HYB2, I_HYW3, I_HYFREQ, I_HYSKIP,
       I_MQN, I_MKVN, I_WUQ, I_WUKV, I_GQN, I_GKN, I_RW, I_RB, I_EG, I_EU, I_EDN, I_SG, I_SU, I_SD };

__device__ __forceinline__ int otid() { int t = threadIdx.x; asm volatile("" : "+v"(t)); return t; }
__device__ __forceinline__ int owid() { return __builtin_amdgcn_readfirstlane(otid() >> 6); }
__device__ __forceinline__ float bf2f(bf16_t v) { return __uint_as_float(((unsigned)v) << 16); }
__device__ __forceinline__ bf16_t f2bf(float f) { unsigned u = __float_as_uint(f); u += 0x7FFFu + ((u >> 16) & 1u); return (bf16_t)(u >> 16); }
__device__ __forceinline__ unsigned pk2(float lo, float hi) { unsigned r; asm volatile("v_cvt_pk_bf16_f32 %0, %1, %2" : "=v"(r) : "v"(lo), "v"(hi)); return r; }
__device__ __forceinline__ float wave_sum(float v) {
#pragma unroll
    for (int o = 32; o >= 1; o >>= 1) v += __shfl_xor(v, o);
    return v;
}
__device__ __forceinline__ float rdlane(float v, int l) { return __int_as_float(__builtin_amdgcn_readlane(__float_as_int(v), l)); }
__device__ __forceinline__ float silu_f(float x) { return x / (1.0f + __expf(-x)); }
__device__ __forceinline__ const float* resid_src(const Params& p, int l, int row) {
    if (l == 0) return row < NLAT ? p.in[I_X] + (size_t)row * DM : p.in[I_CTX] + (size_t)(row - NLAT) * DM;
    return (const float*)(p.ws + O_X) + (size_t)row * DM;
}
__device__ __forceinline__ int row_batch(int row) { return row < NLAT ? row >> 11 : 8; }
#define ROWCOL(j, lane) ((j) * 256 + (lane) * 4)


struct GUnit { int arow0; const bf16_t* B; int orow0, ocol0; };
struct GemmDesc { const bf16_t* A; int lda; const int* ridx; int ldb; int K; };

struct EpiStoreBf16 {
    bf16_t* O; int ldo;
    __device__ __forceinline__ void operator()(const f32x4 (&acc)[2][2][4][2], const GUnit& u, int wr, int wc, int fr, int fq) const {
#pragma unroll
        for (int ai = 0; ai < 2; ++ai)
#pragma unroll
            for (int m = 0; m < 4; ++m) {
                bf16_t* rowp = O + (size_t)(u.orow0 + ai * 128 + wr * 64 + m * 16 + fr) * ldo + u.ocol0 + wc * 32 + 4 * fq;
#pragma unroll
                for (int bj = 0; bj < 2; ++bj)
#pragma unroll
                    for (int n = 0; n < 2; ++n) { const f32x4 v = acc[ai][bj][m][n]; u32x2 w; w.x = pk2(v[0], v[1]); w.y = pk2(v[2], v[3]); *(u32x2*)(rowp + bj * 128 + n * 16) = w; }
            }
    }
};
struct EpiSwiGLU {
    bf16_t* O;
    __device__ __forceinline__ void operator()(const f32x4 (&acc)[2][2][4][2], const GUnit& u, int wr, int wc, int fr, int fq) const {
#pragma unroll
        for (int ai = 0; ai < 2; ++ai)
#pragma unroll
            for (int m = 0; m < 4; ++m) {
                bf16_t* rowp = O + (size_t)(u.orow0 + ai * 128 + wr * 64 + m * 16 + fr) * EH + u.ocol0 + wc * 32 + 4 * fq;
#pragma unroll
                for (int n = 0; n < 2; ++n) { const f32x4 g = acc[ai][0][m][n], up = acc[ai][1][m][n]; float h[4];
#pragma unroll
                    for (int j = 0; j < 4; ++j) h[j] = silu_f(g[j]) * up[j];
                    u32x2 w; w.x = pk2(h[0], h[1]); w.y = pk2(h[2], h[3]); *(u32x2*)(rowp + n * 16) = w; }
            }
    }
};

__device__ __forceinline__ unsigned pk4_fp8(float a, float b, float c, float d) { int r = __builtin_amdgcn_cvt_pk_fp8_f32(a, b, 0, false); r = __builtin_amdgcn_cvt_pk_fp8_f32(c, d, r, true); return (unsigned)r; }
constexpr float HID8_SCALE = 16.0f;
constexpr float W8_SCALE = 256.0f;
struct EpiSwiGLU8 {
    unsigned char* O;
    __device__ __forceinline__ void operator()(const f32x4 (&acc)[2][2][4][2], const GUnit& u, int wr, int wc, int fr, int fq) const {
#pragma unroll
        for (int ai = 0; ai < 2; ++ai)
#pragma unroll
            for (int m = 0; m < 4; ++m) {
                unsigned char* rowp = O + (size_t)(u.orow0 + ai * 128 + wr * 64 + m * 16 + fr) * EH + u.ocol0 + wc * 32 + 4 * fq;
#pragma unroll
                for (int n = 0; n < 2; ++n) { const f32x4 g = acc[ai][0][m][n], up = acc[ai][1][m][n]; float h[4];
#pragma unroll
                    for (int j = 0; j < 4; ++j) h[j] = silu_f(g[j]) * up[j] * HID8_SCALE;
                    *(unsigned*)(rowp + n * 16) = pk4_fp8(h[0], h[1], h[2], h[3]); }
            }
    }
};

template <class Epi>
__device__ __forceinline__ void gemm_unit_simple(const GemmDesc& g, const GUnit& u, const Epi& E) {
    int tid = otid();
    const int wid = __builtin_amdgcn_readfirstlane(tid >> 6), lane = tid & 63, wr = wid >> 2, wc = wid & 3, fr = lane & 15, fq = lane >> 4;
    f32x4 acc[2][2][4][2];
#pragma unroll
    for (int a = 0; a < 2; ++a)
#pragma unroll
        for (int b = 0; b < 2; ++b)
#pragma unroll
            for (int m = 0; m < 4; ++m)
#pragma unroll
                for (int n = 0; n < 2; ++n) acc[a][b][m][n] = (f32x4){0.f, 0.f, 0.f, 0.f};
    const bf16_t* ap[2][4]; const bf16_t* bp[2][2];
#pragma unroll
    for (int ai = 0; ai < 2; ++ai)
#pragma unroll
        for (int m = 0; m < 4; ++m) { const int r = u.arow0 + ai * 128 + wr * 64 + m * 16 + fr; int src = g.ridx ? g.ridx[r] : r; if (src < 0) src = 0; ap[ai][m] = g.A + (size_t)src * g.lda + 8 * fq; }
#pragma unroll
    for (int bj = 0; bj < 2; ++bj)
#pragma unroll
        for (int n = 0; n < 2; ++n) bp[bj][n] = u.B + (size_t)(bj * 128 + wc * 32 + n * 16 + fr) * g.ldb + 8 * fq;
    int Kq = g.K; asm volatile("" : "+s"(Kq));
#pragma unroll 1
    for (int k0 = 0; k0 < Kq; k0 += 32) {
        bf16x8 a[2][4], b[2][2];
#pragma unroll
        for (int ai = 0; ai < 2; ++ai)
#pragma unroll
            for (int m = 0; m < 4; ++m) a[ai][m] = *(const bf16x8*)(ap[ai][m] + k0);
#pragma unroll
        for (int bj = 0; bj < 2; ++bj)
#pragma unroll
            for (int n = 0; n < 2; ++n) b[bj][n] = *(const bf16x8*)(bp[bj][n] + k0);
#pragma unroll
        for (int ai = 0; ai < 2; ++ai)
#pragma unroll
            for (int bj = 0; bj < 2; ++bj)
#pragma unroll
                for (int m = 0; m < 4; ++m)
#pragma unroll
                    for (int n = 0; n < 2; ++n) acc[ai][bj][m][n] = __builtin_amdgcn_mfma_f32_16x16x32_bf16(b[bj][n], a[ai][m], acc[ai][bj][m][n], 0, 0, 0);
    }
    E(acc, u, wr, wc, fr, fq);
}

struct DenseSched {
    const bf16_t* Bt; int ldb, nM, nN, row0, pn0;
    __device__ __forceinline__ int count() const { return nM * nN; }
    __device__ __forceinline__ int ncol() const { return nN; }
    __device__ __forceinline__ void unit(int i, GUnit& u) const { const int pm = i / nN, pn = pn0 + i % nN; u.arow0 = row0 + pm * 256; u.B = Bt + (size_t)pn * 256 * ldb; u.orow0 = u.arow0; u.ocol0 = pn * 256; }
};
struct MoeSched {
    const LAS int* te; const LAS int* ts; int ntiles, npn; const bf16_t* Bt; size_t estride; int ldb, ocolw;
    __device__ __forceinline__ int count() const { return ntiles * npn; }
    __device__ __forceinline__ int ncol() const { return npn; }
    __device__ __forceinline__ void unit(int i, GUnit& u) const { const int t = i / npn, pn = i % npn; const int e = te[t]; u.arow0 = ts[t]; u.B = Bt + (size_t)e * estride + (size_t)pn * 256 * ldb; u.orow0 = u.arow0; u.ocol0 = pn * ocolw; }
};
template <class Sched, class Epi>
__device__ __forceinline__ void gemm_phase_simple(const GemmDesc& g, const Sched& S, const Epi& E) {
    const int n = S.count();
    for (int i = blockIdx.x; i < n; i += gridDim.x) { GUnit u; S.unit(i, u); gemm_unit_simple(g, u, E); }
}
__device__ __forceinline__ int wave_incl_scan(int v, int lane) {
#pragma unroll
    for (int o = 1; o < 64; o <<= 1) { const int t = __shfl_up(v, o); if (lane >= o) v += t; }
    return v;
}
__device__ __forceinline__ int moe_build_tiles(const unsigned* cnt, int nshared, LAS int* te, LAS int* ts, LAS int* misc) {
    __syncthreads();
    const int tid = otid();
    if (tid < 64) {
        const int c = (int)cnt[tid], ntile = (c + 255) >> 8, incl = wave_incl_scan(ntile, tid), first = incl - ntile;
        for (int j = 0; j < ntile; ++j) { te[first + j] = tid; ts[first + j] = (first + j) * 256; }
        const int nrt = __shfl(incl, 63);
        for (int j = tid; j < nshared; j += 64) { te[nrt + j] = NEXP; ts[nrt + j] = RSLOTS + j * 256; }
        if (tid == 0) misc[0] = nrt + nshared;
    }
    __syncthreads();
    return misc[0];
}
#ifndef FAST_GEMM
#define FAST_GEMM 0
#endif
#if !FAST_GEMM
#define GEMM_PHASE(g, S, E) gemm_phase_simple(g, S, E)
#endif

#if FAST_GEMM
constexpr int HTB = 128 * 64 * 2;
__device__ __forceinline__ int lds_byte(int r, int c) { const int st = (r >> 4) * 2 + (c >> 5), rr = r & 15, cc = c & 31, ob = rr * 64 + cc * 2; return st * 1024 + (ob ^ (((ob >> 9) & 1) << 5)); }
__device__ __forceinline__ void stage_rc(int b, int& R, int& C) { const int st = b / 1024, sb = b % 1024, swz = sb ^ (((sb >> 9) & 1) << 5); R = (st >> 1) * 16 + swz / 64; C = (st & 1) * 32 + (swz % 64) / 2; }

typedef int v8i __attribute__((ext_vector_type(8)));
typedef int v4i __attribute__((ext_vector_type(4)));
template <int ESZ, class Sched, class Epi>
__device__ __forceinline__ void gemm_phase_fast(LAS unsigned char* lds, const GemmDesc& g, const Sched& S, const Epi& E, int scA = 127, int scB = 127) {
    const int tid = otid(), wid = __builtin_amdgcn_readfirstlane(tid >> 6), lane = tid & 63, wr = wid >> 2, wc = wid & 3, fr = lane & 15, fq = lane >> 4;
    const int K = g.K, nunits = S.count(), G = gridDim.x, c0 = blockIdx.x;
    int nt = K * ESZ / 128; asm volatile("" : "+s"(nt));
    const int npn = S.ncol(); const bool xmap = (G % 8 == 0) && ((G / 8) % npn == 0); const int xT = xmap ? (G / 8) / npn : 1, xx = c0 % 8, xr = c0 / 8;
#define F_UNIT(ui_) (xmap ? (((ui_) * 8 + xx) * xT + xr / npn) * npn + xr % npn : (ui_) * G + c0)
    if (F_UNIT(0) >= nunits) return;
    int R[2], C[2]; unsigned voffB[2];
#pragma unroll
    for (int i = 0; i < 2; ++i) { stage_rc(tid * 16 + i * 8192, R[i], C[i]); voffB[i] = (unsigned)(R[i] * g.ldb) * (unsigned)ESZ + (unsigned)C[i] * 2u; }
    const size_t kstep = 128;
    const size_t hstepB = (size_t)128 * g.ldb * ESZ;
    const unsigned ldsw = (unsigned)wid * 1024u;
    const int aoff = lds_byte(wr * 64 + fr, fq * 8), boff = lds_byte(wc * 32 + fr, fq * 8);
    const char* Ab = (const char*)g.A;
#define F_SA(b, h) (((b) * 2 + (h)) * HTB)
#define F_SB(b, h) ((4 + (b) * 2 + (h)) * HTB)
#define F_STAGE(bufoff, gbase, voff) do { _Pragma("unroll") for (int _i = 0; _i < 2; ++_i) \
        __builtin_amdgcn_global_load_lds((const unsigned*)((const char*)(gbase) + (voff)[_i]), (LAS unsigned*)(lds + (bufoff) + ldsw + _i * 8192), 16, 0, 0); } while (0)
#define F_LDA(dst, b, h) do { _Pragma("unroll") for (int m = 0; m < 4; ++m) { if constexpr (ESZ == 2) { _Pragma("unroll") for (int k = 0; k < 2; ++k) dst[m][k] = *(const LAS bf16x8*)(lds + F_SA(b, h) + aoff + m * 2048 + k * 1024); } \
        else { const v4i lo_ = *(const LAS v4i*)(lds + F_SA(b, h) + aoff + m * 2048), hi_ = *(const LAS v4i*)(lds + F_SA(b, h) + aoff + m * 2048 + 1024); dst##8[m] = __builtin_shufflevector(lo_, hi_, 0, 1, 2, 3, 4, 5, 6, 7); } } } while (0)
#define F_LDB(dst, b, h) do { _Pragma("unroll") for (int n = 0; n < 2; ++n) { if constexpr (ESZ == 2) { _Pragma("unroll") for (int k = 0; k < 2; ++k) dst[n][k] = *(const LAS bf16x8*)(lds + F_SB(b, h) + boff + n * 2048 + k * 1024); } \
        else { const v4i lo_ = *(const LAS v4i*)(lds + F_SB(b, h) + boff + n * 2048), hi_ = *(const LAS v4i*)(lds + F_SB(b, h) + boff + n * 2048 + 1024); dst##8[n] = __builtin_shufflevector(lo_, hi_, 0, 1, 2, 3, 4, 5, 6, 7); } } } while (0)
#define F_MMA(ai, bj, At, Bt) do { __builtin_amdgcn_s_setprio(1); _Pragma("unroll") for (int m = 0; m < 4; ++m) _Pragma("unroll") for (int n = 0; n < 2; ++n) { \
        if constexpr (ESZ == 2) { _Pragma("unroll") for (int k = 0; k < 2; ++k) acc[ai][bj][m][n] = __builtin_amdgcn_mfma_f32_16x16x32_bf16(Bt[n][k], At[m][k], acc[ai][bj][m][n], 0, 0, 0); } \
        else acc[ai][bj][m][n] = __builtin_amdgcn_mfma_scale_f32_16x16x128_f8f6f4(Bt##8[n], At##8[m], acc[ai][bj][m][n], 0, 0, 0, scB, 0, scA); } \
        __builtin_amdgcn_s_setprio(0); } while (0)
#define F_WAIT_V(n) asm volatile("s_waitcnt vmcnt(" #n ")" ::: "memory")
#define F_WAIT_L(n) asm volatile("s_waitcnt lgkmcnt(" #n ")" ::: "memory")
#define F_BAR __builtin_amdgcn_s_barrier()
#define F_SCHED __builtin_amdgcn_sched_barrier(0)
#define F_AROWS(u, dst) do { _Pragma("unroll") for (int _h = 0; _h < 2; ++_h) _Pragma("unroll") for (int _i = 0; _i < 2; ++_i) { const int _r = (u).arow0 + _h * 128 + R[_i]; int _s = g.ridx ? g.ridx[_r] : _r; if (_s < 0) _s = 0; dst[_h][_i] = _s; } } while (0)
#define F_AOFFS(src, dst) do { _Pragma("unroll") for (int _h = 0; _h < 2; ++_h) _Pragma("unroll") for (int _i = 0; _i < 2; ++_i) dst[_h][_i] = (unsigned)src[_h][_i] * (unsigned)g.lda * (unsigned)ESZ + (unsigned)C[_i] * 2u; } while (0)
    GUnit cur, nxt; int ui = 0;
    S.unit(F_UNIT(0), cur);
    f32x4 acc[2][2][4][2];
#pragma unroll
    for (int a = 0; a < 2; ++a)
#pragma unroll
        for (int b = 0; b < 2; ++b)
#pragma unroll
            for (int m = 0; m < 4; ++m)
#pragma unroll
                for (int n = 0; n < 2; ++n) acc[a][b][m][n] = (f32x4){0.f, 0.f, 0.f, 0.f};
    bf16x8 At[4][2], B0[2][2], B1[2][2]; v8i At8[4], B08[2], B18[2];
    unsigned voA[2][2]; int rnx[2][2];
    F_AROWS(cur, rnx); F_AOFFS(rnx, voA);
    const char* cB = (const char*)cur.B;
    F_STAGE(F_SB(0, 0), cB, voffB); F_STAGE(F_SA(0, 0), Ab, voA[0]); F_STAGE(F_SB(0, 1), cB + hstepB, voffB); F_STAGE(F_SA(0, 1), Ab, voA[1]);
    if (wr == 1) F_BAR;
    F_WAIT_V(4); F_BAR;
    F_STAGE(F_SB(1, 0), cB + kstep, voffB); F_STAGE(F_SA(1, 0), Ab + kstep, voA[0]); F_STAGE(F_SB(1, 1), cB + hstepB + kstep, voffB);
    F_WAIT_V(6); F_BAR;
    for (;;) {
        const int Ln = F_UNIT(ui + 1); const bool has_next = Ln < nunits;
        if (has_next) { S.unit(Ln, nxt); F_AROWS(nxt, rnx); }
        const char* nB = has_next ? (const char*)nxt.B : cB;
        for (int t = 0; t < nt; t += 2) {
            const bool last = (t == nt - 2);
            const char* a1 = Ab + (size_t)(t + 1) * kstep;
            const char* a2 = last ? Ab : Ab + (size_t)(t + 2) * kstep; const char* b2 = last ? nB : cB + (size_t)(t + 2) * kstep;
            const char* a3 = a2 + kstep; const char* b3 = b2 + kstep;
            F_LDB(B0, 0, 0); F_SCHED; F_LDA(At, 0, 0); F_STAGE(F_SA(1, 1), a1, voA[1]);
            if (last && has_next) F_AOFFS(rnx, voA);
            F_WAIT_L(8); F_BAR; F_WAIT_L(0); F_MMA(0, 0, At, B0); F_BAR; F_SCHED;
            F_LDB(B1, 0, 1); F_STAGE(F_SB(0, 0), b2, voffB);
            F_BAR; F_WAIT_L(0); F_MMA(0, 1, At, B1); F_BAR;
            F_LDA(At, 0, 1); F_STAGE(F_SA(0, 0), a2, voA[0]);
            F_BAR; F_WAIT_L(0); F_MMA(1, 0, At, B0); F_BAR; F_SCHED;
            F_STAGE(F_SB(0, 1), b2 + hstepB, voffB);
            F_WAIT_V(6); F_BAR; F_MMA(1, 1, At, B1); F_BAR;
            F_LDB(B0, 1, 0); F_SCHED; F_LDA(At, 1, 0); F_STAGE(F_SA(0, 1), a2, voA[1]);
            F_WAIT_L(8); F_BAR; F_WAIT_L(0); F_MMA(0, 0, At, B0); F_BAR; F_SCHED;
            F_LDB(B1, 1, 1); F_STAGE(F_SB(1, 0), b3, voffB);
            F_BAR; F_WAIT_L(0); F_MMA(0, 1, At, B1); F_BAR;
            F_LDA(At, 1, 1); F_STAGE(F_SA(1, 0), a3, voA[0]);
            F_BAR; F_WAIT_L(0); F_MMA(1, 0, At, B0); F_BAR; F_SCHED;
            F_STAGE(F_SB(1, 1), b3 + hstepB, voffB);
            F_WAIT_V(6); F_BAR; F_MMA(1, 1, At, B1); F_BAR;
        }
        E(acc, cur, wr, wc, fr, fq);
        if (!has_next) break;
#pragma unroll
        for (int a = 0; a < 2; ++a)
#pragma unroll
            for (int b = 0; b < 2; ++b)
#pragma unroll
                for (int m = 0; m < 4; ++m)
#pragma unroll
                    for (int n = 0; n < 2; ++n) acc[a][b][m][n] = (f32x4){0.f, 0.f, 0.f, 0.f};
        cur = nxt; cB = nB; ++ui;
    }
    F_WAIT_V(0);
    if (wr == 0) F_BAR;
    F_BAR;
#undef F_UNIT
#undef F_SA
#undef F_SB
#undef F_STAGE
#undef F_LDA
#undef F_LDB
#undef F_MMA
#undef F_WAIT_V
#undef F_WAIT_L
#undef F_BAR
#undef F_SCHED
#undef F_AROWS
#undef F_AOFFS
}
#define GEMM_PHASE(g, S, E) gemm_phase_fast<2>(lds, g, S, E)
#define GEMM_PHASE8(g, S, E, sa, sb) gemm_phase_fast<1>(lds, g, S, E, sa, sb)
#endif

#define SBAR() __builtin_amdgcn_sched_barrier(0)
__device__ __forceinline__ int crow(int r, int hi) { return (r & 3) + 8 * (r >> 2) + 4 * hi; }
template <int DQK> __device__ __forceinline__ int kaddr(int row, int chunk) {
    const int sw = (DQK == 128) ? (row & 7) : ((row >> 1) & 7);
    return row * (DQK * 2) + ((chunk ^ sw) << 4);
}
__device__ __forceinline__ void partialSM(f32x16& p0, f32x16& p1, float& m_reg, float& mn, float& alpha, float C, float thr) {
    float pmax = p0[0];
#pragma unroll
    for (int r = 1; r < 16; ++r) pmax = fmaxf(pmax, p0[r]);
#pragma unroll
    for (int r = 0; r < 16; ++r) pmax = fmaxf(pmax, p1[r]);
    { auto rr = __builtin_amdgcn_permlane32_swap(__float_as_uint(pmax), __float_as_uint(pmax), false, false);
      pmax = fmaxf(__uint_as_float(rr[0]), __uint_as_float(rr[1])); }
    if (__builtin_expect(__all(pmax - m_reg <= thr), 1)) { mn = m_reg; alpha = 1.f; }
    else { mn = fmaxf(m_reg, pmax); alpha = __builtin_amdgcn_exp2f((m_reg - mn) * C); m_reg = mn; }
    const float mnC = -mn * C;
#pragma unroll
    for (int r = 0; r < 16; ++r) p0[r] = fmaf(p0[r], C, mnC);
#pragma unroll
    for (int r = 0; r < 16; ++r) p1[r] = fmaf(p1[r], C, mnC);
#pragma unroll
    for (int r = 0; r < 16; ++r) p0[r] = __builtin_amdgcn_exp2f(p0[r]);
}
__device__ __forceinline__ void finishSM(f32x16& p0, f32x16& p1, float alpha, float& l_reg, bf16x8& pa0, bf16x8& pa1, bf16x8& pa2, bf16x8& pa3) {
#pragma unroll
    for (int r = 0; r < 16; ++r) p1[r] = __builtin_amdgcn_exp2f(p1[r]);
    float ps = 0;
#pragma unroll
    for (int r = 0; r < 16; ++r) ps += p0[r];
#pragma unroll
    for (int r = 0; r < 16; ++r) ps += p1[r];
    { auto rr = __builtin_amdgcn_permlane32_swap(__float_as_uint(ps), __float_as_uint(ps), false, false);
      ps = __uint_as_float(rr[0]) + __uint_as_float(rr[1]); }
    l_reg = l_reg * alpha + ps;
#define PK4(P, BASE, OUT) do { unsigned a0 = pk2(P[BASE + 0], P[BASE + 1]), a1 = pk2(P[BASE + 2], P[BASE + 3]);   \
    unsigned b0 = pk2(P[BASE + 4], P[BASE + 5]), b1 = pk2(P[BASE + 6], P[BASE + 7]);                              \
    auto r0 = __builtin_amdgcn_permlane32_swap(a0, b0, false, false); auto r1 = __builtin_amdgcn_permlane32_swap(a1, b1, false, false); \
    u32x4 w = {r0[0], r1[0], r0[1], r1[1]}; OUT = *reinterpret_cast<bf16x8*>(&w); } while (0)
    PK4(p0, 0, pa0); PK4(p0, 8, pa1); PK4(p1, 0, pa2); PK4(p1, 8, pa3);
#undef PK4
}
template <int DQK> __device__ __forceinline__ void qkt(f32x16& p0, f32x16& p1, const char* Ks, const bf16x8* qr, int r32, int hi) {
    p0 = f32x16{}; p1 = f32x16{};
#pragma unroll
    for (int d0 = 0; d0 < DQK / 16; ++d0) { const int ch = 2 * d0 + hi;
        const bf16x8 b0 = *reinterpret_cast<const bf16x8*>(Ks + kaddr<DQK>(r32, ch));
        const bf16x8 b1 = *reinterpret_cast<const bf16x8*>(Ks + kaddr<DQK>(32 + r32, ch));
        p0 = __builtin_amdgcn_mfma_f32_32x32x16_bf16(b0, qr[d0], p0, 0, 0, 0);
        p1 = __builtin_amdgcn_mfma_f32_32x32x16_bf16(b1, qr[d0], p1, 0, 0, 0); }
}
__device__ __forceinline__ int v_st(int k, int c) { const int kk = (k & ~0xC) | ((k & 4) << 1) | ((k & 8) >> 1); return ((kk >> 3) * 4 + (c >> 5)) * 512 + ((kk & 7) * 32 + (c & 31)) * 2; }
__device__ __forceinline__ int v_rd_base(int lane) { return ((lane & 3) << 3) | (((lane >> 2) & 3) << 6) | (((lane >> 4) & 1) << 5) | (((lane >> 5) & 1) << 8); }
constexpr int v_rd_off(int d0, int ks, int half) { return d0 * 512 + ks * 4096 + half * 2048; }
template <int OFF> __device__ __forceinline__ s16x4 tr_read(int vb) {
    s16x4 r; asm volatile("ds_read_b64_tr_b16 %0, %1 offset:%2" : "=&v"(r) : "v"(vb), "i"(OFF) : "memory"); return r;
}
template <int D0> __device__ __forceinline__ void pv_one(f32x16& od, int vb, bf16x8 pa0, bf16x8 pa1, bf16x8 pa2, bf16x8 pa3) {
    const s16x4 l0 = tr_read<v_rd_off(D0, 0, 0)>(vb), h0 = tr_read<v_rd_off(D0, 0, 1)>(vb), l1 = tr_read<v_rd_off(D0, 1, 0)>(vb), h1 = tr_read<v_rd_off(D0, 1, 1)>(vb);
    const s16x4 l2 = tr_read<v_rd_off(D0, 2, 0)>(vb), h2 = tr_read<v_rd_off(D0, 2, 1)>(vb), l3 = tr_read<v_rd_off(D0, 3, 0)>(vb), h3 = tr_read<v_rd_off(D0, 3, 1)>(vb);
    asm volatile("s_waitcnt lgkmcnt(0)" ::: "memory"); SBAR();
#define PK(L, H) (bf16x8){L[0], L[1], L[2], L[3], H[0], H[1], H[2], H[3]}
    od = __builtin_amdgcn_mfma_f32_32x32x16_bf16(pa0, PK(l0, h0), od, 0, 0, 0);
    od = __builtin_amdgcn_mfma_f32_32x32x16_bf16(pa1, PK(l1, h1), od, 0, 0, 0);
    od = __builtin_amdgcn_mfma_f32_32x32x16_bf16(pa2, PK(l2, h2), od, 0, 0, 0);
    od = __builtin_amdgcn_mfma_f32_32x32x16_bf16(pa3, PK(l3, h3), od, 0, 0, 0);
#undef PK
}
__device__ __forceinline__ void pv_d0(f32x16* o, int vb, bf16x8 pa0, bf16x8 pa1, bf16x8 pa2, bf16x8 pa3) {
    pv_one<0>(o[0], vb, pa0, pa1, pa2, pa3); pv_one<1>(o[1], vb, pa0, pa1, pa2, pa3); pv_one<2>(o[2], vb, pa0, pa1, pa2, pa3); pv_one<3>(o[3], vb, pa0, pa1, pa2, pa3);
}

template <int DQK, int SDEPTH>
__device__ __forceinline__ void attn_body(const bf16_t* __restrict__ Qb, const bf16_t* __restrict__ Kh, const bf16_t* __restrict__ Vh, bf16_t* __restrict__ Ob, int ldo, int nkeys, float scale, char* lds) {
    constexpr int SHM_V = 64 * 128 * 2, SHM_K = 64 * DQK * 2, NKC = DQK / 8, KPT = NKC / 8;
    int tid = otid();
    const int wid = __builtin_amdgcn_readfirstlane(tid >> 6), lane = tid & 63, r32 = lane & 31, hi = lane >> 5;
    char* V_lds = lds; char* K_lds = lds + 2 * SHM_V;
    float* ws = (float*)(lds + 2 * SHM_V + 2 * SHM_K) + wid * 64; float* li_l = ws; float* al_l = ws + 32;
    const float C = scale * 1.4426950408889634f, thr = 8.0f / scale;
    float m_reg = -1e30f, l_reg = 0; f32x16 o[4] = {}; bf16x8 qr[DQK / 16];
    const bf16_t* Qw = Qb + (long)(wid * 32 + r32) * DQK + hi * 8;
#pragma unroll
    for (int d0 = 0; d0 < DQK / 16; ++d0) qr[d0] = *reinterpret_cast<const bf16x8*>(Qw + d0 * 16);
    const int sr = tid >> 4, sc = (tid & 15) * 8, vst0 = v_st(sr, sc), vst1 = v_st(32 + sr, sc);
    int kgo[KPT], klo[KPT];
#pragma unroll
    for (int i = 0; i < KPT; ++i) { const int q = tid + 512 * i, row = q / NKC, ch = q % NKC; kgo[i] = row * DQK + ch * 8; klo[i] = kaddr<DQK>(row, ch); }
    const int vb0 = (int)(uintptr_t)V_lds + v_rd_base(lane);
    struct { bf16x8 vs0, vs1, ks[KPT]; } sr_[SDEPTH ? SDEPTH : 1];
#define SLOAD(i, k0) do { sr_[i].vs0 = *reinterpret_cast<const bf16x8*>(&Vh[(long)((k0) + sr) * 128 + sc]); sr_[i].vs1 = *reinterpret_cast<const bf16x8*>(&Vh[(long)((k0) + 32 + sr) * 128 + sc]); \
    _Pragma("unroll") for (int _q = 0; _q < KPT; ++_q) sr_[i].ks[_q] = *reinterpret_cast<const bf16x8*>(&Kh[(long)(k0) * DQK + kgo[_q]]); } while (0)
#define SWRITE(b, i) do { *(bf16x8*)(V_lds + (b) * SHM_V + vst0) = sr_[i].vs0; *(bf16x8*)(V_lds + (b) * SHM_V + vst1) = sr_[i].vs1; \
    _Pragma("unroll") for (int _q = 0; _q < KPT; ++_q) *(bf16x8*)(K_lds + (b) * SHM_K + klo[_q]) = sr_[i].ks[_q]; } while (0)
#define SWAIT() do { if constexpr (SDEPTH == 2) { if constexpr (KPT == 2) asm volatile("s_waitcnt vmcnt(4)" ::: "memory"); else asm volatile("s_waitcnt vmcnt(5)" ::: "memory"); } \
    else asm volatile("s_waitcnt vmcnt(0)" ::: "memory"); } while (0)
#define RESC(a) do { if (__any((a) < 1.f)) { if (hi == 0) al_l[r32] = (a); asm volatile("s_waitcnt lgkmcnt(0)" ::: "memory"); \
    _Pragma("unroll") for (int d = 0; d < 4; ++d) _Pragma("unroll") for (int r = 0; r < 16; ++r) o[d][r] *= al_l[crow(r, hi)]; } } while (0)
    bf16x8 pa0, pa1, pa2, pa3; const int NT = nkeys / 64;
    if constexpr (SDEPTH == 0) {
        f32x16 pA0, pA1; float mnA, alA;
        SLOAD(0, 0); asm volatile("s_waitcnt vmcnt(0)" ::: "memory"); SWRITE(0, 0); __syncthreads();
        for (int j = 0; j < NT; ++j) {
            const int bo = j & 1;
            if (j + 1 < NT) SLOAD(0, (j + 1) * 64);
            SBAR(); qkt<DQK>(pA0, pA1, K_lds + bo * SHM_K, qr, r32, hi); partialSM(pA0, pA1, m_reg, mnA, alA, C, thr);
            RESC(alA); finishSM(pA0, pA1, alA, l_reg, pa0, pa1, pa2, pa3); SBAR();
            pv_d0(o, vb0 + bo * SHM_V, pa0, pa1, pa2, pa3);
            if (j + 1 < NT) { asm volatile("s_waitcnt vmcnt(0)" ::: "memory"); SWRITE(bo ^ 1, 0); }
            __syncthreads();
        }
    } else {
    f32x16 pA0, pA1, pB0, pB1; float mnA, mnB, alA, alB;
    constexpr int SE = 0, SO = SDEPTH - 1;
    SLOAD(SE, 0); asm volatile("s_waitcnt vmcnt(0)" ::: "memory"); SWRITE(0, SE); __syncthreads();
    qkt<DQK>(pA0, pA1, K_lds, qr, r32, hi); partialSM(pA0, pA1, m_reg, mnA, alA, C, thr);
    SLOAD(SO, 64); if constexpr (SDEPTH == 2) { if (2 < NT) SLOAD(SE, 2 * 64); }
    SWAIT(); SWRITE(1, SO); __syncthreads();
    for (int j = 1; j + 1 < NT; j += 2) {
        SBAR(); qkt<DQK>(pB0, pB1, K_lds + SHM_K, qr, r32, hi);
        finishSM(pA0, pA1, alA, l_reg, pa0, pa1, pa2, pa3); SBAR();
        SLOAD(SO, (j + SDEPTH) * 64); SBAR();
        pv_d0(o, vb0, pa0, pa1, pa2, pa3); partialSM(pB0, pB1, m_reg, mnB, alB, C, thr);
        __syncthreads(); SWAIT(); SWRITE(0, SE);
        RESC(alB); __syncthreads();
        SBAR(); qkt<DQK>(pA0, pA1, K_lds, qr, r32, hi);
        finishSM(pB0, pB1, alB, l_reg, pa0, pa1, pa2, pa3); SBAR();
        if (SDEPTH == 1 || j + 3 < NT) SLOAD(SE, (j + 1 + SDEPTH) * 64); SBAR();
        pv_d0(o, vb0 + SHM_V, pa0, pa1, pa2, pa3); partialSM(pA0, pA1, m_reg, mnA, alA, C, thr);
        __syncthreads(); SWAIT(); SWRITE(1, SO);
        RESC(alA); __syncthreads();
    }
    SBAR(); qkt<DQK>(pB0, pB1, K_lds + SHM_K, qr, r32, hi);
    finishSM(pA0, pA1, alA, l_reg, pa0, pa1, pa2, pa3); SBAR();
    pv_d0(o, vb0, pa0, pa1, pa2, pa3); partialSM(pB0, pB1, m_reg, mnB, alB, C, thr);
    __syncthreads(); RESC(alB);
    finishSM(pB0, pB1, alB, l_reg, pa0, pa1, pa2, pa3); SBAR();
    pv_d0(o, vb0 + SHM_V, pa0, pa1, pa2, pa3);
    }
    if (hi == 0) li_l[r32] = l_reg; asm volatile("s_waitcnt lgkmcnt(0)" ::: "memory");
    float rli[16];
#pragma unroll
    for (int r = 0; r < 16; ++r) rli[r] = __builtin_amdgcn_rcpf(li_l[crow(r, hi)]);
    bf16_t* Ow = Ob + (long)(wid * 32) * ldo;
#pragma unroll
    for (int r = 0; r < 16; ++r) { const int orow = crow(r, hi);
#pragma unroll
        for (int d0 = 0; d0 < 4; ++d0) Ow[(long)orow * ldo + d0 * 32 + r32] = f2bf(o[d0][r] * rli[r]); }
    __syncthreads();
#undef SLOAD
#undef SWRITE
#undef SWAIT
#undef RESC
}

struct CvtMat { const float* src; bf16_t* dst; const float* kscale; int N, lddst, nb, mode; };
__device__ __forceinline__ void cvt_block(const CvtMat& m, int kb, int nbk, int lane) {
    const int a = lane & 7, ng = lane >> 3, k0 = kb * 64 + 8 * a, n0 = nbk * 32 + 4 * ng;
    const float* s = m.src + (size_t)k0 * m.N + n0;
    f32x4 v[8];
#pragma unroll
    for (int j = 0; j < 8; ++j) v[j] = *(const f32x4*)(s + (size_t)j * m.N);
    if (m.kscale) {
#pragma unroll
        for (int j = 0; j < 8; ++j) v[j] *= m.kscale[k0 + j];
    }
#pragma unroll
    for (int i = 0; i < 4; ++i) { const int n = n0 + i, row = (m.mode == 0) ? n : ((n >> 7) * 256 + (n & 127) + (m.mode - 1) * 128);
        u32x4 w; w.x = pk2(v[0][i], v[1][i]); w.y = pk2(v[2][i], v[3][i]); w.z = pk2(v[4][i], v[5][i]); w.w = pk2(v[6][i], v[7][i]);
        *(u32x4*)(m.dst + (size_t)row * m.lddst + k0) = w; }
}
__device__ __forceinline__ void cvt_block8(const CvtMat& m, unsigned char* dst8, int kb, int nbk, int lane) {
    const int a = lane & 7, ng = lane >> 3, k0 = kb * 64 + 8 * a, n0 = nbk * 32 + 4 * ng;
    const float* s = m.src + (size_t)k0 * m.N + n0;
    f32x4 v[8];
#pragma unroll
    for (int j = 0; j < 8; ++j) v[j] = *(const f32x4*)(s + (size_t)j * m.N) * W8_SCALE;
#pragma unroll
    for (int i = 0; i < 4; ++i) { const int n = n0 + i, row = (m.mode == 0) ? n : ((n >> 7) * 256 + (n & 127) + (m.mode - 1) * 128);
        u32x2 w; w.x = pk4_fp8(v[0][i], v[1][i], v[2][i], v[3][i]); w.y = pk4_fp8(v[4][i], v[5][i], v[6][i], v[7][i]);
        *(u32x2*)(dst8 + (size_t)row * m.lddst + k0) = w; }
}
constexpr int CVT_SMALL = 3904 + 2048 + 432 + 192;
__device__ __forceinline__ void cvt_small_task(const Params& p, int l, int t, int lane) {
    unsigned char* ws = p.ws; CvtMat m;
    if (t < 3904) { m = CvtMat{p.in[I_WIN] + (size_t)l * DM * IN_COLS, (bf16_t*)(ws + O_WIN) + (size_t)l * NP * DM, nullptr, IN_COLS, DM, 122, 0}; }
    else if ((t -= 3904) < 2048) { m = CvtMat{p.in[I_WOUT] + (size_t)l * DM * DM, (bf16_t*)(ws + O_WOUT) + (size_t)l * DM * DM, nullptr, DM, DM, 64, 0}; }
    else if ((t -= 2048) < 432) { m = CvtMat{p.in[I_WUQ] + (size_t)l * 768 * 1152, (bf16_t*)(ws + O_WUQ) + (size_t)l * NQP * 768, p.in[I_MQN] + l * 768, 1152, 768, 36, 0}; }
    else { t -= 432; m = CvtMat{p.in[I_WUKV] + (size_t)l * 256 * 1536, (bf16_t*)(ws + O_WUKV) + (size_t)l * 1536 * 256, p.in[I_MKVN] + l * 256, 1536, 256, 48, 0}; }
    cvt_block(m, t / m.nb, t % m.nb, lane);
}
constexpr int CVT_EXP = 65 * 1536;
__device__ __forceinline__ void cvt_exp_task(const Params& p, int l, int t, int lane) {
    unsigned char* ws = p.ws;
    const int e = t / 1536, r = t % 1536, which = r >> 9, q = r & 511; CvtMat m;
    if (which < 2) {
        const float* src = (e < NEXP) ? p.in[which == 0 ? I_EG : I_EU] + ((size_t)l * NEXP + e) * DM * EH : p.in[which == 0 ? I_SG : I_SU] + (size_t)l * DM * EH;
        m = CvtMat{src, (bf16_t*)(ws + O_EGU) + (size_t)e * 1024 * 2048, nullptr, EH, DM, 16, 1 + which};
    } else {
        const float* src = (e < NEXP) ? p.in[I_EDN] + ((size_t)l * NEXP + e) * EH * DM : p.in[I_SD] + (size_t)l * EH * DM;
        m = CvtMat{src, (bf16_t*)(ws + O_ED) + (size_t)e * 2048 * 512, nullptr, DM, EH, 64, 0};
    }
#if MOE_FP8
    cvt_block8(m, which < 2 ? p.ws + O_EGU + (size_t)e * 1024 * 2048 : p.ws + O_ED + (size_t)e * 2048 * 512, q / m.nb, q % m.nb, lane);
#else
    cvt_block(m, q / m.nb, q % m.nb, lane);
#endif
}
__device__ __forceinline__ void cvt_exp_all(const Params& p, int l) {
    const int lane = otid() & 63, gw = blockIdx.x * 8 + owid(), GW = gridDim.x * 8;
    for (int t = gw; t < CVT_EXP; t += GW) cvt_exp_task(p, l, t, lane);
}
__device__ __forceinline__ void adaln_tasks(const Params& p, LAS float* lf) {
    const int lane = otid() & 63, wid = owid();
    float* MOD = (float*)(p.ws + O_MOD);
    for (int task = blockIdx.x; task < 384; task += gridDim.x) {
        const int cb = task % 192, l = task / 192, col = cb * 64 + lane;
        const float* W = p.in[I_ADAW] + (size_t)l * DM * 12288 + col;
        float acc[9];
#pragma unroll
        for (int r = 0; r < 9; ++r) acc[r] = 0.f;
        for (int kb = wid * 256; kb < wid * 256 + 256; kb += 64) {
            float sv[9];
#pragma unroll
            for (int r = 0; r < 8; ++r) sv[r] = silu_f(p.in[I_C][r * DM + kb + lane]);
            sv[8] = silu_f(p.in[I_CCTX][kb + lane]);
#pragma unroll 8
            for (int kk = 0; kk < 64; ++kk) { const float w = W[(size_t)(kb + kk) * 12288];
#pragma unroll
                for (int r = 0; r < 9; ++r) acc[r] += rdlane(sv[r], kk) * w; }
        }
#pragma unroll
        for (int r = 0; r < 9; ++r) lf[(wid * 9 + r) * 64 + lane] = acc[r];
        __syncthreads();
        for (int r = wid; r < 9; r += 8) { float s = p.in[I_ADAB][l * 12288 + col];
#pragma unroll
            for (int w = 0; w < 8; ++w) s += lf[(w * 9 + r) * 64 + lane];
            MOD[(size_t)(l * 9 + r) * 12288 + col] = s; }
        __syncthreads();
    }
}
__device__ __forceinline__ void hss_tasks(const Params& p) {
    const int lane = otid() & 63, gw = blockIdx.x * 8 + owid(), GW = gridDim.x * 8;
    for (int task = gw; task < 3 * 1024; task += GW) {
        const int set = task >> 10, l = (set == 1) ? 1 : 0, nset = (set == 2) ? 1 : 0, ord = (task >> 9) & 1, ch = task & 511, n = nset ? 256 : 2048;
        const float* HF = (const float*)(p.ws + O_HF) + (size_t)l * HF_LAYER + (nset ? HF_L0 : 0);
        const float* hf = HF + (size_t)((ord * 2 + 0) * 512 + ch) * n; const float* hb = HF + (size_t)((ord * 2 + 1) * 512 + ch) * n;
        float s = 0.f;
        for (int i = lane; i < n; i += 64) { const float a = hf[i], b = (i == 0) ? 0.f : hb[i]; s += a * a + b * b; }
        s = wave_sum(s);
        if (lane == 0) ((float*)(p.ws + O_HSS))[(size_t)((l * 2 + nset) * 2 + ord) * 512 + ch] = s;
    }
}
__device__ __forceinline__ void hyf_task(const Params& p, int l, int nset, int i0, LAS float* lf) {
    int tid = otid(); const int n = nset ? 256 : 2048;
    LAS float* feats = lf; LAS float* hd1 = lf + 8 * 33; LAS float* hd2 = hd1 + 512;
    if (tid < 8 * 33) { const int pos = tid / 33, f = tid % 33, i = i0 + pos; const float t = (float)i / (float)(n - 1), ang = 6.283185307179586f * (float)i / (float)n; float v;
        if (f == 0) v = t; else { const int j = (f - 1) & 15; const float band = 1e-4f + (float)j * ((15.0f - 1e-4f) / 15.0f); v = (f <= 16) ? cosf(ang * band) : sinf(ang * band); }
        feats[tid] = v; }
    __syncthreads();
    { const int pos = tid >> 6, j = tid & 63; const float* w1 = p.in[I_HYW1] + l * 33 * 64; float s = p.in[I_HYB1][l * 64 + j];
      for (int f = 0; f < 33; ++f) s += feats[pos * 33 + f] * w1[f * 64 + j];
      hd1[tid] = sinf(p.in[I_HYFREQ][l * 64 + j] * s); }
    __syncthreads();
    { const int pos = tid >> 6, j = tid & 63; const float* w2 = p.in[I_HYW2] + l * 64 * 64; float s = p.in[I_HYB2][l * 64 + j];
      for (int f = 0; f < 64; ++f) s += hd1[pos * 64 + f] * w2[f * 64 + j];
      hd2[tid] = sinf(p.in[I_HYFREQ][l * 64 + j] * s); }
    __syncthreads();
    const float* w3 = p.in[I_HYW3] + (size_t)l * 64 * 2048 + tid * 4;
    f32x4 acc[8];
#pragma unroll
    for (int q = 0; q < 8; ++q) acc[q] = (f32x4){0.f, 0.f, 0.f, 0.f};
    for (int j = 0; j < 64; ++j) { const f32x4 w = *(const f32x4*)(w3 + (size_t)j * 2048);
#pragma unroll
        for (int q = 0; q < 8; ++q) acc[q] += w * hd2[q * 64 + j]; }
    float* HF = (float*)(p.ws + O_HF) + (size_t)l * HF_LAYER + (nset ? HF_L0 : 0);
#pragma unroll
    for (int c = 0; c < 4; ++c) { const int col = tid * 4 + c, ord = col >> 10, dir = (col >> 9) & 1, ch = col & 511;
        const float delta = 3.0701134573253944f + (float)ch * ((15.350567286626973f - 3.0701134573253944f) / 511.0f); float v[8];
#pragma unroll
        for (int q = 0; q < 8; ++q) { const int i = i0 + q; const float t = (float)i / (float)(n - 1); v[q] = acc[q][c] * __expf(-t * delta); }
        float* dst = HF + (size_t)((ord * 2 + dir) * 512 + ch) * n + i0;
        *(f32x4*)dst = (f32x4){v[0], v[1], v[2], v[3]}; *(f32x4*)(dst + 4) = (f32x4){v[4], v[5], v[6], v[7]};    }
    __syncthreads();
}
__device__ __forceinline__ void rope_tables(const Params& p);
__device__ __forceinline__ void phase_prologue(const Params& p, LAS unsigned char* lds) {
    const int tid = otid(); LAS float* lf = (LAS float*)lds;
    { const size_t gt = (size_t)blockIdx.x * NTHREADS + tid, GT = (size_t)gridDim.x * NTHREADS;
      for (int l = 0; l < NLAYER; ++l) {
          u32x4* z1 = (u32x4*)((bf16_t*)(p.ws + O_WIN) + ((size_t)l * NP + IN_COLS) * DM); const size_t n1 = (size_t)(NP - IN_COLS) * DM * 2 / 16;
          for (size_t i = gt; i < n1; i += GT) z1[i] = (u32x4){0u, 0u, 0u, 0u};
          u32x4* z2 = (u32x4*)((bf16_t*)(p.ws + O_WUQ) + ((size_t)l * NQP + 1152) * 768); const size_t n2 = (size_t)(NQP - 1152) * 768 * 2 / 16;
          for (size_t i = gt; i < n2; i += GT) z2[i] = (u32x4){0u, 0u, 0u, 0u};
      } }
    rope_tables(p);
    adaln_tasks(p, lf);
    for (int t = blockIdx.x; t < 544; t += gridDim.x) { if (t < 512) hyf_task(p, t >> 8, 0, (t & 255) * 8, lf); else hyf_task(p, 0, 1, (t - 512) * 8, lf); }
    { const int lane = tid & 63, gw = blockIdx.x * 8 + owid(), GW = gridDim.x * 8;
      for (int t = gw; t < NLAYER * CVT_SMALL; t += GW) cvt_small_task(p, t / CVT_SMALL, t % CVT_SMALL, lane); }
    cvt_exp_all(p, 0);
}

__device__ __forceinline__ void norm1_row(const Params& p, int l, int row, const float (&x)[32], int lane) {
    float ss = 0.f;
#pragma unroll
    for (int i = 0; i < 32; ++i) ss += x[i] * x[i];
    ss = wave_sum(ss); const float rstd = rsqrtf(ss * (1.0f / DM) + EPS);
    const float* g = p.in[I_NORMG] + (size_t)(l * 4 + 0) * DM; const float* mod = (const float*)(p.ws + O_MOD) + (size_t)(l * 9 + row_batch(row)) * 12288;
    bf16_t* H = (bf16_t*)(p.ws + O_H) + (size_t)row * DM;
#pragma unroll
    for (int j = 0; j < 8; ++j) { const int c = ROWCOL(j, lane); const f32x4 gv = *(const f32x4*)(g + c), sh = *(const f32x4*)(mod + c), sc = *(const f32x4*)(mod + DM + c); float h[4];
#pragma unroll
        for (int q = 0; q < 4; ++q) h[q] = x[j * 4 + q] * rstd * gv[q] * (1.0f + sc[q]) + sh[q];
        u32x2 w; w.x = pk2(h[0], h[1]); w.y = pk2(h[2], h[3]); *(u32x2*)(H + c) = w; }
}
__device__ __forceinline__ void phase_norm1(const Params& p, int l) {
    const int lane = otid() & 63, gw = blockIdx.x * 8 + owid(), GW = gridDim.x * 8;
    const int lane0 = lane;
    for (int row = gw; row < NTOK; row += GW) { int lane = lane0; asm volatile("" : "+v"(lane)); const float* src = resid_src(p, l, row); float x[32];
#pragma unroll
        for (int j = 0; j < 8; ++j) { const f32x4 v = *(const f32x4*)(src + ROWCOL(j, lane)); x[j * 4] = v[0]; x[j * 4 + 1] = v[1]; x[j * 4 + 2] = v[2]; x[j * 4 + 3] = v[3]; }
        norm1_row(p, l, row, x, lane); }
}

__device__ __forceinline__ void rope_tables(const Params& p) {
    float* T = (float*)(p.ws + O_ROPE);
    for (int i = blockIdx.x * NTHREADS + otid(); i < 64 * 32 + 64 * 16; i += gridDim.x * NTHREADS) {
        float a; if (i < 64 * 32) a = (float)(i >> 5) * exp2f(-(float)(i & 31) * (13.287712379549449f / 32.0f)); else { const int q = i - 64 * 32; a = (float)(q >> 4) * exp2f(-(float)(q & 15) * (13.287712379549449f / 16.0f)); }
        float sn, cs; sincosf(a, &sn, &cs); T[2 * i] = cs; T[2 * i + 1] = sn; }
}
__device__ __forceinline__ void unpack8(const u32x4 v, float (&x)[8]) {
#pragma unroll
    for (int j = 0; j < 4; ++j) { x[2 * j] = __uint_as_float(v[j] << 16); x[2 * j + 1] = __uint_as_float(v[j] & 0xffff0000u); }
}
__device__ __forceinline__ u32x4 pack8(const float (&x)[8]) { u32x4 w; w.x = pk2(x[0], x[1]); w.y = pk2(x[2], x[3]); w.z = pk2(x[4], x[5]); w.w = pk2(x[6], x[7]); return w; }
template <int PX> __device__ __forceinline__ void rope8(float (&x)[8], const float* cs, bool second) {
#pragma unroll
    for (int j = 0; j < 8; ++j) { const float pr = __shfl_xor(x[j], PX), c = cs[2 * j], sn = cs[2 * j + 1]; x[j] = second ? pr * sn + x[j] * c : x[j] * c - pr * sn; }
}
__device__ __forceinline__ void gqa_post_row(const Params& p, int l, int row, int lane) {
    const bf16_t* P = (const bf16_t*)(p.ws + O_P) + (size_t)row * NP;
    const bool isctx = row >= NLAT; const int b = isctx ? (row - NLAT) >> 8 : row >> 11, t = isctx ? (row - NLAT) & 255 : row & 2047;
    const int j = lane & 15, hq = lane >> 4, half = j >> 3; const bool second = (j >> 2) & 1;
    const float* cs = (const float*)(p.ws + O_ROPE) + ((size_t)(half ? (t & 63) : (t >> 6)) * 32 + 8 * (j & 3)) * 2;
    const int kpos = isctx ? t : CTXL + t;
#pragma unroll
    for (int ps = 0; ps < 2; ++ps) {
        const bool isk = (ps == 1) && (hq >= 2); const int h = (ps == 0) ? hq : (isk ? hq - 2 : 4 + hq);
        const bf16_t* src = P + (isk ? C_GK : C_GQ) + h * 128 + 8 * j; const float* gn = (isk ? p.in[I_GKN] : p.in[I_GQN]) + l * 128 + 8 * j;
        float x[8]; unpack8(*(const u32x4*)src, x);
        float ss = 0.f;
#pragma unroll
        for (int q = 0; q < 8; ++q) ss += x[q] * x[q];
        ss += __shfl_xor(ss, 1); ss += __shfl_xor(ss, 2); ss += __shfl_xor(ss, 4); ss += __shfl_xor(ss, 8);
        const float rstd = rsqrtf(ss * (1.0f / 128.0f) + EPS); const f32x4 g0 = *(const f32x4*)gn, g1 = *(const f32x4*)(gn + 4);
#pragma unroll
        for (int q = 0; q < 4; ++q) { x[q] *= rstd * g0[q]; x[4 + q] *= rstd * g1[q]; }
        if (!isctx) rope8<4>(x, cs, second);
        bf16_t* dst = isk ? (bf16_t*)(p.ws + O_KG) + ((size_t)(b * 2 + h) * LK + kpos) * 128
                          : (isctx ? (bf16_t*)(p.ws + O_QGC) + ((size_t)(b * 6 + h) * CTXL + t) * 128 : (bf16_t*)(p.ws + O_QG) + ((size_t)(b * 6 + h) * SEQ + t) * 128);
        *(u32x4*)(dst + 8 * j) = pack8(x);
    }
    if (lane < 32) { const int h = lane >> 4; *(u32x4*)((bf16_t*)(p.ws + O_VG) + ((size_t)(b * 2 + h) * LK + kpos) * 128 + 8 * j) = *(const u32x4*)(P + C_GV + h * 128 + 8 * j); }
}
__device__ __forceinline__ void seq_of(int row, int& s0, int& n) { if (row < NLAT) { s0 = row & ~2047; n = SEQ; } else { s0 = NLAT + ((row - NLAT) & ~255); n = CTXL; } }
__device__ __forceinline__ void load_conv_tile(const bf16_t* P, int t0, int pc0, LAS float* u) {
    int s0, n; seq_of(t0, s0, n);
    for (int i = otid(); i < 66 * 64; i += NTHREADS) { const int r = i >> 6, c = i & 63, row = t0 - 1 + r;
        u[r * 65 + c] = (row >= s0 && row < s0 + n) ? bf2f(P[(size_t)row * NP + pc0 + c]) : 0.f; }
}
__device__ __forceinline__ void hy_prep_task(const Params& p, int l, int t0, int c0, LAS float* u) {
    const bf16_t* P = (const bf16_t*)(p.ws + O_P);
    load_conv_tile(P, t0, c0, u);
    __syncthreads();
    const int tid = otid(), c = tid >> 3, tc = (tid & 7) * 8; const float* cw = p.in[I_HYCONV] + (size_t)l * 3 * 1536 + c0 + c;
    const float w0 = cw[0], w1 = cw[1536], w2 = cw[3072]; float y[8];
#pragma unroll
    for (int j = 0; j < 8; ++j) y[j] = w0 * u[(tc + j) * 65 + c] + w1 * u[(tc + j + 1) * 65 + c] + w2 * u[(tc + j + 2) * 65 + c];
    const int ch = c0 + c; bf16_t* dst = (ch < 512 ? (bf16_t*)(p.ws + O_VT) + (size_t)ch * NTOK : (bf16_t*)(p.ws + O_X1T) + (size_t)(ch - 512) * NTOK) + t0 + tc;
    u32x4 w; w.x = pk2(y[0], y[1]); w.y = pk2(y[2], y[3]); w.z = pk2(y[4], y[5]); w.w = pk2(y[6], y[7]); *(u32x4*)dst = w;
    __syncthreads();
}
__device__ __forceinline__ void mla_post_row(const Params& p, int l, int row, int lane) {
    const bf16_t* P = (const bf16_t*)(p.ws + O_P) + (size_t)row * NP;
    const bool isctx = row >= NLAT; const int b = isctx ? (row - NLAT) >> 8 : row >> 11, t = isctx ? (row - NLAT) & 255 : row & 2047;
    float sq = 0.f, skv = 0.f; float x[8];
    unpack8(*(const u32x4*)(P + C_CQ + 8 * lane), x);
#pragma unroll
    for (int q = 0; q < 8; ++q) sq += x[q] * x[q];
    if (lane < 32) { unpack8(*(const u32x4*)(P + C_CQ + 512 + 8 * lane), x);
#pragma unroll
        for (int q = 0; q < 8; ++q) sq += x[q] * x[q];
        unpack8(*(const u32x4*)(P + C_CKV + 8 * lane), x);
#pragma unroll
        for (int q = 0; q < 8; ++q) skv += x[q] * x[q]; }
    const float rq = rsqrtf(wave_sum(sq) * (1.0f / 768.0f) + EPS), rkv = rsqrtf(wave_sum(skv) * (1.0f / 256.0f) + EPS);
    const bf16_t* QR = (const bf16_t*)(p.ws + O_QRAW) + (size_t)row * NQP; const bf16_t* KV = (const bf16_t*)(p.ws + O_KVRAW) + (size_t)row * 1536;
    const int kpos = isctx ? t : CTXL + t;
    const float* RM = (const float*)(p.ws + O_ROPE) + 64 * 32 * 2;
#pragma unroll
    for (int ps = 0; ps < 3; ++ps) { const int id = ps * 64 + lane; const bool act = id < 144; const int h = act ? id / 24 : 0, cj = act ? id % 24 : 0, rc = cj - 16;
        unpack8(*(const u32x4*)(QR + h * 192 + 8 * cj), x);
#pragma unroll
        for (int q = 0; q < 8; ++q) x[q] *= rq;
        if (!isctx) { const int rcc = rc < 0 ? 0 : rc; const float* cs = RM + ((size_t)((rcc >> 2) ? (t & 63) : (t >> 6)) * 16 + 8 * (rcc & 1)) * 2; float y[8];
#pragma unroll
            for (int q = 0; q < 8; ++q) y[q] = x[q];
            rope8<2>(y, cs, (rcc >> 1) & 1);
            if (rc >= 0) {
#pragma unroll
                for (int q = 0; q < 8; ++q) x[q] = y[q]; } }
        bf16_t* qd = isctx ? (bf16_t*)(p.ws + O_QMC) + ((size_t)(b * 6 + h) * CTXL + t) * 192 : (bf16_t*)(p.ws + O_QM) + ((size_t)(b * 6 + h) * SEQ + t) * 192;
        if (act) *(u32x4*)(qd + 8 * cj) = pack8(x); }
#pragma unroll
    for (int ps = 0; ps < 3; ++ps) { const int id = ps * 64 + lane, h = id >> 5, c = id & 31;
        unpack8(*(const u32x4*)(KV + h * 256 + 8 * c), x);
#pragma unroll
        for (int q = 0; q < 8; ++q) x[q] *= rkv;
        bf16_t* d = (c < 16) ? (bf16_t*)(p.ws + O_KM) + ((size_t)(b * 6 + h) * LK + kpos) * 192 + 8 * c : (bf16_t*)(p.ws + O_VM) + ((size_t)(b * 6 + h) * LK + kpos) * 128 + 8 * (c - 16);
        *(u32x4*)d = pack8(x); }
    { const int h = lane >> 3, rc = lane & 7; unpack8(*(const u32x4*)(P + C_KR + 8 * rc), x);
      if (!isctx) { const float* cs = RM + ((size_t)((rc >> 2) ? (t & 63) : (t >> 6)) * 16 + 8 * (rc & 1)) * 2; rope8<2>(x, cs, (rc >> 1) & 1); }
      if (lane < 48) *(u32x4*)((bf16_t*)(p.ws + O_KM) + ((size_t)(b * 6 + h) * LK + kpos) * 192 + 128 + 8 * rc) = pack8(x); }
}

__device__ __forceinline__ void hyconv_unit_valu(const Params& p, int l, int nset, int c, LAS float* lf) {
    const int tid = otid(), n = nset ? CTXL : SEQ, tokbase = nset ? NLAT : 0;
    LAS float* kc = lf; LAS float* z = lf + 4096; LAS float* z2 = z + 8 * SEQ;
    const float* HF = (const float*)(p.ws + O_HF) + (size_t)l * HF_LAYER + (nset ? HF_L0 : 0); const float* HSS = (const float*)(p.ws + O_HSS) + (size_t)((l * 2 + nset) * 2) * 512;
    const bf16_t* VT = (const bf16_t*)(p.ws + O_VT) + (size_t)c * NTOK + tokbase; const bf16_t* X1T = (const bf16_t*)(p.ws + O_X1T) + (size_t)c * NTOK + tokbase;
    bf16_t* Y2T = (bf16_t*)(p.ws + O_Y2T) + (size_t)c * NTOK + tokbase;
    for (int i = tid; i < 8 * n; i += NTHREADS) z[i] = bf2f(VT[i]);
    for (int ord = 0; ord < 2; ++ord) {
        const float rs = rsqrtf(HSS[ord * 512 + c] + EPS); const float* hf = HF + (size_t)((ord * 2 + 0) * 512 + c) * n; const float* hb = HF + (size_t)((ord * 2 + 1) * 512 + c) * n;
        for (int m = tid; m < 2 * n; m += NTHREADS) { const int lag = m - (n - 1); kc[m] = (m == 2 * n - 1) ? 0.f : (lag >= 0 ? hf[lag] : hb[-lag]) * rs; }
        __syncthreads();
        const LAS float* zs = ord ? z2 : z; const float skip = p.in[I_HYSKIP][(size_t)(l * 2 + ord) * 512 + c];
        for (int q = tid; q < n; q += NTHREADS) {
            const int b = q / (n >> 3), t0 = (q % (n >> 3)) * 8; float acc[8];
#pragma unroll
            for (int j = 0; j < 8; ++j) acc[j] = 0.f;
            const LAS float* zb = zs + b * n;
            for (int sb = 0; sb < n; sb += 8) {
                const LAS float* kb = kc + (t0 - sb + n - 8); float w[16];
#pragma unroll
                for (int i = 0; i < 4; ++i) { const f32x4 v = *(const LAS f32x4*)(kb + 4 * i); w[4 * i] = v[0]; w[4 * i + 1] = v[1]; w[4 * i + 2] = v[2]; w[4 * i + 3] = v[3]; }
                const f32x4 za = *(const LAS f32x4*)(zb + sb), zc = *(const LAS f32x4*)(zb + sb + 4); const float zv[8] = {za[0], za[1], za[2], za[3], zc[0], zc[1], zc[2], zc[3]};
#pragma unroll
                for (int ss = 0; ss < 8; ++ss)
#pragma unroll
                    for (int j = 0; j < 8; ++j) acc[j] += w[j - ss + 7] * zv[ss];
            }
            if (ord == 0) {
#pragma unroll
                for (int j = 0; j < 8; ++j) { const int idx = b * n + t0 + j; z2[idx] = bf2f(X1T[idx]) * (acc[j] + skip * z[idx]); }
            } else { float y[8];
#pragma unroll
                for (int j = 0; j < 8; ++j) y[j] = acc[j] + skip * z2[b * n + t0 + j];
                u32x4 w; w.x = pk2(y[0], y[1]); w.y = pk2(y[2], y[3]); w.z = pk2(y[4], y[5]); w.w = pk2(y[6], y[7]); *(u32x4*)(Y2T + b * n + t0) = w; }
        }
        __syncthreads();
    }
}
constexpr int HC_COPYB = 8256, HC_ROWB = 4560, HC_PAD = 112, HC_KR = 4112, HC_M0 = 2064;
constexpr int HC_ZOFF = 8 * HC_COPYB, HC_Z2OFF = HC_ZOFF + 8 * HC_ROWB;
__device__ __forceinline__ void hyconv_unit_mfma(const Params& p, int l, int c, LAS unsigned char* lds) {
    const int tid = otid(), wid = __builtin_amdgcn_readfirstlane(tid >> 6), lane = tid & 63;
    LAS unsigned char* CP = lds; LAS unsigned char* Zr = lds + HC_ZOFF; LAS unsigned char* Z2r = lds + HC_Z2OFF;
    const float* HF = (const float*)(p.ws + O_HF) + (size_t)l * HF_LAYER; const float* HSS = (const float*)(p.ws + O_HSS) + (size_t)(l * 4) * 512;
    const bf16_t* VT = (const bf16_t*)(p.ws + O_VT) + (size_t)c * NTOK; const bf16_t* X1T = (const bf16_t*)(p.ws + O_X1T) + (size_t)c * NTOK; bf16_t* Y2T = (bf16_t*)(p.ws + O_Y2T) + (size_t)c * NTOK;
    for (int q = tid; q < 8 * 256; q += NTHREADS) { const int b = q >> 8, ch = q & 255; *(LAS u32x4*)(Zr + b * HC_ROWB + (HC_PAD + ch * 8) * 2) = *(const u32x4*)(VT + b * SEQ + ch * 8); }
    for (int q = tid; q < 8 * 29; q += NTHREADS) { const int b = q / 29, ch = q % 29; const int e0 = ch < 14 ? ch * 8 : HC_PAD + SEQ + (ch - 14) * 8; *(LAS u32x4*)(Zr + b * HC_ROWB + e0 * 2) = (u32x4){0u, 0u, 0u, 0u}; }
    const int a = lane & 31, kg = lane >> 5, bq = a >> 2, isub = a & 3;
    const int Aoff = (a & 7) * HC_COPYB + (HC_M0 - 8 * (a >> 3) + 8 * kg) * 2;
    const int g0 = 2 * wid;
    const int Boff = bq * HC_ROWB + (HC_PAD + 128 * g0 + 32 * isub + 8 * kg) * 2;
    for (int ord = 0; ord < 2; ++ord) {
        LAS float* kr = (LAS float*)(ord == 0 ? Z2r : Zr);
        { const float rs = rsqrtf(HSS[ord * 512 + c] + EPS); const float* hf = HF + (size_t)((ord * 2 + 0) * 512 + c) * SEQ; const float* hb = HF + (size_t)((ord * 2 + 1) * 512 + c) * SEQ;
          for (int m = tid; m < HC_KR; m += NTHREADS) { const int lag = HC_M0 - m; float v = 0.f; if (lag >= 0 && lag < SEQ) v = hf[lag] * rs; else if (lag < 0 && lag > -SEQ) v = hb[-lag] * rs; kr[m] = v; } }
        __syncthreads();
        for (int q = tid; q < 8 * 516; q += NTHREADS) { const int sft = q / 516, ch = q % 516; float v[8];
#pragma unroll
            for (int j = 0; j < 8; ++j) { const int m = ch * 8 + j - sft; v[j] = (m >= 0 && m < HC_KR) ? kr[m] : 0.f; }
            u32x4 w; w.x = pk2(v[0], v[1]); w.y = pk2(v[2], v[3]); w.z = pk2(v[4], v[5]); w.w = pk2(v[6], v[7]); *(LAS u32x4*)(CP + sft * HC_COPYB + ch * 16) = w; }
        __syncthreads();
        if (ord == 0) for (int q = tid; q < 8 * 29; q += NTHREADS) { const int b = q / 29, ch = q % 29; const int e0 = ch < 14 ? ch * 8 : HC_PAD + SEQ + (ch - 14) * 8; *(LAS u32x4*)(Z2r + b * HC_ROWB + e0 * 2) = (u32x4){0u, 0u, 0u, 0u}; }
        const LAS unsigned char* Zs = ord ? Z2r : Zr;
        f32x16 acc0 = {}, acc1 = {};
        const int e_lo = 16 * wid - 127, e_mid0 = 16 * wid - 119, e_mid1 = 16 * wid + 7, e_hi = 16 * wid + 15;
        for (int e = e_lo; e < e_mid0; ++e) { const bf16x8 A = *(const LAS bf16x8*)(CP + Aoff - 32 * e); const bf16x8 B0 = *(const LAS bf16x8*)(Zs + Boff - 32 * e);
            acc0 = __builtin_amdgcn_mfma_f32_32x32x16_bf16(A, B0, acc0, 0, 0, 0); }
#pragma unroll 2
        for (int e = e_mid0; e <= e_mid1; ++e) { const bf16x8 A = *(const LAS bf16x8*)(CP + Aoff - 32 * e); const bf16x8 B0 = *(const LAS bf16x8*)(Zs + Boff - 32 * e); const bf16x8 B1 = *(const LAS bf16x8*)(Zs + Boff + 256 - 32 * e);
            acc0 = __builtin_amdgcn_mfma_f32_32x32x16_bf16(A, B0, acc0, 0, 0, 0); acc1 = __builtin_amdgcn_mfma_f32_32x32x16_bf16(A, B1, acc1, 0, 0, 0); }
        for (int e = e_mid1 + 1; e <= e_hi; ++e) { const bf16x8 A = *(const LAS bf16x8*)(CP + Aoff - 32 * e); const bf16x8 B1 = *(const LAS bf16x8*)(Zs + Boff + 256 - 32 * e);
            acc1 = __builtin_amdgcn_mfma_f32_32x32x16_bf16(A, B1, acc1, 0, 0, 0); }
        const float skip = p.in[I_HYSKIP][(size_t)(l * 2 + ord) * 512 + c];
#pragma unroll
        for (int gi = 0; gi < 2; ++gi) {
#pragma unroll
            for (int q = 0; q < 4; ++q) { const int t = 128 * (g0 + gi) + 32 * isub + 8 * q + 4 * kg; float y[4];
#pragma unroll
                for (int j = 0; j < 4; ++j) y[j] = gi ? acc1[4 * q + j] : acc0[4 * q + j];
                const u32x2 zz = *(const LAS u32x2*)(Zs + bq * HC_ROWB + (HC_PAD + t) * 2);
                const float z0 = __uint_as_float(zz.x << 16), z1 = __uint_as_float(zz.x & 0xffff0000u), z2 = __uint_as_float(zz.y << 16), z3 = __uint_as_float(zz.y & 0xffff0000u);
                y[0] += skip * z0; y[1] += skip * z1; y[2] += skip * z2; y[3] += skip * z3;
                if (ord == 0) { const u32x2 xx = *(const u32x2*)(X1T + bq * SEQ + t);
                    y[0] *= __uint_as_float(xx.x << 16); y[1] *= __uint_as_float(xx.x & 0xffff0000u); y[2] *= __uint_as_float(xx.y << 16); y[3] *= __uint_as_float(xx.y & 0xffff0000u);
                    u32x2 w; w.x = pk2(y[0], y[1]); w.y = pk2(y[2], y[3]); *(LAS u32x2*)(Z2r + bq * HC_ROWB + (HC_PAD + t) * 2) = w; }
                else { u32x2 w; w.x = pk2(y[0], y[1]); w.y = pk2(y[2], y[3]); *(u32x2*)(Y2T + bq * SEQ + t) = w; } }
        }
        __syncthreads();
    }
}
__device__ __forceinline__ void hy_fin_task(const Params& p, int l, int t0, int c0, LAS float* u) {
    const bf16_t* P = (const bf16_t*)(p.ws + O_P); LAS float* y = u + 66 * 65;
    load_conv_tile(P, t0, 1024 + c0, u);
    const int tid = otid();
    { const int c = tid >> 3, tc = (tid & 7) * 8; const u32x4 v = *(const u32x4*)((const bf16_t*)(p.ws + O_Y2T) + (size_t)(c0 + c) * NTOK + t0 + tc);
#pragma unroll
      for (int j = 0; j < 4; ++j) { y[c * 65 + tc + 2 * j] = __uint_as_float(v[j] << 16); y[c * 65 + tc + 2 * j + 1] = __uint_as_float(v[j] & 0xffff0000u); } }
    __syncthreads();
    { const int t = tid >> 3, cc = (tid & 7) * 8; const float* cw = p.in[I_HYCONV] + (size_t)l * 3 * 1536 + 1024 + c0 + cc; float o[8];
#pragma unroll
      for (int j = 0; j < 8; ++j) { const int c = cc + j; const float x2 = cw[j] * u[t * 65 + c] + cw[1536 + j] * u[(t + 1) * 65 + c] + cw[3072 + j] * u[(t + 2) * 65 + c]; o[j] = x2 * y[c * 65 + t]; }
      u32x4 w; w.x = pk2(o[0], o[1]); w.y = pk2(o[2], o[3]); w.z = pk2(o[4], o[5]); w.w = pk2(o[6], o[7]);
      *(u32x4*)((bf16_t*)(p.ws + O_MIX) + (size_t)(t0 + t) * DM + c0 + cc) = w; }
    __syncthreads();
}

__device__ __forceinline__ void mla_unit(const Params& p, int b, int h, int qb, bool ctxq, LAS unsigned char* lds) {
    unsigned char* ws = p.ws;
    const bf16_t* Q = ctxq ? (const bf16_t*)(ws + O_QMC) + (size_t)(b * 6 + h) * CTXL * 192 : (const bf16_t*)(ws + O_QM) + ((size_t)(b * 6 + h) * SEQ + qb * 256) * 192;
    bf16_t* O = (bf16_t*)(ws + O_MIX) + (size_t)(ctxq ? NLAT + b * CTXL : b * SEQ + qb * 256) * DM + 512 + h * 128;
    attn_body<192, 0>(Q, (const bf16_t*)(ws + O_KM) + (size_t)(b * 6 + h) * LK * 192, (const bf16_t*)(ws + O_VM) + (size_t)(b * 6 + h) * LK * 128, O, DM, ctxq ? CTXL : LK, 0.07216878364870322f, (char*)lds);
}
__device__ __forceinline__ void gqa_unit(const Params& p, int b, int h, int qb, bool ctxq, LAS unsigned char* lds) {
    unsigned char* ws = p.ws;
    const bf16_t* Q = ctxq ? (const bf16_t*)(ws + O_QGC) + (size_t)(b * 6 + h) * CTXL * 128 : (const bf16_t*)(ws + O_QG) + ((size_t)(b * 6 + h) * SEQ + qb * 256) * 128;
    bf16_t* O = (bf16_t*)(ws + O_MIX) + (size_t)(ctxq ? NLAT + b * CTXL : b * SEQ + qb * 256) * DM + 1280 + h * 128;
    attn_body<128, GQA_SD>(Q, (const bf16_t*)(ws + O_KG) + (size_t)(b * 2 + h / 3) * LK * 128, (const bf16_t*)(ws + O_VG) + (size_t)(b * 2 + h / 3) * LK * 128, O, DM, ctxq ? CTXL : LK, 0.08838834764831845f, (char*)lds);
}
__device__ __forceinline__ void phase_mixer(const Params& p, int l, LAS unsigned char* lds) {
    const int G = gridDim.x, bid = blockIdx.x; const bool last = (l == NLAYER - 1);
    for (int u = bid; u < 384 + (last ? 0 : 48); u += G) { if (u < 384) mla_unit(p, u / 48, (u >> 3) % 6, u & 7, false, lds); else mla_unit(p, (u - 384) / 6, (u - 384) % 6, 0, true, lds); }
    for (int u = (bid + G / 2) % G; u < 384 + (last ? 0 : 48); u += G) { if (u < 384) gqa_unit(p, u / 48, (u >> 3) % 6, u & 7, false, lds); else gqa_unit(p, (u - 384) / 6, (u - 384) % 6, 0, true, lds); }
#ifndef CONV_REP
#define CONV_REP 1
#endif
    for (int rep = 0; rep < CONV_REP; ++rep) {
#if HY_MFMA
    for (int u = bid; u < 512; u += G) hyconv_unit_mfma(p, l, u, lds);
    if (!last) for (int u = bid; u < 512; u += G) hyconv_unit_valu(p, l, 1, u, (LAS float*)lds);
#else
    for (int u = bid; u < (last ? 512 : 1024); u += G) hyconv_unit_valu(p, l, u >> 9, u & 511, (LAS float*)lds);
#endif
    }
}

constexpr int RT_FS = DM + 4;
__device__ __forceinline__ void route_row_pre(const Params& p, int l, int row, int lane, LAS float* fdst, const float* g1, const float* g2) {
    const float* mod = (const float*)(p.ws + O_MOD) + (size_t)(l * 9 + row_batch(row)) * 12288;
    const bf16_t* O = (const bf16_t*)(p.ws + O_OUT) + (size_t)row * DM; const float* rs = resid_src(p, l, row); float* X = (float*)(p.ws + O_X) + (size_t)row * DM; bf16_t* H = (bf16_t*)(p.ws + O_H) + (size_t)row * DM;
    float o[32], x[32]; float ss = 0.f;
#pragma unroll
    for (int j = 0; j < 8; ++j) { const u32x2 v = *(const u32x2*)(O + ROWCOL(j, lane)); o[j * 4] = __uint_as_float(v.x << 16); o[j * 4 + 1] = __uint_as_float(v.x & 0xffff0000u); o[j * 4 + 2] = __uint_as_float(v.y << 16); o[j * 4 + 3] = __uint_as_float(v.y & 0xffff0000u); }
#pragma unroll
    for (int i = 0; i < 32; ++i) ss += o[i] * o[i];
    const float r1 = rsqrtf(wave_sum(ss) * (1.0f / DM) + EPS); float s2 = 0.f;
#pragma unroll
    for (int j = 0; j < 8; ++j) { const int c = ROWCOL(j, lane); const f32x4 xv = *(const f32x4*)(rs + c), gv = *(const f32x4*)(g1 + c), ga = *(const f32x4*)(mod + 2 * DM + c); f32x4 xn;
#pragma unroll
        for (int q = 0; q < 4; ++q) { xn[q] = xv[q] + ga[q] * (o[j * 4 + q] * r1 * gv[q]); x[j * 4 + q] = xn[q]; s2 += xn[q] * xn[q]; }
        *(f32x4*)(X + c) = xn; }
    const float r2 = rsqrtf(wave_sum(s2) * (1.0f / DM) + EPS);
#pragma unroll
    for (int j = 0; j < 8; ++j) { const int c = ROWCOL(j, lane); const f32x4 gv = *(const f32x4*)(g2 + c), sh = *(const f32x4*)(mod + 3 * DM + c), sc = *(const f32x4*)(mod + 4 * DM + c); f32x4 f;
#pragma unroll
        for (int q = 0; q < 4; ++q) f[q] = x[j * 4 + q] * r2 * gv[q] * (1.0f + sc[q]) + sh[q];
#if MOE_FP8
        *(unsigned*)((unsigned char*)(p.ws + O_H) + (size_t)row * DM + c) = pk4_fp8(f[0], f[1], f[2], f[3]);
#else
        u32x2 w; w.x = pk2(f[0], f[1]); w.y = pk2(f[2], f[3]); *(u32x2*)(H + c) = w;
#endif
        *(LAS f32x4*)(fdst + c) = f; }
}
__device__ __forceinline__ void route_row_topk(const Params& p, int l, int row, int lane, float logit, LAS unsigned* cntL) {
    const float score = 1.0f / (1.0f + expf(-logit)), biased = score + p.in[I_RB][l * 64 + lane];
    float m1 = biased; m1 = fmaxf(m1, __shfl_xor(m1, 1)); m1 = fmaxf(m1, __shfl_xor(m1, 2)); m1 = fmaxf(m1, __shfl_xor(m1, 4));
    const unsigned long long bal = __ballot(biased == m1); const int first = __builtin_ctz((unsigned)((bal >> (lane & ~7)) & 0xffull));
    float m2 = ((lane & 7) == first) ? -INFINITY : biased; m2 = fmaxf(m2, __shfl_xor(m2, 1)); m2 = fmaxf(m2, __shfl_xor(m2, 2)); m2 = fmaxf(m2, __shfl_xor(m2, 4));
    const float gs = m1 + m2; const int grp = lane >> 3; int rank = 0;
#pragma unroll
    for (int q = 0; q < 8; ++q) { const float v = rdlane(gs, q * 8); rank += (v > gs || (v == gs && q < grp)) ? 1 : 0; }
    const float cand = (rank < 4) ? biased : -INFINITY; int re = 0;
    for (int q = 0; q < 64; ++q) { const float v = rdlane(cand, q); re += (v > cand || (v == cand && q < lane)) ? 1 : 0; }
    const bool sel = re < TOPK; const float ssum = wave_sum(sel ? score : 0.f);
    if (sel) { ((int*)(p.ws + O_EIDX))[(size_t)row * 8 + re] = lane; ((float*)(p.ws + O_GATE))[(size_t)row * 8 + re] = score / ssum * 2.5f;
        ((int*)(p.ws + O_SLOT))[(size_t)row * 8 + re] = (int)__hip_atomic_fetch_add(&cntL[lane], 1u, __ATOMIC_RELAXED, __HIP_MEMORY_SCOPE_WORKGROUP); }
}
__device__ __forceinline__ void phase_route(const Params& p, int l, LAS unsigned char* lds) {
    const int tid = otid(), wid = __builtin_amdgcn_readfirstlane(tid >> 6), lane0 = tid & 63; const bool last = (l == NLAYER - 1); const int NR = last ? NLAT : NTOK;
    LAS float* frow = (LAS float*)lds; LAS float* part = frow;
    const float* g1 = p.in[I_NORMG] + (size_t)(l * 4 + 1) * DM; const float* g2 = p.in[I_NORMG] + (size_t)(l * 4 + 2) * DM;
    const float* RW = p.in[I_RW] + (size_t)l * DM * NEXP; LAS unsigned* cntL = (LAS unsigned*)(lds + LDS_CNTL);
    if (tid < 64) cntL[tid] = 0u;
    { int* stok = (int*)(p.ws + O_STOK); for (int i = blockIdx.x * NTHREADS + tid; i < NSLOTS; i += gridDim.x * NTHREADS) stok[i] = (i < RSLOTS) ? -1 : ((i - RSLOTS) < NR ? i - RSLOTS : -1); }
    for (int g = blockIdx.x; g < NR / 16; g += gridDim.x) {
        int lane = lane0; asm volatile("" : "+v"(lane));
        for (int rr = 0; rr < 2; ++rr) route_row_pre(p, l, g * 16 + wid * 2 + rr, lane, frow + (wid * 2 + rr) * RT_FS, g1, g2);
        __syncthreads();
        f32x4 acc[4];
#pragma unroll
        for (int j = 0; j < 4; ++j) acc[j] = (f32x4){0.f, 0.f, 0.f, 0.f};
        { const int r16 = lane & 15, kq = lane >> 4; const LAS float* fa = frow + r16 * RT_FS + wid * 256 + 4 * kq; const float* rb = RW + (size_t)(wid * 256 + 4 * kq) * 64 + 4 * r16;
#pragma unroll 2
          for (int st = 0; st < 16; ++st) { const f32x4 a = *(const LAS f32x4*)(fa + 16 * st); f32x4 b[4];
#pragma unroll
              for (int i = 0; i < 4; ++i) b[i] = *(const f32x4*)(rb + (size_t)(16 * st + i) * 64);
#pragma unroll
              for (int i = 0; i < 4; ++i)
#pragma unroll
                  for (int j = 0; j < 4; ++j) acc[j] = __builtin_amdgcn_mfma_f32_16x16x4f32(a[i], b[i][j], acc[j], 0, 0, 0); }
          __syncthreads();
#pragma unroll
          for (int r = 0; r < 4; ++r) *(LAS f32x4*)(part + (wid * 16 + 4 * kq + r) * 64 + 4 * r16) = (f32x4){acc[0][r], acc[1][r], acc[2][r], acc[3][r]}; }
        __syncthreads();
        for (int rr = 0; rr < 2; ++rr) { const int r16 = wid * 2 + rr; float logit = 0.f;
#pragma unroll
            for (int w = 0; w < 8; ++w) logit += part[(w * 16 + r16) * 64 + lane];
            route_row_topk(p, l, g * 16 + r16, lane, logit, cntL); }
        __syncthreads();
    }
    __syncthreads();
    if (tid < 64) ((unsigned*)(p.ws + O_WCNT))[blockIdx.x * 64 + tid] = cntL[tid];
}
__device__ __forceinline__ void phase_place(const Params& p, int l, LAS unsigned char* lds) {
    const int tid = otid(); const int NR = (l == NLAYER - 1) ? NLAT : NTOK, G = gridDim.x;
    LAS int* woff = (LAS int*)lds; LAS int* csum = woff + 512 * 64; LAS int* pstart = csum + 8 * 64;
    const unsigned* wcnt = (const unsigned*)(p.ws + O_WCNT);
    for (int i = tid; i < G * 64; i += NTHREADS) woff[i] = (int)wcnt[i];
    __syncthreads();
    { const int e = tid & 63, ch = tid >> 6, cs = (G + 7) >> 3, w0 = ch * cs, w1 = (w0 + cs < G) ? w0 + cs : G; int run = 0;
      for (int w = w0; w < w1; ++w) { const int t = woff[w * 64 + e]; woff[w * 64 + e] = run; run += t; }
      csum[ch * 64 + e] = run;
      __syncthreads();
      int base = 0, tot = 0;
#pragma unroll
      for (int c2 = 0; c2 < 8; ++c2) { const int v = csum[c2 * 64 + e]; if (c2 < ch) base += v; tot += v; }
      for (int w = w0; w < w1; ++w) woff[w * 64 + e] += base;
      if (tid < 64) { const int ntile = (tot + 255) >> 8; pstart[tid] = (wave_incl_scan(ntile, tid) - ntile) * 256;
          if (blockIdx.x == 0) ((unsigned*)(p.ws + O_CTL))[CW_CNT + l * 64 + tid] = (unsigned)tot; } }
    __syncthreads();
    const int* eidx = (const int*)(p.ws + O_EIDX); int* slot = (int*)(p.ws + O_SLOT); int* stok = (int*)(p.ws + O_STOK);
    for (int i = blockIdx.x * NTHREADS + tid; i < NR * TOPK; i += G * NTHREADS) { const int row = i / TOPK, k = i % TOPK, e = eidx[(size_t)row * 8 + k], wg = (row >> 4) % G;
        const int s = pstart[e] + woff[wg * 64 + e] + slot[(size_t)row * 8 + k]; slot[(size_t)row * 8 + k] = s; stok[s] = row; }
    __syncthreads();
}
__device__ __forceinline__ void phase_final(const Params& p, int l) {
    const int lane = otid() & 63, gw = blockIdx.x * 8 + owid(), GW = gridDim.x * 8; const bool last = (l == NLAYER - 1); const int NR = last ? NLAT : NTOK;
    const bf16_t* DO = (const bf16_t*)(p.ws + O_DOUT); const float* g3 = p.in[I_NORMG] + (size_t)(l * 4 + 3) * DM;
    const int lane0 = lane;
    for (int row = gw; row < NR; row += GW) {
        int lane = lane0; asm volatile("" : "+v"(lane));
        const int sl = (lane < TOPK) ? ((const int*)(p.ws + O_SLOT))[(size_t)row * 8 + lane] : 0; const float gl = (lane < TOPK) ? ((const float*)(p.ws + O_GATE))[(size_t)row * 8 + lane] : 0.f;
        float y[32];
#pragma unroll
        for (int i = 0; i < 32; ++i) y[i] = 0.f;
#pragma unroll
        for (int kb = 0; kb < 7; kb += 4) {
            u32x2 v[4][8]; float gt[4];
#pragma unroll
            for (int kk = 0; kk < 4; ++kk) { const int k = kb + kk; if (k < 7) { const int s = (k == 0) ? RSLOTS + row : __builtin_amdgcn_readlane(sl, k - 1); const bf16_t* src = DO + (size_t)s * DM; gt[kk] = (k == 0) ? 1.0f : rdlane(gl, k - 1);
#pragma unroll
                for (int j = 0; j < 8; ++j) v[kk][j] = *(const u32x2*)(src + ROWCOL(j, lane)); } }
#pragma unroll
            for (int kk = 0; kk < 4; ++kk) { if (kb + kk < 7) {
#pragma unroll
                for (int j = 0; j < 8; ++j) { const float g = gt[kk]; y[j * 4] += g * __uint_as_float(v[kk][j].x << 16); y[j * 4 + 1] += g * __uint_as_float(v[kk][j].x & 0xffff0000u); y[j * 4 + 2] += g * __uint_as_float(v[kk][j].y << 16); y[j * 4 + 3] += g * __uint_as_float(v[kk][j].y & 0xffff0000u); } } }
        }
        float ss = 0.f;
#pragma unroll
        for (int i = 0; i < 32; ++i) ss += y[i] * y[i];
        const float r = rsqrtf(wave_sum(ss) * (1.0f / DM) + EPS); const float* mod = (const float*)(p.ws + O_MOD) + (size_t)(l * 9 + row_batch(row)) * 12288;
        float* X = (float*)(p.ws + O_X) + (size_t)row * DM; float x[32];
#pragma unroll
        for (int j = 0; j < 8; ++j) { const int c = ROWCOL(j, lane); const f32x4 xv = *(const f32x4*)(X + c), gv = *(const f32x4*)(g3 + c), gf = *(const f32x4*)(mod + 5 * DM + c); f32x4 xn;
#pragma unroll
            for (int q = 0; q < 4; ++q) { xn[q] = xv[q] + gf[q] * (y[j * 4 + q] * r * gv[q]); x[j * 4 + q] = xn[q]; }
            if (last) *(f32x4*)(p.out + (size_t)row * DM + c) = xn; else *(f32x4*)(X + c) = xn; }
        if (!last) norm1_row(p, l + 1, row, x, lane);
    }
}

#define XB_TMO      128
#define XB_XCNT(j)  (256  + 64 * (j))
#define XB_XSUB(j)  (1280 + 64 * (j))
#define XB_XGEN(j)  (2304 + 64 * (j))
#define XB_TOP      3328
#define XB_TOPGEN   3392
#define XCD_BAR_WORDS 3456
#define XB_SPIN_CAP (1u << 23)

__device__ __forceinline__ unsigned xb_ld(unsigned* p)              { return __hip_atomic_load(p, __ATOMIC_RELAXED, __HIP_MEMORY_SCOPE_AGENT); }
__device__ __forceinline__ unsigned xb_add(unsigned* p, unsigned v) { return __hip_atomic_fetch_add(p, v, __ATOMIC_RELAXED, __HIP_MEMORY_SCOPE_AGENT); }
__device__ __forceinline__ unsigned xb_xcc_id() { return (unsigned)__builtin_amdgcn_s_getreg((3 << 11) | 20) & 0xFu; }
#define XB_SPIN(cond, bar) do { unsigned _sp = 0; while (cond) { __builtin_amdgcn_s_sleep(1); \
    if ((++_sp & 255u) == 0u) { if (xb_ld(&(bar)[XB_TMO])) break; if (_sp > XB_SPIN_CAP) { atomicAdd(&(bar)[XB_TMO], 1u); break; } } } } while (0)

struct XcdBarrier {
    unsigned* bar; unsigned x;
    volatile LAS unsigned* st;
};

__device__ __forceinline__ XcdBarrier xcd_barrier_post(unsigned* bar, volatile LAS unsigned* st) {
    XcdBarrier b; b.bar = bar; b.x = xb_xcc_id(); b.st = st;
    if (threadIdx.x == 0) (void)xb_add(&bar[XB_XCNT(b.x)], 1u);
    return b;
}
__device__ __forceinline__ void xcd_barrier_complete(unsigned* bar, unsigned x, unsigned& nloc, unsigned& nx) {
    const unsigned G = gridDim.x * gridDim.y * gridDim.z;
    unsigned sum, cnt, mine, sp = 0u;
    for (;;) {
        sum = 0u; cnt = 0u; mine = 0u;
#pragma unroll
        for (unsigned j = 0; j < 16; ++j) { const unsigned c = xb_ld(&bar[XB_XCNT(j)]); sum += c; cnt += (c > 0u) ? 1u : 0u; mine = (j == x) ? c : mine; }
        if (sum == G) break;
        __builtin_amdgcn_s_sleep(1);
        if ((++sp & 255u) == 0u) { if (xb_ld(&bar[XB_TMO])) break; if (sp > XB_SPIN_CAP) { atomicAdd(&bar[XB_TMO], 1u); break; } }
    }
    nloc = mine > 0u ? mine : 1u; nx = cnt > 0u ? cnt : 1u;
}

__device__ __forceinline__ void xcd_barrier(const XcdBarrier& b) {
    asm volatile("s_waitcnt vmcnt(0)" ::: "memory");
    __syncthreads();
    if (threadIdx.x == 0) {
        unsigned* bar = b.bar;
        __builtin_amdgcn_s_waitcnt(0);
        unsigned nloc = b.st[0], nx = b.st[1];
        if (nloc == 0u) { xcd_barrier_complete(bar, b.x, nloc, nx); b.st[0] = nloc; b.st[1] = nx; }
        const unsigned old = xb_add(&bar[XB_XSUB(b.x)], 1u);
        const unsigned gen = old / nloc;
        if (old + 1u == (gen + 1u) * nloc) {
            __builtin_amdgcn_fence(__ATOMIC_RELEASE, "agent");
            asm volatile("s_waitcnt vmcnt(0)" ::: "memory");
            const unsigned og = xb_add(&bar[XB_TOP], 1u);
            const unsigned tg = og / nx;
            if (og + 1u == (tg + 1u) * nx) xb_add(&bar[XB_TOPGEN], 1u);
            else XB_SPIN(xb_ld(&bar[XB_TOPGEN]) == tg, bar);
            __builtin_amdgcn_fence(__ATOMIC_ACQUIRE, "agent");
            xb_add(&bar[XB_XGEN(b.x)], 1u);
            asm volatile("s_waitcnt vmcnt(0)" ::: "memory");
        } else {
            XB_SPIN(xb_ld(&bar[XB_XGEN(b.x)]) == gen, bar);
            __builtin_amdgcn_fence(__ATOMIC_ACQUIRE, "agent");
            asm volatile("s_waitcnt vmcnt(0)" ::: "memory");
        }
    }
    __syncthreads();
}


enum { PH_PRO = 0, PH_NORM1, PH_WIN, PH_POSTA, PH_POSTB, PH_MIXER, PH_HYFIN, PH_WOUT, PH_ROUTE, PH_PLACE, PH_GEMM1, PH_GEMM2, PH_FINAL, PH_COUNT };

template <int PH>
__device__ __forceinline__ void run_phase(const Params& p_in, int l, LAS unsigned char* lds) {
#if MEGA
    const __attribute__((address_space(4))) Params* kp = (const __attribute__((address_space(4))) Params*)__builtin_amdgcn_kernarg_segment_ptr(); asm volatile("" : "+s"(kp)); (void)p_in;
    Params p;
#pragma unroll
    for (int i_ = 0; i_ < 31; ++i_) p.in[i_] = kp->in[i_];
    p.out = kp->out; p.ws = kp->ws; p.layer = 0; p.pad = 0;
#else
    Params p = p_in; { unsigned char* w = p.ws; asm volatile("" : "+s"(w)); p.ws = w; }
#endif
    unsigned char* ws = p.ws; const bool last = (l == NLAYER - 1);
    const int gw = blockIdx.x * 8 + owid(), GW = gridDim.x * 8, lane = otid() & 63;
    if constexpr (PH == PH_PRO) { phase_prologue(p, lds); }
    if constexpr (PH == PH_NORM1) { phase_norm1(p, l); }
    if constexpr (PH == PH_WIN) {
        GemmDesc g{(const bf16_t*)(ws + O_H), DM, nullptr, DM, DM}; EpiStoreBf16 E{(bf16_t*)(ws + O_P), NP};
        const bf16_t* Bt = (const bf16_t*)(ws + O_WIN) + (size_t)l * NP * DM;
        if (!last) { DenseSched S{Bt, DM, NTOK / 256, 16, 0, 0}; GEMM_PHASE(g, S, E); }
        else { DenseSched S{Bt, DM, NLAT / 256, 16, 0, 0}; GEMM_PHASE(g, S, E); DenseSched S2{Bt, DM, NCTX / 256, 4, NLAT, 12}; GEMM_PHASE(g, S2, E); }
    }
    if constexpr (PH == PH_POSTA) {
#ifndef DBG_SKIP
#define DBG_SKIP 0
#endif
        if (!(DBG_SKIP & 1)) { GemmDesc g{(const bf16_t*)(ws + O_P) + C_CQ, NP, nullptr, 768, 768}; EpiStoreBf16 E{(bf16_t*)(ws + O_QRAW), NQP};
          DenseSched S{(const bf16_t*)(ws + O_WUQ) + (size_t)l * NQP * 768, 768, (last ? NLAT : NTOK) / 256, 5, 0, 0}; GEMM_PHASE(g, S, E); }
        if (!(DBG_SKIP & 2)) { GemmDesc g{(const bf16_t*)(ws + O_P) + C_CKV, NP, nullptr, 256, 256}; EpiStoreBf16 E{(bf16_t*)(ws + O_KVRAW), 1536};
          DenseSched S{(const bf16_t*)(ws + O_WUKV) + (size_t)l * 1536 * 256, 256, NTOK / 256, 6, 0, 0}; GEMM_PHASE(g, S, E); }
        const int ntt = (last ? NLAT : NTOK) / 64;
        if (!(DBG_SKIP & 4)) for (int t = blockIdx.x; t < ntt * 16; t += gridDim.x) hy_prep_task(p, l, (t >> 4) * 64, (t & 15) * 64, (LAS float*)lds);
        if (!(DBG_SKIP & 8)) for (int row = gw; row < NTOK; row += GW) gqa_post_row(p, l, row, lane);
    }
    if constexpr (PH == PH_POSTB) { if (l == 0) hss_tasks(p); for (int row = gw; row < NTOK; row += GW) mla_post_row(p, l, row, lane); }
    if constexpr (PH == PH_MIXER) { phase_mixer(p, l, lds); }
    if constexpr (PH == PH_HYFIN) { const int ntt = (last ? NLAT : NTOK) / 64; for (int t = blockIdx.x; t < ntt * 8; t += gridDim.x) hy_fin_task(p, l, (t >> 3) * 64, (t & 7) * 64, (LAS float*)lds); }
    if constexpr (PH == PH_WOUT) {
        GemmDesc g{(const bf16_t*)(ws + O_MIX), DM, nullptr, DM, DM}; EpiStoreBf16 E{(bf16_t*)(ws + O_OUT), DM};
        DenseSched S{(const bf16_t*)(ws + O_WOUT) + (size_t)l * DM * DM, DM, (last ? NLAT : NTOK) / 256, 8, 0, 0}; GEMM_PHASE(g, S, E);
    }
    if constexpr (PH == PH_ROUTE) { phase_route(p, l, lds); }
    if constexpr (PH == PH_PLACE) { phase_place(p, l, lds); }
    if constexpr (PH == PH_GEMM1 || PH == PH_GEMM2) {
        LAS int* te = (LAS int*)(lds + LDS_TILES); LAS int* ts = te + MAXTILES; LAS int* misc = (LAS int*)(lds + LDS_MISC) + 16;
        const int nt = moe_build_tiles((const unsigned*)(ws + O_CTL) + CW_CNT + l * 64, (last ? NLAT : NTOK) / 256, te, ts, misc);
#if MOE_FP8
        if constexpr (PH == PH_GEMM1) {
            GemmDesc g{(const bf16_t*)(ws + O_H), DM, (const int*)(ws + O_STOK), DM, DM}; EpiSwiGLU8 E{ws + O_HID};
            MoeSched S{te, ts, nt, 4, (const bf16_t*)(ws + O_EGU), (size_t)1024 * 1024, DM / 2, 128}; GEMM_PHASE8(g, S, E, 127, 119);
        } else {
            GemmDesc g{(const bf16_t*)(ws + O_HID), EH, nullptr, EH, EH}; EpiStoreBf16 E{(bf16_t*)(ws + O_DOUT), DM};
            MoeSched S{te, ts, nt, 8, (const bf16_t*)(ws + O_ED), (size_t)2048 * 256, EH / 2, 256}; GEMM_PHASE8(g, S, E, 123, 119);
        }
#else
        if constexpr (PH == PH_GEMM1) {
            GemmDesc g{(const bf16_t*)(ws + O_H), DM, (const int*)(ws + O_STOK), DM, DM}; EpiSwiGLU E{(bf16_t*)(ws + O_HID)};
            MoeSched S{te, ts, nt, 4, (const bf16_t*)(ws + O_EGU), (size_t)1024 * 2048, DM, 128}; GEMM_PHASE(g, S, E);
        } else {
            GemmDesc g{(const bf16_t*)(ws + O_HID), EH, nullptr, EH, EH}; EpiStoreBf16 E{(bf16_t*)(ws + O_DOUT), DM};
            MoeSched S{te, ts, nt, 8, (const bf16_t*)(ws + O_ED), (size_t)2048 * 512, EH, 256}; GEMM_PHASE(g, S, E);
        }
#endif
        __syncthreads();
    }
    if constexpr (PH == PH_FINAL) {
        phase_final(p, l);
        if (!last) cvt_exp_all(p, l + 1);
    }
}

#ifndef MEGA
#define MEGA 0
#endif


#if MEGA
__global__ void __launch_bounds__(NTHREADS, 2) mega_fwd(Params p) {
    extern __shared__ __attribute__((aligned(16))) unsigned char lds_raw[];
    LAS unsigned char* lds = (LAS unsigned char*)lds_raw;
    volatile LAS unsigned* xbw = (volatile LAS unsigned*)(lds + LDS_MISC);
    if (otid() == 0) { xbw[0] = 0u; xbw[1] = 0u; }
    __syncthreads();
    { const XcdBarrier b0 = xcd_barrier_post((unsigned*)(p.ws + O_CTL) + CW_BAR, xbw); if (otid() == 0) xbw[2] = b0.x; }
    __syncthreads();
#define GRID_BAR() do { XcdBarrier b_; b_.bar = (unsigned*)(p.ws + O_CTL) + CW_BAR; b_.x = xbw[2]; b_.st = xbw; xcd_barrier(b_); } while (0)
#ifndef DBL_MASK
#define DBL_MASK 0
#endif
#define RUNP(PH, l) do { run_phase<PH>(p, l, lds); GRID_BAR(); if ((DBL_MASK >> PH) & 1) { run_phase<PH>(p, l, lds); GRID_BAR(); } } while (0)
#ifndef DLY_MASK
#define DLY_MASK 0
#endif
#define RUND(PH, l) do { if ((DLY_MASK >> PH) & 1) { const unsigned long long t0_ = wall_clock64(); run_phase<PH>(p, l, lds); const unsigned long long t1_ = wall_clock64(); while (wall_clock64() < t1_ + (t1_ - t0_)) __builtin_amdgcn_s_sleep(8); } else run_phase<PH>(p, l, lds); } while (0)
    RUNP(PH_PRO, 0);
#define LAYER(l) do { if ((l) == 0) RUNP(PH_NORM1, l); \
        RUNP(PH_WIN, l); RUNP(PH_POSTA, l); RUNP(PH_POSTB, l); RUNP(PH_MIXER, l); RUNP(PH_HYFIN, l); RUNP(PH_WOUT, l); \
        RUND(PH_ROUTE, l); GRID_BAR(); RUND(PH_PLACE, l); GRID_BAR(); RUNP(PH_GEMM1, l); RUNP(PH_GEMM2, l); RUND(PH_FINAL, l); \
        if ((l) + 1 < NLAYER) GRID_BAR(); } while (0)
    LAYER(0);
    LAYER(1);
}
#endif

#if !MEGA
template <int PH> __global__ void __launch_bounds__(NTHREADS, 2) k_phase(Params p) {
    extern __shared__ __attribute__((aligned(16))) unsigned char lds_raw[];
    run_phase<PH>(p, p.layer, (LAS unsigned char*)lds_raw);
}
template <int PH> static bool prep_phase() { return hipFuncSetAttribute((const void*)k_phase<PH>, hipFuncAttributeMaxDynamicSharedMemorySize, LDS_BYTES) == hipSuccess; }
static int g_nlaunch = 0;
#ifndef DBG_STOP
#define DBG_STOP 1000
#define DBG_DUMP 0
#else
#define DBG_DUMP 1
#ifndef DBG_SET
#define DBG_SET 31
#endif
#endif
template <int PH> static void launch_phase(Params p, int l, hipStream_t st) { if (g_nlaunch++ >= DBG_STOP) return; p.layer = l; hipLaunchKernelGGL(k_phase<PH>, dim3(256), dim3(NTHREADS), LDS_BYTES, st, p); }
#endif


#if DBG_DUMP
__device__ __forceinline__ float san(float x) { return (x == x && fabsf(x) < 1e6f) ? x : 1.0f; }
__global__ void __launch_bounds__(256) k_dump(Params p) {
    const size_t N = (size_t)NLAT * DM;
    const bf16_t* b1 = (const bf16_t*)(p.ws + O_WIN); const size_t n1 = (O_X - O_WIN) / 2;
    const bf16_t* b2 = (const bf16_t*)(p.ws + O_H); const size_t n2 = (size_t)NTOK * DM;
    const bf16_t* b3 = (const bf16_t*)(p.ws + O_A); const size_t n3 = (O_AEND - O_A) / 2;
    const float* f1 = (const float*)(p.ws + O_MOD); const size_t m1 = (O_WIN - O_MOD) / 4;
    const float* f2 = (const float*)(p.ws + O_X); const size_t m2 = (size_t)NTOK * DM;
    for (size_t i = (size_t)blockIdx.x * 256 + otid(); i < N; i += (size_t)gridDim.x * 256) {
        float v = 0.f;
        if (DBG_SET & 1) for (size_t e = i; e < n1; e += N) v += san(bf2f(b1[e]));
        if (DBG_SET & 2) for (size_t e = i; e < n2; e += N) v += san(bf2f(b2[e]));
        if (DBG_SET & 4) for (size_t e = i; e < n3; e += N) v += san(bf2f(b3[e]));
        if (DBG_SET & 8) for (size_t e = i; e < m1; e += N) v += san(f1[e]);
        if (DBG_SET & 16) for (size_t e = i; e < m2; e += N) v += san(f2[e]);
        if (DBG_SET & 32) v += san(bf2f(((const bf16_t*)(p.ws + O_WUKV))[i % ((size_t)2 * 1536 * 256)]));
        if (DBG_SET & 64) { const size_t r = i % NTOK, c = (i / NTOK) % 256; v += san(bf2f(((const bf16_t*)(p.ws + O_P))[r * NP + C_CKV + c])); }
        if (DBG_SET & 128) v += san(bf2f(((const bf16_t*)(p.ws + O_KVRAW))[i % ((size_t)NTOK * 1536)]));
        p.out[i] = v;
    }
}
#endif
static int g_grid = 0;
extern "C" void kernel_launch(void* const* d_in, const int* in_sizes, int n_in, void* d_out, int out_size, void* d_ws, size_t ws_size, hipStream_t stream) {
    static int ok = 0;
    if (ok == 0) {
        if (n_in != 31 || in_sizes[0] != NLAT * DM || out_size != NLAT * DM || ws_size < WS_END) { fprintf(stderr, "kernel_launch: unexpected shapes (n_in %d, ws %zu, need %zu)\n", n_in, ws_size, (size_t)WS_END); ok = -1; return; }
        bool good = true;
#if !MEGA
        good = good && prep_phase<0>() && prep_phase<1>() && prep_phase<2>() && prep_phase<3>() && prep_phase<4>() && prep_phase<5>() && prep_phase<6>() && prep_phase<7>() && prep_phase<8>() && prep_phase<9>() && prep_phase<10>() && prep_phase<11>() && prep_phase<12>();
#endif
#if MEGA
        good = hipFuncSetAttribute((const void*)mega_fwd, hipFuncAttributeMaxDynamicSharedMemorySize, LDS_BYTES) == hipSuccess;
        int dev = 0, cus = 0, per_cu = 0;
        if (hipGetDevice(&dev) != hipSuccess || hipDeviceGetAttribute(&cus, hipDeviceAttributeMultiprocessorCount, dev) != hipSuccess) good = false;
        if (good && (hipOccupancyMaxActiveBlocksPerMultiprocessor(&per_cu, (const void*)mega_fwd, NTHREADS, LDS_BYTES) != hipSuccess || per_cu < 1)) { fprintf(stderr, "kernel_launch: occupancy query says %d workgroups per CU\n", per_cu); good = false; }
        g_grid = cus;
#endif
        if (!good) { fprintf(stderr, "kernel_launch: set-up failed\n"); ok = -1; return; }
        ok = 1;
    }
    if (ok < 0) return;
    Params p{}; for (int i = 0; i < 31; ++i) p.in[i] = (const float*)d_in[i]; p.out = (float*)d_out; p.ws = (unsigned char*)d_ws; p.layer = 0; p.pad = 0;
#ifdef POISON_WS
    hipMemsetAsync((char*)d_ws, 0xFF, WS_END, stream);
#endif
    hipMemsetAsync((char*)d_ws + O_CTL, 0, ZERO_BYTES, stream);
#if !MEGA
    g_nlaunch = 0;
    launch_phase<PH_PRO>(p, 0, stream);
    for (int l = 0; l < NLAYER; ++l) {
        if (l == 0) launch_phase<PH_NORM1>(p, l, stream);
        launch_phase<PH_WIN>(p, l, stream); launch_phase<PH_POSTA>(p, l, stream); launch_phase<PH_POSTB>(p, l, stream); launch_phase<PH_MIXER>(p, l, stream);
        launch_phase<PH_HYFIN>(p, l, stream); launch_phase<PH_WOUT>(p, l, stream); launch_phase<PH_ROUTE>(p, l, stream); launch_phase<PH_PLACE>(p, l, stream);
        launch_phase<PH_GEMM1>(p, l, stream); launch_phase<PH_GEMM2>(p, l, stream); launch_phase<PH_FINAL>(p, l, stream);
    }
#if DBG_DUMP
    hipLaunchKernelGGL(k_dump, dim3(2048), dim3(256), 0, stream, p);
#endif
#else
    hipLaunchKernelGGL(mega_fwd, dim3(g_grid), dim3(NTHREADS), LDS_BYTES, stream, p);
#endif
}
```

```cpp
#define MOE_FP8 1
#define GQA_SD 1
#define FAST_GEMM 1
#define MEGA 1
#include <hip/hip_runtime.h>
#include <stdint.h>
#include <stdio.h>

#define LAS __attribute__((address_space(3)))
typedef unsigned short bf16_t;
typedef short bf16x8 __attribute__((ext_vector_type(8)));
typedef short s16x4 __attribute__((ext_vector_type(4)));
typedef float f32x4 __attribute__((ext_vector_type(4)));
typedef float f32x16 __attribute__((ext_vector_type(16)));
typedef unsigned u32x4 __attribute__((ext_vector_type(4)));
typedef unsigned u32x2 __attribute__((ext_vector_type(2)));

constexpr int DM = 2048, NB = 8, SEQ = 2048, CTXL = 256, NLAT = NB * SEQ, NCTX = NB * CTXL, NTOK = NLAT + NCTX, NLAYER = 2;
constexpr int NP = 4096;
constexpr int C_CQ = 1536, C_GQ = 2304, C_CKV = 3072, C_KR = 3328, C_GK = 3392, C_GV = 3648, IN_COLS = 3904;
constexpr int NEXP = 64, TOPK = 6, EH = 512;
constexpr int LK = CTXL + SEQ;
constexpr int RSLOTS = 126976;
constexpr int NSLOTS = RSLOTS + NTOK;
constexpr int MAXTILES = NSLOTS / 256;
constexpr int NQP = 1280;
constexpr float EPS = 1e-6f;
constexpr int NTHREADS = 512;
#ifndef GQA_SD
#define GQA_SD 2
#endif
#ifndef HY_MFMA
#define HY_MFMA 1
#endif
#ifndef MOE_FP8
#define MOE_FP8 0
#endif
#ifndef FAST_GEMM
#define FAST_GEMM 1
#endif
#ifndef MEGA
#define MEGA 1
#endif

constexpr size_t al256(size_t x) { return (x + 255) & ~(size_t)255; }
constexpr size_t O_CTL = 0;
constexpr size_t CTL_BYTES = 65536;
constexpr size_t O_MOD = O_CTL + CTL_BYTES;
constexpr size_t O_HSS = O_MOD + al256((size_t)NLAYER * 9 * 12288 * 4);
constexpr size_t ZERO_BYTES = O_HSS + al256((size_t)NLAYER * 2 * 2 * 512 * 4);
constexpr size_t O_HF = ZERO_BYTES;
constexpr size_t HF_L0 = (size_t)2 * 2 * 512 * 2048, HF_L1 = (size_t)2 * 2 * 512 * 256, HF_LAYER = HF_L0 + HF_L1;
constexpr size_t O_WIN = O_HF + al256(NLAYER * HF_LAYER * 4);
constexpr size_t O_WOUT = O_WIN + (size_t)NLAYER * NP * DM * 2;
constexpr size_t O_WUQ = O_WOUT + (size_t)NLAYER * DM * DM * 2;
constexpr size_t O_WUKV = O_WUQ + al256((size_t)NLAYER * NQP * 768 * 2);
constexpr size_t O_EGU = O_WUKV + al256((size_t)NLAYER * 1536 * 256 * 2);
constexpr size_t O_ED = O_EGU + (size_t)65 * 1024 * 2048 * 2;
constexpr size_t O_X = O_ED + (size_t)65 * 2048 * 512 * 2;
constexpr size_t O_H = O_X + (size_t)NTOK * DM * 4;
constexpr size_t O_EIDX = O_H + (size_t)NTOK * DM * 2;
constexpr size_t O_GATE = O_EIDX + (size_t)NTOK * 8 * 4;
constexpr size_t O_SLOT = O_GATE + (size_t)NTOK * 8 * 4;
constexpr size_t O_STOK = O_SLOT + (size_t)NTOK * 8 * 4;
constexpr size_t O_WCNT = O_STOK + al256((size_t)NSLOTS * 4);
constexpr size_t O_ROPE = O_WCNT + (size_t)1024 * 64 * 4;
constexpr size_t O_HID = O_ROPE + (size_t)(64 * 32 + 64 * 16) * 8;
constexpr size_t O_A = O_HID + (size_t)NSLOTS * EH * 2;
constexpr size_t O_P = O_A;
constexpr size_t O_QRAW = O_P + (size_t)NTOK * NP * 2;
constexpr size_t O_KVRAW = O_QRAW + (size_t)NTOK * NQP * 2;
constexpr size_t O_QM = O_KVRAW + (size_t)NTOK * 1536 * 2;
constexpr size_t O_QMC = O_QM + (size_t)NB * 6 * SEQ * 192 * 2;
constexpr size_t O_KM = O_QMC + (size_t)NB * 6 * CTXL * 192 * 2;
constexpr size_t O_VM = O_KM + (size_t)NB * 6 * LK * 192 * 2;
constexpr size_t O_QG = O_VM + (size_t)NB * 6 * LK * 128 * 2;
constexpr size_t O_QGC = O_QG + (size_t)NB * 6 * SEQ * 128 * 2;
constexpr size_t O_KG = O_QGC + (size_t)NB * 6 * CTXL * 128 * 2;
constexpr size_t O_VG = O_KG + (size_t)NB * 2 * LK * 128 * 2;
constexpr size_t O_VT = O_VG + (size_t)NB * 2 * LK * 128 * 2;
constexpr size_t O_X1T = O_VT + (size_t)512 * NTOK * 2;
constexpr size_t O_Y2T = O_X1T + (size_t)512 * NTOK * 2;
constexpr size_t O_MIX = O_Y2T + (size_t)512 * NTOK * 2;
constexpr size_t O_OUT = O_MIX + (size_t)NTOK * DM * 2;
constexpr size_t O_AEND = O_OUT + (size_t)NTOK * DM * 2;
constexpr size_t O_DOUT = O_A;
static_assert(O_DOUT + (size_t)NSLOTS * DM * 2 <= O_AEND, "DOUT must fit the mixer scratch region");
constexpr size_t WS_END = O_AEND;

constexpr int CW_BAR = 0;
constexpr int CW_CNT = 4096;
constexpr int CW_CUR = 4096 + 128;
constexpr int CW_Q = 4096 + 256;

constexpr int LDS_BYTES = 148480;
constexpr int LDS_MISC = 147456;
constexpr int LDS_TILES = 131072;
constexpr int LDS_CNTL = LDS_MISC + 512;

struct Params { const float* in[31]; float* out; unsigned char* ws; int layer; int pad; };

enum { I_X = 0, I_C, I_CTX, I_CCTX, I_ADAW, I_ADAB, I_NORMG, I_WIN, I_WOUT, I_HYCONV, I_HYW1, I_HYB1, I_HYW2, I_HYB2, I_HYW3, I_HYFREQ, I_HYSKIP,
       I_MQN, I_MKVN, I_WUQ, I_WUKV, I_GQN, I_GKN, I_RW, I_RB, I_EG, I_EU, I_EDN, I_SG, I_SU, I_SD };

__device__ __forceinline__ int otid() { int t = threadIdx.x; asm volatile("" : "+v"(t)); return t; }
__device__ __forceinline__ int owid() { return __builtin_amdgcn_readfirstlane(otid() >> 6); }
__device__ __forceinline__ float bf2f(bf16_t v) { return __uint_as_float(((unsigned)v) << 16); }
__device__ __forceinline__ bf16_t f2bf(float f) { unsigned u = __float_as_uint(f); u += 0x7FFFu + ((u >> 16) & 1u); return (bf16_t)(u >> 16); }
__device__ __forceinline__ unsigned pk2(float lo, float hi) { unsigned r; asm volatile("v_cvt_pk_bf16_f32 %0, %1, %2" : "=v"(r) : "v"(lo), "v"(hi)); return r; }
__device__ __forceinline__ float wave_sum(float v) {
#pragma unroll
    for (int o = 32; o >= 1; o >>= 1) v += __shfl_xor(v, o);
    return v;
}
__device__ __forceinline__ float rdlane(float v, int l) { return __int_as_float(__builtin_amdgcn_readlane(__float_as_int(v), l)); }
__device__ __forceinline__ float silu_f(float x) { return x / (1.0f + __expf(-x)); }
__device__ __forceinline__ const float* resid_src(const Params& p, int l, int row) {
    if (l == 0) return row < NLAT ? p.in[I_X] + (size_t)row * DM : p.in[I_CTX] + (size_t)(row - NLAT) * DM;
    return (const float*)(p.ws + O_X) + (size_t)row * DM;
}
__device__ __forceinline__ int row_batch(int row) { return row < NLAT ? row >> 11 : 8; }
#define ROWCOL(j, lane) ((j) * 256 + (lane) * 4)


struct GUnit { int arow0; const bf16_t* B; int orow0, ocol0; };
struct GemmDesc { const bf16_t* A; int lda; const int* ridx; int ldb; int K; };

__host__ __device__ __forceinline__ int perm32(int rho) { const int n = rho >> 4, i = rho & 15; return 8 * (i >> 2) + 4 * n + (i & 3); }
struct EpiStoreBf16 {
    static constexpr bool PERM = (FAST_GEMM != 0);
    bf16_t* O; int ldo;
    __device__ __forceinline__ void operator()(const f32x4 (&acc)[2][2][4][2], const GUnit& u, int wr, int wc, int fr, int fq) const {
#pragma unroll
        for (int ai = 0; ai < 2; ++ai)
#pragma unroll
            for (int m = 0; m < 4; ++m) {
                bf16_t* rowp = O + (size_t)(u.orow0 + ai * 128 + wr * 64 + m * 16 + fr) * ldo + u.ocol0 + wc * 32 + (PERM ? 8 : 4) * fq;
#pragma unroll
                for (int bj = 0; bj < 2; ++bj) {
                    if constexpr (PERM) { const f32x4 v0 = acc[ai][bj][m][0], v1 = acc[ai][bj][m][1]; u32x4 w; w.x = pk2(v0[0], v0[1]); w.y = pk2(v0[2], v0[3]); w.z = pk2(v1[0], v1[1]); w.w = pk2(v1[2], v1[3]); *(u32x4*)(rowp + bj * 128) = w; }
                    else {
#pragma unroll
                        for (int n = 0; n < 2; ++n) { const f32x4 v = acc[ai][bj][m][n]; u32x2 w; w.x = pk2(v[0], v[1]); w.y = pk2(v[2], v[3]); *(u32x2*)(rowp + bj * 128 + n * 16) = w; } } }
            }
    }
};
struct EpiSwiGLU {
    static constexpr bool PERM = (FAST_GEMM != 0);
    bf16_t* O;
    __device__ __forceinline__ void operator()(const f32x4 (&acc)[2][2][4][2], const GUnit& u, int wr, int wc, int fr, int fq) const {
#pragma unroll
        for (int ai = 0; ai < 2; ++ai)
#pragma unroll
            for (int m = 0; m < 4; ++m) {
                bf16_t* rowp = O + (size_t)(u.orow0 + ai * 128 + wr * 64 + m * 16 + fr) * EH + u.ocol0 + wc * 32 + (PERM ? 8 : 4) * fq;
#pragma unroll
                for (int n = 0; n < 2; ++n) { const f32x4 g = acc[ai][0][m][n], up = acc[ai][1][m][n]; float h[4];
#pragma unroll
                    for (int j = 0; j < 4; ++j) h[j] = silu_f(g[j]) * up[j];
                    u32x2 w; w.x = pk2(h[0], h[1]); w.y = pk2(h[2], h[3]); *(u32x2*)(rowp + n * (PERM ? 4 : 16)) = w; }
            }
    }
};

__device__ __forceinline__ unsigned pk4_fp8(float a, float b, float c, float d) { int r = __builtin_amdgcn_cvt_pk_fp8_f32(a, b, 0, false); r = __builtin_amdgcn_cvt_pk_fp8_f32(c, d, r, true); return (unsigned)r; }
constexpr float HID8_SCALE = 16.0f;
constexpr float W8_SCALE = 256.0f;
struct EpiSwiGLU8 {
    static constexpr bool PERM = (FAST_GEMM != 0);
    unsigned char* O;
    __device__ __forceinline__ void operator()(const f32x4 (&acc)[2][2][4][2], const GUnit& u, int wr, int wc, int fr, int fq) const {
#pragma unroll
        for (int ai = 0; ai < 2; ++ai)
#pragma unroll
            for (int m = 0; m < 4; ++m) {
                unsigned char* rowp = O + (size_t)(u.orow0 + ai * 128 + wr * 64 + m * 16 + fr) * EH + u.ocol0 + wc * 32 + (PERM ? 8 : 4) * fq;
#pragma unroll
                for (int n = 0; n < 2; ++n) { const f32x4 g = acc[ai][0][m][n], up = acc[ai][1][m][n]; float h[4];
#pragma unroll
                    for (int j = 0; j < 4; ++j) h[j] = silu_f(g[j]) * up[j] * HID8_SCALE;
                    *(unsigned*)(rowp + n * (PERM ? 4 : 16)) = pk4_fp8(h[0], h[1], h[2], h[3]); }
            }
    }
};

template <class Epi>
__device__ __forceinline__ void gemm_unit_simple(const GemmDesc& g, const GUnit& u, const Epi& E) {
    int tid = otid();
    const int wid = __builtin_amdgcn_readfirstlane(tid >> 6), lane = tid & 63, wr = wid >> 2, wc = wid & 3, fr = lane & 15, fq = lane >> 4;
    f32x4 acc[2][2][4][2];
#pragma unroll
    for (int a = 0; a < 2; ++a)
#pragma unroll
        for (int b = 0; b < 2; ++b)
#pragma unroll
            for (int m = 0; m < 4; ++m)
#pragma unroll
                for (int n = 0; n < 2; ++n) acc[a][b][m][n] = (f32x4){0.f, 0.f, 0.f, 0.f};
    const bf16_t* ap[2][4]; const bf16_t* bp[2][2];
#pragma unroll
    for (int ai = 0; ai < 2; ++ai)
#pragma unroll
        for (int m = 0; m < 4; ++m) { const int r = u.arow0 + ai * 128 + wr * 64 + m * 16 + fr; int src = g.ridx ? g.ridx[r] : r; if (src < 0) src = 0; ap[ai][m] = g.A + (size_t)src * g.lda + 8 * fq; }
#pragma unroll
    for (int bj = 0; bj < 2; ++bj)
#pragma unroll
        for (int n = 0; n < 2; ++n) bp[bj][n] = u.B + (size_t)(bj * 128 + wc * 32 + n * 16 + fr) * g.ldb + 8 * fq;
    int Kq = g.K; asm volatile("" : "+s"(Kq));
#pragma unroll 1
    for (int k0 = 0; k0 < Kq; k0 += 32) {
        bf16x8 a[2][4], b[2][2];
#pragma unroll
        for (int ai = 0; ai < 2; ++ai)
#pragma unroll
            for (int m = 0; m < 4; ++m) a[ai][m] = *(const bf16x8*)(ap[ai][m] + k0);
#pragma unroll
        for (int bj = 0; bj < 2; ++bj)
#pragma unroll
            for (int n = 0; n < 2; ++n) b[bj][n] = *(const bf16x8*)(bp[bj][n] + k0);
#pragma unroll
        for (int ai = 0; ai < 2; ++ai)
#pragma unroll
            for (int bj = 0; bj < 2; ++bj)
#pragma unroll
                for (int m = 0; m < 4; ++m)
#pragma unroll
                    for (int n = 0; n < 2; ++n) acc[ai][bj][m][n] = __builtin_amdgcn_mfma_f32_16x16x32_bf16(b[bj][n], a[ai][m], acc[ai][bj][m][n], 0, 0, 0);
    }
    E(acc, u, wr, wc, fr, fq);
}

struct DenseSched {
    const bf16_t* Bt; int ldb, nM, nN, row0, pn0;
    __device__ __forceinline__ int count() const { return nM * nN; }
    __device__ __forceinline__ int ncol() const { return nN; }
    __device__ __forceinline__ void unit(int i, GUnit& u) const { const int pm = i / nN, pn = pn0 + i % nN; u.arow0 = row0 + pm * 256; u.B = Bt + (size_t)pn * 256 * ldb; u.orow0 = u.arow0; u.ocol0 = pn * 256; }
};
struct MoeSched {
    const LAS int* te; const LAS int* ts; int ntiles, npn; const bf16_t* Bt; size_t estride; int ldb, ocolw;
    __device__ __forceinline__ int count() const { return ntiles * npn; }
    __device__ __forceinline__ int ncol() const { return npn; }
    __device__ __forceinline__ void unit(int i, GUnit& u) const { const int t = i / npn, pn = i % npn; const int e = te[t]; u.arow0 = ts[t]; u.B = Bt + (size_t)e * estride + (size_t)pn * 256 * ldb; u.orow0 = u.arow0; u.ocol0 = pn * ocolw; }
};
template <class Sched, class Epi>
__device__ __forceinline__ void gemm_phase_simple(const GemmDesc& g, const Sched& S, const Epi& E) {
    const int n = S.count();
    for (int i = blockIdx.x; i < n; i += gridDim.x) { GUnit u; S.unit(i, u); gemm_unit_simple(g, u, E); }
}
__device__ __forceinline__ int wave_incl_scan(int v, int lane) {
#pragma unroll
    for (int o = 1; o < 64; o <<= 1) { const int t = __shfl_up(v, o); if (lane >= o) v += t; }
    return v;
}
__device__ __forceinline__ int moe_build_tiles(const unsigned* cnt, int nshared, LAS int* te, LAS int* ts, LAS int* misc) {
    __syncthreads();
    const int tid = otid();
    if (tid < 64) {
        const int c = (int)cnt[tid], ntile = (c + 255) >> 8, incl = wave_incl_scan(ntile, tid), first = incl - ntile;
        for (int j = 0; j < ntile; ++j) { te[first + j] = tid; ts[first + j] = (first + j) * 256; }
        const int nrt = __shfl(incl, 63);
        for (int j = tid; j < nshared; j += 64) { te[nrt + j] = NEXP; ts[nrt + j] = RSLOTS + j * 256; }
        if (tid == 0) misc[0] = nrt + nshared;
    }
    __syncthreads();
    return misc[0];
}
#ifndef FAST_GEMM
#define FAST_GEMM 0
#endif
#if !FAST_GEMM
#define GEMM_PHASE(g, S, E) gemm_phase_simple(g, S, E)
#endif

#if FAST_GEMM
constexpr int HTB = 128 * 64 * 2;
__device__ __forceinline__ int lds_byte(int r, int c) { const int st = (r >> 4) * 2 + (c >> 5), rr = r & 15, cc = c & 31, ob = rr * 64 + cc * 2; return st * 1024 + (ob ^ (((ob >> 9) & 1) << 5)); }
__device__ __forceinline__ void stage_rc(int b, int& R, int& C) { const int st = b / 1024, sb = b % 1024, swz = sb ^ (((sb >> 9) & 1) << 5); R = (st >> 1) * 16 + swz / 64; C = (st & 1) * 32 + (swz % 64) / 2; }

typedef int v8i __attribute__((ext_vector_type(8)));
typedef int v4i __attribute__((ext_vector_type(4)));
template <int ESZ, class Sched, class Epi>
__device__ __forceinline__ void gemm_phase_fast(LAS unsigned char* lds, const GemmDesc& g, const Sched& S, const Epi& E, int scA = 127, int scB = 127) {
    const int tid = otid(), wid = __builtin_amdgcn_readfirstlane(tid >> 6), lane = tid & 63, wr = wid >> 2, wc = wid & 3, fr = lane & 15, fq = lane >> 4;
    const int K = g.K, nunits = S.count(), G = gridDim.x, c0 = blockIdx.x;
    int nt = K * ESZ / 128; asm volatile("" : "+s"(nt));
    const int npn = S.ncol(); const bool xmap = (G % 8 == 0) && ((G / 8) % npn == 0); const int xT = xmap ? (G / 8) / npn : 1, xx = c0 % 8, xr = c0 / 8;
#define F_UNIT(ui_) (xmap ? (((ui_) * 8 + xx) * xT + xr / npn) * npn + xr % npn : (ui_) * G + c0)
    if (F_UNIT(0) >= nunits) return;
    int R[2], C[2]; unsigned voffB[2];
#pragma unroll
    for (int i = 0; i < 2; ++i) { stage_rc(tid * 16 + i * 8192, R[i], C[i]); const int Rb = Epi::PERM ? ((R[i] & ~31) + perm32(R[i] & 31)) : R[i]; voffB[i] = (unsigned)(Rb * g.ldb) * (unsigned)ESZ + (unsigned)C[i] * 2u; }
    const size_t kstep = 128;
    const size_t hstepB = (size_t)128 * g.ldb * ESZ;
    const unsigned ldsw = (unsigned)wid * 1024u;
    const int aoff = lds_byte(wr * 64 + fr, fq * 8), boff = lds_byte(wc * 32 + fr, fq * 8);
    const char* Ab = (const char*)g.A;
#define F_SA(b, h) (((b) * 2 + (h)) * HTB)
#define F_SB(b, h) ((4 + (b) * 2 + (h)) * HTB)
#define F_STAGE(bufoff, gbase, voff) do { _Pragma("unroll") for (int _i = 0; _i < 2; ++_i) \
        __builtin_amdgcn_global_load_lds((const unsigned*)((const char*)(gbase) + (voff)[_i]), (LAS unsigned*)(lds + (bufoff) + ldsw + _i * 8192), 16, 0, 0); } while (0)
#define F_LDA(dst, b, h) do { _Pragma("unroll") for (int m = 0; m < 4; ++m) { if constexpr (ESZ == 2) { _Pragma("unroll") for (int k = 0; k < 2; ++k) dst[m][k] = *(const LAS bf16x8*)(lds + F_SA(b, h) + aoff + m * 2048 + k * 1024); } \
        else { const v4i lo_ = *(const LAS v4i*)(lds + F_SA(b, h) + aoff + m * 2048), hi_ = *(const LAS v4i*)(lds + F_SA(b, h) + aoff + m * 2048 + 1024); dst##8[m] = __builtin_shufflevector(lo_, hi_, 0, 1, 2, 3, 4, 5, 6, 7); } } } while (0)
#define F_LDB(dst, b, h) do { _Pragma("unroll") for (int n = 0; n < 2; ++n) { if constexpr (ESZ == 2) { _Pragma("unroll") for (int k = 0; k < 2; ++k) dst[n][k] = *(const LAS bf16x8*)(lds + F_SB(b, h) + boff + n * 2048 + k * 1024); } \
        else { const v4i lo_ = *(const LAS v4i*)(lds + F_SB(b, h) + boff + n * 2048), hi_ = *(const LAS v4i*)(lds + F_SB(b, h) + boff + n * 2048 + 1024); dst##8[n] = __builtin_shufflevector(lo_, hi_, 0, 1, 2, 3, 4, 5, 6, 7); } } } while (0)
#define F_MMA(ai, bj, At, Bt) do { __builtin_amdgcn_s_setprio(1); _Pragma("unroll") for (int m = 0; m < 4; ++m) _Pragma("unroll") for (int n = 0; n < 2; ++n) { \
        if constexpr (ESZ == 2) { _Pragma("unroll") for (int k = 0; k < 2; ++k) acc[ai][bj][m][n] = __builtin_amdgcn_mfma_f32_16x16x32_bf16(Bt[n][k], At[m][k], acc[ai][bj][m][n], 0, 0, 0); } \
        else acc[ai][bj][m][n] = __builtin_amdgcn_mfma_scale_f32_16x16x128_f8f6f4(Bt##8[n], At##8[m], acc[ai][bj][m][n], 0, 0, 0, scB, 0, scA); } \
        __builtin_amdgcn_s_setprio(0); } while (0)
#define F_WAIT_V(n) asm volatile("s_waitcnt vmcnt(" #n ")" ::: "memory")
#define F_WAIT_L(n) asm volatile("s_waitcnt lgkmcnt(" #n ")" ::: "memory")
#define F_BAR __builtin_amdgcn_s_barrier()
#define F_SCHED __builtin_amdgcn_sched_barrier(0)
#define F_AROWS(u, dst) do { _Pragma("unroll") for (int _h = 0; _h < 2; ++_h) _Pragma("unroll") for (int _i = 0; _i < 2; ++_i) { const int _r = (u).arow0 + _h * 128 + R[_i]; int _s = g.ridx ? g.ridx[_r] : _r; if (_s < 0) _s = 0; dst[_h][_i] = _s; } } while (0)
#define F_AOFFS(src, dst) do { _Pragma("unroll") for (int _h = 0; _h < 2; ++_h) _Pragma("unroll") for (int _i = 0; _i < 2; ++_i) dst[_h][_i] = (unsigned)src[_h][_i] * (unsigned)g.lda * (unsigned)ESZ + (unsigned)C[_i] * 2u; } while (0)
    GUnit cur, nxt; int ui = 0;
    S.unit(F_UNIT(0), cur);
    f32x4 acc[2][2][4][2];
#pragma unroll
    for (int a = 0; a < 2; ++a)
#pragma unroll
        for (int b = 0; b < 2; ++b)
#pragma unroll
            for (int m = 0; m < 4; ++m)
#pragma unroll
                for (int n = 0; n < 2; ++n) acc[a][b][m][n] = (f32x4){0.f, 0.f, 0.f, 0.f};
    bf16x8 At[4][2], B0[2][2], B1[2][2]; v8i At8[4], B08[2], B18[2];
    unsigned voA[2][2]; int rnx[2][2];
    F_AROWS(cur, rnx); F_AOFFS(rnx, voA);
    const char* cB = (const char*)cur.B;
    F_STAGE(F_SB(0, 0), cB, voffB); F_STAGE(F_SA(0, 0), Ab, voA[0]); F_STAGE(F_SB(0, 1), cB + hstepB, voffB); F_STAGE(F_SA(0, 1), Ab, voA[1]);
    if (wr == 1) F_BAR;
    F_WAIT_V(4); F_BAR;
    F_STAGE(F_SB(1, 0), cB + kstep, voffB); F_STAGE(F_SA(1, 0), Ab + kstep, voA[0]); F_STAGE(F_SB(1, 1), cB + hstepB + kstep, voffB);
    F_WAIT_V(6); F_BAR;
    for (;;) {
        const int Ln = F_UNIT(ui + 1); const bool has_next = Ln < nunits;
        if (has_next) { S.unit(Ln, nxt); F_AROWS(nxt, rnx); }
        const char* nB = has_next ? (const char*)nxt.B : cB;
        for (int t = 0; t < nt; t += 2) {
            const bool last = (t == nt - 2);
            const char* a1 = Ab + (size_t)(t + 1) * kstep;
            const char* a2 = last ? Ab : Ab + (size_t)(t + 2) * kstep; const char* b2 = last ? nB : cB + (size_t)(t + 2) * kstep;
            const char* a3 = a2 + kstep; const char* b3 = b2 + kstep;
            F_LDB(B0, 0, 0); F_SCHED; F_LDA(At, 0, 0); F_STAGE(F_SA(1, 1), a1, voA[1]);
            if (last && has_next) F_AOFFS(rnx, voA);
            F_WAIT_L(8); F_BAR; F_WAIT_L(0); F_MMA(0, 0, At, B0); F_BAR; F_SCHED;
            F_LDB(B1, 0, 1); F_STAGE(F_SB(0, 0), b2, voffB);
            F_BAR; F_WAIT_L(0); F_MMA(0, 1, At, B1); F_BAR;
            F_LDA(At, 0, 1); F_STAGE(F_SA(0, 0), a2, voA[0]);
            F_BAR; F_WAIT_L(0); F_MMA(1, 0, At, B0); F_BAR; F_SCHED;
            F_STAGE(F_SB(0, 1), b2 + hstepB, voffB);
            F_WAIT_V(6); F_BAR; F_MMA(1, 1, At, B1); F_BAR;
            F_LDB(B0, 1, 0); F_SCHED; F_LDA(At, 1, 0); F_STAGE(F_SA(0, 1), a2, voA[1]);
            F_WAIT_L(8); F_BAR; F_WAIT_L(0); F_MMA(0, 0, At, B0); F_BAR; F_SCHED;
            F_LDB(B1, 1, 1); F_STAGE(F_SB(1, 0), b3, voffB);
            F_BAR; F_WAIT_L(0); F_MMA(0, 1, At, B1); F_BAR;
            F_LDA(At, 1, 1); F_STAGE(F_SA(1, 0), a3, voA[0]);
            F_BAR; F_WAIT_L(0); F_MMA(1, 0, At, B0); F_BAR; F_SCHED;
            F_STAGE(F_SB(1, 1), b3 + hstepB, voffB);
            F_WAIT_V(6); F_BAR; F_MMA(1, 1, At, B1); F_BAR;
        }
        E(acc, cur, wr, wc, fr, fq);
        if (!has_next) break;
#pragma unroll
        for (int a = 0; a < 2; ++a)
#pragma unroll
            for (int b = 0; b < 2; ++b)
#pragma unroll
                for (int m = 0; m < 4; ++m)
#pragma unroll
                    for (int n = 0; n < 2; ++n) acc[a][b][m][n] = (f32x4){0.f, 0.f, 0.f, 0.f};
        cur = nxt; cB = nB; ++ui;
    }
    F_WAIT_V(0);
    if (wr == 0) F_BAR;
    F_BAR;
#undef F_UNIT
#undef F_SA
#undef F_SB
#undef F_STAGE
#undef F_LDA
#undef F_LDB
#undef F_MMA
#undef F_WAIT_V
#undef F_WAIT_L
#undef F_BAR
#undef F_SCHED
#undef F_AROWS
#undef F_AOFFS
}
#define GEMM_PHASE(g, S, E) gemm_phase_fast<2>(lds, g, S, E)
#define GEMM_PHASE8(g, S, E, sa, sb) gemm_phase_fast<1>(lds, g, S, E, sa, sb)
#endif

#define SBAR() __builtin_amdgcn_sched_barrier(0)
__device__ __forceinline__ int crow(int r, int hi) { return (r & 3) + 8 * (r >> 2) + 4 * hi; }
template <int DQK> __device__ __forceinline__ int kaddr(int row, int chunk) {
    const int sw = (DQK == 128) ? (row & 7) : ((row >> 1) & 7);
    return row * (DQK * 2) + ((chunk ^ sw) << 4);
}
__device__ __forceinline__ void partialSM(f32x16& p0, f32x16& p1, float& m_reg, float& mn, float& alpha, float C, float thr) {
    float pmax = p0[0];
#pragma unroll
    for (int r = 1; r < 16; ++r) pmax = fmaxf(pmax, p0[r]);
#pragma unroll
    for (int r = 0; r < 16; ++r) pmax = fmaxf(pmax, p1[r]);
    { auto rr = __builtin_amdgcn_permlane32_swap(__float_as_uint(pmax), __float_as_uint(pmax), false, false);
      pmax = fmaxf(__uint_as_float(rr[0]), __uint_as_float(rr[1])); }
    if (__builtin_expect(__all(pmax - m_reg <= thr), 1)) { mn = m_reg; alpha = 1.f; }
    else { mn = fmaxf(m_reg, pmax); alpha = __builtin_amdgcn_exp2f((m_reg - mn) * C); m_reg = mn; }
    const float mnC = -mn * C;
#pragma unroll
    for (int r = 0; r < 16; ++r) p0[r] = fmaf(p0[r], C, mnC);
#pragma unroll
    for (int r = 0; r < 16; ++r) p1[r] = fmaf(p1[r], C, mnC);
#pragma unroll
    for (int r = 0; r < 16; ++r) p0[r] = __builtin_amdgcn_exp2f(p0[r]);
}
__device__ __forceinline__ void finishSM(f32x16& p0, f32x16& p1, float alpha, float& l_reg, bf16x8& pa0, bf16x8& pa1, bf16x8& pa2, bf16x8& pa3) {
#pragma unroll
    for (int r = 0; r < 16; ++r) p1[r] = __builtin_amdgcn_exp2f(p1[r]);
    float ps = 0;
#pragma unroll
    for (int r = 0; r < 16; ++r) ps += p0[r];
#pragma unroll
    for (int r = 0; r < 16; ++r) ps += p1[r];
    { auto rr = __builtin_amdgcn_permlane32_swap(__float_as_uint(ps), __float_as_uint(ps), false, false);
      ps = __uint_as_float(rr[0]) + __uint_as_float(rr[1]); }
    l_reg = l_reg * alpha + ps;
#define PK4(P, BASE, OUT) do { unsigned a0 = pk2(P[BASE + 0], P[BASE + 1]), a1 = pk2(P[BASE + 2], P[BASE + 3]);   \
    unsigned b0 = pk2(P[BASE + 4], P[BASE + 5]), b1 = pk2(P[BASE + 6], P[BASE + 7]);                              \
    auto r0 = __builtin_amdgcn_permlane32_swap(a0, b0, false, false); auto r1 = __builtin_amdgcn_permlane32_swap(a1, b1, false, false); \
    u32x4 w = {r0[0], r1[0], r0[1], r1[1]}; OUT = *reinterpret_cast<bf16x8*>(&w); } while (0)
    PK4(p0, 0, pa0); PK4(p0, 8, pa1); PK4(p1, 0, pa2); PK4(p1, 8, pa3);
#undef PK4
}
template <int DQK> __device__ __forceinline__ void qkt(f32x16& p0, f32x16& p1, const char* Ks, const bf16x8* qr, int r32, int hi) {
    p0 = f32x16{}; p1 = f32x16{};
#pragma unroll
    for (int d0 = 0; d0 < DQK / 16; ++d0) { const int ch = 2 * d0 + hi;
        const bf16x8 b0 = *reinterpret_cast<const bf16x8*>(Ks + kaddr<DQK>(r32, ch));
        const bf16x8 b1 = *reinterpret_cast<const bf16x8*>(Ks + kaddr<DQK>(32 + r32, ch));
        p0 = __builtin_amdgcn_mfma_f32_32x32x16_bf16(b0, qr[d0], p0, 0, 0, 0);
        p1 = __builtin_amdgcn_mfma_f32_32x32x16_bf16(b1, qr[d0], p1, 0, 0, 0); }
}
__device__ __forceinline__ int v_st(int k, int c) { const int kk = (k & ~0xC) | ((k & 4) << 1) | ((k & 8) >> 1); return ((kk >> 3) * 4 + (c >> 5)) * 512 + ((kk & 7) * 32 + (c & 31)) * 2; }
__device__ __forceinline__ int v_rd_base(int lane) { return ((lane & 3) << 3) | (((lane >> 2) & 3) << 6) | (((lane >> 4) & 1) << 5) | (((lane >> 5) & 1) << 8); }
constexpr int v_rd_off(int d0, int ks, int half) { return d0 * 512 + ks * 4096 + half * 2048; }
template <int OFF> __device__ __forceinline__ s16x4 tr_read(int vb) {
    s16x4 r; asm volatile("ds_read_b64_tr_b16 %0, %1 offset:%2" : "=&v"(r) : "v"(vb), "i"(OFF) : "memory"); return r;
}
template <int D0> __device__ __forceinline__ void pv_one(f32x16& od, int vb, bf16x8 pa0, bf16x8 pa1, bf16x8 pa2, bf16x8 pa3) {
    const s16x4 l0 = tr_read<v_rd_off(D0, 0, 0)>(vb), h0 = tr_read<v_rd_off(D0, 0, 1)>(vb), l1 = tr_read<v_rd_off(D0, 1, 0)>(vb), h1 = tr_read<v_rd_off(D0, 1, 1)>(vb);
    const s16x4 l2 = tr_read<v_rd_off(D0, 2, 0)>(vb), h2 = tr_read<v_rd_off(D0, 2, 1)>(vb), l3 = tr_read<v_rd_off(D0, 3, 0)>(vb), h3 = tr_read<v_rd_off(D0, 3, 1)>(vb);
    asm volatile("s_waitcnt lgkmcnt(0)" ::: "memory"); SBAR();
#define PK(L, H) (bf16x8){L[0], L[1], L[2], L[3], H[0], H[1], H[2], H[3]}
    od = __builtin_amdgcn_mfma_f32_32x32x16_bf16(pa0, PK(l0, h0), od, 0, 0, 0);
    od = __builtin_amdgcn_mfma_f32_32x32x16_bf16(pa1, PK(l1, h1), od, 0, 0, 0);
    od = __builtin_amdgcn_mfma_f32_32x32x16_bf16(pa2, PK(l2, h2), od, 0, 0, 0);
    od = __builtin_amdgcn_mfma_f32_32x32x16_bf16(pa3, PK(l3, h3), od, 0, 0, 0);
#undef PK
}
__device__ __forceinline__ void pv_d0(f32x16* o, int vb, bf16x8 pa0, bf16x8 pa1, bf16x8 pa2, bf16x8 pa3) {
    pv_one<0>(o[0], vb, pa0, pa1, pa2, pa3); pv_one<1>(o[1], vb, pa0, pa1, pa2, pa3); pv_one<2>(o[2], vb, pa0, pa1, pa2, pa3); pv_one<3>(o[3], vb, pa0, pa1, pa2, pa3);
}

template <int DQK, int SDEPTH>
__device__ __forceinline__ void attn_body(const bf16_t* __restrict__ Qb, const bf16_t* __restrict__ Kh, const bf16_t* __restrict__ Vh, bf16_t* __restrict__ Ob, int ldo, int nkeys, float scale, char* lds) {
    constexpr int SHM_V = 64 * 128 * 2, SHM_K = 64 * DQK * 2, NKC = DQK / 8, KPT = NKC / 8;
    int tid = otid();
    const int wid = __builtin_amdgcn_readfirstlane(tid >> 6), lane = tid & 63, r32 = lane & 31, hi = lane >> 5;
    char* V_lds = lds; char* K_lds = lds + 2 * SHM_V;
    float* ws = (float*)(lds + 2 * SHM_V + 2 * SHM_K) + wid * 64; float* li_l = ws; float* al_l = ws + 32;
    const float C = scale * 1.4426950408889634f, thr = 8.0f / scale;
    float m_reg = -1e30f, l_reg = 0; f32x16 o[4] = {}; bf16x8 qr[DQK / 16];
    const bf16_t* Qw = Qb + (long)(wid * 32 + r32) * DQK + hi * 8;
#pragma unroll
    for (int d0 = 0; d0 < DQK / 16; ++d0) qr[d0] = *reinterpret_cast<const bf16x8*>(Qw + d0 * 16);
    const int sr = tid >> 4, sc = (tid & 15) * 8, vst0 = v_st(sr, sc), vst1 = v_st(32 + sr, sc);
    int kgo[KPT], klo[KPT];
#pragma unroll
    for (int i = 0; i < KPT; ++i) { const int q = tid + 512 * i, row = q / NKC, ch = q % NKC; kgo[i] = row * DQK + ch * 8; klo[i] = kaddr<DQK>(row, ch); }
    const int vb0 = (int)(uintptr_t)V_lds + v_rd_base(lane);
    struct { bf16x8 vs0, vs1, ks[KPT]; } sr_[SDEPTH ? SDEPTH : 1];
#define SLOAD(i, k0) do { sr_[i].vs0 = *reinterpret_cast<const bf16x8*>(&Vh[(long)((k0) + sr) * 128 + sc]); sr_[i].vs1 = *reinterpret_cast<const bf16x8*>(&Vh[(long)((k0) + 32 + sr) * 128 + sc]); \
    _Pragma("unroll") for (int _q = 0; _q < KPT; ++_q) sr_[i].ks[_q] = *reinterpret_cast<const bf16x8*>(&Kh[(long)(k0) * DQK + kgo[_q]]); } while (0)
#define SWRITE(b, i) do { *(bf16x8*)(V_lds + (b) * SHM_V + vst0) = sr_[i].vs0; *(bf16x8*)(V_lds + (b) * SHM_V + vst1) = sr_[i].vs1; \
    _Pragma("unroll") for (int _q = 0; _q < KPT; ++_q) *(bf16x8*)(K_lds + (b) * SHM_K + klo[_q]) = sr_[i].ks[_q]; } while (0)
#define SWAIT() do { if constexpr (SDEPTH == 2) { if constexpr (KPT == 2) asm volatile("s_waitcnt vmcnt(4)" ::: "memory"); else asm volatile("s_waitcnt vmcnt(5)" ::: "memory"); } \
    else asm volatile("s_waitcnt vmcnt(0)" ::: "memory"); } while (0)
#define RESC(a) do { if (__any((a) < 1.f)) { if (hi == 0) al_l[r32] = (a); asm volatile("s_waitcnt lgkmcnt(0)" ::: "memory"); \
    _Pragma("unroll") for (int d = 0; d < 4; ++d) _Pragma("unroll") for (int r = 0; r < 16; ++r) o[d][r] *= al_l[crow(r, hi)]; } } while (0)
    bf16x8 pa0, pa1, pa2, pa3; const int NT = nkeys / 64;
    if constexpr (SDEPTH == 0) {
        f32x16 pA0, pA1; float mnA, alA;
        SLOAD(0, 0); asm volatile("s_waitcnt vmcnt(0)" ::: "memory"); SWRITE(0, 0); __syncthreads();
        for (int j = 0; j < NT; ++j) {
            const int bo = j & 1;
            if (j + 1 < NT) SLOAD(0, (j + 1) * 64);
            SBAR(); qkt<DQK>(pA0, pA1, K_lds + bo * SHM_K, qr, r32, hi); partialSM(pA0, pA1, m_reg, mnA, alA, C, thr);
            RESC(alA); finishSM(pA0, pA1, alA, l_reg, pa0, pa1, pa2, pa3); SBAR();
            pv_d0(o, vb0 + bo * SHM_V, pa0, pa1, pa2, pa3);
            if (j + 1 < NT) { asm volatile("s_waitcnt vmcnt(0)" ::: "memory"); SWRITE(bo ^ 1, 0); }
            __syncthreads();
        }
    } else {
    f32x16 pA0, pA1, pB0, pB1; float mnA, mnB, alA, alB;
    constexpr int SE = 0, SO = SDEPTH - 1;
    SLOAD(SE, 0); asm volatile("s_waitcnt vmcnt(0)" ::: "memory"); SWRITE(0, SE); __syncthreads();
    qkt<DQK>(pA0, pA1, K_lds, qr, r32, hi); partialSM(pA0, pA1, m_reg, mnA, alA, C, thr);
    SLOAD(SO, 64); if constexpr (SDEPTH == 2) { if (2 < NT) SLOAD(SE, 2 * 64); }
    SWAIT(); SWRITE(1, SO); __syncthreads();
    for (int j = 1; j + 1 < NT; j += 2) {
        SBAR(); qkt<DQK>(pB0, pB1, K_lds + SHM_K, qr, r32, hi);
        finishSM(pA0, pA1, alA, l_reg, pa0, pa1, pa2, pa3); SBAR();
        SLOAD(SO, (j + SDEPTH) * 64); SBAR();
        pv_d0(o, vb0, pa0, pa1, pa2, pa3); partialSM(pB0, pB1, m_reg, mnB, alB, C, thr);
        __syncthreads(); SWAIT(); SWRITE(0, SE);
        RESC(alB); __syncthreads();
        SBAR(); qkt<DQK>(pA0, pA1, K_lds, qr, r32, hi);
        finishSM(pB0, pB1, alB, l_reg, pa0, pa1, pa2, pa3); SBAR();
        if (SDEPTH == 1 || j + 3 < NT) SLOAD(SE, (j + 1 + SDEPTH) * 64); SBAR();
        pv_d0(o, vb0 + SHM_V, pa0, pa1, pa2, pa3); partialSM(pA0, pA1, m_reg, mnA, alA, C, thr);
        __syncthreads(); SWAIT(); SWRITE(1, SO);
        RESC(alA); __syncthreads();
    }
    SBAR(); qkt<DQK>(pB0, pB1, K_lds + SHM_K, qr, r32, hi);
    finishSM(pA0, pA1, alA, l_reg, pa0, pa1, pa2, pa3); SBAR();
    pv_d0(o, vb0, pa0, pa1, pa2, pa3); partialSM(pB0, pB1, m_reg, mnB, alB, C, thr);
    __syncthreads(); RESC(alB);
    finishSM(pB0, pB1, alB, l_reg, pa0, pa1, pa2, pa3); SBAR();
    pv_d0(o, vb0 + SHM_V, pa0, pa1, pa2, pa3);
    }
    if (hi == 0) li_l[r32] = l_reg; asm volatile("s_waitcnt lgkmcnt(0)" ::: "memory");
    float rli[16];
#pragma unroll
    for (int r = 0; r < 16; ++r) rli[r] = __builtin_amdgcn_rcpf(li_l[crow(r, hi)]);
    bf16_t* Ow = Ob + (long)(wid * 32) * ldo;
#pragma unroll
    for (int r = 0; r < 16; ++r) { const int orow = crow(r, hi);
#pragma unroll
        for (int d0 = 0; d0 < 4; ++d0) Ow[(long)orow * ldo + d0 * 32 + r32] = f2bf(o[d0][r] * rli[r]); }
    __syncthreads();
#undef SLOAD
#undef SWRITE
#undef SWAIT
#undef RESC
}

struct CvtMat { const float* src; bf16_t* dst; const float* kscale; int N, lddst, nb, mode; };
__device__ __forceinline__ void cvt_block(const CvtMat& m, int kb, int nbk, int lane) {
    const int a = lane & 7, ng = lane >> 3, k0 = kb * 64 + 8 * a, n0 = nbk * 32 + 4 * ng;
    const float* s = m.src + (size_t)k0 * m.N + n0;
    f32x4 v[8];
#pragma unroll
    for (int j = 0; j < 8; ++j) v[j] = *(const f32x4*)(s + (size_t)j * m.N);
    if (m.kscale) {
#pragma unroll
        for (int j = 0; j < 8; ++j) v[j] *= m.kscale[k0 + j];
    }
#pragma unroll
    for (int i = 0; i < 4; ++i) { const int n = n0 + i, row = (m.mode == 0) ? n : ((n >> 7) * 256 + (n & 127) + (m.mode - 1) * 128);
        u32x4 w; w.x = pk2(v[0][i], v[1][i]); w.y = pk2(v[2][i], v[3][i]); w.z = pk2(v[4][i], v[5][i]); w.w = pk2(v[6][i], v[7][i]);
        *(u32x4*)(m.dst + (size_t)row * m.lddst + k0) = w; }
}
__device__ __forceinline__ void cvt_block8(const CvtMat& m, unsigned char* dst8, int kb, int nbk, int lane) {
    const int a = lane & 7, ng = lane >> 3, k0 = kb * 64 + 8 * a, n0 = nbk * 32 + 4 * ng;
    const float* s = m.src + (size_t)k0 * m.N + n0;
    f32x4 v[8];
#pragma unroll
    for (int j = 0; j < 8; ++j) v[j] = *(const f32x4*)(s + (size_t)j * m.N) * W8_SCALE;
#pragma unroll
    for (int i = 0; i < 4; ++i) { const int n = n0 + i, row = (m.mode == 0) ? n : ((n >> 7) * 256 + (n & 127) + (m.mode - 1) * 128);
        u32x2 w; w.x = pk4_fp8(v[0][i], v[1][i], v[2][i], v[3][i]); w.y = pk4_fp8(v[4][i], v[5][i], v[6][i], v[7][i]);
        *(u32x2*)(dst8 + (size_t)row * m.lddst + k0) = w; }
}
constexpr int CVT_SMALL = 3904 + 2048 + 432 + 192;
__device__ __forceinline__ void cvt_small_task(const Params& p, int l, int t, int lane) {
    unsigned char* ws = p.ws; CvtMat m;
    if (t < 3904) { m = CvtMat{p.in[I_WIN] + (size_t)l * DM * IN_COLS, (bf16_t*)(ws + O_WIN) + (size_t)l * NP * DM, nullptr, IN_COLS, DM, 122, 0}; }
    else if ((t -= 3904) < 2048) { m = CvtMat{p.in[I_WOUT] + (size_t)l * DM * DM, (bf16_t*)(ws + O_WOUT) + (size_t)l * DM * DM, nullptr, DM, DM, 64, 0}; }
    else if ((t -= 2048) < 432) { m = CvtMat{p.in[I_WUQ] + (size_t)l * 768 * 1152, (bf16_t*)(ws + O_WUQ) + (size_t)l * NQP * 768, p.in[I_MQN] + l * 768, 1152, 768, 36, 0}; }
    else { t -= 432; m = CvtMat{p.in[I_WUKV] + (size_t)l * 256 * 1536, (bf16_t*)(ws + O_WUKV) + (size_t)l * 1536 * 256, p.in[I_MKVN] + l * 256, 1536, 256, 48, 0}; }
    cvt_block(m, t / m.nb, t % m.nb, lane);
}
constexpr int CVT_EXP = 65 * 1536;
__device__ __forceinline__ void cvt_exp_task(const Params& p, int l, int t, int lane) {
    unsigned char* ws = p.ws;
    const int e = t / 1536, r = t % 1536, which = r >> 9, q = r & 511; CvtMat m;
    if (which < 2) {
        const float* src = (e < NEXP) ? p.in[which == 0 ? I_EG : I_EU] + ((size_t)l * NEXP + e) * DM * EH : p.in[which == 0 ? I_SG : I_SU] + (size_t)l * DM * EH;
        m = CvtMat{src, (bf16_t*)(ws + O_EGU) + (size_t)e * 1024 * 2048, nullptr, EH, DM, 16, 1 + which};
    } else {
        const float* src = (e < NEXP) ? p.in[I_EDN] + ((size_t)l * NEXP + e) * EH * DM : p.in[I_SD] + (size_t)l * EH * DM;
        m = CvtMat{src, (bf16_t*)(ws + O_ED) + (size_t)e * 2048 * 512, nullptr, DM, EH, 64, 0};
    }
#if MOE_FP8
    cvt_block8(m, which < 2 ? p.ws + O_EGU + (size_t)e * 1024 * 2048 : p.ws + O_ED + (size_t)e * 2048 * 512, q / m.nb, q % m.nb, lane);
#else
    cvt_block(m, q / m.nb, q % m.nb, lane);
#endif
}
__device__ __forceinline__ void cvt_exp_all(const Params& p, int l) {
    const int lane = otid() & 63, gw = blockIdx.x * 8 + owid(), GW = gridDim.x * 8;
    for (int t = gw; t < CVT_EXP; t += GW) cvt_exp_task(p, l, t, lane);
}
__device__ __forceinline__ void adaln_tasks(const Params& p, LAS float* lf) {
    const int lane = otid() & 63, wid = owid();
    float* MOD = (float*)(p.ws + O_MOD);
    for (int task = blockIdx.x; task < 384; task += gridDim.x) {
        const int cb = task % 192, l = task / 192, col = cb * 64 + lane;
        const float* W = p.in[I_ADAW] + (size_t)l * DM * 12288 + col;
        float acc[9];
#pragma unroll
        for (int r = 0; r < 9; ++r) acc[r] = 0.f;
        for (int kb = wid * 256; kb < wid * 256 + 256; kb += 64) {
            float sv[9];
#pragma unroll
            for (int r = 0; r < 8; ++r) sv[r] = silu_f(p.in[I_C][r * DM + kb + lane]);
            sv[8] = silu_f(p.in[I_CCTX][kb + lane]);
#pragma unroll 8
            for (int kk = 0; kk < 64; ++kk) { const float w = W[(size_t)(kb + kk) * 12288];
#pragma unroll
                for (int r = 0; r < 9; ++r) acc[r] += rdlane(sv[r], kk) * w; }
        }
#pragma unroll
        for (int r = 0; r < 9; ++r) lf[(wid * 9 + r) * 64 + lane] = acc[r];
        __syncthreads();
        for (int r = wid; r < 9; r += 8) { float s = p.in[I_ADAB][l * 12288 + col];
#pragma unroll
            for (int w = 0; w < 8; ++w) s += lf[(w * 9 + r) * 64 + lane];
            MOD[(size_t)(l * 9 + r) * 12288 + col] = s; }
        __syncthreads();
    }
}
__device__ __forceinline__ void hss_tasks(const Params& p) {
    const int lane = otid() & 63, gw = blockIdx.x * 8 + owid(), GW = gridDim.x * 8;
    for (int task = gw; task < 3 * 1024; task += GW) {
        const int set = task >> 10, l = (set == 1) ? 1 : 0, nset = (set == 2) ? 1 : 0, ord = (task >> 9) & 1, ch = task & 511, n = nset ? 256 : 2048;
        const float* HF = (const float*)(p.ws + O_HF) + (size_t)l * HF_LAYER + (nset ? HF_L0 : 0);
        const float* hf = HF + (size_t)((ord * 2 + 0) * 512 + ch) * n; const float* hb = HF + (size_t)((ord * 2 + 1) * 512 + ch) * n;
        float s = 0.f;
        for (int i = lane; i < n; i += 64) { const float a = hf[i], b = (i == 0) ? 0.f : hb[i]; s += a * a + b * b; }
        s = wave_sum(s);
        if (lane == 0) ((float*)(p.ws + O_HSS))[(size_t)((l * 2 + nset) * 2 + ord) * 512 + ch] = s;
    }
}
__device__ __forceinline__ void hyf_task(const Params& p, int l, int nset, int i0, LAS float* lf) {
    int tid = otid(); const int n = nset ? 256 : 2048;
    LAS float* feats = lf; LAS float* hd1 = lf + 8 * 33; LAS float* hd2 = hd1 + 512;
    if (tid < 8 * 33) { const int pos = tid / 33, f = tid % 33, i = i0 + pos; const float t = (float)i / (float)(n - 1), ang = 6.283185307179586f * (float)i / (float)n; float v;
        if (f == 0) v = t; else { const int j = (f - 1) & 15; const float band = 1e-4f + (float)j * ((15.0f - 1e-4f) / 15.0f); v = (f <= 16) ? cosf(ang * band) : sinf(ang * band); }
        feats[tid] = v; }
    __syncthreads();
    { const int pos = tid >> 6, j = tid & 63; const float* w1 = p.in[I_HYW1] + l * 33 * 64; float s = p.in[I_HYB1][l * 64 + j];
      for (int f = 0; f < 33; ++f) s += feats[pos * 33 + f] * w1[f * 64 + j];
      hd1[tid] = sinf(p.in[I_HYFREQ][l * 64 + j] * s); }
    __syncthreads();
    { const int pos = tid >> 6, j = tid & 63; const float* w2 = p.in[I_HYW2] + l * 64 * 64; float s = p.in[I_HYB2][l * 64 + j];
      for (int f = 0; f < 64; ++f) s += hd1[pos * 64 + f] * w2[f * 64 + j];
      hd2[tid] = sinf(p.in[I_HYFREQ][l * 64 + j] * s); }
    __syncthreads();
    const float* w3 = p.in[I_HYW3] + (size_t)l * 64 * 2048 + tid * 4;
    f32x4 acc[8];
#pragma unroll
    for (int q = 0; q < 8; ++q) acc[q] = (f32x4){0.f, 0.f, 0.f, 0.f};
    for (int j = 0; j < 64; ++j) { const f32x4 w = *(const f32x4*)(w3 + (size_t)j * 2048);
#pragma unroll
        for (int q = 0; q < 8; ++q) acc[q] += w * hd2[q * 64 + j]; }
    float* HF = (float*)(p.ws + O_HF) + (size_t)l * HF_LAYER + (nset ? HF_L0 : 0);
#pragma unroll
    for (int c = 0; c < 4; ++c) { const int col = tid * 4 + c, ord = col >> 10, dir = (col >> 9) & 1, ch = col & 511;
        const float delta = 3.0701134573253944f + (float)ch * ((15.350567286626973f - 3.0701134573253944f) / 511.0f); float v[8];
#pragma unroll
        for (int q = 0; q < 8; ++q) { const int i = i0 + q; const float t = (float)i / (float)(n - 1); v[q] = acc[q][c] * __expf(-t * delta); }
        float* dst = HF + (size_t)((ord * 2 + dir) * 512 + ch) * n + i0;
        *(f32x4*)dst = (f32x4){v[0], v[1], v[2], v[3]}; *(f32x4*)(dst + 4) = (f32x4){v[4], v[5], v[6], v[7]};    }
    __syncthreads();
}
__device__ __forceinline__ void rope_tables(const Params& p);
__device__ __forceinline__ void phase_prologue(const Params& p, LAS unsigned char* lds) {
    const int tid = otid(); LAS float* lf = (LAS float*)lds;
    { const size_t gt = (size_t)blockIdx.x * NTHREADS + tid, GT = (size_t)gridDim.x * NTHREADS;
      for (int l = 0; l < NLAYER; ++l) {
          u32x4* z1 = (u32x4*)((bf16_t*)(p.ws + O_WIN) + ((size_t)l * NP + IN_COLS) * DM); const size_t n1 = (size_t)(NP - IN_COLS) * DM * 2 / 16;
          for (size_t i = gt; i < n1; i += GT) z1[i] = (u32x4){0u, 0u, 0u, 0u};
          u32x4* z2 = (u32x4*)((bf16_t*)(p.ws + O_WUQ) + ((size_t)l * NQP + 1152) * 768); const size_t n2 = (size_t)(NQP - 1152) * 768 * 2 / 16;
          for (size_t i = gt; i < n2; i += GT) z2[i] = (u32x4){0u, 0u, 0u, 0u};
      } }
    rope_tables(p);
    adaln_tasks(p, lf);
    for (int t = blockIdx.x; t < 544; t += gridDim.x) { if (t < 512) hyf_task(p, t >> 8, 0, (t & 255) * 8, lf); else hyf_task(p, 0, 1, (t - 512) * 8, lf); }
    { const int lane = tid & 63, gw = blockIdx.x * 8 + owid(), GW = gridDim.x * 8;
      for (int t = gw; t < NLAYER * CVT_SMALL; t += GW) cvt_small_task(p, t / CVT_SMALL, t % CVT_SMALL, lane); }
    cvt_exp_all(p, 0);
}

__device__ __forceinline__ void norm1_row(const Params& p, int l, int row, const float (&x)[32], int lane) {
    float ss = 0.f;
#pragma unroll
    for (int i = 0; i < 32; ++i) ss += x[i] * x[i];
    ss = wave_sum(ss); const float rstd = rsqrtf(ss * (1.0f / DM) + EPS);
    const float* g = p.in[I_NORMG] + (size_t)(l * 4 + 0) * DM; const float* mod = (const float*)(p.ws + O_MOD) + (size_t)(l * 9 + row_batch(row)) * 12288;
    bf16_t* H = (bf16_t*)(p.ws + O_H) + (size_t)row * DM;
#pragma unroll
    for (int j = 0; j < 8; ++j) { const int c = ROWCOL(j, lane); const f32x4 gv = *(const f32x4*)(g + c), sh = *(const f32x4*)(mod + c), sc = *(const f32x4*)(mod + DM + c); float h[4];
#pragma unroll
        for (int q = 0; q < 4; ++q) h[q] = x[j * 4 + q] * rstd * gv[q] * (1.0f + sc[q]) + sh[q];
        u32x2 w; w.x = pk2(h[0], h[1]); w.y = pk2(h[2], h[3]); *(u32x2*)(H + c) = w; }
}
__device__ __forceinline__ void phase_norm1(const Params& p, int l) {
    const int lane = otid() & 63, gw = blockIdx.x * 8 + owid(), GW = gridDim.x * 8;
    const int lane0 = lane;
    for (int row = gw; row < NTOK; row += GW) { int lane = lane0; asm volatile("" : "+v"(lane)); const float* src = resid_src(p, l, row); float x[32];
#pragma unroll
        for (int j = 0; j < 8; ++j) { const f32x4 v = *(const f32x4*)(src + ROWCOL(j, lane)); x[j * 4] = v[0]; x[j * 4 + 1] = v[1]; x[j * 4 + 2] = v[2]; x[j * 4 + 3] = v[3]; }
        norm1_row(p, l, row, x, lane); }
}

__device__ __forceinline__ void rope_tables(const Params& p) {
    float* T = (float*)(p.ws + O_ROPE);
    for (int i = blockIdx.x * NTHREADS + otid(); i < 64 * 32 + 64 * 16; i += gridDim.x * NTHREADS) {
        float a; if (i < 64 * 32) a = (float)(i >> 5) * exp2f(-(float)(i & 31) * (13.287712379549449f / 32.0f)); else { const int q = i - 64 * 32; a = (float)(q >> 4) * exp2f(-(float)(q & 15) * (13.287712379549449f / 16.0f)); }
        float sn, cs; sincosf(a, &sn, &cs); T[2 * i] = cs; T[2 * i + 1] = sn; }
}
__device__ __forceinline__ void unpack8(const u32x4 v, float (&x)[8]) {
#pragma unroll
    for (int j = 0; j < 4; ++j) { x[2 * j] = __uint_as_float(v[j] << 16); x[2 * j + 1] = __uint_as_float(v[j] & 0xffff0000u); }
}
__device__ __forceinline__ u32x4 pack8(const float (&x)[8]) { u32x4 w; w.x = pk2(x[0], x[1]); w.y = pk2(x[2], x[3]); w.z = pk2(x[4], x[5]); w.w = pk2(x[6], x[7]); return w; }
template <int PX> __device__ __forceinline__ void rope8(float (&x)[8], const float* cs, bool second) {
#pragma unroll
    for (int j = 0; j < 8; ++j) { const float pr = __shfl_xor(x[j], PX), c = cs[2 * j], sn = cs[2 * j + 1]; x[j] = second ? pr * sn + x[j] * c : x[j] * c - pr * sn; }
}
__device__ __forceinline__ void gqa_post_row(const Params& p, int l, int row, int lane) {
    const bf16_t* P = (const bf16_t*)(p.ws + O_P) + (size_t)row * NP;
    const bool isctx = row >= NLAT; const int b = isctx ? (row - NLAT) >> 8 : row >> 11, t = isctx ? (row - NLAT) & 255 : row & 2047;
    const int j = lane & 15, hq = lane >> 4, half = j >> 3; const bool second = (j >> 2) & 1;
    const float* cs = (const float*)(p.ws + O_ROPE) + ((size_t)(half ? (t & 63) : (t >> 6)) * 32 + 8 * (j & 3)) * 2;
    const int kpos = isctx ? t : CTXL + t;
#pragma unroll
    for (int ps = 0; ps < 2; ++ps) {
        const bool isk = (ps == 1) && (hq >= 2); const int h = (ps == 0) ? hq : (isk ? hq - 2 : 4 + hq);
        const bf16_t* src = P + (isk ? C_GK : C_GQ) + h * 128 + 8 * j; const float* gn = (isk ? p.in[I_GKN] : p.in[I_GQN]) + l * 128 + 8 * j;
        float x[8]; unpack8(*(const u32x4*)src, x);
        float ss = 0.f;
#pragma unroll
        for (int q = 0; q < 8; ++q) ss += x[q] * x[q];
        ss += __shfl_xor(ss, 1); ss += __shfl_xor(ss, 2); ss += __shfl_xor(ss, 4); ss += __shfl_xor(ss, 8);
        const float rstd = rsqrtf(ss * (1.0f / 128.0f) + EPS); const f32x4 g0 = *(const f32x4*)gn, g1 = *(const f32x4*)(gn + 4);
#pragma unroll
        for (int q = 0; q < 4; ++q) { x[q] *= rstd * g0[q]; x[4 + q] *= rstd * g1[q]; }
        if (!isctx) rope8<4>(x, cs, second);
        bf16_t* dst = isk ? (bf16_t*)(p.ws + O_KG) + ((size_t)(b * 2 + h) * LK + kpos) * 128
                          : (isctx ? (bf16_t*)(p.ws + O_QGC) + ((size_t)(b * 6 + h) * CTXL + t) * 128 : (bf16_t*)(p.ws + O_QG) + ((size_t)(b * 6 + h) * SEQ + t) * 128);
        *(u32x4*)(dst + 8 * j) = pack8(x);
    }
    if (lane < 32) { const int h = lane >> 4; *(u32x4*)((bf16_t*)(p.ws + O_VG) + ((size_t)(b * 2 + h) * LK + kpos) * 128 + 8 * j) = *(const u32x4*)(P + C_GV + h * 128 + 8 * j); }
}
__device__ __forceinline__ void seq_of(int row, int& s0, int& n) { if (row < NLAT) { s0 = row & ~2047; n = SEQ; } else { s0 = NLAT + ((row - NLAT) & ~255); n = CTXL; } }
__device__ __forceinline__ void load_conv_tile(const bf16_t* P, int t0, int pc0, LAS float* u) {
    int s0, n; seq_of(t0, s0, n);
    for (int i = otid(); i < 66 * 8; i += NTHREADS) { const int r = i >> 3, c = (i & 7) * 8, row = t0 - 1 + r;
        float x[8];
        if (row >= s0 && row < s0 + n) { const u32x4 v = *(const u32x4*)(P + (size_t)row * NP + pc0 + c);
#pragma unroll
            for (int j = 0; j < 4; ++j) { x[2 * j] = __uint_as_float(v[j] << 16); x[2 * j + 1] = __uint_as_float(v[j] & 0xffff0000u); } }
        else {
#pragma unroll
            for (int j = 0; j < 8; ++j) x[j] = 0.f; }
#pragma unroll
        for (int j = 0; j < 8; ++j) u[r * 65 + c + j] = x[j]; }
}
__device__ __forceinline__ void hy_prep_task(const Params& p, int l, int t0, int c0, LAS float* u) {
    const bf16_t* P = (const bf16_t*)(p.ws + O_P);
    load_conv_tile(P, t0, c0, u);
    __syncthreads();
    const int tid = otid(), c = tid >> 3, tc = (tid & 7) * 8; const float* cw = p.in[I_HYCONV] + (size_t)l * 3 * 1536 + c0 + c;
    const float w0 = cw[0], w1 = cw[1536], w2 = cw[3072]; float y[8];
#pragma unroll
    for (int j = 0; j < 8; ++j) y[j] = w0 * u[(tc + j) * 65 + c] + w1 * u[(tc + j + 1) * 65 + c] + w2 * u[(tc + j + 2) * 65 + c];
    const int ch = c0 + c; bf16_t* dst = (ch < 512 ? (bf16_t*)(p.ws + O_VT) + (size_t)ch * NTOK : (bf16_t*)(p.ws + O_X1T) + (size_t)(ch - 512) * NTOK) + t0 + tc;
    u32x4 w; w.x = pk2(y[0], y[1]); w.y = pk2(y[2], y[3]); w.z = pk2(y[4], y[5]); w.w = pk2(y[6], y[7]); *(u32x4*)dst = w;
    __syncthreads();
}
__device__ __forceinline__ void mla_post_row(const Params& p, int l, int row, int lane) {
    const bf16_t* P = (const bf16_t*)(p.ws + O_P) + (size_t)row * NP;
    const bool isctx = row >= NLAT; const int b = isctx ? (row - NLAT) >> 8 : row >> 11, t = isctx ? (row - NLAT) & 255 : row & 2047;
    float sq = 0.f, skv = 0.f; float x[8];
    unpack8(*(const u32x4*)(P + C_CQ + 8 * lane), x);
#pragma unroll
    for (int q = 0; q < 8; ++q) sq += x[q] * x[q];
    if (lane < 32) { unpack8(*(const u32x4*)(P + C_CQ + 512 + 8 * lane), x);
#pragma unroll
        for (int q = 0; q < 8; ++q) sq += x[q] * x[q];
        unpack8(*(const u32x4*)(P + C_CKV + 8 * lane), x);
#pragma unroll
        for (int q = 0; q < 8; ++q) skv += x[q] * x[q]; }
    const float rq = rsqrtf(wave_sum(sq) * (1.0f / 768.0f) + EPS), rkv = rsqrtf(wave_sum(skv) * (1.0f / 256.0f) + EPS);
    const bf16_t* QR = (const bf16_t*)(p.ws + O_QRAW) + (size_t)row * NQP; const bf16_t* KV = (const bf16_t*)(p.ws + O_KVRAW) + (size_t)row * 1536;
    const int kpos = isctx ? t : CTXL + t;
    const float* RM = (const float*)(p.ws + O_ROPE) + 64 * 32 * 2;
#pragma unroll
    for (int ps = 0; ps < 3; ++ps) { const int id = ps * 64 + lane; const bool act = id < 144; const int h = act ? id / 24 : 0, cj = act ? id % 24 : 0, rc = cj - 16;
        unpack8(*(const u32x4*)(QR + h * 192 + 8 * cj), x);
#pragma unroll
        for (int q = 0; q < 8; ++q) x[q] *= rq;
        if (!isctx) { const int rcc = rc < 0 ? 0 : rc; const float* cs = RM + ((size_t)((rcc >> 2) ? (t & 63) : (t >> 6)) * 16 + 8 * (rcc & 1)) * 2; float y[8];
#pragma unroll
            for (int q = 0; q < 8; ++q) y[q] = x[q];
            rope8<2>(y, cs, (rcc >> 1) & 1);
            if (rc >= 0) {
#pragma unroll
                for (int q = 0; q < 8; ++q) x[q] = y[q]; } }
        bf16_t* qd = isctx ? (bf16_t*)(p.ws + O_QMC) + ((size_t)(b * 6 + h) * CTXL + t) * 192 : (bf16_t*)(p.ws + O_QM) + ((size_t)(b * 6 + h) * SEQ + t) * 192;
        if (act) *(u32x4*)(qd + 8 * cj) = pack8(x); }
#pragma unroll
    for (int ps = 0; ps < 3; ++ps) { const int id = ps * 64 + lane, h = id >> 5, c = id & 31;
        unpack8(*(const u32x4*)(KV + h * 256 + 8 * c), x);
#pragma unroll
        for (int q = 0; q < 8; ++q) x[q] *= rkv;
        bf16_t* d = (c < 16) ? (bf16_t*)(p.ws + O_KM) + ((size_t)(b * 6 + h) * LK + kpos) * 192 + 8 * c : (bf16_t*)(p.ws + O_VM) + ((size_t)(b * 6 + h) * LK + kpos) * 128 + 8 * (c - 16);
        *(u32x4*)d = pack8(x); }
    { const int h = lane >> 3, rc = lane & 7; unpack8(*(const u32x4*)(P + C_KR + 8 * rc), x);
      if (!isctx) { const float* cs = RM + ((size_t)((rc >> 2) ? (t & 63) : (t >> 6)) * 16 + 8 * (rc & 1)) * 2; rope8<2>(x, cs, (rc >> 1) & 1); }
      if (lane < 48) *(u32x4*)((bf16_t*)(p.ws + O_KM) + ((size_t)(b * 6 + h) * LK + kpos) * 192 + 128 + 8 * rc) = pack8(x); }
}

__device__ __forceinline__ void hyconv_unit_valu(const Params& p, int l, int nset, int c, LAS float* lf) {
    const int tid = otid(), n = nset ? CTXL : SEQ, tokbase = nset ? NLAT : 0;
    LAS float* kc = lf; LAS float* z = lf + 4096; LAS float* z2 = z + 8 * SEQ;
    const float* HF = (const float*)(p.ws + O_HF) + (size_t)l * HF_LAYER + (nset ? HF_L0 : 0); const float* HSS = (const float*)(p.ws + O_HSS) + (size_t)((l * 2 + nset) * 2) * 512;
    const bf16_t* VT = (const bf16_t*)(p.ws + O_VT) + (size_t)c * NTOK + tokbase; const bf16_t* X1T = (const bf16_t*)(p.ws + O_X1T) + (size_t)c * NTOK + tokbase;
    bf16_t* Y2T = (bf16_t*)(p.ws + O_Y2T) + (size_t)c * NTOK + tokbase;
    for (int i = tid; i < 8 * n; i += NTHREADS) z[i] = bf2f(VT[i]);
    for (int ord = 0; ord < 2; ++ord) {
        const float rs = rsqrtf(HSS[ord * 512 + c] + EPS); const float* hf = HF + (size_t)((ord * 2 + 0) * 512 + c) * n; const float* hb = HF + (size_t)((ord * 2 + 1) * 512 + c) * n;
        for (int m = tid; m < 2 * n; m += NTHREADS) { const int lag = m - (n - 1); kc[m] = (m == 2 * n - 1) ? 0.f : (lag >= 0 ? hf[lag] : hb[-lag]) * rs; }
        __syncthreads();
        const LAS float* zs = ord ? z2 : z; const float skip = p.in[I_HYSKIP][(size_t)(l * 2 + ord) * 512 + c];
        for (int q = tid; q < n; q += NTHREADS) {
            const int b = q / (n >> 3), t0 = (q % (n >> 3)) * 8; float acc[8];
#pragma unroll
            for (int j = 0; j < 8; ++j) acc[j] = 0.f;
            const LAS float* zb = zs + b * n;
            for (int sb = 0; sb < n; sb += 8) {
                const LAS float* kb = kc + (t0 - sb + n - 8); float w[16];
#pragma unroll
                for (int i = 0; i < 4; ++i) { const f32x4 v = *(const LAS f32x4*)(kb + 4 * i); w[4 * i] = v[0]; w[4 * i + 1] = v[1]; w[4 * i + 2] = v[2]; w[4 * i + 3] = v[3]; }
                const f32x4 za = *(const LAS f32x4*)(zb + sb), zc = *(const LAS f32x4*)(zb + sb + 4); const float zv[8] = {za[0], za[1], za[2], za[3], zc[0], zc[1], zc[2], zc[3]};
#pragma unroll
                for (int ss = 0; ss < 8; ++ss)
#pragma unroll
                    for (int j = 0; j < 8; ++j) acc[j] += w[j - ss + 7] * zv[ss];
            }
            if (ord == 0) {
#pragma unroll
                for (int j = 0; j < 8; ++j) { const int idx = b * n + t0 + j; z2[idx] = bf2f(X1T[idx]) * (acc[j] + skip * z[idx]); }
            } else { float y[8];
#pragma unroll
                for (int j = 0; j < 8; ++j) y[j] = acc[j] + skip * z2[b * n + t0 + j];
                u32x4 w; w.x = pk2(y[0], y[1]); w.y = pk2(y[2], y[3]); w.z = pk2(y[4], y[5]); w.w = pk2(y[6], y[7]); *(u32x4*)(Y2T + b * n + t0) = w; }
        }
        __syncthreads();
    }
}
constexpr int HC_COPYB = 8256, HC_ROWB = 4560, HC_PAD = 112, HC_KR = 4112, HC_M0 = 2064;
constexpr int HC_ZOFF = 8 * HC_COPYB, HC_Z2OFF = HC_ZOFF + 8 * HC_ROWB;
__device__ __forceinline__ void hyconv_unit_mfma(const Params& p, int l, int c, LAS unsigned char* lds) {
    const int tid = otid(), wid = __builtin_amdgcn_readfirstlane(tid >> 6), lane = tid & 63;
    LAS unsigned char* CP = lds; LAS unsigned char* Zr = lds + HC_ZOFF; LAS unsigned char* Z2r = lds + HC_Z2OFF;
    const float* HF = (const float*)(p.ws + O_HF) + (size_t)l * HF_LAYER; const float* HSS = (const float*)(p.ws + O_HSS) + (size_t)(l * 4) * 512;
    const bf16_t* VT = (const bf16_t*)(p.ws + O_VT) + (size_t)c * NTOK; const bf16_t* X1T = (const bf16_t*)(p.ws + O_X1T) + (size_t)c * NTOK; bf16_t* Y2T = (bf16_t*)(p.ws + O_Y2T) + (size_t)c * NTOK;
    for (int q = tid; q < 8 * 256; q += NTHREADS) { const int b = q >> 8, ch = q & 255; *(LAS u32x4*)(Zr + b * HC_ROWB + (HC_PAD + ch * 8) * 2) = *(const u32x4*)(VT + b * SEQ + ch * 8); }
    for (int q = tid; q < 8 * 29; q += NTHREADS) { const int b = q / 29, ch = q % 29; const int e0 = ch < 14 ? ch * 8 : HC_PAD + SEQ + (ch - 14) * 8; *(LAS u32x4*)(Zr + b * HC_ROWB + e0 * 2) = (u32x4){0u, 0u, 0u, 0u}; }
    const int a = lane & 31, kg = lane >> 5, bq = a >> 2, isub = a & 3;
    const int Aoff = (a & 7) * HC_COPYB + (HC_M0 - 8 * (a >> 3) + 8 * kg) * 2;
    const int g0 = 2 * wid;
    const int Boff = bq * HC_ROWB + (HC_PAD + 128 * g0 + 32 * isub + 8 * kg) * 2;
    for (int ord = 0; ord < 2; ++ord) {
        LAS float* kr = (LAS float*)(ord == 0 ? Z2r : Zr);
        { const float rs = rsqrtf(HSS[ord * 512 + c] + EPS); const float* hf = HF + (size_t)((ord * 2 + 0) * 512 + c) * SEQ; const float* hb = HF + (size_t)((ord * 2 + 1) * 512 + c) * SEQ;
          for (int m = tid; m < HC_KR; m += NTHREADS) { const int lag = HC_M0 - m; float v = 0.f; if (lag >= 0 && lag < SEQ) v = hf[lag] * rs; else if (lag < 0 && lag > -SEQ) v = hb[-lag] * rs; kr[m] = v; } }
        __syncthreads();
        for (int q = tid; q < 8 * 516; q += NTHREADS) { const int sft = q / 516, ch = q % 516; float v[8];
#pragma unroll
            for (int j = 0; j < 8; ++j) { const int m = ch * 8 + j - sft; v[j] = (m >= 0 && m < HC_KR) ? kr[m] : 0.f; }
            u32x4 w; w.x = pk2(v[0], v[1]); w.y = pk2(v[2], v[3]); w.z = pk2(v[4], v[5]); w.w = pk2(v[6], v[7]); *(LAS u32x4*)(CP + sft * HC_COPYB + ch * 16) = w; }
        __syncthreads();
        if (ord == 0) for (int q = tid; q < 8 * 29; q += NTHREADS) { const int b = q / 29, ch = q % 29; const int e0 = ch < 14 ? ch * 8 : HC_PAD + SEQ + (ch - 14) * 8; *(LAS u32x4*)(Z2r + b * HC_ROWB + e0 * 2) = (u32x4){0u, 0u, 0u, 0u}; }
        const LAS unsigned char* Zs = ord ? Z2r : Zr;
        f32x16 acc0 = {}, acc1 = {};
        const int e_lo = 16 * wid - 127, e_mid0 = 16 * wid - 119, e_mid1 = 16 * wid + 7, e_hi = 16 * wid + 15;
        for (int e = e_lo; e < e_mid0; ++e) { const bf16x8 A = *(const LAS bf16x8*)(CP + Aoff - 32 * e); const bf16x8 B0 = *(const LAS bf16x8*)(Zs + Boff - 32 * e);
            acc0 = __builtin_amdgcn_mfma_f32_32x32x16_bf16(A, B0, acc0, 0, 0, 0); }
#pragma unroll 2
        for (int e = e_mid0; e <= e_mid1; ++e) { const bf16x8 A = *(const LAS bf16x8*)(CP + Aoff - 32 * e); const bf16x8 B0 = *(const LAS bf16x8*)(Zs + Boff - 32 * e); const bf16x8 B1 = *(const LAS bf16x8*)(Zs + Boff + 256 - 32 * e);
            acc0 = __builtin_amdgcn_mfma_f32_32x32x16_bf16(A, B0, acc0, 0, 0, 0); acc1 = __builtin_amdgcn_mfma_f32_32x32x16_bf16(A, B1, acc1, 0, 0, 0); }
        for (int e = e_mid1 + 1; e <= e_hi; ++e) { const bf16x8 A = *(const LAS bf16x8*)(CP + Aoff - 32 * e); const bf16x8 B1 = *(const LAS bf16x8*)(Zs + Boff + 256 - 32 * e);
            acc1 = __builtin_amdgcn_mfma_f32_32x32x16_bf16(A, B1, acc1, 0, 0, 0); }
        const float skip = p.in[I_HYSKIP][(size_t)(l * 2 + ord) * 512 + c];
#pragma unroll
        for (int gi = 0; gi < 2; ++gi) {
#pragma unroll
            for (int q = 0; q < 4; ++q) { const int t = 128 * (g0 + gi) + 32 * isub + 8 * q + 4 * kg; float y[4];
#pragma unroll
                for (int j = 0; j < 4; ++j) y[j] = gi ? acc1[4 * q + j] : acc0[4 * q + j];
                const u32x2 zz = *(const LAS u32x2*)(Zs + bq * HC_ROWB + (HC_PAD + t) * 2);
                const float z0 = __uint_as_float(zz.x << 16), z1 = __uint_as_float(zz.x & 0xffff0000u), z2 = __uint_as_float(zz.y << 16), z3 = __uint_as_float(zz.y & 0xffff0000u);
                y[0] += skip * z0; y[1] += skip * z1; y[2] += skip * z2; y[3] += skip * z3;
                if (ord == 0) { const u32x2 xx = *(const u32x2*)(X1T + bq * SEQ + t);
                    y[0] *= __uint_as_float(xx.x << 16); y[1] *= __uint_as_float(xx.x & 0xffff0000u); y[2] *= __uint_as_float(xx.y << 16); y[3] *= __uint_as_float(xx.y & 0xffff0000u);
                    u32x2 w; w.x = pk2(y[0], y[1]); w.y = pk2(y[2], y[3]); *(LAS u32x2*)(Z2r + bq * HC_ROWB + (HC_PAD + t) * 2) = w; }
                else { u32x2 w; w.x = pk2(y[0], y[1]); w.y = pk2(y[2], y[3]); *(u32x2*)(Y2T + bq * SEQ + t) = w; } }
        }
        __syncthreads();
    }
}
__device__ __forceinline__ void hy_fin_task(const Params& p, int l, int t0, int c0, LAS float* u) {
    const bf16_t* P = (const bf16_t*)(p.ws + O_P); LAS float* y = u + 66 * 65;
    load_conv_tile(P, t0, 1024 + c0, u);
    const int tid = otid();
    { const int c = tid >> 3, tc = (tid & 7) * 8; const u32x4 v = *(const u32x4*)((const bf16_t*)(p.ws + O_Y2T) + (size_t)(c0 + c) * NTOK + t0 + tc);
#pragma unroll
      for (int j = 0; j < 4; ++j) { y[c * 65 + tc + 2 * j] = __uint_as_float(v[j] << 16); y[c * 65 + tc + 2 * j + 1] = __uint_as_float(v[j] & 0xffff0000u); } }
    __syncthreads();
    { const int t = tid >> 3, cc = (tid & 7) * 8; const float* cw = p.in[I_HYCONV] + (size_t)l * 3 * 1536 + 1024 + c0 + cc; float o[8];
#pragma unroll
      for (int j = 0; j < 8; ++j) { const int c = cc + j; const float x2 = cw[j] * u[t * 65 + c] + cw[1536 + j] * u[(t + 1) * 65 + c] + cw[3072 + j] * u[(t + 2) * 65 + c]; o[j] = x2 * y[c * 65 + t]; }
      u32x4 w; w.x = pk2(o[0], o[1]); w.y = pk2(o[2], o[3]); w.z = pk2(o[4], o[5]); w.w = pk2(o[6], o[7]);
      *(u32x4*)((bf16_t*)(p.ws + O_MIX) + (size_t)(t0 + t) * DM + c0 + cc) = w; }
    __syncthreads();
}

__device__ __forceinline__ void mla_unit(const Params& p, int b, int h, int qb, bool ctxq, LAS unsigned char* lds) {
    unsigned char* ws = p.ws;
    const bf16_t* Q = ctxq ? (const bf16_t*)(ws + O_QMC) + (size_t)(b * 6 + h) * CTXL * 192 : (const bf16_t*)(ws + O_QM) + ((size_t)(b * 6 + h) * SEQ + qb * 256) * 192;
    bf16_t* O = (bf16_t*)(ws + O_MIX) + (size_t)(ctxq ? NLAT + b * CTXL : b * SEQ + qb * 256) * DM + 512 + h * 128;
    attn_body<192, 0>(Q, (const bf16_t*)(ws + O_KM) + (size_t)(b * 6 + h) * LK * 192, (const bf16_t*)(ws + O_VM) + (size_t)(b * 6 + h) * LK * 128, O, DM, ctxq ? CTXL : LK, 0.07216878364870322f, (char*)lds);
}
__device__ __forceinline__ void gqa_unit(const Params& p, int b, int h, int qb, bool ctxq, LAS unsigned char* lds) {
    unsigned char* ws = p.ws;
    const bf16_t* Q = ctxq ? (const bf16_t*)(ws + O_QGC) + (size_t)(b * 6 + h) * CTXL * 128 : (const bf16_t*)(ws + O_QG) + ((size_t)(b * 6 + h) * SEQ + qb * 256) * 128;
    bf16_t* O = (bf16_t*)(ws + O_MIX) + (size_t)(ctxq ? NLAT + b * CTXL : b * SEQ + qb * 256) * DM + 1280 + h * 128;
    attn_body<128, GQA_SD>(Q, (const bf16_t*)(ws + O_KG) + (size_t)(b * 2 + h / 3) * LK * 128, (const bf16_t*)(ws + O_VG) + (size_t)(b * 2 + h / 3) * LK * 128, O, DM, ctxq ? CTXL : LK, 0.08838834764831845f, (char*)lds);
}
__device__ __forceinline__ void phase_mixer(const Params& p, int l, LAS unsigned char* lds) {
    const int G = gridDim.x, bid = blockIdx.x; const bool last = (l == NLAYER - 1);
    for (int u = bid; u < 384 + (last ? 0 : 48); u += G) { if (u < 384) mla_unit(p, u / 48, (u >> 3) % 6, u & 7, false, lds); else mla_unit(p, (u - 384) / 6, (u - 384) % 6, 0, true, lds); }
    for (int u = (bid + G / 2) % G; u < 384 + (last ? 0 : 48); u += G) { if (u < 384) gqa_unit(p, u / 48, (u >> 3) % 6, u & 7, false, lds); else gqa_unit(p, (u - 384) / 6, (u - 384) % 6, 0, true, lds); }
#ifndef CONV_REP
#define CONV_REP 1
#endif
    for (int rep = 0; rep < CONV_REP; ++rep) {
#if HY_MFMA
    for (int u = bid; u < 512; u += G) hyconv_unit_mfma(p, l, u, lds);
    if (!last) for (int u = bid; u < 512; u += G) hyconv_unit_valu(p, l, 1, u, (LAS float*)lds);
#else
    for (int u = bid; u < (last ? 512 : 1024); u += G) hyconv_unit_valu(p, l, u >> 9, u & 511, (LAS float*)lds);
#endif
    }
}

constexpr int RT_FS = DM + 4;
__device__ __forceinline__ void route_row_pre(const Params& p, int l, int row, int lane, LAS float* fdst, const float* g1, const float* g2) {
    const float* mod = (const float*)(p.ws + O_MOD) + (size_t)(l * 9 + row_batch(row)) * 12288;
    const bf16_t* O = (const bf16_t*)(p.ws + O_OUT) + (size_t)row * DM; const float* rs = resid_src(p, l, row); float* X = (float*)(p.ws + O_X) + (size_t)row * DM; bf16_t* H = (bf16_t*)(p.ws + O_H) + (size_t)row * DM;
    float o[32], x[32]; float ss = 0.f;
#pragma unroll
    for (int j = 0; j < 8; ++j) { const u32x2 v = *(const u32x2*)(O + ROWCOL(j, lane)); o[j * 4] = __uint_as_float(v.x << 16); o[j * 4 + 1] = __uint_as_float(v.x & 0xffff0000u); o[j * 4 + 2] = __uint_as_float(v.y << 16); o[j * 4 + 3] = __uint_as_float(v.y & 0xffff0000u); }
#pragma unroll
    for (int i = 0; i < 32; ++i) ss += o[i] * o[i];
    const float r1 = rsqrtf(wave_sum(ss) * (1.0f / DM) + EPS); float s2 = 0.f;
#pragma unroll
    for (int j = 0; j < 8; ++j) { const int c = ROWCOL(j, lane); const f32x4 xv = *(const f32x4*)(rs + c), gv = *(const f32x4*)(g1 + c), ga = *(const f32x4*)(mod + 2 * DM + c); f32x4 xn;
#pragma unroll
        for (int q = 0; q < 4; ++q) { xn[q] = xv[q] + ga[q] * (o[j * 4 + q] * r1 * gv[q]); x[j * 4 + q] = xn[q]; s2 += xn[q] * xn[q]; }
        *(f32x4*)(X + c) = xn; }
    const float r2 = rsqrtf(wave_sum(s2) * (1.0f / DM) + EPS);
#pragma unroll
    for (int j = 0; j < 8; ++j) { const int c = ROWCOL(j, lane); const f32x4 gv = *(const f32x4*)(g2 + c), sh = *(const f32x4*)(mod + 3 * DM + c), sc = *(const f32x4*)(mod + 4 * DM + c); f32x4 f;
#pragma unroll
        for (int q = 0; q < 4; ++q) f[q] = x[j * 4 + q] * r2 * gv[q] * (1.0f + sc[q]) + sh[q];
#if MOE_FP8
        *(unsigned*)((unsigned char*)(p.ws + O_H) + (size_t)row * DM + c) = pk4_fp8(f[0], f[1], f[2], f[3]);
#else
        u32x2 w; w.x = pk2(f[0], f[1]); w.y = pk2(f[2], f[3]); *(u32x2*)(H + c) = w;
#endif
        *(LAS f32x4*)(fdst + c) = f; }
}
__device__ __forceinline__ void route_row_topk(const Params& p, int l, int row, int lane, float logit, LAS unsigned* cntL) {
    const float score = 1.0f / (1.0f + expf(-logit)), biased = score + p.in[I_RB][l * 64 + lane];
    float m1 = biased; m1 = fmaxf(m1, __shfl_xor(m1, 1)); m1 = fmaxf(m1, __shfl_xor(m1, 2)); m1 = fmaxf(m1, __shfl_xor(m1, 4));
    const unsigned long long bal = __ballot(biased == m1); const int first = __builtin_ctz((unsigned)((bal >> (lane & ~7)) & 0xffull));
    float m2 = ((lane & 7) == first) ? -INFINITY : biased; m2 = fmaxf(m2, __shfl_xor(m2, 1)); m2 = fmaxf(m2, __shfl_xor(m2, 2)); m2 = fmaxf(m2, __shfl_xor(m2, 4));
    const float gs = m1 + m2; const int grp = lane >> 3; int rank = 0;
#pragma unroll
    for (int q = 0; q < 8; ++q) { const float v = rdlane(gs, q * 8); rank += (v > gs || (v == gs && q < grp)) ? 1 : 0; }
    const float cand = (rank < 4) ? biased : -INFINITY; int re = 0;
    for (int q = 0; q < 64; ++q) { const float v = rdlane(cand, q); re += (v > cand || (v == cand && q < lane)) ? 1 : 0; }
    const bool sel = re < TOPK; const float ssum = wave_sum(sel ? score : 0.f);
    if (sel) { ((int*)(p.ws + O_EIDX))[(size_t)row * 8 + re] = lane; ((float*)(p.ws + O_GATE))[(size_t)row * 8 + re] = score / ssum * 2.5f;
        ((int*)(p.ws + O_SLOT))[(size_t)row * 8 + re] = (int)__hip_atomic_fetch_add(&cntL[lane], 1u, __ATOMIC_RELAXED, __HIP_MEMORY_SCOPE_WORKGROUP); }
}
__device__ __forceinline__ void phase_route(const Params& p, int l, LAS unsigned char* lds) {
    const int tid = otid(), wid = __builtin_amdgcn_readfirstlane(tid >> 6), lane0 = tid & 63; const bool last = (l == NLAYER - 1); const int NR = last ? NLAT : NTOK;
    LAS float* frow = (LAS float*)lds; LAS float* part = frow;
    const float* g1 = p.in[I_NORMG] + (size_t)(l * 4 + 1) * DM; const float* g2 = p.in[I_NORMG] + (size_t)(l * 4 + 2) * DM;
    const float* RW = p.in[I_RW] + (size_t)l * DM * NEXP; LAS unsigned* cntL = (LAS unsigned*)(lds + LDS_CNTL);
    if (tid < 64) cntL[tid] = 0u;
    { int* stok = (int*)(p.ws + O_STOK); for (int i = blockIdx.x * NTHREADS + tid; i < NSLOTS; i += gridDim.x * NTHREADS) stok[i] = (i < RSLOTS) ? -1 : ((i - RSLOTS) < NR ? i - RSLOTS : -1); }
    for (int g = blockIdx.x; g < NR / 16; g += gridDim.x) {
        int lane = lane0; asm volatile("" : "+v"(lane));
        for (int rr = 0; rr < 2; ++rr) route_row_pre(p, l, g * 16 + wid * 2 + rr, lane, frow + (wid * 2 + rr) * RT_FS, g1, g2);
        __syncthreads();
        f32x4 acc[4];
#pragma unroll
        for (int j = 0; j < 4; ++j) acc[j] = (f32x4){0.f, 0.f, 0.f, 0.f};
        { const int r16 = lane & 15, kq = lane >> 4; const LAS float* fa = frow + r16 * RT_FS + wid * 256 + 4 * kq; const float* rb = RW + (size_t)(wid * 256 + 4 * kq) * 64 + 4 * r16;
#pragma unroll 2
          for (int st = 0; st < 16; ++st) { const f32x4 a = *(const LAS f32x4*)(fa + 16 * st); f32x4 b[4];
#pragma unroll
              for (int i = 0; i < 4; ++i) b[i] = *(const f32x4*)(rb + (size_t)(16 * st + i) * 64);
#pragma unroll
              for (int i = 0; i < 4; ++i)
#pragma unroll
                  for (int j = 0; j < 4; ++j) acc[j] = __builtin_amdgcn_mfma_f32_16x16x4f32(a[i], b[i][j], acc[j], 0, 0, 0); }
          __syncthreads();
#pragma unroll
          for (int r = 0; r < 4; ++r) *(LAS f32x4*)(part + (wid * 16 + 4 * kq + r) * 64 + 4 * r16) = (f32x4){acc[0][r], acc[1][r], acc[2][r], acc[3][r]}; }
        __syncthreads();
        for (int rr = 0; rr < 2; ++rr) { const int r16 = wid * 2 + rr; float logit = 0.f;
#pragma unroll
            for (int w = 0; w < 8; ++w) logit += part[(w * 16 + r16) * 64 + lane];
            route_row_topk(p, l, g * 16 + r16, lane, logit, cntL); }
        __syncthreads();
    }
    __syncthreads();
    if (tid < 64) ((unsigned*)(p.ws + O_WCNT))[blockIdx.x * 64 + tid] = cntL[tid];
}
__device__ __forceinline__ void phase_place(const Params& p, int l, LAS unsigned char* lds) {
    const int tid = otid(); const int NR = (l == NLAYER - 1) ? NLAT : NTOK, G = gridDim.x;
    LAS int* woff = (LAS int*)lds; LAS int* csum = woff + 512 * 64; LAS int* pstart = csum + 8 * 64;
    const unsigned* wcnt = (const unsigned*)(p.ws + O_WCNT);
    for (int i = tid; i < G * 64; i += NTHREADS) woff[i] = (int)wcnt[i];
    __syncthreads();
    { const int e = tid & 63, ch = tid >> 6, cs = (G + 7) >> 3, w0 = ch * cs, w1 = (w0 + cs < G) ? w0 + cs : G; int run = 0;
      for (int w = w0; w < w1; ++w) { const int t = woff[w * 64 + e]; woff[w * 64 + e] = run; run += t; }
      csum[ch * 64 + e] = run;
      __syncthreads();
      int base = 0, tot = 0;
#pragma unroll
      for (int c2 = 0; c2 < 8; ++c2) { const int v = csum[c2 * 64 + e]; if (c2 < ch) base += v; tot += v; }
      for (int w = w0; w < w1; ++w) woff[w * 64 + e] += base;
      if (tid < 64) { const int ntile = (tot + 255) >> 8; pstart[tid] = (wave_incl_scan(ntile, tid) - ntile) * 256;
          if (blockIdx.x == 0) ((unsigned*)(p.ws + O_CTL))[CW_CNT + l * 64 + tid] = (unsigned)tot; } }
    __syncthreads();
    const int* eidx = (const int*)(p.ws + O_EIDX); int* slot = (int*)(p.ws + O_SLOT); int* stok = (int*)(p.ws + O_STOK);
    for (int i = blockIdx.x * NTHREADS + tid; i < NR * TOPK; i += G * NTHREADS) { const int row = i / TOPK, k = i % TOPK, e = eidx[(size_t)row * 8 + k], wg = (row >> 4) % G;
        const int s = pstart[e] + woff[wg * 64 + e] + slot[(size_t)row * 8 + k]; slot[(size_t)row * 8 + k] = s; stok[s] = row; }
    __syncthreads();
}
__device__ __forceinline__ void phase_final(const Params& p, int l) {
    const int lane = otid() & 63, gw = blockIdx.x * 8 + owid(), GW = gridDim.x * 8; const bool last = (l == NLAYER - 1); const int NR = last ? NLAT : NTOK;
    const bf16_t* DO = (const bf16_t*)(p.ws + O_DOUT); const float* g3 = p.in[I_NORMG] + (size_t)(l * 4 + 3) * DM;
    const int lane0 = lane;
    for (int row = gw; row < NR; row += GW) {
        int lane = lane0; asm volatile("" : "+v"(lane));
        const int sl = (lane < TOPK) ? ((const int*)(p.ws + O_SLOT))[(size_t)row * 8 + lane] : 0; const float gl = (lane < TOPK) ? ((const float*)(p.ws + O_GATE))[(size_t)row * 8 + lane] : 0.f;
        float y[32];
#pragma unroll
        for (int i = 0; i < 32; ++i) y[i] = 0.f;
#pragma unroll
        for (int kb = 0; kb < 7; kb += 4) {
            u32x2 v[4][8]; float gt[4];
#pragma unroll
            for (int kk = 0; kk < 4; ++kk) { const int k = kb + kk; if (k < 7) { const int s = (k == 0) ? RSLOTS + row : __builtin_amdgcn_readlane(sl, k - 1); const bf16_t* src = DO + (size_t)s * DM; gt[kk] = (k == 0) ? 1.0f : rdlane(gl, k - 1);
#pragma unroll
                for (int j = 0; j < 8; ++j) v[kk][j] = *(const u32x2*)(src + ROWCOL(j, lane)); } }
#pragma unroll
            for (int kk = 0; kk < 4; ++kk) { if (kb + kk < 7) {
#pragma unroll
                for (int j = 0; j < 8; ++j) { const float g = gt[kk]; y[j * 4] += g * __uint_as_float(v[kk][j].x << 16); y[j * 4 + 1] += g * __uint_as_float(v[kk][j].x & 0xffff0000u); y[j * 4 + 2] += g * __uint_as_float(v[kk][j].y << 16); y[j * 4 + 3] += g * __uint_as_float(v[kk][j].y & 0xffff0000u); } } }
        }
        float ss = 0.f;
#pragma unroll
        for (int i = 0; i < 32; ++i) ss += y[i] * y[i];
        const float r = rsqrtf(wave_sum(ss) * (1.0f / DM) + EPS); const float* mod = (const float*)(p.ws + O_MOD) + (size_t)(l * 9 + row_batch(row)) * 12288;
        float* X = (float*)(p.ws + O_X) + (size_t)row * DM; float x[32];
#pragma unroll
        for (int j = 0; j < 8; ++j) { const int c = ROWCOL(j, lane); const f32x4 xv = *(const f32x4*)(X + c), gv = *(const f32x4*)(g3 + c), gf = *(const f32x4*)(mod + 5 * DM + c); f32x4 xn;
#pragma unroll
            for (int q = 0; q < 4; ++q) { xn[q] = xv[q] + gf[q] * (y[j * 4 + q] * r * gv[q]); x[j * 4 + q] = xn[q]; }
            if (last) *(f32x4*)(p.out + (size_t)row * DM + c) = xn; else *(f32x4*)(X + c) = xn; }
        if (!last) norm1_row(p, l + 1, row, x, lane);
    }
}

#define XB_TMO      128
#define XB_XCNT(j)  (256  + 64 * (j))
#define XB_XSUB(j)  (1280 + 64 * (j))
#define XB_XGEN(j)  (2304 + 64 * (j))
#define XB_TOP      3328
#define XB_TOPGEN   3392
#define XCD_BAR_WORDS 3456
#define XB_SPIN_CAP (1u << 23)

__device__ __forceinline__ unsigned xb_ld(unsigned* p)              { return __hip_atomic_load(p, __ATOMIC_RELAXED, __HIP_MEMORY_SCOPE_AGENT); }
__device__ __forceinline__ unsigned xb_add(unsigned* p, unsigned v) { return __hip_atomic_fetch_add(p, v, __ATOMIC_RELAXED, __HIP_MEMORY_SCOPE_AGENT); }
__device__ __forceinline__ unsigned xb_xcc_id() { return (unsigned)__builtin_amdgcn_s_getreg((3 << 11) | 20) & 0xFu; }
#define XB_SPIN(cond, bar) do { unsigned _sp = 0; while (cond) { __builtin_amdgcn_s_sleep(1); \
    if ((++_sp & 255u) == 0u) { if (xb_ld(&(bar)[XB_TMO])) break; if (_sp > XB_SPIN_CAP) { atomicAdd(&(bar)[XB_TMO], 1u); break; } } } } while (0)

struct XcdBarrier {
    unsigned* bar; unsigned x;
    volatile LAS unsigned* st;
};

__device__ __forceinline__ XcdBarrier xcd_barrier_post(unsigned* bar, volatile LAS unsigned* st) {
    XcdBarrier b; b.bar = bar; b.x = xb_xcc_id(); b.st = st;
    if (threadIdx.x == 0) (void)xb_add(&bar[XB_XCNT(b.x)], 1u);
    return b;
}
__device__ __forceinline__ void xcd_barrier_complete(unsigned* bar, unsigned x, unsigned& nloc, unsigned& nx) {
    const unsigned G = gridDim.x * gridDim.y * gridDim.z;
    unsigned sum, cnt, mine, sp = 0u;
    for (;;) {
        sum = 0u; cnt = 0u; mine = 0u;
#pragma unroll
        for (unsigned j = 0; j < 16; ++j) { const unsigned c = xb_ld(&bar[XB_XCNT(j)]); sum += c; cnt += (c > 0u) ? 1u : 0u; mine = (j == x) ? c : mine; }
        if (sum == G) break;
        __builtin_amdgcn_s_sleep(1);
        if ((++sp & 255u) == 0u) { if (xb_ld(&bar[XB_TMO])) break; if (sp > XB_SPIN_CAP) { atomicAdd(&bar[XB_TMO], 1u); break; } }
    }
    nloc = mine > 0u ? mine : 1u; nx = cnt > 0u ? cnt : 1u;
}

__device__ __forceinline__ void xcd_barrier(const XcdBarrier& b) {
    asm volatile("s_waitcnt vmcnt(0)" ::: "memory");
    __syncthreads();
    if (threadIdx.x == 0) {
        unsigned* bar = b.bar;
        __builtin_amdgcn_s_waitcnt(0);
        unsigned nloc = b.st[0], nx = b.st[1];
        if (nloc == 0u) { xcd_barrier_complete(bar, b.x, nloc, nx); b.st[0] = nloc; b.st[1] = nx; }
        const unsigned old = xb_add(&bar[XB_XSUB(b.x)], 1u);
        const unsigned gen = old / nloc;
        if (old + 1u == (gen + 1u) * nloc) {
            __builtin_amdgcn_fence(__ATOMIC_RELEASE, "agent");
            asm volatile("s_waitcnt vmcnt(0)" ::: "memory");
            const unsigned og = xb_add(&bar[XB_TOP], 1u);
            const unsigned tg = og / nx;
            if (og + 1u == (tg + 1u) * nx) xb_add(&bar[XB_TOPGEN], 1u);
            else XB_SPIN(xb_ld(&bar[XB_TOPGEN]) == tg, bar);
            __builtin_amdgcn_fence(__ATOMIC_ACQUIRE, "agent");
            xb_add(&bar[XB_XGEN(b.x)], 1u);
            asm volatile("s_waitcnt vmcnt(0)" ::: "memory");
        } else {
            XB_SPIN(xb_ld(&bar[XB_XGEN(b.x)]) == gen, bar);
            __builtin_amdgcn_fence(__ATOMIC_ACQUIRE, "agent");
            asm volatile("s_waitcnt vmcnt(0)" ::: "memory");
        }
    }
    __syncthreads();
}


enum { PH_PRO = 0, PH_NORM1, PH_WIN, PH_POSTA, PH_POSTB, PH_MIXER, PH_HYFIN, PH_WOUT, PH_ROUTE, PH_PLACE, PH_GEMM1, PH_GEMM2, PH_FINAL, PH_COUNT };

template <int PH>
__device__ __forceinline__ void run_phase(const Params& p_in, int l, LAS unsigned char* lds) {
#if MEGA
    const __attribute__((address_space(4))) Params* kp = (const __attribute__((address_space(4))) Params*)__builtin_amdgcn_kernarg_segment_ptr(); asm volatile("" : "+s"(kp)); (void)p_in;
    Params p;
#pragma unroll
    for (int i_ = 0; i_ < 31; ++i_) p.in[i_] = kp->in[i_];
    p.out = kp->out; p.ws = kp->ws; p.layer = 0; p.pad = 0;
#else
    Params p = p_in; { unsigned char* w = p.ws; asm volatile("" : "+s"(w)); p.ws = w; }
#endif
    unsigned char* ws = p.ws; const bool last = (l == NLAYER - 1);
    const int gw = blockIdx.x * 8 + owid(), GW = gridDim.x * 8, lane = otid() & 63;
    if constexpr (PH == PH_PRO) { phase_prologue(p, lds); }
    if constexpr (PH == PH_NORM1) { phase_norm1(p, l); }
    if constexpr (PH == PH_WIN) {
        GemmDesc g{(const bf16_t*)(ws + O_H), DM, nullptr, DM, DM}; EpiStoreBf16 E{(bf16_t*)(ws + O_P), NP};
        const bf16_t* Bt = (const bf16_t*)(ws + O_WIN) + (size_t)l * NP * DM;
        if (!last) { DenseSched S{Bt, DM, NTOK / 256, 16, 0, 0}; GEMM_PHASE(g, S, E); }
        else { DenseSched S{Bt, DM, NLAT / 256, 16, 0, 0}; GEMM_PHASE(g, S, E); DenseSched S2{Bt, DM, NCTX / 256, 4, NLAT, 12}; GEMM_PHASE(g, S2, E); }
    }
    if constexpr (PH == PH_POSTA) {
#ifndef DBG_SKIP
#define DBG_SKIP 0
#endif
        if (!(DBG_SKIP & 1)) { GemmDesc g{(const bf16_t*)(ws + O_P) + C_CQ, NP, nullptr, 768, 768}; EpiStoreBf16 E{(bf16_t*)(ws + O_QRAW), NQP};
          DenseSched S{(const bf16_t*)(ws + O_WUQ) + (size_t)l * NQP * 768, 768, (last ? NLAT : NTOK) / 256, 5, 0, 0}; GEMM_PHASE(g, S, E); }
        if (!(DBG_SKIP & 2)) { GemmDesc g{(const bf16_t*)(ws + O_P) + C_CKV, NP, nullptr, 256, 256}; EpiStoreBf16 E{(bf16_t*)(ws + O_KVRAW), 1536};
          DenseSched S{(const bf16_t*)(ws + O_WUKV) + (size_t)l * 1536 * 256, 256, NTOK / 256, 6, 0, 0}; GEMM_PHASE(g, S, E); }
        const int ntt = (last ? NLAT : NTOK) / 64;
        if (!(DBG_SKIP & 4)) for (int t = blockIdx.x; t < ntt * 16; t += gridDim.x) hy_prep_task(p, l, (t >> 4) * 64, (t & 15) * 64, (LAS float*)lds);
        if (!(DBG_SKIP & 8)) for (int row = gw; row < NTOK; row += GW) gqa_post_row(p, l, row, lane);
    }
    if constexpr (PH == PH_POSTB) { if (l == 0) hss_tasks(p); for (int row = gw; row < NTOK; row += GW) mla_post_row(p, l, row, lane); }
    if constexpr (PH == PH_MIXER) { phase_mixer(p, l, lds); }
    if constexpr (PH == PH_HYFIN) { const int ntt = (last ? NLAT : NTOK) / 64; for (int t = blockIdx.x; t < ntt * 8; t += gridDim.x) hy_fin_task(p, l, (t >> 3) * 64, (t & 7) * 64, (LAS float*)lds); }
    if constexpr (PH == PH_WOUT) {
        GemmDesc g{(const bf16_t*)(ws + O_MIX), DM, nullptr, DM, DM}; EpiStoreBf16 E{(bf16_t*)(ws + O_OUT), DM};
        DenseSched S{(const bf16_t*)(ws + O_WOUT) + (size_t)l * DM * DM, DM, (last ? NLAT : NTOK) / 256, 8, 0, 0}; GEMM_PHASE(g, S, E);
    }
    if constexpr (PH == PH_ROUTE) { phase_route(p, l, lds); }
    if constexpr (PH == PH_PLACE) { phase_place(p, l, lds); }
    if constexpr (PH == PH_GEMM1 || PH == PH_GEMM2) {
        LAS int* te = (LAS int*)(lds + LDS_TILES); LAS int* ts = te + MAXTILES; LAS int* misc = (LAS int*)(lds + LDS_MISC) + 16;
        const int nt = moe_build_tiles((const unsigned*)(ws + O_CTL) + CW_CNT + l * 64, (last ? NLAT : NTOK) / 256, te, ts, misc);
#if MOE_FP8
        if constexpr (PH == PH_GEMM1) {
            GemmDesc g{(const bf16_t*)(ws + O_H), DM, (const int*)(ws + O_STOK), DM, DM}; EpiSwiGLU8 E{ws + O_HID};
            MoeSched S{te, ts, nt, 4, (const bf16_t*)(ws + O_EGU), (size_t)1024 * 1024, DM / 2, 128}; GEMM_PHASE8(g, S, E, 127, 119);
        } else {
            GemmDesc g{(const bf16_t*)(ws + O_HID), EH, nullptr, EH, EH}; EpiStoreBf16 E{(bf16_t*)(ws + O_DOUT), DM};
            MoeSched S{te, ts, nt, 8, (const bf16_t*)(ws + O_ED), (size_t)2048 * 256, EH / 2, 256}; GEMM_PHASE8(g, S, E, 123, 119);
        }
#else
        if constexpr (PH == PH_GEMM1) {
            GemmDesc g{(const bf16_t*)(ws + O_H), DM, (const int*)(ws + O_STOK), DM, DM}; EpiSwiGLU E{(bf16_t*)(ws + O_HID)};
            MoeSched S{te, ts, nt, 4, (const bf16_t*)(ws + O_EGU), (size_t)1024 * 2048, DM, 128}; GEMM_PHASE(g, S, E);
        } else {
            GemmDesc g{(const bf16_t*)(ws + O_HID), EH, nullptr, EH, EH}; EpiStoreBf16 E{(bf16_t*)(ws + O_DOUT), DM};
            MoeSched S{te, ts, nt, 8, (const bf16_t*)(ws + O_ED), (size_t)2048 * 512, EH, 256}; GEMM_PHASE(g, S, E);
        }
#endif
        __syncthreads();
    }
    if constexpr (PH == PH_FINAL) {
        phase_final(p, l);
        if (!last) cvt_exp_all(p, l + 1);
    }
}

#ifndef MEGA
#define MEGA 0
#endif


#if MEGA
__global__ void __launch_bounds__(NTHREADS, 2) mega_fwd(Params p) {
    extern __shared__ __attribute__((aligned(16))) unsigned char lds_raw[];
    LAS unsigned char* lds = (LAS unsigned char*)lds_raw;
    volatile LAS unsigned* xbw = (volatile LAS unsigned*)(lds + LDS_MISC);
    if (otid() == 0) { xbw[0] = 0u; xbw[1] = 0u; }
    __syncthreads();
    { const XcdBarrier b0 = xcd_barrier_post((unsigned*)(p.ws + O_CTL) + CW_BAR, xbw); if (otid() == 0) xbw[2] = b0.x; }
    __syncthreads();
#define GRID_BAR() do { XcdBarrier b_; b_.bar = (unsigned*)(p.ws + O_CTL) + CW_BAR; b_.x = xbw[2]; b_.st = xbw; xcd_barrier(b_); } while (0)
#ifndef DBL_MASK
#define DBL_MASK 0
#endif
#define RUNP(PH, l) do { run_phase<PH>(p, l, lds); GRID_BAR(); if ((DBL_MASK >> PH) & 1) { run_phase<PH>(p, l, lds); GRID_BAR(); } } while (0)
#ifndef DLY_MASK
#define DLY_MASK 0
#endif
#define RUND(PH, l) do { if ((DLY_MASK >> PH) & 1) { const unsigned long long t0_ = wall_clock64(); run_phase<PH>(p, l, lds); const unsigned long long t1_ = wall_clock64(); while (wall_clock64() < t1_ + (t1_ - t0_)) __builtin_amdgcn_s_sleep(8); } else run_phase<PH>(p, l, lds); } while (0)
    RUNP(PH_PRO, 0);
#define LAYER(l) do { if ((l) == 0) RUNP(PH_NORM1, l); \
        RUNP(PH_WIN, l); RUNP(PH_POSTA, l); RUNP(PH_POSTB, l); RUNP(PH_MIXER, l); RUNP(PH_HYFIN, l); RUNP(PH_WOUT, l); \
        RUND(PH_ROUTE, l); GRID_BAR(); RUND(PH_PLACE, l); GRID_BAR(); RUNP(PH_GEMM1, l); RUNP(PH_GEMM2, l); RUND(PH_FINAL, l); \
        if ((l) + 1 < NLAYER) GRID_BAR(); } while (0)
    LAYER(0);
    LAYER(1);
}
#endif

#if !MEGA
template <int PH> __global__ void __launch_bounds__(NTHREADS, 2) k_phase(Params p) {
    extern __shared__ __attribute__((aligned(16))) unsigned char lds_raw[];
    run_phase<PH>(p, p.layer, (LAS unsigned char*)lds_raw);
}
template <int PH> static bool prep_phase() { return hipFuncSetAttribute((const void*)k_phase<PH>, hipFuncAttributeMaxDynamicSharedMemorySize, LDS_BYTES) == hipSuccess; }
static int g_nlaunch = 0;
#ifndef DBG_STOP
#define DBG_STOP 1000
#define DBG_DUMP 0
#else
#define DBG_DUMP 1
#ifndef DBG_SET
#define DBG_SET 31
#endif
#endif
template <int PH> static void launch_phase(Params p, int l, hipStream_t st) { if (g_nlaunch++ >= DBG_STOP) return; p.layer = l; hipLaunchKernelGGL(k_phase<PH>, dim3(256), dim3(NTHREADS), LDS_BYTES, st, p); }
#endif


#if DBG_DUMP
__device__ __forceinline__ float san(float x) { return (x == x && fabsf(x) < 1e6f) ? x : 1.0f; }
__global__ void __launch_bounds__(256) k_dump(Params p) {
    const size_t N = (size_t)NLAT * DM;
    const bf16_t* b1 = (const bf16_t*)(p.ws + O_WIN); const size_t n1 = (O_X - O_WIN) / 2;
    const bf16_t* b2 = (const bf16_t*)(p.ws + O_H); const size_t n2 = (size_t)NTOK * DM;
    const bf16_t* b3 = (const bf16_t*)(p.ws + O_A); const size_t n3 = (O_AEND - O_A) / 2;
    const float* f1 = (const float*)(p.ws + O_MOD); const size_t m1 = (O_WIN - O_MOD) / 4;
    const float* f2 = (const float*)(p.ws + O_X); const size_t m2 = (size_t)NTOK * DM;
    for (size_t i = (size_t)blockIdx.x * 256 + otid(); i < N; i += (size_t)gridDim.x * 256) {
        float v = 0.f;
        if (DBG_SET & 1) for (size_t e = i; e < n1; e += N) v += san(bf2f(b1[e]));
        if (DBG_SET & 2) for (size_t e = i; e < n2; e += N) v += san(bf2f(b2[e]));
        if (DBG_SET & 4) for (size_t e = i; e < n3; e += N) v += san(bf2f(b3[e]));
        if (DBG_SET & 8) for (size_t e = i; e < m1; e += N) v += san(f1[e]);
        if (DBG_SET & 16) for (size_t e = i; e < m2; e += N) v += san(f2[e]);
        if (DBG_SET & 32) v += san(bf2f(((const bf16_t*)(p.ws + O_WUKV))[i % ((size_t)2 * 1536 * 256)]));
        if (DBG_SET & 64) { const size_t r = i % NTOK, c = (i / NTOK) % 256; v += san(bf2f(((const bf16_t*)(p.ws + O_P))[r * NP + C_CKV + c])); }
        if (DBG_SET & 128) v += san(bf2f(((const bf16_t*)(p.ws + O_KVRAW))[i % ((size_t)NTOK * 1536)]));
        p.out[i] = v;
    }
}
#endif
static int g_grid = 0;
extern "C" void kernel_launch(void* const* d_in, const int* in_sizes, int n_in, void* d_out, int out_size, void* d_ws, size_t ws_size, hipStream_t stream) {
    static int ok = 0;
    if (ok == 0) {
        if (n_in != 31 || in_sizes[0] != NLAT * DM || out_size != NLAT * DM || ws_size < WS_END) { fprintf(stderr, "kernel_launch: unexpected shapes (n_in %d, ws %zu, need %zu)\n", n_in, ws_size, (size_t)WS_END); ok = -1; return; }
        bool good = true;
#if !MEGA
        good = good && prep_phase<0>() && prep_phase<1>() && prep_phase<2>() && prep_phase<3>() && prep_phase<4>() && prep_phase<5>() && prep_phase<6>() && prep_phase<7>() && prep_phase<8>() && prep_phase<9>() && prep_phase<10>() && prep_phase<11>() && prep_phase<12>();
#endif
#if MEGA
        good = hipFuncSetAttribute((const void*)mega_fwd, hipFuncAttributeMaxDynamicSharedMemorySize, LDS_BYTES) == hipSuccess;
        int dev = 0, cus = 0, per_cu = 0;
        if (hipGetDevice(&dev) != hipSuccess || hipDeviceGetAttribute(&cus, hipDeviceAttributeMultiprocessorCount, dev) != hipSuccess) good = false;
        if (good && (hipOccupancyMaxActiveBlocksPerMultiprocessor(&per_cu, (const void*)mega_fwd, NTHREADS, LDS_BYTES) != hipSuccess || per_cu < 1)) { fprintf(stderr, "kernel_launch: occupancy query says %d workgroups per CU\n", per_cu); good = false; }
        g_grid = cus;
#endif
        if (!good) { fprintf(stderr, "kernel_launch: set-up failed\n"); ok = -1; return; }
        ok = 1;
    }
    if (ok < 0) return;
    Params p{}; for (int i = 0; i < 31; ++i) p.in[i] = (const float*)d_in[i]; p.out = (float*)d_out; p.ws = (unsigned char*)d_ws; p.layer = 0; p.pad = 0;
#ifdef POISON_WS
    hipMemsetAsync((char*)d_ws, 0xFF, WS_END, stream);
#endif
    hipMemsetAsync((char*)d_ws + O_CTL, 0, ZERO_BYTES, stream);
#if !MEGA
    g_nlaunch = 0;
    launch_phase<PH_PRO>(p, 0, stream);
    for (int l = 0; l < NLAYER; ++l) {
        if (l == 0) launch_phase<PH_NORM1>(p, l, stream);
        launch_phase<PH_WIN>(p, l, stream); launch_phase<PH_POSTA>(p, l, stream); launch_phase<PH_POSTB>(p, l, stream); launch_phase<PH_MIXER>(p, l, stream);
        launch_phase<PH_HYFIN>(p, l, stream); launch_phase<PH_WOUT>(p, l, stream); launch_phase<PH_ROUTE>(p, l, stream); launch_phase<PH_PLACE>(p, l, stream);
        launch_phase<PH_GEMM1>(p, l, stream); launch_phase<PH_GEMM2>(p, l, stream); launch_phase<PH_FINAL>(p, l, stream);
    }
#if DBG_DUMP
    hipLaunchKernelGGL(k_dump, dim3(2048), dim3(256), 0, stream, p);
#endif
#else
    hipLaunchKernelGGL(mega_fwd, dim3(g_grid), dim3(NTHREADS), LDS_BYTES, stream, p);
#endif
}
```

```cpp
#define MOE_FP8 1
#define GQA_SD 1
#define FAST_GEMM 1
#define MEGA 1
#include <hip/hip_runtime.h>
#include <stdint.h>
#include <stdio.h>

#define LAS __attribute__((address_space(3)))
typedef unsigned short bf16_t;
typedef short bf16x8 __attribute__((ext_vector_type(8)));
typedef short s16x4 __attribute__((ext_vector_type(4)));
typedef float f32x4 __attribute__((ext_vector_type(4)));
typedef float f32x16 __attribute__((ext_vector_type(16)));
typedef unsigned u32x4 __attribute__((ext_vector_type(4)));
typedef unsigned u32x2 __attribute__((ext_vector_type(2)));

constexpr int DM = 2048, NB = 8, SEQ = 2048, CTXL = 256, NLAT = NB * SEQ, NCTX = NB * CTXL, NTOK = NLAT + NCTX, NLAYER = 2;
constexpr int NP = 4096;
constexpr int C_CQ = 1536, C_GQ = 2304, C_CKV = 3072, C_KR = 3328, C_GK = 3392, C_GV = 3648, IN_COLS = 3904;
constexpr int NEXP = 64, TOPK = 6, EH = 512;
constexpr int LK = CTXL + SEQ;
constexpr int RSLOTS = 126976;
constexpr int NSLOTS = RSLOTS + NTOK;
constexpr int MAXTILES = NSLOTS / 256;
constexpr int NQP = 1280;
constexpr float EPS = 1e-6f;
constexpr int NTHREADS = 512;
#ifndef GQA_SD
#define GQA_SD 2
#endif
#ifndef HY_MFMA
#define HY_MFMA 1
#endif
#ifndef MOE_FP8
#define MOE_FP8 0
#endif
#ifndef DENSE_FP8
#define DENSE_FP8 0
#endif
#define WIN8 ((DENSE_FP8 & 1) != 0)
#define WOUT8 ((DENSE_FP8 & 2) != 0)
constexpr float MIX8_SCALE = 16.0f;
#ifndef DOUT_FP8
#define DOUT_FP8 MOE_FP8
#endif
constexpr float DOUT8_SCALE = 16.0f;
#ifndef FAST_GEMM
#define FAST_GEMM 1
#endif
#ifndef MEGA
#define MEGA 1
#endif

constexpr size_t al256(size_t x) { return (x + 255) & ~(size_t)255; }
constexpr size_t O_CTL = 0;
constexpr size_t CTL_BYTES = 65536;
constexpr size_t O_MOD = O_CTL + CTL_BYTES;
constexpr size_t O_HSS = O_MOD + al256((size_t)NLAYER * 9 * 12288 * 4);
constexpr size_t ZERO_BYTES = O_HSS + al256((size_t)NLAYER * 2 * 2 * 512 * 4);
constexpr size_t O_HF = ZERO_BYTES;
constexpr size_t HF_L0 = (size_t)2 * 2 * 512 * 2048, HF_L1 = (size_t)2 * 2 * 512 * 256, HF_LAYER = HF_L0 + HF_L1;
constexpr size_t O_WIN = O_HF + al256(NLAYER * HF_LAYER * 4);
constexpr size_t O_WOUT = O_WIN + (size_t)NLAYER * NP * DM * 2;
constexpr size_t O_WUQ = O_WOUT + (size_t)NLAYER * DM * DM * 2;
constexpr size_t O_WUKV = O_WUQ + al256((size_t)NLAYER * NQP * 768 * 2);
constexpr size_t O_EGU = O_WUKV + al256((size_t)NLAYER * 1536 * 256 * 2);
constexpr size_t O_ED = O_EGU + (size_t)65 * 1024 * 2048 * 2;
constexpr size_t O_X = O_ED + (size_t)65 * 2048 * 512 * 2;
constexpr size_t O_H = O_X + (size_t)NTOK * DM * 4;
constexpr size_t O_EIDX = O_H + (size_t)NTOK * DM * 2;
constexpr size_t O_GATE = O_EIDX + (size_t)NTOK * 8 * 4;
constexpr size_t O_SLOT = O_GATE + (size_t)NTOK * 8 * 4;
constexpr size_t O_STOK = O_SLOT + (size_t)NTOK * 8 * 4;
constexpr size_t O_WCNT = O_STOK + al256((size_t)NSLOTS * 4);
constexpr size_t O_ROPE = O_WCNT + (size_t)1024 * 64 * 4;
constexpr size_t O_HID = O_ROPE + (size_t)(64 * 32 + 64 * 16) * 8;
constexpr size_t O_A = O_HID + (size_t)NSLOTS * EH * 2;
constexpr size_t O_P = O_A;
constexpr size_t O_QRAW = O_P + (size_t)NTOK * NP * 2;
constexpr size_t O_KVRAW = O_QRAW + (size_t)NTOK * NQP * 2;
constexpr size_t O_QM = O_KVRAW + (size_t)NTOK * 1536 * 2;
constexpr size_t O_QMC = O_QM + (size_t)NB * 6 * SEQ * 192 * 2;
constexpr size_t O_KM = O_QMC + (size_t)NB * 6 * CTXL * 192 * 2;
constexpr size_t O_VM = O_KM + (size_t)NB * 6 * LK * 192 * 2;
constexpr size_t O_QG = O_VM + (size_t)NB * 6 * LK * 128 * 2;
constexpr size_t O_QGC = O_QG + (size_t)NB * 6 * SEQ * 128 * 2;
constexpr size_t O_KG = O_QGC + (size_t)NB * 6 * CTXL * 128 * 2;
constexpr size_t O_VG = O_KG + (size_t)NB * 2 * LK * 128 * 2;
constexpr size_t O_VT = O_VG + (size_t)NB * 2 * LK * 128 * 2;
constexpr size_t O_X1T = O_VT + (size_t)512 * NTOK * 2;
constexpr size_t O_Y2T = O_X1T + (size_t)512 * NTOK * 2;
constexpr size_t O_MIX = O_Y2T + (size_t)512 * NTOK * 2;
constexpr size_t O_OUT = O_MIX + (size_t)NTOK * DM * 2;
constexpr size_t O_AEND = O_OUT + (size_t)NTOK * DM * 2;
constexpr size_t O_DOUT = O_A;
static_assert(O_DOUT + (size_t)NSLOTS * DM * 2 <= O_AEND, "DOUT must fit the mixer scratch region");
constexpr size_t WS_END = O_AEND;

constexpr int CW_BAR = 0;
constexpr int CW_CNT = 4096;
constexpr int CW_CUR = 4096 + 128;
constexpr int CW_Q = 4096 + 256;

constexpr int LDS_BYTES = 148480;
constexpr int LDS_MISC = 147456;
constexpr int LDS_TILES = 131072;
constexpr int LDS_CNTL = LDS_MISC + 512;

struct Params { const float* in[31]; float* out; unsigned char* ws; int layer; int pad; };

enum { I_X = 0, I_C, I_CTX, I_CCTX, I_ADAW, I_ADAB, I_NORMG, I_WIN, I_WOUT, I_HYCONV, I_HYW1, I_HYB1, I_HYW2, I_HYB2, I_HYW3, I_HYFREQ, I_HYSKIP,
       I_MQN, I_MKVN, I_WUQ, I_WUKV, I_GQN, I_GKN, I_RW, I_RB, I_EG, I_EU, I_EDN, I_SG, I_SU, I_SD };

__device__ __forceinline__ int otid() { int t = threadIdx.x; asm volatile("" : "+v"(t)); return t; }
__device__ __forceinline__ int owid() { return __builtin_amdgcn_readfirstlane(otid() >> 6); }
__device__ __forceinline__ float bf2f(bf16_t v) { return __uint_as_float(((unsigned)v) << 16); }
__device__ __forceinline__ bf16_t f2bf(float f) { unsigned u = __float_as_uint(f); u += 0x7FFFu + ((u >> 16) & 1u); return (bf16_t)(u >> 16); }
__device__ __forceinline__ unsigned pk2(float lo, float hi) { unsigned r; asm volatile("v_cvt_pk_bf16_f32 %0, %1, %2" : "=v"(r) : "v"(lo), "v"(hi)); return r; }
__device__ __forceinline__ float wave_sum(float v) {
#pragma unroll
    for (int o = 32; o >= 1; o >>= 1) v += __shfl_xor(v, o);
    return v;
}
__device__ __forceinline__ float rdlane(float v, int l) { return __int_as_float(__builtin_amdgcn_readlane(__float_as_int(v), l)); }
__device__ __forceinline__ float silu_f(float x) { return x / (1.0f + __expf(-x)); }
__device__ __forceinline__ const float* resid_src(const Params& p, int l, int row) {
    if (l == 0) return row < NLAT ? p.in[I_X] + (size_t)row * DM : p.in[I_CTX] + (size_t)(row - NLAT) * DM;
    return (const float*)(p.ws + O_X) + (size_t)row * DM;
}
__device__ __forceinline__ int row_batch(int row) { return row < NLAT ? row >> 11 : 8; }
#define ROWCOL(j, lane) ((j) * 256 + (lane) * 4)


struct GUnit { int arow0; const bf16_t* B; int orow0, ocol0; };
struct GemmDesc { const bf16_t* A; int lda; const int* ridx; int ldb; int K; };

__host__ __device__ __forceinline__ int perm32(int rho) { const int n = rho >> 4, i = rho & 15; return 8 * (i >> 2) + 4 * n + (i & 3); }
struct EpiStoreBf16 {
    static constexpr bool PERM = (FAST_GEMM != 0);
    bf16_t* O; int ldo;
    __device__ __forceinline__ void operator()(const f32x4 (&acc)[2][2][4][2], const GUnit& u, int wr, int wc, int fr, int fq) const {
#pragma unroll
        for (int ai = 0; ai < 2; ++ai)
#pragma unroll
            for (int m = 0; m < 4; ++m) {
                bf16_t* rowp = O + (size_t)(u.orow0 + ai * 128 + wr * 64 + m * 16 + fr) * ldo + u.ocol0 + wc * 32 + (PERM ? 8 : 4) * fq;
#pragma unroll
                for (int bj = 0; bj < 2; ++bj) {
                    if constexpr (PERM) { const f32x4 v0 = acc[ai][bj][m][0], v1 = acc[ai][bj][m][1]; u32x4 w; w.x = pk2(v0[0], v0[1]); w.y = pk2(v0[2], v0[3]); w.z = pk2(v1[0], v1[1]); w.w = pk2(v1[2], v1[3]); *(u32x4*)(rowp + bj * 128) = w; }
                    else {
#pragma unroll
                        for (int n = 0; n < 2; ++n) { const f32x4 v = acc[ai][bj][m][n]; u32x2 w; w.x = pk2(v[0], v[1]); w.y = pk2(v[2], v[3]); *(u32x2*)(rowp + bj * 128 + n * 16) = w; } } }
            }
    }
};
struct EpiSwiGLU {
    static constexpr bool PERM = (FAST_GEMM != 0);
    bf16_t* O;
    __device__ __forceinline__ void operator()(const f32x4 (&acc)[2][2][4][2], const GUnit& u, int wr, int wc, int fr, int fq) const {
#pragma unroll
        for (int ai = 0; ai < 2; ++ai)
#pragma unroll
            for (int m = 0; m < 4; ++m) {
                bf16_t* rowp = O + (size_t)(u.orow0 + ai * 128 + wr * 64 + m * 16 + fr) * EH + u.ocol0 + wc * 32 + (PERM ? 8 : 4) * fq;
#pragma unroll
                for (int n = 0; n < 2; ++n) { const f32x4 g = acc[ai][0][m][n], up = acc[ai][1][m][n]; float h[4];
#pragma unroll
                    for (int j = 0; j < 4; ++j) h[j] = silu_f(g[j]) * up[j];
                    u32x2 w; w.x = pk2(h[0], h[1]); w.y = pk2(h[2], h[3]); *(u32x2*)(rowp + n * (PERM ? 4 : 16)) = w; }
            }
    }
};

__device__ __forceinline__ unsigned pk4_fp8(float a, float b, float c, float d) { int r = __builtin_amdgcn_cvt_pk_fp8_f32(a, b, 0, false); r = __builtin_amdgcn_cvt_pk_fp8_f32(c, d, r, true); return (unsigned)r; }
constexpr float HID8_SCALE = 16.0f;
constexpr float W8_SCALE = 256.0f;
struct EpiSwiGLU8 {
    static constexpr bool PERM = (FAST_GEMM != 0);
    unsigned char* O;
    __device__ __forceinline__ void operator()(const f32x4 (&acc)[2][2][4][2], const GUnit& u, int wr, int wc, int fr, int fq) const {
#pragma unroll
        for (int ai = 0; ai < 2; ++ai)
#pragma unroll
            for (int m = 0; m < 4; ++m) {
                unsigned char* rowp = O + (size_t)(u.orow0 + ai * 128 + wr * 64 + m * 16 + fr) * EH + u.ocol0 + wc * 32 + (PERM ? 8 : 4) * fq;
#pragma unroll
                for (int n = 0; n < 2; ++n) { const f32x4 g = acc[ai][0][m][n], up = acc[ai][1][m][n]; float h[4];
#pragma unroll
                    for (int j = 0; j < 4; ++j) h[j] = silu_f(g[j]) * up[j] * HID8_SCALE;
                    *(unsigned*)(rowp + n * (PERM ? 4 : 16)) = pk4_fp8(h[0], h[1], h[2], h[3]); }
            }
    }
};

struct EpiStoreFp8 {
    static constexpr bool PERM = true;
    unsigned char* O; int ldo; float scale;
    __device__ __forceinline__ void operator()(const f32x4 (&acc)[2][2][4][2], const GUnit& u, int wr, int wc, int fr, int fq) const {
#pragma unroll
        for (int ai = 0; ai < 2; ++ai)
#pragma unroll
            for (int m = 0; m < 4; ++m) {
                unsigned char* rowp = O + (size_t)(u.orow0 + ai * 128 + wr * 64 + m * 16 + fr) * ldo + u.ocol0 + wc * 32 + 8 * fq;
#pragma unroll
                for (int bj = 0; bj < 2; ++bj) { const f32x4 v0 = acc[ai][bj][m][0] * scale, v1 = acc[ai][bj][m][1] * scale; u32x2 w; w.x = pk4_fp8(v0[0], v0[1], v0[2], v0[3]); w.y = pk4_fp8(v1[0], v1[1], v1[2], v1[3]); *(u32x2*)(rowp + bj * 128) = w; }
            }
    }
};

template <class Epi>
__device__ __forceinline__ void gemm_unit_simple(const GemmDesc& g, const GUnit& u, const Epi& E) {
    int tid = otid();
    const int wid = __builtin_amdgcn_readfirstlane(tid >> 6), lane = tid & 63, wr = wid >> 2, wc = wid & 3, fr = lane & 15, fq = lane >> 4;
    f32x4 acc[2][2][4][2];
#pragma unroll
    for (int a = 0; a < 2; ++a)
#pragma unroll
        for (int b = 0; b < 2; ++b)
#pragma unroll
            for (int m = 0; m < 4; ++m)
#pragma unroll
                for (int n = 0; n < 2; ++n) acc[a][b][m][n] = (f32x4){0.f, 0.f, 0.f, 0.f};
    const bf16_t* ap[2][4]; const bf16_t* bp[2][2];
#pragma unroll
    for (int ai = 0; ai < 2; ++ai)
#pragma unroll
        for (int m = 0; m < 4; ++m) { const int r = u.arow0 + ai * 128 + wr * 64 + m * 16 + fr; int src = g.ridx ? g.ridx[r] : r; if (src < 0) src = 0; ap[ai][m] = g.A + (size_t)src * g.lda + 8 * fq; }
#pragma unroll
    for (int bj = 0; bj < 2; ++bj)
#pragma unroll
        for (int n = 0; n < 2; ++n) bp[bj][n] = u.B + (size_t)(bj * 128 + wc * 32 + n * 16 + fr) * g.ldb + 8 * fq;
    int Kq = g.K; asm volatile("" : "+s"(Kq));
#pragma unroll 1
    for (int k0 = 0; k0 < Kq; k0 += 32) {
        bf16x8 a[2][4], b[2][2];
#pragma unroll
        for (int ai = 0; ai < 2; ++ai)
#pragma unroll
            for (int m = 0; m < 4; ++m) a[ai][m] = *(const bf16x8*)(ap[ai][m] + k0);
#pragma unroll
        for (int bj = 0; bj < 2; ++bj)
#pragma unroll
            for (int n = 0; n < 2; ++n) b[bj][n] = *(const bf16x8*)(bp[bj][n] + k0);
#pragma unroll
        for (int ai = 0; ai < 2; ++ai)
#pragma unroll
            for (int bj = 0; bj < 2; ++bj)
#pragma unroll
                for (int m = 0; m < 4; ++m)
#pragma unroll
                    for (int n = 0; n < 2; ++n) acc[ai][bj][m][n] = __builtin_amdgcn_mfma_f32_16x16x32_bf16(b[bj][n], a[ai][m], acc[ai][bj][m][n], 0, 0, 0);
    }
    E(acc, u, wr, wc, fr, fq);
}

struct DenseSched {
    const bf16_t* Bt; int ldb, nM, nN, row0, pn0;
    __device__ __forceinline__ int count() const { return nM * nN; }
    __device__ __forceinline__ int ncol() const { return nN; }
    __device__ __forceinline__ void unit(int i, GUnit& u) const { const int pm = i / nN, pn = pn0 + i % nN; u.arow0 = row0 + pm * 256; u.B = Bt + (size_t)pn * 256 * ldb; u.orow0 = u.arow0; u.ocol0 = pn * 256; }
};
struct MoeSched {
    const LAS int* te; const LAS int* ts; int ntiles, npn; const bf16_t* Bt; size_t estride; int ldb, ocolw;
    __device__ __forceinline__ int count() const { return ntiles * npn; }
    __device__ __forceinline__ int ncol() const { return npn; }
    __device__ __forceinline__ void unit(int i, GUnit& u) const { const int t = i / npn, pn = i % npn; const int e = te[t]; u.arow0 = ts[t]; u.B = Bt + (size_t)e * estride + (size_t)pn * 256 * ldb; u.orow0 = u.arow0; u.ocol0 = pn * ocolw; }
};
template <class Sched, class Epi>
__device__ __forceinline__ void gemm_phase_simple(const GemmDesc& g, const Sched& S, const Epi& E) {
    const int n = S.count();
    for (int i = blockIdx.x; i < n; i += gridDim.x) { GUnit u; S.unit(i, u); gemm_unit_simple(g, u, E); }
}
__device__ __forceinline__ int wave_incl_scan(int v, int lane) {
#pragma unroll
    for (int o = 1; o < 64; o <<= 1) { const int t = __shfl_up(v, o); if (lane >= o) v += t; }
    return v;
}
__device__ __forceinline__ int moe_build_tiles(const unsigned* cnt, int nshared, LAS int* te, LAS int* ts, LAS int* misc) {
    __syncthreads();
    const int tid = otid();
    if (tid < 64) {
        const int c = (int)cnt[tid], ntile = (c + 255) >> 8, incl = wave_incl_scan(ntile, tid), first = incl - ntile;
        for (int j = 0; j < ntile; ++j) { te[first + j] = tid; ts[first + j] = (first + j) * 256; }
        const int nrt = __shfl(incl, 63);
        for (int j = tid; j < nshared; j += 64) { te[nrt + j] = NEXP; ts[nrt + j] = RSLOTS + j * 256; }
        if (tid == 0) misc[0] = nrt + nshared;
    }
    __syncthreads();
    return misc[0];
}
#ifndef FAST_GEMM
#define FAST_GEMM 0
#endif
#if !FAST_GEMM
#define GEMM_PHASE(g, S, E) gemm_phase_simple(g, S, E)
#endif

#if FAST_GEMM
constexpr int HTB = 128 * 64 * 2;
__device__ __forceinline__ int lds_byte(int r, int c) { const int st = (r >> 4) * 2 + (c >> 5), rr = r & 15, cc = c & 31, ob = rr * 64 + cc * 2; return st * 1024 + (ob ^ (((ob >> 9) & 1) << 5)); }
__device__ __forceinline__ void stage_rc(int b, int& R, int& C) { const int st = b / 1024, sb = b % 1024, swz = sb ^ (((sb >> 9) & 1) << 5); R = (st >> 1) * 16 + swz / 64; C = (st & 1) * 32 + (swz % 64) / 2; }

typedef int v8i __attribute__((ext_vector_type(8)));
typedef int v4i __attribute__((ext_vector_type(4)));
template <int ESZ, class Sched, class Epi>
__device__ __forceinline__ void gemm_phase_fast(LAS unsigned char* lds, const GemmDesc& g, const Sched& S, const Epi& E, int scA = 127, int scB = 127) {
    const int tid = otid(), wid = __builtin_amdgcn_readfirstlane(tid >> 6), lane = tid & 63, wr = wid >> 2, wc = wid & 3, fr = lane & 15, fq = lane >> 4;
    const int K = g.K, nunits = S.count(), G = gridDim.x, c0 = blockIdx.x;
    int nt = K * ESZ / 128; asm volatile("" : "+s"(nt));
    const int npn = S.ncol(); const bool xmap = (G % 8 == 0) && ((G / 8) % npn == 0); const int xT = xmap ? (G / 8) / npn : 1, xx = c0 % 8, xr = c0 / 8;
#define F_UNIT(ui_) (xmap ? (((ui_) * 8 + xx) * xT + xr / npn) * npn + xr % npn : (ui_) * G + c0)
    if (F_UNIT(0) >= nunits) return;
    int R[2], C[2]; unsigned voffB[2];
#pragma unroll
    for (int i = 0; i < 2; ++i) { stage_rc(tid * 16 + i * 8192, R[i], C[i]); const int Rb = Epi::PERM ? ((R[i] & ~31) + perm32(R[i] & 31)) : R[i]; voffB[i] = (unsigned)(Rb * g.ldb) * (unsigned)ESZ + (unsigned)C[i] * 2u; }
    const size_t kstep = 128;
    const size_t hstepB = (size_t)128 * g.ldb * ESZ;
    const unsigned ldsw = (unsigned)wid * 1024u;
    const int aoff = lds_byte(wr * 64 + fr, fq * 8), boff = lds_byte(wc * 32 + fr, fq * 8);
    const char* Ab = (const char*)g.A;
#define F_SA(b, h) (((b) * 2 + (h)) * HTB)
#define F_SB(b, h) ((4 + (b) * 2 + (h)) * HTB)
#define F_STAGE(bufoff, gbase, voff) do { _Pragma("unroll") for (int _i = 0; _i < 2; ++_i) \
        __builtin_amdgcn_global_load_lds((const unsigned*)((const char*)(gbase) + (voff)[_i]), (LAS unsigned*)(lds + (bufoff) + ldsw + _i * 8192), 16, 0, 0); } while (0)
#define F_LDA(dst, b, h) do { _Pragma("unroll") for (int m = 0; m < 4; ++m) { if constexpr (ESZ == 2) { _Pragma("unroll") for (int k = 0; k < 2; ++k) dst[m][k] = *(const LAS bf16x8*)(lds + F_SA(b, h) + aoff + m * 2048 + k * 1024); } \
        else { const v4i lo_ = *(const LAS v4i*)(lds + F_SA(b, h) + aoff + m * 2048), hi_ = *(const LAS v4i*)(lds + F_SA(b, h) + aoff + m * 2048 + 1024); dst##8[m] = __builtin_shufflevector(lo_, hi_, 0, 1, 2, 3, 4, 5, 6, 7); } } } while (0)
#define F_LDB(dst, b, h) do { _Pragma("unroll") for (int n = 0; n < 2; ++n) { if constexpr (ESZ == 2) { _Pragma("unroll") for (int k = 0; k < 2; ++k) dst[n][k] = *(const LAS bf16x8*)(lds + F_SB(b, h) + boff + n * 2048 + k * 1024); } \
        else { const v4i lo_ = *(const LAS v4i*)(lds + F_SB(b, h) + boff + n * 2048), hi_ = *(const LAS v4i*)(lds + F_SB(b, h) + boff + n * 2048 + 1024); dst##8[n] = __builtin_shufflevector(lo_, hi_, 0, 1, 2, 3, 4, 5, 6, 7); } } } while (0)
#define F_MMA(ai, bj, At, Bt) do { __builtin_amdgcn_s_setprio(1); _Pragma("unroll") for (int m = 0; m < 4; ++m) _Pragma("unroll") for (int n = 0; n < 2; ++n) { \
        if constexpr (ESZ == 2) { _Pragma("unroll") for (int k = 0; k < 2; ++k) acc[ai][bj][m][n] = __builtin_amdgcn_mfma_f32_16x16x32_bf16(Bt[n][k], At[m][k], acc[ai][bj][m][n], 0, 0, 0); } \
        else acc[ai][bj][m][n] = __builtin_amdgcn_mfma_scale_f32_16x16x128_f8f6f4(Bt##8[n], At##8[m], acc[ai][bj][m][n], 0, 0, 0, scB, 0, scA); } \
        __builtin_amdgcn_s_setprio(0); } while (0)
#define F_WAIT_V(n) asm volatile("s_waitcnt vmcnt(" #n ")" ::: "memory")
#define F_WAIT_L(n) asm volatile("s_waitcnt lgkmcnt(" #n ")" ::: "memory")
#define F_BAR __builtin_amdgcn_s_barrier()
#define F_SCHED __builtin_amdgcn_sched_barrier(0)
#define F_AROWS(u, dst) do { _Pragma("unroll") for (int _h = 0; _h < 2; ++_h) _Pragma("unroll") for (int _i = 0; _i < 2; ++_i) { const int _r = (u).arow0 + _h * 128 + R[_i]; int _s = g.ridx ? g.ridx[_r] : _r; if (_s < 0) _s = 0; dst[_h][_i] = _s; } } while (0)
#define F_AOFFS(src, dst) do { _Pragma("unroll") for (int _h = 0; _h < 2; ++_h) _Pragma("unroll") for (int _i = 0; _i < 2; ++_i) dst[_h][_i] = (unsigned)src[_h][_i] * (unsigned)g.lda * (unsigned)ESZ + (unsigned)C[_i] * 2u; } while (0)
    GUnit cur, nxt; int ui = 0;
    S.unit(F_UNIT(0), cur);
    f32x4 acc[2][2][4][2];
#pragma unroll
    for (int a = 0; a < 2; ++a)
#pragma unroll
        for (int b = 0; b < 2; ++b)
#pragma unroll
            for (int m = 0; m < 4; ++m)
#pragma unroll
                for (int n = 0; n < 2; ++n) acc[a][b][m][n] = (f32x4){0.f, 0.f, 0.f, 0.f};
    bf16x8 At[4][2], B0[2][2], B1[2][2]; v8i At8[4], B08[2], B18[2];
    unsigned voA[2][2]; int rnx[2][2];
    F_AROWS(cur, rnx); F_AOFFS(rnx, voA);
    const char* cB = (const char*)cur.B;
    F_STAGE(F_SB(0, 0), cB, voffB); F_STAGE(F_SA(0, 0), Ab, voA[0]); F_STAGE(F_SB(0, 1), cB + hstepB, voffB); F_STAGE(F_SA(0, 1), Ab, voA[1]);
    if (wr == 1) F_BAR;
    F_WAIT_V(4); F_BAR;
    F_STAGE(F_SB(1, 0), cB + kstep, voffB); F_STAGE(F_SA(1, 0), Ab + kstep, voA[0]); F_STAGE(F_SB(1, 1), cB + hstepB + kstep, voffB);
    F_WAIT_V(6); F_BAR;
    for (;;) {
        const int Ln = F_UNIT(ui + 1); const bool has_next = Ln < nunits;
        if (has_next) { S.unit(Ln, nxt); F_AROWS(nxt, rnx); }
        const char* nB = has_next ? (const char*)nxt.B : cB;
        for (int t = 0; t < nt; t += 2) {
            const bool last = (t == nt - 2);
            const char* a1 = Ab + (size_t)(t + 1) * kstep;
            const char* a2 = last ? Ab : Ab + (size_t)(t + 2) * kstep; const char* b2 = last ? nB : cB + (size_t)(t + 2) * kstep;
            const char* a3 = a2 + kstep; const char* b3 = b2 + kstep;
            F_LDB(B0, 0, 0); F_SCHED; F_LDA(At, 0, 0); F_STAGE(F_SA(1, 1), a1, voA[1]);
            if (last && has_next) F_AOFFS(rnx, voA);
            F_WAIT_L(8); F_BAR; F_WAIT_L(0); F_MMA(0, 0, At, B0); F_BAR; F_SCHED;
            F_LDB(B1, 0, 1); F_STAGE(F_SB(0, 0), b2, voffB);
            F_BAR; F_WAIT_L(0); F_MMA(0, 1, At, B1); F_BAR;
            F_LDA(At, 0, 1); F_STAGE(F_SA(0, 0), a2, voA[0]);
            F_BAR; F_WAIT_L(0); F_MMA(1, 0, At, B0); F_BAR; F_SCHED;
            F_STAGE(F_SB(0, 1), b2 + hstepB, voffB);
            F_WAIT_V(6); F_BAR; F_MMA(1, 1, At, B1); F_BAR;
            F_LDB(B0, 1, 0); F_SCHED; F_LDA(At, 1, 0); F_STAGE(F_SA(0, 1), a2, voA[1]);
            F_WAIT_L(8); F_BAR; F_WAIT_L(0); F_MMA(0, 0, At, B0); F_BAR; F_SCHED;
            F_LDB(B1, 1, 1); F_STAGE(F_SB(1, 0), b3, voffB);
            F_BAR; F_WAIT_L(0); F_MMA(0, 1, At, B1); F_BAR;
            F_LDA(At, 1, 1); F_STAGE(F_SA(1, 0), a3, voA[0]);
            F_BAR; F_WAIT_L(0); F_MMA(1, 0, At, B0); F_BAR; F_SCHED;
            F_STAGE(F_SB(1, 1), b3 + hstepB, voffB);
            F_WAIT_V(6); F_BAR; F_MMA(1, 1, At, B1); F_BAR;
        }
        E(acc, cur, wr, wc, fr, fq);
        if (!has_next) break;
#pragma unroll
        for (int a = 0; a < 2; ++a)
#pragma unroll
            for (int b = 0; b < 2; ++b)
#pragma unroll
                for (int m = 0; m < 4; ++m)
#pragma unroll
                    for (int n = 0; n < 2; ++n) acc[a][b][m][n] = (f32x4){0.f, 0.f, 0.f, 0.f};
        cur = nxt; cB = nB; ++ui;
    }
    F_WAIT_V(0);
    if (wr == 0) F_BAR;
    F_BAR;
#undef F_UNIT
#undef F_SA
#undef F_SB
#undef F_STAGE
#undef F_LDA
#undef F_LDB
#undef F_MMA
#undef F_WAIT_V
#undef F_WAIT_L
#undef F_BAR
#undef F_SCHED
#undef F_AROWS
#undef F_AOFFS
}
#define GEMM_PHASE(g, S, E) gemm_phase_fast<2>(lds, g, S, E)
#define GEMM_PHASE8(g, S, E, sa, sb) gemm_phase_fast<1>(lds, g, S, E, sa, sb)
#endif

#define SBAR() __builtin_amdgcn_sched_barrier(0)
__device__ __forceinline__ int crow(int r, int hi) { return (r & 3) + 8 * (r >> 2) + 4 * hi; }
template <int DQK> __device__ __forceinline__ int kaddr(int row, int chunk) {
    const int sw = (DQK == 128) ? (row & 7) : ((row >> 1) & 7);
    return row * (DQK * 2) + ((chunk ^ sw) << 4);
}
__device__ __forceinline__ void partialSM(f32x16& p0, f32x16& p1, float& m_reg, float& mn, float& alpha, float C, float thr) {
    float pmax = p0[0];
#pragma unroll
    for (int r = 1; r < 16; ++r) pmax = fmaxf(pmax, p0[r]);
#pragma unroll
    for (int r = 0; r < 16; ++r) pmax = fmaxf(pmax, p1[r]);
    { auto rr = __builtin_amdgcn_permlane32_swap(__float_as_uint(pmax), __float_as_uint(pmax), false, false);
      pmax = fmaxf(__uint_as_float(rr[0]), __uint_as_float(rr[1])); }
    if (__builtin_expect(__all(pmax - m_reg <= thr), 1)) { mn = m_reg; alpha = 1.f; }
    else { mn = fmaxf(m_reg, pmax); alpha = __builtin_amdgcn_exp2f((m_reg - mn) * C); m_reg = mn; }
    const float mnC = -mn * C;
#pragma unroll
    for (int r = 0; r < 16; ++r) p0[r] = fmaf(p0[r], C, mnC);
#pragma unroll
    for (int r = 0; r < 16; ++r) p1[r] = fmaf(p1[r], C, mnC);
#pragma unroll
    for (int r = 0; r < 16; ++r) p0[r] = __builtin_amdgcn_exp2f(p0[r]);
}
__device__ __forceinline__ void finishSM(f32x16& p0, f32x16& p1, float alpha, float& l_reg, bf16x8& pa0, bf16x8& pa1, bf16x8& pa2, bf16x8& pa3) {
#pragma unroll
    for (int r = 0; r < 16; ++r) p1[r] = __builtin_amdgcn_exp2f(p1[r]);
    float ps = 0;
#pragma unroll
    for (int r = 0; r < 16; ++r) ps += p0[r];
#pragma unroll
    for (int r = 0; r < 16; ++r) ps += p1[r];
    { auto rr = __builtin_amdgcn_permlane32_swap(__float_as_uint(ps), __float_as_uint(ps), false, false);
      ps = __uint_as_float(rr[0]) + __uint_as_float(rr[1]); }
    l_reg = l_reg * alpha + ps;
#define PK4(P, BASE, OUT) do { unsigned a0 = pk2(P[BASE + 0], P[BASE + 1]), a1 = pk2(P[BASE + 2], P[BASE + 3]);   \
    unsigned b0 = pk2(P[BASE + 4], P[BASE + 5]), b1 = pk2(P[BASE + 6], P[BASE + 7]);                              \
    auto r0 = __builtin_amdgcn_permlane32_swap(a0, b0, false, false); auto r1 = __builtin_amdgcn_permlane32_swap(a1, b1, false, false); \
    u32x4 w = {r0[0], r1[0], r0[1], r1[1]}; OUT = *reinterpret_cast<bf16x8*>(&w); } while (0)
    PK4(p0, 0, pa0); PK4(p0, 8, pa1); PK4(p1, 0, pa2); PK4(p1, 8, pa3);
#undef PK4
}
template <int DQK> __device__ __forceinline__ void qkt(f32x16& p0, f32x16& p1, const char* Ks, const bf16x8* qr, int r32, int hi) {
    p0 = f32x16{}; p1 = f32x16{};
#pragma unroll
    for (int d0 = 0; d0 < DQK / 16; ++d0) { const int ch = 2 * d0 + hi;
        const bf16x8 b0 = *reinterpret_cast<const bf16x8*>(Ks + kaddr<DQK>(r32, ch));
        const bf16x8 b1 = *reinterpret_cast<const bf16x8*>(Ks + kaddr<DQK>(32 + r32, ch));
        p0 = __builtin_amdgcn_mfma_f32_32x32x16_bf16(b0, qr[d0], p0, 0, 0, 0);
        p1 = __builtin_amdgcn_mfma_f32_32x32x16_bf16(b1, qr[d0], p1, 0, 0, 0); }
}
__device__ __forceinline__ int v_st(int k, int c) { const int kk = (k & ~0xC) | ((k & 4) << 1) | ((k & 8) >> 1); return ((kk >> 3) * 4 + (c >> 5)) * 512 + ((kk & 7) * 32 + (c & 31)) * 2; }
__device__ __forceinline__ int v_rd_base(int lane) { return ((lane & 3) << 3) | (((lane >> 2) & 3) << 6) | (((lane >> 4) & 1) << 5) | (((lane >> 5) & 1) << 8); }
constexpr int v_rd_off(int d0, int ks, int half) { return d0 * 512 + ks * 4096 + half * 2048; }
template <int OFF> __device__ __forceinline__ s16x4 tr_read(int vb) {
    s16x4 r; asm volatile("ds_read_b64_tr_b16 %0, %1 offset:%2" : "=&v"(r) : "v"(vb), "i"(OFF) : "memory"); return r;
}
template <int D0> __device__ __forceinline__ void pv_one(f32x16& od, int vb, bf16x8 pa0, bf16x8 pa1, bf16x8 pa2, bf16x8 pa3) {
    const s16x4 l0 = tr_read<v_rd_off(D0, 0, 0)>(vb), h0 = tr_read<v_rd_off(D0, 0, 1)>(vb), l1 = tr_read<v_rd_off(D0, 1, 0)>(vb), h1 = tr_read<v_rd_off(D0, 1, 1)>(vb);
    const s16x4 l2 = tr_read<v_rd_off(D0, 2, 0)>(vb), h2 = tr_read<v_rd_off(D0, 2, 1)>(vb), l3 = tr_read<v_rd_off(D0, 3, 0)>(vb), h3 = tr_read<v_rd_off(D0, 3, 1)>(vb);
    asm volatile("s_waitcnt lgkmcnt(0)" ::: "memory"); SBAR();
#define PK(L, H) (bf16x8){L[0], L[1], L[2], L[3], H[0], H[1], H[2], H[3]}
    od = __builtin_amdgcn_mfma_f32_32x32x16_bf16(pa0, PK(l0, h0), od, 0, 0, 0);
    od = __builtin_amdgcn_mfma_f32_32x32x16_bf16(pa1, PK(l1, h1), od, 0, 0, 0);
    od = __builtin_amdgcn_mfma_f32_32x32x16_bf16(pa2, PK(l2, h2), od, 0, 0, 0);
    od = __builtin_amdgcn_mfma_f32_32x32x16_bf16(pa3, PK(l3, h3), od, 0, 0, 0);
#undef PK
}
__device__ __forceinline__ void pv_d0(f32x16* o, int vb, bf16x8 pa0, bf16x8 pa1, bf16x8 pa2, bf16x8 pa3) {
    pv_one<0>(o[0], vb, pa0, pa1, pa2, pa3); pv_one<1>(o[1], vb, pa0, pa1, pa2, pa3); pv_one<2>(o[2], vb, pa0, pa1, pa2, pa3); pv_one<3>(o[3], vb, pa0, pa1, pa2, pa3);
}

template <int DQK, int SDEPTH>
__device__ __forceinline__ void attn_body(const bf16_t* __restrict__ Qb, const bf16_t* __restrict__ Kh, const bf16_t* __restrict__ Vh, bf16_t* __restrict__ Ob, int ldo, int nkeys, float scale, char* lds) {
    constexpr int SHM_V = 64 * 128 * 2, SHM_K = 64 * DQK * 2, NKC = DQK / 8, KPT = NKC / 8;
    int tid = otid();
    const int wid = __builtin_amdgcn_readfirstlane(tid >> 6), lane = tid & 63, r32 = lane & 31, hi = lane >> 5;
    char* V_lds = lds; char* K_lds = lds + 2 * SHM_V;
    float* ws = (float*)(lds + 2 * SHM_V + 2 * SHM_K) + wid * 64; float* li_l = ws; float* al_l = ws + 32;
    const float C = scale * 1.4426950408889634f, thr = 8.0f / scale;
    float m_reg = -1e30f, l_reg = 0; f32x16 o[4] = {}; bf16x8 qr[DQK / 16];
    const bf16_t* Qw = Qb + (long)(wid * 32 + r32) * DQK + hi * 8;
#pragma unroll
    for (int d0 = 0; d0 < DQK / 16; ++d0) qr[d0] = *reinterpret_cast<const bf16x8*>(Qw + d0 * 16);
    const int sr = tid >> 4, sc = (tid & 15) * 8, vst0 = v_st(sr, sc), vst1 = v_st(32 + sr, sc);
    int kgo[KPT], klo[KPT];
#pragma unroll
    for (int i = 0; i < KPT; ++i) { const int q = tid + 512 * i, row = q / NKC, ch = q % NKC; kgo[i] = row * DQK + ch * 8; klo[i] = kaddr<DQK>(row, ch); }
    const int vb0 = (int)(uintptr_t)V_lds + v_rd_base(lane);
    struct { bf16x8 vs0, vs1, ks[KPT]; } sr_[SDEPTH ? SDEPTH : 1];
#define SLOAD(i, k0) do { sr_[i].vs0 = *reinterpret_cast<const bf16x8*>(&Vh[(long)((k0) + sr) * 128 + sc]); sr_[i].vs1 = *reinterpret_cast<const bf16x8*>(&Vh[(long)((k0) + 32 + sr) * 128 + sc]); \
    _Pragma("unroll") for (int _q = 0; _q < KPT; ++_q) sr_[i].ks[_q] = *reinterpret_cast<const bf16x8*>(&Kh[(long)(k0) * DQK + kgo[_q]]); } while (0)
#define SWRITE(b, i) do { *(bf16x8*)(V_lds + (b) * SHM_V + vst0) = sr_[i].vs0; *(bf16x8*)(V_lds + (b) * SHM_V + vst1) = sr_[i].vs1; \
    _Pragma("unroll") for (int _q = 0; _q < KPT; ++_q) *(bf16x8*)(K_lds + (b) * SHM_K + klo[_q]) = sr_[i].ks[_q]; } while (0)
#define SWAIT() do { if constexpr (SDEPTH == 2) { if constexpr (KPT == 2) asm volatile("s_waitcnt vmcnt(4)" ::: "memory"); else asm volatile("s_waitcnt vmcnt(5)" ::: "memory"); } \
    else asm volatile("s_waitcnt vmcnt(0)" ::: "memory"); } while (0)
#define RESC(a) do { if (__any((a) < 1.f)) { if (hi == 0) al_l[r32] = (a); asm volatile("s_waitcnt lgkmcnt(0)" ::: "memory"); \
    _Pragma("unroll") for (int d = 0; d < 4; ++d) _Pragma("unroll") for (int r = 0; r < 16; ++r) o[d][r] *= al_l[crow(r, hi)]; } } while (0)
    bf16x8 pa0, pa1, pa2, pa3; const int NT = nkeys / 64;
    if constexpr (SDEPTH == 0) {
        f32x16 pA0, pA1; float mnA, alA;
        SLOAD(0, 0); asm volatile("s_waitcnt vmcnt(0)" ::: "memory"); SWRITE(0, 0); __syncthreads();
        for (int j = 0; j < NT; ++j) {
            const int bo = j & 1;
            if (j + 1 < NT) SLOAD(0, (j + 1) * 64);
            SBAR(); qkt<DQK>(pA0, pA1, K_lds + bo * SHM_K, qr, r32, hi); partialSM(pA0, pA1, m_reg, mnA, alA, C, thr);
            RESC(alA); finishSM(pA0, pA1, alA, l_reg, pa0, pa1, pa2, pa3); SBAR();
            pv_d0(o, vb0 + bo * SHM_V, pa0, pa1, pa2, pa3);
            if (j + 1 < NT) { asm volatile("s_waitcnt vmcnt(0)" ::: "memory"); SWRITE(bo ^ 1, 0); }
            __syncthreads();
        }
    } else {
    f32x16 pA0, pA1, pB0, pB1; float mnA, mnB, alA, alB;
    constexpr int SE = 0, SO = SDEPTH - 1;
    SLOAD(SE, 0); asm volatile("s_waitcnt vmcnt(0)" ::: "memory"); SWRITE(0, SE); __syncthreads();
    qkt<DQK>(pA0, pA1, K_lds, qr, r32, hi); partialSM(pA0, pA1, m_reg, mnA, alA, C, thr);
    SLOAD(SO, 64); if constexpr (SDEPTH == 2) { if (2 < NT) SLOAD(SE, 2 * 64); }
    SWAIT(); SWRITE(1, SO); __syncthreads();
    for (int j = 1; j + 1 < NT; j += 2) {
        SBAR(); qkt<DQK>(pB0, pB1, K_lds + SHM_K, qr, r32, hi);
        finishSM(pA0, pA1, alA, l_reg, pa0, pa1, pa2, pa3); SBAR();
        SLOAD(SO, (j + SDEPTH) * 64); SBAR();
        pv_d0(o, vb0, pa0, pa1, pa2, pa3); partialSM(pB0, pB1, m_reg, mnB, alB, C, thr);
        __syncthreads(); SWAIT(); SWRITE(0, SE);
        RESC(alB); __syncthreads();
        SBAR(); qkt<DQK>(pA0, pA1, K_lds, qr, r32, hi);
        finishSM(pB0, pB1, alB, l_reg, pa0, pa1, pa2, pa3); SBAR();
        if (SDEPTH == 1 || j + 3 < NT) SLOAD(SE, (j + 1 + SDEPTH) * 64); SBAR();
        pv_d0(o, vb0 + SHM_V, pa0, pa1, pa2, pa3); partialSM(pA0, pA1, m_reg, mnA, alA, C, thr);
        __syncthreads(); SWAIT(); SWRITE(1, SO);
        RESC(alA); __syncthreads();
    }
    SBAR(); qkt<DQK>(pB0, pB1, K_lds + SHM_K, qr, r32, hi);
    finishSM(pA0, pA1, alA, l_reg, pa0, pa1, pa2, pa3); SBAR();
    pv_d0(o, vb0, pa0, pa1, pa2, pa3); partialSM(pB0, pB1, m_reg, mnB, alB, C, thr);
    __syncthreads(); RESC(alB);
    finishSM(pB0, pB1, alB, l_reg, pa0, pa1, pa2, pa3); SBAR();
    pv_d0(o, vb0 + SHM_V, pa0, pa1, pa2, pa3);
    }
    if (hi == 0) li_l[r32] = l_reg; asm volatile("s_waitcnt lgkmcnt(0)" ::: "memory");
    float rli[16];
#pragma unroll
    for (int r = 0; r < 16; ++r) rli[r] = __builtin_amdgcn_rcpf(li_l[crow(r, hi)]);
    bf16_t* Ow = Ob + (long)(wid * 32) * ldo;
#pragma unroll
    for (int r = 0; r < 16; ++r) { const int orow = crow(r, hi);
#pragma unroll
        for (int d0 = 0; d0 < 4; ++d0) {
#if WOUT8
            ((unsigned char*)Ob)[(long)(wid * 32 + orow) * ldo + d0 * 32 + r32] = (unsigned char)(pk4_fp8(o[d0][r] * rli[r] * MIX8_SCALE, 0.f, 0.f, 0.f) & 0xffu);
#else
            Ow[(long)orow * ldo + d0 * 32 + r32] = f2bf(o[d0][r] * rli[r]);
#endif
        } }
    __syncthreads();
#undef SLOAD
#undef SWRITE
#undef SWAIT
#undef RESC
}

struct CvtMat { const float* src; bf16_t* dst; const float* kscale; int N, lddst, nb, mode; };
__device__ __forceinline__ void cvt_block(const CvtMat& m, int kb, int nbk, int lane) {
    const int a = lane & 7, ng = lane >> 3, k0 = kb * 64 + 8 * a, n0 = nbk * 32 + 4 * ng;
    const float* s = m.src + (size_t)k0 * m.N + n0;
    f32x4 v[8];
#pragma unroll
    for (int j = 0; j < 8; ++j) v[j] = *(const f32x4*)(s + (size_t)j * m.N);
    if (m.kscale) {
#pragma unroll
        for (int j = 0; j < 8; ++j) v[j] *= m.kscale[k0 + j];
    }
#pragma unroll
    for (int i = 0; i < 4; ++i) { const int n = n0 + i, row = (m.mode == 0) ? n : ((n >> 7) * 256 + (n & 127) + (m.mode - 1) * 128);
        u32x4 w; w.x = pk2(v[0][i], v[1][i]); w.y = pk2(v[2][i], v[3][i]); w.z = pk2(v[4][i], v[5][i]); w.w = pk2(v[6][i], v[7][i]);
        *(u32x4*)(m.dst + (size_t)row * m.lddst + k0) = w; }
}
__device__ __forceinline__ void cvt_block8(const CvtMat& m, unsigned char* dst8, int kb, int nbk, int lane) {
    const int a = lane & 7, ng = lane >> 3, k0 = kb * 64 + 8 * a, n0 = nbk * 32 + 4 * ng;
    const float* s = m.src + (size_t)k0 * m.N + n0;
    f32x4 v[8];
#pragma unroll
    for (int j = 0; j < 8; ++j) v[j] = *(const f32x4*)(s + (size_t)j * m.N) * W8_SCALE;
#pragma unroll
    for (int i = 0; i < 4; ++i) { const int n = n0 + i, row = (m.mode == 0) ? n : ((n >> 7) * 256 + (n & 127) + (m.mode - 1) * 128);
        u32x2 w; w.x = pk4_fp8(v[0][i], v[1][i], v[2][i], v[3][i]); w.y = pk4_fp8(v[4][i], v[5][i], v[6][i], v[7][i]);
        *(u32x2*)(dst8 + (size_t)row * m.lddst + k0) = w; }
}
constexpr int CVT_SMALL = 3904 + 2048 + 432 + 192;
__device__ __forceinline__ void cvt_small_task(const Params& p, int l, int t, int lane) {
    unsigned char* ws = p.ws; CvtMat m; int which_ = 3;
    if (t < 3904) { which_ = 0; m = CvtMat{p.in[I_WIN] + (size_t)l * DM * IN_COLS, (bf16_t*)(ws + O_WIN) + (size_t)l * NP * DM, nullptr, IN_COLS, DM, 122, 0}; }
    else if ((t -= 3904) < 2048) { which_ = 1; m = CvtMat{p.in[I_WOUT] + (size_t)l * DM * DM, (bf16_t*)(ws + O_WOUT) + (size_t)l * DM * DM, nullptr, DM, DM, 64, 0}; }
    else if ((t -= 2048) < 432) { m = CvtMat{p.in[I_WUQ] + (size_t)l * 768 * 1152, (bf16_t*)(ws + O_WUQ) + (size_t)l * NQP * 768, p.in[I_MQN] + l * 768, 1152, 768, 36, 0}; }
    else { t -= 432; m = CvtMat{p.in[I_WUKV] + (size_t)l * 256 * 1536, (bf16_t*)(ws + O_WUKV) + (size_t)l * 1536 * 256, p.in[I_MKVN] + l * 256, 1536, 256, 48, 0}; }
    if (WIN8 && which_ == 0) cvt_block8(m, p.ws + O_WIN + (size_t)l * NP * DM, t / m.nb, t % m.nb, lane);
    else if (WOUT8 && which_ == 1) cvt_block8(m, p.ws + O_WOUT + (size_t)l * DM * DM, t / m.nb, t % m.nb, lane);
    else cvt_block(m, t / m.nb, t % m.nb, lane);
}
constexpr int CVT_EXP = 65 * 1536;
__device__ __forceinline__ void cvt_exp_task(const Params& p, int l, int t, int lane) {
    unsigned char* ws = p.ws;
    const int e = t / 1536, r = t % 1536, which = r >> 9, q = r & 511; CvtMat m;
    if (which < 2) {
        const float* src = (e < NEXP) ? p.in[which == 0 ? I_EG : I_EU] + ((size_t)l * NEXP + e) * DM * EH : p.in[which == 0 ? I_SG : I_SU] + (size_t)l * DM * EH;
        m = CvtMat{src, (bf16_t*)(ws + O_EGU) + (size_t)e * 1024 * 2048, nullptr, EH, DM, 16, 1 + which};
    } else {
        const float* src = (e < NEXP) ? p.in[I_EDN] + ((size_t)l * NEXP + e) * EH * DM : p.in[I_SD] + (size_t)l * EH * DM;
        m = CvtMat{src, (bf16_t*)(ws + O_ED) + (size_t)e * 2048 * 512, nullptr, DM, EH, 64, 0};
    }
#if MOE_FP8
    cvt_block8(m, which < 2 ? p.ws + O_EGU + (size_t)e * 1024 * 2048 : p.ws + O_ED + (size_t)e * 2048 * 512, q / m.nb, q % m.nb, lane);
#else
    cvt_block(m, q / m.nb, q % m.nb, lane);
#endif
}
__device__ __forceinline__ void cvt_exp_all(const Params& p, int l) {
    const int lane = otid() & 63, gw = blockIdx.x * 8 + owid(), GW = gridDim.x * 8;
    for (int t = gw; t < CVT_EXP; t += GW) cvt_exp_task(p, l, t, lane);
}
__device__ __forceinline__ void adaln_tasks(const Params& p, LAS float* lf) {
    const int lane = otid() & 63, wid = owid();
    float* MOD = (float*)(p.ws + O_MOD);
    for (int task = blockIdx.x; task < 384; task += gridDim.x) {
        const int cb = task % 192, l = task / 192, col = cb * 64 + lane;
        const float* W = p.in[I_ADAW] + (size_t)l * DM * 12288 + col;
        float acc[9];
#pragma unroll
        for (int r = 0; r < 9; ++r) acc[r] = 0.f;
        for (int kb = wid * 256; kb < wid * 256 + 256; kb += 64) {
            float sv[9];
#pragma unroll
            for (int r = 0; r < 8; ++r) sv[r] = silu_f(p.in[I_C][r * DM + kb + lane]);
            sv[8] = silu_f(p.in[I_CCTX][kb + lane]);
#pragma unroll 8
            for (int kk = 0; kk < 64; ++kk) { const float w = W[(size_t)(kb + kk) * 12288];
#pragma unroll
                for (int r = 0; r < 9; ++r) acc[r] += rdlane(sv[r], kk) * w; }
        }
#pragma unroll
        for (int r = 0; r < 9; ++r) lf[(wid * 9 + r) * 64 + lane] = acc[r];
        __syncthreads();
        for (int r = wid; r < 9; r += 8) { float s = p.in[I_ADAB][l * 12288 + col];
#pragma unroll
            for (int w = 0; w < 8; ++w) s += lf[(w * 9 + r) * 64 + lane];
            MOD[(size_t)(l * 9 + r) * 12288 + col] = s; }
        __syncthreads();
    }
}
__device__ __forceinline__ void hss_tasks(const Params& p) {
    const int lane = otid() & 63, gw = blockIdx.x * 8 + owid(), GW = gridDim.x * 8;
    for (int task = gw; task < 3 * 1024; task += GW) {
        const int set = task >> 10, l = (set == 1) ? 1 : 0, nset = (set == 2) ? 1 : 0, ord = (task >> 9) & 1, ch = task & 511, n = nset ? 256 : 2048;
        const float* HF = (const float*)(p.ws + O_HF) + (size_t)l * HF_LAYER + (nset ? HF_L0 : 0);
        const float* hf = HF + (size_t)((ord * 2 + 0) * 512 + ch) * n; const float* hb = HF + (size_t)((ord * 2 + 1) * 512 + ch) * n;
        float s = 0.f;
        for (int i = lane; i < n; i += 64) { const float a = hf[i], b = (i == 0) ? 0.f : hb[i]; s += a * a + b * b; }
        s = wave_sum(s);
        if (lane == 0) ((float*)(p.ws + O_HSS))[(size_t)((l * 2 + nset) * 2 + ord) * 512 + ch] = s;
    }
}
__device__ __forceinline__ void hyf_task(const Params& p, int l, int nset, int i0, LAS float* lf) {
    int tid = otid(); const int n = nset ? 256 : 2048;
    LAS float* feats = lf; LAS float* hd1 = lf + 8 * 33; LAS float* hd2 = hd1 + 512;
    if (tid < 8 * 33) { const int pos = tid / 33, f = tid % 33, i = i0 + pos; const float t = (float)i / (float)(n - 1), ang = 6.283185307179586f * (float)i / (float)n; float v;
        if (f == 0) v = t; else { const int j = (f - 1) & 15; const float band = 1e-4f + (float)j * ((15.0f - 1e-4f) / 15.0f); v = (f <= 16) ? cosf(ang * band) : sinf(ang * band); }
        feats[tid] = v; }
    __syncthreads();
    { const int pos = tid >> 6, j = tid & 63; const float* w1 = p.in[I_HYW1] + l * 33 * 64; float s = p.in[I_HYB1][l * 64 + j];
      for (int f = 0; f < 33; ++f) s += feats[pos * 33 + f] * w1[f * 64 + j];
      hd1[tid] = sinf(p.in[I_HYFREQ][l * 64 + j] * s); }
    __syncthreads();
    { const int pos = tid >> 6, j = tid & 63; const float* w2 = p.in[I_HYW2] + l * 64 * 64; float s = p.in[I_HYB2][l * 64 + j];
      for (int f = 0; f < 64; ++f) s += hd1[pos * 64 + f] * w2[f * 64 + j];
      hd2[tid] = sinf(p.in[I_HYFREQ][l * 64 + j] * s); }
    __syncthreads();
    const float* w3 = p.in[I_HYW3] + (size_t)l * 64 * 2048 + tid * 4;
    f32x4 acc[8];
#pragma unroll
    for (int q = 0; q < 8; ++q) acc[q] = (f32x4){0.f, 0.f, 0.f, 0.f};
    for (int j = 0; j < 64; ++j) { const f32x4 w = *(const f32x4*)(w3 + (size_t)j * 2048);
#pragma unroll
        for (int q = 0; q < 8; ++q) acc[q] += w * hd2[q * 64 + j]; }
    float* HF = (float*)(p.ws + O_HF) + (size_t)l * HF_LAYER + (nset ? HF_L0 : 0);
#pragma unroll
    for (int c = 0; c < 4; ++c) { const int col = tid * 4 + c, ord = col >> 10, dir = (col >> 9) & 1, ch = col & 511;
        const float delta = 3.0701134573253944f + (float)ch * ((15.350567286626973f - 3.0701134573253944f) / 511.0f); float v[8];
#pragma unroll
        for (int q = 0; q < 8; ++q) { const int i = i0 + q; const float t = (float)i / (float)(n - 1); v[q] = acc[q][c] * __expf(-t * delta); }
        float* dst = HF + (size_t)((ord * 2 + dir) * 512 + ch) * n + i0;
        *(f32x4*)dst = (f32x4){v[0], v[1], v[2], v[3]}; *(f32x4*)(dst + 4) = (f32x4){v[4], v[5], v[6], v[7]};    }
    __syncthreads();
}
__device__ __forceinline__ void rope_tables(const Params& p);
__device__ __forceinline__ void phase_prologue(const Params& p, LAS unsigned char* lds) {
    const int tid = otid(); LAS float* lf = (LAS float*)lds;
    { const size_t gt = (size_t)blockIdx.x * NTHREADS + tid, GT = (size_t)gridDim.x * NTHREADS;
      for (int l = 0; l < NLAYER; ++l) {
          u32x4* z1 = WIN8 ? (u32x4*)(p.ws + O_WIN + ((size_t)l * NP + IN_COLS) * DM) : (u32x4*)((bf16_t*)(p.ws + O_WIN) + ((size_t)l * NP + IN_COLS) * DM); const size_t n1 = (size_t)(NP - IN_COLS) * DM * (WIN8 ? 1 : 2) / 16;
          for (size_t i = gt; i < n1; i += GT) z1[i] = (u32x4){0u, 0u, 0u, 0u};
          u32x4* z2 = (u32x4*)((bf16_t*)(p.ws + O_WUQ) + ((size_t)l * NQP + 1152) * 768); const size_t n2 = (size_t)(NQP - 1152) * 768 * 2 / 16;
          for (size_t i = gt; i < n2; i += GT) z2[i] = (u32x4){0u, 0u, 0u, 0u};
      } }
    rope_tables(p);
    adaln_tasks(p, lf);
    for (int t = blockIdx.x; t < 544; t += gridDim.x) { if (t < 512) hyf_task(p, t >> 8, 0, (t & 255) * 8, lf); else hyf_task(p, 0, 1, (t - 512) * 8, lf); }
    { const int lane = tid & 63, gw = blockIdx.x * 8 + owid(), GW = gridDim.x * 8;
      for (int t = gw; t < NLAYER * CVT_SMALL; t += GW) cvt_small_task(p, t / CVT_SMALL, t % CVT_SMALL, lane); }
    cvt_exp_all(p, 0);
}

__device__ __forceinline__ void norm1_row(const Params& p, int l, int row, const float (&x)[32], int lane) {
    float ss = 0.f;
#pragma unroll
    for (int i = 0; i < 32; ++i) ss += x[i] * x[i];
    ss = wave_sum(ss); const float rstd = rsqrtf(ss * (1.0f / DM) + EPS);
    const float* g = p.in[I_NORMG] + (size_t)(l * 4 + 0) * DM; const float* mod = (const float*)(p.ws + O_MOD) + (size_t)(l * 9 + row_batch(row)) * 12288;
    bf16_t* H = (bf16_t*)(p.ws + O_H) + (size_t)row * DM;
#pragma unroll
    for (int j = 0; j < 8; ++j) { const int c = ROWCOL(j, lane); const f32x4 gv = *(const f32x4*)(g + c), sh = *(const f32x4*)(mod + c), sc = *(const f32x4*)(mod + DM + c); float h[4];
#pragma unroll
        for (int q = 0; q < 4; ++q) h[q] = x[j * 4 + q] * rstd * gv[q] * (1.0f + sc[q]) + sh[q];
#if WIN8
        *(unsigned*)((unsigned char*)(p.ws + O_H) + (size_t)row * DM + c) = pk4_fp8(h[0], h[1], h[2], h[3]);
#else
        u32x2 w; w.x = pk2(h[0], h[1]); w.y = pk2(h[2], h[3]); *(u32x2*)(H + c) = w;
#endif
    }
}
__device__ __forceinline__ void phase_norm1(const Params& p, int l) {
    const int lane = otid() & 63, gw = blockIdx.x * 8 + owid(), GW = gridDim.x * 8;
    const int lane0 = lane;
    for (int row = gw; row < NTOK; row += GW) { int lane = lane0; asm volatile("" : "+v"(lane)); const float* src = resid_src(p, l, row); float x[32];
#pragma unroll
        for (int j = 0; j < 8; ++j) { const f32x4 v = *(const f32x4*)(src + ROWCOL(j, lane)); x[j * 4] = v[0]; x[j * 4 + 1] = v[1]; x[j * 4 + 2] = v[2]; x[j * 4 + 3] = v[3]; }
        norm1_row(p, l, row, x, lane); }
}

__device__ __forceinline__ void rope_tables(const Params& p) {
    float* T = (float*)(p.ws + O_ROPE);
    for (int i = blockIdx.x * NTHREADS + otid(); i < 64 * 32 + 64 * 16; i += gridDim.x * NTHREADS) {
        float a; if (i < 64 * 32) a = (float)(i >> 5) * exp2f(-(float)(i & 31) * (13.287712379549449f / 32.0f)); else { const int q = i - 64 * 32; a = (float)(q >> 4) * exp2f(-(float)(q & 15) * (13.287712379549449f / 16.0f)); }
        float sn, cs; sincosf(a, &sn, &cs); T[2 * i] = cs; T[2 * i + 1] = sn; }
}
__device__ __forceinline__ void unpack8(const u32x4 v, float (&x)[8]) {
#pragma unroll
    for (int j = 0; j < 4; ++j) { x[2 * j] = __uint_as_float(v[j] << 16); x[2 * j + 1] = __uint_as_float(v[j] & 0xffff0000u); }
}
__device__ __forceinline__ u32x4 pack8(const float (&x)[8]) { u32x4 w; w.x = pk2(x[0], x[1]); w.y = pk2(x[2], x[3]); w.z = pk2(x[4], x[5]); w.w = pk2(x[6], x[7]); return w; }
template <int PX> __device__ __forceinline__ void rope8(float (&x)[8], const float* cs, bool second) {
#pragma unroll
    for (int j = 0; j < 8; ++j) { const float pr = __shfl_xor(x[j], PX), c = cs[2 * j], sn = cs[2 * j + 1]; x[j] = second ? pr * sn + x[j] * c : x[j] * c - pr * sn; }
}
__device__ __forceinline__ void gqa_post_row(const Params& p, int l, int row, int lane) {
    const bf16_t* P = (const bf16_t*)(p.ws + O_P) + (size_t)row * NP;
    const bool isctx = row >= NLAT; const int b = isctx ? (row - NLAT) >> 8 : row >> 11, t = isctx ? (row - NLAT) & 255 : row & 2047;
    const int j = lane & 15, hq = lane >> 4, half = j >> 3; const bool second = (j >> 2) & 1;
    const float* cs = (const float*)(p.ws + O_ROPE) + ((size_t)(half ? (t & 63) : (t >> 6)) * 32 + 8 * (j & 3)) * 2;
    const int kpos = isctx ? t : CTXL + t;
#pragma unroll
    for (int ps = 0; ps < 2; ++ps) {
        const bool isk = (ps == 1) && (hq >= 2); const int h = (ps == 0) ? hq : (isk ? hq - 2 : 4 + hq);
        const bf16_t* src = P + (isk ? C_GK : C_GQ) + h * 128 + 8 * j; const float* gn = (isk ? p.in[I_GKN] : p.in[I_GQN]) + l * 128 + 8 * j;
        float x[8]; unpack8(*(const u32x4*)src, x);
        float ss = 0.f;
#pragma unroll
        for (int q = 0; q < 8; ++q) ss += x[q] * x[q];
        ss += __shfl_xor(ss, 1); ss += __shfl_xor(ss, 2); ss += __shfl_xor(ss, 4); ss += __shfl_xor(ss, 8);
        const float rstd = rsqrtf(ss * (1.0f / 128.0f) + EPS); const f32x4 g0 = *(const f32x4*)gn, g1 = *(const f32x4*)(gn + 4);
#pragma unroll
        for (int q = 0; q < 4; ++q) { x[q] *= rstd * g0[q]; x[4 + q] *= rstd * g1[q]; }
        if (!isctx) rope8<4>(x, cs, second);
        bf16_t* dst = isk ? (bf16_t*)(p.ws + O_KG) + ((size_t)(b * 2 + h) * LK + kpos) * 128
                          : (isctx ? (bf16_t*)(p.ws + O_QGC) + ((size_t)(b * 6 + h) * CTXL + t) * 128 : (bf16_t*)(p.ws + O_QG) + ((size_t)(b * 6 + h) * SEQ + t) * 128);
        *(u32x4*)(dst + 8 * j) = pack8(x);
    }
    if (lane < 32) { const int h = lane >> 4; *(u32x4*)((bf16_t*)(p.ws + O_VG) + ((size_t)(b * 2 + h) * LK + kpos) * 128 + 8 * j) = *(const u32x4*)(P + C_GV + h * 128 + 8 * j); }
}
__device__ __forceinline__ void seq_of(int row, int& s0, int& n) { if (row < NLAT) { s0 = row & ~2047; n = SEQ; } else { s0 = NLAT + ((row - NLAT) & ~255); n = CTXL; } }
__device__ __forceinline__ void load_conv_tile(const bf16_t* P, int t0, int pc0, LAS float* u) {
    int s0, n; seq_of(t0, s0, n);
    for (int i = otid(); i < 66 * 8; i += NTHREADS) { const int r = i >> 3, c = (i & 7) * 8, row = t0 - 1 + r;
        float x[8];
        if (row >= s0 && row < s0 + n) { const u32x4 v = *(const u32x4*)(P + (size_t)row * NP + pc0 + c);
#pragma unroll
            for (int j = 0; j < 4; ++j) { x[2 * j] = __uint_as_float(v[j] << 16); x[2 * j + 1] = __uint_as_float(v[j] & 0xffff0000u); } }
        else {
#pragma unroll
            for (int j = 0; j < 8; ++j) x[j] = 0.f; }
#pragma unroll
        for (int j = 0; j < 8; ++j) u[r * 65 + c + j] = x[j]; }
}
__device__ __forceinline__ void hy_prep_task(const Params& p, int l, int t0, int c0, LAS float* u) {
    const bf16_t* P = (const bf16_t*)(p.ws + O_P);
    load_conv_tile(P, t0, c0, u);
    __syncthreads();
    const int tid = otid(), c = tid >> 3, tc = (tid & 7) * 8; const float* cw = p.in[I_HYCONV] + (size_t)l * 3 * 1536 + c0 + c;
    const float w0 = cw[0], w1 = cw[1536], w2 = cw[3072]; float y[8];
#pragma unroll
    for (int j = 0; j < 8; ++j) y[j] = w0 * u[(tc + j) * 65 + c] + w1 * u[(tc + j + 1) * 65 + c] + w2 * u[(tc + j + 2) * 65 + c];
    const int ch = c0 + c; bf16_t* dst = (ch < 512 ? (bf16_t*)(p.ws + O_VT) + (size_t)ch * NTOK : (bf16_t*)(p.ws + O_X1T) + (size_t)(ch - 512) * NTOK) + t0 + tc;
    u32x4 w; w.x = pk2(y[0], y[1]); w.y = pk2(y[2], y[3]); w.z = pk2(y[4], y[5]); w.w = pk2(y[6], y[7]); *(u32x4*)dst = w;
    __syncthreads();
}
__device__ __forceinline__ void mla_post_row(const Params& p, int l, int row, int lane) {
    const bf16_t* P = (const bf16_t*)(p.ws + O_P) + (size_t)row * NP;
    const bool isctx = row >= NLAT; const int b = isctx ? (row - NLAT) >> 8 : row >> 11, t = isctx ? (row - NLAT) & 255 : row & 2047;
    float sq = 0.f, skv = 0.f; float x[8];
    unpack8(*(const u32x4*)(P + C_CQ + 8 * lane), x);
#pragma unroll
    for (int q = 0; q < 8; ++q) sq += x[q] * x[q];
    if (lane < 32) { unpack8(*(const u32x4*)(P + C_CQ + 512 + 8 * lane), x);
#pragma unroll
        for (int q = 0; q < 8; ++q) sq += x[q] * x[q];
        unpack8(*(const u32x4*)(P + C_CKV + 8 * lane), x);
#pragma unroll
        for (int q = 0; q < 8; ++q) skv += x[q] * x[q]; }
    const float rq = rsqrtf(wave_sum(sq) * (1.0f / 768.0f) + EPS), rkv = rsqrtf(wave_sum(skv) * (1.0f / 256.0f) + EPS);
    const bf16_t* QR = (const bf16_t*)(p.ws + O_QRAW) + (size_t)row * NQP; const bf16_t* KV = (const bf16_t*)(p.ws + O_KVRAW) + (size_t)row * 1536;
    const int kpos = isctx ? t : CTXL + t;
    const float* RM = (const float*)(p.ws + O_ROPE) + 64 * 32 * 2;
#pragma unroll
    for (int ps = 0; ps < 3; ++ps) { const int id = ps * 64 + lane; const bool act = id < 144; const int h = act ? id / 24 : 0, cj = act ? id % 24 : 0, rc = cj - 16;
        unpack8(*(const u32x4*)(QR + h * 192 + 8 * cj), x);
#pragma unroll
        for (int q = 0; q < 8; ++q) x[q] *= rq;
        if (!isctx) { const int rcc = rc < 0 ? 0 : rc; const float* cs = RM + ((size_t)((rcc >> 2) ? (t & 63) : (t >> 6)) * 16 + 8 * (rcc & 1)) * 2; float y[8];
#pragma unroll
            for (int q = 0; q < 8; ++q) y[q] = x[q];
            rope8<2>(y, cs, (rcc >> 1) & 1);
            if (rc >= 0) {
#pragma unroll
                for (int q = 0; q < 8; ++q) x[q] = y[q]; } }
        bf16_t* qd = isctx ? (bf16_t*)(p.ws + O_QMC) + ((size_t)(b * 6 + h) * CTXL + t) * 192 : (bf16_t*)(p.ws + O_QM) + ((size_t)(b * 6 + h) * SEQ + t) * 192;
        if (act) *(u32x4*)(qd + 8 * cj) = pack8(x); }
#pragma unroll
    for (int ps = 0; ps < 3; ++ps) { const int id = ps * 64 + lane, h = id >> 5, c = id & 31;
        unpack8(*(const u32x4*)(KV + h * 256 + 8 * c), x);
#pragma unroll
        for (int q = 0; q < 8; ++q) x[q] *= rkv;
        bf16_t* d = (c < 16) ? (bf16_t*)(p.ws + O_KM) + ((size_t)(b * 6 + h) * LK + kpos) * 192 + 8 * c : (bf16_t*)(p.ws + O_VM) + ((size_t)(b * 6 + h) * LK + kpos) * 128 + 8 * (c - 16);
        *(u32x4*)d = pack8(x); }
    { const int h = lane >> 3, rc = lane & 7; unpack8(*(const u32x4*)(P + C_KR + 8 * rc), x);
      if (!isctx) { const float* cs = RM + ((size_t)((rc >> 2) ? (t & 63) : (t >> 6)) * 16 + 8 * (rc & 1)) * 2; rope8<2>(x, cs, (rc >> 1) & 1); }
      if (lane < 48) *(u32x4*)((bf16_t*)(p.ws + O_KM) + ((size_t)(b * 6 + h) * LK + kpos) * 192 + 128 + 8 * rc) = pack8(x); }
}

__device__ __forceinline__ void hyconv_unit_valu(const Params& p, int l, int nset, int c, LAS float* lf) {
    const int tid = otid(), n = nset ? CTXL : SEQ, tokbase = nset ? NLAT : 0;
    LAS float* kc = lf; LAS float* z = lf + 4096; LAS float* z2 = z + 8 * SEQ;
    const float* HF = (const float*)(p.ws + O_HF) + (size_t)l * HF_LAYER + (nset ? HF_L0 : 0); const float* HSS = (const float*)(p.ws + O_HSS) + (size_t)((l * 2 + nset) * 2) * 512;
    const bf16_t* VT = (const bf16_t*)(p.ws + O_VT) + (size_t)c * NTOK + tokbase; const bf16_t* X1T = (const bf16_t*)(p.ws + O_X1T) + (size_t)c * NTOK + tokbase;
    bf16_t* Y2T = (bf16_t*)(p.ws + O_Y2T) + (size_t)c * NTOK + tokbase;
    for (int i = tid; i < 8 * n; i += NTHREADS) z[i] = bf2f(VT[i]);
    for (int ord = 0; ord < 2; ++ord) {
        const float rs = rsqrtf(HSS[ord * 512 + c] + EPS); const float* hf = HF + (size_t)((ord * 2 + 0) * 512 + c) * n; const float* hb = HF + (size_t)((ord * 2 + 1) * 512 + c) * n;
        for (int m = tid; m < 2 * n; m += NTHREADS) { const int lag = m - (n - 1); kc[m] = (m == 2 * n - 1) ? 0.f : (lag >= 0 ? hf[lag] : hb[-lag]) * rs; }
        __syncthreads();
        const LAS float* zs = ord ? z2 : z; const float skip = p.in[I_HYSKIP][(size_t)(l * 2 + ord) * 512 + c];
        for (int q = tid; q < n; q += NTHREADS) {
            const int b = q / (n >> 3), t0 = (q % (n >> 3)) * 8; float acc[8];
#pragma unroll
            for (int j = 0; j < 8; ++j) acc[j] = 0.f;
            const LAS float* zb = zs + b * n;
            for (int sb = 0; sb < n; sb += 8) {
                const LAS float* kb = kc + (t0 - sb + n - 8); float w[16];
#pragma unroll
                for (int i = 0; i < 4; ++i) { const f32x4 v = *(const LAS f32x4*)(kb + 4 * i); w[4 * i] = v[0]; w[4 * i + 1] = v[1]; w[4 * i + 2] = v[2]; w[4 * i + 3] = v[3]; }
                const f32x4 za = *(const LAS f32x4*)(zb + sb), zc = *(const LAS f32x4*)(zb + sb + 4); const float zv[8] = {za[0], za[1], za[2], za[3], zc[0], zc[1], zc[2], zc[3]};
#pragma unroll
                for (int ss = 0; ss < 8; ++ss)
#pragma unroll
                    for (int j = 0; j < 8; ++j) acc[j] += w[j - ss + 7] * zv[ss];
            }
            if (ord == 0) {
#pragma unroll
                for (int j = 0; j < 8; ++j) { const int idx = b * n + t0 + j; z2[idx] = bf2f(X1T[idx]) * (acc[j] + skip * z[idx]); }
            } else { float y[8];
#pragma unroll
                for (int j = 0; j < 8; ++j) y[j] = acc[j] + skip * z2[b * n + t0 + j];
                u32x4 w; w.x = pk2(y[0], y[1]); w.y = pk2(y[2], y[3]); w.z = pk2(y[4], y[5]); w.w = pk2(y[6], y[7]); *(u32x4*)(Y2T + b * n + t0) = w; }
        }
        __syncthreads();
    }
}
constexpr int HC_COPYB = 8256, HC_ROWB = 4560, HC_PAD = 112, HC_KR = 4112, HC_M0 = 2064;
constexpr int HC_ZOFF = 8 * HC_COPYB, HC_Z2OFF = HC_ZOFF + 8 * HC_ROWB;
__device__ __forceinline__ void hyconv_unit_mfma(const Params& p, int l, int c, LAS unsigned char* lds) {
    const int tid = otid(), wid = __builtin_amdgcn_readfirstlane(tid >> 6), lane = tid & 63;
    LAS unsigned char* CP = lds; LAS unsigned char* Zr = lds + HC_ZOFF; LAS unsigned char* Z2r = lds + HC_Z2OFF;
    const float* HF = (const float*)(p.ws + O_HF) + (size_t)l * HF_LAYER; const float* HSS = (const float*)(p.ws + O_HSS) + (size_t)(l * 4) * 512;
    const bf16_t* VT = (const bf16_t*)(p.ws + O_VT) + (size_t)c * NTOK; const bf16_t* X1T = (const bf16_t*)(p.ws + O_X1T) + (size_t)c * NTOK; bf16_t* Y2T = (bf16_t*)(p.ws + O_Y2T) + (size_t)c * NTOK;
    for (int q = tid; q < 8 * 256; q += NTHREADS) { const int b = q >> 8, ch = q & 255; *(LAS u32x4*)(Zr + b * HC_ROWB + (HC_PAD + ch * 8) * 2) = *(const u32x4*)(VT + b * SEQ + ch * 8); }
    for (int q = tid; q < 8 * 29; q += NTHREADS) { const int b = q / 29, ch = q % 29; const int e0 = ch < 14 ? ch * 8 : HC_PAD + SEQ + (ch - 14) * 8; *(LAS u32x4*)(Zr + b * HC_ROWB + e0 * 2) = (u32x4){0u, 0u, 0u, 0u}; }
    const int a = lane & 31, kg = lane >> 5, bq = a >> 2, isub = a & 3;
    const int Aoff = (a & 7) * HC_COPYB + (HC_M0 - 8 * (a >> 3) + 8 * kg) * 2;
    const int g0 = 2 * wid;
    const int Boff = bq * HC_ROWB + (HC_PAD + 128 * g0 + 32 * isub + 8 * kg) * 2;
    for (int ord = 0; ord < 2; ++ord) {
        LAS float* kr = (LAS float*)(ord == 0 ? Z2r : Zr);
        { const float rs = rsqrtf(HSS[ord * 512 + c] + EPS); const float* hf = HF + (size_t)((ord * 2 + 0) * 512 + c) * SEQ; const float* hb = HF + (size_t)((ord * 2 + 1) * 512 + c) * SEQ;
          for (int m = tid; m < HC_KR; m += NTHREADS) { const int lag = HC_M0 - m; float v = 0.f; if (lag >= 0 && lag < SEQ) v = hf[lag] * rs; else if (lag < 0 && lag > -SEQ) v = hb[-lag] * rs; kr[m] = v; } }
        __syncthreads();
        for (int q = tid; q < 8 * 516; q += NTHREADS) { const int sft = q / 516, ch = q % 516; float v[8];
#pragma unroll
            for (int j = 0; j < 8; ++j) { const int m = ch * 8 + j - sft; v[j] = (m >= 0 && m < HC_KR) ? kr[m] : 0.f; }
            u32x4 w; w.x = pk2(v[0], v[1]); w.y = pk2(v[2], v[3]); w.z = pk2(v[4], v[5]); w.w = pk2(v[6], v[7]); *(LAS u32x4*)(CP + sft * HC_COPYB + ch * 16) = w; }
        __syncthreads();
        if (ord == 0) for (int q = tid; q < 8 * 29; q += NTHREADS) { const int b = q / 29, ch = q % 29; const int e0 = ch < 14 ? ch * 8 : HC_PAD + SEQ + (ch - 14) * 8; *(LAS u32x4*)(Z2r + b * HC_ROWB + e0 * 2) = (u32x4){0u, 0u, 0u, 0u}; }
        const LAS unsigned char* Zs = ord ? Z2r : Zr;
        f32x16 acc0 = {}, acc1 = {};
        const int e_lo = 16 * wid - 127, e_mid0 = 16 * wid - 119, e_mid1 = 16 * wid + 7, e_hi = 16 * wid + 15;
        for (int e = e_lo; e < e_mid0; ++e) { const bf16x8 A = *(const LAS bf16x8*)(CP + Aoff - 32 * e); const bf16x8 B0 = *(const LAS bf16x8*)(Zs + Boff - 32 * e);
            acc0 = __builtin_amdgcn_mfma_f32_32x32x16_bf16(A, B0, acc0, 0, 0, 0); }
#pragma unroll 2
        for (int e = e_mid0; e <= e_mid1; ++e) { const bf16x8 A = *(const LAS bf16x8*)(CP + Aoff - 32 * e); const bf16x8 B0 = *(const LAS bf16x8*)(Zs + Boff - 32 * e); const bf16x8 B1 = *(const LAS bf16x8*)(Zs + Boff + 256 - 32 * e);
            acc0 = __builtin_amdgcn_mfma_f32_32x32x16_bf16(A, B0, acc0, 0, 0, 0); acc1 = __builtin_amdgcn_mfma_f32_32x32x16_bf16(A, B1, acc1, 0, 0, 0); }
        for (int e = e_mid1 + 1; e <= e_hi; ++e) { const bf16x8 A = *(const LAS bf16x8*)(CP + Aoff - 32 * e); const bf16x8 B1 = *(const LAS bf16x8*)(Zs + Boff + 256 - 32 * e);
            acc1 = __builtin_amdgcn_mfma_f32_32x32x16_bf16(A, B1, acc1, 0, 0, 0); }
        const float skip = p.in[I_HYSKIP][(size_t)(l * 2 + ord) * 512 + c];
#pragma unroll
        for (int gi = 0; gi < 2; ++gi) {
#pragma unroll
            for (int q = 0; q < 4; ++q) { const int t = 128 * (g0 + gi) + 32 * isub + 8 * q + 4 * kg; float y[4];
#pragma unroll
                for (int j = 0; j < 4; ++j) y[j] = gi ? acc1[4 * q + j] : acc0[4 * q + j];
                const u32x2 zz = *(const LAS u32x2*)(Zs + bq * HC_ROWB + (HC_PAD + t) * 2);
                const float z0 = __uint_as_float(zz.x << 16), z1 = __uint_as_float(zz.x & 0xffff0000u), z2 = __uint_as_float(zz.y << 16), z3 = __uint_as_float(zz.y & 0xffff0000u);
                y[0] += skip * z0; y[1] += skip * z1; y[2] += skip * z2; y[3] += skip * z3;
                if (ord == 0) { const u32x2 xx = *(const u32x2*)(X1T + bq * SEQ + t);
                    y[0] *= __uint_as_float(xx.x << 16); y[1] *= __uint_as_float(xx.x & 0xffff0000u); y[2] *= __uint_as_float(xx.y << 16); y[3] *= __uint_as_float(xx.y & 0xffff0000u);
                    u32x2 w; w.x = pk2(y[0], y[1]); w.y = pk2(y[2], y[3]); *(LAS u32x2*)(Z2r + bq * HC_ROWB + (HC_PAD + t) * 2) = w; }
                else { u32x2 w; w.x = pk2(y[0], y[1]); w.y = pk2(y[2], y[3]); *(u32x2*)(Y2T + bq * SEQ + t) = w; } }
        }
        __syncthreads();
    }
}
__device__ __forceinline__ void hy_fin_task(const Params& p, int l, int t0, int c0, LAS float* u) {
    const bf16_t* P = (const bf16_t*)(p.ws + O_P); LAS float* y = u + 66 * 65;
    load_conv_tile(P, t0, 1024 + c0, u);
    const int tid = otid();
    { const int c = tid >> 3, tc = (tid & 7) * 8; const u32x4 v = *(const u32x4*)((const bf16_t*)(p.ws + O_Y2T) + (size_t)(c0 + c) * NTOK + t0 + tc);
#pragma unroll
      for (int j = 0; j < 4; ++j) { y[c * 65 + tc + 2 * j] = __uint_as_float(v[j] << 16); y[c * 65 + tc + 2 * j + 1] = __uint_as_float(v[j] & 0xffff0000u); } }
    __syncthreads();
    { const int t = tid >> 3, cc = (tid & 7) * 8; const float* cw = p.in[I_HYCONV] + (size_t)l * 3 * 1536 + 1024 + c0 + cc; float o[8];
#pragma unroll
      for (int j = 0; j < 8; ++j) { const int c = cc + j; const float x2 = cw[j] * u[t * 65 + c] + cw[1536 + j] * u[(t + 1) * 65 + c] + cw[3072 + j] * u[(t + 2) * 65 + c]; o[j] = x2 * y[c * 65 + t]; }
#if WOUT8
      u32x2 w; w.x = pk4_fp8(o[0] * MIX8_SCALE, o[1] * MIX8_SCALE, o[2] * MIX8_SCALE, o[3] * MIX8_SCALE); w.y = pk4_fp8(o[4] * MIX8_SCALE, o[5] * MIX8_SCALE, o[6] * MIX8_SCALE, o[7] * MIX8_SCALE);
      *(u32x2*)(p.ws + O_MIX + (size_t)(t0 + t) * DM + c0 + cc) = w; }
#else
      u32x4 w; w.x = pk2(o[0], o[1]); w.y = pk2(o[2], o[3]); w.z = pk2(o[4], o[5]); w.w = pk2(o[6], o[7]);
      *(u32x4*)((bf16_t*)(p.ws + O_MIX) + (size_t)(t0 + t) * DM + c0 + cc) = w; }
#endif
    __syncthreads();
}

__device__ __forceinline__ void mla_unit(const Params& p, int b, int h, int qb, bool ctxq, LAS unsigned char* lds) {
    unsigned char* ws = p.ws;
    const bf16_t* Q = ctxq ? (const bf16_t*)(ws + O_QMC) + (size_t)(b * 6 + h) * CTXL * 192 : (const bf16_t*)(ws + O_QM) + ((size_t)(b * 6 + h) * SEQ + qb * 256) * 192;
#if WOUT8
    bf16_t* O = (bf16_t*)(ws + O_MIX + (size_t)(ctxq ? NLAT + b * CTXL : b * SEQ + qb * 256) * DM + 512 + h * 128);
#else
    bf16_t* O = (bf16_t*)(ws + O_MIX) + (size_t)(ctxq ? NLAT + b * CTXL : b * SEQ + qb * 256) * DM + 512 + h * 128;
#endif
    attn_body<192, 0>(Q, (const bf16_t*)(ws + O_KM) + (size_t)(b * 6 + h) * LK * 192, (const bf16_t*)(ws + O_VM) + (size_t)(b * 6 + h) * LK * 128, O, DM, ctxq ? CTXL : LK, 0.07216878364870322f, (char*)lds);
}
__device__ __forceinline__ void gqa_unit(const Params& p, int b, int h, int qb, bool ctxq, LAS unsigned char* lds) {
    unsigned char* ws = p.ws;
    const bf16_t* Q = ctxq ? (const bf16_t*)(ws + O_QGC) + (size_t)(b * 6 + h) * CTXL * 128 : (const bf16_t*)(ws + O_QG) + ((size_t)(b * 6 + h) * SEQ + qb * 256) * 128;
#if WOUT8
    bf16_t* O = (bf16_t*)(ws + O_MIX + (size_t)(ctxq ? NLAT + b * CTXL : b * SEQ + qb * 256) * DM + 1280 + h * 128);
#else
    bf16_t* O = (bf16_t*)(ws + O_MIX) + (size_t)(ctxq ? NLAT + b * CTXL : b * SEQ + qb * 256) * DM + 1280 + h * 128;
#endif
    attn_body<128, GQA_SD>(Q, (const bf16_t*)(ws + O_KG) + (size_t)(b * 2 + h / 3) * LK * 128, (const bf16_t*)(ws + O_VG) + (size_t)(b * 2 + h / 3) * LK * 128, O, DM, ctxq ? CTXL : LK, 0.08838834764831845f, (char*)lds);
}
__device__ __forceinline__ void phase_mixer(const Params& p, int l, LAS unsigned char* lds) {
    const int G = gridDim.x, bid = blockIdx.x; const bool last = (l == NLAYER - 1);
    for (int u = bid; u < 384 + (last ? 0 : 48); u += G) { if (u < 384) mla_unit(p, u / 48, (u >> 3) % 6, u & 7, false, lds); else mla_unit(p, (u - 384) / 6, (u - 384) % 6, 0, true, lds); }
    for (int u = (bid + G / 2) % G; u < 384 + (last ? 0 : 48); u += G) { if (u < 384) gqa_unit(p, u / 48, (u >> 3) % 6, u & 7, false, lds); else gqa_unit(p, (u - 384) / 6, (u - 384) % 6, 0, true, lds); }
#ifndef CONV_REP
#define CONV_REP 1
#endif
    for (int rep = 0; rep < CONV_REP; ++rep) {
#if HY_MFMA
    for (int u = bid; u < 512; u += G) hyconv_unit_mfma(p, l, u, lds);
    if (!last) for (int u = bid; u < 512; u += G) hyconv_unit_valu(p, l, 1, u, (LAS float*)lds);
#else
    for (int u = bid; u < (last ? 512 : 1024); u += G) hyconv_unit_valu(p, l, u >> 9, u & 511, (LAS float*)lds);
#endif
    }
}

constexpr int RT_FS = DM + 4;
__device__ __forceinline__ void route_row_pre(const Params& p, int l, int row, int lane, LAS float* fdst, const float* g1, const float* g2) {
    const float* mod = (const float*)(p.ws + O_MOD) + (size_t)(l * 9 + row_batch(row)) * 12288;
    const bf16_t* O = (const bf16_t*)(p.ws + O_OUT) + (size_t)row * DM; const float* rs = resid_src(p, l, row); float* X = (float*)(p.ws + O_X) + (size_t)row * DM; bf16_t* H = (bf16_t*)(p.ws + O_H) + (size_t)row * DM;
    float o[32], x[32]; float ss = 0.f;
#pragma unroll
    for (int j = 0; j < 8; ++j) { const u32x2 v = *(const u32x2*)(O + ROWCOL(j, lane)); o[j * 4] = __uint_as_float(v.x << 16); o[j * 4 + 1] = __uint_as_float(v.x & 0xffff0000u); o[j * 4 + 2] = __uint_as_float(v.y << 16); o[j * 4 + 3] = __uint_as_float(v.y & 0xffff0000u); }
#pragma unroll
    for (int i = 0; i < 32; ++i) ss += o[i] * o[i];
    const float r1 = rsqrtf(wave_sum(ss) * (1.0f / DM) + EPS); float s2 = 0.f;
#pragma unroll
    for (int j = 0; j < 8; ++j) { const int c = ROWCOL(j, lane); const f32x4 xv = *(const f32x4*)(rs + c), gv = *(const f32x4*)(g1 + c), ga = *(const f32x4*)(mod + 2 * DM + c); f32x4 xn;
#pragma unroll
        for (int q = 0; q < 4; ++q) { xn[q] = xv[q] + ga[q] * (o[j * 4 + q] * r1 * gv[q]); x[j * 4 + q] = xn[q]; s2 += xn[q] * xn[q]; }
        *(f32x4*)(X + c) = xn; }
    const float r2 = rsqrtf(wave_sum(s2) * (1.0f / DM) + EPS);
#pragma unroll
    for (int j = 0; j < 8; ++j) { const int c = ROWCOL(j, lane); const f32x4 gv = *(const f32x4*)(g2 + c), sh = *(const f32x4*)(mod + 3 * DM + c), sc = *(const f32x4*)(mod + 4 * DM + c); f32x4 f;
#pragma unroll
        for (int q = 0; q < 4; ++q) f[q] = x[j * 4 + q] * r2 * gv[q] * (1.0f + sc[q]) + sh[q];
#if MOE_FP8
        *(unsigned*)((unsigned char*)(p.ws + O_H) + (size_t)row * DM + c) = pk4_fp8(f[0], f[1], f[2], f[3]);
#else
        u32x2 w; w.x = pk2(f[0], f[1]); w.y = pk2(f[2], f[3]); *(u32x2*)(H + c) = w;
#endif
        *(LAS f32x4*)(fdst + c) = f; }
}
__device__ __forceinline__ void route_row_topk(const Params& p, int l, int row, int lane, float logit, LAS unsigned* cntL) {
    const float score = 1.0f / (1.0f + expf(-logit)), biased = score + p.in[I_RB][l * 64 + lane];
    float m1 = biased; m1 = fmaxf(m1, __shfl_xor(m1, 1)); m1 = fmaxf(m1, __shfl_xor(m1, 2)); m1 = fmaxf(m1, __shfl_xor(m1, 4));
    const unsigned long long bal = __ballot(biased == m1); const int first = __builtin_ctz((unsigned)((bal >> (lane & ~7)) & 0xffull));
    float m2 = ((lane & 7) == first) ? -INFINITY : biased; m2 = fmaxf(m2, __shfl_xor(m2, 1)); m2 = fmaxf(m2, __shfl_xor(m2, 2)); m2 = fmaxf(m2, __shfl_xor(m2, 4));
    const float gs = m1 + m2; const int grp = lane >> 3; int rank = 0;
#pragma unroll
    for (int q = 0; q < 8; ++q) { const float v = rdlane(gs, q * 8); rank += (v > gs || (v == gs && q < grp)) ? 1 : 0; }
    const float cand = (rank < 4) ? biased : -INFINITY; int re = 0;
    for (int q = 0; q < 64; ++q) { const float v = rdlane(cand, q); re += (v > cand || (v == cand && q < lane)) ? 1 : 0; }
    const bool sel = re < TOPK; const float ssum = wave_sum(sel ? score : 0.f);
    if (sel) { ((int*)(p.ws + O_EIDX))[(size_t)row * 8 + re] = lane; ((float*)(p.ws + O_GATE))[(size_t)row * 8 + re] = score / ssum * 2.5f;
        ((int*)(p.ws + O_SLOT))[(size_t)row * 8 + re] = (int)__hip_atomic_fetch_add(&cntL[lane], 1u, __ATOMIC_RELAXED, __HIP_MEMORY_SCOPE_WORKGROUP); }
}
__device__ __forceinline__ void phase_route(const Params& p, int l, LAS unsigned char* lds) {
    const int tid = otid(), wid = __builtin_amdgcn_readfirstlane(tid >> 6), lane0 = tid & 63; const bool last = (l == NLAYER - 1); const int NR = last ? NLAT : NTOK;
    LAS float* frow = (LAS float*)lds; LAS float* part = frow;
    const float* g1 = p.in[I_NORMG] + (size_t)(l * 4 + 1) * DM; const float* g2 = p.in[I_NORMG] + (size_t)(l * 4 + 2) * DM;
    const float* RW = p.in[I_RW] + (size_t)l * DM * NEXP; LAS unsigned* cntL = (LAS unsigned*)(lds + LDS_CNTL);
    if (tid < 64) cntL[tid] = 0u;
    { int* stok = (int*)(p.ws + O_STOK); for (int i = blockIdx.x * NTHREADS + tid; i < NSLOTS; i += gridDim.x * NTHREADS) stok[i] = (i < RSLOTS) ? -1 : ((i - RSLOTS) < NR ? i - RSLOTS : -1); }
    for (int g = blockIdx.x; g < NR / 16; g += gridDim.x) {
        int lane = lane0; asm volatile("" : "+v"(lane));
        for (int rr = 0; rr < 2; ++rr) route_row_pre(p, l, g * 16 + wid * 2 + rr, lane, frow + (wid * 2 + rr) * RT_FS, g1, g2);
        __syncthreads();
        f32x4 acc[4];
#pragma unroll
        for (int j = 0; j < 4; ++j) acc[j] = (f32x4){0.f, 0.f, 0.f, 0.f};
        { const int r16 = lane & 15, kq = lane >> 4; const LAS float* fa = frow + r16 * RT_FS + wid * 256 + 4 * kq; const float* rb = RW + (size_t)(wid * 256 + 4 * kq) * 64 + 4 * r16;
#pragma unroll 2
          for (int st = 0; st < 16; ++st) { const f32x4 a = *(const LAS f32x4*)(fa + 16 * st); f32x4 b[4];
#pragma unroll
              for (int i = 0; i < 4; ++i) b[i] = *(const f32x4*)(rb + (size_t)(16 * st + i) * 64);
#pragma unroll
              for (int i = 0; i < 4; ++i)
#pragma unroll
                  for (int j = 0; j < 4; ++j) acc[j] = __builtin_amdgcn_mfma_f32_16x16x4f32(a[i], b[i][j], acc[j], 0, 0, 0); }
          __syncthreads();
#pragma unroll
          for (int r = 0; r < 4; ++r) *(LAS f32x4*)(part + (wid * 16 + 4 * kq + r) * 64 + 4 * r16) = (f32x4){acc[0][r], acc[1][r], acc[2][r], acc[3][r]}; }
        __syncthreads();
        for (int rr = 0; rr < 2; ++rr) { const int r16 = wid * 2 + rr; float logit = 0.f;
#pragma unroll
            for (int w = 0; w < 8; ++w) logit += part[(w * 16 + r16) * 64 + lane];
            route_row_topk(p, l, g * 16 + r16, lane, logit, cntL); }
        __syncthreads();
    }
    __syncthreads();
    if (tid < 64) ((unsigned*)(p.ws + O_WCNT))[blockIdx.x * 64 + tid] = cntL[tid];
}
__device__ __forceinline__ void phase_place(const Params& p, int l, LAS unsigned char* lds) {
    const int tid = otid(); const int NR = (l == NLAYER - 1) ? NLAT : NTOK, G = gridDim.x;
    LAS int* woff = (LAS int*)lds; LAS int* csum = woff + 512 * 64; LAS int* pstart = csum + 8 * 64;
    const unsigned* wcnt = (const unsigned*)(p.ws + O_WCNT);
    for (int i = tid; i < G * 64; i += NTHREADS) woff[i] = (int)wcnt[i];
    __syncthreads();
    { const int e = tid & 63, ch = tid >> 6, cs = (G + 7) >> 3, w0 = ch * cs, w1 = (w0 + cs < G) ? w0 + cs : G; int run = 0;
      for (int w = w0; w < w1; ++w) { const int t = woff[w * 64 + e]; woff[w * 64 + e] = run; run += t; }
      csum[ch * 64 + e] = run;
      __syncthreads();
      int base = 0, tot = 0;
#pragma unroll
      for (int c2 = 0; c2 < 8; ++c2) { const int v = csum[c2 * 64 + e]; if (c2 < ch) base += v; tot += v; }
      for (int w = w0; w < w1; ++w) woff[w * 64 + e] += base;
      if (tid < 64) { const int ntile = (tot + 255) >> 8; pstart[tid] = (wave_incl_scan(ntile, tid) - ntile) * 256;
          if (blockIdx.x == 0) ((unsigned*)(p.ws + O_CTL))[CW_CNT + l * 64 + tid] = (unsigned)tot; } }
    __syncthreads();
    const int* eidx = (const int*)(p.ws + O_EIDX); int* slot = (int*)(p.ws + O_SLOT); int* stok = (int*)(p.ws + O_STOK);
    for (int i = blockIdx.x * NTHREADS + tid; i < NR * TOPK; i += G * NTHREADS) { const int row = i / TOPK, k = i % TOPK, e = eidx[(size_t)row * 8 + k], wg = (row >> 4) % G;
        const int s = pstart[e] + woff[wg * 64 + e] + slot[(size_t)row * 8 + k]; slot[(size_t)row * 8 + k] = s; stok[s] = row; }
    __syncthreads();
}
__device__ __forceinline__ void phase_final(const Params& p, int l) {
    const int lane = otid() & 63, gw = blockIdx.x * 8 + owid(), GW = gridDim.x * 8; const bool last = (l == NLAYER - 1); const int NR = last ? NLAT : NTOK;
    const bf16_t* DO = (const bf16_t*)(p.ws + O_DOUT); const float* g3 = p.in[I_NORMG] + (size_t)(l * 4 + 3) * DM;
    const int lane0 = lane;
    for (int row = gw; row < NR; row += GW) {
        int lane = lane0; asm volatile("" : "+v"(lane));
        const int sl = (lane < TOPK) ? ((const int*)(p.ws + O_SLOT))[(size_t)row * 8 + lane] : 0; const float gl = (lane < TOPK) ? ((const float*)(p.ws + O_GATE))[(size_t)row * 8 + lane] : 0.f;
        float y[32];
#pragma unroll
        for (int i = 0; i < 32; ++i) y[i] = 0.f;
#if DOUT_FP8
        { const unsigned char* DO8 = p.ws + O_DOUT; unsigned v[7][8]; float gt[7];
#pragma unroll
          for (int k = 0; k < 7; ++k) { const int s = (k == 0) ? RSLOTS + row : __builtin_amdgcn_readlane(sl, k - 1); const unsigned char* src = DO8 + (size_t)s * DM; gt[k] = ((k == 0) ? 1.0f : rdlane(gl, k - 1)) * (1.0f / DOUT8_SCALE);
#pragma unroll
              for (int j = 0; j < 8; ++j) v[k][j] = *(const unsigned*)(src + ROWCOL(j, lane)); }
#pragma unroll
          for (int k = 0; k < 7; ++k)
#pragma unroll
              for (int j = 0; j < 8; ++j) { typedef float f32x2v __attribute__((ext_vector_type(2))); const f32x2v lo = __builtin_amdgcn_cvt_pk_f32_fp8((int)v[k][j], false), hi = __builtin_amdgcn_cvt_pk_f32_fp8((int)v[k][j], true);
                  y[j * 4] += gt[k] * lo.x; y[j * 4 + 1] += gt[k] * lo.y; y[j * 4 + 2] += gt[k] * hi.x; y[j * 4 + 3] += gt[k] * hi.y; } }
#else
#pragma unroll
        for (int kb = 0; kb < 7; kb += 4) {
            u32x2 v[4][8]; float gt[4];
#pragma unroll
            for (int kk = 0; kk < 4; ++kk) { const int k = kb + kk; if (k < 7) { const int s = (k == 0) ? RSLOTS + row : __builtin_amdgcn_readlane(sl, k - 1); const bf16_t* src = DO + (size_t)s * DM; gt[kk] = (k == 0) ? 1.0f : rdlane(gl, k - 1);
#pragma unroll
                for (int j = 0; j < 8; ++j) v[kk][j] = *(const u32x2*)(src + ROWCOL(j, lane)); } }
#pragma unroll
            for (int kk = 0; kk < 4; ++kk) { if (kb + kk < 7) {
#pragma unroll
                for (int j = 0; j < 8; ++j) { const float g = gt[kk]; y[j * 4] += g * __uint_as_float(v[kk][j].x << 16); y[j * 4 + 1] += g * __uint_as_float(v[kk][j].x & 0xffff0000u); y[j * 4 + 2] += g * __uint_as_float(v[kk][j].y << 16); y[j * 4 + 3] += g * __uint_as_float(v[kk][j].y & 0xffff0000u); } } }
        }
#endif
        float ss = 0.f;
#pragma unroll
        for (int i = 0; i < 32; ++i) ss += y[i] * y[i];
        const float r = rsqrtf(wave_sum(ss) * (1.0f / DM) + EPS); const float* mod = (const float*)(p.ws + O_MOD) + (size_t)(l * 9 + row_batch(row)) * 12288;
        float* X = (float*)(p.ws + O_X) + (size_t)row * DM; float x[32];
#pragma unroll
        for (int j = 0; j < 8; ++j) { const int c = ROWCOL(j, lane); const f32x4 xv = *(const f32x4*)(X + c), gv = *(const f32x4*)(g3 + c), gf = *(const f32x4*)(mod + 5 * DM + c); f32x4 xn;
#pragma unroll
            for (int q = 0; q < 4; ++q) { xn[q] = xv[q] + gf[q] * (y[j * 4 + q] * r * gv[q]); x[j * 4 + q] = xn[q]; }
            if (last) *(f32x4*)(p.out + (size_t)row * DM + c) = xn; else *(f32x4*)(X + c) = xn; }
        if (!last) norm1_row(p, l + 1, row, x, lane);
    }
}

#define XB_TMO      128
#define XB_XCNT(j)  (256  + 64 * (j))
#define XB_XSUB(j)  (1280 + 64 * (j))
#define XB_XGEN(j)  (2304 + 64 * (j))
#define XB_TOP      3328
#define XB_TOPGEN   3392
#define XCD_BAR_WORDS 3456
#define XB_SPIN_CAP (1u << 23)

__device__ __forceinline__ unsigned xb_ld(unsigned* p)              { return __hip_atomic_load(p, __ATOMIC_RELAXED, __HIP_MEMORY_SCOPE_AGENT); }
__device__ __forceinline__ unsigned xb_add(unsigned* p, unsigned v) { return __hip_atomic_fetch_add(p, v, __ATOMIC_RELAXED, __HIP_MEMORY_SCOPE_AGENT); }
__device__ __forceinline__ unsigned xb_xcc_id() { return (unsigned)__builtin_amdgcn_s_getreg((3 << 11) | 20) & 0xFu; }
#define XB_SPIN(cond, bar) do { unsigned _sp = 0; while (cond) { __builtin_amdgcn_s_sleep(1); \
    if ((++_sp & 255u) == 0u) { if (xb_ld(&(bar)[XB_TMO])) break; if (_sp > XB_SPIN_CAP) { atomicAdd(&(bar)[XB_TMO], 1u); break; } } } } while (0)

struct XcdBarrier {
    unsigned* bar; unsigned x;
    volatile LAS unsigned* st;
};

__device__ __forceinline__ XcdBarrier xcd_barrier_post(unsigned* bar, volatile LAS unsigned* st) {
    XcdBarrier b; b.bar = bar; b.x = xb_xcc_id(); b.st = st;
    if (threadIdx.x == 0) (void)xb_add(&bar[XB_XCNT(b.x)], 1u);
    return b;
}
__device__ __forceinline__ void xcd_barrier_complete(unsigned* bar, unsigned x, unsigned& nloc, unsigned& nx) {
    const unsigned G = gridDim.x * gridDim.y * gridDim.z;
    unsigned sum, cnt, mine, sp = 0u;
    for (;;) {
        sum = 0u; cnt = 0u; mine = 0u;
#pragma unroll
        for (unsigned j = 0; j < 16; ++j) { const unsigned c = xb_ld(&bar[XB_XCNT(j)]); sum += c; cnt += (c > 0u) ? 1u : 0u; mine = (j == x) ? c : mine; }
        if (sum == G) break;
        __builtin_amdgcn_s_sleep(1);
        if ((++sp & 255u) == 0u) { if (xb_ld(&bar[XB_TMO])) break; if (sp > XB_SPIN_CAP) { atomicAdd(&bar[XB_TMO], 1u); break; } }
    }
    nloc = mine > 0u ? mine : 1u; nx = cnt > 0u ? cnt : 1u;
}

__device__ __forceinline__ void xcd_barrier(const XcdBarrier& b) {
    asm volatile("s_waitcnt vmcnt(0)" ::: "memory");
    __syncthreads();
    if (threadIdx.x == 0) {
        unsigned* bar = b.bar;
        __builtin_amdgcn_s_waitcnt(0);
        unsigned nloc = b.st[0], nx = b.st[1];
        if (nloc == 0u) { xcd_barrier_complete(bar, b.x, nloc, nx); b.st[0] = nloc; b.st[1] = nx; }
        const unsigned old = xb_add(&bar[XB_XSUB(b.x)], 1u);
        const unsigned gen = old / nloc;
        if (old + 1u == (gen + 1u) * nloc) {
            __builtin_amdgcn_fence(__ATOMIC_RELEASE, "agent");
            asm volatile("s_waitcnt vmcnt(0)" ::: "memory");
            const unsigned og = xb_add(&bar[XB_TOP], 1u);
            const unsigned tg = og / nx;
            if (og + 1u == (tg + 1u) * nx) xb_add(&bar[XB_TOPGEN], 1u);
            else XB_SPIN(xb_ld(&bar[XB_TOPGEN]) == tg, bar);
            __builtin_amdgcn_fence(__ATOMIC_ACQUIRE, "agent");
            xb_add(&bar[XB_XGEN(b.x)], 1u);
            asm volatile("s_waitcnt vmcnt(0)" ::: "memory");
        } else {
            XB_SPIN(xb_ld(&bar[XB_XGEN(b.x)]) == gen, bar);
            __builtin_amdgcn_fence(__ATOMIC_ACQUIRE, "agent");
            asm volatile("s_waitcnt vmcnt(0)" ::: "memory");
        }
    }
    __syncthreads();
}


enum { PH_PRO = 0, PH_NORM1, PH_WIN, PH_POSTA, PH_POSTB, PH_MIXER, PH_HYFIN, PH_WOUT, PH_ROUTE, PH_PLACE, PH_GEMM1, PH_GEMM2, PH_FINAL, PH_COUNT };

template <int PH>
__device__ __forceinline__ void run_phase(const Params& p_in, int l, LAS unsigned char* lds) {
#if MEGA
    const __attribute__((address_space(4))) Params* kp = (const __attribute__((address_space(4))) Params*)__builtin_amdgcn_kernarg_segment_ptr(); asm volatile("" : "+s"(kp)); (void)p_in;
    Params p;
#pragma unroll
    for (int i_ = 0; i_ < 31; ++i_) p.in[i_] = kp->in[i_];
    p.out = kp->out; p.ws = kp->ws; p.layer = 0; p.pad = 0;
#else
    Params p = p_in; { unsigned char* w = p.ws; asm volatile("" : "+s"(w)); p.ws = w; }
#endif
    unsigned char* ws = p.ws; const bool last = (l == NLAYER - 1);
    const int gw = blockIdx.x * 8 + owid(), GW = gridDim.x * 8, lane = otid() & 63;
    if constexpr (PH == PH_PRO) { phase_prologue(p, lds); }
    if constexpr (PH == PH_NORM1) { phase_norm1(p, l); }
    if constexpr (PH == PH_WIN) {
        EpiStoreBf16 E{(bf16_t*)(ws + O_P), NP}; GemmDesc g{(const bf16_t*)(ws + O_H), DM, nullptr, DM, DM};
#if WIN8
        const bf16_t* Bt = (const bf16_t*)(ws + O_WIN + (size_t)l * NP * DM);
        if (!last) { DenseSched S{Bt, DM / 2, NTOK / 256, 16, 0, 0}; GEMM_PHASE8(g, S, E, 127, 119); }
        else { DenseSched S{Bt, DM / 2, NLAT / 256, 16, 0, 0}; GEMM_PHASE8(g, S, E, 127, 119); DenseSched S2{Bt, DM / 2, NCTX / 256, 4, NLAT, 12}; GEMM_PHASE8(g, S2, E, 127, 119); }
#else
        const bf16_t* Bt = (const bf16_t*)(ws + O_WIN) + (size_t)l * NP * DM;
        if (!last) { DenseSched S{Bt, DM, NTOK / 256, 16, 0, 0}; GEMM_PHASE(g, S, E); }
        else { DenseSched S{Bt, DM, NLAT / 256, 16, 0, 0}; GEMM_PHASE(g, S, E); DenseSched S2{Bt, DM, NCTX / 256, 4, NLAT, 12}; GEMM_PHASE(g, S2, E); }
#endif
    }
    if constexpr (PH == PH_POSTA) {
#ifndef DBG_SKIP
#define DBG_SKIP 0
#endif
        if (!(DBG_SKIP & 1)) { GemmDesc g{(const bf16_t*)(ws + O_P) + C_CQ, NP, nullptr, 768, 768}; EpiStoreBf16 E{(bf16_t*)(ws + O_QRAW), NQP};
          DenseSched S{(const bf16_t*)(ws + O_WUQ) + (size_t)l * NQP * 768, 768, (last ? NLAT : NTOK) / 256, 5, 0, 0}; GEMM_PHASE(g, S, E); }
        if (!(DBG_SKIP & 2)) { GemmDesc g{(const bf16_t*)(ws + O_P) + C_CKV, NP, nullptr, 256, 256}; EpiStoreBf16 E{(bf16_t*)(ws + O_KVRAW), 1536};
          DenseSched S{(const bf16_t*)(ws + O_WUKV) + (size_t)l * 1536 * 256, 256, NTOK / 256, 6, 0, 0}; GEMM_PHASE(g, S, E); }
        const int ntt = (last ? NLAT : NTOK) / 64;
        if (!(DBG_SKIP & 4)) for (int t = blockIdx.x; t < ntt * 16; t += gridDim.x) hy_prep_task(p, l, (t >> 4) * 64, (t & 15) * 64, (LAS float*)lds);
        if (!(DBG_SKIP & 8)) for (int row = gw; row < NTOK; row += GW) gqa_post_row(p, l, row, lane);
    }
    if constexpr (PH == PH_POSTB) { if (l == 0) hss_tasks(p); for (int row = gw; row < NTOK; row += GW) mla_post_row(p, l, row, lane); }
    if constexpr (PH == PH_MIXER) { phase_mixer(p, l, lds); }
    if constexpr (PH == PH_HYFIN) { const int ntt = (last ? NLAT : NTOK) / 64; for (int t = blockIdx.x; t < ntt * 8; t += gridDim.x) hy_fin_task(p, l, (t >> 3) * 64, (t & 7) * 64, (LAS float*)lds); }
    if constexpr (PH == PH_WOUT) {
        GemmDesc g{(const bf16_t*)(ws + O_MIX), DM, nullptr, DM, DM}; EpiStoreBf16 E{(bf16_t*)(ws + O_OUT), DM};
#if WOUT8
        DenseSched S{(const bf16_t*)(ws + O_WOUT + (size_t)l * DM * DM), DM / 2, (last ? NLAT : NTOK) / 256, 8, 0, 0}; GEMM_PHASE8(g, S, E, 123, 119);
#else
        DenseSched S{(const bf16_t*)(ws + O_WOUT) + (size_t)l * DM * DM, DM, (last ? NLAT : NTOK) / 256, 8, 0, 0}; GEMM_PHASE(g, S, E);
#endif
    }
    if constexpr (PH == PH_ROUTE) { phase_route(p, l, lds); }
    if constexpr (PH == PH_PLACE) { phase_place(p, l, lds); }
    if constexpr (PH == PH_GEMM1 || PH == PH_GEMM2) {
        LAS int* te = (LAS int*)(lds + LDS_TILES); LAS int* ts = te + MAXTILES; LAS int* misc = (LAS int*)(lds + LDS_MISC) + 16;
        const int nt = moe_build_tiles((const unsigned*)(ws + O_CTL) + CW_CNT + l * 64, (last ? NLAT : NTOK) / 256, te, ts, misc);
#if MOE_FP8
        if constexpr (PH == PH_GEMM1) {
            GemmDesc g{(const bf16_t*)(ws + O_H), DM, (const int*)(ws + O_STOK), DM, DM}; EpiSwiGLU8 E{ws + O_HID};
            MoeSched S{te, ts, nt, 4, (const bf16_t*)(ws + O_EGU), (size_t)1024 * 1024, DM / 2, 128}; GEMM_PHASE8(g, S, E, 127, 119);
        } else {
            GemmDesc g{(const bf16_t*)(ws + O_HID), EH, nullptr, EH, EH};
            MoeSched S{te, ts, nt, 8, (const bf16_t*)(ws + O_ED), (size_t)2048 * 256, EH / 2, 256};
#if DOUT_FP8
            EpiStoreFp8 E{ws + O_DOUT, DM, DOUT8_SCALE}; GEMM_PHASE8(g, S, E, 123, 119);
#else
            EpiStoreBf16 E{(bf16_t*)(ws + O_DOUT), DM}; GEMM_PHASE8(g, S, E, 123, 119);
#endif
        }
#else
        if constexpr (PH == PH_GEMM1) {
            GemmDesc g{(const bf16_t*)(ws + O_H), DM, (const int*)(ws + O_STOK), DM, DM}; EpiSwiGLU E{(bf16_t*)(ws + O_HID)};
            MoeSched S{te, ts, nt, 4, (const bf16_t*)(ws + O_EGU), (size_t)1024 * 2048, DM, 128}; GEMM_PHASE(g, S, E);
        } else {
            GemmDesc g{(const bf16_t*)(ws + O_HID), EH, nullptr, EH, EH}; EpiStoreBf16 E{(bf16_t*)(ws + O_DOUT), DM};
            MoeSched S{te, ts, nt, 8, (const bf16_t*)(ws + O_ED), (size_t)2048 * 512, EH, 256}; GEMM_PHASE(g, S, E);
        }
#endif
        __syncthreads();
    }
    if constexpr (PH == PH_FINAL) {
        phase_final(p, l);
        if (!last) cvt_exp_all(p, l + 1);
    }
}

#ifndef MEGA
#define MEGA 0
#endif


#if MEGA
__global__ void __launch_bounds__(NTHREADS, 2) mega_fwd(Params p) {
    extern __shared__ __attribute__((aligned(16))) unsigned char lds_raw[];
    LAS unsigned char* lds = (LAS unsigned char*)lds_raw;
    volatile LAS unsigned* xbw = (volatile LAS unsigned*)(lds + LDS_MISC);
    if (otid() == 0) { xbw[0] = 0u; xbw[1] = 0u; }
    __syncthreads();
    { const XcdBarrier b0 = xcd_barrier_post((unsigned*)(p.ws + O_CTL) + CW_BAR, xbw); if (otid() == 0) xbw[2] = b0.x; }
    __syncthreads();
#define GRID_BAR() do { XcdBarrier b_; b_.bar = (unsigned*)(p.ws + O_CTL) + CW_BAR; b_.x = xbw[2]; b_.st = xbw; xcd_barrier(b_); } while (0)
#ifndef DBL_MASK
#define DBL_MASK 0
#endif
#define RUNP(PH, l) do { run_phase<PH>(p, l, lds); GRID_BAR(); if ((DBL_MASK >> PH) & 1) { run_phase<PH>(p, l, lds); GRID_BAR(); } } while (0)
#ifndef DLY_MASK
#define DLY_MASK 0
#endif
#define RUND(PH, l) do { if ((DLY_MASK >> PH) & 1) { const unsigned long long t0_ = wall_clock64(); run_phase<PH>(p, l, lds); const unsigned long long t1_ = wall_clock64(); while (wall_clock64() < t1_ + (t1_ - t0_)) __builtin_amdgcn_s_sleep(8); } else run_phase<PH>(p, l, lds); } while (0)
    RUNP(PH_PRO, 0);
#define LAYER(l) do { if ((l) == 0) RUNP(PH_NORM1, l); \
        RUNP(PH_WIN, l); RUNP(PH_POSTA, l); RUNP(PH_POSTB, l); RUNP(PH_MIXER, l); RUNP(PH_HYFIN, l); RUNP(PH_WOUT, l); \
        RUND(PH_ROUTE, l); GRID_BAR(); RUND(PH_PLACE, l); GRID_BAR(); RUNP(PH_GEMM1, l); RUNP(PH_GEMM2, l); RUND(PH_FINAL, l); \
        if ((l) + 1 < NLAYER) GRID_BAR(); } while (0)
    LAYER(0);
    LAYER(1);
}
#endif

#if !MEGA
template <int PH> __global__ void __launch_bounds__(NTHREADS, 2) k_phase(Params p) {
    extern __shared__ __attribute__((aligned(16))) unsigned char lds_raw[];
    run_phase<PH>(p, p.layer, (LAS unsigned char*)lds_raw);
}
template <int PH> static bool prep_phase() { return hipFuncSetAttribute((const void*)k_phase<PH>, hipFuncAttributeMaxDynamicSharedMemorySize, LDS_BYTES) == hipSuccess; }
static int g_nlaunch = 0;
#ifndef DBG_STOP
#define DBG_STOP 1000
#define DBG_DUMP 0
#else
#define DBG_DUMP 1
#ifndef DBG_SET
#define DBG_SET 31
#endif
#endif
template <int PH> static void launch_phase(Params p, int l, hipStream_t st) { if (g_nlaunch++ >= DBG_STOP) return; p.layer = l; hipLaunchKernelGGL(k_phase<PH>, dim3(256), dim3(NTHREADS), LDS_BYTES, st, p); }
#endif


#if DBG_DUMP
__device__ __forceinline__ float san(float x) { return (x == x && fabsf(x) < 1e6f) ? x : 1.0f; }
__global__ void __launch_bounds__(256) k_dump(Params p) {
    const size_t N = (size_t)NLAT * DM;
    const bf16_t* b1 = (const bf16_t*)(p.ws + O_WIN); const size_t n1 = (O_X - O_WIN) / 2;
    const bf16_t* b2 = (const bf16_t*)(p.ws + O_H); const size_t n2 = (size_t)NTOK * DM;
    const bf16_t* b3 = (const bf16_t*)(p.ws + O_A); const size_t n3 = (O_AEND - O_A) / 2;
    const float* f1 = (const float*)(p.ws + O_MOD); const size_t m1 = (O_WIN - O_MOD) / 4;
    const float* f2 = (const float*)(p.ws + O_X); const size_t m2 = (size_t)NTOK * DM;
    for (size_t i = (size_t)blockIdx.x * 256 + otid(); i < N; i += (size_t)gridDim.x * 256) {
        float v = 0.f;
        if (DBG_SET & 1) for (size_t e = i; e < n1; e += N) v += san(bf2f(b1[e]));
        if (DBG_SET & 2) for (size_t e = i; e < n2; e += N) v += san(bf2f(b2[e]));
        if (DBG_SET & 4) for (size_t e = i; e < n3; e += N) v += san(bf2f(b3[e]));
        if (DBG_SET & 8) for (size_t e = i; e < m1; e += N) v += san(f1[e]);
        if (DBG_SET & 16) for (size_t e = i; e < m2; e += N) v += san(f2[e]);
        if (DBG_SET & 32) v += san(bf2f(((const bf16_t*)(p.ws + O_WUKV))[i % ((size_t)2 * 1536 * 256)]));
        if (DBG_SET & 64) { const size_t r = i % NTOK, c = (i / NTOK) % 256; v += san(bf2f(((const bf16_t*)(p.ws + O_P))[r * NP + C_CKV + c])); }
        if (DBG_SET & 128) v += san(bf2f(((const bf16_t*)(p.ws + O_KVRAW))[i % ((size_t)NTOK * 1536)]));
        p.out[i] = v;
    }
}
#endif
static int g_grid = 0;
extern "C" void kernel_launch(void* const* d_in, const int* in_sizes, int n_in, void* d_out, int out_size, void* d_ws, size_t ws_size, hipStream_t stream) {
    static int ok = 0;
    if (ok == 0) {
        if (n_in != 31 || in_sizes[0] != NLAT * DM || out_size != NLAT * DM || ws_size < WS_END) { fprintf(stderr, "kernel_launch: unexpected shapes (n_in %d, ws %zu, need %zu)\n", n_in, ws_size, (size_t)WS_END); ok = -1; return; }
        bool good = true;
#if !MEGA
        good = good && prep_phase<0>() && prep_phase<1>() && prep_phase<2>() && prep_phase<3>() && prep_phase<4>() && prep_phase<5>() && prep_phase<6>() && prep_phase<7>() && prep_phase<8>() && prep_phase<9>() && prep_phase<10>() && prep_phase<11>() && prep_phase<12>();
#endif
#if MEGA
        good = hipFuncSetAttribute((const void*)mega_fwd, hipFuncAttributeMaxDynamicSharedMemorySize, LDS_BYTES) == hipSuccess;
        int dev = 0, cus = 0, per_cu = 0;
        if (hipGetDevice(&dev) != hipSuccess || hipDeviceGetAttribute(&cus, hipDeviceAttributeMultiprocessorCount, dev) != hipSuccess) good = false;
        if (good && (hipOccupancyMaxActiveBlocksPerMultiprocessor(&per_cu, (const void*)mega_fwd, NTHREADS, LDS_BYTES) != hipSuccess || per_cu < 1)) { fprintf(stderr, "kernel_launch: occupancy query says %d workgroups per CU\n", per_cu); good = false; }
        g_grid = cus;
#endif
        if (!good) { fprintf(stderr, "kernel_launch: set-up failed\n"); ok = -1; return; }
        ok = 1;
    }
    if (ok < 0) return;
    Params p{}; for (int i = 0; i < 31; ++i) p.in[i] = (const float*)d_in[i]; p.out = (float*)d_out; p.ws = (unsigned char*)d_ws; p.layer = 0; p.pad = 0;
#ifdef POISON_WS
    hipMemsetAsync((char*)d_ws, 0xFF, WS_END, stream);
#endif
    hipMemsetAsync((char*)d_ws + O_CTL, 0, ZERO_BYTES, stream);
#if !MEGA
    g_nlaunch = 0;
    launch_phase<PH_PRO>(p, 0, stream);
    for (int l = 0; l < NLAYER; ++l) {
        if (l == 0) launch_phase<PH_NORM1>(p, l, stream);
        launch_phase<PH_WIN>(p, l, stream); launch_phase<PH_POSTA>(p, l, stream); launch_phase<PH_POSTB>(p, l, stream); launch_phase<PH_MIXER>(p, l, stream);
        launch_phase<PH_HYFIN>(p, l, stream); launch_phase<PH_WOUT>(p, l, stream); launch_phase<PH_ROUTE>(p, l, stream); launch_phase<PH_PLACE>(p, l, stream);
        launch_phase<PH_GEMM1>(p, l, stream); launch_phase<PH_GEMM2>(p, l, stream); launch_phase<PH_FINAL>(p, l, stream);
    }
#if DBG_DUMP
    hipLaunchKernelGGL(k_dump, dim3(2048), dim3(256), 0, stream, p);
#endif
#else
    hipLaunchKernelGGL(mega_fwd, dim3(g_grid), dim3(NTHREADS), LDS_BYTES, stream, p);
#endif
}
```

```cpp
#define MOE_FP8 1
#define GQA_SD 1
#define FAST_GEMM 1
#define MEGA 1
#include <hip/hip_runtime.h>
#include <stdint.h>
#include <stdio.h>

#define LAS __attribute__((address_space(3)))
typedef unsigned short bf16_t;
typedef short bf16x8 __attribute__((ext_vector_type(8)));
typedef short s16x4 __attribute__((ext_vector_type(4)));
typedef float f32x4 __attribute__((ext_vector_type(4)));
typedef float f32x16 __attribute__((ext_vector_type(16)));
typedef unsigned u32x4 __attribute__((ext_vector_type(4)));
typedef unsigned u32x2 __attribute__((ext_vector_type(2)));

constexpr int DM = 2048, NB = 8, SEQ = 2048, CTXL = 256, NLAT = NB * SEQ, NCTX = NB * CTXL, NTOK = NLAT + NCTX, NLAYER = 2;
constexpr int NP = 4096;
constexpr int C_CQ = 1536, C_GQ = 2304, C_CKV = 3072, C_KR = 3328, C_GK = 3392, C_GV = 3648, IN_COLS = 3904;
constexpr int NEXP = 64, TOPK = 6, EH = 512;
constexpr int LK = CTXL + SEQ;
constexpr int RSLOTS = 126976;
constexpr int NSLOTS = RSLOTS + NTOK;
constexpr int MAXTILES = NSLOTS / 256;
constexpr int NQP = 1280;
constexpr float EPS = 1e-6f;
constexpr int NTHREADS = 512;
#ifndef GQA_SD
#define GQA_SD 2
#endif
#ifndef HY_MFMA
#define HY_MFMA 1
#endif
#ifndef MOE_FP8
#define MOE_FP8 0
#endif
#ifndef DENSE_FP8
#define DENSE_FP8 0
#endif
#define WIN8 ((DENSE_FP8 & 1) != 0)
#define WOUT8 ((DENSE_FP8 & 2) != 0)
constexpr float MIX8_SCALE = 16.0f;
#ifndef DOUT_FP8
#define DOUT_FP8 MOE_FP8
#endif
constexpr float DOUT8_SCALE = 8.0f;
#ifndef FAST_GEMM
#define FAST_GEMM 1
#endif
#ifndef MEGA
#define MEGA 1
#endif

constexpr size_t al256(size_t x) { return (x + 255) & ~(size_t)255; }
constexpr size_t O_CTL = 0;
constexpr size_t CTL_BYTES = 65536;
constexpr size_t O_MOD = O_CTL + CTL_BYTES;
constexpr size_t O_HSS = O_MOD + al256((size_t)NLAYER * 9 * 12288 * 4);
constexpr size_t ZERO_BYTES = O_HSS + al256((size_t)NLAYER * 2 * 2 * 512 * 4);
constexpr size_t O_HF = ZERO_BYTES;
constexpr size_t HF_L0 = (size_t)2 * 2 * 512 * 2048, HF_L1 = (size_t)2 * 2 * 512 * 256, HF_LAYER = HF_L0 + HF_L1;
constexpr size_t O_WIN = O_HF + al256(NLAYER * HF_LAYER * 4);
constexpr size_t O_WOUT = O_WIN + (size_t)NLAYER * NP * DM * 2;
constexpr size_t O_WUQ = O_WOUT + (size_t)NLAYER * DM * DM * 2;
constexpr size_t O_WUKV = O_WUQ + al256((size_t)NLAYER * NQP * 768 * 2);
constexpr size_t O_EGU = O_WUKV + al256((size_t)NLAYER * 1536 * 256 * 2);
constexpr size_t O_ED = O_EGU + (size_t)65 * 1024 * 2048 * 2;
constexpr size_t O_X = O_ED + (size_t)65 * 2048 * 512 * 2;
constexpr size_t O_H = O_X + (size_t)NTOK * DM * 4;
constexpr size_t O_EIDX = O_H + (size_t)NTOK * DM * 2;
constexpr size_t O_GATE = O_EIDX + (size_t)NTOK * 8 * 4;
constexpr size_t O_SLOT = O_GATE + (size_t)NTOK * 8 * 4;
constexpr size_t O_STOK = O_SLOT + (size_t)NTOK * 8 * 4;
constexpr size_t O_WCNT = O_STOK + al256((size_t)NSLOTS * 4);
constexpr size_t O_ROPE = O_WCNT + (size_t)1024 * 64 * 4;
constexpr size_t O_HID = O_ROPE + (size_t)(64 * 32 + 64 * 16) * 8;
constexpr size_t O_A = O_HID + (size_t)NSLOTS * EH * 2;
constexpr size_t O_P = O_A;
constexpr size_t O_QRAW = O_P + (size_t)NTOK * NP * 2;
constexpr size_t O_KVRAW = O_QRAW + (size_t)NTOK * NQP * 2;
constexpr size_t O_QM = O_KVRAW + (size_t)NTOK * 1536 * 2;
constexpr size_t O_QMC = O_QM + (size_t)NB * 6 * SEQ * 192 * 2;
constexpr size_t O_KM = O_QMC + (size_t)NB * 6 * CTXL * 192 * 2;
constexpr size_t O_VM = O_KM + (size_t)NB * 6 * LK * 192 * 2;
constexpr size_t O_QG = O_VM + (size_t)NB * 6 * LK * 128 * 2;
constexpr size_t O_QGC = O_QG + (size_t)NB * 6 * SEQ * 128 * 2;
constexpr size_t O_KG = O_QGC + (size_t)NB * 6 * CTXL * 128 * 2;
constexpr size_t O_VG = O_KG + (size_t)NB * 2 * LK * 128 * 2;
constexpr size_t O_VT = O_VG + (size_t)NB * 2 * LK * 128 * 2;
constexpr size_t O_X1T = O_VT + (size_t)512 * NTOK * 2;
constexpr size_t O_Y2T = O_X1T + (size_t)512 * NTOK * 2;
constexpr size_t O_MIX = O_Y2T + (size_t)512 * NTOK * 2;
constexpr size_t O_OUT = O_MIX + (size_t)NTOK * DM * 2;
constexpr size_t O_AEND = O_OUT + (size_t)NTOK * DM * 2;
constexpr size_t O_DOUT = O_A;
static_assert(O_DOUT + (size_t)NSLOTS * DM * 2 <= O_AEND, "DOUT must fit the mixer scratch region");
constexpr size_t WS_END = O_AEND;

constexpr int CW_BAR = 0;
constexpr int CW_CNT = 4096;
constexpr int CW_CUR = 4096 + 128;
constexpr int CW_Q = 4096 + 256;

constexpr int LDS_BYTES = 148480;
constexpr int LDS_MISC = 147456;
constexpr int LDS_TILES = 131072;
constexpr int LDS_CNTL = LDS_MISC + 512;

struct Params { const float* in[31]; float* out; unsigned char* ws; int layer; int pad; };

enum { I_X = 0, I_C, I_CTX, I_CCTX, I_ADAW, I_ADAB, I_NORMG, I_WIN, I_WOUT, I_HYCONV, I_HYW1, I_HYB1, I_HYW2, I_HYB2, I_HYW3, I_HYFREQ, I_HYSKIP,
       I_MQN, I_MKVN, I_WUQ, I_WUKV, I_GQN, I_GKN, I_RW, I_RB, I_EG, I_EU, I_EDN, I_SG, I_SU, I_SD };

__device__ __forceinline__ int otid() { int t = threadIdx.x; asm volatile("" : "+v"(t)); return t; }
__device__ __forceinline__ int owid() { return __builtin_amdgcn_readfirstlane(otid() >> 6); }
__device__ __forceinline__ float bf2f(bf16_t v) { return __uint_as_float(((unsigned)v) << 16); }
__device__ __forceinline__ bf16_t f2bf(float f) { unsigned u = __float_as_uint(f); u += 0x7FFFu + ((u >> 16) & 1u); return (bf16_t)(u >> 16); }
__device__ __forceinline__ unsigned pk2(float lo, float hi) { unsigned r; asm volatile("v_cvt_pk_bf16_f32 %0, %1, %2" : "=v"(r) : "v"(lo), "v"(hi)); return r; }
__device__ __forceinline__ float wave_sum(float v) {
#pragma unroll
    for (int o = 32; o >= 1; o >>= 1) v += __shfl_xor(v, o);
    return v;
}
__device__ __forceinline__ float rdlane(float v, int l) { return __int_as_float(__builtin_amdgcn_readlane(__float_as_int(v), l)); }
__device__ __forceinline__ float silu_f(float x) { return x / (1.0f + __expf(-x)); }
__device__ __forceinline__ const float* resid_src(const Params& p, int l, int row) {
    if (l == 0) return row < NLAT ? p.in[I_X] + (size_t)row * DM : p.in[I_CTX] + (size_t)(row - NLAT) * DM;
    return (const float*)(p.ws + O_X) + (size_t)row * DM;
}
__device__ __forceinline__ int row_batch(int row) { return row < NLAT ? row >> 11 : 8; }
#define ROWCOL(j, lane) ((j) * 256 + (lane) * 4)


struct GUnit { int arow0; const bf16_t* B; int orow0, ocol0; };
struct GemmDesc { const bf16_t* A; int lda; const int* ridx; int ldb; int K; };

__host__ __device__ __forceinline__ int perm32(int rho) { const int n = rho >> 4, i = rho & 15; return 8 * (i >> 2) + 4 * n + (i & 3); }
struct EpiStoreBf16 {
    static constexpr bool PERM = (FAST_GEMM != 0);
    bf16_t* O; int ldo;
    __device__ __forceinline__ void operator()(const f32x4 (&acc)[2][2][4][2], const GUnit& u, int wr, int wc, int fr, int fq) const {
#pragma unroll
        for (int ai = 0; ai < 2; ++ai)
#pragma unroll
            for (int m = 0; m < 4; ++m) {
                bf16_t* rowp = O + (size_t)(u.orow0 + ai * 128 + wr * 64 + m * 16 + fr) * ldo + u.ocol0 + wc * 32 + (PERM ? 8 : 4) * fq;
#pragma unroll
                for (int bj = 0; bj < 2; ++bj) {
                    if constexpr (PERM) { const f32x4 v0 = acc[ai][bj][m][0], v1 = acc[ai][bj][m][1]; u32x4 w; w.x = pk2(v0[0], v0[1]); w.y = pk2(v0[2], v0[3]); w.z = pk2(v1[0], v1[1]); w.w = pk2(v1[2], v1[3]); *(u32x4*)(rowp + bj * 128) = w; }
                    else {
#pragma unroll
                        for (int n = 0; n < 2; ++n) { const f32x4 v = acc[ai][bj][m][n]; u32x2 w; w.x = pk2(v[0], v[1]); w.y = pk2(v[2], v[3]); *(u32x2*)(rowp + bj * 128 + n * 16) = w; } } }
            }
    }
};
struct EpiSwiGLU {
    static constexpr bool PERM = (FAST_GEMM != 0);
    bf16_t* O;
    __device__ __forceinline__ void operator()(const f32x4 (&acc)[2][2][4][2], const GUnit& u, int wr, int wc, int fr, int fq) const {
#pragma unroll
        for (int ai = 0; ai < 2; ++ai)
#pragma unroll
            for (int m = 0; m < 4; ++m) {
                bf16_t* rowp = O + (size_t)(u.orow0 + ai * 128 + wr * 64 + m * 16 + fr) * EH + u.ocol0 + wc * 32 + (PERM ? 8 : 4) * fq;
#pragma unroll
                for (int n = 0; n < 2; ++n) { const f32x4 g = acc[ai][0][m][n], up = acc[ai][1][m][n]; float h[4];
#pragma unroll
                    for (int j = 0; j < 4; ++j) h[j] = silu_f(g[j]) * up[j];
                    u32x2 w; w.x = pk2(h[0], h[1]); w.y = pk2(h[2], h[3]); *(u32x2*)(rowp + n * (PERM ? 4 : 16)) = w; }
            }
    }
};

__device__ __forceinline__ float clamp8(float x) { return __builtin_amdgcn_fmed3f(x, -448.0f, 448.0f); }
__device__ __forceinline__ unsigned pk4_fp8(float a, float b, float c, float d) { int r = __builtin_amdgcn_cvt_pk_fp8_f32(clamp8(a), clamp8(b), 0, false); r = __builtin_amdgcn_cvt_pk_fp8_f32(clamp8(c), clamp8(d), r, true); return (unsigned)r; }
constexpr float HID8_SCALE = 8.0f;
constexpr float W8_SCALE = 256.0f;
struct EpiSwiGLU8 {
    static constexpr bool PERM = (FAST_GEMM != 0);
    unsigned char* O;
    __device__ __forceinline__ void operator()(const f32x4 (&acc)[2][2][4][2], const GUnit& u, int wr, int wc, int fr, int fq) const {
#pragma unroll
        for (int ai = 0; ai < 2; ++ai)
#pragma unroll
            for (int m = 0; m < 4; ++m) {
                unsigned char* rowp = O + (size_t)(u.orow0 + ai * 128 + wr * 64 + m * 16 + fr) * EH + u.ocol0 + wc * 32 + (PERM ? 8 : 4) * fq;
#pragma unroll
                for (int n = 0; n < 2; ++n) { const f32x4 g = acc[ai][0][m][n], up = acc[ai][1][m][n]; float h[4];
#pragma unroll
                    for (int j = 0; j < 4; ++j) h[j] = silu_f(g[j]) * up[j] * HID8_SCALE;
                    *(unsigned*)(rowp + n * (PERM ? 4 : 16)) = pk4_fp8(h[0], h[1], h[2], h[3]); }
            }
    }
};

struct EpiStoreFp8 {
    static constexpr bool PERM = true;
    unsigned char* O; int ldo; float scale;
    __device__ __forceinline__ void operator()(const f32x4 (&acc)[2][2][4][2], const GUnit& u, int wr, int wc, int fr, int fq) const {
#pragma unroll
        for (int ai = 0; ai < 2; ++ai)
#pragma unroll
            for (int m = 0; m < 4; ++m) {
                unsigned char* rowp = O + (size_t)(u.orow0 + ai * 128 + wr * 64 + m * 16 + fr) * ldo + u.ocol0 + wc * 32 + 8 * fq;
#pragma unroll
                for (int bj = 0; bj < 2; ++bj) { const f32x4 v0 = acc[ai][bj][m][0] * scale, v1 = acc[ai][bj][m][1] * scale; u32x2 w; w.x = pk4_fp8(v0[0], v0[1], v0[2], v0[3]); w.y = pk4_fp8(v1[0], v1[1], v1[2], v1[3]); *(u32x2*)(rowp + bj * 128) = w; }
            }
    }
};

template <class Epi>
__device__ __forceinline__ void gemm_unit_simple(const GemmDesc& g, const GUnit& u, const Epi& E) {
    int tid = otid();
    const int wid = __builtin_amdgcn_readfirstlane(tid >> 6), lane = tid & 63, wr = wid >> 2, wc = wid & 3, fr = lane & 15, fq = lane >> 4;
    f32x4 acc[2][2][4][2];
#pragma unroll
    for (int a = 0; a < 2; ++a)
#pragma unroll
        for (int b = 0; b < 2; ++b)
#pragma unroll
            for (int m = 0; m < 4; ++m)
#pragma unroll
                for (int n = 0; n < 2; ++n) acc[a][b][m][n] = (f32x4){0.f, 0.f, 0.f, 0.f};
    const bf16_t* ap[2][4]; const bf16_t* bp[2][2];
#pragma unroll
    for (int ai = 0; ai < 2; ++ai)
#pragma unroll
        for (int m = 0; m < 4; ++m) { const int r = u.arow0 + ai * 128 + wr * 64 + m * 16 + fr; int src = g.ridx ? g.ridx[r] : r; if (src < 0) src = 0; ap[ai][m] = g.A + (size_t)src * g.lda + 8 * fq; }
#pragma unroll
    for (int bj = 0; bj < 2; ++bj)
#pragma unroll
        for (int n = 0; n < 2; ++n) bp[bj][n] = u.B + (size_t)(bj * 128 + wc * 32 + n * 16 + fr) * g.ldb + 8 * fq;
    int Kq = g.K; asm volatile("" : "+s"(Kq));
#pragma unroll 1
    for (int k0 = 0; k0 < Kq; k0 += 32) {
        bf16x8 a[2][4], b[2][2];
#pragma unroll
        for (int ai = 0; ai < 2; ++ai)
#pragma unroll
            for (int m = 0; m < 4; ++m) a[ai][m] = *(const bf16x8*)(ap[ai][m] + k0);
#pragma unroll
        for (int bj = 0; bj < 2; ++bj)
#pragma unroll
            for (int n = 0; n < 2; ++n) b[bj][n] = *(const bf16x8*)(bp[bj][n] + k0);
#pragma unroll
        for (int ai = 0; ai < 2; ++ai)
#pragma unroll
            for (int bj = 0; bj < 2; ++bj)
#pragma unroll
                for (int m = 0; m < 4; ++m)
#pragma unroll
                    for (int n = 0; n < 2; ++n) acc[ai][bj][m][n] = __builtin_amdgcn_mfma_f32_16x16x32_bf16(b[bj][n], a[ai][m], acc[ai][bj][m][n], 0, 0, 0);
    }
    E(acc, u, wr, wc, fr, fq);
}

struct DenseSched {
    const bf16_t* Bt; int ldb, nM, nN, row0, pn0;
    __device__ __forceinline__ int count() const { return nM * nN; }
    __device__ __forceinline__ int ncol() const { return nN; }
    __device__ __forceinline__ void unit(int i, GUnit& u) const { const int pm = i / nN, pn = pn0 + i % nN; u.arow0 = row0 + pm * 256; u.B = Bt + (size_t)pn * 256 * ldb; u.orow0 = u.arow0; u.ocol0 = pn * 256; }
};
struct MoeSched {
    const LAS int* te; const LAS int* ts; int ntiles, npn; const bf16_t* Bt; size_t estride; int ldb, ocolw;
    __device__ __forceinline__ int count() const { return ntiles * npn; }
    __device__ __forceinline__ int ncol() const { return npn; }
    __device__ __forceinline__ void unit(int i, GUnit& u) const { const int t = i / npn, pn = i % npn; const int e = te[t]; u.arow0 = ts[t]; u.B = Bt + (size_t)e * estride + (size_t)pn * 256 * ldb; u.orow0 = u.arow0; u.ocol0 = pn * ocolw; }
};
template <class Sched, class Epi>
__device__ __forceinline__ void gemm_phase_simple(const GemmDesc& g, const Sched& S, const Epi& E) {
    const int n = S.count();
    for (int i = blockIdx.x; i < n; i += gridDim.x) { GUnit u; S.unit(i, u); gemm_unit_simple(g, u, E); }
}
__device__ __forceinline__ int wave_incl_scan(int v, int lane) {
#pragma unroll
    for (int o = 1; o < 64; o <<= 1) { const int t = __shfl_up(v, o); if (lane >= o) v += t; }
    return v;
}
__device__ __forceinline__ int moe_build_tiles(const unsigned* cnt, int nshared, LAS int* te, LAS int* ts, LAS int* misc) {
    __syncthreads();
    const int tid = otid();
    if (tid < 64) {
        const int c = (int)cnt[tid], ntile = (c + 255) >> 8, incl = wave_incl_scan(ntile, tid), first = incl - ntile;
        for (int j = 0; j < ntile; ++j) { te[first + j] = tid; ts[first + j] = (first + j) * 256; }
        const int nrt = __shfl(incl, 63);
        for (int j = tid; j < nshared; j += 64) { te[nrt + j] = NEXP; ts[nrt + j] = RSLOTS + j * 256; }
        if (tid == 0) misc[0] = nrt + nshared;
    }
    __syncthreads();
    return misc[0];
}
#ifndef FAST_GEMM
#define FAST_GEMM 0
#endif
#if !FAST_GEMM
#define GEMM_PHASE(g, S, E) gemm_phase_simple(g, S, E)
#endif

#if FAST_GEMM
constexpr int HTB = 128 * 64 * 2;
__device__ __forceinline__ int lds_byte(int r, int c) { const int st = (r >> 4) * 2 + (c >> 5), rr = r & 15, cc = c & 31, ob = rr * 64 + cc * 2; return st * 1024 + (ob ^ (((ob >> 9) & 1) << 5)); }
__device__ __forceinline__ void stage_rc(int b, int& R, int& C) { const int st = b / 1024, sb = b % 1024, swz = sb ^ (((sb >> 9) & 1) << 5); R = (st >> 1) * 16 + swz / 64; C = (st & 1) * 32 + (swz % 64) / 2; }

typedef int v8i __attribute__((ext_vector_type(8)));
typedef int v4i __attribute__((ext_vector_type(4)));
template <int ESZ, class Sched, class Epi>
__device__ __forceinline__ void gemm_phase_fast(LAS unsigned char* lds, const GemmDesc& g, const Sched& S, const Epi& E, int scA = 127, int scB = 127) {
    const int tid = otid(), wid = __builtin_amdgcn_readfirstlane(tid >> 6), lane = tid & 63, wr = wid >> 2, wc = wid & 3, fr = lane & 15, fq = lane >> 4;
    const int K = g.K, nunits = S.count(), G = gridDim.x, c0 = blockIdx.x;
    int nt = K * ESZ / 128; asm volatile("" : "+s"(nt));
    const int npn = S.ncol(); const bool xmap = (G % 8 == 0) && ((G / 8) % npn == 0); const int xT = xmap ? (G / 8) / npn : 1, xx = c0 % 8, xr = c0 / 8;
#define F_UNIT(ui_) (xmap ? (((ui_) * 8 + xx) * xT + xr / npn) * npn + xr % npn : (ui_) * G + c0)
    if (F_UNIT(0) >= nunits) return;
    int R[2], C[2]; unsigned voffB[2];
#pragma unroll
    for (int i = 0; i < 2; ++i) { stage_rc(tid * 16 + i * 8192, R[i], C[i]); const int Rb = Epi::PERM ? ((R[i] & ~31) + perm32(R[i] & 31)) : R[i]; voffB[i] = (unsigned)(Rb * g.ldb) * (unsigned)ESZ + (unsigned)C[i] * 2u; }
    const size_t kstep = 128;
    const size_t hstepB = (size_t)128 * g.ldb * ESZ;
    const unsigned ldsw = (unsigned)wid * 1024u;
    const int aoff = lds_byte(wr * 64 + fr, fq * 8), boff = lds_byte(wc * 32 + fr, fq * 8);
    const char* Ab = (const char*)g.A;
#define F_SA(b, h) (((b) * 2 + (h)) * HTB)
#define F_SB(b, h) ((4 + (b) * 2 + (h)) * HTB)
#define F_STAGE(bufoff, gbase, voff) do { _Pragma("unroll") for (int _i = 0; _i < 2; ++_i) \
        __builtin_amdgcn_global_load_lds((const unsigned*)((const char*)(gbase) + (voff)[_i]), (LAS unsigned*)(lds + (bufoff) + ldsw + _i * 8192), 16, 0, 0); } while (0)
#define F_LDA(dst, b, h) do { _Pragma("unroll") for (int m = 0; m < 4; ++m) { if constexpr (ESZ == 2) { _Pragma("unroll") for (int k = 0; k < 2; ++k) dst[m][k] = *(const LAS bf16x8*)(lds + F_SA(b, h) + aoff + m * 2048 + k * 1024); } \
        else { const v4i lo_ = *(const LAS v4i*)(lds + F_SA(b, h) + aoff + m * 2048), hi_ = *(const LAS v4i*)(lds + F_SA(b, h) + aoff + m * 2048 + 1024); dst##8[m] = __builtin_shufflevector(lo_, hi_, 0, 1, 2, 3, 4, 5, 6, 7); } } } while (0)
#define F_LDB(dst, b, h) do { _Pragma("unroll") for (int n = 0; n < 2; ++n) { if constexpr (ESZ == 2) { _Pragma("unroll") for (int k = 0; k < 2; ++k) dst[n][k] = *(const LAS bf16x8*)(lds + F_SB(b, h) + boff + n * 2048 + k * 1024); } \
        else { const v4i lo_ = *(const LAS v4i*)(lds + F_SB(b, h) + boff + n * 2048), hi_ = *(const LAS v4i*)(lds + F_SB(b, h) + boff + n * 2048 + 1024); dst##8[n] = __builtin_shufflevector(lo_, hi_, 0, 1, 2, 3, 4, 5, 6, 7); } } } while (0)
#define F_MMA(ai, bj, At, Bt) do { __builtin_amdgcn_s_setprio(1); _Pragma("unroll") for (int m = 0; m < 4; ++m) _Pragma("unroll") for (int n = 0; n < 2; ++n) { \
        if constexpr (ESZ == 2) { _Pragma("unroll") for (int k = 0; k < 2; ++k) acc[ai][bj][m][n] = __builtin_amdgcn_mfma_f32_16x16x32_bf16(Bt[n][k], At[m][k], acc[ai][bj][m][n], 0, 0, 0); } \
        else acc[ai][bj][m][n] = __builtin_amdgcn_mfma_scale_f32_16x16x128_f8f6f4(Bt##8[n], At##8[m], acc[ai][bj][m][n], 0, 0, 0, scB, 0, scA); } \
        __builtin_amdgcn_s_setprio(0); } while (0)
#define F_WAIT_V(n) asm volatile("s_waitcnt vmcnt(" #n ")" ::: "memory")
#define F_WAIT_L(n) asm volatile("s_waitcnt lgkmcnt(" #n ")" ::: "memory")
#define F_BAR __builtin_amdgcn_s_barrier()
#define F_SCHED __builtin_amdgcn_sched_barrier(0)
#define F_AROWS(u, dst) do { _Pragma("unroll") for (int _h = 0; _h < 2; ++_h) _Pragma("unroll") for (int _i = 0; _i < 2; ++_i) { const int _r = (u).arow0 + _h * 128 + R[_i]; int _s = g.ridx ? g.ridx[_r] : _r; if (_s < 0) _s = 0; dst[_h][_i] = _s; } } while (0)
#define F_AOFFS(src, dst) do { _Pragma("unroll") for (int _h = 0; _h < 2; ++_h) _Pragma("unroll") for (int _i = 0; _i < 2; ++_i) dst[_h][_i] = (unsigned)src[_h][_i] * (unsigned)g.lda * (unsigned)ESZ + (unsigned)C[_i] * 2u; } while (0)
    GUnit cur, nxt; int ui = 0;
    S.unit(F_UNIT(0), cur);
    f32x4 acc[2][2][4][2];
#pragma unroll
    for (int a = 0; a < 2; ++a)
#pragma unroll
        for (int b = 0; b < 2; ++b)
#pragma unroll
            for (int m = 0; m < 4; ++m)
#pragma unroll
                for (int n = 0; n < 2; ++n) acc[a][b][m][n] = (f32x4){0.f, 0.f, 0.f, 0.f};
    bf16x8 At[4][2], B0[2][2], B1[2][2]; v8i At8[4], B08[2], B18[2];
    unsigned voA[2][2]; int rnx[2][2];
    F_AROWS(cur, rnx); F_AOFFS(rnx, voA);
    const char* cB = (const char*)cur.B;
    F_STAGE(F_SB(0, 0), cB, voffB); F_STAGE(F_SA(0, 0), Ab, voA[0]); F_STAGE(F_SB(0, 1), cB + hstepB, voffB); F_STAGE(F_SA(0, 1), Ab, voA[1]);
    if (wr == 1) F_BAR;
    F_WAIT_V(4); F_BAR;
    F_STAGE(F_SB(1, 0), cB + kstep, voffB); F_STAGE(F_SA(1, 0), Ab + kstep, voA[0]); F_STAGE(F_SB(1, 1), cB + hstepB + kstep, voffB);
    F_WAIT_V(6); F_BAR;
    for (;;) {
        const int Ln = F_UNIT(ui + 1); const bool has_next = Ln < nunits;
        if (has_next) { S.unit(Ln, nxt); F_AROWS(nxt, rnx); }
        const char* nB = has_next ? (const char*)nxt.B : cB;
        for (int t = 0; t < nt; t += 2) {
            const bool last = (t == nt - 2);
            const char* a1 = Ab + (size_t)(t + 1) * kstep;
            const char* a2 = last ? Ab : Ab + (size_t)(t + 2) * kstep; const char* b2 = last ? nB : cB + (size_t)(t + 2) * kstep;
            const char* a3 = a2 + kstep; const char* b3 = b2 + kstep;
            F_LDB(B0, 0, 0); F_SCHED; F_LDA(At, 0, 0); F_STAGE(F_SA(1, 1), a1, voA[1]);
            if (last && has_next) F_AOFFS(rnx, voA);
            F_WAIT_L(8); F_BAR; F_WAIT_L(0); F_MMA(0, 0, At, B0); F_BAR; F_SCHED;
            F_LDB(B1, 0, 1); F_STAGE(F_SB(0, 0), b2, voffB);
            F_BAR; F_WAIT_L(0); F_MMA(0, 1, At, B1); F_BAR;
            F_LDA(At, 0, 1); F_STAGE(F_SA(0, 0), a2, voA[0]);
            F_BAR; F_WAIT_L(0); F_MMA(1, 0, At, B0); F_BAR; F_SCHED;
            F_STAGE(F_SB(0, 1), b2 + hstepB, voffB);
            F_WAIT_V(6); F_BAR; F_MMA(1, 1, At, B1); F_BAR;
            F_LDB(B0, 1, 0); F_SCHED; F_LDA(At, 1, 0); F_STAGE(F_SA(0, 1), a2, voA[1]);
            F_WAIT_L(8); F_BAR; F_WAIT_L(0); F_MMA(0, 0, At, B0); F_BAR; F_SCHED;
            F_LDB(B1, 1, 1); F_STAGE(F_SB(1, 0), b3, voffB);
            F_BAR; F_WAIT_L(0); F_MMA(0, 1, At, B1); F_BAR;
            F_LDA(At, 1, 1); F_STAGE(F_SA(1, 0), a3, voA[0]);
            F_BAR; F_WAIT_L(0); F_MMA(1, 0, At, B0); F_BAR; F_SCHED;
            F_STAGE(F_SB(1, 1), b3 + hstepB, voffB);
            F_WAIT_V(6); F_BAR; F_MMA(1, 1, At, B1); F_BAR;
        }
        E(acc, cur, wr, wc, fr, fq);
        if (!has_next) break;
#pragma unroll
        for (int a = 0; a < 2; ++a)
#pragma unroll
            for (int b = 0; b < 2; ++b)
#pragma unroll
                for (int m = 0; m < 4; ++m)
#pragma unroll
                    for (int n = 0; n < 2; ++n) acc[a][b][m][n] = (f32x4){0.f, 0.f, 0.f, 0.f};
        cur = nxt; cB = nB; ++ui;
    }
    F_WAIT_V(0);
    if (wr == 0) F_BAR;
    F_BAR;
#undef F_UNIT
#undef F_SA
#undef F_SB
#undef F_STAGE
#undef F_LDA
#undef F_LDB
#undef F_MMA
#undef F_WAIT_V
#undef F_WAIT_L
#undef F_BAR
#undef F_SCHED
#undef F_AROWS
#undef F_AOFFS
}
#define GEMM_PHASE(g, S, E) gemm_phase_fast<2>(lds, g, S, E)
#define GEMM_PHASE8(g, S, E, sa, sb) gemm_phase_fast<1>(lds, g, S, E, sa, sb)
#endif

#define SBAR() __builtin_amdgcn_sched_barrier(0)
__device__ __forceinline__ int crow(int r, int hi) { return (r & 3) + 8 * (r >> 2) + 4 * hi; }
template <int DQK> __device__ __forceinline__ int kaddr(int row, int chunk) {
    const int sw = (DQK == 128) ? (row & 7) : ((row >> 1) & 7);
    return row * (DQK * 2) + ((chunk ^ sw) << 4);
}
__device__ __forceinline__ void partialSM(f32x16& p0, f32x16& p1, float& m_reg, float& mn, float& alpha, float C, float thr) {
    float pmax = p0[0];
#pragma unroll
    for (int r = 1; r < 16; ++r) pmax = fmaxf(pmax, p0[r]);
#pragma unroll
    for (int r = 0; r < 16; ++r) pmax = fmaxf(pmax, p1[r]);
    { auto rr = __builtin_amdgcn_permlane32_swap(__float_as_uint(pmax), __float_as_uint(pmax), false, false);
      pmax = fmaxf(__uint_as_float(rr[0]), __uint_as_float(rr[1])); }
    if (__builtin_expect(__all(pmax - m_reg <= thr), 1)) { mn = m_reg; alpha = 1.f; }
    else { mn = fmaxf(m_reg, pmax); alpha = __builtin_amdgcn_exp2f((m_reg - mn) * C); m_reg = mn; }
    const float mnC = -mn * C;
#pragma unroll
    for (int r = 0; r < 16; ++r) p0[r] = fmaf(p0[r], C, mnC);
#pragma unroll
    for (int r = 0; r < 16; ++r) p1[r] = fmaf(p1[r], C, mnC);
#pragma unroll
    for (int r = 0; r < 16; ++r) p0[r] = __builtin_amdgcn_exp2f(p0[r]);
}
__device__ __forceinline__ void finishSM(f32x16& p0, f32x16& p1, float alpha, float& l_reg, bf16x8& pa0, bf16x8& pa1, bf16x8& pa2, bf16x8& pa3) {
#pragma unroll
    for (int r = 0; r < 16; ++r) p1[r] = __builtin_amdgcn_exp2f(p1[r]);
    float ps = 0;
#pragma unroll
    for (int r = 0; r < 16; ++r) ps += p0[r];
#pragma unroll
    for (int r = 0; r < 16; ++r) ps += p1[r];
    { auto rr = __builtin_amdgcn_permlane32_swap(__float_as_uint(ps), __float_as_uint(ps), false, false);
      ps = __uint_as_float(rr[0]) + __uint_as_float(rr[1]); }
    l_reg = l_reg * alpha + ps;
#define PK4(P, BASE, OUT) do { unsigned a0 = pk2(P[BASE + 0], P[BASE + 1]), a1 = pk2(P[BASE + 2], P[BASE + 3]);   \
    unsigned b0 = pk2(P[BASE + 4], P[BASE + 5]), b1 = pk2(P[BASE + 6], P[BASE + 7]);                              \
    auto r0 = __builtin_amdgcn_permlane32_swap(a0, b0, false, false); auto r1 = __builtin_amdgcn_permlane32_swap(a1, b1, false, false); \
    u32x4 w = {r0[0], r1[0], r0[1], r1[1]}; OUT = *reinterpret_cast<bf16x8*>(&w); } while (0)
    PK4(p0, 0, pa0); PK4(p0, 8, pa1); PK4(p1, 0, pa2); PK4(p1, 8, pa3);
#undef PK4
}
template <int DQK> __device__ __forceinline__ void qkt(f32x16& p0, f32x16& p1, const char* Ks, const bf16x8* qr, int r32, int hi) {
    p0 = f32x16{}; p1 = f32x16{};
#pragma unroll
    for (int d0 = 0; d0 < DQK / 16; ++d0) { const int ch = 2 * d0 + hi;
        const bf16x8 b0 = *reinterpret_cast<const bf16x8*>(Ks + kaddr<DQK>(r32, ch));
        const bf16x8 b1 = *reinterpret_cast<const bf16x8*>(Ks + kaddr<DQK>(32 + r32, ch));
        p0 = __builtin_amdgcn_mfma_f32_32x32x16_bf16(b0, qr[d0], p0, 0, 0, 0);
        p1 = __builtin_amdgcn_mfma_f32_32x32x16_bf16(b1, qr[d0], p1, 0, 0, 0); }
}
__device__ __forceinline__ int v_st(int k, int c) { const int kk = (k & ~0xC) | ((k & 4) << 1) | ((k & 8) >> 1); return ((kk >> 3) * 4 + (c >> 5)) * 512 + ((kk & 7) * 32 + (c & 31)) * 2; }
__device__ __forceinline__ int v_rd_base(int lane) { return ((lane & 3) << 3) | (((lane >> 2) & 3) << 6) | (((lane >> 4) & 1) << 5) | (((lane >> 5) & 1) << 8); }
constexpr int v_rd_off(int d0, int ks, int half) { return d0 * 512 + ks * 4096 + half * 2048; }
template <int OFF> __device__ __forceinline__ s16x4 tr_read(int vb) {
    s16x4 r; asm volatile("ds_read_b64_tr_b16 %0, %1 offset:%2" : "=&v"(r) : "v"(vb), "i"(OFF) : "memory"); return r;
}
template <int D0> __device__ __forceinline__ void pv_one(f32x16& od, int vb, bf16x8 pa0, bf16x8 pa1, bf16x8 pa2, bf16x8 pa3) {
    const s16x4 l0 = tr_read<v_rd_off(D0, 0, 0)>(vb), h0 = tr_read<v_rd_off(D0, 0, 1)>(vb), l1 = tr_read<v_rd_off(D0, 1, 0)>(vb), h1 = tr_read<v_rd_off(D0, 1, 1)>(vb);
    const s16x4 l2 = tr_read<v_rd_off(D0, 2, 0)>(vb), h2 = tr_read<v_rd_off(D0, 2, 1)>(vb), l3 = tr_read<v_rd_off(D0, 3, 0)>(vb), h3 = tr_read<v_rd_off(D0, 3, 1)>(vb);
    asm volatile("s_waitcnt lgkmcnt(0)" ::: "memory"); SBAR();
#define PK(L, H) (bf16x8){L[0], L[1], L[2], L[3], H[0], H[1], H[2], H[3]}
    od = __builtin_amdgcn_mfma_f32_32x32x16_bf16(pa0, PK(l0, h0), od, 0, 0, 0);
    od = __builtin_amdgcn_mfma_f32_32x32x16_bf16(pa1, PK(l1, h1), od, 0, 0, 0);
    od = __builtin_amdgcn_mfma_f32_32x32x16_bf16(pa2, PK(l2, h2), od, 0, 0, 0);
    od = __builtin_amdgcn_mfma_f32_32x32x16_bf16(pa3, PK(l3, h3), od, 0, 0, 0);
#undef PK
}
__device__ __forceinline__ void pv_d0(f32x16* o, int vb, bf16x8 pa0, bf16x8 pa1, bf16x8 pa2, bf16x8 pa3) {
    pv_one<0>(o[0], vb, pa0, pa1, pa2, pa3); pv_one<1>(o[1], vb, pa0, pa1, pa2, pa3); pv_one<2>(o[2], vb, pa0, pa1, pa2, pa3); pv_one<3>(o[3], vb, pa0, pa1, pa2, pa3);
}

template <int DQK, int SDEPTH>
__device__ __forceinline__ void attn_body(const bf16_t* __restrict__ Qb, const bf16_t* __restrict__ Kh, const bf16_t* __restrict__ Vh, bf16_t* __restrict__ Ob, int ldo, int nkeys, float scale, char* lds) {
    constexpr int SHM_V = 64 * 128 * 2, SHM_K = 64 * DQK * 2, NKC = DQK / 8, KPT = NKC / 8;
    int tid = otid();
    const int wid = __builtin_amdgcn_readfirstlane(tid >> 6), lane = tid & 63, r32 = lane & 31, hi = lane >> 5;
    char* V_lds = lds; char* K_lds = lds + 2 * SHM_V;
    float* ws = (float*)(lds + 2 * SHM_V + 2 * SHM_K) + wid * 64; float* li_l = ws; float* al_l = ws + 32;
    const float C = scale * 1.4426950408889634f, thr = 8.0f / scale;
    float m_reg = -1e30f, l_reg = 0; f32x16 o[4] = {}; bf16x8 qr[DQK / 16];
    const bf16_t* Qw = Qb + (long)(wid * 32 + r32) * DQK + hi * 8;
#pragma unroll
    for (int d0 = 0; d0 < DQK / 16; ++d0) qr[d0] = *reinterpret_cast<const bf16x8*>(Qw + d0 * 16);
    const int sr = tid >> 4, sc = (tid & 15) * 8, vst0 = v_st(sr, sc), vst1 = v_st(32 + sr, sc);
    int kgo[KPT], klo[KPT];
#pragma unroll
    for (int i = 0; i < KPT; ++i) { const int q = tid + 512 * i, row = q / NKC, ch = q % NKC; kgo[i] = row * DQK + ch * 8; klo[i] = kaddr<DQK>(row, ch); }
    const int vb0 = (int)(uintptr_t)V_lds + v_rd_base(lane);
    struct { bf16x8 vs0, vs1, ks[KPT]; } sr_[SDEPTH ? SDEPTH : 1];
#define SLOAD(i, k0) do { sr_[i].vs0 = *reinterpret_cast<const bf16x8*>(&Vh[(long)((k0) + sr) * 128 + sc]); sr_[i].vs1 = *reinterpret_cast<const bf16x8*>(&Vh[(long)((k0) + 32 + sr) * 128 + sc]); \
    _Pragma("unroll") for (int _q = 0; _q < KPT; ++_q) sr_[i].ks[_q] = *reinterpret_cast<const bf16x8*>(&Kh[(long)(k0) * DQK + kgo[_q]]); } while (0)
#define SWRITE(b, i) do { *(bf16x8*)(V_lds + (b) * SHM_V + vst0) = sr_[i].vs0; *(bf16x8*)(V_lds + (b) * SHM_V + vst1) = sr_[i].vs1; \
    _Pragma("unroll") for (int _q = 0; _q < KPT; ++_q) *(bf16x8*)(K_lds + (b) * SHM_K + klo[_q]) = sr_[i].ks[_q]; } while (0)
#define SWAIT() do { if constexpr (SDEPTH == 2) { if constexpr (KPT == 2) asm volatile("s_waitcnt vmcnt(4)" ::: "memory"); else asm volatile("s_waitcnt vmcnt(5)" ::: "memory"); } \
    else asm volatile("s_waitcnt vmcnt(0)" ::: "memory"); } while (0)
#define RESC(a) do { if (__any((a) < 1.f)) { if (hi == 0) al_l[r32] = (a); asm volatile("s_waitcnt lgkmcnt(0)" ::: "memory"); \
    _Pragma("unroll") for (int d = 0; d < 4; ++d) _Pragma("unroll") for (int r = 0; r < 16; ++r) o[d][r] *= al_l[crow(r, hi)]; } } while (0)
    bf16x8 pa0, pa1, pa2, pa3; const int NT = nkeys / 64;
    if constexpr (SDEPTH == 0) {
        f32x16 pA0, pA1; float mnA, alA;
        SLOAD(0, 0); asm volatile("s_waitcnt vmcnt(0)" ::: "memory"); SWRITE(0, 0); __syncthreads();
        for (int j = 0; j < NT; ++j) {
            const int bo = j & 1;
            if (j + 1 < NT) SLOAD(0, (j + 1) * 64);
            SBAR(); qkt<DQK>(pA0, pA1, K_lds + bo * SHM_K, qr, r32, hi); partialSM(pA0, pA1, m_reg, mnA, alA, C, thr);
            RESC(alA); finishSM(pA0, pA1, alA, l_reg, pa0, pa1, pa2, pa3); SBAR();
            pv_d0(o, vb0 + bo * SHM_V, pa0, pa1, pa2, pa3);
            if (j + 1 < NT) { asm volatile("s_waitcnt vmcnt(0)" ::: "memory"); SWRITE(bo ^ 1, 0); }
            __syncthreads();
        }
    } else {
    f32x16 pA0, pA1, pB0, pB1; float mnA, mnB, alA, alB;
    constexpr int SE = 0, SO = SDEPTH - 1;
    SLOAD(SE, 0); asm volatile("s_waitcnt vmcnt(0)" ::: "memory"); SWRITE(0, SE); __syncthreads();
    qkt<DQK>(pA0, pA1, K_lds, qr, r32, hi); partialSM(pA0, pA1, m_reg, mnA, alA, C, thr);
    SLOAD(SO, 64); if constexpr (SDEPTH == 2) { if (2 < NT) SLOAD(SE, 2 * 64); }
    SWAIT(); SWRITE(1, SO); __syncthreads();
    for (int j = 1; j + 1 < NT; j += 2) {
        SBAR(); qkt<DQK>(pB0, pB1, K_lds + SHM_K, qr, r32, hi);
        finishSM(pA0, pA1, alA, l_reg, pa0, pa1, pa2, pa3); SBAR();
        SLOAD(SO, (j + SDEPTH) * 64); SBAR();
        pv_d0(o, vb0, pa0, pa1, pa2, pa3); partialSM(pB0, pB1, m_reg, mnB, alB, C, thr);
        __syncthreads(); SWAIT(); SWRITE(0, SE);
        RESC(alB); __syncthreads();
        SBAR(); qkt<DQK>(pA0, pA1, K_lds, qr, r32, hi);
        finishSM(pB0, pB1, alB, l_reg, pa0, pa1, pa2, pa3); SBAR();
        if (SDEPTH == 1 || j + 3 < NT) SLOAD(SE, (j + 1 + SDEPTH) * 64); SBAR();
        pv_d0(o, vb0 + SHM_V, pa0, pa1, pa2, pa3); partialSM(pA0, pA1, m_reg, mnA, alA, C, thr);
        __syncthreads(); SWAIT(); SWRITE(1, SO);
        RESC(alA); __syncthreads();
    }
    SBAR(); qkt<DQK>(pB0, pB1, K_lds + SHM_K, qr, r32, hi);
    finishSM(pA0, pA1, alA, l_reg, pa0, pa1, pa2, pa3); SBAR();
    pv_d0(o, vb0, pa0, pa1, pa2, pa3); partialSM(pB0, pB1, m_reg, mnB, alB, C, thr);
    __syncthreads(); RESC(alB);
    finishSM(pB0, pB1, alB, l_reg, pa0, pa1, pa2, pa3); SBAR();
    pv_d0(o, vb0 + SHM_V, pa0, pa1, pa2, pa3);
    }
    if (hi == 0) li_l[r32] = l_reg; asm volatile("s_waitcnt lgkmcnt(0)" ::: "memory");
    float rli[16];
#pragma unroll
    for (int r = 0; r < 16; ++r) rli[r] = __builtin_amdgcn_rcpf(li_l[crow(r, hi)]);
    bf16_t* Ow = Ob + (long)(wid * 32) * ldo;
#pragma unroll
    for (int r = 0; r < 16; ++r) { const int orow = crow(r, hi);
#pragma unroll
        for (int d0 = 0; d0 < 4; ++d0) {
#if WOUT8
            ((unsigned char*)Ob)[(long)(wid * 32 + orow) * ldo + d0 * 32 + r32] = (unsigned char)(pk4_fp8(o[d0][r] * rli[r] * MIX8_SCALE, 0.f, 0.f, 0.f) & 0xffu);
#else
            Ow[(long)orow * ldo + d0 * 32 + r32] = f2bf(o[d0][r] * rli[r]);
#endif
        } }
    __syncthreads();
#undef SLOAD
#undef SWRITE
#undef SWAIT
#undef RESC
}

struct CvtMat { const float* src; bf16_t* dst; const float* kscale; int N, lddst, nb, mode; };
__device__ __forceinline__ void cvt_block(const CvtMat& m, int kb, int nbk, int lane) {
    const int a = lane & 7, ng = lane >> 3, k0 = kb * 64 + 8 * a, n0 = nbk * 32 + 4 * ng;
    const float* s = m.src + (size_t)k0 * m.N + n0;
    f32x4 v[8];
#pragma unroll
    for (int j = 0; j < 8; ++j) v[j] = *(const f32x4*)(s + (size_t)j * m.N);
    if (m.kscale) {
#pragma unroll
        for (int j = 0; j < 8; ++j) v[j] *= m.kscale[k0 + j];
    }
#pragma unroll
    for (int i = 0; i < 4; ++i) { const int n = n0 + i, row = (m.mode == 0) ? n : ((n >> 7) * 256 + (n & 127) + (m.mode - 1) * 128);
        u32x4 w; w.x = pk2(v[0][i], v[1][i]); w.y = pk2(v[2][i], v[3][i]); w.z = pk2(v[4][i], v[5][i]); w.w = pk2(v[6][i], v[7][i]);
        *(u32x4*)(m.dst + (size_t)row * m.lddst + k0) = w; }
}
__device__ __forceinline__ void cvt_block8(const CvtMat& m, unsigned char* dst8, int kb, int nbk, int lane) {
    const int a = lane & 7, ng = lane >> 3, k0 = kb * 64 + 8 * a, n0 = nbk * 32 + 4 * ng;
    const float* s = m.src + (size_t)k0 * m.N + n0;
    f32x4 v[8];
#pragma unroll
    for (int j = 0; j < 8; ++j) v[j] = *(const f32x4*)(s + (size_t)j * m.N) * W8_SCALE;
#pragma unroll
    for (int i = 0; i < 4; ++i) { const int n = n0 + i, row = (m.mode == 0) ? n : ((n >> 7) * 256 + (n & 127) + (m.mode - 1) * 128);
        u32x2 w; w.x = pk4_fp8(v[0][i], v[1][i], v[2][i], v[3][i]); w.y = pk4_fp8(v[4][i], v[5][i], v[6][i], v[7][i]);
        *(u32x2*)(dst8 + (size_t)row * m.lddst + k0) = w; }
}
constexpr int CVT_SMALL = 3904 + 2048 + 432 + 192;
__device__ __forceinline__ void cvt_small_task(const Params& p, int l, int t, int lane) {
    unsigned char* ws = p.ws; CvtMat m; int which_ = 3;
    if (t < 3904) { which_ = 0; m = CvtMat{p.in[I_WIN] + (size_t)l * DM * IN_COLS, (bf16_t*)(ws + O_WIN) + (size_t)l * NP * DM, nullptr, IN_COLS, DM, 122, 0}; }
    else if ((t -= 3904) < 2048) { which_ = 1; m = CvtMat{p.in[I_WOUT] + (size_t)l * DM * DM, (bf16_t*)(ws + O_WOUT) + (size_t)l * DM * DM, nullptr, DM, DM, 64, 0}; }
    else if ((t -= 2048) < 432) { m = CvtMat{p.in[I_WUQ] + (size_t)l * 768 * 1152, (bf16_t*)(ws + O_WUQ) + (size_t)l * NQP * 768, p.in[I_MQN] + l * 768, 1152, 768, 36, 0}; }
    else { t -= 432; m = CvtMat{p.in[I_WUKV] + (size_t)l * 256 * 1536, (bf16_t*)(ws + O_WUKV) + (size_t)l * 1536 * 256, p.in[I_MKVN] + l * 256, 1536, 256, 48, 0}; }
    if (WIN8 && which_ == 0) cvt_block8(m, p.ws + O_WIN + (size_t)l * NP * DM, t / m.nb, t % m.nb, lane);
    else if (WOUT8 && which_ == 1) cvt_block8(m, p.ws + O_WOUT + (size_t)l * DM * DM, t / m.nb, t % m.nb, lane);
    else cvt_block(m, t / m.nb, t % m.nb, lane);
}
constexpr int CVT_EXP = 65 * 1536;
__device__ __forceinline__ void cvt_exp_task(const Params& p, int l, int t, int lane) {
    unsigned char* ws = p.ws;
    const int e = t / 1536, r = t % 1536, which = r >> 9, q = r & 511; CvtMat m;
    if (which < 2) {
        const float* src = (e < NEXP) ? p.in[which == 0 ? I_EG : I_EU] + ((size_t)l * NEXP + e) * DM * EH : p.in[which == 0 ? I_SG : I_SU] + (size_t)l * DM * EH;
        m = CvtMat{src, (bf16_t*)(ws + O_EGU) + (size_t)e * 1024 * 2048, nullptr, EH, DM, 16, 1 + which};
    } else {
        const float* src = (e < NEXP) ? p.in[I_EDN] + ((size_t)l * NEXP + e) * EH * DM : p.in[I_SD] + (size_t)l * EH * DM;
        m = CvtMat{src, (bf16_t*)(ws + O_ED) + (size_t)e * 2048 * 512, nullptr, DM, EH, 64, 0};
    }
#if MOE_FP8
    cvt_block8(m, which < 2 ? p.ws + O_EGU + (size_t)e * 1024 * 2048 : p.ws + O_ED + (size_t)e * 2048 * 512, q / m.nb, q % m.nb, lane);
#else
    cvt_block(m, q / m.nb, q % m.nb, lane);
#endif
}
__device__ __forceinline__ void cvt_exp_all(const Params& p, int l) {
    const int lane = otid() & 63, gw = blockIdx.x * 8 + owid(), GW = gridDim.x * 8;
    for (int t = gw; t < CVT_EXP; t += GW) cvt_exp_task(p, l, t, lane);
}
__device__ __forceinline__ void adaln_tasks(const Params& p, LAS float* lf) {
    const int lane = otid() & 63, wid = owid();
    float* MOD = (float*)(p.ws + O_MOD);
    for (int task = blockIdx.x; task < 384; task += gridDim.x) {
        const int cb = task % 192, l = task / 192, col = cb * 64 + lane;
        const float* W = p.in[I_ADAW] + (size_t)l * DM * 12288 + col;
        float acc[9];
#pragma unroll
        for (int r = 0; r < 9; ++r) acc[r] = 0.f;
        for (int kb = wid * 256; kb < wid * 256 + 256; kb += 64) {
            float sv[9];
#pragma unroll
            for (int r = 0; r < 8; ++r) sv[r] = silu_f(p.in[I_C][r * DM + kb + lane]);
            sv[8] = silu_f(p.in[I_CCTX][kb + lane]);
#pragma unroll 8
            for (int kk = 0; kk < 64; ++kk) { const float w = W[(size_t)(kb + kk) * 12288];
#pragma unroll
                for (int r = 0; r < 9; ++r) acc[r] += rdlane(sv[r], kk) * w; }
        }
#pragma unroll
        for (int r = 0; r < 9; ++r) lf[(wid * 9 + r) * 64 + lane] = acc[r];
        __syncthreads();
        for (int r = wid; r < 9; r += 8) { float s = p.in[I_ADAB][l * 12288 + col];
#pragma unroll
            for (int w = 0; w < 8; ++w) s += lf[(w * 9 + r) * 64 + lane];
            MOD[(size_t)(l * 9 + r) * 12288 + col] = s; }
        __syncthreads();
    }
}
__device__ __forceinline__ void hss_tasks(const Params& p) {
    const int lane = otid() & 63, gw = blockIdx.x * 8 + owid(), GW = gridDim.x * 8;
    for (int task = gw; task < 3 * 1024; task += GW) {
        const int set = task >> 10, l = (set == 1) ? 1 : 0, nset = (set == 2) ? 1 : 0, ord = (task >> 9) & 1, ch = task & 511, n = nset ? 256 : 2048;
        const float* HF = (const float*)(p.ws + O_HF) + (size_t)l * HF_LAYER + (nset ? HF_L0 : 0);
        const float* hf = HF + (size_t)((ord * 2 + 0) * 512 + ch) * n; const float* hb = HF + (size_t)((ord * 2 + 1) * 512 + ch) * n;
        float s = 0.f;
        for (int i = lane; i < n; i += 64) { const float a = hf[i], b = (i == 0) ? 0.f : hb[i]; s += a * a + b * b; }
        s = wave_sum(s);
        if (lane == 0) ((float*)(p.ws + O_HSS))[(size_t)((l * 2 + nset) * 2 + ord) * 512 + ch] = s;
    }
}
__device__ __forceinline__ void hyf_task(const Params& p, int l, int nset, int i0, LAS float* lf) {
    int tid = otid(); const int n = nset ? 256 : 2048;
    LAS float* feats = lf; LAS float* hd1 = lf + 8 * 33; LAS float* hd2 = hd1 + 512;
    if (tid < 8 * 33) { const int pos = tid / 33, f = tid % 33, i = i0 + pos; const float t = (float)i / (float)(n - 1), ang = 6.283185307179586f * (float)i / (float)n; float v;
        if (f == 0) v = t; else { const int j = (f - 1) & 15; const float band = 1e-4f + (float)j * ((15.0f - 1e-4f) / 15.0f); v = (f <= 16) ? cosf(ang * band) : sinf(ang * band); }
        feats[tid] = v; }
    __syncthreads();
    { const int pos = tid >> 6, j = tid & 63; const float* w1 = p.in[I_HYW1] + l * 33 * 64; float s = p.in[I_HYB1][l * 64 + j];
      for (int f = 0; f < 33; ++f) s += feats[pos * 33 + f] * w1[f * 64 + j];
      hd1[tid] = sinf(p.in[I_HYFREQ][l * 64 + j] * s); }
    __syncthreads();
    { const int pos = tid >> 6, j = tid & 63; const float* w2 = p.in[I_HYW2] + l * 64 * 64; float s = p.in[I_HYB2][l * 64 + j];
      for (int f = 0; f < 64; ++f) s += hd1[pos * 64 + f] * w2[f * 64 + j];
      hd2[tid] = sinf(p.in[I_HYFREQ][l * 64 + j] * s); }
    __syncthreads();
    const float* w3 = p.in[I_HYW3] + (size_t)l * 64 * 2048 + tid * 4;
    f32x4 acc[8];
#pragma unroll
    for (int q = 0; q < 8; ++q) acc[q] = (f32x4){0.f, 0.f, 0.f, 0.f};
    for (int j = 0; j < 64; ++j) { const f32x4 w = *(const f32x4*)(w3 + (size_t)j * 2048);
#pragma unroll
        for (int q = 0; q < 8; ++q) acc[q] += w * hd2[q * 64 + j]; }
    float* HF = (float*)(p.ws + O_HF) + (size_t)l * HF_LAYER + (nset ? HF_L0 : 0);
#pragma unroll
    for (int c = 0; c < 4; ++c) { const int col = tid * 4 + c, ord = col >> 10, dir = (col >> 9) & 1, ch = col & 511;
        const float delta = 3.0701134573253944f + (float)ch * ((15.350567286626973f - 3.0701134573253944f) / 511.0f); float v[8];
#pragma unroll
        for (int q = 0; q < 8; ++q) { const int i = i0 + q; const float t = (float)i / (float)(n - 1); v[q] = acc[q][c] * __expf(-t * delta); }
        float* dst = HF + (size_t)((ord * 2 + dir) * 512 + ch) * n + i0;
        *(f32x4*)dst = (f32x4){v[0], v[1], v[2], v[3]}; *(f32x4*)(dst + 4) = (f32x4){v[4], v[5], v[6], v[7]};    }
    __syncthreads();
}
__device__ __forceinline__ void rope_tables(const Params& p);
__device__ __forceinline__ void phase_prologue(const Params& p, LAS unsigned char* lds) {
    const int tid = otid(); LAS float* lf = (LAS float*)lds;
    { const size_t gt = (size_t)blockIdx.x * NTHREADS + tid, GT = (size_t)gridDim.x * NTHREADS;
      for (int l = 0; l < NLAYER; ++l) {
          u32x4* z1 = WIN8 ? (u32x4*)(p.ws + O_WIN + ((size_t)l * NP + IN_COLS) * DM) : (u32x4*)((bf16_t*)(p.ws + O_WIN) + ((size_t)l * NP + IN_COLS) * DM); const size_t n1 = (size_t)(NP - IN_COLS) * DM * (WIN8 ? 1 : 2) / 16;
          for (size_t i = gt; i < n1; i += GT) z1[i] = (u32x4){0u, 0u, 0u, 0u};
          u32x4* z2 = (u32x4*)((bf16_t*)(p.ws + O_WUQ) + ((size_t)l * NQP + 1152) * 768); const size_t n2 = (size_t)(NQP - 1152) * 768 * 2 / 16;
          for (size_t i = gt; i < n2; i += GT) z2[i] = (u32x4){0u, 0u, 0u, 0u};
      } }
    rope_tables(p);
    adaln_tasks(p, lf);
    for (int t = blockIdx.x; t < 544; t += gridDim.x) { if (t < 512) hyf_task(p, t >> 8, 0, (t & 255) * 8, lf); else hyf_task(p, 0, 1, (t - 512) * 8, lf); }
    { const int lane = tid & 63, gw = blockIdx.x * 8 + owid(), GW = gridDim.x * 8;
      for (int t = gw; t < NLAYER * CVT_SMALL; t += GW) cvt_small_task(p, t / CVT_SMALL, t % CVT_SMALL, lane); }
    cvt_exp_all(p, 0);
}

__device__ __forceinline__ void norm1_row(const Params& p, int l, int row, const float (&x)[32], int lane) {
    float ss = 0.f;
#pragma unroll
    for (int i = 0; i < 32; ++i) ss += x[i] * x[i];
    ss = wave_sum(ss); const float rstd = rsqrtf(ss * (1.0f / DM) + EPS);
    const float* g = p.in[I_NORMG] + (size_t)(l * 4 + 0) * DM; const float* mod = (const float*)(p.ws + O_MOD) + (size_t)(l * 9 + row_batch(row)) * 12288;
    bf16_t* H = (bf16_t*)(p.ws + O_H) + (size_t)row * DM;
#pragma unroll
    for (int j = 0; j < 8; ++j) { const int c = ROWCOL(j, lane); const f32x4 gv = *(const f32x4*)(g + c), sh = *(const f32x4*)(mod + c), sc = *(const f32x4*)(mod + DM + c); float h[4];
#pragma unroll
        for (int q = 0; q < 4; ++q) h[q] = x[j * 4 + q] * rstd * gv[q] * (1.0f + sc[q]) + sh[q];
#if WIN8
        *(unsigned*)((unsigned char*)(p.ws + O_H) + (size_t)row * DM + c) = pk4_fp8(h[0], h[1], h[2], h[3]);
#else
        u32x2 w; w.x = pk2(h[0], h[1]); w.y = pk2(h[2], h[3]); *(u32x2*)(H + c) = w;
#endif
    }
}
__device__ __forceinline__ void phase_norm1(const Params& p, int l) {
    const int lane = otid() & 63, gw = blockIdx.x * 8 + owid(), GW = gridDim.x * 8;
    const int lane0 = lane;
    for (int row = gw; row < NTOK; row += GW) { int lane = lane0; asm volatile("" : "+v"(lane)); const float* src = resid_src(p, l, row); float x[32];
#pragma unroll
        for (int j = 0; j < 8; ++j) { const f32x4 v = *(const f32x4*)(src + ROWCOL(j, lane)); x[j * 4] = v[0]; x[j * 4 + 1] = v[1]; x[j * 4 + 2] = v[2]; x[j * 4 + 3] = v[3]; }
        norm1_row(p, l, row, x, lane); }
}

__device__ __forceinline__ void rope_tables(const Params& p) {
    float* T = (float*)(p.ws + O_ROPE);
    for (int i = blockIdx.x * NTHREADS + otid(); i < 64 * 32 + 64 * 16; i += gridDim.x * NTHREADS) {
        float a; if (i < 64 * 32) a = (float)(i >> 5) * exp2f(-(float)(i & 31) * (13.287712379549449f / 32.0f)); else { const int q = i - 64 * 32; a = (float)(q >> 4) * exp2f(-(float)(q & 15) * (13.287712379549449f / 16.0f)); }
        float sn, cs; sincosf(a, &sn, &cs); T[2 * i] = cs; T[2 * i + 1] = sn; }
}
__device__ __forceinline__ void unpack8(const u32x4 v, float (&x)[8]) {
#pragma unroll
    for (int j = 0; j < 4; ++j) { x[2 * j] = __uint_as_float(v[j] << 16); x[2 * j + 1] = __uint_as_float(v[j] & 0xffff0000u); }
}
__device__ __forceinline__ u32x4 pack8(const float (&x)[8]) { u32x4 w; w.x = pk2(x[0], x[1]); w.y = pk2(x[2], x[3]); w.z = pk2(x[4], x[5]); w.w = pk2(x[6], x[7]); return w; }
template <int PX> __device__ __forceinline__ void rope8(float (&x)[8], const float* cs, bool second) {
#pragma unroll
    for (int j = 0; j < 8; ++j) { const float pr = __shfl_xor(x[j], PX), c = cs[2 * j], sn = cs[2 * j + 1]; x[j] = second ? pr * sn + x[j] * c : x[j] * c - pr * sn; }
}
__device__ __forceinline__ void gqa_post_row(const Params& p, int l, int row, int lane) {
    const bf16_t* P = (const bf16_t*)(p.ws + O_P) + (size_t)row * NP;
    const bool isctx = row >= NLAT; const int b = isctx ? (row - NLAT) >> 8 : row >> 11, t = isctx ? (row - NLAT) & 255 : row & 2047;
    const int j = lane & 15, hq = lane >> 4, half = j >> 3; const bool second = (j >> 2) & 1;
    const float* cs = (const float*)(p.ws + O_ROPE) + ((size_t)(half ? (t & 63) : (t >> 6)) * 32 + 8 * (j & 3)) * 2;
    const int kpos = isctx ? t : CTXL + t;
#pragma unroll
    for (int ps = 0; ps < 2; ++ps) {
        const bool isk = (ps == 1) && (hq >= 2); const int h = (ps == 0) ? hq : (isk ? hq - 2 : 4 + hq);
        const bf16_t* src = P + (isk ? C_GK : C_GQ) + h * 128 + 8 * j; const float* gn = (isk ? p.in[I_GKN] : p.in[I_GQN]) + l * 128 + 8 * j;
        float x[8]; unpack8(*(const u32x4*)src, x);
        float ss = 0.f;
#pragma unroll
        for (int q = 0; q < 8; ++q) ss += x[q] * x[q];
        ss += __shfl_xor(ss, 1); ss += __shfl_xor(ss, 2); ss += __shfl_xor(ss, 4); ss += __shfl_xor(ss, 8);
        const float rstd = rsqrtf(ss * (1.0f / 128.0f) + EPS); const f32x4 g0 = *(const f32x4*)gn, g1 = *(const f32x4*)(gn + 4);
#pragma unroll
        for (int q = 0; q < 4; ++q) { x[q] *= rstd * g0[q]; x[4 + q] *= rstd * g1[q]; }
        if (!isctx) rope8<4>(x, cs, second);
        bf16_t* dst = isk ? (bf16_t*)(p.ws + O_KG) + ((size_t)(b * 2 + h) * LK + kpos) * 128
                          : (isctx ? (bf16_t*)(p.ws + O_QGC) + ((size_t)(b * 6 + h) * CTXL + t) * 128 : (bf16_t*)(p.ws + O_QG) + ((size_t)(b * 6 + h) * SEQ + t) * 128);
        *(u32x4*)(dst + 8 * j) = pack8(x);
    }
    if (lane < 32) { const int h = lane >> 4; *(u32x4*)((bf16_t*)(p.ws + O_VG) + ((size_t)(b * 2 + h) * LK + kpos) * 128 + 8 * j) = *(const u32x4*)(P + C_GV + h * 128 + 8 * j); }
}
__device__ __forceinline__ void seq_of(int row, int& s0, int& n) { if (row < NLAT) { s0 = row & ~2047; n = SEQ; } else { s0 = NLAT + ((row - NLAT) & ~255); n = CTXL; } }
__device__ __forceinline__ void load_conv_tile(const bf16_t* P, int t0, int pc0, LAS float* u) {
    int s0, n; seq_of(t0, s0, n);
    for (int i = otid(); i < 66 * 8; i += NTHREADS) { const int r = i >> 3, c = (i & 7) * 8, row = t0 - 1 + r;
        float x[8];
        if (row >= s0 && row < s0 + n) { const u32x4 v = *(const u32x4*)(P + (size_t)row * NP + pc0 + c);
#pragma unroll
            for (int j = 0; j < 4; ++j) { x[2 * j] = __uint_as_float(v[j] << 16); x[2 * j + 1] = __uint_as_float(v[j] & 0xffff0000u); } }
        else {
#pragma unroll
            for (int j = 0; j < 8; ++j) x[j] = 0.f; }
#pragma unroll
        for (int j = 0; j < 8; ++j) u[r * 65 + c + j] = x[j]; }
}
__device__ __forceinline__ void hy_prep_task(const Params& p, int l, int t0, int c0, LAS float* u) {
    const bf16_t* P = (const bf16_t*)(p.ws + O_P);
#pragma unroll
    for (int q = 0; q < 4; ++q) load_conv_tile(P, t0, c0 + 64 * q, u + q * (66 * 65));
    __syncthreads();
    const int tid = otid(), c = tid >> 3, tc = (tid & 7) * 8;
#pragma unroll
    for (int q = 0; q < 4; ++q) { const LAS float* uq = u + q * (66 * 65); const int ch = c0 + 64 * q + c; const float* cw = p.in[I_HYCONV] + (size_t)l * 3 * 1536 + ch;
        const float w0 = cw[0], w1 = cw[1536], w2 = cw[3072]; float y[8];
#pragma unroll
        for (int j = 0; j < 8; ++j) y[j] = w0 * uq[(tc + j) * 65 + c] + w1 * uq[(tc + j + 1) * 65 + c] + w2 * uq[(tc + j + 2) * 65 + c];
        bf16_t* dst = (ch < 512 ? (bf16_t*)(p.ws + O_VT) + (size_t)ch * NTOK : (bf16_t*)(p.ws + O_X1T) + (size_t)(ch - 512) * NTOK) + t0 + tc;
        u32x4 w; w.x = pk2(y[0], y[1]); w.y = pk2(y[2], y[3]); w.z = pk2(y[4], y[5]); w.w = pk2(y[6], y[7]); *(u32x4*)dst = w; }
    __syncthreads();
}
__device__ __forceinline__ void mla_post_row(const Params& p, int l, int row, int lane) {
    const bf16_t* P = (const bf16_t*)(p.ws + O_P) + (size_t)row * NP;
    const bool isctx = row >= NLAT; const int b = isctx ? (row - NLAT) >> 8 : row >> 11, t = isctx ? (row - NLAT) & 255 : row & 2047;
    float sq = 0.f, skv = 0.f; float x[8];
    unpack8(*(const u32x4*)(P + C_CQ + 8 * lane), x);
#pragma unroll
    for (int q = 0; q < 8; ++q) sq += x[q] * x[q];
    if (lane < 32) { unpack8(*(const u32x4*)(P + C_CQ + 512 + 8 * lane), x);
#pragma unroll
        for (int q = 0; q < 8; ++q) sq += x[q] * x[q];
        unpack8(*(const u32x4*)(P + C_CKV + 8 * lane), x);
#pragma unroll
        for (int q = 0; q < 8; ++q) skv += x[q] * x[q]; }
    const float rq = rsqrtf(wave_sum(sq) * (1.0f / 768.0f) + EPS), rkv = rsqrtf(wave_sum(skv) * (1.0f / 256.0f) + EPS);
    const bf16_t* QR = (const bf16_t*)(p.ws + O_QRAW) + (size_t)row * NQP; const bf16_t* KV = (const bf16_t*)(p.ws + O_KVRAW) + (size_t)row * 1536;
    const int kpos = isctx ? t : CTXL + t;
    const float* RM = (const float*)(p.ws + O_ROPE) + 64 * 32 * 2;
#pragma unroll
    for (int ps = 0; ps < 3; ++ps) { const int id = ps * 64 + lane; const bool act = id < 144; const int h = act ? id / 24 : 0, cj = act ? id % 24 : 0, rc = cj - 16;
        unpack8(*(const u32x4*)(QR + h * 192 + 8 * cj), x);
#pragma unroll
        for (int q = 0; q < 8; ++q) x[q] *= rq;
        if (!isctx) { const int rcc = rc < 0 ? 0 : rc; const float* cs = RM + ((size_t)((rcc >> 2) ? (t & 63) : (t >> 6)) * 16 + 8 * (rcc & 1)) * 2; float y[8];
#pragma unroll
            for (int q = 0; q < 8; ++q) y[q] = x[q];
            rope8<2>(y, cs, (rcc >> 1) & 1);
            if (rc >= 0) {
#pragma unroll
                for (int q = 0; q < 8; ++q) x[q] = y[q]; } }
        bf16_t* qd = isctx ? (bf16_t*)(p.ws + O_QMC) + ((size_t)(b * 6 + h) * CTXL + t) * 192 : (bf16_t*)(p.ws + O_QM) + ((size_t)(b * 6 + h) * SEQ + t) * 192;
        if (act) *(u32x4*)(qd + 8 * cj) = pack8(x); }
#pragma unroll
    for (int ps = 0; ps < 3; ++ps) { const int id = ps * 64 + lane, h = id >> 5, c = id & 31;
        unpack8(*(const u32x4*)(KV + h * 256 + 8 * c), x);
#pragma unroll
        for (int q = 0; q < 8; ++q) x[q] *= rkv;
        bf16_t* d = (c < 16) ? (bf16_t*)(p.ws + O_KM) + ((size_t)(b * 6 + h) * LK + kpos) * 192 + 8 * c : (bf16_t*)(p.ws + O_VM) + ((size_t)(b * 6 + h) * LK + kpos) * 128 + 8 * (c - 16);
        *(u32x4*)d = pack8(x); }
    { const int h = lane >> 3, rc = lane & 7; unpack8(*(const u32x4*)(P + C_KR + 8 * rc), x);
      if (!isctx) { const float* cs = RM + ((size_t)((rc >> 2) ? (t & 63) : (t >> 6)) * 16 + 8 * (rc & 1)) * 2; rope8<2>(x, cs, (rc >> 1) & 1); }
      if (lane < 48) *(u32x4*)((bf16_t*)(p.ws + O_KM) + ((size_t)(b * 6 + h) * LK + kpos) * 192 + 128 + 8 * rc) = pack8(x); }
}

__device__ __forceinline__ void hyconv_unit_valu(const Params& p, int l, int nset, int c, LAS float* lf) {
    const int tid = otid(), n = nset ? CTXL : SEQ, tokbase = nset ? NLAT : 0;
    LAS float* kc = lf; LAS float* z = lf + 4096; LAS float* z2 = z + 8 * SEQ;
    const float* HF = (const float*)(p.ws + O_HF) + (size_t)l * HF_LAYER + (nset ? HF_L0 : 0); const float* HSS = (const float*)(p.ws + O_HSS) + (size_t)((l * 2 + nset) * 2) * 512;
    const bf16_t* VT = (const bf16_t*)(p.ws + O_VT) + (size_t)c * NTOK + tokbase; const bf16_t* X1T = (const bf16_t*)(p.ws + O_X1T) + (size_t)c * NTOK + tokbase;
    bf16_t* Y2T = (bf16_t*)(p.ws + O_Y2T) + (size_t)c * NTOK + tokbase;
    for (int i = tid; i < 8 * n; i += NTHREADS) z[i] = bf2f(VT[i]);
    for (int ord = 0; ord < 2; ++ord) {
        const float rs = rsqrtf(HSS[ord * 512 + c] + EPS); const float* hf = HF + (size_t)((ord * 2 + 0) * 512 + c) * n; const float* hb = HF + (size_t)((ord * 2 + 1) * 512 + c) * n;
        for (int m = tid; m < 2 * n; m += NTHREADS) { const int lag = m - (n - 1); kc[m] = (m == 2 * n - 1) ? 0.f : (lag >= 0 ? hf[lag] : hb[-lag]) * rs; }
        __syncthreads();
        const LAS float* zs = ord ? z2 : z; const float skip = p.in[I_HYSKIP][(size_t)(l * 2 + ord) * 512 + c];
        for (int q = tid; q < n; q += NTHREADS) {
            const int b = q / (n >> 3), t0 = (q % (n >> 3)) * 8; float acc[8];
#pragma unroll
            for (int j = 0; j < 8; ++j) acc[j] = 0.f;
            const LAS float* zb = zs + b * n;
            for (int sb = 0; sb < n; sb += 8) {
                const LAS float* kb = kc + (t0 - sb + n - 8); float w[16];
#pragma unroll
                for (int i = 0; i < 4; ++i) { const f32x4 v = *(const LAS f32x4*)(kb + 4 * i); w[4 * i] = v[0]; w[4 * i + 1] = v[1]; w[4 * i + 2] = v[2]; w[4 * i + 3] = v[3]; }
                const f32x4 za = *(const LAS f32x4*)(zb + sb), zc = *(const LAS f32x4*)(zb + sb + 4); const float zv[8] = {za[0], za[1], za[2], za[3], zc[0], zc[1], zc[2], zc[3]};
#pragma unroll
                for (int ss = 0; ss < 8; ++ss)
#pragma unroll
                    for (int j = 0; j < 8; ++j) acc[j] += w[j - ss + 7] * zv[ss];
            }
            if (ord == 0) {
#pragma unroll
                for (int j = 0; j < 8; ++j) { const int idx = b * n + t0 + j; z2[idx] = bf2f(X1T[idx]) * (acc[j] + skip * z[idx]); }
            } else { float y[8];
#pragma unroll
                for (int j = 0; j < 8; ++j) y[j] = acc[j] + skip * z2[b * n + t0 + j];
                u32x4 w; w.x = pk2(y[0], y[1]); w.y = pk2(y[2], y[3]); w.z = pk2(y[4], y[5]); w.w = pk2(y[6], y[7]); *(u32x4*)(Y2T + b * n + t0) = w; }
        }
        __syncthreads();
    }
}
constexpr int HC_COPYB = 8256, HC_ROWB = 4560, HC_PAD = 112, HC_KR = 4112, HC_M0 = 2064;
constexpr int HC_ZOFF = 8 * HC_COPYB, HC_Z2OFF = HC_ZOFF + 8 * HC_ROWB;
__device__ __forceinline__ void hyconv_unit_mfma(const Params& p, int l, int c, LAS unsigned char* lds) {
    const int tid = otid(), wid = __builtin_amdgcn_readfirstlane(tid >> 6), lane = tid & 63;
    LAS unsigned char* CP = lds; LAS unsigned char* Zr = lds + HC_ZOFF; LAS unsigned char* Z2r = lds + HC_Z2OFF;
    const float* HF = (const float*)(p.ws + O_HF) + (size_t)l * HF_LAYER; const float* HSS = (const float*)(p.ws + O_HSS) + (size_t)(l * 4) * 512;
    const bf16_t* VT = (const bf16_t*)(p.ws + O_VT) + (size_t)c * NTOK; const bf16_t* X1T = (const bf16_t*)(p.ws + O_X1T) + (size_t)c * NTOK; bf16_t* Y2T = (bf16_t*)(p.ws + O_Y2T) + (size_t)c * NTOK;
    for (int q = tid; q < 8 * 256; q += NTHREADS) { const int b = q >> 8, ch = q & 255; *(LAS u32x4*)(Zr + b * HC_ROWB + (HC_PAD + ch * 8) * 2) = *(const u32x4*)(VT + b * SEQ + ch * 8); }
    for (int q = tid; q < 8 * 29; q += NTHREADS) { const int b = q / 29, ch = q % 29; const int e0 = ch < 14 ? ch * 8 : HC_PAD + SEQ + (ch - 14) * 8; *(LAS u32x4*)(Zr + b * HC_ROWB + e0 * 2) = (u32x4){0u, 0u, 0u, 0u}; }
    const int a = lane & 31, kg = lane >> 5, bq = a >> 2, isub = a & 3;
    const int Aoff = (a & 7) * HC_COPYB + (HC_M0 - 8 * (a >> 3) + 8 * kg) * 2;
    const int g0 = 2 * wid;
    const int Boff = bq * HC_ROWB + (HC_PAD + 128 * g0 + 32 * isub + 8 * kg) * 2;
    for (int ord = 0; ord < 2; ++ord) {
        LAS float* kr = (LAS float*)(ord == 0 ? Z2r : Zr);
        { const float rs = rsqrtf(HSS[ord * 512 + c] + EPS); const float* hf = HF + (size_t)((ord * 2 + 0) * 512 + c) * SEQ; const float* hb = HF + (size_t)((ord * 2 + 1) * 512 + c) * SEQ;
          for (int m = tid; m < HC_KR; m += NTHREADS) { const int lag = HC_M0 - m; float v = 0.f; if (lag >= 0 && lag < SEQ) v = hf[lag] * rs; else if (lag < 0 && lag > -SEQ) v = hb[-lag] * rs; kr[m] = v; } }
        __syncthreads();
        for (int q = tid; q < 8 * 516; q += NTHREADS) { const int sft = q / 516, ch = q % 516; float v[8];
#pragma unroll
            for (int j = 0; j < 8; ++j) { const int m = ch * 8 + j - sft; v[j] = (m >= 0 && m < HC_KR) ? kr[m] : 0.f; }
            u32x4 w; w.x = pk2(v[0], v[1]); w.y = pk2(v[2], v[3]); w.z = pk2(v[4], v[5]); w.w = pk2(v[6], v[7]); *(LAS u32x4*)(CP + sft * HC_COPYB + ch * 16) = w; }
        __syncthreads();
        if (ord == 0) for (int q = tid; q < 8 * 29; q += NTHREADS) { const int b = q / 29, ch = q % 29; const int e0 = ch < 14 ? ch * 8 : HC_PAD + SEQ + (ch - 14) * 8; *(LAS u32x4*)(Z2r + b * HC_ROWB + e0 * 2) = (u32x4){0u, 0u, 0u, 0u}; }
        const LAS unsigned char* Zs = ord ? Z2r : Zr;
        f32x16 acc0 = {}, acc1 = {};
        const int e_lo = 16 * wid - 127, e_mid0 = 16 * wid - 119, e_mid1 = 16 * wid + 7, e_hi = 16 * wid + 15;
        for (int e = e_lo; e < e_mid0; ++e) { const bf16x8 A = *(const LAS bf16x8*)(CP + Aoff - 32 * e); const bf16x8 B0 = *(const LAS bf16x8*)(Zs + Boff - 32 * e);
            acc0 = __builtin_amdgcn_mfma_f32_32x32x16_bf16(A, B0, acc0, 0, 0, 0); }
#pragma unroll 2
        for (int e = e_mid0; e <= e_mid1; ++e) { const bf16x8 A = *(const LAS bf16x8*)(CP + Aoff - 32 * e); const bf16x8 B0 = *(const LAS bf16x8*)(Zs + Boff - 32 * e); const bf16x8 B1 = *(const LAS bf16x8*)(Zs + Boff + 256 - 32 * e);
            acc0 = __builtin_amdgcn_mfma_f32_32x32x16_bf16(A, B0, acc0, 0, 0, 0); acc1 = __builtin_amdgcn_mfma_f32_32x32x16_bf16(A, B1, acc1, 0, 0, 0); }
        for (int e = e_mid1 + 1; e <= e_hi; ++e) { const bf16x8 A = *(const LAS bf16x8*)(CP + Aoff - 32 * e); const bf16x8 B1 = *(const LAS bf16x8*)(Zs + Boff + 256 - 32 * e);
            acc1 = __builtin_amdgcn_mfma_f32_32x32x16_bf16(A, B1, acc1, 0, 0, 0); }
        const float skip = p.in[I_HYSKIP][(size_t)(l * 2 + ord) * 512 + c];
#pragma unroll
        for (int gi = 0; gi < 2; ++gi) {
#pragma unroll
            for (int q = 0; q < 4; ++q) { const int t = 128 * (g0 + gi) + 32 * isub + 8 * q + 4 * kg; float y[4];
#pragma unroll
                for (int j = 0; j < 4; ++j) y[j] = gi ? acc1[4 * q + j] : acc0[4 * q + j];
                const u32x2 zz = *(const LAS u32x2*)(Zs + bq * HC_ROWB + (HC_PAD + t) * 2);
                const float z0 = __uint_as_float(zz.x << 16), z1 = __uint_as_float(zz.x & 0xffff0000u), z2 = __uint_as_float(zz.y << 16), z3 = __uint_as_float(zz.y & 0xffff0000u);
                y[0] += skip * z0; y[1] += skip * z1; y[2] += skip * z2; y[3] += skip * z3;
                if (ord == 0) { const u32x2 xx = *(const u32x2*)(X1T + bq * SEQ + t);
                    y[0] *= __uint_as_float(xx.x << 16); y[1] *= __uint_as_float(xx.x & 0xffff0000u); y[2] *= __uint_as_float(xx.y << 16); y[3] *= __uint_as_float(xx.y & 0xffff0000u);
                    u32x2 w; w.x = pk2(y[0], y[1]); w.y = pk2(y[2], y[3]); *(LAS u32x2*)(Z2r + bq * HC_ROWB + (HC_PAD + t) * 2) = w; }
                else { u32x2 w; w.x = pk2(y[0], y[1]); w.y = pk2(y[2], y[3]); *(u32x2*)(Y2T + bq * SEQ + t) = w; } }
        }
        __syncthreads();
    }
}
__device__ __forceinline__ void hy_fin_task(const Params& p, int l, int t0, int c0, LAS float* u) {
    const bf16_t* P = (const bf16_t*)(p.ws + O_P); LAS float* y = u + 66 * 65;
    load_conv_tile(P, t0, 1024 + c0, u);
    const int tid = otid();
    { const int c = tid >> 3, tc = (tid & 7) * 8; const u32x4 v = *(const u32x4*)((const bf16_t*)(p.ws + O_Y2T) + (size_t)(c0 + c) * NTOK + t0 + tc);
#pragma unroll
      for (int j = 0; j < 4; ++j) { y[c * 65 + tc + 2 * j] = __uint_as_float(v[j] << 16); y[c * 65 + tc + 2 * j + 1] = __uint_as_float(v[j] & 0xffff0000u); } }
    __syncthreads();
    { const int t = tid >> 3, cc = (tid & 7) * 8; const float* cw = p.in[I_HYCONV] + (size_t)l * 3 * 1536 + 1024 + c0 + cc; float o[8];
#pragma unroll
      for (int j = 0; j < 8; ++j) { const int c = cc + j; const float x2 = cw[j] * u[t * 65 + c] + cw[1536 + j] * u[(t + 1) * 65 + c] + cw[3072 + j] * u[(t + 2) * 65 + c]; o[j] = x2 * y[c * 65 + t]; }
#if WOUT8
      u32x2 w; w.x = pk4_fp8(o[0] * MIX8_SCALE, o[1] * MIX8_SCALE, o[2] * MIX8_SCALE, o[3] * MIX8_SCALE); w.y = pk4_fp8(o[4] * MIX8_SCALE, o[5] * MIX8_SCALE, o[6] * MIX8_SCALE, o[7] * MIX8_SCALE);
      *(u32x2*)(p.ws + O_MIX + (size_t)(t0 + t) * DM + c0 + cc) = w; }
#else
      u32x4 w; w.x = pk2(o[0], o[1]); w.y = pk2(o[2], o[3]); w.z = pk2(o[4], o[5]); w.w = pk2(o[6], o[7]);
      *(u32x4*)((bf16_t*)(p.ws + O_MIX) + (size_t)(t0 + t) * DM + c0 + cc) = w; }
#endif
    __syncthreads();
}

__device__ __forceinline__ void mla_unit(const Params& p, int b, int h, int qb, bool ctxq, LAS unsigned char* lds) {
    unsigned char* ws = p.ws;
    const bf16_t* Q = ctxq ? (const bf16_t*)(ws + O_QMC) + (size_t)(b * 6 + h) * CTXL * 192 : (const bf16_t*)(ws + O_QM) + ((size_t)(b * 6 + h) * SEQ + qb * 256) * 192;
#if WOUT8
    bf16_t* O = (bf16_t*)(ws + O_MIX + (size_t)(ctxq ? NLAT + b * CTXL : b * SEQ + qb * 256) * DM + 512 + h * 128);
#else
    bf16_t* O = (bf16_t*)(ws + O_MIX) + (size_t)(ctxq ? NLAT + b * CTXL : b * SEQ + qb * 256) * DM + 512 + h * 128;
#endif
    attn_body<192, 0>(Q, (const bf16_t*)(ws + O_KM) + (size_t)(b * 6 + h) * LK * 192, (const bf16_t*)(ws + O_VM) + (size_t)(b * 6 + h) * LK * 128, O, DM, ctxq ? CTXL : LK, 0.07216878364870322f, (char*)lds);
}
__device__ __forceinline__ void gqa_unit(const Params& p, int b, int h, int qb, bool ctxq, LAS unsigned char* lds) {
    unsigned char* ws = p.ws;
    const bf16_t* Q = ctxq ? (const bf16_t*)(ws + O_QGC) + (size_t)(b * 6 + h) * CTXL * 128 : (const bf16_t*)(ws + O_QG) + ((size_t)(b * 6 + h) * SEQ + qb * 256) * 128;
#if WOUT8
    bf16_t* O = (bf16_t*)(ws + O_MIX + (size_t)(ctxq ? NLAT + b * CTXL : b * SEQ + qb * 256) * DM + 1280 + h * 128);
#else
    bf16_t* O = (bf16_t*)(ws + O_MIX) + (size_t)(ctxq ? NLAT + b * CTXL : b * SEQ + qb * 256) * DM + 1280 + h * 128;
#endif
    attn_body<128, GQA_SD>(Q, (const bf16_t*)(ws + O_KG) + (size_t)(b * 2 + h / 3) * LK * 128, (const bf16_t*)(ws + O_VG) + (size_t)(b * 2 + h / 3) * LK * 128, O, DM, ctxq ? CTXL : LK, 0.08838834764831845f, (char*)lds);
}
__device__ __forceinline__ void phase_mixer(const Params& p, int l, LAS unsigned char* lds) {
    const int G = gridDim.x, bid = blockIdx.x; const bool last = (l == NLAYER - 1);
    for (int u = bid; u < 384 + (last ? 0 : 48); u += G) { if (u < 384) mla_unit(p, u / 48, (u >> 3) % 6, u & 7, false, lds); else mla_unit(p, (u - 384) / 6, (u - 384) % 6, 0, true, lds); }
    for (int u = (bid + G / 2) % G; u < 384 + (last ? 0 : 48); u += G) { if (u < 384) gqa_unit(p, u / 48, (u >> 3) % 6, u & 7, false, lds); else gqa_unit(p, (u - 384) / 6, (u - 384) % 6, 0, true, lds); }
#ifndef CONV_REP
#define CONV_REP 1
#endif
    for (int rep = 0; rep < CONV_REP; ++rep) {
#if HY_MFMA
    for (int u = bid; u < 512; u += G) hyconv_unit_mfma(p, l, u, lds);
    if (!last) for (int u = bid; u < 512; u += G) hyconv_unit_valu(p, l, 1, u, (LAS float*)lds);
#else
    for (int u = bid; u < (last ? 512 : 1024); u += G) hyconv_unit_valu(p, l, u >> 9, u & 511, (LAS float*)lds);
#endif
    }
}

constexpr int RT_FS = DM + 4;
__device__ __forceinline__ void route_row_pre(const Params& p, int l, int row, int lane, LAS float* fdst, const float* g1, const float* g2) {
    const float* mod = (const float*)(p.ws + O_MOD) + (size_t)(l * 9 + row_batch(row)) * 12288;
    const bf16_t* O = (const bf16_t*)(p.ws + O_OUT) + (size_t)row * DM; const float* rs = resid_src(p, l, row); float* X = (float*)(p.ws + O_X) + (size_t)row * DM; bf16_t* H = (bf16_t*)(p.ws + O_H) + (size_t)row * DM;
    float o[32], x[32]; float ss = 0.f;
#pragma unroll
    for (int j = 0; j < 8; ++j) { const u32x2 v = *(const u32x2*)(O + ROWCOL(j, lane)); o[j * 4] = __uint_as_float(v.x << 16); o[j * 4 + 1] = __uint_as_float(v.x & 0xffff0000u); o[j * 4 + 2] = __uint_as_float(v.y << 16); o[j * 4 + 3] = __uint_as_float(v.y & 0xffff0000u); }
#pragma unroll
    for (int i = 0; i < 32; ++i) ss += o[i] * o[i];
    const float r1 = rsqrtf(wave_sum(ss) * (1.0f / DM) + EPS); float s2 = 0.f;
#pragma unroll
    for (int j = 0; j < 8; ++j) { const int c = ROWCOL(j, lane); const f32x4 xv = *(const f32x4*)(rs + c), gv = *(const f32x4*)(g1 + c), ga = *(const f32x4*)(mod + 2 * DM + c); f32x4 xn;
#pragma unroll
        for (int q = 0; q < 4; ++q) { xn[q] = xv[q] + ga[q] * (o[j * 4 + q] * r1 * gv[q]); x[j * 4 + q] = xn[q]; s2 += xn[q] * xn[q]; }
        *(f32x4*)(X + c) = xn; }
    const float r2 = rsqrtf(wave_sum(s2) * (1.0f / DM) + EPS);
#pragma unroll
    for (int j = 0; j < 8; ++j) { const int c = ROWCOL(j, lane); const f32x4 gv = *(const f32x4*)(g2 + c), sh = *(const f32x4*)(mod + 3 * DM + c), sc = *(const f32x4*)(mod + 4 * DM + c); f32x4 f;
#pragma unroll
        for (int q = 0; q < 4; ++q) f[q] = x[j * 4 + q] * r2 * gv[q] * (1.0f + sc[q]) + sh[q];
#if MOE_FP8
        *(unsigned*)((unsigned char*)(p.ws + O_H) + (size_t)row * DM + c) = pk4_fp8(f[0], f[1], f[2], f[3]);
#else
        u32x2 w; w.x = pk2(f[0], f[1]); w.y = pk2(f[2], f[3]); *(u32x2*)(H + c) = w;
#endif
        *(LAS f32x4*)(fdst + c) = f; }
}
__device__ __forceinline__ void route_row_topk(const Params& p, int l, int row, int lane, float logit, LAS unsigned* cntL) {
    const float score = 1.0f / (1.0f + expf(-logit)), biased = score + p.in[I_RB][l * 64 + lane];
    float m1 = biased; m1 = fmaxf(m1, __shfl_xor(m1, 1)); m1 = fmaxf(m1, __shfl_xor(m1, 2)); m1 = fmaxf(m1, __shfl_xor(m1, 4));
    const unsigned long long bal = __ballot(biased == m1); const int first = __builtin_ctz((unsigned)((bal >> (lane & ~7)) & 0xffull));
    float m2 = ((lane & 7) == first) ? -INFINITY : biased; m2 = fmaxf(m2, __shfl_xor(m2, 1)); m2 = fmaxf(m2, __shfl_xor(m2, 2)); m2 = fmaxf(m2, __shfl_xor(m2, 4));
    const float gs = m1 + m2; const int grp = lane >> 3; int rank = 0;
#pragma unroll
    for (int q = 0; q < 8; ++q) { const float v = rdlane(gs, q * 8); rank += (v > gs || (v == gs && q < grp)) ? 1 : 0; }
    const float cand = (rank < 4) ? biased : -INFINITY; int re = 0;
    for (int q = 0; q < 64; ++q) { const float v = rdlane(cand, q); re += (v > cand || (v == cand && q < lane)) ? 1 : 0; }
    const bool sel = re < TOPK; const float ssum = wave_sum(sel ? score : 0.f);
    if (sel) { ((int*)(p.ws + O_EIDX))[(size_t)row * 8 + re] = lane; ((float*)(p.ws + O_GATE))[(size_t)row * 8 + re] = score / ssum * 2.5f;
        ((int*)(p.ws + O_SLOT))[(size_t)row * 8 + re] = (int)__hip_atomic_fetch_add(&cntL[lane], 1u, __ATOMIC_RELAXED, __HIP_MEMORY_SCOPE_WORKGROUP); }
}
__device__ __forceinline__ void phase_route(const Params& p, int l, LAS unsigned char* lds) {
    const int tid = otid(), wid = __builtin_amdgcn_readfirstlane(tid >> 6), lane0 = tid & 63; const bool last = (l == NLAYER - 1); const int NR = last ? NLAT : NTOK;
    LAS float* frow = (LAS float*)lds; LAS float* part = frow;
    const float* g1 = p.in[I_NORMG] + (size_t)(l * 4 + 1) * DM; const float* g2 = p.in[I_NORMG] + (size_t)(l * 4 + 2) * DM;
    const float* RW = p.in[I_RW] + (size_t)l * DM * NEXP; LAS unsigned* cntL = (LAS unsigned*)(lds + LDS_CNTL);
    if (tid < 64) cntL[tid] = 0u;
    { int* stok = (int*)(p.ws + O_STOK); for (int i = blockIdx.x * NTHREADS + tid; i < NSLOTS; i += gridDim.x * NTHREADS) stok[i] = (i < RSLOTS) ? -1 : ((i - RSLOTS) < NR ? i - RSLOTS : -1); }
    for (int g = blockIdx.x; g < NR / 16; g += gridDim.x) {
        int lane = lane0; asm volatile("" : "+v"(lane));
        for (int rr = 0; rr < 2; ++rr) route_row_pre(p, l, g * 16 + wid * 2 + rr, lane, frow + (wid * 2 + rr) * RT_FS, g1, g2);
        __syncthreads();
        f32x4 acc[4];
#pragma unroll
        for (int j = 0; j < 4; ++j) acc[j] = (f32x4){0.f, 0.f, 0.f, 0.f};
        { const int r16 = lane & 15, kq = lane >> 4; const LAS float* fa = frow + r16 * RT_FS + wid * 256 + 4 * kq; const float* rb = RW + (size_t)(wid * 256 + 4 * kq) * 64 + 4 * r16;
#pragma unroll 2
          for (int st = 0; st < 16; ++st) { const f32x4 a = *(const LAS f32x4*)(fa + 16 * st); f32x4 b[4];
#pragma unroll
              for (int i = 0; i < 4; ++i) b[i] = *(const f32x4*)(rb + (size_t)(16 * st + i) * 64);
#pragma unroll
              for (int i = 0; i < 4; ++i)
#pragma unroll
                  for (int j = 0; j < 4; ++j) acc[j] = __builtin_amdgcn_mfma_f32_16x16x4f32(a[i], b[i][j], acc[j], 0, 0, 0); }
          __syncthreads();
#pragma unroll
          for (int r = 0; r < 4; ++r) *(LAS f32x4*)(part + (wid * 16 + 4 * kq + r) * 64 + 4 * r16) = (f32x4){acc[0][r], acc[1][r], acc[2][r], acc[3][r]}; }
        __syncthreads();
        for (int rr = 0; rr < 2; ++rr) { const int r16 = wid * 2 + rr; float logit = 0.f;
#pragma unroll
            for (int w = 0; w < 8; ++w) logit += part[(w * 16 + r16) * 64 + lane];
            route_row_topk(p, l, g * 16 + r16, lane, logit, cntL); }
        __syncthreads();
    }
    __syncthreads();
    if (tid < 64) ((unsigned*)(p.ws + O_WCNT))[blockIdx.x * 64 + tid] = cntL[tid];
}
__device__ __forceinline__ void phase_place(const Params& p, int l, LAS unsigned char* lds) {
    const int tid = otid(); const int NR = (l == NLAYER - 1) ? NLAT : NTOK, G = gridDim.x;
    LAS int* woff = (LAS int*)lds; LAS int* csum = woff + 512 * 64; LAS int* pstart = csum + 8 * 64;
    const unsigned* wcnt = (const unsigned*)(p.ws + O_WCNT);
    for (int i = tid; i < G * 64; i += NTHREADS) woff[i] = (int)wcnt[i];
    __syncthreads();
    { const int e = tid & 63, ch = tid >> 6, cs = (G + 7) >> 3, w0 = ch * cs, w1 = (w0 + cs < G) ? w0 + cs : G; int run = 0;
      for (int w = w0; w < w1; ++w) { const int t = woff[w * 64 + e]; woff[w * 64 + e] = run; run += t; }
      csum[ch * 64 + e] = run;
      __syncthreads();
      int base = 0, tot = 0;
#pragma unroll
      for (int c2 = 0; c2 < 8; ++c2) { const int v = csum[c2 * 64 + e]; if (c2 < ch) base += v; tot += v; }
      for (int w = w0; w < w1; ++w) woff[w * 64 + e] += base;
      if (tid < 64) { const int ntile = (tot + 255) >> 8; pstart[tid] = (wave_incl_scan(ntile, tid) - ntile) * 256;
          if (blockIdx.x == 0) ((unsigned*)(p.ws + O_CTL))[CW_CNT + l * 64 + tid] = (unsigned)tot; } }
    __syncthreads();
    const int* eidx = (const int*)(p.ws + O_EIDX); int* slot = (int*)(p.ws + O_SLOT); int* stok = (int*)(p.ws + O_STOK);
    for (int i = blockIdx.x * NTHREADS + tid; i < NR * TOPK; i += G * NTHREADS) { const int row = i / TOPK, k = i % TOPK, e = eidx[(size_t)row * 8 + k], wg = (row >> 4) % G;
        const int s = pstart[e] + woff[wg * 64 + e] + slot[(size_t)row * 8 + k]; slot[(size_t)row * 8 + k] = s; stok[s] = row; }
    __syncthreads();
}
__device__ __forceinline__ void phase_final(const Params& p, int l) {
    const int lane = otid() & 63, gw = blockIdx.x * 8 + owid(), GW = gridDim.x * 8; const bool last = (l == NLAYER - 1); const int NR = last ? NLAT : NTOK;
    const bf16_t* DO = (const bf16_t*)(p.ws + O_DOUT); const float* g3 = p.in[I_NORMG] + (size_t)(l * 4 + 3) * DM;
    const int lane0 = lane;
    for (int row = gw; row < NR; row += GW) {
        int lane = lane0; asm volatile("" : "+v"(lane));
        const int sl = (lane < TOPK) ? ((const int*)(p.ws + O_SLOT))[(size_t)row * 8 + lane] : 0; const float gl = (lane < TOPK) ? ((const float*)(p.ws + O_GATE))[(size_t)row * 8 + lane] : 0.f;
        float y[32];
#pragma unroll
        for (int i = 0; i < 32; ++i) y[i] = 0.f;
#if DOUT_FP8
        { const unsigned char* DO8 = p.ws + O_DOUT; unsigned v[7][8]; float gt[7];
#pragma unroll
          for (int k = 0; k < 7; ++k) { const int s = (k == 0) ? RSLOTS + row : __builtin_amdgcn_readlane(sl, k - 1); const unsigned char* src = DO8 + (size_t)s * DM; gt[k] = ((k == 0) ? 1.0f : rdlane(gl, k - 1)) * (1.0f / DOUT8_SCALE);
#pragma unroll
              for (int j = 0; j < 8; ++j) v[k][j] = *(const unsigned*)(src + ROWCOL(j, lane)); }
#pragma unroll
          for (int k = 0; k < 7; ++k)
#pragma unroll
              for (int j = 0; j < 8; ++j) { typedef float f32x2v __attribute__((ext_vector_type(2))); const f32x2v lo = __builtin_amdgcn_cvt_pk_f32_fp8((int)v[k][j], false), hi = __builtin_amdgcn_cvt_pk_f32_fp8((int)v[k][j], true);
                  y[j * 4] += gt[k] * lo.x; y[j * 4 + 1] += gt[k] * lo.y; y[j * 4 + 2] += gt[k] * hi.x; y[j * 4 + 3] += gt[k] * hi.y; } }
#else
#pragma unroll
        for (int kb = 0; kb < 7; kb += 4) {
            u32x2 v[4][8]; float gt[4];
#pragma unroll
            for (int kk = 0; kk < 4; ++kk) { const int k = kb + kk; if (k < 7) { const int s = (k == 0) ? RSLOTS + row : __builtin_amdgcn_readlane(sl, k - 1); const bf16_t* src = DO + (size_t)s * DM; gt[kk] = (k == 0) ? 1.0f : rdlane(gl, k - 1);
#pragma unroll
                for (int j = 0; j < 8; ++j) v[kk][j] = *(const u32x2*)(src + ROWCOL(j, lane)); } }
#pragma unroll
            for (int kk = 0; kk < 4; ++kk) { if (kb + kk < 7) {
#pragma unroll
                for (int j = 0; j < 8; ++j) { const float g = gt[kk]; y[j * 4] += g * __uint_as_float(v[kk][j].x << 16); y[j * 4 + 1] += g * __uint_as_float(v[kk][j].x & 0xffff0000u); y[j * 4 + 2] += g * __uint_as_float(v[kk][j].y << 16); y[j * 4 + 3] += g * __uint_as_float(v[kk][j].y & 0xffff0000u); } } }
        }
#endif
        float ss = 0.f;
#pragma unroll
        for (int i = 0; i < 32; ++i) ss += y[i] * y[i];
        const float r = rsqrtf(wave_sum(ss) * (1.0f / DM) + EPS); const float* mod = (const float*)(p.ws + O_MOD) + (size_t)(l * 9 + row_batch(row)) * 12288;
        float* X = (float*)(p.ws + O_X) + (size_t)row * DM; float x[32];
#pragma unroll
        for (int j = 0; j < 8; ++j) { const int c = ROWCOL(j, lane); const f32x4 xv = *(const f32x4*)(X + c), gv = *(const f32x4*)(g3 + c), gf = *(const f32x4*)(mod + 5 * DM + c); f32x4 xn;
#pragma unroll
            for (int q = 0; q < 4; ++q) { xn[q] = xv[q] + gf[q] * (y[j * 4 + q] * r * gv[q]); x[j * 4 + q] = xn[q]; }
            if (last) *(f32x4*)(p.out + (size_t)row * DM + c) = xn; else *(f32x4*)(X + c) = xn; }
        if (!last) norm1_row(p, l + 1, row, x, lane);
    }
}

#define XB_TMO      128
#define XB_XCNT(j)  (256  + 64 * (j))
#define XB_XSUB(j)  (1280 + 64 * (j))
#define XB_XGEN(j)  (2304 + 64 * (j))
#define XB_TOP      3328
#define XB_TOPGEN   3392
#define XCD_BAR_WORDS 3456
#define XB_SPIN_CAP (1u << 23)

__device__ __forceinline__ unsigned xb_ld(unsigned* p)              { return __hip_atomic_load(p, __ATOMIC_RELAXED, __HIP_MEMORY_SCOPE_AGENT); }
__device__ __forceinline__ unsigned xb_add(unsigned* p, unsigned v) { return __hip_atomic_fetch_add(p, v, __ATOMIC_RELAXED, __HIP_MEMORY_SCOPE_AGENT); }
__device__ __forceinline__ unsigned xb_xcc_id() { return (unsigned)__builtin_amdgcn_s_getreg((3 << 11) | 20) & 0xFu; }
#define XB_SPIN(cond, bar) do { unsigned _sp = 0; while (cond) { __builtin_amdgcn_s_sleep(1); \
    if ((++_sp & 255u) == 0u) { if (xb_ld(&(bar)[XB_TMO])) break; if (_sp > XB_SPIN_CAP) { atomicAdd(&(bar)[XB_TMO], 1u); break; } } } } while (0)

struct XcdBarrier {
    unsigned* bar; unsigned x;
    volatile LAS unsigned* st;
};

__device__ __forceinline__ XcdBarrier xcd_barrier_post(unsigned* bar, volatile LAS unsigned* st) {
    XcdBarrier b; b.bar = bar; b.x = xb_xcc_id(); b.st = st;
    if (threadIdx.x == 0) (void)xb_add(&bar[XB_XCNT(b.x)], 1u);
    return b;
}
__device__ __forceinline__ void xcd_barrier_complete(unsigned* bar, unsigned x, unsigned& nloc, unsigned& nx) {
    const unsigned G = gridDim.x * gridDim.y * gridDim.z;
    unsigned sum, cnt, mine, sp = 0u;
    for (;;) {
        sum = 0u; cnt = 0u; mine = 0u;
#pragma unroll
        for (unsigned j = 0; j < 16; ++j) { const unsigned c = xb_ld(&bar[XB_XCNT(j)]); sum += c; cnt += (c > 0u) ? 1u : 0u; mine = (j == x) ? c : mine; }
        if (sum == G) break;
        __builtin_amdgcn_s_sleep(1);
        if ((++sp & 255u) == 0u) { if (xb_ld(&bar[XB_TMO])) break; if (sp > XB_SPIN_CAP) { atomicAdd(&bar[XB_TMO], 1u); break; } }
    }
    nloc = mine > 0u ? mine : 1u; nx = cnt > 0u ? cnt : 1u;
}

__device__ __forceinline__ void xcd_barrier(const XcdBarrier& b) {
    asm volatile("s_waitcnt vmcnt(0)" ::: "memory");
    __syncthreads();
    if (threadIdx.x == 0) {
        unsigned* bar = b.bar;
        __builtin_amdgcn_s_waitcnt(0);
        unsigned nloc = b.st[0], nx = b.st[1];
        if (nloc == 0u) { xcd_barrier_complete(bar, b.x, nloc, nx); b.st[0] = nloc; b.st[1] = nx; }
        const unsigned old = xb_add(&bar[XB_XSUB(b.x)], 1u);
        const unsigned gen = old / nloc;
        if (old + 1u == (gen + 1u) * nloc) {
            __builtin_amdgcn_fence(__ATOMIC_RELEASE, "agent");
            asm volatile("s_waitcnt vmcnt(0)" ::: "memory");
            const unsigned og = xb_add(&bar[XB_TOP], 1u);
            const unsigned tg = og / nx;
            if (og + 1u == (tg + 1u) * nx) xb_add(&bar[XB_TOPGEN], 1u);
            else XB_SPIN(xb_ld(&bar[XB_TOPGEN]) == tg, bar);
            __builtin_amdgcn_fence(__ATOMIC_ACQUIRE, "agent");
            xb_add(&bar[XB_XGEN(b.x)], 1u);
            asm volatile("s_waitcnt vmcnt(0)" ::: "memory");
        } else {
            XB_SPIN(xb_ld(&bar[XB_XGEN(b.x)]) == gen, bar);
            __builtin_amdgcn_fence(__ATOMIC_ACQUIRE, "agent");
            asm volatile("s_waitcnt vmcnt(0)" ::: "memory");
        }
    }
    __syncthreads();
}


enum { PH_PRO = 0, PH_NORM1, PH_WIN, PH_POSTA, PH_POSTB, PH_MIXER, PH_HYFIN, PH_WOUT, PH_ROUTE, PH_PLACE, PH_GEMM1, PH_GEMM2, PH_FINAL, PH_COUNT };

template <int PH>
__device__ __forceinline__ void run_phase(const Params& p_in, int l, LAS unsigned char* lds) {
#if MEGA
    const __attribute__((address_space(4))) Params* kp = (const __attribute__((address_space(4))) Params*)__builtin_amdgcn_kernarg_segment_ptr(); asm volatile("" : "+s"(kp)); (void)p_in;
    Params p;
#pragma unroll
    for (int i_ = 0; i_ < 31; ++i_) p.in[i_] = kp->in[i_];
    p.out = kp->out; p.ws = kp->ws; p.layer = 0; p.pad = 0;
#else
    Params p = p_in; { unsigned char* w = p.ws; asm volatile("" : "+s"(w)); p.ws = w; }
#endif
    unsigned char* ws = p.ws; const bool last = (l == NLAYER - 1);
    const int gw = blockIdx.x * 8 + owid(), GW = gridDim.x * 8, lane = otid() & 63;
    if constexpr (PH == PH_PRO) { phase_prologue(p, lds); }
    if constexpr (PH == PH_NORM1) { phase_norm1(p, l); }
    if constexpr (PH == PH_WIN) {
        EpiStoreBf16 E{(bf16_t*)(ws + O_P), NP}; GemmDesc g{(const bf16_t*)(ws + O_H), DM, nullptr, DM, DM};
#if WIN8
        const bf16_t* Bt = (const bf16_t*)(ws + O_WIN + (size_t)l * NP * DM);
        if (!last) { DenseSched S{Bt, DM / 2, NTOK / 256, 16, 0, 0}; GEMM_PHASE8(g, S, E, 127, 119); }
        else { DenseSched S{Bt, DM / 2, NLAT / 256, 16, 0, 0}; GEMM_PHASE8(g, S, E, 127, 119); DenseSched S2{Bt, DM / 2, NCTX / 256, 4, NLAT, 12}; GEMM_PHASE8(g, S2, E, 127, 119); }
#else
        const bf16_t* Bt = (const bf16_t*)(ws + O_WIN) + (size_t)l * NP * DM;
        if (!last) { DenseSched S{Bt, DM, NTOK / 256, 16, 0, 0}; GEMM_PHASE(g, S, E); }
        else { DenseSched S{Bt, DM, NLAT / 256, 16, 0, 0}; GEMM_PHASE(g, S, E); DenseSched S2{Bt, DM, NCTX / 256, 4, NLAT, 12}; GEMM_PHASE(g, S2, E); }
#endif
    }
    if constexpr (PH == PH_POSTA) {
#ifndef DBG_SKIP
#define DBG_SKIP 0
#endif
        if (!(DBG_SKIP & 1)) { GemmDesc g{(const bf16_t*)(ws + O_P) + C_CQ, NP, nullptr, 768, 768}; EpiStoreBf16 E{(bf16_t*)(ws + O_QRAW), NQP};
          DenseSched S{(const bf16_t*)(ws + O_WUQ) + (size_t)l * NQP * 768, 768, (last ? NLAT : NTOK) / 256, 5, 0, 0}; GEMM_PHASE(g, S, E); }
        if (!(DBG_SKIP & 2)) { GemmDesc g{(const bf16_t*)(ws + O_P) + C_CKV, NP, nullptr, 256, 256}; EpiStoreBf16 E{(bf16_t*)(ws + O_KVRAW), 1536};
          DenseSched S{(const bf16_t*)(ws + O_WUKV) + (size_t)l * 1536 * 256, 256, NTOK / 256, 6, 0, 0}; GEMM_PHASE(g, S, E); }
        const int ntt = (last ? NLAT : NTOK) / 64;
        if (!(DBG_SKIP & 4)) for (int t = blockIdx.x; t < ntt * 4; t += gridDim.x) hy_prep_task(p, l, (t >> 2) * 64, (t & 3) * 256, (LAS float*)lds);
        if (!(DBG_SKIP & 8)) for (int row = gw; row < NTOK; row += GW) gqa_post_row(p, l, row, lane);
    }
    if constexpr (PH == PH_POSTB) { if (l == 0) hss_tasks(p); for (int row = gw; row < NTOK; row += GW) mla_post_row(p, l, row, lane); }
    if constexpr (PH == PH_MIXER) { phase_mixer(p, l, lds); }
    if constexpr (PH == PH_HYFIN) { const int ntt = (last ? NLAT : NTOK) / 64; for (int t = blockIdx.x; t < ntt * 8; t += gridDim.x) hy_fin_task(p, l, (t >> 3) * 64, (t & 7) * 64, (LAS float*)lds); }
    if constexpr (PH == PH_WOUT) {
        GemmDesc g{(const bf16_t*)(ws + O_MIX), DM, nullptr, DM, DM}; EpiStoreBf16 E{(bf16_t*)(ws + O_OUT), DM};
#if WOUT8
        DenseSched S{(const bf16_t*)(ws + O_WOUT + (size_t)l * DM * DM), DM / 2, (last ? NLAT : NTOK) / 256, 8, 0, 0}; GEMM_PHASE8(g, S, E, 123, 119);
#else
        DenseSched S{(const bf16_t*)(ws + O_WOUT) + (size_t)l * DM * DM, DM, (last ? NLAT : NTOK) / 256, 8, 0, 0}; GEMM_PHASE(g, S, E);
#endif
    }
    if constexpr (PH == PH_ROUTE) { phase_route(p, l, lds); }
    if constexpr (PH == PH_PLACE) { phase_place(p, l, lds); }
    if constexpr (PH == PH_GEMM1 || PH == PH_GEMM2) {
        LAS int* te = (LAS int*)(lds + LDS_TILES); LAS int* ts = te + MAXTILES; LAS int* misc = (LAS int*)(lds + LDS_MISC) + 16;
        const int nt = moe_build_tiles((const unsigned*)(ws + O_CTL) + CW_CNT + l * 64, (last ? NLAT : NTOK) / 256, te, ts, misc);
#if MOE_FP8
        if constexpr (PH == PH_GEMM1) {
            GemmDesc g{(const bf16_t*)(ws + O_H), DM, (const int*)(ws + O_STOK), DM, DM}; EpiSwiGLU8 E{ws + O_HID};
            MoeSched S{te, ts, nt, 4, (const bf16_t*)(ws + O_EGU), (size_t)1024 * 1024, DM / 2, 128}; GEMM_PHASE8(g, S, E, 127, 119);
        } else {
            GemmDesc g{(const bf16_t*)(ws + O_HID), EH, nullptr, EH, EH};
            MoeSched S{te, ts, nt, 8, (const bf16_t*)(ws + O_ED), (size_t)2048 * 256, EH / 2, 256};
#if DOUT_FP8
            EpiStoreFp8 E{ws + O_DOUT, DM, DOUT8_SCALE}; GEMM_PHASE8(g, S, E, 124, 119);
#else
            EpiStoreBf16 E{(bf16_t*)(ws + O_DOUT), DM}; GEMM_PHASE8(g, S, E, 124, 119);
#endif
        }
#else
        if constexpr (PH == PH_GEMM1) {
            GemmDesc g{(const bf16_t*)(ws + O_H), DM, (const int*)(ws + O_STOK), DM, DM}; EpiSwiGLU E{(bf16_t*)(ws + O_HID)};
            MoeSched S{te, ts, nt, 4, (const bf16_t*)(ws + O_EGU), (size_t)1024 * 2048, DM, 128}; GEMM_PHASE(g, S, E);
        } else {
            GemmDesc g{(const bf16_t*)(ws + O_HID), EH, nullptr, EH, EH}; EpiStoreBf16 E{(bf16_t*)(ws + O_DOUT), DM};
            MoeSched S{te, ts, nt, 8, (const bf16_t*)(ws + O_ED), (size_t)2048 * 512, EH, 256}; GEMM_PHASE(g, S, E);
        }
#endif
        __syncthreads();
    }
    if constexpr (PH == PH_FINAL) {
        phase_final(p, l);
        if (!last) cvt_exp_all(p, l + 1);
    }
}

#ifndef MEGA
#define MEGA 0
#endif


#if MEGA
__global__ void __launch_bounds__(NTHREADS, 2) mega_fwd(Params p) {
    extern __shared__ __attribute__((aligned(16))) unsigned char lds_raw[];
    LAS unsigned char* lds = (LAS unsigned char*)lds_raw;
    volatile LAS unsigned* xbw = (volatile LAS unsigned*)(lds + LDS_MISC);
    if (otid() == 0) { xbw[0] = 0u; xbw[1] = 0u; }
    __syncthreads();
    { const XcdBarrier b0 = xcd_barrier_post((unsigned*)(p.ws + O_CTL) + CW_BAR, xbw); if (otid() == 0) xbw[2] = b0.x; }
    __syncthreads();
#define GRID_BAR() do { XcdBarrier b_; b_.bar = (unsigned*)(p.ws + O_CTL) + CW_BAR; b_.x = xbw[2]; b_.st = xbw; xcd_barrier(b_); } while (0)
#ifndef DBL_MASK
#define DBL_MASK 0
#endif
#define RUNP(PH, l) do { run_phase<PH>(p, l, lds); GRID_BAR(); if ((DBL_MASK >> PH) & 1) { run_phase<PH>(p, l, lds); GRID_BAR(); } } while (0)
#ifndef DLY_MASK
#define DLY_MASK 0
#endif
#define RUND(PH, l) do { if ((DLY_MASK >> PH) & 1) { const unsigned long long t0_ = wall_clock64(); run_phase<PH>(p, l, lds); const unsigned long long t1_ = wall_clock64(); while (wall_clock64() < t1_ + (t1_ - t0_)) __builtin_amdgcn_s_sleep(8); } else run_phase<PH>(p, l, lds); } while (0)
    RUNP(PH_PRO, 0);
#define LAYER(l) do { if ((l) == 0) RUNP(PH_NORM1, l); \
        RUNP(PH_WIN, l); RUNP(PH_POSTA, l); RUNP(PH_POSTB, l); RUNP(PH_MIXER, l); RUNP(PH_HYFIN, l); RUNP(PH_WOUT, l); \
        RUND(PH_ROUTE, l); GRID_BAR(); RUND(PH_PLACE, l); GRID_BAR(); RUNP(PH_GEMM1, l); RUNP(PH_GEMM2, l); RUND(PH_FINAL, l); \
        if ((l) + 1 < NLAYER) GRID_BAR(); } while (0)
    LAYER(0);
    LAYER(1);
}
#endif

#if !MEGA
template <int PH> __global__ void __launch_bounds__(NTHREADS, 2) k_phase(Params p) {
    extern __shared__ __attribute__((aligned(16))) unsigned char lds_raw[];
    run_phase<PH>(p, p.layer, (LAS unsigned char*)lds_raw);
}
template <int PH> static bool prep_phase() { return hipFuncSetAttribute((const void*)k_phase<PH>, hipFuncAttributeMaxDynamicSharedMemorySize, LDS_BYTES) == hipSuccess; }
static int g_nlaunch = 0;
#ifndef DBG_STOP
#define DBG_STOP 1000
#define DBG_DUMP 0
#else
#define DBG_DUMP 1
#ifndef DBG_SET
#define DBG_SET 31
#endif
#endif
template <int PH> static void launch_phase(Params p, int l, hipStream_t st) { if (g_nlaunch++ >= DBG_STOP) return; p.layer = l; hipLaunchKernelGGL(k_phase<PH>, dim3(256), dim3(NTHREADS), LDS_BYTES, st, p); }
#endif


#if DBG_DUMP
__device__ __forceinline__ float san(float x) { return (x == x && fabsf(x) < 1e6f) ? x : 1.0f; }
__global__ void __launch_bounds__(256) k_dump(Params p) {
    const size_t N = (size_t)NLAT * DM;
    const bf16_t* b1 = (const bf16_t*)(p.ws + O_WIN); const size_t n1 = (O_X - O_WIN) / 2;
    const bf16_t* b2 = (const bf16_t*)(p.ws + O_H); const size_t n2 = (size_t)NTOK * DM;
    const bf16_t* b3 = (const bf16_t*)(p.ws + O_A); const size_t n3 = (O_AEND - O_A) / 2;
    const float* f1 = (const float*)(p.ws + O_MOD); const size_t m1 = (O_WIN - O_MOD) / 4;
    const float* f2 = (const float*)(p.ws + O_X); const size_t m2 = (size_t)NTOK * DM;
    for (size_t i = (size_t)blockIdx.x * 256 + otid(); i < N; i += (size_t)gridDim.x * 256) {
        float v = 0.f;
        if (DBG_SET & 1) for (size_t e = i; e < n1; e += N) v += san(bf2f(b1[e]));
        if (DBG_SET & 2) for (size_t e = i; e < n2; e += N) v += san(bf2f(b2[e]));
        if (DBG_SET & 4) for (size_t e = i; e < n3; e += N) v += san(bf2f(b3[e]));
        if (DBG_SET & 8) for (size_t e = i; e < m1; e += N) v += san(f1[e]);
        if (DBG_SET & 16) for (size_t e = i; e < m2; e += N) v += san(f2[e]);
        if (DBG_SET & 32) v += san(bf2f(((const bf16_t*)(p.ws + O_WUKV))[i % ((size_t)2 * 1536 * 256)]));
        if (DBG_SET & 64) { const size_t r = i % NTOK, c = (i / NTOK) % 256; v += san(bf2f(((const bf16_t*)(p.ws + O_P))[r * NP + C_CKV + c])); }
        if (DBG_SET & 128) v += san(bf2f(((const bf16_t*)(p.ws + O_KVRAW))[i % ((size_t)NTOK * 1536)]));
        p.out[i] = v;
    }
}
#endif
static int g_grid = 0;
extern "C" void kernel_launch(void* const* d_in, const int* in_sizes, int n_in, void* d_out, int out_size, void* d_ws, size_t ws_size, hipStream_t stream) {
    static int ok = 0;
    if (ok == 0) {
        if (n_in != 31 || in_sizes[0] != NLAT * DM || out_size != NLAT * DM || ws_size < WS_END) { fprintf(stderr, "kernel_launch: unexpected shapes (n_in %d, ws %zu, need %zu)\n", n_in, ws_size, (size_t)WS_END); ok = -1; return; }
        bool good = true;
#if !MEGA
        good = good && prep_phase<0>() && prep_phase<1>() && prep_phase<2>() && prep_phase<3>() && prep_phase<4>() && prep_phase<5>() && prep_phase<6>() && prep_phase<7>() && prep_phase<8>() && prep_phase<9>() && prep_phase<10>() && prep_phase<11>() && prep_phase<12>();
#endif
#if MEGA
        good = hipFuncSetAttribute((const void*)mega_fwd, hipFuncAttributeMaxDynamicSharedMemorySize, LDS_BYTES) == hipSuccess;
        int dev = 0, cus = 0, per_cu = 0;
        if (hipGetDevice(&dev) != hipSuccess || hipDeviceGetAttribute(&cus, hipDeviceAttributeMultiprocessorCount, dev) != hipSuccess) good = false;
        if (good && (hipOccupancyMaxActiveBlocksPerMultiprocessor(&per_cu, (const void*)mega_fwd, NTHREADS, LDS_BYTES) != hipSuccess || per_cu < 1)) { fprintf(stderr, "kernel_launch: occupancy query says %d workgroups per CU\n", per_cu); good = false; }
        g_grid = cus;
#endif
        if (!good) { fprintf(stderr, "kernel_launch: set-up failed\n"); ok = -1; return; }
        ok = 1;
    }
    if (ok < 0) return;
    Params p{}; for (int i = 0; i < 31; ++i) p.in[i] = (const float*)d_in[i]; p.out = (float*)d_out; p.ws = (unsigned char*)d_ws; p.layer = 0; p.pad = 0;
#ifdef POISON_WS
    hipMemsetAsync((char*)d_ws, 0xFF, WS_END, stream);
#endif
    hipMemsetAsync((char*)d_ws + O_CTL, 0, ZERO_BYTES, stream);
#if !MEGA
    g_nlaunch = 0;
    launch_phase<PH_PRO>(p, 0, stream);
    for (int l = 0; l < NLAYER; ++l) {
        if (l == 0) launch_phase<PH_NORM1>(p, l, stream);
        launch_phase<PH_WIN>(p, l, stream); launch_phase<PH_POSTA>(p, l, stream); launch_phase<PH_POSTB>(p, l, stream); launch_phase<PH_MIXER>(p, l, stream);
        launch_phase<PH_HYFIN>(p, l, stream); launch_phase<PH_WOUT>(p, l, stream); launch_phase<PH_ROUTE>(p, l, stream); launch_phase<PH_PLACE>(p, l, stream);
        launch_phase<PH_GEMM1>(p, l, stream); launch_phase<PH_GEMM2>(p, l, stream); launch_phase<PH_FINAL>(p, l, stream);
    }
#if DBG_DUMP
    hipLaunchKernelGGL(k_dump, dim3(2048), dim3(256), 0, stream, p);
#endif
#else
    hipLaunchKernelGGL(mega_fwd, dim3(g_grid), dim3(NTHREADS), LDS_BYTES, stream, p);
#endif
}
```

```cpp
#define MOE_FP8 1
#define GQA_SD 1
#define FAST_GEMM 1
#define MEGA 1
#include <hip/hip_runtime.h>
#include <stdint.h>
#include <stdio.h>

#define LAS __attribute__((address_space(3)))
typedef unsigned short bf16_t;
typedef short bf16x8 __attribute__((ext_vector_type(8)));
typedef short s16x4 __attribute__((ext_vector_type(4)));
typedef float f32x4 __attribute__((ext_vector_type(4)));
typedef float f32x16 __attribute__((ext_vector_type(16)));
typedef unsigned u32x4 __attribute__((ext_vector_type(4)));
typedef unsigned u32x2 __attribute__((ext_vector_type(2)));

constexpr int DM = 2048, NB = 8, SEQ = 2048, CTXL = 256, NLAT = NB * SEQ, NCTX = NB * CTXL, NTOK = NLAT + NCTX, NLAYER = 2;
constexpr int NP = 4096;
constexpr int C_CQ = 1536, C_GQ = 2304, C_CKV = 3072, C_KR = 3328, C_GK = 3392, C_GV = 3648, IN_COLS = 3904;
constexpr int NEXP = 64, TOPK = 6, EH = 512;
constexpr int LK = CTXL + SEQ;
constexpr int RSLOTS = 126976;
constexpr int NSLOTS = RSLOTS + NTOK;
constexpr int MAXTILES = NSLOTS / 256;
constexpr int NQP = 1280;
constexpr float EPS = 1e-6f;
constexpr int NTHREADS = 512;
#ifndef GQA_SD
#define GQA_SD 2
#endif
#ifndef HY_MFMA
#define HY_MFMA 1
#endif
#ifndef MOE_FP8
#define MOE_FP8 0
#endif
#ifndef HY_KRB
#define HY_KRB 0
#endif
#ifndef ROUTER_X3
#define ROUTER_X3 1
#endif
#ifndef DENSE_FP8
#define DENSE_FP8 0
#endif
#define WIN8 ((DENSE_FP8 & 1) != 0)
#define WOUT8 ((DENSE_FP8 & 2) != 0)
#define WOUT8G ((DENSE_FP8 & 6) != 0)
constexpr float MIX8_SCALE = 16.0f;
#ifndef DOUT_FP8
#define DOUT_FP8 MOE_FP8
#endif
constexpr float DOUT8_SCALE = 8.0f;
#ifndef FAST_GEMM
#define FAST_GEMM 1
#endif
#ifndef MEGA
#define MEGA 1
#endif

constexpr size_t al256(size_t x) { return (x + 255) & ~(size_t)255; }
constexpr size_t O_CTL = 0;
constexpr size_t CTL_BYTES = 65536;
constexpr size_t O_MOD = O_CTL + CTL_BYTES;
constexpr size_t O_HSS = O_MOD + al256((size_t)NLAYER * 9 * 12288 * 4);
constexpr size_t ZERO_BYTES = O_HSS + al256((size_t)NLAYER * 2 * 2 * 512 * 4);
constexpr size_t O_HF = ZERO_BYTES;
constexpr size_t HF_L0 = (size_t)2 * 2 * 512 * 2048, HF_L1 = (size_t)2 * 2 * 512 * 256, HF_LAYER = HF_L0 + HF_L1;
constexpr size_t O_WIN = O_HF + al256(NLAYER * HF_LAYER * 4);
constexpr size_t O_WOUT = O_WIN + (size_t)NLAYER * NP * DM * 2;
constexpr size_t O_WUQ = O_WOUT + (size_t)NLAYER * DM * DM * 2;
constexpr size_t O_WUKV = O_WUQ + al256((size_t)NLAYER * NQP * 768 * 2);
constexpr size_t O_EGU = O_WUKV + al256((size_t)NLAYER * 1536 * 256 * 2);
constexpr size_t O_ED = O_EGU + (size_t)65 * 1024 * 2048 * 2;
constexpr size_t O_X = O_ED + (size_t)65 * 2048 * 512 * 2;
constexpr size_t O_H = O_X + (size_t)NTOK * DM * 4;
constexpr size_t O_EIDX = O_H + (size_t)NTOK * DM * 2;
constexpr size_t O_GATE = O_EIDX + (size_t)NTOK * 8 * 4;
constexpr size_t O_SLOT = O_GATE + (size_t)NTOK * 8 * 4;
constexpr size_t O_STOK = O_SLOT + (size_t)NTOK * 8 * 4;
constexpr size_t O_WCNT = O_STOK + al256((size_t)NSLOTS * 4);
constexpr size_t O_ROPE = O_WCNT + (size_t)1024 * 64 * 4;
constexpr size_t O_MODC = O_ROPE + (size_t)(64 * 32 + 64 * 16) * 8;
constexpr size_t O_RW2 = O_MODC + (size_t)NLAYER * 9 * 6 * DM * 4;
constexpr size_t O_KRB = O_RW2 + (size_t)NLAYER * 2 * NEXP * DM * 2;
constexpr size_t O_HID = O_KRB + (size_t)NLAYER * 2 * 512 * 4128 * 2;
constexpr size_t O_A = O_HID + (size_t)NSLOTS * EH * 2;
constexpr size_t O_P = O_A;
constexpr size_t O_QRAW = O_P + (size_t)NTOK * NP * 2;
constexpr size_t O_KVRAW = O_QRAW + (size_t)NTOK * NQP * 2;
constexpr size_t O_QM = O_KVRAW + (size_t)NTOK * 1536 * 2;
constexpr size_t O_QMC = O_QM + (size_t)NB * 6 * SEQ * 192 * 2;
constexpr size_t O_KM = O_QMC + (size_t)NB * 6 * CTXL * 192 * 2;
constexpr size_t O_VM = O_KM + (size_t)NB * 6 * LK * 192 * 2;
constexpr size_t O_QG = O_VM + (size_t)NB * 6 * LK * 128 * 2;
constexpr size_t O_QGC = O_QG + (size_t)NB * 6 * SEQ * 128 * 2;
constexpr size_t O_KG = O_QGC + (size_t)NB * 6 * CTXL * 128 * 2;
constexpr size_t O_VG = O_KG + (size_t)NB * 2 * LK * 128 * 2;
constexpr size_t O_VT = O_VG + (size_t)NB * 2 * LK * 128 * 2;
constexpr size_t O_X1T = O_VT + (size_t)512 * NTOK * 2;
constexpr size_t O_Y2T = O_X1T + (size_t)512 * NTOK * 2;
constexpr size_t O_MIX = O_Y2T + (size_t)512 * NTOK * 2;
constexpr size_t O_OUT = O_MIX + (size_t)NTOK * DM * 2;
constexpr size_t O_AEND = O_OUT + (size_t)NTOK * DM * 2;
constexpr size_t O_DOUT = O_A;
static_assert(O_DOUT + (size_t)NSLOTS * DM * 2 <= O_AEND, "DOUT must fit the mixer scratch region");
constexpr size_t WS_END = O_AEND;

constexpr int CW_BAR = 0;
constexpr int CW_CNT = 4096;
constexpr int CW_CUR = 4096 + 128;
constexpr int CW_Q = 4096 + 256;

constexpr int LDS_BYTES = 148480;
constexpr int LDS_MISC = 147456;
constexpr int LDS_TILES = 131072;
#ifndef CVT_BG
#define CVT_BG (MEGA && MOE_FP8)
#endif
#ifndef WT_STORES
#define WT_STORES 0
#endif
__device__ __forceinline__ void st16_wt(void* p, u32x4 v) { asm volatile("global_store_dwordx4 %0, %1, off sc1\n\ts_nop 1" :: "v"(p), "v"(v) : "memory");     }
constexpr int LDS_BGCUR = LDS_MISC + 768;
constexpr int LDS_BGFLAG = LDS_MISC + 800;
constexpr int LDS_CNTL = LDS_MISC + 512;

struct Params { const float* in[31]; float* out; unsigned char* ws; int layer; int pad; };

enum { I_X = 0, I_C, I_CTX, I_CCTX, I_ADAW, I_ADAB, I_NORMG, I_WIN, I_WOUT, I_HYCONV, I_HYW1, I_HYB1, I_HYW2, I_HYB2, I_HYW3, I_HYFREQ, I_HYSKIP,
       I_MQN, I_MKVN, I_WUQ, I_WUKV, I_GQN, I_GKN, I_RW, I_RB, I_EG, I_EU, I_EDN, I_SG, I_SU, I_SD };

__device__ __forceinline__ int otid() { int t = threadIdx.x; asm volatile("" : "+v"(t)); return t; }
__device__ __forceinline__ int owid() { return __builtin_amdgcn_readfirstlane(otid() >> 6); }
__device__ __forceinline__ float bf2f(bf16_t v) { return __uint_as_float(((unsigned)v) << 16); }
__device__ __forceinline__ bf16_t f2bf(float f) { unsigned u = __float_as_uint(f); u += 0x7FFFu + ((u >> 16) & 1u); return (bf16_t)(u >> 16); }
__device__ __forceinline__ unsigned pk2(float lo, float hi) { unsigned r; asm volatile("v_cvt_pk_bf16_f32 %0, %1, %2" : "=v"(r) : "v"(lo), "v"(hi)); return r; }
__device__ __forceinline__ float wave_sum(float v) {
#pragma unroll
    for (int o = 32; o >= 1; o >>= 1) v += __shfl_xor(v, o);
    return v;
}
__device__ __forceinline__ float rdlane(float v, int l) { return __int_as_float(__builtin_amdgcn_readlane(__float_as_int(v), l)); }
__device__ __forceinline__ float silu_f(float x) { return x / (1.0f + __expf(-x)); }
__device__ __forceinline__ const float* resid_src(const Params& p, int l, int row) {
    if (l == 0) return row < NLAT ? p.in[I_X] + (size_t)row * DM : p.in[I_CTX] + (size_t)(row - NLAT) * DM;
    return (const float*)(p.ws + O_X) + (size_t)row * DM;
}
#ifndef XB16
#define XB16 1
#endif
__device__ __forceinline__ f32x4 ld_xrow(const Params& p, int l, int row, int c) {
    if (l == 0 || !XB16) return *(const f32x4*)(resid_src(p, l, row) + c);
    const u32x2 t = *(const u32x2*)((const bf16_t*)(p.ws + O_X) + (size_t)row * DM + c);
    return (f32x4){__uint_as_float(t.x << 16), __uint_as_float(t.x & 0xffff0000u), __uint_as_float(t.y << 16), __uint_as_float(t.y & 0xffff0000u)};
}
__device__ __forceinline__ void st_xrow(const Params& p, int row, int c, f32x4 v) {
    if (XB16) { u32x2 w; w.x = pk2(v[0], v[1]); w.y = pk2(v[2], v[3]); *(u32x2*)((bf16_t*)(p.ws + O_X) + (size_t)row * DM + c) = w; }
    else *(f32x4*)((float*)(p.ws + O_X) + (size_t)row * DM + c) = v;
}
__device__ __forceinline__ int row_batch(int row) { return row < NLAT ? row >> 11 : 8; }
#ifndef CVT_NT
#define CVT_NT 1
#endif
#ifndef NT2
#define NT2 511
#endif
#if NT2 & 64
#define LDNT(T, ptr) __builtin_nontemporal_load((const T*)(ptr))
#else
#define LDNT(T, ptr) (*(const T*)(ptr))
#endif
#if NT2 & 128
#define LDNT2(T, ptr) __builtin_nontemporal_load((const T*)(ptr))
#else
#define LDNT2(T, ptr) (*(const T*)(ptr))
#endif
#if NT2 & 256
#define STNT(T, ptr, val) __builtin_nontemporal_store((val), (T*)(ptr))
#else
#define STNT(T, ptr, val) (*(T*)(ptr) = (val))
#endif
#if NT2 & 8192
#define LDNT3(T, ptr) __builtin_nontemporal_load((const T*)(ptr))
#else
#define LDNT3(T, ptr) (*(const T*)(ptr))
#endif
#ifndef RC8
#define RC8 1
#endif
#if RC8
#define MCB16 1
#endif
#ifndef MCB16
#define MCB16 0
#endif
__device__ __forceinline__ f32x4 ld_mc(const Params& p, int l, int row, int v, int c) {
    const size_t idx = (size_t)((l * 9 + row_batch(row)) * 6 + v) * DM + c;
    if (!MCB16) return *(const f32x4*)((const float*)(p.ws + O_MODC) + idx);
    const u32x2 t = *(const u32x2*)((const bf16_t*)(p.ws + O_MODC) + idx);
    return (f32x4){__uint_as_float(t.x << 16), __uint_as_float(t.x & 0xffff0000u), __uint_as_float(t.y << 16), __uint_as_float(t.y & 0xffff0000u)};
}
#define ROWCOL(j, lane) ((j) * 256 + (lane) * 4)


struct GUnit { int arow0; const bf16_t* B; int orow0, ocol0; };
struct GemmDesc { const bf16_t* A; int lda; const int* ridx; int ldb; int K; };

__host__ __device__ __forceinline__ int perm32(int rho) { const int n = rho >> 4, i = rho & 15; return 8 * (i >> 2) + 4 * n + (i & 3); }
__host__ __device__ __forceinline__ int perm32b(int rho) { const int n = rho >> 4, i = rho & 15, fq = i >> 2; return 8 * (((fq & 1) << 1) | (fq >> 1)) + 4 * n + (i & 3); }
struct EpiStoreBf16 {
    static constexpr bool PERM = (FAST_GEMM != 0); static constexpr int PERMKIND = 0; static constexpr int NVM = PERM ? 16 : 32;
    bf16_t* O; int ldo;
    __device__ __forceinline__ void operator()(const f32x4 (&acc)[2][2][4][2], const GUnit& u, int wr, int wc, int fr, int fq) const {
#pragma unroll
        for (int ai = 0; ai < 2; ++ai)
#pragma unroll
            for (int m = 0; m < 4; ++m) {
                bf16_t* rowp = O + (size_t)(u.orow0 + ai * 128 + wr * 64 + m * 16 + fr) * ldo + u.ocol0 + wc * 32 + (PERM ? 8 : 4) * fq;
#pragma unroll
                for (int bj = 0; bj < 2; ++bj) {
                    if constexpr (PERM) { const f32x4 v0 = acc[ai][bj][m][0], v1 = acc[ai][bj][m][1]; u32x4 w; w.x = pk2(v0[0], v0[1]); w.y = pk2(v0[2], v0[3]); w.z = pk2(v1[0], v1[1]); w.w = pk2(v1[2], v1[3]); if (WT_STORES & 1) st16_wt(rowp + bj * 128, w); else if (NT2 & 512) __builtin_nontemporal_store(w, (u32x4*)(rowp + bj * 128)); else *(u32x4*)(rowp + bj * 128) = w; }
                    else {
#pragma unroll
                        for (int n = 0; n < 2; ++n) { const f32x4 v = acc[ai][bj][m][n]; u32x2 w; w.x = pk2(v[0], v[1]); w.y = pk2(v[2], v[3]); *(u32x2*)(rowp + bj * 128 + n * 16) = w; } } }
            }
    }
};
struct EpiSwiGLU {
    static constexpr bool PERM = (FAST_GEMM != 0); static constexpr int PERMKIND = 0; static constexpr int NVM = 8;
    bf16_t* O;
    __device__ __forceinline__ void operator()(const f32x4 (&acc)[2][2][4][2], const GUnit& u, int wr, int wc, int fr, int fq) const {
#pragma unroll
        for (int ai = 0; ai < 2; ++ai)
#pragma unroll
            for (int m = 0; m < 4; ++m) {
                bf16_t* rowp = O + (size_t)(u.orow0 + ai * 128 + wr * 64 + m * 16 + fr) * EH + u.ocol0 + wc * 32 + (PERM ? 8 : 4) * fq;
#pragma unroll
                for (int n = 0; n < 2; ++n) { const f32x4 g = acc[ai][0][m][n], up = acc[ai][1][m][n]; float h[4];
#pragma unroll
                    for (int j = 0; j < 4; ++j) h[j] = silu_f(g[j]) * up[j];
                    u32x2 w; w.x = pk2(h[0], h[1]); w.y = pk2(h[2], h[3]); *(u32x2*)(rowp + n * (PERM ? 4 : 16)) = w; }
            }
    }
};

__device__ __forceinline__ float clamp8(float x) { return __builtin_amdgcn_fmed3f(x, -448.0f, 448.0f); }
__device__ __forceinline__ unsigned pk4_fp8(float a, float b, float c, float d) { int r = __builtin_amdgcn_cvt_pk_fp8_f32(clamp8(a), clamp8(b), 0, false); r = __builtin_amdgcn_cvt_pk_fp8_f32(clamp8(c), clamp8(d), r, true); return (unsigned)r; }
constexpr float HID8_SCALE = 8.0f;
constexpr float W8_SCALE = 256.0f;
__device__ __forceinline__ void swap32(unsigned& a, unsigned& b) { auto r = __builtin_amdgcn_permlane32_swap(a, b, false, false); a = r[0]; b = r[1]; }
struct EpiSwiGLU8 {
    static constexpr bool PERM = true; static constexpr int PERMKIND = 1; static constexpr int NVM = 4;
    unsigned char* O;
    __device__ __forceinline__ void operator()(const f32x4 (&acc)[2][2][4][2], const GUnit& u, int wr, int wc, int fr, int fq) const {
        const int hi = fq >> 1, cg = (fq & 1) * 16;
#pragma unroll
        for (int ai = 0; ai < 2; ++ai)
#pragma unroll
            for (int mp = 0; mp < 4; mp += 2) { unsigned w[2][2];
#pragma unroll
                for (int mm = 0; mm < 2; ++mm)
#pragma unroll
                    for (int n = 0; n < 2; ++n) { const f32x4 g = acc[ai][0][mp + mm][n], up = acc[ai][1][mp + mm][n]; float h[4];
#pragma unroll
                        for (int j = 0; j < 4; ++j) h[j] = silu_f(g[j]) * up[j] * HID8_SCALE;
                        w[mm][n] = pk4_fp8(h[0], h[1], h[2], h[3]); }
                swap32(w[0][0], w[1][0]); swap32(w[0][1], w[1][1]);
                const u32x4 o = hi ? (u32x4){w[0][0], w[0][1], w[1][0], w[1][1]} : (u32x4){w[0][0], w[0][1], w[1][0], w[1][1]};
                unsigned char* op_ = O + (size_t)(u.orow0 + ai * 128 + wr * 64 + (mp + hi) * 16 + fr) * EH + u.ocol0 + wc * 32 + cg;
                if (WT_STORES & 1) st16_wt(op_, o); else if (NT2 & 1024) __builtin_nontemporal_store(o, (u32x4*)op_); else *(u32x4*)op_ = o; }
    }
};
struct EpiStoreFp8 {
    static constexpr bool PERM = true; static constexpr int PERMKIND = 1; static constexpr int NVM = 8;
    unsigned char* O; int ldo; float scale;
    __device__ __forceinline__ void operator()(const f32x4 (&acc)[2][2][4][2], const GUnit& u, int wr, int wc, int fr, int fq) const {
        const int hi = fq >> 1, cg = (fq & 1) * 16;
#pragma unroll
        for (int ai = 0; ai < 2; ++ai)
#pragma unroll
            for (int mp = 0; mp < 4; mp += 2)
#pragma unroll
                for (int bj = 0; bj < 2; ++bj) { unsigned w[2][2];
#pragma unroll
                    for (int mm = 0; mm < 2; ++mm) { const f32x4 v0 = acc[ai][bj][mp + mm][0] * scale, v1 = acc[ai][bj][mp + mm][1] * scale; w[mm][0] = pk4_fp8(v0[0], v0[1], v0[2], v0[3]); w[mm][1] = pk4_fp8(v1[0], v1[1], v1[2], v1[3]); }
                    swap32(w[0][0], w[1][0]); swap32(w[0][1], w[1][1]);
                    const u32x4 o = {w[0][0], w[0][1], w[1][0], w[1][1]};
                    unsigned char* op_ = O + (size_t)(u.orow0 + ai * 128 + wr * 64 + (mp + hi) * 16 + fr) * ldo + u.ocol0 + bj * 128 + wc * 32 + cg;
                    if (WT_STORES & 1) st16_wt(op_, o); else if (NT2 & 2048) __builtin_nontemporal_store(o, (u32x4*)op_); else *(u32x4*)op_ = o; }
    }
};

template <class Epi>
__device__ __forceinline__ void gemm_unit_simple(const GemmDesc& g, const GUnit& u, const Epi& E) {
    int tid = otid();
    const int wid = __builtin_amdgcn_readfirstlane(tid >> 6), lane = tid & 63, wr = wid >> 2, wc = wid & 3, fr = lane & 15, fq = lane >> 4;
    f32x4 acc[2][2][4][2];
#pragma unroll
    for (int a = 0; a < 2; ++a)
#pragma unroll
        for (int b = 0; b < 2; ++b)
#pragma unroll
            for (int m = 0; m < 4; ++m)
#pragma unroll
                for (int n = 0; n < 2; ++n) acc[a][b][m][n] = (f32x4){0.f, 0.f, 0.f, 0.f};
    const bf16_t* ap[2][4]; const bf16_t* bp[2][2];
#pragma unroll
    for (int ai = 0; ai < 2; ++ai)
#pragma unroll
        for (int m = 0; m < 4; ++m) { const int r = u.arow0 + ai * 128 + wr * 64 + m * 16 + fr; int src = g.ridx ? g.ridx[r] : r; if (src < 0) src = 0; ap[ai][m] = g.A + (size_t)src * g.lda + 8 * fq; }
#pragma unroll
    for (int bj = 0; bj < 2; ++bj)
#pragma unroll
        for (int n = 0; n < 2; ++n) bp[bj][n] = u.B + (size_t)(bj * 128 + wc * 32 + n * 16 + fr) * g.ldb + 8 * fq;
    int Kq = g.K; asm volatile("" : "+s"(Kq));
#pragma unroll 1
    for (int k0 = 0; k0 < Kq; k0 += 32) {
        bf16x8 a[2][4], b[2][2];
#pragma unroll
        for (int ai = 0; ai < 2; ++ai)
#pragma unroll
            for (int m = 0; m < 4; ++m) a[ai][m] = *(const bf16x8*)(ap[ai][m] + k0);
#pragma unroll
        for (int bj = 0; bj < 2; ++bj)
#pragma unroll
            for (int n = 0; n < 2; ++n) b[bj][n] = *(const bf16x8*)(bp[bj][n] + k0);
#pragma unroll
        for (int ai = 0; ai < 2; ++ai)
#pragma unroll
            for (int bj = 0; bj < 2; ++bj)
#pragma unroll
                for (int m = 0; m < 4; ++m)
#pragma unroll
                    for (int n = 0; n < 2; ++n) acc[ai][bj][m][n] = __builtin_amdgcn_mfma_f32_16x16x32_bf16(b[bj][n], a[ai][m], acc[ai][bj][m][n], 0, 0, 0);
    }
    E(acc, u, wr, wc, fr, fq);
}

struct DenseSched {
    const bf16_t* Bt; int ldb, nM, nN, row0, pn0;
    __device__ __forceinline__ int count() const { return nM * nN; }
    __device__ __forceinline__ int ncol() const { return nN; }
    __device__ __forceinline__ void unit(int i, GUnit& u) const { const int pm = i / nN, pn = pn0 + i % nN; u.arow0 = row0 + pm * 256; u.B = Bt + (size_t)pn * 256 * ldb; u.orow0 = u.arow0; u.ocol0 = pn * 256; }
};
struct MoeSched {
    const LAS int* te; const LAS int* ts; int ntiles, npn; const bf16_t* Bt; size_t estride; int ldb, ocolw;
    __device__ __forceinline__ int count() const { return ntiles * npn; }
    __device__ __forceinline__ int ncol() const { return npn; }
    __device__ __forceinline__ void unit(int i, GUnit& u) const { const int t = i / npn, pn = i % npn; const int e = te[t]; u.arow0 = ts[t]; u.B = Bt + (size_t)e * estride + (size_t)pn * 256 * ldb; u.orow0 = u.arow0; u.ocol0 = pn * ocolw; }
};
template <class Sched, class Epi>
__device__ __forceinline__ void gemm_phase_simple(const GemmDesc& g, const Sched& S, const Epi& E) {
    const int n = S.count();
    for (int i = blockIdx.x; i < n; i += gridDim.x) { GUnit u; S.unit(i, u); gemm_unit_simple(g, u, E); }
}
__device__ __forceinline__ int wave_incl_scan(int v, int lane) {
#pragma unroll
    for (int o = 1; o < 64; o <<= 1) { const int t = __shfl_up(v, o); if (lane >= o) v += t; }
    return v;
}
__device__ __forceinline__ int moe_build_tiles(const unsigned* cnt, int nshared, LAS int* te, LAS int* ts, LAS int* misc) {
    __syncthreads();
    const int tid = otid();
    if (tid < 64) {
        const int c = (int)cnt[tid], ntile = (c + 255) >> 8, incl = wave_incl_scan(ntile, tid), first = incl - ntile;
        for (int j = 0; j < ntile; ++j) { te[first + j] = tid; ts[first + j] = (first + j) * 256; }
        const int nrt = __shfl(incl, 63);
        for (int j = tid; j < nshared; j += 64) { te[nrt + j] = NEXP; ts[nrt + j] = RSLOTS + j * 256; }
        if (tid == 0) misc[0] = nrt + nshared;
    }
    __syncthreads();
    return misc[0];
}
#ifndef FAST_GEMM
#define FAST_GEMM 0
#endif
#if !FAST_GEMM
#define GEMM_PHASE(g, S, E) gemm_phase_simple(g, S, E)
#endif

#if FAST_GEMM
constexpr int HTB = 128 * 64 * 2;
__device__ __forceinline__ int lds_byte(int r, int c) { const int st = (r >> 4) * 2 + (c >> 5), rr = r & 15, cc = c & 31, ob = rr * 64 + cc * 2; return st * 1024 + (ob ^ (((ob >> 9) & 1) << 5)); }
__device__ __forceinline__ void stage_rc(int b, int& R, int& C) { const int st = b / 1024, sb = b % 1024, swz = sb ^ (((sb >> 9) & 1) << 5); R = (st >> 1) * 16 + swz / 64; C = (st & 1) * 32 + (swz % 64) / 2; }

#ifndef KREP_PROBE
#define KREP_PROBE 1
#endif
#ifndef EPI_REP
#define EPI_REP 1
#endif
#ifndef GEMM_EARLY
#define GEMM_EARLY 1
#endif
typedef float f32x2z __attribute__((ext_vector_type(2)));
#ifndef ZERO64
#define ZERO64 1
#endif
__device__ __forceinline__ f32x4 zero4() {
#if ZERO64
    f32x2z a, b; asm("v_mov_b64 %0, 0" : "=v"(a)); asm("v_mov_b64 %0, 0" : "=v"(b)); return (f32x4){a.x, a.y, b.x, b.y};
#else
    return (f32x4){0.f, 0.f, 0.f, 0.f};
#endif
}
template <int N> __device__ __forceinline__ void wait_vm() { asm volatile("s_waitcnt vmcnt(%0)" :: "n"(N) : "memory"); }
typedef int v8i __attribute__((ext_vector_type(8)));
typedef int v4i __attribute__((ext_vector_type(4)));
template <int ESZ, class Sched, class Epi>
__device__ __forceinline__ void gemm_phase_fast(LAS unsigned char* lds, const GemmDesc& g, const Sched& S, const Epi& E, int scA = 127, int scB = 127, int rot = 0, int lo = 0) {
    const int tid = otid(), wid = __builtin_amdgcn_readfirstlane(tid >> 6), lane = tid & 63, wr = wid >> 2, wc = wid & 3, fr = lane & 15, fq = lane >> 4;
    const int K = g.K, nunits = S.count(), G = gridDim.x, c0 = blockIdx.x;
    int nt = K * ESZ / 128; asm volatile("" : "+s"(nt));
    const int krep = (KREP_PROBE > 1 && ESZ == 1 && K == 512) ? KREP_PROBE : 1; scB -= (krep == 2) ? 1 : ((krep == 4) ? 2 : 0);
    const int npn = S.ncol(); const bool xmap = (G % 8 == 0) && ((G / 8) % npn == 0); const int xT = xmap ? (G / 8) / npn : 1, xx = (c0 + rot) % 8, xr = c0 / 8;
#define F_UNIT(ui_) (xmap ? (((ui_) * 8 + xx) * xT + xr / npn) * npn + xr % npn : ((ui_) == 0 ? c0 : (c0 >= lo ? G + ((ui_) - 1) * (G - lo) + (c0 - lo) : nunits)))
    if (F_UNIT(0) >= nunits) return;
    int R[2], C[2]; unsigned voffB[2];
#pragma unroll
    for (int i = 0; i < 2; ++i) { stage_rc(tid * 16 + i * 8192, R[i], C[i]); const int Rb = Epi::PERM ? ((R[i] & ~31) + (Epi::PERMKIND ? perm32b(R[i] & 31) : perm32(R[i] & 31))) : R[i]; voffB[i] = (unsigned)(Rb * g.ldb) * (unsigned)ESZ + (unsigned)C[i] * 2u; }
    const size_t kstep = 128;
    const size_t hstepB = (size_t)128 * g.ldb * ESZ;
    const unsigned ldsw = (unsigned)wid * 1024u;
    const int aoff = lds_byte(wr * 64 + fr, fq * 8), boff = lds_byte(wc * 32 + fr, fq * 8);
    const char* Ab = (const char*)g.A;
#define F_SA(b, h) (((b) * 2 + (h)) * HTB)
#define F_SB(b, h) ((4 + (b) * 2 + (h)) * HTB)
#define F_STAGE(bufoff, gbase, voff) do { _Pragma("unroll") for (int _i = 0; _i < 2; ++_i) \
        __builtin_amdgcn_global_load_lds((const unsigned*)((const char*)(gbase) + (voff)[_i]), (LAS unsigned*)(lds + (bufoff) + ldsw + _i * 8192), 16, 0, 0); } while (0)
#define F_LDA(dst, b, h) do { _Pragma("unroll") for (int m = 0; m < 4; ++m) { if constexpr (ESZ == 2) { _Pragma("unroll") for (int k = 0; k < 2; ++k) dst[m][k] = *(const LAS bf16x8*)(lds + F_SA(b, h) + aoff + m * 2048 + k * 1024); } \
        else { const v4i lo_ = *(const LAS v4i*)(lds + F_SA(b, h) + aoff + m * 2048), hi_ = *(const LAS v4i*)(lds + F_SA(b, h) + aoff + m * 2048 + 1024); dst##8[m] = __builtin_shufflevector(lo_, hi_, 0, 1, 2, 3, 4, 5, 6, 7); } } } while (0)
#define F_LDB(dst, b, h) do { _Pragma("unroll") for (int n = 0; n < 2; ++n) { if constexpr (ESZ == 2) { _Pragma("unroll") for (int k = 0; k < 2; ++k) dst[n][k] = *(const LAS bf16x8*)(lds + F_SB(b, h) + boff + n * 2048 + k * 1024); } \
        else { const v4i lo_ = *(const LAS v4i*)(lds + F_SB(b, h) + boff + n * 2048), hi_ = *(const LAS v4i*)(lds + F_SB(b, h) + boff + n * 2048 + 1024); dst##8[n] = __builtin_shufflevector(lo_, hi_, 0, 1, 2, 3, 4, 5, 6, 7); } } } while (0)
#define F_MMA(ai, bj, At, Bt) do { __builtin_amdgcn_s_setprio(1); _Pragma("unroll") for (int m = 0; m < 4; ++m) _Pragma("unroll") for (int n = 0; n < 2; ++n) { \
        if constexpr (ESZ == 2) { _Pragma("unroll") for (int k = 0; k < 2; ++k) acc[ai][bj][m][n] = __builtin_amdgcn_mfma_f32_16x16x32_bf16(Bt[n][k], At[m][k], acc[ai][bj][m][n], 0, 0, 0); } \
        else acc[ai][bj][m][n] = __builtin_amdgcn_mfma_scale_f32_16x16x128_f8f6f4(Bt##8[n], At##8[m], acc[ai][bj][m][n], 0, 0, 0, scB, 0, scA); } \
        __builtin_amdgcn_s_setprio(0); } while (0)
#define F_WAIT_V(n) asm volatile("s_waitcnt vmcnt(" #n ")" ::: "memory")
#define F_WAIT_L(n) asm volatile("s_waitcnt lgkmcnt(" #n ")" ::: "memory")
#define F_BAR __builtin_amdgcn_s_barrier()
#define F_SCHED __builtin_amdgcn_sched_barrier(0)
#define F_AROWS(u, dst) do { _Pragma("unroll") for (int _h = 0; _h < 2; ++_h) _Pragma("unroll") for (int _i = 0; _i < 2; ++_i) { const int _r = (u).arow0 + _h * 128 + R[_i]; int _s = g.ridx ? g.ridx[_r] : _r; if (_s < 0) _s = 0; dst[_h][_i] = _s; } } while (0)
#define F_AOFFS(src, dst) do { _Pragma("unroll") for (int _h = 0; _h < 2; ++_h) _Pragma("unroll") for (int _i = 0; _i < 2; ++_i) dst[_h][_i] = (unsigned)(src[_h][_i] < 0 ? 0 : src[_h][_i]) * (unsigned)g.lda * (unsigned)ESZ + (unsigned)C[_i] * 2u; } while (0)
#define F_AROWS_ASYNC(u, dst) do { _Pragma("unroll") for (int _h = 0; _h < 2; ++_h) _Pragma("unroll") for (int _i = 0; _i < 2; ++_i) { const int _r = (u).arow0 + _h * 128 + R[_i]; \
        if (g.ridx) { int _v; asm volatile("global_load_dword %0, %1, off" : "=v"(_v) : "v"(g.ridx + _r) : "memory"); dst[_h][_i] = _v; } else dst[_h][_i] = _r; } } while (0)
#define F_AUSE(x) do { _Pragma("unroll") for (int _h = 0; _h < 2; ++_h) _Pragma("unroll") for (int _i = 0; _i < 2; ++_i) asm volatile("" : "+v"(x[_h][_i])); } while (0)
    GUnit cur, nxt; int ui = 0;
    S.unit(F_UNIT(0), cur);
    f32x4 acc[2][2][4][2];
#pragma unroll
    for (int a = 0; a < 2; ++a)
#pragma unroll
        for (int b = 0; b < 2; ++b)
#pragma unroll
            for (int m = 0; m < 4; ++m)
#pragma unroll
                for (int n = 0; n < 2; ++n) acc[a][b][m][n] = (f32x4){0.f, 0.f, 0.f, 0.f};
    bf16x8 At[4][2], B0[2][2], B1[2][2]; v8i At8[4], B08[2], B18[2];
    unsigned voA[2][2]; int rnx[2][2];
    F_AROWS(cur, rnx); F_AOFFS(rnx, voA);
    const char* cB = (const char*)cur.B;
    F_STAGE(F_SB(0, 0), cB, voffB); F_STAGE(F_SA(0, 0), Ab, voA[0]); F_STAGE(F_SB(0, 1), cB + hstepB, voffB); F_STAGE(F_SA(0, 1), Ab, voA[1]);
    if (wr == 1) F_BAR;
    F_WAIT_V(4); F_BAR;
    F_STAGE(F_SB(1, 0), cB + kstep, voffB); F_STAGE(F_SA(1, 0), Ab + kstep, voA[0]); F_STAGE(F_SB(1, 1), cB + hstepB + kstep, voffB);
#if GEMM_EARLY
    F_STAGE(F_SA(1, 1), Ab + kstep, voA[1]); F_WAIT_V(8); F_BAR;
#else
    F_WAIT_V(6); F_BAR;
#endif
    for (;;) {
        const int Ln = F_UNIT(ui + 1); const bool has_next = Ln < nunits;
        if (has_next) { S.unit(Ln, nxt); if (GEMM_EARLY) F_AROWS_ASYNC(nxt, rnx); else F_AROWS(nxt, rnx); }
        const char* nB = has_next ? (const char*)nxt.B : cB;
#pragma unroll 1
        for (int tt = 0; tt < nt * krep; tt += 2) {
            const int t = tt % nt; const bool last = (tt == nt * krep - 2), wrap = (t == nt - 2);
            const char* a1 = Ab + (size_t)(t + 1) * kstep;
            const char* a2 = wrap ? Ab : Ab + (size_t)(t + 2) * kstep; const char* b2 = wrap ? (last ? nB : cB) : cB + (size_t)(t + 2) * kstep;
            const char* a3 = a2 + kstep; const char* b3 = b2 + kstep;
            F_LDB(B0, 0, 0); F_SCHED; F_LDA(At, 0, 0); if (!GEMM_EARLY) F_STAGE(F_SA(1, 1), a1, voA[1]);
            if (last && has_next) { if (GEMM_EARLY) F_AUSE(rnx); F_AOFFS(rnx, voA); }
            F_WAIT_L(8); F_BAR; F_WAIT_L(0); F_MMA(0, 0, At, B0); F_BAR; F_SCHED;
            F_LDB(B1, 0, 1); F_STAGE(F_SB(0, 0), b2, voffB);
            F_BAR; F_WAIT_L(0); F_MMA(0, 1, At, B1); F_BAR;
            F_LDA(At, 0, 1); F_STAGE(F_SA(0, 0), a2, voA[0]);
            F_BAR; F_WAIT_L(0); F_MMA(1, 0, At, B0); F_BAR; F_SCHED;
            F_STAGE(F_SB(0, 1), b2 + hstepB, voffB);
            if (GEMM_EARLY == 1) asm volatile("s_cmp_lg_u32 %0, 0\n\ts_cbranch_scc1 1f\n\ts_cmp_eq_u32 %1, 0\n\ts_cbranch_scc1 1f\n\ts_waitcnt vmcnt(%2)\n\ts_branch 2f\n1:\n\ts_waitcnt vmcnt(6)\n2:" :: "s"(tt), "s"(ui), "n"(6 + Epi::NVM) : "scc", "memory");
            else if (GEMM_EARLY == 2) F_WAIT_V(6);
            else F_WAIT_V(6);
            F_BAR; F_MMA(1, 1, At, B1); F_BAR;
            F_LDB(B0, 1, 0); F_SCHED; F_LDA(At, 1, 0); F_STAGE(F_SA(0, 1), a2, voA[1]);
            F_WAIT_L(8); F_BAR; F_WAIT_L(0); F_MMA(0, 0, At, B0); F_BAR; F_SCHED;
            F_LDB(B1, 1, 1); F_STAGE(F_SB(1, 0), b3, voffB);
            F_BAR; F_WAIT_L(0); F_MMA(0, 1, At, B1); F_BAR;
            F_LDA(At, 1, 1); F_STAGE(F_SA(1, 0), a3, voA[0]);
            F_BAR; F_WAIT_L(0); F_MMA(1, 0, At, B0); F_BAR; F_SCHED;
            F_STAGE(F_SB(1, 1), b3 + hstepB, voffB);
            F_WAIT_V(6); F_BAR; F_MMA(1, 1, At, B1); F_BAR;
            if (GEMM_EARLY) F_STAGE(F_SA(1, 1), a3, voA[1]);
        }
#pragma unroll
        for (int er_ = 0; er_ < EPI_REP; ++er_) E(acc, cur, wr, wc, fr, fq);
        if (!has_next) break;
#pragma unroll
        for (int a = 0; a < 2; ++a)
#pragma unroll
            for (int b = 0; b < 2; ++b)
#pragma unroll
                for (int m = 0; m < 4; ++m)
#pragma unroll
                    for (int n = 0; n < 2; ++n) acc[a][b][m][n] = zero4();
        cur = nxt; cB = nB; ++ui;
    }
    F_WAIT_V(0);
    if (wr == 0) F_BAR;
    F_BAR;
#undef F_UNIT
#undef F_SA
#undef F_SB
#undef F_STAGE
#undef F_LDA
#undef F_LDB
#undef F_MMA
#undef F_WAIT_V
#undef F_WAIT_L
#undef F_BAR
#undef F_SCHED
#undef F_AROWS
#undef F_AROWS_ASYNC
#undef F_AUSE
#undef F_AOFFS
}
#define GEMM_PHASE(g, S, E) gemm_phase_fast<2>(lds, g, S, E)
#define GEMM_PHASE8(g, S, E, sa, sb) gemm_phase_fast<1>(lds, g, S, E, sa, sb)
#ifndef GEMM_ROT
#define GEMM_ROT 1
#endif
#define GEMM_PHASE_R(g, S, E, rot, lo) gemm_phase_fast<2>(lds, g, S, E, 127, 127, GEMM_ROT ? (rot) : 0, GEMM_ROT ? (lo) : 0)
#define GEMM_PHASE8_R(g, S, E, sa, sb, rot) gemm_phase_fast<1>(lds, g, S, E, sa, sb, GEMM_ROT ? (rot) : 0, 0)
#endif

#define SBAR() __builtin_amdgcn_sched_barrier(0)
#ifndef ATT_OPAIR
#define ATT_OPAIR 0
#endif
#ifndef ATT_OSTAGE
#define ATT_OSTAGE 0
#endif
#ifdef ATT_SETPRIO
#define ATT_PRIO(x) __builtin_amdgcn_s_setprio(x)
#else
#define ATT_PRIO(x) do { } while (0)
#endif
__device__ __forceinline__ int crow(int r, int hi) { return (r & 3) + 8 * (r >> 2) + 4 * hi; }
template <int DQK> __device__ __forceinline__ int kaddr(int row, int chunk) {
    const int sw = (DQK == 128) ? (row & 7) : ((row >> 1) & 7);
    return row * (DQK * 2) + ((chunk ^ sw) << 4);
}
__device__ __forceinline__ void partialSM(f32x16& p0, f32x16& p1, float& m_reg, float& mn, float& alpha, float C, float thr) {
    float pmax = p0[0];
#pragma unroll
    for (int r = 1; r < 16; ++r) pmax = fmaxf(pmax, p0[r]);
#pragma unroll
    for (int r = 0; r < 16; ++r) pmax = fmaxf(pmax, p1[r]);
    { auto rr = __builtin_amdgcn_permlane32_swap(__float_as_uint(pmax), __float_as_uint(pmax), false, false);
      pmax = fmaxf(__uint_as_float(rr[0]), __uint_as_float(rr[1])); }
    if (__builtin_expect(__all(pmax - m_reg <= thr), 1)) { mn = m_reg; alpha = 1.f; }
    else { mn = fmaxf(m_reg, pmax); alpha = __builtin_amdgcn_exp2f((m_reg - mn) * C); m_reg = mn; }
    const float mnC = -mn * C;
#pragma unroll
    for (int r = 0; r < 16; ++r) p0[r] = fmaf(p0[r], C, mnC);
#pragma unroll
    for (int r = 0; r < 16; ++r) p1[r] = fmaf(p1[r], C, mnC);
#pragma unroll
    for (int r = 0; r < 16; ++r) p0[r] = __builtin_amdgcn_exp2f(p0[r]);
}
__device__ __forceinline__ void finishSM(f32x16& p0, f32x16& p1, float alpha, float& l_reg, bf16x8& pa0, bf16x8& pa1, bf16x8& pa2, bf16x8& pa3) {
#pragma unroll
    for (int r = 0; r < 16; ++r) p1[r] = __builtin_amdgcn_exp2f(p1[r]);
    float ps = 0;
#pragma unroll
    for (int r = 0; r < 16; ++r) ps += p0[r];
#pragma unroll
    for (int r = 0; r < 16; ++r) ps += p1[r];
    { auto rr = __builtin_amdgcn_permlane32_swap(__float_as_uint(ps), __float_as_uint(ps), false, false);
      ps = __uint_as_float(rr[0]) + __uint_as_float(rr[1]); }
    l_reg = l_reg * alpha + ps;
#define PK4(P, BASE, OUT) do { unsigned a0 = pk2(P[BASE + 0], P[BASE + 1]), a1 = pk2(P[BASE + 2], P[BASE + 3]);   \
    unsigned b0 = pk2(P[BASE + 4], P[BASE + 5]), b1 = pk2(P[BASE + 6], P[BASE + 7]);                              \
    auto r0 = __builtin_amdgcn_permlane32_swap(a0, b0, false, false); auto r1 = __builtin_amdgcn_permlane32_swap(a1, b1, false, false); \
    u32x4 w = {r0[0], r1[0], r0[1], r1[1]}; OUT = *reinterpret_cast<bf16x8*>(&w); } while (0)
    PK4(p0, 0, pa0); PK4(p0, 8, pa1); PK4(p1, 0, pa2); PK4(p1, 8, pa3);
#undef PK4
}
template <int DQK, int QREG> __device__ __forceinline__ void qkt(f32x16& p0, f32x16& p1, const char* Ks, const bf16x8* qr, const bf16_t* Qw, int r32, int hi) {
    p0 = f32x16{}; p1 = f32x16{};
    bf16x8 qx[DQK / 16 - QREG + 1];
#pragma unroll
    for (int d0 = QREG; d0 < DQK / 16; ++d0) qx[d0 - QREG] = *reinterpret_cast<const bf16x8*>(Qw + d0 * 16);
#pragma unroll
    for (int d0 = 0; d0 < DQK / 16; ++d0) { const int ch = 2 * d0 + hi; const bf16x8 qv = (d0 < QREG) ? qr[d0] : qx[d0 < QREG ? 0 : d0 - QREG];
        const bf16x8 b0 = *reinterpret_cast<const bf16x8*>(Ks + kaddr<DQK>(r32, ch));
        const bf16x8 b1 = *reinterpret_cast<const bf16x8*>(Ks + kaddr<DQK>(32 + r32, ch));
        p0 = __builtin_amdgcn_mfma_f32_32x32x16_bf16(b0, qv, p0, 0, 0, 0);
        p1 = __builtin_amdgcn_mfma_f32_32x32x16_bf16(b1, qv, p1, 0, 0, 0); }
}
__device__ __forceinline__ int v_st(int k, int c) { const int kk = (k & ~0xC) | ((k & 4) << 1) | ((k & 8) >> 1); return ((kk >> 3) * 4 + (c >> 5)) * 512 + ((kk & 7) * 32 + (c & 31)) * 2; }
__device__ __forceinline__ int v_rd_base(int lane) { return ((lane & 3) << 3) | (((lane >> 2) & 3) << 6) | (((lane >> 4) & 1) << 5) | (((lane >> 5) & 1) << 8); }
constexpr int v_rd_off(int d0, int ks, int half) { return d0 * 512 + ks * 4096 + half * 2048; }
template <int OFF> __device__ __forceinline__ s16x4 tr_read(int vb) {
    s16x4 r; asm volatile("ds_read_b64_tr_b16 %0, %1 offset:%2" : "=&v"(r) : "v"(vb), "i"(OFF) : "memory"); return r;
}
template <int D0> __device__ __forceinline__ void pv_one(f32x16& od, int vb, bf16x8 pa0, bf16x8 pa1, bf16x8 pa2, bf16x8 pa3) {
    const s16x4 l0 = tr_read<v_rd_off(D0, 0, 0)>(vb), h0 = tr_read<v_rd_off(D0, 0, 1)>(vb), l1 = tr_read<v_rd_off(D0, 1, 0)>(vb), h1 = tr_read<v_rd_off(D0, 1, 1)>(vb);
    const s16x4 l2 = tr_read<v_rd_off(D0, 2, 0)>(vb), h2 = tr_read<v_rd_off(D0, 2, 1)>(vb), l3 = tr_read<v_rd_off(D0, 3, 0)>(vb), h3 = tr_read<v_rd_off(D0, 3, 1)>(vb);
    asm volatile("s_waitcnt lgkmcnt(0)" ::: "memory"); SBAR();
#define PK(L, H) (bf16x8){L[0], L[1], L[2], L[3], H[0], H[1], H[2], H[3]}
    od = __builtin_amdgcn_mfma_f32_32x32x16_bf16(pa0, PK(l0, h0), od, 0, 0, 0);
    od = __builtin_amdgcn_mfma_f32_32x32x16_bf16(pa1, PK(l1, h1), od, 0, 0, 0);
    od = __builtin_amdgcn_mfma_f32_32x32x16_bf16(pa2, PK(l2, h2), od, 0, 0, 0);
    od = __builtin_amdgcn_mfma_f32_32x32x16_bf16(pa3, PK(l3, h3), od, 0, 0, 0);
#undef PK
}
__device__ __forceinline__ void pv_d0(f32x16* o, int vb, bf16x8 pa0, bf16x8 pa1, bf16x8 pa2, bf16x8 pa3) {
    pv_one<0>(o[0], vb, pa0, pa1, pa2, pa3); pv_one<1>(o[1], vb, pa0, pa1, pa2, pa3); pv_one<2>(o[2], vb, pa0, pa1, pa2, pa3); pv_one<3>(o[3], vb, pa0, pa1, pa2, pa3);
}

template <int DQK, int SDEPTH, int QREG = DQK / 16>
__device__ __forceinline__ void attn_body(const bf16_t* __restrict__ Qb, const bf16_t* __restrict__ Kh, const bf16_t* __restrict__ Vh, bf16_t* __restrict__ Ob, int ldo, int nkeys, float scale, char* lds) {
    constexpr int SHM_V = 64 * 128 * 2, SHM_K = 64 * DQK * 2, NKC = DQK / 8, KPT = NKC / 8;
    int tid = otid();
    const int wid = __builtin_amdgcn_readfirstlane(tid >> 6), lane = tid & 63, r32 = lane & 31, hi = lane >> 5;
    char* V_lds = lds; char* K_lds = lds + 2 * SHM_V;
    float* ws = (float*)(lds + 2 * SHM_V + 2 * SHM_K) + wid * 64; float* li_l = ws; float* al_l = ws + 32;
    const float C = scale * 1.4426950408889634f, thr = 8.0f / scale;
    float m_reg = -1e30f, l_reg = 0; f32x16 o[4] = {}; bf16x8 qr[QREG];
    const bf16_t* Qw = Qb + (long)(wid * 32 + r32) * DQK + hi * 8;
#pragma unroll
    for (int d0 = 0; d0 < QREG; ++d0) qr[d0] = *reinterpret_cast<const bf16x8*>(Qw + d0 * 16);
    const int sr = tid >> 4, sc = (tid & 15) * 8, vst0 = v_st(sr, sc), vst1 = v_st(32 + sr, sc);
    int kgo[KPT], klo[KPT];
#pragma unroll
    for (int i = 0; i < KPT; ++i) { const int q = tid + 512 * i, row = q / NKC, ch = q % NKC; kgo[i] = row * DQK + ch * 8; klo[i] = kaddr<DQK>(row, ch); }
    const int vb0 = (int)(uintptr_t)V_lds + v_rd_base(lane);
    struct { bf16x8 vs0, vs1, ks[KPT]; } sr_[SDEPTH ? SDEPTH : 1];
#define SLOAD(i, k0) do { sr_[i].vs0 = *reinterpret_cast<const bf16x8*>(&Vh[(long)((k0) + sr) * 128 + sc]); sr_[i].vs1 = *reinterpret_cast<const bf16x8*>(&Vh[(long)((k0) + 32 + sr) * 128 + sc]); \
    _Pragma("unroll") for (int _q = 0; _q < KPT; ++_q) sr_[i].ks[_q] = *reinterpret_cast<const bf16x8*>(&Kh[(long)(k0) * DQK + kgo[_q]]); } while (0)
#define SWRITE(b, i) do { *(bf16x8*)(V_lds + (b) * SHM_V + vst0) = sr_[i].vs0; *(bf16x8*)(V_lds + (b) * SHM_V + vst1) = sr_[i].vs1; \
    _Pragma("unroll") for (int _q = 0; _q < KPT; ++_q) *(bf16x8*)(K_lds + (b) * SHM_K + klo[_q]) = sr_[i].ks[_q]; } while (0)
#define SWAIT() do { if constexpr (SDEPTH == 2) { if constexpr (KPT == 2) asm volatile("s_waitcnt vmcnt(4)" ::: "memory"); else asm volatile("s_waitcnt vmcnt(5)" ::: "memory"); } \
    else asm volatile("s_waitcnt vmcnt(0)" ::: "memory"); } while (0)
#define RESC(a) do { if (__any((a) < 1.f)) { if (hi == 0) al_l[r32] = (a); asm volatile("s_waitcnt lgkmcnt(0)" ::: "memory"); \
    _Pragma("unroll") for (int d = 0; d < 4; ++d) _Pragma("unroll") for (int r = 0; r < 16; ++r) o[d][r] *= al_l[crow(r, hi)]; } } while (0)
    bf16x8 pa0, pa1, pa2, pa3; const int NT = nkeys / 64;
    if constexpr (SDEPTH == 0) {
        f32x16 pA0, pA1; float mnA, alA;
        SLOAD(0, 0); asm volatile("s_waitcnt vmcnt(0)" ::: "memory"); SWRITE(0, 0); __syncthreads();
        for (int j = 0; j < NT; ++j) {
            const int bo = j & 1;
            if (j + 1 < NT) SLOAD(0, (j + 1) * 64);
            SBAR(); ATT_PRIO(1); qkt<DQK, QREG>(pA0, pA1, K_lds + bo * SHM_K, qr, Qw, r32, hi); ATT_PRIO(0); partialSM(pA0, pA1, m_reg, mnA, alA, C, thr);
            RESC(alA); finishSM(pA0, pA1, alA, l_reg, pa0, pa1, pa2, pa3); SBAR();
            ATT_PRIO(1); pv_d0(o, vb0 + bo * SHM_V, pa0, pa1, pa2, pa3); ATT_PRIO(0);
            if (j + 1 < NT) { asm volatile("s_waitcnt vmcnt(0)" ::: "memory"); SWRITE(bo ^ 1, 0); }
            __syncthreads();
        }
    } else {
    f32x16 pA0, pA1, pB0, pB1; float mnA, mnB, alA, alB;
    constexpr int SE = 0, SO = SDEPTH - 1;
    SLOAD(SE, 0); asm volatile("s_waitcnt vmcnt(0)" ::: "memory"); SWRITE(0, SE); __syncthreads();
    qkt<DQK, QREG>(pA0, pA1, K_lds, qr, Qw, r32, hi); partialSM(pA0, pA1, m_reg, mnA, alA, C, thr);
    SLOAD(SO, 64); if constexpr (SDEPTH == 2) { if (2 < NT) SLOAD(SE, 2 * 64); }
    SWAIT(); SWRITE(1, SO); __syncthreads();
    for (int j = 1; j + 1 < NT; j += 2) {
        SBAR(); qkt<DQK, QREG>(pB0, pB1, K_lds + SHM_K, qr, Qw, r32, hi);
        finishSM(pA0, pA1, alA, l_reg, pa0, pa1, pa2, pa3); SBAR();
        SLOAD(SO, (j + SDEPTH) * 64); SBAR();
        pv_d0(o, vb0, pa0, pa1, pa2, pa3); partialSM(pB0, pB1, m_reg, mnB, alB, C, thr);
        __syncthreads(); SWAIT(); SWRITE(0, SE);
        RESC(alB); __syncthreads();
        SBAR(); qkt<DQK, QREG>(pA0, pA1, K_lds, qr, Qw, r32, hi);
        finishSM(pB0, pB1, alB, l_reg, pa0, pa1, pa2, pa3); SBAR();
        if (SDEPTH == 1 || j + 3 < NT) SLOAD(SE, (j + 1 + SDEPTH) * 64); SBAR();
        pv_d0(o, vb0 + SHM_V, pa0, pa1, pa2, pa3); partialSM(pA0, pA1, m_reg, mnA, alA, C, thr);
        __syncthreads(); SWAIT(); SWRITE(1, SO);
        RESC(alA); __syncthreads();
    }
    SBAR(); qkt<DQK, QREG>(pB0, pB1, K_lds + SHM_K, qr, Qw, r32, hi);
    finishSM(pA0, pA1, alA, l_reg, pa0, pa1, pa2, pa3); SBAR();
    pv_d0(o, vb0, pa0, pa1, pa2, pa3); partialSM(pB0, pB1, m_reg, mnB, alB, C, thr);
    __syncthreads(); RESC(alB);
    finishSM(pB0, pB1, alB, l_reg, pa0, pa1, pa2, pa3); SBAR();
    pv_d0(o, vb0 + SHM_V, pa0, pa1, pa2, pa3);
    }
    if (hi == 0) li_l[r32] = l_reg; asm volatile("s_waitcnt lgkmcnt(0)" ::: "memory");
    float rli[16];
#pragma unroll
    for (int r = 0; r < 16; ++r) rli[r] = __builtin_amdgcn_rcpf(li_l[crow(r, hi)]);
    bf16_t* Ow = Ob + (long)(wid * 32) * ldo;
#if ATT_OSTAGE && !WOUT8
    __syncthreads();
    { char* og = lds + wid * (32 * 272);
#pragma unroll
      for (int d0 = 0; d0 < 4; ++d0)
#pragma unroll
          for (int r = 0; r < 16; r += 2) { const float v0 = o[d0][r] * rli[r], v1 = o[d0][r + 1] * rli[r + 1];
              const float snd = (lane & 1) ? v0 : v1; const float rcv = __int_as_float(__builtin_amdgcn_update_dpp(0, __float_as_int(snd), 0xB1, 0xF, 0xF, true));
              const unsigned w = (lane & 1) ? pk2(rcv, v1) : pk2(v0, rcv); const int row = crow(r, hi) + (lane & 1);
              *(unsigned*)(og + row * 272 + (d0 * 32 + (r32 & ~1)) * 2) = w; }
      asm volatile("s_waitcnt lgkmcnt(0)" ::: "memory");
#pragma unroll
      for (int i = 0; i < 8; ++i) { const int q = lane + 64 * i, row = q >> 4, cc = q & 15; *(u32x4*)(Ow + (long)row * ldo + cc * 8) = *(const u32x4*)(og + row * 272 + cc * 16); } }
#elif ATT_OPAIR && !WOUT8
#pragma unroll
    for (int d0 = 0; d0 < 4; ++d0)
#pragma unroll
        for (int r = 0; r < 16; r += 2) { const float v0 = o[d0][r] * rli[r], v1 = o[d0][r + 1] * rli[r + 1];
            const float snd = (lane & 1) ? v0 : v1; const float rcv = __int_as_float(__builtin_amdgcn_update_dpp(0, __float_as_int(snd), 0xB1, 0xF, 0xF, true));
            const unsigned w = (lane & 1) ? pk2(rcv, v1) : pk2(v0, rcv);
            *(unsigned*)(Ow + (long)(crow(r, hi) + (lane & 1)) * ldo + d0 * 32 + (r32 & ~1)) = w; }
#else
#pragma unroll
    for (int r = 0; r < 16; ++r) { const int orow = crow(r, hi);
#pragma unroll
        for (int d0 = 0; d0 < 4; ++d0) {
#if WOUT8
            ((unsigned char*)Ob)[(long)(wid * 32 + orow) * ldo + d0 * 32 + r32] = (unsigned char)(pk4_fp8(o[d0][r] * rli[r] * MIX8_SCALE, 0.f, 0.f, 0.f) & 0xffu);
#else
            Ow[(long)orow * ldo + d0 * 32 + r32] = f2bf(o[d0][r] * rli[r]);
#endif
        } }
#endif
    __syncthreads();
#undef SLOAD
#undef SWRITE
#undef SWAIT
#undef RESC
}

#ifndef ATT_DMA
#define ATT_DMA 3
#endif
#if ATT_DMA
template <int DQK>
__device__ __forceinline__ void attn_body_dma(const bf16_t* __restrict__ Qb, const bf16_t* __restrict__ Kh, const bf16_t* __restrict__ Vh, bf16_t* __restrict__ Ob, int ldo, int nkeys, float scale, LAS unsigned char* ldsL) {
    constexpr int SHM_V = 64 * 128 * 2, SHM_K = 64 * DQK * 2, TILE = SHM_K + SHM_V, NKC = DQK / 8, KPT = NKC / 8;
    const int tid = otid(), wid = __builtin_amdgcn_readfirstlane(tid >> 6), lane = tid & 63, r32 = lane & 31, hi = lane >> 5;
    char* lds = (char*)ldsL;
    float* ws = (float*)(lds + 3 * TILE) + wid * 64; float* li_l = ws; float* al_l = ws + 32;
    const float C = scale * 1.4426950408889634f, thr = 8.0f / scale;
    float m_reg = -1e30f, l_reg = 0; f32x16 o[4] = {}; bf16x8 qr[DQK / 16];
    const bf16_t* Qw = Qb + (long)(wid * 32 + r32) * DQK + hi * 8;
#pragma unroll
    for (int d0 = 0; d0 < DQK / 16; ++d0) qr[d0] = LDNT3(bf16x8, Qw + d0 * 16);
    unsigned kgo[KPT], vgo[2];
#pragma unroll
    for (int i = 0; i < KPT; ++i) { const int q = i * 512 + tid, row = q / NKC, cp = q % NKC, sw = (DQK == 128) ? (row & 7) : ((row >> 1) & 7); kgo[i] = (unsigned)(row * DQK + ((cp ^ sw) << 3)) * 2u; }
#pragma unroll
    for (int i = 0; i < 2; ++i) { const int q = i * 512 + tid, st = q >> 5, w16 = q & 31, kk = (st >> 2) * 8 + (w16 >> 2), k = (kk & ~0xC) | ((kk & 4) << 1) | ((kk & 8) >> 1), c = (st & 3) * 32 + (w16 & 3) * 8; vgo[i] = (unsigned)(k * 128 + c) * 2u; }
    const int ldsb = (int)(uintptr_t)ldsL;
    const int vrb = v_rd_base(lane);
#define D_TILE(t, boff) do { const char* kp_ = (const char*)(Kh + (size_t)(t) * 64 * DQK); const char* vp_ = (const char*)(Vh + (size_t)(t) * 64 * 128); \
        _Pragma("unroll") for (int i_ = 0; i_ < KPT; ++i_) __builtin_amdgcn_global_load_lds((const unsigned*)(kp_ + kgo[i_]), (LAS unsigned*)(ldsL + (boff) + i_ * 8192 + wid * 1024), 16, 0, 0); \
        _Pragma("unroll") for (int i_ = 0; i_ < 2; ++i_) __builtin_amdgcn_global_load_lds((const unsigned*)(vp_ + vgo[i_]), (LAS unsigned*)(ldsL + (boff) + SHM_K + i_ * 8192 + wid * 1024), 16, 0, 0); } while (0)
#define D_WAIT1() do { if constexpr (KPT == 2) asm volatile("s_waitcnt vmcnt(4)" ::: "memory"); else asm volatile("s_waitcnt vmcnt(5)" ::: "memory"); } while (0)
#define D_WAIT2() do { if constexpr (KPT == 2) asm volatile("s_waitcnt vmcnt(8)" ::: "memory"); else asm volatile("s_waitcnt vmcnt(10)" ::: "memory"); } while (0)
#define D_WAIT0() asm volatile("s_waitcnt vmcnt(0)" ::: "memory")
#define D_BAR() do { asm volatile("s_waitcnt lgkmcnt(0)" ::: "memory"); __builtin_amdgcn_s_barrier(); asm volatile("" ::: "memory"); } while (0)
#define D_RESC(a) do { if (__any((a) < 1.f)) { if (hi == 0) al_l[r32] = (a); asm volatile("s_waitcnt lgkmcnt(0)" ::: "memory"); \
    _Pragma("unroll") for (int d = 0; d < 4; ++d) _Pragma("unroll") for (int r = 0; r < 16; ++r) o[d][r] *= al_l[crow(r, hi)]; } } while (0)
#define D_HALF(j, PC0, PC1, mnC, alC, PP0, PP1, alP, lastwait) do { \
        if (lastwait) D_WAIT0(); else D_WAIT1(); D_BAR(); \
        SBAR(); qkt<DQK, DQK / 16>(PC0, PC1, lds + o1, qr, Qw, r32, hi); \
        finishSM(PP0, PP1, alP, l_reg, pa0, pa1, pa2, pa3); SBAR(); \
        pv_d0(o, ldsb + o0 + SHM_K + vrb, pa0, pa1, pa2, pa3); partialSM(PC0, PC1, m_reg, mnC, alC, C, thr); \
        D_BAR(); \
        if ((j) + 2 < NT) D_TILE((j) + 2, o0); \
        D_RESC(alC); \
        { const int t_ = o0; o0 = o1; o1 = o2; o2 = t_; } } while (0)
    f32x16 pA0, pA1, pB0, pB1; float mnA, mnB, alA, alB; bf16x8 pa0, pa1, pa2, pa3; const int NT = nkeys / 64;
    int o0 = 0, o1 = TILE, o2 = 2 * TILE;
    D_TILE(0, 0); D_TILE(1, TILE); D_TILE(2, 2 * TILE);
    D_WAIT2(); D_BAR();
    qkt<DQK, DQK / 16>(pA0, pA1, lds, qr, Qw, r32, hi); partialSM(pA0, pA1, m_reg, mnA, alA, C, thr);
    for (int j = 1; j + 1 < NT; j += 2) {
        D_HALF(j, pB0, pB1, mnB, alB, pA0, pA1, alA, false);
        D_HALF(j + 1, pA0, pA1, mnA, alA, pB0, pB1, alB, false);
    }
    D_HALF(NT - 1, pB0, pB1, mnB, alB, pA0, pA1, alA, true);
    finishSM(pB0, pB1, alB, l_reg, pa0, pa1, pa2, pa3); SBAR();
    pv_d0(o, ldsb + o0 + SHM_K + vrb, pa0, pa1, pa2, pa3);
    if (hi == 0) li_l[r32] = l_reg; asm volatile("s_waitcnt lgkmcnt(0)" ::: "memory");
    float rli[16];
#pragma unroll
    for (int r = 0; r < 16; ++r) rli[r] = __builtin_amdgcn_rcpf(li_l[crow(r, hi)]);
    bf16_t* Ow = Ob + (long)(wid * 32) * ldo;
#pragma unroll
    for (int r = 0; r < 16; ++r) { const int orow = crow(r, hi);
#pragma unroll
        for (int d0 = 0; d0 < 4; ++d0) { if (NT2 & 4096) __builtin_nontemporal_store(f2bf(o[d0][r] * rli[r]), &Ow[(long)orow * ldo + d0 * 32 + r32]); else Ow[(long)orow * ldo + d0 * 32 + r32] = f2bf(o[d0][r] * rli[r]); } }
    D_BAR();
#undef D_TILE
#undef D_WAIT1
#undef D_WAIT2
#undef D_WAIT0
#undef D_BAR
#undef D_RESC
#undef D_HALF
}
#endif

struct CvtMat { const float* src; bf16_t* dst; const float* kscale; int N, lddst, nb, mode; };
__device__ __forceinline__ void cvt_block(const CvtMat& m, int kb, int nbk, int lane) {
    const int a = lane & 7, ng = lane >> 3, k0 = kb * 64 + 8 * a, n0 = nbk * 32 + 4 * ng;
    const float* s = m.src + (size_t)k0 * m.N + n0;
    f32x4 v[8];
#pragma unroll
    for (int j = 0; j < 8; ++j) v[j] = (NT2 & 2) ? __builtin_nontemporal_load((const f32x4*)(s + (size_t)j * m.N)) : *(const f32x4*)(s + (size_t)j * m.N);
    if (m.kscale) {
#pragma unroll
        for (int j = 0; j < 8; ++j) v[j] *= m.kscale[k0 + j];
    }
#pragma unroll
    for (int i = 0; i < 4; ++i) { const int n = n0 + i, row = (m.mode == 0) ? n : ((n >> 7) * 256 + (n & 127) + (m.mode - 1) * 128);
        u32x4 w; w.x = pk2(v[0][i], v[1][i]); w.y = pk2(v[2][i], v[3][i]); w.z = pk2(v[4][i], v[5][i]); w.w = pk2(v[6][i], v[7][i]);
        *(u32x4*)(m.dst + (size_t)row * m.lddst + k0) = w; }
}
__device__ __forceinline__ void cvt_block8(const CvtMat& m, unsigned char* dst8, int kb, int nbk, int lane) {
    const int a = lane & 7, ng = lane >> 3, k0 = kb * 64 + 8 * a, n0 = nbk * 32 + 4 * ng;
    const float* s = m.src + (size_t)k0 * m.N + n0;
    f32x4 v[8];
#pragma unroll
    for (int j = 0; j < 8; ++j) v[j] = (CVT_NT ? __builtin_nontemporal_load((const f32x4*)(s + (size_t)j * m.N)) : *(const f32x4*)(s + (size_t)j * m.N)) * W8_SCALE;
#if WT_STORES & 2
    u32x2 w[4];
#pragma unroll
    for (int i = 0; i < 4; ++i) { w[i].x = pk4_fp8(v[0][i], v[1][i], v[2][i], v[3][i]); w[i].y = pk4_fp8(v[4][i], v[5][i], v[6][i], v[7][i]); }
    const bool odd = (a & 1) != 0;
    const u32x2 s0 = odd ? w[0] : w[2], s1 = odd ? w[1] : w[3]; u32x2 r0, r1;
    r0.x = (unsigned)__builtin_amdgcn_update_dpp(0, (int)s0.x, 0xB1, 0xF, 0xF, false); r0.y = (unsigned)__builtin_amdgcn_update_dpp(0, (int)s0.y, 0xB1, 0xF, 0xF, false);
    r1.x = (unsigned)__builtin_amdgcn_update_dpp(0, (int)s1.x, 0xB1, 0xF, 0xF, false); r1.y = (unsigned)__builtin_amdgcn_update_dpp(0, (int)s1.y, 0xB1, 0xF, 0xF, false);
    const u32x4 oA = odd ? (u32x4){r0.x, r0.y, w[2].x, w[2].y} : (u32x4){w[0].x, w[0].y, r0.x, r0.y}, oB = odd ? (u32x4){r1.x, r1.y, w[3].x, w[3].y} : (u32x4){w[1].x, w[1].y, r1.x, r1.y};
    const int kbase = k0 - (odd ? 8 : 0);
#pragma unroll
    for (int ii = 0; ii < 2; ++ii) { const int n = n0 + (odd ? 2 : 0) + ii, row = (m.mode == 0) ? n : ((n >> 7) * 256 + (n & 127) + (m.mode - 1) * 128);
        st16_wt(dst8 + (size_t)row * m.lddst + kbase, ii ? oB : oA); }
#else
#pragma unroll
    for (int i = 0; i < 4; ++i) { const int n = n0 + i, row = (m.mode == 0) ? n : ((n >> 7) * 256 + (n & 127) + (m.mode - 1) * 128);
        u32x2 w; w.x = pk4_fp8(v[0][i], v[1][i], v[2][i], v[3][i]); w.y = pk4_fp8(v[4][i], v[5][i], v[6][i], v[7][i]);
        if (NT2 & 8) __builtin_nontemporal_store(w, (u32x2*)(dst8 + (size_t)row * m.lddst + k0)); else *(u32x2*)(dst8 + (size_t)row * m.lddst + k0) = w; }
#endif
}
constexpr int CVT_SMALL = 3904 + 2048 + 432 + 192;
__device__ __forceinline__ void cvt_small_task(const Params& p, int l, int t, int lane) {
    unsigned char* ws = p.ws; CvtMat m; int which_ = 3;
    if (t < 3904) { which_ = 0; m = CvtMat{p.in[I_WIN] + (size_t)l * DM * IN_COLS, (bf16_t*)(ws + O_WIN) + (size_t)l * NP * DM, nullptr, IN_COLS, DM, 122, 0}; }
    else if ((t -= 3904) < 2048) { which_ = 1; m = CvtMat{p.in[I_WOUT] + (size_t)l * DM * DM, (bf16_t*)(ws + O_WOUT) + (size_t)l * DM * DM, nullptr, DM, DM, 64, 0}; }
    else if ((t -= 2048) < 432) { m = CvtMat{p.in[I_WUQ] + (size_t)l * 768 * 1152, (bf16_t*)(ws + O_WUQ) + (size_t)l * NQP * 768, p.in[I_MQN] + l * 768, 1152, 768, 36, 0}; }
    else { t -= 432; m = CvtMat{p.in[I_WUKV] + (size_t)l * 256 * 1536, (bf16_t*)(ws + O_WUKV) + (size_t)l * 1536 * 256, p.in[I_MKVN] + l * 256, 1536, 256, 48, 0}; }
    if (WIN8 && which_ == 0) cvt_block8(m, p.ws + O_WIN + (size_t)l * NP * DM, t / m.nb, t % m.nb, lane);
    else if (WOUT8 && which_ == 1) cvt_block8(m, p.ws + O_WOUT + (size_t)l * DM * DM, t / m.nb, t % m.nb, lane);
    else cvt_block(m, t / m.nb, t % m.nb, lane);
}
constexpr int CVT_EXP = 65 * 1536;
__device__ __forceinline__ void cvt_exp_blk(const Params& p, int l, int e, int which, int q, int lane);
__device__ __forceinline__ void cvt_exp_task(const Params& p, int l, int t, int lane) { const int e = t / 1536, r = t % 1536; cvt_exp_blk(p, l, e, r >> 9, r & 511, lane); }
constexpr int CVT_GU = 65 * 1024;
__device__ __forceinline__ void cvt_exp_task_bg(const Params& p, int l, int t, int lane) {
    if (t < CVT_GU) { const int r = t & 1023; cvt_exp_blk(p, l, t >> 10, r >> 9, r & 511, lane); } else { t -= CVT_GU; cvt_exp_blk(p, l, t >> 9, 2, t & 511, lane); }
}
__device__ __forceinline__ void cvt_exp_blk(const Params& p, int l, int e, int which, int q, int lane) {
    unsigned char* ws = p.ws; CvtMat m;
    if (which < 2) {
        const float* src = (e < NEXP) ? p.in[which == 0 ? I_EG : I_EU] + ((size_t)l * NEXP + e) * DM * EH : p.in[which == 0 ? I_SG : I_SU] + (size_t)l * DM * EH;
        m = CvtMat{src, (bf16_t*)(ws + O_EGU) + (size_t)e * 1024 * 2048, nullptr, EH, DM, 16, 1 + which};
    } else {
        const float* src = (e < NEXP) ? p.in[I_EDN] + ((size_t)l * NEXP + e) * EH * DM : p.in[I_SD] + (size_t)l * EH * DM;
        m = CvtMat{src, (bf16_t*)(ws + O_ED) + (size_t)e * 2048 * 512, nullptr, DM, EH, 64, 0};
    }
#if MOE_FP8
    const int lb = CVT_BG ? l : 0;
    cvt_block8(m, which < 2 ? p.ws + O_EGU + ((size_t)lb * 65 + e) * 1024 * 2048 : p.ws + O_ED + ((size_t)lb * 65 + e) * 2048 * 512, q / m.nb, q % m.nb, lane);
#else
    cvt_block(m, q / m.nb, q % m.nb, lane);
#endif
}
#if MOE_FP8 && defined(CVT_TWO)
struct CvtJob { const float* s; unsigned char* d; int N, lddst, mode, k0, n0; };
__device__ __forceinline__ CvtJob cvt_exp_job(const Params& p, int l, int t, int lane) {
    const int e = t / 1536, r = t % 1536, which = r >> 9, q = r & 511, a = lane & 7, ng = lane >> 3; CvtJob j;
    if (which < 2) { j.s = (e < NEXP) ? p.in[which == 0 ? I_EG : I_EU] + ((size_t)l * NEXP + e) * DM * EH : p.in[which == 0 ? I_SG : I_SU] + (size_t)l * DM * EH;
        j.d = p.ws + O_EGU + (size_t)e * 1024 * 2048; j.N = EH; j.lddst = DM; j.mode = 1 + which; j.k0 = (q / 16) * 64 + 8 * a; j.n0 = (q % 16) * 32 + 4 * ng; }
    else { j.s = (e < NEXP) ? p.in[I_EDN] + ((size_t)l * NEXP + e) * EH * DM : p.in[I_SD] + (size_t)l * EH * DM;
        j.d = p.ws + O_ED + (size_t)e * 2048 * 512; j.N = DM; j.lddst = EH; j.mode = 0; j.k0 = (q / 64) * 64 + 8 * a; j.n0 = (q % 64) * 32 + 4 * ng; }
    return j;
}
__device__ __forceinline__ void cvt_job_load(const CvtJob& j, f32x4 (&v)[8]) {
    const float* s = j.s + (size_t)j.k0 * j.N + j.n0;
#pragma unroll
    for (int q = 0; q < 8; ++q) v[q] = *(const f32x4*)(s + (size_t)q * j.N);
}
__device__ __forceinline__ void cvt_job_store(const CvtJob& j, const f32x4 (&v)[8]) {
#pragma unroll
    for (int i = 0; i < 4; ++i) { const int n = j.n0 + i, row = (j.mode == 0) ? n : ((n >> 7) * 256 + (n & 127) + (j.mode - 1) * 128);
        u32x2 w; w.x = pk4_fp8(v[0][i] * W8_SCALE, v[1][i] * W8_SCALE, v[2][i] * W8_SCALE, v[3][i] * W8_SCALE); w.y = pk4_fp8(v[4][i] * W8_SCALE, v[5][i] * W8_SCALE, v[6][i] * W8_SCALE, v[7][i] * W8_SCALE);
        *(u32x2*)(j.d + (size_t)row * j.lddst + j.k0) = w; }
}
__device__ __forceinline__ void cvt_exp_all(const Params& p, int l) {
    const int lane = otid() & 63, gw = blockIdx.x * 8 + owid(), GW = gridDim.x * 8;
    for (int t = gw; t < CVT_EXP; t += 2 * GW) { const bool two = (t + GW) < CVT_EXP;
        const CvtJob j0 = cvt_exp_job(p, l, t, lane), j1 = cvt_exp_job(p, l, two ? t + GW : t, lane); f32x4 v0[8], v1[8];
        cvt_job_load(j0, v0); cvt_job_load(j1, v1);
        cvt_job_store(j0, v0); if (two) cvt_job_store(j1, v1); }
}
#else
__device__ __forceinline__ void cvt_exp_all(const Params& p, int l) {
    const int lane = otid() & 63, gw = blockIdx.x * 8 + owid(), GW = gridDim.x * 8;
    for (int t = gw; t < CVT_EXP; t += GW) cvt_exp_task(p, l, t, lane);
}
#endif
#if CVT_BG
#ifndef BG_DRAIN_REP
#define BG_DRAIN_REP 1
#endif
__device__ __forceinline__ bool cvt_bg_step(LAS unsigned char* lds, int limit, int rep = 1) {
    const int wid = owid(), lane = otid() & 63;
    volatile LAS int* cur = (volatile LAS int*)(lds + LDS_BGCUR);
    const int k = __builtin_amdgcn_readfirstlane(cur[wid]);
    const int T = (blockIdx.x * 8 + wid) + k * (int)(gridDim.x * 8);
    if (T >= limit) return false;
    if (lane == 0) cur[wid] = k + 1;
    const __attribute__((address_space(4))) Params* kp = (const __attribute__((address_space(4))) Params*)__builtin_amdgcn_kernarg_segment_ptr(); asm volatile("" : "+s"(kp));
    Params p;
#pragma unroll
    for (int i_ = 0; i_ < 31; ++i_) p.in[i_] = kp->in[i_];
    p.out = kp->out; p.ws = kp->ws; p.layer = 0; p.pad = 0;
    const int l = (T >= CVT_EXP) ? 1 : 0;
    for (int r_ = 0; r_ < rep; ++r_) cvt_exp_task_bg(p, l, T - l * CVT_EXP, lane);
    return true;
}
#ifndef BG_TWO
#define BG_TWO 0
#endif
struct BgJob { const float* s; unsigned char* d; int lddst, mode, n0; size_t N; };
__device__ __forceinline__ BgJob cvt_bg_decode(const Params& p, int T, int lane) {
    const int l = (T >= CVT_EXP) ? 1 : 0; int t = T - l * CVT_EXP, e, which, q, nb; const int a = lane & 7, ng = lane >> 3; BgJob j; const float* src; unsigned char* dst;
    if (t < CVT_GU) { const int r = t & 1023; e = t >> 10; which = r >> 9; q = r & 511; } else { t -= CVT_GU; e = t >> 9; which = 2; q = t & 511; }
    if (which < 2) { src = (e < NEXP) ? p.in[which == 0 ? I_EG : I_EU] + ((size_t)l * NEXP + e) * DM * EH : p.in[which == 0 ? I_SG : I_SU] + (size_t)l * DM * EH;
        dst = p.ws + O_EGU + ((size_t)l * 65 + e) * 1024 * 2048; j.N = EH; j.lddst = DM; j.mode = 1 + which; nb = 16; }
    else { src = (e < NEXP) ? p.in[I_EDN] + ((size_t)l * NEXP + e) * EH * DM : p.in[I_SD] + (size_t)l * EH * DM;
        dst = p.ws + O_ED + ((size_t)l * 65 + e) * 2048 * 512; j.N = DM; j.lddst = EH; j.mode = 0; nb = 64; }
    const int k0 = (q / nb) * 64 + 8 * a; j.n0 = (q % nb) * 32 + 4 * ng; j.s = src + (size_t)k0 * j.N + j.n0; j.d = dst + k0;
    return j;
}
__device__ __forceinline__ void cvt_bg_store(const BgJob& j, const f32x4 (&v)[8]) {
#pragma unroll
    for (int i = 0; i < 4; ++i) { const int n = j.n0 + i, row = (j.mode == 0) ? n : ((n >> 7) * 256 + (n & 127) + (j.mode - 1) * 128);
        u32x2 w; w.x = pk4_fp8(v[0][i] * W8_SCALE, v[1][i] * W8_SCALE, v[2][i] * W8_SCALE, v[3][i] * W8_SCALE); w.y = pk4_fp8(v[4][i] * W8_SCALE, v[5][i] * W8_SCALE, v[6][i] * W8_SCALE, v[7][i] * W8_SCALE);
        *(u32x2*)(j.d + (size_t)row * j.lddst) = w; }
}
__device__ __forceinline__ bool cvt_bg_step2(LAS unsigned char* lds, int limit) {
    const int wid = owid(), lane = otid() & 63, GW = (int)(gridDim.x * 8);
    volatile LAS int* cur = (volatile LAS int*)(lds + LDS_BGCUR);
    const int k = __builtin_amdgcn_readfirstlane(cur[wid]);
    const int T0 = (blockIdx.x * 8 + wid) + k * GW, T1 = T0 + GW;
    if (T0 >= limit) return false;
    const bool two = T1 < limit;
    if (lane == 0) cur[wid] = k + (two ? 2 : 1);
    const __attribute__((address_space(4))) Params* kp = (const __attribute__((address_space(4))) Params*)__builtin_amdgcn_kernarg_segment_ptr(); asm volatile("" : "+s"(kp));
    Params p;
#pragma unroll
    for (int i_ = 0; i_ < 31; ++i_) p.in[i_] = kp->in[i_];
    p.out = kp->out; p.ws = kp->ws; p.layer = 0; p.pad = 0;
    const BgJob j0 = cvt_bg_decode(p, T0, lane), j1 = cvt_bg_decode(p, two ? T1 : T0, lane); f32x4 v0[8], v1[8];
#pragma unroll
    for (int q = 0; q < 8; ++q) v0[q] = *(const f32x4*)(j0.s + (size_t)q * j0.N);
#pragma unroll
    for (int q = 0; q < 8; ++q) v1[q] = *(const f32x4*)(j1.s + (size_t)q * j1.N);
    cvt_bg_store(j0, v0); if (two) cvt_bg_store(j1, v1);
    return true;
}
#endif
__device__ __forceinline__ void adaln_tasks(const Params& p, LAS float* lf) {
    const int lane = otid() & 63, wid = owid();
    float* MOD = (float*)(p.ws + O_MOD);
    for (int task = blockIdx.x; task < 384; task += gridDim.x) {
        const int cb = task % 192, l = task / 192, col = cb * 64 + lane;
        const float* W = p.in[I_ADAW] + (size_t)l * DM * 12288 + col;
        float acc[9];
#pragma unroll
        for (int r = 0; r < 9; ++r) acc[r] = 0.f;
        for (int kb = wid * 256; kb < wid * 256 + 256; kb += 64) {
            float sv[9];
#pragma unroll
            for (int r = 0; r < 8; ++r) sv[r] = silu_f(p.in[I_C][r * DM + kb + lane]);
            sv[8] = silu_f(p.in[I_CCTX][kb + lane]);
#pragma unroll 8
            for (int kk = 0; kk < 64; ++kk) { const float w = (NT2 & 1) ? __builtin_nontemporal_load(W + (size_t)(kb + kk) * 12288) : W[(size_t)(kb + kk) * 12288];
#pragma unroll
                for (int r = 0; r < 9; ++r) acc[r] += rdlane(sv[r], kk) * w; }
        }
#pragma unroll
        for (int r = 0; r < 9; ++r) lf[(wid * 9 + r) * 64 + lane] = acc[r];
        __syncthreads();
        for (int r = wid; r < 9; r += 8) { float s = p.in[I_ADAB][l * 12288 + col];
#pragma unroll
            for (int w = 0; w < 8; ++w) s += lf[(w * 9 + r) * 64 + lane];
            MOD[(size_t)(l * 9 + r) * 12288 + col] = s; }
        __syncthreads();
    }
}
__device__ __forceinline__ void hss_tasks(const Params& p) {
    const int lane = otid() & 63, gw = blockIdx.x * 8 + owid(), GW = gridDim.x * 8;
    for (int task = gw; task < 3 * 1024; task += GW) {
        const int set = task >> 10, l = (set == 1) ? 1 : 0, nset = (set == 2) ? 1 : 0, ord = (task >> 9) & 1, ch = task & 511, n = nset ? 256 : 2048;
        const float* HF = (const float*)(p.ws + O_HF) + (size_t)l * HF_LAYER + (nset ? HF_L0 : 0);
        const float* hf = HF + (size_t)((ord * 2 + 0) * 512 + ch) * n; const float* hb = HF + (size_t)((ord * 2 + 1) * 512 + ch) * n;
        float s = 0.f;
        for (int i = lane; i < n; i += 64) { const float a = hf[i], b = (i == 0) ? 0.f : hb[i]; s += a * a + b * b; }
        s = wave_sum(s);
        if (lane == 0) ((float*)(p.ws + O_HSS))[(size_t)((l * 2 + nset) * 2 + ord) * 512 + ch] = s;
#if HY_KRB
        if (nset == 0) {
            const float rs = rsqrtf(s + EPS); bf16_t* kr = (bf16_t*)(p.ws + O_KRB) + (size_t)((l * 2 + ord) * 512 + ch) * 4128;
            for (int q = lane; q < 516; q += 64) { float v[8];
#pragma unroll
                for (int j = 0; j < 8; ++j) { const int lag = 2064 - (q * 8 + j); v[j] = (lag >= 0 && lag < SEQ) ? hf[lag] * rs : ((lag < 0 && lag > -SEQ) ? hb[-lag] * rs : 0.f); }
                u32x4 w; w.x = pk2(v[0], v[1]); w.y = pk2(v[2], v[3]); w.z = pk2(v[4], v[5]); w.w = pk2(v[6], v[7]); *(u32x4*)(kr + q * 8) = w; }
        }
#endif
    }
}
__device__ __forceinline__ void hyf_task(const Params& p, int l, int nset, int i0, LAS float* lf) {
    int tid = otid(); const int n = nset ? 256 : 2048;
    LAS float* feats = lf; LAS float* hd1 = lf + 8 * 33; LAS float* hd2 = hd1 + 512;
    if (tid < 8 * 33) { const int pos = tid / 33, f = tid % 33, i = i0 + pos; const float t = (float)i / (float)(n - 1), ang = 6.283185307179586f * (float)i / (float)n; float v;
        if (f == 0) v = t; else { const int j = (f - 1) & 15; const float band = 1e-4f + (float)j * ((15.0f - 1e-4f) / 15.0f); v = (f <= 16) ? cosf(ang * band) : sinf(ang * band); }
        feats[tid] = v; }
    __syncthreads();
    { const int pos = tid >> 6, j = tid & 63; const float* w1 = p.in[I_HYW1] + l * 33 * 64; float s = p.in[I_HYB1][l * 64 + j];
      for (int f = 0; f < 33; ++f) s += feats[pos * 33 + f] * w1[f * 64 + j];
      hd1[tid] = sinf(p.in[I_HYFREQ][l * 64 + j] * s); }
    __syncthreads();
    { const int pos = tid >> 6, j = tid & 63; const float* w2 = p.in[I_HYW2] + l * 64 * 64; float s = p.in[I_HYB2][l * 64 + j];
      for (int f = 0; f < 64; ++f) s += hd1[pos * 64 + f] * w2[f * 64 + j];
      hd2[tid] = sinf(p.in[I_HYFREQ][l * 64 + j] * s); }
    __syncthreads();
    const float* w3 = p.in[I_HYW3] + (size_t)l * 64 * 2048 + tid * 4;
    f32x4 acc[8];
#pragma unroll
    for (int q = 0; q < 8; ++q) acc[q] = (f32x4){0.f, 0.f, 0.f, 0.f};
    for (int j = 0; j < 64; ++j) { const f32x4 w = *(const f32x4*)(w3 + (size_t)j * 2048);
#pragma unroll
        for (int q = 0; q < 8; ++q) acc[q] += w * hd2[q * 64 + j]; }
    float* HF = (float*)(p.ws + O_HF) + (size_t)l * HF_LAYER + (nset ? HF_L0 : 0);
#pragma unroll
    for (int c = 0; c < 4; ++c) { const int col = tid * 4 + c, ord = col >> 10, dir = (col >> 9) & 1, ch = col & 511;
        const float delta = 3.0701134573253944f + (float)ch * ((15.350567286626973f - 3.0701134573253944f) / 511.0f); float v[8];
#pragma unroll
        for (int q = 0; q < 8; ++q) { const int i = i0 + q; const float t = (float)i / (float)(n - 1); v[q] = acc[q][c] * __expf(-t * delta); }
        float* dst = HF + (size_t)((ord * 2 + dir) * 512 + ch) * n + i0;
        *(f32x4*)dst = (f32x4){v[0], v[1], v[2], v[3]}; *(f32x4*)(dst + 4) = (f32x4){v[4], v[5], v[6], v[7]};    }
    __syncthreads();
}
__device__ __forceinline__ void rope_tables(const Params& p);
__device__ __forceinline__ void phase_prologue(const Params& p, LAS unsigned char* lds) {
    const int tid = otid(); LAS float* lf = (LAS float*)lds;
    { const size_t gt = (size_t)blockIdx.x * NTHREADS + tid, GT = (size_t)gridDim.x * NTHREADS;
      for (int l = 0; l < NLAYER; ++l) {
          u32x4* z1 = WIN8 ? (u32x4*)(p.ws + O_WIN + ((size_t)l * NP + IN_COLS) * DM) : (u32x4*)((bf16_t*)(p.ws + O_WIN) + ((size_t)l * NP + IN_COLS) * DM); const size_t n1 = (size_t)(NP - IN_COLS) * DM * (WIN8 ? 1 : 2) / 16;
          for (size_t i = gt; i < n1; i += GT) z1[i] = (u32x4){0u, 0u, 0u, 0u};
          u32x4* z2 = (u32x4*)((bf16_t*)(p.ws + O_WUQ) + ((size_t)l * NQP + 1152) * 768); const size_t n2 = (size_t)(NQP - 1152) * 768 * 2 / 16;
          for (size_t i = gt; i < n2; i += GT) z2[i] = (u32x4){0u, 0u, 0u, 0u};
      } }
    rope_tables(p);
#if ROUTER_X3
    { bf16_t* R2 = (bf16_t*)(p.ws + O_RW2);
      for (int i = blockIdx.x * NTHREADS + tid; i < NLAYER * NEXP * DM; i += gridDim.x * NTHREADS) { const int j = i & 7, ln = (i >> 3) & 63, eg = (i >> 9) & 3, st = (i >> 11) & 7, w = (i >> 14) & 7, ll = i >> 17;
          const int k = w * 256 + 32 * st + 8 * (ln >> 4) + j, e = 16 * eg + (ln & 15);
          const float wv = p.in[I_RW][((size_t)ll * DM + k) * NEXP + e]; const bf16_t hi = f2bf(wv); const size_t o = (size_t)(i & 0x1ffff);
          R2[(size_t)(ll * 2 + 0) * NEXP * DM + o] = hi; R2[(size_t)(ll * 2 + 1) * NEXP * DM + o] = f2bf(wv - bf2f(hi)); } }
#endif
#ifndef PRO_REP
#define PRO_REP 0
#endif
    adaln_tasks(p, lf); if (PRO_REP & 1) adaln_tasks(p, lf);
    for (int rep_ = 0; rep_ < ((PRO_REP & 2) ? 2 : 1); ++rep_)
    for (int t = (int)gridDim.x - 1 - (int)blockIdx.x; t < 544; t += gridDim.x) { if (t < 512) hyf_task(p, t >> 8, 0, (t & 255) * 8, lf); else hyf_task(p, 0, 1, (t - 512) * 8, lf); }
    { const int G = gridDim.x, nh = (G < 384 && 2 * G > 384) ? 384 - G : 0;
      if ((int)blockIdx.x >= nh) { const int lane = tid & 63, gw = ((int)blockIdx.x - nh) * 8 + owid(), GW = (G - nh) * 8;
        for (int rep_ = 0; rep_ < ((PRO_REP & 4) ? 2 : 1); ++rep_)
        for (int t = gw; t < NLAYER * CVT_SMALL; t += GW) cvt_small_task(p, t / CVT_SMALL, t % CVT_SMALL, lane); } }
#if !CVT_BG
    cvt_exp_all(p, 0);
#endif
}

__device__ __forceinline__ void norm1_row(const Params& p, int l, int row, const float (&x)[32], int lane) {
    float ss = 0.f;
#pragma unroll
    for (int i = 0; i < 32; ++i) ss += x[i] * x[i];
    ss = wave_sum(ss); const float rstd = rsqrtf(ss * (1.0f / DM) + EPS);
    const float* g = p.in[I_NORMG] + (size_t)(l * 4 + 0) * DM; const float* mod = (const float*)(p.ws + O_MOD) + (size_t)(l * 9 + row_batch(row)) * 12288;
    bf16_t* H = (bf16_t*)(p.ws + O_H) + (size_t)row * DM;
#pragma unroll
    for (int j = 0; j < 8; ++j) { const int c = ROWCOL(j, lane); const f32x4 gv = *(const f32x4*)(g + c), sh = *(const f32x4*)(mod + c), sc = *(const f32x4*)(mod + DM + c); float h[4];
#pragma unroll
        for (int q = 0; q < 4; ++q) h[q] = x[j * 4 + q] * rstd * gv[q] * (1.0f + sc[q]) + sh[q];
#if WIN8
        *(unsigned*)((unsigned char*)(p.ws + O_H) + (size_t)row * DM + c) = pk4_fp8(h[0], h[1], h[2], h[3]);
#else
        u32x2 w; w.x = pk2(h[0], h[1]); w.y = pk2(h[2], h[3]); *(u32x2*)(H + c) = w;
#endif
    }
}
__device__ __forceinline__ void norm1_row_c(const Params& p, int l, int row, const float (&x)[32], int lane) {
    const float* mc = (const float*)(p.ws + O_MODC) + (size_t)((l * 9 + row_batch(row)) * 6 + 4) * DM; f32x4 a4[8], a5[8];
#pragma unroll
    for (int j = 0; j < 8; ++j) { a4[j] = ld_mc(p, l, row, 4, ROWCOL(j, lane)); a5[j] = ld_mc(p, l, row, 5, ROWCOL(j, lane)); }
    float ss = 0.f;
#pragma unroll
    for (int i = 0; i < 32; ++i) ss += x[i] * x[i];
    ss = wave_sum(ss); const float rstd = rsqrtf(ss * (1.0f / DM) + EPS);
    bf16_t* H = (bf16_t*)(p.ws + O_H) + (size_t)row * DM;
#pragma unroll
    for (int j = 0; j < 8; ++j) { const int c = ROWCOL(j, lane); float h[4];
#pragma unroll
        for (int q = 0; q < 4; ++q) h[q] = x[j * 4 + q] * rstd * a4[j][q] + a5[j][q];
#if WIN8
        *(unsigned*)((unsigned char*)(p.ws + O_H) + (size_t)row * DM + c) = pk4_fp8(h[0], h[1], h[2], h[3]);
#else
        u32x2 w; w.x = pk2(h[0], h[1]); w.y = pk2(h[2], h[3]); *(u32x2*)(H + c) = w;
#endif
    }
}
__device__ __forceinline__ void phase_norm1(const Params& p, int l) {
    { float* mc = (float*)(p.ws + O_MODC); const float* MODp = (const float*)(p.ws + O_MOD);
      for (int i = blockIdx.x * NTHREADS + otid(); i < NLAYER * 9 * DM; i += gridDim.x * NTHREADS) { const int c = i % DM, r = (i / DM) % 9, ll = i / (9 * DM); const float* m = MODp + (size_t)(ll * 9 + r) * 12288;
          const float g0 = p.in[I_NORMG][(size_t)(ll * 4 + 0) * DM + c], g1 = p.in[I_NORMG][(size_t)(ll * 4 + 1) * DM + c], g2 = p.in[I_NORMG][(size_t)(ll * 4 + 2) * DM + c], g3 = p.in[I_NORMG][(size_t)(ll * 4 + 3) * DM + c]; float* d = mc + (size_t)((ll * 9 + r) * 6) * DM + c;
          const float v0 = m[2 * DM + c] * g1, v1 = g2 * (1.0f + m[4 * DM + c]), v2 = m[3 * DM + c], v3 = m[5 * DM + c] * g3, v4 = g0 * (1.0f + m[DM + c]), v5 = m[c];
          if (MCB16) { bf16_t* db = (bf16_t*)(p.ws + O_MODC) + (size_t)((ll * 9 + r) * 6) * DM + c; db[0] = f2bf(v0); db[DM] = f2bf(v1); db[2 * DM] = f2bf(v2); db[3 * DM] = f2bf(v3); db[4 * DM] = f2bf(v4); db[5 * DM] = f2bf(v5); }
          else { d[0] = v0; d[DM] = v1; d[2 * DM] = v2; d[3 * DM] = v3; d[4 * DM] = v4; d[5 * DM] = v5; } } }
    const int lane = otid() & 63, gw = blockIdx.x * 8 + owid(), GW = gridDim.x * 8;
    const int lane0 = lane;
    for (int row = gw; row < NTOK; row += GW) { int lane = lane0; asm volatile("" : "+v"(lane)); const float* src = resid_src(p, l, row); float x[32];
#pragma unroll
        for (int j = 0; j < 8; ++j) { const f32x4 v = (NT2 & 4) ? __builtin_nontemporal_load((const f32x4*)(src + ROWCOL(j, lane))) : *(const f32x4*)(src + ROWCOL(j, lane)); x[j * 4] = v[0]; x[j * 4 + 1] = v[1]; x[j * 4 + 2] = v[2]; x[j * 4 + 3] = v[3]; }
        norm1_row(p, l, row, x, lane); }
}

__device__ __forceinline__ void rope_tables(const Params& p) {
    float* T = (float*)(p.ws + O_ROPE);
    for (int i = blockIdx.x * NTHREADS + otid(); i < 64 * 32 + 64 * 16; i += gridDim.x * NTHREADS) {
        float a; if (i < 64 * 32) a = (float)(i >> 5) * exp2f(-(float)(i & 31) * (13.287712379549449f / 32.0f)); else { const int q = i - 64 * 32; a = (float)(q >> 4) * exp2f(-(float)(q & 15) * (13.287712379549449f / 16.0f)); }
        float sn, cs; sincosf(a, &sn, &cs); T[2 * i] = cs; T[2 * i + 1] = sn; }
}
__device__ __forceinline__ void unpack8(const u32x4 v, float (&x)[8]) {
#pragma unroll
    for (int j = 0; j < 4; ++j) { x[2 * j] = __uint_as_float(v[j] << 16); x[2 * j + 1] = __uint_as_float(v[j] & 0xffff0000u); }
}
__device__ __forceinline__ u32x4 pack8(const float (&x)[8]) { u32x4 w; w.x = pk2(x[0], x[1]); w.y = pk2(x[2], x[3]); w.z = pk2(x[4], x[5]); w.w = pk2(x[6], x[7]); return w; }
template <int PX> __device__ __forceinline__ void rope8(float (&x)[8], const float* cs, bool second) {
#pragma unroll
    for (int j = 0; j < 8; ++j) { const float pr = __shfl_xor(x[j], PX), c = cs[2 * j], sn = cs[2 * j + 1]; x[j] = second ? pr * sn + x[j] * c : x[j] * c - pr * sn; }
}
__device__ __forceinline__ void gqa_post_row(const Params& p, int l, int row, int lane) {
    const bf16_t* P = (const bf16_t*)(p.ws + O_P) + (size_t)row * NP;
    const bool isctx = row >= NLAT; const int b = isctx ? (row - NLAT) >> 8 : row >> 11, t = isctx ? (row - NLAT) & 255 : row & 2047;
    const int j = lane & 15, hq = lane >> 4, half = j >> 3; const bool second = (j >> 2) & 1;
    const float* cs = (const float*)(p.ws + O_ROPE) + ((size_t)(half ? (t & 63) : (t >> 6)) * 32 + 8 * (j & 3)) * 2;
    const int kpos = isctx ? t : CTXL + t;
#pragma unroll
    for (int ps = 0; ps < 2; ++ps) {
        const bool isk = (ps == 1) && (hq >= 2); const int h = (ps == 0) ? hq : (isk ? hq - 2 : 4 + hq);
        const bf16_t* src = P + (isk ? C_GK : C_GQ) + h * 128 + 8 * j; const float* gn = (isk ? p.in[I_GKN] : p.in[I_GQN]) + l * 128 + 8 * j;
        float x[8]; unpack8(LDNT2(u32x4, src), x);
        float ss = 0.f;
#pragma unroll
        for (int q = 0; q < 8; ++q) ss += x[q] * x[q];
        ss += __shfl_xor(ss, 1); ss += __shfl_xor(ss, 2); ss += __shfl_xor(ss, 4); ss += __shfl_xor(ss, 8);
        const float rstd = rsqrtf(ss * (1.0f / 128.0f) + EPS); const f32x4 g0 = *(const f32x4*)gn, g1 = *(const f32x4*)(gn + 4);
#pragma unroll
        for (int q = 0; q < 4; ++q) { x[q] *= rstd * g0[q]; x[4 + q] *= rstd * g1[q]; }
        if (!isctx) rope8<4>(x, cs, second);
        bf16_t* dst = isk ? (bf16_t*)(p.ws + O_KG) + ((size_t)(b * 2 + h) * LK + kpos) * 128
                          : (isctx ? (bf16_t*)(p.ws + O_QGC) + ((size_t)(b * 6 + h) * CTXL + t) * 128 : (bf16_t*)(p.ws + O_QG) + ((size_t)(b * 6 + h) * SEQ + t) * 128);
        *(u32x4*)(dst + 8 * j) = pack8(x);
    }
    if (lane < 32) { const int h = lane >> 4; *(u32x4*)((bf16_t*)(p.ws + O_VG) + ((size_t)(b * 2 + h) * LK + kpos) * 128 + 8 * j) = LDNT2(u32x4, P + C_GV + h * 128 + 8 * j); }
}
__device__ __forceinline__ void seq_of(int row, int& s0, int& n) { if (row < NLAT) { s0 = row & ~2047; n = SEQ; } else { s0 = NLAT + ((row - NLAT) & ~255); n = CTXL; } }
__device__ __forceinline__ void load_conv_tile(const bf16_t* P, int t0, int pc0, LAS float* u) {
    int s0, n; seq_of(t0, s0, n);
    for (int i = otid(); i < 66 * 8; i += NTHREADS) { const int r = i >> 3, c = (i & 7) * 8, row = t0 - 1 + r;
        float x[8];
        if (row >= s0 && row < s0 + n) { const u32x4 v = LDNT2(u32x4, P + (size_t)row * NP + pc0 + c);
#pragma unroll
            for (int j = 0; j < 4; ++j) { x[2 * j] = __uint_as_float(v[j] << 16); x[2 * j + 1] = __uint_as_float(v[j] & 0xffff0000u); } }
        else {
#pragma unroll
            for (int j = 0; j < 8; ++j) x[j] = 0.f; }
#pragma unroll
        for (int j = 0; j < 8; ++j) u[r * 65 + c + j] = x[j]; }
}
__device__ __forceinline__ void hy_prep_task(const Params& p, int l, int t0, int c0, LAS float* u) {
    const bf16_t* P = (const bf16_t*)(p.ws + O_P);
#pragma unroll
    for (int q = 0; q < 4; ++q) load_conv_tile(P, t0, c0 + 64 * q, u + q * (66 * 65));
    __syncthreads();
    const int tid = otid(), c = tid >> 3, tc = (tid & 7) * 8;
#pragma unroll
    for (int q = 0; q < 4; ++q) { const LAS float* uq = u + q * (66 * 65); const int ch = c0 + 64 * q + c; const float* cw = p.in[I_HYCONV] + (size_t)l * 3 * 1536 + ch;
        const float w0 = cw[0], w1 = cw[1536], w2 = cw[3072]; float y[8], uu[10];
#pragma unroll
        for (int j = 0; j < 10; ++j) uu[j] = uq[(tc + j) * 65 + c];
#pragma unroll
        for (int j = 0; j < 8; ++j) y[j] = w0 * uu[j] + w1 * uu[j + 1] + w2 * uu[j + 2];
        bf16_t* dst = (ch < 512 ? (bf16_t*)(p.ws + O_VT) + (size_t)ch * NTOK : (bf16_t*)(p.ws + O_X1T) + (size_t)(ch - 512) * NTOK) + t0 + tc;
        u32x4 w; w.x = pk2(y[0], y[1]); w.y = pk2(y[2], y[3]); w.z = pk2(y[4], y[5]); w.w = pk2(y[6], y[7]); *(u32x4*)dst = w; }
    __syncthreads();
}
__device__ __forceinline__ void mla_post_row(const Params& p, int l, int row, int lane) {
    const bf16_t* P = (const bf16_t*)(p.ws + O_P) + (size_t)row * NP;
    const bool isctx = row >= NLAT; const int b = isctx ? (row - NLAT) >> 8 : row >> 11, t = isctx ? (row - NLAT) & 255 : row & 2047;
    float sq = 0.f, skv = 0.f; float x[8];
    unpack8(*(const u32x4*)(P + C_CQ + 8 * lane), x);
#pragma unroll
    for (int q = 0; q < 8; ++q) sq += x[q] * x[q];
    if (lane < 32) { unpack8(*(const u32x4*)(P + C_CQ + 512 + 8 * lane), x);
#pragma unroll
        for (int q = 0; q < 8; ++q) sq += x[q] * x[q];
        unpack8(*(const u32x4*)(P + C_CKV + 8 * lane), x);
#pragma unroll
        for (int q = 0; q < 8; ++q) skv += x[q] * x[q]; }
    const float rq = rsqrtf(wave_sum(sq) * (1.0f / 768.0f) + EPS), rkv = rsqrtf(wave_sum(skv) * (1.0f / 256.0f) + EPS);
    const bf16_t* QR = (const bf16_t*)(p.ws + O_QRAW) + (size_t)row * NQP; const bf16_t* KV = (const bf16_t*)(p.ws + O_KVRAW) + (size_t)row * 1536;
    const int kpos = isctx ? t : CTXL + t;
    const float* RM = (const float*)(p.ws + O_ROPE) + 64 * 32 * 2;
#pragma unroll
    for (int ps = 0; ps < 3; ++ps) { const int id = ps * 64 + lane; const bool act = id < 144; const int h = act ? id / 24 : 0, cj = act ? id % 24 : 0, rc = cj - 16;
        unpack8(LDNT2(u32x4, QR + h * 192 + 8 * cj), x);
#pragma unroll
        for (int q = 0; q < 8; ++q) x[q] *= rq;
        if (!isctx) { const int rcc = rc < 0 ? 0 : rc; const float* cs = RM + ((size_t)((rcc >> 2) ? (t & 63) : (t >> 6)) * 16 + 8 * (rcc & 1)) * 2; float y[8];
#pragma unroll
            for (int q = 0; q < 8; ++q) y[q] = x[q];
            rope8<2>(y, cs, (rcc >> 1) & 1);
            if (rc >= 0) {
#pragma unroll
                for (int q = 0; q < 8; ++q) x[q] = y[q]; } }
        bf16_t* qd = isctx ? (bf16_t*)(p.ws + O_QMC) + ((size_t)(b * 6 + h) * CTXL + t) * 192 : (bf16_t*)(p.ws + O_QM) + ((size_t)(b * 6 + h) * SEQ + t) * 192;
        if (act) *(u32x4*)(qd + 8 * cj) = pack8(x); }
#pragma unroll
    for (int ps = 0; ps < 3; ++ps) { const int id = ps * 64 + lane, h = id >> 5, c = id & 31;
        unpack8(LDNT2(u32x4, KV + h * 256 + 8 * c), x);
#pragma unroll
        for (int q = 0; q < 8; ++q) x[q] *= rkv;
        bf16_t* d = (c < 16) ? (bf16_t*)(p.ws + O_KM) + ((size_t)(b * 6 + h) * LK + kpos) * 192 + 8 * c : (bf16_t*)(p.ws + O_VM) + ((size_t)(b * 6 + h) * LK + kpos) * 128 + 8 * (c - 16);
        *(u32x4*)d = pack8(x); }
    { const int h = lane >> 3, rc = lane & 7; unpack8(*(const u32x4*)(P + C_KR + 8 * rc), x);
      if (!isctx) { const float* cs = RM + ((size_t)((rc >> 2) ? (t & 63) : (t >> 6)) * 16 + 8 * (rc & 1)) * 2; rope8<2>(x, cs, (rc >> 1) & 1); }
      if (lane < 48) *(u32x4*)((bf16_t*)(p.ws + O_KM) + ((size_t)(b * 6 + h) * LK + kpos) * 192 + 128 + 8 * rc) = pack8(x); }
}

__device__ __forceinline__ void hyconv_unit_valu(const Params& p, int l, int nset, int c, LAS float* lf) {
    const int tid = otid(), n = nset ? CTXL : SEQ, tokbase = nset ? NLAT : 0;
    LAS float* kc = lf; LAS float* z = lf + 4096; LAS float* z2 = z + 8 * SEQ;
    const float* HF = (const float*)(p.ws + O_HF) + (size_t)l * HF_LAYER + (nset ? HF_L0 : 0); const float* HSS = (const float*)(p.ws + O_HSS) + (size_t)((l * 2 + nset) * 2) * 512;
    const bf16_t* VT = (const bf16_t*)(p.ws + O_VT) + (size_t)c * NTOK + tokbase; const bf16_t* X1T = (const bf16_t*)(p.ws + O_X1T) + (size_t)c * NTOK + tokbase;
    bf16_t* Y2T = (bf16_t*)(p.ws + O_Y2T) + (size_t)c * NTOK + tokbase;
    for (int i = tid; i < 8 * n; i += NTHREADS) z[i] = bf2f(VT[i]);
    for (int ord = 0; ord < 2; ++ord) {
        const float rs = rsqrtf(HSS[ord * 512 + c] + EPS); const float* hf = HF + (size_t)((ord * 2 + 0) * 512 + c) * n; const float* hb = HF + (size_t)((ord * 2 + 1) * 512 + c) * n;
        for (int m = tid; m < 2 * n; m += NTHREADS) { const int lag = m - (n - 1); kc[m] = (m == 2 * n - 1) ? 0.f : (lag >= 0 ? hf[lag] : hb[-lag]) * rs; }
        __syncthreads();
        const LAS float* zs = ord ? z2 : z; const float skip = p.in[I_HYSKIP][(size_t)(l * 2 + ord) * 512 + c];
        for (int q = tid; q < n; q += NTHREADS) {
            const int b = q / (n >> 3), t0 = (q % (n >> 3)) * 8; float acc[8];
#pragma unroll
            for (int j = 0; j < 8; ++j) acc[j] = 0.f;
            const LAS float* zb = zs + b * n;
            for (int sb = 0; sb < n; sb += 8) {
                const LAS float* kb = kc + (t0 - sb + n - 8); float w[16];
#pragma unroll
                for (int i = 0; i < 4; ++i) { const f32x4 v = *(const LAS f32x4*)(kb + 4 * i); w[4 * i] = v[0]; w[4 * i + 1] = v[1]; w[4 * i + 2] = v[2]; w[4 * i + 3] = v[3]; }
                const f32x4 za = *(const LAS f32x4*)(zb + sb), zc = *(const LAS f32x4*)(zb + sb + 4); const float zv[8] = {za[0], za[1], za[2], za[3], zc[0], zc[1], zc[2], zc[3]};
#pragma unroll
                for (int ss = 0; ss < 8; ++ss)
#pragma unroll
                    for (int j = 0; j < 8; ++j) acc[j] += w[j - ss + 7] * zv[ss];
            }
            if (ord == 0) {
#pragma unroll
                for (int j = 0; j < 8; ++j) { const int idx = b * n + t0 + j; z2[idx] = bf2f(X1T[idx]) * (acc[j] + skip * z[idx]); }
            } else { float y[8];
#pragma unroll
                for (int j = 0; j < 8; ++j) y[j] = acc[j] + skip * z2[b * n + t0 + j];
                u32x4 w; w.x = pk2(y[0], y[1]); w.y = pk2(y[2], y[3]); w.z = pk2(y[4], y[5]); w.w = pk2(y[6], y[7]); *(u32x4*)(Y2T + b * n + t0) = w; }
        }
        __syncthreads();
    }
}
constexpr int HC_COPYB = 8256, HC_ROWB = 4560, HC_PAD = 112, HC_KR = 4112, HC_M0 = 2064;
constexpr int HC_ZOFF = 8 * HC_COPYB, HC_Z2OFF = HC_ZOFF + 8 * HC_ROWB;
__device__ __forceinline__ void hyconv_unit_mfma(const Params& p, int l, int c, LAS unsigned char* lds) {
    const int tid = otid(), wid = __builtin_amdgcn_readfirstlane(tid >> 6), lane = tid & 63;
    LAS unsigned char* CP = lds; LAS unsigned char* Zr = lds + HC_ZOFF; LAS unsigned char* Z2r = lds + HC_Z2OFF;
    const float* HF = (const float*)(p.ws + O_HF) + (size_t)l * HF_LAYER; const float* HSS = (const float*)(p.ws + O_HSS) + (size_t)(l * 4) * 512;
    const bf16_t* VT = (const bf16_t*)(p.ws + O_VT) + (size_t)c * NTOK; const bf16_t* X1T = (const bf16_t*)(p.ws + O_X1T) + (size_t)c * NTOK; bf16_t* Y2T = (bf16_t*)(p.ws + O_Y2T) + (size_t)c * NTOK;
    for (int q = tid; q < 8 * 256; q += NTHREADS) { const int b = q >> 8, ch = q & 255; *(LAS u32x4*)(Zr + b * HC_ROWB + (HC_PAD + ch * 8) * 2) = *(const u32x4*)(VT + b * SEQ + ch * 8); }
    for (int q = tid; q < 8 * 29; q += NTHREADS) { const int b = q / 29, ch = q % 29; const int e0 = ch < 14 ? ch * 8 : HC_PAD + SEQ + (ch - 14) * 8; *(LAS u32x4*)(Zr + b * HC_ROWB + e0 * 2) = (u32x4){0u, 0u, 0u, 0u}; }
    const int a = lane & 31, kg = lane >> 5, bq = a >> 2, isub = a & 3;
    const int Aoff = (a & 7) * HC_COPYB + (HC_M0 - 8 * (a >> 3) + 8 * kg) * 2;
    const int g0 = 2 * wid;
    const int Boff = bq * HC_ROWB + (HC_PAD + 128 * g0 + 32 * isub + 8 * kg) * 2;
    for (int ord = 0; ord < 2; ++ord) {
#if HY_KRB
        { const bf16_t* krg = (const bf16_t*)(p.ws + O_KRB) + (size_t)((l * 2 + ord) * 512 + c) * 4128;
          for (int q = tid; q < 516; q += NTHREADS) { const u32x4 Q = *(const u32x4*)(krg + q * 8); const u32x4 P = q ? *(const u32x4*)(krg + (q - 1) * 8) : (u32x4){0u, 0u, 0u, 0u};
              const unsigned D[8] = {P.x, P.y, P.z, P.w, Q.x, Q.y, Q.z, Q.w};
#pragma unroll
              for (int sft = 0; sft < 8; ++sft) { u32x4 w;
                  if ((sft & 1) == 0) { const int k0 = (8 - sft) >> 1; w = (u32x4){D[k0], D[k0 + 1], D[k0 + 2], D[k0 + 3]}; }
                  else { const int k0 = (7 - sft) >> 1; w.x = __builtin_amdgcn_alignbyte(D[k0 + 1], D[k0], 2); w.y = __builtin_amdgcn_alignbyte(D[k0 + 2], D[k0 + 1], 2); w.z = __builtin_amdgcn_alignbyte(D[k0 + 3], D[k0 + 2], 2); w.w = __builtin_amdgcn_alignbyte(D[k0 + 4], D[k0 + 3], 2); }
                  *(LAS u32x4*)(CP + sft * HC_COPYB + q * 16) = w; } } }
        __syncthreads();
#else
        LAS float* kr = (LAS float*)(ord == 0 ? Z2r : Zr);
        { const float rs = rsqrtf(HSS[ord * 512 + c] + EPS); const float* hf = HF + (size_t)((ord * 2 + 0) * 512 + c) * SEQ; const float* hb = HF + (size_t)((ord * 2 + 1) * 512 + c) * SEQ;
          for (int m = tid; m < HC_KR; m += NTHREADS) { const int lag = HC_M0 - m; float v = 0.f; if (lag >= 0 && lag < SEQ) v = hf[lag] * rs; else if (lag < 0 && lag > -SEQ) v = hb[-lag] * rs; kr[m] = v; } }
        __syncthreads();
        for (int q = tid; q < 8 * 516; q += NTHREADS) { const int sft = q / 516, ch = q % 516; float v[8];
#pragma unroll
            for (int j = 0; j < 8; ++j) { const int m = ch * 8 + j - sft; v[j] = (m >= 0 && m < HC_KR) ? kr[m] : 0.f; }
            u32x4 w; w.x = pk2(v[0], v[1]); w.y = pk2(v[2], v[3]); w.z = pk2(v[4], v[5]); w.w = pk2(v[6], v[7]); *(LAS u32x4*)(CP + sft * HC_COPYB + ch * 16) = w; }
        __syncthreads();
#endif
        if (ord == 0) for (int q = tid; q < 8 * 29; q += NTHREADS) { const int b = q / 29, ch = q % 29; const int e0 = ch < 14 ? ch * 8 : HC_PAD + SEQ + (ch - 14) * 8; *(LAS u32x4*)(Z2r + b * HC_ROWB + e0 * 2) = (u32x4){0u, 0u, 0u, 0u}; }
        const LAS unsigned char* Zs = ord ? Z2r : Zr;
        f32x16 acc0 = {}, acc1 = {};
        const int e_lo = 16 * wid - 127, e_mid0 = 16 * wid - 119, e_mid1 = 16 * wid + 7, e_hi = 16 * wid + 15;
        for (int e = e_lo; e < e_mid0; ++e) { const bf16x8 A = *(const LAS bf16x8*)(CP + Aoff - 32 * e); const bf16x8 B0 = *(const LAS bf16x8*)(Zs + Boff - 32 * e);
            acc0 = __builtin_amdgcn_mfma_f32_32x32x16_bf16(A, B0, acc0, 0, 0, 0); }
#pragma unroll 2
        for (int e = e_mid0; e <= e_mid1; ++e) { const bf16x8 A = *(const LAS bf16x8*)(CP + Aoff - 32 * e); const bf16x8 B0 = *(const LAS bf16x8*)(Zs + Boff - 32 * e); const bf16x8 B1 = *(const LAS bf16x8*)(Zs + Boff + 256 - 32 * e);
            acc0 = __builtin_amdgcn_mfma_f32_32x32x16_bf16(A, B0, acc0, 0, 0, 0); acc1 = __builtin_amdgcn_mfma_f32_32x32x16_bf16(A, B1, acc1, 0, 0, 0); }
        for (int e = e_mid1 + 1; e <= e_hi; ++e) { const bf16x8 A = *(const LAS bf16x8*)(CP + Aoff - 32 * e); const bf16x8 B1 = *(const LAS bf16x8*)(Zs + Boff + 256 - 32 * e);
            acc1 = __builtin_amdgcn_mfma_f32_32x32x16_bf16(A, B1, acc1, 0, 0, 0); }
        const float skip = p.in[I_HYSKIP][(size_t)(l * 2 + ord) * 512 + c];
#pragma unroll
        for (int gi = 0; gi < 2; ++gi) {
#pragma unroll
            for (int q = 0; q < 4; ++q) { const int t = 128 * (g0 + gi) + 32 * isub + 8 * q + 4 * kg; float y[4];
#pragma unroll
                for (int j = 0; j < 4; ++j) y[j] = gi ? acc1[4 * q + j] : acc0[4 * q + j];
                const u32x2 zz = *(const LAS u32x2*)(Zs + bq * HC_ROWB + (HC_PAD + t) * 2);
                const float z0 = __uint_as_float(zz.x << 16), z1 = __uint_as_float(zz.x & 0xffff0000u), z2 = __uint_as_float(zz.y << 16), z3 = __uint_as_float(zz.y & 0xffff0000u);
                y[0] += skip * z0; y[1] += skip * z1; y[2] += skip * z2; y[3] += skip * z3;
                if (ord == 0) { const u32x2 xx = LDNT3(u32x2, X1T + bq * SEQ + t);
                    y[0] *= __uint_as_float(xx.x << 16); y[1] *= __uint_as_float(xx.x & 0xffff0000u); y[2] *= __uint_as_float(xx.y << 16); y[3] *= __uint_as_float(xx.y & 0xffff0000u);
                    u32x2 w; w.x = pk2(y[0], y[1]); w.y = pk2(y[2], y[3]); *(LAS u32x2*)(Z2r + bq * HC_ROWB + (HC_PAD + t) * 2) = w; }
                else { u32x2 w; w.x = pk2(y[0], y[1]); w.y = pk2(y[2], y[3]); *(u32x2*)(Y2T + bq * SEQ + t) = w; } }
        }
        __syncthreads();
    }
}
__device__ __forceinline__ void hy_fin_task(const Params& p, int l, int t0, int c0, LAS float* u) {
    const bf16_t* P = (const bf16_t*)(p.ws + O_P); LAS float* y = u + 66 * 65;
    load_conv_tile(P, t0, 1024 + c0, u);
    const int tid = otid();
    { const int c = tid >> 3, tc = (tid & 7) * 8; const u32x4 v = LDNT3(u32x4, (const bf16_t*)(p.ws + O_Y2T) + (size_t)(c0 + c) * NTOK + t0 + tc);
#pragma unroll
      for (int j = 0; j < 4; ++j) { y[c * 65 + tc + 2 * j] = __uint_as_float(v[j] << 16); y[c * 65 + tc + 2 * j + 1] = __uint_as_float(v[j] & 0xffff0000u); } }
    __syncthreads();
    { const int t = tid >> 3, cc = (tid & 7) * 8; const float* cw = p.in[I_HYCONV] + (size_t)l * 3 * 1536 + 1024 + c0 + cc; float o[8];
#pragma unroll
      for (int j = 0; j < 8; ++j) { const int c = cc + j; const float x2 = cw[j] * u[t * 65 + c] + cw[1536 + j] * u[(t + 1) * 65 + c] + cw[3072 + j] * u[(t + 2) * 65 + c]; o[j] = x2 * y[c * 65 + t]; }
#if WOUT8
      u32x2 w; w.x = pk4_fp8(o[0] * MIX8_SCALE, o[1] * MIX8_SCALE, o[2] * MIX8_SCALE, o[3] * MIX8_SCALE); w.y = pk4_fp8(o[4] * MIX8_SCALE, o[5] * MIX8_SCALE, o[6] * MIX8_SCALE, o[7] * MIX8_SCALE);
      *(u32x2*)(p.ws + O_MIX + (size_t)(t0 + t) * DM + c0 + cc) = w; }
#else
      u32x4 w; w.x = pk2(o[0], o[1]); w.y = pk2(o[2], o[3]); w.z = pk2(o[4], o[5]); w.w = pk2(o[6], o[7]);
      *(u32x4*)((bf16_t*)(p.ws + O_MIX) + (size_t)(t0 + t) * DM + c0 + cc) = w; }
#endif
    __syncthreads();
}

__device__ __forceinline__ void mla_unit(const Params& p, int b, int h, int qb, bool ctxq, LAS unsigned char* lds) {
    unsigned char* ws = p.ws;
    const bf16_t* Q = ctxq ? (const bf16_t*)(ws + O_QMC) + (size_t)(b * 6 + h) * CTXL * 192 : (const bf16_t*)(ws + O_QM) + ((size_t)(b * 6 + h) * SEQ + qb * 256) * 192;
#if WOUT8
    bf16_t* O = (bf16_t*)(ws + O_MIX + (size_t)(ctxq ? NLAT + b * CTXL : b * SEQ + qb * 256) * DM + 512 + h * 128);
#else
    bf16_t* O = (bf16_t*)(ws + O_MIX) + (size_t)(ctxq ? NLAT + b * CTXL : b * SEQ + qb * 256) * DM + 512 + h * 128;
#endif
#if ATT_DMA & 1
    attn_body_dma<192>(Q, (const bf16_t*)(ws + O_KM) + (size_t)(b * 6 + h) * LK * 192, (const bf16_t*)(ws + O_VM) + (size_t)(b * 6 + h) * LK * 128, O, DM, ctxq ? CTXL : LK, 0.07216878364870322f, lds);
#else
    attn_body<192, 0>(Q, (const bf16_t*)(ws + O_KM) + (size_t)(b * 6 + h) * LK * 192, (const bf16_t*)(ws + O_VM) + (size_t)(b * 6 + h) * LK * 128, O, DM, ctxq ? CTXL : LK, 0.07216878364870322f, (char*)lds);
#endif
}
__device__ __forceinline__ void gqa_unit(const Params& p, int b, int h, int qb, bool ctxq, LAS unsigned char* lds) {
    unsigned char* ws = p.ws;
    const bf16_t* Q = ctxq ? (const bf16_t*)(ws + O_QGC) + (size_t)(b * 6 + h) * CTXL * 128 : (const bf16_t*)(ws + O_QG) + ((size_t)(b * 6 + h) * SEQ + qb * 256) * 128;
#if WOUT8
    bf16_t* O = (bf16_t*)(ws + O_MIX + (size_t)(ctxq ? NLAT + b * CTXL : b * SEQ + qb * 256) * DM + 1280 + h * 128);
#else
    bf16_t* O = (bf16_t*)(ws + O_MIX) + (size_t)(ctxq ? NLAT + b * CTXL : b * SEQ + qb * 256) * DM + 1280 + h * 128;
#endif
#if ATT_DMA & 2
    attn_body_dma<128>(Q, (const bf16_t*)(ws + O_KG) + (size_t)(b * 2 + h / 3) * LK * 128, (const bf16_t*)(ws + O_VG) + (size_t)(b * 2 + h / 3) * LK * 128, O, DM, ctxq ? CTXL : LK, 0.08838834764831845f, lds);
#else
    attn_body<128, GQA_SD>(Q, (const bf16_t*)(ws + O_KG) + (size_t)(b * 2 + h / 3) * LK * 128, (const bf16_t*)(ws + O_VG) + (size_t)(b * 2 + h / 3) * LK * 128, O, DM, ctxq ? CTXL : LK, 0.08838834764831845f, (char*)lds);
#endif
}
__device__ __forceinline__ void phase_mixer(const Params& p, int l, LAS unsigned char* lds) {
    const int G = gridDim.x, bid = blockIdx.x; const bool last = (l == NLAYER - 1);
#ifndef MLA_REP
#define MLA_REP 1
#endif
#ifndef GQA_REP
#define GQA_REP 1
#endif
    for (int rep_ = 0; rep_ < MLA_REP; ++rep_)
    for (int u = bid; u < 384 + (last ? 0 : 48); u += G) { if (u < 384) mla_unit(p, u / 48, (u >> 3) % 6, u & 7, false, lds); else mla_unit(p, (u - 384) / 6, (u - 384) % 6, 0, true, lds); }
    for (int rep_ = 0; rep_ < GQA_REP; ++rep_)
    for (int u = (bid + G / 2) % G; u < 384 + (last ? 0 : 48); u += G) { if (u < 384) gqa_unit(p, u / 48, (u >> 3) % 6, u & 7, false, lds); else gqa_unit(p, (u - 384) / 6, (u - 384) % 6, 0, true, lds); }
#ifndef CONV_REP
#define CONV_REP 1
#endif
    for (int rep = 0; rep < CONV_REP; ++rep) {
#if HY_MFMA
    for (int u = bid; u < 512; u += G) hyconv_unit_mfma(p, l, u, lds);
    if (!last) for (int u = bid; u < 512; u += G) hyconv_unit_valu(p, l, 1, u, (LAS float*)lds);
#else
    for (int u = bid; u < (last ? 512 : 1024); u += G) hyconv_unit_valu(p, l, u >> 9, u & 511, (LAS float*)lds);
#endif
    }
}

constexpr int RT_FS = DM + 4;
constexpr int RT_HS = DM + 8;
__device__ __forceinline__ void route_row_pre(const Params& p, int l, int row, int lane, LAS float* fdst, const float* g1, const float* g2) {
    const float* mc = (const float*)(p.ws + O_MODC) + (size_t)((l * 9 + row_batch(row)) * 6) * DM;
    const bf16_t* O = (const bf16_t*)(p.ws + O_OUT) + (size_t)row * DM; const float* rs = resid_src(p, l, row); float* X = (float*)(p.ws + O_X) + (size_t)row * DM; bf16_t* H = (bf16_t*)(p.ws + O_H) + (size_t)row * DM;
    u32x2 ov[8]; f32x4 xv[8], a1[8], a2[8], shv[8];
#pragma unroll
    for (int j = 0; j < 8; ++j) { const int c = ROWCOL(j, lane); ov[j] = *(const u32x2*)(O + c); xv[j] = ld_xrow(p, l, row, c); a1[j] = ld_mc(p, l, row, 0, c); a2[j] = ld_mc(p, l, row, 1, c); shv[j] = ld_mc(p, l, row, 2, c); }
    float o[32]; float ss = 0.f;
#pragma unroll
    for (int j = 0; j < 8; ++j) { o[j * 4] = __uint_as_float(ov[j].x << 16); o[j * 4 + 1] = __uint_as_float(ov[j].x & 0xffff0000u); o[j * 4 + 2] = __uint_as_float(ov[j].y << 16); o[j * 4 + 3] = __uint_as_float(ov[j].y & 0xffff0000u); }
#pragma unroll
    for (int i = 0; i < 32; ++i) ss += o[i] * o[i];
    const float r1 = rsqrtf(wave_sum(ss) * (1.0f / DM) + EPS); float s2 = 0.f;
#pragma unroll
    for (int j = 0; j < 8; ++j) { const int c = ROWCOL(j, lane);
#pragma unroll
        for (int q = 0; q < 4; ++q) { xv[j][q] += a1[j][q] * (o[j * 4 + q] * r1); s2 += xv[j][q] * xv[j][q]; }
        st_xrow(p, row, c, xv[j]); }
    const float r2 = rsqrtf(wave_sum(s2) * (1.0f / DM) + EPS);
#pragma unroll
    for (int j = 0; j < 8; ++j) { const int c = ROWCOL(j, lane); f32x4 f;
#pragma unroll
        for (int q = 0; q < 4; ++q) f[q] = xv[j][q] * r2 * a2[j][q] + shv[j][q];
#if MOE_FP8
        *(unsigned*)((unsigned char*)(p.ws + O_H) + (size_t)row * DM + c) = pk4_fp8(f[0], f[1], f[2], f[3]);
#else
        u32x2 w; w.x = pk2(f[0], f[1]); w.y = pk2(f[2], f[3]); *(u32x2*)(H + c) = w;
#endif
#if ROUTER_X3
        { float fl[4]; u32x2 wh, wl; wh.x = pk2(f[0], f[1]); wh.y = pk2(f[2], f[3]);
          fl[0] = f[0] - __uint_as_float(wh.x << 16); fl[1] = f[1] - __uint_as_float(wh.x & 0xffff0000u); fl[2] = f[2] - __uint_as_float(wh.y << 16); fl[3] = f[3] - __uint_as_float(wh.y & 0xffff0000u);
          wl.x = pk2(fl[0], fl[1]); wl.y = pk2(fl[2], fl[3]);
          *(LAS u32x2*)((LAS bf16_t*)fdst + c) = wh; *(LAS u32x2*)((LAS bf16_t*)fdst + 16 * RT_HS + c) = wl; }
#else
        *(LAS f32x4*)(fdst + c) = f;
#endif
    }
}
#if RC8
__device__ __forceinline__ void route_row_pre8(const Params& p, int l, int row, int lane, LAS float* fdst) {
    const bf16_t* O = (const bf16_t*)(p.ws + O_OUT) + (size_t)row * DM; const bf16_t* MC = (const bf16_t*)(p.ws + O_MODC) + (size_t)((l * 9 + row_batch(row)) * 6) * DM;
    bf16_t* Xb = (bf16_t*)(p.ws + O_X) + (size_t)row * DM;
    u32x4 ov[4], xb[4], a1b[4], a2b[4], shb[4]; f32x4 xf[4][2];
#pragma unroll
    for (int j = 0; j < 4; ++j) { const int c = j * 512 + lane * 8; ov[j] = LDNT(u32x4, O + c); a1b[j] = *(const u32x4*)(MC + c); a2b[j] = *(const u32x4*)(MC + DM + c); shb[j] = *(const u32x4*)(MC + 2 * DM + c);
#if NT2 & 16
        if (l == 0) { const float* rs = resid_src(p, 0, row); xf[j][0] = __builtin_nontemporal_load((const f32x4*)(rs + c)); xf[j][1] = __builtin_nontemporal_load((const f32x4*)(rs + c + 4)); } else xb[j] = LDNT(u32x4, Xb + c); }
#else
        if (l == 0) { const float* rs = resid_src(p, 0, row); xf[j][0] = *(const f32x4*)(rs + c); xf[j][1] = *(const f32x4*)(rs + c + 4); } else xb[j] = *(const u32x4*)(Xb + c); }
#endif
    float o[32], x[32]; float ss = 0.f;
#pragma unroll
    for (int j = 0; j < 4; ++j) { float t[8]; unpack8(ov[j], t);
#pragma unroll
        for (int q = 0; q < 8; ++q) { o[j * 8 + q] = t[q]; ss += t[q] * t[q]; } }
    const float r1 = rsqrtf(wave_sum(ss) * (1.0f / DM) + EPS); float s2 = 0.f;
#pragma unroll
    for (int j = 0; j < 4; ++j) { const int c = j * 512 + lane * 8; float xx[8], a[8], t[8]; unpack8(a1b[j], a);
        if (l == 0) {
#pragma unroll
            for (int q = 0; q < 4; ++q) { xx[q] = xf[j][0][q]; xx[4 + q] = xf[j][1][q]; } }
        else unpack8(xb[j], xx);
#pragma unroll
        for (int q = 0; q < 8; ++q) { t[q] = xx[q] + a[q] * (o[j * 8 + q] * r1); x[j * 8 + q] = t[q]; s2 += t[q] * t[q]; }
        STNT(u32x4, Xb + c, pack8(t)); }
    const float r2 = rsqrtf(wave_sum(s2) * (1.0f / DM) + EPS);
#pragma unroll
    for (int j = 0; j < 4; ++j) { const int c = j * 512 + lane * 8; float a2[8], sh[8], f[8], fl[8]; unpack8(a2b[j], a2); unpack8(shb[j], sh);
#pragma unroll
        for (int q = 0; q < 8; ++q) f[q] = x[j * 8 + q] * r2 * a2[q] + sh[q];
        u32x2 w8; w8.x = pk4_fp8(f[0], f[1], f[2], f[3]); w8.y = pk4_fp8(f[4], f[5], f[6], f[7]);
        *(u32x2*)((unsigned char*)(p.ws + O_H) + (size_t)row * DM + c) = w8;
        const u32x4 wh = pack8(f); float th[8]; unpack8(wh, th);
#pragma unroll
        for (int q = 0; q < 8; ++q) fl[q] = f[q] - th[q];
        *(LAS u32x4*)((LAS bf16_t*)fdst + c) = wh; *(LAS u32x4*)((LAS bf16_t*)fdst + 16 * RT_HS + c) = pack8(fl); }
}
#ifndef ROUTE2
#define ROUTE2 0
#endif
#if ROUTE2
__device__ __forceinline__ void route_rows_pre8(const Params& p, int l, int row0, int lane, LAS float* fdst0) {
    const bf16_t* MC = (const bf16_t*)(p.ws + O_MODC) + (size_t)((l * 9 + row_batch(row0)) * 6) * DM;
    u32x4 ov[2][4], a1b[4], a2b[4], shb[4];
#pragma unroll
    for (int j = 0; j < 4; ++j) { const int c = j * 512 + lane * 8; a1b[j] = *(const u32x4*)(MC + c); a2b[j] = *(const u32x4*)(MC + DM + c); shb[j] = *(const u32x4*)(MC + 2 * DM + c); }
#pragma unroll
    for (int rr = 0; rr < 2; ++rr) { const int row = row0 + rr; const bf16_t* O = (const bf16_t*)(p.ws + O_OUT) + (size_t)row * DM; const bf16_t* Xb = (const bf16_t*)(p.ws + O_X) + (size_t)row * DM;
#pragma unroll
        for (int j = 0; j < 4; ++j) { const int c = j * 512 + lane * 8; ov[rr][j] = *(const u32x4*)(O + c); } (void)Xb; }
#pragma unroll
    for (int rr = 0; rr < 2; ++rr) { const int row = row0 + rr; bf16_t* Xb = (bf16_t*)(p.ws + O_X) + (size_t)row * DM; LAS float* fdst = (LAS float*)((LAS bf16_t*)fdst0 + rr * RT_HS);
        u32x4 xb[4]; f32x4 xf[4][2];
#pragma unroll
        for (int j = 0; j < 4; ++j) { const int c = j * 512 + lane * 8;
            if (l == 0) { const float* rs = resid_src(p, 0, row); xf[j][0] = *(const f32x4*)(rs + c); xf[j][1] = *(const f32x4*)(rs + c + 4); } else xb[j] = *(const u32x4*)(Xb + c); }
        float o[32], x[32]; float ss = 0.f;
#pragma unroll
        for (int j = 0; j < 4; ++j) { float t[8]; unpack8(ov[rr][j], t);
#pragma unroll
            for (int q = 0; q < 8; ++q) { o[j * 8 + q] = t[q]; ss += t[q] * t[q]; } }
        const float r1 = rsqrtf(wave_sum(ss) * (1.0f / DM) + EPS); float s2 = 0.f;
#pragma unroll
        for (int j = 0; j < 4; ++j) { const int c = j * 512 + lane * 8; float xx[8], a[8], t[8]; unpack8(a1b[j], a);
            if (l == 0) {
#pragma unroll
                for (int q = 0; q < 4; ++q) { xx[q] = xf[j][0][q]; xx[4 + q] = xf[j][1][q]; } }
            else unpack8(xb[j], xx);
#pragma unroll
            for (int q = 0; q < 8; ++q) { t[q] = xx[q] + a[q] * (o[j * 8 + q] * r1); x[j * 8 + q] = t[q]; s2 += t[q] * t[q]; }
            *(u32x4*)(Xb + c) = pack8(t); }
        const float r2 = rsqrtf(wave_sum(s2) * (1.0f / DM) + EPS);
#pragma unroll
        for (int j = 0; j < 4; ++j) { const int c = j * 512 + lane * 8; float a2[8], sh[8], f[8], fl[8]; unpack8(a2b[j], a2); unpack8(shb[j], sh);
#pragma unroll
            for (int q = 0; q < 8; ++q) f[q] = x[j * 8 + q] * r2 * a2[q] + sh[q];
            u32x2 w8; w8.x = pk4_fp8(f[0], f[1], f[2], f[3]); w8.y = pk4_fp8(f[4], f[5], f[6], f[7]);
            *(u32x2*)((unsigned char*)(p.ws + O_H) + (size_t)row * DM + c) = w8;
            const u32x4 wh = pack8(f); float th[8]; unpack8(wh, th);
#pragma unroll
            for (int q = 0; q < 8; ++q) fl[q] = f[q] - th[q];
            *(LAS u32x4*)((LAS bf16_t*)fdst + c) = wh; *(LAS u32x4*)((LAS bf16_t*)fdst + 16 * RT_HS + c) = pack8(fl); } }
}
#endif
__device__ __forceinline__ void norm1_row_c8(const Params& p, int l, int row, const float (&x)[32], int lane) {
    const bf16_t* MC = (const bf16_t*)(p.ws + O_MODC) + (size_t)((l * 9 + row_batch(row)) * 6 + 4) * DM; u32x4 a4b[4], a5b[4];
#pragma unroll
    for (int j = 0; j < 4; ++j) { const int c = j * 512 + lane * 8; a4b[j] = *(const u32x4*)(MC + c); a5b[j] = *(const u32x4*)(MC + DM + c); }
    float ss = 0.f;
#pragma unroll
    for (int i = 0; i < 32; ++i) ss += x[i] * x[i];
    ss = wave_sum(ss); const float rstd = rsqrtf(ss * (1.0f / DM) + EPS);
    bf16_t* H = (bf16_t*)(p.ws + O_H) + (size_t)row * DM;
#pragma unroll
    for (int j = 0; j < 4; ++j) { const int c = j * 512 + lane * 8; float a4[8], a5[8], h[8]; unpack8(a4b[j], a4); unpack8(a5b[j], a5);
#pragma unroll
        for (int q = 0; q < 8; ++q) h[q] = x[j * 8 + q] * rstd * a4[q] + a5[q];
        *(u32x4*)(H + c) = pack8(h); }
}
#endif
__device__ __forceinline__ void route_row_topk(const Params& p, int l, int row, int lane, float logit, LAS unsigned* cntL) {
    const float score = 1.0f / (1.0f + expf(-logit)), biased = score + p.in[I_RB][l * 64 + lane];
    float m1 = biased; m1 = fmaxf(m1, __shfl_xor(m1, 1)); m1 = fmaxf(m1, __shfl_xor(m1, 2)); m1 = fmaxf(m1, __shfl_xor(m1, 4));
    const unsigned long long bal = __ballot(biased == m1); const int first = __builtin_ctz((unsigned)((bal >> (lane & ~7)) & 0xffull));
    float m2 = ((lane & 7) == first) ? -INFINITY : biased; m2 = fmaxf(m2, __shfl_xor(m2, 1)); m2 = fmaxf(m2, __shfl_xor(m2, 2)); m2 = fmaxf(m2, __shfl_xor(m2, 4));
    const float gs = m1 + m2; const int grp = lane >> 3; int rank = 0;
#pragma unroll
    for (int q = 0; q < 8; ++q) { const float v = rdlane(gs, q * 8); rank += (v > gs || (v == gs && q < grp)) ? 1 : 0; }
    const float cand = (rank < 4) ? biased : -INFINITY; int re = 0;
    for (int q = 0; q < 64; ++q) { const float v = rdlane(cand, q); re += (v > cand || (v == cand && q < lane)) ? 1 : 0; }
    const bool sel = re < TOPK; const float ssum = wave_sum(sel ? score : 0.f);
    if (sel) { ((int*)(p.ws + O_EIDX))[(size_t)row * 8 + re] = lane; ((float*)(p.ws + O_GATE))[(size_t)row * 8 + re] = score / ssum * 2.5f;
        ((int*)(p.ws + O_SLOT))[(size_t)row * 8 + re] = (int)__hip_atomic_fetch_add(&cntL[lane], 1u, __ATOMIC_RELAXED, __HIP_MEMORY_SCOPE_WORKGROUP); }
}
__device__ __forceinline__ void phase_route(const Params& p, int l, LAS unsigned char* lds) {
    const int tid = otid(), wid = __builtin_amdgcn_readfirstlane(tid >> 6), lane0 = tid & 63; const bool last = (l == NLAYER - 1); const int NR = last ? NLAT : NTOK;
    LAS float* frow = (LAS float*)lds; LAS float* part = frow;
    const float* g1 = p.in[I_NORMG] + (size_t)(l * 4 + 1) * DM; const float* g2 = p.in[I_NORMG] + (size_t)(l * 4 + 2) * DM;
    const float* RW = p.in[I_RW] + (size_t)l * DM * NEXP; LAS unsigned* cntL = (LAS unsigned*)(lds + LDS_CNTL);
    if (tid < 64) cntL[tid] = 0u;
    { int* stok = (int*)(p.ws + O_STOK); for (int i = blockIdx.x * NTHREADS + tid; i < NSLOTS; i += gridDim.x * NTHREADS) stok[i] = (i < RSLOTS) ? -1 : ((i - RSLOTS) < NR ? i - RSLOTS : -1); }
    for (int g = blockIdx.x; g < NR / 16; g += gridDim.x) {
        int lane = lane0; asm volatile("" : "+v"(lane));
#if ROUTER_X3
#if RC8
#if ROUTE2
        route_rows_pre8(p, l, g * 16 + wid * 2, lane, (LAS float*)((LAS bf16_t*)lds + (wid * 2) * RT_HS));
#else
        for (int rr = 0; rr < 2; ++rr) route_row_pre8(p, l, g * 16 + wid * 2 + rr, lane, (LAS float*)((LAS bf16_t*)lds + (wid * 2 + rr) * RT_HS));
#endif
#else
        for (int rr = 0; rr < 2; ++rr) route_row_pre(p, l, g * 16 + wid * 2 + rr, lane, (LAS float*)((LAS bf16_t*)lds + (wid * 2 + rr) * RT_HS), g1, g2);
#endif
        __syncthreads();
        f32x4 acc[4];
#pragma unroll
        for (int j = 0; j < 4; ++j) acc[j] = (f32x4){0.f, 0.f, 0.f, 0.f};
        { const int r16 = lane & 15, kq = lane >> 4; const LAS bf16_t* fh = (const LAS bf16_t*)lds + r16 * RT_HS + wid * 256 + 8 * kq; const LAS bf16_t* fl = fh + 16 * RT_HS;
          const bf16_t* wh = (const bf16_t*)(p.ws + O_RW2) + (size_t)(l * 2) * NEXP * DM + (size_t)wid * (8 * 4 * 64 * 8) + lane * 8; const bf16_t* wl = wh + (size_t)NEXP * DM;
#pragma unroll 2
          for (int st = 0; st < 8; ++st) { const bf16x8 ah = *(const LAS bf16x8*)(fh + 32 * st), al = *(const LAS bf16x8*)(fl + 32 * st); bf16x8 bh[4], bl[4];
#pragma unroll
              for (int eg = 0; eg < 4; ++eg) { bh[eg] = *(const bf16x8*)(wh + (st * 4 + eg) * 512); bl[eg] = *(const bf16x8*)(wl + (st * 4 + eg) * 512); }
#pragma unroll
              for (int eg = 0; eg < 4; ++eg) { acc[eg] = __builtin_amdgcn_mfma_f32_16x16x32_bf16(ah, bh[eg], acc[eg], 0, 0, 0); acc[eg] = __builtin_amdgcn_mfma_f32_16x16x32_bf16(ah, bl[eg], acc[eg], 0, 0, 0); acc[eg] = __builtin_amdgcn_mfma_f32_16x16x32_bf16(al, bh[eg], acc[eg], 0, 0, 0); } }
          __syncthreads();
#pragma unroll
          for (int eg = 0; eg < 4; ++eg)
#pragma unroll
              for (int r = 0; r < 4; ++r) part[(wid * 16 + 4 * kq + r) * 64 + 16 * eg + r16] = acc[eg][r]; }
#else
        for (int rr = 0; rr < 2; ++rr) route_row_pre(p, l, g * 16 + wid * 2 + rr, lane, frow + (wid * 2 + rr) * RT_FS, g1, g2);
        __syncthreads();
        f32x4 acc[4];
#pragma unroll
        for (int j = 0; j < 4; ++j) acc[j] = (f32x4){0.f, 0.f, 0.f, 0.f};
        { const int r16 = lane & 15, kq = lane >> 4; const LAS float* fa = frow + r16 * RT_FS + wid * 256 + 4 * kq; const float* rb = RW + (size_t)(wid * 256 + 4 * kq) * 64 + 4 * r16;
#pragma unroll 2
          for (int st = 0; st < 16; ++st) { const f32x4 a = *(const LAS f32x4*)(fa + 16 * st); f32x4 b[4];
#pragma unroll
              for (int i = 0; i < 4; ++i) b[i] = *(const f32x4*)(rb + (size_t)(16 * st + i) * 64);
#pragma unroll
              for (int i = 0; i < 4; ++i)
#pragma unroll
                  for (int j = 0; j < 4; ++j) acc[j] = __builtin_amdgcn_mfma_f32_16x16x4f32(a[i], b[i][j], acc[j], 0, 0, 0); }
          __syncthreads();
#pragma unroll
          for (int r = 0; r < 4; ++r) *(LAS f32x4*)(part + (wid * 16 + 4 * kq + r) * 64 + 4 * r16) = (f32x4){acc[0][r], acc[1][r], acc[2][r], acc[3][r]}; }
#endif
        __syncthreads();
        for (int rr = 0; rr < 2; ++rr) { const int r16 = wid * 2 + rr; float logit = 0.f;
#pragma unroll
            for (int w = 0; w < 8; ++w) logit += part[(w * 16 + r16) * 64 + lane];
            route_row_topk(p, l, g * 16 + r16, lane, logit, cntL); }
        __syncthreads();
    }
    __syncthreads();
    if (tid < 64) ((unsigned*)(p.ws + O_WCNT))[blockIdx.x * 64 + tid] = cntL[tid];
}
__device__ __forceinline__ void phase_place(const Params& p, int l, LAS unsigned char* lds) {
    const int tid = otid(); const int NR = (l == NLAYER - 1) ? NLAT : NTOK, G = gridDim.x;
    LAS int* woff = (LAS int*)lds; LAS int* csum = woff + 512 * 64; LAS int* pstart = csum + 8 * 64;
    const unsigned* wcnt = (const unsigned*)(p.ws + O_WCNT);
    for (int i = tid; i < G * 64; i += NTHREADS) woff[i] = (int)wcnt[i];
    __syncthreads();
    { const int e = tid & 63, ch = tid >> 6, cs = (G + 7) >> 3, w0 = ch * cs, w1 = (w0 + cs < G) ? w0 + cs : G; int run = 0;
      for (int w = w0; w < w1; ++w) { const int t = woff[w * 64 + e]; woff[w * 64 + e] = run; run += t; }
      csum[ch * 64 + e] = run;
      __syncthreads();
      int base = 0, tot = 0;
#pragma unroll
      for (int c2 = 0; c2 < 8; ++c2) { const int v = csum[c2 * 64 + e]; if (c2 < ch) base += v; tot += v; }
      for (int w = w0; w < w1; ++w) woff[w * 64 + e] += base;
      if (tid < 64) { const int ntile = (tot + 255) >> 8; pstart[tid] = (wave_incl_scan(ntile, tid) - ntile) * 256;
          if (blockIdx.x == 0) ((unsigned*)(p.ws + O_CTL))[CW_CNT + l * 64 + tid] = (unsigned)tot; } }
    __syncthreads();
    const int* eidx = (const int*)(p.ws + O_EIDX); int* slot = (int*)(p.ws + O_SLOT); int* stok = (int*)(p.ws + O_STOK);
    for (int i = blockIdx.x * NTHREADS + tid; i < NR * TOPK; i += G * NTHREADS) { const int row = i / TOPK, k = i % TOPK, e = eidx[(size_t)row * 8 + k], wg = (row >> 4) % G;
        const int s = pstart[e] + woff[wg * 64 + e] + slot[(size_t)row * 8 + k]; slot[(size_t)row * 8 + k] = s; stok[s] = row; }
    __syncthreads();
}
__device__ __forceinline__ void phase_final(const Params& p, int l) {
    const int lane = otid() & 63, gw = blockIdx.x * 8 + owid(), GW = gridDim.x * 8; const bool last = (l == NLAYER - 1); const int NR = last ? NLAT : NTOK;
    const bf16_t* DO = (const bf16_t*)(p.ws + O_DOUT);
    const int lane0 = lane;
    for (int row = gw; row < NR; row += GW) {
        int lane = lane0; asm volatile("" : "+v"(lane));
        const int sl = (lane < TOPK) ? ((const int*)(p.ws + O_SLOT))[(size_t)row * 8 + lane] : 0; const float gl = (lane < TOPK) ? ((const float*)(p.ws + O_GATE))[(size_t)row * 8 + lane] : 0.f;
#if RC8 && DOUT_FP8
        {
            bf16_t* Xb = (bf16_t*)(p.ws + O_X) + (size_t)row * DM; const bf16_t* M3 = (const bf16_t*)(p.ws + O_MODC) + (size_t)((l * 9 + row_batch(row)) * 6 + 3) * DM;
            u32x4 xb[4], a3b[4]; u32x2 v[7][4]; float gt[7]; const unsigned char* DO8 = p.ws + O_DOUT;
#pragma unroll
            for (int j = 0; j < 4; ++j) { const int c = j * 512 + lane * 8; xb[j] = LDNT(u32x4, Xb + c); a3b[j] = *(const u32x4*)(M3 + c); }
#pragma unroll
            for (int k = 0; k < 7; ++k) { const int s = (k == 0) ? RSLOTS + row : __builtin_amdgcn_readlane(sl, k - 1); const unsigned char* src = DO8 + (size_t)s * DM; gt[k] = ((k == 0) ? 1.0f : rdlane(gl, k - 1)) * (1.0f / DOUT8_SCALE);
#pragma unroll
                for (int j = 0; j < 4; ++j) v[k][j] = LDNT(u32x2, src + j * 512 + lane * 8); }
            float y[32];
#pragma unroll
            for (int i = 0; i < 32; ++i) y[i] = 0.f;
#pragma unroll
            for (int k = 0; k < 7; ++k)
#pragma unroll
                for (int j = 0; j < 4; ++j) { typedef float f32x2v __attribute__((ext_vector_type(2)));
                    const f32x2v l0 = __builtin_amdgcn_cvt_pk_f32_fp8((int)v[k][j].x, false), h0 = __builtin_amdgcn_cvt_pk_f32_fp8((int)v[k][j].x, true), l1 = __builtin_amdgcn_cvt_pk_f32_fp8((int)v[k][j].y, false), h1 = __builtin_amdgcn_cvt_pk_f32_fp8((int)v[k][j].y, true);
                    y[j * 8] += gt[k] * l0.x; y[j * 8 + 1] += gt[k] * l0.y; y[j * 8 + 2] += gt[k] * h0.x; y[j * 8 + 3] += gt[k] * h0.y; y[j * 8 + 4] += gt[k] * l1.x; y[j * 8 + 5] += gt[k] * l1.y; y[j * 8 + 6] += gt[k] * h1.x; y[j * 8 + 7] += gt[k] * h1.y; }
            float ss = 0.f;
#pragma unroll
            for (int i = 0; i < 32; ++i) ss += y[i] * y[i];
            const float r = rsqrtf(wave_sum(ss) * (1.0f / DM) + EPS); float x[32];
#pragma unroll
            for (int j = 0; j < 4; ++j) { const int c = j * 512 + lane * 8; float xx[8], a3[8], t[8]; unpack8(xb[j], xx); unpack8(a3b[j], a3);
#pragma unroll
                for (int q = 0; q < 8; ++q) { t[q] = xx[q] + a3[q] * (y[j * 8 + q] * r); x[j * 8 + q] = t[q]; }
#if NT2 & 32
                if (last) { __builtin_nontemporal_store((f32x4){t[0], t[1], t[2], t[3]}, (f32x4*)(p.out + (size_t)row * DM + c)); __builtin_nontemporal_store((f32x4){t[4], t[5], t[6], t[7]}, (f32x4*)(p.out + (size_t)row * DM + c + 4)); }
#else
                if (last) { *(f32x4*)(p.out + (size_t)row * DM + c) = (f32x4){t[0], t[1], t[2], t[3]}; *(f32x4*)(p.out + (size_t)row * DM + c + 4) = (f32x4){t[4], t[5], t[6], t[7]}; }
#endif
                else STNT(u32x4, Xb + c, pack8(t)); }
            if (!last) norm1_row_c8(p, l + 1, row, x, lane);
            continue;
        }
#endif
        f32x4 xv[8], a3[8];
        { const float* Xr = (const float*)(p.ws + O_X) + (size_t)row * DM; const float* m3 = (const float*)(p.ws + O_MODC) + (size_t)((l * 9 + row_batch(row)) * 6 + 3) * DM;
#pragma unroll
          for (int j = 0; j < 8; ++j) { xv[j] = XB16 ? ld_xrow(p, 1, row, ROWCOL(j, lane)) : *(const f32x4*)(Xr + ROWCOL(j, lane)); a3[j] = ld_mc(p, l, row, 3, ROWCOL(j, lane)); } }
        float y[32];
#pragma unroll
        for (int i = 0; i < 32; ++i) y[i] = 0.f;
#if DOUT_FP8
        { const unsigned char* DO8 = p.ws + O_DOUT; unsigned v[7][8]; float gt[7];
#pragma unroll
          for (int k = 0; k < 7; ++k) { const int s = (k == 0) ? RSLOTS + row : __builtin_amdgcn_readlane(sl, k - 1); const unsigned char* src = DO8 + (size_t)s * DM; gt[k] = ((k == 0) ? 1.0f : rdlane(gl, k - 1)) * (1.0f / DOUT8_SCALE);
#pragma unroll
              for (int j = 0; j < 8; ++j) v[k][j] = *(const unsigned*)(src + ROWCOL(j, lane)); }
#pragma unroll
          for (int k = 0; k < 7; ++k)
#pragma unroll
              for (int j = 0; j < 8; ++j) { typedef float f32x2v __attribute__((ext_vector_type(2))); const f32x2v lo = __builtin_amdgcn_cvt_pk_f32_fp8((int)v[k][j], false), hi = __builtin_amdgcn_cvt_pk_f32_fp8((int)v[k][j], true);
                  y[j * 4] += gt[k] * lo.x; y[j * 4 + 1] += gt[k] * lo.y; y[j * 4 + 2] += gt[k] * hi.x; y[j * 4 + 3] += gt[k] * hi.y; } }
#else
#pragma unroll
        for (int kb = 0; kb < 7; kb += 4) {
            u32x2 v[4][8]; float gt[4];
#pragma unroll
            for (int kk = 0; kk < 4; ++kk) { const int k = kb + kk; if (k < 7) { const int s = (k == 0) ? RSLOTS + row : __builtin_amdgcn_readlane(sl, k - 1); const bf16_t* src = DO + (size_t)s * DM; gt[kk] = (k == 0) ? 1.0f : rdlane(gl, k - 1);
#pragma unroll
                for (int j = 0; j < 8; ++j) v[kk][j] = *(const u32x2*)(src + ROWCOL(j, lane)); } }
#pragma unroll
            for (int kk = 0; kk < 4; ++kk) { if (kb + kk < 7) {
#pragma unroll
                for (int j = 0; j < 8; ++j) { const float g = gt[kk]; y[j * 4] += g * __uint_as_float(v[kk][j].x << 16); y[j * 4 + 1] += g * __uint_as_float(v[kk][j].x & 0xffff0000u); y[j * 4 + 2] += g * __uint_as_float(v[kk][j].y << 16); y[j * 4 + 3] += g * __uint_as_float(v[kk][j].y & 0xffff0000u); } } }
        }
#endif
        float ss = 0.f;
#pragma unroll
        for (int i = 0; i < 32; ++i) ss += y[i] * y[i];
        const float r = rsqrtf(wave_sum(ss) * (1.0f / DM) + EPS);
        float* X = (float*)(p.ws + O_X) + (size_t)row * DM; float x[32];
#pragma unroll
        for (int j = 0; j < 8; ++j) { const int c = ROWCOL(j, lane); f32x4 xn;
#pragma unroll
            for (int q = 0; q < 4; ++q) { xn[q] = xv[j][q] + a3[j][q] * (y[j * 4 + q] * r); x[j * 4 + q] = xn[q]; }
            if (last) *(f32x4*)(p.out + (size_t)row * DM + c) = xn; else st_xrow(p, row, c, xn); }
        if (!last) norm1_row_c(p, l + 1, row, x, lane);
    }
}

#define XB_TMO      128
#define XB_XCNT(j)  (256  + 64 * (j))
#define XB_XSUB(j)  (1280 + 64 * (j))
#define XB_XGEN(j)  (2304 + 64 * (j))
#define XB_TOP      3328
#define XB_TOPGEN   3392
#define XCD_BAR_WORDS 3456
#define XB_SPIN_CAP (1u << 23)

__device__ __forceinline__ unsigned xb_ld(unsigned* p)              { return __hip_atomic_load(p, __ATOMIC_RELAXED, __HIP_MEMORY_SCOPE_AGENT); }
__device__ __forceinline__ unsigned xb_add(unsigned* p, unsigned v) { return __hip_atomic_fetch_add(p, v, __ATOMIC_RELAXED, __HIP_MEMORY_SCOPE_AGENT); }
__device__ __forceinline__ unsigned xb_xcc_id() { return (unsigned)__builtin_amdgcn_s_getreg((3 << 11) | 20) & 0xFu; }
#define XB_SPIN(cond, bar) do { unsigned _sp = 0; while (cond) { __builtin_amdgcn_s_sleep(1); \
    if ((++_sp & 255u) == 0u) { if (xb_ld(&(bar)[XB_TMO])) break; if (_sp > XB_SPIN_CAP) { atomicAdd(&(bar)[XB_TMO], 1u); break; } } } } while (0)

struct XcdBarrier {
    unsigned* bar; unsigned x;
    volatile LAS unsigned* st;
};

__device__ __forceinline__ XcdBarrier xcd_barrier_post(unsigned* bar, volatile LAS unsigned* st) {
    XcdBarrier b; b.bar = bar; b.x = xb_xcc_id(); b.st = st;
    if (threadIdx.x == 0) (void)xb_add(&bar[XB_XCNT(b.x)], 1u);
    return b;
}
__device__ __forceinline__ void xcd_barrier_complete(unsigned* bar, unsigned x, unsigned& nloc, unsigned& nx) {
    const unsigned G = gridDim.x * gridDim.y * gridDim.z;
    unsigned sum, cnt, mine, sp = 0u;
    for (;;) {
        sum = 0u; cnt = 0u; mine = 0u;
#pragma unroll
        for (unsigned j = 0; j < 16; ++j) { const unsigned c = xb_ld(&bar[XB_XCNT(j)]); sum += c; cnt += (c > 0u) ? 1u : 0u; mine = (j == x) ? c : mine; }
        if (sum == G) break;
        __builtin_amdgcn_s_sleep(1);
        if ((++sp & 255u) == 0u) { if (xb_ld(&bar[XB_TMO])) break; if (sp > XB_SPIN_CAP) { atomicAdd(&bar[XB_TMO], 1u); break; } }
    }
    nloc = mine > 0u ? mine : 1u; nx = cnt > 0u ? cnt : 1u;
}

__device__ __forceinline__ void xcd_barrier(const XcdBarrier& b) {
    asm volatile("s_waitcnt vmcnt(0)" ::: "memory");
    __syncthreads();
    if (threadIdx.x == 0) {
        unsigned* bar = b.bar;
        __builtin_amdgcn_s_waitcnt(0);
        unsigned nloc = b.st[0], nx = b.st[1];
        if (nloc == 0u) { xcd_barrier_complete(bar, b.x, nloc, nx); b.st[0] = nloc; b.st[1] = nx; }
        const unsigned old = xb_add(&bar[XB_XSUB(b.x)], 1u);
        const unsigned gen = old / nloc;
        if (old + 1u == (gen + 1u) * nloc) {
            __builtin_amdgcn_fence(__ATOMIC_RELEASE, "agent");
            asm volatile("s_waitcnt vmcnt(0)" ::: "memory");
            const unsigned og = xb_add(&bar[XB_TOP], 1u);
            const unsigned tg = og / nx;
            if (og + 1u == (tg + 1u) * nx) xb_add(&bar[XB_TOPGEN], 1u);
            else XB_SPIN(xb_ld(&bar[XB_TOPGEN]) == tg, bar);
            __builtin_amdgcn_fence(__ATOMIC_ACQUIRE, "agent");
            xb_add(&bar[XB_XGEN(b.x)], 1u);
            asm volatile("s_waitcnt vmcnt(0)" ::: "memory");
        } else {
            XB_SPIN(xb_ld(&bar[XB_XGEN(b.x)]) == gen, bar);
            __builtin_amdgcn_fence(__ATOMIC_ACQUIRE, "agent");
            asm volatile("s_waitcnt vmcnt(0)" ::: "memory");
        }
    }
    __syncthreads();
}


#if CVT_BG
__device__ __forceinline__ void xcd_barrier_work(const XcdBarrier& b, LAS unsigned char* lds) {
    volatile LAS unsigned* fl = (volatile LAS unsigned*)(lds + LDS_BGFLAG);
    asm volatile("s_waitcnt vmcnt(0)" ::: "memory");
    __syncthreads();
    if (threadIdx.x == 0) {
        unsigned* bar = b.bar;
        __builtin_amdgcn_s_waitcnt(0);
        unsigned nloc = b.st[0], nx = b.st[1];
        if (nloc == 0u) { xcd_barrier_complete(bar, b.x, nloc, nx); b.st[0] = nloc; b.st[1] = nx; }
        const unsigned old = xb_add(&bar[XB_XSUB(b.x)], 1u);
        const unsigned gen = old / nloc;
        if (old + 1u == (gen + 1u) * nloc) {
            __builtin_amdgcn_fence(__ATOMIC_RELEASE, "agent");
            asm volatile("s_waitcnt vmcnt(0)" ::: "memory");
            const unsigned og = xb_add(&bar[XB_TOP], 1u);
            const unsigned tg = og / nx;
            if (og + 1u == (tg + 1u) * nx) xb_add(&bar[XB_TOPGEN], 1u);
            else XB_SPIN(xb_ld(&bar[XB_TOPGEN]) == tg, bar);
            __builtin_amdgcn_fence(__ATOMIC_ACQUIRE, "agent");
            xb_add(&bar[XB_XGEN(b.x)], 1u);
            asm volatile("s_waitcnt vmcnt(0)" ::: "memory");
            fl[0] = 0xFFFFFFFFu;
        } else fl[0] = gen;
    }
    __syncthreads();
    const unsigned gen = fl[0];
    if (gen != 0xFFFFFFFFu) {
        unsigned sp = 0u;
        for (;;) {
            if (threadIdx.x == 0) { unsigned rel = (xb_ld(&b.bar[XB_XGEN(b.x)]) != gen) ? 1u : 0u;
                if (!rel && (++sp & 255u) == 0u) { if (xb_ld(&b.bar[XB_TMO])) rel = 1u; else if (sp > XB_SPIN_CAP) { atomicAdd(&b.bar[XB_TMO], 1u); rel = 1u; } }
                fl[1] = rel; }
            __syncthreads();
            const unsigned rel = fl[1];
            __syncthreads();
            if (rel) break;
            if (!((BG_TWO & 1) ? cvt_bg_step2(lds, 2 * CVT_EXP) : cvt_bg_step(lds, 2 * CVT_EXP))) __builtin_amdgcn_s_sleep(1);
        }
        if (threadIdx.x == 0) { __builtin_amdgcn_fence(__ATOMIC_ACQUIRE, "agent"); asm volatile("s_waitcnt vmcnt(0)" ::: "memory"); }
    }
    __syncthreads();
}
#endif

enum { PH_PRO = 0, PH_NORM1, PH_WIN, PH_POSTA, PH_POSTB, PH_MIXER, PH_HYFIN, PH_WOUT, PH_ROUTE, PH_PLACE, PH_GEMM1, PH_GEMM2, PH_FINAL, PH_COUNT };

template <int PH>
__device__ __forceinline__ void run_phase(const Params& p_in, int l, LAS unsigned char* lds) {
#if MEGA
    const __attribute__((address_space(4))) Params* kp = (const __attribute__((address_space(4))) Params*)__builtin_amdgcn_kernarg_segment_ptr(); asm volatile("" : "+s"(kp)); (void)p_in;
    Params p;
#pragma unroll
    for (int i_ = 0; i_ < 31; ++i_) p.in[i_] = kp->in[i_];
    p.out = kp->out; p.ws = kp->ws; p.layer = 0; p.pad = 0;
#else
    Params p = p_in; { unsigned char* w = p.ws; asm volatile("" : "+s"(w)); p.ws = w; }
#endif
    unsigned char* ws = p.ws; const bool last = (l == NLAYER - 1);
    const int gw = blockIdx.x * 8 + owid(), GW = gridDim.x * 8, lane = otid() & 63;
    if constexpr (PH == PH_PRO) { phase_prologue(p, lds); }
    if constexpr (PH == PH_NORM1) { phase_norm1(p, l); }
    if constexpr (PH == PH_WIN) {
        EpiStoreBf16 E{(bf16_t*)(ws + O_P), NP}; GemmDesc g{(const bf16_t*)(ws + O_H), DM, nullptr, DM, DM};
#if WIN8
        const bf16_t* Bt = (const bf16_t*)(ws + O_WIN + (size_t)l * NP * DM);
        if (!last) { DenseSched S{Bt, DM / 2, NTOK / 256, 16, 0, 0}; GEMM_PHASE8(g, S, E, 127, 119); }
        else { DenseSched S{Bt, DM / 2, NLAT / 256, 16, 0, 0}; GEMM_PHASE8(g, S, E, 127, 119); DenseSched S2{Bt, DM / 2, NCTX / 256, 4, NLAT, 12}; GEMM_PHASE8(g, S2, E, 127, 119); }
#else
        const bf16_t* Bt = (const bf16_t*)(ws + O_WIN) + (size_t)l * NP * DM;
        if (!last) { DenseSched S{Bt, DM, NTOK / 256, 16, 0, 0}; GEMM_PHASE(g, S, E); }
        else { DenseSched S{Bt, DM, NLAT / 256, 16, 0, 0}; GEMM_PHASE(g, S, E); DenseSched S2{Bt, DM, NCTX / 256, 4, NLAT, 12}; GEMM_PHASE_R(g, S2, E, 4, 0); }
#endif
    }
    if constexpr (PH == PH_POSTA) {
#ifndef DBG_SKIP
#define DBG_SKIP 0
#endif
#ifndef PA_GEMM_REP
#define PA_GEMM_REP 1
#endif
        for (int rep_ = 0; rep_ < PA_GEMM_REP; ++rep_) {
        if (!(DBG_SKIP & 1)) { GemmDesc g{(const bf16_t*)(ws + O_P) + C_CQ, NP, nullptr, 768, 768}; EpiStoreBf16 E{(bf16_t*)(ws + O_QRAW), NQP};
          DenseSched S{(const bf16_t*)(ws + O_WUQ) + (size_t)l * NQP * 768, 768, (last ? NLAT : NTOK) / 256, 5, 0, 0}; GEMM_PHASE(g, S, E); }
        if (!(DBG_SKIP & 2)) { GemmDesc g{(const bf16_t*)(ws + O_P) + C_CKV, NP, nullptr, 256, 256}; EpiStoreBf16 E{(bf16_t*)(ws + O_KVRAW), 1536};
          DenseSched S{(const bf16_t*)(ws + O_WUKV) + (size_t)l * 1536 * 256, 256, NTOK / 256, 6, 0, 0}; GEMM_PHASE_R(g, S, E, 0, (last ? NLAT : NTOK) / 256 * 5 - 256); }
        }
        const int ntt = (last ? NLAT : NTOK) / 64;
        if (!(DBG_SKIP & 4)) for (int t = blockIdx.x; t < ntt * 4; t += gridDim.x) hy_prep_task(p, l, (t >> 2) * 64, (t & 3) * 256, (LAS float*)lds);
        if (!(DBG_SKIP & 8)) for (int row = gw; row < NTOK; row += GW) gqa_post_row(p, l, row, lane);
    }
    if constexpr (PH == PH_POSTB) { if (l == 0) hss_tasks(p); for (int row = gw; row < NTOK; row += GW) mla_post_row(p, l, row, lane); }
    if constexpr (PH == PH_MIXER) { phase_mixer(p, l, lds); }
    if constexpr (PH == PH_HYFIN) { const int ntt = (last ? NLAT : NTOK) / 64; for (int t = blockIdx.x; t < ntt * 8; t += gridDim.x) hy_fin_task(p, l, (t >> 3) * 64, (t & 7) * 64, (LAS float*)lds); }
    if constexpr (PH == PH_WOUT) {
        GemmDesc g{(const bf16_t*)(ws + O_MIX), DM, nullptr, DM, DM}; EpiStoreBf16 E{(bf16_t*)(ws + O_OUT), DM};
#if WOUT8
        DenseSched S{(const bf16_t*)(ws + O_WOUT + (size_t)l * DM * DM), DM / 2, (last ? NLAT : NTOK) / 256, 8, 0, 0}; GEMM_PHASE8(g, S, E, 127, 115);
#elif WOUT8G
        { GemmDesc g8{(const bf16_t*)(ws + O_QM), DM, nullptr, DM, DM}; DenseSched S{(const bf16_t*)(ws + O_QG), DM / 2, (last ? NLAT : NTOK) / 256, 8, 0, 0}; GEMM_PHASE8(g8, S, E, 123, 119); }
#else
        DenseSched S{(const bf16_t*)(ws + O_WOUT) + (size_t)l * DM * DM, DM, (last ? NLAT : NTOK) / 256, 8, 0, 0}; GEMM_PHASE_R(g, S, E, 4, 0);
#endif
    }
    if constexpr (PH == PH_ROUTE) { phase_route(p, l, lds); }
    if constexpr (PH == PH_PLACE) { phase_place(p, l, lds);
#if CVT_BG
        { __syncthreads(); while ((BG_TWO & 2) ? cvt_bg_step2(lds, l * CVT_EXP + CVT_GU) : cvt_bg_step(lds, l * CVT_EXP + CVT_GU, (BG_DRAIN_REP & 3))) { } }
#endif
    }
    if constexpr (PH == PH_GEMM1 || PH == PH_GEMM2) {
        LAS int* te = (LAS int*)(lds + LDS_TILES); LAS int* ts = te + MAXTILES; LAS int* misc = (LAS int*)(lds + LDS_MISC) + 16;
        const int nt = moe_build_tiles((const unsigned*)(ws + O_CTL) + CW_CNT + l * 64, (last ? NLAT : NTOK) / 256, te, ts, misc);
#if MOE_FP8
        if constexpr (PH == PH_GEMM1) {
            GemmDesc g{(const bf16_t*)(ws + O_H), DM, (const int*)(ws + O_STOK), DM, DM}; EpiSwiGLU8 E{ws + O_HID};
            MoeSched S{te, ts, nt, 4, (const bf16_t*)(ws + O_EGU + (size_t)(CVT_BG ? l : 0) * 65 * 1024 * 2048), (size_t)1024 * 1024, DM / 2, 128}; GEMM_PHASE8_R(g, S, E, 127, 119, 2);
        } else {
            GemmDesc g{(const bf16_t*)(ws + O_HID), EH, nullptr, EH, EH};
            MoeSched S{te, ts, nt, 8, (const bf16_t*)(ws + O_ED + (size_t)(CVT_BG ? l : 0) * 65 * 2048 * 512), (size_t)2048 * 256, EH / 2, 256};
#if DOUT_FP8
            static_assert(DOUT8_SCALE == 8.0f, "the output scale is folded into the weight block scale below (119 + 3)");
            EpiStoreFp8 E{ws + O_DOUT, DM, 1.0f}; GEMM_PHASE8_R(g, S, E, 124, 122, 6);
#else
            EpiStoreBf16 E{(bf16_t*)(ws + O_DOUT), DM}; GEMM_PHASE8(g, S, E, 124, 119);
#endif
        }
#else
        if constexpr (PH == PH_GEMM1) {
            GemmDesc g{(const bf16_t*)(ws + O_H), DM, (const int*)(ws + O_STOK), DM, DM}; EpiSwiGLU E{(bf16_t*)(ws + O_HID)};
            MoeSched S{te, ts, nt, 4, (const bf16_t*)(ws + O_EGU), (size_t)1024 * 2048, DM, 128}; GEMM_PHASE(g, S, E);
        } else {
            GemmDesc g{(const bf16_t*)(ws + O_HID), EH, nullptr, EH, EH}; EpiStoreBf16 E{(bf16_t*)(ws + O_DOUT), DM};
            MoeSched S{te, ts, nt, 8, (const bf16_t*)(ws + O_ED), (size_t)2048 * 512, EH, 256}; GEMM_PHASE(g, S, E);
        }
#endif
        __syncthreads();
#if CVT_BG
        if constexpr (PH == PH_GEMM1) { while ((BG_TWO & 2) ? cvt_bg_step2(lds, (l + 1) * CVT_EXP) : cvt_bg_step(lds, (l + 1) * CVT_EXP, (BG_DRAIN_REP >> 2) ? (BG_DRAIN_REP >> 2) : 1)) { } }
#endif
    }
    if constexpr (PH == PH_FINAL) {
        phase_final(p, l);
#if CVT_BG
#else
        if (!last) cvt_exp_all(p, l + 1);
#endif
    }
}

#ifndef MEGA
#define MEGA 0
#endif


#if MEGA
__global__ void __launch_bounds__(NTHREADS, 2) mega_fwd(Params p) {
    extern __shared__ __attribute__((aligned(16))) unsigned char lds_raw[];
    LAS unsigned char* lds = (LAS unsigned char*)lds_raw;
    volatile LAS unsigned* xbw = (volatile LAS unsigned*)(lds + LDS_MISC);
    if (otid() == 0) { xbw[0] = 0u; xbw[1] = 0u; }
    if (otid() < 8) ((volatile LAS int*)(lds + LDS_BGCUR))[otid()] = 0;
    __syncthreads();
    { const XcdBarrier b0 = xcd_barrier_post((unsigned*)(p.ws + O_CTL) + CW_BAR, xbw); if (otid() == 0) xbw[2] = b0.x; }
    __syncthreads();
#define GRID_BAR() do { XcdBarrier b_; b_.bar = (unsigned*)(p.ws + O_CTL) + CW_BAR; b_.x = xbw[2]; b_.st = xbw; xcd_barrier(b_); } while (0)
#if CVT_BG
#define GRID_BARW(l) do { XcdBarrier b_; b_.bar = (unsigned*)(p.ws + O_CTL) + CW_BAR; b_.x = xbw[2]; b_.st = xbw; if (l) xcd_barrier_work(b_, lds); else xcd_barrier(b_); } while (0)
#else
#define GRID_BARW(l) GRID_BAR()
#endif
#ifndef DBL_MASK
#define DBL_MASK 0
#endif
#define RUNP(PH, l) do { run_phase<PH>(p, l, lds); GRID_BARW((l) == 0 || PH < PH_GEMM1); if ((DBL_MASK >> PH) & 1) { run_phase<PH>(p, l, lds); GRID_BAR(); } } while (0)
#ifndef DLY_MASK
#define DLY_MASK 0
#endif
#define RUND(PH, l) do { if ((DLY_MASK >> PH) & 1) { const unsigned long long t0_ = wall_clock64(); run_phase<PH>(p, l, lds); const unsigned long long t1_ = wall_clock64(); while (wall_clock64() < t1_ + (t1_ - t0_)) __builtin_amdgcn_s_sleep(8); } else run_phase<PH>(p, l, lds); } while (0)
    RUNP(PH_PRO, 0);
#if WOUT8G && !WOUT8
#define MIX8CVT(l) do { const size_t n8_ = (size_t)NTOK * DM / 8; const bf16_t* src_ = (const bf16_t*)(p.ws + O_MIX); unsigned char* dst_ = p.ws + O_QM; \
        for (size_t i_ = (size_t)blockIdx.x * NTHREADS + otid(); i_ < n8_; i_ += (size_t)gridDim.x * NTHREADS) { float x_[8]; unpack8(*(const u32x4*)(src_ + i_ * 8), x_); u32x2 w_; w_.x = pk4_fp8(x_[0] * 16.f, x_[1] * 16.f, x_[2] * 16.f, x_[3] * 16.f); w_.y = pk4_fp8(x_[4] * 16.f, x_[5] * 16.f, x_[6] * 16.f, x_[7] * 16.f); *(u32x2*)(dst_ + i_ * 8) = w_; } \
        { const size_t nw_ = (size_t)DM * DM / 8; const bf16_t* ws_ = (const bf16_t*)(p.ws + O_WOUT) + (size_t)(l) * DM * DM; unsigned char* wd_ = p.ws + O_QG; \
          for (size_t i_ = (size_t)blockIdx.x * NTHREADS + otid(); i_ < nw_; i_ += (size_t)gridDim.x * NTHREADS) { float x_[8]; unpack8(*(const u32x4*)(ws_ + i_ * 8), x_); u32x2 w_; w_.x = pk4_fp8(x_[0] * 256.f, x_[1] * 256.f, x_[2] * 256.f, x_[3] * 256.f); w_.y = pk4_fp8(x_[4] * 256.f, x_[5] * 256.f, x_[6] * 256.f, x_[7] * 256.f); *(u32x2*)(wd_ + i_ * 8) = w_; } } \
        GRID_BAR(); } while (0)
#else
#define MIX8CVT(l) do { } while (0)
#endif
#define LAYER(l) do { if ((l) == 0) RUNP(PH_NORM1, l); \
        RUNP(PH_WIN, l); RUNP(PH_POSTA, l); RUNP(PH_POSTB, l); RUNP(PH_MIXER, l); RUNP(PH_HYFIN, l); MIX8CVT(l); RUNP(PH_WOUT, l); \
        RUND(PH_ROUTE, l); GRID_BARW(1); RUND(PH_PLACE, l); GRID_BARW(1); RUNP(PH_GEMM1, l); RUNP(PH_GEMM2, l); RUND(PH_FINAL, l); \
        if ((l) + 1 < NLAYER) GRID_BARW(1); } while (0)
    LAYER(0);
    LAYER(1);
}
#endif

#if !MEGA
template <int PH> __global__ void __launch_bounds__(NTHREADS, 2) k_phase(Params p) {
    extern __shared__ __attribute__((aligned(16))) unsigned char lds_raw[];
    run_phase<PH>(p, p.layer, (LAS unsigned char*)lds_raw);
}
template <int PH> static bool prep_phase() { return hipFuncSetAttribute((const void*)k_phase<PH>, hipFuncAttributeMaxDynamicSharedMemorySize, LDS_BYTES) == hipSuccess; }
static int g_nlaunch = 0;
#ifndef DBG_STOP
#define DBG_STOP 1000
#define DBG_DUMP 0
#else
#define DBG_DUMP 1
#ifndef DBG_SET
#define DBG_SET 31
#endif
#endif
template <int PH> static void launch_phase(Params p, int l, hipStream_t st) { if (g_nlaunch++ >= DBG_STOP) return; p.layer = l; hipLaunchKernelGGL(k_phase<PH>, dim3(256), dim3(NTHREADS), LDS_BYTES, st, p); }
#endif


#if DBG_DUMP
__device__ __forceinline__ float san(float x) { return (x == x && fabsf(x) < 1e6f) ? x : 1.0f; }
__global__ void __launch_bounds__(256) k_dump(Params p) {
    const size_t N = (size_t)NLAT * DM;
    const bf16_t* b1 = (const bf16_t*)(p.ws + O_WIN); const size_t n1 = (O_X - O_WIN) / 2;
    const bf16_t* b2 = (const bf16_t*)(p.ws + O_H); const size_t n2 = (size_t)NTOK * DM;
    const bf16_t* b3 = (const bf16_t*)(p.ws + O_A); const size_t n3 = (O_AEND - O_A) / 2;
    const float* f1 = (const float*)(p.ws + O_MOD); const size_t m1 = (O_WIN - O_MOD) / 4;
    const float* f2 = (const float*)(p.ws + O_X); const size_t m2 = (size_t)NTOK * DM;
    for (size_t i = (size_t)blockIdx.x * 256 + otid(); i < N; i += (size_t)gridDim.x * 256) {
        float v = 0.f;
        if (DBG_SET & 1) for (size_t e = i; e < n1; e += N) v += san(bf2f(b1[e]));
        if (DBG_SET & 2) for (size_t e = i; e < n2; e += N) v += san(bf2f(b2[e]));
        if (DBG_SET & 4) for (size_t e = i; e < n3; e += N) v += san(bf2f(b3[e]));
        if (DBG_SET & 8) for (size_t e = i; e < m1; e += N) v += san(f1[e]);
        if (DBG_SET & 16) for (size_t e = i; e < m2; e += N) v += san(f2[e]);
        if (DBG_SET & 32) v += san(bf2f(((const bf16_t*)(p.ws + O_WUKV))[i % ((size_t)2 * 1536 * 256)]));
        if (DBG_SET & 64) { const size_t r = i % NTOK, c = (i / NTOK) % 256; v += san(bf2f(((const bf16_t*)(p.ws + O_P))[r * NP + C_CKV + c])); }
        if (DBG_SET & 128) v += san(bf2f(((const bf16_t*)(p.ws + O_KVRAW))[i % ((size_t)NTOK * 1536)]));
        p.out[i] = v;
    }
}
#endif
static int g_grid = 0;
extern "C" void kernel_launch(void* const* d_in, const int* in_sizes, int n_in, void* d_out, int out_size, void* d_ws, size_t ws_size, hipStream_t stream) {
    static int ok = 0;
    if (ok == 0) {
        if (n_in != 31 || in_sizes[0] != NLAT * DM || out_size != NLAT * DM || ws_size < WS_END) { fprintf(stderr, "kernel_launch: unexpected shapes (n_in %d, ws %zu, need %zu)\n", n_in, ws_size, (size_t)WS_END); ok = -1; return; }
        bool good = true;
#if !MEGA
        good = good && prep_phase<0>() && prep_phase<1>() && prep_phase<2>() && prep_phase<3>() && prep_phase<4>() && prep_phase<5>() && prep_phase<6>() && prep_phase<7>() && prep_phase<8>() && prep_phase<9>() && prep_phase<10>() && prep_phase<11>() && prep_phase<12>();
#endif
#if MEGA
        good = hipFuncSetAttribute((const void*)mega_fwd, hipFuncAttributeMaxDynamicSharedMemorySize, LDS_BYTES) == hipSuccess;
        int dev = 0, cus = 0, per_cu = 0;
        if (hipGetDevice(&dev) != hipSuccess || hipDeviceGetAttribute(&cus, hipDeviceAttributeMultiprocessorCount, dev) != hipSuccess) good = false;
        if (good && (hipOccupancyMaxActiveBlocksPerMultiprocessor(&per_cu, (const void*)mega_fwd, NTHREADS, LDS_BYTES) != hipSuccess || per_cu < 1)) { fprintf(stderr, "kernel_launch: occupancy query says %d workgroups per CU\n", per_cu); good = false; }
        g_grid = cus;
#endif
        if (!good) { fprintf(stderr, "kernel_launch: set-up failed\n"); ok = -1; return; }
        ok = 1;
    }
    if (ok < 0) return;
    Params p{}; for (int i = 0; i < 31; ++i) p.in[i] = (const float*)d_in[i]; p.out = (float*)d_out; p.ws = (unsigned char*)d_ws; p.layer = 0; p.pad = 0;
#ifdef POISON_WS
    hipMemsetAsync((char*)d_ws, 0xFF, WS_END, stream);
#endif
    hipMemsetAsync((char*)d_ws + O_CTL, 0, ZERO_BYTES, stream);
#if !MEGA
    g_nlaunch = 0;
    launch_phase<PH_PRO>(p, 0, stream);
    for (int l = 0; l < NLAYER; ++l) {
        if (l == 0) launch_phase<PH_NORM1>(p, l, stream);
        launch_phase<PH_WIN>(p, l, stream); launch_phase<PH_POSTA>(p, l, stream); launch_phase<PH_POSTB>(p, l, stream); launch_phase<PH_MIXER>(p, l, stream);
        launch_phase<PH_HYFIN>(p, l, stream); launch_phase<PH_WOUT>(p, l, stream); launch_phase<PH_ROUTE>(p, l, stream); launch_phase<PH_PLACE>(p, l, stream);
        launch_phase<PH_GEMM1>(p, l, stream); launch_phase<PH_GEMM2>(p, l, stream); launch_phase<PH_FINAL>(p, l, stream);
    }
#if DBG_DUMP
    hipLaunchKernelGGL(k_dump, dim3(2048), dim3(256), 0, stream, p);
#endif
#else
    hipLaunchKernelGGL(mega_fwd, dim3(g_grid), dim3(NTHREADS), LDS_BYTES, stream, p);
#endif
}
```

```cpp
#define MOE_FP8 1
#define GQA_SD 1
#define FAST_GEMM 1
#define MEGA 1
#include <hip/hip_runtime.h>
#include <stdint.h>
#include <stdio.h>

#define LAS __attribute__((address_space(3)))
typedef unsigned short bf16_t;
typedef short bf16x8 __attribute__((ext_vector_type(8)));
typedef short s16x4 __attribute__((ext_vector_type(4)));
typedef float f32x4 __attribute__((ext_vector_type(4)));
typedef float f32x16 __attribute__((ext_vector_type(16)));
typedef unsigned u32x4 __attribute__((ext_vector_type(4)));
typedef unsigned u32x2 __attribute__((ext_vector_type(2)));

constexpr int DM = 2048, NB = 8, SEQ = 2048, CTXL = 256, NLAT = NB * SEQ, NCTX = NB * CTXL, NTOK = NLAT + NCTX, NLAYER = 2;
constexpr int NP = 4096;
constexpr int C_CQ = 1536, C_GQ = 2304, C_CKV = 3072, C_KR = 3328, C_GK = 3392, C_GV = 3648, IN_COLS = 3904;
constexpr int NEXP = 64, TOPK = 6, EH = 512;
constexpr int LK = CTXL + SEQ;
constexpr int RSLOTS = 126976;
constexpr int NSLOTS = RSLOTS + NTOK;
constexpr int MAXTILES = NSLOTS / 256;
constexpr int NQP = 1280;
constexpr float EPS = 1e-6f;
constexpr int NTHREADS = 512;
#ifndef GQA_SD
#define GQA_SD 2
#endif
#ifndef HY_MFMA
#define HY_MFMA 1
#endif
#ifndef MOE_FP8
#define MOE_FP8 0
#endif
#ifndef HY_KRB
#define HY_KRB 0
#endif
#ifndef ROUTER_X3
#define ROUTER_X3 1
#endif
#ifndef DENSE_FP8
#define DENSE_FP8 0
#endif
#define WIN8 ((DENSE_FP8 & 1) != 0)
#define WOUT8 ((DENSE_FP8 & 2) != 0)
#define WOUT8G ((DENSE_FP8 & 6) != 0)
constexpr float MIX8_SCALE = 16.0f;
#ifndef DOUT_FP8
#define DOUT_FP8 MOE_FP8
#endif
constexpr float DOUT8_SCALE = 8.0f;
#ifndef FAST_GEMM
#define FAST_GEMM 1
#endif
#ifndef MEGA
#define MEGA 1
#endif

constexpr size_t al256(size_t x) { return (x + 255) & ~(size_t)255; }
constexpr size_t O_CTL = 0;
constexpr size_t CTL_BYTES = 65536;
constexpr size_t O_MOD = O_CTL + CTL_BYTES;
constexpr size_t O_HSS = O_MOD + al256((size_t)NLAYER * 9 * 12288 * 4);
constexpr size_t ZERO_BYTES = O_HSS + al256((size_t)NLAYER * 2 * 2 * 512 * 4);
constexpr size_t O_HF = ZERO_BYTES;
constexpr size_t HF_L0 = (size_t)2 * 2 * 512 * 2048, HF_L1 = (size_t)2 * 2 * 512 * 256, HF_LAYER = HF_L0 + HF_L1;
constexpr size_t O_WIN = O_HF + al256(NLAYER * HF_LAYER * 4);
constexpr size_t O_WOUT = O_WIN + (size_t)NLAYER * NP * DM * 2;
constexpr size_t O_WUQ = O_WOUT + (size_t)NLAYER * DM * DM * 2;
constexpr size_t O_WUKV = O_WUQ + al256((size_t)NLAYER * NQP * 768 * 2);
constexpr size_t O_EGU = O_WUKV + al256((size_t)NLAYER * 1536 * 256 * 2);
constexpr size_t O_ED = O_EGU + (size_t)65 * 1024 * 2048 * 2;
constexpr size_t O_X = O_ED + (size_t)65 * 2048 * 512 * 2;
constexpr size_t O_H = O_X + (size_t)NTOK * DM * 4;
constexpr size_t O_EIDX = O_H + (size_t)NTOK * DM * 2;
constexpr size_t O_GATE = O_EIDX + (size_t)NTOK * 8 * 4;
constexpr size_t O_SLOT = O_GATE + (size_t)NTOK * 8 * 4;
constexpr size_t O_STOK = O_SLOT + (size_t)NTOK * 8 * 4;
constexpr size_t O_WCNT = O_STOK + al256((size_t)NSLOTS * 4);
constexpr size_t O_ROPE = O_WCNT + (size_t)1024 * 64 * 4;
constexpr size_t O_MODC = O_ROPE + (size_t)(64 * 32 + 64 * 16) * 8;
constexpr size_t O_RW2 = O_MODC + (size_t)NLAYER * 9 * 6 * DM * 4;
constexpr size_t O_KRB = O_RW2 + (size_t)NLAYER * 2 * NEXP * DM * 2;
constexpr size_t O_HID = O_KRB + (size_t)NLAYER * 2 * 512 * 4128 * 2;
constexpr size_t O_A = O_HID + (size_t)NSLOTS * EH * 2;
constexpr size_t O_P = O_A;
constexpr size_t O_QRAW = O_P + (size_t)NTOK * NP * 2;
constexpr size_t O_KVRAW = O_QRAW + (size_t)NTOK * NQP * 2;
constexpr size_t O_QM = O_KVRAW + (size_t)NTOK * 1536 * 2;
constexpr size_t O_QMC = O_QM + (size_t)NB * 6 * SEQ * 192 * 2;
constexpr size_t O_KM = O_QMC + (size_t)NB * 6 * CTXL * 192 * 2;
constexpr size_t O_VM = O_KM + (size_t)NB * 6 * LK * 192 * 2;
constexpr size_t O_QG = O_VM + (size_t)NB * 6 * LK * 128 * 2;
constexpr size_t O_QGC = O_QG + (size_t)NB * 6 * SEQ * 128 * 2;
constexpr size_t O_KG = O_QGC + (size_t)NB * 6 * CTXL * 128 * 2;
constexpr size_t O_VG = O_KG + (size_t)NB * 2 * LK * 128 * 2;
constexpr size_t O_VT = O_VG + (size_t)NB * 2 * LK * 128 * 2;
constexpr size_t O_X1T = O_VT + (size_t)512 * NTOK * 2;
constexpr size_t O_Y2T = O_X1T + (size_t)512 * NTOK * 2;
constexpr size_t O_MIX = O_Y2T + (size_t)512 * NTOK * 2;
constexpr size_t O_OUT = O_MIX + (size_t)NTOK * DM * 2;
constexpr size_t O_AEND = O_OUT + (size_t)NTOK * DM * 2;
constexpr size_t O_DOUT = O_A;
static_assert(O_DOUT + (size_t)NSLOTS * DM * 2 <= O_AEND, "DOUT must fit the mixer scratch region");
constexpr size_t WS_END = O_AEND;

constexpr int CW_BAR = 0;
constexpr int CW_CNT = 4096;
constexpr int CW_CUR = 4096 + 128;
constexpr int CW_Q = 4096 + 256;

constexpr int LDS_BYTES = 148480;
constexpr int LDS_MISC = 147456;
constexpr int LDS_TILES = 131072;
#ifndef CVT_BG
#define CVT_BG (MEGA && MOE_FP8)
#endif
#ifndef WT_STORES
#define WT_STORES 0
#endif
__device__ __forceinline__ void st16_wt(void* p, u32x4 v) { asm volatile("global_store_dwordx4 %0, %1, off sc1\n\ts_nop 1" :: "v"(p), "v"(v) : "memory");     }
constexpr int LDS_BGCUR = LDS_MISC + 768;
constexpr int LDS_BGFLAG = LDS_MISC + 800;
constexpr int LDS_CNTL = LDS_MISC + 512;

struct Params { const float* in[31]; float* out; unsigned char* ws; int layer; int pad; };

enum { I_X = 0, I_C, I_CTX, I_CCTX, I_ADAW, I_ADAB, I_NORMG, I_WIN, I_WOUT, I_HYCONV, I_HYW1, I_HYB1, I_HYW2, I_HYB2, I_HYW3, I_HYFREQ, I_HYSKIP,
       I_MQN, I_MKVN, I_WUQ, I_WUKV, I_GQN, I_GKN, I_RW, I_RB, I_EG, I_EU, I_EDN, I_SG, I_SU, I_SD };

__device__ __forceinline__ int otid() { int t = threadIdx.x; asm volatile("" : "+v"(t)); return t; }
__device__ __forceinline__ int owid() { return __builtin_amdgcn_readfirstlane(otid() >> 6); }
__device__ __forceinline__ float bf2f(bf16_t v) { return __uint_as_float(((unsigned)v) << 16); }
__device__ __forceinline__ bf16_t f2bf(float f) { unsigned u = __float_as_uint(f); u += 0x7FFFu + ((u >> 16) & 1u); return (bf16_t)(u >> 16); }
__device__ __forceinline__ unsigned pk2(float lo, float hi) { unsigned r; asm volatile("v_cvt_pk_bf16_f32 %0, %1, %2" : "=v"(r) : "v"(lo), "v"(hi)); return r; }
__device__ __forceinline__ float wave_sum(float v) {
#pragma unroll
    for (int o = 32; o >= 1; o >>= 1) v += __shfl_xor(v, o);
    return v;
}
__device__ __forceinline__ float rdlane(float v, int l) { return __int_as_float(__builtin_amdgcn_readlane(__float_as_int(v), l)); }
__device__ __forceinline__ float silu_f(float x) { return x / (1.0f + __expf(-x)); }
__device__ __forceinline__ const float* resid_src(const Params& p, int l, int row) {
    if (l == 0) return row < NLAT ? p.in[I_X] + (size_t)row * DM : p.in[I_CTX] + (size_t)(row - NLAT) * DM;
    return (const float*)(p.ws + O_X) + (size_t)row * DM;
}
#ifndef XB16
#define XB16 1
#endif
__device__ __forceinline__ f32x4 ld_xrow(const Params& p, int l, int row, int c) {
    if (l == 0 || !XB16) return *(const f32x4*)(resid_src(p, l, row) + c);
    const u32x2 t = *(const u32x2*)((const bf16_t*)(p.ws + O_X) + (size_t)row * DM + c);
    return (f32x4){__uint_as_float(t.x << 16), __uint_as_float(t.x & 0xffff0000u), __uint_as_float(t.y << 16), __uint_as_float(t.y & 0xffff0000u)};
}
__device__ __forceinline__ void st_xrow(const Params& p, int row, int c, f32x4 v) {
    if (XB16) { u32x2 w; w.x = pk2(v[0], v[1]); w.y = pk2(v[2], v[3]); *(u32x2*)((bf16_t*)(p.ws + O_X) + (size_t)row * DM + c) = w; }
    else *(f32x4*)((float*)(p.ws + O_X) + (size_t)row * DM + c) = v;
}
__device__ __forceinline__ int row_batch(int row) { return row < NLAT ? row >> 11 : 8; }
#ifndef CVT_NT
#define CVT_NT 1
#endif
#ifndef NT2
#define NT2 511
#endif
#if NT2 & 64
#define LDNT(T, ptr) __builtin_nontemporal_load((const T*)(ptr))
#else
#define LDNT(T, ptr) (*(const T*)(ptr))
#endif
#if NT2 & 128
#define LDNT2(T, ptr) __builtin_nontemporal_load((const T*)(ptr))
#else
#define LDNT2(T, ptr) (*(const T*)(ptr))
#endif
#if NT2 & 256
#define STNT(T, ptr, val) __builtin_nontemporal_store((val), (T*)(ptr))
#else
#define STNT(T, ptr, val) (*(T*)(ptr) = (val))
#endif
#ifndef RC8
#define RC8 1
#endif
#if RC8
#define MCB16 1
#endif
#ifndef MCB16
#define MCB16 0
#endif
__device__ __forceinline__ f32x4 ld_mc(const Params& p, int l, int row, int v, int c) {
    const size_t idx = (size_t)((l * 9 + row_batch(row)) * 6 + v) * DM + c;
    if (!MCB16) return *(const f32x4*)((const float*)(p.ws + O_MODC) + idx);
    const u32x2 t = *(const u32x2*)((const bf16_t*)(p.ws + O_MODC) + idx);
    return (f32x4){__uint_as_float(t.x << 16), __uint_as_float(t.x & 0xffff0000u), __uint_as_float(t.y << 16), __uint_as_float(t.y & 0xffff0000u)};
}
#define ROWCOL(j, lane) ((j) * 256 + (lane) * 4)


struct GUnit { int arow0; const bf16_t* B; int orow0, ocol0; };
struct GemmDesc { const bf16_t* A; int lda; const int* ridx; int ldb; int K; };

__host__ __device__ __forceinline__ int perm32(int rho) { const int n = rho >> 4, i = rho & 15; return 8 * (i >> 2) + 4 * n + (i & 3); }
__host__ __device__ __forceinline__ int perm32b(int rho) { const int n = rho >> 4, i = rho & 15, fq = i >> 2; return 8 * (((fq & 1) << 1) | (fq >> 1)) + 4 * n + (i & 3); }
struct EpiStoreBf16 {
    static constexpr bool PERM = (FAST_GEMM != 0); static constexpr int PERMKIND = 0; static constexpr int NVM = PERM ? 16 : 32;
    bf16_t* O; int ldo;
    __device__ __forceinline__ void operator()(const f32x4 (&acc)[2][2][4][2], const GUnit& u, int wr, int wc, int fr, int fq) const {
#pragma unroll
        for (int ai = 0; ai < 2; ++ai)
#pragma unroll
            for (int m = 0; m < 4; ++m) {
                bf16_t* rowp = O + (size_t)(u.orow0 + ai * 128 + wr * 64 + m * 16 + fr) * ldo + u.ocol0 + wc * 32 + (PERM ? 8 : 4) * fq;
#pragma unroll
                for (int bj = 0; bj < 2; ++bj) {
                    if constexpr (PERM) { const f32x4 v0 = acc[ai][bj][m][0], v1 = acc[ai][bj][m][1]; u32x4 w; w.x = pk2(v0[0], v0[1]); w.y = pk2(v0[2], v0[3]); w.z = pk2(v1[0], v1[1]); w.w = pk2(v1[2], v1[3]); if (WT_STORES & 1) st16_wt(rowp + bj * 128, w); else *(u32x4*)(rowp + bj * 128) = w; }
                    else {
#pragma unroll
                        for (int n = 0; n < 2; ++n) { const f32x4 v = acc[ai][bj][m][n]; u32x2 w; w.x = pk2(v[0], v[1]); w.y = pk2(v[2], v[3]); *(u32x2*)(rowp + bj * 128 + n * 16) = w; } } }
            }
    }
};
struct EpiSwiGLU {
    static constexpr bool PERM = (FAST_GEMM != 0); static constexpr int PERMKIND = 0; static constexpr int NVM = 8;
    bf16_t* O;
    __device__ __forceinline__ void operator()(const f32x4 (&acc)[2][2][4][2], const GUnit& u, int wr, int wc, int fr, int fq) const {
#pragma unroll
        for (int ai = 0; ai < 2; ++ai)
#pragma unroll
            for (int m = 0; m < 4; ++m) {
                bf16_t* rowp = O + (size_t)(u.orow0 + ai * 128 + wr * 64 + m * 16 + fr) * EH + u.ocol0 + wc * 32 + (PERM ? 8 : 4) * fq;
#pragma unroll
                for (int n = 0; n < 2; ++n) { const f32x4 g = acc[ai][0][m][n], up = acc[ai][1][m][n]; float h[4];
#pragma unroll
                    for (int j = 0; j < 4; ++j) h[j] = silu_f(g[j]) * up[j];
                    u32x2 w; w.x = pk2(h[0], h[1]); w.y = pk2(h[2], h[3]); *(u32x2*)(rowp + n * (PERM ? 4 : 16)) = w; }
            }
    }
};

__device__ __forceinline__ float clamp8(float x) { return __builtin_amdgcn_fmed3f(x, -448.0f, 448.0f); }
__device__ __forceinline__ unsigned pk4_fp8(float a, float b, float c, float d) { int r = __builtin_amdgcn_cvt_pk_fp8_f32(clamp8(a), clamp8(b), 0, false); r = __builtin_amdgcn_cvt_pk_fp8_f32(clamp8(c), clamp8(d), r, true); return (unsigned)r; }
constexpr float HID8_SCALE = 8.0f;
constexpr float W8_SCALE = 256.0f;
__device__ __forceinline__ void swap32(unsigned& a, unsigned& b) { auto r = __builtin_amdgcn_permlane32_swap(a, b, false, false); a = r[0]; b = r[1]; }
struct EpiSwiGLU8 {
    static constexpr bool PERM = true; static constexpr int PERMKIND = 1; static constexpr int NVM = 4;
    unsigned char* O;
    __device__ __forceinline__ void operator()(const f32x4 (&acc)[2][2][4][2], const GUnit& u, int wr, int wc, int fr, int fq) const {
        const int hi = fq >> 1, cg = (fq & 1) * 16;
#pragma unroll
        for (int ai = 0; ai < 2; ++ai)
#pragma unroll
            for (int mp = 0; mp < 4; mp += 2) { unsigned w[2][2];
#pragma unroll
                for (int mm = 0; mm < 2; ++mm)
#pragma unroll
                    for (int n = 0; n < 2; ++n) { const f32x4 g = acc[ai][0][mp + mm][n], up = acc[ai][1][mp + mm][n]; float h[4];
#pragma unroll
                        for (int j = 0; j < 4; ++j) h[j] = silu_f(g[j]) * up[j] * HID8_SCALE;
                        w[mm][n] = pk4_fp8(h[0], h[1], h[2], h[3]); }
                swap32(w[0][0], w[1][0]); swap32(w[0][1], w[1][1]);
                const u32x4 o = hi ? (u32x4){w[0][0], w[0][1], w[1][0], w[1][1]} : (u32x4){w[0][0], w[0][1], w[1][0], w[1][1]};
                unsigned char* op_ = O + (size_t)(u.orow0 + ai * 128 + wr * 64 + (mp + hi) * 16 + fr) * EH + u.ocol0 + wc * 32 + cg;
                if (WT_STORES & 1) st16_wt(op_, o); else *(u32x4*)op_ = o; }
    }
};
struct EpiStoreFp8 {
    static constexpr bool PERM = true; static constexpr int PERMKIND = 1; static constexpr int NVM = 8;
    unsigned char* O; int ldo; float scale;
    __device__ __forceinline__ void operator()(const f32x4 (&acc)[2][2][4][2], const GUnit& u, int wr, int wc, int fr, int fq) const {
        const int hi = fq >> 1, cg = (fq & 1) * 16;
#pragma unroll
        for (int ai = 0; ai < 2; ++ai)
#pragma unroll
            for (int mp = 0; mp < 4; mp += 2)
#pragma unroll
                for (int bj = 0; bj < 2; ++bj) { unsigned w[2][2];
#pragma unroll
                    for (int mm = 0; mm < 2; ++mm) { const f32x4 v0 = acc[ai][bj][mp + mm][0] * scale, v1 = acc[ai][bj][mp + mm][1] * scale; w[mm][0] = pk4_fp8(v0[0], v0[1], v0[2], v0[3]); w[mm][1] = pk4_fp8(v1[0], v1[1], v1[2], v1[3]); }
                    swap32(w[0][0], w[1][0]); swap32(w[0][1], w[1][1]);
                    const u32x4 o = {w[0][0], w[0][1], w[1][0], w[1][1]};
                    unsigned char* op_ = O + (size_t)(u.orow0 + ai * 128 + wr * 64 + (mp + hi) * 16 + fr) * ldo + u.ocol0 + bj * 128 + wc * 32 + cg;
                    if (WT_STORES & 1) st16_wt(op_, o); else *(u32x4*)op_ = o; }
    }
};

template <class Epi>
__device__ __forceinline__ void gemm_unit_simple(const GemmDesc& g, const GUnit& u, const Epi& E) {
    int tid = otid();
    const int wid = __builtin_amdgcn_readfirstlane(tid >> 6), lane = tid & 63, wr = wid >> 2, wc = wid & 3, fr = lane & 15, fq = lane >> 4;
    f32x4 acc[2][2][4][2];
#pragma unroll
    for (int a = 0; a < 2; ++a)
#pragma unroll
        for (int b = 0; b < 2; ++b)
#pragma unroll
            for (int m = 0; m < 4; ++m)
#pragma unroll
                for (int n = 0; n < 2; ++n) acc[a][b][m][n] = (f32x4){0.f, 0.f, 0.f, 0.f};
    const bf16_t* ap[2][4]; const bf16_t* bp[2][2];
#pragma unroll
    for (int ai = 0; ai < 2; ++ai)
#pragma unroll
        for (int m = 0; m < 4; ++m) { const int r = u.arow0 + ai * 128 + wr * 64 + m * 16 + fr; int src = g.ridx ? g.ridx[r] : r; if (src < 0) src = 0; ap[ai][m] = g.A + (size_t)src * g.lda + 8 * fq; }
#pragma unroll
    for (int bj = 0; bj < 2; ++bj)
#pragma unroll
        for (int n = 0; n < 2; ++n) bp[bj][n] = u.B + (size_t)(bj * 128 + wc * 32 + n * 16 + fr) * g.ldb + 8 * fq;
    int Kq = g.K; asm volatile("" : "+s"(Kq));
#pragma unroll 1
    for (int k0 = 0; k0 < Kq; k0 += 32) {
        bf16x8 a[2][4], b[2][2];
#pragma unroll
        for (int ai = 0; ai < 2; ++ai)
#pragma unroll
            for (int m = 0; m < 4; ++m) a[ai][m] = *(const bf16x8*)(ap[ai][m] + k0);
#pragma unroll
        for (int bj = 0; bj < 2; ++bj)
#pragma unroll
            for (int n = 0; n < 2; ++n) b[bj][n] = *(const bf16x8*)(bp[bj][n] + k0);
#pragma unroll
        for (int ai = 0; ai < 2; ++ai)
#pragma unroll
            for (int bj = 0; bj < 2; ++bj)
#pragma unroll
                for (int m = 0; m < 4; ++m)
#pragma unroll
                    for (int n = 0; n < 2; ++n) acc[ai][bj][m][n] = __builtin_amdgcn_mfma_f32_16x16x32_bf16(b[bj][n], a[ai][m], acc[ai][bj][m][n], 0, 0, 0);
    }
    E(acc, u, wr, wc, fr, fq);
}

struct DenseSched {
    const bf16_t* Bt; int ldb, nM, nN, row0, pn0;
    __device__ __forceinline__ int count() const { return nM * nN; }
    __device__ __forceinline__ int ncol() const { return nN; }
    __device__ __forceinline__ void unit(int i, GUnit& u) const { const int pm = i / nN, pn = pn0 + i % nN; u.arow0 = row0 + pm * 256; u.B = Bt + (size_t)pn * 256 * ldb; u.orow0 = u.arow0; u.ocol0 = pn * 256; }
};
struct MoeSched {
    const LAS int* te; const LAS int* ts; int ntiles, npn; const bf16_t* Bt; size_t estride; int ldb, ocolw;
    __device__ __forceinline__ int count() const { return ntiles * npn; }
    __device__ __forceinline__ int ncol() const { return npn; }
    __device__ __forceinline__ void unit(int i, GUnit& u) const { const int t = i / npn, pn = i % npn; const int e = te[t]; u.arow0 = ts[t]; u.B = Bt + (size_t)e * estride + (size_t)pn * 256 * ldb; u.orow0 = u.arow0; u.ocol0 = pn * ocolw; }
};
template <class Sched, class Epi>
__device__ __forceinline__ void gemm_phase_simple(const GemmDesc& g, const Sched& S, const Epi& E) {
    const int n = S.count();
    for (int i = blockIdx.x; i < n; i += gridDim.x) { GUnit u; S.unit(i, u); gemm_unit_simple(g, u, E); }
}
__device__ __forceinline__ int wave_incl_scan(int v, int lane) {
#pragma unroll
    for (int o = 1; o < 64; o <<= 1) { const int t = __shfl_up(v, o); if (lane >= o) v += t; }
    return v;
}
__device__ __forceinline__ int moe_build_tiles(const unsigned* cnt, int nshared, LAS int* te, LAS int* ts, LAS int* misc) {
    __syncthreads();
    const int tid = otid();
    if (tid < 64) {
        const int c = (int)cnt[tid], ntile = (c + 255) >> 8, incl = wave_incl_scan(ntile, tid), first = incl - ntile;
        for (int j = 0; j < ntile; ++j) { te[first + j] = tid; ts[first + j] = (first + j) * 256; }
        const int nrt = __shfl(incl, 63);
        for (int j = tid; j < nshared; j += 64) { te[nrt + j] = NEXP; ts[nrt + j] = RSLOTS + j * 256; }
        if (tid == 0) misc[0] = nrt + nshared;
    }
    __syncthreads();
    return misc[0];
}
#ifndef FAST_GEMM
#define FAST_GEMM 0
#endif
#if !FAST_GEMM
#define GEMM_PHASE(g, S, E) gemm_phase_simple(g, S, E)
#endif

#if FAST_GEMM
constexpr int HTB = 128 * 64 * 2;
__device__ __forceinline__ int lds_byte(int r, int c) { const int st = (r >> 4) * 2 + (c >> 5), rr = r & 15, cc = c & 31, ob = rr * 64 + cc * 2; return st * 1024 + (ob ^ (((ob >> 9) & 1) << 5)); }
__device__ __forceinline__ void stage_rc(int b, int& R, int& C) { const int st = b / 1024, sb = b % 1024, swz = sb ^ (((sb >> 9) & 1) << 5); R = (st >> 1) * 16 + swz / 64; C = (st & 1) * 32 + (swz % 64) / 2; }

#ifndef KREP_PROBE
#define KREP_PROBE 1
#endif
#ifndef EPI_REP
#define EPI_REP 1
#endif
#ifndef GEMM_EARLY
#define GEMM_EARLY 1
#endif
typedef float f32x2z __attribute__((ext_vector_type(2)));
#ifndef ZERO64
#define ZERO64 1
#endif
__device__ __forceinline__ f32x4 zero4() {
#if ZERO64
    f32x2z a, b; asm("v_mov_b64 %0, 0" : "=v"(a)); asm("v_mov_b64 %0, 0" : "=v"(b)); return (f32x4){a.x, a.y, b.x, b.y};
#else
    return (f32x4){0.f, 0.f, 0.f, 0.f};
#endif
}
template <int N> __device__ __forceinline__ void wait_vm() { asm volatile("s_waitcnt vmcnt(%0)" :: "n"(N) : "memory"); }
typedef int v8i __attribute__((ext_vector_type(8)));
typedef int v4i __attribute__((ext_vector_type(4)));
template <int ESZ, class Sched, class Epi>
__device__ __forceinline__ void gemm_phase_fast(LAS unsigned char* lds, const GemmDesc& g, const Sched& S, const Epi& E, int scA = 127, int scB = 127, int rot = 0, int lo = 0) {
    const int tid = otid(), wid = __builtin_amdgcn_readfirstlane(tid >> 6), lane = tid & 63, wr = wid >> 2, wc = wid & 3, fr = lane & 15, fq = lane >> 4;
    const int K = g.K, nunits = S.count(), G = gridDim.x, c0 = blockIdx.x;
    int nt = K * ESZ / 128; asm volatile("" : "+s"(nt));
    const int krep = (KREP_PROBE > 1 && ESZ == 1 && K == 512) ? KREP_PROBE : 1; scB -= (krep == 2) ? 1 : ((krep == 4) ? 2 : 0);
    const int npn = S.ncol(); const bool xmap = (G % 8 == 0) && ((G / 8) % npn == 0); const int xT = xmap ? (G / 8) / npn : 1, xx = (c0 + rot) % 8, xr = c0 / 8;
#define F_UNIT(ui_) (xmap ? (((ui_) * 8 + xx) * xT + xr / npn) * npn + xr % npn : ((ui_) == 0 ? c0 : (c0 >= lo ? G + ((ui_) - 1) * (G - lo) + (c0 - lo) : nunits)))
    if (F_UNIT(0) >= nunits) return;
    int R[2], C[2]; unsigned voffB[2];
#pragma unroll
    for (int i = 0; i < 2; ++i) { stage_rc(tid * 16 + i * 8192, R[i], C[i]); const int Rb = Epi::PERM ? ((R[i] & ~31) + (Epi::PERMKIND ? perm32b(R[i] & 31) : perm32(R[i] & 31))) : R[i]; voffB[i] = (unsigned)(Rb * g.ldb) * (unsigned)ESZ + (unsigned)C[i] * 2u; }
    const size_t kstep = 128;
    const size_t hstepB = (size_t)128 * g.ldb * ESZ;
    const unsigned ldsw = (unsigned)wid * 1024u;
    const int aoff = lds_byte(wr * 64 + fr, fq * 8), boff = lds_byte(wc * 32 + fr, fq * 8);
    const char* Ab = (const char*)g.A;
#define F_SA(b, h) (((b) * 2 + (h)) * HTB)
#define F_SB(b, h) ((4 + (b) * 2 + (h)) * HTB)
#define F_STAGE(bufoff, gbase, voff) do { _Pragma("unroll") for (int _i = 0; _i < 2; ++_i) \
        __builtin_amdgcn_global_load_lds((const unsigned*)((const char*)(gbase) + (voff)[_i]), (LAS unsigned*)(lds + (bufoff) + ldsw + _i * 8192), 16, 0, 0); } while (0)
#define F_LDA(dst, b, h) do { _Pragma("unroll") for (int m = 0; m < 4; ++m) { if constexpr (ESZ == 2) { _Pragma("unroll") for (int k = 0; k < 2; ++k) dst[m][k] = *(const LAS bf16x8*)(lds + F_SA(b, h) + aoff + m * 2048 + k * 1024); } \
        else { const v4i lo_ = *(const LAS v4i*)(lds + F_SA(b, h) + aoff + m * 2048), hi_ = *(const LAS v4i*)(lds + F_SA(b, h) + aoff + m * 2048 + 1024); dst##8[m] = __builtin_shufflevector(lo_, hi_, 0, 1, 2, 3, 4, 5, 6, 7); } } } while (0)
#define F_LDB(dst, b, h) do { _Pragma("unroll") for (int n = 0; n < 2; ++n) { if constexpr (ESZ == 2) { _Pragma("unroll") for (int k = 0; k < 2; ++k) dst[n][k] = *(const LAS bf16x8*)(lds + F_SB(b, h) + boff + n * 2048 + k * 1024); } \
        else { const v4i lo_ = *(const LAS v4i*)(lds + F_SB(b, h) + boff + n * 2048), hi_ = *(const LAS v4i*)(lds + F_SB(b, h) + boff + n * 2048 + 1024); dst##8[n] = __builtin_shufflevector(lo_, hi_, 0, 1, 2, 3, 4, 5, 6, 7); } } } while (0)
#define F_MMA(ai, bj, At, Bt) do { __builtin_amdgcn_s_setprio(1); _Pragma("unroll") for (int m = 0; m < 4; ++m) _Pragma("unroll") for (int n = 0; n < 2; ++n) { \
        if constexpr (ESZ == 2) { _Pragma("unroll") for (int k = 0; k < 2; ++k) acc[ai][bj][m][n] = __builtin_amdgcn_mfma_f32_16x16x32_bf16(Bt[n][k], At[m][k], acc[ai][bj][m][n], 0, 0, 0); } \
        else acc[ai][bj][m][n] = __builtin_amdgcn_mfma_scale_f32_16x16x128_f8f6f4(Bt##8[n], At##8[m], acc[ai][bj][m][n], 0, 0, 0, scB, 0, scA); } \
        __builtin_amdgcn_s_setprio(0); } while (0)
#define F_WAIT_V(n) asm volatile("s_waitcnt vmcnt(" #n ")" ::: "memory")
#define F_WAIT_L(n) asm volatile("s_waitcnt lgkmcnt(" #n ")" ::: "memory")
#define F_BAR __builtin_amdgcn_s_barrier()
#define F_SCHED __builtin_amdgcn_sched_barrier(0)
#define F_AROWS(u, dst) do { _Pragma("unroll") for (int _h = 0; _h < 2; ++_h) _Pragma("unroll") for (int _i = 0; _i < 2; ++_i) { const int _r = (u).arow0 + _h * 128 + R[_i]; int _s = g.ridx ? g.ridx[_r] : _r; if (_s < 0) _s = 0; dst[_h][_i] = _s; } } while (0)
#define F_AOFFS(src, dst) do { _Pragma("unroll") for (int _h = 0; _h < 2; ++_h) _Pragma("unroll") for (int _i = 0; _i < 2; ++_i) dst[_h][_i] = (unsigned)(src[_h][_i] < 0 ? 0 : src[_h][_i]) * (unsigned)g.lda * (unsigned)ESZ + (unsigned)C[_i] * 2u; } while (0)
#define F_AROWS_ASYNC(u, dst) do { _Pragma("unroll") for (int _h = 0; _h < 2; ++_h) _Pragma("unroll") for (int _i = 0; _i < 2; ++_i) { const int _r = (u).arow0 + _h * 128 + R[_i]; \
        if (g.ridx) { int _v; asm volatile("global_load_dword %0, %1, off" : "=v"(_v) : "v"(g.ridx + _r) : "memory"); dst[_h][_i] = _v; } else dst[_h][_i] = _r; } } while (0)
#define F_AUSE(x) do { _Pragma("unroll") for (int _h = 0; _h < 2; ++_h) _Pragma("unroll") for (int _i = 0; _i < 2; ++_i) asm volatile("" : "+v"(x[_h][_i])); } while (0)
    GUnit cur, nxt; int ui = 0;
    S.unit(F_UNIT(0), cur);
    f32x4 acc[2][2][4][2];
#pragma unroll
    for (int a = 0; a < 2; ++a)
#pragma unroll
        for (int b = 0; b < 2; ++b)
#pragma unroll
            for (int m = 0; m < 4; ++m)
#pragma unroll
                for (int n = 0; n < 2; ++n) acc[a][b][m][n] = (f32x4){0.f, 0.f, 0.f, 0.f};
    bf16x8 At[4][2], B0[2][2], B1[2][2]; v8i At8[4], B08[2], B18[2];
    unsigned voA[2][2]; int rnx[2][2];
    F_AROWS(cur, rnx); F_AOFFS(rnx, voA);
    const char* cB = (const char*)cur.B;
    F_STAGE(F_SB(0, 0), cB, voffB); F_STAGE(F_SA(0, 0), Ab, voA[0]); F_STAGE(F_SB(0, 1), cB + hstepB, voffB); F_STAGE(F_SA(0, 1), Ab, voA[1]);
    if (wr == 1) F_BAR;
    F_WAIT_V(4); F_BAR;
    F_STAGE(F_SB(1, 0), cB + kstep, voffB); F_STAGE(F_SA(1, 0), Ab + kstep, voA[0]); F_STAGE(F_SB(1, 1), cB + hstepB + kstep, voffB);
#if GEMM_EARLY
    F_STAGE(F_SA(1, 1), Ab + kstep, voA[1]); F_WAIT_V(8); F_BAR;
#else
    F_WAIT_V(6); F_BAR;
#endif
    for (;;) {
        const int Ln = F_UNIT(ui + 1); const bool has_next = Ln < nunits;
        if (has_next) { S.unit(Ln, nxt); if (GEMM_EARLY) F_AROWS_ASYNC(nxt, rnx); else F_AROWS(nxt, rnx); }
        const char* nB = has_next ? (const char*)nxt.B : cB;
#pragma unroll 1
        for (int tt = 0; tt < nt * krep; tt += 2) {
            const int t = tt % nt; const bool last = (tt == nt * krep - 2), wrap = (t == nt - 2);
            const char* a1 = Ab + (size_t)(t + 1) * kstep;
            const char* a2 = wrap ? Ab : Ab + (size_t)(t + 2) * kstep; const char* b2 = wrap ? (last ? nB : cB) : cB + (size_t)(t + 2) * kstep;
            const char* a3 = a2 + kstep; const char* b3 = b2 + kstep;
            F_LDB(B0, 0, 0); F_SCHED; F_LDA(At, 0, 0); if (!GEMM_EARLY) F_STAGE(F_SA(1, 1), a1, voA[1]);
            if (last && has_next) { if (GEMM_EARLY) F_AUSE(rnx); F_AOFFS(rnx, voA); }
            F_WAIT_L(8); F_BAR; F_WAIT_L(0); F_MMA(0, 0, At, B0); F_BAR; F_SCHED;
            F_LDB(B1, 0, 1); F_STAGE(F_SB(0, 0), b2, voffB);
            F_BAR; F_WAIT_L(0); F_MMA(0, 1, At, B1); F_BAR;
            F_LDA(At, 0, 1); F_STAGE(F_SA(0, 0), a2, voA[0]);
            F_BAR; F_WAIT_L(0); F_MMA(1, 0, At, B0); F_BAR; F_SCHED;
            F_STAGE(F_SB(0, 1), b2 + hstepB, voffB);
            if (GEMM_EARLY == 1) asm volatile("s_cmp_lg_u32 %0, 0\n\ts_cbranch_scc1 1f\n\ts_cmp_eq_u32 %1, 0\n\ts_cbranch_scc1 1f\n\ts_waitcnt vmcnt(%2)\n\ts_branch 2f\n1:\n\ts_waitcnt vmcnt(6)\n2:" :: "s"(tt), "s"(ui), "n"(6 + Epi::NVM) : "scc", "memory");
            else if (GEMM_EARLY == 2) F_WAIT_V(6);
            else F_WAIT_V(6);
            F_BAR; F_MMA(1, 1, At, B1); F_BAR;
            F_LDB(B0, 1, 0); F_SCHED; F_LDA(At, 1, 0); F_STAGE(F_SA(0, 1), a2, voA[1]);
            F_WAIT_L(8); F_BAR; F_WAIT_L(0); F_MMA(0, 0, At, B0); F_BAR; F_SCHED;
            F_LDB(B1, 1, 1); F_STAGE(F_SB(1, 0), b3, voffB);
            F_BAR; F_WAIT_L(0); F_MMA(0, 1, At, B1); F_BAR;
            F_LDA(At, 1, 1); F_STAGE(F_SA(1, 0), a3, voA[0]);
            F_BAR; F_WAIT_L(0); F_MMA(1, 0, At, B0); F_BAR; F_SCHED;
            F_STAGE(F_SB(1, 1), b3 + hstepB, voffB);
            F_WAIT_V(6); F_BAR; F_MMA(1, 1, At, B1); F_BAR;
            if (GEMM_EARLY) F_STAGE(F_SA(1, 1), a3, voA[1]);
        }
#pragma unroll
        for (int er_ = 0; er_ < EPI_REP; ++er_) E(acc, cur, wr, wc, fr, fq);
        if (!has_next) break;
#pragma unroll
        for (int a = 0; a < 2; ++a)
#pragma unroll
            for (int b = 0; b < 2; ++b)
#pragma unroll
                for (int m = 0; m < 4; ++m)
#pragma unroll
                    for (int n = 0; n < 2; ++n) acc[a][b][m][n] = zero4();
        cur = nxt; cB = nB; ++ui;
    }
    F_WAIT_V(0);
    if (wr == 0) F_BAR;
    F_BAR;
#undef F_UNIT
#undef F_SA
#undef F_SB
#undef F_STAGE
#undef F_LDA
#undef F_LDB
#undef F_MMA
#undef F_WAIT_V
#undef F_WAIT_L
#undef F_BAR
#undef F_SCHED
#undef F_AROWS
#undef F_AROWS_ASYNC
#undef F_AUSE
#undef F_AOFFS
}
#define GEMM_PHASE(g, S, E) gemm_phase_fast<2>(lds, g, S, E)
#define GEMM_PHASE8(g, S, E, sa, sb) gemm_phase_fast<1>(lds, g, S, E, sa, sb)
#ifndef GEMM_ROT
#define GEMM_ROT 1
#endif
#define GEMM_PHASE_R(g, S, E, rot, lo) gemm_phase_fast<2>(lds, g, S, E, 127, 127, GEMM_ROT ? (rot) : 0, GEMM_ROT ? (lo) : 0)
#define GEMM_PHASE8_R(g, S, E, sa, sb, rot) gemm_phase_fast<1>(lds, g, S, E, sa, sb, GEMM_ROT ? (rot) : 0, 0)
#endif

#define SBAR() __builtin_amdgcn_sched_barrier(0)
#ifndef ATT_OPAIR
#define ATT_OPAIR 0
#endif
#ifndef ATT_OSTAGE
#define ATT_OSTAGE 0
#endif
#ifdef ATT_SETPRIO
#define ATT_PRIO(x) __builtin_amdgcn_s_setprio(x)
#else
#define ATT_PRIO(x) do { } while (0)
#endif
__device__ __forceinline__ int crow(int r, int hi) { return (r & 3) + 8 * (r >> 2) + 4 * hi; }
template <int DQK> __device__ __forceinline__ int kaddr(int row, int chunk) {
    const int sw = (DQK == 128) ? (row & 7) : ((row >> 1) & 7);
    return row * (DQK * 2) + ((chunk ^ sw) << 4);
}
__device__ __forceinline__ void partialSM(f32x16& p0, f32x16& p1, float& m_reg, float& mn, float& alpha, float C, float thr) {
    float pmax = p0[0];
#pragma unroll
    for (int r = 1; r < 16; ++r) pmax = fmaxf(pmax, p0[r]);
#pragma unroll
    for (int r = 0; r < 16; ++r) pmax = fmaxf(pmax, p1[r]);
    { auto rr = __builtin_amdgcn_permlane32_swap(__float_as_uint(pmax), __float_as_uint(pmax), false, false);
      pmax = fmaxf(__uint_as_float(rr[0]), __uint_as_float(rr[1])); }
    if (__builtin_expect(__all(pmax - m_reg <= thr), 1)) { mn = m_reg; alpha = 1.f; }
    else { mn = fmaxf(m_reg, pmax); alpha = __builtin_amdgcn_exp2f((m_reg - mn) * C); m_reg = mn; }
    const float mnC = -mn * C;
#pragma unroll
    for (int r = 0; r < 16; ++r) p0[r] = fmaf(p0[r], C, mnC);
#pragma unroll
    for (int r = 0; r < 16; ++r) p1[r] = fmaf(p1[r], C, mnC);
#pragma unroll
    for (int r = 0; r < 16; ++r) p0[r] = __builtin_amdgcn_exp2f(p0[r]);
}
__device__ __forceinline__ void finishSM(f32x16& p0, f32x16& p1, float alpha, float& l_reg, bf16x8& pa0, bf16x8& pa1, bf16x8& pa2, bf16x8& pa3) {
#pragma unroll
    for (int r = 0; r < 16; ++r) p1[r] = __builtin_amdgcn_exp2f(p1[r]);
    float ps = 0;
#pragma unroll
    for (int r = 0; r < 16; ++r) ps += p0[r];
#pragma unroll
    for (int r = 0; r < 16; ++r) ps += p1[r];
    { auto rr = __builtin_amdgcn_permlane32_swap(__float_as_uint(ps), __float_as_uint(ps), false, false);
      ps = __uint_as_float(rr[0]) + __uint_as_float(rr[1]); }
    l_reg = l_reg * alpha + ps;
#define PK4(P, BASE, OUT) do { unsigned a0 = pk2(P[BASE + 0], P[BASE + 1]), a1 = pk2(P[BASE + 2], P[BASE + 3]);   \
    unsigned b0 = pk2(P[BASE + 4], P[BASE + 5]), b1 = pk2(P[BASE + 6], P[BASE + 7]);                              \
    auto r0 = __builtin_amdgcn_permlane32_swap(a0, b0, false, false); auto r1 = __builtin_amdgcn_permlane32_swap(a1, b1, false, false); \
    u32x4 w = {r0[0], r1[0], r0[1], r1[1]}; OUT = *reinterpret_cast<bf16x8*>(&w); } while (0)
    PK4(p0, 0, pa0); PK4(p0, 8, pa1); PK4(p1, 0, pa2); PK4(p1, 8, pa3);
#undef PK4
}
template <int DQK, int QREG> __device__ __forceinline__ void qkt(f32x16& p0, f32x16& p1, const char* Ks, const bf16x8* qr, const bf16_t* Qw, int r32, int hi) {
    p0 = f32x16{}; p1 = f32x16{};
    bf16x8 qx[DQK / 16 - QREG + 1];
#pragma unroll
    for (int d0 = QREG; d0 < DQK / 16; ++d0) qx[d0 - QREG] = *reinterpret_cast<const bf16x8*>(Qw + d0 * 16);
#pragma unroll
    for (int d0 = 0; d0 < DQK / 16; ++d0) { const int ch = 2 * d0 + hi; const bf16x8 qv = (d0 < QREG) ? qr[d0] : qx[d0 < QREG ? 0 : d0 - QREG];
        const bf16x8 b0 = *reinterpret_cast<const bf16x8*>(Ks + kaddr<DQK>(r32, ch));
        const bf16x8 b1 = *reinterpret_cast<const bf16x8*>(Ks + kaddr<DQK>(32 + r32, ch));
        p0 = __builtin_amdgcn_mfma_f32_32x32x16_bf16(b0, qv, p0, 0, 0, 0);
        p1 = __builtin_amdgcn_mfma_f32_32x32x16_bf16(b1, qv, p1, 0, 0, 0); }
}
__device__ __forceinline__ int v_st(int k, int c) { const int kk = (k & ~0xC) | ((k & 4) << 1) | ((k & 8) >> 1); return ((kk >> 3) * 4 + (c >> 5)) * 512 + ((kk & 7) * 32 + (c & 31)) * 2; }
__device__ __forceinline__ int v_rd_base(int lane) { return ((lane & 3) << 3) | (((lane >> 2) & 3) << 6) | (((lane >> 4) & 1) << 5) | (((lane >> 5) & 1) << 8); }
constexpr int v_rd_off(int d0, int ks, int half) { return d0 * 512 + ks * 4096 + half * 2048; }
template <int OFF> __device__ __forceinline__ s16x4 tr_read(int vb) {
    s16x4 r; asm volatile("ds_read_b64_tr_b16 %0, %1 offset:%2" : "=&v"(r) : "v"(vb), "i"(OFF) : "memory"); return r;
}
template <int D0> __device__ __forceinline__ void pv_one(f32x16& od, int vb, bf16x8 pa0, bf16x8 pa1, bf16x8 pa2, bf16x8 pa3) {
    const s16x4 l0 = tr_read<v_rd_off(D0, 0, 0)>(vb), h0 = tr_read<v_rd_off(D0, 0, 1)>(vb), l1 = tr_read<v_rd_off(D0, 1, 0)>(vb), h1 = tr_read<v_rd_off(D0, 1, 1)>(vb);
    const s16x4 l2 = tr_read<v_rd_off(D0, 2, 0)>(vb), h2 = tr_read<v_rd_off(D0, 2, 1)>(vb), l3 = tr_read<v_rd_off(D0, 3, 0)>(vb), h3 = tr_read<v_rd_off(D0, 3, 1)>(vb);
    asm volatile("s_waitcnt lgkmcnt(0)" ::: "memory"); SBAR();
#define PK(L, H) (bf16x8){L[0], L[1], L[2], L[3], H[0], H[1], H[2], H[3]}
    od = __builtin_amdgcn_mfma_f32_32x32x16_bf16(pa0, PK(l0, h0), od, 0, 0, 0);
    od = __builtin_amdgcn_mfma_f32_32x32x16_bf16(pa1, PK(l1, h1), od, 0, 0, 0);
    od = __builtin_amdgcn_mfma_f32_32x32x16_bf16(pa2, PK(l2, h2), od, 0, 0, 0);
    od = __builtin_amdgcn_mfma_f32_32x32x16_bf16(pa3, PK(l3, h3), od, 0, 0, 0);
#undef PK
}
__device__ __forceinline__ void pv_d0(f32x16* o, int vb, bf16x8 pa0, bf16x8 pa1, bf16x8 pa2, bf16x8 pa3) {
    pv_one<0>(o[0], vb, pa0, pa1, pa2, pa3); pv_one<1>(o[1], vb, pa0, pa1, pa2, pa3); pv_one<2>(o[2], vb, pa0, pa1, pa2, pa3); pv_one<3>(o[3], vb, pa0, pa1, pa2, pa3);
}

template <int DQK, int SDEPTH, int QREG = DQK / 16>
__device__ __forceinline__ void attn_body(const bf16_t* __restrict__ Qb, const bf16_t* __restrict__ Kh, const bf16_t* __restrict__ Vh, bf16_t* __restrict__ Ob, int ldo, int nkeys, float scale, char* lds) {
    constexpr int SHM_V = 64 * 128 * 2, SHM_K = 64 * DQK * 2, NKC = DQK / 8, KPT = NKC / 8;
    int tid = otid();
    const int wid = __builtin_amdgcn_readfirstlane(tid >> 6), lane = tid & 63, r32 = lane & 31, hi = lane >> 5;
    char* V_lds = lds; char* K_lds = lds + 2 * SHM_V;
    float* ws = (float*)(lds + 2 * SHM_V + 2 * SHM_K) + wid * 64; float* li_l = ws; float* al_l = ws + 32;
    const float C = scale * 1.4426950408889634f, thr = 8.0f / scale;
    float m_reg = -1e30f, l_reg = 0; f32x16 o[4] = {}; bf16x8 qr[QREG];
    const bf16_t* Qw = Qb + (long)(wid * 32 + r32) * DQK + hi * 8;
#pragma unroll
    for (int d0 = 0; d0 < QREG; ++d0) qr[d0] = *reinterpret_cast<const bf16x8*>(Qw + d0 * 16);
    const int sr = tid >> 4, sc = (tid & 15) * 8, vst0 = v_st(sr, sc), vst1 = v_st(32 + sr, sc);
    int kgo[KPT], klo[KPT];
#pragma unroll
    for (int i = 0; i < KPT; ++i) { const int q = tid + 512 * i, row = q / NKC, ch = q % NKC; kgo[i] = row * DQK + ch * 8; klo[i] = kaddr<DQK>(row, ch); }
    const int vb0 = (int)(uintptr_t)V_lds + v_rd_base(lane);
    struct { bf16x8 vs0, vs1, ks[KPT]; } sr_[SDEPTH ? SDEPTH : 1];
#define SLOAD(i, k0) do { sr_[i].vs0 = *reinterpret_cast<const bf16x8*>(&Vh[(long)((k0) + sr) * 128 + sc]); sr_[i].vs1 = *reinterpret_cast<const bf16x8*>(&Vh[(long)((k0) + 32 + sr) * 128 + sc]); \
    _Pragma("unroll") for (int _q = 0; _q < KPT; ++_q) sr_[i].ks[_q] = *reinterpret_cast<const bf16x8*>(&Kh[(long)(k0) * DQK + kgo[_q]]); } while (0)
#define SWRITE(b, i) do { *(bf16x8*)(V_lds + (b) * SHM_V + vst0) = sr_[i].vs0; *(bf16x8*)(V_lds + (b) * SHM_V + vst1) = sr_[i].vs1; \
    _Pragma("unroll") for (int _q = 0; _q < KPT; ++_q) *(bf16x8*)(K_lds + (b) * SHM_K + klo[_q]) = sr_[i].ks[_q]; } while (0)
#define SWAIT() do { if constexpr (SDEPTH == 2) { if constexpr (KPT == 2) asm volatile("s_waitcnt vmcnt(4)" ::: "memory"); else asm volatile("s_waitcnt vmcnt(5)" ::: "memory"); } \
    else asm volatile("s_waitcnt vmcnt(0)" ::: "memory"); } while (0)
#define RESC(a) do { if (__any((a) < 1.f)) { if (hi == 0) al_l[r32] = (a); asm volatile("s_waitcnt lgkmcnt(0)" ::: "memory"); \
    _Pragma("unroll") for (int d = 0; d < 4; ++d) _Pragma("unroll") for (int r = 0; r < 16; ++r) o[d][r] *= al_l[crow(r, hi)]; } } while (0)
    bf16x8 pa0, pa1, pa2, pa3; const int NT = nkeys / 64;
    if constexpr (SDEPTH == 0) {
        f32x16 pA0, pA1; float mnA, alA;
        SLOAD(0, 0); asm volatile("s_waitcnt vmcnt(0)" ::: "memory"); SWRITE(0, 0); __syncthreads();
        for (int j = 0; j < NT; ++j) {
            const int bo = j & 1;
            if (j + 1 < NT) SLOAD(0, (j + 1) * 64);
            SBAR(); ATT_PRIO(1); qkt<DQK, QREG>(pA0, pA1, K_lds + bo * SHM_K, qr, Qw, r32, hi); ATT_PRIO(0); partialSM(pA0, pA1, m_reg, mnA, alA, C, thr);
            RESC(alA); finishSM(pA0, pA1, alA, l_reg, pa0, pa1, pa2, pa3); SBAR();
            ATT_PRIO(1); pv_d0(o, vb0 + bo * SHM_V, pa0, pa1, pa2, pa3); ATT_PRIO(0);
            if (j + 1 < NT) { asm volatile("s_waitcnt vmcnt(0)" ::: "memory"); SWRITE(bo ^ 1, 0); }
            __syncthreads();
        }
    } else {
    f32x16 pA0, pA1, pB0, pB1; float mnA, mnB, alA, alB;
    constexpr int SE = 0, SO = SDEPTH - 1;
    SLOAD(SE, 0); asm volatile("s_waitcnt vmcnt(0)" ::: "memory"); SWRITE(0, SE); __syncthreads();
    qkt<DQK, QREG>(pA0, pA1, K_lds, qr, Qw, r32, hi); partialSM(pA0, pA1, m_reg, mnA, alA, C, thr);
    SLOAD(SO, 64); if constexpr (SDEPTH == 2) { if (2 < NT) SLOAD(SE, 2 * 64); }
    SWAIT(); SWRITE(1, SO); __syncthreads();
    for (int j = 1; j + 1 < NT; j += 2) {
        SBAR(); qkt<DQK, QREG>(pB0, pB1, K_lds + SHM_K, qr, Qw, r32, hi);
        finishSM(pA0, pA1, alA, l_reg, pa0, pa1, pa2, pa3); SBAR();
        SLOAD(SO, (j + SDEPTH) * 64); SBAR();
        pv_d0(o, vb0, pa0, pa1, pa2, pa3); partialSM(pB0, pB1, m_reg, mnB, alB, C, thr);
        __syncthreads(); SWAIT(); SWRITE(0, SE);
        RESC(alB); __syncthreads();
        SBAR(); qkt<DQK, QREG>(pA0, pA1, K_lds, qr, Qw, r32, hi);
        finishSM(pB0, pB1, alB, l_reg, pa0, pa1, pa2, pa3); SBAR();
        if (SDEPTH == 1 || j + 3 < NT) SLOAD(SE, (j + 1 + SDEPTH) * 64); SBAR();
        pv_d0(o, vb0 + SHM_V, pa0, pa1, pa2, pa3); partialSM(pA0, pA1, m_reg, mnA, alA, C, thr);
        __syncthreads(); SWAIT(); SWRITE(1, SO);
        RESC(alA); __syncthreads();
    }
    SBAR(); qkt<DQK, QREG>(pB0, pB1, K_lds + SHM_K, qr, Qw, r32, hi);
    finishSM(pA0, pA1, alA, l_reg, pa0, pa1, pa2, pa3); SBAR();
    pv_d0(o, vb0, pa0, pa1, pa2, pa3); partialSM(pB0, pB1, m_reg, mnB, alB, C, thr);
    __syncthreads(); RESC(alB);
    finishSM(pB0, pB1, alB, l_reg, pa0, pa1, pa2, pa3); SBAR();
    pv_d0(o, vb0 + SHM_V, pa0, pa1, pa2, pa3);
    }
    if (hi == 0) li_l[r32] = l_reg; asm volatile("s_waitcnt lgkmcnt(0)" ::: "memory");
    float rli[16];
#pragma unroll
    for (int r = 0; r < 16; ++r) rli[r] = __builtin_amdgcn_rcpf(li_l[crow(r, hi)]);
    bf16_t* Ow = Ob + (long)(wid * 32) * ldo;
#if ATT_OSTAGE && !WOUT8
    __syncthreads();
    { char* og = lds + wid * (32 * 272);
#pragma unroll
      for (int d0 = 0; d0 < 4; ++d0)
#pragma unroll
          for (int r = 0; r < 16; r += 2) { const float v0 = o[d0][r] * rli[r], v1 = o[d0][r + 1] * rli[r + 1];
              const float snd = (lane & 1) ? v0 : v1; const float rcv = __int_as_float(__builtin_amdgcn_update_dpp(0, __float_as_int(snd), 0xB1, 0xF, 0xF, true));
              const unsigned w = (lane & 1) ? pk2(rcv, v1) : pk2(v0, rcv); const int row = crow(r, hi) + (lane & 1);
              *(unsigned*)(og + row * 272 + (d0 * 32 + (r32 & ~1)) * 2) = w; }
      asm volatile("s_waitcnt lgkmcnt(0)" ::: "memory");
#pragma unroll
      for (int i = 0; i < 8; ++i) { const int q = lane + 64 * i, row = q >> 4, cc = q & 15; *(u32x4*)(Ow + (long)row * ldo + cc * 8) = *(const u32x4*)(og + row * 272 + cc * 16); } }
#elif ATT_OPAIR && !WOUT8
#pragma unroll
    for (int d0 = 0; d0 < 4; ++d0)
#pragma unroll
        for (int r = 0; r < 16; r += 2) { const float v0 = o[d0][r] * rli[r], v1 = o[d0][r + 1] * rli[r + 1];
            const float snd = (lane & 1) ? v0 : v1; const float rcv = __int_as_float(__builtin_amdgcn_update_dpp(0, __float_as_int(snd), 0xB1, 0xF, 0xF, true));
            const unsigned w = (lane & 1) ? pk2(rcv, v1) : pk2(v0, rcv);
            *(unsigned*)(Ow + (long)(crow(r, hi) + (lane & 1)) * ldo + d0 * 32 + (r32 & ~1)) = w; }
#else
#pragma unroll
    for (int r = 0; r < 16; ++r) { const int orow = crow(r, hi);
#pragma unroll
        for (int d0 = 0; d0 < 4; ++d0) {
#if WOUT8
            ((unsigned char*)Ob)[(long)(wid * 32 + orow) * ldo + d0 * 32 + r32] = (unsigned char)(pk4_fp8(o[d0][r] * rli[r] * MIX8_SCALE, 0.f, 0.f, 0.f) & 0xffu);
#else
            Ow[(long)orow * ldo + d0 * 32 + r32] = f2bf(o[d0][r] * rli[r]);
#endif
        } }
#endif
    __syncthreads();
#undef SLOAD
#undef SWRITE
#undef SWAIT
#undef RESC
}

#ifndef ATT_DMA
#define ATT_DMA 3
#endif
#if ATT_DMA
template <int DQK>
__device__ __forceinline__ void attn_body_dma(const bf16_t* __restrict__ Qb, const bf16_t* __restrict__ Kh, const bf16_t* __restrict__ Vh, bf16_t* __restrict__ Ob, int ldo, int nkeys, float scale, LAS unsigned char* ldsL) {
    constexpr int SHM_V = 64 * 128 * 2, SHM_K = 64 * DQK * 2, TILE = SHM_K + SHM_V, NKC = DQK / 8, KPT = NKC / 8;
    const int tid = otid(), wid = __builtin_amdgcn_readfirstlane(tid >> 6), lane = tid & 63, r32 = lane & 31, hi = lane >> 5;
    char* lds = (char*)ldsL;
    float* ws = (float*)(lds + 3 * TILE) + wid * 64; float* li_l = ws; float* al_l = ws + 32;
    const float C = scale * 1.4426950408889634f, thr = 8.0f / scale;
    float m_reg = -1e30f, l_reg = 0; f32x16 o[4] = {}; bf16x8 qr[DQK / 16];
    const bf16_t* Qw = Qb + (long)(wid * 32 + r32) * DQK + hi * 8;
#pragma unroll
    for (int d0 = 0; d0 < DQK / 16; ++d0) qr[d0] = *reinterpret_cast<const bf16x8*>(Qw + d0 * 16);
    unsigned kgo[KPT], vgo[2];
#pragma unroll
    for (int i = 0; i < KPT; ++i) { const int q = i * 512 + tid, row = q / NKC, cp = q % NKC, sw = (DQK == 128) ? (row & 7) : ((row >> 1) & 7); kgo[i] = (unsigned)(row * DQK + ((cp ^ sw) << 3)) * 2u; }
#pragma unroll
    for (int i = 0; i < 2; ++i) { const int q = i * 512 + tid, st = q >> 5, w16 = q & 31, kk = (st >> 2) * 8 + (w16 >> 2), k = (kk & ~0xC) | ((kk & 4) << 1) | ((kk & 8) >> 1), c = (st & 3) * 32 + (w16 & 3) * 8; vgo[i] = (unsigned)(k * 128 + c) * 2u; }
    const int ldsb = (int)(uintptr_t)ldsL;
    const int vrb = v_rd_base(lane);
#define D_TILE(t, boff) do { const char* kp_ = (const char*)(Kh + (size_t)(t) * 64 * DQK); const char* vp_ = (const char*)(Vh + (size_t)(t) * 64 * 128); \
        _Pragma("unroll") for (int i_ = 0; i_ < KPT; ++i_) __builtin_amdgcn_global_load_lds((const unsigned*)(kp_ + kgo[i_]), (LAS unsigned*)(ldsL + (boff) + i_ * 8192 + wid * 1024), 16, 0, 0); \
        _Pragma("unroll") for (int i_ = 0; i_ < 2; ++i_) __builtin_amdgcn_global_load_lds((const unsigned*)(vp_ + vgo[i_]), (LAS unsigned*)(ldsL + (boff) + SHM_K + i_ * 8192 + wid * 1024), 16, 0, 0); } while (0)
#define D_WAIT1() do { if constexpr (KPT == 2) asm volatile("s_waitcnt vmcnt(4)" ::: "memory"); else asm volatile("s_waitcnt vmcnt(5)" ::: "memory"); } while (0)
#define D_WAIT2() do { if constexpr (KPT == 2) asm volatile("s_waitcnt vmcnt(8)" ::: "memory"); else asm volatile("s_waitcnt vmcnt(10)" ::: "memory"); } while (0)
#define D_WAIT0() asm volatile("s_waitcnt vmcnt(0)" ::: "memory")
#define D_BAR() do { asm volatile("s_waitcnt lgkmcnt(0)" ::: "memory"); __builtin_amdgcn_s_barrier(); asm volatile("" ::: "memory"); } while (0)
#define D_RESC(a) do { if (__any((a) < 1.f)) { if (hi == 0) al_l[r32] = (a); asm volatile("s_waitcnt lgkmcnt(0)" ::: "memory"); \
    _Pragma("unroll") for (int d = 0; d < 4; ++d) _Pragma("unroll") for (int r = 0; r < 16; ++r) o[d][r] *= al_l[crow(r, hi)]; } } while (0)
#define D_HALF(j, PC0, PC1, mnC, alC, PP0, PP1, alP, lastwait) do { \
        if (lastwait) D_WAIT0(); else D_WAIT1(); D_BAR(); \
        SBAR(); qkt<DQK, DQK / 16>(PC0, PC1, lds + o1, qr, Qw, r32, hi); \
        finishSM(PP0, PP1, alP, l_reg, pa0, pa1, pa2, pa3); SBAR(); \
        pv_d0(o, ldsb + o0 + SHM_K + vrb, pa0, pa1, pa2, pa3); partialSM(PC0, PC1, m_reg, mnC, alC, C, thr); \
        D_BAR(); \
        if ((j) + 2 < NT) D_TILE((j) + 2, o0); \
        D_RESC(alC); \
        { const int t_ = o0; o0 = o1; o1 = o2; o2 = t_; } } while (0)
    f32x16 pA0, pA1, pB0, pB1; float mnA, mnB, alA, alB; bf16x8 pa0, pa1, pa2, pa3; const int NT = nkeys / 64;
    int o0 = 0, o1 = TILE, o2 = 2 * TILE;
    D_TILE(0, 0); D_TILE(1, TILE); D_TILE(2, 2 * TILE);
    D_WAIT2(); D_BAR();
    qkt<DQK, DQK / 16>(pA0, pA1, lds, qr, Qw, r32, hi); partialSM(pA0, pA1, m_reg, mnA, alA, C, thr);
    for (int j = 1; j + 1 < NT; j += 2) {
        D_HALF(j, pB0, pB1, mnB, alB, pA0, pA1, alA, false);
        D_HALF(j + 1, pA0, pA1, mnA, alA, pB0, pB1, alB, false);
    }
    D_HALF(NT - 1, pB0, pB1, mnB, alB, pA0, pA1, alA, true);
    finishSM(pB0, pB1, alB, l_reg, pa0, pa1, pa2, pa3); SBAR();
    pv_d0(o, ldsb + o0 + SHM_K + vrb, pa0, pa1, pa2, pa3);
    if (hi == 0) li_l[r32] = l_reg; asm volatile("s_waitcnt lgkmcnt(0)" ::: "memory");
    float rli[16];
#pragma unroll
    for (int r = 0; r < 16; ++r) rli[r] = __builtin_amdgcn_rcpf(li_l[crow(r, hi)]);
    bf16_t* Ow = Ob + (long)(wid * 32) * ldo;
#pragma unroll
    for (int r = 0; r < 16; ++r) { const int orow = crow(r, hi);
#pragma unroll
        for (int d0 = 0; d0 < 4; ++d0) Ow[(long)orow * ldo + d0 * 32 + r32] = f2bf(o[d0][r] * rli[r]); }
    D_BAR();
#undef D_TILE
#undef D_WAIT1
#undef D_WAIT2
#undef D_WAIT0
#undef D_BAR
#undef D_RESC
#undef D_HALF
}
#endif

struct CvtMat { const float* src; bf16_t* dst; const float* kscale; int N, lddst, nb, mode; };
__device__ __forceinline__ void cvt_block(const CvtMat& m, int kb, int nbk, int lane) {
    const int a = lane & 7, ng = lane >> 3, k0 = kb * 64 + 8 * a, n0 = nbk * 32 + 4 * ng;
    const float* s = m.src + (size_t)k0 * m.N + n0;
    f32x4 v[8];
#pragma unroll
    for (int j = 0; j < 8; ++j) v[j] = (NT2 & 2) ? __builtin_nontemporal_load((const f32x4*)(s + (size_t)j * m.N)) : *(const f32x4*)(s + (size_t)j * m.N);
    if (m.kscale) {
#pragma unroll
        for (int j = 0; j < 8; ++j) v[j] *= m.kscale[k0 + j];
    }
#pragma unroll
    for (int i = 0; i < 4; ++i) { const int n = n0 + i, row = (m.mode == 0) ? n : ((n >> 7) * 256 + (n & 127) + (m.mode - 1) * 128);
        u32x4 w; w.x = pk2(v[0][i], v[1][i]); w.y = pk2(v[2][i], v[3][i]); w.z = pk2(v[4][i], v[5][i]); w.w = pk2(v[6][i], v[7][i]);
        *(u32x4*)(m.dst + (size_t)row * m.lddst + k0) = w; }
}
__device__ __forceinline__ void cvt_block8(const CvtMat& m, unsigned char* dst8, int kb, int nbk, int lane) {
    const int a = lane & 7, ng = lane >> 3, k0 = kb * 64 + 8 * a, n0 = nbk * 32 + 4 * ng;
    const float* s = m.src + (size_t)k0 * m.N + n0;
    f32x4 v[8];
#pragma unroll
    for (int j = 0; j < 8; ++j) v[j] = (CVT_NT ? __builtin_nontemporal_load((const f32x4*)(s + (size_t)j * m.N)) : *(const f32x4*)(s + (size_t)j * m.N)) * W8_SCALE;
#if WT_STORES & 2
    u32x2 w[4];
#pragma unroll
    for (int i = 0; i < 4; ++i) { w[i].x = pk4_fp8(v[0][i], v[1][i], v[2][i], v[3][i]); w[i].y = pk4_fp8(v[4][i], v[5][i], v[6][i], v[7][i]); }
    const bool odd = (a & 1) != 0;
    const u32x2 s0 = odd ? w[0] : w[2], s1 = odd ? w[1] : w[3]; u32x2 r0, r1;
    r0.x = (unsigned)__builtin_amdgcn_update_dpp(0, (int)s0.x, 0xB1, 0xF, 0xF, false); r0.y = (unsigned)__builtin_amdgcn_update_dpp(0, (int)s0.y, 0xB1, 0xF, 0xF, false);
    r1.x = (unsigned)__builtin_amdgcn_update_dpp(0, (int)s1.x, 0xB1, 0xF, 0xF, false); r1.y = (unsigned)__builtin_amdgcn_update_dpp(0, (int)s1.y, 0xB1, 0xF, 0xF, false);
    const u32x4 oA = odd ? (u32x4){r0.x, r0.y, w[2].x, w[2].y} : (u32x4){w[0].x, w[0].y, r0.x, r0.y}, oB = odd ? (u32x4){r1.x, r1.y, w[3].x, w[3].y} : (u32x4){w[1].x, w[1].y, r1.x, r1.y};
    const int kbase = k0 - (odd ? 8 : 0);
#pragma unroll
    for (int ii = 0; ii < 2; ++ii) { const int n = n0 + (odd ? 2 : 0) + ii, row = (m.mode == 0) ? n : ((n >> 7) * 256 + (n & 127) + (m.mode - 1) * 128);
        st16_wt(dst8 + (size_t)row * m.lddst + kbase, ii ? oB : oA); }
#else
#pragma unroll
    for (int i = 0; i < 4; ++i) { const int n = n0 + i, row = (m.mode == 0) ? n : ((n >> 7) * 256 + (n & 127) + (m.mode - 1) * 128);
        u32x2 w; w.x = pk4_fp8(v[0][i], v[1][i], v[2][i], v[3][i]); w.y = pk4_fp8(v[4][i], v[5][i], v[6][i], v[7][i]);
        if (NT2 & 8) __builtin_nontemporal_store(w, (u32x2*)(dst8 + (size_t)row * m.lddst + k0)); else *(u32x2*)(dst8 + (size_t)row * m.lddst + k0) = w; }
#endif
}
constexpr int CVT_SMALL = 3904 + 2048 + 432 + 192;
__device__ __forceinline__ void cvt_small_task(const Params& p, int l, int t, int lane) {
    unsigned char* ws = p.ws; CvtMat m; int which_ = 3;
    if (t < 3904) { which_ = 0; m = CvtMat{p.in[I_WIN] + (size_t)l * DM * IN_COLS, (bf16_t*)(ws + O_WIN) + (size_t)l * NP * DM, nullptr, IN_COLS, DM, 122, 0}; }
    else if ((t -= 3904) < 2048) { which_ = 1; m = CvtMat{p.in[I_WOUT] + (size_t)l * DM * DM, (bf16_t*)(ws + O_WOUT) + (size_t)l * DM * DM, nullptr, DM, DM, 64, 0}; }
    else if ((t -= 2048) < 432) { m = CvtMat{p.in[I_WUQ] + (size_t)l * 768 * 1152, (bf16_t*)(ws + O_WUQ) + (size_t)l * NQP * 768, p.in[I_MQN] + l * 768, 1152, 768, 36, 0}; }
    else { t -= 432; m = CvtMat{p.in[I_WUKV] + (size_t)l * 256 * 1536, (bf16_t*)(ws + O_WUKV) + (size_t)l * 1536 * 256, p.in[I_MKVN] + l * 256, 1536, 256, 48, 0}; }
    if (WIN8 && which_ == 0) cvt_block8(m, p.ws + O_WIN + (size_t)l * NP * DM, t / m.nb, t % m.nb, lane);
    else if (WOUT8 && which_ == 1) cvt_block8(m, p.ws + O_WOUT + (size_t)l * DM * DM, t / m.nb, t % m.nb, lane);
    else cvt_block(m, t / m.nb, t % m.nb, lane);
}
constexpr int CVT_EXP = 65 * 1536;
__device__ __forceinline__ void cvt_exp_blk(const Params& p, int l, int e, int which, int q, int lane);
__device__ __forceinline__ void cvt_exp_task(const Params& p, int l, int t, int lane) { const int e = t / 1536, r = t % 1536; cvt_exp_blk(p, l, e, r >> 9, r & 511, lane); }
constexpr int CVT_GU = 65 * 1024;
__device__ __forceinline__ void cvt_exp_task_bg(const Params& p, int l, int t, int lane) {
    if (t < CVT_GU) { const int r = t & 1023; cvt_exp_blk(p, l, t >> 10, r >> 9, r & 511, lane); } else { t -= CVT_GU; cvt_exp_blk(p, l, t >> 9, 2, t & 511, lane); }
}
__device__ __forceinline__ void cvt_exp_blk(const Params& p, int l, int e, int which, int q, int lane) {
    unsigned char* ws = p.ws; CvtMat m;
    if (which < 2) {
        const float* src = (e < NEXP) ? p.in[which == 0 ? I_EG : I_EU] + ((size_t)l * NEXP + e) * DM * EH : p.in[which == 0 ? I_SG : I_SU] + (size_t)l * DM * EH;
        m = CvtMat{src, (bf16_t*)(ws + O_EGU) + (size_t)e * 1024 * 2048, nullptr, EH, DM, 16, 1 + which};
    } else {
        const float* src = (e < NEXP) ? p.in[I_EDN] + ((size_t)l * NEXP + e) * EH * DM : p.in[I_SD] + (size_t)l * EH * DM;
        m = CvtMat{src, (bf16_t*)(ws + O_ED) + (size_t)e * 2048 * 512, nullptr, DM, EH, 64, 0};
    }
#if MOE_FP8
    const int lb = CVT_BG ? l : 0;
    cvt_block8(m, which < 2 ? p.ws + O_EGU + ((size_t)lb * 65 + e) * 1024 * 2048 : p.ws + O_ED + ((size_t)lb * 65 + e) * 2048 * 512, q / m.nb, q % m.nb, lane);
#else
    cvt_block(m, q / m.nb, q % m.nb, lane);
#endif
}
#if MOE_FP8 && defined(CVT_TWO)
struct CvtJob { const float* s; unsigned char* d; int N, lddst, mode, k0, n0; };
__device__ __forceinline__ CvtJob cvt_exp_job(const Params& p, int l, int t, int lane) {
    const int e = t / 1536, r = t % 1536, which = r >> 9, q = r & 511, a = lane & 7, ng = lane >> 3; CvtJob j;
    if (which < 2) { j.s = (e < NEXP) ? p.in[which == 0 ? I_EG : I_EU] + ((size_t)l * NEXP + e) * DM * EH : p.in[which == 0 ? I_SG : I_SU] + (size_t)l * DM * EH;
        j.d = p.ws + O_EGU + (size_t)e * 1024 * 2048; j.N = EH; j.lddst = DM; j.mode = 1 + which; j.k0 = (q / 16) * 64 + 8 * a; j.n0 = (q % 16) * 32 + 4 * ng; }
    else { j.s = (e < NEXP) ? p.in[I_EDN] + ((size_t)l * NEXP + e) * EH * DM : p.in[I_SD] + (size_t)l * EH * DM;
        j.d = p.ws + O_ED + (size_t)e * 2048 * 512; j.N = DM; j.lddst = EH; j.mode = 0; j.k0 = (q / 64) * 64 + 8 * a; j.n0 = (q % 64) * 32 + 4 * ng; }
    return j;
}
__device__ __forceinline__ void cvt_job_load(const CvtJob& j, f32x4 (&v)[8]) {
    const float* s = j.s + (size_t)j.k0 * j.N + j.n0;
#pragma unroll
    for (int q = 0; q < 8; ++q) v[q] = *(const f32x4*)(s + (size_t)q * j.N);
}
__device__ __forceinline__ void cvt_job_store(const CvtJob& j, const f32x4 (&v)[8]) {
#pragma unroll
    for (int i = 0; i < 4; ++i) { const int n = j.n0 + i, row = (j.mode == 0) ? n : ((n >> 7) * 256 + (n & 127) + (j.mode - 1) * 128);
        u32x2 w; w.x = pk4_fp8(v[0][i] * W8_SCALE, v[1][i] * W8_SCALE, v[2][i] * W8_SCALE, v[3][i] * W8_SCALE); w.y = pk4_fp8(v[4][i] * W8_SCALE, v[5][i] * W8_SCALE, v[6][i] * W8_SCALE, v[7][i] * W8_SCALE);
        *(u32x2*)(j.d + (size_t)row * j.lddst + j.k0) = w; }
}
__device__ __forceinline__ void cvt_exp_all(const Params& p, int l) {
    const int lane = otid() & 63, gw = blockIdx.x * 8 + owid(), GW = gridDim.x * 8;
    for (int t = gw; t < CVT_EXP; t += 2 * GW) { const bool two = (t + GW) < CVT_EXP;
        const CvtJob j0 = cvt_exp_job(p, l, t, lane), j1 = cvt_exp_job(p, l, two ? t + GW : t, lane); f32x4 v0[8], v1[8];
        cvt_job_load(j0, v0); cvt_job_load(j1, v1);
        cvt_job_store(j0, v0); if (two) cvt_job_store(j1, v1); }
}
#else
__device__ __forceinline__ void cvt_exp_all(const Params& p, int l) {
    const int lane = otid() & 63, gw = blockIdx.x * 8 + owid(), GW = gridDim.x * 8;
    for (int t = gw; t < CVT_EXP; t += GW) cvt_exp_task(p, l, t, lane);
}
#endif
#if CVT_BG
#ifndef BG_DRAIN_REP
#define BG_DRAIN_REP 1
#endif
__device__ __forceinline__ bool cvt_bg_step(LAS unsigned char* lds, int limit, int rep = 1) {
    const int wid = owid(), lane = otid() & 63;
    volatile LAS int* cur = (volatile LAS int*)(lds + LDS_BGCUR);
    const int k = __builtin_amdgcn_readfirstlane(cur[wid]);
    const int T = (blockIdx.x * 8 + wid) + k * (int)(gridDim.x * 8);
    if (T >= limit) return false;
    if (lane == 0) cur[wid] = k + 1;
    const __attribute__((address_space(4))) Params* kp = (const __attribute__((address_space(4))) Params*)__builtin_amdgcn_kernarg_segment_ptr(); asm volatile("" : "+s"(kp));
    Params p;
#pragma unroll
    for (int i_ = 0; i_ < 31; ++i_) p.in[i_] = kp->in[i_];
    p.out = kp->out; p.ws = kp->ws; p.layer = 0; p.pad = 0;
    const int l = (T >= CVT_EXP) ? 1 : 0;
    for (int r_ = 0; r_ < rep; ++r_) cvt_exp_task_bg(p, l, T - l * CVT_EXP, lane);
    return true;
}
#ifndef BG_TWO
#define BG_TWO 0
#endif
struct BgJob { const float* s; unsigned char* d; int lddst, mode, n0; size_t N; };
__device__ __forceinline__ BgJob cvt_bg_decode(const Params& p, int T, int lane) {
    const int l = (T >= CVT_EXP) ? 1 : 0; int t = T - l * CVT_EXP, e, which, q, nb; const int a = lane & 7, ng = lane >> 3; BgJob j; const float* src; unsigned char* dst;
    if (t < CVT_GU) { const int r = t & 1023; e = t >> 10; which = r >> 9; q = r & 511; } else { t -= CVT_GU; e = t >> 9; which = 2; q = t & 511; }
    if (which < 2) { src = (e < NEXP) ? p.in[which == 0 ? I_EG : I_EU] + ((size_t)l * NEXP + e) * DM * EH : p.in[which == 0 ? I_SG : I_SU] + (size_t)l * DM * EH;
        dst = p.ws + O_EGU + ((size_t)l * 65 + e) * 1024 * 2048; j.N = EH; j.lddst = DM; j.mode = 1 + which; nb = 16; }
    else { src = (e < NEXP) ? p.in[I_EDN] + ((size_t)l * NEXP + e) * EH * DM : p.in[I_SD] + (size_t)l * EH * DM;
        dst = p.ws + O_ED + ((size_t)l * 65 + e) * 2048 * 512; j.N = DM; j.lddst = EH; j.mode = 0; nb = 64; }
    const int k0 = (q / nb) * 64 + 8 * a; j.n0 = (q % nb) * 32 + 4 * ng; j.s = src + (size_t)k0 * j.N + j.n0; j.d = dst + k0;
    return j;
}
__device__ __forceinline__ void cvt_bg_store(const BgJob& j, const f32x4 (&v)[8]) {
#pragma unroll
    for (int i = 0; i < 4; ++i) { const int n = j.n0 + i, row = (j.mode == 0) ? n : ((n >> 7) * 256 + (n & 127) + (j.mode - 1) * 128);
        u32x2 w; w.x = pk4_fp8(v[0][i] * W8_SCALE, v[1][i] * W8_SCALE, v[2][i] * W8_SCALE, v[3][i] * W8_SCALE); w.y = pk4_fp8(v[4][i] * W8_SCALE, v[5][i] * W8_SCALE, v[6][i] * W8_SCALE, v[7][i] * W8_SCALE);
        *(u32x2*)(j.d + (size_t)row * j.lddst) = w; }
}
__device__ __forceinline__ bool cvt_bg_step2(LAS unsigned char* lds, int limit) {
    const int wid = owid(), lane = otid() & 63, GW = (int)(gridDim.x * 8);
    volatile LAS int* cur = (volatile LAS int*)(lds + LDS_BGCUR);
    const int k = __builtin_amdgcn_readfirstlane(cur[wid]);
    const int T0 = (blockIdx.x * 8 + wid) + k * GW, T1 = T0 + GW;
    if (T0 >= limit) return false;
    const bool two = T1 < limit;
    if (lane == 0) cur[wid] = k + (two ? 2 : 1);
    const __attribute__((address_space(4))) Params* kp = (const __attribute__((address_space(4))) Params*)__builtin_amdgcn_kernarg_segment_ptr(); asm volatile("" : "+s"(kp));
    Params p;
#pragma unroll
    for (int i_ = 0; i_ < 31; ++i_) p.in[i_] = kp->in[i_];
    p.out = kp->out; p.ws = kp->ws; p.layer = 0; p.pad = 0;
    const BgJob j0 = cvt_bg_decode(p, T0, lane), j1 = cvt_bg_decode(p, two ? T1 : T0, lane); f32x4 v0[8], v1[8];
#pragma unroll
    for (int q = 0; q < 8; ++q) v0[q] = *(const f32x4*)(j0.s + (size_t)q * j0.N);
#pragma unroll
    for (int q = 0; q < 8; ++q) v1[q] = *(const f32x4*)(j1.s + (size_t)q * j1.N);
    cvt_bg_store(j0, v0); if (two) cvt_bg_store(j1, v1);
    return true;
}
#endif
__device__ __forceinline__ void adaln_tasks(const Params& p, LAS float* lf) {
    const int lane = otid() & 63, wid = owid();
    float* MOD = (float*)(p.ws + O_MOD);
    for (int task = blockIdx.x; task < 384; task += gridDim.x) {
        const int cb = task % 192, l = task / 192, col = cb * 64 + lane;
        const float* W = p.in[I_ADAW] + (size_t)l * DM * 12288 + col;
        float acc[9];
#pragma unroll
        for (int r = 0; r < 9; ++r) acc[r] = 0.f;
        for (int kb = wid * 256; kb < wid * 256 + 256; kb += 64) {
            float sv[9];
#pragma unroll
            for (int r = 0; r < 8; ++r) sv[r] = silu_f(p.in[I_C][r * DM + kb + lane]);
            sv[8] = silu_f(p.in[I_CCTX][kb + lane]);
#pragma unroll 8
            for (int kk = 0; kk < 64; ++kk) { const float w = (NT2 & 1) ? __builtin_nontemporal_load(W + (size_t)(kb + kk) * 12288) : W[(size_t)(kb + kk) * 12288];
#pragma unroll
                for (int r = 0; r < 9; ++r) acc[r] += rdlane(sv[r], kk) * w; }
        }
#pragma unroll
        for (int r = 0; r < 9; ++r) lf[(wid * 9 + r) * 64 + lane] = acc[r];
        __syncthreads();
        for (int r = wid; r < 9; r += 8) { float s = p.in[I_ADAB][l * 12288 + col];
#pragma unroll
            for (int w = 0; w < 8; ++w) s += lf[(w * 9 + r) * 64 + lane];
            MOD[(size_t)(l * 9 + r) * 12288 + col] = s; }
        __syncthreads();
    }
}
__device__ __forceinline__ void hss_tasks(const Params& p) {
    const int lane = otid() & 63, gw = blockIdx.x * 8 + owid(), GW = gridDim.x * 8;
    for (int task = gw; task < 3 * 1024; task += GW) {
        const int set = task >> 10, l = (set == 1) ? 1 : 0, nset = (set == 2) ? 1 : 0, ord = (task >> 9) & 1, ch = task & 511, n = nset ? 256 : 2048;
        const float* HF = (const float*)(p.ws + O_HF) + (size_t)l * HF_LAYER + (nset ? HF_L0 : 0);
        const float* hf = HF + (size_t)((ord * 2 + 0) * 512 + ch) * n; const float* hb = HF + (size_t)((ord * 2 + 1) * 512 + ch) * n;
        float s = 0.f;
        for (int i = lane; i < n; i += 64) { const float a = hf[i], b = (i == 0) ? 0.f : hb[i]; s += a * a + b * b; }
        s = wave_sum(s);
        if (lane == 0) ((float*)(p.ws + O_HSS))[(size_t)((l * 2 + nset) * 2 + ord) * 512 + ch] = s;
#if HY_KRB
        if (nset == 0) {
            const float rs = rsqrtf(s + EPS); bf16_t* kr = (bf16_t*)(p.ws + O_KRB) + (size_t)((l * 2 + ord) * 512 + ch) * 4128;
            for (int q = lane; q < 516; q += 64) { float v[8];
#pragma unroll
                for (int j = 0; j < 8; ++j) { const int lag = 2064 - (q * 8 + j); v[j] = (lag >= 0 && lag < SEQ) ? hf[lag] * rs : ((lag < 0 && lag > -SEQ) ? hb[-lag] * rs : 0.f); }
                u32x4 w; w.x = pk2(v[0], v[1]); w.y = pk2(v[2], v[3]); w.z = pk2(v[4], v[5]); w.w = pk2(v[6], v[7]); *(u32x4*)(kr + q * 8) = w; }
        }
#endif
    }
}
__device__ __forceinline__ void hyf_task(const Params& p, int l, int nset, int i0, LAS float* lf) {
    int tid = otid(); const int n = nset ? 256 : 2048;
    LAS float* feats = lf; LAS float* hd1 = lf + 8 * 33; LAS float* hd2 = hd1 + 512;
    if (tid < 8 * 33) { const int pos = tid / 33, f = tid % 33, i = i0 + pos; const float t = (float)i / (float)(n - 1), ang = 6.283185307179586f * (float)i / (float)n; float v;
        if (f == 0) v = t; else { const int j = (f - 1) & 15; const float band = 1e-4f + (float)j * ((15.0f - 1e-4f) / 15.0f); v = (f <= 16) ? cosf(ang * band) : sinf(ang * band); }
        feats[tid] = v; }
    __syncthreads();
    { const int pos = tid >> 6, j = tid & 63; const float* w1 = p.in[I_HYW1] + l * 33 * 64; float s = p.in[I_HYB1][l * 64 + j];
      for (int f = 0; f < 33; ++f) s += feats[pos * 33 + f] * w1[f * 64 + j];
      hd1[tid] = sinf(p.in[I_HYFREQ][l * 64 + j] * s); }
    __syncthreads();
    { const int pos = tid >> 6, j = tid & 63; const float* w2 = p.in[I_HYW2] + l * 64 * 64; float s = p.in[I_HYB2][l * 64 + j];
      for (int f = 0; f < 64; ++f) s += hd1[pos * 64 + f] * w2[f * 64 + j];
      hd2[tid] = sinf(p.in[I_HYFREQ][l * 64 + j] * s); }
    __syncthreads();
    const float* w3 = p.in[I_HYW3] + (size_t)l * 64 * 2048 + tid * 4;
    f32x4 acc[8];
#pragma unroll
    for (int q = 0; q < 8; ++q) acc[q] = (f32x4){0.f, 0.f, 0.f, 0.f};
    for (int j = 0; j < 64; ++j) { const f32x4 w = *(const f32x4*)(w3 + (size_t)j * 2048);
#pragma unroll
        for (int q = 0; q < 8; ++q) acc[q] += w * hd2[q * 64 + j]; }
    float* HF = (float*)(p.ws + O_HF) + (size_t)l * HF_LAYER + (nset ? HF_L0 : 0);
#pragma unroll
    for (int c = 0; c < 4; ++c) { const int col = tid * 4 + c, ord = col >> 10, dir = (col >> 9) & 1, ch = col & 511;
        const float delta = 3.0701134573253944f + (float)ch * ((15.350567286626973f - 3.0701134573253944f) / 511.0f); float v[8];
#pragma unroll
        for (int q = 0; q < 8; ++q) { const int i = i0 + q; const float t = (float)i / (float)(n - 1); v[q] = acc[q][c] * __expf(-t * delta); }
        float* dst = HF + (size_t)((ord * 2 + dir) * 512 + ch) * n + i0;
        *(f32x4*)dst = (f32x4){v[0], v[1], v[2], v[3]}; *(f32x4*)(dst + 4) = (f32x4){v[4], v[5], v[6], v[7]};    }
    __syncthreads();
}
__device__ __forceinline__ void rope_tables(const Params& p);
__device__ __forceinline__ void phase_prologue(const Params& p, LAS unsigned char* lds) {
    const int tid = otid(); LAS float* lf = (LAS float*)lds;
    { const size_t gt = (size_t)blockIdx.x * NTHREADS + tid, GT = (size_t)gridDim.x * NTHREADS;
      for (int l = 0; l < NLAYER; ++l) {
          u32x4* z1 = WIN8 ? (u32x4*)(p.ws + O_WIN + ((size_t)l * NP + IN_COLS) * DM) : (u32x4*)((bf16_t*)(p.ws + O_WIN) + ((size_t)l * NP + IN_COLS) * DM); const size_t n1 = (size_t)(NP - IN_COLS) * DM * (WIN8 ? 1 : 2) / 16;
          for (size_t i = gt; i < n1; i += GT) z1[i] = (u32x4){0u, 0u, 0u, 0u};
          u32x4* z2 = (u32x4*)((bf16_t*)(p.ws + O_WUQ) + ((size_t)l * NQP + 1152) * 768); const size_t n2 = (size_t)(NQP - 1152) * 768 * 2 / 16;
          for (size_t i = gt; i < n2; i += GT) z2[i] = (u32x4){0u, 0u, 0u, 0u};
      } }
    rope_tables(p);
#if ROUTER_X3
    { bf16_t* R2 = (bf16_t*)(p.ws + O_RW2);
      for (int i = blockIdx.x * NTHREADS + tid; i < NLAYER * NEXP * DM; i += gridDim.x * NTHREADS) { const int j = i & 7, ln = (i >> 3) & 63, eg = (i >> 9) & 3, st = (i >> 11) & 7, w = (i >> 14) & 7, ll = i >> 17;
          const int k = w * 256 + 32 * st + 8 * (ln >> 4) + j, e = 16 * eg + (ln & 15);
          const float wv = p.in[I_RW][((size_t)ll * DM + k) * NEXP + e]; const bf16_t hi = f2bf(wv); const size_t o = (size_t)(i & 0x1ffff);
          R2[(size_t)(ll * 2 + 0) * NEXP * DM + o] = hi; R2[(size_t)(ll * 2 + 1) * NEXP * DM + o] = f2bf(wv - bf2f(hi)); } }
#endif
#ifndef PRO_REP
#define PRO_REP 0
#endif
    adaln_tasks(p, lf); if (PRO_REP & 1) adaln_tasks(p, lf);
    for (int rep_ = 0; rep_ < ((PRO_REP & 2) ? 2 : 1); ++rep_)
    for (int t = (int)gridDim.x - 1 - (int)blockIdx.x; t < 544; t += gridDim.x) { if (t < 512) hyf_task(p, t >> 8, 0, (t & 255) * 8, lf); else hyf_task(p, 0, 1, (t - 512) * 8, lf); }
    { const int G = gridDim.x, nh = (G < 384 && 2 * G > 384) ? 384 - G : 0;
      if ((int)blockIdx.x >= nh) { const int lane = tid & 63, gw = ((int)blockIdx.x - nh) * 8 + owid(), GW = (G - nh) * 8;
        for (int rep_ = 0; rep_ < ((PRO_REP & 4) ? 2 : 1); ++rep_)
        for (int t = gw; t < NLAYER * CVT_SMALL; t += GW) cvt_small_task(p, t / CVT_SMALL, t % CVT_SMALL, lane); } }
#if !CVT_BG
    cvt_exp_all(p, 0);
#endif
}

__device__ __forceinline__ void norm1_row(const Params& p, int l, int row, const float (&x)[32], int lane) {
    float ss = 0.f;
#pragma unroll
    for (int i = 0; i < 32; ++i) ss += x[i] * x[i];
    ss = wave_sum(ss); const float rstd = rsqrtf(ss * (1.0f / DM) + EPS);
    const float* g = p.in[I_NORMG] + (size_t)(l * 4 + 0) * DM; const float* mod = (const float*)(p.ws + O_MOD) + (size_t)(l * 9 + row_batch(row)) * 12288;
    bf16_t* H = (bf16_t*)(p.ws + O_H) + (size_t)row * DM;
#pragma unroll
    for (int j = 0; j < 8; ++j) { const int c = ROWCOL(j, lane); const f32x4 gv = *(const f32x4*)(g + c), sh = *(const f32x4*)(mod + c), sc = *(const f32x4*)(mod + DM + c); float h[4];
#pragma unroll
        for (int q = 0; q < 4; ++q) h[q] = x[j * 4 + q] * rstd * gv[q] * (1.0f + sc[q]) + sh[q];
#if WIN8
        *(unsigned*)((unsigned char*)(p.ws + O_H) + (size_t)row * DM + c) = pk4_fp8(h[0], h[1], h[2], h[3]);
#else
        u32x2 w; w.x = pk2(h[0], h[1]); w.y = pk2(h[2], h[3]); *(u32x2*)(H + c) = w;
#endif
    }
}
__device__ __forceinline__ void norm1_row_c(const Params& p, int l, int row, const float (&x)[32], int lane) {
    const float* mc = (const float*)(p.ws + O_MODC) + (size_t)((l * 9 + row_batch(row)) * 6 + 4) * DM; f32x4 a4[8], a5[8];
#pragma unroll
    for (int j = 0; j < 8; ++j) { a4[j] = ld_mc(p, l, row, 4, ROWCOL(j, lane)); a5[j] = ld_mc(p, l, row, 5, ROWCOL(j, lane)); }
    float ss = 0.f;
#pragma unroll
    for (int i = 0; i < 32; ++i) ss += x[i] * x[i];
    ss = wave_sum(ss); const float rstd = rsqrtf(ss * (1.0f / DM) + EPS);
    bf16_t* H = (bf16_t*)(p.ws + O_H) + (size_t)row * DM;
#pragma unroll
    for (int j = 0; j < 8; ++j) { const int c = ROWCOL(j, lane); float h[4];
#pragma unroll
        for (int q = 0; q < 4; ++q) h[q] = x[j * 4 + q] * rstd * a4[j][q] + a5[j][q];
#if WIN8
        *(unsigned*)((unsigned char*)(p.ws + O_H) + (size_t)row * DM + c) = pk4_fp8(h[0], h[1], h[2], h[3]);
#else
        u32x2 w; w.x = pk2(h[0], h[1]); w.y = pk2(h[2], h[3]); *(u32x2*)(H + c) = w;
#endif
    }
}
__device__ __forceinline__ void phase_norm1(const Params& p, int l) {
    { float* mc = (float*)(p.ws + O_MODC); const float* MODp = (const float*)(p.ws + O_MOD);
      for (int i = blockIdx.x * NTHREADS + otid(); i < NLAYER * 9 * DM; i += gridDim.x * NTHREADS) { const int c = i % DM, r = (i / DM) % 9, ll = i / (9 * DM); const float* m = MODp + (size_t)(ll * 9 + r) * 12288;
          const float g0 = p.in[I_NORMG][(size_t)(ll * 4 + 0) * DM + c], g1 = p.in[I_NORMG][(size_t)(ll * 4 + 1) * DM + c], g2 = p.in[I_NORMG][(size_t)(ll * 4 + 2) * DM + c], g3 = p.in[I_NORMG][(size_t)(ll * 4 + 3) * DM + c]; float* d = mc + (size_t)((ll * 9 + r) * 6) * DM + c;
          const float v0 = m[2 * DM + c] * g1, v1 = g2 * (1.0f + m[4 * DM + c]), v2 = m[3 * DM + c], v3 = m[5 * DM + c] * g3, v4 = g0 * (1.0f + m[DM + c]), v5 = m[c];
          if (MCB16) { bf16_t* db = (bf16_t*)(p.ws + O_MODC) + (size_t)((ll * 9 + r) * 6) * DM + c; db[0] = f2bf(v0); db[DM] = f2bf(v1); db[2 * DM] = f2bf(v2); db[3 * DM] = f2bf(v3); db[4 * DM] = f2bf(v4); db[5 * DM] = f2bf(v5); }
          else { d[0] = v0; d[DM] = v1; d[2 * DM] = v2; d[3 * DM] = v3; d[4 * DM] = v4; d[5 * DM] = v5; } } }
    const int lane = otid() & 63, gw = blockIdx.x * 8 + owid(), GW = gridDim.x * 8;
    const int lane0 = lane;
    for (int row = gw; row < NTOK; row += GW) { int lane = lane0; asm volatile("" : "+v"(lane)); const float* src = resid_src(p, l, row); float x[32];
#pragma unroll
        for (int j = 0; j < 8; ++j) { const f32x4 v = (NT2 & 4) ? __builtin_nontemporal_load((const f32x4*)(src + ROWCOL(j, lane))) : *(const f32x4*)(src + ROWCOL(j, lane)); x[j * 4] = v[0]; x[j * 4 + 1] = v[1]; x[j * 4 + 2] = v[2]; x[j * 4 + 3] = v[3]; }
        norm1_row(p, l, row, x, lane); }
}

__device__ __forceinline__ void rope_tables(const Params& p) {
    float* T = (float*)(p.ws + O_ROPE);
    for (int i = blockIdx.x * NTHREADS + otid(); i < 64 * 32 + 64 * 16; i += gridDim.x * NTHREADS) {
        float a; if (i < 64 * 32) a = (float)(i >> 5) * exp2f(-(float)(i & 31) * (13.287712379549449f / 32.0f)); else { const int q = i - 64 * 32; a = (float)(q >> 4) * exp2f(-(float)(q & 15) * (13.287712379549449f / 16.0f)); }
        float sn, cs; sincosf(a, &sn, &cs); T[2 * i] = cs; T[2 * i + 1] = sn; }
}
__device__ __forceinline__ void unpack8(const u32x4 v, float (&x)[8]) {
#pragma unroll
    for (int j = 0; j < 4; ++j) { x[2 * j] = __uint_as_float(v[j] << 16); x[2 * j + 1] = __uint_as_float(v[j] & 0xffff0000u); }
}
__device__ __forceinline__ u32x4 pack8(const float (&x)[8]) { u32x4 w; w.x = pk2(x[0], x[1]); w.y = pk2(x[2], x[3]); w.z = pk2(x[4], x[5]); w.w = pk2(x[6], x[7]); return w; }
template <int PX> __device__ __forceinline__ void rope8(float (&x)[8], const float* cs, bool second) {
#pragma unroll
    for (int j = 0; j < 8; ++j) { const float pr = __shfl_xor(x[j], PX), c = cs[2 * j], sn = cs[2 * j + 1]; x[j] = second ? pr * sn + x[j] * c : x[j] * c - pr * sn; }
}
__device__ __forceinline__ void gqa_post_row(const Params& p, int l, int row, int lane) {
    const bf16_t* P = (const bf16_t*)(p.ws + O_P) + (size_t)row * NP;
    const bool isctx = row >= NLAT; const int b = isctx ? (row - NLAT) >> 8 : row >> 11, t = isctx ? (row - NLAT) & 255 : row & 2047;
    const int j = lane & 15, hq = lane >> 4, half = j >> 3; const bool second = (j >> 2) & 1;
    const float* cs = (const float*)(p.ws + O_ROPE) + ((size_t)(half ? (t & 63) : (t >> 6)) * 32 + 8 * (j & 3)) * 2;
    const int kpos = isctx ? t : CTXL + t;
#pragma unroll
    for (int ps = 0; ps < 2; ++ps) {
        const bool isk = (ps == 1) && (hq >= 2); const int h = (ps == 0) ? hq : (isk ? hq - 2 : 4 + hq);
        const bf16_t* src = P + (isk ? C_GK : C_GQ) + h * 128 + 8 * j; const float* gn = (isk ? p.in[I_GKN] : p.in[I_GQN]) + l * 128 + 8 * j;
        float x[8]; unpack8(LDNT2(u32x4, src), x);
        float ss = 0.f;
#pragma unroll
        for (int q = 0; q < 8; ++q) ss += x[q] * x[q];
        ss += __shfl_xor(ss, 1); ss += __shfl_xor(ss, 2); ss += __shfl_xor(ss, 4); ss += __shfl_xor(ss, 8);
        const float rstd = rsqrtf(ss * (1.0f / 128.0f) + EPS); const f32x4 g0 = *(const f32x4*)gn, g1 = *(const f32x4*)(gn + 4);
#pragma unroll
        for (int q = 0; q < 4; ++q) { x[q] *= rstd * g0[q]; x[4 + q] *= rstd * g1[q]; }
        if (!isctx) rope8<4>(x, cs, second);
        bf16_t* dst = isk ? (bf16_t*)(p.ws + O_KG) + ((size_t)(b * 2 + h) * LK + kpos) * 128
                          : (isctx ? (bf16_t*)(p.ws + O_QGC) + ((size_t)(b * 6 + h) * CTXL + t) * 128 : (bf16_t*)(p.ws + O_QG) + ((size_t)(b * 6 + h) * SEQ + t) * 128);
        *(u32x4*)(dst + 8 * j) = pack8(x);
    }
    if (lane < 32) { const int h = lane >> 4; *(u32x4*)((bf16_t*)(p.ws + O_VG) + ((size_t)(b * 2 + h) * LK + kpos) * 128 + 8 * j) = LDNT2(u32x4, P + C_GV + h * 128 + 8 * j); }
}
__device__ __forceinline__ void seq_of(int row, int& s0, int& n) { if (row < NLAT) { s0 = row & ~2047; n = SEQ; } else { s0 = NLAT + ((row - NLAT) & ~255); n = CTXL; } }
__device__ __forceinline__ void load_conv_tile(const bf16_t* P, int t0, int pc0, LAS float* u) {
    int s0, n; seq_of(t0, s0, n);
    for (int i = otid(); i < 66 * 8; i += NTHREADS) { const int r = i >> 3, c = (i & 7) * 8, row = t0 - 1 + r;
        float x[8];
        if (row >= s0 && row < s0 + n) { const u32x4 v = LDNT2(u32x4, P + (size_t)row * NP + pc0 + c);
#pragma unroll
            for (int j = 0; j < 4; ++j) { x[2 * j] = __uint_as_float(v[j] << 16); x[2 * j + 1] = __uint_as_float(v[j] & 0xffff0000u); } }
        else {
#pragma unroll
            for (int j = 0; j < 8; ++j) x[j] = 0.f; }
#pragma unroll
        for (int j = 0; j < 8; ++j) u[r * 65 + c + j] = x[j]; }
}
__device__ __forceinline__ void hy_prep_task(const Params& p, int l, int t0, int c0, LAS float* u) {
    const bf16_t* P = (const bf16_t*)(p.ws + O_P);
#pragma unroll
    for (int q = 0; q < 4; ++q) load_conv_tile(P, t0, c0 + 64 * q, u + q * (66 * 65));
    __syncthreads();
    const int tid = otid(), c = tid >> 3, tc = (tid & 7) * 8;
#pragma unroll
    for (int q = 0; q < 4; ++q) { const LAS float* uq = u + q * (66 * 65); const int ch = c0 + 64 * q + c; const float* cw = p.in[I_HYCONV] + (size_t)l * 3 * 1536 + ch;
        const float w0 = cw[0], w1 = cw[1536], w2 = cw[3072]; float y[8], uu[10];
#pragma unroll
        for (int j = 0; j < 10; ++j) uu[j] = uq[(tc + j) * 65 + c];
#pragma unroll
        for (int j = 0; j < 8; ++j) y[j] = w0 * uu[j] + w1 * uu[j + 1] + w2 * uu[j + 2];
        bf16_t* dst = (ch < 512 ? (bf16_t*)(p.ws + O_VT) + (size_t)ch * NTOK : (bf16_t*)(p.ws + O_X1T) + (size_t)(ch - 512) * NTOK) + t0 + tc;
        u32x4 w; w.x = pk2(y[0], y[1]); w.y = pk2(y[2], y[3]); w.z = pk2(y[4], y[5]); w.w = pk2(y[6], y[7]); *(u32x4*)dst = w; }
    __syncthreads();
}
__device__ __forceinline__ void mla_post_row(const Params& p, int l, int row, int lane) {
    const bf16_t* P = (const bf16_t*)(p.ws + O_P) + (size_t)row * NP;
    const bool isctx = row >= NLAT; const int b = isctx ? (row - NLAT) >> 8 : row >> 11, t = isctx ? (row - NLAT) & 255 : row & 2047;
    float sq = 0.f, skv = 0.f; float x[8];
    unpack8(*(const u32x4*)(P + C_CQ + 8 * lane), x);
#pragma unroll
    for (int q = 0; q < 8; ++q) sq += x[q] * x[q];
    if (lane < 32) { unpack8(*(const u32x4*)(P + C_CQ + 512 + 8 * lane), x);
#pragma unroll
        for (int q = 0; q < 8; ++q) sq += x[q] * x[q];
        unpack8(*(const u32x4*)(P + C_CKV + 8 * lane), x);
#pragma unroll
        for (int q = 0; q < 8; ++q) skv += x[q] * x[q]; }
    const float rq = rsqrtf(wave_sum(sq) * (1.0f / 768.0f) + EPS), rkv = rsqrtf(wave_sum(skv) * (1.0f / 256.0f) + EPS);
    const bf16_t* QR = (const bf16_t*)(p.ws + O_QRAW) + (size_t)row * NQP; const bf16_t* KV = (const bf16_t*)(p.ws + O_KVRAW) + (size_t)row * 1536;
    const int kpos = isctx ? t : CTXL + t;
    const float* RM = (const float*)(p.ws + O_ROPE) + 64 * 32 * 2;
#pragma unroll
    for (int ps = 0; ps < 3; ++ps) { const int id = ps * 64 + lane; const bool act = id < 144; const int h = act ? id / 24 : 0, cj = act ? id % 24 : 0, rc = cj - 16;
        unpack8(LDNT2(u32x4, QR + h * 192 + 8 * cj), x);
#pragma unroll
        for (int q = 0; q < 8; ++q) x[q] *= rq;
        if (!isctx) { const int rcc = rc < 0 ? 0 : rc; const float* cs = RM + ((size_t)((rcc >> 2) ? (t & 63) : (t >> 6)) * 16 + 8 * (rcc & 1)) * 2; float y[8];
#pragma unroll
            for (int q = 0; q < 8; ++q) y[q] = x[q];
            rope8<2>(y, cs, (rcc >> 1) & 1);
            if (rc >= 0) {
#pragma unroll
                for (int q = 0; q < 8; ++q) x[q] = y[q]; } }
        bf16_t* qd = isctx ? (bf16_t*)(p.ws + O_QMC) + ((size_t)(b * 6 + h) * CTXL + t) * 192 : (bf16_t*)(p.ws + O_QM) + ((size_t)(b * 6 + h) * SEQ + t) * 192;
        if (act) *(u32x4*)(qd + 8 * cj) = pack8(x); }
#pragma unroll
    for (int ps = 0; ps < 3; ++ps) { const int id = ps * 64 + lane, h = id >> 5, c = id & 31;
        unpack8(LDNT2(u32x4, KV + h * 256 + 8 * c), x);
#pragma unroll
        for (int q = 0; q < 8; ++q) x[q] *= rkv;
        bf16_t* d = (c < 16) ? (bf16_t*)(p.ws + O_KM) + ((size_t)(b * 6 + h) * LK + kpos) * 192 + 8 * c : (bf16_t*)(p.ws + O_VM) + ((size_t)(b * 6 + h) * LK + kpos) * 128 + 8 * (c - 16);
        *(u32x4*)d = pack8(x); }
    { const int h = lane >> 3, rc = lane & 7; unpack8(*(const u32x4*)(P + C_KR + 8 * rc), x);
      if (!isctx) { const float* cs = RM + ((size_t)((rc >> 2) ? (t & 63) : (t >> 6)) * 16 + 8 * (rc & 1)) * 2; rope8<2>(x, cs, (rc >> 1) & 1); }
      if (lane < 48) *(u32x4*)((bf16_t*)(p.ws + O_KM) + ((size_t)(b * 6 + h) * LK + kpos) * 192 + 128 + 8 * rc) = pack8(x); }
}

__device__ __forceinline__ void hyconv_unit_valu(const Params& p, int l, int nset, int c, LAS float* lf) {
    const int tid = otid(), n = nset ? CTXL : SEQ, tokbase = nset ? NLAT : 0;
    LAS float* kc = lf; LAS float* z = lf + 4096; LAS float* z2 = z + 8 * SEQ;
    const float* HF = (const float*)(p.ws + O_HF) + (size_t)l * HF_LAYER + (nset ? HF_L0 : 0); const float* HSS = (const float*)(p.ws + O_HSS) + (size_t)((l * 2 + nset) * 2) * 512;
    const bf16_t* VT = (const bf16_t*)(p.ws + O_VT) + (size_t)c * NTOK + tokbase; const bf16_t* X1T = (const bf16_t*)(p.ws + O_X1T) + (size_t)c * NTOK + tokbase;
    bf16_t* Y2T = (bf16_t*)(p.ws + O_Y2T) + (size_t)c * NTOK + tokbase;
    for (int i = tid; i < 8 * n; i += NTHREADS) z[i] = bf2f(VT[i]);
    for (int ord = 0; ord < 2; ++ord) {
        const float rs = rsqrtf(HSS[ord * 512 + c] + EPS); const float* hf = HF + (size_t)((ord * 2 + 0) * 512 + c) * n; const float* hb = HF + (size_t)((ord * 2 + 1) * 512 + c) * n;
        for (int m = tid; m < 2 * n; m += NTHREADS) { const int lag = m - (n - 1); kc[m] = (m == 2 * n - 1) ? 0.f : (lag >= 0 ? hf[lag] : hb[-lag]) * rs; }
        __syncthreads();
        const LAS float* zs = ord ? z2 : z; const float skip = p.in[I_HYSKIP][(size_t)(l * 2 + ord) * 512 + c];
        for (int q = tid; q < n; q += NTHREADS) {
            const int b = q / (n >> 3), t0 = (q % (n >> 3)) * 8; float acc[8];
#pragma unroll
            for (int j = 0; j < 8; ++j) acc[j] = 0.f;
            const LAS float* zb = zs + b * n;
            for (int sb = 0; sb < n; sb += 8) {
                const LAS float* kb = kc + (t0 - sb + n - 8); float w[16];
#pragma unroll
                for (int i = 0; i < 4; ++i) { const f32x4 v = *(const LAS f32x4*)(kb + 4 * i); w[4 * i] = v[0]; w[4 * i + 1] = v[1]; w[4 * i + 2] = v[2]; w[4 * i + 3] = v[3]; }
                const f32x4 za = *(const LAS f32x4*)(zb + sb), zc = *(const LAS f32x4*)(zb + sb + 4); const float zv[8] = {za[0], za[1], za[2], za[3], zc[0], zc[1], zc[2], zc[3]};
#pragma unroll
                for (int ss = 0; ss < 8; ++ss)
#pragma unroll
                    for (int j = 0; j < 8; ++j) acc[j] += w[j - ss + 7] * zv[ss];
            }
            if (ord == 0) {
#pragma unroll
                for (int j = 0; j < 8; ++j) { const int idx = b * n + t0 + j; z2[idx] = bf2f(X1T[idx]) * (acc[j] + skip * z[idx]); }
            } else { float y[8];
#pragma unroll
                for (int j = 0; j < 8; ++j) y[j] = acc[j] + skip * z2[b * n + t0 + j];
                u32x4 w; w.x = pk2(y[0], y[1]); w.y = pk2(y[2], y[3]); w.z = pk2(y[4], y[5]); w.w = pk2(y[6], y[7]); *(u32x4*)(Y2T + b * n + t0) = w; }
        }
        __syncthreads();
    }
}
constexpr int HC_COPYB = 8256, HC_ROWB = 4560, HC_PAD = 112, HC_KR = 4112, HC_M0 = 2064;
constexpr int HC_ZOFF = 8 * HC_COPYB, HC_Z2OFF = HC_ZOFF + 8 * HC_ROWB;
__device__ __forceinline__ void hyconv_unit_mfma(const Params& p, int l, int c, LAS unsigned char* lds) {
    const int tid = otid(), wid = __builtin_amdgcn_readfirstlane(tid >> 6), lane = tid & 63;
    LAS unsigned char* CP = lds; LAS unsigned char* Zr = lds + HC_ZOFF; LAS unsigned char* Z2r = lds + HC_Z2OFF;
    const float* HF = (const float*)(p.ws + O_HF) + (size_t)l * HF_LAYER; const float* HSS = (const float*)(p.ws + O_HSS) + (size_t)(l * 4) * 512;
    const bf16_t* VT = (const bf16_t*)(p.ws + O_VT) + (size_t)c * NTOK; const bf16_t* X1T = (const bf16_t*)(p.ws + O_X1T) + (size_t)c * NTOK; bf16_t* Y2T = (bf16_t*)(p.ws + O_Y2T) + (size_t)c * NTOK;
    for (int q = tid; q < 8 * 256; q += NTHREADS) { const int b = q >> 8, ch = q & 255; *(LAS u32x4*)(Zr + b * HC_ROWB + (HC_PAD + ch * 8) * 2) = *(const u32x4*)(VT + b * SEQ + ch * 8); }
    for (int q = tid; q < 8 * 29; q += NTHREADS) { const int b = q / 29, ch = q % 29; const int e0 = ch < 14 ? ch * 8 : HC_PAD + SEQ + (ch - 14) * 8; *(LAS u32x4*)(Zr + b * HC_ROWB + e0 * 2) = (u32x4){0u, 0u, 0u, 0u}; }
    const int a = lane & 31, kg = lane >> 5, bq = a >> 2, isub = a & 3;
    const int Aoff = (a & 7) * HC_COPYB + (HC_M0 - 8 * (a >> 3) + 8 * kg) * 2;
    const int g0 = 2 * wid;
    const int Boff = bq * HC_ROWB + (HC_PAD + 128 * g0 + 32 * isub + 8 * kg) * 2;
    for (int ord = 0; ord < 2; ++ord) {
#if HY_KRB
        { const bf16_t* krg = (const bf16_t*)(p.ws + O_KRB) + (size_t)((l * 2 + ord) * 512 + c) * 4128;
          for (int q = tid; q < 516; q += NTHREADS) { const u32x4 Q = *(const u32x4*)(krg + q * 8); const u32x4 P = q ? *(const u32x4*)(krg + (q - 1) * 8) : (u32x4){0u, 0u, 0u, 0u};
              const unsigned D[8] = {P.x, P.y, P.z, P.w, Q.x, Q.y, Q.z, Q.w};
#pragma unroll
              for (int sft = 0; sft < 8; ++sft) { u32x4 w;
                  if ((sft & 1) == 0) { const int k0 = (8 - sft) >> 1; w = (u32x4){D[k0], D[k0 + 1], D[k0 + 2], D[k0 + 3]}; }
                  else { const int k0 = (7 - sft) >> 1; w.x = __builtin_amdgcn_alignbyte(D[k0 + 1], D[k0], 2); w.y = __builtin_amdgcn_alignbyte(D[k0 + 2], D[k0 + 1], 2); w.z = __builtin_amdgcn_alignbyte(D[k0 + 3], D[k0 + 2], 2); w.w = __builtin_amdgcn_alignbyte(D[k0 + 4], D[k0 + 3], 2); }
                  *(LAS u32x4*)(CP + sft * HC_COPYB + q * 16) = w; } } }
        __syncthreads();
#else
        LAS float* kr = (LAS float*)(ord == 0 ? Z2r : Zr);
        { const float rs = rsqrtf(HSS[ord * 512 + c] + EPS); const float* hf = HF + (size_t)((ord * 2 + 0) * 512 + c) * SEQ; const float* hb = HF + (size_t)((ord * 2 + 1) * 512 + c) * SEQ;
          for (int m = tid; m < HC_KR; m += NTHREADS) { const int lag = HC_M0 - m; float v = 0.f; if (lag >= 0 && lag < SEQ) v = hf[lag] * rs; else if (lag < 0 && lag > -SEQ) v = hb[-lag] * rs; kr[m] = v; } }
        __syncthreads();
        for (int q = tid; q < 8 * 516; q += NTHREADS) { const int sft = q / 516, ch = q % 516; float v[8];
#pragma unroll
            for (int j = 0; j < 8; ++j) { const int m = ch * 8 + j - sft; v[j] = (m >= 0 && m < HC_KR) ? kr[m] : 0.f; }
            u32x4 w; w.x = pk2(v[0], v[1]); w.y = pk2(v[2], v[3]); w.z = pk2(v[4], v[5]); w.w = pk2(v[6], v[7]); *(LAS u32x4*)(CP + sft * HC_COPYB + ch * 16) = w; }
        __syncthreads();
#endif
        if (ord == 0) for (int q = tid; q < 8 * 29; q += NTHREADS) { const int b = q / 29, ch = q % 29; const int e0 = ch < 14 ? ch * 8 : HC_PAD + SEQ + (ch - 14) * 8; *(LAS u32x4*)(Z2r + b * HC_ROWB + e0 * 2) = (u32x4){0u, 0u, 0u, 0u}; }
        const LAS unsigned char* Zs = ord ? Z2r : Zr;
        f32x16 acc0 = {}, acc1 = {};
        const int e_lo = 16 * wid - 127, e_mid0 = 16 * wid - 119, e_mid1 = 16 * wid + 7, e_hi = 16 * wid + 15;
        for (int e = e_lo; e < e_mid0; ++e) { const bf16x8 A = *(const LAS bf16x8*)(CP + Aoff - 32 * e); const bf16x8 B0 = *(const LAS bf16x8*)(Zs + Boff - 32 * e);
            acc0 = __builtin_amdgcn_mfma_f32_32x32x16_bf16(A, B0, acc0, 0, 0, 0); }
#pragma unroll 2
        for (int e = e_mid0; e <= e_mid1; ++e) { const bf16x8 A = *(const LAS bf16x8*)(CP + Aoff - 32 * e); const bf16x8 B0 = *(const LAS bf16x8*)(Zs + Boff - 32 * e); const bf16x8 B1 = *(const LAS bf16x8*)(Zs + Boff + 256 - 32 * e);
            acc0 = __builtin_amdgcn_mfma_f32_32x32x16_bf16(A, B0, acc0, 0, 0, 0); acc1 = __builtin_amdgcn_mfma_f32_32x32x16_bf16(A, B1, acc1, 0, 0, 0); }
        for (int e = e_mid1 + 1; e <= e_hi; ++e) { const bf16x8 A = *(const LAS bf16x8*)(CP + Aoff - 32 * e); const bf16x8 B1 = *(const LAS bf16x8*)(Zs + Boff + 256 - 32 * e);
            acc1 = __builtin_amdgcn_mfma_f32_32x32x16_bf16(A, B1, acc1, 0, 0, 0); }
        const float skip = p.in[I_HYSKIP][(size_t)(l * 2 + ord) * 512 + c];
#pragma unroll
        for (int gi = 0; gi < 2; ++gi) {
#pragma unroll
            for (int q = 0; q < 4; ++q) { const int t = 128 * (g0 + gi) + 32 * isub + 8 * q + 4 * kg; float y[4];
#pragma unroll
                for (int j = 0; j < 4; ++j) y[j] = gi ? acc1[4 * q + j] : acc0[4 * q + j];
                const u32x2 zz = *(const LAS u32x2*)(Zs + bq * HC_ROWB + (HC_PAD + t) * 2);
                const float z0 = __uint_as_float(zz.x << 16), z1 = __uint_as_float(zz.x & 0xffff0000u), z2 = __uint_as_float(zz.y << 16), z3 = __uint_as_float(zz.y & 0xffff0000u);
                y[0] += skip * z0; y[1] += skip * z1; y[2] += skip * z2; y[3] += skip * z3;
                if (ord == 0) { const u32x2 xx = *(const u32x2*)(X1T + bq * SEQ + t);
                    y[0] *= __uint_as_float(xx.x << 16); y[1] *= __uint_as_float(xx.x & 0xffff0000u); y[2] *= __uint_as_float(xx.y << 16); y[3] *= __uint_as_float(xx.y & 0xffff0000u);
                    u32x2 w; w.x = pk2(y[0], y[1]); w.y = pk2(y[2], y[3]); *(LAS u32x2*)(Z2r + bq * HC_ROWB + (HC_PAD + t) * 2) = w; }
                else { u32x2 w; w.x = pk2(y[0], y[1]); w.y = pk2(y[2], y[3]); *(u32x2*)(Y2T + bq * SEQ + t) = w; } }
        }
        __syncthreads();
    }
}
__device__ __forceinline__ void hy_fin_task(const Params& p, int l, int t0, int c0, LAS float* u) {
    const bf16_t* P = (const bf16_t*)(p.ws + O_P); LAS float* y = u + 66 * 65;
    load_conv_tile(P, t0, 1024 + c0, u);
    const int tid = otid();
    { const int c = tid >> 3, tc = (tid & 7) * 8; const u32x4 v = *(const u32x4*)((const bf16_t*)(p.ws + O_Y2T) + (size_t)(c0 + c) * NTOK + t0 + tc);
#pragma unroll
      for (int j = 0; j < 4; ++j) { y[c * 65 + tc + 2 * j] = __uint_as_float(v[j] << 16); y[c * 65 + tc + 2 * j + 1] = __uint_as_float(v[j] & 0xffff0000u); } }
    __syncthreads();
    { const int t = tid >> 3, cc = (tid & 7) * 8; const float* cw = p.in[I_HYCONV] + (size_t)l * 3 * 1536 + 1024 + c0 + cc; float o[8];
#pragma unroll
      for (int j = 0; j < 8; ++j) { const int c = cc + j; const float x2 = cw[j] * u[t * 65 + c] + cw[1536 + j] * u[(t + 1) * 65 + c] + cw[3072 + j] * u[(t + 2) * 65 + c]; o[j] = x2 * y[c * 65 + t]; }
#if WOUT8
      u32x2 w; w.x = pk4_fp8(o[0] * MIX8_SCALE, o[1] * MIX8_SCALE, o[2] * MIX8_SCALE, o[3] * MIX8_SCALE); w.y = pk4_fp8(o[4] * MIX8_SCALE, o[5] * MIX8_SCALE, o[6] * MIX8_SCALE, o[7] * MIX8_SCALE);
      *(u32x2*)(p.ws + O_MIX + (size_t)(t0 + t) * DM + c0 + cc) = w; }
#else
      u32x4 w; w.x = pk2(o[0], o[1]); w.y = pk2(o[2], o[3]); w.z = pk2(o[4], o[5]); w.w = pk2(o[6], o[7]);
      *(u32x4*)((bf16_t*)(p.ws + O_MIX) + (size_t)(t0 + t) * DM + c0 + cc) = w; }
#endif
    __syncthreads();
}

__device__ __forceinline__ void mla_unit(const Params& p, int b, int h, int qb, bool ctxq, LAS unsigned char* lds) {
    unsigned char* ws = p.ws;
    const bf16_t* Q = ctxq ? (const bf16_t*)(ws + O_QMC) + (size_t)(b * 6 + h) * CTXL * 192 : (const bf16_t*)(ws + O_QM) + ((size_t)(b * 6 + h) * SEQ + qb * 256) * 192;
#if WOUT8
    bf16_t* O = (bf16_t*)(ws + O_MIX + (size_t)(ctxq ? NLAT + b * CTXL : b * SEQ + qb * 256) * DM + 512 + h * 128);
#else
    bf16_t* O = (bf16_t*)(ws + O_MIX) + (size_t)(ctxq ? NLAT + b * CTXL : b * SEQ + qb * 256) * DM + 512 + h * 128;
#endif
#if ATT_DMA & 1
    attn_body_dma<192>(Q, (const bf16_t*)(ws + O_KM) + (size_t)(b * 6 + h) * LK * 192, (const bf16_t*)(ws + O_VM) + (size_t)(b * 6 + h) * LK * 128, O, DM, ctxq ? CTXL : LK, 0.07216878364870322f, lds);
#else
    attn_body<192, 0>(Q, (const bf16_t*)(ws + O_KM) + (size_t)(b * 6 + h) * LK * 192, (const bf16_t*)(ws + O_VM) + (size_t)(b * 6 + h) * LK * 128, O, DM, ctxq ? CTXL : LK, 0.07216878364870322f, (char*)lds);
#endif
}
__device__ __forceinline__ void gqa_unit(const Params& p, int b, int h, int qb, bool ctxq, LAS unsigned char* lds) {
    unsigned char* ws = p.ws;
    const bf16_t* Q = ctxq ? (const bf16_t*)(ws + O_QGC) + (size_t)(b * 6 + h) * CTXL * 128 : (const bf16_t*)(ws + O_QG) + ((size_t)(b * 6 + h) * SEQ + qb * 256) * 128;
#if WOUT8
    bf16_t* O = (bf16_t*)(ws + O_MIX + (size_t)(ctxq ? NLAT + b * CTXL : b * SEQ + qb * 256) * DM + 1280 + h * 128);
#else
    bf16_t* O = (bf16_t*)(ws + O_MIX) + (size_t)(ctxq ? NLAT + b * CTXL : b * SEQ + qb * 256) * DM + 1280 + h * 128;
#endif
#if ATT_DMA & 2
    attn_body_dma<128>(Q, (const bf16_t*)(ws + O_KG) + (size_t)(b * 2 + h / 3) * LK * 128, (const bf16_t*)(ws + O_VG) + (size_t)(b * 2 + h / 3) * LK * 128, O, DM, ctxq ? CTXL : LK, 0.08838834764831845f, lds);
#else
    attn_body<128, GQA_SD>(Q, (const bf16_t*)(ws + O_KG) + (size_t)(b * 2 + h / 3) * LK * 128, (const bf16_t*)(ws + O_VG) + (size_t)(b * 2 + h / 3) * LK * 128, O, DM, ctxq ? CTXL : LK, 0.08838834764831845f, (char*)lds);
#endif
}
__device__ __forceinline__ void phase_mixer(const Params& p, int l, LAS unsigned char* lds) {
    const int G = gridDim.x, bid = blockIdx.x; const bool last = (l == NLAYER - 1);
#ifndef MLA_REP
#define MLA_REP 1
#endif
#ifndef GQA_REP
#define GQA_REP 1
#endif
    for (int rep_ = 0; rep_ < MLA_REP; ++rep_)
    for (int u = bid; u < 384 + (last ? 0 : 48); u += G) { if (u < 384) mla_unit(p, u / 48, (u >> 3) % 6, u & 7, false, lds); else mla_unit(p, (u - 384) / 6, (u - 384) % 6, 0, true, lds); }
    for (int rep_ = 0; rep_ < GQA_REP; ++rep_)
    for (int u = (bid + G / 2) % G; u < 384 + (last ? 0 : 48); u += G) { if (u < 384) gqa_unit(p, u / 48, (u >> 3) % 6, u & 7, false, lds); else gqa_unit(p, (u - 384) / 6, (u - 384) % 6, 0, true, lds); }
#ifndef CONV_REP
#define CONV_REP 1
#endif
    for (int rep = 0; rep < CONV_REP; ++rep) {
#if HY_MFMA
    for (int u = bid; u < 512; u += G) hyconv_unit_mfma(p, l, u, lds);
    if (!last) for (int u = bid; u < 512; u += G) hyconv_unit_valu(p, l, 1, u, (LAS float*)lds);
#else
    for (int u = bid; u < (last ? 512 : 1024); u += G) hyconv_unit_valu(p, l, u >> 9, u & 511, (LAS float*)lds);
#endif
    }
}

constexpr int RT_FS = DM + 4;
constexpr int RT_HS = DM + 8;
__device__ __forceinline__ void route_row_pre(const Params& p, int l, int row, int lane, LAS float* fdst, const float* g1, const float* g2) {
    const float* mc = (const float*)(p.ws + O_MODC) + (size_t)((l * 9 + row_batch(row)) * 6) * DM;
    const bf16_t* O = (const bf16_t*)(p.ws + O_OUT) + (size_t)row * DM; const float* rs = resid_src(p, l, row); float* X = (float*)(p.ws + O_X) + (size_t)row * DM; bf16_t* H = (bf16_t*)(p.ws + O_H) + (size_t)row * DM;
    u32x2 ov[8]; f32x4 xv[8], a1[8], a2[8], shv[8];
#pragma unroll
    for (int j = 0; j < 8; ++j) { const int c = ROWCOL(j, lane); ov[j] = *(const u32x2*)(O + c); xv[j] = ld_xrow(p, l, row, c); a1[j] = ld_mc(p, l, row, 0, c); a2[j] = ld_mc(p, l, row, 1, c); shv[j] = ld_mc(p, l, row, 2, c); }
    float o[32]; float ss = 0.f;
#pragma unroll
    for (int j = 0; j < 8; ++j) { o[j * 4] = __uint_as_float(ov[j].x << 16); o[j * 4 + 1] = __uint_as_float(ov[j].x & 0xffff0000u); o[j * 4 + 2] = __uint_as_float(ov[j].y << 16); o[j * 4 + 3] = __uint_as_float(ov[j].y & 0xffff0000u); }
#pragma unroll
    for (int i = 0; i < 32; ++i) ss += o[i] * o[i];
    const float r1 = rsqrtf(wave_sum(ss) * (1.0f / DM) + EPS); float s2 = 0.f;
#pragma unroll
    for (int j = 0; j < 8; ++j) { const int c = ROWCOL(j, lane);
#pragma unroll
        for (int q = 0; q < 4; ++q) { xv[j][q] += a1[j][q] * (o[j * 4 + q] * r1); s2 += xv[j][q] * xv[j][q]; }
        st_xrow(p, row, c, xv[j]); }
    const float r2 = rsqrtf(wave_sum(s2) * (1.0f / DM) + EPS);
#pragma unroll
    for (int j = 0; j < 8; ++j) { const int c = ROWCOL(j, lane); f32x4 f;
#pragma unroll
        for (int q = 0; q < 4; ++q) f[q] = xv[j][q] * r2 * a2[j][q] + shv[j][q];
#if MOE_FP8
        *(unsigned*)((unsigned char*)(p.ws + O_H) + (size_t)row * DM + c) = pk4_fp8(f[0], f[1], f[2], f[3]);
#else
        u32x2 w; w.x = pk2(f[0], f[1]); w.y = pk2(f[2], f[3]); *(u32x2*)(H + c) = w;
#endif
#if ROUTER_X3
        { float fl[4]; u32x2 wh, wl; wh.x = pk2(f[0], f[1]); wh.y = pk2(f[2], f[3]);
          fl[0] = f[0] - __uint_as_float(wh.x << 16); fl[1] = f[1] - __uint_as_float(wh.x & 0xffff0000u); fl[2] = f[2] - __uint_as_float(wh.y << 16); fl[3] = f[3] - __uint_as_float(wh.y & 0xffff0000u);
          wl.x = pk2(fl[0], fl[1]); wl.y = pk2(fl[2], fl[3]);
          *(LAS u32x2*)((LAS bf16_t*)fdst + c) = wh; *(LAS u32x2*)((LAS bf16_t*)fdst + 16 * RT_HS + c) = wl; }
#else
        *(LAS f32x4*)(fdst + c) = f;
#endif
    }
}
#if RC8
__device__ __forceinline__ void route_row_pre8(const Params& p, int l, int row, int lane, LAS float* fdst) {
    const bf16_t* O = (const bf16_t*)(p.ws + O_OUT) + (size_t)row * DM; const bf16_t* MC = (const bf16_t*)(p.ws + O_MODC) + (size_t)((l * 9 + row_batch(row)) * 6) * DM;
    bf16_t* Xb = (bf16_t*)(p.ws + O_X) + (size_t)row * DM;
    u32x4 ov[4], xb[4], a1b[4], a2b[4], shb[4]; f32x4 xf[4][2];
#pragma unroll
    for (int j = 0; j < 4; ++j) { const int c = j * 512 + lane * 8; ov[j] = LDNT(u32x4, O + c); a1b[j] = *(const u32x4*)(MC + c); a2b[j] = *(const u32x4*)(MC + DM + c); shb[j] = *(const u32x4*)(MC + 2 * DM + c);
#if NT2 & 16
        if (l == 0) { const float* rs = resid_src(p, 0, row); xf[j][0] = __builtin_nontemporal_load((const f32x4*)(rs + c)); xf[j][1] = __builtin_nontemporal_load((const f32x4*)(rs + c + 4)); } else xb[j] = LDNT(u32x4, Xb + c); }
#else
        if (l == 0) { const float* rs = resid_src(p, 0, row); xf[j][0] = *(const f32x4*)(rs + c); xf[j][1] = *(const f32x4*)(rs + c + 4); } else xb[j] = *(const u32x4*)(Xb + c); }
#endif
    float o[32], x[32]; float ss = 0.f;
#pragma unroll
    for (int j = 0; j < 4; ++j) { float t[8]; unpack8(ov[j], t);
#pragma unroll
        for (int q = 0; q < 8; ++q) { o[j * 8 + q] = t[q]; ss += t[q] * t[q]; } }
    const float r1 = rsqrtf(wave_sum(ss) * (1.0f / DM) + EPS); float s2 = 0.f;
#pragma unroll
    for (int j = 0; j < 4; ++j) { const int c = j * 512 + lane * 8; float xx[8], a[8], t[8]; unpack8(a1b[j], a);
        if (l == 0) {
#pragma unroll
            for (int q = 0; q < 4; ++q) { xx[q] = xf[j][0][q]; xx[4 + q] = xf[j][1][q]; } }
        else unpack8(xb[j], xx);
#pragma unroll
        for (int q = 0; q < 8; ++q) { t[q] = xx[q] + a[q] * (o[j * 8 + q] * r1); x[j * 8 + q] = t[q]; s2 += t[q] * t[q]; }
        STNT(u32x4, Xb + c, pack8(t)); }
    const float r2 = rsqrtf(wave_sum(s2) * (1.0f / DM) + EPS);
#pragma unroll
    for (int j = 0; j < 4; ++j) { const int c = j * 512 + lane * 8; float a2[8], sh[8], f[8], fl[8]; unpack8(a2b[j], a2); unpack8(shb[j], sh);
#pragma unroll
        for (int q = 0; q < 8; ++q) f[q] = x[j * 8 + q] * r2 * a2[q] + sh[q];
        u32x2 w8; w8.x = pk4_fp8(f[0], f[1], f[2], f[3]); w8.y = pk4_fp8(f[4], f[5], f[6], f[7]);
        *(u32x2*)((unsigned char*)(p.ws + O_H) + (size_t)row * DM + c) = w8;
        const u32x4 wh = pack8(f); float th[8]; unpack8(wh, th);
#pragma unroll
        for (int q = 0; q < 8; ++q) fl[q] = f[q] - th[q];
        *(LAS u32x4*)((LAS bf16_t*)fdst + c) = wh; *(LAS u32x4*)((LAS bf16_t*)fdst + 16 * RT_HS + c) = pack8(fl); }
}
#ifndef ROUTE2
#define ROUTE2 0
#endif
#if ROUTE2
__device__ __forceinline__ void route_rows_pre8(const Params& p, int l, int row0, int lane, LAS float* fdst0) {
    const bf16_t* MC = (const bf16_t*)(p.ws + O_MODC) + (size_t)((l * 9 + row_batch(row0)) * 6) * DM;
    u32x4 ov[2][4], a1b[4], a2b[4], shb[4];
#pragma unroll
    for (int j = 0; j < 4; ++j) { const int c = j * 512 + lane * 8; a1b[j] = *(const u32x4*)(MC + c); a2b[j] = *(const u32x4*)(MC + DM + c); shb[j] = *(const u32x4*)(MC + 2 * DM + c); }
#pragma unroll
    for (int rr = 0; rr < 2; ++rr) { const int row = row0 + rr; const bf16_t* O = (const bf16_t*)(p.ws + O_OUT) + (size_t)row * DM; const bf16_t* Xb = (const bf16_t*)(p.ws + O_X) + (size_t)row * DM;
#pragma unroll
        for (int j = 0; j < 4; ++j) { const int c = j * 512 + lane * 8; ov[rr][j] = *(const u32x4*)(O + c); } (void)Xb; }
#pragma unroll
    for (int rr = 0; rr < 2; ++rr) { const int row = row0 + rr; bf16_t* Xb = (bf16_t*)(p.ws + O_X) + (size_t)row * DM; LAS float* fdst = (LAS float*)((LAS bf16_t*)fdst0 + rr * RT_HS);
        u32x4 xb[4]; f32x4 xf[4][2];
#pragma unroll
        for (int j = 0; j < 4; ++j) { const int c = j * 512 + lane * 8;
            if (l == 0) { const float* rs = resid_src(p, 0, row); xf[j][0] = *(const f32x4*)(rs + c); xf[j][1] = *(const f32x4*)(rs + c + 4); } else xb[j] = *(const u32x4*)(Xb + c); }
        float o[32], x[32]; float ss = 0.f;
#pragma unroll
        for (int j = 0; j < 4; ++j) { float t[8]; unpack8(ov[rr][j], t);
#pragma unroll
            for (int q = 0; q < 8; ++q) { o[j * 8 + q] = t[q]; ss += t[q] * t[q]; } }
        const float r1 = rsqrtf(wave_sum(ss) * (1.0f / DM) + EPS); float s2 = 0.f;
#pragma unroll
        for (int j = 0; j < 4; ++j) { const int c = j * 512 + lane * 8; float xx[8], a[8], t[8]; unpack8(a1b[j], a);
            if (l == 0) {
#pragma unroll
                for (int q = 0; q < 4; ++q) { xx[q] = xf[j][0][q]; xx[4 + q] = xf[j][1][q]; } }
            else unpack8(xb[j], xx);
#pragma unroll
            for (int q = 0; q < 8; ++q) { t[q] = xx[q] + a[q] * (o[j * 8 + q] * r1); x[j * 8 + q] = t[q]; s2 += t[q] * t[q]; }
            *(u32x4*)(Xb + c) = pack8(t); }
        const float r2 = rsqrtf(wave_sum(s2) * (1.0f / DM) + EPS);
#pragma unroll
        for (int j = 0; j < 4; ++j) { const int c = j * 512 + lane * 8; float a2[8], sh[8], f[8], fl[8]; unpack8(a2b[j], a2); unpack8(shb[j], sh);
#pragma unroll
            for (int q = 0; q < 8; ++q) f[q] = x[j * 8 + q] * r2 * a2[q] + sh[q];
            u32x2 w8; w8.x = pk4_fp8(f[0], f[1], f[2], f[3]); w8.y = pk4_fp8(f[4], f[5], f[6], f[7]);
            *(u32x2*)((unsigned char*)(p.ws + O_H) + (size_t)row * DM + c) = w8;
            const u32x4 wh = pack8(f); float th[8]; unpack8(wh, th);
#pragma unroll
            for (int q = 0; q < 8; ++q) fl[q] = f[q] - th[q];
            *(LAS u32x4*)((LAS bf16_t*)fdst + c) = wh; *(LAS u32x4*)((LAS bf16_t*)fdst + 16 * RT_HS + c) = pack8(fl); } }
}
#endif
__device__ __forceinline__ void norm1_row_c8(const Params& p, int l, int row, const float (&x)[32], int lane) {
    const bf16_t* MC = (const bf16_t*)(p.ws + O_MODC) + (size_t)((l * 9 + row_batch(row)) * 6 + 4) * DM; u32x4 a4b[4], a5b[4];
#pragma unroll
    for (int j = 0; j < 4; ++j) { const int c = j * 512 + lane * 8; a4b[j] = *(const u32x4*)(MC + c); a5b[j] = *(const u32x4*)(MC + DM + c); }
    float ss = 0.f;
#pragma unroll
    for (int i = 0; i < 32; ++i) ss += x[i] * x[i];
    ss = wave_sum(ss); const float rstd = rsqrtf(ss * (1.0f / DM) + EPS);
    bf16_t* H = (bf16_t*)(p.ws + O_H) + (size_t)row * DM;
#pragma unroll
    for (int j = 0; j < 4; ++j) { const int c = j * 512 + lane * 8; float a4[8], a5[8], h[8]; unpack8(a4b[j], a4); unpack8(a5b[j], a5);
#pragma unroll
        for (int q = 0; q < 8; ++q) h[q] = x[j * 8 + q] * rstd * a4[q] + a5[q];
        *(u32x4*)(H + c) = pack8(h); }
}
#endif
__device__ __forceinline__ void route_row_topk(const Params& p, int l, int row, int lane, float logit, LAS unsigned* cntL) {
    const float score = 1.0f / (1.0f + expf(-logit)), biased = score + p.in[I_RB][l * 64 + lane];
    float m1 = biased; m1 = fmaxf(m1, __shfl_xor(m1, 1)); m1 = fmaxf(m1, __shfl_xor(m1, 2)); m1 = fmaxf(m1, __shfl_xor(m1, 4));
    const unsigned long long bal = __ballot(biased == m1); const int first = __builtin_ctz((unsigned)((bal >> (lane & ~7)) & 0xffull));
    float m2 = ((lane & 7) == first) ? -INFINITY : biased; m2 = fmaxf(m2, __shfl_xor(m2, 1)); m2 = fmaxf(m2, __shfl_xor(m2, 2)); m2 = fmaxf(m2, __shfl_xor(m2, 4));
    const float gs = m1 + m2; const int grp = lane >> 3; int rank = 0;
#pragma unroll
    for (int q = 0; q < 8; ++q) { const float v = rdlane(gs, q * 8); rank += (v > gs || (v == gs && q < grp)) ? 1 : 0; }
    const float cand = (rank < 4) ? biased : -INFINITY; int re = 0;
    for (int q = 0; q < 64; ++q) { const float v = rdlane(cand, q); re += (v > cand || (v == cand && q < lane)) ? 1 : 0; }
    const bool sel = re < TOPK; const float ssum = wave_sum(sel ? score : 0.f);
    if (sel) { ((int*)(p.ws + O_EIDX))[(size_t)row * 8 + re] = lane; ((float*)(p.ws + O_GATE))[(size_t)row * 8 + re] = score / ssum * 2.5f;
        ((int*)(p.ws + O_SLOT))[(size_t)row * 8 + re] = (int)__hip_atomic_fetch_add(&cntL[lane], 1u, __ATOMIC_RELAXED, __HIP_MEMORY_SCOPE_WORKGROUP); }
}
__device__ __forceinline__ void phase_route(const Params& p, int l, LAS unsigned char* lds) {
    const int tid = otid(), wid = __builtin_amdgcn_readfirstlane(tid >> 6), lane0 = tid & 63; const bool last = (l == NLAYER - 1); const int NR = last ? NLAT : NTOK;
    LAS float* frow = (LAS float*)lds; LAS float* part = frow;
    const float* g1 = p.in[I_NORMG] + (size_t)(l * 4 + 1) * DM; const float* g2 = p.in[I_NORMG] + (size_t)(l * 4 + 2) * DM;
    const float* RW = p.in[I_RW] + (size_t)l * DM * NEXP; LAS unsigned* cntL = (LAS unsigned*)(lds + LDS_CNTL);
    if (tid < 64) cntL[tid] = 0u;
    { int* stok = (int*)(p.ws + O_STOK); for (int i = blockIdx.x * NTHREADS + tid; i < NSLOTS; i += gridDim.x * NTHREADS) stok[i] = (i < RSLOTS) ? -1 : ((i - RSLOTS) < NR ? i - RSLOTS : -1); }
    for (int g = blockIdx.x; g < NR / 16; g += gridDim.x) {
        int lane = lane0; asm volatile("" : "+v"(lane));
#if ROUTER_X3
#if RC8
#if ROUTE2
        route_rows_pre8(p, l, g * 16 + wid * 2, lane, (LAS float*)((LAS bf16_t*)lds + (wid * 2) * RT_HS));
#else
        for (int rr = 0; rr < 2; ++rr) route_row_pre8(p, l, g * 16 + wid * 2 + rr, lane, (LAS float*)((LAS bf16_t*)lds + (wid * 2 + rr) * RT_HS));
#endif
#else
        for (int rr = 0; rr < 2; ++rr) route_row_pre(p, l, g * 16 + wid * 2 + rr, lane, (LAS float*)((LAS bf16_t*)lds + (wid * 2 + rr) * RT_HS), g1, g2);
#endif
        __syncthreads();
        f32x4 acc[4];
#pragma unroll
        for (int j = 0; j < 4; ++j) acc[j] = (f32x4){0.f, 0.f, 0.f, 0.f};
        { const int r16 = lane & 15, kq = lane >> 4; const LAS bf16_t* fh = (const LAS bf16_t*)lds + r16 * RT_HS + wid * 256 + 8 * kq; const LAS bf16_t* fl = fh + 16 * RT_HS;
          const bf16_t* wh = (const bf16_t*)(p.ws + O_RW2) + (size_t)(l * 2) * NEXP * DM + (size_t)wid * (8 * 4 * 64 * 8) + lane * 8; const bf16_t* wl = wh + (size_t)NEXP * DM;
#pragma unroll 2
          for (int st = 0; st < 8; ++st) { const bf16x8 ah = *(const LAS bf16x8*)(fh + 32 * st), al = *(const LAS bf16x8*)(fl + 32 * st); bf16x8 bh[4], bl[4];
#pragma unroll
              for (int eg = 0; eg < 4; ++eg) { bh[eg] = *(const bf16x8*)(wh + (st * 4 + eg) * 512); bl[eg] = *(const bf16x8*)(wl + (st * 4 + eg) * 512); }
#pragma unroll
              for (int eg = 0; eg < 4; ++eg) { acc[eg] = __builtin_amdgcn_mfma_f32_16x16x32_bf16(ah, bh[eg], acc[eg], 0, 0, 0); acc[eg] = __builtin_amdgcn_mfma_f32_16x16x32_bf16(ah, bl[eg], acc[eg], 0, 0, 0); acc[eg] = __builtin_amdgcn_mfma_f32_16x16x32_bf16(al, bh[eg], acc[eg], 0, 0, 0); } }
          __syncthreads();
#pragma unroll
          for (int eg = 0; eg < 4; ++eg)
#pragma unroll
              for (int r = 0; r < 4; ++r) part[(wid * 16 + 4 * kq + r) * 64 + 16 * eg + r16] = acc[eg][r]; }
#else
        for (int rr = 0; rr < 2; ++rr) route_row_pre(p, l, g * 16 + wid * 2 + rr, lane, frow + (wid * 2 + rr) * RT_FS, g1, g2);
        __syncthreads();
        f32x4 acc[4];
#pragma unroll
        for (int j = 0; j < 4; ++j) acc[j] = (f32x4){0.f, 0.f, 0.f, 0.f};
        { const int r16 = lane & 15, kq = lane >> 4; const LAS float* fa = frow + r16 * RT_FS + wid * 256 + 4 * kq; const float* rb = RW + (size_t)(wid * 256 + 4 * kq) * 64 + 4 * r16;
#pragma unroll 2
          for (int st = 0; st < 16; ++st) { const f32x4 a = *(const LAS f32x4*)(fa + 16 * st); f32x4 b[4];
#pragma unroll
              for (int i = 0; i < 4; ++i) b[i] = *(const f32x4*)(rb + (size_t)(16 * st + i) * 64);
#pragma unroll
              for (int i = 0; i < 4; ++i)
#pragma unroll
                  for (int j = 0; j < 4; ++j) acc[j] = __builtin_amdgcn_mfma_f32_16x16x4f32(a[i], b[i][j], acc[j], 0, 0, 0); }
          __syncthreads();
#pragma unroll
          for (int r = 0; r < 4; ++r) *(LAS f32x4*)(part + (wid * 16 + 4 * kq + r) * 64 + 4 * r16) = (f32x4){acc[0][r], acc[1][r], acc[2][r], acc[3][r]}; }
#endif
        __syncthreads();
        for (int rr = 0; rr < 2; ++rr) { const int r16 = wid * 2 + rr; float logit = 0.f;
#pragma unroll
            for (int w = 0; w < 8; ++w) logit += part[(w * 16 + r16) * 64 + lane];
            route_row_topk(p, l, g * 16 + r16, lane, logit, cntL); }
        __syncthreads();
    }
    __syncthreads();
    if (tid < 64) ((unsigned*)(p.ws + O_WCNT))[blockIdx.x * 64 + tid] = cntL[tid];
}
__device__ __forceinline__ void phase_place(const Params& p, int l, LAS unsigned char* lds) {
    const int tid = otid(); const int NR = (l == NLAYER - 1) ? NLAT : NTOK, G = gridDim.x;
    LAS int* woff = (LAS int*)lds; LAS int* csum = woff + 512 * 64; LAS int* pstart = csum + 8 * 64;
    const unsigned* wcnt = (const unsigned*)(p.ws + O_WCNT);
    for (int i = tid; i < G * 64; i += NTHREADS) woff[i] = (int)wcnt[i];
    __syncthreads();
    { const int e = tid & 63, ch = tid >> 6, cs = (G + 7) >> 3, w0 = ch * cs, w1 = (w0 + cs < G) ? w0 + cs : G; int run = 0;
      for (int w = w0; w < w1; ++w) { const int t = woff[w * 64 + e]; woff[w * 64 + e] = run; run += t; }
      csum[ch * 64 + e] = run;
      __syncthreads();
      int base = 0, tot = 0;
#pragma unroll
      for (int c2 = 0; c2 < 8; ++c2) { const int v = csum[c2 * 64 + e]; if (c2 < ch) base += v; tot += v; }
      for (int w = w0; w < w1; ++w) woff[w * 64 + e] += base;
      if (tid < 64) { const int ntile = (tot + 255) >> 8; pstart[tid] = (wave_incl_scan(ntile, tid) - ntile) * 256;
          if (blockIdx.x == 0) ((unsigned*)(p.ws + O_CTL))[CW_CNT + l * 64 + tid] = (unsigned)tot; } }
    __syncthreads();
    const int* eidx = (const int*)(p.ws + O_EIDX); int* slot = (int*)(p.ws + O_SLOT); int* stok = (int*)(p.ws + O_STOK);
    for (int i = blockIdx.x * NTHREADS + tid; i < NR * TOPK; i += G * NTHREADS) { const int row = i / TOPK, k = i % TOPK, e = eidx[(size_t)row * 8 + k], wg = (row >> 4) % G;
        const int s = pstart[e] + woff[wg * 64 + e] + slot[(size_t)row * 8 + k]; slot[(size_t)row * 8 + k] = s; stok[s] = row; }
    __syncthreads();
}
__device__ __forceinline__ void phase_final(const Params& p, int l) {
    const int lane = otid() & 63, gw = blockIdx.x * 8 + owid(), GW = gridDim.x * 8; const bool last = (l == NLAYER - 1); const int NR = last ? NLAT : NTOK;
    const bf16_t* DO = (const bf16_t*)(p.ws + O_DOUT);
    const int lane0 = lane;
    for (int row = gw; row < NR; row += GW) {
        int lane = lane0; asm volatile("" : "+v"(lane));
        const int sl = (lane < TOPK) ? ((const int*)(p.ws + O_SLOT))[(size_t)row * 8 + lane] : 0; const float gl = (lane < TOPK) ? ((const float*)(p.ws + O_GATE))[(size_t)row * 8 + lane] : 0.f;
#if RC8 && DOUT_FP8
        {
            bf16_t* Xb = (bf16_t*)(p.ws + O_X) + (size_t)row * DM; const bf16_t* M3 = (const bf16_t*)(p.ws + O_MODC) + (size_t)((l * 9 + row_batch(row)) * 6 + 3) * DM;
            u32x4 xb[4], a3b[4]; u32x2 v[7][4]; float gt[7]; const unsigned char* DO8 = p.ws + O_DOUT;
#pragma unroll
            for (int j = 0; j < 4; ++j) { const int c = j * 512 + lane * 8; xb[j] = LDNT(u32x4, Xb + c); a3b[j] = *(const u32x4*)(M3 + c); }
#pragma unroll
            for (int k = 0; k < 7; ++k) { const int s = (k == 0) ? RSLOTS + row : __builtin_amdgcn_readlane(sl, k - 1); const unsigned char* src = DO8 + (size_t)s * DM; gt[k] = ((k == 0) ? 1.0f : rdlane(gl, k - 1)) * (1.0f / DOUT8_SCALE);
#pragma unroll
                for (int j = 0; j < 4; ++j) v[k][j] = LDNT(u32x2, src + j * 512 + lane * 8); }
            float y[32];
#pragma unroll
            for (int i = 0; i < 32; ++i) y[i] = 0.f;
#pragma unroll
            for (int k = 0; k < 7; ++k)
#pragma unroll
                for (int j = 0; j < 4; ++j) { typedef float f32x2v __attribute__((ext_vector_type(2)));
                    const f32x2v l0 = __builtin_amdgcn_cvt_pk_f32_fp8((int)v[k][j].x, false), h0 = __builtin_amdgcn_cvt_pk_f32_fp8((int)v[k][j].x, true), l1 = __builtin_amdgcn_cvt_pk_f32_fp8((int)v[k][j].y, false), h1 = __builtin_amdgcn_cvt_pk_f32_fp8((int)v[k][j].y, true);
                    y[j * 8] += gt[k] * l0.x; y[j * 8 + 1] += gt[k] * l0.y; y[j * 8 + 2] += gt[k] * h0.x; y[j * 8 + 3] += gt[k] * h0.y; y[j * 8 + 4] += gt[k] * l1.x; y[j * 8 + 5] += gt[k] * l1.y; y[j * 8 + 6] += gt[k] * h1.x; y[j * 8 + 7] += gt[k] * h1.y; }
            float ss = 0.f;
#pragma unroll
            for (int i = 0; i < 32; ++i) ss += y[i] * y[i];
            const float r = rsqrtf(wave_sum(ss) * (1.0f / DM) + EPS); float x[32];
#pragma unroll
            for (int j = 0; j < 4; ++j) { const int c = j * 512 + lane * 8; float xx[8], a3[8], t[8]; unpack8(xb[j], xx); unpack8(a3b[j], a3);
#pragma unroll
                for (int q = 0; q < 8; ++q) { t[q] = xx[q] + a3[q] * (y[j * 8 + q] * r); x[j * 8 + q] = t[q]; }
#if NT2 & 32
                if (last) { __builtin_nontemporal_store((f32x4){t[0], t[1], t[2], t[3]}, (f32x4*)(p.out + (size_t)row * DM + c)); __builtin_nontemporal_store((f32x4){t[4], t[5], t[6], t[7]}, (f32x4*)(p.out + (size_t)row * DM + c + 4)); }
#else
                if (last) { *(f32x4*)(p.out + (size_t)row * DM + c) = (f32x4){t[0], t[1], t[2], t[3]}; *(f32x4*)(p.out + (size_t)row * DM + c + 4) = (f32x4){t[4], t[5], t[6], t[7]}; }
#endif
                else STNT(u32x4, Xb + c, pack8(t)); }
            if (!last) norm1_row_c8(p, l + 1, row, x, lane);
            continue;
        }
#endif
        f32x4 xv[8], a3[8];
        { const float* Xr = (const float*)(p.ws + O_X) + (size_t)row * DM; const float* m3 = (const float*)(p.ws + O_MODC) + (size_t)((l * 9 + row_batch(row)) * 6 + 3) * DM;
#pragma unroll
          for (int j = 0; j < 8; ++j) { xv[j] = XB16 ? ld_xrow(p, 1, row, ROWCOL(j, lane)) : *(const f32x4*)(Xr + ROWCOL(j, lane)); a3[j] = ld_mc(p, l, row, 3, ROWCOL(j, lane)); } }
        float y[32];
#pragma unroll
        for (int i = 0; i < 32; ++i) y[i] = 0.f;
#if DOUT_FP8
        { const unsigned char* DO8 = p.ws + O_DOUT; unsigned v[7][8]; float gt[7];
#pragma unroll
          for (int k = 0; k < 7; ++k) { const int s = (k == 0) ? RSLOTS + row : __builtin_amdgcn_readlane(sl, k - 1); const unsigned char* src = DO8 + (size_t)s * DM; gt[k] = ((k == 0) ? 1.0f : rdlane(gl, k - 1)) * (1.0f / DOUT8_SCALE);
#pragma unroll
              for (int j = 0; j < 8; ++j) v[k][j] = *(const unsigned*)(src + ROWCOL(j, lane)); }
#pragma unroll
          for (int k = 0; k < 7; ++k)
#pragma unroll
              for (int j = 0; j < 8; ++j) { typedef float f32x2v __attribute__((ext_vector_type(2))); const f32x2v lo = __builtin_amdgcn_cvt_pk_f32_fp8((int)v[k][j], false), hi = __builtin_amdgcn_cvt_pk_f32_fp8((int)v[k][j], true);
                  y[j * 4] += gt[k] * lo.x; y[j * 4 + 1] += gt[k] * lo.y; y[j * 4 + 2] += gt[k] * hi.x; y[j * 4 + 3] += gt[k] * hi.y; } }
#else
#pragma unroll
        for (int kb = 0; kb < 7; kb += 4) {
            u32x2 v[4][8]; float gt[4];
#pragma unroll
            for (int kk = 0; kk < 4; ++kk) { const int k = kb + kk; if (k < 7) { const int s = (k == 0) ? RSLOTS + row : __builtin_amdgcn_readlane(sl, k - 1); const bf16_t* src = DO + (size_t)s * DM; gt[kk] = (k == 0) ? 1.0f : rdlane(gl, k - 1);
#pragma unroll
                for (int j = 0; j < 8; ++j) v[kk][j] = *(const u32x2*)(src + ROWCOL(j, lane)); } }
#pragma unroll
            for (int kk = 0; kk < 4; ++kk) { if (kb + kk < 7) {
#pragma unroll
                for (int j = 0; j < 8; ++j) { const float g = gt[kk]; y[j * 4] += g * __uint_as_float(v[kk][j].x << 16); y[j * 4 + 1] += g * __uint_as_float(v[kk][j].x & 0xffff0000u); y[j * 4 + 2] += g * __uint_as_float(v[kk][j].y << 16); y[j * 4 + 3] += g * __uint_as_float(v[kk][j].y & 0xffff0000u); } } }
        }
#endif
        float ss = 0.f;
#pragma unroll
        for (int i = 0; i < 32; ++i) ss += y[i] * y[i];
        const float r = rsqrtf(wave_sum(ss) * (1.0f / DM) + EPS);
        float* X = (float*)(p.ws + O_X) + (size_t)row * DM; float x[32];
#pragma unroll
        for (int j = 0; j < 8; ++j) { const int c = ROWCOL(j, lane); f32x4 xn;
#pragma unroll
            for (int q = 0; q < 4; ++q) { xn[q] = xv[j][q] + a3[j][q] * (y[j * 4 + q] * r); x[j * 4 + q] = xn[q]; }
            if (last) *(f32x4*)(p.out + (size_t)row * DM + c) = xn; else st_xrow(p, row, c, xn); }
        if (!last) norm1_row_c(p, l + 1, row, x, lane);
    }
}

#define XB_TMO      128
#define XB_XCNT(j)  (256  + 64 * (j))
#define XB_XSUB(j)  (1280 + 64 * (j))
#define XB_XGEN(j)  (2304 + 64 * (j))
#define XB_TOP      3328
#define XB_TOPGEN   3392
#define XCD_BAR_WORDS 3456
#define XB_SPIN_CAP (1u << 23)

__device__ __forceinline__ unsigned xb_ld(unsigned* p)              { return __hip_atomic_load(p, __ATOMIC_RELAXED, __HIP_MEMORY_SCOPE_AGENT); }
__device__ __forceinline__ unsigned xb_add(unsigned* p, unsigned v) { return __hip_atomic_fetch_add(p, v, __ATOMIC_RELAXED, __HIP_MEMORY_SCOPE_AGENT); }
__device__ __forceinline__ unsigned xb_xcc_id() { return (unsigned)__builtin_amdgcn_s_getreg((3 << 11) | 20) & 0xFu; }
#define XB_SPIN(cond, bar) do { unsigned _sp = 0; while (cond) { __builtin_amdgcn_s_sleep(1); \
    if ((++_sp & 255u) == 0u) { if (xb_ld(&(bar)[XB_TMO])) break; if (_sp > XB_SPIN_CAP) { atomicAdd(&(bar)[XB_TMO], 1u); break; } } } } while (0)

struct XcdBarrier {
    unsigned* bar; unsigned x;
    volatile LAS unsigned* st;
};

__device__ __forceinline__ XcdBarrier xcd_barrier_post(unsigned* bar, volatile LAS unsigned* st) {
    XcdBarrier b; b.bar = bar; b.x = xb_xcc_id(); b.st = st;
    if (threadIdx.x == 0) (void)xb_add(&bar[XB_XCNT(b.x)], 1u);
    return b;
}
__device__ __forceinline__ void xcd_barrier_complete(unsigned* bar, unsigned x, unsigned& nloc, unsigned& nx) {
    const unsigned G = gridDim.x * gridDim.y * gridDim.z;
    unsigned sum, cnt, mine, sp = 0u;
    for (;;) {
        sum = 0u; cnt = 0u; mine = 0u;
#pragma unroll
        for (unsigned j = 0; j < 16; ++j) { const unsigned c = xb_ld(&bar[XB_XCNT(j)]); sum += c; cnt += (c > 0u) ? 1u : 0u; mine = (j == x) ? c : mine; }
        if (sum == G) break;
        __builtin_amdgcn_s_sleep(1);
        if ((++sp & 255u) == 0u) { if (xb_ld(&bar[XB_TMO])) break; if (sp > XB_SPIN_CAP) { atomicAdd(&bar[XB_TMO], 1u); break; } }
    }
    nloc = mine > 0u ? mine : 1u; nx = cnt > 0u ? cnt : 1u;
}

__device__ __forceinline__ void xcd_barrier(const XcdBarrier& b) {
    asm volatile("s_waitcnt vmcnt(0)" ::: "memory");
    __syncthreads();
    if (threadIdx.x == 0) {
        unsigned* bar = b.bar;
        __builtin_amdgcn_s_waitcnt(0);
        unsigned nloc = b.st[0], nx = b.st[1];
        if (nloc == 0u) { xcd_barrier_complete(bar, b.x, nloc, nx); b.st[0] = nloc; b.st[1] = nx; }
        const unsigned old = xb_add(&bar[XB_XSUB(b.x)], 1u);
        const unsigned gen = old / nloc;
        if (old + 1u == (gen + 1u) * nloc) {
            __builtin_amdgcn_fence(__ATOMIC_RELEASE, "agent");
            asm volatile("s_waitcnt vmcnt(0)" ::: "memory");
            const unsigned og = xb_add(&bar[XB_TOP], 1u);
            const unsigned tg = og / nx;
            if (og + 1u == (tg + 1u) * nx) xb_add(&bar[XB_TOPGEN], 1u);
            else XB_SPIN(xb_ld(&bar[XB_TOPGEN]) == tg, bar);
            __builtin_amdgcn_fence(__ATOMIC_ACQUIRE, "agent");
            xb_add(&bar[XB_XGEN(b.x)], 1u);
            asm volatile("s_waitcnt vmcnt(0)" ::: "memory");
        } else {
            XB_SPIN(xb_ld(&bar[XB_XGEN(b.x)]) == gen, bar);
            __builtin_amdgcn_fence(__ATOMIC_ACQUIRE, "agent");
            asm volatile("s_waitcnt vmcnt(0)" ::: "memory");
        }
    }
    __syncthreads();
}


#if CVT_BG
__device__ __forceinline__ void xcd_barrier_work(const XcdBarrier& b, LAS unsigned char* lds) {
    volatile LAS unsigned* fl = (volatile LAS unsigned*)(lds + LDS_BGFLAG);
    asm volatile("s_waitcnt vmcnt(0)" ::: "memory");
    __syncthreads();
    if (threadIdx.x == 0) {
        unsigned* bar = b.bar;
        __builtin_amdgcn_s_waitcnt(0);
        unsigned nloc = b.st[0], nx = b.st[1];
        if (nloc == 0u) { xcd_barrier_complete(bar, b.x, nloc, nx); b.st[0] = nloc; b.st[1] = nx; }
        const unsigned old = xb_add(&bar[XB_XSUB(b.x)], 1u);
        const unsigned gen = old / nloc;
        if (old + 1u == (gen + 1u) * nloc) {
            __builtin_amdgcn_fence(__ATOMIC_RELEASE, "agent");
            asm volatile("s_waitcnt vmcnt(0)" ::: "memory");
            const unsigned og = xb_add(&bar[XB_TOP], 1u);
            const unsigned tg = og / nx;
            if (og + 1u == (tg + 1u) * nx) xb_add(&bar[XB_TOPGEN], 1u);
            else XB_SPIN(xb_ld(&bar[XB_TOPGEN]) == tg, bar);
            __builtin_amdgcn_fence(__ATOMIC_ACQUIRE, "agent");
            xb_add(&bar[XB_XGEN(b.x)], 1u);
            asm volatile("s_waitcnt vmcnt(0)" ::: "memory");
            fl[0] = 0xFFFFFFFFu;
        } else fl[0] = gen;
    }
    __syncthreads();
    const unsigned gen = fl[0];
    if (gen != 0xFFFFFFFFu) {
        unsigned sp = 0u;
        for (;;) {
            if (threadIdx.x == 0) { unsigned rel = (xb_ld(&b.bar[XB_XGEN(b.x)]) != gen) ? 1u : 0u;
                if (!rel && (++sp & 255u) == 0u) { if (xb_ld(&b.bar[XB_TMO])) rel = 1u; else if (sp > XB_SPIN_CAP) { atomicAdd(&b.bar[XB_TMO], 1u); rel = 1u; } }
                fl[1] = rel; }
            __syncthreads();
            const unsigned rel = fl[1];
            __syncthreads();
            if (rel) break;
            if (!((BG_TWO & 1) ? cvt_bg_step2(lds, 2 * CVT_EXP) : cvt_bg_step(lds, 2 * CVT_EXP))) __builtin_amdgcn_s_sleep(1);
        }
        if (threadIdx.x == 0) { __builtin_amdgcn_fence(__ATOMIC_ACQUIRE, "agent"); asm volatile("s_waitcnt vmcnt(0)" ::: "memory"); }
    }
    __syncthreads();
}
#endif

enum { PH_PRO = 0, PH_NORM1, PH_WIN, PH_POSTA, PH_POSTB, PH_MIXER, PH_HYFIN, PH_WOUT, PH_ROUTE, PH_PLACE, PH_GEMM1, PH_GEMM2, PH_FINAL, PH_COUNT };

template <int PH>
__device__ __forceinline__ void run_phase(const Params& p_in, int l, LAS unsigned char* lds) {
#if MEGA
    const __attribute__((address_space(4))) Params* kp = (const __attribute__((address_space(4))) Params*)__builtin_amdgcn_kernarg_segment_ptr(); asm volatile("" : "+s"(kp)); (void)p_in;
    Params p;
#pragma unroll
    for (int i_ = 0; i_ < 31; ++i_) p.in[i_] = kp->in[i_];
    p.out = kp->out; p.ws = kp->ws; p.layer = 0; p.pad = 0;
#else
    Params p = p_in; { unsigned char* w = p.ws; asm volatile("" : "+s"(w)); p.ws = w; }
#endif
    unsigned char* ws = p.ws; const bool last = (l == NLAYER - 1);
    const int gw = blockIdx.x * 8 + owid(), GW = gridDim.x * 8, lane = otid() & 63;
    if constexpr (PH == PH_PRO) { phase_prologue(p, lds); }
    if constexpr (PH == PH_NORM1) { phase_norm1(p, l); }
    if constexpr (PH == PH_WIN) {
        EpiStoreBf16 E{(bf16_t*)(ws + O_P), NP}; GemmDesc g{(const bf16_t*)(ws + O_H), DM, nullptr, DM, DM};
#if WIN8
        const bf16_t* Bt = (const bf16_t*)(ws + O_WIN + (size_t)l * NP * DM);
        if (!last) { DenseSched S{Bt, DM / 2, NTOK / 256, 16, 0, 0}; GEMM_PHASE8(g, S, E, 127, 119); }
        else { DenseSched S{Bt, DM / 2, NLAT / 256, 16, 0, 0}; GEMM_PHASE8(g, S, E, 127, 119); DenseSched S2{Bt, DM / 2, NCTX / 256, 4, NLAT, 12}; GEMM_PHASE8(g, S2, E, 127, 119); }
#else
        const bf16_t* Bt = (const bf16_t*)(ws + O_WIN) + (size_t)l * NP * DM;
        if (!last) { DenseSched S{Bt, DM, NTOK / 256, 16, 0, 0}; GEMM_PHASE(g, S, E); }
        else { DenseSched S{Bt, DM, NLAT / 256, 16, 0, 0}; GEMM_PHASE(g, S, E); DenseSched S2{Bt, DM, NCTX / 256, 4, NLAT, 12}; GEMM_PHASE_R(g, S2, E, 4, 0); }
#endif
    }
    if constexpr (PH == PH_POSTA) {
#ifndef DBG_SKIP
#define DBG_SKIP 0
#endif
#ifndef PA_GEMM_REP
#define PA_GEMM_REP 1
#endif
        for (int rep_ = 0; rep_ < PA_GEMM_REP; ++rep_) {
        if (!(DBG_SKIP & 1)) { GemmDesc g{(const bf16_t*)(ws + O_P) + C_CQ, NP, nullptr, 768, 768}; EpiStoreBf16 E{(bf16_t*)(ws + O_QRAW), NQP};
          DenseSched S{(const bf16_t*)(ws + O_WUQ) + (size_t)l * NQP * 768, 768, (last ? NLAT : NTOK) / 256, 5, 0, 0}; GEMM_PHASE(g, S, E); }
        if (!(DBG_SKIP & 2)) { GemmDesc g{(const bf16_t*)(ws + O_P) + C_CKV, NP, nullptr, 256, 256}; EpiStoreBf16 E{(bf16_t*)(ws + O_KVRAW), 1536};
          DenseSched S{(const bf16_t*)(ws + O_WUKV) + (size_t)l * 1536 * 256, 256, NTOK / 256, 6, 0, 0}; GEMM_PHASE_R(g, S, E, 0, (last ? NLAT : NTOK) / 256 * 5 - 256); }
        }
        const int ntt = (last ? NLAT : NTOK) / 64;
        if (!(DBG_SKIP & 4)) for (int t = blockIdx.x; t < ntt * 4; t += gridDim.x) hy_prep_task(p, l, (t >> 2) * 64, (t & 3) * 256, (LAS float*)lds);
        if (!(DBG_SKIP & 8)) for (int row = gw; row < NTOK; row += GW) gqa_post_row(p, l, row, lane);
    }
    if constexpr (PH == PH_POSTB) { if (l == 0) hss_tasks(p); for (int row = gw; row < NTOK; row += GW) mla_post_row(p, l, row, lane); }
    if constexpr (PH == PH_MIXER) { phase_mixer(p, l, lds); }
    if constexpr (PH == PH_HYFIN) { const int ntt = (last ? NLAT : NTOK) / 64; for (int t = blockIdx.x; t < ntt * 8; t += gridDim.x) hy_fin_task(p, l, (t >> 3) * 64, (t & 7) * 64, (LAS float*)lds); }
    if constexpr (PH == PH_WOUT) {
        GemmDesc g{(const bf16_t*)(ws + O_MIX), DM, nullptr, DM, DM}; EpiStoreBf16 E{(bf16_t*)(ws + O_OUT), DM};
#if WOUT8
        DenseSched S{(const bf16_t*)(ws + O_WOUT + (size_t)l * DM * DM), DM / 2, (last ? NLAT : NTOK) / 256, 8, 0, 0}; GEMM_PHASE8(g, S, E, 127, 115);
#elif WOUT8G
        { GemmDesc g8{(const bf16_t*)(ws + O_QM), DM, nullptr, DM, DM}; DenseSched S{(const bf16_t*)(ws + O_QG), DM / 2, (last ? NLAT : NTOK) / 256, 8, 0, 0}; GEMM_PHASE8(g8, S, E, 123, 119); }
#else
        DenseSched S{(const bf16_t*)(ws + O_WOUT) + (size_t)l * DM * DM, DM, (last ? NLAT : NTOK) / 256, 8, 0, 0}; GEMM_PHASE_R(g, S, E, 4, 0);
#endif
    }
    if constexpr (PH == PH_ROUTE) { phase_route(p, l, lds); }
    if constexpr (PH == PH_PLACE) { phase_place(p, l, lds);
#if CVT_BG
        { __syncthreads(); while ((BG_TWO & 2) ? cvt_bg_step2(lds, l * CVT_EXP + CVT_GU) : cvt_bg_step(lds, l * CVT_EXP + CVT_GU, (BG_DRAIN_REP & 3))) { } }
#endif
    }
    if constexpr (PH == PH_GEMM1 || PH == PH_GEMM2) {
        LAS int* te = (LAS int*)(lds + LDS_TILES); LAS int* ts = te + MAXTILES; LAS int* misc = (LAS int*)(lds + LDS_MISC) + 16;
        const int nt = moe_build_tiles((const unsigned*)(ws + O_CTL) + CW_CNT + l * 64, (last ? NLAT : NTOK) / 256, te, ts, misc);
#if MOE_FP8
        if constexpr (PH == PH_GEMM1) {
            GemmDesc g{(const bf16_t*)(ws + O_H), DM, (const int*)(ws + O_STOK), DM, DM}; EpiSwiGLU8 E{ws + O_HID};
            MoeSched S{te, ts, nt, 4, (const bf16_t*)(ws + O_EGU + (size_t)(CVT_BG ? l : 0) * 65 * 1024 * 2048), (size_t)1024 * 1024, DM / 2, 128}; GEMM_PHASE8_R(g, S, E, 127, 119, 2);
        } else {
            GemmDesc g{(const bf16_t*)(ws + O_HID), EH, nullptr, EH, EH};
            MoeSched S{te, ts, nt, 8, (const bf16_t*)(ws + O_ED + (size_t)(CVT_BG ? l : 0) * 65 * 2048 * 512), (size_t)2048 * 256, EH / 2, 256};
#if DOUT_FP8
            static_assert(DOUT8_SCALE == 8.0f, "the output scale is folded into the weight block scale below (119 + 3)");
            EpiStoreFp8 E{ws + O_DOUT, DM, 1.0f}; GEMM_PHASE8_R(g, S, E, 124, 122, 6);
#else
            EpiStoreBf16 E{(bf16_t*)(ws + O_DOUT), DM}; GEMM_PHASE8(g, S, E, 124, 119);
#endif
        }
#else
        if constexpr (PH == PH_GEMM1) {
            GemmDesc g{(const bf16_t*)(ws + O_H), DM, (const int*)(ws + O_STOK), DM, DM}; EpiSwiGLU E{(bf16_t*)(ws + O_HID)};
            MoeSched S{te, ts, nt, 4, (const bf16_t*)(ws + O_EGU), (size_t)1024 * 2048, DM, 128}; GEMM_PHASE(g, S, E);
        } else {
            GemmDesc g{(const bf16_t*)(ws + O_HID), EH, nullptr, EH, EH}; EpiStoreBf16 E{(bf16_t*)(ws + O_DOUT), DM};
            MoeSched S{te, ts, nt, 8, (const bf16_t*)(ws + O_ED), (size_t)2048 * 512, EH, 256}; GEMM_PHASE(g, S, E);
        }
#endif
        __syncthreads();
#if CVT_BG
        if constexpr (PH == PH_GEMM1) { while ((BG_TWO & 2) ? cvt_bg_step2(lds, (l + 1) * CVT_EXP) : cvt_bg_step(lds, (l + 1) * CVT_EXP, (BG_DRAIN_REP >> 2) ? (BG_DRAIN_REP >> 2) : 1)) { } }
#endif
    }
    if constexpr (PH == PH_FINAL) {
        phase_final(p, l);
#if CVT_BG
#else
        if (!last) cvt_exp_all(p, l + 1);
#endif
    }
}

#ifndef MEGA
#define MEGA 0
#endif


#if MEGA
__global__ void __launch_bounds__(NTHREADS, 2) mega_fwd(Params p) {
    extern __shared__ __attribute__((aligned(16))) unsigned char lds_raw[];
    LAS unsigned char* lds = (LAS unsigned char*)lds_raw;
    volatile LAS unsigned* xbw = (volatile LAS unsigned*)(lds + LDS_MISC);
    if (otid() == 0) { xbw[0] = 0u; xbw[1] = 0u; }
    if (otid() < 8) ((volatile LAS int*)(lds + LDS_BGCUR))[otid()] = 0;
    __syncthreads();
    { const XcdBarrier b0 = xcd_barrier_post((unsigned*)(p.ws + O_CTL) + CW_BAR, xbw); if (otid() == 0) xbw[2] = b0.x; }
    __syncthreads();
#define GRID_BAR() do { XcdBarrier b_; b_.bar = (unsigned*)(p.ws + O_CTL) + CW_BAR; b_.x = xbw[2]; b_.st = xbw; xcd_barrier(b_); } while (0)
#if CVT_BG
#define GRID_BARW(l) do { XcdBarrier b_; b_.bar = (unsigned*)(p.ws + O_CTL) + CW_BAR; b_.x = xbw[2]; b_.st = xbw; if (l) xcd_barrier_work(b_, lds); else xcd_barrier(b_); } while (0)
#else
#define GRID_BARW(l) GRID_BAR()
#endif
#ifndef DBL_MASK
#define DBL_MASK 0
#endif
#define RUNP(PH, l) do { run_phase<PH>(p, l, lds); GRID_BARW((l) == 0 || PH < PH_GEMM1); if ((DBL_MASK >> PH) & 1) { run_phase<PH>(p, l, lds); GRID_BAR(); } } while (0)
#ifndef DLY_MASK
#define DLY_MASK 0
#endif
#define RUND(PH, l) do { if ((DLY_MASK >> PH) & 1) { const unsigned long long t0_ = wall_clock64(); run_phase<PH>(p, l, lds); const unsigned long long t1_ = wall_clock64(); while (wall_clock64() < t1_ + (t1_ - t0_)) __builtin_amdgcn_s_sleep(8); } else run_phase<PH>(p, l, lds); } while (0)
    RUNP(PH_PRO, 0);
#if WOUT8G && !WOUT8
#define MIX8CVT(l) do { const size_t n8_ = (size_t)NTOK * DM / 8; const bf16_t* src_ = (const bf16_t*)(p.ws + O_MIX); unsigned char* dst_ = p.ws + O_QM; \
        for (size_t i_ = (size_t)blockIdx.x * NTHREADS + otid(); i_ < n8_; i_ += (size_t)gridDim.x * NTHREADS) { float x_[8]; unpack8(*(const u32x4*)(src_ + i_ * 8), x_); u32x2 w_; w_.x = pk4_fp8(x_[0] * 16.f, x_[1] * 16.f, x_[2] * 16.f, x_[3] * 16.f); w_.y = pk4_fp8(x_[4] * 16.f, x_[5] * 16.f, x_[6] * 16.f, x_[7] * 16.f); *(u32x2*)(dst_ + i_ * 8) = w_; } \
        { const size_t nw_ = (size_t)DM * DM / 8; const bf16_t* ws_ = (const bf16_t*)(p.ws + O_WOUT) + (size_t)(l) * DM * DM; unsigned char* wd_ = p.ws + O_QG; \
          for (size_t i_ = (size_t)blockIdx.x * NTHREADS + otid(); i_ < nw_; i_ += (size_t)gridDim.x * NTHREADS) { float x_[8]; unpack8(*(const u32x4*)(ws_ + i_ * 8), x_); u32x2 w_; w_.x = pk4_fp8(x_[0] * 256.f, x_[1] * 256.f, x_[2] * 256.f, x_[3] * 256.f); w_.y = pk4_fp8(x_[4] * 256.f, x_[5] * 256.f, x_[6] * 256.f, x_[7] * 256.f); *(u32x2*)(wd_ + i_ * 8) = w_; } } \
        GRID_BAR(); } while (0)
#else
#define MIX8CVT(l) do { } while (0)
#endif
#define LAYER(l) do { if ((l) == 0) RUNP(PH_NORM1, l); \
        RUNP(PH_WIN, l); RUNP(PH_POSTA, l); RUNP(PH_POSTB, l); RUNP(PH_MIXER, l); RUNP(PH_HYFIN, l); MIX8CVT(l); RUNP(PH_WOUT, l); \
        RUND(PH_ROUTE, l); GRID_BARW(1); RUND(PH_PLACE, l); GRID_BARW(1); RUNP(PH_GEMM1, l); RUNP(PH_GEMM2, l); RUND(PH_FINAL, l); \
        if ((l) + 1 < NLAYER) GRID_BARW(1); } while (0)
    LAYER(0);
    LAYER(1);
}
#endif

#if !MEGA
template <int PH> __global__ void __launch_bounds__(NTHREADS, 2) k_phase(Params p) {
    extern __shared__ __attribute__((aligned(16))) unsigned char lds_raw[];
    run_phase<PH>(p, p.layer, (LAS unsigned char*)lds_raw);
}
template <int PH> static bool prep_phase() { return hipFuncSetAttribute((const void*)k_phase<PH>, hipFuncAttributeMaxDynamicSharedMemorySize, LDS_BYTES) == hipSuccess; }
static int g_nlaunch = 0;
#ifndef DBG_STOP
#define DBG_STOP 1000
#define DBG_DUMP 0
#else
#define DBG_DUMP 1
#ifndef DBG_SET
#define DBG_SET 31
#endif
#endif
template <int PH> static void launch_phase(Params p, int l, hipStream_t st) { if (g_nlaunch++ >= DBG_STOP) return; p.layer = l; hipLaunchKernelGGL(k_phase<PH>, dim3(256), dim3(NTHREADS), LDS_BYTES, st, p); }
#endif


#if DBG_DUMP
__device__ __forceinline__ float san(float x) { return (x == x && fabsf(x) < 1e6f) ? x : 1.0f; }
__global__ void __launch_bounds__(256) k_dump(Params p) {
    const size_t N = (size_t)NLAT * DM;
    const bf16_t* b1 = (const bf16_t*)(p.ws + O_WIN); const size_t n1 = (O_X - O_WIN) / 2;
    const bf16_t* b2 = (const bf16_t*)(p.ws + O_H); const size_t n2 = (size_t)NTOK * DM;
    const bf16_t* b3 = (const bf16_t*)(p.ws + O_A); const size_t n3 = (O_AEND - O_A) / 2;
    const float* f1 = (const float*)(p.ws + O_MOD); const size_t m1 = (O_WIN - O_MOD) / 4;
    const float* f2 = (const float*)(p.ws + O_X); const size_t m2 = (size_t)NTOK * DM;
    for (size_t i = (size_t)blockIdx.x * 256 + otid(); i < N; i += (size_t)gridDim.x * 256) {
        float v = 0.f;
        if (DBG_SET & 1) for (size_t e = i; e < n1; e += N) v += san(bf2f(b1[e]));
        if (DBG_SET & 2) for (size_t e = i; e < n2; e += N) v += san(bf2f(b2[e]));
        if (DBG_SET & 4) for (size_t e = i; e < n3; e += N) v += san(bf2f(b3[e]));
        if (DBG_SET & 8) for (size_t e = i; e < m1; e += N) v += san(f1[e]);
        if (DBG_SET & 16) for (size_t e = i; e < m2; e += N) v += san(f2[e]);
        if (DBG_SET & 32) v += san(bf2f(((const bf16_t*)(p.ws + O_WUKV))[i % ((size_t)2 * 1536 * 256)]));
        if (DBG_SET & 64) { const size_t r = i % NTOK, c = (i / NTOK) % 256; v += san(bf2f(((const bf16_t*)(p.ws + O_P))[r * NP + C_CKV + c])); }
        if (DBG_SET & 128) v += san(bf2f(((const bf16_t*)(p.ws + O_KVRAW))[i % ((size_t)NTOK * 1536)]));
        p.out[i] = v;
    }
}
#endif
static int g_grid = 0;
extern "C" void kernel_launch(void* const* d_in, const int* in_sizes, int n_in, void* d_out, int out_size, void* d_ws, size_t ws_size, hipStream_t stream) {
    static int ok = 0;
    if (ok == 0) {
        if (n_in != 31 || in_sizes[0] != NLAT * DM || out_size != NLAT * DM || ws_size < WS_END) { fprintf(stderr, "kernel_launch: unexpected shapes (n_in %d, ws %zu, need %zu)\n", n_in, ws_size, (size_t)WS_END); ok = -1; return; }
        bool good = true;
#if !MEGA
        good = good && prep_phase<0>() && prep_phase<1>() && prep_phase<2>() && prep_phase<3>() && prep_phase<4>() && prep_phase<5>() && prep_phase<6>() && prep_phase<7>() && prep_phase<8>() && prep_phase<9>() && prep_phase<10>() && prep_phase<11>() && prep_phase<12>();
#endif
#if MEGA
        good = hipFuncSetAttribute((const void*)mega_fwd, hipFuncAttributeMaxDynamicSharedMemorySize, LDS_BYTES) == hipSuccess;
        int dev = 0, cus = 0, per_cu = 0;
        if (hipGetDevice(&dev) != hipSuccess || hipDeviceGetAttribute(&cus, hipDeviceAttributeMultiprocessorCount, dev) != hipSuccess) good = false;
        if (good && (hipOccupancyMaxActiveBlocksPerMultiprocessor(&per_cu, (const void*)mega_fwd, NTHREADS, LDS_BYTES) != hipSuccess || per_cu < 1)) { fprintf(stderr, "kernel_launch: occupancy query says %d workgroups per CU\n", per_cu); good = false; }
        g_grid = cus;
#endif
        if (!good) { fprintf(stderr, "kernel_launch: set-up failed\n"); ok = -1; return; }
        ok = 1;
    }
    if (ok < 0) return;
    Params p{}; for (int i = 0; i < 31; ++i) p.in[i] = (const float*)d_in[i]; p.out = (float*)d_out; p.ws = (unsigned char*)d_ws; p.layer = 0; p.pad = 0;
#ifdef POISON_WS
    hipMemsetAsync((char*)d_ws, 0xFF, WS_END, stream);
#endif
    hipMemsetAsync((char*)d_ws + O_CTL, 0, ZERO_BYTES, stream);
#if !MEGA
    g_nlaunch = 0;
    launch_phase<PH_PRO>(p, 0, stream);
    for (int l = 0; l < NLAYER; ++l) {
        if (l == 0) launch_phase<PH_NORM1>(p, l, stream);
        launch_phase<PH_WIN>(p, l, stream); launch_phase<PH_POSTA>(p, l, stream); launch_phase<PH_POSTB>(p, l, stream); launch_phase<PH_MIXER>(p, l, stream);
        launch_phase<PH_HYFIN>(p, l, stream); launch_phase<PH_WOUT>(p, l, stream); launch_phase<PH_ROUTE>(p, l, stream); launch_phase<PH_PLACE>(p, l, stream);
        launch_phase<PH_GEMM1>(p, l, stream); launch_phase<PH_GEMM2>(p, l, stream); launch_phase<PH_FINAL>(p, l, stream);
    }
#if DBG_DUMP
    hipLaunchKernelGGL(k_dump, dim3(2048), dim3(256), 0, stream, p);
#endif
#else
    hipLaunchKernelGGL(mega_fwd, dim3(g_grid), dim3(NTHREADS), LDS_BYTES, stream, p);
#endif
}
```

```cpp
#define MOE_FP8 1
#define GQA_SD 1
#define FAST_GEMM 1
#define MEGA 1
#include <hip/hip_runtime.h>
#include <stdint.h>
#include <stdio.h>

#define LAS __attribute__((address_space(3)))
typedef unsigned short bf16_t;
typedef short bf16x8 __attribute__((ext_vector_type(8)));
typedef short s16x4 __attribute__((ext_vector_type(4)));
typedef float f32x4 __attribute__((ext_vector_type(4)));
typedef float f32x16 __attribute__((ext_vector_type(16)));
typedef unsigned u32x4 __attribute__((ext_vector_type(4)));
typedef unsigned u32x2 __attribute__((ext_vector_type(2)));

constexpr int DM = 2048, NB = 8, SEQ = 2048, CTXL = 256, NLAT = NB * SEQ, NCTX = NB * CTXL, NTOK = NLAT + NCTX, NLAYER = 2;
constexpr int NP = 4096;
constexpr int C_CQ = 1536, C_GQ = 2304, C_CKV = 3072, C_KR = 3328, C_GK = 3392, C_GV = 3648, IN_COLS = 3904;
constexpr int NEXP = 64, TOPK = 6, EH = 512;
constexpr int LK = CTXL + SEQ;
constexpr int RSLOTS = 126976;
constexpr int NSLOTS = RSLOTS + NTOK;
constexpr int MAXTILES = NSLOTS / 256;
constexpr int NQP = 1280;
constexpr float EPS = 1e-6f;
constexpr int NTHREADS = 512;
#ifndef GQA_SD
#define GQA_SD 2
#endif
#ifndef HY_MFMA
#define HY_MFMA 1
#endif
#ifndef MOE_FP8
#define MOE_FP8 0
#endif
#ifndef HY_KRB
#define HY_KRB 0
#endif
#ifndef ROUTER_X3
#define ROUTER_X3 1
#endif
#ifndef DENSE_FP8
#define DENSE_FP8 0
#endif
#define WIN8 ((DENSE_FP8 & 1) != 0)
#define WOUT8 ((DENSE_FP8 & 2) != 0)
#define WOUT8G ((DENSE_FP8 & 6) != 0)
constexpr float MIX8_SCALE = 16.0f;
#ifndef DOUT_FP8
#define DOUT_FP8 MOE_FP8
#endif
constexpr float DOUT8_SCALE = 8.0f;
#ifndef FAST_GEMM
#define FAST_GEMM 1
#endif
#ifndef MEGA
#define MEGA 1
#endif

constexpr size_t al256(size_t x) { return (x + 255) & ~(size_t)255; }
constexpr size_t O_CTL = 0;
constexpr size_t CTL_BYTES = 65536;
constexpr size_t O_MOD = O_CTL + CTL_BYTES;
constexpr size_t O_HSS = O_MOD + al256((size_t)NLAYER * 9 * 12288 * 4);
constexpr size_t ZERO_BYTES = O_HSS + al256((size_t)NLAYER * 2 * 2 * 512 * 4);
constexpr size_t O_HF = ZERO_BYTES;
constexpr size_t HF_L0 = (size_t)2 * 2 * 512 * 2048, HF_L1 = (size_t)2 * 2 * 512 * 256, HF_LAYER = HF_L0 + HF_L1;
constexpr size_t O_WIN = O_HF + al256(NLAYER * HF_LAYER * 4);
constexpr size_t O_WOUT = O_WIN + (size_t)NLAYER * NP * DM * 2;
constexpr size_t O_WUQ = O_WOUT + (size_t)NLAYER * DM * DM * 2;
constexpr size_t O_WUKV = O_WUQ + al256((size_t)NLAYER * NQP * 768 * 2);
constexpr size_t O_EGU = O_WUKV + al256((size_t)NLAYER * 1536 * 256 * 2);
constexpr size_t O_ED = O_EGU + (size_t)65 * 1024 * 2048 * 2;
constexpr size_t O_X = O_ED + (size_t)65 * 2048 * 512 * 2;
constexpr size_t O_H = O_X + (size_t)NTOK * DM * 4;
constexpr size_t O_EIDX = O_H + (size_t)NTOK * DM * 2;
constexpr size_t O_GATE = O_EIDX + (size_t)NTOK * 8 * 4;
constexpr size_t O_SLOT = O_GATE + (size_t)NTOK * 8 * 4;
constexpr size_t O_STOK = O_SLOT + (size_t)NTOK * 8 * 4;
constexpr size_t O_WCNT = O_STOK + al256((size_t)NSLOTS * 4);
constexpr size_t O_ROPE = O_WCNT + (size_t)1024 * 64 * 4;
constexpr size_t O_MODC = O_ROPE + (size_t)(64 * 32 + 64 * 16) * 8;
constexpr size_t O_RW2 = O_MODC + (size_t)NLAYER * 9 * 6 * DM * 4;
constexpr size_t O_KRB = O_RW2 + (size_t)NLAYER * 2 * NEXP * DM * 2;
constexpr size_t O_HID = O_KRB + (size_t)NLAYER * 2 * 512 * 4128 * 2;
constexpr size_t O_A = O_HID + (size_t)NSLOTS * EH * 2;
constexpr size_t O_P = O_A;
constexpr size_t O_QRAW = O_P + (size_t)NTOK * NP * 2;
constexpr size_t O_KVRAW = O_QRAW + (size_t)NTOK * NQP * 2;
constexpr size_t O_QM = O_KVRAW + (size_t)NTOK * 1536 * 2;
constexpr size_t O_QMC = O_QM + (size_t)NB * 6 * SEQ * 192 * 2;
constexpr size_t O_KM = O_QMC + (size_t)NB * 6 * CTXL * 192 * 2;
constexpr size_t O_VM = O_KM + (size_t)NB * 6 * LK * 192 * 2;
constexpr size_t O_QG = O_VM + (size_t)NB * 6 * LK * 128 * 2;
constexpr size_t O_QGC = O_QG + (size_t)NB * 6 * SEQ * 128 * 2;
constexpr size_t O_KG = O_QGC + (size_t)NB * 6 * CTXL * 128 * 2;
constexpr size_t O_VG = O_KG + (size_t)NB * 2 * LK * 128 * 2;
constexpr size_t O_VT = O_VG + (size_t)NB * 2 * LK * 128 * 2;
constexpr size_t O_X1T = O_VT + (size_t)512 * NTOK * 2;
constexpr size_t O_Y2T = O_X1T + (size_t)512 * NTOK * 2;
constexpr size_t O_MIX = O_Y2T + (size_t)512 * NTOK * 2;
constexpr size_t O_OUT = O_MIX + (size_t)NTOK * DM * 2;
constexpr size_t O_AEND = O_OUT + (size_t)NTOK * DM * 2;
constexpr size_t O_DOUT = O_A;
static_assert(O_DOUT + (size_t)NSLOTS * DM * 2 <= O_AEND, "DOUT must fit the mixer scratch region");
constexpr size_t WS_END = O_AEND;

constexpr int CW_BAR = 0;
constexpr int CW_CNT = 4096;
constexpr int CW_CUR = 4096 + 128;
constexpr int CW_Q = 4096 + 256;

constexpr int LDS_BYTES = 148480;
constexpr int LDS_MISC = 147456;
constexpr int LDS_TILES = 131072;
#ifndef CVT_BG
#define CVT_BG (MEGA && MOE_FP8)
#endif
#ifndef WT_STORES
#define WT_STORES 0
#endif
__device__ __forceinline__ void st16_wt(void* p, u32x4 v) { asm volatile("global_store_dwordx4 %0, %1, off sc1\n\ts_nop 1" :: "v"(p), "v"(v) : "memory");     }
constexpr int LDS_BGCUR = LDS_MISC + 768;
constexpr int LDS_BGFLAG = LDS_MISC + 800;
constexpr int LDS_CNTL = LDS_MISC + 512;

struct Params { const float* in[31]; float* out; unsigned char* ws; int layer; int pad; };

enum { I_X = 0, I_C, I_CTX, I_CCTX, I_ADAW, I_ADAB, I_NORMG, I_WIN, I_WOUT, I_HYCONV, I_HYW1, I_HYB1, I_HYW2, I_HYB2, I_HYW3, I_HYFREQ, I_HYSKIP,
       I_MQN, I_MKVN, I_WUQ, I_WUKV, I_GQN, I_GKN, I_RW, I_RB, I_EG, I_EU, I_EDN, I_SG, I_SU, I_SD };

__device__ __forceinline__ int otid() { int t = threadIdx.x; asm volatile("" : "+v"(t)); return t; }
__device__ __forceinline__ int owid() { return __builtin_amdgcn_readfirstlane(otid() >> 6); }
__device__ __forceinline__ float bf2f(bf16_t v) { return __uint_as_float(((unsigned)v) << 16); }
__device__ __forceinline__ bf16_t f2bf(float f) { unsigned u = __float_as_uint(f); u += 0x7FFFu + ((u >> 16) & 1u); return (bf16_t)(u >> 16); }
__device__ __forceinline__ unsigned pk2(float lo, float hi) { unsigned r; asm volatile("v_cvt_pk_bf16_f32 %0, %1, %2" : "=v"(r) : "v"(lo), "v"(hi)); return r; }
__device__ __forceinline__ float wave_sum(float v) {
#pragma unroll
    for (int o = 32; o >= 1; o >>= 1) v += __shfl_xor(v, o);
    return v;
}
__device__ __forceinline__ float rdlane(float v, int l) { return __int_as_float(__builtin_amdgcn_readlane(__float_as_int(v), l)); }
__device__ __forceinline__ float silu_f(float x) { return x / (1.0f + __expf(-x)); }
__device__ __forceinline__ const float* resid_src(const Params& p, int l, int row) {
    if (l == 0) return row < NLAT ? p.in[I_X] + (size_t)row * DM : p.in[I_CTX] + (size_t)(row - NLAT) * DM;
    return (const float*)(p.ws + O_X) + (size_t)row * DM;
}
#ifndef XB16
#define XB16 1
#endif
__device__ __forceinline__ f32x4 ld_xrow(const Params& p, int l, int row, int c) {
    if (l == 0 || !XB16) return *(const f32x4*)(resid_src(p, l, row) + c);
    const u32x2 t = *(const u32x2*)((const bf16_t*)(p.ws + O_X) + (size_t)row * DM + c);
    return (f32x4){__uint_as_float(t.x << 16), __uint_as_float(t.x & 0xffff0000u), __uint_as_float(t.y << 16), __uint_as_float(t.y & 0xffff0000u)};
}
__device__ __forceinline__ void st_xrow(const Params& p, int row, int c, f32x4 v) {
    if (XB16) { u32x2 w; w.x = pk2(v[0], v[1]); w.y = pk2(v[2], v[3]); *(u32x2*)((bf16_t*)(p.ws + O_X) + (size_t)row * DM + c) = w; }
    else *(f32x4*)((float*)(p.ws + O_X) + (size_t)row * DM + c) = v;
}
__device__ __forceinline__ int row_batch(int row) { return row < NLAT ? row >> 11 : 8; }
#ifndef CVT_NT
#define CVT_NT 1
#endif
#ifndef NT2
#define NT2 511
#endif
#if NT2 & 64
#define LDNT(T, ptr) __builtin_nontemporal_load((const T*)(ptr))
#else
#define LDNT(T, ptr) (*(const T*)(ptr))
#endif
#if NT2 & 128
#define LDNT2(T, ptr) __builtin_nontemporal_load((const T*)(ptr))
#else
#define LDNT2(T, ptr) (*(const T*)(ptr))
#endif
#if NT2 & 256
#define STNT(T, ptr, val) __builtin_nontemporal_store((val), (T*)(ptr))
#else
#define STNT(T, ptr, val) (*(T*)(ptr) = (val))
#endif
#if NT2 & 8192
#define LDNT3(T, ptr) __builtin_nontemporal_load((const T*)(ptr))
#else
#define LDNT3(T, ptr) (*(const T*)(ptr))
#endif
#ifndef RC8
#define RC8 1
#endif
#if RC8
#define MCB16 1
#endif
#ifndef MCB16
#define MCB16 0
#endif
__device__ __forceinline__ f32x4 ld_mc(const Params& p, int l, int row, int v, int c) {
    const size_t idx = (size_t)((l * 9 + row_batch(row)) * 6 + v) * DM + c;
    if (!MCB16) return *(const f32x4*)((const float*)(p.ws + O_MODC) + idx);
    const u32x2 t = *(const u32x2*)((const bf16_t*)(p.ws + O_MODC) + idx);
    return (f32x4){__uint_as_float(t.x << 16), __uint_as_float(t.x & 0xffff0000u), __uint_as_float(t.y << 16), __uint_as_float(t.y & 0xffff0000u)};
}
#define ROWCOL(j, lane) ((j) * 256 + (lane) * 4)


struct GUnit { int arow0; const bf16_t* B; int orow0, ocol0; };
struct GemmDesc { const bf16_t* A; int lda; const int* ridx; int ldb; int K; };

__host__ __device__ __forceinline__ int perm32(int rho) { const int n = rho >> 4, i = rho & 15; return 8 * (i >> 2) + 4 * n + (i & 3); }
__host__ __device__ __forceinline__ int perm32b(int rho) { const int n = rho >> 4, i = rho & 15, fq = i >> 2; return 8 * (((fq & 1) << 1) | (fq >> 1)) + 4 * n + (i & 3); }
struct EpiStoreBf16 {
    static constexpr bool PERM = (FAST_GEMM != 0); static constexpr int PERMKIND = 0; static constexpr int NVM = PERM ? 16 : 32;
    bf16_t* O; int ldo;
    __device__ __forceinline__ void operator()(const f32x4 (&acc)[2][2][4][2], const GUnit& u, int wr, int wc, int fr, int fq) const {
#pragma unroll
        for (int ai = 0; ai < 2; ++ai)
#pragma unroll
            for (int m = 0; m < 4; ++m) {
                bf16_t* rowp = O + (size_t)(u.orow0 + ai * 128 + wr * 64 + m * 16 + fr) * ldo + u.ocol0 + wc * 32 + (PERM ? 8 : 4) * fq;
#pragma unroll
                for (int bj = 0; bj < 2; ++bj) {
                    if constexpr (PERM) { const f32x4 v0 = acc[ai][bj][m][0], v1 = acc[ai][bj][m][1]; u32x4 w; w.x = pk2(v0[0], v0[1]); w.y = pk2(v0[2], v0[3]); w.z = pk2(v1[0], v1[1]); w.w = pk2(v1[2], v1[3]); if (WT_STORES & 1) st16_wt(rowp + bj * 128, w); else if (NT2 & 512) __builtin_nontemporal_store(w, (u32x4*)(rowp + bj * 128)); else *(u32x4*)(rowp + bj * 128) = w; }
                    else {
#pragma unroll
                        for (int n = 0; n < 2; ++n) { const f32x4 v = acc[ai][bj][m][n]; u32x2 w; w.x = pk2(v[0], v[1]); w.y = pk2(v[2], v[3]); *(u32x2*)(rowp + bj * 128 + n * 16) = w; } } }
            }
    }
};
struct EpiSwiGLU {
    static constexpr bool PERM = (FAST_GEMM != 0); static constexpr int PERMKIND = 0; static constexpr int NVM = 8;
    bf16_t* O;
    __device__ __forceinline__ void operator()(const f32x4 (&acc)[2][2][4][2], const GUnit& u, int wr, int wc, int fr, int fq) const {
#pragma unroll
        for (int ai = 0; ai < 2; ++ai)
#pragma unroll
            for (int m = 0; m < 4; ++m) {
                bf16_t* rowp = O + (size_t)(u.orow0 + ai * 128 + wr * 64 + m * 16 + fr) * EH + u.ocol0 + wc * 32 + (PERM ? 8 : 4) * fq;
#pragma unroll
                for (int n = 0; n < 2; ++n) { const f32x4 g = acc[ai][0][m][n], up = acc[ai][1][m][n]; float h[4];
#pragma unroll
                    for (int j = 0; j < 4; ++j) h[j] = silu_f(g[j]) * up[j];
                    u32x2 w; w.x = pk2(h[0], h[1]); w.y = pk2(h[2], h[3]); *(u32x2*)(rowp + n * (PERM ? 4 : 16)) = w; }
            }
    }
};

__device__ __forceinline__ float clamp8(float x) { return __builtin_amdgcn_fmed3f(x, -448.0f, 448.0f); }
__device__ __forceinline__ unsigned pk4_fp8(float a, float b, float c, float d) { int r = __builtin_amdgcn_cvt_pk_fp8_f32(clamp8(a), clamp8(b), 0, false); r = __builtin_amdgcn_cvt_pk_fp8_f32(clamp8(c), clamp8(d), r, true); return (unsigned)r; }
constexpr float HID8_SCALE = 8.0f;
constexpr float W8_SCALE = 256.0f;
__device__ __forceinline__ void swap32(unsigned& a, unsigned& b) { auto r = __builtin_amdgcn_permlane32_swap(a, b, false, false); a = r[0]; b = r[1]; }
struct EpiSwiGLU8 {
    static constexpr bool PERM = true; static constexpr int PERMKIND = 1; static constexpr int NVM = 4;
    unsigned char* O;
    __device__ __forceinline__ void operator()(const f32x4 (&acc)[2][2][4][2], const GUnit& u, int wr, int wc, int fr, int fq) const {
        const int hi = fq >> 1, cg = (fq & 1) * 16;
#pragma unroll
        for (int ai = 0; ai < 2; ++ai)
#pragma unroll
            for (int mp = 0; mp < 4; mp += 2) { unsigned w[2][2];
#pragma unroll
                for (int mm = 0; mm < 2; ++mm)
#pragma unroll
                    for (int n = 0; n < 2; ++n) { const f32x4 g = acc[ai][0][mp + mm][n], up = acc[ai][1][mp + mm][n]; float h[4];
#pragma unroll
                        for (int j = 0; j < 4; ++j) h[j] = silu_f(g[j]) * up[j] * HID8_SCALE;
                        w[mm][n] = pk4_fp8(h[0], h[1], h[2], h[3]); }
                swap32(w[0][0], w[1][0]); swap32(w[0][1], w[1][1]);
                const u32x4 o = hi ? (u32x4){w[0][0], w[0][1], w[1][0], w[1][1]} : (u32x4){w[0][0], w[0][1], w[1][0], w[1][1]};
                unsigned char* op_ = O + (size_t)(u.orow0 + ai * 128 + wr * 64 + (mp + hi) * 16 + fr) * EH + u.ocol0 + wc * 32 + cg;
                if (WT_STORES & 1) st16_wt(op_, o); else if (NT2 & 1024) __builtin_nontemporal_store(o, (u32x4*)op_); else *(u32x4*)op_ = o; }
    }
};
struct EpiStoreFp8 {
    static constexpr bool PERM = true; static constexpr int PERMKIND = 1; static constexpr int NVM = 8;
    unsigned char* O; int ldo; float scale;
    __device__ __forceinline__ void operator()(const f32x4 (&acc)[2][2][4][2], const GUnit& u, int wr, int wc, int fr, int fq) const {
        const int hi = fq >> 1, cg = (fq & 1) * 16;
#pragma unroll
        for (int ai = 0; ai < 2; ++ai)
#pragma unroll
            for (int mp = 0; mp < 4; mp += 2)
#pragma unroll
                for (int bj = 0; bj < 2; ++bj) { unsigned w[2][2];
#pragma unroll
                    for (int mm = 0; mm < 2; ++mm) { const f32x4 v0 = acc[ai][bj][mp + mm][0] * scale, v1 = acc[ai][bj][mp + mm][1] * scale; w[mm][0] = pk4_fp8(v0[0], v0[1], v0[2], v0[3]); w[mm][1] = pk4_fp8(v1[0], v1[1], v1[2], v1[3]); }
                    swap32(w[0][0], w[1][0]); swap32(w[0][1], w[1][1]);
                    const u32x4 o = {w[0][0], w[0][1], w[1][0], w[1][1]};
                    unsigned char* op_ = O + (size_t)(u.orow0 + ai * 128 + wr * 64 + (mp + hi) * 16 + fr) * ldo + u.ocol0 + bj * 128 + wc * 32 + cg;
                    if (WT_STORES & 1) st16_wt(op_, o); else if (NT2 & 2048) __builtin_nontemporal_store(o, (u32x4*)op_); else *(u32x4*)op_ = o; }
    }
};

template <class Epi>
__device__ __forceinline__ void gemm_unit_simple(const GemmDesc& g, const GUnit& u, const Epi& E) {
    int tid = otid();
    const int wid = __builtin_amdgcn_readfirstlane(tid >> 6), lane = tid & 63, wr = wid >> 2, wc = wid & 3, fr = lane & 15, fq = lane >> 4;
    f32x4 acc[2][2][4][2];
#pragma unroll
    for (int a = 0; a < 2; ++a)
#pragma unroll
        for (int b = 0; b < 2; ++b)
#pragma unroll
            for (int m = 0; m < 4; ++m)
#pragma unroll
                for (int n = 0; n < 2; ++n) acc[a][b][m][n] = (f32x4){0.f, 0.f, 0.f, 0.f};
    const bf16_t* ap[2][4]; const bf16_t* bp[2][2];
#pragma unroll
    for (int ai = 0; ai < 2; ++ai)
#pragma unroll
        for (int m = 0; m < 4; ++m) { const int r = u.arow0 + ai * 128 + wr * 64 + m * 16 + fr; int src = g.ridx ? g.ridx[r] : r; if (src < 0) src = 0; ap[ai][m] = g.A + (size_t)src * g.lda + 8 * fq; }
#pragma unroll
    for (int bj = 0; bj < 2; ++bj)
#pragma unroll
        for (int n = 0; n < 2; ++n) bp[bj][n] = u.B + (size_t)(bj * 128 + wc * 32 + n * 16 + fr) * g.ldb + 8 * fq;
    int Kq = g.K; asm volatile("" : "+s"(Kq));
#pragma unroll 1
    for (int k0 = 0; k0 < Kq; k0 += 32) {
        bf16x8 a[2][4], b[2][2];
#pragma unroll
        for (int ai = 0; ai < 2; ++ai)
#pragma unroll
            for (int m = 0; m < 4; ++m) a[ai][m] = *(const bf16x8*)(ap[ai][m] + k0);
#pragma unroll
        for (int bj = 0; bj < 2; ++bj)
#pragma unroll
            for (int n = 0; n < 2; ++n) b[bj][n] = *(const bf16x8*)(bp[bj][n] + k0);
#pragma unroll
        for (int ai = 0; ai < 2; ++ai)
#pragma unroll
            for (int bj = 0; bj < 2; ++bj)
#pragma unroll
                for (int m = 0; m < 4; ++m)
#pragma unroll
                    for (int n = 0; n < 2; ++n) acc[ai][bj][m][n] = __builtin_amdgcn_mfma_f32_16x16x32_bf16(b[bj][n], a[ai][m], acc[ai][bj][m][n], 0, 0, 0);
    }
    E(acc, u, wr, wc, fr, fq);
}

#ifndef MOE_BNT
#define MOE_BNT 0
#endif
struct DenseSched {
    static constexpr int BAUX = 0;
    const bf16_t* Bt; int ldb, nM, nN, row0, pn0;
    __device__ __forceinline__ int count() const { return nM * nN; }
    __device__ __forceinline__ int ncol() const { return nN; }
    __device__ __forceinline__ void unit(int i, GUnit& u) const { const int pm = i / nN, pn = pn0 + i % nN; u.arow0 = row0 + pm * 256; u.B = Bt + (size_t)pn * 256 * ldb; u.orow0 = u.arow0; u.ocol0 = pn * 256; }
};
struct MoeSched {
    static constexpr int BAUX = MOE_BNT;
    const LAS int* te; const LAS int* ts; int ntiles, npn; const bf16_t* Bt; size_t estride; int ldb, ocolw;
    __device__ __forceinline__ int count() const { return ntiles * npn; }
    __device__ __forceinline__ int ncol() const { return npn; }
    __device__ __forceinline__ void unit(int i, GUnit& u) const { const int t = i / npn, pn = i % npn; const int e = te[t]; u.arow0 = ts[t]; u.B = Bt + (size_t)e * estride + (size_t)pn * 256 * ldb; u.orow0 = u.arow0; u.ocol0 = pn * ocolw; }
};
template <class Sched, class Epi>
__device__ __forceinline__ void gemm_phase_simple(const GemmDesc& g, const Sched& S, const Epi& E) {
    const int n = S.count();
    for (int i = blockIdx.x; i < n; i += gridDim.x) { GUnit u; S.unit(i, u); gemm_unit_simple(g, u, E); }
}
__device__ __forceinline__ int wave_incl_scan(int v, int lane) {
#pragma unroll
    for (int o = 1; o < 64; o <<= 1) { const int t = __shfl_up(v, o); if (lane >= o) v += t; }
    return v;
}
__device__ __forceinline__ int moe_build_tiles(const unsigned* cnt, int nshared, LAS int* te, LAS int* ts, LAS int* misc) {
    __syncthreads();
    const int tid = otid();
    if (tid < 64) {
        const int c = (int)cnt[tid], ntile = (c + 255) >> 8, incl = wave_incl_scan(ntile, tid), first = incl - ntile;
        for (int j = 0; j < ntile; ++j) { te[first + j] = tid; ts[first + j] = (first + j) * 256; }
        const int nrt = __shfl(incl, 63);
        for (int j = tid; j < nshared; j += 64) { te[nrt + j] = NEXP; ts[nrt + j] = RSLOTS + j * 256; }
        if (tid == 0) misc[0] = nrt + nshared;
    }
    __syncthreads();
    return misc[0];
}
#ifndef FAST_GEMM
#define FAST_GEMM 0
#endif
#if !FAST_GEMM
#define GEMM_PHASE(g, S, E) gemm_phase_simple(g, S, E)
#endif

#if FAST_GEMM
constexpr int HTB = 128 * 64 * 2;
__device__ __forceinline__ int lds_byte(int r, int c) { const int st = (r >> 4) * 2 + (c >> 5), rr = r & 15, cc = c & 31, ob = rr * 64 + cc * 2; return st * 1024 + (ob ^ (((ob >> 9) & 1) << 5)); }
__device__ __forceinline__ void stage_rc(int b, int& R, int& C) { const int st = b / 1024, sb = b % 1024, swz = sb ^ (((sb >> 9) & 1) << 5); R = (st >> 1) * 16 + swz / 64; C = (st & 1) * 32 + (swz % 64) / 2; }

#ifndef KREP_PROBE
#define KREP_PROBE 1
#endif
#ifndef EPI_REP
#define EPI_REP 1
#endif
#ifndef GEMM_EARLY
#define GEMM_EARLY 1
#endif
typedef float f32x2z __attribute__((ext_vector_type(2)));
#ifndef ZERO64
#define ZERO64 1
#endif
__device__ __forceinline__ f32x4 zero4() {
#if ZERO64
    f32x2z a, b; asm("v_mov_b64 %0, 0" : "=v"(a)); asm("v_mov_b64 %0, 0" : "=v"(b)); return (f32x4){a.x, a.y, b.x, b.y};
#else
    return (f32x4){0.f, 0.f, 0.f, 0.f};
#endif
}
template <int N> __device__ __forceinline__ void wait_vm() { asm volatile("s_waitcnt vmcnt(%0)" :: "n"(N) : "memory"); }
typedef int v8i __attribute__((ext_vector_type(8)));
typedef int v4i __attribute__((ext_vector_type(4)));
template <int ESZ, class Sched, class Epi>
__device__ __forceinline__ void gemm_phase_fast(LAS unsigned char* lds, const GemmDesc& g, const Sched& S, const Epi& E, int scA = 127, int scB = 127, int rot = 0, int lo = 0) {
    const int tid = otid(), wid = __builtin_amdgcn_readfirstlane(tid >> 6), lane = tid & 63, wr = wid >> 2, wc = wid & 3, fr = lane & 15, fq = lane >> 4;
    const int K = g.K, nunits = S.count(), G = gridDim.x, c0 = blockIdx.x;
    int nt = K * ESZ / 128; asm volatile("" : "+s"(nt));
    const int krep = (KREP_PROBE > 1 && ESZ == 1 && K == 512) ? KREP_PROBE : 1; scB -= (krep == 2) ? 1 : ((krep == 4) ? 2 : 0);
    const int npn = S.ncol(); const bool xmap = (G % 8 == 0) && ((G / 8) % npn == 0); const int xT = xmap ? (G / 8) / npn : 1, xx = (c0 + rot) % 8, xr = c0 / 8;
#define F_UNIT(ui_) (xmap ? (((ui_) * 8 + xx) * xT + xr / npn) * npn + xr % npn : ((ui_) == 0 ? c0 : (c0 >= lo ? G + ((ui_) - 1) * (G - lo) + (c0 - lo) : nunits)))
    if (F_UNIT(0) >= nunits) return;
    int R[2], C[2]; unsigned voffB[2];
#pragma unroll
    for (int i = 0; i < 2; ++i) { stage_rc(tid * 16 + i * 8192, R[i], C[i]); const int Rb = Epi::PERM ? ((R[i] & ~31) + (Epi::PERMKIND ? perm32b(R[i] & 31) : perm32(R[i] & 31))) : R[i]; voffB[i] = (unsigned)(Rb * g.ldb) * (unsigned)ESZ + (unsigned)C[i] * 2u; }
    const size_t kstep = 128;
    const size_t hstepB = (size_t)128 * g.ldb * ESZ;
    const unsigned ldsw = (unsigned)wid * 1024u;
    const int aoff = lds_byte(wr * 64 + fr, fq * 8), boff = lds_byte(wc * 32 + fr, fq * 8);
    const char* Ab = (const char*)g.A;
#define F_SA(b, h) (((b) * 2 + (h)) * HTB)
#define F_SB(b, h) ((4 + (b) * 2 + (h)) * HTB)
#define F_STAGE(bufoff, gbase, voff) do { _Pragma("unroll") for (int _i = 0; _i < 2; ++_i) \
        __builtin_amdgcn_global_load_lds((const unsigned*)((const char*)(gbase) + (voff)[_i]), (LAS unsigned*)(lds + (bufoff) + ldsw + _i * 8192), 16, 0, 0); } while (0)
#define F_STAGEB(bufoff, gbase, voff) do { _Pragma("unroll") for (int _i = 0; _i < 2; ++_i) \
        __builtin_amdgcn_global_load_lds((const unsigned*)((const char*)(gbase) + (voff)[_i]), (LAS unsigned*)(lds + (bufoff) + ldsw + _i * 8192), 16, 0, Sched::BAUX); } while (0)
#define F_LDA(dst, b, h) do { _Pragma("unroll") for (int m = 0; m < 4; ++m) { if constexpr (ESZ == 2) { _Pragma("unroll") for (int k = 0; k < 2; ++k) dst[m][k] = *(const LAS bf16x8*)(lds + F_SA(b, h) + aoff + m * 2048 + k * 1024); } \
        else { const v4i lo_ = *(const LAS v4i*)(lds + F_SA(b, h) + aoff + m * 2048), hi_ = *(const LAS v4i*)(lds + F_SA(b, h) + aoff + m * 2048 + 1024); dst##8[m] = __builtin_shufflevector(lo_, hi_, 0, 1, 2, 3, 4, 5, 6, 7); } } } while (0)
#define F_LDB(dst, b, h) do { _Pragma("unroll") for (int n = 0; n < 2; ++n) { if constexpr (ESZ == 2) { _Pragma("unroll") for (int k = 0; k < 2; ++k) dst[n][k] = *(const LAS bf16x8*)(lds + F_SB(b, h) + boff + n * 2048 + k * 1024); } \
        else { const v4i lo_ = *(const LAS v4i*)(lds + F_SB(b, h) + boff + n * 2048), hi_ = *(const LAS v4i*)(lds + F_SB(b, h) + boff + n * 2048 + 1024); dst##8[n] = __builtin_shufflevector(lo_, hi_, 0, 1, 2, 3, 4, 5, 6, 7); } } } while (0)
#define F_MMA(ai, bj, At, Bt) do { __builtin_amdgcn_s_setprio(1); _Pragma("unroll") for (int m = 0; m < 4; ++m) _Pragma("unroll") for (int n = 0; n < 2; ++n) { \
        if constexpr (ESZ == 2) { _Pragma("unroll") for (int k = 0; k < 2; ++k) acc[ai][bj][m][n] = __builtin_amdgcn_mfma_f32_16x16x32_bf16(Bt[n][k], At[m][k], acc[ai][bj][m][n], 0, 0, 0); } \
        else acc[ai][bj][m][n] = __builtin_amdgcn_mfma_scale_f32_16x16x128_f8f6f4(Bt##8[n], At##8[m], acc[ai][bj][m][n], 0, 0, 0, scB, 0, scA); } \
        __builtin_amdgcn_s_setprio(0); } while (0)
#define F_WAIT_V(n) asm volatile("s_waitcnt vmcnt(" #n ")" ::: "memory")
#define F_WAIT_L(n) asm volatile("s_waitcnt lgkmcnt(" #n ")" ::: "memory")
#define F_BAR __builtin_amdgcn_s_barrier()
#define F_SCHED __builtin_amdgcn_sched_barrier(0)
#define F_AROWS(u, dst) do { _Pragma("unroll") for (int _h = 0; _h < 2; ++_h) _Pragma("unroll") for (int _i = 0; _i < 2; ++_i) { const int _r = (u).arow0 + _h * 128 + R[_i]; int _s = g.ridx ? g.ridx[_r] : _r; if (_s < 0) _s = 0; dst[_h][_i] = _s; } } while (0)
#define F_AOFFS(src, dst) do { _Pragma("unroll") for (int _h = 0; _h < 2; ++_h) _Pragma("unroll") for (int _i = 0; _i < 2; ++_i) dst[_h][_i] = (unsigned)(src[_h][_i] < 0 ? 0 : src[_h][_i]) * (unsigned)g.lda * (unsigned)ESZ + (unsigned)C[_i] * 2u; } while (0)
#define F_AROWS_ASYNC(u, dst) do { _Pragma("unroll") for (int _h = 0; _h < 2; ++_h) _Pragma("unroll") for (int _i = 0; _i < 2; ++_i) { const int _r = (u).arow0 + _h * 128 + R[_i]; \
        if (g.ridx) { int _v; asm volatile("global_load_dword %0, %1, off" : "=v"(_v) : "v"(g.ridx + _r) : "memory"); dst[_h][_i] = _v; } else dst[_h][_i] = _r; } } while (0)
#define F_AUSE(x) do { _Pragma("unroll") for (int _h = 0; _h < 2; ++_h) _Pragma("unroll") for (int _i = 0; _i < 2; ++_i) asm volatile("" : "+v"(x[_h][_i])); } while (0)
    GUnit cur, nxt; int ui = 0;
    S.unit(F_UNIT(0), cur);
    f32x4 acc[2][2][4][2];
#pragma unroll
    for (int a = 0; a < 2; ++a)
#pragma unroll
        for (int b = 0; b < 2; ++b)
#pragma unroll
            for (int m = 0; m < 4; ++m)
#pragma unroll
                for (int n = 0; n < 2; ++n) acc[a][b][m][n] = (f32x4){0.f, 0.f, 0.f, 0.f};
    bf16x8 At[4][2], B0[2][2], B1[2][2]; v8i At8[4], B08[2], B18[2];
    unsigned voA[2][2]; int rnx[2][2];
    F_AROWS(cur, rnx); F_AOFFS(rnx, voA);
    const char* cB = (const char*)cur.B;
    F_STAGEB(F_SB(0, 0), cB, voffB); F_STAGE(F_SA(0, 0), Ab, voA[0]); F_STAGEB(F_SB(0, 1), cB + hstepB, voffB); F_STAGE(F_SA(0, 1), Ab, voA[1]);
    if (wr == 1) F_BAR;
    F_WAIT_V(4); F_BAR;
    F_STAGEB(F_SB(1, 0), cB + kstep, voffB); F_STAGE(F_SA(1, 0), Ab + kstep, voA[0]); F_STAGEB(F_SB(1, 1), cB + hstepB + kstep, voffB);
#if GEMM_EARLY
    F_STAGE(F_SA(1, 1), Ab + kstep, voA[1]); F_WAIT_V(8); F_BAR;
#else
    F_WAIT_V(6); F_BAR;
#endif
    for (;;) {
        const int Ln = F_UNIT(ui + 1); const bool has_next = Ln < nunits;
        if (has_next) { S.unit(Ln, nxt); if (GEMM_EARLY) F_AROWS_ASYNC(nxt, rnx); else F_AROWS(nxt, rnx); }
        const char* nB = has_next ? (const char*)nxt.B : cB;
#pragma unroll 1
        for (int tt = 0; tt < nt * krep; tt += 2) {
            const int t = tt % nt; const bool last = (tt == nt * krep - 2), wrap = (t == nt - 2);
            const char* a1 = Ab + (size_t)(t + 1) * kstep;
            const char* a2 = wrap ? Ab : Ab + (size_t)(t + 2) * kstep; const char* b2 = wrap ? (last ? nB : cB) : cB + (size_t)(t + 2) * kstep;
            const char* a3 = a2 + kstep; const char* b3 = b2 + kstep;
            F_LDB(B0, 0, 0); F_SCHED; F_LDA(At, 0, 0); if (!GEMM_EARLY) F_STAGE(F_SA(1, 1), a1, voA[1]);
            if (last && has_next) { if (GEMM_EARLY) F_AUSE(rnx); F_AOFFS(rnx, voA); }
            F_WAIT_L(8); F_BAR; F_WAIT_L(0); F_MMA(0, 0, At, B0); F_BAR; F_SCHED;
            F_LDB(B1, 0, 1); F_STAGEB(F_SB(0, 0), b2, voffB);
            F_BAR; F_WAIT_L(0); F_MMA(0, 1, At, B1); F_BAR;
            F_LDA(At, 0, 1); F_STAGE(F_SA(0, 0), a2, voA[0]);
            F_BAR; F_WAIT_L(0); F_MMA(1, 0, At, B0); F_BAR; F_SCHED;
            F_STAGEB(F_SB(0, 1), b2 + hstepB, voffB);
            if (GEMM_EARLY == 1) asm volatile("s_cmp_lg_u32 %0, 0\n\ts_cbranch_scc1 1f\n\ts_cmp_eq_u32 %1, 0\n\ts_cbranch_scc1 1f\n\ts_waitcnt vmcnt(%2)\n\ts_branch 2f\n1:\n\ts_waitcnt vmcnt(6)\n2:" :: "s"(tt), "s"(ui), "n"(6 + Epi::NVM) : "scc", "memory");
            else if (GEMM_EARLY == 2) F_WAIT_V(6);
            else F_WAIT_V(6);
            F_BAR; F_MMA(1, 1, At, B1); F_BAR;
            F_LDB(B0, 1, 0); F_SCHED; F_LDA(At, 1, 0); F_STAGE(F_SA(0, 1), a2, voA[1]);
            F_WAIT_L(8); F_BAR; F_WAIT_L(0); F_MMA(0, 0, At, B0); F_BAR; F_SCHED;
            F_LDB(B1, 1, 1); F_STAGEB(F_SB(1, 0), b3, voffB);
            F_BAR; F_WAIT_L(0); F_MMA(0, 1, At, B1); F_BAR;
            F_LDA(At, 1, 1); F_STAGE(F_SA(1, 0), a3, voA[0]);
            F_BAR; F_WAIT_L(0); F_MMA(1, 0, At, B0); F_BAR; F_SCHED;
            F_STAGEB(F_SB(1, 1), b3 + hstepB, voffB);
            F_WAIT_V(6); F_BAR; F_MMA(1, 1, At, B1); F_BAR;
            if (GEMM_EARLY) F_STAGE(F_SA(1, 1), a3, voA[1]);
        }
#pragma unroll
        for (int er_ = 0; er_ < EPI_REP; ++er_) E(acc, cur, wr, wc, fr, fq);
        if (!has_next) break;
#pragma unroll
        for (int a = 0; a < 2; ++a)
#pragma unroll
            for (int b = 0; b < 2; ++b)
#pragma unroll
                for (int m = 0; m < 4; ++m)
#pragma unroll
                    for (int n = 0; n < 2; ++n) acc[a][b][m][n] = zero4();
        cur = nxt; cB = nB; ++ui;
    }
    F_WAIT_V(0);
    if (wr == 0) F_BAR;
    F_BAR;
#undef F_UNIT
#undef F_SA
#undef F_SB
#undef F_STAGE
#undef F_STAGEB
#undef F_LDA
#undef F_LDB
#undef F_MMA
#undef F_WAIT_V
#undef F_WAIT_L
#undef F_BAR
#undef F_SCHED
#undef F_AROWS
#undef F_AROWS_ASYNC
#undef F_AUSE
#undef F_AOFFS
}
#define GEMM_PHASE(g, S, E) gemm_phase_fast<2>(lds, g, S, E)
#define GEMM_PHASE8(g, S, E, sa, sb) gemm_phase_fast<1>(lds, g, S, E, sa, sb)
#ifndef GEMM_ROT
#define GEMM_ROT 1
#endif
#define GEMM_PHASE_R(g, S, E, rot, lo) gemm_phase_fast<2>(lds, g, S, E, 127, 127, GEMM_ROT ? (rot) : 0, GEMM_ROT ? (lo) : 0)
#define GEMM_PHASE8_R(g, S, E, sa, sb, rot) gemm_phase_fast<1>(lds, g, S, E, sa, sb, GEMM_ROT ? (rot) : 0, 0)
#endif

#define SBAR() __builtin_amdgcn_sched_barrier(0)
#ifndef ATT_OPAIR
#define ATT_OPAIR 0
#endif
#ifndef ATT_OSTAGE
#define ATT_OSTAGE 0
#endif
#ifdef ATT_SETPRIO
#define ATT_PRIO(x) __builtin_amdgcn_s_setprio(x)
#else
#define ATT_PRIO(x) do { } while (0)
#endif
__device__ __forceinline__ int crow(int r, int hi) { return (r & 3) + 8 * (r >> 2) + 4 * hi; }
template <int DQK> __device__ __forceinline__ int kaddr(int row, int chunk) {
    const int sw = (DQK == 128) ? (row & 7) : ((row >> 1) & 7);
    return row * (DQK * 2) + ((chunk ^ sw) << 4);
}
__device__ __forceinline__ void partialSM(f32x16& p0, f32x16& p1, float& m_reg, float& mn, float& alpha, float C, float thr) {
    float pmax = p0[0];
#pragma unroll
    for (int r = 1; r < 16; ++r) pmax = fmaxf(pmax, p0[r]);
#pragma unroll
    for (int r = 0; r < 16; ++r) pmax = fmaxf(pmax, p1[r]);
    { auto rr = __builtin_amdgcn_permlane32_swap(__float_as_uint(pmax), __float_as_uint(pmax), false, false);
      pmax = fmaxf(__uint_as_float(rr[0]), __uint_as_float(rr[1])); }
    if (__builtin_expect(__all(pmax - m_reg <= thr), 1)) { mn = m_reg; alpha = 1.f; }
    else { mn = fmaxf(m_reg, pmax); alpha = __builtin_amdgcn_exp2f((m_reg - mn) * C); m_reg = mn; }
    const float mnC = -mn * C;
#pragma unroll
    for (int r = 0; r < 16; ++r) p0[r] = fmaf(p0[r], C, mnC);
#pragma unroll
    for (int r = 0; r < 16; ++r) p1[r] = fmaf(p1[r], C, mnC);
#pragma unroll
    for (int r = 0; r < 16; ++r) p0[r] = __builtin_amdgcn_exp2f(p0[r]);
}
__device__ __forceinline__ void finishSM(f32x16& p0, f32x16& p1, float alpha, float& l_reg, bf16x8& pa0, bf16x8& pa1, bf16x8& pa2, bf16x8& pa3) {
#pragma unroll
    for (int r = 0; r < 16; ++r) p1[r] = __builtin_amdgcn_exp2f(p1[r]);
    float ps = 0;
#pragma unroll
    for (int r = 0; r < 16; ++r) ps += p0[r];
#pragma unroll
    for (int r = 0; r < 16; ++r) ps += p1[r];
    { auto rr = __builtin_amdgcn_permlane32_swap(__float_as_uint(ps), __float_as_uint(ps), false, false);
      ps = __uint_as_float(rr[0]) + __uint_as_float(rr[1]); }
    l_reg = l_reg * alpha + ps;
#define PK4(P, BASE, OUT) do { unsigned a0 = pk2(P[BASE + 0], P[BASE + 1]), a1 = pk2(P[BASE + 2], P[BASE + 3]);   \
    unsigned b0 = pk2(P[BASE + 4], P[BASE + 5]), b1 = pk2(P[BASE + 6], P[BASE + 7]);                              \
    auto r0 = __builtin_amdgcn_permlane32_swap(a0, b0, false, false); auto r1 = __builtin_amdgcn_permlane32_swap(a1, b1, false, false); \
    u32x4 w = {r0[0], r1[0], r0[1], r1[1]}; OUT = *reinterpret_cast<bf16x8*>(&w); } while (0)
    PK4(p0, 0, pa0); PK4(p0, 8, pa1); PK4(p1, 0, pa2); PK4(p1, 8, pa3);
#undef PK4
}
template <int DQK, int QREG> __device__ __forceinline__ void qkt(f32x16& p0, f32x16& p1, const char* Ks, const bf16x8* qr, const bf16_t* Qw, int r32, int hi) {
    p0 = f32x16{}; p1 = f32x16{};
    bf16x8 qx[DQK / 16 - QREG + 1];
#pragma unroll
    for (int d0 = QREG; d0 < DQK / 16; ++d0) qx[d0 - QREG] = *reinterpret_cast<const bf16x8*>(Qw + d0 * 16);
#pragma unroll
    for (int d0 = 0; d0 < DQK / 16; ++d0) { const int ch = 2 * d0 + hi; const bf16x8 qv = (d0 < QREG) ? qr[d0] : qx[d0 < QREG ? 0 : d0 - QREG];
        const bf16x8 b0 = *reinterpret_cast<const bf16x8*>(Ks + kaddr<DQK>(r32, ch));
        const bf16x8 b1 = *reinterpret_cast<const bf16x8*>(Ks + kaddr<DQK>(32 + r32, ch));
        p0 = __builtin_amdgcn_mfma_f32_32x32x16_bf16(b0, qv, p0, 0, 0, 0);
        p1 = __builtin_amdgcn_mfma_f32_32x32x16_bf16(b1, qv, p1, 0, 0, 0); }
}
__device__ __forceinline__ int v_st(int k, int c) { const int kk = (k & ~0xC) | ((k & 4) << 1) | ((k & 8) >> 1); return ((kk >> 3) * 4 + (c >> 5)) * 512 + ((kk & 7) * 32 + (c & 31)) * 2; }
__device__ __forceinline__ int v_rd_base(int lane) { return ((lane & 3) << 3) | (((lane >> 2) & 3) << 6) | (((lane >> 4) & 1) << 5) | (((lane >> 5) & 1) << 8); }
constexpr int v_rd_off(int d0, int ks, int half) { return d0 * 512 + ks * 4096 + half * 2048; }
template <int OFF> __device__ __forceinline__ s16x4 tr_read(int vb) {
    s16x4 r; asm volatile("ds_read_b64_tr_b16 %0, %1 offset:%2" : "=&v"(r) : "v"(vb), "i"(OFF) : "memory"); return r;
}
template <int D0> __device__ __forceinline__ void pv_one(f32x16& od, int vb, bf16x8 pa0, bf16x8 pa1, bf16x8 pa2, bf16x8 pa3) {
    const s16x4 l0 = tr_read<v_rd_off(D0, 0, 0)>(vb), h0 = tr_read<v_rd_off(D0, 0, 1)>(vb), l1 = tr_read<v_rd_off(D0, 1, 0)>(vb), h1 = tr_read<v_rd_off(D0, 1, 1)>(vb);
    const s16x4 l2 = tr_read<v_rd_off(D0, 2, 0)>(vb), h2 = tr_read<v_rd_off(D0, 2, 1)>(vb), l3 = tr_read<v_rd_off(D0, 3, 0)>(vb), h3 = tr_read<v_rd_off(D0, 3, 1)>(vb);
    asm volatile("s_waitcnt lgkmcnt(0)" ::: "memory"); SBAR();
#define PK(L, H) (bf16x8){L[0], L[1], L[2], L[3], H[0], H[1], H[2], H[3]}
    od = __builtin_amdgcn_mfma_f32_32x32x16_bf16(pa0, PK(l0, h0), od, 0, 0, 0);
    od = __builtin_amdgcn_mfma_f32_32x32x16_bf16(pa1, PK(l1, h1), od, 0, 0, 0);
    od = __builtin_amdgcn_mfma_f32_32x32x16_bf16(pa2, PK(l2, h2), od, 0, 0, 0);
    od = __builtin_amdgcn_mfma_f32_32x32x16_bf16(pa3, PK(l3, h3), od, 0, 0, 0);
#undef PK
}
__device__ __forceinline__ void pv_d0(f32x16* o, int vb, bf16x8 pa0, bf16x8 pa1, bf16x8 pa2, bf16x8 pa3) {
    pv_one<0>(o[0], vb, pa0, pa1, pa2, pa3); pv_one<1>(o[1], vb, pa0, pa1, pa2, pa3); pv_one<2>(o[2], vb, pa0, pa1, pa2, pa3); pv_one<3>(o[3], vb, pa0, pa1, pa2, pa3);
}

template <int DQK, int SDEPTH, int QREG = DQK / 16>
__device__ __forceinline__ void attn_body(const bf16_t* __restrict__ Qb, const bf16_t* __restrict__ Kh, const bf16_t* __restrict__ Vh, bf16_t* __restrict__ Ob, int ldo, int nkeys, float scale, char* lds) {
    constexpr int SHM_V = 64 * 128 * 2, SHM_K = 64 * DQK * 2, NKC = DQK / 8, KPT = NKC / 8;
    int tid = otid();
    const int wid = __builtin_amdgcn_readfirstlane(tid >> 6), lane = tid & 63, r32 = lane & 31, hi = lane >> 5;
    char* V_lds = lds; char* K_lds = lds + 2 * SHM_V;
    float* ws = (float*)(lds + 2 * SHM_V + 2 * SHM_K) + wid * 64; float* li_l = ws; float* al_l = ws + 32;
    const float C = scale * 1.4426950408889634f, thr = 8.0f / scale;
    float m_reg = -1e30f, l_reg = 0; f32x16 o[4] = {}; bf16x8 qr[QREG];
    const bf16_t* Qw = Qb + (long)(wid * 32 + r32) * DQK + hi * 8;
#pragma unroll
    for (int d0 = 0; d0 < QREG; ++d0) qr[d0] = *reinterpret_cast<const bf16x8*>(Qw + d0 * 16);
    const int sr = tid >> 4, sc = (tid & 15) * 8, vst0 = v_st(sr, sc), vst1 = v_st(32 + sr, sc);
    int kgo[KPT], klo[KPT];
#pragma unroll
    for (int i = 0; i < KPT; ++i) { const int q = tid + 512 * i, row = q / NKC, ch = q % NKC; kgo[i] = row * DQK + ch * 8; klo[i] = kaddr<DQK>(row, ch); }
    const int vb0 = (int)(uintptr_t)V_lds + v_rd_base(lane);
    struct { bf16x8 vs0, vs1, ks[KPT]; } sr_[SDEPTH ? SDEPTH : 1];
#define SLOAD(i, k0) do { sr_[i].vs0 = *reinterpret_cast<const bf16x8*>(&Vh[(long)((k0) + sr) * 128 + sc]); sr_[i].vs1 = *reinterpret_cast<const bf16x8*>(&Vh[(long)((k0) + 32 + sr) * 128 + sc]); \
    _Pragma("unroll") for (int _q = 0; _q < KPT; ++_q) sr_[i].ks[_q] = *reinterpret_cast<const bf16x8*>(&Kh[(long)(k0) * DQK + kgo[_q]]); } while (0)
#define SWRITE(b, i) do { *(bf16x8*)(V_lds + (b) * SHM_V + vst0) = sr_[i].vs0; *(bf16x8*)(V_lds + (b) * SHM_V + vst1) = sr_[i].vs1; \
    _Pragma("unroll") for (int _q = 0; _q < KPT; ++_q) *(bf16x8*)(K_lds + (b) * SHM_K + klo[_q]) = sr_[i].ks[_q]; } while (0)
#define SWAIT() do { if constexpr (SDEPTH == 2) { if constexpr (KPT == 2) asm volatile("s_waitcnt vmcnt(4)" ::: "memory"); else asm volatile("s_waitcnt vmcnt(5)" ::: "memory"); } \
    else asm volatile("s_waitcnt vmcnt(0)" ::: "memory"); } while (0)
#define RESC(a) do { if (__any((a) < 1.f)) { if (hi == 0) al_l[r32] = (a); asm volatile("s_waitcnt lgkmcnt(0)" ::: "memory"); \
    _Pragma("unroll") for (int d = 0; d < 4; ++d) _Pragma("unroll") for (int r = 0; r < 16; ++r) o[d][r] *= al_l[crow(r, hi)]; } } while (0)
    bf16x8 pa0, pa1, pa2, pa3; const int NT = nkeys / 64;
    if constexpr (SDEPTH == 0) {
        f32x16 pA0, pA1; float mnA, alA;
        SLOAD(0, 0); asm volatile("s_waitcnt vmcnt(0)" ::: "memory"); SWRITE(0, 0); __syncthreads();
        for (int j = 0; j < NT; ++j) {
            const int bo = j & 1;
            if (j + 1 < NT) SLOAD(0, (j + 1) * 64);
            SBAR(); ATT_PRIO(1); qkt<DQK, QREG>(pA0, pA1, K_lds + bo * SHM_K, qr, Qw, r32, hi); ATT_PRIO(0); partialSM(pA0, pA1, m_reg, mnA, alA, C, thr);
            RESC(alA); finishSM(pA0, pA1, alA, l_reg, pa0, pa1, pa2, pa3); SBAR();
            ATT_PRIO(1); pv_d0(o, vb0 + bo * SHM_V, pa0, pa1, pa2, pa3); ATT_PRIO(0);
            if (j + 1 < NT) { asm volatile("s_waitcnt vmcnt(0)" ::: "memory"); SWRITE(bo ^ 1, 0); }
            __syncthreads();
        }
    } else {
    f32x16 pA0, pA1, pB0, pB1; float mnA, mnB, alA, alB;
    constexpr int SE = 0, SO = SDEPTH - 1;
    SLOAD(SE, 0); asm volatile("s_waitcnt vmcnt(0)" ::: "memory"); SWRITE(0, SE); __syncthreads();
    qkt<DQK, QREG>(pA0, pA1, K_lds, qr, Qw, r32, hi); partialSM(pA0, pA1, m_reg, mnA, alA, C, thr);
    SLOAD(SO, 64); if constexpr (SDEPTH == 2) { if (2 < NT) SLOAD(SE, 2 * 64); }
    SWAIT(); SWRITE(1, SO); __syncthreads();
    for (int j = 1; j + 1 < NT; j += 2) {
        SBAR(); qkt<DQK, QREG>(pB0, pB1, K_lds + SHM_K, qr, Qw, r32, hi);
        finishSM(pA0, pA1, alA, l_reg, pa0, pa1, pa2, pa3); SBAR();
        SLOAD(SO, (j + SDEPTH) * 64); SBAR();
        pv_d0(o, vb0, pa0, pa1, pa2, pa3); partialSM(pB0, pB1, m_reg, mnB, alB, C, thr);
        __syncthreads(); SWAIT(); SWRITE(0, SE);
        RESC(alB); __syncthreads();
        SBAR(); qkt<DQK, QREG>(pA0, pA1, K_lds, qr, Qw, r32, hi);
        finishSM(pB0, pB1, alB, l_reg, pa0, pa1, pa2, pa3); SBAR();
        if (SDEPTH == 1 || j + 3 < NT) SLOAD(SE, (j + 1 + SDEPTH) * 64); SBAR();
        pv_d0(o, vb0 + SHM_V, pa0, pa1, pa2, pa3); partialSM(pA0, pA1, m_reg, mnA, alA, C, thr);
        __syncthreads(); SWAIT(); SWRITE(1, SO);
        RESC(alA); __syncthreads();
    }
    SBAR(); qkt<DQK, QREG>(pB0, pB1, K_lds + SHM_K, qr, Qw, r32, hi);
    finishSM(pA0, pA1, alA, l_reg, pa0, pa1, pa2, pa3); SBAR();
    pv_d0(o, vb0, pa0, pa1, pa2, pa3); partialSM(pB0, pB1, m_reg, mnB, alB, C, thr);
    __syncthreads(); RESC(alB);
    finishSM(pB0, pB1, alB, l_reg, pa0, pa1, pa2, pa3); SBAR();
    pv_d0(o, vb0 + SHM_V, pa0, pa1, pa2, pa3);
    }
    if (hi == 0) li_l[r32] = l_reg; asm volatile("s_waitcnt lgkmcnt(0)" ::: "memory");
    float rli[16];
#pragma unroll
    for (int r = 0; r < 16; ++r) rli[r] = __builtin_amdgcn_rcpf(li_l[crow(r, hi)]);
    bf16_t* Ow = Ob + (long)(wid * 32) * ldo;
#if ATT_OSTAGE && !WOUT8
    __syncthreads();
    { char* og = lds + wid * (32 * 272);
#pragma unroll
      for (int d0 = 0; d0 < 4; ++d0)
#pragma unroll
          for (int r = 0; r < 16; r += 2) { const float v0 = o[d0][r] * rli[r], v1 = o[d0][r + 1] * rli[r + 1];
              const float snd = (lane & 1) ? v0 : v1; const float rcv = __int_as_float(__builtin_amdgcn_update_dpp(0, __float_as_int(snd), 0xB1, 0xF, 0xF, true));
              const unsigned w = (lane & 1) ? pk2(rcv, v1) : pk2(v0, rcv); const int row = crow(r, hi) + (lane & 1);
              *(unsigned*)(og + row * 272 + (d0 * 32 + (r32 & ~1)) * 2) = w; }
      asm volatile("s_waitcnt lgkmcnt(0)" ::: "memory");
#pragma unroll
      for (int i = 0; i < 8; ++i) { const int q = lane + 64 * i, row = q >> 4, cc = q & 15; *(u32x4*)(Ow + (long)row * ldo + cc * 8) = *(const u32x4*)(og + row * 272 + cc * 16); } }
#elif ATT_OPAIR && !WOUT8
#pragma unroll
    for (int d0 = 0; d0 < 4; ++d0)
#pragma unroll
        for (int r = 0; r < 16; r += 2) { const float v0 = o[d0][r] * rli[r], v1 = o[d0][r + 1] * rli[r + 1];
            const float snd = (lane & 1) ? v0 : v1; const float rcv = __int_as_float(__builtin_amdgcn_update_dpp(0, __float_as_int(snd), 0xB1, 0xF, 0xF, true));
            const unsigned w = (lane & 1) ? pk2(rcv, v1) : pk2(v0, rcv);
            *(unsigned*)(Ow + (long)(crow(r, hi) + (lane & 1)) * ldo + d0 * 32 + (r32 & ~1)) = w; }
#else
#pragma unroll
    for (int r = 0; r < 16; ++r) { const int orow = crow(r, hi);
#pragma unroll
        for (int d0 = 0; d0 < 4; ++d0) {
#if WOUT8
            ((unsigned char*)Ob)[(long)(wid * 32 + orow) * ldo + d0 * 32 + r32] = (unsigned char)(pk4_fp8(o[d0][r] * rli[r] * MIX8_SCALE, 0.f, 0.f, 0.f) & 0xffu);
#else
            Ow[(long)orow * ldo + d0 * 32 + r32] = f2bf(o[d0][r] * rli[r]);
#endif
        } }
#endif
    __syncthreads();
#undef SLOAD
#undef SWRITE
#undef SWAIT
#undef RESC
}

#ifndef ATT_DMA
#define ATT_DMA 3
#endif
#if ATT_DMA
template <int DQK>
__device__ __forceinline__ void attn_body_dma(const bf16_t* __restrict__ Qb, const bf16_t* __restrict__ Kh, const bf16_t* __restrict__ Vh, bf16_t* __restrict__ Ob, int ldo, int nkeys, float scale, LAS unsigned char* ldsL) {
    constexpr int SHM_V = 64 * 128 * 2, SHM_K = 64 * DQK * 2, TILE = SHM_K + SHM_V, NKC = DQK / 8, KPT = NKC / 8;
    const int tid = otid(), wid = __builtin_amdgcn_readfirstlane(tid >> 6), lane = tid & 63, r32 = lane & 31, hi = lane >> 5;
    char* lds = (char*)ldsL;
    float* ws = (float*)(lds + 3 * TILE) + wid * 64; float* li_l = ws; float* al_l = ws + 32;
    const float C = scale * 1.4426950408889634f, thr = 8.0f / scale;
    float m_reg = -1e30f, l_reg = 0; f32x16 o[4] = {}; bf16x8 qr[DQK / 16];
    const bf16_t* Qw = Qb + (long)(wid * 32 + r32) * DQK + hi * 8;
#pragma unroll
    for (int d0 = 0; d0 < DQK / 16; ++d0) qr[d0] = LDNT3(bf16x8, Qw + d0 * 16);
    unsigned kgo[KPT], vgo[2];
#pragma unroll
    for (int i = 0; i < KPT; ++i) { const int q = i * 512 + tid, row = q / NKC, cp = q % NKC, sw = (DQK == 128) ? (row & 7) : ((row >> 1) & 7); kgo[i] = (unsigned)(row * DQK + ((cp ^ sw) << 3)) * 2u; }
#pragma unroll
    for (int i = 0; i < 2; ++i) { const int q = i * 512 + tid, st = q >> 5, w16 = q & 31, kk = (st >> 2) * 8 + (w16 >> 2), k = (kk & ~0xC) | ((kk & 4) << 1) | ((kk & 8) >> 1), c = (st & 3) * 32 + (w16 & 3) * 8; vgo[i] = (unsigned)(k * 128 + c) * 2u; }
    const int ldsb = (int)(uintptr_t)ldsL;
    const int vrb = v_rd_base(lane);
#define D_TILE(t, boff) do { const char* kp_ = (const char*)(Kh + (size_t)(t) * 64 * DQK); const char* vp_ = (const char*)(Vh + (size_t)(t) * 64 * 128); \
        _Pragma("unroll") for (int i_ = 0; i_ < KPT; ++i_) __builtin_amdgcn_global_load_lds((const unsigned*)(kp_ + kgo[i_]), (LAS unsigned*)(ldsL + (boff) + i_ * 8192 + wid * 1024), 16, 0, 0); \
        _Pragma("unroll") for (int i_ = 0; i_ < 2; ++i_) __builtin_amdgcn_global_load_lds((const unsigned*)(vp_ + vgo[i_]), (LAS unsigned*)(ldsL + (boff) + SHM_K + i_ * 8192 + wid * 1024), 16, 0, 0); } while (0)
#define D_WAIT1() do { if constexpr (KPT == 2) asm volatile("s_waitcnt vmcnt(4)" ::: "memory"); else asm volatile("s_waitcnt vmcnt(5)" ::: "memory"); } while (0)
#define D_WAIT2() do { if constexpr (KPT == 2) asm volatile("s_waitcnt vmcnt(8)" ::: "memory"); else asm volatile("s_waitcnt vmcnt(10)" ::: "memory"); } while (0)
#define D_WAIT0() asm volatile("s_waitcnt vmcnt(0)" ::: "memory")
#define D_BAR() do { asm volatile("s_waitcnt lgkmcnt(0)" ::: "memory"); __builtin_amdgcn_s_barrier(); asm volatile("" ::: "memory"); } while (0)
#define D_RESC(a) do { if (__any((a) < 1.f)) { if (hi == 0) al_l[r32] = (a); asm volatile("s_waitcnt lgkmcnt(0)" ::: "memory"); \
    _Pragma("unroll") for (int d = 0; d < 4; ++d) _Pragma("unroll") for (int r = 0; r < 16; ++r) o[d][r] *= al_l[crow(r, hi)]; } } while (0)
#define D_HALF(j, PC0, PC1, mnC, alC, PP0, PP1, alP, lastwait) do { \
        if (lastwait) D_WAIT0(); else D_WAIT1(); D_BAR(); \
        SBAR(); qkt<DQK, DQK / 16>(PC0, PC1, lds + o1, qr, Qw, r32, hi); \
        finishSM(PP0, PP1, alP, l_reg, pa0, pa1, pa2, pa3); SBAR(); \
        pv_d0(o, ldsb + o0 + SHM_K + vrb, pa0, pa1, pa2, pa3); partialSM(PC0, PC1, m_reg, mnC, alC, C, thr); \
        D_BAR(); \
        if ((j) + 2 < NT) D_TILE((j) + 2, o0); \
        D_RESC(alC); \
        { const int t_ = o0; o0 = o1; o1 = o2; o2 = t_; } } while (0)
    f32x16 pA0, pA1, pB0, pB1; float mnA, mnB, alA, alB; bf16x8 pa0, pa1, pa2, pa3; const int NT = nkeys / 64;
    int o0 = 0, o1 = TILE, o2 = 2 * TILE;
    D_TILE(0, 0); D_TILE(1, TILE); D_TILE(2, 2 * TILE);
    D_WAIT2(); D_BAR();
    qkt<DQK, DQK / 16>(pA0, pA1, lds, qr, Qw, r32, hi); partialSM(pA0, pA1, m_reg, mnA, alA, C, thr);
    for (int j = 1; j + 1 < NT; j += 2) {
        D_HALF(j, pB0, pB1, mnB, alB, pA0, pA1, alA, false);
        D_HALF(j + 1, pA0, pA1, mnA, alA, pB0, pB1, alB, false);
    }
    D_HALF(NT - 1, pB0, pB1, mnB, alB, pA0, pA1, alA, true);
    finishSM(pB0, pB1, alB, l_reg, pa0, pa1, pa2, pa3); SBAR();
    pv_d0(o, ldsb + o0 + SHM_K + vrb, pa0, pa1, pa2, pa3);
    if (hi == 0) li_l[r32] = l_reg; asm volatile("s_waitcnt lgkmcnt(0)" ::: "memory");
    float rli[16];
#pragma unroll
    for (int r = 0; r < 16; ++r) rli[r] = __builtin_amdgcn_rcpf(li_l[crow(r, hi)]);
    bf16_t* Ow = Ob + (long)(wid * 32) * ldo;
#pragma unroll
    for (int r = 0; r < 16; ++r) { const int orow = crow(r, hi);
#pragma unroll
        for (int d0 = 0; d0 < 4; ++d0) { if (NT2 & 4096) __builtin_nontemporal_store(f2bf(o[d0][r] * rli[r]), &Ow[(long)orow * ldo + d0 * 32 + r32]); else Ow[(long)orow * ldo + d0 * 32 + r32] = f2bf(o[d0][r] * rli[r]); } }
    D_BAR();
#undef D_TILE
#undef D_WAIT1
#undef D_WAIT2
#undef D_WAIT0
#undef D_BAR
#undef D_RESC
#undef D_HALF
}
#endif

struct CvtMat { const float* src; bf16_t* dst; const float* kscale; int N, lddst, nb, mode; };
__device__ __forceinline__ void cvt_block(const CvtMat& m, int kb, int nbk, int lane) {
    const int a = lane & 7, ng = lane >> 3, k0 = kb * 64 + 8 * a, n0 = nbk * 32 + 4 * ng;
    const float* s = m.src + (size_t)k0 * m.N + n0;
    f32x4 v[8];
#pragma unroll
    for (int j = 0; j < 8; ++j) v[j] = (NT2 & 2) ? __builtin_nontemporal_load((const f32x4*)(s + (size_t)j * m.N)) : *(const f32x4*)(s + (size_t)j * m.N);
    if (m.kscale) {
#pragma unroll
        for (int j = 0; j < 8; ++j) v[j] *= m.kscale[k0 + j];
    }
#pragma unroll
    for (int i = 0; i < 4; ++i) { const int n = n0 + i, row = (m.mode == 0) ? n : ((n >> 7) * 256 + (n & 127) + (m.mode - 1) * 128);
        u32x4 w; w.x = pk2(v[0][i], v[1][i]); w.y = pk2(v[2][i], v[3][i]); w.z = pk2(v[4][i], v[5][i]); w.w = pk2(v[6][i], v[7][i]);
        *(u32x4*)(m.dst + (size_t)row * m.lddst + k0) = w; }
}
__device__ __forceinline__ void cvt_block8(const CvtMat& m, unsigned char* dst8, int kb, int nbk, int lane) {
    const int a = lane & 7, ng = lane >> 3, k0 = kb * 64 + 8 * a, n0 = nbk * 32 + 4 * ng;
    const float* s = m.src + (size_t)k0 * m.N + n0;
    f32x4 v[8];
#pragma unroll
    for (int j = 0; j < 8; ++j) v[j] = (CVT_NT ? __builtin_nontemporal_load((const f32x4*)(s + (size_t)j * m.N)) : *(const f32x4*)(s + (size_t)j * m.N)) * W8_SCALE;
#if WT_STORES & 2
    u32x2 w[4];
#pragma unroll
    for (int i = 0; i < 4; ++i) { w[i].x = pk4_fp8(v[0][i], v[1][i], v[2][i], v[3][i]); w[i].y = pk4_fp8(v[4][i], v[5][i], v[6][i], v[7][i]); }
    const bool odd = (a & 1) != 0;
    const u32x2 s0 = odd ? w[0] : w[2], s1 = odd ? w[1] : w[3]; u32x2 r0, r1;
    r0.x = (unsigned)__builtin_amdgcn_update_dpp(0, (int)s0.x, 0xB1, 0xF, 0xF, false); r0.y = (unsigned)__builtin_amdgcn_update_dpp(0, (int)s0.y, 0xB1, 0xF, 0xF, false);
    r1.x = (unsigned)__builtin_amdgcn_update_dpp(0, (int)s1.x, 0xB1, 0xF, 0xF, false); r1.y = (unsigned)__builtin_amdgcn_update_dpp(0, (int)s1.y, 0xB1, 0xF, 0xF, false);
    const u32x4 oA = odd ? (u32x4){r0.x, r0.y, w[2].x, w[2].y} : (u32x4){w[0].x, w[0].y, r0.x, r0.y}, oB = odd ? (u32x4){r1.x, r1.y, w[3].x, w[3].y} : (u32x4){w[1].x, w[1].y, r1.x, r1.y};
    const int kbase = k0 - (odd ? 8 : 0);
#pragma unroll
    for (int ii = 0; ii < 2; ++ii) { const int n = n0 + (odd ? 2 : 0) + ii, row = (m.mode == 0) ? n : ((n >> 7) * 256 + (n & 127) + (m.mode - 1) * 128);
        st16_wt(dst8 + (size_t)row * m.lddst + kbase, ii ? oB : oA); }
#else
#pragma unroll
    for (int i = 0; i < 4; ++i) { const int n = n0 + i, row = (m.mode == 0) ? n : ((n >> 7) * 256 + (n & 127) + (m.mode - 1) * 128);
        u32x2 w; w.x = pk4_fp8(v[0][i], v[1][i], v[2][i], v[3][i]); w.y = pk4_fp8(v[4][i], v[5][i], v[6][i], v[7][i]);
        if (NT2 & 8) __builtin_nontemporal_store(w, (u32x2*)(dst8 + (size_t)row * m.lddst + k0)); else *(u32x2*)(dst8 + (size_t)row * m.lddst + k0) = w; }
#endif
}
constexpr int CVT_SMALL = 3904 + 2048 + 432 + 192;
__device__ __forceinline__ void cvt_small_task(const Params& p, int l, int t, int lane) {
    unsigned char* ws = p.ws; CvtMat m; int which_ = 3;
    if (t < 3904) { which_ = 0; m = CvtMat{p.in[I_WIN] + (size_t)l * DM * IN_COLS, (bf16_t*)(ws + O_WIN) + (size_t)l * NP * DM, nullptr, IN_COLS, DM, 122, 0}; }
    else if ((t -= 3904) < 2048) { which_ = 1; m = CvtMat{p.in[I_WOUT] + (size_t)l * DM * DM, (bf16_t*)(ws + O_WOUT) + (size_t)l * DM * DM, nullptr, DM, DM, 64, 0}; }
    else if ((t -= 2048) < 432) { m = CvtMat{p.in[I_WUQ] + (size_t)l * 768 * 1152, (bf16_t*)(ws + O_WUQ) + (size_t)l * NQP * 768, p.in[I_MQN] + l * 768, 1152, 768, 36, 0}; }
    else { t -= 432; m = CvtMat{p.in[I_WUKV] + (size_t)l * 256 * 1536, (bf16_t*)(ws + O_WUKV) + (size_t)l * 1536 * 256, p.in[I_MKVN] + l * 256, 1536, 256, 48, 0}; }
    if (WIN8 && which_ == 0) cvt_block8(m, p.ws + O_WIN + (size_t)l * NP * DM, t / m.nb, t % m.nb, lane);
    else if (WOUT8 && which_ == 1) cvt_block8(m, p.ws + O_WOUT + (size_t)l * DM * DM, t / m.nb, t % m.nb, lane);
    else cvt_block(m, t / m.nb, t % m.nb, lane);
}
constexpr int CVT_EXP = 65 * 1536;
__device__ __forceinline__ void cvt_exp_blk(const Params& p, int l, int e, int which, int q, int lane);
__device__ __forceinline__ void cvt_exp_task(const Params& p, int l, int t, int lane) { const int e = t / 1536, r = t % 1536; cvt_exp_blk(p, l, e, r >> 9, r & 511, lane); }
constexpr int CVT_GU = 65 * 1024;
__device__ __forceinline__ void cvt_exp_task_bg(const Params& p, int l, int t, int lane) {
    if (t < CVT_GU) { const int r = t & 1023; cvt_exp_blk(p, l, t >> 10, r >> 9, r & 511, lane); } else { t -= CVT_GU; cvt_exp_blk(p, l, t >> 9, 2, t & 511, lane); }
}
__device__ __forceinline__ void cvt_exp_blk(const Params& p, int l, int e, int which, int q, int lane) {
    unsigned char* ws = p.ws; CvtMat m;
    if (which < 2) {
        const float* src = (e < NEXP) ? p.in[which == 0 ? I_EG : I_EU] + ((size_t)l * NEXP + e) * DM * EH : p.in[which == 0 ? I_SG : I_SU] + (size_t)l * DM * EH;
        m = CvtMat{src, (bf16_t*)(ws + O_EGU) + (size_t)e * 1024 * 2048, nullptr, EH, DM, 16, 1 + which};
    } else {
        const float* src = (e < NEXP) ? p.in[I_EDN] + ((size_t)l * NEXP + e) * EH * DM : p.in[I_SD] + (size_t)l * EH * DM;
        m = CvtMat{src, (bf16_t*)(ws + O_ED) + (size_t)e * 2048 * 512, nullptr, DM, EH, 64, 0};
    }
#if MOE_FP8
    const int lb = CVT_BG ? l : 0;
    cvt_block8(m, which < 2 ? p.ws + O_EGU + ((size_t)lb * 65 + e) * 1024 * 2048 : p.ws + O_ED + ((size_t)lb * 65 + e) * 2048 * 512, q / m.nb, q % m.nb, lane);
#else
    cvt_block(m, q / m.nb, q % m.nb, lane);
#endif
}
#if MOE_FP8 && defined(CVT_TWO)
struct CvtJob { const float* s; unsigned char* d; int N, lddst, mode, k0, n0; };
__device__ __forceinline__ CvtJob cvt_exp_job(const Params& p, int l, int t, int lane) {
    const int e = t / 1536, r = t % 1536, which = r >> 9, q = r & 511, a = lane & 7, ng = lane >> 3; CvtJob j;
    if (which < 2) { j.s = (e < NEXP) ? p.in[which == 0 ? I_EG : I_EU] + ((size_t)l * NEXP + e) * DM * EH : p.in[which == 0 ? I_SG : I_SU] + (size_t)l * DM * EH;
        j.d = p.ws + O_EGU + (size_t)e * 1024 * 2048; j.N = EH; j.lddst = DM; j.mode = 1 + which; j.k0 = (q / 16) * 64 + 8 * a; j.n0 = (q % 16) * 32 + 4 * ng; }
    else { j.s = (e < NEXP) ? p.in[I_EDN] + ((size_t)l * NEXP + e) * EH * DM : p.in[I_SD] + (size_t)l * EH * DM;
        j.d = p.ws + O_ED + (size_t)e * 2048 * 512; j.N = DM; j.lddst = EH; j.mode = 0; j.k0 = (q / 64) * 64 + 8 * a; j.n0 = (q % 64) * 32 + 4 * ng; }
    return j;
}
__device__ __forceinline__ void cvt_job_load(const CvtJob& j, f32x4 (&v)[8]) {
    const float* s = j.s + (size_t)j.k0 * j.N + j.n0;
#pragma unroll
    for (int q = 0; q < 8; ++q) v[q] = *(const f32x4*)(s + (size_t)q * j.N);
}
__device__ __forceinline__ void cvt_job_store(const CvtJob& j, const f32x4 (&v)[8]) {
#pragma unroll
    for (int i = 0; i < 4; ++i) { const int n = j.n0 + i, row = (j.mode == 0) ? n : ((n >> 7) * 256 + (n & 127) + (j.mode - 1) * 128);
        u32x2 w; w.x = pk4_fp8(v[0][i] * W8_SCALE, v[1][i] * W8_SCALE, v[2][i] * W8_SCALE, v[3][i] * W8_SCALE); w.y = pk4_fp8(v[4][i] * W8_SCALE, v[5][i] * W8_SCALE, v[6][i] * W8_SCALE, v[7][i] * W8_SCALE);
        *(u32x2*)(j.d + (size_t)row * j.lddst + j.k0) = w; }
}
__device__ __forceinline__ void cvt_exp_all(const Params& p, int l) {
    const int lane = otid() & 63, gw = blockIdx.x * 8 + owid(), GW = gridDim.x * 8;
    for (int t = gw; t < CVT_EXP; t += 2 * GW) { const bool two = (t + GW) < CVT_EXP;
        const CvtJob j0 = cvt_exp_job(p, l, t, lane), j1 = cvt_exp_job(p, l, two ? t + GW : t, lane); f32x4 v0[8], v1[8];
        cvt_job_load(j0, v0); cvt_job_load(j1, v1);
        cvt_job_store(j0, v0); if (two) cvt_job_store(j1, v1); }
}
#else
__device__ __forceinline__ void cvt_exp_all(const Params& p, int l) {
    const int lane = otid() & 63, gw = blockIdx.x * 8 + owid(), GW = gridDim.x * 8;
    for (int t = gw; t < CVT_EXP; t += GW) cvt_exp_task(p, l, t, lane);
}
#endif
#if CVT_BG
#ifndef BG_DRAIN_REP
#define BG_DRAIN_REP 1
#endif
__device__ __forceinline__ bool cvt_bg_step(LAS unsigned char* lds, int limit, int rep = 1) {
    const int wid = owid(), lane = otid() & 63;
    volatile LAS int* cur = (volatile LAS int*)(lds + LDS_BGCUR);
    const int k = __builtin_amdgcn_readfirstlane(cur[wid]);
    const int T = (blockIdx.x * 8 + wid) + k * (int)(gridDim.x * 8);
    if (T >= limit) return false;
    if (lane == 0) cur[wid] = k + 1;
    const __attribute__((address_space(4))) Params* kp = (const __attribute__((address_space(4))) Params*)__builtin_amdgcn_kernarg_segment_ptr(); asm volatile("" : "+s"(kp));
    Params p;
#pragma unroll
    for (int i_ = 0; i_ < 31; ++i_) p.in[i_] = kp->in[i_];
    p.out = kp->out; p.ws = kp->ws; p.layer = 0; p.pad = 0;
    const int l = (T >= CVT_EXP) ? 1 : 0;
    for (int r_ = 0; r_ < rep; ++r_) cvt_exp_task_bg(p, l, T - l * CVT_EXP, lane);
    return true;
}
#ifndef BG_TWO
#define BG_TWO 0
#endif
struct BgJob { const float* s; unsigned char* d; int lddst, mode, n0; size_t N; };
__device__ __forceinline__ BgJob cvt_bg_decode(const Params& p, int T, int lane) {
    const int l = (T >= CVT_EXP) ? 1 : 0; int t = T - l * CVT_EXP, e, which, q, nb; const int a = lane & 7, ng = lane >> 3; BgJob j; const float* src; unsigned char* dst;
    if (t < CVT_GU) { const int r = t & 1023; e = t >> 10; which = r >> 9; q = r & 511; } else { t -= CVT_GU; e = t >> 9; which = 2; q = t & 511; }
    if (which < 2) { src = (e < NEXP) ? p.in[which == 0 ? I_EG : I_EU] + ((size_t)l * NEXP + e) * DM * EH : p.in[which == 0 ? I_SG : I_SU] + (size_t)l * DM * EH;
        dst = p.ws + O_EGU + ((size_t)l * 65 + e) * 1024 * 2048; j.N = EH; j.lddst = DM; j.mode = 1 + which; nb = 16; }
    else { src = (e < NEXP) ? p.in[I_EDN] + ((size_t)l * NEXP + e) * EH * DM : p.in[I_SD] + (size_t)l * EH * DM;
        dst = p.ws + O_ED + ((size_t)l * 65 + e) * 2048 * 512; j.N = DM; j.lddst = EH; j.mode = 0; nb = 64; }
    const int k0 = (q / nb) * 64 + 8 * a; j.n0 = (q % nb) * 32 + 4 * ng; j.s = src + (size_t)k0 * j.N + j.n0; j.d = dst + k0;
    return j;
}
__device__ __forceinline__ void cvt_bg_store(const BgJob& j, const f32x4 (&v)[8]) {
#pragma unroll
    for (int i = 0; i < 4; ++i) { const int n = j.n0 + i, row = (j.mode == 0) ? n : ((n >> 7) * 256 + (n & 127) + (j.mode - 1) * 128);
        u32x2 w; w.x = pk4_fp8(v[0][i] * W8_SCALE, v[1][i] * W8_SCALE, v[2][i] * W8_SCALE, v[3][i] * W8_SCALE); w.y = pk4_fp8(v[4][i] * W8_SCALE, v[5][i] * W8_SCALE, v[6][i] * W8_SCALE, v[7][i] * W8_SCALE);
        *(u32x2*)(j.d + (size_t)row * j.lddst) = w; }
}
__device__ __forceinline__ bool cvt_bg_step2(LAS unsigned char* lds, int limit) {
    const int wid = owid(), lane = otid() & 63, GW = (int)(gridDim.x * 8);
    volatile LAS int* cur = (volatile LAS int*)(lds + LDS_BGCUR);
    const int k = __builtin_amdgcn_readfirstlane(cur[wid]);
    const int T0 = (blockIdx.x * 8 + wid) + k * GW, T1 = T0 + GW;
    if (T0 >= limit) return false;
    const bool two = T1 < limit;
    if (lane == 0) cur[wid] = k + (two ? 2 : 1);
    const __attribute__((address_space(4))) Params* kp = (const __attribute__((address_space(4))) Params*)__builtin_amdgcn_kernarg_segment_ptr(); asm volatile("" : "+s"(kp));
    Params p;
#pragma unroll
    for (int i_ = 0; i_ < 31; ++i_) p.in[i_] = kp->in[i_];
    p.out = kp->out; p.ws = kp->ws; p.layer = 0; p.pad = 0;
    const BgJob j0 = cvt_bg_decode(p, T0, lane), j1 = cvt_bg_decode(p, two ? T1 : T0, lane); f32x4 v0[8], v1[8];
#pragma unroll
    for (int q = 0; q < 8; ++q) v0[q] = *(const f32x4*)(j0.s + (size_t)q * j0.N);
#pragma unroll
    for (int q = 0; q < 8; ++q) v1[q] = *(const f32x4*)(j1.s + (size_t)q * j1.N);
    cvt_bg_store(j0, v0); if (two) cvt_bg_store(j1, v1);
    return true;
}
#endif
__device__ __forceinline__ void adaln_tasks(const Params& p, LAS float* lf) {
    const int lane = otid() & 63, wid = owid();
    float* MOD = (float*)(p.ws + O_MOD);
    for (int task = blockIdx.x; task < 384; task += gridDim.x) {
        const int cb = task % 192, l = task / 192, col = cb * 64 + lane;
        const float* W = p.in[I_ADAW] + (size_t)l * DM * 12288 + col;
        float acc[9];
#pragma unroll
        for (int r = 0; r < 9; ++r) acc[r] = 0.f;
        for (int kb = wid * 256; kb < wid * 256 + 256; kb += 64) {
            float sv[9];
#pragma unroll
            for (int r = 0; r < 8; ++r) sv[r] = silu_f(p.in[I_C][r * DM + kb + lane]);
            sv[8] = silu_f(p.in[I_CCTX][kb + lane]);
#pragma unroll 8
            for (int kk = 0; kk < 64; ++kk) { const float w = (NT2 & 1) ? __builtin_nontemporal_load(W + (size_t)(kb + kk) * 12288) : W[(size_t)(kb + kk) * 12288];
#pragma unroll
                for (int r = 0; r < 9; ++r) acc[r] += rdlane(sv[r], kk) * w; }
        }
#pragma unroll
        for (int r = 0; r < 9; ++r) lf[(wid * 9 + r) * 64 + lane] = acc[r];
        __syncthreads();
        for (int r = wid; r < 9; r += 8) { float s = p.in[I_ADAB][l * 12288 + col];
#pragma unroll
            for (int w = 0; w < 8; ++w) s += lf[(w * 9 + r) * 64 + lane];
            MOD[(size_t)(l * 9 + r) * 12288 + col] = s; }
        __syncthreads();
    }
}
__device__ __forceinline__ void hss_tasks(const Params& p) {
    const int lane = otid() & 63, gw = blockIdx.x * 8 + owid(), GW = gridDim.x * 8;
    for (int task = gw; task < 3 * 1024; task += GW) {
        const int set = task >> 10, l = (set == 1) ? 1 : 0, nset = (set == 2) ? 1 : 0, ord = (task >> 9) & 1, ch = task & 511, n = nset ? 256 : 2048;
        const float* HF = (const float*)(p.ws + O_HF) + (size_t)l * HF_LAYER + (nset ? HF_L0 : 0);
        const float* hf = HF + (size_t)((ord * 2 + 0) * 512 + ch) * n; const float* hb = HF + (size_t)((ord * 2 + 1) * 512 + ch) * n;
        float s = 0.f;
        for (int i = lane; i < n; i += 64) { const float a = hf[i], b = (i == 0) ? 0.f : hb[i]; s += a * a + b * b; }
        s = wave_sum(s);
        if (lane == 0) ((float*)(p.ws + O_HSS))[(size_t)((l * 2 + nset) * 2 + ord) * 512 + ch] = s;
#if HY_KRB
        if (nset == 0) {
            const float rs = rsqrtf(s + EPS); bf16_t* kr = (bf16_t*)(p.ws + O_KRB) + (size_t)((l * 2 + ord) * 512 + ch) * 4128;
            for (int q = lane; q < 516; q += 64) { float v[8];
#pragma unroll
                for (int j = 0; j < 8; ++j) { const int lag = 2064 - (q * 8 + j); v[j] = (lag >= 0 && lag < SEQ) ? hf[lag] * rs : ((lag < 0 && lag > -SEQ) ? hb[-lag] * rs : 0.f); }
                u32x4 w; w.x = pk2(v[0], v[1]); w.y = pk2(v[2], v[3]); w.z = pk2(v[4], v[5]); w.w = pk2(v[6], v[7]); *(u32x4*)(kr + q * 8) = w; }
        }
#endif
    }
}
__device__ __forceinline__ void hyf_task(const Params& p, int l, int nset, int i0, LAS float* lf) {
    int tid = otid(); const int n = nset ? 256 : 2048;
    LAS float* feats = lf; LAS float* hd1 = lf + 8 * 33; LAS float* hd2 = hd1 + 512;
    if (tid < 8 * 33) { const int pos = tid / 33, f = tid % 33, i = i0 + pos; const float t = (float)i / (float)(n - 1), ang = 6.283185307179586f * (float)i / (float)n; float v;
        if (f == 0) v = t; else { const int j = (f - 1) & 15; const float band = 1e-4f + (float)j * ((15.0f - 1e-4f) / 15.0f); v = (f <= 16) ? cosf(ang * band) : sinf(ang * band); }
        feats[tid] = v; }
    __syncthreads();
    { const int pos = tid >> 6, j = tid & 63; const float* w1 = p.in[I_HYW1] + l * 33 * 64; float s = p.in[I_HYB1][l * 64 + j];
      for (int f = 0; f < 33; ++f) s += feats[pos * 33 + f] * w1[f * 64 + j];
      hd1[tid] = sinf(p.in[I_HYFREQ][l * 64 + j] * s); }
    __syncthreads();
    { const int pos = tid >> 6, j = tid & 63; const float* w2 = p.in[I_HYW2] + l * 64 * 64; float s = p.in[I_HYB2][l * 64 + j];
      for (int f = 0; f < 64; ++f) s += hd1[pos * 64 + f] * w2[f * 64 + j];
      hd2[tid] = sinf(p.in[I_HYFREQ][l * 64 + j] * s); }
    __syncthreads();
    const float* w3 = p.in[I_HYW3] + (size_t)l * 64 * 2048 + tid * 4;
    f32x4 acc[8];
#pragma unroll
    for (int q = 0; q < 8; ++q) acc[q] = (f32x4){0.f, 0.f, 0.f, 0.f};
    for (int j = 0; j < 64; ++j) { const f32x4 w = *(const f32x4*)(w3 + (size_t)j * 2048);
#pragma unroll
        for (int q = 0; q < 8; ++q) acc[q] += w * hd2[q * 64 + j]; }
    float* HF = (float*)(p.ws + O_HF) + (size_t)l * HF_LAYER + (nset ? HF_L0 : 0);
#pragma unroll
    for (int c = 0; c < 4; ++c) { const int col = tid * 4 + c, ord = col >> 10, dir = (col >> 9) & 1, ch = col & 511;
        const float delta = 3.0701134573253944f + (float)ch * ((15.350567286626973f - 3.0701134573253944f) / 511.0f); float v[8];
#pragma unroll
        for (int q = 0; q < 8; ++q) { const int i = i0 + q; const float t = (float)i / (float)(n - 1); v[q] = acc[q][c] * __expf(-t * delta); }
        float* dst = HF + (size_t)((ord * 2 + dir) * 512 + ch) * n + i0;
        *(f32x4*)dst = (f32x4){v[0], v[1], v[2], v[3]}; *(f32x4*)(dst + 4) = (f32x4){v[4], v[5], v[6], v[7]};    }
    __syncthreads();
}
__device__ __forceinline__ void rope_tables(const Params& p);
__device__ __forceinline__ void phase_prologue(const Params& p, LAS unsigned char* lds) {
    const int tid = otid(); LAS float* lf = (LAS float*)lds;
    { const size_t gt = (size_t)blockIdx.x * NTHREADS + tid, GT = (size_t)gridDim.x * NTHREADS;
      for (int l = 0; l < NLAYER; ++l) {
          u32x4* z1 = WIN8 ? (u32x4*)(p.ws + O_WIN + ((size_t)l * NP + IN_COLS) * DM) : (u32x4*)((bf16_t*)(p.ws + O_WIN) + ((size_t)l * NP + IN_COLS) * DM); const size_t n1 = (size_t)(NP - IN_COLS) * DM * (WIN8 ? 1 : 2) / 16;
          for (size_t i = gt; i < n1; i += GT) z1[i] = (u32x4){0u, 0u, 0u, 0u};
          u32x4* z2 = (u32x4*)((bf16_t*)(p.ws + O_WUQ) + ((size_t)l * NQP + 1152) * 768); const size_t n2 = (size_t)(NQP - 1152) * 768 * 2 / 16;
          for (size_t i = gt; i < n2; i += GT) z2[i] = (u32x4){0u, 0u, 0u, 0u};
      } }
    rope_tables(p);
#if ROUTER_X3
    { bf16_t* R2 = (bf16_t*)(p.ws + O_RW2);
      for (int i = blockIdx.x * NTHREADS + tid; i < NLAYER * NEXP * DM; i += gridDim.x * NTHREADS) { const int j = i & 7, ln = (i >> 3) & 63, eg = (i >> 9) & 3, st = (i >> 11) & 7, w = (i >> 14) & 7, ll = i >> 17;
          const int k = w * 256 + 32 * st + 8 * (ln >> 4) + j, e = 16 * eg + (ln & 15);
          const float wv = p.in[I_RW][((size_t)ll * DM + k) * NEXP + e]; const bf16_t hi = f2bf(wv); const size_t o = (size_t)(i & 0x1ffff);
          R2[(size_t)(ll * 2 + 0) * NEXP * DM + o] = hi; R2[(size_t)(ll * 2 + 1) * NEXP * DM + o] = f2bf(wv - bf2f(hi)); } }
#endif
#ifndef PRO_REP
#define PRO_REP 0
#endif
    adaln_tasks(p, lf); if (PRO_REP & 1) adaln_tasks(p, lf);
    for (int rep_ = 0; rep_ < ((PRO_REP & 2) ? 2 : 1); ++rep_)
    for (int t = (int)gridDim.x - 1 - (int)blockIdx.x; t < 544; t += gridDim.x) { if (t < 512) hyf_task(p, t >> 8, 0, (t & 255) * 8, lf); else hyf_task(p, 0, 1, (t - 512) * 8, lf); }
    { const int G = gridDim.x, nh = (G < 384 && 2 * G > 384) ? 384 - G : 0;
      if ((int)blockIdx.x >= nh) { const int lane = tid & 63, gw = ((int)blockIdx.x - nh) * 8 + owid(), GW = (G - nh) * 8;
        for (int rep_ = 0; rep_ < ((PRO_REP & 4) ? 2 : 1); ++rep_)
        for (int t = gw; t < NLAYER * CVT_SMALL; t += GW) cvt_small_task(p, t / CVT_SMALL, t % CVT_SMALL, lane); } }
#if !CVT_BG
    cvt_exp_all(p, 0);
#endif
}

__device__ __forceinline__ void norm1_row(const Params& p, int l, int row, const float (&x)[32], int lane) {
    float ss = 0.f;
#pragma unroll
    for (int i = 0; i < 32; ++i) ss += x[i] * x[i];
    ss = wave_sum(ss); const float rstd = rsqrtf(ss * (1.0f / DM) + EPS);
    const float* g = p.in[I_NORMG] + (size_t)(l * 4 + 0) * DM; const float* mod = (const float*)(p.ws + O_MOD) + (size_t)(l * 9 + row_batch(row)) * 12288;
    bf16_t* H = (bf16_t*)(p.ws + O_H) + (size_t)row * DM;
#pragma unroll
    for (int j = 0; j < 8; ++j) { const int c = ROWCOL(j, lane); const f32x4 gv = *(const f32x4*)(g + c), sh = *(const f32x4*)(mod + c), sc = *(const f32x4*)(mod + DM + c); float h[4];
#pragma unroll
        for (int q = 0; q < 4; ++q) h[q] = x[j * 4 + q] * rstd * gv[q] * (1.0f + sc[q]) + sh[q];
#if WIN8
        *(unsigned*)((unsigned char*)(p.ws + O_H) + (size_t)row * DM + c) = pk4_fp8(h[0], h[1], h[2], h[3]);
#else
        u32x2 w; w.x = pk2(h[0], h[1]); w.y = pk2(h[2], h[3]); *(u32x2*)(H + c) = w;
#endif
    }
}
__device__ __forceinline__ void norm1_row_c(const Params& p, int l, int row, const float (&x)[32], int lane) {
    const float* mc = (const float*)(p.ws + O_MODC) + (size_t)((l * 9 + row_batch(row)) * 6 + 4) * DM; f32x4 a4[8], a5[8];
#pragma unroll
    for (int j = 0; j < 8; ++j) { a4[j] = ld_mc(p, l, row, 4, ROWCOL(j, lane)); a5[j] = ld_mc(p, l, row, 5, ROWCOL(j, lane)); }
    float ss = 0.f;
#pragma unroll
    for (int i = 0; i < 32; ++i) ss += x[i] * x[i];
    ss = wave_sum(ss); const float rstd = rsqrtf(ss * (1.0f / DM) + EPS);
    bf16_t* H = (bf16_t*)(p.ws + O_H) + (size_t)row * DM;
#pragma unroll
    for (int j = 0; j < 8; ++j) { const int c = ROWCOL(j, lane); float h[4];
#pragma unroll
        for (int q = 0; q < 4; ++q) h[q] = x[j * 4 + q] * rstd * a4[j][q] + a5[j][q];
#if WIN8
        *(unsigned*)((unsigned char*)(p.ws + O_H) + (size_t)row * DM + c) = pk4_fp8(h[0], h[1], h[2], h[3]);
#else
        u32x2 w; w.x = pk2(h[0], h[1]); w.y = pk2(h[2], h[3]); *(u32x2*)(H + c) = w;
#endif
    }
}
__device__ __forceinline__ void phase_norm1(const Params& p, int l) {
    { float* mc = (float*)(p.ws + O_MODC); const float* MODp = (const float*)(p.ws + O_MOD);
      for (int i = blockIdx.x * NTHREADS + otid(); i < NLAYER * 9 * DM; i += gridDim.x * NTHREADS) { const int c = i % DM, r = (i / DM) % 9, ll = i / (9 * DM); const float* m = MODp + (size_t)(ll * 9 + r) * 12288;
          const float g0 = p.in[I_NORMG][(size_t)(ll * 4 + 0) * DM + c], g1 = p.in[I_NORMG][(size_t)(ll * 4 + 1) * DM + c], g2 = p.in[I_NORMG][(size_t)(ll * 4 + 2) * DM + c], g3 = p.in[I_NORMG][(size_t)(ll * 4 + 3) * DM + c]; float* d = mc + (size_t)((ll * 9 + r) * 6) * DM + c;
          const float v0 = m[2 * DM + c] * g1, v1 = g2 * (1.0f + m[4 * DM + c]), v2 = m[3 * DM + c], v3 = m[5 * DM + c] * g3, v4 = g0 * (1.0f + m[DM + c]), v5 = m[c];
          if (MCB16) { bf16_t* db = (bf16_t*)(p.ws + O_MODC) + (size_t)((ll * 9 + r) * 6) * DM + c; db[0] = f2bf(v0); db[DM] = f2bf(v1); db[2 * DM] = f2bf(v2); db[3 * DM] = f2bf(v3); db[4 * DM] = f2bf(v4); db[5 * DM] = f2bf(v5); }
          else { d[0] = v0; d[DM] = v1; d[2 * DM] = v2; d[3 * DM] = v3; d[4 * DM] = v4; d[5 * DM] = v5; } } }
    const int lane = otid() & 63, gw = blockIdx.x * 8 + owid(), GW = gridDim.x * 8;
    const int lane0 = lane;
    for (int row = gw; row < NTOK; row += GW) { int lane = lane0; asm volatile("" : "+v"(lane)); const float* src = resid_src(p, l, row); float x[32];
#pragma unroll
        for (int j = 0; j < 8; ++j) { const f32x4 v = (NT2 & 4) ? __builtin_nontemporal_load((const f32x4*)(src + ROWCOL(j, lane))) : *(const f32x4*)(src + ROWCOL(j, lane)); x[j * 4] = v[0]; x[j * 4 + 1] = v[1]; x[j * 4 + 2] = v[2]; x[j * 4 + 3] = v[3]; }
        norm1_row(p, l, row, x, lane); }
}

__device__ __forceinline__ void rope_tables(const Params& p) {
    float* T = (float*)(p.ws + O_ROPE);
    for (int i = blockIdx.x * NTHREADS + otid(); i < 64 * 32 + 64 * 16; i += gridDim.x * NTHREADS) {
        float a; if (i < 64 * 32) a = (float)(i >> 5) * exp2f(-(float)(i & 31) * (13.287712379549449f / 32.0f)); else { const int q = i - 64 * 32; a = (float)(q >> 4) * exp2f(-(float)(q & 15) * (13.287712379549449f / 16.0f)); }
        float sn, cs; sincosf(a, &sn, &cs); T[2 * i] = cs; T[2 * i + 1] = sn; }
}
__device__ __forceinline__ void unpack8(const u32x4 v, float (&x)[8]) {
#pragma unroll
    for (int j = 0; j < 4; ++j) { x[2 * j] = __uint_as_float(v[j] << 16); x[2 * j + 1] = __uint_as_float(v[j] & 0xffff0000u); }
}
__device__ __forceinline__ u32x4 pack8(const float (&x)[8]) { u32x4 w; w.x = pk2(x[0], x[1]); w.y = pk2(x[2], x[3]); w.z = pk2(x[4], x[5]); w.w = pk2(x[6], x[7]); return w; }
template <int PX> __device__ __forceinline__ void rope8(float (&x)[8], const float* cs, bool second) {
#pragma unroll
    for (int j = 0; j < 8; ++j) { const float pr = __shfl_xor(x[j], PX), c = cs[2 * j], sn = cs[2 * j + 1]; x[j] = second ? pr * sn + x[j] * c : x[j] * c - pr * sn; }
}
__device__ __forceinline__ void gqa_post_row(const Params& p, int l, int row, int lane) {
    const bf16_t* P = (const bf16_t*)(p.ws + O_P) + (size_t)row * NP;
    const bool isctx = row >= NLAT; const int b = isctx ? (row - NLAT) >> 8 : row >> 11, t = isctx ? (row - NLAT) & 255 : row & 2047;
    const int j = lane & 15, hq = lane >> 4, half = j >> 3; const bool second = (j >> 2) & 1;
    const float* cs = (const float*)(p.ws + O_ROPE) + ((size_t)(half ? (t & 63) : (t >> 6)) * 32 + 8 * (j & 3)) * 2;
    const int kpos = isctx ? t : CTXL + t;
#pragma unroll
    for (int ps = 0; ps < 2; ++ps) {
        const bool isk = (ps == 1) && (hq >= 2); const int h = (ps == 0) ? hq : (isk ? hq - 2 : 4 + hq);
        const bf16_t* src = P + (isk ? C_GK : C_GQ) + h * 128 + 8 * j; const float* gn = (isk ? p.in[I_GKN] : p.in[I_GQN]) + l * 128 + 8 * j;
        float x[8]; unpack8(LDNT2(u32x4, src), x);
        float ss = 0.f;
#pragma unroll
        for (int q = 0; q < 8; ++q) ss += x[q] * x[q];
        ss += __shfl_xor(ss, 1); ss += __shfl_xor(ss, 2); ss += __shfl_xor(ss, 4); ss += __shfl_xor(ss, 8);
        const float rstd = rsqrtf(ss * (1.0f / 128.0f) + EPS); const f32x4 g0 = *(const f32x4*)gn, g1 = *(const f32x4*)(gn + 4);
#pragma unroll
        for (int q = 0; q < 4; ++q) { x[q] *= rstd * g0[q]; x[4 + q] *= rstd * g1[q]; }
        if (!isctx) rope8<4>(x, cs, second);
        bf16_t* dst = isk ? (bf16_t*)(p.ws + O_KG) + ((size_t)(b * 2 + h) * LK + kpos) * 128
                          : (isctx ? (bf16_t*)(p.ws + O_QGC) + ((size_t)(b * 6 + h) * CTXL + t) * 128 : (bf16_t*)(p.ws + O_QG) + ((size_t)(b * 6 + h) * SEQ + t) * 128);
        *(u32x4*)(dst + 8 * j) = pack8(x);
    }
    if (lane < 32) { const int h = lane >> 4; *(u32x4*)((bf16_t*)(p.ws + O_VG) + ((size_t)(b * 2 + h) * LK + kpos) * 128 + 8 * j) = LDNT2(u32x4, P + C_GV + h * 128 + 8 * j); }
}
__device__ __forceinline__ void seq_of(int row, int& s0, int& n) { if (row < NLAT) { s0 = row & ~2047; n = SEQ; } else { s0 = NLAT + ((row - NLAT) & ~255); n = CTXL; } }
__device__ __forceinline__ void load_conv_tile(const bf16_t* P, int t0, int pc0, LAS float* u) {
    int s0, n; seq_of(t0, s0, n);
    for (int i = otid(); i < 66 * 8; i += NTHREADS) { const int r = i >> 3, c = (i & 7) * 8, row = t0 - 1 + r;
        float x[8];
        if (row >= s0 && row < s0 + n) { const u32x4 v = LDNT2(u32x4, P + (size_t)row * NP + pc0 + c);
#pragma unroll
            for (int j = 0; j < 4; ++j) { x[2 * j] = __uint_as_float(v[j] << 16); x[2 * j + 1] = __uint_as_float(v[j] & 0xffff0000u); } }
        else {
#pragma unroll
            for (int j = 0; j < 8; ++j) x[j] = 0.f; }
#pragma unroll
        for (int j = 0; j < 8; ++j) u[r * 65 + c + j] = x[j]; }
}
__device__ __forceinline__ void hy_prep_task(const Params& p, int l, int t0, int c0, LAS float* u) {
    const bf16_t* P = (const bf16_t*)(p.ws + O_P);
#pragma unroll
    for (int q = 0; q < 4; ++q) load_conv_tile(P, t0, c0 + 64 * q, u + q * (66 * 65));
    __syncthreads();
    const int tid = otid(), c = tid >> 3, tc = (tid & 7) * 8;
#pragma unroll
    for (int q = 0; q < 4; ++q) { const LAS float* uq = u + q * (66 * 65); const int ch = c0 + 64 * q + c; const float* cw = p.in[I_HYCONV] + (size_t)l * 3 * 1536 + ch;
        const float w0 = cw[0], w1 = cw[1536], w2 = cw[3072]; float y[8], uu[10];
#pragma unroll
        for (int j = 0; j < 10; ++j) uu[j] = uq[(tc + j) * 65 + c];
#pragma unroll
        for (int j = 0; j < 8; ++j) y[j] = w0 * uu[j] + w1 * uu[j + 1] + w2 * uu[j + 2];
        bf16_t* dst = (ch < 512 ? (bf16_t*)(p.ws + O_VT) + (size_t)ch * NTOK : (bf16_t*)(p.ws + O_X1T) + (size_t)(ch - 512) * NTOK) + t0 + tc;
        u32x4 w; w.x = pk2(y[0], y[1]); w.y = pk2(y[2], y[3]); w.z = pk2(y[4], y[5]); w.w = pk2(y[6], y[7]); *(u32x4*)dst = w; }
    __syncthreads();
}
__device__ __forceinline__ void mla_post_row(const Params& p, int l, int row, int lane) {
    const bf16_t* P = (const bf16_t*)(p.ws + O_P) + (size_t)row * NP;
    const bool isctx = row >= NLAT; const int b = isctx ? (row - NLAT) >> 8 : row >> 11, t = isctx ? (row - NLAT) & 255 : row & 2047;
    float sq = 0.f, skv = 0.f; float x[8];
    unpack8(*(const u32x4*)(P + C_CQ + 8 * lane), x);
#pragma unroll
    for (int q = 0; q < 8; ++q) sq += x[q] * x[q];
    if (lane < 32) { unpack8(*(const u32x4*)(P + C_CQ + 512 + 8 * lane), x);
#pragma unroll
        for (int q = 0; q < 8; ++q) sq += x[q] * x[q];
        unpack8(*(const u32x4*)(P + C_CKV + 8 * lane), x);
#pragma unroll
        for (int q = 0; q < 8; ++q) skv += x[q] * x[q]; }
    const float rq = rsqrtf(wave_sum(sq) * (1.0f / 768.0f) + EPS), rkv = rsqrtf(wave_sum(skv) * (1.0f / 256.0f) + EPS);
    const bf16_t* QR = (const bf16_t*)(p.ws + O_QRAW) + (size_t)row * NQP; const bf16_t* KV = (const bf16_t*)(p.ws + O_KVRAW) + (size_t)row * 1536;
    const int kpos = isctx ? t : CTXL + t;
    const float* RM = (const float*)(p.ws + O_ROPE) + 64 * 32 * 2;
#pragma unroll
    for (int ps = 0; ps < 3; ++ps) { const int id = ps * 64 + lane; const bool act = id < 144; const int h = act ? id / 24 : 0, cj = act ? id % 24 : 0, rc = cj - 16;
        unpack8(LDNT2(u32x4, QR + h * 192 + 8 * cj), x);
#pragma unroll
        for (int q = 0; q < 8; ++q) x[q] *= rq;
        if (!isctx) { const int rcc = rc < 0 ? 0 : rc; const float* cs = RM + ((size_t)((rcc >> 2) ? (t & 63) : (t >> 6)) * 16 + 8 * (rcc & 1)) * 2; float y[8];
#pragma unroll
            for (int q = 0; q < 8; ++q) y[q] = x[q];
            rope8<2>(y, cs, (rcc >> 1) & 1);
            if (rc >= 0) {
#pragma unroll
                for (int q = 0; q < 8; ++q) x[q] = y[q]; } }
        bf16_t* qd = isctx ? (bf16_t*)(p.ws + O_QMC) + ((size_t)(b * 6 + h) * CTXL + t) * 192 : (bf16_t*)(p.ws + O_QM) + ((size_t)(b * 6 + h) * SEQ + t) * 192;
        if (act) *(u32x4*)(qd + 8 * cj) = pack8(x); }
#pragma unroll
    for (int ps = 0; ps < 3; ++ps) { const int id = ps * 64 + lane, h = id >> 5, c = id & 31;
        unpack8(LDNT2(u32x4, KV + h * 256 + 8 * c), x);
#pragma unroll
        for (int q = 0; q < 8; ++q) x[q] *= rkv;
        bf16_t* d = (c < 16) ? (bf16_t*)(p.ws + O_KM) + ((size_t)(b * 6 + h) * LK + kpos) * 192 + 8 * c : (bf16_t*)(p.ws + O_VM) + ((size_t)(b * 6 + h) * LK + kpos) * 128 + 8 * (c - 16);
        *(u32x4*)d = pack8(x); }
    { const int h = lane >> 3, rc = lane & 7; unpack8(*(const u32x4*)(P + C_KR + 8 * rc), x);
      if (!isctx) { const float* cs = RM + ((size_t)((rc >> 2) ? (t & 63) : (t >> 6)) * 16 + 8 * (rc & 1)) * 2; rope8<2>(x, cs, (rc >> 1) & 1); }
      if (lane < 48) *(u32x4*)((bf16_t*)(p.ws + O_KM) + ((size_t)(b * 6 + h) * LK + kpos) * 192 + 128 + 8 * rc) = pack8(x); }
}

__device__ __forceinline__ void hyconv_unit_valu(const Params& p, int l, int nset, int c, LAS float* lf) {
    const int tid = otid(), n = nset ? CTXL : SEQ, tokbase = nset ? NLAT : 0;
    LAS float* kc = lf; LAS float* z = lf + 4096; LAS float* z2 = z + 8 * SEQ;
    const float* HF = (const float*)(p.ws + O_HF) + (size_t)l * HF_LAYER + (nset ? HF_L0 : 0); const float* HSS = (const float*)(p.ws + O_HSS) + (size_t)((l * 2 + nset) * 2) * 512;
    const bf16_t* VT = (const bf16_t*)(p.ws + O_VT) + (size_t)c * NTOK + tokbase; const bf16_t* X1T = (const bf16_t*)(p.ws + O_X1T) + (size_t)c * NTOK + tokbase;
    bf16_t* Y2T = (bf16_t*)(p.ws + O_Y2T) + (size_t)c * NTOK + tokbase;
    for (int i = tid; i < 8 * n; i += NTHREADS) z[i] = bf2f(VT[i]);
    for (int ord = 0; ord < 2; ++ord) {
        const float rs = rsqrtf(HSS[ord * 512 + c] + EPS); const float* hf = HF + (size_t)((ord * 2 + 0) * 512 + c) * n; const float* hb = HF + (size_t)((ord * 2 + 1) * 512 + c) * n;
        for (int m = tid; m < 2 * n; m += NTHREADS) { const int lag = m - (n - 1); kc[m] = (m == 2 * n - 1) ? 0.f : (lag >= 0 ? hf[lag] : hb[-lag]) * rs; }
        __syncthreads();
        const LAS float* zs = ord ? z2 : z; const float skip = p.in[I_HYSKIP][(size_t)(l * 2 + ord) * 512 + c];
        for (int q = tid; q < n; q += NTHREADS) {
            const int b = q / (n >> 3), t0 = (q % (n >> 3)) * 8; float acc[8];
#pragma unroll
            for (int j = 0; j < 8; ++j) acc[j] = 0.f;
            const LAS float* zb = zs + b * n;
            for (int sb = 0; sb < n; sb += 8) {
                const LAS float* kb = kc + (t0 - sb + n - 8); float w[16];
#pragma unroll
                for (int i = 0; i < 4; ++i) { const f32x4 v = *(const LAS f32x4*)(kb + 4 * i); w[4 * i] = v[0]; w[4 * i + 1] = v[1]; w[4 * i + 2] = v[2]; w[4 * i + 3] = v[3]; }
                const f32x4 za = *(const LAS f32x4*)(zb + sb), zc = *(const LAS f32x4*)(zb + sb + 4); const float zv[8] = {za[0], za[1], za[2], za[3], zc[0], zc[1], zc[2], zc[3]};
#pragma unroll
                for (int ss = 0; ss < 8; ++ss)
#pragma unroll
                    for (int j = 0; j < 8; ++j) acc[j] += w[j - ss + 7] * zv[ss];
            }
            if (ord == 0) {
#pragma unroll
                for (int j = 0; j < 8; ++j) { const int idx = b * n + t0 + j; z2[idx] = bf2f(X1T[idx]) * (acc[j] + skip * z[idx]); }
            } else { float y[8];
#pragma unroll
                for (int j = 0; j < 8; ++j) y[j] = acc[j] + skip * z2[b * n + t0 + j];
                u32x4 w; w.x = pk2(y[0], y[1]); w.y = pk2(y[2], y[3]); w.z = pk2(y[4], y[5]); w.w = pk2(y[6], y[7]); *(u32x4*)(Y2T + b * n + t0) = w; }
        }
        __syncthreads();
    }
}
constexpr int HC_COPYB = 8256, HC_ROWB = 4560, HC_PAD = 112, HC_KR = 4112, HC_M0 = 2064;
constexpr int HC_ZOFF = 8 * HC_COPYB, HC_Z2OFF = HC_ZOFF + 8 * HC_ROWB;
__device__ __forceinline__ void hyconv_unit_mfma(const Params& p, int l, int c, LAS unsigned char* lds) {
    const int tid = otid(), wid = __builtin_amdgcn_readfirstlane(tid >> 6), lane = tid & 63;
    LAS unsigned char* CP = lds; LAS unsigned char* Zr = lds + HC_ZOFF; LAS unsigned char* Z2r = lds + HC_Z2OFF;
    const float* HF = (const float*)(p.ws + O_HF) + (size_t)l * HF_LAYER; const float* HSS = (const float*)(p.ws + O_HSS) + (size_t)(l * 4) * 512;
    const bf16_t* VT = (const bf16_t*)(p.ws + O_VT) + (size_t)c * NTOK; const bf16_t* X1T = (const bf16_t*)(p.ws + O_X1T) + (size_t)c * NTOK; bf16_t* Y2T = (bf16_t*)(p.ws + O_Y2T) + (size_t)c * NTOK;
    for (int q = tid; q < 8 * 256; q += NTHREADS) { const int b = q >> 8, ch = q & 255; *(LAS u32x4*)(Zr + b * HC_ROWB + (HC_PAD + ch * 8) * 2) = *(const u32x4*)(VT + b * SEQ + ch * 8); }
    for (int q = tid; q < 8 * 29; q += NTHREADS) { const int b = q / 29, ch = q % 29; const int e0 = ch < 14 ? ch * 8 : HC_PAD + SEQ + (ch - 14) * 8; *(LAS u32x4*)(Zr + b * HC_ROWB + e0 * 2) = (u32x4){0u, 0u, 0u, 0u}; }
    const int a = lane & 31, kg = lane >> 5, bq = a >> 2, isub = a & 3;
    const int Aoff = (a & 7) * HC_COPYB + (HC_M0 - 8 * (a >> 3) + 8 * kg) * 2;
    const int g0 = 2 * wid;
    const int Boff = bq * HC_ROWB + (HC_PAD + 128 * g0 + 32 * isub + 8 * kg) * 2;
    for (int ord = 0; ord < 2; ++ord) {
#if HY_KRB
        { const bf16_t* krg = (const bf16_t*)(p.ws + O_KRB) + (size_t)((l * 2 + ord) * 512 + c) * 4128;
          for (int q = tid; q < 516; q += NTHREADS) { const u32x4 Q = *(const u32x4*)(krg + q * 8); const u32x4 P = q ? *(const u32x4*)(krg + (q - 1) * 8) : (u32x4){0u, 0u, 0u, 0u};
              const unsigned D[8] = {P.x, P.y, P.z, P.w, Q.x, Q.y, Q.z, Q.w};
#pragma unroll
              for (int sft = 0; sft < 8; ++sft) { u32x4 w;
                  if ((sft & 1) == 0) { const int k0 = (8 - sft) >> 1; w = (u32x4){D[k0], D[k0 + 1], D[k0 + 2], D[k0 + 3]}; }
                  else { const int k0 = (7 - sft) >> 1; w.x = __builtin_amdgcn_alignbyte(D[k0 + 1], D[k0], 2); w.y = __builtin_amdgcn_alignbyte(D[k0 + 2], D[k0 + 1], 2); w.z = __builtin_amdgcn_alignbyte(D[k0 + 3], D[k0 + 2], 2); w.w = __builtin_amdgcn_alignbyte(D[k0 + 4], D[k0 + 3], 2); }
                  *(LAS u32x4*)(CP + sft * HC_COPYB + q * 16) = w; } } }
        __syncthreads();
#else
        LAS float* kr = (LAS float*)(ord == 0 ? Z2r : Zr);
        { const float rs = rsqrtf(HSS[ord * 512 + c] + EPS); const float* hf = HF + (size_t)((ord * 2 + 0) * 512 + c) * SEQ; const float* hb = HF + (size_t)((ord * 2 + 1) * 512 + c) * SEQ;
          for (int m = tid; m < HC_KR; m += NTHREADS) { const int lag = HC_M0 - m; float v = 0.f; if (lag >= 0 && lag < SEQ) v = hf[lag] * rs; else if (lag < 0 && lag > -SEQ) v = hb[-lag] * rs; kr[m] = v; } }
        __syncthreads();
        for (int q = tid; q < 8 * 516; q += NTHREADS) { const int sft = q / 516, ch = q % 516; float v[8];
#pragma unroll
            for (int j = 0; j < 8; ++j) { const int m = ch * 8 + j - sft; v[j] = (m >= 0 && m < HC_KR) ? kr[m] : 0.f; }
            u32x4 w; w.x = pk2(v[0], v[1]); w.y = pk2(v[2], v[3]); w.z = pk2(v[4], v[5]); w.w = pk2(v[6], v[7]); *(LAS u32x4*)(CP + sft * HC_COPYB + ch * 16) = w; }
        __syncthreads();
#endif
        if (ord == 0) for (int q = tid; q < 8 * 29; q += NTHREADS) { const int b = q / 29, ch = q % 29; const int e0 = ch < 14 ? ch * 8 : HC_PAD + SEQ + (ch - 14) * 8; *(LAS u32x4*)(Z2r + b * HC_ROWB + e0 * 2) = (u32x4){0u, 0u, 0u, 0u}; }
        const LAS unsigned char* Zs = ord ? Z2r : Zr;
        f32x16 acc0 = {}, acc1 = {};
        const int e_lo = 16 * wid - 127, e_mid0 = 16 * wid - 119, e_mid1 = 16 * wid + 7, e_hi = 16 * wid + 15;
        for (int e = e_lo; e < e_mid0; ++e) { const bf16x8 A = *(const LAS bf16x8*)(CP + Aoff - 32 * e); const bf16x8 B0 = *(const LAS bf16x8*)(Zs + Boff - 32 * e);
            acc0 = __builtin_amdgcn_mfma_f32_32x32x16_bf16(A, B0, acc0, 0, 0, 0); }
#pragma unroll 2
        for (int e = e_mid0; e <= e_mid1; ++e) { const bf16x8 A = *(const LAS bf16x8*)(CP + Aoff - 32 * e); const bf16x8 B0 = *(const LAS bf16x8*)(Zs + Boff - 32 * e); const bf16x8 B1 = *(const LAS bf16x8*)(Zs + Boff + 256 - 32 * e);
            acc0 = __builtin_amdgcn_mfma_f32_32x32x16_bf16(A, B0, acc0, 0, 0, 0); acc1 = __builtin_amdgcn_mfma_f32_32x32x16_bf16(A, B1, acc1, 0, 0, 0); }
        for (int e = e_mid1 + 1; e <= e_hi; ++e) { const bf16x8 A = *(const LAS bf16x8*)(CP + Aoff - 32 * e); const bf16x8 B1 = *(const LAS bf16x8*)(Zs + Boff + 256 - 32 * e);
            acc1 = __builtin_amdgcn_mfma_f32_32x32x16_bf16(A, B1, acc1, 0, 0, 0); }
        const float skip = p.in[I_HYSKIP][(size_t)(l * 2 + ord) * 512 + c];
#pragma unroll
        for (int gi = 0; gi < 2; ++gi) {
#pragma unroll
            for (int q = 0; q < 4; ++q) { const int t = 128 * (g0 + gi) + 32 * isub + 8 * q + 4 * kg; float y[4];
#pragma unroll
                for (int j = 0; j < 4; ++j) y[j] = gi ? acc1[4 * q + j] : acc0[4 * q + j];
                const u32x2 zz = *(const LAS u32x2*)(Zs + bq * HC_ROWB + (HC_PAD + t) * 2);
                const float z0 = __uint_as_float(zz.x << 16), z1 = __uint_as_float(zz.x & 0xffff0000u), z2 = __uint_as_float(zz.y << 16), z3 = __uint_as_float(zz.y & 0xffff0000u);
                y[0] += skip * z0; y[1] += skip * z1; y[2] += skip * z2; y[3] += skip * z3;
                if (ord == 0) { const u32x2 xx = LDNT3(u32x2, X1T + bq * SEQ + t);
                    y[0] *= __uint_as_float(xx.x << 16); y[1] *= __uint_as_float(xx.x & 0xffff0000u); y[2] *= __uint_as_float(xx.y << 16); y[3] *= __uint_as_float(xx.y & 0xffff0000u);
                    u32x2 w; w.x = pk2(y[0], y[1]); w.y = pk2(y[2], y[3]); *(LAS u32x2*)(Z2r + bq * HC_ROWB + (HC_PAD + t) * 2) = w; }
                else { u32x2 w; w.x = pk2(y[0], y[1]); w.y = pk2(y[2], y[3]); *(u32x2*)(Y2T + bq * SEQ + t) = w; } }
        }
        __syncthreads();
    }
}
__device__ __forceinline__ void hy_fin_task(const Params& p, int l, int t0, int c0, LAS float* u) {
    const bf16_t* P = (const bf16_t*)(p.ws + O_P); LAS float* y = u + 66 * 65;
    load_conv_tile(P, t0, 1024 + c0, u);
    const int tid = otid();
    { const int c = tid >> 3, tc = (tid & 7) * 8; const u32x4 v = LDNT3(u32x4, (const bf16_t*)(p.ws + O_Y2T) + (size_t)(c0 + c) * NTOK + t0 + tc);
#pragma unroll
      for (int j = 0; j < 4; ++j) { y[c * 65 + tc + 2 * j] = __uint_as_float(v[j] << 16); y[c * 65 + tc + 2 * j + 1] = __uint_as_float(v[j] & 0xffff0000u); } }
    __syncthreads();
    { const int t = tid >> 3, cc = (tid & 7) * 8; const float* cw = p.in[I_HYCONV] + (size_t)l * 3 * 1536 + 1024 + c0 + cc; float o[8];
#pragma unroll
      for (int j = 0; j < 8; ++j) { const int c = cc + j; const float x2 = cw[j] * u[t * 65 + c] + cw[1536 + j] * u[(t + 1) * 65 + c] + cw[3072 + j] * u[(t + 2) * 65 + c]; o[j] = x2 * y[c * 65 + t]; }
#if WOUT8
      u32x2 w; w.x = pk4_fp8(o[0] * MIX8_SCALE, o[1] * MIX8_SCALE, o[2] * MIX8_SCALE, o[3] * MIX8_SCALE); w.y = pk4_fp8(o[4] * MIX8_SCALE, o[5] * MIX8_SCALE, o[6] * MIX8_SCALE, o[7] * MIX8_SCALE);
      *(u32x2*)(p.ws + O_MIX + (size_t)(t0 + t) * DM + c0 + cc) = w; }
#else
      u32x4 w; w.x = pk2(o[0], o[1]); w.y = pk2(o[2], o[3]); w.z = pk2(o[4], o[5]); w.w = pk2(o[6], o[7]);
      *(u32x4*)((bf16_t*)(p.ws + O_MIX) + (size_t)(t0 + t) * DM + c0 + cc) = w; }
#endif
    __syncthreads();
}

__device__ __forceinline__ void mla_unit(const Params& p, int b, int h, int qb, bool ctxq, LAS unsigned char* lds) {
    unsigned char* ws = p.ws;
    const bf16_t* Q = ctxq ? (const bf16_t*)(ws + O_QMC) + (size_t)(b * 6 + h) * CTXL * 192 : (const bf16_t*)(ws + O_QM) + ((size_t)(b * 6 + h) * SEQ + qb * 256) * 192;
#if WOUT8
    bf16_t* O = (bf16_t*)(ws + O_MIX + (size_t)(ctxq ? NLAT + b * CTXL : b * SEQ + qb * 256) * DM + 512 + h * 128);
#else
    bf16_t* O = (bf16_t*)(ws + O_MIX) + (size_t)(ctxq ? NLAT + b * CTXL : b * SEQ + qb * 256) * DM + 512 + h * 128;
#endif
#if ATT_DMA & 1
    attn_body_dma<192>(Q, (const bf16_t*)(ws + O_KM) + (size_t)(b * 6 + h) * LK * 192, (const bf16_t*)(ws + O_VM) + (size_t)(b * 6 + h) * LK * 128, O, DM, ctxq ? CTXL : LK, 0.07216878364870322f, lds);
#else
    attn_body<192, 0>(Q, (const bf16_t*)(ws + O_KM) + (size_t)(b * 6 + h) * LK * 192, (const bf16_t*)(ws + O_VM) + (size_t)(b * 6 + h) * LK * 128, O, DM, ctxq ? CTXL : LK, 0.07216878364870322f, (char*)lds);
#endif
}
__device__ __forceinline__ void gqa_unit(const Params& p, int b, int h, int qb, bool ctxq, LAS unsigned char* lds) {
    unsigned char* ws = p.ws;
    const bf16_t* Q = ctxq ? (const bf16_t*)(ws + O_QGC) + (size_t)(b * 6 + h) * CTXL * 128 : (const bf16_t*)(ws + O_QG) + ((size_t)(b * 6 + h) * SEQ + qb * 256) * 128;
#if WOUT8
    bf16_t* O = (bf16_t*)(ws + O_MIX + (size_t)(ctxq ? NLAT + b * CTXL : b * SEQ + qb * 256) * DM + 1280 + h * 128);
#else
    bf16_t* O = (bf16_t*)(ws + O_MIX) + (size_t)(ctxq ? NLAT + b * CTXL : b * SEQ + qb * 256) * DM + 1280 + h * 128;
#endif
#if ATT_DMA & 2
    attn_body_dma<128>(Q, (const bf16_t*)(ws + O_KG) + (size_t)(b * 2 + h / 3) * LK * 128, (const bf16_t*)(ws + O_VG) + (size_t)(b * 2 + h / 3) * LK * 128, O, DM, ctxq ? CTXL : LK, 0.08838834764831845f, lds);
#else
    attn_body<128, GQA_SD>(Q, (const bf16_t*)(ws + O_KG) + (size_t)(b * 2 + h / 3) * LK * 128, (const bf16_t*)(ws + O_VG) + (size_t)(b * 2 + h / 3) * LK * 128, O, DM, ctxq ? CTXL : LK, 0.08838834764831845f, (char*)lds);
#endif
}
__device__ __forceinline__ void phase_mixer(const Params& p, int l, LAS unsigned char* lds) {
    const int G = gridDim.x, bid = blockIdx.x; const bool last = (l == NLAYER - 1);
#ifndef MLA_REP
#define MLA_REP 1
#endif
#ifndef GQA_REP
#define GQA_REP 1
#endif
#ifndef ATT_XCD
#define ATT_XCD 1
#endif
    if (ATT_XCD && G % 8 == 0) {
        const int x = bid % 8, r = bid / 8, W = G / 8, L = 48 + (last ? 0 : 6);
        for (int j = r; j < L; j += W) { if (j < 48) { const int g = x + 8 * (j >> 3); mla_unit(p, g / 6, g % 6, j & 7, false, lds); } else { const int g = x + 8 * (j - 48); mla_unit(p, g / 6, g % 6, 0, true, lds); } }
        for (int j = (r + W / 2) % W; j < L; j += W) { if (j < 48) { const int kg = x + 8 * (j / 24), w = j % 24; gqa_unit(p, kg >> 1, (kg & 1) * 3 + (w >> 3), w & 7, false, lds); }
                                                      else { const int jj = j - 48, kg = x + 8 * (jj / 3); gqa_unit(p, kg >> 1, (kg & 1) * 3 + jj % 3, 0, true, lds); } }
    } else {
    for (int rep_ = 0; rep_ < MLA_REP; ++rep_)
    for (int u = bid; u < 384 + (last ? 0 : 48); u += G) { if (u < 384) mla_unit(p, u / 48, (u >> 3) % 6, u & 7, false, lds); else mla_unit(p, (u - 384) / 6, (u - 384) % 6, 0, true, lds); }
    for (int rep_ = 0; rep_ < GQA_REP; ++rep_)
    for (int u = (bid + G / 2) % G; u < 384 + (last ? 0 : 48); u += G) { if (u < 384) gqa_unit(p, u / 48, (u >> 3) % 6, u & 7, false, lds); else gqa_unit(p, (u - 384) / 6, (u - 384) % 6, 0, true, lds); }
    }
#ifndef CONV_REP
#define CONV_REP 1
#endif
    for (int rep = 0; rep < CONV_REP; ++rep) {
#if HY_MFMA
    for (int u = bid; u < 512; u += G) hyconv_unit_mfma(p, l, u, lds);
    if (!last) for (int u = bid; u < 512; u += G) hyconv_unit_valu(p, l, 1, u, (LAS float*)lds);
#else
    for (int u = bid; u < (last ? 512 : 1024); u += G) hyconv_unit_valu(p, l, u >> 9, u & 511, (LAS float*)lds);
#endif
    }
}

constexpr int RT_FS = DM + 4;
constexpr int RT_HS = DM + 8;
__device__ __forceinline__ void route_row_pre(const Params& p, int l, int row, int lane, LAS float* fdst, const float* g1, const float* g2) {
    const float* mc = (const float*)(p.ws + O_MODC) + (size_t)((l * 9 + row_batch(row)) * 6) * DM;
    const bf16_t* O = (const bf16_t*)(p.ws + O_OUT) + (size_t)row * DM; const float* rs = resid_src(p, l, row); float* X = (float*)(p.ws + O_X) + (size_t)row * DM; bf16_t* H = (bf16_t*)(p.ws + O_H) + (size_t)row * DM;
    u32x2 ov[8]; f32x4 xv[8], a1[8], a2[8], shv[8];
#pragma unroll
    for (int j = 0; j < 8; ++j) { const int c = ROWCOL(j, lane); ov[j] = *(const u32x2*)(O + c); xv[j] = ld_xrow(p, l, row, c); a1[j] = ld_mc(p, l, row, 0, c); a2[j] = ld_mc(p, l, row, 1, c); shv[j] = ld_mc(p, l, row, 2, c); }
    float o[32]; float ss = 0.f;
#pragma unroll
    for (int j = 0; j < 8; ++j) { o[j * 4] = __uint_as_float(ov[j].x << 16); o[j * 4 + 1] = __uint_as_float(ov[j].x & 0xffff0000u); o[j * 4 + 2] = __uint_as_float(ov[j].y << 16); o[j * 4 + 3] = __uint_as_float(ov[j].y & 0xffff0000u); }
#pragma unroll
    for (int i = 0; i < 32; ++i) ss += o[i] * o[i];
    const float r1 = rsqrtf(wave_sum(ss) * (1.0f / DM) + EPS); float s2 = 0.f;
#pragma unroll
    for (int j = 0; j < 8; ++j) { const int c = ROWCOL(j, lane);
#pragma unroll
        for (int q = 0; q < 4; ++q) { xv[j][q] += a1[j][q] * (o[j * 4 + q] * r1); s2 += xv[j][q] * xv[j][q]; }
        st_xrow(p, row, c, xv[j]); }
    const float r2 = rsqrtf(wave_sum(s2) * (1.0f / DM) + EPS);
#pragma unroll
    for (int j = 0; j < 8; ++j) { const int c = ROWCOL(j, lane); f32x4 f;
#pragma unroll
        for (int q = 0; q < 4; ++q) f[q] = xv[j][q] * r2 * a2[j][q] + shv[j][q];
#if MOE_FP8
        *(unsigned*)((unsigned char*)(p.ws + O_H) + (size_t)row * DM + c) = pk4_fp8(f[0], f[1], f[2], f[3]);
#else
        u32x2 w; w.x = pk2(f[0], f[1]); w.y = pk2(f[2], f[3]); *(u32x2*)(H + c) = w;
#endif
#if ROUTER_X3
        { float fl[4]; u32x2 wh, wl; wh.x = pk2(f[0], f[1]); wh.y = pk2(f[2], f[3]);
          fl[0] = f[0] - __uint_as_float(wh.x << 16); fl[1] = f[1] - __uint_as_float(wh.x & 0xffff0000u); fl[2] = f[2] - __uint_as_float(wh.y << 16); fl[3] = f[3] - __uint_as_float(wh.y & 0xffff0000u);
          wl.x = pk2(fl[0], fl[1]); wl.y = pk2(fl[2], fl[3]);
          *(LAS u32x2*)((LAS bf16_t*)fdst + c) = wh; *(LAS u32x2*)((LAS bf16_t*)fdst + 16 * RT_HS + c) = wl; }
#else
        *(LAS f32x4*)(fdst + c) = f;
#endif
    }
}
#if RC8
__device__ __forceinline__ void route_row_pre8(const Params& p, int l, int row, int lane, LAS float* fdst) {
    const bf16_t* O = (const bf16_t*)(p.ws + O_OUT) + (size_t)row * DM; const bf16_t* MC = (const bf16_t*)(p.ws + O_MODC) + (size_t)((l * 9 + row_batch(row)) * 6) * DM;
    bf16_t* Xb = (bf16_t*)(p.ws + O_X) + (size_t)row * DM;
    u32x4 ov[4], xb[4], a1b[4], a2b[4], shb[4]; f32x4 xf[4][2];
#pragma unroll
    for (int j = 0; j < 4; ++j) { const int c = j * 512 + lane * 8; ov[j] = LDNT(u32x4, O + c); a1b[j] = *(const u32x4*)(MC + c); a2b[j] = *(const u32x4*)(MC + DM + c); shb[j] = *(const u32x4*)(MC + 2 * DM + c);
#if NT2 & 16
        if (l == 0) { const float* rs = resid_src(p, 0, row); xf[j][0] = __builtin_nontemporal_load((const f32x4*)(rs + c)); xf[j][1] = __builtin_nontemporal_load((const f32x4*)(rs + c + 4)); } else xb[j] = LDNT(u32x4, Xb + c); }
#else
        if (l == 0) { const float* rs = resid_src(p, 0, row); xf[j][0] = *(const f32x4*)(rs + c); xf[j][1] = *(const f32x4*)(rs + c + 4); } else xb[j] = *(const u32x4*)(Xb + c); }
#endif
    float o[32], x[32]; float ss = 0.f;
#pragma unroll
    for (int j = 0; j < 4; ++j) { float t[8]; unpack8(ov[j], t);
#pragma unroll
        for (int q = 0; q < 8; ++q) { o[j * 8 + q] = t[q]; ss += t[q] * t[q]; } }
    const float r1 = rsqrtf(wave_sum(ss) * (1.0f / DM) + EPS); float s2 = 0.f;
#pragma unroll
    for (int j = 0; j < 4; ++j) { const int c = j * 512 + lane * 8; float xx[8], a[8], t[8]; unpack8(a1b[j], a);
        if (l == 0) {
#pragma unroll
            for (int q = 0; q < 4; ++q) { xx[q] = xf[j][0][q]; xx[4 + q] = xf[j][1][q]; } }
        else unpack8(xb[j], xx);
#pragma unroll
        for (int q = 0; q < 8; ++q) { t[q] = xx[q] + a[q] * (o[j * 8 + q] * r1); x[j * 8 + q] = t[q]; s2 += t[q] * t[q]; }
        STNT(u32x4, Xb + c, pack8(t)); }
    const float r2 = rsqrtf(wave_sum(s2) * (1.0f / DM) + EPS);
#pragma unroll
    for (int j = 0; j < 4; ++j) { const int c = j * 512 + lane * 8; float a2[8], sh[8], f[8], fl[8]; unpack8(a2b[j], a2); unpack8(shb[j], sh);
#pragma unroll
        for (int q = 0; q < 8; ++q) f[q] = x[j * 8 + q] * r2 * a2[q] + sh[q];
        u32x2 w8; w8.x = pk4_fp8(f[0], f[1], f[2], f[3]); w8.y = pk4_fp8(f[4], f[5], f[6], f[7]);
        *(u32x2*)((unsigned char*)(p.ws + O_H) + (size_t)row * DM + c) = w8;
        const u32x4 wh = pack8(f); float th[8]; unpack8(wh, th);
#pragma unroll
        for (int q = 0; q < 8; ++q) fl[q] = f[q] - th[q];
        *(LAS u32x4*)((LAS bf16_t*)fdst + c) = wh; *(LAS u32x4*)((LAS bf16_t*)fdst + 16 * RT_HS + c) = pack8(fl); }
}
#ifndef ROUTE2
#define ROUTE2 0
#endif
#if ROUTE2
__device__ __forceinline__ void route_rows_pre8(const Params& p, int l, int row0, int lane, LAS float* fdst0) {
    const bf16_t* MC = (const bf16_t*)(p.ws + O_MODC) + (size_t)((l * 9 + row_batch(row0)) * 6) * DM;
    u32x4 ov[2][4], a1b[4], a2b[4], shb[4];
#pragma unroll
    for (int j = 0; j < 4; ++j) { const int c = j * 512 + lane * 8; a1b[j] = *(const u32x4*)(MC + c); a2b[j] = *(const u32x4*)(MC + DM + c); shb[j] = *(const u32x4*)(MC + 2 * DM + c); }
#pragma unroll
    for (int rr = 0; rr < 2; ++rr) { const int row = row0 + rr; const bf16_t* O = (const bf16_t*)(p.ws + O_OUT) + (size_t)row * DM; const bf16_t* Xb = (const bf16_t*)(p.ws + O_X) + (size_t)row * DM;
#pragma unroll
        for (int j = 0; j < 4; ++j) { const int c = j * 512 + lane * 8; ov[rr][j] = *(const u32x4*)(O + c); } (void)Xb; }
#pragma unroll
    for (int rr = 0; rr < 2; ++rr) { const int row = row0 + rr; bf16_t* Xb = (bf16_t*)(p.ws + O_X) + (size_t)row * DM; LAS float* fdst = (LAS float*)((LAS bf16_t*)fdst0 + rr * RT_HS);
        u32x4 xb[4]; f32x4 xf[4][2];
#pragma unroll
        for (int j = 0; j < 4; ++j) { const int c = j * 512 + lane * 8;
            if (l == 0) { const float* rs = resid_src(p, 0, row); xf[j][0] = *(const f32x4*)(rs + c); xf[j][1] = *(const f32x4*)(rs + c + 4); } else xb[j] = *(const u32x4*)(Xb + c); }
        float o[32], x[32]; float ss = 0.f;
#pragma unroll
        for (int j = 0; j < 4; ++j) { float t[8]; unpack8(ov[rr][j], t);
#pragma unroll
            for (int q = 0; q < 8; ++q) { o[j * 8 + q] = t[q]; ss += t[q] * t[q]; } }
        const float r1 = rsqrtf(wave_sum(ss) * (1.0f / DM) + EPS); float s2 = 0.f;
#pragma unroll
        for (int j = 0; j < 4; ++j) { const int c = j * 512 + lane * 8; float xx[8], a[8], t[8]; unpack8(a1b[j], a);
            if (l == 0) {
#pragma unroll
                for (int q = 0; q < 4; ++q) { xx[q] = xf[j][0][q]; xx[4 + q] = xf[j][1][q]; } }
            else unpack8(xb[j], xx);
#pragma unroll
            for (int q = 0; q < 8; ++q) { t[q] = xx[q] + a[q] * (o[j * 8 + q] * r1); x[j * 8 + q] = t[q]; s2 += t[q] * t[q]; }
            *(u32x4*)(Xb + c) = pack8(t); }
        const float r2 = rsqrtf(wave_sum(s2) * (1.0f / DM) + EPS);
#pragma unroll
        for (int j = 0; j < 4; ++j) { const int c = j * 512 + lane * 8; float a2[8], sh[8], f[8], fl[8]; unpack8(a2b[j], a2); unpack8(shb[j], sh);
#pragma unroll
            for (int q = 0; q < 8; ++q) f[q] = x[j * 8 + q] * r2 * a2[q] + sh[q];
            u32x2 w8; w8.x = pk4_fp8(f[0], f[1], f[2], f[3]); w8.y = pk4_fp8(f[4], f[5], f[6], f[7]);
            *(u32x2*)((unsigned char*)(p.ws + O_H) + (size_t)row * DM + c) = w8;
            const u32x4 wh = pack8(f); float th[8]; unpack8(wh, th);
#pragma unroll
            for (int q = 0; q < 8; ++q) fl[q] = f[q] - th[q];
            *(LAS u32x4*)((LAS bf16_t*)fdst + c) = wh; *(LAS u32x4*)((LAS bf16_t*)fdst + 16 * RT_HS + c) = pack8(fl); } }
}
#endif
__device__ __forceinline__ void norm1_row_c8(const Params& p, int l, int row, const float (&x)[32], int lane) {
    const bf16_t* MC = (const bf16_t*)(p.ws + O_MODC) + (size_t)((l * 9 + row_batch(row)) * 6 + 4) * DM; u32x4 a4b[4], a5b[4];
#pragma unroll
    for (int j = 0; j < 4; ++j) { const int c = j * 512 + lane * 8; a4b[j] = *(const u32x4*)(MC + c); a5b[j] = *(const u32x4*)(MC + DM + c); }
    float ss = 0.f;
#pragma unroll
    for (int i = 0; i < 32; ++i) ss += x[i] * x[i];
    ss = wave_sum(ss); const float rstd = rsqrtf(ss * (1.0f / DM) + EPS);
    bf16_t* H = (bf16_t*)(p.ws + O_H) + (size_t)row * DM;
#pragma unroll
    for (int j = 0; j < 4; ++j) { const int c = j * 512 + lane * 8; float a4[8], a5[8], h[8]; unpack8(a4b[j], a4); unpack8(a5b[j], a5);
#pragma unroll
        for (int q = 0; q < 8; ++q) h[q] = x[j * 8 + q] * rstd * a4[q] + a5[q];
        *(u32x4*)(H + c) = pack8(h); }
}
#endif
__device__ __forceinline__ void route_row_topk(const Params& p, int l, int row, int lane, float logit, LAS unsigned* cntL) {
    const float score = 1.0f / (1.0f + expf(-logit)), biased = score + p.in[I_RB][l * 64 + lane];
    float m1 = biased; m1 = fmaxf(m1, __shfl_xor(m1, 1)); m1 = fmaxf(m1, __shfl_xor(m1, 2)); m1 = fmaxf(m1, __shfl_xor(m1, 4));
    const unsigned long long bal = __ballot(biased == m1); const int first = __builtin_ctz((unsigned)((bal >> (lane & ~7)) & 0xffull));
    float m2 = ((lane & 7) == first) ? -INFINITY : biased; m2 = fmaxf(m2, __shfl_xor(m2, 1)); m2 = fmaxf(m2, __shfl_xor(m2, 2)); m2 = fmaxf(m2, __shfl_xor(m2, 4));
    const float gs = m1 + m2; const int grp = lane >> 3; int rank = 0;
#pragma unroll
    for (int q = 0; q < 8; ++q) { const float v = rdlane(gs, q * 8); rank += (v > gs || (v == gs && q < grp)) ? 1 : 0; }
    const float cand = (rank < 4) ? biased : -INFINITY; int re = 0;
    for (int q = 0; q < 64; ++q) { const float v = rdlane(cand, q); re += (v > cand || (v == cand && q < lane)) ? 1 : 0; }
    const bool sel = re < TOPK; const float ssum = wave_sum(sel ? score : 0.f);
    if (sel) { ((int*)(p.ws + O_EIDX))[(size_t)row * 8 + re] = lane; ((float*)(p.ws + O_GATE))[(size_t)row * 8 + re] = score / ssum * 2.5f;
        ((int*)(p.ws + O_SLOT))[(size_t)row * 8 + re] = (int)__hip_atomic_fetch_add(&cntL[lane], 1u, __ATOMIC_RELAXED, __HIP_MEMORY_SCOPE_WORKGROUP); }
}
__device__ __forceinline__ void phase_route(const Params& p, int l, LAS unsigned char* lds) {
    const int tid = otid(), wid = __builtin_amdgcn_readfirstlane(tid >> 6), lane0 = tid & 63; const bool last = (l == NLAYER - 1); const int NR = last ? NLAT : NTOK;
    LAS float* frow = (LAS float*)lds; LAS float* part = frow;
    const float* g1 = p.in[I_NORMG] + (size_t)(l * 4 + 1) * DM; const float* g2 = p.in[I_NORMG] + (size_t)(l * 4 + 2) * DM;
    const float* RW = p.in[I_RW] + (size_t)l * DM * NEXP; LAS unsigned* cntL = (LAS unsigned*)(lds + LDS_CNTL);
    if (tid < 64) cntL[tid] = 0u;
    { int* stok = (int*)(p.ws + O_STOK); for (int i = blockIdx.x * NTHREADS + tid; i < NSLOTS; i += gridDim.x * NTHREADS) stok[i] = (i < RSLOTS) ? -1 : ((i - RSLOTS) < NR ? i - RSLOTS : -1); }
    for (int g = blockIdx.x; g < NR / 16; g += gridDim.x) {
        int lane = lane0; asm volatile("" : "+v"(lane));
#if ROUTER_X3
#if RC8
#if ROUTE2
        route_rows_pre8(p, l, g * 16 + wid * 2, lane, (LAS float*)((LAS bf16_t*)lds + (wid * 2) * RT_HS));
#else
        for (int rr = 0; rr < 2; ++rr) route_row_pre8(p, l, g * 16 + wid * 2 + rr, lane, (LAS float*)((LAS bf16_t*)lds + (wid * 2 + rr) * RT_HS));
#endif
#else
        for (int rr = 0; rr < 2; ++rr) route_row_pre(p, l, g * 16 + wid * 2 + rr, lane, (LAS float*)((LAS bf16_t*)lds + (wid * 2 + rr) * RT_HS), g1, g2);
#endif
        __syncthreads();
        f32x4 acc[4];
#pragma unroll
        for (int j = 0; j < 4; ++j) acc[j] = (f32x4){0.f, 0.f, 0.f, 0.f};
        { const int r16 = lane & 15, kq = lane >> 4; const LAS bf16_t* fh = (const LAS bf16_t*)lds + r16 * RT_HS + wid * 256 + 8 * kq; const LAS bf16_t* fl = fh + 16 * RT_HS;
          const bf16_t* wh = (const bf16_t*)(p.ws + O_RW2) + (size_t)(l * 2) * NEXP * DM + (size_t)wid * (8 * 4 * 64 * 8) + lane * 8; const bf16_t* wl = wh + (size_t)NEXP * DM;
#pragma unroll 2
          for (int st = 0; st < 8; ++st) { const bf16x8 ah = *(const LAS bf16x8*)(fh + 32 * st), al = *(const LAS bf16x8*)(fl + 32 * st); bf16x8 bh[4], bl[4];
#pragma unroll
              for (int eg = 0; eg < 4; ++eg) { bh[eg] = *(const bf16x8*)(wh + (st * 4 + eg) * 512); bl[eg] = *(const bf16x8*)(wl + (st * 4 + eg) * 512); }
#pragma unroll
              for (int eg = 0; eg < 4; ++eg) { acc[eg] = __builtin_amdgcn_mfma_f32_16x16x32_bf16(ah, bh[eg], acc[eg], 0, 0, 0); acc[eg] = __builtin_amdgcn_mfma_f32_16x16x32_bf16(ah, bl[eg], acc[eg], 0, 0, 0); acc[eg] = __builtin_amdgcn_mfma_f32_16x16x32_bf16(al, bh[eg], acc[eg], 0, 0, 0); } }
          __syncthreads();
#pragma unroll
          for (int eg = 0; eg < 4; ++eg)
#pragma unroll
              for (int r = 0; r < 4; ++r) part[(wid * 16 + 4 * kq + r) * 64 + 16 * eg + r16] = acc[eg][r]; }
#else
        for (int rr = 0; rr < 2; ++rr) route_row_pre(p, l, g * 16 + wid * 2 + rr, lane, frow + (wid * 2 + rr) * RT_FS, g1, g2);
        __syncthreads();
        f32x4 acc[4];
#pragma unroll
        for (int j = 0; j < 4; ++j) acc[j] = (f32x4){0.f, 0.f, 0.f, 0.f};
        { const int r16 = lane & 15, kq = lane >> 4; const LAS float* fa = frow + r16 * RT_FS + wid * 256 + 4 * kq; const float* rb = RW + (size_t)(wid * 256 + 4 * kq) * 64 + 4 * r16;
#pragma unroll 2
          for (int st = 0; st < 16; ++st) { const f32x4 a = *(const LAS f32x4*)(fa + 16 * st); f32x4 b[4];
#pragma unroll
              for (int i = 0; i < 4; ++i) b[i] = *(const f32x4*)(rb + (size_t)(16 * st + i) * 64);
#pragma unroll
              for (int i = 0; i < 4; ++i)
#pragma unroll
                  for (int j = 0; j < 4; ++j) acc[j] = __builtin_amdgcn_mfma_f32_16x16x4f32(a[i], b[i][j], acc[j], 0, 0, 0); }
          __syncthreads();
#pragma unroll
          for (int r = 0; r < 4; ++r) *(LAS f32x4*)(part + (wid * 16 + 4 * kq + r) * 64 + 4 * r16) = (f32x4){acc[0][r], acc[1][r], acc[2][r], acc[3][r]}; }
#endif
        __syncthreads();
        for (int rr = 0; rr < 2; ++rr) { const int r16 = wid * 2 + rr; float logit = 0.f;
#pragma unroll
            for (int w = 0; w < 8; ++w) logit += part[(w * 16 + r16) * 64 + lane];
            route_row_topk(p, l, g * 16 + r16, lane, logit, cntL); }
        __syncthreads();
    }
    __syncthreads();
    if (tid < 64) ((unsigned*)(p.ws + O_WCNT))[blockIdx.x * 64 + tid] = cntL[tid];
}
__device__ __forceinline__ void phase_place(const Params& p, int l, LAS unsigned char* lds) {
    const int tid = otid(); const int NR = (l == NLAYER - 1) ? NLAT : NTOK, G = gridDim.x;
    LAS int* woff = (LAS int*)lds; LAS int* csum = woff + 512 * 64; LAS int* pstart = csum + 8 * 64;
    const unsigned* wcnt = (const unsigned*)(p.ws + O_WCNT);
    for (int i = tid; i < G * 64; i += NTHREADS) woff[i] = (int)wcnt[i];
    __syncthreads();
    { const int e = tid & 63, ch = tid >> 6, cs = (G + 7) >> 3, w0 = ch * cs, w1 = (w0 + cs < G) ? w0 + cs : G; int run = 0;
      for (int w = w0; w < w1; ++w) { const int t = woff[w * 64 + e]; woff[w * 64 + e] = run; run += t; }
      csum[ch * 64 + e] = run;
      __syncthreads();
      int base = 0, tot = 0;
#pragma unroll
      for (int c2 = 0; c2 < 8; ++c2) { const int v = csum[c2 * 64 + e]; if (c2 < ch) base += v; tot += v; }
      for (int w = w0; w < w1; ++w) woff[w * 64 + e] += base;
      if (tid < 64) { const int ntile = (tot + 255) >> 8; pstart[tid] = (wave_incl_scan(ntile, tid) - ntile) * 256;
          if (blockIdx.x == 0) ((unsigned*)(p.ws + O_CTL))[CW_CNT + l * 64 + tid] = (unsigned)tot; } }
    __syncthreads();
    const int* eidx = (const int*)(p.ws + O_EIDX); int* slot = (int*)(p.ws + O_SLOT); int* stok = (int*)(p.ws + O_STOK);
    for (int i = blockIdx.x * NTHREADS + tid; i < NR * TOPK; i += G * NTHREADS) { const int row = i / TOPK, k = i % TOPK, e = eidx[(size_t)row * 8 + k], wg = (row >> 4) % G;
        const int s = pstart[e] + woff[wg * 64 + e] + slot[(size_t)row * 8 + k]; slot[(size_t)row * 8 + k] = s; stok[s] = row; }
    __syncthreads();
}
__device__ __forceinline__ void phase_final(const Params& p, int l) {
    const int lane = otid() & 63, gw = blockIdx.x * 8 + owid(), GW = gridDim.x * 8; const bool last = (l == NLAYER - 1); const int NR = last ? NLAT : NTOK;
    const bf16_t* DO = (const bf16_t*)(p.ws + O_DOUT);
    const int lane0 = lane;
    for (int row = gw; row < NR; row += GW) {
        int lane = lane0; asm volatile("" : "+v"(lane));
        const int sl = (lane < TOPK) ? ((const int*)(p.ws + O_SLOT))[(size_t)row * 8 + lane] : 0; const float gl = (lane < TOPK) ? ((const float*)(p.ws + O_GATE))[(size_t)row * 8 + lane] : 0.f;
#if RC8 && DOUT_FP8
        {
            bf16_t* Xb = (bf16_t*)(p.ws + O_X) + (size_t)row * DM; const bf16_t* M3 = (const bf16_t*)(p.ws + O_MODC) + (size_t)((l * 9 + row_batch(row)) * 6 + 3) * DM;
            u32x4 xb[4], a3b[4]; u32x2 v[7][4]; float gt[7]; const unsigned char* DO8 = p.ws + O_DOUT;
#pragma unroll
            for (int j = 0; j < 4; ++j) { const int c = j * 512 + lane * 8; xb[j] = LDNT(u32x4, Xb + c); a3b[j] = *(const u32x4*)(M3 + c); }
#pragma unroll
            for (int k = 0; k < 7; ++k) { const int s = (k == 0) ? RSLOTS + row : __builtin_amdgcn_readlane(sl, k - 1); const unsigned char* src = DO8 + (size_t)s * DM; gt[k] = ((k == 0) ? 1.0f : rdlane(gl, k - 1)) * (1.0f / DOUT8_SCALE);
#pragma unroll
                for (int j = 0; j < 4; ++j) v[k][j] = LDNT(u32x2, src + j * 512 + lane * 8); }
            float y[32];
#pragma unroll
            for (int i = 0; i < 32; ++i) y[i] = 0.f;
#pragma unroll
            for (int k = 0; k < 7; ++k)
#pragma unroll
                for (int j = 0; j < 4; ++j) { typedef float f32x2v __attribute__((ext_vector_type(2)));
                    const f32x2v l0 = __builtin_amdgcn_cvt_pk_f32_fp8((int)v[k][j].x, false), h0 = __builtin_amdgcn_cvt_pk_f32_fp8((int)v[k][j].x, true), l1 = __builtin_amdgcn_cvt_pk_f32_fp8((int)v[k][j].y, false), h1 = __builtin_amdgcn_cvt_pk_f32_fp8((int)v[k][j].y, true);
                    y[j * 8] += gt[k] * l0.x; y[j * 8 + 1] += gt[k] * l0.y; y[j * 8 + 2] += gt[k] * h0.x; y[j * 8 + 3] += gt[k] * h0.y; y[j * 8 + 4] += gt[k] * l1.x; y[j * 8 + 5] += gt[k] * l1.y; y[j * 8 + 6] += gt[k] * h1.x; y[j * 8 + 7] += gt[k] * h1.y; }
            float ss = 0.f;
#pragma unroll
            for (int i = 0; i < 32; ++i) ss += y[i] * y[i];
            const float r = rsqrtf(wave_sum(ss) * (1.0f / DM) + EPS); float x[32];
#pragma unroll
            for (int j = 0; j < 4; ++j) { const int c = j * 512 + lane * 8; float xx[8], a3[8], t[8]; unpack8(xb[j], xx); unpack8(a3b[j], a3);
#pragma unroll
                for (int q = 0; q < 8; ++q) { t[q] = xx[q] + a3[q] * (y[j * 8 + q] * r); x[j * 8 + q] = t[q]; }
#if NT2 & 32
                if (last) { __builtin_nontemporal_store((f32x4){t[0], t[1], t[2], t[3]}, (f32x4*)(p.out + (size_t)row * DM + c)); __builtin_nontemporal_store((f32x4){t[4], t[5], t[6], t[7]}, (f32x4*)(p.out + (size_t)row * DM + c + 4)); }
#else
                if (last) { *(f32x4*)(p.out + (size_t)row * DM + c) = (f32x4){t[0], t[1], t[2], t[3]}; *(f32x4*)(p.out + (size_t)row * DM + c + 4) = (f32x4){t[4], t[5], t[6], t[7]}; }
#endif
                else STNT(u32x4, Xb + c, pack8(t)); }
            if (!last) norm1_row_c8(p, l + 1, row, x, lane);
            continue;
        }
#endif
        f32x4 xv[8], a3[8];
        { const float* Xr = (const float*)(p.ws + O_X) + (size_t)row * DM; const float* m3 = (const float*)(p.ws + O_MODC) + (size_t)((l * 9 + row_batch(row)) * 6 + 3) * DM;
#pragma unroll
          for (int j = 0; j < 8; ++j) { xv[j] = XB16 ? ld_xrow(p, 1, row, ROWCOL(j, lane)) : *(const f32x4*)(Xr + ROWCOL(j, lane)); a3[j] = ld_mc(p, l, row, 3, ROWCOL(j, lane)); } }
        float y[32];
#pragma unroll
        for (int i = 0; i < 32; ++i) y[i] = 0.f;
#if DOUT_FP8
        { const unsigned char* DO8 = p.ws + O_DOUT; unsigned v[7][8]; float gt[7];
#pragma unroll
          for (int k = 0; k < 7; ++k) { const int s = (k == 0) ? RSLOTS + row : __builtin_amdgcn_readlane(sl, k - 1); const unsigned char* src = DO8 + (size_t)s * DM; gt[k] = ((k == 0) ? 1.0f : rdlane(gl, k - 1)) * (1.0f / DOUT8_SCALE);
#pragma unroll
              for (int j = 0; j < 8; ++j) v[k][j] = *(const unsigned*)(src + ROWCOL(j, lane)); }
#pragma unroll
          for (int k = 0; k < 7; ++k)
#pragma unroll
              for (int j = 0; j < 8; ++j) { typedef float f32x2v __attribute__((ext_vector_type(2))); const f32x2v lo = __builtin_amdgcn_cvt_pk_f32_fp8((int)v[k][j], false), hi = __builtin_amdgcn_cvt_pk_f32_fp8((int)v[k][j], true);
                  y[j * 4] += gt[k] * lo.x; y[j * 4 + 1] += gt[k] * lo.y; y[j * 4 + 2] += gt[k] * hi.x; y[j * 4 + 3] += gt[k] * hi.y; } }
#else
#pragma unroll
        for (int kb = 0; kb < 7; kb += 4) {
            u32x2 v[4][8]; float gt[4];
#pragma unroll
            for (int kk = 0; kk < 4; ++kk) { const int k = kb + kk; if (k < 7) { const int s = (k == 0) ? RSLOTS + row : __builtin_amdgcn_readlane(sl, k - 1); const bf16_t* src = DO + (size_t)s * DM; gt[kk] = (k == 0) ? 1.0f : rdlane(gl, k - 1);
#pragma unroll
                for (int j = 0; j < 8; ++j) v[kk][j] = *(const u32x2*)(src + ROWCOL(j, lane)); } }
#pragma unroll
            for (int kk = 0; kk < 4; ++kk) { if (kb + kk < 7) {
#pragma unroll
                for (int j = 0; j < 8; ++j) { const float g = gt[kk]; y[j * 4] += g * __uint_as_float(v[kk][j].x << 16); y[j * 4 + 1] += g * __uint_as_float(v[kk][j].x & 0xffff0000u); y[j * 4 + 2] += g * __uint_as_float(v[kk][j].y << 16); y[j * 4 + 3] += g * __uint_as_float(v[kk][j].y & 0xffff0000u); } } }
        }
#endif
        float ss = 0.f;
#pragma unroll
        for (int i = 0; i < 32; ++i) ss += y[i] * y[i];
        const float r = rsqrtf(wave_sum(ss) * (1.0f / DM) + EPS);
        float* X = (float*)(p.ws + O_X) + (size_t)row * DM; float x[32];
#pragma unroll
        for (int j = 0; j < 8; ++j) { const int c = ROWCOL(j, lane); f32x4 xn;
#pragma unroll
            for (int q = 0; q < 4; ++q) { xn[q] = xv[j][q] + a3[j][q] * (y[j * 4 + q] * r); x[j * 4 + q] = xn[q]; }
            if (last) *(f32x4*)(p.out + (size_t)row * DM + c) = xn; else st_xrow(p, row, c, xn); }
        if (!last) norm1_row_c(p, l + 1, row, x, lane);
    }
}

#define XB_TMO      128
#define XB_XCNT(j)  (256  + 64 * (j))
#define XB_XSUB(j)  (1280 + 64 * (j))
#define XB_XGEN(j)  (2304 + 64 * (j))
#define XB_TOP      3328
#define XB_TOPGEN   3392
#define XCD_BAR_WORDS 3456
#define XB_SPIN_CAP (1u << 23)

__device__ __forceinline__ unsigned xb_ld(unsigned* p)              { return __hip_atomic_load(p, __ATOMIC_RELAXED, __HIP_MEMORY_SCOPE_AGENT); }
__device__ __forceinline__ unsigned xb_add(unsigned* p, unsigned v) { return __hip_atomic_fetch_add(p, v, __ATOMIC_RELAXED, __HIP_MEMORY_SCOPE_AGENT); }
__device__ __forceinline__ unsigned xb_xcc_id() { return (unsigned)__builtin_amdgcn_s_getreg((3 << 11) | 20) & 0xFu; }
#define XB_SPIN(cond, bar) do { unsigned _sp = 0; while (cond) { __builtin_amdgcn_s_sleep(1); \
    if ((++_sp & 255u) == 0u) { if (xb_ld(&(bar)[XB_TMO])) break; if (_sp > XB_SPIN_CAP) { atomicAdd(&(bar)[XB_TMO], 1u); break; } } } } while (0)

struct XcdBarrier {
    unsigned* bar; unsigned x;
    volatile LAS unsigned* st;
};

__device__ __forceinline__ XcdBarrier xcd_barrier_post(unsigned* bar, volatile LAS unsigned* st) {
    XcdBarrier b; b.bar = bar; b.x = xb_xcc_id(); b.st = st;
    if (threadIdx.x == 0) (void)xb_add(&bar[XB_XCNT(b.x)], 1u);
    return b;
}
__device__ __forceinline__ void xcd_barrier_complete(unsigned* bar, unsigned x, unsigned& nloc, unsigned& nx) {
    const unsigned G = gridDim.x * gridDim.y * gridDim.z;
    unsigned sum, cnt, mine, sp = 0u;
    for (;;) {
        sum = 0u; cnt = 0u; mine = 0u;
#pragma unroll
        for (unsigned j = 0; j < 16; ++j) { const unsigned c = xb_ld(&bar[XB_XCNT(j)]); sum += c; cnt += (c > 0u) ? 1u : 0u; mine = (j == x) ? c : mine; }
        if (sum == G) break;
        __builtin_amdgcn_s_sleep(1);
        if ((++sp & 255u) == 0u) { if (xb_ld(&bar[XB_TMO])) break; if (sp > XB_SPIN_CAP) { atomicAdd(&bar[XB_TMO], 1u); break; } }
    }
    nloc = mine > 0u ? mine : 1u; nx = cnt > 0u ? cnt : 1u;
}

__device__ __forceinline__ void xcd_barrier(const XcdBarrier& b) {
    asm volatile("s_waitcnt vmcnt(0)" ::: "memory");
    __syncthreads();
    if (threadIdx.x == 0) {
        unsigned* bar = b.bar;
        __builtin_amdgcn_s_waitcnt(0);
        unsigned nloc = b.st[0], nx = b.st[1];
        if (nloc == 0u) { xcd_barrier_complete(bar, b.x, nloc, nx); b.st[0] = nloc; b.st[1] = nx; }
        const unsigned old = xb_add(&bar[XB_XSUB(b.x)], 1u);
        const unsigned gen = old / nloc;
        if (old + 1u == (gen + 1u) * nloc) {
            __builtin_amdgcn_fence(__ATOMIC_RELEASE, "agent");
            asm volatile("s_waitcnt vmcnt(0)" ::: "memory");
            const unsigned og = xb_add(&bar[XB_TOP], 1u);
            const unsigned tg = og / nx;
            if (og + 1u == (tg + 1u) * nx) xb_add(&bar[XB_TOPGEN], 1u);
            else XB_SPIN(xb_ld(&bar[XB_TOPGEN]) == tg, bar);
            __builtin_amdgcn_fence(__ATOMIC_ACQUIRE, "agent");
            xb_add(&bar[XB_XGEN(b.x)], 1u);
            asm volatile("s_waitcnt vmcnt(0)" ::: "memory");
        } else {
            XB_SPIN(xb_ld(&bar[XB_XGEN(b.x)]) == gen, bar);
            __builtin_amdgcn_fence(__ATOMIC_ACQUIRE, "agent");
            asm volatile("s_waitcnt vmcnt(0)" ::: "memory");
        }
    }
    __syncthreads();
}


#if CVT_BG
__device__ __forceinline__ void xcd_barrier_work(const XcdBarrier& b, LAS unsigned char* lds) {
    volatile LAS unsigned* fl = (volatile LAS unsigned*)(lds + LDS_BGFLAG);
    asm volatile("s_waitcnt vmcnt(0)" ::: "memory");
    __syncthreads();
    if (threadIdx.x == 0) {
        unsigned* bar = b.bar;
        __builtin_amdgcn_s_waitcnt(0);
        unsigned nloc = b.st[0], nx = b.st[1];
        if (nloc == 0u) { xcd_barrier_complete(bar, b.x, nloc, nx); b.st[0] = nloc; b.st[1] = nx; }
        const unsigned old = xb_add(&bar[XB_XSUB(b.x)], 1u);
        const unsigned gen = old / nloc;
        if (old + 1u == (gen + 1u) * nloc) {
            __builtin_amdgcn_fence(__ATOMIC_RELEASE, "agent");
            asm volatile("s_waitcnt vmcnt(0)" ::: "memory");
            const unsigned og = xb_add(&bar[XB_TOP], 1u);
            const unsigned tg = og / nx;
            if (og + 1u == (tg + 1u) * nx) xb_add(&bar[XB_TOPGEN], 1u);
            else XB_SPIN(xb_ld(&bar[XB_TOPGEN]) == tg, bar);
            __builtin_amdgcn_fence(__ATOMIC_ACQUIRE, "agent");
            xb_add(&bar[XB_XGEN(b.x)], 1u);
            asm volatile("s_waitcnt vmcnt(0)" ::: "memory");
            fl[0] = 0xFFFFFFFFu;
        } else fl[0] = gen;
    }
    __syncthreads();
    const unsigned gen = fl[0];
    if (gen != 0xFFFFFFFFu) {
        unsigned sp = 0u;
        for (;;) {
            if (threadIdx.x == 0) { unsigned rel = (xb_ld(&b.bar[XB_XGEN(b.x)]) != gen) ? 1u : 0u;
                if (!rel && (++sp & 255u) == 0u) { if (xb_ld(&b.bar[XB_TMO])) rel = 1u; else if (sp > XB_SPIN_CAP) { atomicAdd(&b.bar[XB_TMO], 1u); rel = 1u; } }
                fl[1] = rel; }
            __syncthreads();
            const unsigned rel = fl[1];
            __syncthreads();
            if (rel) break;
            if (!((BG_TWO & 1) ? cvt_bg_step2(lds, 2 * CVT_EXP) : cvt_bg_step(lds, 2 * CVT_EXP))) __builtin_amdgcn_s_sleep(1);
        }
        if (threadIdx.x == 0) { __builtin_amdgcn_fence(__ATOMIC_ACQUIRE, "agent"); asm volatile("s_waitcnt vmcnt(0)" ::: "memory"); }
    }
    __syncthreads();
}
#endif

enum { PH_PRO = 0, PH_NORM1, PH_WIN, PH_POSTA, PH_POSTB, PH_MIXER, PH_HYFIN, PH_WOUT, PH_ROUTE, PH_PLACE, PH_GEMM1, PH_GEMM2, PH_FINAL, PH_COUNT };

template <int PH>
__device__ __forceinline__ void run_phase(const Params& p_in, int l, LAS unsigned char* lds) {
#if MEGA
    const __attribute__((address_space(4))) Params* kp = (const __attribute__((address_space(4))) Params*)__builtin_amdgcn_kernarg_segment_ptr(); asm volatile("" : "+s"(kp)); (void)p_in;
    Params p;
#pragma unroll
    for (int i_ = 0; i_ < 31; ++i_) p.in[i_] = kp->in[i_];
    p.out = kp->out; p.ws = kp->ws; p.layer = 0; p.pad = 0;
#else
    Params p = p_in; { unsigned char* w = p.ws; asm volatile("" : "+s"(w)); p.ws = w; }
#endif
    unsigned char* ws = p.ws; const bool last = (l == NLAYER - 1);
    const int gw = blockIdx.x * 8 + owid(), GW = gridDim.x * 8, lane = otid() & 63;
    if constexpr (PH == PH_PRO) { phase_prologue(p, lds); }
    if constexpr (PH == PH_NORM1) { phase_norm1(p, l); }
    if constexpr (PH == PH_WIN) {
        EpiStoreBf16 E{(bf16_t*)(ws + O_P), NP}; GemmDesc g{(const bf16_t*)(ws + O_H), DM, nullptr, DM, DM};
#if WIN8
        const bf16_t* Bt = (const bf16_t*)(ws + O_WIN + (size_t)l * NP * DM);
        if (!last) { DenseSched S{Bt, DM / 2, NTOK / 256, 16, 0, 0}; GEMM_PHASE8(g, S, E, 127, 119); }
        else { DenseSched S{Bt, DM / 2, NLAT / 256, 16, 0, 0}; GEMM_PHASE8(g, S, E, 127, 119); DenseSched S2{Bt, DM / 2, NCTX / 256, 4, NLAT, 12}; GEMM_PHASE8(g, S2, E, 127, 119); }
#else
        const bf16_t* Bt = (const bf16_t*)(ws + O_WIN) + (size_t)l * NP * DM;
        if (!last) { DenseSched S{Bt, DM, NTOK / 256, 16, 0, 0}; GEMM_PHASE(g, S, E); }
        else { DenseSched S{Bt, DM, NLAT / 256, 16, 0, 0}; GEMM_PHASE(g, S, E); DenseSched S2{Bt, DM, NCTX / 256, 4, NLAT, 12}; GEMM_PHASE_R(g, S2, E, 4, 0); }
#endif
    }
    if constexpr (PH == PH_POSTA) {
#ifndef DBG_SKIP
#define DBG_SKIP 0
#endif
#ifndef PA_GEMM_REP
#define PA_GEMM_REP 1
#endif
        for (int rep_ = 0; rep_ < PA_GEMM_REP; ++rep_) {
        if (!(DBG_SKIP & 1)) { GemmDesc g{(const bf16_t*)(ws + O_P) + C_CQ, NP, nullptr, 768, 768}; EpiStoreBf16 E{(bf16_t*)(ws + O_QRAW), NQP};
          DenseSched S{(const bf16_t*)(ws + O_WUQ) + (size_t)l * NQP * 768, 768, (last ? NLAT : NTOK) / 256, 5, 0, 0}; GEMM_PHASE(g, S, E); }
        if (!(DBG_SKIP & 2)) { GemmDesc g{(const bf16_t*)(ws + O_P) + C_CKV, NP, nullptr, 256, 256}; EpiStoreBf16 E{(bf16_t*)(ws + O_KVRAW), 1536};
          DenseSched S{(const bf16_t*)(ws + O_WUKV) + (size_t)l * 1536 * 256, 256, NTOK / 256, 6, 0, 0}; GEMM_PHASE_R(g, S, E, 0, (last ? NLAT : NTOK) / 256 * 5 - 256); }
        }
        const int ntt = (last ? NLAT : NTOK) / 64;
        if (!(DBG_SKIP & 4)) for (int t = blockIdx.x; t < ntt * 4; t += gridDim.x) hy_prep_task(p, l, (t >> 2) * 64, (t & 3) * 256, (LAS float*)lds);
        if (!(DBG_SKIP & 8)) for (int row = gw; row < NTOK; row += GW) gqa_post_row(p, l, row, lane);
    }
    if constexpr (PH == PH_POSTB) { if (l == 0) hss_tasks(p); for (int row = gw; row < NTOK; row += GW) mla_post_row(p, l, row, lane); }
    if constexpr (PH == PH_MIXER) { phase_mixer(p, l, lds); }
    if constexpr (PH == PH_HYFIN) { const int ntt = (last ? NLAT : NTOK) / 64; for (int t = blockIdx.x; t < ntt * 8; t += gridDim.x) hy_fin_task(p, l, (t >> 3) * 64, (t & 7) * 64, (LAS float*)lds); }
    if constexpr (PH == PH_WOUT) {
        GemmDesc g{(const bf16_t*)(ws + O_MIX), DM, nullptr, DM, DM}; EpiStoreBf16 E{(bf16_t*)(ws + O_OUT), DM};
#if WOUT8
        DenseSched S{(const bf16_t*)(ws + O_WOUT + (size_t)l * DM * DM), DM / 2, (last ? NLAT : NTOK) / 256, 8, 0, 0}; GEMM_PHASE8(g, S, E, 127, 115);
#elif WOUT8G
        { GemmDesc g8{(const bf16_t*)(ws + O_QM), DM, nullptr, DM, DM}; DenseSched S{(const bf16_t*)(ws + O_QG), DM / 2, (last ? NLAT : NTOK) / 256, 8, 0, 0}; GEMM_PHASE8(g8, S, E, 123, 119); }
#else
        DenseSched S{(const bf16_t*)(ws + O_WOUT) + (size_t)l * DM * DM, DM, (last ? NLAT : NTOK) / 256, 8, 0, 0}; GEMM_PHASE_R(g, S, E, 4, 0);
#endif
    }
    if constexpr (PH == PH_ROUTE) { phase_route(p, l, lds); }
    if constexpr (PH == PH_PLACE) { phase_place(p, l, lds);
#if CVT_BG
        { __syncthreads(); while ((BG_TWO & 2) ? cvt_bg_step2(lds, l * CVT_EXP + CVT_GU) : cvt_bg_step(lds, l * CVT_EXP + CVT_GU, (BG_DRAIN_REP & 3))) { } }
#endif
    }
    if constexpr (PH == PH_GEMM1 || PH == PH_GEMM2) {
        LAS int* te = (LAS int*)(lds + LDS_TILES); LAS int* ts = te + MAXTILES; LAS int* misc = (LAS int*)(lds + LDS_MISC) + 16;
        const int nt = moe_build_tiles((const unsigned*)(ws + O_CTL) + CW_CNT + l * 64, (last ? NLAT : NTOK) / 256, te, ts, misc);
#if MOE_FP8
        if constexpr (PH == PH_GEMM1) {
            GemmDesc g{(const bf16_t*)(ws + O_H), DM, (const int*)(ws + O_STOK), DM, DM}; EpiSwiGLU8 E{ws + O_HID};
            MoeSched S{te, ts, nt, 4, (const bf16_t*)(ws + O_EGU + (size_t)(CVT_BG ? l : 0) * 65 * 1024 * 2048), (size_t)1024 * 1024, DM / 2, 128}; GEMM_PHASE8_R(g, S, E, 127, 119, 2);
        } else {
            GemmDesc g{(const bf16_t*)(ws + O_HID), EH, nullptr, EH, EH};
            MoeSched S{te, ts, nt, 8, (const bf16_t*)(ws + O_ED + (size_t)(CVT_BG ? l : 0) * 65 * 2048 * 512), (size_t)2048 * 256, EH / 2, 256};
#if DOUT_FP8
            static_assert(DOUT8_SCALE == 8.0f, "the output scale is folded into the weight block scale below (119 + 3)");
            EpiStoreFp8 E{ws + O_DOUT, DM, 1.0f}; GEMM_PHASE8_R(g, S, E, 124, 122, 6);
#else
            EpiStoreBf16 E{(bf16_t*)(ws + O_DOUT), DM}; GEMM_PHASE8(g, S, E, 124, 119);
#endif
        }
#else
        if constexpr (PH == PH_GEMM1) {
            GemmDesc g{(const bf16_t*)(ws + O_H), DM, (const int*)(ws + O_STOK), DM, DM}; EpiSwiGLU E{(bf16_t*)(ws + O_HID)};
            MoeSched S{te, ts, nt, 4, (const bf16_t*)(ws + O_EGU), (size_t)1024 * 2048, DM, 128}; GEMM_PHASE(g, S, E);
        } else {
            GemmDesc g{(const bf16_t*)(ws + O_HID), EH, nullptr, EH, EH}; EpiStoreBf16 E{(bf16_t*)(ws + O_DOUT), DM};
            MoeSched S{te, ts, nt, 8, (const bf16_t*)(ws + O_ED), (size_t)2048 * 512, EH, 256}; GEMM_PHASE(g, S, E);
        }
#endif
        __syncthreads();
#if CVT_BG
        if constexpr (PH == PH_GEMM1) { while ((BG_TWO & 2) ? cvt_bg_step2(lds, (l + 1) * CVT_EXP) : cvt_bg_step(lds, (l + 1) * CVT_EXP, (BG_DRAIN_REP >> 2) ? (BG_DRAIN_REP >> 2) : 1)) { } }
#endif
    }
    if constexpr (PH == PH_FINAL) {
        phase_final(p, l);
#if CVT_BG
#else
        if (!last) cvt_exp_all(p, l + 1);
#endif
    }
}

#ifndef MEGA
#define MEGA 0
#endif


#if MEGA
__global__ void __launch_bounds__(NTHREADS, 2) mega_fwd(Params p) {
    extern __shared__ __attribute__((aligned(16))) unsigned char lds_raw[];
    LAS unsigned char* lds = (LAS unsigned char*)lds_raw;
    volatile LAS unsigned* xbw = (volatile LAS unsigned*)(lds + LDS_MISC);
    if (otid() == 0) { xbw[0] = 0u; xbw[1] = 0u; }
    if (otid() < 8) ((volatile LAS int*)(lds + LDS_BGCUR))[otid()] = 0;
    __syncthreads();
    { const XcdBarrier b0 = xcd_barrier_post((unsigned*)(p.ws + O_CTL) + CW_BAR, xbw); if (otid() == 0) xbw[2] = b0.x; }
    __syncthreads();
#define GRID_BAR() do { XcdBarrier b_; b_.bar = (unsigned*)(p.ws + O_CTL) + CW_BAR; b_.x = xbw[2]; b_.st = xbw; xcd_barrier(b_); } while (0)
#if CVT_BG
#define GRID_BARW(l) do { XcdBarrier b_; b_.bar = (unsigned*)(p.ws + O_CTL) + CW_BAR; b_.x = xbw[2]; b_.st = xbw; if (l) xcd_barrier_work(b_, lds); else xcd_barrier(b_); } while (0)
#else
#define GRID_BARW(l) GRID_BAR()
#endif
#ifndef DBL_MASK
#define DBL_MASK 0
#endif
#define RUNP(PH, l) do { run_phase<PH>(p, l, lds); GRID_BARW((l) == 0 || PH < PH_GEMM1); if ((DBL_MASK >> PH) & 1) { run_phase<PH>(p, l, lds); GRID_BAR(); } } while (0)
#ifndef DLY_MASK
#define DLY_MASK 0
#endif
#define RUND(PH, l) do { if ((DLY_MASK >> PH) & 1) { const unsigned long long t0_ = wall_clock64(); run_phase<PH>(p, l, lds); const unsigned long long t1_ = wall_clock64(); while (wall_clock64() < t1_ + (t1_ - t0_)) __builtin_amdgcn_s_sleep(8); } else run_phase<PH>(p, l, lds); } while (0)
    RUNP(PH_PRO, 0);
#if WOUT8G && !WOUT8
#define MIX8CVT(l) do { const size_t n8_ = (size_t)NTOK * DM / 8; const bf16_t* src_ = (const bf16_t*)(p.ws + O_MIX); unsigned char* dst_ = p.ws + O_QM; \
        for (size_t i_ = (size_t)blockIdx.x * NTHREADS + otid(); i_ < n8_; i_ += (size_t)gridDim.x * NTHREADS) { float x_[8]; unpack8(*(const u32x4*)(src_ + i_ * 8), x_); u32x2 w_; w_.x = pk4_fp8(x_[0] * 16.f, x_[1] * 16.f, x_[2] * 16.f, x_[3] * 16.f); w_.y = pk4_fp8(x_[4] * 16.f, x_[5] * 16.f, x_[6] * 16.f, x_[7] * 16.f); *(u32x2*)(dst_ + i_ * 8) = w_; } \
        { const size_t nw_ = (size_t)DM * DM / 8; const bf16_t* ws_ = (const bf16_t*)(p.ws + O_WOUT) + (size_t)(l) * DM * DM; unsigned char* wd_ = p.ws + O_QG; \
          for (size_t i_ = (size_t)blockIdx.x * NTHREADS + otid(); i_ < nw_; i_ += (size_t)gridDim.x * NTHREADS) { float x_[8]; unpack8(*(const u32x4*)(ws_ + i_ * 8), x_); u32x2 w_; w_.x = pk4_fp8(x_[0] * 256.f, x_[1] * 256.f, x_[2] * 256.f, x_[3] * 256.f); w_.y = pk4_fp8(x_[4] * 256.f, x_[5] * 256.f, x_[6] * 256.f, x_[7] * 256.f); *(u32x2*)(wd_ + i_ * 8) = w_; } } \
        GRID_BAR(); } while (0)
#else
#define MIX8CVT(l) do { } while (0)
#endif
#define LAYER(l) do { if ((l) == 0) RUNP(PH_NORM1, l); \
        RUNP(PH_WIN, l); RUNP(PH_POSTA, l); RUNP(PH_POSTB, l); RUNP(PH_MIXER, l); RUNP(PH_HYFIN, l); MIX8CVT(l); RUNP(PH_WOUT, l); \
        RUND(PH_ROUTE, l); GRID_BARW(1); RUND(PH_PLACE, l); GRID_BARW(1); RUNP(PH_GEMM1, l); RUNP(PH_GEMM2, l); RUND(PH_FINAL, l); \
        if ((l) + 1 < NLAYER) GRID_BARW(1); } while (0)
    LAYER(0);
    LAYER(1);
}
#endif

#if !MEGA
template <int PH> __global__ void __launch_bounds__(NTHREADS, 2) k_phase(Params p) {
    extern __shared__ __attribute__((aligned(16))) unsigned char lds_raw[];
    run_phase<PH>(p, p.layer, (LAS unsigned char*)lds_raw);
}
template <int PH> static bool prep_phase() { return hipFuncSetAttribute((const void*)k_phase<PH>, hipFuncAttributeMaxDynamicSharedMemorySize, LDS_BYTES) == hipSuccess; }
static int g_nlaunch = 0;
#ifndef DBG_STOP
#define DBG_STOP 1000
#define DBG_DUMP 0
#else
#define DBG_DUMP 1
#ifndef DBG_SET
#define DBG_SET 31
#endif
#endif
template <int PH> static void launch_phase(Params p, int l, hipStream_t st) { if (g_nlaunch++ >= DBG_STOP) return; p.layer = l; hipLaunchKernelGGL(k_phase<PH>, dim3(256), dim3(NTHREADS), LDS_BYTES, st, p); }
#endif


#if DBG_DUMP
__device__ __forceinline__ float san(float x) { return (x == x && fabsf(x) < 1e6f) ? x : 1.0f; }
__global__ void __launch_bounds__(256) k_dump(Params p) {
    const size_t N = (size_t)NLAT * DM;
    const bf16_t* b1 = (const bf16_t*)(p.ws + O_WIN); const size_t n1 = (O_X - O_WIN) / 2;
    const bf16_t* b2 = (const bf16_t*)(p.ws + O_H); const size_t n2 = (size_t)NTOK * DM;
    const bf16_t* b3 = (const bf16_t*)(p.ws + O_A); const size_t n3 = (O_AEND - O_A) / 2;
    const float* f1 = (const float*)(p.ws + O_MOD); const size_t m1 = (O_WIN - O_MOD) / 4;
    const float* f2 = (const float*)(p.ws + O_X); const size_t m2 = (size_t)NTOK * DM;
    for (size_t i = (size_t)blockIdx.x * 256 + otid(); i < N; i += (size_t)gridDim.x * 256) {
        float v = 0.f;
        if (DBG_SET & 1) for (size_t e = i; e < n1; e += N) v += san(bf2f(b1[e]));
        if (DBG_SET & 2) for (size_t e = i; e < n2; e += N) v += san(bf2f(b2[e]));
        if (DBG_SET & 4) for (size_t e = i; e < n3; e += N) v += san(bf2f(b3[e]));
        if (DBG_SET & 8) for (size_t e = i; e < m1; e += N) v += san(f1[e]);
        if (DBG_SET & 16) for (size_t e = i; e < m2; e += N) v += san(f2[e]);
        if (DBG_SET & 32) v += san(bf2f(((const bf16_t*)(p.ws + O_WUKV))[i % ((size_t)2 * 1536 * 256)]));
        if (DBG_SET & 64) { const size_t r = i % NTOK, c = (i / NTOK) % 256; v += san(bf2f(((const bf16_t*)(p.ws + O_P))[r * NP + C_CKV + c])); }
        if (DBG_SET & 128) v += san(bf2f(((const bf16_t*)(p.ws + O_KVRAW))[i % ((size_t)NTOK * 1536)]));
        p.out[i] = v;
    }
}
#endif
static int g_grid = 0;
extern "C" void kernel_launch(void* const* d_in, const int* in_sizes, int n_in, void* d_out, int out_size, void* d_ws, size_t ws_size, hipStream_t stream) {
    static int ok = 0;
    if (ok == 0) {
        if (n_in != 31 || in_sizes[0] != NLAT * DM || out_size != NLAT * DM || ws_size < WS_END) { fprintf(stderr, "kernel_launch: unexpected shapes (n_in %d, ws %zu, need %zu)\n", n_in, ws_size, (size_t)WS_END); ok = -1; return; }
        bool good = true;
#if !MEGA
        good = good && prep_phase<0>() && prep_phase<1>() && prep_phase<2>() && prep_phase<3>() && prep_phase<4>() && prep_phase<5>() && prep_phase<6>() && prep_phase<7>() && prep_phase<8>() && prep_phase<9>() && prep_phase<10>() && prep_phase<11>() && prep_phase<12>();
#endif
#if MEGA
        good = hipFuncSetAttribute((const void*)mega_fwd, hipFuncAttributeMaxDynamicSharedMemorySize, LDS_BYTES) == hipSuccess;
        int dev = 0, cus = 0, per_cu = 0;
        if (hipGetDevice(&dev) != hipSuccess || hipDeviceGetAttribute(&cus, hipDeviceAttributeMultiprocessorCount, dev) != hipSuccess) good = false;
        if (good && (hipOccupancyMaxActiveBlocksPerMultiprocessor(&per_cu, (const void*)mega_fwd, NTHREADS, LDS_BYTES) != hipSuccess || per_cu < 1)) { fprintf(stderr, "kernel_launch: occupancy query says %d workgroups per CU\n", per_cu); good = false; }
        g_grid = cus;
#endif
        if (!good) { fprintf(stderr, "kernel_launch: set-up failed\n"); ok = -1; return; }
        ok = 1;
    }
    if (ok < 0) return;
    Params p{}; for (int i = 0; i < 31; ++i) p.in[i] = (const float*)d_in[i]; p.out = (float*)d_out; p.ws = (unsigned char*)d_ws; p.layer = 0; p.pad = 0;
#ifdef POISON_WS
    hipMemsetAsync((char*)d_ws, 0xFF, WS_END, stream);
#endif
    hipMemsetAsync((char*)d_ws + O_CTL, 0, ZERO_BYTES, stream);
#if !MEGA
    g_nlaunch = 0;
    launch_phase<PH_PRO>(p, 0, stream);
    for (int l = 0; l < NLAYER; ++l) {
        if (l == 0) launch_phase<PH_NORM1>(p, l, stream);
        launch_phase<PH_WIN>(p, l, stream); launch_phase<PH_POSTA>(p, l, stream); launch_phase<PH_POSTB>(p, l, stream); launch_phase<PH_MIXER>(p, l, stream);
        launch_phase<PH_HYFIN>(p, l, stream); launch_phase<PH_WOUT>(p, l, stream); launch_phase<PH_ROUTE>(p, l, stream); launch_phase<PH_PLACE>(p, l, stream);
        launch_phase<PH_GEMM1>(p, l, stream); launch_phase<PH_GEMM2>(p, l, stream); launch_phase<PH_FINAL>(p, l, stream);
    }
#if DBG_DUMP
    hipLaunchKernelGGL(k_dump, dim3(2048), dim3(256), 0, stream, p);
#endif
#else
    hipLaunchKernelGGL(mega_fwd, dim3(g_grid), dim3(NTHREADS), LDS_BYTES, stream, p);
#endif
}
```
